# Optimizing an MI355X kernel written in HIP

```python
import jax, jax.numpy as jnp
from jax import lax
import numpy as np

D_MODEL = 1024
BATCH = 16
SEQ = 2048
DEPTH = 2

GRID_W = 64
CTX_LEN = 256
HEAD_DIM = 64
N_HEADS_NA = 8
D_NA = N_HEADS_NA * HEAD_DIM
N_HEADS_RW = 8
D_RW = N_HEADS_RW * HEAD_DIM
D_MIX = D_NA + D_RW
WIN_ROWS = 8
WIN_COLS = 16
N_DIR = 2
DECAY_LORA = 32
ICLR_LORA = 32
GATE_LORA = 96
D_RW_IN = 3 * D_RW + N_DIR * (DECAY_LORA + ICLR_LORA) + GATE_LORA
RW_SPLITS = (D_RW, 2 * D_RW, 3 * D_RW, 3 * D_RW + N_DIR * DECAY_LORA, 3 * D_RW + N_DIR * (DECAY_LORA + ICLR_LORA))
D_IN = 3 * D_NA + D_RW_IN
N_EXPERTS = 32
N_GROUPS = 8
EXPERTS_PER_GROUP = N_EXPERTS // N_GROUPS
TOP_K = 2
D_EXPERT = 512
MOE_BLOCK = 128
ROPE_BASE = 10000.0
LN_EPS = 1e-6
GN_EPS = 64e-5
ALPHA = (2 * DEPTH) ** 0.25
BETA = (8 * DEPTH) ** -0.25

kernel_name = 'hybrid_na_rwkv7_moe_diffusion_trunk'


def layer_norm(z, g, b):
    zf = z.astype(jnp.float32)
    mu = jnp.mean(zf, -1, keepdims=True)
    var = jnp.mean(jnp.square(zf - mu), -1, keepdims=True)
    return ((zf - mu) * lax.rsqrt(var + LN_EPS) * g + b).astype(z.dtype)


def modulate(z, shift, scale):
    return z * (1 + scale) + shift


def axial_rope_tables(seq_len):
    t = jnp.arange(seq_len)
    row = (t // GRID_W).astype(jnp.float32)
    col = (t % GRID_W).astype(jnp.float32)
    n_freq = HEAD_DIM // 4
    inv = ROPE_BASE ** (-jnp.arange(n_freq, dtype=jnp.float32) / n_freq)
    ar = row[:, None] * inv
    ac = col[:, None] * inv
    ang = jnp.concatenate([ar, ar, ac, ac], -1)
    return jnp.cos(ang)[:, None, :], jnp.sin(ang)[:, None, :]


def apply_axial_rope(z, cos, sin):
    a, b, cc, d = jnp.split(z, 4, axis=-1)
    rot = jnp.concatenate([-b, a, -d, cc], -1)
    return z * cos + rot * sin


def token_shift(z, mu_prev, mu_next):
    prev = jnp.pad(z[:, :-1], ((0, 0), (1, 0), (0, 0)))
    nxt = jnp.pad(z[:, 1:], ((0, 0), (0, 1), (0, 0)))
    return z + mu_prev * (prev - z) + mu_next * (nxt - z)


def wkv7_scan(s0, r, decay, k, v, kk, a, reverse):
    def step(s, inp):
        r_t, w_t, k_t, v_t, kk_t, a_t = inp
        s_kk = jnp.einsum('bhvk,bhk->bhv', s, kk_t)
        s = s * w_t[:, :, None, :] - s_kk[..., None] * (kk_t * a_t)[:, :, None, :] + v_t[..., None] * k_t[:, :, None, :]
        return s, jnp.einsum('bhvk,bhk->bhv', s, r_t)
    xs = tuple(jnp.moveaxis(z, 1, 0) for z in (r, decay, k, v, kk, a))
    s_fin, ys = lax.scan(step, s0, xs, reverse=reverse)
    return jnp.moveaxis(ys, 0, 1), s_fin


def rwkv7_bidir(p, rope, init_states, mu_prev, mu_next, w0, w2, a0, a2, g2, k_k, k_a, r_k, gn_g, gn_b):
    B, T = p.shape[0], p.shape[1]
    H, N = N_HEADS_RW, HEAD_DIM
    z = token_shift(p.astype(jnp.float32), mu_prev, mu_next)
    r, k, v, lw, la, lg = jnp.split(z, RW_SPLITS, axis=-1)
    r = r.reshape(B, T, H, N)
    k = k.reshape(B, T, H, N)
    v = v.reshape(B, T, H, N)
    if rope is not None:
        r = apply_axial_rope(r, rope[0], rope[1])
        k = apply_axial_rope(k, rope[0], rope[1])
    kk = k * k_k.reshape(H, N)
    kk = kk / jnp.maximum(jnp.sqrt(jnp.sum(kk * kk, -1, keepdims=True)), 1e-12)
    lw = lw.reshape(B, T, N_DIR, DECAY_LORA)
    la = la.reshape(B, T, N_DIR, ICLR_LORA)
    w_log = -jax.nn.softplus(-(w0 + jnp.einsum('btdr,drc->btdc', jnp.tanh(lw), w2))) - 0.5
    decay = jnp.exp(-jnp.exp(w_log)).reshape(B, T, N_DIR, H, N)
    a = jax.nn.sigmoid(a0 + jnp.einsum('btdr,drc->btdc', la, a2)).reshape(B, T, N_DIR, H, N)
    k_dir = k[:, :, None] * (1 + (a - 1) * k_a.reshape(H, N))
    g = jax.nn.sigmoid(lg) @ g2
    outs = []
    states = []
    for d in range(N_DIR):
        s0 = jnp.zeros((B, H, N, N), jnp.float32) if init_states is None else init_states[d]
        y_d, s_d = wkv7_scan(s0, r, decay[:, :, d], k_dir[:, :, d], v, kk, a[:, :, d], reverse=(d == 1))
        outs.append(y_d)
        states.append(s_d)
    y = outs[0] + outs[1]
    mu = jnp.mean(y, -1, keepdims=True)
    var = jnp.mean(jnp.square(y - mu), -1, keepdims=True)
    y = (y - mu) * lax.rsqrt(var + GN_EPS) * gn_g.reshape(H, N) + gn_b.reshape(H, N)
    bonus = jnp.sum(r[:, :, None] * k_dir * r_k, -1, keepdims=True) * v[:, :, None]
    y = y + jnp.sum(bonus, axis=2)
    out = y.reshape(B, T, D_RW) * g
    return out.astype(p.dtype), (states[0], states[1])


def neighbourhood_attention(q, k, v, k_ctx, v_ctx, rpb):
    B, S = q.shape[0], q.shape[1]
    rows = S // GRID_W
    kr = min(WIN_ROWS, rows)

    def grid(z):
        return z.reshape(B, rows, GRID_W, N_HEADS_NA, HEAD_DIM).transpose(1, 0, 3, 2, 4)

    qg, kg, vg = grid(q), grid(k), grid(v)
    cols = jnp.arange(GRID_W)
    col_start = jnp.clip(cols - WIN_COLS // 2, 0, GRID_W - WIN_COLS)
    col_idx = col_start[:, None] + jnp.arange(WIN_COLS)[None, :]
    col_off = col_idx - cols[:, None] + (WIN_COLS - 1)
    rpb_c = rpb[:, :, col_off]

    def one_row(i):
        rs = jnp.clip(i - kr // 2, 0, rows - kr)
        q_i = qg[i]
        k_win = lax.dynamic_slice_in_dim(kg, rs, kr, axis=0)[:, :, :, col_idx]
        v_win = lax.dynamic_slice_in_dim(vg, rs, kr, axis=0)[:, :, :, col_idx]
        row_off = rs + jnp.arange(kr) - i + (WIN_ROWS - 1)
        bias = rpb_c[:, row_off].transpose(0, 2, 1, 3)
        s_loc = jnp.einsum('bhqd,rbhqcd->bhqrc', q_i, k_win).astype(jnp.float32) + bias.astype(jnp.float32)
        s_ctx = jnp.einsum('bhqd,bnhd->bhqn', q_i, k_ctx).astype(jnp.float32)
        s = jnp.concatenate([s_loc.reshape(B, N_HEADS_NA, GRID_W, kr * WIN_COLS), s_ctx], -1)
        pr = jax.nn.softmax(s, axis=-1).astype(v.dtype)
        p_loc = pr[..., :kr * WIN_COLS].reshape(B, N_HEADS_NA, GRID_W, kr, WIN_COLS)
        p_ctx = pr[..., kr * WIN_COLS:]
        return jnp.einsum('bhqrc,rbhqcd->bhqd', p_loc, v_win) + jnp.einsum('bhqn,bnhd->bhqd', p_ctx, v_ctx)

    out = lax.map(one_row, jnp.arange(rows))
    return out.transpose(1, 0, 3, 2, 4).reshape(B, S, D_NA)


def context_attention(q, k, v):
    B, C = q.shape[0], q.shape[1]
    s = jnp.einsum('bqhd,bkhd->bhqk', q, k).astype(jnp.float32)
    pr = jax.nn.softmax(s, axis=-1).astype(v.dtype)
    return jnp.einsum('bhqk,bkhd->bqhd', pr, v).reshape(B, C, D_NA)


def moe_grouped_top2(h, router_w, router_bias, w1, w3, w2):
    N, D = h.shape
    scores = jax.nn.sigmoid(jnp.dot(h, router_w).astype(jnp.float32))
    sel = (scores + router_bias.astype(jnp.float32)).reshape(N, N_GROUPS, EXPERTS_PER_GROUP)
    group_score = jnp.sum(lax.top_k(sel, TOP_K)[0], -1)
    g_idx = jnp.argmax(group_score, -1)
    sel_in_group = jnp.take_along_axis(sel, g_idx[:, None, None], axis=1)[:, 0]
    _, local = lax.top_k(sel_in_group, TOP_K)
    e_idx = (g_idx[:, None] * EXPERTS_PER_GROUP + local).astype(jnp.int32)
    gate = jnp.take_along_axis(scores, e_idx, -1)
    gate = gate / jnp.sum(gate, -1, keepdims=True)
    flat_e = e_idx.reshape(-1)
    nk = flat_e.shape[0]
    order = jnp.argsort(flat_e)
    sorted_e = flat_e[order]
    counts = jnp.bincount(flat_e, length=N_EXPERTS)
    padded = (counts + MOE_BLOCK - 1) // MOE_BLOCK * MOE_BLOCK
    pad_end = jnp.cumsum(padded)
    pad_start = pad_end - padded
    seg_start = jnp.cumsum(counts) - counts
    dest_sorted = (pad_start[sorted_e] + jnp.arange(nk) - seg_start[sorted_e]).astype(jnp.int32)
    dest = jnp.zeros((nk,), jnp.int32).at[order].set(dest_sorted)
    n_blocks = -(-nk // MOE_BLOCK) + N_EXPERTS
    buf_len = n_blocks * MOE_BLOCK
    src_tok = jnp.full((buf_len,), N, jnp.int32).at[dest].set(jnp.arange(nk, dtype=jnp.int32) // TOP_K)
    h_pad = jnp.concatenate([h, jnp.zeros((1, D), h.dtype)], 0)
    xb = h_pad[src_tok].reshape(n_blocks, MOE_BLOCK, D)
    block_expert = jnp.minimum(jnp.searchsorted(pad_end, jnp.arange(n_blocks) * MOE_BLOCK, side='right'), N_EXPERTS - 1)

    def expert_block(args):
        xblk, e = args
        return (jax.nn.silu(xblk @ w1[e]) * (xblk @ w3[e])) @ w2[e]

    yb = lax.map(expert_block, (xb, block_expert)).reshape(buf_len, D)
    y_assign = yb[dest].reshape(N, TOP_K, D)
    return jnp.einsum('nk,nkd->nd', gate.astype(h.dtype), y_assign)


def setup_inputs(seed: int = 0) -> dict:
    key = jax.random.key(seed)
    ks = jax.random.split(key, 32)
    f32 = jnp.float32
    L = DEPTH

    def nrm(k, shape, s):
        return jax.random.normal(k, shape, f32) * s

    return {
        'x': nrm(ks[0], (BATCH, SEQ, D_MODEL), 1.0),
        'c': nrm(ks[1], (BATCH, D_MODEL), 1.0),
        'ctx': nrm(ks[2], (BATCH, CTX_LEN, D_MODEL), 1.0),
        'c_ctx': nrm(ks[3], (D_MODEL,), 1.0),
        'ada_w': nrm(ks[4], (L, D_MODEL, 6 * D_MODEL), 0.5 * D_MODEL ** -0.5),
        'ada_b': nrm(ks[5], (L, 6 * D_MODEL), 0.02),
        'w_in': nrm(ks[6], (L, D_MODEL, D_IN), D_MODEL ** -0.5),
        'na_rpb': nrm(ks[7], (L, N_HEADS_NA, 2 * WIN_ROWS - 1, 2 * WIN_COLS - 1), 0.1),
        'rw_mu_prev': jax.random.uniform(ks[8], (L, D_RW_IN), f32, 0.0, 0.5),
        'rw_mu_next': jax.random.uniform(ks[9], (L, D_RW_IN), f32, 0.0, 0.5),
        'rw_w0': jax.random.uniform(ks[10], (L, N_DIR, D_RW), f32, -5.0, 0.0),
        'rw_w2': nrm(ks[11], (L, N_DIR, DECAY_LORA, D_RW), 0.1 * DECAY_LORA ** -0.5),
        'rw_a0': nrm(ks[12], (L, N_DIR, D_RW), 0.1),
        'rw_a2': nrm(ks[13], (L, N_DIR, ICLR_LORA, D_RW), 0.5 * ICLR_LORA ** -0.5),
        'rw_g2': nrm(ks[14], (L, GATE_LORA, D_RW), GATE_LORA ** -0.5),
        'rw_k_k': 0.85 + nrm(ks[15], (L, D_RW), 0.05),
        'rw_k_a': 1.0 + nrm(ks[16], (L, D_RW), 0.05),
        'rw_r_k': nrm(ks[17], (L, N_HEADS_RW, HEAD_DIM), 0.1),
        'rw_gn_g': 1.0 + nrm(ks[18], (L, D_RW), 0.05),
        'rw_gn_b': nrm(ks[19], (L, D_RW), 0.02),
        'w_out': nrm(ks[20], (L, D_MIX, D_MODEL), BETA * D_MIX ** -0.5),
        'ln1_g': 1.0 + nrm(ks[21], (L, D_MODEL), 0.05),
        'ln1_b': nrm(ks[22], (L, D_MODEL), 0.02),
        'ln2_g': 1.0 + nrm(ks[23], (L, D_MODEL), 0.05),
        'ln2_b': nrm(ks[24], (L, D_MODEL), 0.02),
        'router_w': nrm(ks[25], (D_MODEL, N_EXPERTS), D_MODEL ** -0.5),
        'router_bias': nrm(ks[26], (N_EXPERTS,), 0.01),
        'exp_w1': nrm(ks[27], (L, N_EXPERTS, D_MODEL, D_EXPERT), D_MODEL ** -0.5),
        'exp_w3': nrm(ks[28], (L, N_EXPERTS, D_MODEL, D_EXPERT), D_MODEL ** -0.5),
        'exp_w2': nrm(ks[29], (L, N_EXPERTS, D_EXPERT, D_MODEL), BETA * D_EXPERT ** -0.5),
    }


def reference(x, c, ctx, c_ctx, ada_w, ada_b, w_in, na_rpb, rw_mu_prev, rw_mu_next, rw_w0, rw_w2, rw_a0, rw_a2, rw_g2, rw_k_k, rw_k_a, rw_r_k, rw_gn_g, rw_gn_b, w_out, ln1_g, ln1_b, ln2_g, ln2_b, router_w, router_bias, exp_w1, exp_w3, exp_w2):
    B, S, D = x.shape
    C = ctx.shape[1]
    rope = axial_rope_tables(S)
    q_scale = HEAD_DIM ** -0.5
    for l in range(DEPTH):
        last = l == DEPTH - 1
        mod_x = jnp.split((jax.nn.silu(c) @ ada_w[l] + ada_b[l])[:, None, :], 6, axis=-1)
        mod_c = jnp.split((jax.nn.silu(c_ctx) @ ada_w[l] + ada_b[l])[None, None, :], 6, axis=-1)
        px = modulate(x, mod_x[0], mod_x[1]) @ w_in[l]
        pc = modulate(ctx, mod_c[0], mod_c[1]) @ w_in[l]
        qx, kx, vx = (px[..., i * D_NA:(i + 1) * D_NA].reshape(B, S, N_HEADS_NA, HEAD_DIM) for i in range(3))
        qc, kc, vc = (pc[..., i * D_NA:(i + 1) * D_NA].reshape(B, C, N_HEADS_NA, HEAD_DIM) for i in range(3))
        rw_args = dict(mu_prev=rw_mu_prev[l], mu_next=rw_mu_next[l], w0=rw_w0[l], w2=rw_w2[l], a0=rw_a0[l], a2=rw_a2[l], g2=rw_g2[l], k_k=rw_k_k[l], k_a=rw_k_a[l], r_k=rw_r_k[l], gn_g=rw_gn_g[l], gn_b=rw_gn_b[l])
        rw_c, ctx_states = rwkv7_bidir(pc[..., 3 * D_NA:], None, None, **rw_args)
        rw_x, _ = rwkv7_bidir(px[..., 3 * D_NA:], rope, ctx_states, **rw_args)
        na_x = neighbourhood_attention(qx * q_scale, kx, vx, kc, vc, na_rpb[l])
        o_x = jnp.concatenate([na_x, rw_x], -1) @ w_out[l]
        x = layer_norm(ALPHA * x + mod_x[2] * o_x, ln1_g[l], ln1_b[l])
        hx = modulate(x, mod_x[3], mod_x[4])
        if last:
            y_x = moe_grouped_top2(hx.reshape(B * S, D), router_w, router_bias, exp_w1[l], exp_w3[l], exp_w2[l]).reshape(B, S, D)
        else:
            na_c = context_attention(qc * q_scale, kc, vc)
            o_c = jnp.concatenate([na_c, rw_c], -1) @ w_out[l]
            ctx = layer_norm(ALPHA * ctx + mod_c[2] * o_c, ln1_g[l], ln1_b[l])
            hc = modulate(ctx, mod_c[3], mod_c[4])
            y = moe_grouped_top2(jnp.concatenate([hx.reshape(B * S, D), hc.reshape(B * C, D)], 0), router_w, router_bias, exp_w1[l], exp_w3[l], exp_w2[l])
            y_x = y[:B * S].reshape(B, S, D)
            y_c = y[B * S:].reshape(B, C, D)
            ctx = layer_norm(ALPHA * ctx + mod_c[5] * y_c, ln2_g[l], ln2_b[l])
        x = layer_norm(ALPHA * x + mod_x[5] * y_x, ln2_g[l], ln2_b[l])
    return x
```

```cpp
#include <hip/hip_runtime.h>
#include <cstdio>
#include <cstdint>

constexpr int DM = 1024, NB = 16, SEQ = 2048, CTXL = 256, NTX = NB * SEQ, NTC = NB * CTXL, NTOK = NTX + NTC;
constexpr int DIN = 3296, DINP = 3328, RWOFF = 1536, NHEAD = 8, HD = 64;
constexpr int NEXP = 32, DEXP = 512, LISTCAP = 2 * NTOK;
constexpr int MAXSLOT = 81920;
constexpr float ALPHA = 1.41421356237309515f, LN_EPS = 1e-6f, GN_EPS = 64e-5f;

constexpr size_t MiB = 1u << 20;
constexpr size_t WS_CTL = 0, CTL_ZERO_BYTES = 1 * MiB;
constexpr size_t WS_MODS = 1 * MiB;
constexpr size_t WS_ROPE = 2 * MiB;
constexpr size_t WS_WINT = 3 * MiB;
constexpr size_t WS_WOT = 16 * MiB;
constexpr size_t WS_W13T = 20 * MiB;
constexpr size_t WS_W2T = 84 * MiB;
constexpr size_t WS_LIST = 116 * MiB;
constexpr size_t WS_TOK = 125 * MiB;
constexpr size_t WS_BONUS = 127 * MiB;
constexpr size_t WS_CS = 130 * MiB;
constexpr size_t WS_X1 = 146 * MiB;
constexpr size_t WS_X2 = 218 * MiB;
constexpr size_t WS_X3 = 452 * MiB;
constexpr size_t WS_END = 596 * MiB;
static_assert(WS_WINT + (size_t)2 * DINP * DM * 2 <= WS_WOT && WS_LIST + (size_t)NEXP * LISTCAP * 4 <= WS_TOK && WS_TOK + (size_t)NTOK * 32 <= WS_BONUS, "ws map");
static_assert(WS_BONUS + (size_t)2 * NTOK * 8 * 4 <= WS_CS && WS_X2 + (size_t)NTOK * DINP * 2 <= WS_X3 && WS_X3 + (size_t)2 * NTOK * 512 * 4 <= WS_END, "ws map");
static_assert((size_t)MAXSLOT * 1024 * 2 <= WS_X3 - WS_X2 && (size_t)MAXSLOT * 512 * 2 <= WS_END - WS_X3, "ws map");
constexpr int CW_BAR = 4096;
constexpr int CW_CNT = 8192;
constexpr int RING_BYTES = 131072, LDSCTL_OFF = RING_BYTES, MISC_OFF = LDSCTL_OFF + 320, LDS_BYTES = 147456;
constexpr int PREF_OFF = LDSCTL_OFF + 512;

#define GAS __attribute__((address_space(1)))
#define LAS __attribute__((address_space(3)))
typedef unsigned short bf16;
typedef unsigned v4u __attribute__((ext_vector_type(4)));
typedef unsigned v2u __attribute__((ext_vector_type(2)));
typedef float f32x4 __attribute__((ext_vector_type(4)));
typedef short bf16x8 __attribute__((ext_vector_type(8)));
typedef GAS unsigned gu32;
#define RLX_AGENT __ATOMIC_RELAXED, __HIP_MEMORY_SCOPE_AGENT
#define LDS_WAIT() asm volatile("s_waitcnt lgkmcnt(0)" ::: "memory")
#define VM_WAIT() asm volatile("s_waitcnt vmcnt(0)" ::: "memory")
__device__ __forceinline__ unsigned f2bf(float f) { unsigned u = __builtin_bit_cast(unsigned, f); return (u + 0x7fffu + ((u >> 16) & 1u)) >> 16; }
__device__ __forceinline__ unsigned pk2(float lo, float hi) { return f2bf(lo) | (f2bf(hi) << 16); }
__device__ __forceinline__ float bf2f(unsigned short v) { return __builtin_bit_cast(float, (unsigned)v << 16); }
__device__ __forceinline__ float bflo(unsigned w) { return __builtin_bit_cast(float, w << 16); }
__device__ __forceinline__ float bfhi(unsigned w) { return __builtin_bit_cast(float, w & 0xffff0000u); }
__device__ __forceinline__ float wave_sum(float v) {
#pragma unroll
    for (int o = 1; o < 64; o <<= 1) v += __shfl_xor(v, o);
    return v;
}
__device__ __forceinline__ float sigmoidf_(float x) { return 1.0f / (1.0f + expf(-x)); }
template <int CTRL> __device__ __forceinline__ float dppmov(float v) { return __builtin_bit_cast(float, __builtin_amdgcn_update_dpp(0, __builtin_bit_cast(int, v), CTRL, 0xF, 0xF, true)); }
__device__ __forceinline__ float red8(float v) { v += dppmov<0xB1>(v); v += dppmov<0x4E>(v); v += dppmov<0x141>(v); return v; }

struct TokInfo { int e0, e1, p0, p1; float g0, g1; int pad0, pad1; };
namespace pg8 {
#define PG8_LAS __attribute__((address_space(3)))
typedef unsigned short bf16_t;
typedef short bf16x8 __attribute__((ext_vector_type(8)));
typedef float f32x4 __attribute__((ext_vector_type(4)));
typedef unsigned u32x4 __attribute__((ext_vector_type(4)));
constexpr int BM = 256, BK = 64, HALF = 128, HTB = HALF * BK * 2  , STAGE_BYTES = 8 * HTB, NXCD = 8, WGM = 8;

__host__ __device__ __forceinline__ int lds_byte(int r, int c) { const int st = (r >> 4) * 2 + (c >> 5), rr = r & 15, cc = c & 31, ob = rr * 64 + cc * 2; return st * 1024 + (ob ^ (((ob >> 9) & 1) << 5)); }
__host__ __device__ __forceinline__ void stage_rc(int b, int& R, int& C) { const int st = b / 1024, sb = b % 1024, swz = sb ^ (((sb >> 9) & 1) << 5); R = (st >> 1) * 16 + swz / 64; C = (st & 1) * 32 + (swz % 64) / 2; }
__host__ __device__ __forceinline__ int perm32(int rho) { const int n = rho >> 4, i = rho & 15; return 8 * (i >> 2) + 4 * n + (i & 3); }

struct Unit { int pm, pn, pnb; };
struct Gemm { const bf16_t* A; const bf16_t* Bt; int M, N, K; };

struct StaticOrder {
    int nM, nN, nwg, G, c;
    __host__ __device__ void init(int M, int N, int G_, int c_) { nM = M / BM; nN = N / BM; nwg = nM * nN; G = G_; c = c_; }
    __host__ __device__ bool next(int i, Unit& u) const {
        const long L = (long)i * G + c; if (L >= nwg) return false;
        int wgid = (int)L; { const int q = nwg / NXCD, r = nwg % NXCD, xcd = wgid % NXCD, off = wgid / NXCD; wgid = (xcd < r ? xcd * (q + 1) : r * (q + 1) + (xcd - r) * q) + off; }
        const int nig = WGM * nN, gid = wgid / nig, fm = gid * WGM, gsz = (nM - fm) < WGM ? (nM - fm) : WGM;
        u.pm = fm + ((wgid % nig) % gsz); u.pn = (wgid % nig) / gsz; u.pnb = u.pn; return true;
    }
    __device__ __forceinline__ void a_ready(const Unit&) const {}
    __device__ __forceinline__ void done(const Unit&) const {}
};

__device__ __forceinline__ unsigned cvt_pk_bf16(float lo, float hi) { unsigned r; asm volatile("v_cvt_pk_bf16_f32 %0, %1, %2" : "=v"(r) : "v"(lo), "v"(hi)); return r; }
template <class Epi, class Sched, bool ALIGN_EPI = false, bool SP2 = false>
__device__ __forceinline__ void gemm_phase(PG8_LAS unsigned char* lds, const Gemm g, const Sched& S, const Epi& E) {
    const int tid = threadIdx.x, wid = __builtin_amdgcn_readfirstlane(tid >> 6), lane = tid & 63, wr = wid >> 2, wc = wid & 3, fr = lane & 15, fq = lane >> 4;
    const int K = g.K, nt = K / BK;
    unsigned voffA[2], voffB[2];
#pragma unroll
    for (int i = 0; i < 2; ++i) { int R, C; stage_rc(tid * 16 + i * 8192, R, C); const int Rb = Epi::PERM ? ((R & ~31) + perm32(R & 31)) : R;
        voffA[i] = (unsigned)(R * K + C) * 2u; voffB[i] = (unsigned)(Rb * K + C) * 2u; }
    const size_t kstep = (size_t)(BK * 2);
    const size_t hstep = (size_t)HALF * K * 2;
    const size_t tstep = 2 * hstep;
    const unsigned ldsw = (unsigned)wid * 1024u;
    const int aoff = lds_byte(wr * 64 + fr, fq * 8), boff = lds_byte(wc * 32 + fr, fq * 8);
#define PG8_SA(b, h) (((b) * 2 + (h)) * HTB)
#define PG8_SB(b, h) ((4 + (b) * 2 + (h)) * HTB)
#define PG8_STAGE(bufoff, gbase, voff) do { _Pragma("unroll") for (int _i = 0; _i < 2; ++_i) \
        __builtin_amdgcn_global_load_lds((const unsigned*)((const char*)(gbase) + (voff)[_i]), (PG8_LAS unsigned*)(lds + (bufoff) + ldsw + _i * 8192), 16, 0, 0); } while (0)
#define PG8_LDA(dst, b, h) do { _Pragma("unroll") for (int m = 0; m < 4; ++m) _Pragma("unroll") for (int k = 0; k < 2; ++k) dst[m][k] = *(const PG8_LAS bf16x8*)(lds + PG8_SA(b, h) + aoff + m * 2048 + k * 1024); } while (0)
#define PG8_LDB(dst, b, h) do { _Pragma("unroll") for (int n = 0; n < 2; ++n) _Pragma("unroll") for (int k = 0; k < 2; ++k) dst[n][k] = *(const PG8_LAS bf16x8*)(lds + PG8_SB(b, h) + boff + n * 2048 + k * 1024); } while (0)
#define PG8_MMA(ai, bj, At, Bt) do { __builtin_amdgcn_s_setprio(1); _Pragma("unroll") for (int m = 0; m < 4; ++m) _Pragma("unroll") for (int n = 0; n < 2; ++n) _Pragma("unroll") for (int k = 0; k < 2; ++k) \
        acc[ai][bj][m][n] = __builtin_amdgcn_mfma_f32_16x16x32_bf16(Bt[n][k], At[m][k], acc[ai][bj][m][n], 0, 0, 0); __builtin_amdgcn_s_setprio(0); } while (0)
#define PG8_WAIT_V(n) asm volatile("s_waitcnt vmcnt(" #n ")" ::: "memory")
#define PG8_WAIT_L(n) asm volatile("s_waitcnt lgkmcnt(" #n ")" ::: "memory")
#define PG8_BAR __builtin_amdgcn_s_barrier()
#define PG8_SCHED __builtin_amdgcn_sched_barrier(0)
    Unit cur, nxt; int ui = 0;
    if (!S.next(0, cur)) return;
    f32x4 acc[2][2][4][2];
#pragma unroll
    for (int a = 0; a < 2; ++a)
#pragma unroll
        for (int b = 0; b < 2; ++b)
#pragma unroll
            for (int m = 0; m < 4; ++m)
#pragma unroll
                for (int n = 0; n < 2; ++n) acc[a][b][m][n] = (f32x4){0.f, 0.f, 0.f, 0.f};
    bf16x8 At[4][2], B0[2][2], B1[2][2];
    const char* cA = (const char*)g.A + (size_t)cur.pm * tstep; const char* cB = (const char*)g.Bt + (size_t)cur.pnb * tstep;
    S.a_ready(cur);
    if constexpr (SP2) {
        PG8_STAGE(PG8_SB(0, 0), cB, voffB); PG8_STAGE(PG8_SB(0, 1), cB + hstep, voffB); PG8_STAGE(PG8_SA(0, 0), cA, voffA); PG8_STAGE(PG8_SA(0, 1), cA + hstep, voffA);
        if (wr == 1) PG8_BAR;
        PG8_WAIT_V(2); PG8_BAR;
        PG8_STAGE(PG8_SB(1, 0), cB + kstep, voffB); PG8_STAGE(PG8_SA(1, 0), cA + kstep, voffA); PG8_STAGE(PG8_SB(1, 1), cB + hstep + kstep, voffB);
        PG8_WAIT_V(6); PG8_BAR;
    } else {
        PG8_STAGE(PG8_SB(0, 0), cB, voffB); PG8_STAGE(PG8_SA(0, 0), cA, voffA); PG8_STAGE(PG8_SB(0, 1), cB + hstep, voffB); PG8_STAGE(PG8_SA(0, 1), cA + hstep, voffA);
        if (wr == 1) PG8_BAR;
        PG8_WAIT_V(4); PG8_BAR;
        PG8_STAGE(PG8_SB(1, 0), cB + kstep, voffB); PG8_STAGE(PG8_SA(1, 0), cA + kstep, voffA); PG8_STAGE(PG8_SB(1, 1), cB + hstep + kstep, voffB);
        PG8_WAIT_V(6); PG8_BAR;
    }
    for (;;) {
        const bool has_next = S.next(ui + 1, nxt);
        const char* nA = has_next ? (const char*)g.A + (size_t)nxt.pm * tstep : cA; const char* nB = has_next ? (const char*)g.Bt + (size_t)nxt.pnb * tstep : cB;
        for (int t = 0; t < nt; t += 2) {
            const bool last = (t == nt - 2);
            const char* a1 = cA + (size_t)(t + 1) * kstep;
            const char* a2 = last ? nA : cA + (size_t)(t + 2) * kstep; const char* b2 = last ? nB : cB + (size_t)(t + 2) * kstep;
            const char* a3 = a2 + kstep; const char* b3 = b2 + kstep;
            if (last && has_next) S.a_ready(nxt);
            if constexpr (SP2) {
            PG8_LDB(B0, 0, 0); PG8_LDB(B1, 0, 1); PG8_SCHED; PG8_LDA(At, 0, 0); PG8_STAGE(PG8_SA(1, 1), a1 + hstep, voffA);
            PG8_WAIT_V(8); PG8_WAIT_L(0); PG8_BAR; PG8_MMA(0, 0, At, B0); PG8_MMA(0, 1, At, B1); PG8_BAR; PG8_SCHED;
            PG8_LDA(At, 0, 1); PG8_STAGE(PG8_SB(0, 0), b2, voffB); PG8_STAGE(PG8_SB(0, 1), b2 + hstep, voffB); PG8_STAGE(PG8_SA(0, 0), a2, voffA);
            PG8_WAIT_V(8); PG8_WAIT_L(0); PG8_BAR; PG8_MMA(1, 0, At, B0); PG8_MMA(1, 1, At, B1); PG8_BAR; PG8_SCHED;
            PG8_LDB(B0, 1, 0); PG8_LDB(B1, 1, 1); PG8_SCHED; PG8_LDA(At, 1, 0); PG8_STAGE(PG8_SA(0, 1), a2 + hstep, voffA);
            PG8_WAIT_V(8); PG8_WAIT_L(0); PG8_BAR; PG8_MMA(0, 0, At, B0); PG8_MMA(0, 1, At, B1); PG8_BAR; PG8_SCHED;
            PG8_LDA(At, 1, 1); PG8_STAGE(PG8_SB(1, 0), b3, voffB); PG8_STAGE(PG8_SB(1, 1), b3 + hstep, voffB); PG8_STAGE(PG8_SA(1, 0), a3, voffA);
            PG8_WAIT_V(8); PG8_WAIT_L(0); PG8_BAR; PG8_MMA(1, 0, At, B0); PG8_MMA(1, 1, At, B1); PG8_BAR; PG8_SCHED;
            } else {
            PG8_LDB(B0, 0, 0); PG8_SCHED; PG8_LDA(At, 0, 0); PG8_STAGE(PG8_SA(1, 1), a1 + hstep, voffA);
            PG8_WAIT_L(8); PG8_BAR; PG8_WAIT_L(0); PG8_MMA(0, 0, At, B0); PG8_BAR; PG8_SCHED;
            PG8_LDB(B1, 0, 1); PG8_STAGE(PG8_SB(0, 0), b2, voffB);
            PG8_BAR; PG8_WAIT_L(0); PG8_MMA(0, 1, At, B1); PG8_BAR;
            PG8_LDA(At, 0, 1); PG8_STAGE(PG8_SA(0, 0), a2, voffA);
            PG8_BAR; PG8_WAIT_L(0); PG8_MMA(1, 0, At, B0); PG8_BAR; PG8_SCHED;
            PG8_STAGE(PG8_SB(0, 1), b2 + hstep, voffB);
            PG8_WAIT_V(6); PG8_BAR; PG8_MMA(1, 1, At, B1); PG8_BAR;
            PG8_LDB(B0, 1, 0); PG8_SCHED; PG8_LDA(At, 1, 0); PG8_STAGE(PG8_SA(0, 1), a2 + hstep, voffA);
            PG8_WAIT_L(8); PG8_BAR; PG8_WAIT_L(0); PG8_MMA(0, 0, At, B0); PG8_BAR; PG8_SCHED;
            PG8_LDB(B1, 1, 1); PG8_STAGE(PG8_SB(1, 0), b3, voffB);
            PG8_BAR; PG8_WAIT_L(0); PG8_MMA(0, 1, At, B1); PG8_BAR;
            PG8_LDA(At, 1, 1); PG8_STAGE(PG8_SA(1, 0), a3, voffA);
            PG8_BAR; PG8_WAIT_L(0); PG8_MMA(1, 0, At, B0); PG8_BAR; PG8_SCHED;
            PG8_STAGE(PG8_SB(1, 1), b3 + hstep, voffB);
            PG8_WAIT_V(6); PG8_BAR; PG8_MMA(1, 1, At, B1); PG8_BAR;
            }
        }
        if constexpr (ALIGN_EPI) { if (wr == 0) PG8_BAR; }
        if constexpr (!Epi::AFTER_DRAIN) { E(acc, cur, wr, wc, fr, fq); S.done(cur); }
        if (!has_next) break;
#pragma unroll
        for (int a = 0; a < 2; ++a)
#pragma unroll
            for (int b = 0; b < 2; ++b)
#pragma unroll
                for (int m = 0; m < 4; ++m)
#pragma unroll
                    for (int n = 0; n < 2; ++n) acc[a][b][m][n] = (f32x4){0.f, 0.f, 0.f, 0.f};
        cur = nxt; cA = nA; cB = nB; ++ui;
        if constexpr (ALIGN_EPI) { if (wr == 1) PG8_BAR; }
    }
    PG8_WAIT_V(0);
    if constexpr (!ALIGN_EPI) { if (wr == 0) PG8_BAR; }
    PG8_BAR;
    if constexpr (Epi::AFTER_DRAIN) { E.fused(acc, cur, wr, wc, fr, fq, lds, wid, lane); S.done(cur); }
#undef PG8_SA
#undef PG8_SB
#undef PG8_STAGE
#undef PG8_LDA
#undef PG8_LDB
#undef PG8_MMA
#undef PG8_WAIT_V
#undef PG8_WAIT_L
#undef PG8_BAR
#undef PG8_SCHED
}
}
namespace pg8 {
struct EpiBf16 {
    static constexpr bool PERM = true, AFTER_DRAIN = false;
    bf16_t* O; int ldc;
    __device__ __forceinline__ void operator()(const f32x4 (&acc)[2][2][4][2], const Unit& u, int wr, int wc, int fr, int fq) const {
        const int row0 = u.pm * BM + wr * 64 + fr; const int col0 = u.pn * BM + wc * 32 + 8 * fq;
#pragma unroll
        for (int ai = 0; ai < 2; ++ai)
#pragma unroll
            for (int m = 0; m < 4; ++m) { bf16_t* rowp = O + (size_t)(row0 + ai * HALF + m * 16) * ldc + col0;
#pragma unroll
                for (int bj = 0; bj < 2; ++bj) { const f32x4 v0 = acc[ai][bj][m][0], v1 = acc[ai][bj][m][1];
                    u32x4 w; w.x = cvt_pk_bf16(v0[0], v0[1]); w.y = cvt_pk_bf16(v0[2], v0[3]); w.z = cvt_pk_bf16(v1[0], v1[1]); w.w = cvt_pk_bf16(v1[2], v1[3]);
                    *(u32x4*)(rowp + bj * HALF) = w; } }
    }
};
struct EpiSwiGLU {
    static constexpr bool PERM = true, AFTER_DRAIN = false;
    bf16_t* O; int ldc;
    __device__ __forceinline__ void operator()(const f32x4 (&acc)[2][2][4][2], const Unit& u, int wr, int wc, int fr, int fq) const {
        const int row0 = u.pm * BM + wr * 64 + fr; const int col0 = u.pn * HALF + wc * 32 + 8 * fq;
#pragma unroll
        for (int ai = 0; ai < 2; ++ai)
#pragma unroll
            for (int m = 0; m < 4; ++m) { bf16_t* rowp = O + (size_t)(row0 + ai * HALF + m * 16) * ldc + col0;
                float r[8];
#pragma unroll
                for (int n = 0; n < 2; ++n)
#pragma unroll
                    for (int j = 0; j < 4; ++j) { const float a = acc[ai][0][m][n][j], b = acc[ai][1][m][n][j]; r[n * 4 + j] = a * b / (1.0f + __expf(-a)); }
                u32x4 w; w.x = cvt_pk_bf16(r[0], r[1]); w.y = cvt_pk_bf16(r[2], r[3]); w.z = cvt_pk_bf16(r[4], r[5]); w.w = cvt_pk_bf16(r[6], r[7]);
                *(u32x4*)rowp = w; }
    }
};
struct MoeOrder {
    const PG8_LAS int* pref; int nN, G, c, total;
    __device__ __forceinline__ void init(const PG8_LAS int* pref_, int nN_, int G_, int c_) { pref = pref_; nN = nN_; G = G_; c = c_; total = pref_[32] * nN_; }
    __device__ __forceinline__ bool next(int i, Unit& u) const {
        const int L = i * G + c; if (L >= total) return false;
        const int rt = L / nN, pn = L - rt * nN; int e = 0;
#pragma unroll 1
        for (int k = 1; k < 32; ++k) e += (pref[k] <= rt) ? 1 : 0;
        u.pm = rt; u.pn = pn; u.pnb = e * nN + pn; return true;
    }
    __device__ __forceinline__ void a_ready(const Unit&) const {}
    __device__ __forceinline__ void done(const Unit&) const {}
};
}
#define XB_TMO      128
#define XB_XCNT(j)  (256  + 64 * (j))
#define XB_XSUB(j)  (1280 + 64 * (j))
#define XB_XGEN(j)  (2304 + 64 * (j))
#define XB_TOP      3328
#define XB_TOPGEN   3392
#define XCD_BAR_WORDS 3456
#define XB_SPIN_CAP (1u << 22)

__device__ __forceinline__ unsigned xb_ld(unsigned* p)              { return __hip_atomic_load(p, __ATOMIC_RELAXED, __HIP_MEMORY_SCOPE_AGENT); }
__device__ __forceinline__ unsigned xb_add(unsigned* p, unsigned v) { return __hip_atomic_fetch_add(p, v, __ATOMIC_RELAXED, __HIP_MEMORY_SCOPE_AGENT); }
__device__ __forceinline__ unsigned xb_xcc_id() { return (unsigned)__builtin_amdgcn_s_getreg((3 << 11) | 20) & 0xFu; }
#define XB_SPIN(cond, bar) do { unsigned _sp = 0; while (cond) { __builtin_amdgcn_s_sleep(1); \
    if ((++_sp & 255u) == 0u) { if (xb_ld(&(bar)[XB_TMO])) break; if (_sp > XB_SPIN_CAP) { atomicAdd(&(bar)[XB_TMO], 1u); break; } } } } while (0)

struct XcdBarrier {
    unsigned* bar; unsigned x;
    volatile LAS unsigned* st;
};

__device__ __forceinline__ XcdBarrier xcd_barrier_post(unsigned* bar, volatile LAS unsigned* st) {
    XcdBarrier b; b.bar = bar; b.x = xb_xcc_id(); b.st = st;
    if (threadIdx.x == 0) (void)xb_add(&bar[XB_XCNT(b.x)], 1u);
    return b;
}
__device__ __forceinline__ void xcd_barrier_complete(unsigned* bar, unsigned x, unsigned& nloc, unsigned& nx) {
    const unsigned G = gridDim.x * gridDim.y * gridDim.z;
    unsigned sum, cnt, mine, sp = 0u;
    for (;;) {
        sum = 0u; cnt = 0u; mine = 0u;
#pragma unroll
        for (unsigned j = 0; j < 16; ++j) { const unsigned c = xb_ld(&bar[XB_XCNT(j)]); sum += c; cnt += (c > 0u) ? 1u : 0u; mine = (j == x) ? c : mine; }
        if (sum == G) break;
        __builtin_amdgcn_s_sleep(1);
        if ((++sp & 255u) == 0u) { if (xb_ld(&bar[XB_TMO])) break; if (sp > XB_SPIN_CAP) { atomicAdd(&bar[XB_TMO], 1u); break; } }
    }
    nloc = mine > 0u ? mine : 1u; nx = cnt > 0u ? cnt : 1u;
}

__device__ __forceinline__ void xcd_barrier(const XcdBarrier& b) {
    asm volatile("s_waitcnt vmcnt(0)" ::: "memory");
    __syncthreads();
    if (threadIdx.x == 0) {
        unsigned* bar = b.bar;
        __builtin_amdgcn_s_waitcnt(0);
        unsigned nloc = b.st[0], nx = b.st[1];
        if (nloc == 0u) { xcd_barrier_complete(bar, b.x, nloc, nx); b.st[0] = nloc; b.st[1] = nx; }
        const unsigned old = xb_add(&bar[XB_XSUB(b.x)], 1u);
        const unsigned gen = old / nloc;
        if (old + 1u == (gen + 1u) * nloc) {
            __builtin_amdgcn_fence(__ATOMIC_RELEASE, "agent");
            asm volatile("s_waitcnt vmcnt(0)" ::: "memory");
            const unsigned og = xb_add(&bar[XB_TOP], 1u);
            const unsigned tg = og / nx;
            if (og + 1u == (tg + 1u) * nx) xb_add(&bar[XB_TOPGEN], 1u);
            else XB_SPIN(xb_ld(&bar[XB_TOPGEN]) == tg, bar);
            __builtin_amdgcn_fence(__ATOMIC_ACQUIRE, "agent");
            xb_add(&bar[XB_XGEN(b.x)], 1u);
            asm volatile("s_waitcnt vmcnt(0)" ::: "memory");
        } else {
            XB_SPIN(xb_ld(&bar[XB_XGEN(b.x)]) == gen, bar);
            __builtin_amdgcn_fence(__ATOMIC_ACQUIRE, "agent");
            asm volatile("s_waitcnt vmcnt(0)" ::: "memory");
        }
    }
    __syncthreads();
}
struct Args { const float* in[30]; float* out; unsigned char* ws; int ph_lo, ph_hi; };
enum { I_X = 0, I_C, I_CTX, I_CCTX, I_ADAW, I_ADAB, I_WIN, I_RPB, I_MUP, I_MUN, I_W0, I_W2, I_A0, I_A2, I_G2, I_KK, I_KA, I_RK, I_GNG, I_GNB, I_WOUT, I_LN1G, I_LN1B, I_LN2G, I_LN2B, I_RW, I_RB, I_EW1, I_EW3, I_EW2 };

__device__ __forceinline__ void transpose_item(const float* W, int N, int k0, int n0, bf16* WT, int ldk, int drow0, LAS float* scr, int lane) {
#pragma unroll 8
    for (int i = 0; i < 32; ++i) { const int kk = 2 * i + (lane >> 5); scr[kk * 33 + (lane & 31)] = W[(size_t)(k0 + kk) * N + n0 + (lane & 31)]; }
    LDS_WAIT(); asm volatile("" ::: "memory");
    const int c = lane & 7;
#pragma unroll
    for (int j = 0; j < 4; ++j) { const int n = (lane >> 3) + 8 * j; const LAS float* s = scr + (8 * c) * 33 + n;
        v4u o; o.x = pk2(s[0 * 33], s[1 * 33]); o.y = pk2(s[2 * 33], s[3 * 33]); o.z = pk2(s[4 * 33], s[5 * 33]); o.w = pk2(s[6 * 33], s[7 * 33]);
        *(GAS v4u*)(WT + (size_t)(drow0 + n) * ldk + k0 + 8 * c) = o; }
    LDS_WAIT(); asm volatile("" ::: "memory");
}

__device__ __forceinline__ void phase_prologue(const Args& a, LAS unsigned char* lds) {
    const int tid = threadIdx.x, lane = tid & 63, wave = __builtin_amdgcn_readfirstlane(tid >> 6), G = gridDim.x, bid = blockIdx.x;
    const int gw = bid * 8 + wave, NGW = G * 8;
    bf16* WINT = (bf16*)(a.ws + WS_WINT); bf16* WOT = (bf16*)(a.ws + WS_WOT);
    LAS float* scr = (LAS float*)(lds + wave * 16384);
    constexpr int I_IN = 16 * 103, I_OUT = 16 * 32, I_L = I_IN + I_OUT;
    for (int it = gw; it < 2 * I_L; it += NGW) {
        const int l = it / I_L; int r = it - l * I_L;
        if (r < I_IN) { const int kb = r / 103, nb = r - kb * 103; transpose_item(a.in[I_WIN] + (size_t)l * DM * DIN, DIN, 64 * kb, 32 * nb, WINT + (size_t)l * DINP * DM, DM, 32 * nb, scr, lane); }
        else { r -= I_IN; const int kb = r >> 5, nb = r & 31; transpose_item(a.in[I_WOUT] + (size_t)l * DM * DM, DM, 64 * kb, 32 * nb, WOT + (size_t)l * DM * DM, DM, 32 * nb, scr, lane); }
    }
    for (int i = bid * 512 + tid; i < 8192; i += G * 512) { const int l = i >> 12, r = i & 4095; *(GAS v4u*)(WINT + (size_t)l * DINP * DM + (size_t)DIN * DM + (size_t)r * 8) = (v4u){0u, 0u, 0u, 0u}; }
    { float* rp = (float*)(a.ws + WS_ROPE); const int i = bid * 512 + tid;
      if (i < 1536) { const int idx = i < 512 ? i : i - 512; const int p = idx >> 4, f = idx & 15; const double inv = exp(-(double)f * (9.210340371976184 / 16.0)); const double ang = (double)p * inv;
          const float cs = (float)cos(ang), sn = (float)sin(ang); if (i < 512) { rp[idx] = cs; rp[512 + idx] = sn; } else { rp[1024 + idx] = cs; rp[2048 + idx] = sn; } } }
    __syncthreads();
    LAS float* sl = (LAS float*)lds; LAS float* red = (LAS float*)(lds + 69632);
    for (int i = tid; i < 17 * 1024; i += 512) { const int r = i >> 10, k = i & 1023; const float v = r < 16 ? a.in[I_C][r * 1024 + k] : a.in[I_CCTX][k]; sl[i] = v / (1.0f + expf(-v)); }
    __syncthreads();
    float* mods = (float*)(a.ws + WS_MODS);
    for (int it = bid; it < 192; it += G) {
        const int l = it / 96, ch = it - l * 96; const int kq = tid >> 6, cl = tid & 63, col = ch * 64 + cl;
        const float* W = a.in[I_ADAW] + (size_t)l * DM * 6144 + col;
        float acc[17];
#pragma unroll
        for (int r = 0; r < 17; ++r) acc[r] = 0.f;
        for (int k = kq * 128; k < kq * 128 + 128; ++k) { const float w = W[(size_t)k * 6144];
#pragma unroll
            for (int r = 0; r < 17; ++r) acc[r] += sl[r * 1024 + k] * w; }
#pragma unroll
        for (int r = 0; r < 17; ++r) red[(kq * 17 + r) * 64 + cl] = acc[r];
        __syncthreads();
        for (int i = tid; i < 17 * 64; i += 512) { const int r = i >> 6, c2 = i & 63; float s = 0.f;
#pragma unroll
            for (int q = 0; q < 8; ++q) s += red[(q * 17 + r) * 64 + c2];
            mods[((size_t)l * 17 + r) * 6144 + ch * 64 + c2] = s + a.in[I_ADAB][l * 6144 + ch * 64 + c2]; }
        __syncthreads();
    }
}

__device__ __forceinline__ void phase_modconv(const Args& a, LAS unsigned char* lds, int l) {
    const int tid = threadIdx.x, lane = tid & 63, wave = __builtin_amdgcn_readfirstlane(tid >> 6), G = gridDim.x, bid = blockIdx.x;
    const int gw = bid * 8 + wave, NGW = G * 8;
    const float* mods = (const float*)(a.ws + WS_MODS) + (size_t)l * 17 * 6144;
    bf16* XM = (bf16*)(a.ws + WS_X1);
    const float* xs = l == 0 ? a.in[I_X] : a.out; const float* cs = l == 0 ? a.in[I_CTX] : (const float*)(a.ws + WS_CS);
    for (int m = gw; m < NTOK; m += NGW) {
        const float* src; int mr;
        if (m < NTX) { src = xs + (size_t)m * DM; mr = m / SEQ; } else { src = cs + (size_t)(m - NTX) * DM; mr = 16; }
        const GAS f32x4* xr = (const GAS f32x4*)src + lane; const GAS f32x4* sh = (const GAS f32x4*)(mods + (size_t)mr * 6144) + lane; const GAS f32x4* sc = sh + 256;
        GAS v2u* o8 = (GAS v2u*)(XM + (size_t)m * DM) + lane;
#pragma unroll
        for (int j = 0; j < 4; ++j) { const f32x4 v = xr[64 * j], s = sh[64 * j], c = sc[64 * j]; const f32x4 r = v * (c + 1.0f) + s; v2u w; w.x = pk2(r.x, r.y); w.y = pk2(r.z, r.w); o8[64 * j] = w; }
    }
    LAS float* scr = (LAS float*)(lds + wave * 16384);
    bf16* W13T = (bf16*)(a.ws + WS_W13T); bf16* W2T = (bf16*)(a.ws + WS_W2T);
    for (int it = gw; it < NEXP * 768; it += NGW) {
        const int e = it / 768; int r = it - e * 768; const size_t eo = ((size_t)l * NEXP + e) * (size_t)DM * DEXP;
        if (r < 512) { const int s = r >> 8; r &= 255; const int kb = r >> 4, nb = r & 15, n0 = 32 * nb; const int drow0 = 256 * (n0 >> 7) + 128 * s + (n0 & 127);
            transpose_item((s ? a.in[I_EW3] : a.in[I_EW1]) + eo, DEXP, 64 * kb, n0, W13T + (size_t)e * 1024 * 1024, 1024, drow0, scr, lane); }
        else { r -= 512; const int kb = r >> 5, nb = r & 31; transpose_item(a.in[I_EW2] + eo, DM, 64 * kb, 32 * nb, W2T + (size_t)e * 1024 * 512, 512, 32 * nb, scr, lane); }
    }
}

__device__ __forceinline__ void phase_scan(const Args& a, LAS unsigned char* lds, int l) {
    constexpr int TB = 32;
    const int tid = threadIdx.x, lane = tid & 63, wv = __builtin_amdgcn_readfirstlane(tid >> 6);
    LAS float* ops = (LAS float*)lds;
    LAS float* scal = (LAS float*)(lds + 49152);
    LAS float* zl = (LAS float*)(lds + 49664);
    LAS float* rkraw = (LAS float*)(lds + 57856);
    LAS float* ybuf = (LAS float*)(lds + 74240);
    const bf16* PX = (const bf16*)(a.ws + WS_X2); float* YD = (float*)(a.ws + WS_X3); float* BON = (float*)(a.ws + WS_BONUS); const float* rope = (const float*)(a.ws + WS_ROPE);
    const float* mup = a.in[I_MUP] + l * 1760; const float* mun = a.in[I_MUN] + l * 1760;
    for (int chain = blockIdx.x; chain < 256; chain += gridDim.x) {
        const int b = chain >> 4, h = (chain >> 1) & 7, d = chain & 1, c = lane;
        float w2c[32], a2c[32];
#pragma unroll
        for (int j = 0; j < 32; ++j) { w2c[j] = a.in[I_W2][((size_t)(l * 2 + d) * 32 + j) * 512 + h * 64 + c]; a2c[j] = a.in[I_A2][((size_t)(l * 2 + d) * 32 + j) * 512 + h * 64 + c]; }
        const float w0c = a.in[I_W0][(l * 2 + d) * 512 + h * 64 + c], a0c = a.in[I_A0][(l * 2 + d) * 512 + h * 64 + c];
        const float kkc = a.in[I_KK][l * 512 + h * 64 + c], kac = a.in[I_KA][l * 512 + h * 64 + c], rkc = a.in[I_RK][l * 512 + h * 64 + c];
        const int colr = h * 64 + c, colk = 512 + colr, colv = 1024 + colr, coll = (c < 32) ? (1536 + d * 32 + c) : (1600 + d * 32 + (c - 32));
        const float mpr = mup[colr], mnr = mun[colr], mpk = mup[colk], mnk = mun[colk], mpv = mup[colv], mnv = mun[colv], mpl = mup[coll], mnl = mun[coll];
        float S[8];
#pragma unroll
        for (int j = 0; j < 8; ++j) S[j] = 0.f;
        const int vl = lane >> 3, kq = lane & 7, vrow = 8 * wv + vl;
        for (int seq = 0; seq < 2; ++seq) {
            const int T = seq ? SEQ : CTXL, rowbase = seq ? b * SEQ : NTX + b * CTXL, nblk = T / TB;
            for (int bi = 0; bi < nblk; ++bi) {
                const int tb = d ? (nblk - 1 - bi) : bi, t0 = tb * TB;
                float zv[4];
#pragma unroll
                for (int i = 0; i < 4; ++i) {
                    const int tl = wv + 8 * i, t = t0 + tl; const bf16* p = PX + (size_t)(rowbase + t) * DINP + RWOFF;
                    const bool hp = t > 0, hn = t + 1 < T;
                    const float cr = bf2f(p[colr]), ck = bf2f(p[colk]), cv = bf2f(p[colv]), cl_ = bf2f(p[coll]);
                    const float pr = hp ? bf2f(p[colr - DINP]) : 0.f, pk = hp ? bf2f(p[colk - DINP]) : 0.f, pv = hp ? bf2f(p[colv - DINP]) : 0.f, pl = hp ? bf2f(p[coll - DINP]) : 0.f;
                    const float nr = hn ? bf2f(p[colr + DINP]) : 0.f, nk = hn ? bf2f(p[colk + DINP]) : 0.f, nv = hn ? bf2f(p[colv + DINP]) : 0.f, nl = hn ? bf2f(p[coll + DINP]) : 0.f;
                    const float zr = cr + mpr * (pr - cr) + mnr * (nr - cr), zk = ck + mpk * (pk - ck) + mnk * (nk - ck);
                    zv[i] = cv + mpv * (pv - cv) + mnv * (nv - cv);
                    const float zz = cl_ + mpl * (pl - cl_) + mnl * (nl - cl_);
                    rkraw[tl * 128 + c] = zr; rkraw[tl * 128 + 64 + c] = zk; zl[tl * 64 + c] = (c < 32) ? tanhf(zz) : zz;
                }
                __syncthreads();
#pragma unroll
                for (int i = 0; i < 4; ++i) {
                    const int tl = wv + 8 * i, t = t0 + tl;
                    float r = rkraw[tl * 128 + c], k = rkraw[tl * 128 + 64 + c];
                    if (seq) { const float rp = rkraw[tl * 128 + (c ^ 16)], kp = rkraw[tl * 128 + 64 + (c ^ 16)]; const int qd = c >> 4, f = c & 15;
                        const int ti = (qd < 2) ? ((t >> 6) * 16 + f) : (1024 + (t & 63) * 16 + f); const float cs = rope[ti], sn = rope[ti + ((qd < 2) ? 512 : 1024)];
                        const float sg = (qd & 1) ? sn : -sn; r = r * cs + rp * sg; k = k * cs + kp * sg; }
                    const float kkr = k * kkc; const float ss = wave_sum(kkr * kkr); const float kk = kkr / fmaxf(sqrtf(ss), 1e-12f);
                    float u = w0c, av = a0c;
#pragma unroll
                    for (int j = 0; j < 32; j += 4) { const f32x4 z1 = *(const LAS f32x4*)(zl + tl * 64 + j), z2 = *(const LAS f32x4*)(zl + tl * 64 + 32 + j);
                        u += z1.x * w2c[j] + z1.y * w2c[j + 1] + z1.z * w2c[j + 2] + z1.w * w2c[j + 3]; av += z2.x * a2c[j] + z2.y * a2c[j + 1] + z2.z * a2c[j + 2] + z2.w * a2c[j + 3]; }
                    const float w = expf(-0.6065306597126334f * sigmoidf_(u)), aa = sigmoidf_(av);
                    const float kd = k * (1.0f + (aa - 1.0f) * kac), nb = -kk * aa;
                    const float c1 = wave_sum(nb * r), c2 = wave_sum(kd * r), bon = wave_sum(r * kd * rkc);
                    LAS float* o = ops + tl * 384 + c; o[0] = kk; o[64] = w * r; o[128] = w; o[192] = nb; o[256] = kd; o[320] = zv[i];
                    if (lane == 0) { scal[tl * 4] = c1; scal[tl * 4 + 1] = c2; BON[((size_t)d * NTOK + rowbase + t) * 8 + h] = bon; }
                }
                __syncthreads();
#pragma unroll 2
                for (int s = 0; s < TB; ++s) {
                    const int tl = d ? (TB - 1 - s) : s; const LAS float* o = ops + tl * 384 + kq * 8;
                    const f32x4 ka = *(const LAS f32x4*)(o), kb = *(const LAS f32x4*)(o + 4), ra = *(const LAS f32x4*)(o + 64), rb = *(const LAS f32x4*)(o + 68);
                    const f32x4 wa = *(const LAS f32x4*)(o + 128), wb = *(const LAS f32x4*)(o + 132), na = *(const LAS f32x4*)(o + 192), nb_ = *(const LAS f32x4*)(o + 196);
                    const f32x4 da = *(const LAS f32x4*)(o + 256), db = *(const LAS f32x4*)(o + 260);
                    const float vv = ops[tl * 384 + 320 + vrow], c1 = scal[tl * 4], c2 = scal[tl * 4 + 1];
                    float sk = S[0] * ka.x + S[1] * ka.y + S[2] * ka.z + S[3] * ka.w + S[4] * kb.x + S[5] * kb.y + S[6] * kb.z + S[7] * kb.w;
                    float yy = S[0] * ra.x + S[1] * ra.y + S[2] * ra.z + S[3] * ra.w + S[4] * rb.x + S[5] * rb.y + S[6] * rb.z + S[7] * rb.w;
                    sk = red8(sk); yy = red8(yy);
                    const float y = yy + sk * c1 + vv * c2;
                    S[0] = S[0] * wa.x + sk * na.x + vv * da.x; S[1] = S[1] * wa.y + sk * na.y + vv * da.y; S[2] = S[2] * wa.z + sk * na.z + vv * da.z; S[3] = S[3] * wa.w + sk * na.w + vv * da.w;
                    S[4] = S[4] * wb.x + sk * nb_.x + vv * db.x; S[5] = S[5] * wb.y + sk * nb_.y + vv * db.y; S[6] = S[6] * wb.z + sk * nb_.z + vv * db.z; S[7] = S[7] * wb.w + sk * nb_.w + vv * db.w;
                    if (kq == 0) ybuf[tl * 64 + vrow] = y;
                }
                __syncthreads();
#pragma unroll
                for (int i = 0; i < 4; ++i) { const int tl = wv + 8 * i; YD[((size_t)d * NTOK + rowbase + t0 + tl) * 512 + h * 64 + c] = ybuf[tl * 64 + c]; }
            }
        }
        __syncthreads();
    }
}

typedef short v4i16_t __attribute__((ext_vector_type(4)));
__device__ __forceinline__ int swz_off(int row, int chunk) { return row * 128 + ((chunk ^ (row & 7)) << 4); }
__device__ __forceinline__ void stage_rows(LAS unsigned char* dst, const bf16* src, int nrows, int tid) {
    for (int idx = tid; idx < nrows * 8; idx += 512) { const int r = idx >> 3, ch = idx & 7; const v4u v = *(const GAS v4u*)(src + (size_t)r * DINP + ch * 8); *(LAS v4u*)(dst + swz_off(r, ch)) = v; }
}
struct AttState { float m, l; f32x4 o[4]; };
template <bool LOCAL>
__device__ __forceinline__ void att_kstep(AttState& st, const LAS unsigned char* kb, const LAS unsigned char* vb, int r0, int r1, const bf16x8 (&qf)[2], int lane,
                                          const LAS float* rpbrow, int kc0, int qc, int cs) {
    const int kl = lane & 15, g = lane >> 4;
    f32x4 s0 = {0.f, 0.f, 0.f, 0.f}, s1 = {0.f, 0.f, 0.f, 0.f};
#pragma unroll
    for (int dh = 0; dh < 2; ++dh) {
        const bf16x8 k0 = *(const LAS bf16x8*)(kb + swz_off(r0 + kl, dh * 4 + g)); const bf16x8 k1 = *(const LAS bf16x8*)(kb + swz_off(r1 + kl, dh * 4 + g));
        s0 = __builtin_amdgcn_mfma_f32_16x16x32_bf16(k0, qf[dh], s0, 0, 0, 0); s1 = __builtin_amdgcn_mfma_f32_16x16x32_bf16(k1, qf[dh], s1, 0, 0, 0);
    }
    float sc[8];
#pragma unroll
    for (int j = 0; j < 4; ++j) { sc[j] = s0[j] * 0.125f; sc[4 + j] = s1[j] * 0.125f; }
    if (LOCAL) {
#pragma unroll
        for (int j = 0; j < 8; ++j) { const int kc = kc0 + (j >> 2) * 16 + 4 * g + (j & 3); const bool ok = (kc >= cs) && (kc < cs + 16); const int bi = ok ? (kc - qc + 15) : 0; const float bv = rpbrow[bi]; sc[j] = ok ? sc[j] + bv : -INFINITY; }
    }
    float mt = fmaxf(fmaxf(fmaxf(sc[0], sc[1]), fmaxf(sc[2], sc[3])), fmaxf(fmaxf(sc[4], sc[5]), fmaxf(sc[6], sc[7])));
    mt = fmaxf(mt, __shfl_xor(mt, 16)); mt = fmaxf(mt, __shfl_xor(mt, 32));
    const float mn = fmaxf(st.m, mt); const bool dead = (mn == -INFINITY);
    const float scale = dead ? 1.0f : __expf(st.m - mn);
    float p[8], ps = 0.f;
#pragma unroll
    for (int j = 0; j < 8; ++j) { p[j] = dead ? 0.f : __expf(sc[j] - mn); ps += p[j]; }
    st.l = st.l * scale + ps; st.m = mn;
#pragma unroll
    for (int dt = 0; dt < 4; ++dt) st.o[dt] = st.o[dt] * scale;
    v4u pw; pw.x = pk2(p[0], p[1]); pw.y = pk2(p[2], p[3]); pw.z = pk2(p[4], p[5]); pw.w = pk2(p[6], p[7]);
    const bf16x8 pf = __builtin_bit_cast(bf16x8, pw);
    const int q_ = kl >> 2, p_ = kl & 3;
#pragma unroll
    for (int dt = 0; dt < 4; ++dt) {
        const v4i16_t lo = __builtin_amdgcn_ds_read_tr16_b64_v4i16((LAS v4i16_t*)(vb + swz_off(r0 + 4 * g + q_, 2 * dt + (p_ >> 1)) + (p_ & 1) * 8));
        const v4i16_t hi = __builtin_amdgcn_ds_read_tr16_b64_v4i16((LAS v4i16_t*)(vb + swz_off(r1 + 4 * g + q_, 2 * dt + (p_ >> 1)) + (p_ & 1) * 8));
        const bf16x8 vf = (bf16x8){lo[0], lo[1], lo[2], lo[3], hi[0], hi[1], hi[2], hi[3]};
        st.o[dt] = __builtin_amdgcn_mfma_f32_16x16x32_bf16(vf, pf, st.o[dt], 0, 0, 0);
    }
}
__device__ __forceinline__ void att_merge_store(AttState& st, LAS float* mrg, int qb, int kh, int lane, bf16* orow0  ) {
    LAS float* mine = mrg + qb * (18 * 64) + lane;
    if (kh == 1) { mine[0] = st.m; mine[64] = st.l;
#pragma unroll
        for (int dt = 0; dt < 4; ++dt)
#pragma unroll
            for (int j = 0; j < 4; ++j) mine[(2 + dt * 4 + j) * 64] = st.o[dt][j]; }
    __syncthreads();
    if (kh == 0) {
        const float m1 = mine[0], l1 = mine[64]; const float ms = fmaxf(st.m, m1); const float f0 = __expf(st.m - ms), f1 = __expf(m1 - ms);
        float lc = st.l * f0 + l1 * f1; lc += __shfl_xor(lc, 16); lc += __shfl_xor(lc, 32); const float inv = 1.0f / lc;
        const int q = lane & 15, g = lane >> 4;
#pragma unroll
        for (int dt = 0; dt < 4; ++dt) { float r[4];
#pragma unroll
            for (int j = 0; j < 4; ++j) r[j] = (st.o[dt][j] * f0 + mine[(2 + dt * 4 + j) * 64] * f1) * inv;
            v2u w; w.x = pk2(r[0], r[1]); w.y = pk2(r[2], r[3]); *(GAS v2u*)(orow0 + (size_t)q * DM + dt * 16 + 4 * g) = w; }
    }
}
__device__ __forceinline__ void phase_attn(const Args& a, LAS unsigned char* lds, int l) {
    const int tid = threadIdx.x, lane = tid & 63, wv = __builtin_amdgcn_readfirstlane(tid >> 6), qb = wv & 3, kh = wv >> 2;
    LAS unsigned char* KC = lds; LAS unsigned char* VC = lds + 32768; LAS unsigned char* KL = lds + 65536; LAS unsigned char* VL = lds + 98304;
    LAS float* RPB = (LAS float*)(lds + LDSCTL_OFF + 2048); LAS float* mrg = (LAS float*)KL;
    const bf16* PX = (const bf16*)(a.ws + WS_X2); bf16* CAT = (bf16*)(a.ws + WS_X1);
    for (int blk = blockIdx.x; blk < 256; blk += gridDim.x) {
        const int bh = blk >> 1, b = bh >> 3, h = bh & 7, half = blk & 1;
        __syncthreads();
        const bf16* ctxrow = PX + (size_t)(NTX + b * CTXL) * DINP + h * 64;
        stage_rows(KC, ctxrow + 512, 256, tid); stage_rows(VC, ctxrow + 1024, 256, tid);
        for (int i = tid; i < 465; i += 512) RPB[i] = a.in[I_RPB][((size_t)l * 8 + h) * 465 + i];
        __syncthreads();
        const int kl = lane & 15, g = lane >> 4;
        if (l == 0) {
            for (int rr = 0; rr < 2; ++rr) {
                const int q0 = (half * 8 + rr * 4 + qb) * 16; const bf16* qrow = ctxrow + (size_t)(q0 + kl) * DINP;
                bf16x8 qf[2]; qf[0] = *(const GAS bf16x8*)(qrow + 8 * g); qf[1] = *(const GAS bf16x8*)(qrow + 32 + 8 * g);
                AttState st; st.m = -INFINITY; st.l = 0.f;
#pragma unroll
                for (int dt = 0; dt < 4; ++dt) st.o[dt] = (f32x4){0.f, 0.f, 0.f, 0.f};
                for (int s = 0; s < 4; ++s) att_kstep<false>(st, KC, VC, kh * 128 + s * 32, kh * 128 + s * 32 + 16, qf, lane, RPB, 0, 0, 0);
                att_merge_store(st, mrg, qb, kh, lane, CAT + (size_t)(NTX + b * CTXL + q0) * DM + h * 64);
                __syncthreads();
            }
        }
        for (int ui = 0; ui < 16; ++ui) {
            const int i = half * 16 + ui; const int rs = min(max(i - 4, 0), 24);
            const int qc = qb * 16 + kl, cs = min(max(qc - 8, 0), 48), wc0 = min(max(qb * 16 - 8, 0), 32);
            const bf16* qrow = PX + (size_t)(b * SEQ + i * 64 + qc) * DINP + h * 64;
            bf16x8 qf[2]; qf[0] = *(const GAS bf16x8*)(qrow + 8 * g); qf[1] = *(const GAS bf16x8*)(qrow + 32 + 8 * g);
            AttState st; st.m = -INFINITY; st.l = 0.f;
#pragma unroll
            for (int dt = 0; dt < 4; ++dt) st.o[dt] = (f32x4){0.f, 0.f, 0.f, 0.f};
            for (int s = 0; s < 4; ++s) att_kstep<false>(st, KC, VC, kh * 128 + s * 32, kh * 128 + s * 32 + 16, qf, lane, RPB, 0, 0, 0);
            for (int pass = 0; pass < 2; ++pass) {
                __syncthreads();
                const bf16* lrow = PX + (size_t)(b * SEQ + (rs + 4 * pass) * 64) * DINP + h * 64;
                stage_rows(KL, lrow + 512, 256, tid); stage_rows(VL, lrow + 1024, 256, tid);
                __syncthreads();
                for (int k2 = 0; k2 < 2; ++k2) { const int kr = 2 * kh + k2, arow = rs + 4 * pass + kr;
                    att_kstep<true>(st, KL, VL, kr * 64 + wc0, kr * 64 + wc0 + 16, qf, lane, RPB + (arow - i + 7) * 31, wc0, qc, cs); }
            }
            __syncthreads();
            att_merge_store(st, mrg, qb, kh, lane, CAT + (size_t)(b * SEQ + i * 64 + qb * 16) * DM + h * 64);
        }
    }
}

__device__ __forceinline__ void phase_rwpost(const Args& a, LAS unsigned char* lds, int l) {
    const int tid = threadIdx.x, c = tid, hh = tid >> 6;
    LAS float* sigT = (LAS float*)lds;
    const bf16* PX = (const bf16*)(a.ws + WS_X2); const float* YD = (const float*)(a.ws + WS_X3); const float* BON = (const float*)(a.ws + WS_BONUS); bf16* CAT = (bf16*)(a.ws + WS_X1);
    const float* mup = a.in[I_MUP] + l * 1760; const float* mun = a.in[I_MUN] + l * 1760; const float* g2 = a.in[I_G2] + (size_t)l * 96 * 512;
    const float gng = a.in[I_GNG][l * 512 + c], gnb = a.in[I_GNB][l * 512 + c], mpv = mup[1024 + c], mnv = mun[1024 + c];
    const int nch = (l == 0 ? NTOK : NTX) / 16;
    for (int ch = blockIdx.x; ch < nch; ch += gridDim.x) {
        const int row0 = ch * 16;
        __syncthreads();
        for (int idx = tid; idx < 1536; idx += 512) { const int r = idx / 96, j = idx - r * 96, row = row0 + r; int t, T; if (row < NTX) { t = row & (SEQ - 1); T = SEQ; } else { t = (row - NTX) & (CTXL - 1); T = CTXL; }
            const bf16* p = PX + (size_t)row * DINP + RWOFF + 1664 + j; const float cv = bf2f(p[0]), pv = t > 0 ? bf2f(p[-DINP]) : 0.f, nv = t + 1 < T ? bf2f(p[DINP]) : 0.f;
            const float z = cv + mup[1664 + j] * (pv - cv) + mun[1664 + j] * (nv - cv); sigT[j * 16 + r] = sigmoidf_(z); }
        __syncthreads();
        float ga[16];
#pragma unroll
        for (int r = 0; r < 16; ++r) ga[r] = 0.f;
        for (int j = 0; j < 96; ++j) { const float gv = g2[j * 512 + c];
#pragma unroll
            for (int r4 = 0; r4 < 4; ++r4) { const f32x4 s = *(const LAS f32x4*)(sigT + j * 16 + r4 * 4); ga[r4 * 4] += s.x * gv; ga[r4 * 4 + 1] += s.y * gv; ga[r4 * 4 + 2] += s.z * gv; ga[r4 * 4 + 3] += s.w * gv; } }
#pragma unroll
        for (int r = 0; r < 16; ++r) { const int row = row0 + r; int t, T; if (row < NTX) { t = row & (SEQ - 1); T = SEQ; } else { t = (row - NTX) & (CTXL - 1); T = CTXL; }
            const float y = YD[(size_t)row * 512 + c] + YD[((size_t)NTOK + row) * 512 + c];
            const float mean = wave_sum(y) * (1.0f / 64.0f); const float dv = y - mean; const float var = wave_sum(dv * dv) * (1.0f / 64.0f);
            const float yn = dv * (1.0f / sqrtf(var + GN_EPS)) * gng + gnb;
            const bf16* p = PX + (size_t)row * DINP + RWOFF + 1024 + c; const float cv = bf2f(p[0]), pv = t > 0 ? bf2f(p[-DINP]) : 0.f, nv = t + 1 < T ? bf2f(p[DINP]) : 0.f;
            const float zv = cv + mpv * (pv - cv) + mnv * (nv - cv);
            const float bon = BON[(size_t)row * 8 + hh] + BON[((size_t)NTOK + row) * 8 + hh];
            CAT[(size_t)row * DM + 512 + c] = (bf16)f2bf((yn + bon * zv) * ga[r]); }
    }
}

__device__ __forceinline__ void phase_ln1_route(const Args& a, LAS unsigned char* lds, int l) {
    const int tid = threadIdx.x, lane = tid & 63, wave = __builtin_amdgcn_readfirstlane(tid >> 6), G = gridDim.x, bid = blockIdx.x;
    const int gw = bid * 8 + wave, NGW = G * 8;
    LAS float* rwt = (LAS float*)lds;
    for (int i = tid; i < 32768; i += 512) { const int k = i >> 5, e = i & 31; rwt[e * 1024 + k] = a.in[I_RW][i]; }
    __syncthreads();
    const float* mods = (const float*)(a.ws + WS_MODS) + (size_t)l * 17 * 6144;
    const bf16* O = (const bf16*)(a.ws + WS_X3); bf16* HM = (bf16*)(a.ws + WS_X1);
    const float* xs = l == 0 ? a.in[I_X] : a.out; const float* cs = l == 0 ? a.in[I_CTX] : (const float*)(a.ws + WS_CS);
    float* xo = a.out; float* co = (float*)(a.ws + WS_CS);
    int* LIST = (int*)(a.ws + WS_LIST); TokInfo* TOK = (TokInfo*)(a.ws + WS_TOK); unsigned* cnt = (unsigned*)(a.ws + WS_CTL) + CW_CNT + l * 64;
    const GAS f32x4* lg = (const GAS f32x4*)(a.in[I_LN1G] + l * DM) + lane; const GAS f32x4* lb = (const GAS f32x4*)(a.in[I_LN1B] + l * DM) + lane;
    const int Mrows = l == 0 ? NTOK : NTX;
    const float biasv = a.in[I_RB][(lane >> 1) & 31];
    for (int m = gw; m < Mrows; m += NGW) {
        const float* src; float* dst; int mr;
        if (m < NTX) { src = xs + (size_t)m * DM; dst = xo + (size_t)m * DM; mr = m / SEQ; } else { src = cs + (size_t)(m - NTX) * DM; dst = co + (size_t)(m - NTX) * DM; mr = 16; }
        const GAS f32x4* xr = (const GAS f32x4*)src + lane; const GAS f32x4* md = (const GAS f32x4*)(mods + (size_t)mr * 6144) + lane;
        const GAS v2u* orow = (const GAS v2u*)(O + (size_t)m * DM) + lane;
        f32x4 v[4]; float s = 0.f;
#pragma unroll
        for (int j = 0; j < 4; ++j) { const f32x4 x = xr[64 * j], gt = md[512 + 64 * j]; const v2u ow = orow[64 * j]; const f32x4 o = {bflo(ow.x), bfhi(ow.x), bflo(ow.y), bfhi(ow.y)};
            v[j] = x * ALPHA + gt * o; s += (v[j].x + v[j].y) + (v[j].z + v[j].w); }
        const float mean = wave_sum(s) * (1.f / DM); float s2 = 0.f;
#pragma unroll
        for (int j = 0; j < 4; ++j) { v[j] = v[j] - mean; s2 += (v[j].x * v[j].x + v[j].y * v[j].y) + (v[j].z * v[j].z + v[j].w * v[j].w); }
        const float rstd = 1.f / sqrtf(wave_sum(s2) * (1.f / DM) + LN_EPS);
        float part[32];
#pragma unroll
        for (int e = 0; e < 32; ++e) part[e] = 0.f;
        GAS f32x4* dr = (GAS f32x4*)dst + lane; GAS v2u* hr = (GAS v2u*)(HM + (size_t)m * DM) + lane;
#pragma unroll
        for (int j = 0; j < 4; ++j) { const f32x4 x1 = v[j] * rstd * lg[64 * j] + lb[64 * j]; dr[64 * j] = x1;
            const f32x4 hm = x1 * (md[1024 + 64 * j] + 1.0f) + md[768 + 64 * j]; v2u w; w.x = pk2(hm.x, hm.y); w.y = pk2(hm.z, hm.w); hr[64 * j] = w;
#pragma unroll
            for (int e = 0; e < 32; ++e) { const f32x4 rw = *(const LAS f32x4*)(rwt + e * 1024 + 256 * j + 4 * lane); part[e] += hm.x * rw.x + hm.y * rw.y + hm.z * rw.z + hm.w * rw.w;
                if ((e & 7) == 7) asm volatile("" ::: "memory"); } }
        float p16[16], p8[8], p4[4], p2[2], p1;
        { const bool up = (lane & 32) != 0;
#pragma unroll
          for (int e = 0; e < 16; ++e) { const float mine = up ? part[16 + e] : part[e], oth = up ? part[e] : part[16 + e]; p16[e] = mine + __shfl_xor(oth, 32); } }
        { const bool up = (lane & 16) != 0;
#pragma unroll
          for (int e = 0; e < 8; ++e) { const float mine = up ? p16[8 + e] : p16[e], oth = up ? p16[e] : p16[8 + e]; p8[e] = mine + __shfl_xor(oth, 16); } }
        { const bool up = (lane & 8) != 0;
#pragma unroll
          for (int e = 0; e < 4; ++e) { const float mine = up ? p8[4 + e] : p8[e], oth = up ? p8[e] : p8[4 + e]; p4[e] = mine + __shfl_xor(oth, 8); } }
        { const bool up = (lane & 4) != 0;
#pragma unroll
          for (int e = 0; e < 2; ++e) { const float mine = up ? p4[2 + e] : p4[e], oth = up ? p4[e] : p4[2 + e]; p2[e] = mine + __shfl_xor(oth, 4); } }
        { const bool up = (lane & 2) != 0; const float mine = up ? p2[1] : p2[0], oth = up ? p2[0] : p2[1]; p1 = mine + __shfl_xor(oth, 2); }
        const float logit = p1 + __shfl_xor(p1, 1);
        const float score = sigmoidf_(logit), sel = score + biasv;
        const int gl = lane & ~7;
        const float q0 = __shfl(sel, gl), q1 = __shfl(sel, gl + 2), q2 = __shfl(sel, gl + 4), q3 = __shfl(sel, gl + 6);
        const float mx = fmaxf(fmaxf(q0, q1), fmaxf(q2, q3));
        float top2;
        { float a0 = q0, a1 = q1, a2 = q2, a3 = q3; float t;
          if (a0 < a1) { t = a0; a0 = a1; a1 = t; } if (a2 < a3) { t = a2; a2 = a3; a3 = t; } if (a0 < a2) { t = a0; a0 = a2; a2 = t; } if (a1 < a3) { t = a1; a1 = a3; a3 = t; } if (a1 < a2) { t = a1; a1 = a2; a2 = t; }
          top2 = a0 + a1; (void)mx; }
        float best = __shfl(top2, 0); int gidx = 0;
#pragma unroll
        for (int gg = 1; gg < 8; ++gg) { const float sc = __shfl(top2, gg * 8); if (sc > best) { best = sc; gidx = gg; } }
        const float r0 = __shfl(sel, gidx * 8), r1 = __shfl(sel, gidx * 8 + 2), r2 = __shfl(sel, gidx * 8 + 4), r3 = __shfl(sel, gidx * 8 + 6);
        int i0 = 0; float b0 = r0; if (r1 > b0) { b0 = r1; i0 = 1; } if (r2 > b0) { b0 = r2; i0 = 2; } if (r3 > b0) { b0 = r3; i0 = 3; }
        int i1 = -1; float b1 = -INFINITY;
        if (i0 != 0 && r0 > b1) { b1 = r0; i1 = 0; } if (i0 != 1 && r1 > b1) { b1 = r1; i1 = 1; } if (i0 != 2 && r2 > b1) { b1 = r2; i1 = 2; } if (i0 != 3 && r3 > b1) { b1 = r3; i1 = 3; }
        const int e0 = gidx * 4 + i0, e1 = gidx * 4 + i1;
        const float s0 = __shfl(score, 2 * e0), s1 = __shfl(score, 2 * e1); const float gs = 1.0f / (s0 + s1);
        if (lane == 0) { const int p0 = (int)atomicAdd(cnt + e0, 1u), p1_ = (int)atomicAdd(cnt + e1, 1u);
            LIST[(size_t)e0 * LISTCAP + p0] = m; LIST[(size_t)e1 * LISTCAP + p1_] = m;
            TokInfo ti; ti.e0 = e0; ti.e1 = e1; ti.p0 = p0; ti.p1 = p1_; ti.g0 = s0 * gs; ti.g1 = s1 * gs; ti.pad0 = 0; ti.pad1 = 0; TOK[m] = ti; }
    }
}

__device__ __forceinline__ void moe_prefix(const Args& a, LAS unsigned char* lds, int l) {
    LAS int* pref = (LAS int*)(lds + PREF_OFF);
    __syncthreads();
    if (threadIdx.x == 0) { const unsigned* cnt = (const unsigned*)(a.ws + WS_CTL) + CW_CNT + l * 64; int acc = 0;
        for (int e = 0; e < 32; ++e) { const int c = (int)__hip_atomic_load(cnt + e, RLX_AGENT); pref[e] = acc; pref[40 + e] = c; acc += (c + 255) >> 8; } pref[32] = acc; }
    __syncthreads();
}
__device__ __forceinline__ void phase_gather(const Args& a, LAS unsigned char* lds, int l) {
    const int tid = threadIdx.x, lane = tid & 63, wave = __builtin_amdgcn_readfirstlane(tid >> 6), G = gridDim.x, bid = blockIdx.x;
    const int gw = bid * 8 + wave, NGW = G * 8;
    moe_prefix(a, lds, l);
    const LAS int* pref = (const LAS int*)(lds + PREF_OFF);
    const bf16* HM = (const bf16*)(a.ws + WS_X1); bf16* XB = (bf16*)(a.ws + WS_X2); const int* LIST = (const int*)(a.ws + WS_LIST);
    const int total = pref[32] * 256;
    for (int slot = gw; slot < total; slot += NGW) {
        const int rt = slot >> 8; int e = 0;
        for (int k = 1; k < 32; ++k) e += (pref[k] <= rt) ? 1 : 0;
        const int pos = slot - pref[e] * 256; GAS v4u* dst = (GAS v4u*)(XB + (size_t)slot * DM) + lane;
        if (pos < pref[40 + e]) { const int tok = LIST[(size_t)e * LISTCAP + pos]; const GAS v4u* srcp = (const GAS v4u*)(HM + (size_t)tok * DM) + lane; dst[0] = srcp[0]; dst[64] = srcp[64]; }
        else { dst[0] = (v4u){0u, 0u, 0u, 0u}; dst[64] = (v4u){0u, 0u, 0u, 0u}; }
    }
}

__device__ __forceinline__ void phase_ln2(const Args& a, LAS unsigned char* lds, int l) {
    const int tid = threadIdx.x, lane = tid & 63, wave = __builtin_amdgcn_readfirstlane(tid >> 6), G = gridDim.x, bid = blockIdx.x;
    const int gw = bid * 8 + wave, NGW = G * 8;
    moe_prefix(a, lds, l);
    const LAS int* pref = (const LAS int*)(lds + PREF_OFF);
    const float* mods = (const float*)(a.ws + WS_MODS) + (size_t)l * 17 * 6144;
    const bf16* Y = (const bf16*)(a.ws + WS_X2); const TokInfo* TOK = (const TokInfo*)(a.ws + WS_TOK);
    float* xo = a.out; float* co = (float*)(a.ws + WS_CS);
    const GAS f32x4* lg = (const GAS f32x4*)(a.in[I_LN2G] + l * DM) + lane; const GAS f32x4* lb = (const GAS f32x4*)(a.in[I_LN2B] + l * DM) + lane;
    const int Mrows = l == 0 ? NTOK : NTX;
    for (int m = gw; m < Mrows; m += NGW) {
        float* xr_; int mr;
        if (m < NTX) { xr_ = xo + (size_t)m * DM; mr = m / SEQ; } else { xr_ = co + (size_t)(m - NTX) * DM; mr = 16; }
        const TokInfo ti = TOK[m];
        const int sl0 = pref[ti.e0] * 256 + ti.p0, sl1 = pref[ti.e1] * 256 + ti.p1;
        GAS f32x4* xr = (GAS f32x4*)xr_ + lane; const GAS f32x4* md = (const GAS f32x4*)(mods + (size_t)mr * 6144) + lane;
        const GAS v2u* y0 = (const GAS v2u*)(Y + (size_t)sl0 * DM) + lane; const GAS v2u* y1 = (const GAS v2u*)(Y + (size_t)sl1 * DM) + lane;
        f32x4 v[4]; float s = 0.f;
#pragma unroll
        for (int j = 0; j < 4; ++j) { const f32x4 x = xr[64 * j], gt = md[1280 + 64 * j]; const v2u a0 = y0[64 * j], a1 = y1[64 * j];
            const f32x4 ya = {bflo(a0.x), bfhi(a0.x), bflo(a0.y), bfhi(a0.y)}, yb = {bflo(a1.x), bfhi(a1.x), bflo(a1.y), bfhi(a1.y)};
            v[j] = x * ALPHA + gt * (ya * ti.g0 + yb * ti.g1); s += (v[j].x + v[j].y) + (v[j].z + v[j].w); }
        const float mean = wave_sum(s) * (1.f / DM); float s2 = 0.f;
#pragma unroll
        for (int j = 0; j < 4; ++j) { v[j] = v[j] - mean; s2 += (v[j].x * v[j].x + v[j].y * v[j].y) + (v[j].z * v[j].z + v[j].w * v[j].w); }
        const float rstd = 1.f / sqrtf(wave_sum(s2) * (1.f / DM) + LN_EPS);
#pragma unroll
        for (int j = 0; j < 4; ++j) xr[64 * j] = v[j] * rstd * lg[64 * j] + lb[64 * j];
    }
}

constexpr int PH_PER_LAYER = 11, N_PHASES = 1 + 2 * PH_PER_LAYER;
template <int K> __device__ __forceinline__ void run_phase(const Args& args, LAS unsigned char* lds, int l) {
    const int G = gridDim.x, bid = blockIdx.x;
    bf16* X1 = (bf16*)(args.ws + WS_X1); bf16* X2 = (bf16*)(args.ws + WS_X2); bf16* X3 = (bf16*)(args.ws + WS_X3);
    const int Mrows = (l == 0) ? NTOK : NTX;
    if constexpr (K == 0) phase_prologue(args, lds);
    if constexpr (K == 1) phase_modconv(args, lds, l);
    if constexpr (K == 2) { __syncthreads();
        pg8::Gemm g{X1, (const bf16*)(args.ws + WS_WINT) + (size_t)l * DINP * DM, NTOK, DINP, DM}; pg8::StaticOrder S; S.init(NTOK, DINP, G, bid);
        pg8::EpiBf16 E{X2, DINP}; pg8::gemm_phase<pg8::EpiBf16, pg8::StaticOrder, true, true>(lds, g, S, E); }
    if constexpr (K == 3) phase_scan(args, lds, l);
    if constexpr (K == 4) phase_attn(args, lds, l);
    if constexpr (K == 5) phase_rwpost(args, lds, l);
    if constexpr (K == 6) { __syncthreads();
        pg8::Gemm g{X1, (const bf16*)(args.ws + WS_WOT) + (size_t)l * DM * DM, Mrows, DM, DM}; pg8::StaticOrder S; S.init(Mrows, DM, G, bid);
        pg8::EpiBf16 E{X3, DM}; pg8::gemm_phase<pg8::EpiBf16, pg8::StaticOrder, true, true>(lds, g, S, E); }
    if constexpr (K == 7) phase_ln1_route(args, lds, l);
    if constexpr (K == 8) phase_gather(args, lds, l);
    if constexpr (K == 9) { moe_prefix(args, lds, l);
        pg8::Gemm g{X2, (const bf16*)(args.ws + WS_W13T), MAXSLOT, 1024, DM}; pg8::MoeOrder S; S.init((const LAS int*)(lds + PREF_OFF), 4, G, bid);
        pg8::EpiSwiGLU E{X3, DEXP}; pg8::gemm_phase<pg8::EpiSwiGLU, pg8::MoeOrder, true, true>(lds, g, S, E); }
    if constexpr (K == 10) { moe_prefix(args, lds, l);
        pg8::Gemm g{X3, (const bf16*)(args.ws + WS_W2T), MAXSLOT, 1024, DEXP}; pg8::MoeOrder S; S.init((const LAS int*)(lds + PREF_OFF), 4, G, bid);
        pg8::EpiBf16 E{X2, DM}; pg8::gemm_phase<pg8::EpiBf16, pg8::MoeOrder, true, true>(lds, g, S, E); }
    if constexpr (K == 11) phase_ln2(args, lds, l);
}
template <int K> __global__ void __launch_bounds__(512, 2) fwd_ph(Args args) {
    extern __shared__ __attribute__((aligned(16))) unsigned char lds_raw[];
    LAS unsigned char* lds = (LAS unsigned char*)lds_raw;
    for (int u = threadIdx.x; u < (LDS_BYTES - LDSCTL_OFF) / 4; u += 512) ((LAS unsigned*)(lds + LDSCTL_OFF))[u] = 0u;
    __syncthreads();
    run_phase<K>(args, lds, args.ph_lo);
}
template <int K> static void launch_ph(const Args& a, int grid, hipStream_t stream) {
    static bool attr = false;
    if (!attr) { (void)hipFuncSetAttribute((const void*)fwd_ph<K>, hipFuncAttributeMaxDynamicSharedMemorySize, LDS_BYTES); attr = true; }
    hipLaunchKernelGGL(fwd_ph<K>, dim3(grid), dim3(512), LDS_BYTES, stream, a);
}

extern "C" void kernel_launch(void* const* d_in, const int* in_sizes, int n_in, void* d_out, int out_size, void* d_ws, size_t ws_size, hipStream_t stream) {
    static int grid = 0;
    if (grid == 0) {
        if (n_in != 30 || in_sizes[0] != NTX * DM || out_size != NTX * DM || ws_size < WS_END) {
            fprintf(stderr, "kernel_launch: unexpected problem (n_in %d, in0 %d, out %d, ws %zu < %zu?); nothing launched\n", n_in, n_in > 0 ? in_sizes[0] : -1, out_size, ws_size, (size_t)WS_END); grid = -1; return; }
        int dev = 0, cus = 0;
        if (hipGetDevice(&dev) != hipSuccess || hipDeviceGetAttribute(&cus, hipDeviceAttributeMultiprocessorCount, dev) != hipSuccess) { grid = -1; return; }
        (void)hipGetLastError();
        grid = cus > 0 ? cus : 256;
    }
    if (grid < 0) return;
    if (hipMemsetAsync((char*)d_ws + WS_CTL, 0, CTL_ZERO_BYTES, stream) != hipSuccess) return;
    Args a{};
    for (int i = 0; i < 30; ++i) a.in[i] = (const float*)d_in[i];
    a.out = (float*)d_out; a.ws = (unsigned char*)d_ws; a.ph_hi = 0;
    a.ph_lo = 0; launch_ph<0>(a, grid, stream);
    for (int l = 0; l < 2; ++l) { a.ph_lo = l;
        launch_ph<1>(a, grid, stream); launch_ph<2>(a, grid, stream); launch_ph<3>(a, grid, stream); launch_ph<4>(a, grid, stream); launch_ph<5>(a, grid, stream); launch_ph<6>(a, grid, stream);
        launch_ph<7>(a, grid, stream); launch_ph<8>(a, grid, stream); launch_ph<9>(a, grid, stream); launch_ph<10>(a, grid, stream); launch_ph<11>(a, grid, stream); }
}
```

```cpp
#define ONE_LAUNCH 1
#include <hip/hip_runtime.h>
#include <cstdio>
#include <cstdint>

constexpr int DM = 1024, NB = 16, SEQ = 2048, CTXL = 256, NTX = NB * SEQ, NTC = NB * CTXL, NTOK = NTX + NTC;
constexpr int DIN = 3296, DINP = 3328, RWOFF = 1536, NHEAD = 8, HD = 64;
constexpr int NEXP = 32, DEXP = 512, LISTCAP = 2 * NTOK;
constexpr int MAXSLOT = 81920;
constexpr float ALPHA = 1.41421356237309515f, LN_EPS = 1e-6f, GN_EPS = 64e-5f;

constexpr size_t MiB = 1u << 20;
constexpr size_t WS_CTL = 0, CTL_ZERO_BYTES = 1 * MiB;
constexpr size_t WS_MODS = 1 * MiB;
constexpr size_t WS_ROPE = 2 * MiB;
constexpr size_t WS_WINT = 3 * MiB;
constexpr size_t WS_WOT = 16 * MiB;
constexpr size_t WS_W13T = 20 * MiB;
constexpr size_t WS_W2T = 84 * MiB;
constexpr size_t WS_LIST = 116 * MiB;
constexpr size_t WS_TOK = 125 * MiB;
constexpr size_t WS_BONUS = 127 * MiB;
constexpr size_t WS_CS = 130 * MiB;
constexpr size_t WS_X1 = 146 * MiB;
constexpr size_t WS_X2 = 218 * MiB;
constexpr size_t WS_X3 = 452 * MiB;
constexpr size_t WS_END = 596 * MiB;
static_assert(WS_WINT + (size_t)2 * DINP * DM * 2 <= WS_WOT && WS_LIST + (size_t)NEXP * LISTCAP * 4 <= WS_TOK && WS_TOK + (size_t)NTOK * 32 <= WS_BONUS, "ws map");
static_assert(WS_BONUS + (size_t)2 * NTOK * 8 * 4 <= WS_CS && WS_X2 + (size_t)NTOK * DINP * 2 <= WS_X3 && WS_X3 + (size_t)2 * NTOK * 512 * 4 <= WS_END, "ws map");
static_assert((size_t)MAXSLOT * 1024 * 2 <= WS_X3 - WS_X2 && (size_t)MAXSLOT * 512 * 2 <= WS_END - WS_X3, "ws map");
constexpr int CW_BAR = 4096;
constexpr int CW_CNT = 8192;
constexpr int RING_BYTES = 131072, LDSCTL_OFF = RING_BYTES, MISC_OFF = LDSCTL_OFF + 320, LDS_BYTES = 147456;
constexpr int PREF_OFF = LDSCTL_OFF + 512;

#define GAS __attribute__((address_space(1)))
#define LAS __attribute__((address_space(3)))
typedef unsigned short bf16;
typedef unsigned v4u __attribute__((ext_vector_type(4)));
typedef unsigned v2u __attribute__((ext_vector_type(2)));
typedef float f32x4 __attribute__((ext_vector_type(4)));
typedef short bf16x8 __attribute__((ext_vector_type(8)));
typedef GAS unsigned gu32;
#define RLX_AGENT __ATOMIC_RELAXED, __HIP_MEMORY_SCOPE_AGENT
#define LDS_WAIT() asm volatile("s_waitcnt lgkmcnt(0)" ::: "memory")
#define VM_WAIT() asm volatile("s_waitcnt vmcnt(0)" ::: "memory")
__device__ __forceinline__ unsigned f2bf(float f) { unsigned u = __builtin_bit_cast(unsigned, f); return (u + 0x7fffu + ((u >> 16) & 1u)) >> 16; }
typedef float f32x2_t_ __attribute__((ext_vector_type(2))); typedef __bf16 bf16x2_t_ __attribute__((ext_vector_type(2)));
__device__ __forceinline__ unsigned pk2(float lo, float hi) { f32x2_t_ v = {lo, hi}; bf16x2_t_ b = __builtin_convertvector(v, bf16x2_t_); return __builtin_bit_cast(unsigned, b); }
__device__ __forceinline__ unsigned short f2bf1(float f) { return (unsigned short)(pk2(f, 0.f) & 0xffffu); }
__device__ __forceinline__ float bf2f(unsigned short v) { return __builtin_bit_cast(float, (unsigned)v << 16); }
__device__ __forceinline__ float bflo(unsigned w) { return __builtin_bit_cast(float, w << 16); }
__device__ __forceinline__ float bfhi(unsigned w) { return __builtin_bit_cast(float, w & 0xffff0000u); }
__device__ __forceinline__ float sigmoidf_(float x) { return 1.0f / (1.0f + expf(-x)); }
__device__ __forceinline__ float shx(float v, int k, int lane) { return __builtin_bit_cast(float, __builtin_amdgcn_ds_bpermute((lane ^ k) << 2, __builtin_bit_cast(int, v))); }
__device__ __forceinline__ float shi(float v, int src) { return __builtin_bit_cast(float, __builtin_amdgcn_ds_bpermute(src << 2, __builtin_bit_cast(int, v))); }
template <int CTRL> __device__ __forceinline__ float dppmov(float v) { return __builtin_bit_cast(float, __builtin_amdgcn_update_dpp(0, __builtin_bit_cast(int, v), CTRL, 0xF, 0xF, true)); }
__device__ __forceinline__ float wave_sum(float v) {
    v += dppmov<0xB1>(v); v += dppmov<0x4E>(v); v += dppmov<0x141>(v); v += dppmov<0x140>(v);
    const int iv = __builtin_bit_cast(int, v);
    return (__builtin_bit_cast(float, __builtin_amdgcn_readlane(iv, 0)) + __builtin_bit_cast(float, __builtin_amdgcn_readlane(iv, 16))) + (__builtin_bit_cast(float, __builtin_amdgcn_readlane(iv, 32)) + __builtin_bit_cast(float, __builtin_amdgcn_readlane(iv, 48)));
}
__device__ __forceinline__ float red8(float v) { v += dppmov<0xB1>(v); v += dppmov<0x4E>(v); v += dppmov<0x141>(v); return v; }

struct TokInfo { int e0, e1, p0, p1; float g0, g1; int pad0, pad1; };

constexpr int WID_OFF = LDSCTL_OFF + 1536;
__device__ __forceinline__ int hw_slot() { return (int)__builtin_amdgcn_s_getreg((5 << 11) | 4) & 63; }
__device__ __forceinline__ int lane_id() { int l; asm volatile("v_mbcnt_lo_u32_b32 %0, -1, 0\n\tv_mbcnt_hi_u32_b32 %0, -1, %0" : "=v"(l)); return l; }
__device__ __forceinline__ void hw_tid_init() { *(volatile LAS int*)(uintptr_t)(WID_OFF + 4 * hw_slot()) = (int)(threadIdx.x >> 6); }
__device__ __forceinline__ int hw_tid() { const int w = *(volatile LAS int*)(uintptr_t)(WID_OFF + 4 * hw_slot()); int t = (__builtin_amdgcn_readfirstlane(w) << 6) | lane_id(); asm volatile("" : "+v"(t)); return t; }
namespace pg8 {
#define PG8_LAS __attribute__((address_space(3)))
typedef unsigned short bf16_t;
typedef short bf16x8 __attribute__((ext_vector_type(8)));
typedef float f32x4 __attribute__((ext_vector_type(4)));
typedef unsigned u32x4 __attribute__((ext_vector_type(4)));
constexpr int BM = 256, BK = 64, HALF = 128, HTB = HALF * BK * 2  , STAGE_BYTES = 8 * HTB, NXCD = 8, WGM = 8;

__host__ __device__ __forceinline__ int lds_byte(int r, int c) { const int st = (r >> 4) * 2 + (c >> 5), rr = r & 15, cc = c & 31, ob = rr * 64 + cc * 2; return st * 1024 + (ob ^ (((ob >> 9) & 1) << 5)); }
__host__ __device__ __forceinline__ void stage_rc(int b, int& R, int& C) { const int st = b / 1024, sb = b % 1024, swz = sb ^ (((sb >> 9) & 1) << 5); R = (st >> 1) * 16 + swz / 64; C = (st & 1) * 32 + (swz % 64) / 2; }
__host__ __device__ __forceinline__ int perm32(int rho) { const int n = rho >> 4, i = rho & 15; return 8 * (i >> 2) + 4 * n + (i & 3); }

struct Unit { int pm, pn, pnb; };
struct Gemm { const bf16_t* A; const bf16_t* Bt; int M, N, K; };

struct StaticOrder {
    int nM, nN, nwg, G, c;
    __host__ __device__ void init(int M, int N, int G_, int c_) { nM = M / BM; nN = N / BM; nwg = nM * nN; G = G_; c = c_; }
    __host__ __device__ bool next(int i, Unit& u) const {
        const long L = (long)i * G + c; if (L >= nwg) return false;
        int wgid = (int)L; { const int q = nwg / NXCD, r = nwg % NXCD, xcd = wgid % NXCD, off = wgid / NXCD; wgid = (xcd < r ? xcd * (q + 1) : r * (q + 1) + (xcd - r) * q) + off; }
        const int nig = WGM * nN, gid = wgid / nig, fm = gid * WGM, gsz = (nM - fm) < WGM ? (nM - fm) : WGM;
        u.pm = fm + ((wgid % nig) % gsz); u.pn = (wgid % nig) / gsz; u.pnb = u.pn; return true;
    }
    __device__ __forceinline__ void a_ready(const Unit&) const {}
    __device__ __forceinline__ void done(const Unit&) const {}
};

__device__ __forceinline__ unsigned cvt_pk_bf16(float lo, float hi) { unsigned r; asm volatile("v_cvt_pk_bf16_f32 %0, %1, %2" : "=v"(r) : "v"(lo), "v"(hi)); return r; }
template <class Epi, class Sched, bool ALIGN_EPI = false, bool SP2 = false>
__device__ __forceinline__ void gemm_phase(PG8_LAS unsigned char* lds, const Gemm g, const Sched& S, const Epi& E) {
    const int tid = hw_tid(), wid = __builtin_amdgcn_readfirstlane(tid >> 6), lane = tid & 63, wr = wid >> 2, wc = wid & 3, fr = lane & 15, fq = lane >> 4;
    const int K = g.K, nt = K / BK;
    unsigned voffA[2], voffB[2];
#pragma unroll
    for (int i = 0; i < 2; ++i) { int R, C; stage_rc(tid * 16 + i * 8192, R, C); const int Rb = Epi::PERM ? ((R & ~31) + perm32(R & 31)) : R;
        voffA[i] = (unsigned)(R * K + C) * 2u; voffB[i] = (unsigned)(Rb * K + C) * 2u; }
    const size_t kstep = (size_t)(BK * 2);
    const size_t hstep = (size_t)HALF * K * 2;
    const size_t tstep = 2 * hstep;
    const unsigned ldsw = (unsigned)wid * 1024u;
    const int aoff = lds_byte(wr * 64 + fr, fq * 8), boff = lds_byte(wc * 32 + fr, fq * 8);
#define PG8_SA(b, h) (((b) * 2 + (h)) * HTB)
#define PG8_SB(b, h) ((4 + (b) * 2 + (h)) * HTB)
#define PG8_STAGE(bufoff, gbase, voff) do { _Pragma("unroll") for (int _i = 0; _i < 2; ++_i) \
        __builtin_amdgcn_global_load_lds((const unsigned*)((const char*)(gbase) + (voff)[_i]), (PG8_LAS unsigned*)(lds + (bufoff) + ldsw + _i * 8192), 16, 0, 0); } while (0)
#define PG8_LDA(dst, b, h) do { _Pragma("unroll") for (int m = 0; m < 4; ++m) _Pragma("unroll") for (int k = 0; k < 2; ++k) dst[m][k] = *(const PG8_LAS bf16x8*)(lds + PG8_SA(b, h) + aoff + m * 2048 + k * 1024); } while (0)
#define PG8_LDB(dst, b, h) do { _Pragma("unroll") for (int n = 0; n < 2; ++n) _Pragma("unroll") for (int k = 0; k < 2; ++k) dst[n][k] = *(const PG8_LAS bf16x8*)(lds + PG8_SB(b, h) + boff + n * 2048 + k * 1024); } while (0)
#define PG8_MMA(ai, bj, At, Bt) do { __builtin_amdgcn_s_setprio(1); _Pragma("unroll") for (int m = 0; m < 4; ++m) _Pragma("unroll") for (int n = 0; n < 2; ++n) _Pragma("unroll") for (int k = 0; k < 2; ++k) \
        acc[ai][bj][m][n] = __builtin_amdgcn_mfma_f32_16x16x32_bf16(Bt[n][k], At[m][k], acc[ai][bj][m][n], 0, 0, 0); __builtin_amdgcn_s_setprio(0); } while (0)
#define PG8_WAIT_V(n) asm volatile("s_waitcnt vmcnt(" #n ")" ::: "memory")
#define PG8_WAIT_L(n) asm volatile("s_waitcnt lgkmcnt(" #n ")" ::: "memory")
#define PG8_BAR __builtin_amdgcn_s_barrier()
#define PG8_SCHED __builtin_amdgcn_sched_barrier(0)
    Unit cur, nxt; int ui = 0;
    if (!S.next(0, cur)) return;
    f32x4 acc[2][2][4][2];
#pragma unroll
    for (int a = 0; a < 2; ++a)
#pragma unroll
        for (int b = 0; b < 2; ++b)
#pragma unroll
            for (int m = 0; m < 4; ++m)
#pragma unroll
                for (int n = 0; n < 2; ++n) acc[a][b][m][n] = (f32x4){0.f, 0.f, 0.f, 0.f};
    bf16x8 At[4][2], B0[2][2], B1[2][2];
    const char* cA = (const char*)g.A + (size_t)cur.pm * tstep; const char* cB = (const char*)g.Bt + (size_t)cur.pnb * tstep;
    S.a_ready(cur);
    if constexpr (SP2) {
        PG8_STAGE(PG8_SB(0, 0), cB, voffB); PG8_STAGE(PG8_SB(0, 1), cB + hstep, voffB); PG8_STAGE(PG8_SA(0, 0), cA, voffA); PG8_STAGE(PG8_SA(0, 1), cA + hstep, voffA);
        if (wr == 1) PG8_BAR;
        PG8_WAIT_V(2); PG8_BAR;
        PG8_STAGE(PG8_SB(1, 0), cB + kstep, voffB); PG8_STAGE(PG8_SA(1, 0), cA + kstep, voffA); PG8_STAGE(PG8_SB(1, 1), cB + hstep + kstep, voffB);
        PG8_WAIT_V(6); PG8_BAR;
    } else {
        PG8_STAGE(PG8_SB(0, 0), cB, voffB); PG8_STAGE(PG8_SA(0, 0), cA, voffA); PG8_STAGE(PG8_SB(0, 1), cB + hstep, voffB); PG8_STAGE(PG8_SA(0, 1), cA + hstep, voffA);
        if (wr == 1) PG8_BAR;
        PG8_WAIT_V(4); PG8_BAR;
        PG8_STAGE(PG8_SB(1, 0), cB + kstep, voffB); PG8_STAGE(PG8_SA(1, 0), cA + kstep, voffA); PG8_STAGE(PG8_SB(1, 1), cB + hstep + kstep, voffB);
        PG8_WAIT_V(6); PG8_BAR;
    }
    for (;;) {
        const bool has_next = S.next(ui + 1, nxt);
        const char* nA = has_next ? (const char*)g.A + (size_t)nxt.pm * tstep : cA; const char* nB = has_next ? (const char*)g.Bt + (size_t)nxt.pnb * tstep : cB;
        for (int t = 0; t < nt; t += 2) {
            const bool last = (t == nt - 2);
            const char* a1 = cA + (size_t)(t + 1) * kstep;
            const char* a2 = last ? nA : cA + (size_t)(t + 2) * kstep; const char* b2 = last ? nB : cB + (size_t)(t + 2) * kstep;
            const char* a3 = a2 + kstep; const char* b3 = b2 + kstep;
            if (last && has_next) S.a_ready(nxt);
            if constexpr (SP2) {
            PG8_LDB(B0, 0, 0); PG8_LDB(B1, 0, 1); PG8_SCHED; PG8_LDA(At, 0, 0); PG8_STAGE(PG8_SA(1, 1), a1 + hstep, voffA);
            PG8_WAIT_V(8); PG8_WAIT_L(0); PG8_BAR; PG8_MMA(0, 0, At, B0); PG8_MMA(0, 1, At, B1); PG8_BAR; PG8_SCHED;
            PG8_LDA(At, 0, 1); PG8_STAGE(PG8_SB(0, 0), b2, voffB); PG8_STAGE(PG8_SB(0, 1), b2 + hstep, voffB); PG8_STAGE(PG8_SA(0, 0), a2, voffA);
            PG8_WAIT_V(8); PG8_WAIT_L(0); PG8_BAR; PG8_MMA(1, 0, At, B0); PG8_MMA(1, 1, At, B1); PG8_BAR; PG8_SCHED;
            PG8_LDB(B0, 1, 0); PG8_LDB(B1, 1, 1); PG8_SCHED; PG8_LDA(At, 1, 0); PG8_STAGE(PG8_SA(0, 1), a2 + hstep, voffA);
            PG8_WAIT_V(8); PG8_WAIT_L(0); PG8_BAR; PG8_MMA(0, 0, At, B0); PG8_MMA(0, 1, At, B1); PG8_BAR; PG8_SCHED;
            PG8_LDA(At, 1, 1); PG8_STAGE(PG8_SB(1, 0), b3, voffB); PG8_STAGE(PG8_SB(1, 1), b3 + hstep, voffB); PG8_STAGE(PG8_SA(1, 0), a3, voffA);
            PG8_WAIT_V(8); PG8_WAIT_L(0); PG8_BAR; PG8_MMA(1, 0, At, B0); PG8_MMA(1, 1, At, B1); PG8_BAR; PG8_SCHED;
            } else {
            PG8_LDB(B0, 0, 0); PG8_SCHED; PG8_LDA(At, 0, 0); PG8_STAGE(PG8_SA(1, 1), a1 + hstep, voffA);
            PG8_WAIT_L(8); PG8_BAR; PG8_WAIT_L(0); PG8_MMA(0, 0, At, B0); PG8_BAR; PG8_SCHED;
            PG8_LDB(B1, 0, 1); PG8_STAGE(PG8_SB(0, 0), b2, voffB);
            PG8_BAR; PG8_WAIT_L(0); PG8_MMA(0, 1, At, B1); PG8_BAR;
            PG8_LDA(At, 0, 1); PG8_STAGE(PG8_SA(0, 0), a2, voffA);
            PG8_BAR; PG8_WAIT_L(0); PG8_MMA(1, 0, At, B0); PG8_BAR; PG8_SCHED;
            PG8_STAGE(PG8_SB(0, 1), b2 + hstep, voffB);
            PG8_WAIT_V(6); PG8_BAR; PG8_MMA(1, 1, At, B1); PG8_BAR;
            PG8_LDB(B0, 1, 0); PG8_SCHED; PG8_LDA(At, 1, 0); PG8_STAGE(PG8_SA(0, 1), a2 + hstep, voffA);
            PG8_WAIT_L(8); PG8_BAR; PG8_WAIT_L(0); PG8_MMA(0, 0, At, B0); PG8_BAR; PG8_SCHED;
            PG8_LDB(B1, 1, 1); PG8_STAGE(PG8_SB(1, 0), b3, voffB);
            PG8_BAR; PG8_WAIT_L(0); PG8_MMA(0, 1, At, B1); PG8_BAR;
            PG8_LDA(At, 1, 1); PG8_STAGE(PG8_SA(1, 0), a3, voffA);
            PG8_BAR; PG8_WAIT_L(0); PG8_MMA(1, 0, At, B0); PG8_BAR; PG8_SCHED;
            PG8_STAGE(PG8_SB(1, 1), b3 + hstep, voffB);
            PG8_WAIT_V(6); PG8_BAR; PG8_MMA(1, 1, At, B1); PG8_BAR;
            }
        }
        if constexpr (ALIGN_EPI) { if (wr == 0) PG8_BAR; }
        if constexpr (!Epi::AFTER_DRAIN) { E(acc, cur, wr, wc, fr, fq); S.done(cur); }
        if (!has_next) break;
#pragma unroll
        for (int a = 0; a < 2; ++a)
#pragma unroll
            for (int b = 0; b < 2; ++b)
#pragma unroll
                for (int m = 0; m < 4; ++m)
#pragma unroll
                    for (int n = 0; n < 2; ++n) acc[a][b][m][n] = (f32x4){0.f, 0.f, 0.f, 0.f};
        cur = nxt; cA = nA; cB = nB; ++ui;
        if constexpr (ALIGN_EPI) { if (wr == 1) PG8_BAR; }
    }
    PG8_WAIT_V(0);
    if constexpr (!ALIGN_EPI) { if (wr == 0) PG8_BAR; }
    PG8_BAR;
    if constexpr (Epi::AFTER_DRAIN) { E.fused(acc, cur, wr, wc, fr, fq, lds, wid, lane); S.done(cur); }
#undef PG8_SA
#undef PG8_SB
#undef PG8_STAGE
#undef PG8_LDA
#undef PG8_LDB
#undef PG8_MMA
#undef PG8_WAIT_V
#undef PG8_WAIT_L
#undef PG8_BAR
#undef PG8_SCHED
}
}
namespace pg8 {
struct EpiBf16 {
    static constexpr bool PERM = true, AFTER_DRAIN = false;
    bf16_t* O; int ldc;
    __device__ __forceinline__ void operator()(const f32x4 (&acc)[2][2][4][2], const Unit& u, int wr, int wc, int fr, int fq) const {
        const int row0 = u.pm * BM + wr * 64 + fr; const int col0 = u.pn * BM + wc * 32 + 8 * fq;
#pragma unroll
        for (int ai = 0; ai < 2; ++ai)
#pragma unroll
            for (int m = 0; m < 4; ++m) { bf16_t* rowp = O + (size_t)(row0 + ai * HALF + m * 16) * ldc + col0;
#pragma unroll
                for (int bj = 0; bj < 2; ++bj) { const f32x4 v0 = acc[ai][bj][m][0], v1 = acc[ai][bj][m][1];
                    u32x4 w; w.x = cvt_pk_bf16(v0[0], v0[1]); w.y = cvt_pk_bf16(v0[2], v0[3]); w.z = cvt_pk_bf16(v1[0], v1[1]); w.w = cvt_pk_bf16(v1[2], v1[3]);
                    *(u32x4*)(rowp + bj * HALF) = w; } }
    }
};
struct EpiSwiGLU {
    static constexpr bool PERM = true, AFTER_DRAIN = false;
    bf16_t* O; int ldc;
    __device__ __forceinline__ void operator()(const f32x4 (&acc)[2][2][4][2], const Unit& u, int wr, int wc, int fr, int fq) const {
        const int row0 = u.pm * BM + wr * 64 + fr; const int col0 = u.pn * HALF + wc * 32 + 8 * fq;
#pragma unroll
        for (int ai = 0; ai < 2; ++ai)
#pragma unroll
            for (int m = 0; m < 4; ++m) { bf16_t* rowp = O + (size_t)(row0 + ai * HALF + m * 16) * ldc + col0;
                float r[8];
#pragma unroll
                for (int n = 0; n < 2; ++n)
#pragma unroll
                    for (int j = 0; j < 4; ++j) { const float a = acc[ai][0][m][n][j], b = acc[ai][1][m][n][j]; r[n * 4 + j] = a * b / (1.0f + __expf(-a)); }
                u32x4 w; w.x = cvt_pk_bf16(r[0], r[1]); w.y = cvt_pk_bf16(r[2], r[3]); w.z = cvt_pk_bf16(r[4], r[5]); w.w = cvt_pk_bf16(r[6], r[7]);
                *(u32x4*)rowp = w; }
    }
};
struct MoeOrder {
    const PG8_LAS int* pref; int nN, G, c, total;
    __device__ __forceinline__ void init(const PG8_LAS int* pref_, int nN_, int G_, int c_) { pref = pref_; nN = nN_; G = G_; c = c_; total = pref_[32] * nN_; }
    __device__ __forceinline__ bool next(int i, Unit& u) const {
        const int L = i * G + c; if (L >= total) return false;
        const int rt = L / nN, pn = L - rt * nN; int e = 0;
#pragma unroll 1
        for (int k = 1; k < 32; ++k) e += (pref[k] <= rt) ? 1 : 0;
        u.pm = rt; u.pn = pn; u.pnb = e * nN + pn; return true;
    }
    __device__ __forceinline__ void a_ready(const Unit&) const {}
    __device__ __forceinline__ void done(const Unit&) const {}
};
}
#define XB_TMO      128
#define XB_XCNT(j)  (256  + 64 * (j))
#define XB_XSUB(j)  (1280 + 64 * (j))
#define XB_XGEN(j)  (2304 + 64 * (j))
#define XB_TOP      3328
#define XB_TOPGEN   3392
#define XCD_BAR_WORDS 3456
#define XB_SPIN_CAP (1u << 22)

__device__ __forceinline__ unsigned xb_ld(unsigned* p)              { return __hip_atomic_load(p, __ATOMIC_RELAXED, __HIP_MEMORY_SCOPE_AGENT); }
__device__ __forceinline__ unsigned xb_add(unsigned* p, unsigned v) { return __hip_atomic_fetch_add(p, v, __ATOMIC_RELAXED, __HIP_MEMORY_SCOPE_AGENT); }
__device__ __forceinline__ unsigned xb_xcc_id() { return (unsigned)__builtin_amdgcn_s_getreg((3 << 11) | 20) & 0xFu; }
#define XB_SPIN(cond, bar) do { unsigned _sp = 0; while (cond) { __builtin_amdgcn_s_sleep(1); \
    if ((++_sp & 255u) == 0u) { if (xb_ld(&(bar)[XB_TMO])) break; if (_sp > XB_SPIN_CAP) { atomicAdd(&(bar)[XB_TMO], 1u); break; } } } } while (0)

struct XcdBarrier {
    unsigned* bar; unsigned x;
    volatile LAS unsigned* st;
};

__device__ __forceinline__ XcdBarrier xcd_barrier_post(unsigned* bar, volatile LAS unsigned* st) {
    XcdBarrier b; b.bar = bar; b.x = xb_xcc_id(); b.st = st;
    if (hw_tid() == 0) (void)xb_add(&bar[XB_XCNT(b.x)], 1u);
    return b;
}
__device__ __forceinline__ void xcd_barrier_complete(unsigned* bar, unsigned x, unsigned& nloc, unsigned& nx) {
    const unsigned G = gridDim.x * gridDim.y * gridDim.z;
    unsigned sum, cnt, mine, sp = 0u;
    for (;;) {
        sum = 0u; cnt = 0u; mine = 0u;
#pragma unroll
        for (unsigned j = 0; j < 16; ++j) { const unsigned c = xb_ld(&bar[XB_XCNT(j)]); sum += c; cnt += (c > 0u) ? 1u : 0u; mine = (j == x) ? c : mine; }
        if (sum == G) break;
        __builtin_amdgcn_s_sleep(1);
        if ((++sp & 255u) == 0u) { if (xb_ld(&bar[XB_TMO])) break; if (sp > XB_SPIN_CAP) { atomicAdd(&bar[XB_TMO], 1u); break; } }
    }
    nloc = mine > 0u ? mine : 1u; nx = cnt > 0u ? cnt : 1u;
}

__device__ __forceinline__ void xcd_barrier(const XcdBarrier& b) {
    asm volatile("s_waitcnt vmcnt(0)" ::: "memory");
    __syncthreads();
    if (hw_tid() == 0) {
        unsigned* bar = b.bar;
        __builtin_amdgcn_s_waitcnt(0);
        unsigned nloc = b.st[0], nx = b.st[1];
        if (nloc == 0u) { xcd_barrier_complete(bar, b.x, nloc, nx); b.st[0] = nloc; b.st[1] = nx; }
        const unsigned old = xb_add(&bar[XB_XSUB(b.x)], 1u);
        const unsigned gen = old / nloc;
        if (old + 1u == (gen + 1u) * nloc) {
            __builtin_amdgcn_fence(__ATOMIC_RELEASE, "agent");
            asm volatile("s_waitcnt vmcnt(0)" ::: "memory");
            const unsigned og = xb_add(&bar[XB_TOP], 1u);
            const unsigned tg = og / nx;
            if (og + 1u == (tg + 1u) * nx) xb_add(&bar[XB_TOPGEN], 1u);
            else XB_SPIN(xb_ld(&bar[XB_TOPGEN]) == tg, bar);
            __builtin_amdgcn_fence(__ATOMIC_ACQUIRE, "agent");
            xb_add(&bar[XB_XGEN(b.x)], 1u);
            asm volatile("s_waitcnt vmcnt(0)" ::: "memory");
        } else {
            XB_SPIN(xb_ld(&bar[XB_XGEN(b.x)]) == gen, bar);
            __builtin_amdgcn_fence(__ATOMIC_ACQUIRE, "agent");
            asm volatile("s_waitcnt vmcnt(0)" ::: "memory");
        }
    }
    __syncthreads();
}
struct Args { const float* in[30]; float* out; unsigned char* ws; int ph_lo, ph_hi; };
#define CAS __attribute__((address_space(4)))
struct KA { const CAS unsigned char* kp;
    __device__ __forceinline__ const float* in(int i) const { return *(const float* const CAS*)(kp + 8 * i); }
    __device__ __forceinline__ float* out() const { return *(float* const CAS*)(kp + 240); }
    __device__ __forceinline__ unsigned char* ws() const { return *(unsigned char* const CAS*)(kp + 248); } };
__device__ __forceinline__ KA ka_get() { const CAS unsigned char* kp = (const CAS unsigned char*)__builtin_amdgcn_kernarg_segment_ptr(); asm volatile("" : "+s"(kp)); return KA{kp}; }
__device__ __forceinline__ int opaque_tid() { return hw_tid(); }
static_assert(sizeof(Args) == 264, "kernarg layout");
enum { I_X = 0, I_C, I_CTX, I_CCTX, I_ADAW, I_ADAB, I_WIN, I_RPB, I_MUP, I_MUN, I_W0, I_W2, I_A0, I_A2, I_G2, I_KK, I_KA, I_RK, I_GNG, I_GNB, I_WOUT, I_LN1G, I_LN1B, I_LN2G, I_LN2B, I_RW, I_RB, I_EW1, I_EW3, I_EW2 };

__device__ __forceinline__ void transpose_item(const float* W, int N, int k0, int n0, bf16* WT, int ldk, int drow0, LAS float* scr, int lane) {
#pragma unroll 8
    for (int i = 0; i < 32; ++i) { const int kk = 2 * i + (lane >> 5); scr[kk * 33 + (lane & 31)] = W[(size_t)(k0 + kk) * N + n0 + (lane & 31)]; }
    LDS_WAIT(); asm volatile("" ::: "memory");
    const int c = lane & 7;
#pragma unroll
    for (int j = 0; j < 4; ++j) { const int n = (lane >> 3) + 8 * j; const LAS float* s = scr + (8 * c) * 33 + n;
        v4u o; o.x = pk2(s[0 * 33], s[1 * 33]); o.y = pk2(s[2 * 33], s[3 * 33]); o.z = pk2(s[4 * 33], s[5 * 33]); o.w = pk2(s[6 * 33], s[7 * 33]);
        *(GAS v4u*)(WT + (size_t)(drow0 + n) * ldk + k0 + 8 * c) = o; }
    LDS_WAIT(); asm volatile("" ::: "memory");
}

__device__ __forceinline__ void phase_prologue(LAS unsigned char* lds) {
    const KA a = ka_get();
    const int tid = opaque_tid(), lane = tid & 63, wave = __builtin_amdgcn_readfirstlane(tid >> 6), G = gridDim.x, bid = blockIdx.x;
    const int gw = bid * 8 + wave, NGW = G * 8;
    bf16* WINT = (bf16*)(a.ws() + WS_WINT); bf16* WOT = (bf16*)(a.ws() + WS_WOT);
    LAS float* scr = (LAS float*)(lds + wave * 16384);
    constexpr int I_IN = 16 * 103, I_OUT = 16 * 32, I_L = I_IN + I_OUT;
    for (int it = gw; it < 2 * I_L; it += NGW) {
        const int l = it / I_L; int r = it - l * I_L;
        if (r < I_IN) { const int kb = r / 103, nb = r - kb * 103; transpose_item(a.in(I_WIN) + (size_t)l * DM * DIN, DIN, 64 * kb, 32 * nb, WINT + (size_t)l * DINP * DM, DM, 32 * nb, scr, lane); }
        else { r -= I_IN; const int kb = r >> 5, nb = r & 31; transpose_item(a.in(I_WOUT) + (size_t)l * DM * DM, DM, 64 * kb, 32 * nb, WOT + (size_t)l * DM * DM, DM, 32 * nb, scr, lane); }
    }
    for (int i = bid * 512 + tid; i < 8192; i += G * 512) { const int l = i >> 12, r = i & 4095; *(GAS v4u*)(WINT + (size_t)l * DINP * DM + (size_t)DIN * DM + (size_t)r * 8) = (v4u){0u, 0u, 0u, 0u}; }
    { float* rp = (float*)(a.ws() + WS_ROPE); const int i = bid * 512 + tid;
      if (i < 1536) { const int idx = i < 512 ? i : i - 512; const int p = idx >> 4, f = idx & 15; const double inv = exp(-(double)f * (9.210340371976184 / 16.0)); const double ang = (double)p * inv;
          const float cs = (float)cos(ang), sn = (float)sin(ang); if (i < 512) { rp[idx] = cs; rp[512 + idx] = sn; } else { rp[1024 + idx] = cs; rp[2048 + idx] = sn; } } }
    __syncthreads();
    LAS float* sl = (LAS float*)lds; LAS float* red = (LAS float*)(lds + 69632);
    for (int i = tid; i < 17 * 1024; i += 512) { const int r = i >> 10, k = i & 1023; const float v = r < 16 ? a.in(I_C)[r * 1024 + k] : a.in(I_CCTX)[k]; sl[i] = v / (1.0f + expf(-v)); }
    __syncthreads();
    float* mods = (float*)(a.ws() + WS_MODS);
    for (int it = bid; it < 192; it += G) {
        const int l = it / 96, ch = it - l * 96; const int kq = tid >> 6, cl = tid & 63, col = ch * 64 + cl;
        const float* W = a.in(I_ADAW) + (size_t)l * DM * 6144 + col;
        float acc[17];
#pragma unroll
        for (int r = 0; r < 17; ++r) acc[r] = 0.f;
        for (int k0 = kq * 128; k0 < kq * 128 + 128; k0 += 8) { float w8[8];
#pragma unroll
            for (int q = 0; q < 8; ++q) w8[q] = W[(size_t)(k0 + q) * 6144];
#pragma unroll
            for (int r = 0; r < 17; ++r) { const f32x4 s0 = *(const LAS f32x4*)(sl + r * 1024 + k0), s1 = *(const LAS f32x4*)(sl + r * 1024 + k0 + 4);
                acc[r] += s0.x * w8[0] + s0.y * w8[1] + s0.z * w8[2] + s0.w * w8[3] + s1.x * w8[4] + s1.y * w8[5] + s1.z * w8[6] + s1.w * w8[7]; } }
#pragma unroll
        for (int r = 0; r < 17; ++r) red[(kq * 17 + r) * 64 + cl] = acc[r];
        __syncthreads();
        for (int i = tid; i < 17 * 64; i += 512) { const int r = i >> 6, c2 = i & 63; float s = 0.f;
#pragma unroll
            for (int q = 0; q < 8; ++q) s += red[(q * 17 + r) * 64 + c2];
            mods[((size_t)l * 17 + r) * 6144 + ch * 64 + c2] = s + a.in(I_ADAB)[l * 6144 + ch * 64 + c2]; }
        __syncthreads();
    }
}

__device__ __forceinline__ void phase_modconv(LAS unsigned char* lds, int l) {
    const KA a = ka_get();
    const int tid = opaque_tid(), lane = tid & 63, wave = __builtin_amdgcn_readfirstlane(tid >> 6), G = gridDim.x, bid = blockIdx.x;
    const int gw = bid * 8 + wave, NGW = G * 8;
    const float* mods = (const float*)(a.ws() + WS_MODS) + (size_t)l * 17 * 6144;
    bf16* XM = (bf16*)(a.ws() + WS_X1);
    const float* xs = l == 0 ? a.in(I_X) : a.out(); const float* cs = l == 0 ? a.in(I_CTX) : (const float*)(a.ws() + WS_CS);
    for (int m = gw; m < NTOK; m += NGW) {
        const float* src; int mr;
        if (m < NTX) { src = xs + (size_t)m * DM; mr = m / SEQ; } else { src = cs + (size_t)(m - NTX) * DM; mr = 16; }
        const GAS f32x4* xr = (const GAS f32x4*)src + lane; const GAS f32x4* sh = (const GAS f32x4*)(mods + (size_t)mr * 6144) + lane; const GAS f32x4* sc = sh + 256;
        GAS v2u* o8 = (GAS v2u*)(XM + (size_t)m * DM) + lane;
#pragma unroll
        for (int j = 0; j < 4; ++j) { const f32x4 v = xr[64 * j], s = sh[64 * j], c = sc[64 * j]; const f32x4 r = v * (c + 1.0f) + s; v2u w; w.x = pk2(r.x, r.y); w.y = pk2(r.z, r.w); o8[64 * j] = w; }
    }
}

__device__ __forceinline__ void phase_scan_direct(LAS unsigned char* lds, int l) {
    const KA a = ka_get();
    constexpr int TB = 32;
    const int tid = opaque_tid(), lane = tid & 63, wv = __builtin_amdgcn_readfirstlane(tid >> 6);
    LAS float* ops = (LAS float*)lds;
    LAS float* scal = (LAS float*)(lds + 49152);
    LAS float* zl = (LAS float*)(lds + 49664);
    LAS float* rkraw = (LAS float*)(lds + 57856);
    LAS float* ybuf = (LAS float*)(lds + 74240);
    const bf16* PX = (const bf16*)(a.ws() + WS_X2); float* YD = (float*)(a.ws() + WS_X3); float* BON = (float*)(a.ws() + WS_BONUS); const float* rope = (const float*)(a.ws() + WS_ROPE);
    const float* mup = a.in(I_MUP) + l * 1760; const float* mun = a.in(I_MUN) + l * 1760;
    for (int chain = blockIdx.x; chain < 256; chain += gridDim.x) {
        const int b = chain >> 4, h = (chain >> 1) & 7, d = chain & 1, c = lane;
        float w2c[32], a2c[32];
#pragma unroll
        for (int j = 0; j < 32; ++j) { w2c[j] = a.in(I_W2)[((size_t)(l * 2 + d) * 32 + j) * 512 + h * 64 + c]; a2c[j] = a.in(I_A2)[((size_t)(l * 2 + d) * 32 + j) * 512 + h * 64 + c]; }
        const float w0c = a.in(I_W0)[(l * 2 + d) * 512 + h * 64 + c], a0c = a.in(I_A0)[(l * 2 + d) * 512 + h * 64 + c];
        const float kkc = a.in(I_KK)[l * 512 + h * 64 + c], kac = a.in(I_KA)[l * 512 + h * 64 + c], rkc = a.in(I_RK)[l * 512 + h * 64 + c];
        const int colr = h * 64 + c, colk = 512 + colr, colv = 1024 + colr, coll = (c < 32) ? (1536 + d * 32 + c) : (1600 + d * 32 + (c - 32));
        const float mpr = mup[colr], mnr = mun[colr], mpk = mup[colk], mnk = mun[colk], mpv = mup[colv], mnv = mun[colv], mpl = mup[coll], mnl = mun[coll];
        float S[8];
#pragma unroll
        for (int j = 0; j < 8; ++j) S[j] = 0.f;
        const int vl = lane >> 3, kq = lane & 7, vrow = 8 * wv + vl;
        for (int seq = 0; seq < 2; ++seq) {
            const int T = seq ? SEQ : CTXL, rowbase = seq ? b * SEQ : NTX + b * CTXL, nblk = T / TB;
            for (int bi = 0; bi < nblk; ++bi) {
                const int tb = d ? (nblk - 1 - bi) : bi, t0 = tb * TB;
                float zv[4];
#pragma unroll
                for (int i = 0; i < 4; ++i) {
                    const int tl = wv + 8 * i, t = t0 + tl; const bf16* p = PX + (size_t)(rowbase + t) * DINP + RWOFF;
                    const bool hp = t > 0, hn = t + 1 < T;
                    const float cr = bf2f(p[colr]), ck = bf2f(p[colk]), cv = bf2f(p[colv]), cl_ = bf2f(p[coll]);
                    const float pr = hp ? bf2f(p[colr - DINP]) : 0.f, pk = hp ? bf2f(p[colk - DINP]) : 0.f, pv = hp ? bf2f(p[colv - DINP]) : 0.f, pl = hp ? bf2f(p[coll - DINP]) : 0.f;
                    const float nr = hn ? bf2f(p[colr + DINP]) : 0.f, nk = hn ? bf2f(p[colk + DINP]) : 0.f, nv = hn ? bf2f(p[colv + DINP]) : 0.f, nl = hn ? bf2f(p[coll + DINP]) : 0.f;
                    const float zr = cr + mpr * (pr - cr) + mnr * (nr - cr), zk = ck + mpk * (pk - ck) + mnk * (nk - ck);
                    zv[i] = cv + mpv * (pv - cv) + mnv * (nv - cv);
                    const float zz = cl_ + mpl * (pl - cl_) + mnl * (nl - cl_);
                    rkraw[tl * 128 + c] = zr; rkraw[tl * 128 + 64 + c] = zk; zl[tl * 64 + c] = (c < 32) ? tanhf(zz) : zz;
                }
                __syncthreads();
#pragma unroll
                for (int i = 0; i < 4; ++i) {
                    const int tl = wv + 8 * i, t = t0 + tl;
                    float r = rkraw[tl * 128 + c], k = rkraw[tl * 128 + 64 + c];
                    if (seq) { const float rp = rkraw[tl * 128 + (c ^ 16)], kp = rkraw[tl * 128 + 64 + (c ^ 16)]; const int qd = c >> 4, f = c & 15;
                        const int ti = (qd < 2) ? ((t >> 6) * 16 + f) : (1024 + (t & 63) * 16 + f); const float cs = rope[ti], sn = rope[ti + ((qd < 2) ? 512 : 1024)];
                        const float sg = (qd & 1) ? sn : -sn; r = r * cs + rp * sg; k = k * cs + kp * sg; }
                    const float kkr = k * kkc; const float ss = wave_sum(kkr * kkr); const float kk = kkr / fmaxf(sqrtf(ss), 1e-12f);
                    float u = w0c, av = a0c;
#pragma unroll
                    for (int j = 0; j < 32; j += 4) { const f32x4 z1 = *(const LAS f32x4*)(zl + tl * 64 + j), z2 = *(const LAS f32x4*)(zl + tl * 64 + 32 + j);
                        u += z1.x * w2c[j] + z1.y * w2c[j + 1] + z1.z * w2c[j + 2] + z1.w * w2c[j + 3]; av += z2.x * a2c[j] + z2.y * a2c[j + 1] + z2.z * a2c[j + 2] + z2.w * a2c[j + 3]; }
                    const float w = expf(-0.6065306597126334f * sigmoidf_(u)), aa = sigmoidf_(av);
                    const float kd = k * (1.0f + (aa - 1.0f) * kac), nb = -kk * aa;
                    const float c1 = wave_sum(nb * r), c2 = wave_sum(kd * r), bon = wave_sum(r * kd * rkc);
                    LAS float* o = ops + tl * 384 + c; o[0] = kk; o[64] = w * r; o[128] = w; o[192] = nb; o[256] = kd; o[320] = zv[i];
                    if (lane == 0) { scal[tl * 4] = c1; scal[tl * 4 + 1] = c2; BON[((size_t)d * NTOK + rowbase + t) * 8 + h] = bon; }
                }
                __syncthreads();
#pragma unroll 2
                for (int s = 0; s < TB; ++s) {
                    const int tl = d ? (TB - 1 - s) : s; const LAS float* o = ops + tl * 384 + kq * 8;
                    const f32x4 ka = *(const LAS f32x4*)(o), kb = *(const LAS f32x4*)(o + 4), ra = *(const LAS f32x4*)(o + 64), rb = *(const LAS f32x4*)(o + 68);
                    const f32x4 wa = *(const LAS f32x4*)(o + 128), wb = *(const LAS f32x4*)(o + 132), na = *(const LAS f32x4*)(o + 192), nb_ = *(const LAS f32x4*)(o + 196);
                    const f32x4 da = *(const LAS f32x4*)(o + 256), db = *(const LAS f32x4*)(o + 260);
                    const float vv = ops[tl * 384 + 320 + vrow], c1 = scal[tl * 4], c2 = scal[tl * 4 + 1];
                    float sk = S[0] * ka.x + S[1] * ka.y + S[2] * ka.z + S[3] * ka.w + S[4] * kb.x + S[5] * kb.y + S[6] * kb.z + S[7] * kb.w;
                    float yy = S[0] * ra.x + S[1] * ra.y + S[2] * ra.z + S[3] * ra.w + S[4] * rb.x + S[5] * rb.y + S[6] * rb.z + S[7] * rb.w;
                    sk = red8(sk); yy = red8(yy);
                    const float y = yy + sk * c1 + vv * c2;
                    S[0] = S[0] * wa.x + sk * na.x + vv * da.x; S[1] = S[1] * wa.y + sk * na.y + vv * da.y; S[2] = S[2] * wa.z + sk * na.z + vv * da.z; S[3] = S[3] * wa.w + sk * na.w + vv * da.w;
                    S[4] = S[4] * wb.x + sk * nb_.x + vv * db.x; S[5] = S[5] * wb.y + sk * nb_.y + vv * db.y; S[6] = S[6] * wb.z + sk * nb_.z + vv * db.z; S[7] = S[7] * wb.w + sk * nb_.w + vv * db.w;
                    if (kq == 0) ybuf[tl * 64 + vrow] = y;
                }
                __syncthreads();
#pragma unroll
                for (int i = 0; i < 4; ++i) { const int tl = wv + 8 * i; YD[((size_t)d * NTOK + rowbase + t0 + tl) * 512 + h * 64 + c] = ybuf[tl * 64 + c]; }
            }
        }
        __syncthreads();
    }
}

typedef short v4i16_t __attribute__((ext_vector_type(4)));
__device__ __forceinline__ int swz_off(int row, int chunk) { return row * 128 + ((chunk ^ (row & 7)) << 4); }
__device__ __forceinline__ void stage_rows(LAS unsigned char* dst, const bf16* src, int nrows, int tid) {
    for (int idx = tid; idx < nrows * 8; idx += 512) { const int r = idx >> 3, ch = idx & 7; const v4u v = *(const GAS v4u*)(src + (size_t)r * DINP + ch * 8); *(LAS v4u*)(dst + swz_off(r, ch)) = v; }
}
struct AttState { float m, l; f32x4 o[4]; };
template <bool LOCAL>
__device__ __forceinline__ void att_kstep(AttState& st, const LAS unsigned char* kb, const LAS unsigned char* vb, int r0, int r1, const bf16x8 (&qf)[2], int lane,
                                          const LAS float* rpbrow, int kc0, int qc, int cs) {
    const int kl = lane & 15, g = lane >> 4;
    f32x4 s0 = {0.f, 0.f, 0.f, 0.f}, s1 = {0.f, 0.f, 0.f, 0.f};
#pragma unroll
    for (int dh = 0; dh < 2; ++dh) {
        const bf16x8 k0 = *(const LAS bf16x8*)(kb + swz_off(r0 + kl, dh * 4 + g)); const bf16x8 k1 = *(const LAS bf16x8*)(kb + swz_off(r1 + kl, dh * 4 + g));
        s0 = __builtin_amdgcn_mfma_f32_16x16x32_bf16(k0, qf[dh], s0, 0, 0, 0); s1 = __builtin_amdgcn_mfma_f32_16x16x32_bf16(k1, qf[dh], s1, 0, 0, 0);
    }
    float sc[8];
#pragma unroll
    for (int j = 0; j < 4; ++j) { sc[j] = s0[j] * 0.125f; sc[4 + j] = s1[j] * 0.125f; }
    if (LOCAL) {
        float bv[8]; bool ok[8];
#pragma unroll
        for (int j = 0; j < 8; ++j) { const int kc = kc0 + (j >> 2) * 16 + 4 * g + (j & 3); ok[j] = (kc >= cs) && (kc < cs + 16); const int bi = ok[j] ? (kc - qc + 15) : 0;
            const unsigned ad = (unsigned)(uintptr_t)(rpbrow + bi); asm volatile("ds_read_b32 %0, %1" : "=v"(bv[j]) : "v"(ad)); }
        asm volatile("s_waitcnt lgkmcnt(0)" : "+v"(bv[0]), "+v"(bv[1]), "+v"(bv[2]), "+v"(bv[3]), "+v"(bv[4]), "+v"(bv[5]), "+v"(bv[6]), "+v"(bv[7]) :: "memory");
#pragma unroll
        for (int j = 0; j < 8; ++j) sc[j] = ok[j] ? sc[j] + bv[j] : -INFINITY;
    }
    float mt = fmaxf(fmaxf(fmaxf(sc[0], sc[1]), fmaxf(sc[2], sc[3])), fmaxf(fmaxf(sc[4], sc[5]), fmaxf(sc[6], sc[7])));
    mt = fmaxf(mt, shx(mt, 16, lane)); mt = fmaxf(mt, shx(mt, 32, lane));
    const float mn = fmaxf(st.m, mt); const bool dead = (mn == -INFINITY);
    const float scale = dead ? 1.0f : __expf(st.m - mn);
    float p[8], ps = 0.f;
#pragma unroll
    for (int j = 0; j < 8; ++j) { p[j] = dead ? 0.f : __expf(sc[j] - mn); ps += p[j]; }
    st.l = st.l * scale + ps; st.m = mn;
#pragma unroll
    for (int dt = 0; dt < 4; ++dt) st.o[dt] = st.o[dt] * scale;
    v4u pw; pw.x = pk2(p[0], p[1]); pw.y = pk2(p[2], p[3]); pw.z = pk2(p[4], p[5]); pw.w = pk2(p[6], p[7]);
    const bf16x8 pf = __builtin_bit_cast(bf16x8, pw);
    const int q_ = kl >> 2, p_ = kl & 3;
#pragma unroll
    for (int dt = 0; dt < 4; ++dt) {
        const v4i16_t lo = __builtin_amdgcn_ds_read_tr16_b64_v4i16((LAS v4i16_t*)(vb + swz_off(r0 + 4 * g + q_, 2 * dt + (p_ >> 1)) + (p_ & 1) * 8));
        const v4i16_t hi = __builtin_amdgcn_ds_read_tr16_b64_v4i16((LAS v4i16_t*)(vb + swz_off(r1 + 4 * g + q_, 2 * dt + (p_ >> 1)) + (p_ & 1) * 8));
        const bf16x8 vf = (bf16x8){lo[0], lo[1], lo[2], lo[3], hi[0], hi[1], hi[2], hi[3]};
        st.o[dt] = __builtin_amdgcn_mfma_f32_16x16x32_bf16(vf, pf, st.o[dt], 0, 0, 0);
    }
}
__device__ __forceinline__ void att_merge_store(AttState& st, LAS float* mrg, int qb, int kh, int lane, bf16* orow0  ) {
    LAS float* mine = mrg + qb * (18 * 64) + lane;
    if (kh == 1) { mine[0] = st.m; mine[64] = st.l;
#pragma unroll
        for (int dt = 0; dt < 4; ++dt)
#pragma unroll
            for (int j = 0; j < 4; ++j) mine[(2 + dt * 4 + j) * 64] = st.o[dt][j]; }
    __syncthreads();
    if (kh == 0) {
        const float m1 = mine[0], l1 = mine[64]; const float ms = fmaxf(st.m, m1); const float f0 = __expf(st.m - ms), f1 = __expf(m1 - ms);
        float lc = st.l * f0 + l1 * f1; lc += shx(lc, 16, lane); lc += shx(lc, 32, lane); const float inv = 1.0f / lc;
        const int q = lane & 15, g = lane >> 4;
#pragma unroll
        for (int dt = 0; dt < 4; ++dt) { float r[4];
#pragma unroll
            for (int j = 0; j < 4; ++j) r[j] = (st.o[dt][j] * f0 + mine[(2 + dt * 4 + j) * 64] * f1) * inv;
            v2u w; w.x = pk2(r[0], r[1]); w.y = pk2(r[2], r[3]); *(GAS v2u*)(orow0 + (size_t)q * DM + dt * 16 + 4 * g) = w; }
    }
}
__device__ __forceinline__ void phase_attn(LAS unsigned char* lds, int l) {
    const KA a = ka_get();
    const int tid = opaque_tid(), lane = tid & 63, wv = __builtin_amdgcn_readfirstlane(tid >> 6), qb = wv & 3, kh = wv >> 2;
    LAS unsigned char* KC = lds; LAS unsigned char* VC = lds + 32768; LAS unsigned char* KL = lds + 65536; LAS unsigned char* VL = lds + 98304;
    LAS float* RPB = (LAS float*)(lds + LDSCTL_OFF + 2048); LAS float* mrg = (LAS float*)KL;
    const bf16* PX = (const bf16*)(a.ws() + WS_X2); bf16* CAT = (bf16*)(a.ws() + WS_X1);
    for (int blk = blockIdx.x; blk < 256; blk += gridDim.x) {
        const int bh = blk >> 1, b = bh >> 3, h = bh & 7, half = blk & 1;
        __syncthreads();
        const bf16* ctxrow = PX + (size_t)(NTX + b * CTXL) * DINP + h * 64;
        stage_rows(KC, ctxrow + 512, 256, tid); stage_rows(VC, ctxrow + 1024, 256, tid);
        for (int i = tid; i < 465; i += 512) RPB[i] = a.in(I_RPB)[((size_t)l * 8 + h) * 465 + i];
        __syncthreads();
        const int kl = lane & 15, g = lane >> 4;
        if (l == 0) {
            for (int rr = 0; rr < 2; ++rr) {
                const int q0 = (half * 8 + rr * 4 + qb) * 16; const bf16* qrow = ctxrow + (size_t)(q0 + kl) * DINP;
                bf16x8 qf[2]; qf[0] = *(const GAS bf16x8*)(qrow + 8 * g); qf[1] = *(const GAS bf16x8*)(qrow + 32 + 8 * g);
                AttState st; st.m = -INFINITY; st.l = 0.f;
#pragma unroll
                for (int dt = 0; dt < 4; ++dt) st.o[dt] = (f32x4){0.f, 0.f, 0.f, 0.f};
                for (int s = 0; s < 4; ++s) att_kstep<false>(st, KC, VC, kh * 128 + s * 32, kh * 128 + s * 32 + 16, qf, lane, RPB, 0, 0, 0);
                att_merge_store(st, mrg, qb, kh, lane, CAT + (size_t)(NTX + b * CTXL + q0) * DM + h * 64);
                __syncthreads();
            }
        }
        v4u pfk[4], pfv[4];
#define ATT_ISSUE(SIDX) do { const int i_ = half * 16 + ((SIDX) >> 1); const int rs_ = min(max(i_ - 4, 0), 24); const bf16* lr_ = PX + (size_t)(b * SEQ + (rs_ + 4 * ((SIDX) & 1)) * 64) * DINP + h * 64; \
            _Pragma("unroll") for (int q__ = 0; q__ < 4; ++q__) { const int idx_ = tid + 512 * q__; const bf16* p_ = lr_ + (size_t)(idx_ >> 3) * DINP + (idx_ & 7) * 8; pfk[q__] = *(const GAS v4u*)(p_ + 512); pfv[q__] = *(const GAS v4u*)(p_ + 1024); } } while (0)
        ATT_ISSUE(0);
        bf16x8 qn[2]; { const bf16* qrow = PX + (size_t)(b * SEQ + (half * 16) * 64 + qb * 16 + kl) * DINP + h * 64; qn[0] = *(const GAS bf16x8*)(qrow + 8 * g); qn[1] = *(const GAS bf16x8*)(qrow + 32 + 8 * g); }
        for (int ui = 0; ui < 16; ++ui) {
            const int i = half * 16 + ui; const int rs = min(max(i - 4, 0), 24);
            const int qc = qb * 16 + kl, cs = min(max(qc - 8, 0), 48), wc0 = min(max(qb * 16 - 8, 0), 32);
            bf16x8 qf[2]; qf[0] = qn[0]; qf[1] = qn[1];
            { const int in_ = half * 16 + (ui < 15 ? ui + 1 : ui); const bf16* qrow = PX + (size_t)(b * SEQ + in_ * 64 + qc) * DINP + h * 64; qn[0] = *(const GAS bf16x8*)(qrow + 8 * g); qn[1] = *(const GAS bf16x8*)(qrow + 32 + 8 * g); }
            AttState st; st.m = -INFINITY; st.l = 0.f;
#pragma unroll
            for (int dt = 0; dt < 4; ++dt) st.o[dt] = (f32x4){0.f, 0.f, 0.f, 0.f};
            for (int s = 0; s < 4; ++s) att_kstep<false>(st, KC, VC, kh * 128 + s * 32, kh * 128 + s * 32 + 16, qf, lane, RPB, 0, 0, 0);
            for (int pass = 0; pass < 2; ++pass) {
                __syncthreads();
#pragma unroll
                for (int q__ = 0; q__ < 4; ++q__) { const int idx_ = tid + 512 * q__; const int o_ = swz_off(idx_ >> 3, idx_ & 7); *(LAS v4u*)(KL + o_) = pfk[q__]; *(LAS v4u*)(VL + o_) = pfv[q__]; }
                __syncthreads();
                if (2 * ui + pass + 1 < 32) ATT_ISSUE(2 * ui + pass + 1);
                for (int k2 = 0; k2 < 2; ++k2) { const int kr = 2 * kh + k2, arow = rs + 4 * pass + kr;
                    att_kstep<true>(st, KL, VL, kr * 64 + wc0, kr * 64 + wc0 + 16, qf, lane, RPB + (arow - i + 7) * 31, wc0, qc, cs); }
            }
            __syncthreads();
            att_merge_store(st, mrg, qb, kh, lane, CAT + (size_t)(b * SEQ + i * 64 + qb * 16) * DM + h * 64);
        }
    }
}

__device__ __forceinline__ void phase_rwpost(LAS unsigned char* lds, int l) {
    const KA a = ka_get();
    const int tid = opaque_tid(), lane = tid & 63, hh = __builtin_amdgcn_readfirstlane(tid >> 6), kl = lane & 15, g = lane >> 4;
    const int er = tid >> 5, cq = tid & 31, c0 = cq * 16, hq = cq >> 2;
    LAS bf16* sig = (LAS bf16*)lds;
    LAS float* Gl = (LAS float*)(lds + 4096);
    const bf16* PX = (const bf16*)(a.ws() + WS_X2); const float* YD = (const float*)(a.ws() + WS_X3); const float* BON = (const float*)(a.ws() + WS_BONUS); bf16* CAT = (bf16*)(a.ws() + WS_X1);
    const float* mup = a.in(I_MUP) + l * 1760; const float* mun = a.in(I_MUN) + l * 1760; const float* g2 = a.in(I_G2) + (size_t)l * 96 * 512;
    f32x4 mpvv[4], mnvv[4], gngv[4], gnbv[4];
#pragma unroll
    for (int i = 0; i < 4; ++i) { mpvv[i] = *(const GAS f32x4*)(mup + 1024 + c0 + 4 * i); mnvv[i] = *(const GAS f32x4*)(mun + 1024 + c0 + 4 * i); gngv[i] = *(const GAS f32x4*)(a.in(I_GNG) + l * 512 + c0 + 4 * i); gnbv[i] = *(const GAS f32x4*)(a.in(I_GNB) + l * 512 + c0 + 4 * i); }
    bf16x8 gb[3][4];
#pragma unroll
    for (int ks = 0; ks < 3; ++ks)
#pragma unroll
        for (int nt = 0; nt < 4; ++nt) { v4u w; unsigned t[8];
#pragma unroll
            for (int j = 0; j < 8; ++j) t[j] = f2bf(g2[(size_t)(32 * ks + 8 * g + j) * 512 + 64 * hh + 16 * nt + kl]);
            w.x = t[0] | (t[1] << 16); w.y = t[2] | (t[3] << 16); w.z = t[4] | (t[5] << 16); w.w = t[6] | (t[7] << 16); gb[ks][nt] = __builtin_bit_cast(bf16x8, w); }
    const int nch = (l == 0 ? NTOK : NTX) / 16;
    for (int ch = blockIdx.x; ch < nch; ch += gridDim.x) {
        const int row0 = ch * 16;
        __syncthreads();
        for (int idx = tid; idx < 1536; idx += 512) { const int r = idx / 96, j = idx - r * 96, row = row0 + r; int t, T; if (row < NTX) { t = row & (SEQ - 1); T = SEQ; } else { t = (row - NTX) & (CTXL - 1); T = CTXL; }
            const bf16* p = PX + (size_t)row * DINP + RWOFF + 1664 + j; const int op = t > 0 ? -DINP : 0, on = t + 1 < T ? DINP : 0;
            const float cv = bf2f(p[0]), pv = bf2f(p[op]) * (t > 0 ? 1.f : 0.f), nv = bf2f(p[on]) * (t + 1 < T ? 1.f : 0.f);
            const float z = cv + mup[1664 + j] * (pv - cv) + mun[1664 + j] * (nv - cv); sig[r * 96 + j] = f2bf1(sigmoidf_(z)); }
        const int row = row0 + er; int t, T; if (row < NTX) { t = row & (SEQ - 1); T = SEQ; } else { t = (row - NTX) & (CTXL - 1); T = CTXL; }
        const bf16* pvp = PX + (size_t)row * DINP + RWOFF + 1024 + c0; const int op = t > 0 ? -DINP : 0, on = t + 1 < T ? DINP : 0; const float fp = t > 0 ? 1.f : 0.f, fn = t + 1 < T ? 1.f : 0.f;
        v4u vc[2], vp[2], vn[2]; f32x4 y0[4], y1[4];
#pragma unroll
        for (int i = 0; i < 2; ++i) { vc[i] = *(const GAS v4u*)(pvp + 8 * i); vp[i] = *(const GAS v4u*)(pvp + op + 8 * i); vn[i] = *(const GAS v4u*)(pvp + on + 8 * i); }
#pragma unroll
        for (int i = 0; i < 4; ++i) { y0[i] = *(const GAS f32x4*)(YD + (size_t)row * 512 + c0 + 4 * i); y1[i] = *(const GAS f32x4*)(YD + ((size_t)NTOK + row) * 512 + c0 + 4 * i); }
        const float bon = BON[(size_t)row * 8 + hq] + BON[((size_t)NTOK + row) * 8 + hq];
        __syncthreads();
        { f32x4 acc[4];
#pragma unroll
          for (int nt = 0; nt < 4; ++nt) acc[nt] = (f32x4){0.f, 0.f, 0.f, 0.f};
#pragma unroll
          for (int ks = 0; ks < 3; ++ks) { const bf16x8 af = *(const LAS bf16x8*)(sig + kl * 96 + 32 * ks + 8 * g);
#pragma unroll
              for (int nt = 0; nt < 4; ++nt) acc[nt] = __builtin_amdgcn_mfma_f32_16x16x32_bf16(af, gb[ks][nt], acc[nt], 0, 0, 0); }
#pragma unroll
          for (int nt = 0; nt < 4; ++nt)
#pragma unroll
              for (int j = 0; j < 4; ++j) Gl[(4 * g + j) * 512 + 64 * hh + 16 * nt + kl] = acc[nt][j]; }
        __syncthreads();
        f32x4 y[4]; float s = 0.f;
#pragma unroll
        for (int i = 0; i < 4; ++i) { y[i] = y0[i] + y1[i]; s += (y[i].x + y[i].y) + (y[i].z + y[i].w); }
        s += dppmov<0xB1>(s); s += dppmov<0x4E>(s); const float mean = s * (1.0f / 64.0f); float q = 0.f;
#pragma unroll
        for (int i = 0; i < 4; ++i) { y[i] = y[i] - mean; q += (y[i].x * y[i].x + y[i].y * y[i].y) + (y[i].z * y[i].z + y[i].w * y[i].w); }
        q += dppmov<0xB1>(q); q += dppmov<0x4E>(q); const float rstd = 1.0f / sqrtf(q * (1.0f / 64.0f) + GN_EPS);
        unsigned ow[8];
#pragma unroll
        for (int i = 0; i < 4; ++i) { const unsigned cw0 = vc[i >> 1][(i & 1) * 2], cw1 = vc[i >> 1][(i & 1) * 2 + 1], pw0 = vp[i >> 1][(i & 1) * 2], pw1 = vp[i >> 1][(i & 1) * 2 + 1], nw0 = vn[i >> 1][(i & 1) * 2], nw1 = vn[i >> 1][(i & 1) * 2 + 1];
            const f32x4 cv = {bflo(cw0), bfhi(cw0), bflo(cw1), bfhi(cw1)}, pv = {bflo(pw0) * fp, bfhi(pw0) * fp, bflo(pw1) * fp, bfhi(pw1) * fp}, nv = {bflo(nw0) * fn, bfhi(nw0) * fn, bflo(nw1) * fn, bfhi(nw1) * fn};
            const f32x4 mpv = mpvv[i], mnv = mnvv[i], gng = gngv[i], gnb = gnbv[i];
            const f32x4 zv = cv + mpv * (pv - cv) + mnv * (nv - cv);
            const f32x4 gt = *(const LAS f32x4*)(Gl + er * 512 + c0 + 4 * i);
            const f32x4 o = (y[i] * rstd * gng + gnb + zv * bon) * gt;
            ow[2 * i] = pk2(o.x, o.y); ow[2 * i + 1] = pk2(o.z, o.w); }
        GAS v4u* dst = (GAS v4u*)(CAT + (size_t)row * DM + 512 + c0); dst[0] = (v4u){ow[0], ow[1], ow[2], ow[3]}; dst[1] = (v4u){ow[4], ow[5], ow[6], ow[7]};
    }
}

__device__ __forceinline__ void phase_ln1_route(LAS unsigned char* lds, int l) {
    const KA a = ka_get();
    const int tid = opaque_tid(), lane = tid & 63, wave = __builtin_amdgcn_readfirstlane(tid >> 6), G = gridDim.x, bid = blockIdx.x;
    const int gw = bid * 8 + wave, NGW = G * 8;
    LAS float* rwt = (LAS float*)lds;
#pragma unroll
    for (int i = tid; i < 8192; i += 512) { const int k = i >> 3, eg = i & 7; const f32x4 w4 = *(const GAS f32x4*)(a.in(I_RW) + k * 32 + 4 * eg);
        rwt[(4 * eg) * 1024 + k] = w4.x; rwt[(4 * eg + 1) * 1024 + k] = w4.y; rwt[(4 * eg + 2) * 1024 + k] = w4.z; rwt[(4 * eg + 3) * 1024 + k] = w4.w; }
    if (tid < 32) ((LAS int*)(lds + LDSCTL_OFF + 1024))[tid] = 0;
    __syncthreads();
    const float* mods = (const float*)(a.ws() + WS_MODS) + (size_t)l * 17 * 6144;
    const bf16* O = (const bf16*)(a.ws() + WS_X3); bf16* HM = (bf16*)(a.ws() + WS_X1);
    const float* xs = l == 0 ? a.in(I_X) : a.out(); const float* cs = l == 0 ? a.in(I_CTX) : (const float*)(a.ws() + WS_CS);
    float* xo = a.out(); float* co = (float*)(a.ws() + WS_CS);
    int* HIST = (int*)(a.ws() + WS_LIST); TokInfo* TOK = (TokInfo*)(a.ws() + WS_TOK); LAS int* lcnt = (LAS int*)(lds + LDSCTL_OFF + 1024);
    const GAS f32x4* lg = (const GAS f32x4*)(a.in(I_LN1G) + l * DM) + lane; const GAS f32x4* lb = (const GAS f32x4*)(a.in(I_LN1B) + l * DM) + lane;
    const int Mrows = l == 0 ? NTOK : NTX;
    const float biasv = a.in(I_RB)[(lane >> 1) & 31];
    f32x4 lgv[4], lbv[4];
#pragma unroll
    for (int j = 0; j < 4; ++j) { lgv[j] = lg[64 * j]; lbv[j] = lb[64 * j]; }
    f32x4 nx[4]; v2u no[4];
#define LN1_FETCH(M) do { const int m_ = (M) < Mrows ? (M) : gw; const float* s_ = m_ < NTX ? xs + (size_t)m_ * DM : cs + (size_t)(m_ - NTX) * DM; \
        const GAS f32x4* xr_ = (const GAS f32x4*)s_ + lane; const GAS v2u* or_ = (const GAS v2u*)(O + (size_t)m_ * DM) + lane; \
        _Pragma("unroll") for (int j_ = 0; j_ < 4; ++j_) { nx[j_] = xr_[64 * j_]; no[j_] = or_[64 * j_]; } } while (0)
    LN1_FETCH(gw);
    for (int m = gw; m < Mrows; m += NGW) {
        float* dst; int mr;
        if (m < NTX) { dst = xo + (size_t)m * DM; mr = m / SEQ; } else { dst = co + (size_t)(m - NTX) * DM; mr = 16; }
        const GAS f32x4* md = (const GAS f32x4*)(mods + (size_t)mr * 6144) + lane;
        f32x4 v[4], sc2[4], sh2[4]; float s = 0.f;
#pragma unroll
        for (int j = 0; j < 4; ++j) { sc2[j] = md[1024 + 64 * j]; sh2[j] = md[768 + 64 * j]; }
#pragma unroll
        for (int j = 0; j < 4; ++j) { const f32x4 x = nx[j], gt = md[512 + 64 * j]; const v2u ow = no[j]; const f32x4 o = {bflo(ow.x), bfhi(ow.x), bflo(ow.y), bfhi(ow.y)};
            v[j] = x * ALPHA + gt * o; s += (v[j].x + v[j].y) + (v[j].z + v[j].w); }
        LN1_FETCH(m + NGW);
        const float mean = wave_sum(s) * (1.f / DM); float s2 = 0.f;
#pragma unroll
        for (int j = 0; j < 4; ++j) { v[j] = v[j] - mean; s2 += (v[j].x * v[j].x + v[j].y * v[j].y) + (v[j].z * v[j].z + v[j].w * v[j].w); }
        const float rstd = 1.f / sqrtf(wave_sum(s2) * (1.f / DM) + LN_EPS);
        float part[32];
#pragma unroll
        for (int e = 0; e < 32; ++e) part[e] = 0.f;
        GAS f32x4* dr = (GAS f32x4*)dst + lane; GAS v2u* hr = (GAS v2u*)(HM + (size_t)m * DM) + lane;
#pragma unroll
        for (int j = 0; j < 4; ++j) { const f32x4 x1 = v[j] * rstd * lgv[j] + lbv[j]; dr[64 * j] = x1;
            const f32x4 hm = x1 * (sc2[j] + 1.0f) + sh2[j]; v2u w; w.x = pk2(hm.x, hm.y); w.y = pk2(hm.z, hm.w); hr[64 * j] = w;
#pragma unroll
            for (int e8 = 0; e8 < 4; ++e8) { f32x4 rw[8]; const unsigned ra = (unsigned)((256 * j + 4 * lane) * 4 + (e8 >> 1) * 65536);
#pragma unroll
                for (int q = 0; q < 8; ++q) asm volatile("ds_read_b128 %0, %1 offset:%2" : "=v"(rw[q]) : "v"(ra), "i"(((e8 & 1) * 8 + q) * 4096));
                asm volatile("s_waitcnt lgkmcnt(0)" : "+v"(rw[0]), "+v"(rw[1]), "+v"(rw[2]), "+v"(rw[3]), "+v"(rw[4]), "+v"(rw[5]), "+v"(rw[6]), "+v"(rw[7]) :: "memory");
#pragma unroll
                for (int q = 0; q < 8; ++q) part[e8 * 8 + q] += hm.x * rw[q].x + hm.y * rw[q].y + hm.z * rw[q].z + hm.w * rw[q].w;
#ifdef PROBE_ROUTER
                { f32x4 rw2[8];
#pragma unroll
                  for (int q = 0; q < 8; ++q) asm volatile("ds_read_b128 %0, %1 offset:%2" : "=v"(rw2[q]) : "v"(ra), "i"(((e8 & 1) * 8 + q) * 4096));
                  asm volatile("s_waitcnt lgkmcnt(0)" : "+v"(rw2[0]), "+v"(rw2[1]), "+v"(rw2[2]), "+v"(rw2[3]), "+v"(rw2[4]), "+v"(rw2[5]), "+v"(rw2[6]), "+v"(rw2[7]) :: "memory");
#pragma unroll
                  for (int q = 0; q < 8; ++q) { float dmy = hm.x * rw2[q].x + hm.y * rw2[q].y + hm.z * rw2[q].z + hm.w * rw2[q].w; asm volatile("" :: "v"(dmy)); } }
#endif
            } }
        float p16[16], p8[8], p4[4], p2[2], p1;
        { const bool up = (lane & 32) != 0;
#pragma unroll
          for (int e = 0; e < 16; ++e) { const float mine = up ? part[16 + e] : part[e], oth = up ? part[e] : part[16 + e]; p16[e] = mine + shx(oth, 32, lane); } }
        { const bool up = (lane & 16) != 0;
#pragma unroll
          for (int e = 0; e < 8; ++e) { const float mine = up ? p16[8 + e] : p16[e], oth = up ? p16[e] : p16[8 + e]; p8[e] = mine + shx(oth, 16, lane); } }
        { const bool up = (lane & 8) != 0;
#pragma unroll
          for (int e = 0; e < 4; ++e) { const float mine = up ? p8[4 + e] : p8[e], oth = up ? p8[e] : p8[4 + e]; p4[e] = mine + dppmov<0x128>(oth); } }
        { const bool up = (lane & 4) != 0;
#pragma unroll
          for (int e = 0; e < 2; ++e) { const float mine = up ? p4[2 + e] : p4[e], oth = up ? p4[e] : p4[2 + e]; p2[e] = mine + shx(oth, 4, lane); } }
        { const bool up = (lane & 2) != 0; const float mine = up ? p2[1] : p2[0], oth = up ? p2[0] : p2[1]; p1 = mine + dppmov<0x4E>(oth); }
        const float logit = p1 + dppmov<0xB1>(p1);
        const float score = sigmoidf_(logit), sel = score + biasv;
        const int gl = lane & ~7;
        const float q0 = shi(sel, gl), q1 = shi(sel, gl + 2), q2 = shi(sel, gl + 4), q3 = shi(sel, gl + 6);
        const float mx = fmaxf(fmaxf(q0, q1), fmaxf(q2, q3));
        float top2;
        { float a0 = q0, a1 = q1, a2 = q2, a3 = q3; float t;
          if (a0 < a1) { t = a0; a0 = a1; a1 = t; } if (a2 < a3) { t = a2; a2 = a3; a3 = t; } if (a0 < a2) { t = a0; a0 = a2; a2 = t; } if (a1 < a3) { t = a1; a1 = a3; a3 = t; } if (a1 < a2) { t = a1; a1 = a2; a2 = t; }
          top2 = a0 + a1; (void)mx; }
        float best = __builtin_bit_cast(float, __builtin_amdgcn_readlane(__builtin_bit_cast(int, top2), 0)); int gidx = 0;
#pragma unroll
        for (int gg = 1; gg < 8; ++gg) { const float sc = __builtin_bit_cast(float, __builtin_amdgcn_readlane(__builtin_bit_cast(int, top2), gg * 8)); if (sc > best) { best = sc; gidx = gg; } }
        const float r0 = shi(sel, gidx * 8), r1 = shi(sel, gidx * 8 + 2), r2 = shi(sel, gidx * 8 + 4), r3 = shi(sel, gidx * 8 + 6);
        int i0 = 0; float b0 = r0; if (r1 > b0) { b0 = r1; i0 = 1; } if (r2 > b0) { b0 = r2; i0 = 2; } if (r3 > b0) { b0 = r3; i0 = 3; }
        int i1 = -1; float b1 = -INFINITY;
        if (i0 != 0 && r0 > b1) { b1 = r0; i1 = 0; } if (i0 != 1 && r1 > b1) { b1 = r1; i1 = 1; } if (i0 != 2 && r2 > b1) { b1 = r2; i1 = 2; } if (i0 != 3 && r3 > b1) { b1 = r3; i1 = 3; }
        const int e0 = gidx * 4 + i0, e1 = gidx * 4 + i1;
        const float s0 = shi(score, 2 * e0), s1 = shi(score, 2 * e1); const float gs = 1.0f / (s0 + s1);
        if (lane == 0) { const int p0 = __hip_atomic_fetch_add(lcnt + e0, 1, __ATOMIC_RELAXED, __HIP_MEMORY_SCOPE_WORKGROUP), p1_ = __hip_atomic_fetch_add(lcnt + e1, 1, __ATOMIC_RELAXED, __HIP_MEMORY_SCOPE_WORKGROUP);
            TokInfo ti; ti.e0 = e0; ti.e1 = e1; ti.p0 = p0; ti.p1 = p1_; ti.g0 = s0 * gs; ti.g1 = s1 * gs; ti.pad0 = 0; ti.pad1 = 0; TOK[m] = ti; }
    }
    __syncthreads();
    if (tid < 32) HIST[bid * 32 + tid] = lcnt[tid];
}

template <bool FULL> __device__ __forceinline__ void moe_tables(LAS unsigned char* lds, int l) {
    const KA a = ka_get(); const int tid = opaque_tid(), G = gridDim.x;
    LAS int* pref = (LAS int*)(lds + PREF_OFF); LAS int* bb = (LAS int*)lds; LAS int* tot = (LAS int*)(lds + 65536);
    const int* HIST = (const int*)(a.ws() + WS_LIST);
    __syncthreads();
    const int e = tid & 31, grp = tid >> 5;
    int loc[16]; int run = 0;
#pragma unroll
    for (int i = 0; i < 16; ++i) { const int b = grp * 16 + i; loc[i] = (b < G) ? HIST[b * 32 + e] : 0; }
#pragma unroll
    for (int i = 0; i < 16; ++i) { const int v = loc[i]; loc[i] = run; run += v; }
    tot[grp * 32 + e] = run;
    __syncthreads();
    int base = 0, total = 0;
#pragma unroll
    for (int q = 0; q < 16; ++q) { const int v = tot[q * 32 + e]; base += (q < grp) ? v : 0; total += v; }
    if (FULL) {
#pragma unroll
        for (int i = 0; i < 16; ++i) bb[(grp * 16 + i) * 32 + e] = base + loc[i]; }
    if (grp == 0) pref[40 + e] = total;
    __syncthreads();
    if (tid == 0) { int acc = 0; for (int k = 0; k < 32; ++k) { pref[k] = acc; acc += (pref[40 + k] + 255) >> 8; } pref[32] = acc; }
    __syncthreads();
}
__device__ __forceinline__ void phase_gather(LAS unsigned char* lds, int l) {
    const KA a = ka_get();
    const int tid = opaque_tid(), lane = tid & 63, wave = __builtin_amdgcn_readfirstlane(tid >> 6), G = gridDim.x, bid = blockIdx.x;
    const int gw = bid * 8 + wave, NGW = G * 8;
    moe_tables<true>(lds, l);
    const LAS int* pref = (const LAS int*)(lds + PREF_OFF); const LAS int* bb = (const LAS int*)lds;
    const bf16* HM = (const bf16*)(a.ws() + WS_X1); bf16* XB = (bf16*)(a.ws() + WS_X2); const TokInfo* TOK = (const TokInfo*)(a.ws() + WS_TOK);
    const int Mrows = l == 0 ? NTOK : NTX;
    for (int m = gw; m < Mrows; m += NGW) {
        const TokInfo ti = TOK[m]; const int blk = (m % NGW) >> 3;
        const int sl0 = pref[ti.e0] * 256 + bb[blk * 32 + ti.e0] + ti.p0, sl1 = pref[ti.e1] * 256 + bb[blk * 32 + ti.e1] + ti.p1;
        const GAS v4u* srcp = (const GAS v4u*)(HM + (size_t)m * DM) + lane; const v4u v0 = srcp[0], v1 = srcp[64];
        GAS v4u* d0 = (GAS v4u*)(XB + (size_t)sl0 * DM) + lane; GAS v4u* d1 = (GAS v4u*)(XB + (size_t)sl1 * DM) + lane;
        d0[0] = v0; d0[64] = v1; d1[0] = v0; d1[64] = v1;
    }
    for (int e = 0; e < 32; ++e) {
        const int c = pref[40 + e], npad = ((c + 255) & ~255) - c, r0 = pref[e] * 256 + c;
        for (int r = gw; r < npad; r += NGW) { GAS v4u* dst = (GAS v4u*)(XB + (size_t)(r0 + r) * DM) + lane; dst[0] = (v4u){0u, 0u, 0u, 0u}; dst[64] = (v4u){0u, 0u, 0u, 0u}; }
    }
}

__device__ __forceinline__ void phase_ln2(LAS unsigned char* lds, int l) {
    const KA a = ka_get();
    const int tid = opaque_tid(), lane = tid & 63, wave = __builtin_amdgcn_readfirstlane(tid >> 6), G = gridDim.x, bid = blockIdx.x;
    const int gw = bid * 8 + wave, NGW = G * 8;
    moe_tables<true>(lds, l);
    const LAS int* pref = (const LAS int*)(lds + PREF_OFF); const LAS int* bb = (const LAS int*)lds;
    const float* mods = (const float*)(a.ws() + WS_MODS) + (size_t)l * 17 * 6144;
    const bf16* Y = (const bf16*)(a.ws() + WS_X2); const TokInfo* TOK = (const TokInfo*)(a.ws() + WS_TOK);
    float* xo = a.out(); float* co = (float*)(a.ws() + WS_CS);
    const GAS f32x4* lg = (const GAS f32x4*)(a.in(I_LN2G) + l * DM) + lane; const GAS f32x4* lb = (const GAS f32x4*)(a.in(I_LN2B) + l * DM) + lane;
    const int Mrows = l == 0 ? NTOK : NTX;
    f32x4 lgv[4], lbv[4];
#pragma unroll
    for (int j = 0; j < 4; ++j) { lgv[j] = lg[64 * j]; lbv[j] = lb[64 * j]; }
    TokInfo tnext = TOK[gw < Mrows ? gw : 0];
    for (int m = gw; m < Mrows; m += NGW) {
        float* xr_; int mr;
        if (m < NTX) { xr_ = xo + (size_t)m * DM; mr = m / SEQ; } else { xr_ = co + (size_t)(m - NTX) * DM; mr = 16; }
        const TokInfo ti = tnext; tnext = TOK[(m + NGW) < Mrows ? (m + NGW) : m]; const int blk = (m % NGW) >> 3;
        const int sl0 = pref[ti.e0] * 256 + bb[blk * 32 + ti.e0] + ti.p0, sl1 = pref[ti.e1] * 256 + bb[blk * 32 + ti.e1] + ti.p1;
        GAS f32x4* xr = (GAS f32x4*)xr_ + lane; const GAS f32x4* md = (const GAS f32x4*)(mods + (size_t)mr * 6144) + lane;
        const GAS v2u* y0 = (const GAS v2u*)(Y + (size_t)sl0 * DM) + lane; const GAS v2u* y1 = (const GAS v2u*)(Y + (size_t)sl1 * DM) + lane;
        f32x4 v[4], msc[4], msh[4]; float s = 0.f;
        if (l == 0) { const GAS f32x4* mn = (const GAS f32x4*)(mods + (size_t)17 * 6144 + (size_t)mr * 6144) + lane;
#pragma unroll
            for (int j = 0; j < 4; ++j) { msc[j] = mn[256 + 64 * j]; msh[j] = mn[64 * j]; } }
#pragma unroll
        for (int j = 0; j < 4; ++j) { const f32x4 x = xr[64 * j], gt = md[1280 + 64 * j]; const v2u a0 = y0[64 * j], a1 = y1[64 * j];
            const f32x4 ya = {bflo(a0.x), bfhi(a0.x), bflo(a0.y), bfhi(a0.y)}, yb = {bflo(a1.x), bfhi(a1.x), bflo(a1.y), bfhi(a1.y)};
            v[j] = x * ALPHA + gt * (ya * ti.g0 + yb * ti.g1); s += (v[j].x + v[j].y) + (v[j].z + v[j].w); }
        const float mean = wave_sum(s) * (1.f / DM); float s2 = 0.f;
#pragma unroll
        for (int j = 0; j < 4; ++j) { v[j] = v[j] - mean; s2 += (v[j].x * v[j].x + v[j].y * v[j].y) + (v[j].z * v[j].z + v[j].w * v[j].w); }
        const float rstd = 1.f / sqrtf(wave_sum(s2) * (1.f / DM) + LN_EPS);
        if (l == 0) {
            GAS v2u* o8 = (GAS v2u*)((bf16*)(a.ws() + WS_X1) + (size_t)m * DM) + lane;
#pragma unroll
            for (int j = 0; j < 4; ++j) { const f32x4 xn = v[j] * rstd * lgv[j] + lbv[j]; xr[64 * j] = xn; const f32x4 r = xn * (msc[j] + 1.0f) + msh[j]; v2u w; w.x = pk2(r.x, r.y); w.y = pk2(r.z, r.w); o8[64 * j] = w; }
        } else {
#pragma unroll
            for (int j = 0; j < 4; ++j) xr[64 * j] = v[j] * rstd * lgv[j] + lbv[j];
        }
    }
}
namespace csc {
constexpr int ARR = 0;
constexpr int RAW = 0;
constexpr int ZL = 34816;
constexpr int WLO = 57344;
constexpr int FR = 58368;
constexpr int AABT = 87040;
constexpr int LWO = 91136;
constexpr int AAO = 107520;
__device__ __forceinline__ int sw16(int row, int chunk) { return row * 128 + ((chunk ^ (row & 7)) << 4); }
__device__ __forceinline__ v2u cvt4(const f32x4 v) { v2u r; r.x = pk2(v[0], v[1]); r.y = pk2(v[2], v[3]); return r; }
__device__ __forceinline__ bf16x8 mk8(v2u lo, v2u hi) { v4u w; w.x = lo.x; w.y = lo.y; w.z = hi.x; w.w = hi.y; return __builtin_bit_cast(bf16x8, w); }
__device__ __forceinline__ v2u trd(const LAS unsigned char* p) { return __builtin_bit_cast(v2u, __builtin_amdgcn_ds_read_tr16_b64_v4i16((LAS v4i16_t*)p)); }
__device__ __forceinline__ int opq(int v) { asm volatile("" : "+v"(v)); return v; }
__device__ __forceinline__ int opqs(int v) { asm volatile("" : "+s"(v)); return v; }
}
namespace bgc {
constexpr int CBUF = LDSCTL_OFF + 4096, CPITCH = 80, NITEMS = NEXP * 1536;
struct Item { const float* src; bf16* dst; int N, ld; };
__device__ __forceinline__ Item decode(const KA& a, int l, int item) {
    const int e = item / 1536; int r = item - e * 1536; const int m = r >> 9, t = r & 511; const size_t eo = ((size_t)l * NEXP + e) * (size_t)DM * DEXP; Item it;
    if (m < 2) { const int kt = t >> 4, nt = t & 15, j0 = 32 * nt; it.N = DEXP; it.ld = 1024; it.src = (m ? a.in(I_EW3) : a.in(I_EW1)) + eo + (size_t)(32 * kt) * DEXP + j0;
        it.dst = (bf16*)(a.ws() + WS_W13T) + (size_t)e * 1024 * 1024 + (size_t)(256 * (j0 >> 7) + 128 * m + (j0 & 127)) * 1024 + 32 * kt; }
    else { const int kt = t >> 5, nt = t & 31; it.N = DM; it.ld = 512; it.src = a.in(I_EW2) + eo + (size_t)(32 * kt) * DM + 32 * nt; it.dst = (bf16*)(a.ws() + WS_W2T) + (size_t)e * 1024 * 512 + (size_t)(32 * nt) * 512 + 32 * kt; }
    return it; }
__device__ __forceinline__ void issue(const KA& a, int l, int item, int lane, f32x4 (&cv)[4]) { const Item it = decode(a, l, item);
#pragma unroll
    for (int i = 0; i < 4; ++i) cv[i] = *(const GAS f32x4*)(it.src + (size_t)((lane >> 3) + 8 * i) * it.N + (lane & 7) * 4); }
__device__ __forceinline__ void finish(const KA& a, int l, int item, int lane, int slot, LAS unsigned char* lds, const f32x4 (&cv)[4]) { const Item it = decode(a, l, item);
    LAS unsigned char* buf = lds + CBUF + slot * (32 * CPITCH);
#pragma unroll
    for (int i = 0; i < 4; ++i)
#pragma unroll
        for (int u = 0; u < 4; ++u) *(LAS bf16*)(buf + ((lane & 7) * 4 + u) * CPITCH + ((lane >> 3) + 8 * i) * 2) = f2bf1(cv[i][u]);
    LDS_WAIT(); asm volatile("" ::: "memory");
    const int n = lane >> 1, hf = lane & 1; const v4u w0 = *(const LAS v4u*)(buf + n * CPITCH + hf * 32), w1 = *(const LAS v4u*)(buf + n * CPITCH + hf * 32 + 16);
    GAS v4u* d = (GAS v4u*)(it.dst + (size_t)n * it.ld + 16 * hf); d[0] = w0; d[1] = w1;
    LDS_WAIT(); asm volatile("" ::: "memory"); }
}
#ifndef SCAN_PROBE
#define SCAN_PROBE 0
#endif
#define REPK(k) for (int rep_ = 0; rep_ < ((SCAN_PROBE == (k)) ? 2 : 1); ++rep_)
__device__ __forceinline__ void phase_scan(LAS unsigned char* lds, int l) {
    using namespace csc;
    const KA a = ka_get();
    const int tid = opaque_tid(), lane0 = tid & 63, wv = __builtin_amdgcn_readfirstlane(tid >> 6);
    const bf16* PX = (const bf16*)(a.ws() + WS_X2); float* YD = (float*)(a.ws() + WS_X3); float* BON = (float*)(a.ws() + WS_BONUS);
    const float* mup = a.in(I_MUP) + l * 1760; const float* mun = a.in(I_MUN) + l * 1760;
    const f32x4 Z4 = {0.f, 0.f, 0.f, 0.f}; const v2u Z2 = {0u, 0u};
    for (int chain = blockIdx.x; chain < 256; chain += gridDim.x) {
        const int b = chain >> 4, h = (chain >> 1) & 7, d = chain & 1; const int c0_ = opq(lane0);
        float kkc[2], kac[2], rkc[2], mur[2][2], muk[2][2], muv[2][2], mul[2][2], ropef[2]; bf16x8 w2f[2], a2f[2]; float w0c[2], a0c[2];
        { const int ln = c0_, kl = ln & 15, g = ln >> 4, cp = ln & 31;
#pragma unroll
          for (int u = 0; u < 2; ++u) { const int c = 2 * cp + u; ropef[u] = exp2f(-(float)(c & 15) * (13.287712379549449f / 16.0f));
            kkc[u] = a.in(I_KK)[l * 512 + h * 64 + c]; kac[u] = a.in(I_KA)[l * 512 + h * 64 + c]; rkc[u] = a.in(I_RK)[l * 512 + h * 64 + c];
            const int colr = h * 64 + c, coll = (c < 32) ? (1536 + d * 32 + c) : (1600 + d * 32 + (c - 32));
            mur[u][0] = d ? mun[colr] : mup[colr]; mur[u][1] = d ? mup[colr] : mun[colr]; muk[u][0] = d ? mun[512 + colr] : mup[512 + colr]; muk[u][1] = d ? mup[512 + colr] : mun[512 + colr];
            muv[u][0] = d ? mun[1024 + colr] : mup[1024 + colr]; muv[u][1] = d ? mup[1024 + colr] : mun[1024 + colr]; mul[u][0] = d ? mun[coll] : mup[coll]; mul[u][1] = d ? mup[coll] : mun[coll]; }
#pragma unroll
        for (int i = 0; i < 2; ++i) { const int cc = h * 64 + 16 * ((wv >> 2) * 2 + i) + kl; unsigned t[8], u[8];
#pragma unroll
            for (int j = 0; j < 8; ++j) { t[j] = f2bf(a.in(I_W2)[((size_t)(l * 2 + d) * 32 + 8 * g + j) * 512 + cc]); u[j] = f2bf(a.in(I_A2)[((size_t)(l * 2 + d) * 32 + 8 * g + j) * 512 + cc]); }
            w2f[i] = __builtin_bit_cast(bf16x8, (v4u){t[0] | (t[1] << 16), t[2] | (t[3] << 16), t[4] | (t[5] << 16), t[6] | (t[7] << 16)});
            a2f[i] = __builtin_bit_cast(bf16x8, (v4u){u[0] | (u[1] << 16), u[2] | (u[3] << 16), u[4] | (u[5] << 16), u[6] | (u[7] << 16)});
            w0c[i] = a.in(I_W0)[(l * 2 + d) * 512 + cc]; a0c[i] = a.in(I_A0)[(l * 2 + d) * 512 + cc]; } }
        f32x4 St[4] = {Z4, Z4, Z4, Z4};
        f32x4 cvt_[4] = {Z4, Z4, Z4, Z4}; int cit = blockIdx.x * 8 + wv, cpend = -1; const int cstride = gridDim.x * 8;
#define BGC_WINDOW() do { const int ln_ = opq(lane0); if (cpend >= 0) bgc::finish(a, l, cpend, ln_, wv & 3, lds, cvt_); if (cit < bgc::NITEMS) { bgc::issue(a, l, cit, ln_, cvt_); cpend = cit; cit += cstride; } else cpend = -1; } while (0)
        for (int seq = 0; seq < 2; ++seq) {
            const int T = seq ? SEQ : CTXL, rowbase = seq ? b * SEQ : NTX + b * CTXL, ngrp = T / 64;
            v4u pre[5];
#define CSC_PREFETCH(GRP) do { const int s0_ = (GRP) * 64; const int tlo_ = d ? (T - 64 - s0_) : s0_; \
                _Pragma("unroll") for (int i_ = 0; i_ < 5; ++i_) { const int id_ = opq(tid) + 512 * i_; const int rr_ = id_ >> 5, ch_ = id_ & 31; const int t_ = tlo_ - 1 + rr_; \
                    const int col_ = RWOFF + (ch_ < 24 ? (ch_ >> 3) * 512 + h * 64 + (ch_ & 7) * 8 : (ch_ < 28 ? 1536 + d * 32 + (ch_ - 24) * 8 : 1600 + d * 32 + (ch_ - 28) * 8)); \
                    const bool ok_ = (id_ < 66 * 32) && t_ >= 0 && t_ < T; const int tc_ = ok_ ? t_ : 0; \
                    const v4u v_ = *(const GAS v4u*)(PX + (size_t)(rowbase + tc_) * DINP + col_); pre[i_] = ok_ ? v_ : (v4u){0u, 0u, 0u, 0u}; } } while (0)
            CSC_PREFETCH(0);
            for (int grp = 0; grp < ngrp; ++grp) {
                const int s0 = grp * 64;
                int lane = opq(lane0); int c = lane, kl = lane & 15, g = lane >> 4, q_ = kl >> 2, p_ = kl & 3; (void)q_; (void)p_;
#pragma unroll
                for (int i = 0; i < 5; ++i) { const int id = opq(tid) + 512 * i; if (id < 66 * 32) *(LAS v4u*)(lds + RAW + id * 16) = pre[i]; }
                __syncthreads();
                int sl = opqs(wv);
                float Rk[4][2], Rq[4][2], Rr[4][2], Rv[4][2];
                REPK(1) { const int cp = lane & 31, sh = lane >> 5, sb = 8 * sl + 4 * sh; const int rbase = d ? 64 - sb : sb + 1, rdir = d ? -256 : 256;
                  const LAS bf16* p0 = (const LAS bf16*)(lds + RAW) + (rbase * 256 + 2 * cp) - rdir;
                  float pr[6][2], pk[6][2], pv[6][2], pl[6][2];
#pragma unroll
                  for (int j = 0; j < 6; ++j) { const LAS unsigned* p = (const LAS unsigned*)(p0 + j * rdir); const unsigned wr = p[0], wk = p[32], wv_ = p[64], wl = p[96];
                      pr[j][0] = bflo(wr); pr[j][1] = bfhi(wr); pk[j][0] = bflo(wk); pk[j][1] = bfhi(wk); pv[j][0] = bflo(wv_); pv[j][1] = bfhi(wv_); pl[j][0] = bflo(wl); pl[j][1] = bfhi(wl); }
                  const int qd = cp >> 3;
#pragma unroll
                  for (int i = 0; i < 4; ++i) { const int sloc = sb + i; float r[2], k[2], zz[2];
#pragma unroll
                      for (int u = 0; u < 2; ++u) { r[u] = pr[i + 1][u] + mur[u][0] * (pr[i][u] - pr[i + 1][u]) + mur[u][1] * (pr[i + 2][u] - pr[i + 1][u]); k[u] = pk[i + 1][u] + muk[u][0] * (pk[i][u] - pk[i + 1][u]) + muk[u][1] * (pk[i + 2][u] - pk[i + 1][u]);
                          Rv[i][u] = pv[i + 1][u] + muv[u][0] * (pv[i][u] - pv[i + 1][u]) + muv[u][1] * (pv[i + 2][u] - pv[i + 1][u]);
                          const float z = pl[i + 1][u] + mul[u][0] * (pl[i][u] - pl[i + 1][u]) + mul[u][1] * (pl[i + 2][u] - pl[i + 1][u]);
                          const float th = 1.0f - 2.0f * __builtin_amdgcn_rcpf(1.0f + __expf(2.0f * z)); zz[u] = cp < 16 ? th : z; }
                      ((LAS unsigned*)(lds + ZL))[sloc * 32 + cp] = pk2(zz[0], zz[1]);
                      if (seq) { const int t = d ? (T - 1 - (s0 + sloc)) : (s0 + sloc); const float pos = (float)((qd < 2) ? (t >> 6) : (t & 63));
#pragma unroll
                          for (int u = 0; u < 2; ++u) { const float rp = dppmov<0x128>(r[u]), kp = dppmov<0x128>(k[u]); const float ang = pos * ropef[u]; const float cs = __cosf(ang), sn = __sinf(ang);
                              const float sg = (qd & 1) ? sn : -sn; r[u] = r[u] * cs + rp * sg; k[u] = k[u] * cs + kp * sg; } }
                      const float k0 = k[0] * kkc[0], k1 = k[1] * kkc[1]; float ss = k0 * k0 + k1 * k1;
                      ss += dppmov<0xB1>(ss); ss += dppmov<0x4E>(ss); ss += dppmov<0x141>(ss); ss += dppmov<0x140>(ss);
                      { const int iv = __builtin_bit_cast(int, ss); const float a0 = __builtin_bit_cast(float, __builtin_amdgcn_readlane(iv, 0)) + __builtin_bit_cast(float, __builtin_amdgcn_readlane(iv, 16)), a1 = __builtin_bit_cast(float, __builtin_amdgcn_readlane(iv, 32)) + __builtin_bit_cast(float, __builtin_amdgcn_readlane(iv, 48)); ss = sh ? a1 : a0; }
                      const float rn = __builtin_amdgcn_rsqf(fmaxf(ss, 1e-24f));
                      Rk[i][0] = k0 * rn; Rk[i][1] = k1 * rn; Rq[i][0] = k[0]; Rq[i][1] = k[1]; Rr[i][0] = r[0]; Rr[i][1] = r[1]; } }
                __syncthreads();
                lane = opq(lane0); c = lane; kl = lane & 15; g = lane >> 4; q_ = kl >> 2; p_ = kl & 3;
                REPK(2) { const int wq = opqs(wv); const int st = wq & 3; const LAS unsigned char* zrow = lds + ZL + (16 * st + kl) * 128;
                  const bf16x8 zw = *(const LAS bf16x8*)(zrow + 16 * g), za = *(const LAS bf16x8*)(zrow + 64 + 16 * g);
#pragma unroll
                  for (int i = 0; i < 2; ++i) { const int cc = 16 * ((wq >> 2) * 2 + i) + kl;
                      const f32x4 uw = __builtin_amdgcn_mfma_f32_16x16x32_bf16(zw, w2f[i], Z4, 0, 0, 0), ua = __builtin_amdgcn_mfma_f32_16x16x32_bf16(za, a2f[i], Z4, 0, 0, 0);
#pragma unroll
                      for (int j = 0; j < 4; ++j) { const int srow = 16 * st + 4 * g + j;
                          ((LAS float*)(lds + LWO))[srow * 64 + cc] = -0.6065306597126334f * __builtin_amdgcn_rcpf(1.0f + __expf(-(uw[j] + w0c[i]))); ((LAS float*)(lds + AAO))[srow * 64 + cc] = __builtin_amdgcn_rcpf(1.0f + __expf(-(ua[j] + a0c[i]))); } } }
                __syncthreads();
                lane = opq(lane0); c = lane; kl = lane & 15; g = lane >> 4; q_ = kl >> 2; p_ = kl & 3;
                sl = opqs(wv);
                REPK(4) { const int cp = lane & 31, sh = lane >> 5, q = sl >> 1, hf = sl & 1; typedef float f32x2_ __attribute__((ext_vector_type(2)));
                  const LAS f32x2_* lwp = (const LAS f32x2_*)((const LAS float*)(lds + LWO) + (16 * q) * 64 + 2 * cp); const LAS f32x2_* aap = (const LAS f32x2_*)((const LAS float*)(lds + AAO) + (8 * sl + 4 * sh) * 64 + 2 * cp);
                  f32x2_ qs[4];
#pragma unroll
                  for (int j = 0; j < 4; ++j) { qs[j] = lwp[(4 * j) * 32] + lwp[(4 * j + 1) * 32] + lwp[(4 * j + 2) * 32] + lwp[(4 * j + 3) * 32]; }
                  const f32x2_ cL = (qs[0] + qs[1]) + (qs[2] + qs[3]); const int part = 2 * hf + sh;
                  f32x2_ run = part == 0 ? (f32x2_){0.f, 0.f} : (part == 1 ? qs[0] : (part == 2 ? qs[0] + qs[1] : qs[0] + qs[1] + qs[2]));
                  const float wl0 = __expf(cL.x), wl1 = __expf(cL.y);
                  if (part == 3) ((LAS f32x2_*)(lds + WLO))[q * 32 + cp] = (f32x2_){wl0, wl1};
#pragma unroll
                  for (int i = 0; i < 4; ++i) { const int sloc = 8 * sl + 4 * sh + i, s = 4 * part + i; const f32x2_ lwi = lwp[s * 32]; const f32x2_ cprev = run; run = run + lwi; const f32x2_ aa = aap[i * 32];
                      const float kd0 = Rq[i][0] * (1.0f + (aa.x - 1.0f) * kac[0]), kd1 = Rq[i][1] * (1.0f + (aa.y - 1.0f) * kac[1]), nb0 = -Rk[i][0] * aa.x, nb1 = -Rk[i][1] * aa.y;
                      float bon = Rr[i][0] * kd0 * rkc[0] + Rr[i][1] * kd1 * rkc[1];
                      bon += dppmov<0xB1>(bon); bon += dppmov<0x4E>(bon); bon += dppmov<0x141>(bon); bon += dppmov<0x140>(bon);
                      { const int iv = __builtin_bit_cast(int, bon); const float a0 = __builtin_bit_cast(float, __builtin_amdgcn_readlane(iv, 0)) + __builtin_bit_cast(float, __builtin_amdgcn_readlane(iv, 16)), a1 = __builtin_bit_cast(float, __builtin_amdgcn_readlane(iv, 32)) + __builtin_bit_cast(float, __builtin_amdgcn_readlane(iv, 48)); bon = sh ? a1 : a0; }
                      if (cp == 0) { const int t = d ? (T - 1 - (s0 + sloc)) : (s0 + sloc); BON[((size_t)d * NTOK + rowbase + t) * 8 + h] = bon; }
                      const float e1x = __expf(cprev.x), e1y = __expf(cprev.y), e2x = __expf(-run.x), e2y = __expf(-run.y), e3x = __builtin_amdgcn_rcpf(e2x), e3y = __builtin_amdgcn_rcpf(e2y);
                      LAS unsigned char* base = lds + ARR + q * (7 * 2048) + sw16(s, cp >> 2) + (cp & 3) * 4;
                      *(LAS unsigned*)(base) = pk2(Rk[i][0] * e1x, Rk[i][1] * e1y); *(LAS unsigned*)(base + 2048) = pk2(nb0 * e2x, nb1 * e2y); *(LAS unsigned*)(base + 4096) = pk2(kd0 * e2x, kd1 * e2y); *(LAS unsigned*)(base + 6144) = pk2(Rr[i][0] * e3x, Rr[i][1] * e3y);
                      *(LAS unsigned*)(base + 12288) = pk2(Rv[i][0], Rv[i][1]); } }
                __syncthreads();
                lane = opq(lane0); c = lane; kl = lane & 15; g = lane >> 4; q_ = kl >> 2; p_ = kl & 3;
                if (grp + 1 < ngrp) CSC_PREFETCH(grp + 1);
                if (wv < 4) BGC_WINDOW();
                REPK(5) if (wv >= 4) { const int q = opqs(wv) - 4; const LAS unsigned char* A0 = lds + ARR + q * (7 * 2048);
                    bf16x8 at[2], bt[2], kt[2], rt[2];
#pragma unroll
                    for (int ks = 0; ks < 2; ++ks) { const int o = sw16(kl, ks * 4 + g); at[ks] = *(const LAS bf16x8*)(A0 + o); bt[ks] = *(const LAS bf16x8*)(A0 + 2048 + o); kt[ks] = *(const LAS bf16x8*)(A0 + 4096 + o); rt[ks] = *(const LAS bf16x8*)(A0 + 6144 + o); }
                    f32x4 ABt = Z4, AKt = Z4, RBt = Z4, RKt = Z4;
#pragma unroll
                    for (int ks = 0; ks < 2; ++ks) { ABt = __builtin_amdgcn_mfma_f32_16x16x32_bf16(bt[ks], at[ks], ABt, 0, 0, 0); AKt = __builtin_amdgcn_mfma_f32_16x16x32_bf16(kt[ks], at[ks], AKt, 0, 0, 0);
                        RBt = __builtin_amdgcn_mfma_f32_16x16x32_bf16(bt[ks], rt[ks], RBt, 0, 0, 0); RKt = __builtin_amdgcn_mfma_f32_16x16x32_bf16(kt[ks], rt[ks], RKt, 0, 0, 0); }
#pragma unroll
                    for (int j = 0; j < 4; ++j) { const int jj = 4 * g + j; ABt[j] = jj < kl ? ABt[j] : 0.f; AKt[j] = jj < kl ? AKt[j] : 0.f; RBt[j] = jj <= kl ? RBt[j] : 0.f; RKt[j] = jj <= kl ? RKt[j] : 0.f; }
                    float Tr[16]; const float ab0 = ABt[0], ab1 = ABt[1], ab2 = ABt[2], ab3 = ABt[3];
                    const int abi[4] = {__builtin_bit_cast(int, ab0), __builtin_bit_cast(int, ab1), __builtin_bit_cast(int, ab2), __builtin_bit_cast(int, ab3)};
#pragma unroll
                    for (int i = 0; i < 16; ++i) Tr[i] = (i == kl) ? 1.f : 0.f;
#pragma unroll
                    for (int j = 14; j >= 0; --j) { float acc = 0.f;
#pragma unroll
                        for (int i = j + 1; i < 16; ++i) acc += Tr[i] * __builtin_bit_cast(float, __builtin_amdgcn_readlane(abi[j & 3], i + 16 * (j >> 2)));
                        Tr[j] = (j < kl) ? acc : Tr[j]; }
                    float tsel[4];
#pragma unroll
                    for (int e = 0; e < 4; ++e) tsel[e] = g == 0 ? Tr[e] : (g == 1 ? Tr[4 + e] : (g == 2 ? Tr[8 + e] : Tr[12 + e]));
                    v2u tf2; tf2.x = pk2(tsel[0], tsel[1]); tf2.y = pk2(tsel[2], tsel[3]);
                    const bf16x8 Tf = mk8(tf2, Z2), RBf = mk8(cvt4(RBt), Z2);
                    f32x4 AhT[4], QhT[4];
#pragma unroll
                    for (int ct = 0; ct < 4; ++ct) {
                        const bf16x8 Alo = mk8(trd(A0 + sw16(4 * g + q_, 2 * ct + (p_ >> 1)) + (p_ & 1) * 8), Z2);
                        AhT[ct] = __builtin_amdgcn_mfma_f32_16x16x32_bf16(Alo, Tf, Z4, 0, 0, 0);
                        const f32x4 Ah = __builtin_amdgcn_mfma_f32_16x16x32_bf16(Tf, Alo, Z4, 0, 0, 0);
                        const v2u rw = *(const LAS v2u*)(A0 + 6144 + sw16(kl, 2 * ct + (g >> 1)) + (g & 1) * 8);
                        const f32x4 rinit = {bflo(rw.x), bfhi(rw.x), bflo(rw.y), bfhi(rw.y)};
                        QhT[ct] = __builtin_amdgcn_mfma_f32_16x16x32_bf16(mk8(cvt4(Ah), Z2), RBf, rinit, 0, 0, 0); }
                    LAS unsigned char* fr = lds + FR + q * 7168 + lane * 16;
                    *(LAS bf16x8*)(fr) = mk8(cvt4(AhT[0]), cvt4(AhT[1])); *(LAS bf16x8*)(fr + 1024) = mk8(cvt4(AhT[2]), cvt4(AhT[3]));
                    *(LAS bf16x8*)(fr + 2048) = mk8(cvt4(QhT[0]), cvt4(QhT[1])); *(LAS bf16x8*)(fr + 3072) = mk8(cvt4(QhT[2]), cvt4(QhT[3]));
                    *(LAS bf16x8*)(fr + 4096) = mk8(cvt4(AKt), Z2); *(LAS bf16x8*)(fr + 5120) = mk8(cvt4(RBt), cvt4(RKt)); *(LAS bf16x8*)(fr + 6144) = Tf;
                }
                __syncthreads();
                lane = opq(lane0); c = lane; kl = lane & 15; g = lane >> 4; q_ = kl >> 2; p_ = kl & 3;
                if (wv >= 4) BGC_WINDOW();
                if (wv < 4) { const int vt = opqs(wv);
                    f32x4 Uh[4], Yh[4]; v2u vtrs[4];
#pragma unroll
                    for (int q = 0; q < 4; ++q) { const LAS unsigned char* A0 = lds + ARR + q * (7 * 2048); const LAS unsigned char* fr = lds + FR + q * 7168 + lane * 16;
                        const bf16x8 AKf = *(const LAS bf16x8*)(fr + 4096), RBRK = *(const LAS bf16x8*)(fr + 5120), Tf = *(const LAS bf16x8*)(fr + 6144);
                        vtrs[q] = trd(A0 + 12288 + sw16(4 * g + q_, 2 * vt + (p_ >> 1)) + (p_ & 1) * 8);
                        const f32x4 X1 = __builtin_amdgcn_mfma_f32_16x16x32_bf16(AKf, mk8(vtrs[q], Z2), Z4, 0, 0, 0);
                        Uh[q] = __builtin_amdgcn_mfma_f32_16x16x32_bf16(Tf, mk8(cvt4(X1), Z2), Z4, 0, 0, 0);
                        Yh[q] = __builtin_amdgcn_mfma_f32_16x16x32_bf16(RBRK, mk8(cvt4(Uh[q]), vtrs[q]), Z4, 0, 0, 0); }
#pragma unroll
                    for (int q = 0; q < 4; ++q) { const LAS unsigned char* A0 = lds + ARR + q * (7 * 2048); const LAS unsigned char* fr = lds + FR + q * 7168 + lane * 16;
                        const bf16x8 Ap0 = *(const LAS bf16x8*)(fr), Ap1 = *(const LAS bf16x8*)(fr + 1024), Qp0 = *(const LAS bf16x8*)(fr + 2048), Qp1 = *(const LAS bf16x8*)(fr + 3072);
                        bf16x8 bk[4]; f32x4 wl[4];
#pragma unroll
                        for (int ct = 0; ct < 4; ++ct) { wl[ct] = *(const LAS f32x4*)(lds + WLO + (q * 64 + 16 * ct + 4 * g) * 4); const int o = sw16(4 * g + q_, 2 * ct + (p_ >> 1)) + (p_ & 1) * 8; bk[ct] = mk8(trd(A0 + 2048 + o), trd(A0 + 4096 + o)); }
                        const bf16x8 bs0 = mk8(cvt4(St[0]), cvt4(St[1])), bs1 = mk8(cvt4(St[2]), cvt4(St[3]));
                        f32x4 U = __builtin_amdgcn_mfma_f32_16x16x32_bf16(Ap0, bs0, Uh[q], 0, 0, 0); U = __builtin_amdgcn_mfma_f32_16x16x32_bf16(Ap1, bs1, U, 0, 0, 0);
                        f32x4 Y = __builtin_amdgcn_mfma_f32_16x16x32_bf16(Qp0, bs0, Yh[q], 0, 0, 0); Y = __builtin_amdgcn_mfma_f32_16x16x32_bf16(Qp1, bs1, Y, 0, 0, 0);
                        const bf16x8 UV = mk8(cvt4(U), vtrs[q]);
#pragma unroll
                        for (int ct = 0; ct < 4; ++ct) St[ct] = __builtin_amdgcn_mfma_f32_16x16x32_bf16(bk[ct], UV, St[ct], 0, 0, 0) * wl[ct];
#pragma unroll
                        for (int j = 0; j < 4; ++j) { const int sg = s0 + 16 * q + 4 * g + j; const int t = d ? (T - 1 - sg) : sg; YD[((size_t)d * NTOK + rowbase + t) * 512 + h * 64 + 16 * vt + kl] = Y[j]; }
                    }
                }
                __syncthreads();
            }
#undef CSC_PREFETCH
        }
        if (cpend >= 0) { bgc::finish(a, l, cpend, opq(lane0), wv & 3, lds, cvt_); cpend = -1; }
        for (; cit < bgc::NITEMS; cit += cstride) { bgc::issue(a, l, cit, opq(lane0), cvt_); bgc::finish(a, l, cit, opq(lane0), wv & 3, lds, cvt_); }
#undef BGC_WINDOW
    }
}
constexpr int PH_PER_LAYER = 11, N_PHASES = 1 + 2 * PH_PER_LAYER;
template <int K> __device__ __forceinline__ void run_phase(LAS unsigned char* lds, int l) {
    if constexpr (K == 0) phase_prologue(lds);
    if constexpr (K == 1) phase_modconv(lds, l);
    if constexpr (K == 3) phase_scan(lds, l);
    if constexpr (K == 4) phase_attn(lds, l);
    if constexpr (K == 5) phase_rwpost(lds, l);
    if constexpr (K == 7) phase_ln1_route(lds, l);
    if constexpr (K == 8) phase_gather(lds, l);
    if constexpr (K == 11) phase_ln2(lds, l);
    if constexpr (K == 2 || K == 6 || K == 9 || K == 10) {
        const KA a = ka_get(); unsigned char* ws = a.ws(); const int G = gridDim.x, bid = blockIdx.x;
        bf16* X1 = (bf16*)(ws + WS_X1); bf16* X2 = (bf16*)(ws + WS_X2); bf16* X3 = (bf16*)(ws + WS_X3);
        if constexpr (K == 2) { __syncthreads();
            pg8::Gemm g{X1, (const bf16*)(ws + WS_WINT) + (size_t)l * DINP * DM, NTOK, DINP, DM}; pg8::StaticOrder S; S.init(NTOK, DINP, G, bid);
            pg8::EpiBf16 E{X2, DINP}; pg8::gemm_phase<pg8::EpiBf16, pg8::StaticOrder, true, true>(lds, g, S, E); }
        if constexpr (K == 6) { __syncthreads();
            const int Mrows = (l == 0) ? NTOK : NTX;
            pg8::Gemm g{X1, (const bf16*)(ws + WS_WOT) + (size_t)l * DM * DM, Mrows, DM, DM}; pg8::StaticOrder S; S.init(Mrows, DM, G, bid);
            pg8::EpiBf16 E{X3, DM}; pg8::gemm_phase<pg8::EpiBf16, pg8::StaticOrder, true, true>(lds, g, S, E); }
        if constexpr (K == 9) { moe_tables<false>(lds, l);
            pg8::Gemm g{X2, (const bf16*)(ws + WS_W13T), MAXSLOT, 1024, DM}; pg8::MoeOrder S; S.init((const LAS int*)(lds + PREF_OFF), 4, G, bid);
            pg8::EpiSwiGLU E{X3, DEXP}; pg8::gemm_phase<pg8::EpiSwiGLU, pg8::MoeOrder, true, true>(lds, g, S, E); }
        if constexpr (K == 10) { moe_tables<false>(lds, l);
            pg8::Gemm g{X3, (const bf16*)(ws + WS_W2T), MAXSLOT, 1024, DEXP}; pg8::MoeOrder S; S.init((const LAS int*)(lds + PREF_OFF), 4, G, bid);
            pg8::EpiBf16 E{X2, DM}; pg8::gemm_phase<pg8::EpiBf16, pg8::MoeOrder, true, true>(lds, g, S, E); }
    }
}
__device__ __forceinline__ void grid_sync(LAS unsigned char* lds) {
    const KA a = ka_get(); XcdBarrier b; b.bar = (unsigned*)(a.ws() + WS_CTL) + CW_BAR; b.x = xb_xcc_id(); b.st = (volatile LAS unsigned*)(lds + MISC_OFF) + 8; xcd_barrier(b);
#ifdef PROBE_BAR
    xcd_barrier(b);
#endif
}
#ifndef ONE_LAUNCH
template <int K> __global__ void __launch_bounds__(512, 2) fwd_ph(Args args) {
    extern __shared__ __attribute__((aligned(16))) unsigned char lds_raw[];
    LAS unsigned char* lds = (LAS unsigned char*)lds_raw;
    for (int u = threadIdx.x; u < (LDS_BYTES - LDSCTL_OFF) / 4; u += 512) ((LAS unsigned*)(lds + LDSCTL_OFF))[u] = 0u;
    __syncthreads();
    hw_tid_init();
    __syncthreads();
    run_phase<K>(lds, args.ph_lo);
}
template <int K> static void launch_ph(const Args& a, int grid, hipStream_t stream) {
    static bool attr = false;
    if (!attr) { (void)hipFuncSetAttribute((const void*)fwd_ph<K>, hipFuncAttributeMaxDynamicSharedMemorySize, LDS_BYTES); attr = true; }
    hipLaunchKernelGGL(fwd_ph<K>, dim3(grid), dim3(512), LDS_BYTES, stream, a);
}
#else
__global__ void __launch_bounds__(512, 2) fwd(Args args) {
    extern __shared__ __attribute__((aligned(16))) unsigned char lds_raw[];
    LAS unsigned char* lds = (LAS unsigned char*)lds_raw;
    for (int u = threadIdx.x; u < (LDS_BYTES - LDSCTL_OFF) / 4; u += 512) ((LAS unsigned*)(lds + LDSCTL_OFF))[u] = 0u;
    __syncthreads();
    hw_tid_init();
    __syncthreads();
    (void)xcd_barrier_post((unsigned*)(args.ws + WS_CTL) + CW_BAR, (volatile LAS unsigned*)(lds + MISC_OFF) + 8);
    run_phase<0>(lds, 0);
#ifdef PROBE_P0
    __syncthreads(); run_phase<0>(lds, 0);
#endif
    grid_sync(lds);
#ifndef PROBE_REP
#define PROBE_REP -1
#endif
#define RUNP(K) do { run_phase<K>(lds, l); if (PROBE_REP == K) { __syncthreads(); run_phase<K>(lds, l); } } while (0)
    for (int l = 0; l < 2; ++l) {
        if (l == 0) { RUNP(1); grid_sync(lds); }
        RUNP(2); grid_sync(lds);
        RUNP(3);
        RUNP(4); grid_sync(lds);
        RUNP(5); grid_sync(lds);
        RUNP(6); grid_sync(lds);
        run_phase<7>(lds, l); if (PROBE_REP == 7 && l == 0) { __syncthreads(); run_phase<7>(lds, l); } grid_sync(lds);
        RUNP(8); grid_sync(lds);
        RUNP(9); grid_sync(lds);
        RUNP(10); grid_sync(lds);
        run_phase<11>(lds, l); if (l == 0) grid_sync(lds);
    }
}
#endif

extern "C" void kernel_launch(void* const* d_in, const int* in_sizes, int n_in, void* d_out, int out_size, void* d_ws, size_t ws_size, hipStream_t stream) {
    static int grid = 0;
    if (grid == 0) {
        if (n_in != 30 || in_sizes[0] != NTX * DM || out_size != NTX * DM || ws_size < WS_END) {
            fprintf(stderr, "kernel_launch: unexpected problem (n_in %d, in0 %d, out %d, ws %zu < %zu?); nothing launched\n", n_in, n_in > 0 ? in_sizes[0] : -1, out_size, ws_size, (size_t)WS_END); grid = -1; return; }
        int dev = 0, cus = 0;
        if (hipGetDevice(&dev) != hipSuccess || hipDeviceGetAttribute(&cus, hipDeviceAttributeMultiprocessorCount, dev) != hipSuccess) { grid = -1; return; }
#ifdef ONE_LAUNCH
        if (hipFuncSetAttribute((const void*)fwd, hipFuncAttributeMaxDynamicSharedMemorySize, LDS_BYTES) != hipSuccess) { fprintf(stderr, "kernel_launch: hipFuncSetAttribute failed\n"); grid = -1; return; }
#endif
        (void)hipGetLastError();
        grid = cus > 0 ? cus : 256;
    }
    if (grid < 0) return;
    if (hipMemsetAsync((char*)d_ws + WS_CTL, 0, CTL_ZERO_BYTES, stream) != hipSuccess) return;
    Args a{};
    for (int i = 0; i < 30; ++i) a.in[i] = (const float*)d_in[i];
    a.out = (float*)d_out; a.ws = (unsigned char*)d_ws; a.ph_lo = 0; a.ph_hi = 0;
#ifndef ONE_LAUNCH
    launch_ph<0>(a, grid, stream);
    for (int l = 0; l < 2; ++l) { a.ph_lo = l;
        launch_ph<1>(a, grid, stream); launch_ph<2>(a, grid, stream); launch_ph<3>(a, grid, stream); launch_ph<4>(a, grid, stream); launch_ph<5>(a, grid, stream); launch_ph<6>(a, grid, stream);
        launch_ph<7>(a, grid, stream); launch_ph<8>(a, grid, stream); launch_ph<9>(a, grid, stream); launch_ph<10>(a, grid, stream); launch_ph<11>(a, grid, stream); }
#else
    hipLaunchKernelGGL(fwd, dim3(grid), dim3(512), LDS_BYTES, stream, a);
#endif
}
```

```cpp
#define ONE_LAUNCH 1
#include <hip/hip_runtime.h>
#include <cstdio>
#include <cstdint>

constexpr int DM = 1024, NB = 16, SEQ = 2048, CTXL = 256, NTX = NB * SEQ, NTC = NB * CTXL, NTOK = NTX + NTC;
constexpr int DIN = 3296, DINP = 3328, RWOFF = 1536, NHEAD = 8, HD = 64;
constexpr int NEXP = 32, DEXP = 512, LISTCAP = 2 * NTOK;
constexpr int MAXSLOT = 81920;
constexpr float ALPHA = 1.41421356237309515f, LN_EPS = 1e-6f, GN_EPS = 64e-5f;

constexpr size_t MiB = 1u << 20;
constexpr size_t WS_CTL = 0, CTL_ZERO_BYTES = 1 * MiB;
constexpr size_t WS_MODS = 1 * MiB;
constexpr size_t WS_ROPE = 2 * MiB;
constexpr size_t WS_WINT = 3 * MiB;
constexpr size_t WS_WOT = 16 * MiB;
constexpr size_t WS_W13T = 20 * MiB;
constexpr size_t WS_W2T = 84 * MiB;
constexpr size_t WS_LIST = 116 * MiB;
constexpr size_t WS_TOK = 125 * MiB;
constexpr size_t WS_BONUS = 127 * MiB;
constexpr size_t WS_CS = 130 * MiB;
constexpr size_t WS_X1 = 146 * MiB;
constexpr size_t WS_X2 = 218 * MiB;
constexpr size_t WS_X3 = 452 * MiB;
constexpr size_t WS_END = 596 * MiB;
static_assert(WS_WINT + (size_t)2 * DINP * DM * 2 <= WS_WOT && WS_LIST + (size_t)NEXP * LISTCAP * 4 <= WS_TOK && WS_TOK + (size_t)NTOK * 32 <= WS_BONUS, "ws map");
static_assert(WS_BONUS + (size_t)2 * NTOK * 8 * 4 <= WS_CS && WS_X2 + (size_t)NTOK * DINP * 2 <= WS_X3 && WS_X3 + (size_t)2 * NTOK * 512 * 4 <= WS_END, "ws map");
static_assert((size_t)MAXSLOT * 1024 * 2 <= WS_X3 - WS_X2 && (size_t)MAXSLOT * 512 * 2 <= WS_END - WS_X3, "ws map");
constexpr int CW_BAR = 4096;
constexpr int CW_CNT = 8192;
constexpr int RING_BYTES = 131072, LDSCTL_OFF = RING_BYTES, MISC_OFF = LDSCTL_OFF + 320, LDS_BYTES = 147456;
constexpr int PREF_OFF = LDSCTL_OFF + 512;

#define GAS __attribute__((address_space(1)))
#define LAS __attribute__((address_space(3)))
typedef unsigned short bf16;
typedef unsigned v4u __attribute__((ext_vector_type(4)));
typedef unsigned v2u __attribute__((ext_vector_type(2)));
typedef float f32x4 __attribute__((ext_vector_type(4)));
typedef short bf16x8 __attribute__((ext_vector_type(8)));
typedef GAS unsigned gu32;
#define RLX_AGENT __ATOMIC_RELAXED, __HIP_MEMORY_SCOPE_AGENT
#define LDS_WAIT() asm volatile("s_waitcnt lgkmcnt(0)" ::: "memory")
#define VM_WAIT() asm volatile("s_waitcnt vmcnt(0)" ::: "memory")
__device__ __forceinline__ unsigned f2bf(float f) { unsigned u = __builtin_bit_cast(unsigned, f); return (u + 0x7fffu + ((u >> 16) & 1u)) >> 16; }
typedef float f32x2_t_ __attribute__((ext_vector_type(2))); typedef __bf16 bf16x2_t_ __attribute__((ext_vector_type(2)));
__device__ __forceinline__ unsigned pk2(float lo, float hi) { f32x2_t_ v = {lo, hi}; bf16x2_t_ b = __builtin_convertvector(v, bf16x2_t_); return __builtin_bit_cast(unsigned, b); }
__device__ __forceinline__ unsigned short f2bf1(float f) { return (unsigned short)(pk2(f, 0.f) & 0xffffu); }
__device__ __forceinline__ float bf2f(unsigned short v) { return __builtin_bit_cast(float, (unsigned)v << 16); }
__device__ __forceinline__ float bflo(unsigned w) { return __builtin_bit_cast(float, w << 16); }
__device__ __forceinline__ float bfhi(unsigned w) { return __builtin_bit_cast(float, w & 0xffff0000u); }
__device__ __forceinline__ float sigmoidf_(float x) { return 1.0f / (1.0f + expf(-x)); }
__device__ __forceinline__ float shx(float v, int k, int lane) { return __builtin_bit_cast(float, __builtin_amdgcn_ds_bpermute((lane ^ k) << 2, __builtin_bit_cast(int, v))); }
__device__ __forceinline__ float shi(float v, int src) { return __builtin_bit_cast(float, __builtin_amdgcn_ds_bpermute(src << 2, __builtin_bit_cast(int, v))); }
template <int CTRL> __device__ __forceinline__ float dppmov(float v) { return __builtin_bit_cast(float, __builtin_amdgcn_update_dpp(0, __builtin_bit_cast(int, v), CTRL, 0xF, 0xF, true)); }
__device__ __forceinline__ float wave_sum(float v) {
    v += dppmov<0xB1>(v); v += dppmov<0x4E>(v); v += dppmov<0x141>(v); v += dppmov<0x140>(v);
    const int iv = __builtin_bit_cast(int, v);
    return (__builtin_bit_cast(float, __builtin_amdgcn_readlane(iv, 0)) + __builtin_bit_cast(float, __builtin_amdgcn_readlane(iv, 16))) + (__builtin_bit_cast(float, __builtin_amdgcn_readlane(iv, 32)) + __builtin_bit_cast(float, __builtin_amdgcn_readlane(iv, 48)));
}
__device__ __forceinline__ float red8(float v) { v += dppmov<0xB1>(v); v += dppmov<0x4E>(v); v += dppmov<0x141>(v); return v; }

struct TokInfo { int e0, e1, p0, p1; float g0, g1; int pad0, pad1; };

constexpr int WID_OFF = LDSCTL_OFF + 1536;
__device__ __forceinline__ int hw_slot() { return (int)__builtin_amdgcn_s_getreg((5 << 11) | 4) & 63; }
__device__ __forceinline__ int lane_id() { int l; asm volatile("v_mbcnt_lo_u32_b32 %0, -1, 0\n\tv_mbcnt_hi_u32_b32 %0, -1, %0" : "=v"(l)); return l; }
__device__ __forceinline__ void hw_tid_init() { *(volatile LAS int*)(uintptr_t)(WID_OFF + 4 * hw_slot()) = (int)(threadIdx.x >> 6); }
__device__ __forceinline__ int hw_tid() { const int w = *(volatile LAS int*)(uintptr_t)(WID_OFF + 4 * hw_slot()); int t = (__builtin_amdgcn_readfirstlane(w) << 6) | lane_id(); asm volatile("" : "+v"(t)); return t; }
namespace pg8 {
#define PG8_LAS __attribute__((address_space(3)))
typedef unsigned short bf16_t;
typedef short bf16x8 __attribute__((ext_vector_type(8)));
typedef float f32x4 __attribute__((ext_vector_type(4)));
typedef unsigned u32x4 __attribute__((ext_vector_type(4)));
constexpr int BM = 256, BK = 64, HALF = 128, HTB = HALF * BK * 2  , STAGE_BYTES = 8 * HTB, NXCD = 8, WGM = 8;

__host__ __device__ __forceinline__ int lds_byte(int r, int c) { const int st = (r >> 4) * 2 + (c >> 5), rr = r & 15, cc = c & 31, ob = rr * 64 + cc * 2; return st * 1024 + (ob ^ (((ob >> 9) & 1) << 5)); }
__host__ __device__ __forceinline__ void stage_rc(int b, int& R, int& C) { const int st = b / 1024, sb = b % 1024, swz = sb ^ (((sb >> 9) & 1) << 5); R = (st >> 1) * 16 + swz / 64; C = (st & 1) * 32 + (swz % 64) / 2; }
__host__ __device__ __forceinline__ int perm32(int rho) { const int n = rho >> 4, i = rho & 15; return 8 * (i >> 2) + 4 * n + (i & 3); }

struct Unit { int pm, pn, pnb; };
struct Gemm { const bf16_t* A; const bf16_t* Bt; int M, N, K; };

struct StaticOrder {
    int nM, nN, nwg, G, c;
    __host__ __device__ void init(int M, int N, int G_, int c_) { nM = M / BM; nN = N / BM; nwg = nM * nN; G = G_; c = c_; }
    __host__ __device__ bool next(int i, Unit& u) const {
        const long L = (long)i * G + c; if (L >= nwg) return false;
        int wgid = (int)L; { const int q = nwg / NXCD, r = nwg % NXCD, xcd = wgid % NXCD, off = wgid / NXCD; wgid = (xcd < r ? xcd * (q + 1) : r * (q + 1) + (xcd - r) * q) + off; }
        const int nig = WGM * nN, gid = wgid / nig, fm = gid * WGM, gsz = (nM - fm) < WGM ? (nM - fm) : WGM;
        u.pm = fm + ((wgid % nig) % gsz); u.pn = (wgid % nig) / gsz; u.pnb = u.pn; return true;
    }
    __device__ __forceinline__ void a_ready(const Unit&) const {}
    __device__ __forceinline__ void done(const Unit&) const {}
};

__device__ __forceinline__ unsigned cvt_pk_bf16(float lo, float hi) { unsigned r; asm volatile("v_cvt_pk_bf16_f32 %0, %1, %2" : "=v"(r) : "v"(lo), "v"(hi)); return r; }
template <class Epi, class Sched, bool ALIGN_EPI = false, bool SP2 = false>
__device__ __forceinline__ void gemm_phase(PG8_LAS unsigned char* lds, const Gemm g, const Sched& S, const Epi& E) {
    const int tid = hw_tid(), wid = __builtin_amdgcn_readfirstlane(tid >> 6), lane = tid & 63, wr = wid >> 2, wc = wid & 3, fr = lane & 15, fq = lane >> 4;
    const int K = g.K, nt = K / BK;
    unsigned voffA[2], voffB[2];
#pragma unroll
    for (int i = 0; i < 2; ++i) { int R, C; stage_rc(tid * 16 + i * 8192, R, C); const int Rb = Epi::PERM ? ((R & ~31) + perm32(R & 31)) : R;
        voffA[i] = (unsigned)(R * K + C) * 2u; voffB[i] = (unsigned)(Rb * K + C) * 2u; }
    const size_t kstep = (size_t)(BK * 2);
    const size_t hstep = (size_t)HALF * K * 2;
    const size_t tstep = 2 * hstep;
    const unsigned ldsw = (unsigned)wid * 1024u;
    const int aoff = lds_byte(wr * 64 + fr, fq * 8), boff = lds_byte(wc * 32 + fr, fq * 8);
#define PG8_SA(b, h) (((b) * 2 + (h)) * HTB)
#define PG8_SB(b, h) ((4 + (b) * 2 + (h)) * HTB)
#define PG8_STAGE(bufoff, gbase, voff) do { _Pragma("unroll") for (int _i = 0; _i < 2; ++_i) \
        __builtin_amdgcn_global_load_lds((const unsigned*)((const char*)(gbase) + (voff)[_i]), (PG8_LAS unsigned*)(lds + (bufoff) + ldsw + _i * 8192), 16, 0, 0); } while (0)
#define PG8_LDA(dst, b, h) do { _Pragma("unroll") for (int m = 0; m < 4; ++m) _Pragma("unroll") for (int k = 0; k < 2; ++k) dst[m][k] = *(const PG8_LAS bf16x8*)(lds + PG8_SA(b, h) + aoff + m * 2048 + k * 1024); } while (0)
#define PG8_LDB(dst, b, h) do { _Pragma("unroll") for (int n = 0; n < 2; ++n) _Pragma("unroll") for (int k = 0; k < 2; ++k) dst[n][k] = *(const PG8_LAS bf16x8*)(lds + PG8_SB(b, h) + boff + n * 2048 + k * 1024); } while (0)
#define PG8_MMA(ai, bj, At, Bt) do { __builtin_amdgcn_s_setprio(1); _Pragma("unroll") for (int m = 0; m < 4; ++m) _Pragma("unroll") for (int n = 0; n < 2; ++n) _Pragma("unroll") for (int k = 0; k < 2; ++k) \
        acc[ai][bj][m][n] = __builtin_amdgcn_mfma_f32_16x16x32_bf16(Bt[n][k], At[m][k], acc[ai][bj][m][n], 0, 0, 0); __builtin_amdgcn_s_setprio(0); } while (0)
#define PG8_WAIT_V(n) asm volatile("s_waitcnt vmcnt(" #n ")" ::: "memory")
#define PG8_WAIT_L(n) asm volatile("s_waitcnt lgkmcnt(" #n ")" ::: "memory")
#define PG8_BAR __builtin_amdgcn_s_barrier()
#define PG8_SCHED __builtin_amdgcn_sched_barrier(0)
    Unit cur, nxt; int ui = 0;
    if (!S.next(0, cur)) return;
    f32x4 acc[2][2][4][2];
#pragma unroll
    for (int a = 0; a < 2; ++a)
#pragma unroll
        for (int b = 0; b < 2; ++b)
#pragma unroll
            for (int m = 0; m < 4; ++m)
#pragma unroll
                for (int n = 0; n < 2; ++n) acc[a][b][m][n] = (f32x4){0.f, 0.f, 0.f, 0.f};
    bf16x8 At[4][2], B0[2][2], B1[2][2];
    const char* cA = (const char*)g.A + (size_t)cur.pm * tstep; const char* cB = (const char*)g.Bt + (size_t)cur.pnb * tstep;
    S.a_ready(cur);
    if constexpr (SP2) {
        PG8_STAGE(PG8_SB(0, 0), cB, voffB); PG8_STAGE(PG8_SB(0, 1), cB + hstep, voffB); PG8_STAGE(PG8_SA(0, 0), cA, voffA); PG8_STAGE(PG8_SA(0, 1), cA + hstep, voffA);
        if (wr == 1) PG8_BAR;
        PG8_WAIT_V(2); PG8_BAR;
        PG8_STAGE(PG8_SB(1, 0), cB + kstep, voffB); PG8_STAGE(PG8_SA(1, 0), cA + kstep, voffA); PG8_STAGE(PG8_SB(1, 1), cB + hstep + kstep, voffB);
        PG8_WAIT_V(6); PG8_BAR;
    } else {
        PG8_STAGE(PG8_SB(0, 0), cB, voffB); PG8_STAGE(PG8_SA(0, 0), cA, voffA); PG8_STAGE(PG8_SB(0, 1), cB + hstep, voffB); PG8_STAGE(PG8_SA(0, 1), cA + hstep, voffA);
        if (wr == 1) PG8_BAR;
        PG8_WAIT_V(4); PG8_BAR;
        PG8_STAGE(PG8_SB(1, 0), cB + kstep, voffB); PG8_STAGE(PG8_SA(1, 0), cA + kstep, voffA); PG8_STAGE(PG8_SB(1, 1), cB + hstep + kstep, voffB);
        PG8_WAIT_V(6); PG8_BAR;
    }
    for (;;) {
        const bool has_next = S.next(ui + 1, nxt);
        const char* nA = has_next ? (const char*)g.A + (size_t)nxt.pm * tstep : cA; const char* nB = has_next ? (const char*)g.Bt + (size_t)nxt.pnb * tstep : cB;
        for (int t = 0; t < nt; t += 2) {
            const bool last = (t == nt - 2);
            const char* a1 = cA + (size_t)(t + 1) * kstep;
            const char* a2 = last ? nA : cA + (size_t)(t + 2) * kstep; const char* b2 = last ? nB : cB + (size_t)(t + 2) * kstep;
            const char* a3 = a2 + kstep; const char* b3 = b2 + kstep;
            if (last && has_next) S.a_ready(nxt);
            if constexpr (SP2) {
            PG8_LDB(B0, 0, 0); PG8_LDB(B1, 0, 1); PG8_SCHED; PG8_LDA(At, 0, 0); PG8_STAGE(PG8_SA(1, 1), a1 + hstep, voffA);
            PG8_WAIT_V(8); PG8_WAIT_L(0); PG8_BAR; PG8_MMA(0, 0, At, B0); PG8_MMA(0, 1, At, B1); PG8_BAR; PG8_SCHED;
            PG8_LDA(At, 0, 1); PG8_STAGE(PG8_SB(0, 0), b2, voffB); PG8_STAGE(PG8_SB(0, 1), b2 + hstep, voffB); PG8_STAGE(PG8_SA(0, 0), a2, voffA);
            PG8_WAIT_V(8); PG8_WAIT_L(0); PG8_BAR; PG8_MMA(1, 0, At, B0); PG8_MMA(1, 1, At, B1); PG8_BAR; PG8_SCHED;
            PG8_LDB(B0, 1, 0); PG8_LDB(B1, 1, 1); PG8_SCHED; PG8_LDA(At, 1, 0); PG8_STAGE(PG8_SA(0, 1), a2 + hstep, voffA);
            PG8_WAIT_V(8); PG8_WAIT_L(0); PG8_BAR; PG8_MMA(0, 0, At, B0); PG8_MMA(0, 1, At, B1); PG8_BAR; PG8_SCHED;
            PG8_LDA(At, 1, 1); PG8_STAGE(PG8_SB(1, 0), b3, voffB); PG8_STAGE(PG8_SB(1, 1), b3 + hstep, voffB); PG8_STAGE(PG8_SA(1, 0), a3, voffA);
            PG8_WAIT_V(8); PG8_WAIT_L(0); PG8_BAR; PG8_MMA(1, 0, At, B0); PG8_MMA(1, 1, At, B1); PG8_BAR; PG8_SCHED;
            } else {
            PG8_LDB(B0, 0, 0); PG8_SCHED; PG8_LDA(At, 0, 0); PG8_STAGE(PG8_SA(1, 1), a1 + hstep, voffA);
            PG8_WAIT_L(8); PG8_BAR; PG8_WAIT_L(0); PG8_MMA(0, 0, At, B0); PG8_BAR; PG8_SCHED;
            PG8_LDB(B1, 0, 1); PG8_STAGE(PG8_SB(0, 0), b2, voffB);
            PG8_BAR; PG8_WAIT_L(0); PG8_MMA(0, 1, At, B1); PG8_BAR;
            PG8_LDA(At, 0, 1); PG8_STAGE(PG8_SA(0, 0), a2, voffA);
            PG8_BAR; PG8_WAIT_L(0); PG8_MMA(1, 0, At, B0); PG8_BAR; PG8_SCHED;
            PG8_STAGE(PG8_SB(0, 1), b2 + hstep, voffB);
            PG8_WAIT_V(6); PG8_BAR; PG8_MMA(1, 1, At, B1); PG8_BAR;
            PG8_LDB(B0, 1, 0); PG8_SCHED; PG8_LDA(At, 1, 0); PG8_STAGE(PG8_SA(0, 1), a2 + hstep, voffA);
            PG8_WAIT_L(8); PG8_BAR; PG8_WAIT_L(0); PG8_MMA(0, 0, At, B0); PG8_BAR; PG8_SCHED;
            PG8_LDB(B1, 1, 1); PG8_STAGE(PG8_SB(1, 0), b3, voffB);
            PG8_BAR; PG8_WAIT_L(0); PG8_MMA(0, 1, At, B1); PG8_BAR;
            PG8_LDA(At, 1, 1); PG8_STAGE(PG8_SA(1, 0), a3, voffA);
            PG8_BAR; PG8_WAIT_L(0); PG8_MMA(1, 0, At, B0); PG8_BAR; PG8_SCHED;
            PG8_STAGE(PG8_SB(1, 1), b3 + hstep, voffB);
            PG8_WAIT_V(6); PG8_BAR; PG8_MMA(1, 1, At, B1); PG8_BAR;
            }
        }
        if constexpr (ALIGN_EPI) { if (wr == 0) PG8_BAR; }
        if constexpr (!Epi::AFTER_DRAIN) { E(acc, cur, wr, wc, fr, fq); S.done(cur); }
        if (!has_next) break;
#pragma unroll
        for (int a = 0; a < 2; ++a)
#pragma unroll
            for (int b = 0; b < 2; ++b)
#pragma unroll
                for (int m = 0; m < 4; ++m)
#pragma unroll
                    for (int n = 0; n < 2; ++n) acc[a][b][m][n] = (f32x4){0.f, 0.f, 0.f, 0.f};
        cur = nxt; cA = nA; cB = nB; ++ui;
        if constexpr (ALIGN_EPI) { if (wr == 1) PG8_BAR; }
    }
    PG8_WAIT_V(0);
    if constexpr (!ALIGN_EPI) { if (wr == 0) PG8_BAR; }
    PG8_BAR;
    if constexpr (Epi::AFTER_DRAIN) { E.fused(acc, cur, wr, wc, fr, fq, lds, wid, lane); S.done(cur); }
#undef PG8_SA
#undef PG8_SB
#undef PG8_STAGE
#undef PG8_LDA
#undef PG8_LDB
#undef PG8_MMA
#undef PG8_WAIT_V
#undef PG8_WAIT_L
#undef PG8_BAR
#undef PG8_SCHED
}
}
namespace pg8 {
struct EpiBf16 {
    static constexpr bool PERM = true, AFTER_DRAIN = false;
    bf16_t* O; int ldc;
    __device__ __forceinline__ void operator()(const f32x4 (&acc)[2][2][4][2], const Unit& u, int wr, int wc, int fr, int fq) const {
        const int row0 = u.pm * BM + wr * 64 + fr; const int col0 = u.pn * BM + wc * 32 + 8 * fq;
#pragma unroll
        for (int ai = 0; ai < 2; ++ai)
#pragma unroll
            for (int m = 0; m < 4; ++m) { bf16_t* rowp = O + (size_t)(row0 + ai * HALF + m * 16) * ldc + col0;
#pragma unroll
                for (int bj = 0; bj < 2; ++bj) { const f32x4 v0 = acc[ai][bj][m][0], v1 = acc[ai][bj][m][1];
                    u32x4 w; w.x = cvt_pk_bf16(v0[0], v0[1]); w.y = cvt_pk_bf16(v0[2], v0[3]); w.z = cvt_pk_bf16(v1[0], v1[1]); w.w = cvt_pk_bf16(v1[2], v1[3]);
                    *(u32x4*)(rowp + bj * HALF) = w; } }
    }
};
struct EpiSwiGLU {
    static constexpr bool PERM = true, AFTER_DRAIN = false;
    bf16_t* O; int ldc;
    __device__ __forceinline__ void operator()(const f32x4 (&acc)[2][2][4][2], const Unit& u, int wr, int wc, int fr, int fq) const {
        const int row0 = u.pm * BM + wr * 64 + fr; const int col0 = u.pn * HALF + wc * 32 + 8 * fq;
#pragma unroll
        for (int ai = 0; ai < 2; ++ai)
#pragma unroll
            for (int m = 0; m < 4; ++m) { bf16_t* rowp = O + (size_t)(row0 + ai * HALF + m * 16) * ldc + col0;
                float r[8];
#pragma unroll
                for (int n = 0; n < 2; ++n)
#pragma unroll
                    for (int j = 0; j < 4; ++j) { const float a = acc[ai][0][m][n][j], b = acc[ai][1][m][n][j]; r[n * 4 + j] = a * b / (1.0f + __expf(-a)); }
                u32x4 w; w.x = cvt_pk_bf16(r[0], r[1]); w.y = cvt_pk_bf16(r[2], r[3]); w.z = cvt_pk_bf16(r[4], r[5]); w.w = cvt_pk_bf16(r[6], r[7]);
                *(u32x4*)rowp = w; }
    }
};
struct MoeOrder {
    const PG8_LAS int* pref; int nN, G, c, total;
    __device__ __forceinline__ void init(const PG8_LAS int* pref_, int nN_, int G_, int c_) { pref = pref_; nN = nN_; G = G_; c = c_; total = pref_[32] * nN_; }
    __device__ __forceinline__ bool next(int i, Unit& u) const {
        const int L = i * G + c; if (L >= total) return false;
        const int rt = L / nN, pn = L - rt * nN; int e = 0;
#pragma unroll 1
        for (int k = 1; k < 32; ++k) e += (pref[k] <= rt) ? 1 : 0;
        u.pm = rt; u.pn = pn; u.pnb = e * nN + pn; return true;
    }
    __device__ __forceinline__ void a_ready(const Unit&) const {}
    __device__ __forceinline__ void done(const Unit&) const {}
};
}
#define XB_TMO      128
#define XB_XCNT(j)  (256  + 64 * (j))
#define XB_XSUB(j)  (1280 + 64 * (j))
#define XB_XGEN(j)  (2304 + 64 * (j))
#define XB_TOP      3328
#define XB_TOPGEN   3392
#define XCD_BAR_WORDS 3456
#define XB_SPIN_CAP (1u << 22)

__device__ __forceinline__ unsigned xb_ld(unsigned* p)              { return __hip_atomic_load(p, __ATOMIC_RELAXED, __HIP_MEMORY_SCOPE_AGENT); }
__device__ __forceinline__ unsigned xb_add(unsigned* p, unsigned v) { return __hip_atomic_fetch_add(p, v, __ATOMIC_RELAXED, __HIP_MEMORY_SCOPE_AGENT); }
__device__ __forceinline__ unsigned xb_xcc_id() { return (unsigned)__builtin_amdgcn_s_getreg((3 << 11) | 20) & 0xFu; }
#define XB_SPIN(cond, bar) do { unsigned _sp = 0; while (cond) { __builtin_amdgcn_s_sleep(1); \
    if ((++_sp & 255u) == 0u) { if (xb_ld(&(bar)[XB_TMO])) break; if (_sp > XB_SPIN_CAP) { atomicAdd(&(bar)[XB_TMO], 1u); break; } } } } while (0)

struct XcdBarrier {
    unsigned* bar; unsigned x;
    volatile LAS unsigned* st;
};

__device__ __forceinline__ XcdBarrier xcd_barrier_post(unsigned* bar, volatile LAS unsigned* st) {
    XcdBarrier b; b.bar = bar; b.x = xb_xcc_id(); b.st = st;
    if (hw_tid() == 0) (void)xb_add(&bar[XB_XCNT(b.x)], 1u);
    return b;
}
__device__ __forceinline__ void xcd_barrier_complete(unsigned* bar, unsigned x, unsigned& nloc, unsigned& nx) {
    const unsigned G = gridDim.x * gridDim.y * gridDim.z;
    unsigned sum, cnt, mine, sp = 0u;
    for (;;) {
        sum = 0u; cnt = 0u; mine = 0u;
#pragma unroll
        for (unsigned j = 0; j < 16; ++j) { const unsigned c = xb_ld(&bar[XB_XCNT(j)]); sum += c; cnt += (c > 0u) ? 1u : 0u; mine = (j == x) ? c : mine; }
        if (sum == G) break;
        __builtin_amdgcn_s_sleep(1);
        if ((++sp & 255u) == 0u) { if (xb_ld(&bar[XB_TMO])) break; if (sp > XB_SPIN_CAP) { atomicAdd(&bar[XB_TMO], 1u); break; } }
    }
    nloc = mine > 0u ? mine : 1u; nx = cnt > 0u ? cnt : 1u;
}

__device__ __forceinline__ void xcd_barrier(const XcdBarrier& b) {
    asm volatile("s_waitcnt vmcnt(0)" ::: "memory");
    __syncthreads();
    if (hw_tid() == 0) {
        unsigned* bar = b.bar;
        __builtin_amdgcn_s_waitcnt(0);
        unsigned nloc = b.st[0], nx = b.st[1];
        if (nloc == 0u) { xcd_barrier_complete(bar, b.x, nloc, nx); b.st[0] = nloc; b.st[1] = nx; }
        const unsigned old = xb_add(&bar[XB_XSUB(b.x)], 1u);
        const unsigned gen = old / nloc;
        if (old + 1u == (gen + 1u) * nloc) {
            __builtin_amdgcn_fence(__ATOMIC_RELEASE, "agent");
            asm volatile("s_waitcnt vmcnt(0)" ::: "memory");
            const unsigned og = xb_add(&bar[XB_TOP], 1u);
            const unsigned tg = og / nx;
            if (og + 1u == (tg + 1u) * nx) xb_add(&bar[XB_TOPGEN], 1u);
            else XB_SPIN(xb_ld(&bar[XB_TOPGEN]) == tg, bar);
            __builtin_amdgcn_fence(__ATOMIC_ACQUIRE, "agent");
            xb_add(&bar[XB_XGEN(b.x)], 1u);
            asm volatile("s_waitcnt vmcnt(0)" ::: "memory");
        } else {
            XB_SPIN(xb_ld(&bar[XB_XGEN(b.x)]) == gen, bar);
            __builtin_amdgcn_fence(__ATOMIC_ACQUIRE, "agent");
            asm volatile("s_waitcnt vmcnt(0)" ::: "memory");
        }
    }
    __syncthreads();
}
struct Args { const float* in[30]; float* out; unsigned char* ws; int ph_lo, ph_hi; };
#define CAS __attribute__((address_space(4)))
struct KA { const CAS unsigned char* kp;
    __device__ __forceinline__ const float* in(int i) const { return *(const float* const CAS*)(kp + 8 * i); }
    __device__ __forceinline__ float* out() const { return *(float* const CAS*)(kp + 240); }
    __device__ __forceinline__ unsigned char* ws() const { return *(unsigned char* const CAS*)(kp + 248); } };
__device__ __forceinline__ KA ka_get() { const CAS unsigned char* kp = (const CAS unsigned char*)__builtin_amdgcn_kernarg_segment_ptr(); asm volatile("" : "+s"(kp)); return KA{kp}; }
__device__ __forceinline__ int opaque_tid() { return hw_tid(); }
static_assert(sizeof(Args) == 264, "kernarg layout");
enum { I_X = 0, I_C, I_CTX, I_CCTX, I_ADAW, I_ADAB, I_WIN, I_RPB, I_MUP, I_MUN, I_W0, I_W2, I_A0, I_A2, I_G2, I_KK, I_KA, I_RK, I_GNG, I_GNB, I_WOUT, I_LN1G, I_LN1B, I_LN2G, I_LN2B, I_RW, I_RB, I_EW1, I_EW3, I_EW2 };

__device__ __forceinline__ void transpose_item(const float* W, int N, int k0, int n0, bf16* WT, int ldk, int drow0, LAS float* scr, int lane) {
#pragma unroll 8
    for (int i = 0; i < 32; ++i) { const int kk = 2 * i + (lane >> 5); scr[kk * 33 + (lane & 31)] = W[(size_t)(k0 + kk) * N + n0 + (lane & 31)]; }
    LDS_WAIT(); asm volatile("" ::: "memory");
    const int c = lane & 7;
#pragma unroll
    for (int j = 0; j < 4; ++j) { const int n = (lane >> 3) + 8 * j; const LAS float* s = scr + (8 * c) * 33 + n;
        v4u o; o.x = pk2(s[0 * 33], s[1 * 33]); o.y = pk2(s[2 * 33], s[3 * 33]); o.z = pk2(s[4 * 33], s[5 * 33]); o.w = pk2(s[6 * 33], s[7 * 33]);
        *(GAS v4u*)(WT + (size_t)(drow0 + n) * ldk + k0 + 8 * c) = o; }
    LDS_WAIT(); asm volatile("" ::: "memory");
}

__device__ __forceinline__ void phase_prologue(LAS unsigned char* lds) {
    const KA a = ka_get();
    const int tid = opaque_tid(), lane = tid & 63, wave = __builtin_amdgcn_readfirstlane(tid >> 6), G = gridDim.x, bid = blockIdx.x;
    const int gw = bid * 8 + wave, NGW = G * 8;
    bf16* WINT = (bf16*)(a.ws() + WS_WINT); bf16* WOT = (bf16*)(a.ws() + WS_WOT);
    LAS float* scr = (LAS float*)(lds + wave * 16384);
    constexpr int I_IN = 16 * 103, I_OUT = 16 * 32, I_L = I_IN + I_OUT;
    for (int it = gw; it < 2 * I_L; it += NGW) {
        const int l = it / I_L; int r = it - l * I_L;
        if (r < I_IN) { const int kb = r / 103, nb = r - kb * 103; transpose_item(a.in(I_WIN) + (size_t)l * DM * DIN, DIN, 64 * kb, 32 * nb, WINT + (size_t)l * DINP * DM, DM, 32 * nb, scr, lane); }
        else { r -= I_IN; const int kb = r >> 5, nb = r & 31; transpose_item(a.in(I_WOUT) + (size_t)l * DM * DM, DM, 64 * kb, 32 * nb, WOT + (size_t)l * DM * DM, DM, 32 * nb, scr, lane); }
    }
    for (int i = bid * 512 + tid; i < 8192; i += G * 512) { const int l = i >> 12, r = i & 4095; *(GAS v4u*)(WINT + (size_t)l * DINP * DM + (size_t)DIN * DM + (size_t)r * 8) = (v4u){0u, 0u, 0u, 0u}; }
    { float* rp = (float*)(a.ws() + WS_ROPE); const int i = bid * 512 + tid;
      if (i < 1536) { const int idx = i < 512 ? i : i - 512; const int p = idx >> 4, f = idx & 15; const double inv = exp(-(double)f * (9.210340371976184 / 16.0)); const double ang = (double)p * inv;
          const float cs = (float)cos(ang), sn = (float)sin(ang); if (i < 512) { rp[idx] = cs; rp[512 + idx] = sn; } else { rp[1024 + idx] = cs; rp[2048 + idx] = sn; } } }
    __syncthreads();
    LAS float* sl = (LAS float*)lds; LAS float* red = (LAS float*)(lds + 69632);
    for (int i = tid; i < 17 * 1024; i += 512) { const int r = i >> 10, k = i & 1023; const float v = r < 16 ? a.in(I_C)[r * 1024 + k] : a.in(I_CCTX)[k]; sl[i] = v / (1.0f + expf(-v)); }
    __syncthreads();
    float* mods = (float*)(a.ws() + WS_MODS);
    for (int it = bid; it < 192; it += G) {
        const int l = it / 96, ch = it - l * 96; const int kq = tid >> 6, cl = tid & 63, col = ch * 64 + cl;
        const float* W = a.in(I_ADAW) + (size_t)l * DM * 6144 + col;
        float acc[17];
#pragma unroll
        for (int r = 0; r < 17; ++r) acc[r] = 0.f;
        for (int k0 = kq * 128; k0 < kq * 128 + 128; k0 += 8) { float w8[8];
#pragma unroll
            for (int q = 0; q < 8; ++q) w8[q] = W[(size_t)(k0 + q) * 6144];
#pragma unroll
            for (int r = 0; r < 17; ++r) { const f32x4 s0 = *(const LAS f32x4*)(sl + r * 1024 + k0), s1 = *(const LAS f32x4*)(sl + r * 1024 + k0 + 4);
                acc[r] += s0.x * w8[0] + s0.y * w8[1] + s0.z * w8[2] + s0.w * w8[3] + s1.x * w8[4] + s1.y * w8[5] + s1.z * w8[6] + s1.w * w8[7]; } }
#pragma unroll
        for (int r = 0; r < 17; ++r) red[(kq * 17 + r) * 64 + cl] = acc[r];
        __syncthreads();
        for (int i = tid; i < 17 * 64; i += 512) { const int r = i >> 6, c2 = i & 63; float s = 0.f;
#pragma unroll
            for (int q = 0; q < 8; ++q) s += red[(q * 17 + r) * 64 + c2];
            mods[((size_t)l * 17 + r) * 6144 + ch * 64 + c2] = s + a.in(I_ADAB)[l * 6144 + ch * 64 + c2]; }
        __syncthreads();
    }
}

__device__ __forceinline__ void phase_modconv(LAS unsigned char* lds, int l) {
    const KA a = ka_get();
    const int tid = opaque_tid(), lane = tid & 63, wave = __builtin_amdgcn_readfirstlane(tid >> 6), G = gridDim.x, bid = blockIdx.x;
    const int gw = bid * 8 + wave, NGW = G * 8;
    const float* mods = (const float*)(a.ws() + WS_MODS) + (size_t)l * 17 * 6144;
    bf16* XM = (bf16*)(a.ws() + WS_X1);
    const float* xs = l == 0 ? a.in(I_X) : a.out(); const float* cs = l == 0 ? a.in(I_CTX) : (const float*)(a.ws() + WS_CS);
    for (int m = gw; m < NTOK; m += NGW) {
        const float* src; int mr;
        if (m < NTX) { src = xs + (size_t)m * DM; mr = m / SEQ; } else { src = cs + (size_t)(m - NTX) * DM; mr = 16; }
        const GAS f32x4* xr = (const GAS f32x4*)src + lane; const GAS f32x4* sh = (const GAS f32x4*)(mods + (size_t)mr * 6144) + lane; const GAS f32x4* sc = sh + 256;
        GAS v2u* o8 = (GAS v2u*)(XM + (size_t)m * DM) + lane;
#pragma unroll
        for (int j = 0; j < 4; ++j) { const f32x4 v = xr[64 * j], s = sh[64 * j], c = sc[64 * j]; const f32x4 r = v * (c + 1.0f) + s; v2u w; w.x = pk2(r.x, r.y); w.y = pk2(r.z, r.w); o8[64 * j] = w; }
    }
}

__device__ __forceinline__ void phase_scan_direct(LAS unsigned char* lds, int l) {
    const KA a = ka_get();
    constexpr int TB = 32;
    const int tid = opaque_tid(), lane = tid & 63, wv = __builtin_amdgcn_readfirstlane(tid >> 6);
    LAS float* ops = (LAS float*)lds;
    LAS float* scal = (LAS float*)(lds + 49152);
    LAS float* zl = (LAS float*)(lds + 49664);
    LAS float* rkraw = (LAS float*)(lds + 57856);
    LAS float* ybuf = (LAS float*)(lds + 74240);
    const bf16* PX = (const bf16*)(a.ws() + WS_X2); float* YD = (float*)(a.ws() + WS_X3); float* BON = (float*)(a.ws() + WS_BONUS); const float* rope = (const float*)(a.ws() + WS_ROPE);
    const float* mup = a.in(I_MUP) + l * 1760; const float* mun = a.in(I_MUN) + l * 1760;
    for (int chain = blockIdx.x; chain < 256; chain += gridDim.x) {
        const int b = chain >> 4, h = (chain >> 1) & 7, d = chain & 1, c = lane;
        float w2c[32], a2c[32];
#pragma unroll
        for (int j = 0; j < 32; ++j) { w2c[j] = a.in(I_W2)[((size_t)(l * 2 + d) * 32 + j) * 512 + h * 64 + c]; a2c[j] = a.in(I_A2)[((size_t)(l * 2 + d) * 32 + j) * 512 + h * 64 + c]; }
        const float w0c = a.in(I_W0)[(l * 2 + d) * 512 + h * 64 + c], a0c = a.in(I_A0)[(l * 2 + d) * 512 + h * 64 + c];
        const float kkc = a.in(I_KK)[l * 512 + h * 64 + c], kac = a.in(I_KA)[l * 512 + h * 64 + c], rkc = a.in(I_RK)[l * 512 + h * 64 + c];
        const int colr = h * 64 + c, colk = 512 + colr, colv = 1024 + colr, coll = (c < 32) ? (1536 + d * 32 + c) : (1600 + d * 32 + (c - 32));
        const float mpr = mup[colr], mnr = mun[colr], mpk = mup[colk], mnk = mun[colk], mpv = mup[colv], mnv = mun[colv], mpl = mup[coll], mnl = mun[coll];
        float S[8];
#pragma unroll
        for (int j = 0; j < 8; ++j) S[j] = 0.f;
        const int vl = lane >> 3, kq = lane & 7, vrow = 8 * wv + vl;
        for (int seq = 0; seq < 2; ++seq) {
            const int T = seq ? SEQ : CTXL, rowbase = seq ? b * SEQ : NTX + b * CTXL, nblk = T / TB;
            for (int bi = 0; bi < nblk; ++bi) {
                const int tb = d ? (nblk - 1 - bi) : bi, t0 = tb * TB;
                float zv[4];
#pragma unroll
                for (int i = 0; i < 4; ++i) {
                    const int tl = wv + 8 * i, t = t0 + tl; const bf16* p = PX + (size_t)(rowbase + t) * DINP + RWOFF;
                    const bool hp = t > 0, hn = t + 1 < T;
                    const float cr = bf2f(p[colr]), ck = bf2f(p[colk]), cv = bf2f(p[colv]), cl_ = bf2f(p[coll]);
                    const float pr = hp ? bf2f(p[colr - DINP]) : 0.f, pk = hp ? bf2f(p[colk - DINP]) : 0.f, pv = hp ? bf2f(p[colv - DINP]) : 0.f, pl = hp ? bf2f(p[coll - DINP]) : 0.f;
                    const float nr = hn ? bf2f(p[colr + DINP]) : 0.f, nk = hn ? bf2f(p[colk + DINP]) : 0.f, nv = hn ? bf2f(p[colv + DINP]) : 0.f, nl = hn ? bf2f(p[coll + DINP]) : 0.f;
                    const float zr = cr + mpr * (pr - cr) + mnr * (nr - cr), zk = ck + mpk * (pk - ck) + mnk * (nk - ck);
                    zv[i] = cv + mpv * (pv - cv) + mnv * (nv - cv);
                    const float zz = cl_ + mpl * (pl - cl_) + mnl * (nl - cl_);
                    rkraw[tl * 128 + c] = zr; rkraw[tl * 128 + 64 + c] = zk; zl[tl * 64 + c] = (c < 32) ? tanhf(zz) : zz;
                }
                __syncthreads();
#pragma unroll
                for (int i = 0; i < 4; ++i) {
                    const int tl = wv + 8 * i, t = t0 + tl;
                    float r = rkraw[tl * 128 + c], k = rkraw[tl * 128 + 64 + c];
                    if (seq) { const float rp = rkraw[tl * 128 + (c ^ 16)], kp = rkraw[tl * 128 + 64 + (c ^ 16)]; const int qd = c >> 4, f = c & 15;
                        const int ti = (qd < 2) ? ((t >> 6) * 16 + f) : (1024 + (t & 63) * 16 + f); const float cs = rope[ti], sn = rope[ti + ((qd < 2) ? 512 : 1024)];
                        const float sg = (qd & 1) ? sn : -sn; r = r * cs + rp * sg; k = k * cs + kp * sg; }
                    const float kkr = k * kkc; const float ss = wave_sum(kkr * kkr); const float kk = kkr / fmaxf(sqrtf(ss), 1e-12f);
                    float u = w0c, av = a0c;
#pragma unroll
                    for (int j = 0; j < 32; j += 4) { const f32x4 z1 = *(const LAS f32x4*)(zl + tl * 64 + j), z2 = *(const LAS f32x4*)(zl + tl * 64 + 32 + j);
                        u += z1.x * w2c[j] + z1.y * w2c[j + 1] + z1.z * w2c[j + 2] + z1.w * w2c[j + 3]; av += z2.x * a2c[j] + z2.y * a2c[j + 1] + z2.z * a2c[j + 2] + z2.w * a2c[j + 3]; }
                    const float w = expf(-0.6065306597126334f * sigmoidf_(u)), aa = sigmoidf_(av);
                    const float kd = k * (1.0f + (aa - 1.0f) * kac), nb = -kk * aa;
                    const float c1 = wave_sum(nb * r), c2 = wave_sum(kd * r), bon = wave_sum(r * kd * rkc);
                    LAS float* o = ops + tl * 384 + c; o[0] = kk; o[64] = w * r; o[128] = w; o[192] = nb; o[256] = kd; o[320] = zv[i];
                    if (lane == 0) { scal[tl * 4] = c1; scal[tl * 4 + 1] = c2; BON[((size_t)d * NTOK + rowbase + t) * 8 + h] = bon; }
                }
                __syncthreads();
#pragma unroll 2
                for (int s = 0; s < TB; ++s) {
                    const int tl = d ? (TB - 1 - s) : s; const LAS float* o = ops + tl * 384 + kq * 8;
                    const f32x4 ka = *(const LAS f32x4*)(o), kb = *(const LAS f32x4*)(o + 4), ra = *(const LAS f32x4*)(o + 64), rb = *(const LAS f32x4*)(o + 68);
                    const f32x4 wa = *(const LAS f32x4*)(o + 128), wb = *(const LAS f32x4*)(o + 132), na = *(const LAS f32x4*)(o + 192), nb_ = *(const LAS f32x4*)(o + 196);
                    const f32x4 da = *(const LAS f32x4*)(o + 256), db = *(const LAS f32x4*)(o + 260);
                    const float vv = ops[tl * 384 + 320 + vrow], c1 = scal[tl * 4], c2 = scal[tl * 4 + 1];
                    float sk = S[0] * ka.x + S[1] * ka.y + S[2] * ka.z + S[3] * ka.w + S[4] * kb.x + S[5] * kb.y + S[6] * kb.z + S[7] * kb.w;
                    float yy = S[0] * ra.x + S[1] * ra.y + S[2] * ra.z + S[3] * ra.w + S[4] * rb.x + S[5] * rb.y + S[6] * rb.z + S[7] * rb.w;
                    sk = red8(sk); yy = red8(yy);
                    const float y = yy + sk * c1 + vv * c2;
                    S[0] = S[0] * wa.x + sk * na.x + vv * da.x; S[1] = S[1] * wa.y + sk * na.y + vv * da.y; S[2] = S[2] * wa.z + sk * na.z + vv * da.z; S[3] = S[3] * wa.w + sk * na.w + vv * da.w;
                    S[4] = S[4] * wb.x + sk * nb_.x + vv * db.x; S[5] = S[5] * wb.y + sk * nb_.y + vv * db.y; S[6] = S[6] * wb.z + sk * nb_.z + vv * db.z; S[7] = S[7] * wb.w + sk * nb_.w + vv * db.w;
                    if (kq == 0) ybuf[tl * 64 + vrow] = y;
                }
                __syncthreads();
#pragma unroll
                for (int i = 0; i < 4; ++i) { const int tl = wv + 8 * i; YD[((size_t)d * NTOK + rowbase + t0 + tl) * 512 + h * 64 + c] = ybuf[tl * 64 + c]; }
            }
        }
        __syncthreads();
    }
}

typedef short v4i16_t __attribute__((ext_vector_type(4)));
__device__ __forceinline__ int swz_off(int row, int chunk) { return row * 128 + ((chunk ^ (row & 7)) << 4); }
__device__ __forceinline__ void stage_rows(LAS unsigned char* dst, const bf16* src, int nrows, int tid) {
    for (int idx = tid; idx < nrows * 8; idx += 512) { const int r = idx >> 3, ch = idx & 7; const v4u v = *(const GAS v4u*)(src + (size_t)r * DINP + ch * 8); *(LAS v4u*)(dst + swz_off(r, ch)) = v; }
}
struct AttState { float m, l; f32x4 o[4]; };
template <bool LOCAL>
__device__ __forceinline__ void att_kstep(AttState& st, const LAS unsigned char* kb, const LAS unsigned char* vb, int r0, int r1, const bf16x8 (&qf)[2], int lane,
                                          const LAS float* rpbrow, int kc0, int qc, int cs) {
    const int kl = lane & 15, g = lane >> 4;
    f32x4 s0 = {0.f, 0.f, 0.f, 0.f}, s1 = {0.f, 0.f, 0.f, 0.f};
#pragma unroll
    for (int dh = 0; dh < 2; ++dh) {
        const bf16x8 k0 = *(const LAS bf16x8*)(kb + swz_off(r0 + kl, dh * 4 + g)); const bf16x8 k1 = *(const LAS bf16x8*)(kb + swz_off(r1 + kl, dh * 4 + g));
        s0 = __builtin_amdgcn_mfma_f32_16x16x32_bf16(k0, qf[dh], s0, 0, 0, 0); s1 = __builtin_amdgcn_mfma_f32_16x16x32_bf16(k1, qf[dh], s1, 0, 0, 0);
    }
    float sc[8];
#pragma unroll
    for (int j = 0; j < 4; ++j) { sc[j] = s0[j] * 0.125f; sc[4 + j] = s1[j] * 0.125f; }
    if (LOCAL) {
        float bv[8]; bool ok[8];
#pragma unroll
        for (int j = 0; j < 8; ++j) { const int kc = kc0 + (j >> 2) * 16 + 4 * g + (j & 3); ok[j] = (kc >= cs) && (kc < cs + 16); const int bi = ok[j] ? (kc - qc + 15) : 0;
            const unsigned ad = (unsigned)(uintptr_t)(rpbrow + bi); asm volatile("ds_read_b32 %0, %1" : "=v"(bv[j]) : "v"(ad)); }
        asm volatile("s_waitcnt lgkmcnt(0)" : "+v"(bv[0]), "+v"(bv[1]), "+v"(bv[2]), "+v"(bv[3]), "+v"(bv[4]), "+v"(bv[5]), "+v"(bv[6]), "+v"(bv[7]) :: "memory");
#pragma unroll
        for (int j = 0; j < 8; ++j) sc[j] = ok[j] ? sc[j] + bv[j] : -INFINITY;
    }
    float mt = fmaxf(fmaxf(fmaxf(sc[0], sc[1]), fmaxf(sc[2], sc[3])), fmaxf(fmaxf(sc[4], sc[5]), fmaxf(sc[6], sc[7])));
    mt = fmaxf(mt, shx(mt, 16, lane)); mt = fmaxf(mt, shx(mt, 32, lane));
    const float mn = fmaxf(st.m, mt); const bool dead = (mn == -INFINITY);
    const float scale = dead ? 1.0f : __expf(st.m - mn);
    float p[8], ps = 0.f;
#pragma unroll
    for (int j = 0; j < 8; ++j) { p[j] = dead ? 0.f : __expf(sc[j] - mn); ps += p[j]; }
    st.l = st.l * scale + ps; st.m = mn;
#pragma unroll
    for (int dt = 0; dt < 4; ++dt) st.o[dt] = st.o[dt] * scale;
    v4u pw; pw.x = pk2(p[0], p[1]); pw.y = pk2(p[2], p[3]); pw.z = pk2(p[4], p[5]); pw.w = pk2(p[6], p[7]);
    const bf16x8 pf = __builtin_bit_cast(bf16x8, pw);
    const int q_ = kl >> 2, p_ = kl & 3;
#pragma unroll
    for (int dt = 0; dt < 4; ++dt) {
        const v4i16_t lo = __builtin_amdgcn_ds_read_tr16_b64_v4i16((LAS v4i16_t*)(vb + swz_off(r0 + 4 * g + q_, 2 * dt + (p_ >> 1)) + (p_ & 1) * 8));
        const v4i16_t hi = __builtin_amdgcn_ds_read_tr16_b64_v4i16((LAS v4i16_t*)(vb + swz_off(r1 + 4 * g + q_, 2 * dt + (p_ >> 1)) + (p_ & 1) * 8));
        const bf16x8 vf = (bf16x8){lo[0], lo[1], lo[2], lo[3], hi[0], hi[1], hi[2], hi[3]};
        st.o[dt] = __builtin_amdgcn_mfma_f32_16x16x32_bf16(vf, pf, st.o[dt], 0, 0, 0);
    }
}
__device__ __forceinline__ void att_merge_store(AttState& st, LAS float* mrg, int qb, int kh, int lane, bf16* orow0  ) {
    LAS float* mine = mrg + qb * (18 * 64) + lane;
    if (kh == 1) { mine[0] = st.m; mine[64] = st.l;
#pragma unroll
        for (int dt = 0; dt < 4; ++dt)
#pragma unroll
            for (int j = 0; j < 4; ++j) mine[(2 + dt * 4 + j) * 64] = st.o[dt][j]; }
    __syncthreads();
    if (kh == 0) {
        const float m1 = mine[0], l1 = mine[64]; const float ms = fmaxf(st.m, m1); const float f0 = __expf(st.m - ms), f1 = __expf(m1 - ms);
        float lc = st.l * f0 + l1 * f1; lc += shx(lc, 16, lane); lc += shx(lc, 32, lane); const float inv = 1.0f / lc;
        const int q = lane & 15, g = lane >> 4;
#pragma unroll
        for (int dt = 0; dt < 4; ++dt) { float r[4];
#pragma unroll
            for (int j = 0; j < 4; ++j) r[j] = (st.o[dt][j] * f0 + mine[(2 + dt * 4 + j) * 64] * f1) * inv;
            v2u w; w.x = pk2(r[0], r[1]); w.y = pk2(r[2], r[3]); *(GAS v2u*)(orow0 + (size_t)q * DM + dt * 16 + 4 * g) = w; }
    }
}
__device__ __forceinline__ void phase_attn(LAS unsigned char* lds, int l) {
    const KA a = ka_get();
    const int tid = opaque_tid(), lane = tid & 63, wv = __builtin_amdgcn_readfirstlane(tid >> 6), qb = wv & 3, kh = wv >> 2;
    LAS unsigned char* KC = lds; LAS unsigned char* VC = lds + 32768; LAS unsigned char* KL = lds + 65536; LAS unsigned char* VL = lds + 98304;
    LAS float* RPB = (LAS float*)(lds + LDSCTL_OFF + 2048); LAS float* mrg = (LAS float*)KL;
    const bf16* PX = (const bf16*)(a.ws() + WS_X2); bf16* CAT = (bf16*)(a.ws() + WS_X1);
    for (int blk = blockIdx.x; blk < 256; blk += gridDim.x) {
        const int bh = blk >> 1, b = bh >> 3, h = bh & 7, half = blk & 1;
        __syncthreads();
        const bf16* ctxrow = PX + (size_t)(NTX + b * CTXL) * DINP + h * 64;
        stage_rows(KC, ctxrow + 512, 256, tid); stage_rows(VC, ctxrow + 1024, 256, tid);
        for (int i = tid; i < 465; i += 512) RPB[i] = a.in(I_RPB)[((size_t)l * 8 + h) * 465 + i];
        __syncthreads();
        const int kl = lane & 15, g = lane >> 4;
        if (l == 0) {
            for (int rr = 0; rr < 2; ++rr) {
                const int q0 = (half * 8 + rr * 4 + qb) * 16; const bf16* qrow = ctxrow + (size_t)(q0 + kl) * DINP;
                bf16x8 qf[2]; qf[0] = *(const GAS bf16x8*)(qrow + 8 * g); qf[1] = *(const GAS bf16x8*)(qrow + 32 + 8 * g);
                AttState st; st.m = -INFINITY; st.l = 0.f;
#pragma unroll
                for (int dt = 0; dt < 4; ++dt) st.o[dt] = (f32x4){0.f, 0.f, 0.f, 0.f};
                for (int s = 0; s < 4; ++s) att_kstep<false>(st, KC, VC, kh * 128 + s * 32, kh * 128 + s * 32 + 16, qf, lane, RPB, 0, 0, 0);
                att_merge_store(st, mrg, qb, kh, lane, CAT + (size_t)(NTX + b * CTXL + q0) * DM + h * 64);
                __syncthreads();
            }
        }
        v4u pfk[4], pfv[4];
#define ATT_ISSUE(SIDX) do { const int i_ = half * 16 + ((SIDX) >> 1); const int rs_ = min(max(i_ - 4, 0), 24); const bf16* lr_ = PX + (size_t)(b * SEQ + (rs_ + 4 * ((SIDX) & 1)) * 64) * DINP + h * 64; \
            _Pragma("unroll") for (int q__ = 0; q__ < 4; ++q__) { const int idx_ = tid + 512 * q__; const bf16* p_ = lr_ + (size_t)(idx_ >> 3) * DINP + (idx_ & 7) * 8; pfk[q__] = *(const GAS v4u*)(p_ + 512); pfv[q__] = *(const GAS v4u*)(p_ + 1024); } } while (0)
        ATT_ISSUE(0);
        bf16x8 qn[2]; { const bf16* qrow = PX + (size_t)(b * SEQ + (half * 16) * 64 + qb * 16 + kl) * DINP + h * 64; qn[0] = *(const GAS bf16x8*)(qrow + 8 * g); qn[1] = *(const GAS bf16x8*)(qrow + 32 + 8 * g); }
        for (int ui = 0; ui < 16; ++ui) {
            const int i = half * 16 + ui; const int rs = min(max(i - 4, 0), 24);
            const int qc = qb * 16 + kl, cs = min(max(qc - 8, 0), 48), wc0 = min(max(qb * 16 - 8, 0), 32);
            bf16x8 qf[2]; qf[0] = qn[0]; qf[1] = qn[1];
            { const int in_ = half * 16 + (ui < 15 ? ui + 1 : ui); const bf16* qrow = PX + (size_t)(b * SEQ + in_ * 64 + qc) * DINP + h * 64; qn[0] = *(const GAS bf16x8*)(qrow + 8 * g); qn[1] = *(const GAS bf16x8*)(qrow + 32 + 8 * g); }
            AttState st; st.m = -INFINITY; st.l = 0.f;
#pragma unroll
            for (int dt = 0; dt < 4; ++dt) st.o[dt] = (f32x4){0.f, 0.f, 0.f, 0.f};
            for (int s = 0; s < 4; ++s) att_kstep<false>(st, KC, VC, kh * 128 + s * 32, kh * 128 + s * 32 + 16, qf, lane, RPB, 0, 0, 0);
            for (int pass = 0; pass < 2; ++pass) {
                __syncthreads();
#pragma unroll
                for (int q__ = 0; q__ < 4; ++q__) { const int idx_ = tid + 512 * q__; const int o_ = swz_off(idx_ >> 3, idx_ & 7); *(LAS v4u*)(KL + o_) = pfk[q__]; *(LAS v4u*)(VL + o_) = pfv[q__]; }
                __syncthreads();
                if (2 * ui + pass + 1 < 32) ATT_ISSUE(2 * ui + pass + 1);
                for (int k2 = 0; k2 < 2; ++k2) { const int kr = 2 * kh + k2, arow = rs + 4 * pass + kr;
                    att_kstep<true>(st, KL, VL, kr * 64 + wc0, kr * 64 + wc0 + 16, qf, lane, RPB + (arow - i + 7) * 31, wc0, qc, cs); }
            }
            __syncthreads();
            att_merge_store(st, mrg, qb, kh, lane, CAT + (size_t)(b * SEQ + i * 64 + qb * 16) * DM + h * 64);
        }
    }
}

__device__ __forceinline__ void phase_rwpost(LAS unsigned char* lds, int l) {
    const KA a = ka_get();
    const int tid = opaque_tid(), lane = tid & 63, hh = __builtin_amdgcn_readfirstlane(tid >> 6), kl = lane & 15, g = lane >> 4;
    const int er = tid >> 5, cq = tid & 31, c0 = cq * 16, hq = cq >> 2;
    LAS bf16* sig = (LAS bf16*)lds;
    LAS float* Gl = (LAS float*)(lds + 4096);
    const bf16* PX = (const bf16*)(a.ws() + WS_X2); const float* YD = (const float*)(a.ws() + WS_X3); const float* BON = (const float*)(a.ws() + WS_BONUS); bf16* CAT = (bf16*)(a.ws() + WS_X1);
    const float* mup = a.in(I_MUP) + l * 1760; const float* mun = a.in(I_MUN) + l * 1760; const float* g2 = a.in(I_G2) + (size_t)l * 96 * 512;
    const float* gngp = a.in(I_GNG) + l * 512 + c0; const float* gnbp = a.in(I_GNB) + l * 512 + c0;
    bf16x8 gb[3][4];
#pragma unroll
    for (int ks = 0; ks < 3; ++ks)
#pragma unroll
        for (int nt = 0; nt < 4; ++nt) { v4u w; unsigned t[8];
#pragma unroll
            for (int j = 0; j < 8; ++j) t[j] = f2bf(g2[(size_t)(32 * ks + 8 * g + j) * 512 + 64 * hh + 16 * nt + kl]);
            w.x = t[0] | (t[1] << 16); w.y = t[2] | (t[3] << 16); w.z = t[4] | (t[5] << 16); w.w = t[6] | (t[7] << 16); gb[ks][nt] = __builtin_bit_cast(bf16x8, w); }
    const int nch = (l == 0 ? NTOK : NTX) / 16;
    for (int ch = blockIdx.x; ch < nch; ch += gridDim.x) {
        const int row0 = ch * 16;
        __syncthreads();
        for (int idx = tid; idx < 1536; idx += 512) { const int r = idx / 96, j = idx - r * 96, row = row0 + r; int t, T; if (row < NTX) { t = row & (SEQ - 1); T = SEQ; } else { t = (row - NTX) & (CTXL - 1); T = CTXL; }
            const bf16* p = PX + (size_t)row * DINP + RWOFF + 1664 + j; const int op = t > 0 ? -DINP : 0, on = t + 1 < T ? DINP : 0;
            const float cv = bf2f(p[0]), pv = bf2f(p[op]) * (t > 0 ? 1.f : 0.f), nv = bf2f(p[on]) * (t + 1 < T ? 1.f : 0.f);
            const float z = cv + mup[1664 + j] * (pv - cv) + mun[1664 + j] * (nv - cv); sig[r * 96 + j] = f2bf1(sigmoidf_(z)); }
        const int row = row0 + er; int t, T; if (row < NTX) { t = row & (SEQ - 1); T = SEQ; } else { t = (row - NTX) & (CTXL - 1); T = CTXL; }
        const bf16* pvp = PX + (size_t)row * DINP + RWOFF + 1024 + c0; const int op = t > 0 ? -DINP : 0, on = t + 1 < T ? DINP : 0; const float fp = t > 0 ? 1.f : 0.f, fn = t + 1 < T ? 1.f : 0.f;
        v4u vc[2], vp[2], vn[2]; f32x4 y0[4], y1[4];
#pragma unroll
        for (int i = 0; i < 2; ++i) { vc[i] = *(const GAS v4u*)(pvp + 8 * i); vp[i] = *(const GAS v4u*)(pvp + op + 8 * i); vn[i] = *(const GAS v4u*)(pvp + on + 8 * i); }
#pragma unroll
        for (int i = 0; i < 4; ++i) { y0[i] = *(const GAS f32x4*)(YD + (size_t)row * 512 + c0 + 4 * i); y1[i] = *(const GAS f32x4*)(YD + ((size_t)NTOK + row) * 512 + c0 + 4 * i); }
        const float bon = BON[(size_t)row * 8 + hq] + BON[((size_t)NTOK + row) * 8 + hq];
        __syncthreads();
        { f32x4 acc[4];
#pragma unroll
          for (int nt = 0; nt < 4; ++nt) acc[nt] = (f32x4){0.f, 0.f, 0.f, 0.f};
#pragma unroll
          for (int ks = 0; ks < 3; ++ks) { const bf16x8 af = *(const LAS bf16x8*)(sig + kl * 96 + 32 * ks + 8 * g);
#pragma unroll
              for (int nt = 0; nt < 4; ++nt) acc[nt] = __builtin_amdgcn_mfma_f32_16x16x32_bf16(af, gb[ks][nt], acc[nt], 0, 0, 0); }
#pragma unroll
          for (int nt = 0; nt < 4; ++nt)
#pragma unroll
              for (int j = 0; j < 4; ++j) Gl[(4 * g + j) * 512 + 64 * hh + 16 * nt + kl] = acc[nt][j]; }
        __syncthreads();
        f32x4 y[4]; float s = 0.f;
#pragma unroll
        for (int i = 0; i < 4; ++i) { y[i] = y0[i] + y1[i]; s += (y[i].x + y[i].y) + (y[i].z + y[i].w); }
        s += dppmov<0xB1>(s); s += dppmov<0x4E>(s); const float mean = s * (1.0f / 64.0f); float q = 0.f;
#pragma unroll
        for (int i = 0; i < 4; ++i) { y[i] = y[i] - mean; q += (y[i].x * y[i].x + y[i].y * y[i].y) + (y[i].z * y[i].z + y[i].w * y[i].w); }
        q += dppmov<0xB1>(q); q += dppmov<0x4E>(q); const float rstd = 1.0f / sqrtf(q * (1.0f / 64.0f) + GN_EPS);
        unsigned ow[8];
#pragma unroll
        for (int i = 0; i < 4; ++i) { const unsigned cw0 = vc[i >> 1][(i & 1) * 2], cw1 = vc[i >> 1][(i & 1) * 2 + 1], pw0 = vp[i >> 1][(i & 1) * 2], pw1 = vp[i >> 1][(i & 1) * 2 + 1], nw0 = vn[i >> 1][(i & 1) * 2], nw1 = vn[i >> 1][(i & 1) * 2 + 1];
            const f32x4 cv = {bflo(cw0), bfhi(cw0), bflo(cw1), bfhi(cw1)}, pv = {bflo(pw0) * fp, bfhi(pw0) * fp, bflo(pw1) * fp, bfhi(pw1) * fp}, nv = {bflo(nw0) * fn, bfhi(nw0) * fn, bflo(nw1) * fn, bfhi(nw1) * fn};
            const f32x4 mpv = *(const GAS f32x4*)(mup + 1024 + c0 + 4 * i), mnv = *(const GAS f32x4*)(mun + 1024 + c0 + 4 * i), gng = *(const GAS f32x4*)(gngp + 4 * i), gnb = *(const GAS f32x4*)(gnbp + 4 * i);
            const f32x4 zv = cv + mpv * (pv - cv) + mnv * (nv - cv);
            const f32x4 gt = *(const LAS f32x4*)(Gl + er * 512 + c0 + 4 * i);
            const f32x4 o = (y[i] * rstd * gng + gnb + zv * bon) * gt;
            ow[2 * i] = pk2(o.x, o.y); ow[2 * i + 1] = pk2(o.z, o.w); }
        GAS v4u* dst = (GAS v4u*)(CAT + (size_t)row * DM + 512 + c0); dst[0] = (v4u){ow[0], ow[1], ow[2], ow[3]}; dst[1] = (v4u){ow[4], ow[5], ow[6], ow[7]};
    }
}

__device__ __forceinline__ void phase_ln1_route(LAS unsigned char* lds, int l) {
    const KA a = ka_get();
    const int tid = opaque_tid(), lane = tid & 63, wave = __builtin_amdgcn_readfirstlane(tid >> 6), G = gridDim.x, bid = blockIdx.x;
    const int gw = bid * 8 + wave, NGW = G * 8;
    LAS float* rwt = (LAS float*)lds;
#pragma unroll
    for (int i = tid; i < 8192; i += 512) { const int k = i >> 3, eg = i & 7; const f32x4 w4 = *(const GAS f32x4*)(a.in(I_RW) + k * 32 + 4 * eg);
        rwt[(4 * eg) * 1024 + k] = w4.x; rwt[(4 * eg + 1) * 1024 + k] = w4.y; rwt[(4 * eg + 2) * 1024 + k] = w4.z; rwt[(4 * eg + 3) * 1024 + k] = w4.w; }
    if (tid < 32) ((LAS int*)(lds + LDSCTL_OFF + 1024))[tid] = 0;
    __syncthreads();
    const float* mods = (const float*)(a.ws() + WS_MODS) + (size_t)l * 17 * 6144;
    const bf16* O = (const bf16*)(a.ws() + WS_X3); bf16* HM = (bf16*)(a.ws() + WS_X1);
    const float* xs = l == 0 ? a.in(I_X) : a.out(); const float* cs = l == 0 ? a.in(I_CTX) : (const float*)(a.ws() + WS_CS);
    float* xo = a.out(); float* co = (float*)(a.ws() + WS_CS);
    int* HIST = (int*)(a.ws() + WS_LIST); TokInfo* TOK = (TokInfo*)(a.ws() + WS_TOK); LAS int* lcnt = (LAS int*)(lds + LDSCTL_OFF + 1024);
    const GAS f32x4* lg = (const GAS f32x4*)(a.in(I_LN1G) + l * DM) + lane; const GAS f32x4* lb = (const GAS f32x4*)(a.in(I_LN1B) + l * DM) + lane;
    const int Mrows = l == 0 ? NTOK : NTX;
    const float biasv = a.in(I_RB)[(lane >> 1) & 31];
    f32x4 lgv[4], lbv[4];
#pragma unroll
    for (int j = 0; j < 4; ++j) { lgv[j] = lg[64 * j]; lbv[j] = lb[64 * j]; }
    f32x4 nx[4]; v2u no[4];
#define LN1_FETCH(M) do { const int m_ = (M) < Mrows ? (M) : gw; const float* s_ = m_ < NTX ? xs + (size_t)m_ * DM : cs + (size_t)(m_ - NTX) * DM; \
        const GAS f32x4* xr_ = (const GAS f32x4*)s_ + lane; const GAS v2u* or_ = (const GAS v2u*)(O + (size_t)m_ * DM) + lane; \
        _Pragma("unroll") for (int j_ = 0; j_ < 4; ++j_) { nx[j_] = xr_[64 * j_]; no[j_] = or_[64 * j_]; } } while (0)
    LN1_FETCH(gw);
    for (int m = gw; m < Mrows; m += NGW) {
        float* dst; int mr;
        if (m < NTX) { dst = xo + (size_t)m * DM; mr = m / SEQ; } else { dst = co + (size_t)(m - NTX) * DM; mr = 16; }
        const GAS f32x4* md = (const GAS f32x4*)(mods + (size_t)mr * 6144) + lane;
        f32x4 v[4], sc2[4], sh2[4]; float s = 0.f;
#pragma unroll
        for (int j = 0; j < 4; ++j) { sc2[j] = md[1024 + 64 * j]; sh2[j] = md[768 + 64 * j]; }
#pragma unroll
        for (int j = 0; j < 4; ++j) { const f32x4 x = nx[j], gt = md[512 + 64 * j]; const v2u ow = no[j]; const f32x4 o = {bflo(ow.x), bfhi(ow.x), bflo(ow.y), bfhi(ow.y)};
            v[j] = x * ALPHA + gt * o; s += (v[j].x + v[j].y) + (v[j].z + v[j].w); }
        LN1_FETCH(m + NGW);
        const float mean = wave_sum(s) * (1.f / DM); float s2 = 0.f;
#pragma unroll
        for (int j = 0; j < 4; ++j) { v[j] = v[j] - mean; s2 += (v[j].x * v[j].x + v[j].y * v[j].y) + (v[j].z * v[j].z + v[j].w * v[j].w); }
        const float rstd = 1.f / sqrtf(wave_sum(s2) * (1.f / DM) + LN_EPS);
        float part[32];
#pragma unroll
        for (int e = 0; e < 32; ++e) part[e] = 0.f;
        GAS f32x4* dr = (GAS f32x4*)dst + lane; GAS v2u* hr = (GAS v2u*)(HM + (size_t)m * DM) + lane;
#pragma unroll
        for (int j = 0; j < 4; ++j) { const f32x4 x1 = v[j] * rstd * lgv[j] + lbv[j]; dr[64 * j] = x1;
            const f32x4 hm = x1 * (sc2[j] + 1.0f) + sh2[j]; v2u w; w.x = pk2(hm.x, hm.y); w.y = pk2(hm.z, hm.w); hr[64 * j] = w;
#pragma unroll
            for (int e8 = 0; e8 < 4; ++e8) { f32x4 rw[8]; const unsigned ra = (unsigned)((256 * j + 4 * lane) * 4 + (e8 >> 1) * 65536);
#pragma unroll
                for (int q = 0; q < 8; ++q) asm volatile("ds_read_b128 %0, %1 offset:%2" : "=v"(rw[q]) : "v"(ra), "i"(((e8 & 1) * 8 + q) * 4096));
                asm volatile("s_waitcnt lgkmcnt(0)" : "+v"(rw[0]), "+v"(rw[1]), "+v"(rw[2]), "+v"(rw[3]), "+v"(rw[4]), "+v"(rw[5]), "+v"(rw[6]), "+v"(rw[7]) :: "memory");
#pragma unroll
                for (int q = 0; q < 8; ++q) part[e8 * 8 + q] += hm.x * rw[q].x + hm.y * rw[q].y + hm.z * rw[q].z + hm.w * rw[q].w;
#ifdef PROBE_ROUTER
                { f32x4 rw2[8];
#pragma unroll
                  for (int q = 0; q < 8; ++q) asm volatile("ds_read_b128 %0, %1 offset:%2" : "=v"(rw2[q]) : "v"(ra), "i"(((e8 & 1) * 8 + q) * 4096));
                  asm volatile("s_waitcnt lgkmcnt(0)" : "+v"(rw2[0]), "+v"(rw2[1]), "+v"(rw2[2]), "+v"(rw2[3]), "+v"(rw2[4]), "+v"(rw2[5]), "+v"(rw2[6]), "+v"(rw2[7]) :: "memory");
#pragma unroll
                  for (int q = 0; q < 8; ++q) { float dmy = hm.x * rw2[q].x + hm.y * rw2[q].y + hm.z * rw2[q].z + hm.w * rw2[q].w; asm volatile("" :: "v"(dmy)); } }
#endif
            } }
        float p16[16], p8[8], p4[4], p2[2], p1;
        { const bool up = (lane & 32) != 0;
#pragma unroll
          for (int e = 0; e < 16; ++e) { const float mine = up ? part[16 + e] : part[e], oth = up ? part[e] : part[16 + e]; p16[e] = mine + shx(oth, 32, lane); } }
        { const bool up = (lane & 16) != 0;
#pragma unroll
          for (int e = 0; e < 8; ++e) { const float mine = up ? p16[8 + e] : p16[e], oth = up ? p16[e] : p16[8 + e]; p8[e] = mine + shx(oth, 16, lane); } }
        { const bool up = (lane & 8) != 0;
#pragma unroll
          for (int e = 0; e < 4; ++e) { const float mine = up ? p8[4 + e] : p8[e], oth = up ? p8[e] : p8[4 + e]; p4[e] = mine + dppmov<0x128>(oth); } }
        { const bool up = (lane & 4) != 0;
#pragma unroll
          for (int e = 0; e < 2; ++e) { const float mine = up ? p4[2 + e] : p4[e], oth = up ? p4[e] : p4[2 + e]; p2[e] = mine + shx(oth, 4, lane); } }
        { const bool up = (lane & 2) != 0; const float mine = up ? p2[1] : p2[0], oth = up ? p2[0] : p2[1]; p1 = mine + dppmov<0x4E>(oth); }
        const float logit = p1 + dppmov<0xB1>(p1);
        const float score = sigmoidf_(logit), sel = score + biasv;
        const int gl = lane & ~7;
        const float q0 = shi(sel, gl), q1 = shi(sel, gl + 2), q2 = shi(sel, gl + 4), q3 = shi(sel, gl + 6);
        const float mx = fmaxf(fmaxf(q0, q1), fmaxf(q2, q3));
        float top2;
        { float a0 = q0, a1 = q1, a2 = q2, a3 = q3; float t;
          if (a0 < a1) { t = a0; a0 = a1; a1 = t; } if (a2 < a3) { t = a2; a2 = a3; a3 = t; } if (a0 < a2) { t = a0; a0 = a2; a2 = t; } if (a1 < a3) { t = a1; a1 = a3; a3 = t; } if (a1 < a2) { t = a1; a1 = a2; a2 = t; }
          top2 = a0 + a1; (void)mx; }
        float best = __builtin_bit_cast(float, __builtin_amdgcn_readlane(__builtin_bit_cast(int, top2), 0)); int gidx = 0;
#pragma unroll
        for (int gg = 1; gg < 8; ++gg) { const float sc = __builtin_bit_cast(float, __builtin_amdgcn_readlane(__builtin_bit_cast(int, top2), gg * 8)); if (sc > best) { best = sc; gidx = gg; } }
        const float r0 = shi(sel, gidx * 8), r1 = shi(sel, gidx * 8 + 2), r2 = shi(sel, gidx * 8 + 4), r3 = shi(sel, gidx * 8 + 6);
        int i0 = 0; float b0 = r0; if (r1 > b0) { b0 = r1; i0 = 1; } if (r2 > b0) { b0 = r2; i0 = 2; } if (r3 > b0) { b0 = r3; i0 = 3; }
        int i1 = -1; float b1 = -INFINITY;
        if (i0 != 0 && r0 > b1) { b1 = r0; i1 = 0; } if (i0 != 1 && r1 > b1) { b1 = r1; i1 = 1; } if (i0 != 2 && r2 > b1) { b1 = r2; i1 = 2; } if (i0 != 3 && r3 > b1) { b1 = r3; i1 = 3; }
        const int e0 = gidx * 4 + i0, e1 = gidx * 4 + i1;
        const float s0 = shi(score, 2 * e0), s1 = shi(score, 2 * e1); const float gs = 1.0f / (s0 + s1);
        if (lane == 0) { const int p0 = __hip_atomic_fetch_add(lcnt + e0, 1, __ATOMIC_RELAXED, __HIP_MEMORY_SCOPE_WORKGROUP), p1_ = __hip_atomic_fetch_add(lcnt + e1, 1, __ATOMIC_RELAXED, __HIP_MEMORY_SCOPE_WORKGROUP);
            TokInfo ti; ti.e0 = e0; ti.e1 = e1; ti.p0 = p0; ti.p1 = p1_; ti.g0 = s0 * gs; ti.g1 = s1 * gs; ti.pad0 = 0; ti.pad1 = 0; TOK[m] = ti; }
    }
    __syncthreads();
    if (tid < 32) HIST[bid * 32 + tid] = lcnt[tid];
}

template <bool FULL> __device__ __forceinline__ void moe_tables(LAS unsigned char* lds, int l) {
    const KA a = ka_get(); const int tid = opaque_tid(), G = gridDim.x;
    LAS int* pref = (LAS int*)(lds + PREF_OFF); LAS int* bb = (LAS int*)lds; LAS int* tot = (LAS int*)(lds + 65536);
    const int* HIST = (const int*)(a.ws() + WS_LIST);
    __syncthreads();
    const int e = tid & 31, grp = tid >> 5;
    int loc[16]; int run = 0;
#pragma unroll
    for (int i = 0; i < 16; ++i) { const int b = grp * 16 + i; loc[i] = (b < G) ? HIST[b * 32 + e] : 0; }
#pragma unroll
    for (int i = 0; i < 16; ++i) { const int v = loc[i]; loc[i] = run; run += v; }
    tot[grp * 32 + e] = run;
    __syncthreads();
    int base = 0, total = 0;
#pragma unroll
    for (int q = 0; q < 16; ++q) { const int v = tot[q * 32 + e]; base += (q < grp) ? v : 0; total += v; }
    if (FULL) {
#pragma unroll
        for (int i = 0; i < 16; ++i) bb[(grp * 16 + i) * 32 + e] = base + loc[i]; }
    if (grp == 0) pref[40 + e] = total;
    __syncthreads();
    if (tid == 0) { int acc = 0; for (int k = 0; k < 32; ++k) { pref[k] = acc; acc += (pref[40 + k] + 255) >> 8; } pref[32] = acc; }
    __syncthreads();
}
__device__ __forceinline__ void phase_gather(LAS unsigned char* lds, int l) {
    const KA a = ka_get();
    const int tid = opaque_tid(), lane = tid & 63, wave = __builtin_amdgcn_readfirstlane(tid >> 6), G = gridDim.x, bid = blockIdx.x;
    const int gw = bid * 8 + wave, NGW = G * 8;
    moe_tables<true>(lds, l);
    const LAS int* pref = (const LAS int*)(lds + PREF_OFF); const LAS int* bb = (const LAS int*)lds;
    const bf16* HM = (const bf16*)(a.ws() + WS_X1); bf16* XB = (bf16*)(a.ws() + WS_X2); const TokInfo* TOK = (const TokInfo*)(a.ws() + WS_TOK);
    const int Mrows = l == 0 ? NTOK : NTX;
    for (int m = gw; m < Mrows; m += NGW) {
        const TokInfo ti = TOK[m]; const int blk = (m % NGW) >> 3;
        const int sl0 = pref[ti.e0] * 256 + bb[blk * 32 + ti.e0] + ti.p0, sl1 = pref[ti.e1] * 256 + bb[blk * 32 + ti.e1] + ti.p1;
        const GAS v4u* srcp = (const GAS v4u*)(HM + (size_t)m * DM) + lane; const v4u v0 = srcp[0], v1 = srcp[64];
        GAS v4u* d0 = (GAS v4u*)(XB + (size_t)sl0 * DM) + lane; GAS v4u* d1 = (GAS v4u*)(XB + (size_t)sl1 * DM) + lane;
        d0[0] = v0; d0[64] = v1; d1[0] = v0; d1[64] = v1;
    }
    for (int e = 0; e < 32; ++e) {
        const int c = pref[40 + e], npad = ((c + 255) & ~255) - c, r0 = pref[e] * 256 + c;
        for (int r = gw; r < npad; r += NGW) { GAS v4u* dst = (GAS v4u*)(XB + (size_t)(r0 + r) * DM) + lane; dst[0] = (v4u){0u, 0u, 0u, 0u}; dst[64] = (v4u){0u, 0u, 0u, 0u}; }
    }
}

__device__ __forceinline__ void phase_ln2(LAS unsigned char* lds, int l) {
    const KA a = ka_get();
    const int tid = opaque_tid(), lane = tid & 63, wave = __builtin_amdgcn_readfirstlane(tid >> 6), G = gridDim.x, bid = blockIdx.x;
    const int gw = bid * 8 + wave, NGW = G * 8;
    moe_tables<true>(lds, l);
    const LAS int* pref = (const LAS int*)(lds + PREF_OFF); const LAS int* bb = (const LAS int*)lds;
    const float* mods = (const float*)(a.ws() + WS_MODS) + (size_t)l * 17 * 6144;
    const bf16* Y = (const bf16*)(a.ws() + WS_X2); const TokInfo* TOK = (const TokInfo*)(a.ws() + WS_TOK);
    float* xo = a.out(); float* co = (float*)(a.ws() + WS_CS);
    const GAS f32x4* lg = (const GAS f32x4*)(a.in(I_LN2G) + l * DM) + lane; const GAS f32x4* lb = (const GAS f32x4*)(a.in(I_LN2B) + l * DM) + lane;
    const int Mrows = l == 0 ? NTOK : NTX;
    f32x4 lgv[4], lbv[4];
#pragma unroll
    for (int j = 0; j < 4; ++j) { lgv[j] = lg[64 * j]; lbv[j] = lb[64 * j]; }
    TokInfo tnext = TOK[gw < Mrows ? gw : 0];
    for (int m = gw; m < Mrows; m += NGW) {
        float* xr_; int mr;
        if (m < NTX) { xr_ = xo + (size_t)m * DM; mr = m / SEQ; } else { xr_ = co + (size_t)(m - NTX) * DM; mr = 16; }
        const TokInfo ti = tnext; tnext = TOK[(m + NGW) < Mrows ? (m + NGW) : m]; const int blk = (m % NGW) >> 3;
        const int sl0 = pref[ti.e0] * 256 + bb[blk * 32 + ti.e0] + ti.p0, sl1 = pref[ti.e1] * 256 + bb[blk * 32 + ti.e1] + ti.p1;
        GAS f32x4* xr = (GAS f32x4*)xr_ + lane; const GAS f32x4* md = (const GAS f32x4*)(mods + (size_t)mr * 6144) + lane;
        const GAS v2u* y0 = (const GAS v2u*)(Y + (size_t)sl0 * DM) + lane; const GAS v2u* y1 = (const GAS v2u*)(Y + (size_t)sl1 * DM) + lane;
        f32x4 v[4], msc[4], msh[4]; float s = 0.f;
        if (l == 0) { const GAS f32x4* mn = (const GAS f32x4*)(mods + (size_t)17 * 6144 + (size_t)mr * 6144) + lane;
#pragma unroll
            for (int j = 0; j < 4; ++j) { msc[j] = mn[256 + 64 * j]; msh[j] = mn[64 * j]; } }
#pragma unroll
        for (int j = 0; j < 4; ++j) { const f32x4 x = xr[64 * j], gt = md[1280 + 64 * j]; const v2u a0 = y0[64 * j], a1 = y1[64 * j];
            const f32x4 ya = {bflo(a0.x), bfhi(a0.x), bflo(a0.y), bfhi(a0.y)}, yb = {bflo(a1.x), bfhi(a1.x), bflo(a1.y), bfhi(a1.y)};
            v[j] = x * ALPHA + gt * (ya * ti.g0 + yb * ti.g1); s += (v[j].x + v[j].y) + (v[j].z + v[j].w); }
        const float mean = wave_sum(s) * (1.f / DM); float s2 = 0.f;
#pragma unroll
        for (int j = 0; j < 4; ++j) { v[j] = v[j] - mean; s2 += (v[j].x * v[j].x + v[j].y * v[j].y) + (v[j].z * v[j].z + v[j].w * v[j].w); }
        const float rstd = 1.f / sqrtf(wave_sum(s2) * (1.f / DM) + LN_EPS);
        if (l == 0) {
            GAS v2u* o8 = (GAS v2u*)((bf16*)(a.ws() + WS_X1) + (size_t)m * DM) + lane;
#pragma unroll
            for (int j = 0; j < 4; ++j) { const f32x4 xn = v[j] * rstd * lgv[j] + lbv[j]; xr[64 * j] = xn; const f32x4 r = xn * (msc[j] + 1.0f) + msh[j]; v2u w; w.x = pk2(r.x, r.y); w.y = pk2(r.z, r.w); o8[64 * j] = w; }
        } else {
#pragma unroll
            for (int j = 0; j < 4; ++j) xr[64 * j] = v[j] * rstd * lgv[j] + lbv[j];
        }
    }
}
namespace csc {
constexpr int ARR = 0;
constexpr int RAW = 0;
constexpr int ZL = 34816;
constexpr int WLO = 57344;
constexpr int FR = 58368;
constexpr int AABT = 87040;
constexpr int LWO = 91136;
constexpr int AAO = 107520;
__device__ __forceinline__ int sw16(int row, int chunk) { return row * 128 + ((chunk ^ (row & 7)) << 4); }
__device__ __forceinline__ v2u cvt4(const f32x4 v) { v2u r; r.x = pk2(v[0], v[1]); r.y = pk2(v[2], v[3]); return r; }
__device__ __forceinline__ bf16x8 mk8(v2u lo, v2u hi) { v4u w; w.x = lo.x; w.y = lo.y; w.z = hi.x; w.w = hi.y; return __builtin_bit_cast(bf16x8, w); }
__device__ __forceinline__ v2u trd(const LAS unsigned char* p) { return __builtin_bit_cast(v2u, __builtin_amdgcn_ds_read_tr16_b64_v4i16((LAS v4i16_t*)p)); }
__device__ __forceinline__ int opq(int v) { asm volatile("" : "+v"(v)); return v; }
__device__ __forceinline__ int opqs(int v) { asm volatile("" : "+s"(v)); return v; }
}
namespace bgc {
constexpr int CBUF = LDSCTL_OFF + 4096, CPITCH = 80, NITEMS = NEXP * 1536;
struct Item { const float* src; bf16* dst; int N, ld; };
__device__ __forceinline__ Item decode(const KA& a, int l, int item) {
    const int e = item / 1536; int r = item - e * 1536; const int m = r >> 9, t = r & 511; const size_t eo = ((size_t)l * NEXP + e) * (size_t)DM * DEXP; Item it;
    if (m < 2) { const int kt = t >> 4, nt = t & 15, j0 = 32 * nt; it.N = DEXP; it.ld = 1024; it.src = (m ? a.in(I_EW3) : a.in(I_EW1)) + eo + (size_t)(32 * kt) * DEXP + j0;
        it.dst = (bf16*)(a.ws() + WS_W13T) + (size_t)e * 1024 * 1024 + (size_t)(256 * (j0 >> 7) + 128 * m + (j0 & 127)) * 1024 + 32 * kt; }
    else { const int kt = t >> 5, nt = t & 31; it.N = DM; it.ld = 512; it.src = a.in(I_EW2) + eo + (size_t)(32 * kt) * DM + 32 * nt; it.dst = (bf16*)(a.ws() + WS_W2T) + (size_t)e * 1024 * 512 + (size_t)(32 * nt) * 512 + 32 * kt; }
    return it; }
__device__ __forceinline__ void issue(const KA& a, int l, int item, int lane, f32x4 (&cv)[4]) { const Item it = decode(a, l, item);
#pragma unroll
    for (int i = 0; i < 4; ++i) cv[i] = *(const GAS f32x4*)(it.src + (size_t)((lane >> 3) + 8 * i) * it.N + (lane & 7) * 4); }
__device__ __forceinline__ void finish(const KA& a, int l, int item, int lane, int slot, LAS unsigned char* lds, const f32x4 (&cv)[4]) { const Item it = decode(a, l, item);
    LAS unsigned char* buf = lds + CBUF + slot * (32 * CPITCH);
#pragma unroll
    for (int i = 0; i < 4; ++i)
#pragma unroll
        for (int u = 0; u < 4; ++u) *(LAS bf16*)(buf + ((lane & 7) * 4 + u) * CPITCH + ((lane >> 3) + 8 * i) * 2) = f2bf1(cv[i][u]);
    LDS_WAIT(); asm volatile("" ::: "memory");
    const int n = lane >> 1, hf = lane & 1; const v4u w0 = *(const LAS v4u*)(buf + n * CPITCH + hf * 32), w1 = *(const LAS v4u*)(buf + n * CPITCH + hf * 32 + 16);
    GAS v4u* d = (GAS v4u*)(it.dst + (size_t)n * it.ld + 16 * hf); d[0] = w0; d[1] = w1;
    LDS_WAIT(); asm volatile("" ::: "memory"); }
}
#ifndef SCAN_PROBE
#define SCAN_PROBE 0
#endif
#define REPK(k) for (int rep_ = 0; rep_ < ((SCAN_PROBE == (k)) ? 2 : 1); ++rep_)
__device__ __forceinline__ void phase_scan(LAS unsigned char* lds, int l) {
    using namespace csc;
    const KA a = ka_get();
    const int tid = opaque_tid(), lane0 = tid & 63, wv = __builtin_amdgcn_readfirstlane(tid >> 6);
    const bf16* PX = (const bf16*)(a.ws() + WS_X2); float* YD = (float*)(a.ws() + WS_X3); float* BON = (float*)(a.ws() + WS_BONUS);
    const float* mup = a.in(I_MUP) + l * 1760; const float* mun = a.in(I_MUN) + l * 1760;
    const f32x4 Z4 = {0.f, 0.f, 0.f, 0.f}; const v2u Z2 = {0u, 0u};
    for (int chain = blockIdx.x; chain < 256; chain += gridDim.x) {
        const int b = chain >> 4, h = (chain >> 1) & 7, d = chain & 1; const int c0_ = opq(lane0);
        float kkc[2], kac[2], rkc[2], mur[2][2], muk[2][2], muv[2][2], mul[2][2], ropef[2]; bf16x8 w2f[2], a2f[2]; float w0c[2], a0c[2];
        { const int ln = c0_, kl = ln & 15, g = ln >> 4, cp = ln & 31;
#pragma unroll
          for (int u = 0; u < 2; ++u) { const int c = 2 * cp + u; ropef[u] = exp2f(-(float)(c & 15) * (13.287712379549449f / 16.0f));
            kkc[u] = a.in(I_KK)[l * 512 + h * 64 + c]; kac[u] = a.in(I_KA)[l * 512 + h * 64 + c]; rkc[u] = a.in(I_RK)[l * 512 + h * 64 + c];
            const int colr = h * 64 + c, coll = (c < 32) ? (1536 + d * 32 + c) : (1600 + d * 32 + (c - 32));
            mur[u][0] = d ? mun[colr] : mup[colr]; mur[u][1] = d ? mup[colr] : mun[colr]; muk[u][0] = d ? mun[512 + colr] : mup[512 + colr]; muk[u][1] = d ? mup[512 + colr] : mun[512 + colr];
            muv[u][0] = d ? mun[1024 + colr] : mup[1024 + colr]; muv[u][1] = d ? mup[1024 + colr] : mun[1024 + colr]; mul[u][0] = d ? mun[coll] : mup[coll]; mul[u][1] = d ? mup[coll] : mun[coll]; }
#pragma unroll
        for (int i = 0; i < 2; ++i) { const int cc = h * 64 + 16 * ((wv >> 2) * 2 + i) + kl; unsigned t[8], u[8];
#pragma unroll
            for (int j = 0; j < 8; ++j) { t[j] = f2bf(a.in(I_W2)[((size_t)(l * 2 + d) * 32 + 8 * g + j) * 512 + cc]); u[j] = f2bf(a.in(I_A2)[((size_t)(l * 2 + d) * 32 + 8 * g + j) * 512 + cc]); }
            w2f[i] = __builtin_bit_cast(bf16x8, (v4u){t[0] | (t[1] << 16), t[2] | (t[3] << 16), t[4] | (t[5] << 16), t[6] | (t[7] << 16)});
            a2f[i] = __builtin_bit_cast(bf16x8, (v4u){u[0] | (u[1] << 16), u[2] | (u[3] << 16), u[4] | (u[5] << 16), u[6] | (u[7] << 16)});
            w0c[i] = a.in(I_W0)[(l * 2 + d) * 512 + cc]; a0c[i] = a.in(I_A0)[(l * 2 + d) * 512 + cc]; } }
        f32x4 St[4] = {Z4, Z4, Z4, Z4};
        f32x4 cvt_[4] = {Z4, Z4, Z4, Z4}; int cit = blockIdx.x * 8 + wv, cpend = -1; const int cstride = gridDim.x * 8;
#define BGC_WINDOW() do { const int ln_ = opq(lane0); if (cpend >= 0) bgc::finish(a, l, cpend, ln_, wv & 3, lds, cvt_); if (cit < bgc::NITEMS) { bgc::issue(a, l, cit, ln_, cvt_); cpend = cit; cit += cstride; } else cpend = -1; } while (0)
        for (int seq = 0; seq < 2; ++seq) {
            const int T = seq ? SEQ : CTXL, rowbase = seq ? b * SEQ : NTX + b * CTXL, ngrp = T / 64;
            v4u pre[5];
#define CSC_PREFETCH(GRP) do { const int s0_ = (GRP) * 64; const int tlo_ = d ? (T - 64 - s0_) : s0_; \
                _Pragma("unroll") for (int i_ = 0; i_ < 5; ++i_) { const int id_ = opq(tid) + 512 * i_; const int rr_ = id_ >> 5, ch_ = id_ & 31; const int t_ = tlo_ - 1 + rr_; \
                    const int col_ = RWOFF + (ch_ < 24 ? (ch_ >> 3) * 512 + h * 64 + (ch_ & 7) * 8 : (ch_ < 28 ? 1536 + d * 32 + (ch_ - 24) * 8 : 1600 + d * 32 + (ch_ - 28) * 8)); \
                    const bool ok_ = (id_ < 66 * 32) && t_ >= 0 && t_ < T; const int tc_ = ok_ ? t_ : 0; \
                    const v4u v_ = *(const GAS v4u*)(PX + (size_t)(rowbase + tc_) * DINP + col_); pre[i_] = ok_ ? v_ : (v4u){0u, 0u, 0u, 0u}; } } while (0)
            CSC_PREFETCH(0);
            for (int grp = 0; grp < ngrp; ++grp) {
                const int s0 = grp * 64;
                int lane = opq(lane0); int c = lane, kl = lane & 15, g = lane >> 4, q_ = kl >> 2, p_ = kl & 3; (void)q_; (void)p_;
#pragma unroll
                for (int i = 0; i < 5; ++i) { const int id = opq(tid) + 512 * i; if (id < 66 * 32) *(LAS v4u*)(lds + RAW + id * 16) = pre[i]; }
                __syncthreads();
                int sl = opqs(wv);
                float Rk[4][2], Rq[4][2], Rr[4][2], Rv[4][2];
                REPK(1) { const int cp = lane & 31, sh = lane >> 5, sb = 8 * sl + 4 * sh; const int rbase = d ? 64 - sb : sb + 1, rdir = d ? -256 : 256;
                  const LAS bf16* p0 = (const LAS bf16*)(lds + RAW) + (rbase * 256 + 2 * cp) - rdir;
                  float pr[6][2], pk[6][2], pv[6][2], pl[6][2];
#pragma unroll
                  for (int j = 0; j < 6; ++j) { const LAS unsigned* p = (const LAS unsigned*)(p0 + j * rdir); const unsigned wr = p[0], wk = p[32], wv_ = p[64], wl = p[96];
                      pr[j][0] = bflo(wr); pr[j][1] = bfhi(wr); pk[j][0] = bflo(wk); pk[j][1] = bfhi(wk); pv[j][0] = bflo(wv_); pv[j][1] = bfhi(wv_); pl[j][0] = bflo(wl); pl[j][1] = bfhi(wl); }
                  const int qd = cp >> 3;
#pragma unroll
                  for (int i = 0; i < 4; ++i) { const int sloc = sb + i; float r[2], k[2], zz[2];
#pragma unroll
                      for (int u = 0; u < 2; ++u) { r[u] = pr[i + 1][u] + mur[u][0] * (pr[i][u] - pr[i + 1][u]) + mur[u][1] * (pr[i + 2][u] - pr[i + 1][u]); k[u] = pk[i + 1][u] + muk[u][0] * (pk[i][u] - pk[i + 1][u]) + muk[u][1] * (pk[i + 2][u] - pk[i + 1][u]);
                          Rv[i][u] = pv[i + 1][u] + muv[u][0] * (pv[i][u] - pv[i + 1][u]) + muv[u][1] * (pv[i + 2][u] - pv[i + 1][u]);
                          const float z = pl[i + 1][u] + mul[u][0] * (pl[i][u] - pl[i + 1][u]) + mul[u][1] * (pl[i + 2][u] - pl[i + 1][u]);
                          const float th = 1.0f - 2.0f * __builtin_amdgcn_rcpf(1.0f + __expf(2.0f * z)); zz[u] = cp < 16 ? th : z; }
                      ((LAS unsigned*)(lds + ZL))[sloc * 32 + cp] = pk2(zz[0], zz[1]);
                      if (seq) { const int t = d ? (T - 1 - (s0 + sloc)) : (s0 + sloc); const float pos = (float)((qd < 2) ? (t >> 6) : (t & 63));
#pragma unroll
                          for (int u = 0; u < 2; ++u) { const float rp = dppmov<0x128>(r[u]), kp = dppmov<0x128>(k[u]); const float ang = pos * ropef[u]; const float cs = __cosf(ang), sn = __sinf(ang);
                              const float sg = (qd & 1) ? sn : -sn; r[u] = r[u] * cs + rp * sg; k[u] = k[u] * cs + kp * sg; } }
                      const float k0 = k[0] * kkc[0], k1 = k[1] * kkc[1]; float ss = k0 * k0 + k1 * k1;
                      ss += dppmov<0xB1>(ss); ss += dppmov<0x4E>(ss); ss += dppmov<0x141>(ss); ss += dppmov<0x140>(ss);
                      { const int iv = __builtin_bit_cast(int, ss); const float a0 = __builtin_bit_cast(float, __builtin_amdgcn_readlane(iv, 0)) + __builtin_bit_cast(float, __builtin_amdgcn_readlane(iv, 16)), a1 = __builtin_bit_cast(float, __builtin_amdgcn_readlane(iv, 32)) + __builtin_bit_cast(float, __builtin_amdgcn_readlane(iv, 48)); ss = sh ? a1 : a0; }
                      const float rn = __builtin_amdgcn_rsqf(fmaxf(ss, 1e-24f));
                      Rk[i][0] = k0 * rn; Rk[i][1] = k1 * rn; Rq[i][0] = k[0]; Rq[i][1] = k[1]; Rr[i][0] = r[0]; Rr[i][1] = r[1]; } }
                __syncthreads();
                lane = opq(lane0); c = lane; kl = lane & 15; g = lane >> 4; q_ = kl >> 2; p_ = kl & 3;
                REPK(2) { const int wq = opqs(wv); const int st = wq & 3; const LAS unsigned char* zrow = lds + ZL + (16 * st + kl) * 128;
                  const bf16x8 zw = *(const LAS bf16x8*)(zrow + 16 * g), za = *(const LAS bf16x8*)(zrow + 64 + 16 * g);
#pragma unroll
                  for (int i = 0; i < 2; ++i) { const int cc = 16 * ((wq >> 2) * 2 + i) + kl;
                      const f32x4 uw = __builtin_amdgcn_mfma_f32_16x16x32_bf16(zw, w2f[i], Z4, 0, 0, 0), ua = __builtin_amdgcn_mfma_f32_16x16x32_bf16(za, a2f[i], Z4, 0, 0, 0);
#pragma unroll
                      for (int j = 0; j < 4; ++j) { const int srow = 16 * st + 4 * g + j;
                          ((LAS float*)(lds + LWO))[srow * 64 + cc] = -0.6065306597126334f * __builtin_amdgcn_rcpf(1.0f + __expf(-(uw[j] + w0c[i]))); ((LAS float*)(lds + AAO))[srow * 64 + cc] = __builtin_amdgcn_rcpf(1.0f + __expf(-(ua[j] + a0c[i]))); } } }
                __syncthreads();
                lane = opq(lane0); c = lane; kl = lane & 15; g = lane >> 4; q_ = kl >> 2; p_ = kl & 3;
                sl = opqs(wv);
                REPK(4) { const int cp = lane & 31, sh = lane >> 5, q = sl >> 1, hf = sl & 1; typedef float f32x2_ __attribute__((ext_vector_type(2)));
                  const LAS f32x2_* lwp = (const LAS f32x2_*)((const LAS float*)(lds + LWO) + (16 * q) * 64 + 2 * cp); const LAS f32x2_* aap = (const LAS f32x2_*)((const LAS float*)(lds + AAO) + (8 * sl + 4 * sh) * 64 + 2 * cp);
                  f32x2_ qs[4];
#pragma unroll
                  for (int j = 0; j < 4; ++j) { qs[j] = lwp[(4 * j) * 32] + lwp[(4 * j + 1) * 32] + lwp[(4 * j + 2) * 32] + lwp[(4 * j + 3) * 32]; }
                  const f32x2_ cL = (qs[0] + qs[1]) + (qs[2] + qs[3]); const int part = 2 * hf + sh;
                  f32x2_ run = part == 0 ? (f32x2_){0.f, 0.f} : (part == 1 ? qs[0] : (part == 2 ? qs[0] + qs[1] : qs[0] + qs[1] + qs[2]));
                  const float wl0 = __expf(cL.x), wl1 = __expf(cL.y);
                  if (part == 3) ((LAS f32x2_*)(lds + WLO))[q * 32 + cp] = (f32x2_){wl0, wl1};
#pragma unroll
                  for (int i = 0; i < 4; ++i) { const int sloc = 8 * sl + 4 * sh + i, s = 4 * part + i; const f32x2_ lwi = lwp[s * 32]; const f32x2_ cprev = run; run = run + lwi; const f32x2_ aa = aap[i * 32];
                      const float kd0 = Rq[i][0] * (1.0f + (aa.x - 1.0f) * kac[0]), kd1 = Rq[i][1] * (1.0f + (aa.y - 1.0f) * kac[1]), nb0 = -Rk[i][0] * aa.x, nb1 = -Rk[i][1] * aa.y;
                      float bon = Rr[i][0] * kd0 * rkc[0] + Rr[i][1] * kd1 * rkc[1];
                      bon += dppmov<0xB1>(bon); bon += dppmov<0x4E>(bon); bon += dppmov<0x141>(bon); bon += dppmov<0x140>(bon);
                      { const int iv = __builtin_bit_cast(int, bon); const float a0 = __builtin_bit_cast(float, __builtin_amdgcn_readlane(iv, 0)) + __builtin_bit_cast(float, __builtin_amdgcn_readlane(iv, 16)), a1 = __builtin_bit_cast(float, __builtin_amdgcn_readlane(iv, 32)) + __builtin_bit_cast(float, __builtin_amdgcn_readlane(iv, 48)); bon = sh ? a1 : a0; }
                      if (cp == 0) { const int t = d ? (T - 1 - (s0 + sloc)) : (s0 + sloc); BON[((size_t)d * NTOK + rowbase + t) * 8 + h] = bon; }
                      const float e1x = __expf(cprev.x), e1y = __expf(cprev.y), e2x = __expf(-run.x), e2y = __expf(-run.y), e3x = __builtin_amdgcn_rcpf(e2x), e3y = __builtin_amdgcn_rcpf(e2y);
                      LAS unsigned char* base = lds + ARR + q * (7 * 2048) + sw16(s, cp >> 2) + (cp & 3) * 4;
                      *(LAS unsigned*)(base) = pk2(Rk[i][0] * e1x, Rk[i][1] * e1y); *(LAS unsigned*)(base + 2048) = pk2(nb0 * e2x, nb1 * e2y); *(LAS unsigned*)(base + 4096) = pk2(kd0 * e2x, kd1 * e2y); *(LAS unsigned*)(base + 6144) = pk2(Rr[i][0] * e3x, Rr[i][1] * e3y);
                      *(LAS unsigned*)(base + 12288) = pk2(Rv[i][0], Rv[i][1]); } }
                __syncthreads();
                lane = opq(lane0); c = lane; kl = lane & 15; g = lane >> 4; q_ = kl >> 2; p_ = kl & 3;
                if (grp + 1 < ngrp) CSC_PREFETCH(grp + 1);
                if (wv < 4) BGC_WINDOW();
                REPK(5) if (wv >= 4) { const int q = opqs(wv) - 4; const LAS unsigned char* A0 = lds + ARR + q * (7 * 2048);
                    bf16x8 at[2], bt[2], kt[2], rt[2];
#pragma unroll
                    for (int ks = 0; ks < 2; ++ks) { const int o = sw16(kl, ks * 4 + g); at[ks] = *(const LAS bf16x8*)(A0 + o); bt[ks] = *(const LAS bf16x8*)(A0 + 2048 + o); kt[ks] = *(const LAS bf16x8*)(A0 + 4096 + o); rt[ks] = *(const LAS bf16x8*)(A0 + 6144 + o); }
                    f32x4 ABt = Z4, AKt = Z4, RBt = Z4, RKt = Z4;
#pragma unroll
                    for (int ks = 0; ks < 2; ++ks) { ABt = __builtin_amdgcn_mfma_f32_16x16x32_bf16(bt[ks], at[ks], ABt, 0, 0, 0); AKt = __builtin_amdgcn_mfma_f32_16x16x32_bf16(kt[ks], at[ks], AKt, 0, 0, 0);
                        RBt = __builtin_amdgcn_mfma_f32_16x16x32_bf16(bt[ks], rt[ks], RBt, 0, 0, 0); RKt = __builtin_amdgcn_mfma_f32_16x16x32_bf16(kt[ks], rt[ks], RKt, 0, 0, 0); }
#pragma unroll
                    for (int j = 0; j < 4; ++j) { const int jj = 4 * g + j; ABt[j] = jj < kl ? ABt[j] : 0.f; AKt[j] = jj < kl ? AKt[j] : 0.f; RBt[j] = jj <= kl ? RBt[j] : 0.f; RKt[j] = jj <= kl ? RKt[j] : 0.f; }
                    float Tr[16]; const float ab0 = ABt[0], ab1 = ABt[1], ab2 = ABt[2], ab3 = ABt[3];
                    const int abi[4] = {__builtin_bit_cast(int, ab0), __builtin_bit_cast(int, ab1), __builtin_bit_cast(int, ab2), __builtin_bit_cast(int, ab3)};
#pragma unroll
                    for (int i = 0; i < 16; ++i) Tr[i] = (i == kl) ? 1.f : 0.f;
#pragma unroll
                    for (int j = 14; j >= 0; --j) { float acc = 0.f;
#pragma unroll
                        for (int i = j + 1; i < 16; ++i) acc += Tr[i] * __builtin_bit_cast(float, __builtin_amdgcn_readlane(abi[j & 3], i + 16 * (j >> 2)));
                        Tr[j] = (j < kl) ? acc : Tr[j]; }
                    float tsel[4];
#pragma unroll
                    for (int e = 0; e < 4; ++e) tsel[e] = g == 0 ? Tr[e] : (g == 1 ? Tr[4 + e] : (g == 2 ? Tr[8 + e] : Tr[12 + e]));
                    v2u tf2; tf2.x = pk2(tsel[0], tsel[1]); tf2.y = pk2(tsel[2], tsel[3]);
                    const bf16x8 Tf = mk8(tf2, Z2), RBf = mk8(cvt4(RBt), Z2);
                    f32x4 AhT[4], QhT[4];
#pragma unroll
                    for (int ct = 0; ct < 4; ++ct) {
                        const bf16x8 Alo = mk8(trd(A0 + sw16(4 * g + q_, 2 * ct + (p_ >> 1)) + (p_ & 1) * 8), Z2);
                        AhT[ct] = __builtin_amdgcn_mfma_f32_16x16x32_bf16(Alo, Tf, Z4, 0, 0, 0);
                        const f32x4 Ah = __builtin_amdgcn_mfma_f32_16x16x32_bf16(Tf, Alo, Z4, 0, 0, 0);
                        const v2u rw = *(const LAS v2u*)(A0 + 6144 + sw16(kl, 2 * ct + (g >> 1)) + (g & 1) * 8);
                        const f32x4 rinit = {bflo(rw.x), bfhi(rw.x), bflo(rw.y), bfhi(rw.y)};
                        QhT[ct] = __builtin_amdgcn_mfma_f32_16x16x32_bf16(mk8(cvt4(Ah), Z2), RBf, rinit, 0, 0, 0); }
                    LAS unsigned char* fr = lds + FR + q * 7168 + lane * 16;
                    *(LAS bf16x8*)(fr) = mk8(cvt4(AhT[0]), cvt4(AhT[1])); *(LAS bf16x8*)(fr + 1024) = mk8(cvt4(AhT[2]), cvt4(AhT[3]));
                    *(LAS bf16x8*)(fr + 2048) = mk8(cvt4(QhT[0]), cvt4(QhT[1])); *(LAS bf16x8*)(fr + 3072) = mk8(cvt4(QhT[2]), cvt4(QhT[3]));
                    *(LAS bf16x8*)(fr + 4096) = mk8(cvt4(AKt), Z2); *(LAS bf16x8*)(fr + 5120) = mk8(cvt4(RBt), cvt4(RKt)); *(LAS bf16x8*)(fr + 6144) = Tf;
                }
                __syncthreads();
                lane = opq(lane0); c = lane; kl = lane & 15; g = lane >> 4; q_ = kl >> 2; p_ = kl & 3;
                if (wv >= 4) BGC_WINDOW();
                if (wv < 4) { const int vt = opqs(wv);
                    f32x4 Uh[4], Yh[4]; v2u vtrs[4];
#pragma unroll
                    for (int q = 0; q < 4; ++q) { const LAS unsigned char* A0 = lds + ARR + q * (7 * 2048); const LAS unsigned char* fr = lds + FR + q * 7168 + lane * 16;
                        const bf16x8 AKf = *(const LAS bf16x8*)(fr + 4096), RBRK = *(const LAS bf16x8*)(fr + 5120), Tf = *(const LAS bf16x8*)(fr + 6144);
                        vtrs[q] = trd(A0 + 12288 + sw16(4 * g + q_, 2 * vt + (p_ >> 1)) + (p_ & 1) * 8);
                        const f32x4 X1 = __builtin_amdgcn_mfma_f32_16x16x32_bf16(AKf, mk8(vtrs[q], Z2), Z4, 0, 0, 0);
                        Uh[q] = __builtin_amdgcn_mfma_f32_16x16x32_bf16(Tf, mk8(cvt4(X1), Z2), Z4, 0, 0, 0);
                        Yh[q] = __builtin_amdgcn_mfma_f32_16x16x32_bf16(RBRK, mk8(cvt4(Uh[q]), vtrs[q]), Z4, 0, 0, 0); }
#pragma unroll
                    for (int q = 0; q < 4; ++q) { const LAS unsigned char* A0 = lds + ARR + q * (7 * 2048); const LAS unsigned char* fr = lds + FR + q * 7168 + lane * 16;
                        const bf16x8 Ap0 = *(const LAS bf16x8*)(fr), Ap1 = *(const LAS bf16x8*)(fr + 1024), Qp0 = *(const LAS bf16x8*)(fr + 2048), Qp1 = *(const LAS bf16x8*)(fr + 3072);
                        bf16x8 bk[4]; f32x4 wl[4];
#pragma unroll
                        for (int ct = 0; ct < 4; ++ct) { wl[ct] = *(const LAS f32x4*)(lds + WLO + (q * 64 + 16 * ct + 4 * g) * 4); const int o = sw16(4 * g + q_, 2 * ct + (p_ >> 1)) + (p_ & 1) * 8; bk[ct] = mk8(trd(A0 + 2048 + o), trd(A0 + 4096 + o)); }
                        const bf16x8 bs0 = mk8(cvt4(St[0]), cvt4(St[1])), bs1 = mk8(cvt4(St[2]), cvt4(St[3]));
                        f32x4 U = __builtin_amdgcn_mfma_f32_16x16x32_bf16(Ap0, bs0, Uh[q], 0, 0, 0); U = __builtin_amdgcn_mfma_f32_16x16x32_bf16(Ap1, bs1, U, 0, 0, 0);
                        f32x4 Y = __builtin_amdgcn_mfma_f32_16x16x32_bf16(Qp0, bs0, Yh[q], 0, 0, 0); Y = __builtin_amdgcn_mfma_f32_16x16x32_bf16(Qp1, bs1, Y, 0, 0, 0);
                        const bf16x8 UV = mk8(cvt4(U), vtrs[q]);
#pragma unroll
                        for (int ct = 0; ct < 4; ++ct) St[ct] = __builtin_amdgcn_mfma_f32_16x16x32_bf16(bk[ct], UV, St[ct], 0, 0, 0) * wl[ct];
#pragma unroll
                        for (int j = 0; j < 4; ++j) { const int sg = s0 + 16 * q + 4 * g + j; const int t = d ? (T - 1 - sg) : sg; YD[((size_t)d * NTOK + rowbase + t) * 512 + h * 64 + 16 * vt + kl] = Y[j]; }
                    }
                }
                __syncthreads();
            }
#undef CSC_PREFETCH
        }
        if (cpend >= 0) { bgc::finish(a, l, cpend, opq(lane0), wv & 3, lds, cvt_); cpend = -1; }
        for (; cit < bgc::NITEMS; cit += cstride) { bgc::issue(a, l, cit, opq(lane0), cvt_); bgc::finish(a, l, cit, opq(lane0), wv & 3, lds, cvt_); }
#undef BGC_WINDOW
    }
}
constexpr int PH_PER_LAYER = 11, N_PHASES = 1 + 2 * PH_PER_LAYER;
template <int K> __device__ __forceinline__ void run_phase(LAS unsigned char* lds, int l) {
    if constexpr (K == 0) phase_prologue(lds);
    if constexpr (K == 1) phase_modconv(lds, l);
    if constexpr (K == 3) phase_scan(lds, l);
    if constexpr (K == 4) phase_attn(lds, l);
    if constexpr (K == 5) phase_rwpost(lds, l);
    if constexpr (K == 7) phase_ln1_route(lds, l);
    if constexpr (K == 8) phase_gather(lds, l);
    if constexpr (K == 11) phase_ln2(lds, l);
    if constexpr (K == 2 || K == 6 || K == 9 || K == 10) {
        const KA a = ka_get(); unsigned char* ws = a.ws(); const int G = gridDim.x, bid = blockIdx.x;
        bf16* X1 = (bf16*)(ws + WS_X1); bf16* X2 = (bf16*)(ws + WS_X2); bf16* X3 = (bf16*)(ws + WS_X3);
        if constexpr (K == 2) { __syncthreads();
            pg8::Gemm g{X1, (const bf16*)(ws + WS_WINT) + (size_t)l * DINP * DM, NTOK, DINP, DM}; pg8::StaticOrder S; S.init(NTOK, DINP, G, bid);
            pg8::EpiBf16 E{X2, DINP}; pg8::gemm_phase<pg8::EpiBf16, pg8::StaticOrder, true, true>(lds, g, S, E); }
        if constexpr (K == 6) { __syncthreads();
            const int Mrows = (l == 0) ? NTOK : NTX;
            pg8::Gemm g{X1, (const bf16*)(ws + WS_WOT) + (size_t)l * DM * DM, Mrows, DM, DM}; pg8::StaticOrder S; S.init(Mrows, DM, G, bid);
            pg8::EpiBf16 E{X3, DM}; pg8::gemm_phase<pg8::EpiBf16, pg8::StaticOrder, true, true>(lds, g, S, E); }
        if constexpr (K == 9) { moe_tables<false>(lds, l);
            pg8::Gemm g{X2, (const bf16*)(ws + WS_W13T), MAXSLOT, 1024, DM}; pg8::MoeOrder S; S.init((const LAS int*)(lds + PREF_OFF), 4, G, bid);
            pg8::EpiSwiGLU E{X3, DEXP}; pg8::gemm_phase<pg8::EpiSwiGLU, pg8::MoeOrder, true, true>(lds, g, S, E); }
        if constexpr (K == 10) { moe_tables<false>(lds, l);
            pg8::Gemm g{X3, (const bf16*)(ws + WS_W2T), MAXSLOT, 1024, DEXP}; pg8::MoeOrder S; S.init((const LAS int*)(lds + PREF_OFF), 4, G, bid);
            pg8::EpiBf16 E{X2, DM}; pg8::gemm_phase<pg8::EpiBf16, pg8::MoeOrder, true, true>(lds, g, S, E); }
    }
}
__device__ __forceinline__ void grid_sync(LAS unsigned char* lds) {
    const KA a = ka_get(); XcdBarrier b; b.bar = (unsigned*)(a.ws() + WS_CTL) + CW_BAR; b.x = xb_xcc_id(); b.st = (volatile LAS unsigned*)(lds + MISC_OFF) + 8; xcd_barrier(b);
#ifdef PROBE_BAR
    xcd_barrier(b);
#endif
}
#ifndef ONE_LAUNCH
template <int K> __global__ void __launch_bounds__(512, 2) fwd_ph(Args args) {
    extern __shared__ __attribute__((aligned(16))) unsigned char lds_raw[];
    LAS unsigned char* lds = (LAS unsigned char*)lds_raw;
    for (int u = threadIdx.x; u < (LDS_BYTES - LDSCTL_OFF) / 4; u += 512) ((LAS unsigned*)(lds + LDSCTL_OFF))[u] = 0u;
    __syncthreads();
    hw_tid_init();
    __syncthreads();
    run_phase<K>(lds, args.ph_lo);
}
template <int K> static void launch_ph(const Args& a, int grid, hipStream_t stream) {
    static bool attr = false;
    if (!attr) { (void)hipFuncSetAttribute((const void*)fwd_ph<K>, hipFuncAttributeMaxDynamicSharedMemorySize, LDS_BYTES); attr = true; }
    hipLaunchKernelGGL(fwd_ph<K>, dim3(grid), dim3(512), LDS_BYTES, stream, a);
}
#else
__global__ void __launch_bounds__(512, 2) fwd(Args args) {
    extern __shared__ __attribute__((aligned(16))) unsigned char lds_raw[];
    LAS unsigned char* lds = (LAS unsigned char*)lds_raw;
    for (int u = threadIdx.x; u < (LDS_BYTES - LDSCTL_OFF) / 4; u += 512) ((LAS unsigned*)(lds + LDSCTL_OFF))[u] = 0u;
    __syncthreads();
    hw_tid_init();
    __syncthreads();
    (void)xcd_barrier_post((unsigned*)(args.ws + WS_CTL) + CW_BAR, (volatile LAS unsigned*)(lds + MISC_OFF) + 8);
    run_phase<0>(lds, 0);
#ifdef PROBE_P0
    __syncthreads(); run_phase<0>(lds, 0);
#endif
    grid_sync(lds);
#ifndef PROBE_REP
#define PROBE_REP -1
#endif
#define RUNP(K) do { run_phase<K>(lds, l); if (PROBE_REP == K) { __syncthreads(); run_phase<K>(lds, l); } } while (0)
    for (int l = 0; l < 2; ++l) {
        if (l == 0) { RUNP(1); grid_sync(lds); }
        RUNP(2); grid_sync(lds);
        RUNP(3);
        RUNP(4); grid_sync(lds);
        RUNP(5); grid_sync(lds);
        RUNP(6); grid_sync(lds);
        run_phase<7>(lds, l); if (PROBE_REP == 7 && l == 0) { __syncthreads(); run_phase<7>(lds, l); } grid_sync(lds);
        RUNP(8); grid_sync(lds);
        RUNP(9); grid_sync(lds);
        RUNP(10); grid_sync(lds);
        run_phase<11>(lds, l); if (l == 0) grid_sync(lds);
    }
}
#endif

extern "C" void kernel_launch(void* const* d_in, const int* in_sizes, int n_in, void* d_out, int out_size, void* d_ws, size_t ws_size, hipStream_t stream) {
    static int grid = 0;
    if (grid == 0) {
        if (n_in != 30 || in_sizes[0] != NTX * DM || out_size != NTX * DM || ws_size < WS_END) {
            fprintf(stderr, "kernel_launch: unexpected problem (n_in %d, in0 %d, out %d, ws %zu < %zu?); nothing launched\n", n_in, n_in > 0 ? in_sizes[0] : -1, out_size, ws_size, (size_t)WS_END); grid = -1; return; }
        int dev = 0, cus = 0;
        if (hipGetDevice(&dev) != hipSuccess || hipDeviceGetAttribute(&cus, hipDeviceAttributeMultiprocessorCount, dev) != hipSuccess) { grid = -1; return; }
#ifdef ONE_LAUNCH
        if (hipFuncSetAttribute((const void*)fwd, hipFuncAttributeMaxDynamicSharedMemorySize, LDS_BYTES) != hipSuccess) { fprintf(stderr, "kernel_launch: hipFuncSetAttribute failed\n"); grid = -1; return; }
#endif
        (void)hipGetLastError();
        grid = cus > 0 ? cus : 256;
    }
    if (grid < 0) return;
    if (hipMemsetAsync((char*)d_ws + WS_CTL, 0, CTL_ZERO_BYTES, stream) != hipSuccess) return;
    Args a{};
    for (int i = 0; i < 30; ++i) a.in[i] = (const float*)d_in[i];
    a.out = (float*)d_out; a.ws = (unsigned char*)d_ws; a.ph_lo = 0; a.ph_hi = 0;
#ifndef ONE_LAUNCH
    launch_ph<0>(a, grid, stream);
    for (int l = 0; l < 2; ++l) { a.ph_lo = l;
        launch_ph<1>(a, grid, stream); launch_ph<2>(a, grid, stream); launch_ph<3>(a, grid, stream); launch_ph<4>(a, grid, stream); launch_ph<5>(a, grid, stream); launch_ph<6>(a, grid, stream);
        launch_ph<7>(a, grid, stream); launch_ph<8>(a, grid, stream); launch_ph<9>(a, grid, stream); launch_ph<10>(a, grid, stream); launch_ph<11>(a, grid, stream); }
#else
    hipLaunchKernelGGL(fwd, dim3(grid), dim3(512), LDS_BYTES, stream, a);
#endif
}
```

```cpp
#define ONE_LAUNCH 1
#include <hip/hip_runtime.h>
#include <cstdio>
#include <cstdint>

constexpr int DM = 1024, NB = 16, SEQ = 2048, CTXL = 256, NTX = NB * SEQ, NTC = NB * CTXL, NTOK = NTX + NTC;
constexpr int DIN = 3296, DINP = 3328, RWOFF = 1536, NHEAD = 8, HD = 64;
constexpr int NEXP = 32, DEXP = 512, LISTCAP = 2 * NTOK;
constexpr int MAXSLOT = 81920;
constexpr float ALPHA = 1.41421356237309515f, LN_EPS = 1e-6f, GN_EPS = 64e-5f;

constexpr size_t MiB = 1u << 20;
constexpr size_t WS_CTL = 0, CTL_ZERO_BYTES = 1 * MiB;
constexpr size_t WS_MODS = 1 * MiB;
constexpr size_t WS_ROPE = 2 * MiB;
constexpr size_t WS_WINT = 3 * MiB;
constexpr size_t WS_WOT = 16 * MiB;
constexpr size_t WS_W13T = 20 * MiB;
constexpr size_t WS_W2T = 84 * MiB;
constexpr size_t WS_LIST = 116 * MiB;
constexpr size_t WS_TOK = 125 * MiB;
constexpr size_t WS_BONUS = 127 * MiB;
constexpr size_t WS_CS = 130 * MiB;
constexpr size_t WS_X1 = 146 * MiB;
constexpr size_t WS_X2 = 218 * MiB;
constexpr size_t WS_X3 = 452 * MiB;
constexpr size_t WS_END = 596 * MiB;
static_assert(WS_WINT + (size_t)2 * DINP * DM * 2 <= WS_WOT && WS_LIST + (size_t)NEXP * LISTCAP * 4 <= WS_TOK && WS_TOK + (size_t)NTOK * 32 <= WS_BONUS, "ws map");
static_assert(WS_BONUS + (size_t)2 * NTOK * 8 * 4 <= WS_CS && WS_X2 + (size_t)NTOK * DINP * 2 <= WS_X3 && WS_X3 + (size_t)2 * NTOK * 512 * 4 <= WS_END, "ws map");
static_assert((size_t)MAXSLOT * 1024 * 2 <= WS_X3 - WS_X2 && (size_t)MAXSLOT * 512 * 2 <= WS_END - WS_X3, "ws map");
constexpr int CW_BAR = 4096;
constexpr int CW_CNT = 8192;
constexpr int RING_BYTES = 131072, LDSCTL_OFF = RING_BYTES, MISC_OFF = LDSCTL_OFF + 320, LDS_BYTES = 147456;
constexpr int PREF_OFF = LDSCTL_OFF + 512;

#define GAS __attribute__((address_space(1)))
#define LAS __attribute__((address_space(3)))
typedef unsigned short bf16;
typedef unsigned v4u __attribute__((ext_vector_type(4)));
typedef unsigned v2u __attribute__((ext_vector_type(2)));
typedef float f32x4 __attribute__((ext_vector_type(4)));
typedef short bf16x8 __attribute__((ext_vector_type(8)));
typedef GAS unsigned gu32;
#define RLX_AGENT __ATOMIC_RELAXED, __HIP_MEMORY_SCOPE_AGENT
#define LDS_WAIT() asm volatile("s_waitcnt lgkmcnt(0)" ::: "memory")
#define VM_WAIT() asm volatile("s_waitcnt vmcnt(0)" ::: "memory")
__device__ __forceinline__ unsigned f2bf(float f) { unsigned u = __builtin_bit_cast(unsigned, f); return (u + 0x7fffu + ((u >> 16) & 1u)) >> 16; }
typedef float f32x2_t_ __attribute__((ext_vector_type(2))); typedef __bf16 bf16x2_t_ __attribute__((ext_vector_type(2)));
__device__ __forceinline__ unsigned pk2(float lo, float hi) { f32x2_t_ v = {lo, hi}; bf16x2_t_ b = __builtin_convertvector(v, bf16x2_t_); return __builtin_bit_cast(unsigned, b); }
__device__ __forceinline__ unsigned short f2bf1(float f) { return (unsigned short)(pk2(f, 0.f) & 0xffffu); }
__device__ __forceinline__ float bf2f(unsigned short v) { return __builtin_bit_cast(float, (unsigned)v << 16); }
__device__ __forceinline__ float bflo(unsigned w) { return __builtin_bit_cast(float, w << 16); }
__device__ __forceinline__ float bfhi(unsigned w) { return __builtin_bit_cast(float, w & 0xffff0000u); }
__device__ __forceinline__ float sigmoidf_(float x) { return 1.0f / (1.0f + expf(-x)); }
__device__ __forceinline__ float shx(float v, int k, int lane) { return __builtin_bit_cast(float, __builtin_amdgcn_ds_bpermute((lane ^ k) << 2, __builtin_bit_cast(int, v))); }
__device__ __forceinline__ float shi(float v, int src) { return __builtin_bit_cast(float, __builtin_amdgcn_ds_bpermute(src << 2, __builtin_bit_cast(int, v))); }
template <int CTRL> __device__ __forceinline__ float dppmov(float v) { return __builtin_bit_cast(float, __builtin_amdgcn_update_dpp(0, __builtin_bit_cast(int, v), CTRL, 0xF, 0xF, true)); }
__device__ __forceinline__ float wave_sum(float v) {
    v += dppmov<0xB1>(v); v += dppmov<0x4E>(v); v += dppmov<0x141>(v); v += dppmov<0x140>(v);
    const int iv = __builtin_bit_cast(int, v);
    return (__builtin_bit_cast(float, __builtin_amdgcn_readlane(iv, 0)) + __builtin_bit_cast(float, __builtin_amdgcn_readlane(iv, 16))) + (__builtin_bit_cast(float, __builtin_amdgcn_readlane(iv, 32)) + __builtin_bit_cast(float, __builtin_amdgcn_readlane(iv, 48)));
}
__device__ __forceinline__ float red8(float v) { v += dppmov<0xB1>(v); v += dppmov<0x4E>(v); v += dppmov<0x141>(v); return v; }

struct TokInfo { int e0, e1, p0, p1; float g0, g1; int pad0, pad1; };

constexpr int WID_OFF = LDSCTL_OFF + 1536;
__device__ __forceinline__ int hw_slot() { return (int)__builtin_amdgcn_s_getreg((5 << 11) | 4) & 63; }
__device__ __forceinline__ int lane_id() { int l; asm volatile("v_mbcnt_lo_u32_b32 %0, -1, 0\n\tv_mbcnt_hi_u32_b32 %0, -1, %0" : "=v"(l)); return l; }
__device__ __forceinline__ void hw_tid_init() { *(volatile LAS int*)(uintptr_t)(WID_OFF + 4 * hw_slot()) = (int)(threadIdx.x >> 6); }
__device__ __forceinline__ int hw_tid() { const int w = *(volatile LAS int*)(uintptr_t)(WID_OFF + 4 * hw_slot()); int t = (__builtin_amdgcn_readfirstlane(w) << 6) | lane_id(); asm volatile("" : "+v"(t)); return t; }
namespace pg8 {
#define PG8_LAS __attribute__((address_space(3)))
typedef unsigned short bf16_t;
typedef short bf16x8 __attribute__((ext_vector_type(8)));
typedef float f32x4 __attribute__((ext_vector_type(4)));
typedef unsigned u32x4 __attribute__((ext_vector_type(4)));
constexpr int BM = 256, BK = 64, HALF = 128, HTB = HALF * BK * 2  , STAGE_BYTES = 8 * HTB, NXCD = 8, WGM = 8;

__host__ __device__ __forceinline__ int lds_byte(int r, int c) { const int st = (r >> 4) * 2 + (c >> 5), rr = r & 15, cc = c & 31, ob = rr * 64 + cc * 2; return st * 1024 + (ob ^ (((ob >> 9) & 1) << 5)); }
__host__ __device__ __forceinline__ void stage_rc(int b, int& R, int& C) { const int st = b / 1024, sb = b % 1024, swz = sb ^ (((sb >> 9) & 1) << 5); R = (st >> 1) * 16 + swz / 64; C = (st & 1) * 32 + (swz % 64) / 2; }
__host__ __device__ __forceinline__ int perm32(int rho) { const int n = rho >> 4, i = rho & 15; return 8 * (i >> 2) + 4 * n + (i & 3); }

struct Unit { int pm, pn, pnb; };
struct Gemm { const bf16_t* A; const bf16_t* Bt; int M, N, K; };

struct StaticOrder {
    int nM, nN, nwg, G, c;
    __host__ __device__ void init(int M, int N, int G_, int c_) { nM = M / BM; nN = N / BM; nwg = nM * nN; G = G_; c = c_; }
    __host__ __device__ bool next(int i, Unit& u) const {
        const long L = (long)i * G + c; if (L >= nwg) return false;
        int wgid = (int)L; { const int q = nwg / NXCD, r = nwg % NXCD, xcd = wgid % NXCD, off = wgid / NXCD; wgid = (xcd < r ? xcd * (q + 1) : r * (q + 1) + (xcd - r) * q) + off; }
        const int nig = WGM * nN, gid = wgid / nig, fm = gid * WGM, gsz = (nM - fm) < WGM ? (nM - fm) : WGM;
        u.pm = fm + ((wgid % nig) % gsz); u.pn = (wgid % nig) / gsz; u.pnb = u.pn; return true;
    }
    __device__ __forceinline__ void a_ready(const Unit&) const {}
    __device__ __forceinline__ void done(const Unit&) const {}
};

__device__ __forceinline__ unsigned cvt_pk_bf16(float lo, float hi) { unsigned r; asm volatile("v_cvt_pk_bf16_f32 %0, %1, %2" : "=v"(r) : "v"(lo), "v"(hi)); return r; }
template <class Epi, class Sched, bool ALIGN_EPI = false, bool SP2 = false>
__device__ __forceinline__ void gemm_phase(PG8_LAS unsigned char* lds, const Gemm g, const Sched& S, const Epi& E) {
    const int tid = hw_tid(), wid = __builtin_amdgcn_readfirstlane(tid >> 6), lane = tid & 63, wr = wid >> 2, wc = wid & 3, fr = lane & 15, fq = lane >> 4;
    const int K = g.K, nt = K / BK;
    unsigned voffA[2], voffB[2];
#pragma unroll
    for (int i = 0; i < 2; ++i) { int R, C; stage_rc(tid * 16 + i * 8192, R, C); const int Rb = Epi::PERM ? ((R & ~31) + perm32(R & 31)) : R;
        voffA[i] = (unsigned)(R * K + C) * 2u; voffB[i] = (unsigned)(Rb * K + C) * 2u; }
    const size_t kstep = (size_t)(BK * 2);
    const size_t hstep = (size_t)HALF * K * 2;
    const size_t tstep = 2 * hstep;
    const unsigned ldsw = (unsigned)wid * 1024u;
    const int aoff = lds_byte(wr * 64 + fr, fq * 8), boff = lds_byte(wc * 32 + fr, fq * 8);
#define PG8_SA(b, h) (((b) * 2 + (h)) * HTB)
#define PG8_SB(b, h) ((4 + (b) * 2 + (h)) * HTB)
#define PG8_STAGE(bufoff, gbase, voff) do { _Pragma("unroll") for (int _i = 0; _i < 2; ++_i) \
        __builtin_amdgcn_global_load_lds((const unsigned*)((const char*)(gbase) + (voff)[_i]), (PG8_LAS unsigned*)(lds + (bufoff) + ldsw + _i * 8192), 16, 0, 0); } while (0)
#define PG8_LDA(dst, b, h) do { _Pragma("unroll") for (int m = 0; m < 4; ++m) _Pragma("unroll") for (int k = 0; k < 2; ++k) dst[m][k] = *(const PG8_LAS bf16x8*)(lds + PG8_SA(b, h) + aoff + m * 2048 + k * 1024); } while (0)
#define PG8_LDB(dst, b, h) do { _Pragma("unroll") for (int n = 0; n < 2; ++n) _Pragma("unroll") for (int k = 0; k < 2; ++k) dst[n][k] = *(const PG8_LAS bf16x8*)(lds + PG8_SB(b, h) + boff + n * 2048 + k * 1024); } while (0)
#define PG8_MMA(ai, bj, At, Bt) do { __builtin_amdgcn_s_setprio(1); _Pragma("unroll") for (int m = 0; m < 4; ++m) _Pragma("unroll") for (int n = 0; n < 2; ++n) _Pragma("unroll") for (int k = 0; k < 2; ++k) \
        acc[ai][bj][m][n] = __builtin_amdgcn_mfma_f32_16x16x32_bf16(Bt[n][k], At[m][k], acc[ai][bj][m][n], 0, 0, 0); __builtin_amdgcn_s_setprio(0); } while (0)
#define PG8_WAIT_V(n) asm volatile("s_waitcnt vmcnt(" #n ")" ::: "memory")
#define PG8_WAIT_L(n) asm volatile("s_waitcnt lgkmcnt(" #n ")" ::: "memory")
#define PG8_BAR __builtin_amdgcn_s_barrier()
#define PG8_SCHED __builtin_amdgcn_sched_barrier(0)
    Unit cur, nxt; int ui = 0;
    if (!S.next(0, cur)) return;
    f32x4 acc[2][2][4][2];
#pragma unroll
    for (int a = 0; a < 2; ++a)
#pragma unroll
        for (int b = 0; b < 2; ++b)
#pragma unroll
            for (int m = 0; m < 4; ++m)
#pragma unroll
                for (int n = 0; n < 2; ++n) acc[a][b][m][n] = (f32x4){0.f, 0.f, 0.f, 0.f};
    bf16x8 At[4][2], B0[2][2], B1[2][2];
    const char* cA = (const char*)g.A + (size_t)cur.pm * tstep; const char* cB = (const char*)g.Bt + (size_t)cur.pnb * tstep;
    S.a_ready(cur);
    if constexpr (SP2) {
        PG8_STAGE(PG8_SB(0, 0), cB, voffB); PG8_STAGE(PG8_SB(0, 1), cB + hstep, voffB); PG8_STAGE(PG8_SA(0, 0), cA, voffA); PG8_STAGE(PG8_SA(0, 1), cA + hstep, voffA);
        if (wr == 1) PG8_BAR;
        PG8_WAIT_V(2); PG8_BAR;
        PG8_STAGE(PG8_SB(1, 0), cB + kstep, voffB); PG8_STAGE(PG8_SA(1, 0), cA + kstep, voffA); PG8_STAGE(PG8_SB(1, 1), cB + hstep + kstep, voffB);
        PG8_WAIT_V(6); PG8_BAR;
    } else {
        PG8_STAGE(PG8_SB(0, 0), cB, voffB); PG8_STAGE(PG8_SA(0, 0), cA, voffA); PG8_STAGE(PG8_SB(0, 1), cB + hstep, voffB); PG8_STAGE(PG8_SA(0, 1), cA + hstep, voffA);
        if (wr == 1) PG8_BAR;
        PG8_WAIT_V(4); PG8_BAR;
        PG8_STAGE(PG8_SB(1, 0), cB + kstep, voffB); PG8_STAGE(PG8_SA(1, 0), cA + kstep, voffA); PG8_STAGE(PG8_SB(1, 1), cB + hstep + kstep, voffB);
        PG8_WAIT_V(6); PG8_BAR;
    }
    for (;;) {
        const bool has_next = S.next(ui + 1, nxt);
        const char* nA = has_next ? (const char*)g.A + (size_t)nxt.pm * tstep : cA; const char* nB = has_next ? (const char*)g.Bt + (size_t)nxt.pnb * tstep : cB;
        for (int t = 0; t < nt; t += 2) {
            const bool last = (t == nt - 2);
            const char* a1 = cA + (size_t)(t + 1) * kstep;
            const char* a2 = last ? nA : cA + (size_t)(t + 2) * kstep; const char* b2 = last ? nB : cB + (size_t)(t + 2) * kstep;
            const char* a3 = a2 + kstep; const char* b3 = b2 + kstep;
            if (last && has_next) S.a_ready(nxt);
            if constexpr (SP2) {
            PG8_LDB(B0, 0, 0); PG8_LDB(B1, 0, 1); PG8_SCHED; PG8_LDA(At, 0, 0); PG8_STAGE(PG8_SA(1, 1), a1 + hstep, voffA);
            PG8_WAIT_V(8); PG8_WAIT_L(0); PG8_BAR; PG8_MMA(0, 0, At, B0); PG8_MMA(0, 1, At, B1); PG8_BAR; PG8_SCHED;
            PG8_LDA(At, 0, 1); PG8_STAGE(PG8_SB(0, 0), b2, voffB); PG8_STAGE(PG8_SB(0, 1), b2 + hstep, voffB); PG8_STAGE(PG8_SA(0, 0), a2, voffA);
            PG8_WAIT_V(8); PG8_WAIT_L(0); PG8_BAR; PG8_MMA(1, 0, At, B0); PG8_MMA(1, 1, At, B1); PG8_BAR; PG8_SCHED;
            PG8_LDB(B0, 1, 0); PG8_LDB(B1, 1, 1); PG8_SCHED; PG8_LDA(At, 1, 0); PG8_STAGE(PG8_SA(0, 1), a2 + hstep, voffA);
            PG8_WAIT_V(8); PG8_WAIT_L(0); PG8_BAR; PG8_MMA(0, 0, At, B0); PG8_MMA(0, 1, At, B1); PG8_BAR; PG8_SCHED;
            PG8_LDA(At, 1, 1); PG8_STAGE(PG8_SB(1, 0), b3, voffB); PG8_STAGE(PG8_SB(1, 1), b3 + hstep, voffB); PG8_STAGE(PG8_SA(1, 0), a3, voffA);
            PG8_WAIT_V(8); PG8_WAIT_L(0); PG8_BAR; PG8_MMA(1, 0, At, B0); PG8_MMA(1, 1, At, B1); PG8_BAR; PG8_SCHED;
            } else {
            PG8_LDB(B0, 0, 0); PG8_SCHED; PG8_LDA(At, 0, 0); PG8_STAGE(PG8_SA(1, 1), a1 + hstep, voffA);
            PG8_WAIT_L(8); PG8_BAR; PG8_WAIT_L(0); PG8_MMA(0, 0, At, B0); PG8_BAR; PG8_SCHED;
            PG8_LDB(B1, 0, 1); PG8_STAGE(PG8_SB(0, 0), b2, voffB);
            PG8_BAR; PG8_WAIT_L(0); PG8_MMA(0, 1, At, B1); PG8_BAR;
            PG8_LDA(At, 0, 1); PG8_STAGE(PG8_SA(0, 0), a2, voffA);
            PG8_BAR; PG8_WAIT_L(0); PG8_MMA(1, 0, At, B0); PG8_BAR; PG8_SCHED;
            PG8_STAGE(PG8_SB(0, 1), b2 + hstep, voffB);
            PG8_WAIT_V(6); PG8_BAR; PG8_MMA(1, 1, At, B1); PG8_BAR;
            PG8_LDB(B0, 1, 0); PG8_SCHED; PG8_LDA(At, 1, 0); PG8_STAGE(PG8_SA(0, 1), a2 + hstep, voffA);
            PG8_WAIT_L(8); PG8_BAR; PG8_WAIT_L(0); PG8_MMA(0, 0, At, B0); PG8_BAR; PG8_SCHED;
            PG8_LDB(B1, 1, 1); PG8_STAGE(PG8_SB(1, 0), b3, voffB);
            PG8_BAR; PG8_WAIT_L(0); PG8_MMA(0, 1, At, B1); PG8_BAR;
            PG8_LDA(At, 1, 1); PG8_STAGE(PG8_SA(1, 0), a3, voffA);
            PG8_BAR; PG8_WAIT_L(0); PG8_MMA(1, 0, At, B0); PG8_BAR; PG8_SCHED;
            PG8_STAGE(PG8_SB(1, 1), b3 + hstep, voffB);
            PG8_WAIT_V(6); PG8_BAR; PG8_MMA(1, 1, At, B1); PG8_BAR;
            }
        }
        if constexpr (ALIGN_EPI) { if (wr == 0) PG8_BAR; }
        if constexpr (!Epi::AFTER_DRAIN) { E(acc, cur, wr, wc, fr, fq); S.done(cur); }
        if (!has_next) break;
#pragma unroll
        for (int a = 0; a < 2; ++a)
#pragma unroll
            for (int b = 0; b < 2; ++b)
#pragma unroll
                for (int m = 0; m < 4; ++m)
#pragma unroll
                    for (int n = 0; n < 2; ++n) acc[a][b][m][n] = (f32x4){0.f, 0.f, 0.f, 0.f};
        cur = nxt; cA = nA; cB = nB; ++ui;
        if constexpr (ALIGN_EPI) { if (wr == 1) PG8_BAR; }
    }
    PG8_WAIT_V(0);
    if constexpr (!ALIGN_EPI) { if (wr == 0) PG8_BAR; }
    PG8_BAR;
    if constexpr (Epi::AFTER_DRAIN) { E.fused(acc, cur, wr, wc, fr, fq, lds, wid, lane); S.done(cur); }
#undef PG8_SA
#undef PG8_SB
#undef PG8_STAGE
#undef PG8_LDA
#undef PG8_LDB
#undef PG8_MMA
#undef PG8_WAIT_V
#undef PG8_WAIT_L
#undef PG8_BAR
#undef PG8_SCHED
}
}
namespace pg8 {
struct EpiBf16 {
    static constexpr bool PERM = true, AFTER_DRAIN = false;
    bf16_t* O; int ldc;
    __device__ __forceinline__ void operator()(const f32x4 (&acc)[2][2][4][2], const Unit& u, int wr, int wc, int fr, int fq) const {
        const int row0 = u.pm * BM + wr * 64 + fr; const int col0 = u.pn * BM + wc * 32 + 8 * fq;
#pragma unroll
        for (int ai = 0; ai < 2; ++ai)
#pragma unroll
            for (int m = 0; m < 4; ++m) { bf16_t* rowp = O + (size_t)(row0 + ai * HALF + m * 16) * ldc + col0;
#pragma unroll
                for (int bj = 0; bj < 2; ++bj) { const f32x4 v0 = acc[ai][bj][m][0], v1 = acc[ai][bj][m][1];
                    u32x4 w; w.x = cvt_pk_bf16(v0[0], v0[1]); w.y = cvt_pk_bf16(v0[2], v0[3]); w.z = cvt_pk_bf16(v1[0], v1[1]); w.w = cvt_pk_bf16(v1[2], v1[3]);
                    *(u32x4*)(rowp + bj * HALF) = w; } }
    }
};
struct EpiSwiGLU {
    static constexpr bool PERM = true, AFTER_DRAIN = false;
    bf16_t* O; int ldc;
    __device__ __forceinline__ void operator()(const f32x4 (&acc)[2][2][4][2], const Unit& u, int wr, int wc, int fr, int fq) const {
        const int row0 = u.pm * BM + wr * 64 + fr; const int col0 = u.pn * HALF + wc * 32 + 8 * fq;
#pragma unroll
        for (int ai = 0; ai < 2; ++ai)
#pragma unroll
            for (int m = 0; m < 4; ++m) { bf16_t* rowp = O + (size_t)(row0 + ai * HALF + m * 16) * ldc + col0;
                float r[8];
#pragma unroll
                for (int n = 0; n < 2; ++n)
#pragma unroll
                    for (int j = 0; j < 4; ++j) { const float a = acc[ai][0][m][n][j], b = acc[ai][1][m][n][j]; r[n * 4 + j] = a * b * __builtin_amdgcn_rcpf(1.0f + __expf(-a)); }
                u32x4 w; w.x = cvt_pk_bf16(r[0], r[1]); w.y = cvt_pk_bf16(r[2], r[3]); w.z = cvt_pk_bf16(r[4], r[5]); w.w = cvt_pk_bf16(r[6], r[7]);
                *(u32x4*)rowp = w; }
    }
};
struct MoeOrder {
    const PG8_LAS int* pref; int nN, G, c, total;
    __device__ __forceinline__ void init(const PG8_LAS int* pref_, int nN_, int G_, int c_) { pref = pref_; nN = nN_; G = G_; c = c_; total = pref_[32] * nN_; }
    __device__ __forceinline__ bool next(int i, Unit& u) const {
        const int L = i * G + c; if (L >= total) return false;
        const int rt = L / nN, pn = L - rt * nN; int e = 0;
#pragma unroll 1
        for (int k = 1; k < 32; ++k) e += (pref[k] <= rt) ? 1 : 0;
        u.pm = rt; u.pn = pn; u.pnb = e * nN + pn; return true;
    }
    __device__ __forceinline__ void a_ready(const Unit&) const {}
    __device__ __forceinline__ void done(const Unit&) const {}
};
}
#define XB_TMO      128
#define XB_XCNT(j)  (256  + 64 * (j))
#define XB_XSUB(j)  (1280 + 64 * (j))
#define XB_XGEN(j)  (2304 + 64 * (j))
#define XB_TOP      3328
#define XB_TOPGEN   3392
#define XCD_BAR_WORDS 3456
#define XB_SPIN_CAP (1u << 22)

__device__ __forceinline__ unsigned xb_ld(unsigned* p)              { return __hip_atomic_load(p, __ATOMIC_RELAXED, __HIP_MEMORY_SCOPE_AGENT); }
__device__ __forceinline__ unsigned xb_add(unsigned* p, unsigned v) { return __hip_atomic_fetch_add(p, v, __ATOMIC_RELAXED, __HIP_MEMORY_SCOPE_AGENT); }
__device__ __forceinline__ unsigned xb_xcc_id() { return (unsigned)__builtin_amdgcn_s_getreg((3 << 11) | 20) & 0xFu; }
#define XB_SPIN(cond, bar) do { unsigned _sp = 0; while (cond) { __builtin_amdgcn_s_sleep(1); \
    if ((++_sp & 255u) == 0u) { if (xb_ld(&(bar)[XB_TMO])) break; if (_sp > XB_SPIN_CAP) { atomicAdd(&(bar)[XB_TMO], 1u); break; } } } } while (0)

struct XcdBarrier {
    unsigned* bar; unsigned x;
    volatile LAS unsigned* st;
};

__device__ __forceinline__ XcdBarrier xcd_barrier_post(unsigned* bar, volatile LAS unsigned* st) {
    XcdBarrier b; b.bar = bar; b.x = xb_xcc_id(); b.st = st;
    if (hw_tid() == 0) (void)xb_add(&bar[XB_XCNT(b.x)], 1u);
    return b;
}
__device__ __forceinline__ void xcd_barrier_complete(unsigned* bar, unsigned x, unsigned& nloc, unsigned& nx) {
    const unsigned G = gridDim.x * gridDim.y * gridDim.z;
    unsigned sum, cnt, mine, sp = 0u;
    for (;;) {
        sum = 0u; cnt = 0u; mine = 0u;
#pragma unroll
        for (unsigned j = 0; j < 16; ++j) { const unsigned c = xb_ld(&bar[XB_XCNT(j)]); sum += c; cnt += (c > 0u) ? 1u : 0u; mine = (j == x) ? c : mine; }
        if (sum == G) break;
        __builtin_amdgcn_s_sleep(1);
        if ((++sp & 255u) == 0u) { if (xb_ld(&bar[XB_TMO])) break; if (sp > XB_SPIN_CAP) { atomicAdd(&bar[XB_TMO], 1u); break; } }
    }
    nloc = mine > 0u ? mine : 1u; nx = cnt > 0u ? cnt : 1u;
}

__device__ __forceinline__ void xcd_barrier(const XcdBarrier& b) {
    asm volatile("s_waitcnt vmcnt(0)" ::: "memory");
    __syncthreads();
    if (hw_tid() == 0) {
        unsigned* bar = b.bar;
        __builtin_amdgcn_s_waitcnt(0);
        unsigned nloc = b.st[0], nx = b.st[1];
        if (nloc == 0u) { xcd_barrier_complete(bar, b.x, nloc, nx); b.st[0] = nloc; b.st[1] = nx; }
        const unsigned old = xb_add(&bar[XB_XSUB(b.x)], 1u);
        const unsigned gen = old / nloc;
        if (old + 1u == (gen + 1u) * nloc) {
            __builtin_amdgcn_fence(__ATOMIC_RELEASE, "agent");
            asm volatile("s_waitcnt vmcnt(0)" ::: "memory");
            const unsigned og = xb_add(&bar[XB_TOP], 1u);
            const unsigned tg = og / nx;
            if (og + 1u == (tg + 1u) * nx) xb_add(&bar[XB_TOPGEN], 1u);
            else XB_SPIN(xb_ld(&bar[XB_TOPGEN]) == tg, bar);
            __builtin_amdgcn_fence(__ATOMIC_ACQUIRE, "agent");
            xb_add(&bar[XB_XGEN(b.x)], 1u);
            asm volatile("s_waitcnt vmcnt(0)" ::: "memory");
        } else {
            XB_SPIN(xb_ld(&bar[XB_XGEN(b.x)]) == gen, bar);
            __builtin_amdgcn_fence(__ATOMIC_ACQUIRE, "agent");
            asm volatile("s_waitcnt vmcnt(0)" ::: "memory");
        }
    }
    __syncthreads();
}
struct Args { const float* in[30]; float* out; unsigned char* ws; int ph_lo, ph_hi; };
#define CAS __attribute__((address_space(4)))
struct KA { const CAS unsigned char* kp;
    __device__ __forceinline__ const float* in(int i) const { return *(const float* const CAS*)(kp + 8 * i); }
    __device__ __forceinline__ float* out() const { return *(float* const CAS*)(kp + 240); }
    __device__ __forceinline__ unsigned char* ws() const { return *(unsigned char* const CAS*)(kp + 248); } };
__device__ __forceinline__ KA ka_get() { const CAS unsigned char* kp = (const CAS unsigned char*)__builtin_amdgcn_kernarg_segment_ptr(); asm volatile("" : "+s"(kp)); return KA{kp}; }
__device__ __forceinline__ int opaque_tid() { return hw_tid(); }
static_assert(sizeof(Args) == 264, "kernarg layout");
enum { I_X = 0, I_C, I_CTX, I_CCTX, I_ADAW, I_ADAB, I_WIN, I_RPB, I_MUP, I_MUN, I_W0, I_W2, I_A0, I_A2, I_G2, I_KK, I_KA, I_RK, I_GNG, I_GNB, I_WOUT, I_LN1G, I_LN1B, I_LN2G, I_LN2B, I_RW, I_RB, I_EW1, I_EW3, I_EW2 };

__device__ __forceinline__ void transpose_item(const float* W, int N, int k0, int n0, bf16* WT, int ldk, int drow0, LAS float* scr, int lane) {
#pragma unroll 8
    for (int i = 0; i < 32; ++i) { const int kk = 2 * i + (lane >> 5); scr[kk * 33 + (lane & 31)] = W[(size_t)(k0 + kk) * N + n0 + (lane & 31)]; }
    LDS_WAIT(); asm volatile("" ::: "memory");
    const int c = lane & 7;
#pragma unroll
    for (int j = 0; j < 4; ++j) { const int n = (lane >> 3) + 8 * j; const LAS float* s = scr + (8 * c) * 33 + n;
        v4u o; o.x = pk2(s[0 * 33], s[1 * 33]); o.y = pk2(s[2 * 33], s[3 * 33]); o.z = pk2(s[4 * 33], s[5 * 33]); o.w = pk2(s[6 * 33], s[7 * 33]);
        *(GAS v4u*)(WT + (size_t)(drow0 + n) * ldk + k0 + 8 * c) = o; }
    LDS_WAIT(); asm volatile("" ::: "memory");
}

__device__ __forceinline__ void phase_prologue(LAS unsigned char* lds) {
    const KA a = ka_get();
    const int tid = opaque_tid(), lane = tid & 63, wave = __builtin_amdgcn_readfirstlane(tid >> 6), G = gridDim.x, bid = blockIdx.x;
    const int gw = bid * 8 + wave, NGW = G * 8;
    bf16* WINT = (bf16*)(a.ws() + WS_WINT); bf16* WOT = (bf16*)(a.ws() + WS_WOT);
    LAS float* scr = (LAS float*)(lds + wave * 16384);
    constexpr int I_IN = 16 * 103, I_OUT = 16 * 32, I_L = I_IN + I_OUT;
    for (int it = gw; it < 2 * I_L; it += NGW) {
        const int l = it / I_L; int r = it - l * I_L;
        if (r < I_IN) { const int kb = r / 103, nb = r - kb * 103; transpose_item(a.in(I_WIN) + (size_t)l * DM * DIN, DIN, 64 * kb, 32 * nb, WINT + (size_t)l * DINP * DM, DM, 32 * nb, scr, lane); }
        else { r -= I_IN; const int kb = r >> 5, nb = r & 31; transpose_item(a.in(I_WOUT) + (size_t)l * DM * DM, DM, 64 * kb, 32 * nb, WOT + (size_t)l * DM * DM, DM, 32 * nb, scr, lane); }
    }
    for (int i = bid * 512 + tid; i < 8192; i += G * 512) { const int l = i >> 12, r = i & 4095; *(GAS v4u*)(WINT + (size_t)l * DINP * DM + (size_t)DIN * DM + (size_t)r * 8) = (v4u){0u, 0u, 0u, 0u}; }
    { float* rp = (float*)(a.ws() + WS_ROPE); const int i = bid * 512 + tid;
      if (i < 1536) { const int idx = i < 512 ? i : i - 512; const int p = idx >> 4, f = idx & 15; const double inv = exp(-(double)f * (9.210340371976184 / 16.0)); const double ang = (double)p * inv;
          const float cs = (float)cos(ang), sn = (float)sin(ang); if (i < 512) { rp[idx] = cs; rp[512 + idx] = sn; } else { rp[1024 + idx] = cs; rp[2048 + idx] = sn; } } }
    __syncthreads();
    LAS float* sl = (LAS float*)lds; LAS float* red = (LAS float*)(lds + 69632);
    for (int i = tid; i < 17 * 1024; i += 512) { const int r = i >> 10, k = i & 1023; const float v = r < 16 ? a.in(I_C)[r * 1024 + k] : a.in(I_CCTX)[k]; sl[i] = v / (1.0f + expf(-v)); }
    __syncthreads();
    float* mods = (float*)(a.ws() + WS_MODS);
    for (int it = bid; it < 192; it += G) {
        const int l = it / 96, ch = it - l * 96; const int kq = tid >> 6, cl = tid & 63, col = ch * 64 + cl;
        const float* W = a.in(I_ADAW) + (size_t)l * DM * 6144 + col;
        float acc[17];
#pragma unroll
        for (int r = 0; r < 17; ++r) acc[r] = 0.f;
        for (int k0 = kq * 128; k0 < kq * 128 + 128; k0 += 8) { float w8[8];
#pragma unroll
            for (int q = 0; q < 8; ++q) w8[q] = W[(size_t)(k0 + q) * 6144];
#pragma unroll
            for (int r = 0; r < 17; ++r) { const f32x4 s0 = *(const LAS f32x4*)(sl + r * 1024 + k0), s1 = *(const LAS f32x4*)(sl + r * 1024 + k0 + 4);
                acc[r] += s0.x * w8[0] + s0.y * w8[1] + s0.z * w8[2] + s0.w * w8[3] + s1.x * w8[4] + s1.y * w8[5] + s1.z * w8[6] + s1.w * w8[7]; } }
#pragma unroll
        for (int r = 0; r < 17; ++r) red[(kq * 17 + r) * 64 + cl] = acc[r];
        __syncthreads();
        for (int i = tid; i < 17 * 64; i += 512) { const int r = i >> 6, c2 = i & 63; float s = 0.f;
#pragma unroll
            for (int q = 0; q < 8; ++q) s += red[(q * 17 + r) * 64 + c2];
            mods[((size_t)l * 17 + r) * 6144 + ch * 64 + c2] = s + a.in(I_ADAB)[l * 6144 + ch * 64 + c2]; }
        __syncthreads();
    }
}

__device__ __forceinline__ void phase_modconv(LAS unsigned char* lds, int l) {
    const KA a = ka_get();
    const int tid = opaque_tid(), lane = tid & 63, wave = __builtin_amdgcn_readfirstlane(tid >> 6), G = gridDim.x, bid = blockIdx.x;
    const int gw = bid * 8 + wave, NGW = G * 8;
    const float* mods = (const float*)(a.ws() + WS_MODS) + (size_t)l * 17 * 6144;
    bf16* XM = (bf16*)(a.ws() + WS_X1);
    const float* xs = l == 0 ? a.in(I_X) : a.out(); const float* cs = l == 0 ? a.in(I_CTX) : (const float*)(a.ws() + WS_CS);
    for (int m = gw; m < NTOK; m += NGW) {
        const float* src; int mr;
        if (m < NTX) { src = xs + (size_t)m * DM; mr = m / SEQ; } else { src = cs + (size_t)(m - NTX) * DM; mr = 16; }
        const GAS f32x4* xr = (const GAS f32x4*)src + lane; const GAS f32x4* sh = (const GAS f32x4*)(mods + (size_t)mr * 6144) + lane; const GAS f32x4* sc = sh + 256;
        GAS v2u* o8 = (GAS v2u*)(XM + (size_t)m * DM) + lane;
#pragma unroll
        for (int j = 0; j < 4; ++j) { const f32x4 v = xr[64 * j], s = sh[64 * j], c = sc[64 * j]; const f32x4 r = v * (c + 1.0f) + s; v2u w; w.x = pk2(r.x, r.y); w.y = pk2(r.z, r.w); o8[64 * j] = w; }
    }
}

__device__ __forceinline__ void phase_scan_direct(LAS unsigned char* lds, int l) {
    const KA a = ka_get();
    constexpr int TB = 32;
    const int tid = opaque_tid(), lane = tid & 63, wv = __builtin_amdgcn_readfirstlane(tid >> 6);
    LAS float* ops = (LAS float*)lds;
    LAS float* scal = (LAS float*)(lds + 49152);
    LAS float* zl = (LAS float*)(lds + 49664);
    LAS float* rkraw = (LAS float*)(lds + 57856);
    LAS float* ybuf = (LAS float*)(lds + 74240);
    const bf16* PX = (const bf16*)(a.ws() + WS_X2); float* YD = (float*)(a.ws() + WS_X3); float* BON = (float*)(a.ws() + WS_BONUS); const float* rope = (const float*)(a.ws() + WS_ROPE);
    const float* mup = a.in(I_MUP) + l * 1760; const float* mun = a.in(I_MUN) + l * 1760;
    for (int chain = blockIdx.x; chain < 256; chain += gridDim.x) {
        const int b = chain >> 4, h = (chain >> 1) & 7, d = chain & 1, c = lane;
        float w2c[32], a2c[32];
#pragma unroll
        for (int j = 0; j < 32; ++j) { w2c[j] = a.in(I_W2)[((size_t)(l * 2 + d) * 32 + j) * 512 + h * 64 + c]; a2c[j] = a.in(I_A2)[((size_t)(l * 2 + d) * 32 + j) * 512 + h * 64 + c]; }
        const float w0c = a.in(I_W0)[(l * 2 + d) * 512 + h * 64 + c], a0c = a.in(I_A0)[(l * 2 + d) * 512 + h * 64 + c];
        const float kkc = a.in(I_KK)[l * 512 + h * 64 + c], kac = a.in(I_KA)[l * 512 + h * 64 + c], rkc = a.in(I_RK)[l * 512 + h * 64 + c];
        const int colr = h * 64 + c, colk = 512 + colr, colv = 1024 + colr, coll = (c < 32) ? (1536 + d * 32 + c) : (1600 + d * 32 + (c - 32));
        const float mpr = mup[colr], mnr = mun[colr], mpk = mup[colk], mnk = mun[colk], mpv = mup[colv], mnv = mun[colv], mpl = mup[coll], mnl = mun[coll];
        float S[8];
#pragma unroll
        for (int j = 0; j < 8; ++j) S[j] = 0.f;
        const int vl = lane >> 3, kq = lane & 7, vrow = 8 * wv + vl;
        for (int seq = 0; seq < 2; ++seq) {
            const int T = seq ? SEQ : CTXL, rowbase = seq ? b * SEQ : NTX + b * CTXL, nblk = T / TB;
            for (int bi = 0; bi < nblk; ++bi) {
                const int tb = d ? (nblk - 1 - bi) : bi, t0 = tb * TB;
                float zv[4];
#pragma unroll
                for (int i = 0; i < 4; ++i) {
                    const int tl = wv + 8 * i, t = t0 + tl; const bf16* p = PX + (size_t)(rowbase + t) * DINP + RWOFF;
                    const bool hp = t > 0, hn = t + 1 < T;
                    const float cr = bf2f(p[colr]), ck = bf2f(p[colk]), cv = bf2f(p[colv]), cl_ = bf2f(p[coll]);
                    const float pr = hp ? bf2f(p[colr - DINP]) : 0.f, pk = hp ? bf2f(p[colk - DINP]) : 0.f, pv = hp ? bf2f(p[colv - DINP]) : 0.f, pl = hp ? bf2f(p[coll - DINP]) : 0.f;
                    const float nr = hn ? bf2f(p[colr + DINP]) : 0.f, nk = hn ? bf2f(p[colk + DINP]) : 0.f, nv = hn ? bf2f(p[colv + DINP]) : 0.f, nl = hn ? bf2f(p[coll + DINP]) : 0.f;
                    const float zr = cr + mpr * (pr - cr) + mnr * (nr - cr), zk = ck + mpk * (pk - ck) + mnk * (nk - ck);
                    zv[i] = cv + mpv * (pv - cv) + mnv * (nv - cv);
                    const float zz = cl_ + mpl * (pl - cl_) + mnl * (nl - cl_);
                    rkraw[tl * 128 + c] = zr; rkraw[tl * 128 + 64 + c] = zk; zl[tl * 64 + c] = (c < 32) ? tanhf(zz) : zz;
                }
                __syncthreads();
#pragma unroll
                for (int i = 0; i < 4; ++i) {
                    const int tl = wv + 8 * i, t = t0 + tl;
                    float r = rkraw[tl * 128 + c], k = rkraw[tl * 128 + 64 + c];
                    if (seq) { const float rp = rkraw[tl * 128 + (c ^ 16)], kp = rkraw[tl * 128 + 64 + (c ^ 16)]; const int qd = c >> 4, f = c & 15;
                        const int ti = (qd < 2) ? ((t >> 6) * 16 + f) : (1024 + (t & 63) * 16 + f); const float cs = rope[ti], sn = rope[ti + ((qd < 2) ? 512 : 1024)];
                        const float sg = (qd & 1) ? sn : -sn; r = r * cs + rp * sg; k = k * cs + kp * sg; }
                    const float kkr = k * kkc; const float ss = wave_sum(kkr * kkr); const float kk = kkr / fmaxf(sqrtf(ss), 1e-12f);
                    float u = w0c, av = a0c;
#pragma unroll
                    for (int j = 0; j < 32; j += 4) { const f32x4 z1 = *(const LAS f32x4*)(zl + tl * 64 + j), z2 = *(const LAS f32x4*)(zl + tl * 64 + 32 + j);
                        u += z1.x * w2c[j] + z1.y * w2c[j + 1] + z1.z * w2c[j + 2] + z1.w * w2c[j + 3]; av += z2.x * a2c[j] + z2.y * a2c[j + 1] + z2.z * a2c[j + 2] + z2.w * a2c[j + 3]; }
                    const float w = expf(-0.6065306597126334f * sigmoidf_(u)), aa = sigmoidf_(av);
                    const float kd = k * (1.0f + (aa - 1.0f) * kac), nb = -kk * aa;
                    const float c1 = wave_sum(nb * r), c2 = wave_sum(kd * r), bon = wave_sum(r * kd * rkc);
                    LAS float* o = ops + tl * 384 + c; o[0] = kk; o[64] = w * r; o[128] = w; o[192] = nb; o[256] = kd; o[320] = zv[i];
                    if (lane == 0) { scal[tl * 4] = c1; scal[tl * 4 + 1] = c2; BON[((size_t)d * NTOK + rowbase + t) * 8 + h] = bon; }
                }
                __syncthreads();
#pragma unroll 2
                for (int s = 0; s < TB; ++s) {
                    const int tl = d ? (TB - 1 - s) : s; const LAS float* o = ops + tl * 384 + kq * 8;
                    const f32x4 ka = *(const LAS f32x4*)(o), kb = *(const LAS f32x4*)(o + 4), ra = *(const LAS f32x4*)(o + 64), rb = *(const LAS f32x4*)(o + 68);
                    const f32x4 wa = *(const LAS f32x4*)(o + 128), wb = *(const LAS f32x4*)(o + 132), na = *(const LAS f32x4*)(o + 192), nb_ = *(const LAS f32x4*)(o + 196);
                    const f32x4 da = *(const LAS f32x4*)(o + 256), db = *(const LAS f32x4*)(o + 260);
                    const float vv = ops[tl * 384 + 320 + vrow], c1 = scal[tl * 4], c2 = scal[tl * 4 + 1];
                    float sk = S[0] * ka.x + S[1] * ka.y + S[2] * ka.z + S[3] * ka.w + S[4] * kb.x + S[5] * kb.y + S[6] * kb.z + S[7] * kb.w;
                    float yy = S[0] * ra.x + S[1] * ra.y + S[2] * ra.z + S[3] * ra.w + S[4] * rb.x + S[5] * rb.y + S[6] * rb.z + S[7] * rb.w;
                    sk = red8(sk); yy = red8(yy);
                    const float y = yy + sk * c1 + vv * c2;
                    S[0] = S[0] * wa.x + sk * na.x + vv * da.x; S[1] = S[1] * wa.y + sk * na.y + vv * da.y; S[2] = S[2] * wa.z + sk * na.z + vv * da.z; S[3] = S[3] * wa.w + sk * na.w + vv * da.w;
                    S[4] = S[4] * wb.x + sk * nb_.x + vv * db.x; S[5] = S[5] * wb.y + sk * nb_.y + vv * db.y; S[6] = S[6] * wb.z + sk * nb_.z + vv * db.z; S[7] = S[7] * wb.w + sk * nb_.w + vv * db.w;
                    if (kq == 0) ybuf[tl * 64 + vrow] = y;
                }
                __syncthreads();
#pragma unroll
                for (int i = 0; i < 4; ++i) { const int tl = wv + 8 * i; YD[((size_t)d * NTOK + rowbase + t0 + tl) * 512 + h * 64 + c] = ybuf[tl * 64 + c]; }
            }
        }
        __syncthreads();
    }
}

typedef short v4i16_t __attribute__((ext_vector_type(4)));
__device__ __forceinline__ int swz_off(int row, int chunk) { return row * 128 + ((chunk ^ (row & 7)) << 4); }
__device__ __forceinline__ void stage_rows(LAS unsigned char* dst, const bf16* src, int nrows, int tid) {
    for (int idx = tid; idx < nrows * 8; idx += 512) { const int r = idx >> 3, ch = idx & 7; const v4u v = *(const GAS v4u*)(src + (size_t)r * DINP + ch * 8); *(LAS v4u*)(dst + swz_off(r, ch)) = v; }
}
struct AttState { float m, l; f32x4 o[4]; };
template <bool LOCAL>
__device__ __forceinline__ void att_kstep(AttState& st, const LAS unsigned char* kb, const LAS unsigned char* vb, int r0, int r1, const bf16x8 (&qf)[2], int lane,
                                          const LAS float* rpbrow, int kc0, int qc, int cs) {
    const int kl = lane & 15, g = lane >> 4;
    f32x4 s0 = {0.f, 0.f, 0.f, 0.f}, s1 = {0.f, 0.f, 0.f, 0.f};
#pragma unroll
    for (int dh = 0; dh < 2; ++dh) {
        const bf16x8 k0 = *(const LAS bf16x8*)(kb + swz_off(r0 + kl, dh * 4 + g)); const bf16x8 k1 = *(const LAS bf16x8*)(kb + swz_off(r1 + kl, dh * 4 + g));
        s0 = __builtin_amdgcn_mfma_f32_16x16x32_bf16(k0, qf[dh], s0, 0, 0, 0); s1 = __builtin_amdgcn_mfma_f32_16x16x32_bf16(k1, qf[dh], s1, 0, 0, 0);
    }
    float sc[8];
#pragma unroll
    for (int j = 0; j < 4; ++j) { sc[j] = s0[j] * 0.125f; sc[4 + j] = s1[j] * 0.125f; }
    if (LOCAL) {
        float bv[8]; bool ok[8];
#pragma unroll
        for (int j = 0; j < 8; ++j) { const int kc = kc0 + (j >> 2) * 16 + 4 * g + (j & 3); ok[j] = (kc >= cs) && (kc < cs + 16); const int bi = ok[j] ? (kc - qc + 15) : 0;
            const unsigned ad = (unsigned)(uintptr_t)(rpbrow + bi); asm volatile("ds_read_b32 %0, %1" : "=v"(bv[j]) : "v"(ad)); }
        asm volatile("s_waitcnt lgkmcnt(0)" : "+v"(bv[0]), "+v"(bv[1]), "+v"(bv[2]), "+v"(bv[3]), "+v"(bv[4]), "+v"(bv[5]), "+v"(bv[6]), "+v"(bv[7]) :: "memory");
#pragma unroll
        for (int j = 0; j < 8; ++j) sc[j] = ok[j] ? sc[j] + bv[j] : -INFINITY;
    }
    float mt = fmaxf(fmaxf(fmaxf(sc[0], sc[1]), fmaxf(sc[2], sc[3])), fmaxf(fmaxf(sc[4], sc[5]), fmaxf(sc[6], sc[7])));
    mt = fmaxf(mt, shx(mt, 16, lane)); mt = fmaxf(mt, shx(mt, 32, lane));
    const float mn = fmaxf(st.m, mt); const bool dead = (mn == -INFINITY);
    const float scale = dead ? 1.0f : __expf(st.m - mn);
    float p[8], ps = 0.f;
#pragma unroll
    for (int j = 0; j < 8; ++j) { p[j] = dead ? 0.f : __expf(sc[j] - mn); ps += p[j]; }
    st.l = st.l * scale + ps; st.m = mn;
#pragma unroll
    for (int dt = 0; dt < 4; ++dt) st.o[dt] = st.o[dt] * scale;
    v4u pw; pw.x = pk2(p[0], p[1]); pw.y = pk2(p[2], p[3]); pw.z = pk2(p[4], p[5]); pw.w = pk2(p[6], p[7]);
    const bf16x8 pf = __builtin_bit_cast(bf16x8, pw);
    const int q_ = kl >> 2, p_ = kl & 3;
#pragma unroll
    for (int dt = 0; dt < 4; ++dt) {
        const v4i16_t lo = __builtin_amdgcn_ds_read_tr16_b64_v4i16((LAS v4i16_t*)(vb + swz_off(r0 + 4 * g + q_, 2 * dt + (p_ >> 1)) + (p_ & 1) * 8));
        const v4i16_t hi = __builtin_amdgcn_ds_read_tr16_b64_v4i16((LAS v4i16_t*)(vb + swz_off(r1 + 4 * g + q_, 2 * dt + (p_ >> 1)) + (p_ & 1) * 8));
        const bf16x8 vf = (bf16x8){lo[0], lo[1], lo[2], lo[3], hi[0], hi[1], hi[2], hi[3]};
        st.o[dt] = __builtin_amdgcn_mfma_f32_16x16x32_bf16(vf, pf, st.o[dt], 0, 0, 0);
    }
}
__device__ __forceinline__ void att_merge_store(AttState& st, LAS float* mrg, int qb, int kh, int lane, bf16* orow0  ) {
    LAS float* mine = mrg + qb * (18 * 64) + lane;
    if (kh == 1) { mine[0] = st.m; mine[64] = st.l;
#pragma unroll
        for (int dt = 0; dt < 4; ++dt)
#pragma unroll
            for (int j = 0; j < 4; ++j) mine[(2 + dt * 4 + j) * 64] = st.o[dt][j]; }
    __syncthreads();
    if (kh == 0) {
        const float m1 = mine[0], l1 = mine[64]; const float ms = fmaxf(st.m, m1); const float f0 = __expf(st.m - ms), f1 = __expf(m1 - ms);
        float lc = st.l * f0 + l1 * f1; lc += shx(lc, 16, lane); lc += shx(lc, 32, lane); const float inv = 1.0f / lc;
        const int q = lane & 15, g = lane >> 4;
#pragma unroll
        for (int dt = 0; dt < 4; ++dt) { float r[4];
#pragma unroll
            for (int j = 0; j < 4; ++j) r[j] = (st.o[dt][j] * f0 + mine[(2 + dt * 4 + j) * 64] * f1) * inv;
            v2u w; w.x = pk2(r[0], r[1]); w.y = pk2(r[2], r[3]); *(GAS v2u*)(orow0 + (size_t)q * DM + dt * 16 + 4 * g) = w; }
    }
}
__device__ __forceinline__ void phase_attn(LAS unsigned char* lds, int l) {
    const KA a = ka_get();
    const int tid = opaque_tid(), lane = tid & 63, wv = __builtin_amdgcn_readfirstlane(tid >> 6), qb = wv & 3, kh = wv >> 2;
    LAS unsigned char* KC = lds; LAS unsigned char* VC = lds + 32768; LAS unsigned char* KL = lds + 65536; LAS unsigned char* VL = lds + 98304;
    LAS float* RPB = (LAS float*)(lds + LDSCTL_OFF + 2048); LAS float* mrg = (LAS float*)KL;
    const bf16* PX = (const bf16*)(a.ws() + WS_X2); bf16* CAT = (bf16*)(a.ws() + WS_X1);
    for (int blk = blockIdx.x; blk < 256; blk += gridDim.x) {
        const int bh = blk >> 1, b = bh >> 3, h = bh & 7, half = blk & 1;
        __syncthreads();
        const bf16* ctxrow = PX + (size_t)(NTX + b * CTXL) * DINP + h * 64;
        stage_rows(KC, ctxrow + 512, 256, tid); stage_rows(VC, ctxrow + 1024, 256, tid);
        for (int i = tid; i < 465; i += 512) RPB[i] = a.in(I_RPB)[((size_t)l * 8 + h) * 465 + i];
        __syncthreads();
        const int kl = lane & 15, g = lane >> 4;
        if (l == 0) {
            for (int rr = 0; rr < 2; ++rr) {
                const int q0 = (half * 8 + rr * 4 + qb) * 16; const bf16* qrow = ctxrow + (size_t)(q0 + kl) * DINP;
                bf16x8 qf[2]; qf[0] = *(const GAS bf16x8*)(qrow + 8 * g); qf[1] = *(const GAS bf16x8*)(qrow + 32 + 8 * g);
                AttState st; st.m = -INFINITY; st.l = 0.f;
#pragma unroll
                for (int dt = 0; dt < 4; ++dt) st.o[dt] = (f32x4){0.f, 0.f, 0.f, 0.f};
                for (int s = 0; s < 4; ++s) att_kstep<false>(st, KC, VC, kh * 128 + s * 32, kh * 128 + s * 32 + 16, qf, lane, RPB, 0, 0, 0);
                att_merge_store(st, mrg, qb, kh, lane, CAT + (size_t)(NTX + b * CTXL + q0) * DM + h * 64);
                __syncthreads();
            }
        }
        v4u pfk[4], pfv[4];
#define ATT_ISSUE(SIDX) do { const int i_ = half * 16 + ((SIDX) >> 1); const int rs_ = min(max(i_ - 4, 0), 24); const bf16* lr_ = PX + (size_t)(b * SEQ + (rs_ + 4 * ((SIDX) & 1)) * 64) * DINP + h * 64; \
            _Pragma("unroll") for (int q__ = 0; q__ < 4; ++q__) { const int idx_ = tid + 512 * q__; const bf16* p_ = lr_ + (size_t)(idx_ >> 3) * DINP + (idx_ & 7) * 8; pfk[q__] = *(const GAS v4u*)(p_ + 512); pfv[q__] = *(const GAS v4u*)(p_ + 1024); } } while (0)
        ATT_ISSUE(0);
        bf16x8 qn[2]; { const bf16* qrow = PX + (size_t)(b * SEQ + (half * 16) * 64 + qb * 16 + kl) * DINP + h * 64; qn[0] = *(const GAS bf16x8*)(qrow + 8 * g); qn[1] = *(const GAS bf16x8*)(qrow + 32 + 8 * g); }
        for (int ui = 0; ui < 16; ++ui) {
            const int i = half * 16 + ui; const int rs = min(max(i - 4, 0), 24);
            const int qc = qb * 16 + kl, cs = min(max(qc - 8, 0), 48), wc0 = min(max(qb * 16 - 8, 0), 32);
            bf16x8 qf[2]; qf[0] = qn[0]; qf[1] = qn[1];
            { const int in_ = half * 16 + (ui < 15 ? ui + 1 : ui); const bf16* qrow = PX + (size_t)(b * SEQ + in_ * 64 + qc) * DINP + h * 64; qn[0] = *(const GAS bf16x8*)(qrow + 8 * g); qn[1] = *(const GAS bf16x8*)(qrow + 32 + 8 * g); }
            AttState st; st.m = -INFINITY; st.l = 0.f;
#pragma unroll
            for (int dt = 0; dt < 4; ++dt) st.o[dt] = (f32x4){0.f, 0.f, 0.f, 0.f};
            for (int s = 0; s < 4; ++s) att_kstep<false>(st, KC, VC, kh * 128 + s * 32, kh * 128 + s * 32 + 16, qf, lane, RPB, 0, 0, 0);
            for (int pass = 0; pass < 2; ++pass) {
                __syncthreads();
#pragma unroll
                for (int q__ = 0; q__ < 4; ++q__) { const int idx_ = tid + 512 * q__; const int o_ = swz_off(idx_ >> 3, idx_ & 7); *(LAS v4u*)(KL + o_) = pfk[q__]; *(LAS v4u*)(VL + o_) = pfv[q__]; }
                __syncthreads();
                if (2 * ui + pass + 1 < 32) ATT_ISSUE(2 * ui + pass + 1);
                for (int k2 = 0; k2 < 2; ++k2) { const int kr = 2 * kh + k2, arow = rs + 4 * pass + kr;
                    att_kstep<true>(st, KL, VL, kr * 64 + wc0, kr * 64 + wc0 + 16, qf, lane, RPB + (arow - i + 7) * 31, wc0, qc, cs); }
            }
            __syncthreads();
            att_merge_store(st, mrg, qb, kh, lane, CAT + (size_t)(b * SEQ + i * 64 + qb * 16) * DM + h * 64);
        }
    }
}

__device__ __forceinline__ void phase_rwpost(LAS unsigned char* lds, int l) {
    const KA a = ka_get();
    const int tid = opaque_tid(), lane = tid & 63, hh = __builtin_amdgcn_readfirstlane(tid >> 6), kl = lane & 15, g = lane >> 4;
    const int er = tid >> 5, cq = tid & 31, c0 = cq * 16, hq = cq >> 2;
    LAS bf16* sig = (LAS bf16*)lds;
    LAS float* Gl = (LAS float*)(lds + 4096);
    const bf16* PX = (const bf16*)(a.ws() + WS_X2); const float* YD = (const float*)(a.ws() + WS_X3); const float* BON = (const float*)(a.ws() + WS_BONUS); bf16* CAT = (bf16*)(a.ws() + WS_X1);
    const float* mup = a.in(I_MUP) + l * 1760; const float* mun = a.in(I_MUN) + l * 1760; const float* g2 = a.in(I_G2) + (size_t)l * 96 * 512;
    const float* gngp = a.in(I_GNG) + l * 512 + c0; const float* gnbp = a.in(I_GNB) + l * 512 + c0;
    bf16x8 gb[3][4];
#pragma unroll
    for (int ks = 0; ks < 3; ++ks)
#pragma unroll
        for (int nt = 0; nt < 4; ++nt) { v4u w; unsigned t[8];
#pragma unroll
            for (int j = 0; j < 8; ++j) t[j] = f2bf(g2[(size_t)(32 * ks + 8 * g + j) * 512 + 64 * hh + 16 * nt + kl]);
            w.x = t[0] | (t[1] << 16); w.y = t[2] | (t[3] << 16); w.z = t[4] | (t[5] << 16); w.w = t[6] | (t[7] << 16); gb[ks][nt] = __builtin_bit_cast(bf16x8, w); }
    const int nch = (l == 0 ? NTOK : NTX) / 16;
    for (int ch = blockIdx.x; ch < nch; ch += gridDim.x) {
        const int row0 = ch * 16;
        __syncthreads();
        for (int idx = tid; idx < 1536; idx += 512) { const int r = idx / 96, j = idx - r * 96, row = row0 + r; int t, T; if (row < NTX) { t = row & (SEQ - 1); T = SEQ; } else { t = (row - NTX) & (CTXL - 1); T = CTXL; }
            const bf16* p = PX + (size_t)row * DINP + RWOFF + 1664 + j; const int op = t > 0 ? -DINP : 0, on = t + 1 < T ? DINP : 0;
            const float cv = bf2f(p[0]), pv = bf2f(p[op]) * (t > 0 ? 1.f : 0.f), nv = bf2f(p[on]) * (t + 1 < T ? 1.f : 0.f);
            const float z = cv + mup[1664 + j] * (pv - cv) + mun[1664 + j] * (nv - cv); sig[r * 96 + j] = f2bf1(sigmoidf_(z)); }
        const int row = row0 + er; int t, T; if (row < NTX) { t = row & (SEQ - 1); T = SEQ; } else { t = (row - NTX) & (CTXL - 1); T = CTXL; }
        const bf16* pvp = PX + (size_t)row * DINP + RWOFF + 1024 + c0; const int op = t > 0 ? -DINP : 0, on = t + 1 < T ? DINP : 0; const float fp = t > 0 ? 1.f : 0.f, fn = t + 1 < T ? 1.f : 0.f;
        v4u vc[2], vp[2], vn[2]; f32x4 y0[4], y1[4];
#pragma unroll
        for (int i = 0; i < 2; ++i) { vc[i] = *(const GAS v4u*)(pvp + 8 * i); vp[i] = *(const GAS v4u*)(pvp + op + 8 * i); vn[i] = *(const GAS v4u*)(pvp + on + 8 * i); }
#pragma unroll
        for (int i = 0; i < 4; ++i) { y0[i] = *(const GAS f32x4*)(YD + (size_t)row * 512 + c0 + 4 * i); y1[i] = *(const GAS f32x4*)(YD + ((size_t)NTOK + row) * 512 + c0 + 4 * i); }
        const float bon = BON[(size_t)row * 8 + hq] + BON[((size_t)NTOK + row) * 8 + hq];
        __syncthreads();
        { f32x4 acc[4];
#pragma unroll
          for (int nt = 0; nt < 4; ++nt) acc[nt] = (f32x4){0.f, 0.f, 0.f, 0.f};
#pragma unroll
          for (int ks = 0; ks < 3; ++ks) { const bf16x8 af = *(const LAS bf16x8*)(sig + kl * 96 + 32 * ks + 8 * g);
#pragma unroll
              for (int nt = 0; nt < 4; ++nt) acc[nt] = __builtin_amdgcn_mfma_f32_16x16x32_bf16(af, gb[ks][nt], acc[nt], 0, 0, 0); }
#pragma unroll
          for (int nt = 0; nt < 4; ++nt)
#pragma unroll
              for (int j = 0; j < 4; ++j) Gl[(4 * g + j) * 512 + 64 * hh + 16 * nt + kl] = acc[nt][j]; }
        __syncthreads();
        f32x4 y[4]; float s = 0.f;
#pragma unroll
        for (int i = 0; i < 4; ++i) { y[i] = y0[i] + y1[i]; s += (y[i].x + y[i].y) + (y[i].z + y[i].w); }
        s += dppmov<0xB1>(s); s += dppmov<0x4E>(s); const float mean = s * (1.0f / 64.0f); float q = 0.f;
#pragma unroll
        for (int i = 0; i < 4; ++i) { y[i] = y[i] - mean; q += (y[i].x * y[i].x + y[i].y * y[i].y) + (y[i].z * y[i].z + y[i].w * y[i].w); }
        q += dppmov<0xB1>(q); q += dppmov<0x4E>(q); const float rstd = 1.0f / sqrtf(q * (1.0f / 64.0f) + GN_EPS);
        unsigned ow[8]; f32x4 mpvv[4], mnvv[4], gngv[4], gnbv[4];
#pragma unroll
        for (int i = 0; i < 4; ++i) { mpvv[i] = *(const GAS f32x4*)(mup + 1024 + c0 + 4 * i); mnvv[i] = *(const GAS f32x4*)(mun + 1024 + c0 + 4 * i); gngv[i] = *(const GAS f32x4*)(gngp + 4 * i); gnbv[i] = *(const GAS f32x4*)(gnbp + 4 * i); }
#pragma unroll
        for (int i = 0; i < 4; ++i) { const unsigned cw0 = vc[i >> 1][(i & 1) * 2], cw1 = vc[i >> 1][(i & 1) * 2 + 1], pw0 = vp[i >> 1][(i & 1) * 2], pw1 = vp[i >> 1][(i & 1) * 2 + 1], nw0 = vn[i >> 1][(i & 1) * 2], nw1 = vn[i >> 1][(i & 1) * 2 + 1];
            const f32x4 cv = {bflo(cw0), bfhi(cw0), bflo(cw1), bfhi(cw1)}, pv = {bflo(pw0) * fp, bfhi(pw0) * fp, bflo(pw1) * fp, bfhi(pw1) * fp}, nv = {bflo(nw0) * fn, bfhi(nw0) * fn, bflo(nw1) * fn, bfhi(nw1) * fn};
            const f32x4 mpv = mpvv[i], mnv = mnvv[i], gng = gngv[i], gnb = gnbv[i];
            const f32x4 zv = cv + mpv * (pv - cv) + mnv * (nv - cv);
            const f32x4 gt = *(const LAS f32x4*)(Gl + er * 512 + c0 + 4 * i);
            const f32x4 o = (y[i] * rstd * gng + gnb + zv * bon) * gt;
            ow[2 * i] = pk2(o.x, o.y); ow[2 * i + 1] = pk2(o.z, o.w); }
        GAS v4u* dst = (GAS v4u*)(CAT + (size_t)row * DM + 512 + c0); dst[0] = (v4u){ow[0], ow[1], ow[2], ow[3]}; dst[1] = (v4u){ow[4], ow[5], ow[6], ow[7]};
    }
}

__device__ __forceinline__ void phase_ln1_route(LAS unsigned char* lds, int l) {
    const KA a = ka_get();
    const int tid = opaque_tid(), lane = tid & 63, wave = __builtin_amdgcn_readfirstlane(tid >> 6), G = gridDim.x, bid = blockIdx.x;
    const int gw = bid * 8 + wave, NGW = G * 8;
    LAS float* rwt = (LAS float*)lds;
#pragma unroll
    for (int i = tid; i < 8192; i += 512) { const int k = i >> 3, eg = i & 7; const f32x4 w4 = *(const GAS f32x4*)(a.in(I_RW) + k * 32 + 4 * eg);
        rwt[(4 * eg) * 1024 + k] = w4.x; rwt[(4 * eg + 1) * 1024 + k] = w4.y; rwt[(4 * eg + 2) * 1024 + k] = w4.z; rwt[(4 * eg + 3) * 1024 + k] = w4.w; }
    if (tid < 32) ((LAS int*)(lds + LDSCTL_OFF + 1024))[tid] = 0;
    __syncthreads();
    const float* mods = (const float*)(a.ws() + WS_MODS) + (size_t)l * 17 * 6144;
    const bf16* O = (const bf16*)(a.ws() + WS_X3); bf16* HM = (bf16*)(a.ws() + WS_X1);
    const float* xs = l == 0 ? a.in(I_X) : a.out(); const float* cs = l == 0 ? a.in(I_CTX) : (const float*)(a.ws() + WS_CS);
    float* xo = a.out(); float* co = (float*)(a.ws() + WS_CS);
    int* HIST = (int*)(a.ws() + WS_LIST); TokInfo* TOK = (TokInfo*)(a.ws() + WS_TOK); LAS int* lcnt = (LAS int*)(lds + LDSCTL_OFF + 1024);
    const GAS f32x4* lg = (const GAS f32x4*)(a.in(I_LN1G) + l * DM) + lane; const GAS f32x4* lb = (const GAS f32x4*)(a.in(I_LN1B) + l * DM) + lane;
    const int Mrows = l == 0 ? NTOK : NTX;
    const float biasv = a.in(I_RB)[(lane >> 1) & 31];
    f32x4 lgv[4], lbv[4];
#pragma unroll
    for (int j = 0; j < 4; ++j) { lgv[j] = lg[64 * j]; lbv[j] = lb[64 * j]; }
    f32x4 nx[4]; v2u no[4];
#define LN1_FETCH(M) do { const int m_ = (M) < Mrows ? (M) : gw; const float* s_ = m_ < NTX ? xs + (size_t)m_ * DM : cs + (size_t)(m_ - NTX) * DM; \
        const GAS f32x4* xr_ = (const GAS f32x4*)s_ + lane; const GAS v2u* or_ = (const GAS v2u*)(O + (size_t)m_ * DM) + lane; \
        _Pragma("unroll") for (int j_ = 0; j_ < 4; ++j_) { nx[j_] = xr_[64 * j_]; no[j_] = or_[64 * j_]; } } while (0)
    LN1_FETCH(gw);
    for (int m = gw; m < Mrows; m += NGW) {
        float* dst; int mr;
        if (m < NTX) { dst = xo + (size_t)m * DM; mr = m / SEQ; } else { dst = co + (size_t)(m - NTX) * DM; mr = 16; }
        const GAS f32x4* md = (const GAS f32x4*)(mods + (size_t)mr * 6144) + lane;
        f32x4 v[4], sc2[4], sh2[4], gt1[4]; float s = 0.f;
#pragma unroll
        for (int j = 0; j < 4; ++j) { gt1[j] = md[512 + 64 * j]; sc2[j] = md[1024 + 64 * j]; sh2[j] = md[768 + 64 * j]; }
#pragma unroll
        for (int j = 0; j < 4; ++j) { const f32x4 x = nx[j], gt = gt1[j]; const v2u ow = no[j]; const f32x4 o = {bflo(ow.x), bfhi(ow.x), bflo(ow.y), bfhi(ow.y)};
            v[j] = x * ALPHA + gt * o; s += (v[j].x + v[j].y) + (v[j].z + v[j].w); }
        LN1_FETCH(m + NGW);
        const float mean = wave_sum(s) * (1.f / DM); float s2 = 0.f;
#pragma unroll
        for (int j = 0; j < 4; ++j) { v[j] = v[j] - mean; s2 += (v[j].x * v[j].x + v[j].y * v[j].y) + (v[j].z * v[j].z + v[j].w * v[j].w); }
        const float rstd = 1.f / sqrtf(wave_sum(s2) * (1.f / DM) + LN_EPS);
        float part[32];
#pragma unroll
        for (int e = 0; e < 32; ++e) part[e] = 0.f;
        GAS f32x4* dr = (GAS f32x4*)dst + lane; GAS v2u* hr = (GAS v2u*)(HM + (size_t)m * DM) + lane;
#pragma unroll
        for (int j = 0; j < 4; ++j) { const f32x4 x1 = v[j] * rstd * lgv[j] + lbv[j]; dr[64 * j] = x1;
            const f32x4 hm = x1 * (sc2[j] + 1.0f) + sh2[j]; v2u w; w.x = pk2(hm.x, hm.y); w.y = pk2(hm.z, hm.w); hr[64 * j] = w;
#pragma unroll
            for (int e8 = 0; e8 < 4; ++e8) { f32x4 rw[8]; const unsigned ra = (unsigned)((256 * j + 4 * lane) * 4 + (e8 >> 1) * 65536);
#pragma unroll
                for (int q = 0; q < 8; ++q) asm volatile("ds_read_b128 %0, %1 offset:%2" : "=v"(rw[q]) : "v"(ra), "i"(((e8 & 1) * 8 + q) * 4096));
                asm volatile("s_waitcnt lgkmcnt(0)" : "+v"(rw[0]), "+v"(rw[1]), "+v"(rw[2]), "+v"(rw[3]), "+v"(rw[4]), "+v"(rw[5]), "+v"(rw[6]), "+v"(rw[7]) :: "memory");
#pragma unroll
                for (int q = 0; q < 8; ++q) part[e8 * 8 + q] += hm.x * rw[q].x + hm.y * rw[q].y + hm.z * rw[q].z + hm.w * rw[q].w;
#ifdef PROBE_ROUTER
                { f32x4 rw2[8];
#pragma unroll
                  for (int q = 0; q < 8; ++q) asm volatile("ds_read_b128 %0, %1 offset:%2" : "=v"(rw2[q]) : "v"(ra), "i"(((e8 & 1) * 8 + q) * 4096));
                  asm volatile("s_waitcnt lgkmcnt(0)" : "+v"(rw2[0]), "+v"(rw2[1]), "+v"(rw2[2]), "+v"(rw2[3]), "+v"(rw2[4]), "+v"(rw2[5]), "+v"(rw2[6]), "+v"(rw2[7]) :: "memory");
#pragma unroll
                  for (int q = 0; q < 8; ++q) { float dmy = hm.x * rw2[q].x + hm.y * rw2[q].y + hm.z * rw2[q].z + hm.w * rw2[q].w; asm volatile("" :: "v"(dmy)); } }
#endif
            } }
        float p16[16], p8[8], p4[4], p2[2], p1;
        { const bool up = (lane & 32) != 0;
#pragma unroll
          for (int e = 0; e < 16; ++e) { const float mine = up ? part[16 + e] : part[e], oth = up ? part[e] : part[16 + e]; p16[e] = mine + shx(oth, 32, lane); } }
        { const bool up = (lane & 16) != 0;
#pragma unroll
          for (int e = 0; e < 8; ++e) { const float mine = up ? p16[8 + e] : p16[e], oth = up ? p16[e] : p16[8 + e]; p8[e] = mine + shx(oth, 16, lane); } }
        { const bool up = (lane & 8) != 0;
#pragma unroll
          for (int e = 0; e < 4; ++e) { const float mine = up ? p8[4 + e] : p8[e], oth = up ? p8[e] : p8[4 + e]; p4[e] = mine + dppmov<0x128>(oth); } }
        { const bool up = (lane & 4) != 0;
#pragma unroll
          for (int e = 0; e < 2; ++e) { const float mine = up ? p4[2 + e] : p4[e], oth = up ? p4[e] : p4[2 + e]; p2[e] = mine + shx(oth, 4, lane); } }
        { const bool up = (lane & 2) != 0; const float mine = up ? p2[1] : p2[0], oth = up ? p2[0] : p2[1]; p1 = mine + dppmov<0x4E>(oth); }
        const float logit = p1 + dppmov<0xB1>(p1);
        const float score = sigmoidf_(logit), sel = score + biasv;
        const int gl = lane & ~7;
        const float q0 = shi(sel, gl), q1 = shi(sel, gl + 2), q2 = shi(sel, gl + 4), q3 = shi(sel, gl + 6);
        const float mx = fmaxf(fmaxf(q0, q1), fmaxf(q2, q3));
        float top2;
        { float a0 = q0, a1 = q1, a2 = q2, a3 = q3; float t;
          if (a0 < a1) { t = a0; a0 = a1; a1 = t; } if (a2 < a3) { t = a2; a2 = a3; a3 = t; } if (a0 < a2) { t = a0; a0 = a2; a2 = t; } if (a1 < a3) { t = a1; a1 = a3; a3 = t; } if (a1 < a2) { t = a1; a1 = a2; a2 = t; }
          top2 = a0 + a1; (void)mx; }
        float best = __builtin_bit_cast(float, __builtin_amdgcn_readlane(__builtin_bit_cast(int, top2), 0)); int gidx = 0;
#pragma unroll
        for (int gg = 1; gg < 8; ++gg) { const float sc = __builtin_bit_cast(float, __builtin_amdgcn_readlane(__builtin_bit_cast(int, top2), gg * 8)); if (sc > best) { best = sc; gidx = gg; } }
        const float r0 = shi(sel, gidx * 8), r1 = shi(sel, gidx * 8 + 2), r2 = shi(sel, gidx * 8 + 4), r3 = shi(sel, gidx * 8 + 6);
        int i0 = 0; float b0 = r0; if (r1 > b0) { b0 = r1; i0 = 1; } if (r2 > b0) { b0 = r2; i0 = 2; } if (r3 > b0) { b0 = r3; i0 = 3; }
        int i1 = -1; float b1 = -INFINITY;
        if (i0 != 0 && r0 > b1) { b1 = r0; i1 = 0; } if (i0 != 1 && r1 > b1) { b1 = r1; i1 = 1; } if (i0 != 2 && r2 > b1) { b1 = r2; i1 = 2; } if (i0 != 3 && r3 > b1) { b1 = r3; i1 = 3; }
        const int e0 = gidx * 4 + i0, e1 = gidx * 4 + i1;
        const float s0 = shi(score, 2 * e0), s1 = shi(score, 2 * e1); const float gs = 1.0f / (s0 + s1);
        if (lane == 0) { const int p0 = __hip_atomic_fetch_add(lcnt + e0, 1, __ATOMIC_RELAXED, __HIP_MEMORY_SCOPE_WORKGROUP), p1_ = __hip_atomic_fetch_add(lcnt + e1, 1, __ATOMIC_RELAXED, __HIP_MEMORY_SCOPE_WORKGROUP);
            TokInfo ti; ti.e0 = e0; ti.e1 = e1; ti.p0 = p0; ti.p1 = p1_; ti.g0 = s0 * gs; ti.g1 = s1 * gs; ti.pad0 = 0; ti.pad1 = 0; TOK[m] = ti; }
    }
    __syncthreads();
    if (tid < 32) HIST[bid * 32 + tid] = lcnt[tid];
}

template <bool FULL> __device__ __forceinline__ void moe_tables(LAS unsigned char* lds, int l) {
    const KA a = ka_get(); const int tid = opaque_tid(), G = gridDim.x;
    LAS int* pref = (LAS int*)(lds + PREF_OFF); LAS int* bb = (LAS int*)lds; LAS int* tot = (LAS int*)(lds + 65536);
    const int* HIST = (const int*)(a.ws() + WS_LIST);
    __syncthreads();
    const int e = tid & 31, grp = tid >> 5;
    int loc[16]; int run = 0;
#pragma unroll
    for (int i = 0; i < 16; ++i) { const int b = grp * 16 + i; loc[i] = (b < G) ? HIST[b * 32 + e] : 0; }
#pragma unroll
    for (int i = 0; i < 16; ++i) { const int v = loc[i]; loc[i] = run; run += v; }
    tot[grp * 32 + e] = run;
    __syncthreads();
    int base = 0, total = 0;
#pragma unroll
    for (int q = 0; q < 16; ++q) { const int v = tot[q * 32 + e]; base += (q < grp) ? v : 0; total += v; }
    if (FULL) {
#pragma unroll
        for (int i = 0; i < 16; ++i) bb[(grp * 16 + i) * 32 + e] = base + loc[i]; }
    if (grp == 0) pref[40 + e] = total;
    __syncthreads();
    if (tid == 0) { int acc = 0; for (int k = 0; k < 32; ++k) { pref[k] = acc; acc += (pref[40 + k] + 255) >> 8; } pref[32] = acc; }
    __syncthreads();
}
__device__ __forceinline__ void phase_gather(LAS unsigned char* lds, int l) {
    const KA a = ka_get();
    const int tid = opaque_tid(), lane = tid & 63, wave = __builtin_amdgcn_readfirstlane(tid >> 6), G = gridDim.x, bid = blockIdx.x;
    const int gw = bid * 8 + wave, NGW = G * 8;
    moe_tables<true>(lds, l);
    const LAS int* pref = (const LAS int*)(lds + PREF_OFF); const LAS int* bb = (const LAS int*)lds;
    const bf16* HM = (const bf16*)(a.ws() + WS_X1); bf16* XB = (bf16*)(a.ws() + WS_X2); const TokInfo* TOK = (const TokInfo*)(a.ws() + WS_TOK);
    const int Mrows = l == 0 ? NTOK : NTX;
    for (int m = gw; m < Mrows; m += NGW) {
        const TokInfo ti = TOK[m]; const int blk = (m % NGW) >> 3;
        const int sl0 = pref[ti.e0] * 256 + bb[blk * 32 + ti.e0] + ti.p0, sl1 = pref[ti.e1] * 256 + bb[blk * 32 + ti.e1] + ti.p1;
        const GAS v4u* srcp = (const GAS v4u*)(HM + (size_t)m * DM) + lane; const v4u v0 = srcp[0], v1 = srcp[64];
        GAS v4u* d0 = (GAS v4u*)(XB + (size_t)sl0 * DM) + lane; GAS v4u* d1 = (GAS v4u*)(XB + (size_t)sl1 * DM) + lane;
        d0[0] = v0; d0[64] = v1; d1[0] = v0; d1[64] = v1;
    }
    for (int e = 0; e < 32; ++e) {
        const int c = pref[40 + e], npad = ((c + 255) & ~255) - c, r0 = pref[e] * 256 + c;
        for (int r = gw; r < npad; r += NGW) { GAS v4u* dst = (GAS v4u*)(XB + (size_t)(r0 + r) * DM) + lane; dst[0] = (v4u){0u, 0u, 0u, 0u}; dst[64] = (v4u){0u, 0u, 0u, 0u}; }
    }
}

__device__ __forceinline__ void phase_ln2(LAS unsigned char* lds, int l) {
    const KA a = ka_get();
    const int tid = opaque_tid(), lane = tid & 63, wave = __builtin_amdgcn_readfirstlane(tid >> 6), G = gridDim.x, bid = blockIdx.x;
    const int gw = bid * 8 + wave, NGW = G * 8;
    moe_tables<true>(lds, l);
    const LAS int* pref = (const LAS int*)(lds + PREF_OFF); const LAS int* bb = (const LAS int*)lds;
    const float* mods = (const float*)(a.ws() + WS_MODS) + (size_t)l * 17 * 6144;
    const bf16* Y = (const bf16*)(a.ws() + WS_X2); const TokInfo* TOK = (const TokInfo*)(a.ws() + WS_TOK);
    float* xo = a.out(); float* co = (float*)(a.ws() + WS_CS);
    const GAS f32x4* lg = (const GAS f32x4*)(a.in(I_LN2G) + l * DM) + lane; const GAS f32x4* lb = (const GAS f32x4*)(a.in(I_LN2B) + l * DM) + lane;
    const int Mrows = l == 0 ? NTOK : NTX;
    f32x4 lgv[4], lbv[4];
#pragma unroll
    for (int j = 0; j < 4; ++j) { lgv[j] = lg[64 * j]; lbv[j] = lb[64 * j]; }
    TokInfo tnext = TOK[gw < Mrows ? gw : 0];
    for (int m = gw; m < Mrows; m += NGW) {
        float* xr_; int mr;
        if (m < NTX) { xr_ = xo + (size_t)m * DM; mr = m / SEQ; } else { xr_ = co + (size_t)(m - NTX) * DM; mr = 16; }
        const TokInfo ti = tnext; tnext = TOK[(m + NGW) < Mrows ? (m + NGW) : m]; const int blk = (m % NGW) >> 3;
        const int sl0 = pref[ti.e0] * 256 + bb[blk * 32 + ti.e0] + ti.p0, sl1 = pref[ti.e1] * 256 + bb[blk * 32 + ti.e1] + ti.p1;
        GAS f32x4* xr = (GAS f32x4*)xr_ + lane; const GAS f32x4* md = (const GAS f32x4*)(mods + (size_t)mr * 6144) + lane;
        const GAS v2u* y0 = (const GAS v2u*)(Y + (size_t)sl0 * DM) + lane; const GAS v2u* y1 = (const GAS v2u*)(Y + (size_t)sl1 * DM) + lane;
        f32x4 v[4], msc[4], msh[4]; float s = 0.f;
        if (l == 0) { const GAS f32x4* mn = (const GAS f32x4*)(mods + (size_t)17 * 6144 + (size_t)mr * 6144) + lane;
#pragma unroll
            for (int j = 0; j < 4; ++j) { msc[j] = mn[256 + 64 * j]; msh[j] = mn[64 * j]; } }
        f32x4 xin[4], gin[4]; v2u ain[4], bin[4];
#pragma unroll
        for (int j = 0; j < 4; ++j) { xin[j] = xr[64 * j]; gin[j] = md[1280 + 64 * j]; ain[j] = y0[64 * j]; bin[j] = y1[64 * j]; }
#pragma unroll
        for (int j = 0; j < 4; ++j) { const f32x4 x = xin[j], gt = gin[j]; const v2u a0 = ain[j], a1 = bin[j];
            const f32x4 ya = {bflo(a0.x), bfhi(a0.x), bflo(a0.y), bfhi(a0.y)}, yb = {bflo(a1.x), bfhi(a1.x), bflo(a1.y), bfhi(a1.y)};
            v[j] = x * ALPHA + gt * (ya * ti.g0 + yb * ti.g1); s += (v[j].x + v[j].y) + (v[j].z + v[j].w); }
        const float mean = wave_sum(s) * (1.f / DM); float s2 = 0.f;
#pragma unroll
        for (int j = 0; j < 4; ++j) { v[j] = v[j] - mean; s2 += (v[j].x * v[j].x + v[j].y * v[j].y) + (v[j].z * v[j].z + v[j].w * v[j].w); }
        const float rstd = 1.f / sqrtf(wave_sum(s2) * (1.f / DM) + LN_EPS);
        if (l == 0) {
            GAS v2u* o8 = (GAS v2u*)((bf16*)(a.ws() + WS_X1) + (size_t)m * DM) + lane;
#pragma unroll
            for (int j = 0; j < 4; ++j) { const f32x4 xn = v[j] * rstd * lgv[j] + lbv[j]; xr[64 * j] = xn; const f32x4 r = xn * (msc[j] + 1.0f) + msh[j]; v2u w; w.x = pk2(r.x, r.y); w.y = pk2(r.z, r.w); o8[64 * j] = w; }
        } else {
#pragma unroll
            for (int j = 0; j < 4; ++j) xr[64 * j] = v[j] * rstd * lgv[j] + lbv[j];
        }
    }
}
namespace csc {
constexpr int ARR = 0;
constexpr int RAW = 0;
constexpr int ZL = 34816;
constexpr int WLO = 57344;
constexpr int FR = 58368;
constexpr int AABT = 87040;
constexpr int LWO = 91136;
constexpr int AAO = 107520;
__device__ __forceinline__ int sw16(int row, int chunk) { return row * 128 + ((chunk ^ (row & 7)) << 4); }
__device__ __forceinline__ v2u cvt4(const f32x4 v) { v2u r; r.x = pk2(v[0], v[1]); r.y = pk2(v[2], v[3]); return r; }
__device__ __forceinline__ bf16x8 mk8(v2u lo, v2u hi) { v4u w; w.x = lo.x; w.y = lo.y; w.z = hi.x; w.w = hi.y; return __builtin_bit_cast(bf16x8, w); }
__device__ __forceinline__ v2u trd(const LAS unsigned char* p) { return __builtin_bit_cast(v2u, __builtin_amdgcn_ds_read_tr16_b64_v4i16((LAS v4i16_t*)p)); }
__device__ __forceinline__ int opq(int v) { asm volatile("" : "+v"(v)); return v; }
__device__ __forceinline__ int opqs(int v) { asm volatile("" : "+s"(v)); return v; }
}
namespace bgc {
constexpr int CBUF = LDSCTL_OFF + 4096, CPITCH = 80, NITEMS = NEXP * 1536;
struct Item { const float* src; bf16* dst; int N, ld; };
__device__ __forceinline__ Item decode(const KA& a, int l, int item) {
    const int e = item / 1536; int r = item - e * 1536; const int m = r >> 9, t = r & 511; const size_t eo = ((size_t)l * NEXP + e) * (size_t)DM * DEXP; Item it;
    if (m < 2) { const int kt = t >> 4, nt = t & 15, j0 = 32 * nt; it.N = DEXP; it.ld = 1024; it.src = (m ? a.in(I_EW3) : a.in(I_EW1)) + eo + (size_t)(32 * kt) * DEXP + j0;
        it.dst = (bf16*)(a.ws() + WS_W13T) + (size_t)e * 1024 * 1024 + (size_t)(256 * (j0 >> 7) + 128 * m + (j0 & 127)) * 1024 + 32 * kt; }
    else { const int kt = t >> 5, nt = t & 31; it.N = DM; it.ld = 512; it.src = a.in(I_EW2) + eo + (size_t)(32 * kt) * DM + 32 * nt; it.dst = (bf16*)(a.ws() + WS_W2T) + (size_t)e * 1024 * 512 + (size_t)(32 * nt) * 512 + 32 * kt; }
    return it; }
__device__ __forceinline__ void issue(const KA& a, int l, int item, int lane, f32x4 (&cv)[4]) { const Item it = decode(a, l, item);
#pragma unroll
    for (int i = 0; i < 4; ++i) cv[i] = *(const GAS f32x4*)(it.src + (size_t)((lane >> 3) + 8 * i) * it.N + (lane & 7) * 4); }
__device__ __forceinline__ void finish(const KA& a, int l, int item, int lane, int slot, LAS unsigned char* lds, const f32x4 (&cv)[4]) { const Item it = decode(a, l, item);
    LAS unsigned char* buf = lds + CBUF + slot * (32 * CPITCH);
#pragma unroll
    for (int i = 0; i < 4; ++i)
#pragma unroll
        for (int u = 0; u < 4; ++u) *(LAS bf16*)(buf + ((lane & 7) * 4 + u) * CPITCH + ((lane >> 3) + 8 * i) * 2) = f2bf1(cv[i][u]);
    LDS_WAIT(); asm volatile("" ::: "memory");
    const int n = lane >> 1, hf = lane & 1; const v4u w0 = *(const LAS v4u*)(buf + n * CPITCH + hf * 32), w1 = *(const LAS v4u*)(buf + n * CPITCH + hf * 32 + 16);
    GAS v4u* d = (GAS v4u*)(it.dst + (size_t)n * it.ld + 16 * hf); d[0] = w0; d[1] = w1;
    LDS_WAIT(); asm volatile("" ::: "memory"); }
}
#ifndef SCAN_PROBE
#define SCAN_PROBE 0
#endif
#define REPK(k) for (int rep_ = 0; rep_ < ((SCAN_PROBE == (k)) ? 2 : 1); ++rep_)
__device__ __forceinline__ void phase_scan(LAS unsigned char* lds, int l) {
    using namespace csc;
    const KA a = ka_get();
    const int tid = opaque_tid(), lane0 = tid & 63, wv = __builtin_amdgcn_readfirstlane(tid >> 6);
    const bf16* PX = (const bf16*)(a.ws() + WS_X2); float* YD = (float*)(a.ws() + WS_X3); float* BON = (float*)(a.ws() + WS_BONUS);
    const float* mup = a.in(I_MUP) + l * 1760; const float* mun = a.in(I_MUN) + l * 1760;
    const f32x4 Z4 = {0.f, 0.f, 0.f, 0.f}; const v2u Z2 = {0u, 0u};
    for (int chain = blockIdx.x; chain < 256; chain += gridDim.x) {
        const int b = chain >> 4, h = (chain >> 1) & 7, d = chain & 1; const int c0_ = opq(lane0);
        float kkc[2], kac[2], rkc[2], mur[2][2], muk[2][2], muv[2][2], mul[2][2], ropef[2]; bf16x8 w2f[2], a2f[2]; float w0c[2], a0c[2];
        { const int ln = c0_, kl = ln & 15, g = ln >> 4, cp = ln & 31;
#pragma unroll
          for (int u = 0; u < 2; ++u) { const int c = 2 * cp + u; ropef[u] = exp2f(-(float)(c & 15) * (13.287712379549449f / 16.0f));
            kkc[u] = a.in(I_KK)[l * 512 + h * 64 + c]; kac[u] = a.in(I_KA)[l * 512 + h * 64 + c]; rkc[u] = a.in(I_RK)[l * 512 + h * 64 + c];
            const int colr = h * 64 + c, coll = (c < 32) ? (1536 + d * 32 + c) : (1600 + d * 32 + (c - 32));
            mur[u][0] = d ? mun[colr] : mup[colr]; mur[u][1] = d ? mup[colr] : mun[colr]; muk[u][0] = d ? mun[512 + colr] : mup[512 + colr]; muk[u][1] = d ? mup[512 + colr] : mun[512 + colr];
            muv[u][0] = d ? mun[1024 + colr] : mup[1024 + colr]; muv[u][1] = d ? mup[1024 + colr] : mun[1024 + colr]; mul[u][0] = d ? mun[coll] : mup[coll]; mul[u][1] = d ? mup[coll] : mun[coll]; }
#pragma unroll
        for (int i = 0; i < 2; ++i) { const int cc = h * 64 + 16 * ((wv >> 2) * 2 + i) + kl; unsigned t[8], u[8];
#pragma unroll
            for (int j = 0; j < 8; ++j) { t[j] = f2bf(a.in(I_W2)[((size_t)(l * 2 + d) * 32 + 8 * g + j) * 512 + cc]); u[j] = f2bf(a.in(I_A2)[((size_t)(l * 2 + d) * 32 + 8 * g + j) * 512 + cc]); }
            w2f[i] = __builtin_bit_cast(bf16x8, (v4u){t[0] | (t[1] << 16), t[2] | (t[3] << 16), t[4] | (t[5] << 16), t[6] | (t[7] << 16)});
            a2f[i] = __builtin_bit_cast(bf16x8, (v4u){u[0] | (u[1] << 16), u[2] | (u[3] << 16), u[4] | (u[5] << 16), u[6] | (u[7] << 16)});
            w0c[i] = a.in(I_W0)[(l * 2 + d) * 512 + cc]; a0c[i] = a.in(I_A0)[(l * 2 + d) * 512 + cc]; } }
        f32x4 St[4] = {Z4, Z4, Z4, Z4};
        f32x4 cvt_[4] = {Z4, Z4, Z4, Z4}; int cit = blockIdx.x * 8 + wv, cpend = -1; const int cstride = gridDim.x * 8;
#define BGC_WINDOW() do { const int ln_ = opq(lane0); if (cpend >= 0) bgc::finish(a, l, cpend, ln_, wv & 3, lds, cvt_); if (cit < bgc::NITEMS) { bgc::issue(a, l, cit, ln_, cvt_); cpend = cit; cit += cstride; } else cpend = -1; } while (0)
        for (int seq = 0; seq < 2; ++seq) {
            const int T = seq ? SEQ : CTXL, rowbase = seq ? b * SEQ : NTX + b * CTXL, ngrp = T / 64;
            v4u pre[5];
#define CSC_PREFETCH(GRP) do { const int s0_ = (GRP) * 64; const int tlo_ = d ? (T - 64 - s0_) : s0_; \
                _Pragma("unroll") for (int i_ = 0; i_ < 5; ++i_) { const int id_ = opq(tid) + 512 * i_; const int rr_ = id_ >> 5, ch_ = id_ & 31; const int t_ = tlo_ - 1 + rr_; \
                    const int col_ = RWOFF + (ch_ < 24 ? (ch_ >> 3) * 512 + h * 64 + (ch_ & 7) * 8 : (ch_ < 28 ? 1536 + d * 32 + (ch_ - 24) * 8 : 1600 + d * 32 + (ch_ - 28) * 8)); \
                    const bool ok_ = (id_ < 66 * 32) && t_ >= 0 && t_ < T; const int tc_ = ok_ ? t_ : 0; \
                    const v4u v_ = *(const GAS v4u*)(PX + (size_t)(rowbase + tc_) * DINP + col_); pre[i_] = ok_ ? v_ : (v4u){0u, 0u, 0u, 0u}; } } while (0)
            CSC_PREFETCH(0);
            for (int grp = 0; grp < ngrp; ++grp) {
                const int s0 = grp * 64;
                int lane = opq(lane0); int c = lane, kl = lane & 15, g = lane >> 4, q_ = kl >> 2, p_ = kl & 3; (void)q_; (void)p_;
#pragma unroll
                for (int i = 0; i < 5; ++i) { const int id = opq(tid) + 512 * i; if (id < 66 * 32) *(LAS v4u*)(lds + RAW + id * 16) = pre[i]; }
                __syncthreads();
                int sl = opqs(wv);
                float Rk[4][2], Rq[4][2], Rr[4][2], Rv[4][2];
                REPK(1) { const int cp = lane & 31, sh = lane >> 5, sb = 8 * sl + 4 * sh; const int rbase = d ? 64 - sb : sb + 1, rdir = d ? -256 : 256;
                  const LAS bf16* p0 = (const LAS bf16*)(lds + RAW) + (rbase * 256 + 2 * cp) - rdir;
                  float pr[6][2], pk[6][2], pv[6][2], pl[6][2];
#pragma unroll
                  for (int j = 0; j < 6; ++j) { const LAS unsigned* p = (const LAS unsigned*)(p0 + j * rdir); const unsigned wr = p[0], wk = p[32], wv_ = p[64], wl = p[96];
                      pr[j][0] = bflo(wr); pr[j][1] = bfhi(wr); pk[j][0] = bflo(wk); pk[j][1] = bfhi(wk); pv[j][0] = bflo(wv_); pv[j][1] = bfhi(wv_); pl[j][0] = bflo(wl); pl[j][1] = bfhi(wl); }
                  const int qd = cp >> 3;
#pragma unroll
                  for (int i = 0; i < 4; ++i) { const int sloc = sb + i; float r[2], k[2], zz[2];
#pragma unroll
                      for (int u = 0; u < 2; ++u) { r[u] = pr[i + 1][u] + mur[u][0] * (pr[i][u] - pr[i + 1][u]) + mur[u][1] * (pr[i + 2][u] - pr[i + 1][u]); k[u] = pk[i + 1][u] + muk[u][0] * (pk[i][u] - pk[i + 1][u]) + muk[u][1] * (pk[i + 2][u] - pk[i + 1][u]);
                          Rv[i][u] = pv[i + 1][u] + muv[u][0] * (pv[i][u] - pv[i + 1][u]) + muv[u][1] * (pv[i + 2][u] - pv[i + 1][u]);
                          const float z = pl[i + 1][u] + mul[u][0] * (pl[i][u] - pl[i + 1][u]) + mul[u][1] * (pl[i + 2][u] - pl[i + 1][u]);
                          const float th = 1.0f - 2.0f * __builtin_amdgcn_rcpf(1.0f + __expf(2.0f * z)); zz[u] = cp < 16 ? th : z; }
                      ((LAS unsigned*)(lds + ZL))[sloc * 32 + cp] = pk2(zz[0], zz[1]);
                      if (seq) { const int t = d ? (T - 1 - (s0 + sloc)) : (s0 + sloc); const float pos = (float)((qd < 2) ? (t >> 6) : (t & 63));
#pragma unroll
                          for (int u = 0; u < 2; ++u) { const float rp = dppmov<0x128>(r[u]), kp = dppmov<0x128>(k[u]); const float ang = pos * ropef[u]; const float cs = __cosf(ang), sn = __sinf(ang);
                              const float sg = (qd & 1) ? sn : -sn; r[u] = r[u] * cs + rp * sg; k[u] = k[u] * cs + kp * sg; } }
                      const float k0 = k[0] * kkc[0], k1 = k[1] * kkc[1]; float ss = k0 * k0 + k1 * k1;
                      ss += dppmov<0xB1>(ss); ss += dppmov<0x4E>(ss); ss += dppmov<0x141>(ss); ss += dppmov<0x140>(ss);
                      { const int iv = __builtin_bit_cast(int, ss); const float a0 = __builtin_bit_cast(float, __builtin_amdgcn_readlane(iv, 0)) + __builtin_bit_cast(float, __builtin_amdgcn_readlane(iv, 16)), a1 = __builtin_bit_cast(float, __builtin_amdgcn_readlane(iv, 32)) + __builtin_bit_cast(float, __builtin_amdgcn_readlane(iv, 48)); ss = sh ? a1 : a0; }
                      const float rn = __builtin_amdgcn_rsqf(fmaxf(ss, 1e-24f));
                      Rk[i][0] = k0 * rn; Rk[i][1] = k1 * rn; Rq[i][0] = k[0]; Rq[i][1] = k[1]; Rr[i][0] = r[0]; Rr[i][1] = r[1]; } }
                __syncthreads();
                lane = opq(lane0); c = lane; kl = lane & 15; g = lane >> 4; q_ = kl >> 2; p_ = kl & 3;
                REPK(2) { const int wq = opqs(wv); const int st = wq & 3; const LAS unsigned char* zrow = lds + ZL + (16 * st + kl) * 128;
                  const bf16x8 zw = *(const LAS bf16x8*)(zrow + 16 * g), za = *(const LAS bf16x8*)(zrow + 64 + 16 * g);
#pragma unroll
                  for (int i = 0; i < 2; ++i) { const int cc = 16 * ((wq >> 2) * 2 + i) + kl;
                      const f32x4 uw = __builtin_amdgcn_mfma_f32_16x16x32_bf16(zw, w2f[i], Z4, 0, 0, 0), ua = __builtin_amdgcn_mfma_f32_16x16x32_bf16(za, a2f[i], Z4, 0, 0, 0);
#pragma unroll
                      for (int j = 0; j < 4; ++j) { const int srow = 16 * st + 4 * g + j;
                          ((LAS float*)(lds + LWO))[srow * 64 + cc] = -0.6065306597126334f * __builtin_amdgcn_rcpf(1.0f + __expf(-(uw[j] + w0c[i]))); ((LAS float*)(lds + AAO))[srow * 64 + cc] = __builtin_amdgcn_rcpf(1.0f + __expf(-(ua[j] + a0c[i]))); } } }
                __syncthreads();
                lane = opq(lane0); c = lane; kl = lane & 15; g = lane >> 4; q_ = kl >> 2; p_ = kl & 3;
                sl = opqs(wv);
                REPK(4) { const int cp = lane & 31, sh = lane >> 5, q = sl >> 1, hf = sl & 1; typedef float f32x2_ __attribute__((ext_vector_type(2)));
                  const LAS f32x2_* lwp = (const LAS f32x2_*)((const LAS float*)(lds + LWO) + (16 * q) * 64 + 2 * cp); const LAS f32x2_* aap = (const LAS f32x2_*)((const LAS float*)(lds + AAO) + (8 * sl + 4 * sh) * 64 + 2 * cp);
                  f32x2_ qs[4];
#pragma unroll
                  for (int j = 0; j < 4; ++j) { qs[j] = lwp[(4 * j) * 32] + lwp[(4 * j + 1) * 32] + lwp[(4 * j + 2) * 32] + lwp[(4 * j + 3) * 32]; }
                  const f32x2_ cL = (qs[0] + qs[1]) + (qs[2] + qs[3]); const int part = 2 * hf + sh;
                  f32x2_ run = part == 0 ? (f32x2_){0.f, 0.f} : (part == 1 ? qs[0] : (part == 2 ? qs[0] + qs[1] : qs[0] + qs[1] + qs[2]));
                  const float wl0 = __expf(cL.x), wl1 = __expf(cL.y);
                  if (part == 3) ((LAS f32x2_*)(lds + WLO))[q * 32 + cp] = (f32x2_){wl0, wl1};
#pragma unroll
                  for (int i = 0; i < 4; ++i) { const int sloc = 8 * sl + 4 * sh + i, s = 4 * part + i; const f32x2_ lwi = lwp[s * 32]; const f32x2_ cprev = run; run = run + lwi; const f32x2_ aa = aap[i * 32];
                      const float kd0 = Rq[i][0] * (1.0f + (aa.x - 1.0f) * kac[0]), kd1 = Rq[i][1] * (1.0f + (aa.y - 1.0f) * kac[1]), nb0 = -Rk[i][0] * aa.x, nb1 = -Rk[i][1] * aa.y;
                      float bon = Rr[i][0] * kd0 * rkc[0] + Rr[i][1] * kd1 * rkc[1];
                      bon += dppmov<0xB1>(bon); bon += dppmov<0x4E>(bon); bon += dppmov<0x141>(bon); bon += dppmov<0x140>(bon);
                      { const int iv = __builtin_bit_cast(int, bon); const float a0 = __builtin_bit_cast(float, __builtin_amdgcn_readlane(iv, 0)) + __builtin_bit_cast(float, __builtin_amdgcn_readlane(iv, 16)), a1 = __builtin_bit_cast(float, __builtin_amdgcn_readlane(iv, 32)) + __builtin_bit_cast(float, __builtin_amdgcn_readlane(iv, 48)); bon = sh ? a1 : a0; }
                      if (cp == 0) { const int t = d ? (T - 1 - (s0 + sloc)) : (s0 + sloc); BON[((size_t)d * NTOK + rowbase + t) * 8 + h] = bon; }
                      const float e1x = __expf(cprev.x), e1y = __expf(cprev.y), e2x = __expf(-run.x), e2y = __expf(-run.y), e3x = __builtin_amdgcn_rcpf(e2x), e3y = __builtin_amdgcn_rcpf(e2y);
                      LAS unsigned char* base = lds + ARR + q * (7 * 2048) + sw16(s, cp >> 2) + (cp & 3) * 4;
                      *(LAS unsigned*)(base) = pk2(Rk[i][0] * e1x, Rk[i][1] * e1y); *(LAS unsigned*)(base + 2048) = pk2(nb0 * e2x, nb1 * e2y); *(LAS unsigned*)(base + 4096) = pk2(kd0 * e2x, kd1 * e2y); *(LAS unsigned*)(base + 6144) = pk2(Rr[i][0] * e3x, Rr[i][1] * e3y);
                      *(LAS unsigned*)(base + 12288) = pk2(Rv[i][0], Rv[i][1]); } }
                __syncthreads();
                lane = opq(lane0); c = lane; kl = lane & 15; g = lane >> 4; q_ = kl >> 2; p_ = kl & 3;
                if (grp + 1 < ngrp) CSC_PREFETCH(grp + 1);
                if (wv < 4) BGC_WINDOW();
                REPK(5) if (wv >= 4) { const int q = opqs(wv) - 4; const LAS unsigned char* A0 = lds + ARR + q * (7 * 2048);
                    bf16x8 at[2], bt[2], kt[2], rt[2];
#pragma unroll
                    for (int ks = 0; ks < 2; ++ks) { const int o = sw16(kl, ks * 4 + g); at[ks] = *(const LAS bf16x8*)(A0 + o); bt[ks] = *(const LAS bf16x8*)(A0 + 2048 + o); kt[ks] = *(const LAS bf16x8*)(A0 + 4096 + o); rt[ks] = *(const LAS bf16x8*)(A0 + 6144 + o); }
                    f32x4 ABt = Z4, AKt = Z4, RBt = Z4, RKt = Z4;
#pragma unroll
                    for (int ks = 0; ks < 2; ++ks) { ABt = __builtin_amdgcn_mfma_f32_16x16x32_bf16(bt[ks], at[ks], ABt, 0, 0, 0); AKt = __builtin_amdgcn_mfma_f32_16x16x32_bf16(kt[ks], at[ks], AKt, 0, 0, 0);
                        RBt = __builtin_amdgcn_mfma_f32_16x16x32_bf16(bt[ks], rt[ks], RBt, 0, 0, 0); RKt = __builtin_amdgcn_mfma_f32_16x16x32_bf16(kt[ks], rt[ks], RKt, 0, 0, 0); }
#pragma unroll
                    for (int j = 0; j < 4; ++j) { const int jj = 4 * g + j; ABt[j] = jj < kl ? ABt[j] : 0.f; AKt[j] = jj < kl ? AKt[j] : 0.f; RBt[j] = jj <= kl ? RBt[j] : 0.f; RKt[j] = jj <= kl ? RKt[j] : 0.f; }
                    float Tr[16]; const float ab0 = ABt[0], ab1 = ABt[1], ab2 = ABt[2], ab3 = ABt[3];
                    const int abi[4] = {__builtin_bit_cast(int, ab0), __builtin_bit_cast(int, ab1), __builtin_bit_cast(int, ab2), __builtin_bit_cast(int, ab3)};
#pragma unroll
                    for (int i = 0; i < 16; ++i) Tr[i] = (i == kl) ? 1.f : 0.f;
#pragma unroll
                    for (int j = 14; j >= 0; --j) { float acc = 0.f;
#pragma unroll
                        for (int i = j + 1; i < 16; ++i) acc += Tr[i] * __builtin_bit_cast(float, __builtin_amdgcn_readlane(abi[j & 3], i + 16 * (j >> 2)));
                        Tr[j] = (j < kl) ? acc : Tr[j]; }
                    float tsel[4];
#pragma unroll
                    for (int e = 0; e < 4; ++e) tsel[e] = g == 0 ? Tr[e] : (g == 1 ? Tr[4 + e] : (g == 2 ? Tr[8 + e] : Tr[12 + e]));
                    v2u tf2; tf2.x = pk2(tsel[0], tsel[1]); tf2.y = pk2(tsel[2], tsel[3]);
                    const bf16x8 Tf = mk8(tf2, Z2), RBf = mk8(cvt4(RBt), Z2);
                    f32x4 AhT[4], QhT[4];
#pragma unroll
                    for (int ct = 0; ct < 4; ++ct) {
                        const bf16x8 Alo = mk8(trd(A0 + sw16(4 * g + q_, 2 * ct + (p_ >> 1)) + (p_ & 1) * 8), Z2);
                        AhT[ct] = __builtin_amdgcn_mfma_f32_16x16x32_bf16(Alo, Tf, Z4, 0, 0, 0);
                        const f32x4 Ah = __builtin_amdgcn_mfma_f32_16x16x32_bf16(Tf, Alo, Z4, 0, 0, 0);
                        const v2u rw = *(const LAS v2u*)(A0 + 6144 + sw16(kl, 2 * ct + (g >> 1)) + (g & 1) * 8);
                        const f32x4 rinit = {bflo(rw.x), bfhi(rw.x), bflo(rw.y), bfhi(rw.y)};
                        QhT[ct] = __builtin_amdgcn_mfma_f32_16x16x32_bf16(mk8(cvt4(Ah), Z2), RBf, rinit, 0, 0, 0); }
                    LAS unsigned char* fr = lds + FR + q * 7168 + lane * 16;
                    *(LAS bf16x8*)(fr) = mk8(cvt4(AhT[0]), cvt4(AhT[1])); *(LAS bf16x8*)(fr + 1024) = mk8(cvt4(AhT[2]), cvt4(AhT[3]));
                    *(LAS bf16x8*)(fr + 2048) = mk8(cvt4(QhT[0]), cvt4(QhT[1])); *(LAS bf16x8*)(fr + 3072) = mk8(cvt4(QhT[2]), cvt4(QhT[3]));
                    *(LAS bf16x8*)(fr + 4096) = mk8(cvt4(AKt), Z2); *(LAS bf16x8*)(fr + 5120) = mk8(cvt4(RBt), cvt4(RKt)); *(LAS bf16x8*)(fr + 6144) = Tf;
                }
                __syncthreads();
                lane = opq(lane0); c = lane; kl = lane & 15; g = lane >> 4; q_ = kl >> 2; p_ = kl & 3;
                if (wv >= 4) BGC_WINDOW();
                if (wv < 4) { const int vt = opqs(wv);
                    f32x4 Uh[4], Yh[4]; v2u vtrs[4];
#pragma unroll
                    for (int q = 0; q < 4; ++q) { const LAS unsigned char* A0 = lds + ARR + q * (7 * 2048); const LAS unsigned char* fr = lds + FR + q * 7168 + lane * 16;
                        const bf16x8 AKf = *(const LAS bf16x8*)(fr + 4096), RBRK = *(const LAS bf16x8*)(fr + 5120), Tf = *(const LAS bf16x8*)(fr + 6144);
                        vtrs[q] = trd(A0 + 12288 + sw16(4 * g + q_, 2 * vt + (p_ >> 1)) + (p_ & 1) * 8);
                        const f32x4 X1 = __builtin_amdgcn_mfma_f32_16x16x32_bf16(AKf, mk8(vtrs[q], Z2), Z4, 0, 0, 0);
                        Uh[q] = __builtin_amdgcn_mfma_f32_16x16x32_bf16(Tf, mk8(cvt4(X1), Z2), Z4, 0, 0, 0);
                        Yh[q] = __builtin_amdgcn_mfma_f32_16x16x32_bf16(RBRK, mk8(cvt4(Uh[q]), vtrs[q]), Z4, 0, 0, 0); }
#pragma unroll
                    for (int q = 0; q < 4; ++q) { const LAS unsigned char* A0 = lds + ARR + q * (7 * 2048); const LAS unsigned char* fr = lds + FR + q * 7168 + lane * 16;
                        const bf16x8 Ap0 = *(const LAS bf16x8*)(fr), Ap1 = *(const LAS bf16x8*)(fr + 1024), Qp0 = *(const LAS bf16x8*)(fr + 2048), Qp1 = *(const LAS bf16x8*)(fr + 3072);
                        bf16x8 bk[4]; f32x4 wl[4];
#pragma unroll
                        for (int ct = 0; ct < 4; ++ct) { wl[ct] = *(const LAS f32x4*)(lds + WLO + (q * 64 + 16 * ct + 4 * g) * 4); const int o = sw16(4 * g + q_, 2 * ct + (p_ >> 1)) + (p_ & 1) * 8; bk[ct] = mk8(trd(A0 + 2048 + o), trd(A0 + 4096 + o)); }
                        const bf16x8 bs0 = mk8(cvt4(St[0]), cvt4(St[1])), bs1 = mk8(cvt4(St[2]), cvt4(St[3]));
                        f32x4 U = __builtin_amdgcn_mfma_f32_16x16x32_bf16(Ap0, bs0, Uh[q], 0, 0, 0); U = __builtin_amdgcn_mfma_f32_16x16x32_bf16(Ap1, bs1, U, 0, 0, 0);
                        f32x4 Y = __builtin_amdgcn_mfma_f32_16x16x32_bf16(Qp0, bs0, Yh[q], 0, 0, 0); Y = __builtin_amdgcn_mfma_f32_16x16x32_bf16(Qp1, bs1, Y, 0, 0, 0);
                        const bf16x8 UV = mk8(cvt4(U), vtrs[q]);
#pragma unroll
                        for (int ct = 0; ct < 4; ++ct) St[ct] = __builtin_amdgcn_mfma_f32_16x16x32_bf16(bk[ct], UV, St[ct], 0, 0, 0) * wl[ct];
#pragma unroll
                        for (int j = 0; j < 4; ++j) { const int sg = s0 + 16 * q + 4 * g + j; const int t = d ? (T - 1 - sg) : sg; YD[((size_t)d * NTOK + rowbase + t) * 512 + h * 64 + 16 * vt + kl] = Y[j]; }
                    }
                }
                __syncthreads();
            }
#undef CSC_PREFETCH
        }
        if (cpend >= 0) { bgc::finish(a, l, cpend, opq(lane0), wv & 3, lds, cvt_); cpend = -1; }
        for (; cit < bgc::NITEMS; cit += cstride) { bgc::issue(a, l, cit, opq(lane0), cvt_); bgc::finish(a, l, cit, opq(lane0), wv & 3, lds, cvt_); }
#undef BGC_WINDOW
    }
}
constexpr int PH_PER_LAYER = 11, N_PHASES = 1 + 2 * PH_PER_LAYER;
template <int K> __device__ __forceinline__ void run_phase(LAS unsigned char* lds, int l) {
    if constexpr (K == 0) phase_prologue(lds);
    if constexpr (K == 1) phase_modconv(lds, l);
    if constexpr (K == 3) phase_scan(lds, l);
    if constexpr (K == 4) phase_attn(lds, l);
    if constexpr (K == 5) phase_rwpost(lds, l);
    if constexpr (K == 7) phase_ln1_route(lds, l);
    if constexpr (K == 8) phase_gather(lds, l);
    if constexpr (K == 11) phase_ln2(lds, l);
    if constexpr (K == 2 || K == 6 || K == 9 || K == 10) {
        const KA a = ka_get(); unsigned char* ws = a.ws(); const int G = gridDim.x, bid = blockIdx.x;
        bf16* X1 = (bf16*)(ws + WS_X1); bf16* X2 = (bf16*)(ws + WS_X2); bf16* X3 = (bf16*)(ws + WS_X3);
        if constexpr (K == 2) { __syncthreads();
            pg8::Gemm g{X1, (const bf16*)(ws + WS_WINT) + (size_t)l * DINP * DM, NTOK, DINP, DM}; pg8::StaticOrder S; S.init(NTOK, DINP, G, bid);
            pg8::EpiBf16 E{X2, DINP}; pg8::gemm_phase<pg8::EpiBf16, pg8::StaticOrder, true, true>(lds, g, S, E); }
        if constexpr (K == 6) { __syncthreads();
            const int Mrows = (l == 0) ? NTOK : NTX;
            pg8::Gemm g{X1, (const bf16*)(ws + WS_WOT) + (size_t)l * DM * DM, Mrows, DM, DM}; pg8::StaticOrder S; S.init(Mrows, DM, G, bid);
            pg8::EpiBf16 E{X3, DM}; pg8::gemm_phase<pg8::EpiBf16, pg8::StaticOrder, true, true>(lds, g, S, E); }
        if constexpr (K == 9) { moe_tables<false>(lds, l);
            pg8::Gemm g{X2, (const bf16*)(ws + WS_W13T), MAXSLOT, 1024, DM}; pg8::MoeOrder S; S.init((const LAS int*)(lds + PREF_OFF), 4, G, bid);
            pg8::EpiSwiGLU E{X3, DEXP}; pg8::gemm_phase<pg8::EpiSwiGLU, pg8::MoeOrder, true, true>(lds, g, S, E); }
        if constexpr (K == 10) { moe_tables<false>(lds, l);
            pg8::Gemm g{X3, (const bf16*)(ws + WS_W2T), MAXSLOT, 1024, DEXP}; pg8::MoeOrder S; S.init((const LAS int*)(lds + PREF_OFF), 4, G, bid);
            pg8::EpiBf16 E{X2, DM}; pg8::gemm_phase<pg8::EpiBf16, pg8::MoeOrder, true, true>(lds, g, S, E); }
    }
}
__device__ __forceinline__ void grid_sync(LAS unsigned char* lds) {
    const KA a = ka_get(); XcdBarrier b; b.bar = (unsigned*)(a.ws() + WS_CTL) + CW_BAR; b.x = xb_xcc_id(); b.st = (volatile LAS unsigned*)(lds + MISC_OFF) + 8; xcd_barrier(b);
#ifdef PROBE_BAR
    xcd_barrier(b);
#endif
}
#ifndef ONE_LAUNCH
template <int K> __global__ void __launch_bounds__(512, 2) fwd_ph(Args args) {
    extern __shared__ __attribute__((aligned(16))) unsigned char lds_raw[];
    LAS unsigned char* lds = (LAS unsigned char*)lds_raw;
    for (int u = threadIdx.x; u < (LDS_BYTES - LDSCTL_OFF) / 4; u += 512) ((LAS unsigned*)(lds + LDSCTL_OFF))[u] = 0u;
    __syncthreads();
    hw_tid_init();
    __syncthreads();
    run_phase<K>(lds, args.ph_lo);
}
template <int K> static void launch_ph(const Args& a, int grid, hipStream_t stream) {
    static bool attr = false;
    if (!attr) { (void)hipFuncSetAttribute((const void*)fwd_ph<K>, hipFuncAttributeMaxDynamicSharedMemorySize, LDS_BYTES); attr = true; }
    hipLaunchKernelGGL(fwd_ph<K>, dim3(grid), dim3(512), LDS_BYTES, stream, a);
}
#else
__global__ void __launch_bounds__(512, 2) fwd(Args args) {
    extern __shared__ __attribute__((aligned(16))) unsigned char lds_raw[];
    LAS unsigned char* lds = (LAS unsigned char*)lds_raw;
    for (int u = threadIdx.x; u < (LDS_BYTES - LDSCTL_OFF) / 4; u += 512) ((LAS unsigned*)(lds + LDSCTL_OFF))[u] = 0u;
    __syncthreads();
    hw_tid_init();
    __syncthreads();
    (void)xcd_barrier_post((unsigned*)(args.ws + WS_CTL) + CW_BAR, (volatile LAS unsigned*)(lds + MISC_OFF) + 8);
    run_phase<0>(lds, 0);
#ifdef PROBE_P0
    __syncthreads(); run_phase<0>(lds, 0);
#endif
    grid_sync(lds);
#ifndef PROBE_REP
#define PROBE_REP -1
#endif
#define RUNP(K) do { run_phase<K>(lds, l); if (PROBE_REP == K) { __syncthreads(); run_phase<K>(lds, l); } } while (0)
    for (int l = 0; l < 2; ++l) {
        if (l == 0) { RUNP(1); grid_sync(lds); }
        RUNP(2); grid_sync(lds);
        RUNP(3);
        RUNP(4); grid_sync(lds);
        RUNP(5); grid_sync(lds);
        RUNP(6); grid_sync(lds);
        run_phase<7>(lds, l); if (PROBE_REP == 7 && l == 0) { __syncthreads(); run_phase<7>(lds, l); } grid_sync(lds);
        RUNP(8); grid_sync(lds);
        RUNP(9); grid_sync(lds);
        RUNP(10); grid_sync(lds);
        run_phase<11>(lds, l); if (l == 0) grid_sync(lds);
    }
}
#endif

extern "C" void kernel_launch(void* const* d_in, const int* in_sizes, int n_in, void* d_out, int out_size, void* d_ws, size_t ws_size, hipStream_t stream) {
    static int grid = 0;
    if (grid == 0) {
        if (n_in != 30 || in_sizes[0] != NTX * DM || out_size != NTX * DM || ws_size < WS_END) {
            fprintf(stderr, "kernel_launch: unexpected problem (n_in %d, in0 %d, out %d, ws %zu < %zu?); nothing launched\n", n_in, n_in > 0 ? in_sizes[0] : -1, out_size, ws_size, (size_t)WS_END); grid = -1; return; }
        int dev = 0, cus = 0;
        if (hipGetDevice(&dev) != hipSuccess || hipDeviceGetAttribute(&cus, hipDeviceAttributeMultiprocessorCount, dev) != hipSuccess) { grid = -1; return; }
#ifdef ONE_LAUNCH
        if (hipFuncSetAttribute((const void*)fwd, hipFuncAttributeMaxDynamicSharedMemorySize, LDS_BYTES) != hipSuccess) { fprintf(stderr, "kernel_launch: hipFuncSetAttribute failed\n"); grid = -1; return; }
#endif
        (void)hipGetLastError();
        grid = cus > 0 ? cus : 256;
    }
    if (grid < 0) return;
    if (hipMemsetAsync((char*)d_ws + WS_CTL, 0, CTL_ZERO_BYTES, stream) != hipSuccess) return;
    Args a{};
    for (int i = 0; i < 30; ++i) a.in[i] = (const float*)d_in[i];
    a.out = (float*)d_out; a.ws = (unsigned char*)d_ws; a.ph_lo = 0; a.ph_hi = 0;
#ifndef ONE_LAUNCH
    launch_ph<0>(a, grid, stream);
    for (int l = 0; l < 2; ++l) { a.ph_lo = l;
        launch_ph<1>(a, grid, stream); launch_ph<2>(a, grid, stream); launch_ph<3>(a, grid, stream); launch_ph<4>(a, grid, stream); launch_ph<5>(a, grid, stream); launch_ph<6>(a, grid, stream);
        launch_ph<7>(a, grid, stream); launch_ph<8>(a, grid, stream); launch_ph<9>(a, grid, stream); launch_ph<10>(a, grid, stream); launch_ph<11>(a, grid, stream); }
#else
    hipLaunchKernelGGL(fwd, dim3(grid), dim3(512), LDS_BYTES, stream, a);
#endif
}
```

```cpp
#define ONE_LAUNCH 1
#include <hip/hip_runtime.h>
#include <cstdio>
#include <cstdint>

constexpr int DM = 1024, NB = 16, SEQ = 2048, CTXL = 256, NTX = NB * SEQ, NTC = NB * CTXL, NTOK = NTX + NTC;
constexpr int DIN = 3296, DINP = 3328, RWOFF = 1536, NHEAD = 8, HD = 64;
constexpr int NEXP = 32, DEXP = 512, LISTCAP = 2 * NTOK;
constexpr int MAXSLOT = 81920;
constexpr float ALPHA = 1.41421356237309515f, LN_EPS = 1e-6f, GN_EPS = 64e-5f;

constexpr size_t MiB = 1u << 20;
constexpr size_t WS_CTL = 0, CTL_ZERO_BYTES = 1 * MiB;
constexpr size_t WS_MODS = 1 * MiB;
constexpr size_t WS_ROPE = 2 * MiB;
constexpr size_t WS_WINT = 3 * MiB;
constexpr size_t WS_WOT = 16 * MiB;
constexpr size_t WS_W13T = 20 * MiB;
constexpr size_t WS_W2T = 84 * MiB;
constexpr size_t WS_LIST = 116 * MiB;
constexpr size_t WS_TOK = 125 * MiB;
constexpr size_t WS_BONUS = 127 * MiB;
constexpr size_t WS_CS = 130 * MiB;
constexpr size_t WS_X1 = 146 * MiB;
constexpr size_t WS_X2 = 218 * MiB;
constexpr size_t WS_X3 = 452 * MiB;
constexpr size_t WS_END = 596 * MiB;
static_assert(WS_WINT + (size_t)2 * DINP * DM * 2 <= WS_WOT && WS_LIST + (size_t)NEXP * LISTCAP * 4 <= WS_TOK && WS_TOK + (size_t)NTOK * 32 <= WS_BONUS, "ws map");
static_assert(WS_BONUS + (size_t)2 * NTOK * 8 * 4 <= WS_CS && WS_X2 + (size_t)NTOK * DINP * 2 <= WS_X3 && WS_X3 + (size_t)2 * NTOK * 512 * 4 <= WS_END, "ws map");
static_assert((size_t)MAXSLOT * 1024 * 2 <= WS_X3 - WS_X2 && (size_t)MAXSLOT * 512 * 2 <= WS_END - WS_X3, "ws map");
constexpr int CW_BAR = 4096;
constexpr int CW_CNT = 8192;
constexpr int RING_BYTES = 131072, LDSCTL_OFF = RING_BYTES, MISC_OFF = LDSCTL_OFF + 320, LDS_BYTES = 147456;
constexpr int PREF_OFF = LDSCTL_OFF + 512;

#define GAS __attribute__((address_space(1)))
#define LAS __attribute__((address_space(3)))
typedef unsigned short bf16;
typedef unsigned v4u __attribute__((ext_vector_type(4)));
typedef unsigned v2u __attribute__((ext_vector_type(2)));
typedef float f32x4 __attribute__((ext_vector_type(4)));
typedef short bf16x8 __attribute__((ext_vector_type(8)));
typedef GAS unsigned gu32;
#define RLX_AGENT __ATOMIC_RELAXED, __HIP_MEMORY_SCOPE_AGENT
#define LDS_WAIT() asm volatile("s_waitcnt lgkmcnt(0)" ::: "memory")
#define VM_WAIT() asm volatile("s_waitcnt vmcnt(0)" ::: "memory")
__device__ __forceinline__ unsigned f2bf(float f) { unsigned u = __builtin_bit_cast(unsigned, f); return (u + 0x7fffu + ((u >> 16) & 1u)) >> 16; }
typedef float f32x2_t_ __attribute__((ext_vector_type(2))); typedef __bf16 bf16x2_t_ __attribute__((ext_vector_type(2)));
__device__ __forceinline__ unsigned pk2(float lo, float hi) { f32x2_t_ v = {lo, hi}; bf16x2_t_ b = __builtin_convertvector(v, bf16x2_t_); return __builtin_bit_cast(unsigned, b); }
__device__ __forceinline__ unsigned short f2bf1(float f) { return (unsigned short)(pk2(f, 0.f) & 0xffffu); }
__device__ __forceinline__ float bf2f(unsigned short v) { return __builtin_bit_cast(float, (unsigned)v << 16); }
__device__ __forceinline__ float bflo(unsigned w) { return __builtin_bit_cast(float, w << 16); }
__device__ __forceinline__ float bfhi(unsigned w) { return __builtin_bit_cast(float, w & 0xffff0000u); }
__device__ __forceinline__ float sigmoidf_(float x) { return 1.0f / (1.0f + expf(-x)); }
__device__ __forceinline__ float shx(float v, int k, int lane) { return __builtin_bit_cast(float, __builtin_amdgcn_ds_bpermute((lane ^ k) << 2, __builtin_bit_cast(int, v))); }
__device__ __forceinline__ float shi(float v, int src) { return __builtin_bit_cast(float, __builtin_amdgcn_ds_bpermute(src << 2, __builtin_bit_cast(int, v))); }
template <int CTRL> __device__ __forceinline__ float dppmov(float v) { return __builtin_bit_cast(float, __builtin_amdgcn_update_dpp(0, __builtin_bit_cast(int, v), CTRL, 0xF, 0xF, true)); }
__device__ __forceinline__ float wave_sum(float v) {
    v += dppmov<0xB1>(v); v += dppmov<0x4E>(v); v += dppmov<0x141>(v); v += dppmov<0x140>(v);
    const int iv = __builtin_bit_cast(int, v);
    return (__builtin_bit_cast(float, __builtin_amdgcn_readlane(iv, 0)) + __builtin_bit_cast(float, __builtin_amdgcn_readlane(iv, 16))) + (__builtin_bit_cast(float, __builtin_amdgcn_readlane(iv, 32)) + __builtin_bit_cast(float, __builtin_amdgcn_readlane(iv, 48)));
}
__device__ __forceinline__ float red8(float v) { v += dppmov<0xB1>(v); v += dppmov<0x4E>(v); v += dppmov<0x141>(v); return v; }

struct TokInfo { int e0, e1, p0, p1; float g0, g1; int pad0, pad1; };

constexpr int WID_OFF = LDSCTL_OFF + 1536;
__device__ __forceinline__ int hw_slot() { return (int)__builtin_amdgcn_s_getreg((5 << 11) | 4) & 63; }
__device__ __forceinline__ int lane_id() { int l; asm volatile("v_mbcnt_lo_u32_b32 %0, -1, 0\n\tv_mbcnt_hi_u32_b32 %0, -1, %0" : "=v"(l)); return l; }
__device__ __forceinline__ void hw_tid_init() { *(volatile LAS int*)(uintptr_t)(WID_OFF + 4 * hw_slot()) = (int)(threadIdx.x >> 6); }
__device__ __forceinline__ int hw_tid() { const int w = *(volatile LAS int*)(uintptr_t)(WID_OFF + 4 * hw_slot()); int t = (__builtin_amdgcn_readfirstlane(w) << 6) | lane_id(); asm volatile("" : "+v"(t)); return t; }
namespace pg8 {
#define PG8_LAS __attribute__((address_space(3)))
typedef unsigned short bf16_t;
typedef short bf16x8 __attribute__((ext_vector_type(8)));
typedef float f32x4 __attribute__((ext_vector_type(4)));
typedef unsigned u32x4 __attribute__((ext_vector_type(4)));
constexpr int BM = 256, BK = 64, HALF = 128, HTB = HALF * BK * 2  , STAGE_BYTES = 8 * HTB, NXCD = 8, WGM = 8;

__host__ __device__ __forceinline__ int lds_byte(int r, int c) { const int st = (r >> 4) * 2 + (c >> 5), rr = r & 15, cc = c & 31, ob = rr * 64 + cc * 2; return st * 1024 + (ob ^ (((ob >> 9) & 1) << 5)); }
__host__ __device__ __forceinline__ void stage_rc(int b, int& R, int& C) { const int st = b / 1024, sb = b % 1024, swz = sb ^ (((sb >> 9) & 1) << 5); R = (st >> 1) * 16 + swz / 64; C = (st & 1) * 32 + (swz % 64) / 2; }
__host__ __device__ __forceinline__ int perm32(int rho) { const int n = rho >> 4, i = rho & 15; return 8 * (i >> 2) + 4 * n + (i & 3); }

struct Unit { int pm, pn, pnb; };
struct Gemm { const bf16_t* A; const bf16_t* Bt; int M, N, K; };

struct StaticOrder {
    int nM, nN, nwg, G, c;
    __host__ __device__ void init(int M, int N, int G_, int c_) { nM = M / BM; nN = N / BM; nwg = nM * nN; G = G_; c = c_; }
    __host__ __device__ bool next(int i, Unit& u) const {
        const long L = (long)i * G + c; if (L >= nwg) return false;
        int wgid = (int)L; { const int q = nwg / NXCD, r = nwg % NXCD, xcd = wgid % NXCD, off = wgid / NXCD; wgid = (xcd < r ? xcd * (q + 1) : r * (q + 1) + (xcd - r) * q) + off; }
        const int nig = WGM * nN, gid = wgid / nig, fm = gid * WGM, gsz = (nM - fm) < WGM ? (nM - fm) : WGM;
        u.pm = fm + ((wgid % nig) % gsz); u.pn = (wgid % nig) / gsz; u.pnb = u.pn; return true;
    }
    __device__ __forceinline__ void a_ready(const Unit&) const {}
    __device__ __forceinline__ void done(const Unit&) const {}
};

__device__ __forceinline__ unsigned cvt_pk_bf16(float lo, float hi) { unsigned r; asm volatile("v_cvt_pk_bf16_f32 %0, %1, %2" : "=v"(r) : "v"(lo), "v"(hi)); return r; }
template <class Epi, class Sched, bool ALIGN_EPI = false, bool SP2 = false>
__device__ __forceinline__ void gemm_phase(PG8_LAS unsigned char* lds, const Gemm g, const Sched& S, const Epi& E) {
    const int tid = hw_tid(), wid = __builtin_amdgcn_readfirstlane(tid >> 6), lane = tid & 63, wr = wid >> 2, wc = wid & 3, fr = lane & 15, fq = lane >> 4;
    const int K = g.K, nt = K / BK;
    unsigned voffA[2], voffB[2];
#pragma unroll
    for (int i = 0; i < 2; ++i) { int R, C; stage_rc(tid * 16 + i * 8192, R, C); const int Rb = Epi::PERM ? ((R & ~31) + perm32(R & 31)) : R;
        voffA[i] = (unsigned)(R * K + C) * 2u; voffB[i] = (unsigned)(Rb * K + C) * 2u; }
    const size_t kstep = (size_t)(BK * 2);
    const size_t hstep = (size_t)HALF * K * 2;
    const size_t tstep = 2 * hstep;
    const unsigned ldsw = (unsigned)wid * 1024u;
    const int aoff = lds_byte(wr * 64 + fr, fq * 8), boff = lds_byte(wc * 32 + fr, fq * 8);
#define PG8_SA(b, h) (((b) * 2 + (h)) * HTB)
#define PG8_SB(b, h) ((4 + (b) * 2 + (h)) * HTB)
#define PG8_STAGE(bufoff, gbase, voff) do { _Pragma("unroll") for (int _i = 0; _i < 2; ++_i) \
        __builtin_amdgcn_global_load_lds((const unsigned*)((const char*)(gbase) + (voff)[_i]), (PG8_LAS unsigned*)(lds + (bufoff) + ldsw + _i * 8192), 16, 0, 0); } while (0)
#define PG8_LDA(dst, b, h) do { _Pragma("unroll") for (int m = 0; m < 4; ++m) _Pragma("unroll") for (int k = 0; k < 2; ++k) dst[m][k] = *(const PG8_LAS bf16x8*)(lds + PG8_SA(b, h) + aoff + m * 2048 + k * 1024); } while (0)
#define PG8_LDB(dst, b, h) do { _Pragma("unroll") for (int n = 0; n < 2; ++n) _Pragma("unroll") for (int k = 0; k < 2; ++k) dst[n][k] = *(const PG8_LAS bf16x8*)(lds + PG8_SB(b, h) + boff + n * 2048 + k * 1024); } while (0)
#define PG8_MMA(ai, bj, At, Bt) do { __builtin_amdgcn_s_setprio(1); _Pragma("unroll") for (int m = 0; m < 4; ++m) _Pragma("unroll") for (int n = 0; n < 2; ++n) _Pragma("unroll") for (int k = 0; k < 2; ++k) \
        acc[ai][bj][m][n] = __builtin_amdgcn_mfma_f32_16x16x32_bf16(Bt[n][k], At[m][k], acc[ai][bj][m][n], 0, 0, 0); __builtin_amdgcn_s_setprio(0); } while (0)
#define PG8_WAIT_V(n) asm volatile("s_waitcnt vmcnt(" #n ")" ::: "memory")
#define PG8_WAIT_L(n) asm volatile("s_waitcnt lgkmcnt(" #n ")" ::: "memory")
#define PG8_BAR __builtin_amdgcn_s_barrier()
#define PG8_SCHED __builtin_amdgcn_sched_barrier(0)
    Unit cur, nxt; int ui = 0;
    if (!S.next(0, cur)) return;
    f32x4 acc[2][2][4][2];
#pragma unroll
    for (int a = 0; a < 2; ++a)
#pragma unroll
        for (int b = 0; b < 2; ++b)
#pragma unroll
            for (int m = 0; m < 4; ++m)
#pragma unroll
                for (int n = 0; n < 2; ++n) acc[a][b][m][n] = (f32x4){0.f, 0.f, 0.f, 0.f};
    bf16x8 At[4][2], B0[2][2], B1[2][2];
    const char* cA = (const char*)g.A + (size_t)cur.pm * tstep; const char* cB = (const char*)g.Bt + (size_t)cur.pnb * tstep;
    S.a_ready(cur);
    if constexpr (SP2) {
        PG8_STAGE(PG8_SB(0, 0), cB, voffB); PG8_STAGE(PG8_SB(0, 1), cB + hstep, voffB); PG8_STAGE(PG8_SA(0, 0), cA, voffA); PG8_STAGE(PG8_SA(0, 1), cA + hstep, voffA);
        if (wr == 1) PG8_BAR;
        PG8_WAIT_V(2); PG8_BAR;
        PG8_STAGE(PG8_SB(1, 0), cB + kstep, voffB); PG8_STAGE(PG8_SA(1, 0), cA + kstep, voffA); PG8_STAGE(PG8_SB(1, 1), cB + hstep + kstep, voffB);
        PG8_WAIT_V(6); PG8_BAR;
    } else {
        PG8_STAGE(PG8_SB(0, 0), cB, voffB); PG8_STAGE(PG8_SA(0, 0), cA, voffA); PG8_STAGE(PG8_SB(0, 1), cB + hstep, voffB); PG8_STAGE(PG8_SA(0, 1), cA + hstep, voffA);
        if (wr == 1) PG8_BAR;
        PG8_WAIT_V(4); PG8_BAR;
        PG8_STAGE(PG8_SB(1, 0), cB + kstep, voffB); PG8_STAGE(PG8_SA(1, 0), cA + kstep, voffA); PG8_STAGE(PG8_SB(1, 1), cB + hstep + kstep, voffB);
        PG8_WAIT_V(6); PG8_BAR;
    }
    for (;;) {
        const bool has_next = S.next(ui + 1, nxt);
        const char* nA = has_next ? (const char*)g.A + (size_t)nxt.pm * tstep : cA; const char* nB = has_next ? (const char*)g.Bt + (size_t)nxt.pnb * tstep : cB;
        for (int t = 0; t < nt; t += 2) {
            const bool last = (t == nt - 2);
            const char* a1 = cA + (size_t)(t + 1) * kstep;
            const char* a2 = last ? nA : cA + (size_t)(t + 2) * kstep; const char* b2 = last ? nB : cB + (size_t)(t + 2) * kstep;
            const char* a3 = a2 + kstep; const char* b3 = b2 + kstep;
            if (last && has_next) S.a_ready(nxt);
            if constexpr (SP2) {
            PG8_LDB(B0, 0, 0); PG8_LDB(B1, 0, 1); PG8_SCHED; PG8_LDA(At, 0, 0); PG8_STAGE(PG8_SA(1, 1), a1 + hstep, voffA);
            PG8_WAIT_V(8); PG8_WAIT_L(0); PG8_BAR; PG8_MMA(0, 0, At, B0); PG8_MMA(0, 1, At, B1); PG8_BAR; PG8_SCHED;
            PG8_LDA(At, 0, 1); PG8_STAGE(PG8_SB(0, 0), b2, voffB); PG8_STAGE(PG8_SB(0, 1), b2 + hstep, voffB); PG8_STAGE(PG8_SA(0, 0), a2, voffA);
            PG8_WAIT_V(8); PG8_WAIT_L(0); PG8_BAR; PG8_MMA(1, 0, At, B0); PG8_MMA(1, 1, At, B1); PG8_BAR; PG8_SCHED;
            PG8_LDB(B0, 1, 0); PG8_LDB(B1, 1, 1); PG8_SCHED; PG8_LDA(At, 1, 0); PG8_STAGE(PG8_SA(0, 1), a2 + hstep, voffA);
            PG8_WAIT_V(8); PG8_WAIT_L(0); PG8_BAR; PG8_MMA(0, 0, At, B0); PG8_MMA(0, 1, At, B1); PG8_BAR; PG8_SCHED;
            PG8_LDA(At, 1, 1); PG8_STAGE(PG8_SB(1, 0), b3, voffB); PG8_STAGE(PG8_SB(1, 1), b3 + hstep, voffB); PG8_STAGE(PG8_SA(1, 0), a3, voffA);
            PG8_WAIT_V(8); PG8_WAIT_L(0); PG8_BAR; PG8_MMA(1, 0, At, B0); PG8_MMA(1, 1, At, B1); PG8_BAR; PG8_SCHED;
            } else {
            PG8_LDB(B0, 0, 0); PG8_SCHED; PG8_LDA(At, 0, 0); PG8_STAGE(PG8_SA(1, 1), a1 + hstep, voffA);
            PG8_WAIT_L(8); PG8_BAR; PG8_WAIT_L(0); PG8_MMA(0, 0, At, B0); PG8_BAR; PG8_SCHED;
            PG8_LDB(B1, 0, 1); PG8_STAGE(PG8_SB(0, 0), b2, voffB);
            PG8_BAR; PG8_WAIT_L(0); PG8_MMA(0, 1, At, B1); PG8_BAR;
            PG8_LDA(At, 0, 1); PG8_STAGE(PG8_SA(0, 0), a2, voffA);
            PG8_BAR; PG8_WAIT_L(0); PG8_MMA(1, 0, At, B0); PG8_BAR; PG8_SCHED;
            PG8_STAGE(PG8_SB(0, 1), b2 + hstep, voffB);
            PG8_WAIT_V(6); PG8_BAR; PG8_MMA(1, 1, At, B1); PG8_BAR;
            PG8_LDB(B0, 1, 0); PG8_SCHED; PG8_LDA(At, 1, 0); PG8_STAGE(PG8_SA(0, 1), a2 + hstep, voffA);
            PG8_WAIT_L(8); PG8_BAR; PG8_WAIT_L(0); PG8_MMA(0, 0, At, B0); PG8_BAR; PG8_SCHED;
            PG8_LDB(B1, 1, 1); PG8_STAGE(PG8_SB(1, 0), b3, voffB);
            PG8_BAR; PG8_WAIT_L(0); PG8_MMA(0, 1, At, B1); PG8_BAR;
            PG8_LDA(At, 1, 1); PG8_STAGE(PG8_SA(1, 0), a3, voffA);
            PG8_BAR; PG8_WAIT_L(0); PG8_MMA(1, 0, At, B0); PG8_BAR; PG8_SCHED;
            PG8_STAGE(PG8_SB(1, 1), b3 + hstep, voffB);
            PG8_WAIT_V(6); PG8_BAR; PG8_MMA(1, 1, At, B1); PG8_BAR;
            }
        }
        if constexpr (ALIGN_EPI) { if (wr == 0) PG8_BAR; }
        if constexpr (!Epi::AFTER_DRAIN) { E(acc, cur, wr, wc, fr, fq); S.done(cur); }
        if (!has_next) break;
#pragma unroll
        for (int a = 0; a < 2; ++a)
#pragma unroll
            for (int b = 0; b < 2; ++b)
#pragma unroll
                for (int m = 0; m < 4; ++m)
#pragma unroll
                    for (int n = 0; n < 2; ++n) acc[a][b][m][n] = (f32x4){0.f, 0.f, 0.f, 0.f};
        cur = nxt; cA = nA; cB = nB; ++ui;
        if constexpr (ALIGN_EPI) { if (wr == 1) PG8_BAR; }
    }
    PG8_WAIT_V(0);
    if constexpr (!ALIGN_EPI) { if (wr == 0) PG8_BAR; }
    PG8_BAR;
    if constexpr (Epi::AFTER_DRAIN) { E.fused(acc, cur, wr, wc, fr, fq, lds, wid, lane); S.done(cur); }
#undef PG8_SA
#undef PG8_SB
#undef PG8_STAGE
#undef PG8_LDA
#undef PG8_LDB
#undef PG8_MMA
#undef PG8_WAIT_V
#undef PG8_WAIT_L
#undef PG8_BAR
#undef PG8_SCHED
}
}
namespace pg8 {
struct EpiBf16 {
    static constexpr bool PERM = true, AFTER_DRAIN = false;
    bf16_t* O; int ldc;
    __device__ __forceinline__ void operator()(const f32x4 (&acc)[2][2][4][2], const Unit& u, int wr, int wc, int fr, int fq) const {
        const int row0 = u.pm * BM + wr * 64 + fr; const int col0 = u.pn * BM + wc * 32 + 8 * fq;
#pragma unroll
        for (int ai = 0; ai < 2; ++ai)
#pragma unroll
            for (int m = 0; m < 4; ++m) { bf16_t* rowp = O + (size_t)(row0 + ai * HALF + m * 16) * ldc + col0;
#pragma unroll
                for (int bj = 0; bj < 2; ++bj) { const f32x4 v0 = acc[ai][bj][m][0], v1 = acc[ai][bj][m][1];
                    u32x4 w; w.x = cvt_pk_bf16(v0[0], v0[1]); w.y = cvt_pk_bf16(v0[2], v0[3]); w.z = cvt_pk_bf16(v1[0], v1[1]); w.w = cvt_pk_bf16(v1[2], v1[3]);
                    *(u32x4*)(rowp + bj * HALF) = w; } }
    }
};
struct EpiSwiGLU {
    static constexpr bool PERM = true, AFTER_DRAIN = false;
    bf16_t* O; int ldc;
    __device__ __forceinline__ void operator()(const f32x4 (&acc)[2][2][4][2], const Unit& u, int wr, int wc, int fr, int fq) const {
        const int row0 = u.pm * BM + wr * 64 + fr; const int col0 = u.pn * HALF + wc * 32 + 8 * fq;
#pragma unroll
        for (int ai = 0; ai < 2; ++ai)
#pragma unroll
            for (int m = 0; m < 4; ++m) { bf16_t* rowp = O + (size_t)(row0 + ai * HALF + m * 16) * ldc + col0;
                float r[8];
#pragma unroll
                for (int n = 0; n < 2; ++n)
#pragma unroll
                    for (int j = 0; j < 4; ++j) { const float a = acc[ai][0][m][n][j], b = acc[ai][1][m][n][j]; r[n * 4 + j] = a * b * __builtin_amdgcn_rcpf(1.0f + __expf(-a)); }
                u32x4 w; w.x = cvt_pk_bf16(r[0], r[1]); w.y = cvt_pk_bf16(r[2], r[3]); w.z = cvt_pk_bf16(r[4], r[5]); w.w = cvt_pk_bf16(r[6], r[7]);
                *(u32x4*)rowp = w; }
    }
};
struct MoeOrder {
    const PG8_LAS int* pref; int nN, G, c, total;
    __device__ __forceinline__ void init(const PG8_LAS int* pref_, int nN_, int G_, int c_) { pref = pref_; nN = nN_; G = G_; c = c_; total = pref_[32] * nN_; }
    __device__ __forceinline__ bool next(int i, Unit& u) const {
        const int L = i * G + c; if (L >= total) return false;
        const int rt = L / nN, pn = L - rt * nN; int e = 0;
#pragma unroll 1
        for (int k = 1; k < 32; ++k) e += (pref[k] <= rt) ? 1 : 0;
        u.pm = rt; u.pn = pn; u.pnb = e * nN + pn; return true;
    }
    __device__ __forceinline__ void a_ready(const Unit&) const {}
    __device__ __forceinline__ void done(const Unit&) const {}
};
}
#define XB_TMO      128
#define XB_XCNT(j)  (256  + 64 * (j))
#define XB_XSUB(j)  (1280 + 64 * (j))
#define XB_XGEN(j)  (2304 + 64 * (j))
#define XB_TOP      3328
#define XB_TOPGEN   3392
#define XCD_BAR_WORDS 3456
#define XB_SPIN_CAP (1u << 22)

__device__ __forceinline__ unsigned xb_ld(unsigned* p)              { return __hip_atomic_load(p, __ATOMIC_RELAXED, __HIP_MEMORY_SCOPE_AGENT); }
__device__ __forceinline__ unsigned xb_add(unsigned* p, unsigned v) { return __hip_atomic_fetch_add(p, v, __ATOMIC_RELAXED, __HIP_MEMORY_SCOPE_AGENT); }
__device__ __forceinline__ unsigned xb_xcc_id() { return (unsigned)__builtin_amdgcn_s_getreg((3 << 11) | 20) & 0xFu; }
#define XB_SPIN(cond, bar) do { unsigned _sp = 0; while (cond) { __builtin_amdgcn_s_sleep(1); \
    if ((++_sp & 255u) == 0u) { if (xb_ld(&(bar)[XB_TMO])) break; if (_sp > XB_SPIN_CAP) { atomicAdd(&(bar)[XB_TMO], 1u); break; } } } } while (0)

struct XcdBarrier {
    unsigned* bar; unsigned x;
    volatile LAS unsigned* st;
};

__device__ __forceinline__ XcdBarrier xcd_barrier_post(unsigned* bar, volatile LAS unsigned* st) {
    XcdBarrier b; b.bar = bar; b.x = xb_xcc_id(); b.st = st;
    if (hw_tid() == 0) (void)xb_add(&bar[XB_XCNT(b.x)], 1u);
    return b;
}
__device__ __forceinline__ void xcd_barrier_complete(unsigned* bar, unsigned x, unsigned& nloc, unsigned& nx) {
    const unsigned G = gridDim.x * gridDim.y * gridDim.z;
    unsigned sum, cnt, mine, sp = 0u;
    for (;;) {
        sum = 0u; cnt = 0u; mine = 0u;
#pragma unroll
        for (unsigned j = 0; j < 16; ++j) { const unsigned c = xb_ld(&bar[XB_XCNT(j)]); sum += c; cnt += (c > 0u) ? 1u : 0u; mine = (j == x) ? c : mine; }
        if (sum == G) break;
        __builtin_amdgcn_s_sleep(1);
        if ((++sp & 255u) == 0u) { if (xb_ld(&bar[XB_TMO])) break; if (sp > XB_SPIN_CAP) { atomicAdd(&bar[XB_TMO], 1u); break; } }
    }
    nloc = mine > 0u ? mine : 1u; nx = cnt > 0u ? cnt : 1u;
}

__device__ __forceinline__ void xcd_barrier(const XcdBarrier& b) {
    asm volatile("s_waitcnt vmcnt(0)" ::: "memory");
    __syncthreads();
    if (hw_tid() == 0) {
        unsigned* bar = b.bar;
        __builtin_amdgcn_s_waitcnt(0);
        unsigned nloc = b.st[0], nx = b.st[1];
        if (nloc == 0u) { xcd_barrier_complete(bar, b.x, nloc, nx); b.st[0] = nloc; b.st[1] = nx; }
        const unsigned old = xb_add(&bar[XB_XSUB(b.x)], 1u);
        const unsigned gen = old / nloc;
        if (old + 1u == (gen + 1u) * nloc) {
            __builtin_amdgcn_fence(__ATOMIC_RELEASE, "agent");
            asm volatile("s_waitcnt vmcnt(0)" ::: "memory");
            const unsigned og = xb_add(&bar[XB_TOP], 1u);
            const unsigned tg = og / nx;
            if (og + 1u == (tg + 1u) * nx) xb_add(&bar[XB_TOPGEN], 1u);
            else XB_SPIN(xb_ld(&bar[XB_TOPGEN]) == tg, bar);
            __builtin_amdgcn_fence(__ATOMIC_ACQUIRE, "agent");
            xb_add(&bar[XB_XGEN(b.x)], 1u);
            asm volatile("s_waitcnt vmcnt(0)" ::: "memory");
        } else {
            XB_SPIN(xb_ld(&bar[XB_XGEN(b.x)]) == gen, bar);
            __builtin_amdgcn_fence(__ATOMIC_ACQUIRE, "agent");
            asm volatile("s_waitcnt vmcnt(0)" ::: "memory");
        }
    }
    __syncthreads();
}
struct Args { const float* in[30]; float* out; unsigned char* ws; int ph_lo, ph_hi; };
#define CAS __attribute__((address_space(4)))
struct KA { const CAS unsigned char* kp;
    __device__ __forceinline__ const float* in(int i) const { return *(const float* const CAS*)(kp + 8 * i); }
    __device__ __forceinline__ float* out() const { return *(float* const CAS*)(kp + 240); }
    __device__ __forceinline__ unsigned char* ws() const { return *(unsigned char* const CAS*)(kp + 248); } };
__device__ __forceinline__ KA ka_get() { const CAS unsigned char* kp = (const CAS unsigned char*)__builtin_amdgcn_kernarg_segment_ptr(); asm volatile("" : "+s"(kp)); return KA{kp}; }
__device__ __forceinline__ int opaque_tid() { return hw_tid(); }
static_assert(sizeof(Args) == 264, "kernarg layout");
enum { I_X = 0, I_C, I_CTX, I_CCTX, I_ADAW, I_ADAB, I_WIN, I_RPB, I_MUP, I_MUN, I_W0, I_W2, I_A0, I_A2, I_G2, I_KK, I_KA, I_RK, I_GNG, I_GNB, I_WOUT, I_LN1G, I_LN1B, I_LN2G, I_LN2B, I_RW, I_RB, I_EW1, I_EW3, I_EW2 };

__device__ __forceinline__ void transpose_item(const float* W, int N, int k0, int n0, bf16* WT, int ldk, int drow0, LAS float* scr, int lane) {
#pragma unroll 8
    for (int i = 0; i < 32; ++i) { const int kk = 2 * i + (lane >> 5); scr[kk * 33 + (lane & 31)] = W[(size_t)(k0 + kk) * N + n0 + (lane & 31)]; }
    LDS_WAIT(); asm volatile("" ::: "memory");
    const int c = lane & 7;
#pragma unroll
    for (int j = 0; j < 4; ++j) { const int n = (lane >> 3) + 8 * j; const LAS float* s = scr + (8 * c) * 33 + n;
        v4u o; o.x = pk2(s[0 * 33], s[1 * 33]); o.y = pk2(s[2 * 33], s[3 * 33]); o.z = pk2(s[4 * 33], s[5 * 33]); o.w = pk2(s[6 * 33], s[7 * 33]);
        *(GAS v4u*)(WT + (size_t)(drow0 + n) * ldk + k0 + 8 * c) = o; }
    LDS_WAIT(); asm volatile("" ::: "memory");
}

__device__ __forceinline__ void phase_prologue(LAS unsigned char* lds) {
    const KA a = ka_get();
    const int tid = opaque_tid(), lane = tid & 63, wave = __builtin_amdgcn_readfirstlane(tid >> 6), G = gridDim.x, bid = blockIdx.x;
    const int gw = bid * 8 + wave, NGW = G * 8;
    bf16* WINT = (bf16*)(a.ws() + WS_WINT); bf16* WOT = (bf16*)(a.ws() + WS_WOT);
    LAS float* scr = (LAS float*)(lds + wave * 16384);
    constexpr int I_IN = 16 * 103, I_OUT = 16 * 32, I_L = I_IN + I_OUT;
    for (int it = gw; it < 2 * I_L; it += NGW) {
        const int l = it / I_L; int r = it - l * I_L;
        if (r < I_IN) { const int kb = r / 103, nb = r - kb * 103; transpose_item(a.in(I_WIN) + (size_t)l * DM * DIN, DIN, 64 * kb, 32 * nb, WINT + (size_t)l * DINP * DM, DM, 32 * nb, scr, lane); }
        else { r -= I_IN; const int kb = r >> 5, nb = r & 31; transpose_item(a.in(I_WOUT) + (size_t)l * DM * DM, DM, 64 * kb, 32 * nb, WOT + (size_t)l * DM * DM, DM, 32 * nb, scr, lane); }
    }
    for (int i = bid * 512 + tid; i < 8192; i += G * 512) { const int l = i >> 12, r = i & 4095; *(GAS v4u*)(WINT + (size_t)l * DINP * DM + (size_t)DIN * DM + (size_t)r * 8) = (v4u){0u, 0u, 0u, 0u}; }
    { float* rp = (float*)(a.ws() + WS_ROPE); const int i = bid * 512 + tid;
      if (i < 1536) { const int idx = i < 512 ? i : i - 512; const int p = idx >> 4, f = idx & 15; const double inv = exp(-(double)f * (9.210340371976184 / 16.0)); const double ang = (double)p * inv;
          const float cs = (float)cos(ang), sn = (float)sin(ang); if (i < 512) { rp[idx] = cs; rp[512 + idx] = sn; } else { rp[1024 + idx] = cs; rp[2048 + idx] = sn; } } }
    __syncthreads();
    LAS float* sl = (LAS float*)lds; LAS float* red = (LAS float*)(lds + 69632);
    for (int i = tid; i < 17 * 1024; i += 512) { const int r = i >> 10, k = i & 1023; const float v = r < 16 ? a.in(I_C)[r * 1024 + k] : a.in(I_CCTX)[k]; sl[i] = v / (1.0f + expf(-v)); }
    __syncthreads();
    float* mods = (float*)(a.ws() + WS_MODS);
    for (int it = bid; it < 192; it += G) {
        const int l = it / 96, ch = it - l * 96; const int kq = tid >> 6, cl = tid & 63, col = ch * 64 + cl;
        const float* W = a.in(I_ADAW) + (size_t)l * DM * 6144 + col;
        float acc[17];
#pragma unroll
        for (int r = 0; r < 17; ++r) acc[r] = 0.f;
        for (int k0 = kq * 128; k0 < kq * 128 + 128; k0 += 8) { float w8[8];
#pragma unroll
            for (int q = 0; q < 8; ++q) w8[q] = W[(size_t)(k0 + q) * 6144];
#pragma unroll
            for (int r = 0; r < 17; ++r) { const f32x4 s0 = *(const LAS f32x4*)(sl + r * 1024 + k0), s1 = *(const LAS f32x4*)(sl + r * 1024 + k0 + 4);
                acc[r] += s0.x * w8[0] + s0.y * w8[1] + s0.z * w8[2] + s0.w * w8[3] + s1.x * w8[4] + s1.y * w8[5] + s1.z * w8[6] + s1.w * w8[7]; } }
#pragma unroll
        for (int r = 0; r < 17; ++r) red[(kq * 17 + r) * 64 + cl] = acc[r];
        __syncthreads();
        for (int i = tid; i < 17 * 64; i += 512) { const int r = i >> 6, c2 = i & 63; float s = 0.f;
#pragma unroll
            for (int q = 0; q < 8; ++q) s += red[(q * 17 + r) * 64 + c2];
            mods[((size_t)l * 17 + r) * 6144 + ch * 64 + c2] = s + a.in(I_ADAB)[l * 6144 + ch * 64 + c2]; }
        __syncthreads();
    }
}

__device__ __forceinline__ void phase_modconv(LAS unsigned char* lds, int l) {
    const KA a = ka_get();
    const int tid = opaque_tid(), lane = tid & 63, wave = __builtin_amdgcn_readfirstlane(tid >> 6), G = gridDim.x, bid = blockIdx.x;
    const int gw = bid * 8 + wave, NGW = G * 8;
    const float* mods = (const float*)(a.ws() + WS_MODS) + (size_t)l * 17 * 6144;
    bf16* XM = (bf16*)(a.ws() + WS_X1);
    const float* xs = l == 0 ? a.in(I_X) : a.out(); const float* cs = l == 0 ? a.in(I_CTX) : (const float*)(a.ws() + WS_CS);
    for (int m = gw; m < NTOK; m += NGW) {
        const float* src; int mr;
        if (m < NTX) { src = xs + (size_t)m * DM; mr = m / SEQ; } else { src = cs + (size_t)(m - NTX) * DM; mr = 16; }
        const GAS f32x4* xr = (const GAS f32x4*)src + lane; const GAS f32x4* sh = (const GAS f32x4*)(mods + (size_t)mr * 6144) + lane; const GAS f32x4* sc = sh + 256;
        GAS v2u* o8 = (GAS v2u*)(XM + (size_t)m * DM) + lane;
#pragma unroll
        for (int j = 0; j < 4; ++j) { const f32x4 v = xr[64 * j], s = sh[64 * j], c = sc[64 * j]; const f32x4 r = v * (c + 1.0f) + s; v2u w; w.x = pk2(r.x, r.y); w.y = pk2(r.z, r.w); o8[64 * j] = w; }
    }
}

__device__ __forceinline__ void phase_scan_direct(LAS unsigned char* lds, int l) {
    const KA a = ka_get();
    constexpr int TB = 32;
    const int tid = opaque_tid(), lane = tid & 63, wv = __builtin_amdgcn_readfirstlane(tid >> 6);
    LAS float* ops = (LAS float*)lds;
    LAS float* scal = (LAS float*)(lds + 49152);
    LAS float* zl = (LAS float*)(lds + 49664);
    LAS float* rkraw = (LAS float*)(lds + 57856);
    LAS float* ybuf = (LAS float*)(lds + 74240);
    const bf16* PX = (const bf16*)(a.ws() + WS_X2); float* YD = (float*)(a.ws() + WS_X3); float* BON = (float*)(a.ws() + WS_BONUS); const float* rope = (const float*)(a.ws() + WS_ROPE);
    const float* mup = a.in(I_MUP) + l * 1760; const float* mun = a.in(I_MUN) + l * 1760;
    for (int chain = blockIdx.x; chain < 256; chain += gridDim.x) {
        const int b = chain >> 4, h = (chain >> 1) & 7, d = chain & 1, c = lane;
        float w2c[32], a2c[32];
#pragma unroll
        for (int j = 0; j < 32; ++j) { w2c[j] = a.in(I_W2)[((size_t)(l * 2 + d) * 32 + j) * 512 + h * 64 + c]; a2c[j] = a.in(I_A2)[((size_t)(l * 2 + d) * 32 + j) * 512 + h * 64 + c]; }
        const float w0c = a.in(I_W0)[(l * 2 + d) * 512 + h * 64 + c], a0c = a.in(I_A0)[(l * 2 + d) * 512 + h * 64 + c];
        const float kkc = a.in(I_KK)[l * 512 + h * 64 + c], kac = a.in(I_KA)[l * 512 + h * 64 + c], rkc = a.in(I_RK)[l * 512 + h * 64 + c];
        const int colr = h * 64 + c, colk = 512 + colr, colv = 1024 + colr, coll = (c < 32) ? (1536 + d * 32 + c) : (1600 + d * 32 + (c - 32));
        const float mpr = mup[colr], mnr = mun[colr], mpk = mup[colk], mnk = mun[colk], mpv = mup[colv], mnv = mun[colv], mpl = mup[coll], mnl = mun[coll];
        float S[8];
#pragma unroll
        for (int j = 0; j < 8; ++j) S[j] = 0.f;
        const int vl = lane >> 3, kq = lane & 7, vrow = 8 * wv + vl;
        for (int seq = 0; seq < 2; ++seq) {
            const int T = seq ? SEQ : CTXL, rowbase = seq ? b * SEQ : NTX + b * CTXL, nblk = T / TB;
            for (int bi = 0; bi < nblk; ++bi) {
                const int tb = d ? (nblk - 1 - bi) : bi, t0 = tb * TB;
                float zv[4];
#pragma unroll
                for (int i = 0; i < 4; ++i) {
                    const int tl = wv + 8 * i, t = t0 + tl; const bf16* p = PX + (size_t)(rowbase + t) * DINP + RWOFF;
                    const bool hp = t > 0, hn = t + 1 < T;
                    const float cr = bf2f(p[colr]), ck = bf2f(p[colk]), cv = bf2f(p[colv]), cl_ = bf2f(p[coll]);
                    const float pr = hp ? bf2f(p[colr - DINP]) : 0.f, pk = hp ? bf2f(p[colk - DINP]) : 0.f, pv = hp ? bf2f(p[colv - DINP]) : 0.f, pl = hp ? bf2f(p[coll - DINP]) : 0.f;
                    const float nr = hn ? bf2f(p[colr + DINP]) : 0.f, nk = hn ? bf2f(p[colk + DINP]) : 0.f, nv = hn ? bf2f(p[colv + DINP]) : 0.f, nl = hn ? bf2f(p[coll + DINP]) : 0.f;
                    const float zr = cr + mpr * (pr - cr) + mnr * (nr - cr), zk = ck + mpk * (pk - ck) + mnk * (nk - ck);
                    zv[i] = cv + mpv * (pv - cv) + mnv * (nv - cv);
                    const float zz = cl_ + mpl * (pl - cl_) + mnl * (nl - cl_);
                    rkraw[tl * 128 + c] = zr; rkraw[tl * 128 + 64 + c] = zk; zl[tl * 64 + c] = (c < 32) ? tanhf(zz) : zz;
                }
                __syncthreads();
#pragma unroll
                for (int i = 0; i < 4; ++i) {
                    const int tl = wv + 8 * i, t = t0 + tl;
                    float r = rkraw[tl * 128 + c], k = rkraw[tl * 128 + 64 + c];
                    if (seq) { const float rp = rkraw[tl * 128 + (c ^ 16)], kp = rkraw[tl * 128 + 64 + (c ^ 16)]; const int qd = c >> 4, f = c & 15;
                        const int ti = (qd < 2) ? ((t >> 6) * 16 + f) : (1024 + (t & 63) * 16 + f); const float cs = rope[ti], sn = rope[ti + ((qd < 2) ? 512 : 1024)];
                        const float sg = (qd & 1) ? sn : -sn; r = r * cs + rp * sg; k = k * cs + kp * sg; }
                    const float kkr = k * kkc; const float ss = wave_sum(kkr * kkr); const float kk = kkr / fmaxf(sqrtf(ss), 1e-12f);
                    float u = w0c, av = a0c;
#pragma unroll
                    for (int j = 0; j < 32; j += 4) { const f32x4 z1 = *(const LAS f32x4*)(zl + tl * 64 + j), z2 = *(const LAS f32x4*)(zl + tl * 64 + 32 + j);
                        u += z1.x * w2c[j] + z1.y * w2c[j + 1] + z1.z * w2c[j + 2] + z1.w * w2c[j + 3]; av += z2.x * a2c[j] + z2.y * a2c[j + 1] + z2.z * a2c[j + 2] + z2.w * a2c[j + 3]; }
                    const float w = expf(-0.6065306597126334f * sigmoidf_(u)), aa = sigmoidf_(av);
                    const float kd = k * (1.0f + (aa - 1.0f) * kac), nb = -kk * aa;
                    const float c1 = wave_sum(nb * r), c2 = wave_sum(kd * r), bon = wave_sum(r * kd * rkc);
                    LAS float* o = ops + tl * 384 + c; o[0] = kk; o[64] = w * r; o[128] = w; o[192] = nb; o[256] = kd; o[320] = zv[i];
                    if (lane == 0) { scal[tl * 4] = c1; scal[tl * 4 + 1] = c2; BON[((size_t)d * NTOK + rowbase + t) * 8 + h] = bon; }
                }
                __syncthreads();
#pragma unroll 2
                for (int s = 0; s < TB; ++s) {
                    const int tl = d ? (TB - 1 - s) : s; const LAS float* o = ops + tl * 384 + kq * 8;
                    const f32x4 ka = *(const LAS f32x4*)(o), kb = *(const LAS f32x4*)(o + 4), ra = *(const LAS f32x4*)(o + 64), rb = *(const LAS f32x4*)(o + 68);
                    const f32x4 wa = *(const LAS f32x4*)(o + 128), wb = *(const LAS f32x4*)(o + 132), na = *(const LAS f32x4*)(o + 192), nb_ = *(const LAS f32x4*)(o + 196);
                    const f32x4 da = *(const LAS f32x4*)(o + 256), db = *(const LAS f32x4*)(o + 260);
                    const float vv = ops[tl * 384 + 320 + vrow], c1 = scal[tl * 4], c2 = scal[tl * 4 + 1];
                    float sk = S[0] * ka.x + S[1] * ka.y + S[2] * ka.z + S[3] * ka.w + S[4] * kb.x + S[5] * kb.y + S[6] * kb.z + S[7] * kb.w;
                    float yy = S[0] * ra.x + S[1] * ra.y + S[2] * ra.z + S[3] * ra.w + S[4] * rb.x + S[5] * rb.y + S[6] * rb.z + S[7] * rb.w;
                    sk = red8(sk); yy = red8(yy);
                    const float y = yy + sk * c1 + vv * c2;
                    S[0] = S[0] * wa.x + sk * na.x + vv * da.x; S[1] = S[1] * wa.y + sk * na.y + vv * da.y; S[2] = S[2] * wa.z + sk * na.z + vv * da.z; S[3] = S[3] * wa.w + sk * na.w + vv * da.w;
                    S[4] = S[4] * wb.x + sk * nb_.x + vv * db.x; S[5] = S[5] * wb.y + sk * nb_.y + vv * db.y; S[6] = S[6] * wb.z + sk * nb_.z + vv * db.z; S[7] = S[7] * wb.w + sk * nb_.w + vv * db.w;
                    if (kq == 0) ybuf[tl * 64 + vrow] = y;
                }
                __syncthreads();
#pragma unroll
                for (int i = 0; i < 4; ++i) { const int tl = wv + 8 * i; YD[((size_t)d * NTOK + rowbase + t0 + tl) * 512 + h * 64 + c] = ybuf[tl * 64 + c]; }
            }
        }
        __syncthreads();
    }
}

typedef short v4i16_t __attribute__((ext_vector_type(4)));
__device__ __forceinline__ int swz_off(int row, int chunk) { return row * 128 + ((chunk ^ (row & 7)) << 4); }
__device__ __forceinline__ void stage_rows(LAS unsigned char* dst, const bf16* src, int nrows, int tid) {
    for (int idx = tid; idx < nrows * 8; idx += 512) { const int r = idx >> 3, ch = idx & 7; const v4u v = *(const GAS v4u*)(src + (size_t)r * DINP + ch * 8); *(LAS v4u*)(dst + swz_off(r, ch)) = v; }
}
struct AttState { float m, l; f32x4 o[4]; };
struct AttOff { int k[2]; int v[4]; int boff; unsigned okm; };
__device__ __forceinline__ AttOff att_offsets(int lane, int wc0, int qc, int cs) { AttOff o; const int kl = lane & 15, g = lane >> 4, q_ = kl >> 2, p_ = kl & 3;
#pragma unroll
    for (int dh = 0; dh < 2; ++dh) o.k[dh] = swz_off(kl, dh * 4 + g);
#pragma unroll
    for (int dt = 0; dt < 4; ++dt) o.v[dt] = swz_off(4 * g + q_, 2 * dt + (p_ >> 1)) + (p_ & 1) * 8;
    o.boff = (wc0 + 4 * g - qc + 15) * 4; o.okm = 0u;
#pragma unroll
    for (int j = 0; j < 8; ++j) { const int kc = wc0 + (j >> 2) * 16 + 4 * g + (j & 3); if ((kc >= cs) && (kc < cs + 16)) o.okm |= 1u << j; }
    return o; }
template <bool LOCAL>
__device__ __forceinline__ void att_kstep(AttState& st, const LAS unsigned char* kb, const LAS unsigned char* vb, int r0, const bf16x8 (&qf)[2], int lane, const AttOff& ao, const LAS float* rpbrow) {
    const LAS unsigned char* kr = kb + r0 * 128; const LAS unsigned char* vr = vb + r0 * 128;
    f32x4 s0 = {0.f, 0.f, 0.f, 0.f}, s1 = {0.f, 0.f, 0.f, 0.f};
#pragma unroll
    for (int dh = 0; dh < 2; ++dh) {
        const bf16x8 k0 = *(const LAS bf16x8*)(kr + ao.k[dh]); const bf16x8 k1 = *(const LAS bf16x8*)(kr + ao.k[dh] + 2048);
        s0 = __builtin_amdgcn_mfma_f32_16x16x32_bf16(k0, qf[dh], s0, 0, 0, 0); s1 = __builtin_amdgcn_mfma_f32_16x16x32_bf16(k1, qf[dh], s1, 0, 0, 0);
    }
    float sc[8];
#pragma unroll
    for (int j = 0; j < 4; ++j) { sc[j] = s0[j] * 0.125f; sc[4 + j] = s1[j] * 0.125f; }
    if (LOCAL) {
        float bv[8]; const unsigned ad = (unsigned)(uintptr_t)rpbrow + (unsigned)ao.boff;
#pragma unroll
        for (int j = 0; j < 8; ++j) asm volatile("ds_read_b32 %0, %1 offset:%2" : "=v"(bv[j]) : "v"(ad), "i"(((j >> 2) * 16 + (j & 3)) * 4));
        asm volatile("s_waitcnt lgkmcnt(0)" : "+v"(bv[0]), "+v"(bv[1]), "+v"(bv[2]), "+v"(bv[3]), "+v"(bv[4]), "+v"(bv[5]), "+v"(bv[6]), "+v"(bv[7]) :: "memory");
#pragma unroll
        for (int j = 0; j < 8; ++j) sc[j] = ((ao.okm >> j) & 1u) ? sc[j] + bv[j] : -INFINITY;
    }
    float mt = fmaxf(fmaxf(fmaxf(sc[0], sc[1]), fmaxf(sc[2], sc[3])), fmaxf(fmaxf(sc[4], sc[5]), fmaxf(sc[6], sc[7])));
    mt = fmaxf(mt, shx(mt, 16, lane)); mt = fmaxf(mt, shx(mt, 32, lane));
    const float mn = fmaxf(st.m, mt); const bool dead = (mn == -INFINITY);
    const float scale = dead ? 1.0f : __expf(st.m - mn);
    float p[8], ps = 0.f;
#pragma unroll
    for (int j = 0; j < 8; ++j) { p[j] = dead ? 0.f : __expf(sc[j] - mn); ps += p[j]; }
    st.l = st.l * scale + ps; st.m = mn;
#pragma unroll
    for (int dt = 0; dt < 4; ++dt) st.o[dt] = st.o[dt] * scale;
    v4u pw; pw.x = pk2(p[0], p[1]); pw.y = pk2(p[2], p[3]); pw.z = pk2(p[4], p[5]); pw.w = pk2(p[6], p[7]);
    const bf16x8 pf = __builtin_bit_cast(bf16x8, pw);
#pragma unroll
    for (int dt = 0; dt < 4; ++dt) {
        const v4i16_t lo = __builtin_amdgcn_ds_read_tr16_b64_v4i16((LAS v4i16_t*)(vr + ao.v[dt]));
        const v4i16_t hi = __builtin_amdgcn_ds_read_tr16_b64_v4i16((LAS v4i16_t*)(vr + ao.v[dt] + 2048));
        const bf16x8 vf = (bf16x8){lo[0], lo[1], lo[2], lo[3], hi[0], hi[1], hi[2], hi[3]};
        st.o[dt] = __builtin_amdgcn_mfma_f32_16x16x32_bf16(vf, pf, st.o[dt], 0, 0, 0);
    }
}
__device__ __forceinline__ void att_merge_store(AttState& st, LAS float* mrg, int qb, int kh, int lane, bf16* orow0  ) {
    LAS float* mine = mrg + qb * (18 * 64) + lane;
    if (kh == 1) { mine[0] = st.m; mine[64] = st.l;
#pragma unroll
        for (int dt = 0; dt < 4; ++dt)
#pragma unroll
            for (int j = 0; j < 4; ++j) mine[(2 + dt * 4 + j) * 64] = st.o[dt][j]; }
    __syncthreads();
    if (kh == 0) {
        const float m1 = mine[0], l1 = mine[64]; const float ms = fmaxf(st.m, m1); const float f0 = __expf(st.m - ms), f1 = __expf(m1 - ms);
        float lc = st.l * f0 + l1 * f1; lc += shx(lc, 16, lane); lc += shx(lc, 32, lane); const float inv = 1.0f / lc;
        const int q = lane & 15, g = lane >> 4;
#pragma unroll
        for (int dt = 0; dt < 4; ++dt) { float r[4];
#pragma unroll
            for (int j = 0; j < 4; ++j) r[j] = (st.o[dt][j] * f0 + mine[(2 + dt * 4 + j) * 64] * f1) * inv;
            v2u w; w.x = pk2(r[0], r[1]); w.y = pk2(r[2], r[3]); *(GAS v2u*)(orow0 + (size_t)q * DM + dt * 16 + 4 * g) = w; }
    }
}
__device__ __forceinline__ void phase_attn(LAS unsigned char* lds, int l) {
    const KA a = ka_get();
    const int tid = opaque_tid(), lane = tid & 63, wv = __builtin_amdgcn_readfirstlane(tid >> 6), qb = wv & 3, kh = wv >> 2;
    LAS unsigned char* KC = lds; LAS unsigned char* VC = lds + 32768; LAS unsigned char* KL = lds + 65536; LAS unsigned char* VL = lds + 98304;
    LAS float* RPB = (LAS float*)(lds + LDSCTL_OFF + 2048); LAS float* mrg = (LAS float*)KL;
    const bf16* PX = (const bf16*)(a.ws() + WS_X2); bf16* CAT = (bf16*)(a.ws() + WS_X1);
    for (int blk = blockIdx.x; blk < 256; blk += gridDim.x) {
        const int bh = blk >> 1, b = bh >> 3, h = bh & 7, half = blk & 1;
        __syncthreads();
        const bf16* ctxrow = PX + (size_t)(NTX + b * CTXL) * DINP + h * 64;
        stage_rows(KC, ctxrow + 512, 256, tid); stage_rows(VC, ctxrow + 1024, 256, tid);
        for (int i = tid; i < 465; i += 512) RPB[i] = a.in(I_RPB)[((size_t)l * 8 + h) * 465 + i];
        __syncthreads();
        const int kl = lane & 15, g = lane >> 4;
        const AttOff ao = att_offsets(lane, min(max(qb * 16 - 8, 0), 32), qb * 16 + kl, min(max(qb * 16 + kl - 8, 0), 48));
        if (l == 0) {
            for (int rr = 0; rr < 2; ++rr) {
                const int q0 = (half * 8 + rr * 4 + qb) * 16; const bf16* qrow = ctxrow + (size_t)(q0 + kl) * DINP;
                bf16x8 qf[2]; qf[0] = *(const GAS bf16x8*)(qrow + 8 * g); qf[1] = *(const GAS bf16x8*)(qrow + 32 + 8 * g);
                AttState st; st.m = -INFINITY; st.l = 0.f;
#pragma unroll
                for (int dt = 0; dt < 4; ++dt) st.o[dt] = (f32x4){0.f, 0.f, 0.f, 0.f};
                for (int s = 0; s < 4; ++s) att_kstep<false>(st, KC, VC, kh * 128 + s * 32, qf, lane, ao, RPB);
                att_merge_store(st, mrg, qb, kh, lane, CAT + (size_t)(NTX + b * CTXL + q0) * DM + h * 64);
                __syncthreads();
            }
        }
        v4u pfk0[4], pfv0[4], pfk1[4], pfv1[4];
#define ATT_ISSUE(SIDX, pfk, pfv) do { const int i_ = half * 16 + ((SIDX) >> 1); const int rs_ = min(max(i_ - 4, 0), 24); const bf16* lr_ = PX + (size_t)(b * SEQ + (rs_ + 4 * ((SIDX) & 1)) * 64) * DINP + h * 64; \
            _Pragma("unroll") for (int q__ = 0; q__ < 4; ++q__) { const int idx_ = tid + 512 * q__; const bf16* p_ = lr_ + (size_t)(idx_ >> 3) * DINP + (idx_ & 7) * 8; pfk[q__] = *(const GAS v4u*)(p_ + 512); pfv[q__] = *(const GAS v4u*)(p_ + 1024); } } while (0)
        ATT_ISSUE(0, pfk0, pfv0); ATT_ISSUE(1, pfk1, pfv1);
        bf16x8 qn[2]; { const bf16* qrow = PX + (size_t)(b * SEQ + (half * 16) * 64 + qb * 16 + kl) * DINP + h * 64; qn[0] = *(const GAS bf16x8*)(qrow + 8 * g); qn[1] = *(const GAS bf16x8*)(qrow + 32 + 8 * g); }
        for (int ui = 0; ui < 16; ++ui) {
            const int i = half * 16 + ui; const int rs = min(max(i - 4, 0), 24);
            const int qc = qb * 16 + kl, cs = min(max(qc - 8, 0), 48), wc0 = min(max(qb * 16 - 8, 0), 32);
            bf16x8 qf[2]; qf[0] = qn[0]; qf[1] = qn[1];
            { const int in_ = half * 16 + (ui < 15 ? ui + 1 : ui); const bf16* qrow = PX + (size_t)(b * SEQ + in_ * 64 + qc) * DINP + h * 64; qn[0] = *(const GAS bf16x8*)(qrow + 8 * g); qn[1] = *(const GAS bf16x8*)(qrow + 32 + 8 * g); }
            AttState st; st.m = -INFINITY; st.l = 0.f;
#pragma unroll
            for (int dt = 0; dt < 4; ++dt) st.o[dt] = (f32x4){0.f, 0.f, 0.f, 0.f};
            for (int s = 0; s < 4; ++s) att_kstep<false>(st, KC, VC, kh * 128 + s * 32, qf, lane, ao, RPB);
#define ATT_PASS(pass, pfk, pfv) do { \
                __syncthreads(); \
                _Pragma("unroll") for (int q__ = 0; q__ < 4; ++q__) { const int idx_ = tid + 512 * q__; const int o_ = swz_off(idx_ >> 3, idx_ & 7); *(LAS v4u*)(KL + o_) = pfk[q__]; *(LAS v4u*)(VL + o_) = pfv[q__]; } \
                __syncthreads(); \
                if (ui + 1 < 16) ATT_ISSUE(2 * (ui + 1) + (pass), pfk, pfv); \
                for (int k2 = 0; k2 < 2; ++k2) { const int kr = 2 * kh + k2, arow = rs + 4 * (pass) + kr; \
                    att_kstep<true>(st, KL, VL, kr * 64 + wc0, qf, lane, ao, RPB + (arow - i + 7) * 31); } } while (0)
            ATT_PASS(0, pfk0, pfv0);
            ATT_PASS(1, pfk1, pfv1);
#undef ATT_PASS
            __syncthreads();
            att_merge_store(st, mrg, qb, kh, lane, CAT + (size_t)(b * SEQ + i * 64 + qb * 16) * DM + h * 64);
        }
    }
}

__device__ __forceinline__ void phase_rwpost(LAS unsigned char* lds, int l) {
    const KA a = ka_get();
    const int tid = opaque_tid(), lane = tid & 63, hh = __builtin_amdgcn_readfirstlane(tid >> 6), kl = lane & 15, g = lane >> 4;
    const int er = tid >> 5, cq = tid & 31, c0 = cq * 16, hq = cq >> 2;
    LAS bf16* sig = (LAS bf16*)lds;
    LAS float* Gl = (LAS float*)(lds + 4096);
    const bf16* PX = (const bf16*)(a.ws() + WS_X2); const float* YD = (const float*)(a.ws() + WS_X3); const float* BON = (const float*)(a.ws() + WS_BONUS); bf16* CAT = (bf16*)(a.ws() + WS_X1);
    const float* mup = a.in(I_MUP) + l * 1760; const float* mun = a.in(I_MUN) + l * 1760; const float* g2 = a.in(I_G2) + (size_t)l * 96 * 512;
    const float* gngp = a.in(I_GNG) + l * 512 + c0; const float* gnbp = a.in(I_GNB) + l * 512 + c0;
    bf16x8 gb[3][4];
#pragma unroll
    for (int ks = 0; ks < 3; ++ks)
#pragma unroll
        for (int nt = 0; nt < 4; ++nt) { v4u w; unsigned t[8];
#pragma unroll
            for (int j = 0; j < 8; ++j) t[j] = f2bf(g2[(size_t)(32 * ks + 8 * g + j) * 512 + 64 * hh + 16 * nt + kl]);
            w.x = t[0] | (t[1] << 16); w.y = t[2] | (t[3] << 16); w.z = t[4] | (t[5] << 16); w.w = t[6] | (t[7] << 16); gb[ks][nt] = __builtin_bit_cast(bf16x8, w); }
    const int nch = (l == 0 ? NTOK : NTX) / 16;
    for (int ch = blockIdx.x; ch < nch; ch += gridDim.x) {
        const int row0 = ch * 16;
        __syncthreads();
        for (int idx = tid; idx < 1536; idx += 512) { const int r = idx / 96, j = idx - r * 96, row = row0 + r; int t, T; if (row < NTX) { t = row & (SEQ - 1); T = SEQ; } else { t = (row - NTX) & (CTXL - 1); T = CTXL; }
            const bf16* p = PX + (size_t)row * DINP + RWOFF + 1664 + j; const int op = t > 0 ? -DINP : 0, on = t + 1 < T ? DINP : 0;
            const float cv = bf2f(p[0]), pv = bf2f(p[op]) * (t > 0 ? 1.f : 0.f), nv = bf2f(p[on]) * (t + 1 < T ? 1.f : 0.f);
            const float z = cv + mup[1664 + j] * (pv - cv) + mun[1664 + j] * (nv - cv); sig[r * 96 + j] = f2bf1(sigmoidf_(z)); }
        const int row = row0 + er; int t, T; if (row < NTX) { t = row & (SEQ - 1); T = SEQ; } else { t = (row - NTX) & (CTXL - 1); T = CTXL; }
        const bf16* pvp = PX + (size_t)row * DINP + RWOFF + 1024 + c0; const int op = t > 0 ? -DINP : 0, on = t + 1 < T ? DINP : 0; const float fp = t > 0 ? 1.f : 0.f, fn = t + 1 < T ? 1.f : 0.f;
        v4u vc[2], vp[2], vn[2]; f32x4 y0[4], y1[4];
#pragma unroll
        for (int i = 0; i < 2; ++i) { vc[i] = *(const GAS v4u*)(pvp + 8 * i); vp[i] = *(const GAS v4u*)(pvp + op + 8 * i); vn[i] = *(const GAS v4u*)(pvp + on + 8 * i); }
#pragma unroll
        for (int i = 0; i < 4; ++i) { y0[i] = *(const GAS f32x4*)(YD + (size_t)row * 512 + c0 + 4 * i); y1[i] = *(const GAS f32x4*)(YD + ((size_t)NTOK + row) * 512 + c0 + 4 * i); }
        const float bon = BON[(size_t)row * 8 + hq] + BON[((size_t)NTOK + row) * 8 + hq];
        __syncthreads();
        { f32x4 acc[4];
#pragma unroll
          for (int nt = 0; nt < 4; ++nt) acc[nt] = (f32x4){0.f, 0.f, 0.f, 0.f};
#pragma unroll
          for (int ks = 0; ks < 3; ++ks) { const bf16x8 af = *(const LAS bf16x8*)(sig + kl * 96 + 32 * ks + 8 * g);
#pragma unroll
              for (int nt = 0; nt < 4; ++nt) acc[nt] = __builtin_amdgcn_mfma_f32_16x16x32_bf16(af, gb[ks][nt], acc[nt], 0, 0, 0); }
#pragma unroll
          for (int nt = 0; nt < 4; ++nt)
#pragma unroll
              for (int j = 0; j < 4; ++j) Gl[(4 * g + j) * 512 + 64 * hh + 16 * nt + kl] = acc[nt][j]; }
        __syncthreads();
        f32x4 y[4]; float s = 0.f;
#pragma unroll
        for (int i = 0; i < 4; ++i) { y[i] = y0[i] + y1[i]; s += (y[i].x + y[i].y) + (y[i].z + y[i].w); }
        s += dppmov<0xB1>(s); s += dppmov<0x4E>(s); const float mean = s * (1.0f / 64.0f); float q = 0.f;
#pragma unroll
        for (int i = 0; i < 4; ++i) { y[i] = y[i] - mean; q += (y[i].x * y[i].x + y[i].y * y[i].y) + (y[i].z * y[i].z + y[i].w * y[i].w); }
        q += dppmov<0xB1>(q); q += dppmov<0x4E>(q); const float rstd = 1.0f / sqrtf(q * (1.0f / 64.0f) + GN_EPS);
        unsigned ow[8]; f32x4 mpvv[4], mnvv[4], gngv[4], gnbv[4];
#pragma unroll
        for (int i = 0; i < 4; ++i) { mpvv[i] = *(const GAS f32x4*)(mup + 1024 + c0 + 4 * i); mnvv[i] = *(const GAS f32x4*)(mun + 1024 + c0 + 4 * i); gngv[i] = *(const GAS f32x4*)(gngp + 4 * i); gnbv[i] = *(const GAS f32x4*)(gnbp + 4 * i); }
#pragma unroll
        for (int i = 0; i < 4; ++i) { const unsigned cw0 = vc[i >> 1][(i & 1) * 2], cw1 = vc[i >> 1][(i & 1) * 2 + 1], pw0 = vp[i >> 1][(i & 1) * 2], pw1 = vp[i >> 1][(i & 1) * 2 + 1], nw0 = vn[i >> 1][(i & 1) * 2], nw1 = vn[i >> 1][(i & 1) * 2 + 1];
            const f32x4 cv = {bflo(cw0), bfhi(cw0), bflo(cw1), bfhi(cw1)}, pv = {bflo(pw0) * fp, bfhi(pw0) * fp, bflo(pw1) * fp, bfhi(pw1) * fp}, nv = {bflo(nw0) * fn, bfhi(nw0) * fn, bflo(nw1) * fn, bfhi(nw1) * fn};
            const f32x4 mpv = mpvv[i], mnv = mnvv[i], gng = gngv[i], gnb = gnbv[i];
            const f32x4 zv = cv + mpv * (pv - cv) + mnv * (nv - cv);
            const f32x4 gt = *(const LAS f32x4*)(Gl + er * 512 + c0 + 4 * i);
            const f32x4 o = (y[i] * rstd * gng + gnb + zv * bon) * gt;
            ow[2 * i] = pk2(o.x, o.y); ow[2 * i + 1] = pk2(o.z, o.w); }
        GAS v4u* dst = (GAS v4u*)(CAT + (size_t)row * DM + 512 + c0); dst[0] = (v4u){ow[0], ow[1], ow[2], ow[3]}; dst[1] = (v4u){ow[4], ow[5], ow[6], ow[7]};
    }
}

__device__ __forceinline__ void phase_ln1_route(LAS unsigned char* lds, int l) {
    const KA a = ka_get();
    const int tid = opaque_tid(), lane = tid & 63, wave = __builtin_amdgcn_readfirstlane(tid >> 6), G = gridDim.x, bid = blockIdx.x;
    const int gw = bid * 8 + wave, NGW = G * 8;
    LAS float* rwt = (LAS float*)lds;
#pragma unroll
    for (int i = tid; i < 8192; i += 512) { const int k = i >> 3, eg = i & 7; const f32x4 w4 = *(const GAS f32x4*)(a.in(I_RW) + k * 32 + 4 * eg);
        rwt[(4 * eg) * 1024 + k] = w4.x; rwt[(4 * eg + 1) * 1024 + k] = w4.y; rwt[(4 * eg + 2) * 1024 + k] = w4.z; rwt[(4 * eg + 3) * 1024 + k] = w4.w; }
    if (tid < 32) ((LAS int*)(lds + LDSCTL_OFF + 1024))[tid] = 0;
    __syncthreads();
    const float* mods = (const float*)(a.ws() + WS_MODS) + (size_t)l * 17 * 6144;
    const bf16* O = (const bf16*)(a.ws() + WS_X3); bf16* HM = (bf16*)(a.ws() + WS_X1);
    const float* xs = l == 0 ? a.in(I_X) : a.out(); const float* cs = l == 0 ? a.in(I_CTX) : (const float*)(a.ws() + WS_CS);
    float* xo = a.out(); float* co = (float*)(a.ws() + WS_CS);
    int* HIST = (int*)(a.ws() + WS_LIST); TokInfo* TOK = (TokInfo*)(a.ws() + WS_TOK); LAS int* lcnt = (LAS int*)(lds + LDSCTL_OFF + 1024);
    const GAS f32x4* lg = (const GAS f32x4*)(a.in(I_LN1G) + l * DM) + lane; const GAS f32x4* lb = (const GAS f32x4*)(a.in(I_LN1B) + l * DM) + lane;
    const int Mrows = l == 0 ? NTOK : NTX;
    const float biasv = a.in(I_RB)[(lane >> 1) & 31];
    f32x4 lgv[4], lbv[4];
#pragma unroll
    for (int j = 0; j < 4; ++j) { lgv[j] = lg[64 * j]; lbv[j] = lb[64 * j]; }
    f32x4 nx[4]; v2u no[4];
#define LN1_FETCH(M) do { const int m_ = (M) < Mrows ? (M) : gw; const float* s_ = m_ < NTX ? xs + (size_t)m_ * DM : cs + (size_t)(m_ - NTX) * DM; \
        const GAS f32x4* xr_ = (const GAS f32x4*)s_ + lane; const GAS v2u* or_ = (const GAS v2u*)(O + (size_t)m_ * DM) + lane; \
        _Pragma("unroll") for (int j_ = 0; j_ < 4; ++j_) { nx[j_] = xr_[64 * j_]; no[j_] = or_[64 * j_]; } } while (0)
    LN1_FETCH(gw);
    for (int m = gw; m < Mrows; m += NGW) {
        float* dst; int mr;
        if (m < NTX) { dst = xo + (size_t)m * DM; mr = m / SEQ; } else { dst = co + (size_t)(m - NTX) * DM; mr = 16; }
        const GAS f32x4* md = (const GAS f32x4*)(mods + (size_t)mr * 6144) + lane;
        f32x4 v[4], sc2[4], sh2[4], gt1[4]; float s = 0.f;
#pragma unroll
        for (int j = 0; j < 4; ++j) { gt1[j] = md[512 + 64 * j]; sc2[j] = md[1024 + 64 * j]; sh2[j] = md[768 + 64 * j]; }
#pragma unroll
        for (int j = 0; j < 4; ++j) { const f32x4 x = nx[j], gt = gt1[j]; const v2u ow = no[j]; const f32x4 o = {bflo(ow.x), bfhi(ow.x), bflo(ow.y), bfhi(ow.y)};
            v[j] = x * ALPHA + gt * o; s += (v[j].x + v[j].y) + (v[j].z + v[j].w); }
        LN1_FETCH(m + NGW);
        const float mean = wave_sum(s) * (1.f / DM); float s2 = 0.f;
#pragma unroll
        for (int j = 0; j < 4; ++j) { v[j] = v[j] - mean; s2 += (v[j].x * v[j].x + v[j].y * v[j].y) + (v[j].z * v[j].z + v[j].w * v[j].w); }
        const float rstd = 1.f / sqrtf(wave_sum(s2) * (1.f / DM) + LN_EPS);
        float part[32];
#pragma unroll
        for (int e = 0; e < 32; ++e) part[e] = 0.f;
        GAS f32x4* dr = (GAS f32x4*)dst + lane; GAS v2u* hr = (GAS v2u*)(HM + (size_t)m * DM) + lane;
#pragma unroll
        for (int j = 0; j < 4; ++j) { const f32x4 x1 = v[j] * rstd * lgv[j] + lbv[j]; dr[64 * j] = x1;
            const f32x4 hm = x1 * (sc2[j] + 1.0f) + sh2[j]; v2u w; w.x = pk2(hm.x, hm.y); w.y = pk2(hm.z, hm.w); hr[64 * j] = w;
#pragma unroll
            for (int e8 = 0; e8 < 4; ++e8) { f32x4 rw[8]; const unsigned ra = (unsigned)((256 * j + 4 * lane) * 4 + (e8 >> 1) * 65536);
#pragma unroll
                for (int q = 0; q < 8; ++q) asm volatile("ds_read_b128 %0, %1 offset:%2" : "=v"(rw[q]) : "v"(ra), "i"(((e8 & 1) * 8 + q) * 4096));
                asm volatile("s_waitcnt lgkmcnt(0)" : "+v"(rw[0]), "+v"(rw[1]), "+v"(rw[2]), "+v"(rw[3]), "+v"(rw[4]), "+v"(rw[5]), "+v"(rw[6]), "+v"(rw[7]) :: "memory");
#pragma unroll
                for (int q = 0; q < 8; ++q) part[e8 * 8 + q] += hm.x * rw[q].x + hm.y * rw[q].y + hm.z * rw[q].z + hm.w * rw[q].w;
#ifdef PROBE_ROUTER
                { f32x4 rw2[8];
#pragma unroll
                  for (int q = 0; q < 8; ++q) asm volatile("ds_read_b128 %0, %1 offset:%2" : "=v"(rw2[q]) : "v"(ra), "i"(((e8 & 1) * 8 + q) * 4096));
                  asm volatile("s_waitcnt lgkmcnt(0)" : "+v"(rw2[0]), "+v"(rw2[1]), "+v"(rw2[2]), "+v"(rw2[3]), "+v"(rw2[4]), "+v"(rw2[5]), "+v"(rw2[6]), "+v"(rw2[7]) :: "memory");
#pragma unroll
                  for (int q = 0; q < 8; ++q) { float dmy = hm.x * rw2[q].x + hm.y * rw2[q].y + hm.z * rw2[q].z + hm.w * rw2[q].w; asm volatile("" :: "v"(dmy)); } }
#endif
            } }
        float p16[16], p8[8], p4[4], p2[2], p1;
        { const bool up = (lane & 32) != 0;
#pragma unroll
          for (int e = 0; e < 16; ++e) { const float mine = up ? part[16 + e] : part[e], oth = up ? part[e] : part[16 + e]; p16[e] = mine + shx(oth, 32, lane); } }
        { const bool up = (lane & 16) != 0;
#pragma unroll
          for (int e = 0; e < 8; ++e) { const float mine = up ? p16[8 + e] : p16[e], oth = up ? p16[e] : p16[8 + e]; p8[e] = mine + shx(oth, 16, lane); } }
        { const bool up = (lane & 8) != 0;
#pragma unroll
          for (int e = 0; e < 4; ++e) { const float mine = up ? p8[4 + e] : p8[e], oth = up ? p8[e] : p8[4 + e]; p4[e] = mine + dppmov<0x128>(oth); } }
        { const bool up = (lane & 4) != 0;
#pragma unroll
          for (int e = 0; e < 2; ++e) { const float mine = up ? p4[2 + e] : p4[e], oth = up ? p4[e] : p4[2 + e]; p2[e] = mine + shx(oth, 4, lane); } }
        { const bool up = (lane & 2) != 0; const float mine = up ? p2[1] : p2[0], oth = up ? p2[0] : p2[1]; p1 = mine + dppmov<0x4E>(oth); }
        const float logit = p1 + dppmov<0xB1>(p1);
        const float score = sigmoidf_(logit), sel = score + biasv;
        const int gl = lane & ~7;
        const float q0 = shi(sel, gl), q1 = shi(sel, gl + 2), q2 = shi(sel, gl + 4), q3 = shi(sel, gl + 6);
        const float mx = fmaxf(fmaxf(q0, q1), fmaxf(q2, q3));
        float top2;
        { float a0 = q0, a1 = q1, a2 = q2, a3 = q3; float t;
          if (a0 < a1) { t = a0; a0 = a1; a1 = t; } if (a2 < a3) { t = a2; a2 = a3; a3 = t; } if (a0 < a2) { t = a0; a0 = a2; a2 = t; } if (a1 < a3) { t = a1; a1 = a3; a3 = t; } if (a1 < a2) { t = a1; a1 = a2; a2 = t; }
          top2 = a0 + a1; (void)mx; }
        float best = __builtin_bit_cast(float, __builtin_amdgcn_readlane(__builtin_bit_cast(int, top2), 0)); int gidx = 0;
#pragma unroll
        for (int gg = 1; gg < 8; ++gg) { const float sc = __builtin_bit_cast(float, __builtin_amdgcn_readlane(__builtin_bit_cast(int, top2), gg * 8)); if (sc > best) { best = sc; gidx = gg; } }
        const float r0 = shi(sel, gidx * 8), r1 = shi(sel, gidx * 8 + 2), r2 = shi(sel, gidx * 8 + 4), r3 = shi(sel, gidx * 8 + 6);
        int i0 = 0; float b0 = r0; if (r1 > b0) { b0 = r1; i0 = 1; } if (r2 > b0) { b0 = r2; i0 = 2; } if (r3 > b0) { b0 = r3; i0 = 3; }
        int i1 = -1; float b1 = -INFINITY;
        if (i0 != 0 && r0 > b1) { b1 = r0; i1 = 0; } if (i0 != 1 && r1 > b1) { b1 = r1; i1 = 1; } if (i0 != 2 && r2 > b1) { b1 = r2; i1 = 2; } if (i0 != 3 && r3 > b1) { b1 = r3; i1 = 3; }
        const int e0 = gidx * 4 + i0, e1 = gidx * 4 + i1;
        const float s0 = shi(score, 2 * e0), s1 = shi(score, 2 * e1); const float gs = 1.0f / (s0 + s1);
        if (lane == 0) { const int p0 = __hip_atomic_fetch_add(lcnt + e0, 1, __ATOMIC_RELAXED, __HIP_MEMORY_SCOPE_WORKGROUP), p1_ = __hip_atomic_fetch_add(lcnt + e1, 1, __ATOMIC_RELAXED, __HIP_MEMORY_SCOPE_WORKGROUP);
            TokInfo ti; ti.e0 = e0; ti.e1 = e1; ti.p0 = p0; ti.p1 = p1_; ti.g0 = s0 * gs; ti.g1 = s1 * gs; ti.pad0 = 0; ti.pad1 = 0; TOK[m] = ti; }
    }
    __syncthreads();
    if (tid < 32) HIST[bid * 32 + tid] = lcnt[tid];
}

template <bool FULL> __device__ __forceinline__ void moe_tables(LAS unsigned char* lds, int l) {
    const KA a = ka_get(); const int tid = opaque_tid(), G = gridDim.x;
    LAS int* pref = (LAS int*)(lds + PREF_OFF); LAS int* bb = (LAS int*)lds; LAS int* tot = (LAS int*)(lds + 65536);
    const int* HIST = (const int*)(a.ws() + WS_LIST);
    __syncthreads();
    const int e = tid & 31, grp = tid >> 5;
    int loc[16]; int run = 0;
#pragma unroll
    for (int i = 0; i < 16; ++i) { const int b = grp * 16 + i; loc[i] = (b < G) ? HIST[b * 32 + e] : 0; }
#pragma unroll
    for (int i = 0; i < 16; ++i) { const int v = loc[i]; loc[i] = run; run += v; }
    tot[grp * 32 + e] = run;
    __syncthreads();
    int base = 0, total = 0;
#pragma unroll
    for (int q = 0; q < 16; ++q) { const int v = tot[q * 32 + e]; base += (q < grp) ? v : 0; total += v; }
    if (FULL) {
#pragma unroll
        for (int i = 0; i < 16; ++i) bb[(grp * 16 + i) * 32 + e] = base + loc[i]; }
    if (grp == 0) pref[40 + e] = total;
    __syncthreads();
    if (tid == 0) { int acc = 0; for (int k = 0; k < 32; ++k) { pref[k] = acc; acc += (pref[40 + k] + 255) >> 8; } pref[32] = acc; }
    __syncthreads();
}
__device__ __forceinline__ void phase_gather(LAS unsigned char* lds, int l) {
    const KA a = ka_get();
    const int tid = opaque_tid(), lane = tid & 63, wave = __builtin_amdgcn_readfirstlane(tid >> 6), G = gridDim.x, bid = blockIdx.x;
    const int gw = bid * 8 + wave, NGW = G * 8;
    moe_tables<true>(lds, l);
    const LAS int* pref = (const LAS int*)(lds + PREF_OFF); const LAS int* bb = (const LAS int*)lds;
    const bf16* HM = (const bf16*)(a.ws() + WS_X1); bf16* XB = (bf16*)(a.ws() + WS_X2); const TokInfo* TOK = (const TokInfo*)(a.ws() + WS_TOK);
    const int Mrows = l == 0 ? NTOK : NTX;
    for (int m = gw; m < Mrows; m += NGW) {
        const TokInfo ti = TOK[m]; const int blk = (m % NGW) >> 3;
        const int sl0 = pref[ti.e0] * 256 + bb[blk * 32 + ti.e0] + ti.p0, sl1 = pref[ti.e1] * 256 + bb[blk * 32 + ti.e1] + ti.p1;
        const GAS v4u* srcp = (const GAS v4u*)(HM + (size_t)m * DM) + lane; const v4u v0 = srcp[0], v1 = srcp[64];
        GAS v4u* d0 = (GAS v4u*)(XB + (size_t)sl0 * DM) + lane; GAS v4u* d1 = (GAS v4u*)(XB + (size_t)sl1 * DM) + lane;
        d0[0] = v0; d0[64] = v1; d1[0] = v0; d1[64] = v1;
    }
    for (int e = 0; e < 32; ++e) {
        const int c = pref[40 + e], npad = ((c + 255) & ~255) - c, r0 = pref[e] * 256 + c;
        for (int r = gw; r < npad; r += NGW) { GAS v4u* dst = (GAS v4u*)(XB + (size_t)(r0 + r) * DM) + lane; dst[0] = (v4u){0u, 0u, 0u, 0u}; dst[64] = (v4u){0u, 0u, 0u, 0u}; }
    }
}

__device__ __forceinline__ void phase_ln2(LAS unsigned char* lds, int l) {
    const KA a = ka_get();
    const int tid = opaque_tid(), lane = tid & 63, wave = __builtin_amdgcn_readfirstlane(tid >> 6), G = gridDim.x, bid = blockIdx.x;
    const int gw = bid * 8 + wave, NGW = G * 8;
    moe_tables<true>(lds, l);
    const LAS int* pref = (const LAS int*)(lds + PREF_OFF); const LAS int* bb = (const LAS int*)lds;
    const float* mods = (const float*)(a.ws() + WS_MODS) + (size_t)l * 17 * 6144;
    const bf16* Y = (const bf16*)(a.ws() + WS_X2); const TokInfo* TOK = (const TokInfo*)(a.ws() + WS_TOK);
    float* xo = a.out(); float* co = (float*)(a.ws() + WS_CS);
    const GAS f32x4* lg = (const GAS f32x4*)(a.in(I_LN2G) + l * DM) + lane; const GAS f32x4* lb = (const GAS f32x4*)(a.in(I_LN2B) + l * DM) + lane;
    const int Mrows = l == 0 ? NTOK : NTX;
    f32x4 lgv[4], lbv[4];
#pragma unroll
    for (int j = 0; j < 4; ++j) { lgv[j] = lg[64 * j]; lbv[j] = lb[64 * j]; }
    TokInfo tnext = TOK[gw < Mrows ? gw : 0];
    for (int m = gw; m < Mrows; m += NGW) {
        float* xr_; int mr;
        if (m < NTX) { xr_ = xo + (size_t)m * DM; mr = m / SEQ; } else { xr_ = co + (size_t)(m - NTX) * DM; mr = 16; }
        const TokInfo ti = tnext; tnext = TOK[(m + NGW) < Mrows ? (m + NGW) : m]; const int blk = (m % NGW) >> 3;
        const int sl0 = pref[ti.e0] * 256 + bb[blk * 32 + ti.e0] + ti.p0, sl1 = pref[ti.e1] * 256 + bb[blk * 32 + ti.e1] + ti.p1;
        GAS f32x4* xr = (GAS f32x4*)xr_ + lane; const GAS f32x4* md = (const GAS f32x4*)(mods + (size_t)mr * 6144) + lane;
        const GAS v2u* y0 = (const GAS v2u*)(Y + (size_t)sl0 * DM) + lane; const GAS v2u* y1 = (const GAS v2u*)(Y + (size_t)sl1 * DM) + lane;
        f32x4 v[4], msc[4], msh[4]; float s = 0.f;
        if (l == 0) { const GAS f32x4* mn = (const GAS f32x4*)(mods + (size_t)17 * 6144 + (size_t)mr * 6144) + lane;
#pragma unroll
            for (int j = 0; j < 4; ++j) { msc[j] = mn[256 + 64 * j]; msh[j] = mn[64 * j]; } }
        f32x4 xin[4], gin[4]; v2u ain[4], bin[4];
#pragma unroll
        for (int j = 0; j < 4; ++j) { xin[j] = xr[64 * j]; gin[j] = md[1280 + 64 * j]; ain[j] = y0[64 * j]; bin[j] = y1[64 * j]; }
#pragma unroll
        for (int j = 0; j < 4; ++j) { const f32x4 x = xin[j], gt = gin[j]; const v2u a0 = ain[j], a1 = bin[j];
            const f32x4 ya = {bflo(a0.x), bfhi(a0.x), bflo(a0.y), bfhi(a0.y)}, yb = {bflo(a1.x), bfhi(a1.x), bflo(a1.y), bfhi(a1.y)};
            v[j] = x * ALPHA + gt * (ya * ti.g0 + yb * ti.g1); s += (v[j].x + v[j].y) + (v[j].z + v[j].w); }
        const float mean = wave_sum(s) * (1.f / DM); float s2 = 0.f;
#pragma unroll
        for (int j = 0; j < 4; ++j) { v[j] = v[j] - mean; s2 += (v[j].x * v[j].x + v[j].y * v[j].y) + (v[j].z * v[j].z + v[j].w * v[j].w); }
        const float rstd = 1.f / sqrtf(wave_sum(s2) * (1.f / DM) + LN_EPS);
        if (l == 0) {
            GAS v2u* o8 = (GAS v2u*)((bf16*)(a.ws() + WS_X1) + (size_t)m * DM) + lane;
#pragma unroll
            for (int j = 0; j < 4; ++j) { const f32x4 xn = v[j] * rstd * lgv[j] + lbv[j]; xr[64 * j] = xn; const f32x4 r = xn * (msc[j] + 1.0f) + msh[j]; v2u w; w.x = pk2(r.x, r.y); w.y = pk2(r.z, r.w); o8[64 * j] = w; }
        } else {
#pragma unroll
            for (int j = 0; j < 4; ++j) xr[64 * j] = v[j] * rstd * lgv[j] + lbv[j];
        }
    }
}
namespace csc {
constexpr int ARR = 0;
constexpr int RAW = 0;
constexpr int ZL = 34816;
constexpr int WLO = 57344;
constexpr int FR = 58368;
constexpr int AABT = 87040;
constexpr int LWO = 91136;
constexpr int AAO = 107520;
__device__ __forceinline__ int sw16(int row, int chunk) { return row * 128 + ((chunk ^ (row & 7)) << 4); }
__device__ __forceinline__ v2u cvt4(const f32x4 v) { v2u r; r.x = pk2(v[0], v[1]); r.y = pk2(v[2], v[3]); return r; }
__device__ __forceinline__ bf16x8 mk8(v2u lo, v2u hi) { v4u w; w.x = lo.x; w.y = lo.y; w.z = hi.x; w.w = hi.y; return __builtin_bit_cast(bf16x8, w); }
__device__ __forceinline__ v2u trd(const LAS unsigned char* p) { return __builtin_bit_cast(v2u, __builtin_amdgcn_ds_read_tr16_b64_v4i16((LAS v4i16_t*)p)); }
__device__ __forceinline__ int opq(int v) { asm volatile("" : "+v"(v)); return v; }
__device__ __forceinline__ int opqs(int v) { asm volatile("" : "+s"(v)); return v; }
}
namespace bgc {
constexpr int CBUF = LDSCTL_OFF + 4096, CPITCH = 80, NITEMS = NEXP * 1536;
struct Item { const float* src; bf16* dst; int N, ld; };
__device__ __forceinline__ Item decode(const KA& a, int l, int item) {
    const int e = item / 1536; int r = item - e * 1536; const int m = r >> 9, t = r & 511; const size_t eo = ((size_t)l * NEXP + e) * (size_t)DM * DEXP; Item it;
    if (m < 2) { const int kt = t >> 4, nt = t & 15, j0 = 32 * nt; it.N = DEXP; it.ld = 1024; it.src = (m ? a.in(I_EW3) : a.in(I_EW1)) + eo + (size_t)(32 * kt) * DEXP + j0;
        it.dst = (bf16*)(a.ws() + WS_W13T) + (size_t)e * 1024 * 1024 + (size_t)(256 * (j0 >> 7) + 128 * m + (j0 & 127)) * 1024 + 32 * kt; }
    else { const int kt = t >> 5, nt = t & 31; it.N = DM; it.ld = 512; it.src = a.in(I_EW2) + eo + (size_t)(32 * kt) * DM + 32 * nt; it.dst = (bf16*)(a.ws() + WS_W2T) + (size_t)e * 1024 * 512 + (size_t)(32 * nt) * 512 + 32 * kt; }
    return it; }
__device__ __forceinline__ void issue(const KA& a, int l, int item, int lane, f32x4 (&cv)[4]) { const Item it = decode(a, l, item);
#pragma unroll
    for (int i = 0; i < 4; ++i) cv[i] = *(const GAS f32x4*)(it.src + (size_t)((lane >> 3) + 8 * i) * it.N + (lane & 7) * 4); }
__device__ __forceinline__ void finish(const KA& a, int l, int item, int lane, int slot, LAS unsigned char* lds, const f32x4 (&cv)[4]) { const Item it = decode(a, l, item);
    LAS unsigned char* buf = lds + CBUF + slot * (32 * CPITCH);
#pragma unroll
    for (int i = 0; i < 4; ++i)
#pragma unroll
        for (int u = 0; u < 4; ++u) *(LAS bf16*)(buf + ((lane & 7) * 4 + u) * CPITCH + ((lane >> 3) + 8 * i) * 2) = f2bf1(cv[i][u]);
    LDS_WAIT(); asm volatile("" ::: "memory");
    const int n = lane >> 1, hf = lane & 1; const v4u w0 = *(const LAS v4u*)(buf + n * CPITCH + hf * 32), w1 = *(const LAS v4u*)(buf + n * CPITCH + hf * 32 + 16);
    GAS v4u* d = (GAS v4u*)(it.dst + (size_t)n * it.ld + 16 * hf); d[0] = w0; d[1] = w1;
    LDS_WAIT(); asm volatile("" ::: "memory"); }
}
#ifndef SCAN_PROBE
#define SCAN_PROBE 0
#endif
#define REPK(k) for (int rep_ = 0; rep_ < ((SCAN_PROBE == (k)) ? 2 : 1); ++rep_)
__device__ __forceinline__ void phase_scan(LAS unsigned char* lds, int l) {
    using namespace csc;
    const KA a = ka_get();
    const int tid = opaque_tid(), lane0 = tid & 63, wv = __builtin_amdgcn_readfirstlane(tid >> 6);
    const bf16* PX = (const bf16*)(a.ws() + WS_X2); float* YD = (float*)(a.ws() + WS_X3); float* BON = (float*)(a.ws() + WS_BONUS);
    const float* mup = a.in(I_MUP) + l * 1760; const float* mun = a.in(I_MUN) + l * 1760;
    const f32x4 Z4 = {0.f, 0.f, 0.f, 0.f}; const v2u Z2 = {0u, 0u};
    for (int chain = blockIdx.x; chain < 256; chain += gridDim.x) {
        const int b = chain >> 4, h = (chain >> 1) & 7, d = chain & 1; const int c0_ = opq(lane0);
        float kkc[2], kac[2], rkc[2], mur[2][2], muk[2][2], muv[2][2], mul[2][2], ropef[2]; bf16x8 w2f[2], a2f[2]; float w0c[2], a0c[2];
        { const int ln = c0_, kl = ln & 15, g = ln >> 4, cp = ln & 31;
#pragma unroll
          for (int u = 0; u < 2; ++u) { const int c = 2 * cp + u; ropef[u] = exp2f(-(float)(c & 15) * (13.287712379549449f / 16.0f));
            kkc[u] = a.in(I_KK)[l * 512 + h * 64 + c]; kac[u] = a.in(I_KA)[l * 512 + h * 64 + c]; rkc[u] = a.in(I_RK)[l * 512 + h * 64 + c];
            const int colr = h * 64 + c, coll = (c < 32) ? (1536 + d * 32 + c) : (1600 + d * 32 + (c - 32));
            mur[u][0] = d ? mun[colr] : mup[colr]; mur[u][1] = d ? mup[colr] : mun[colr]; muk[u][0] = d ? mun[512 + colr] : mup[512 + colr]; muk[u][1] = d ? mup[512 + colr] : mun[512 + colr];
            muv[u][0] = d ? mun[1024 + colr] : mup[1024 + colr]; muv[u][1] = d ? mup[1024 + colr] : mun[1024 + colr]; mul[u][0] = d ? mun[coll] : mup[coll]; mul[u][1] = d ? mup[coll] : mun[coll]; }
#pragma unroll
        for (int i = 0; i < 2; ++i) { const int cc = h * 64 + 16 * ((wv >> 2) * 2 + i) + kl; unsigned t[8], u[8];
#pragma unroll
            for (int j = 0; j < 8; ++j) { t[j] = f2bf(a.in(I_W2)[((size_t)(l * 2 + d) * 32 + 8 * g + j) * 512 + cc]); u[j] = f2bf(a.in(I_A2)[((size_t)(l * 2 + d) * 32 + 8 * g + j) * 512 + cc]); }
            w2f[i] = __builtin_bit_cast(bf16x8, (v4u){t[0] | (t[1] << 16), t[2] | (t[3] << 16), t[4] | (t[5] << 16), t[6] | (t[7] << 16)});
            a2f[i] = __builtin_bit_cast(bf16x8, (v4u){u[0] | (u[1] << 16), u[2] | (u[3] << 16), u[4] | (u[5] << 16), u[6] | (u[7] << 16)});
            w0c[i] = a.in(I_W0)[(l * 2 + d) * 512 + cc]; a0c[i] = a.in(I_A0)[(l * 2 + d) * 512 + cc]; } }
        f32x4 St[4] = {Z4, Z4, Z4, Z4};
        f32x4 cvt_[4] = {Z4, Z4, Z4, Z4}; int cit = blockIdx.x * 8 + wv, cpend = -1; const int cstride = gridDim.x * 8;
#define BGC_WINDOW() do { const int ln_ = opq(lane0); if (cpend >= 0) bgc::finish(a, l, cpend, ln_, wv & 3, lds, cvt_); if (cit < bgc::NITEMS) { bgc::issue(a, l, cit, ln_, cvt_); cpend = cit; cit += cstride; } else cpend = -1; } while (0)
        for (int seq = 0; seq < 2; ++seq) {
            const int T = seq ? SEQ : CTXL, rowbase = seq ? b * SEQ : NTX + b * CTXL, ngrp = T / 64;
            v4u pre[5];
#define CSC_PREFETCH(GRP) do { const int s0_ = (GRP) * 64; const int tlo_ = d ? (T - 64 - s0_) : s0_; \
                _Pragma("unroll") for (int i_ = 0; i_ < 5; ++i_) { const int id_ = opq(tid) + 512 * i_; const int rr_ = id_ >> 5, ch_ = id_ & 31; const int t_ = tlo_ - 1 + rr_; \
                    const int col_ = RWOFF + (ch_ < 24 ? (ch_ >> 3) * 512 + h * 64 + (ch_ & 7) * 8 : (ch_ < 28 ? 1536 + d * 32 + (ch_ - 24) * 8 : 1600 + d * 32 + (ch_ - 28) * 8)); \
                    const bool ok_ = (id_ < 66 * 32) && t_ >= 0 && t_ < T; const int tc_ = ok_ ? t_ : 0; \
                    const v4u v_ = *(const GAS v4u*)(PX + (size_t)(rowbase + tc_) * DINP + col_); pre[i_] = ok_ ? v_ : (v4u){0u, 0u, 0u, 0u}; } } while (0)
            CSC_PREFETCH(0);
            for (int grp = 0; grp < ngrp; ++grp) {
                const int s0 = grp * 64;
                int lane = opq(lane0); int c = lane, kl = lane & 15, g = lane >> 4, q_ = kl >> 2, p_ = kl & 3; (void)q_; (void)p_;
#pragma unroll
                for (int i = 0; i < 5; ++i) { const int id = opq(tid) + 512 * i; if (id < 66 * 32) *(LAS v4u*)(lds + RAW + id * 16) = pre[i]; }
                __syncthreads();
                int sl = opqs(wv);
                float Rk[4][2], Rq[4][2], Rr[4][2], Rv[4][2];
                REPK(1) { const int cp = lane & 31, sh = lane >> 5, sb = 8 * sl + 4 * sh; const int rbase = d ? 64 - sb : sb + 1, rdir = d ? -256 : 256;
                  const LAS bf16* p0 = (const LAS bf16*)(lds + RAW) + (rbase * 256 + 2 * cp) - rdir;
                  float pr[6][2], pk[6][2], pv[6][2], pl[6][2];
#pragma unroll
                  for (int j = 0; j < 6; ++j) { const LAS unsigned* p = (const LAS unsigned*)(p0 + j * rdir); const unsigned wr = p[0], wk = p[32], wv_ = p[64], wl = p[96];
                      pr[j][0] = bflo(wr); pr[j][1] = bfhi(wr); pk[j][0] = bflo(wk); pk[j][1] = bfhi(wk); pv[j][0] = bflo(wv_); pv[j][1] = bfhi(wv_); pl[j][0] = bflo(wl); pl[j][1] = bfhi(wl); }
                  const int qd = cp >> 3;
#pragma unroll
                  for (int i = 0; i < 4; ++i) { const int sloc = sb + i; float r[2], k[2], zz[2];
#pragma unroll
                      for (int u = 0; u < 2; ++u) { r[u] = pr[i + 1][u] + mur[u][0] * (pr[i][u] - pr[i + 1][u]) + mur[u][1] * (pr[i + 2][u] - pr[i + 1][u]); k[u] = pk[i + 1][u] + muk[u][0] * (pk[i][u] - pk[i + 1][u]) + muk[u][1] * (pk[i + 2][u] - pk[i + 1][u]);
                          Rv[i][u] = pv[i + 1][u] + muv[u][0] * (pv[i][u] - pv[i + 1][u]) + muv[u][1] * (pv[i + 2][u] - pv[i + 1][u]);
                          const float z = pl[i + 1][u] + mul[u][0] * (pl[i][u] - pl[i + 1][u]) + mul[u][1] * (pl[i + 2][u] - pl[i + 1][u]);
                          const float th = 1.0f - 2.0f * __builtin_amdgcn_rcpf(1.0f + __expf(2.0f * z)); zz[u] = cp < 16 ? th : z; }
                      ((LAS unsigned*)(lds + ZL))[sloc * 32 + cp] = pk2(zz[0], zz[1]);
                      if (seq) { const int t = d ? (T - 1 - (s0 + sloc)) : (s0 + sloc); const float pos = (float)((qd < 2) ? (t >> 6) : (t & 63));
#pragma unroll
                          for (int u = 0; u < 2; ++u) { const float rp = dppmov<0x128>(r[u]), kp = dppmov<0x128>(k[u]); const float ang = pos * ropef[u]; const float cs = __cosf(ang), sn = __sinf(ang);
                              const float sg = (qd & 1) ? sn : -sn; r[u] = r[u] * cs + rp * sg; k[u] = k[u] * cs + kp * sg; } }
                      const float k0 = k[0] * kkc[0], k1 = k[1] * kkc[1]; float ss = k0 * k0 + k1 * k1;
                      ss += dppmov<0xB1>(ss); ss += dppmov<0x4E>(ss); ss += dppmov<0x141>(ss); ss += dppmov<0x140>(ss);
                      { const int iv = __builtin_bit_cast(int, ss); const float a0 = __builtin_bit_cast(float, __builtin_amdgcn_readlane(iv, 0)) + __builtin_bit_cast(float, __builtin_amdgcn_readlane(iv, 16)), a1 = __builtin_bit_cast(float, __builtin_amdgcn_readlane(iv, 32)) + __builtin_bit_cast(float, __builtin_amdgcn_readlane(iv, 48)); ss = sh ? a1 : a0; }
                      const float rn = __builtin_amdgcn_rsqf(fmaxf(ss, 1e-24f));
                      Rk[i][0] = k0 * rn; Rk[i][1] = k1 * rn; Rq[i][0] = k[0]; Rq[i][1] = k[1]; Rr[i][0] = r[0]; Rr[i][1] = r[1]; } }
                __syncthreads();
                lane = opq(lane0); c = lane; kl = lane & 15; g = lane >> 4; q_ = kl >> 2; p_ = kl & 3;
                REPK(2) { const int wq = opqs(wv); const int st = wq & 3; const LAS unsigned char* zrow = lds + ZL + (16 * st + kl) * 128;
                  const bf16x8 zw = *(const LAS bf16x8*)(zrow + 16 * g), za = *(const LAS bf16x8*)(zrow + 64 + 16 * g);
#pragma unroll
                  for (int i = 0; i < 2; ++i) { const int cc = 16 * ((wq >> 2) * 2 + i) + kl;
                      const f32x4 uw = __builtin_amdgcn_mfma_f32_16x16x32_bf16(zw, w2f[i], Z4, 0, 0, 0), ua = __builtin_amdgcn_mfma_f32_16x16x32_bf16(za, a2f[i], Z4, 0, 0, 0);
#pragma unroll
                      for (int j = 0; j < 4; ++j) { const int srow = 16 * st + 4 * g + j;
                          ((LAS float*)(lds + LWO))[srow * 64 + cc] = -0.6065306597126334f * __builtin_amdgcn_rcpf(1.0f + __expf(-(uw[j] + w0c[i]))); ((LAS float*)(lds + AAO))[srow * 64 + cc] = __builtin_amdgcn_rcpf(1.0f + __expf(-(ua[j] + a0c[i]))); } } }
                __syncthreads();
                lane = opq(lane0); c = lane; kl = lane & 15; g = lane >> 4; q_ = kl >> 2; p_ = kl & 3;
                sl = opqs(wv);
                REPK(4) { const int cp = lane & 31, sh = lane >> 5, q = sl >> 1, hf = sl & 1; typedef float f32x2_ __attribute__((ext_vector_type(2)));
                  const LAS f32x2_* lwp = (const LAS f32x2_*)((const LAS float*)(lds + LWO) + (16 * q) * 64 + 2 * cp); const LAS f32x2_* aap = (const LAS f32x2_*)((const LAS float*)(lds + AAO) + (8 * sl + 4 * sh) * 64 + 2 * cp);
                  f32x2_ qs[4];
#pragma unroll
                  for (int j = 0; j < 4; ++j) { qs[j] = lwp[(4 * j) * 32] + lwp[(4 * j + 1) * 32] + lwp[(4 * j + 2) * 32] + lwp[(4 * j + 3) * 32]; }
                  const f32x2_ cL = (qs[0] + qs[1]) + (qs[2] + qs[3]); const int part = 2 * hf + sh;
                  f32x2_ run = part == 0 ? (f32x2_){0.f, 0.f} : (part == 1 ? qs[0] : (part == 2 ? qs[0] + qs[1] : qs[0] + qs[1] + qs[2]));
                  const float wl0 = __expf(cL.x), wl1 = __expf(cL.y);
                  if (part == 3) ((LAS f32x2_*)(lds + WLO))[q * 32 + cp] = (f32x2_){wl0, wl1};
#pragma unroll
                  for (int i = 0; i < 4; ++i) { const int sloc = 8 * sl + 4 * sh + i, s = 4 * part + i; const f32x2_ lwi = lwp[s * 32]; const f32x2_ cprev = run; run = run + lwi; const f32x2_ aa = aap[i * 32];
                      const float kd0 = Rq[i][0] * (1.0f + (aa.x - 1.0f) * kac[0]), kd1 = Rq[i][1] * (1.0f + (aa.y - 1.0f) * kac[1]), nb0 = -Rk[i][0] * aa.x, nb1 = -Rk[i][1] * aa.y;
                      float bon = Rr[i][0] * kd0 * rkc[0] + Rr[i][1] * kd1 * rkc[1];
                      bon += dppmov<0xB1>(bon); bon += dppmov<0x4E>(bon); bon += dppmov<0x141>(bon); bon += dppmov<0x140>(bon);
                      { const int iv = __builtin_bit_cast(int, bon); const float a0 = __builtin_bit_cast(float, __builtin_amdgcn_readlane(iv, 0)) + __builtin_bit_cast(float, __builtin_amdgcn_readlane(iv, 16)), a1 = __builtin_bit_cast(float, __builtin_amdgcn_readlane(iv, 32)) + __builtin_bit_cast(float, __builtin_amdgcn_readlane(iv, 48)); bon = sh ? a1 : a0; }
                      if (cp == 0) { const int t = d ? (T - 1 - (s0 + sloc)) : (s0 + sloc); BON[((size_t)d * NTOK + rowbase + t) * 8 + h] = bon; }
                      const float e1x = __expf(cprev.x), e1y = __expf(cprev.y), e2x = __expf(-run.x), e2y = __expf(-run.y), e3x = __builtin_amdgcn_rcpf(e2x), e3y = __builtin_amdgcn_rcpf(e2y);
                      LAS unsigned char* base = lds + ARR + q * (7 * 2048) + sw16(s, cp >> 2) + (cp & 3) * 4;
                      *(LAS unsigned*)(base) = pk2(Rk[i][0] * e1x, Rk[i][1] * e1y); *(LAS unsigned*)(base + 2048) = pk2(nb0 * e2x, nb1 * e2y); *(LAS unsigned*)(base + 4096) = pk2(kd0 * e2x, kd1 * e2y); *(LAS unsigned*)(base + 6144) = pk2(Rr[i][0] * e3x, Rr[i][1] * e3y);
                      *(LAS unsigned*)(base + 12288) = pk2(Rv[i][0], Rv[i][1]); } }
                __syncthreads();
                lane = opq(lane0); c = lane; kl = lane & 15; g = lane >> 4; q_ = kl >> 2; p_ = kl & 3;
                if (grp + 1 < ngrp) CSC_PREFETCH(grp + 1);
                if (wv < 4) BGC_WINDOW();
                REPK(5) if (wv >= 4) { const int q = opqs(wv) - 4; const LAS unsigned char* A0 = lds + ARR + q * (7 * 2048);
                    bf16x8 at[2], bt[2], kt[2], rt[2];
#pragma unroll
                    for (int ks = 0; ks < 2; ++ks) { const int o = sw16(kl, ks * 4 + g); at[ks] = *(const LAS bf16x8*)(A0 + o); bt[ks] = *(const LAS bf16x8*)(A0 + 2048 + o); kt[ks] = *(const LAS bf16x8*)(A0 + 4096 + o); rt[ks] = *(const LAS bf16x8*)(A0 + 6144 + o); }
                    f32x4 ABt = Z4, AKt = Z4, RBt = Z4, RKt = Z4;
#pragma unroll
                    for (int ks = 0; ks < 2; ++ks) { ABt = __builtin_amdgcn_mfma_f32_16x16x32_bf16(bt[ks], at[ks], ABt, 0, 0, 0); AKt = __builtin_amdgcn_mfma_f32_16x16x32_bf16(kt[ks], at[ks], AKt, 0, 0, 0);
                        RBt = __builtin_amdgcn_mfma_f32_16x16x32_bf16(bt[ks], rt[ks], RBt, 0, 0, 0); RKt = __builtin_amdgcn_mfma_f32_16x16x32_bf16(kt[ks], rt[ks], RKt, 0, 0, 0); }
#pragma unroll
                    for (int j = 0; j < 4; ++j) { const int jj = 4 * g + j; ABt[j] = jj < kl ? ABt[j] : 0.f; AKt[j] = jj < kl ? AKt[j] : 0.f; RBt[j] = jj <= kl ? RBt[j] : 0.f; RKt[j] = jj <= kl ? RKt[j] : 0.f; }
                    float Tr[16]; const float ab0 = ABt[0], ab1 = ABt[1], ab2 = ABt[2], ab3 = ABt[3];
                    const int abi[4] = {__builtin_bit_cast(int, ab0), __builtin_bit_cast(int, ab1), __builtin_bit_cast(int, ab2), __builtin_bit_cast(int, ab3)};
#pragma unroll
                    for (int i = 0; i < 16; ++i) Tr[i] = (i == kl) ? 1.f : 0.f;
#pragma unroll
                    for (int j = 14; j >= 0; --j) { float acc = 0.f;
#pragma unroll
                        for (int i = j + 1; i < 16; ++i) acc += Tr[i] * __builtin_bit_cast(float, __builtin_amdgcn_readlane(abi[j & 3], i + 16 * (j >> 2)));
                        Tr[j] = (j < kl) ? acc : Tr[j]; }
                    float tsel[4];
#pragma unroll
                    for (int e = 0; e < 4; ++e) tsel[e] = g == 0 ? Tr[e] : (g == 1 ? Tr[4 + e] : (g == 2 ? Tr[8 + e] : Tr[12 + e]));
                    v2u tf2; tf2.x = pk2(tsel[0], tsel[1]); tf2.y = pk2(tsel[2], tsel[3]);
                    const bf16x8 Tf = mk8(tf2, Z2), RBf = mk8(cvt4(RBt), Z2);
                    f32x4 AhT[4], QhT[4];
#pragma unroll
                    for (int ct = 0; ct < 4; ++ct) {
                        const bf16x8 Alo = mk8(trd(A0 + sw16(4 * g + q_, 2 * ct + (p_ >> 1)) + (p_ & 1) * 8), Z2);
                        AhT[ct] = __builtin_amdgcn_mfma_f32_16x16x32_bf16(Alo, Tf, Z4, 0, 0, 0);
                        const f32x4 Ah = __builtin_amdgcn_mfma_f32_16x16x32_bf16(Tf, Alo, Z4, 0, 0, 0);
                        const v2u rw = *(const LAS v2u*)(A0 + 6144 + sw16(kl, 2 * ct + (g >> 1)) + (g & 1) * 8);
                        const f32x4 rinit = {bflo(rw.x), bfhi(rw.x), bflo(rw.y), bfhi(rw.y)};
                        QhT[ct] = __builtin_amdgcn_mfma_f32_16x16x32_bf16(mk8(cvt4(Ah), Z2), RBf, rinit, 0, 0, 0); }
                    LAS unsigned char* fr = lds + FR + q * 7168 + lane * 16;
                    *(LAS bf16x8*)(fr) = mk8(cvt4(AhT[0]), cvt4(AhT[1])); *(LAS bf16x8*)(fr + 1024) = mk8(cvt4(AhT[2]), cvt4(AhT[3]));
                    *(LAS bf16x8*)(fr + 2048) = mk8(cvt4(QhT[0]), cvt4(QhT[1])); *(LAS bf16x8*)(fr + 3072) = mk8(cvt4(QhT[2]), cvt4(QhT[3]));
                    *(LAS bf16x8*)(fr + 4096) = mk8(cvt4(AKt), Z2); *(LAS bf16x8*)(fr + 5120) = mk8(cvt4(RBt), cvt4(RKt)); *(LAS bf16x8*)(fr + 6144) = Tf;
                }
                __syncthreads();
                lane = opq(lane0); c = lane; kl = lane & 15; g = lane >> 4; q_ = kl >> 2; p_ = kl & 3;
                if (wv >= 4) BGC_WINDOW();
                if (wv < 4) { const int vt = opqs(wv);
                    f32x4 Uh[4], Yh[4]; v2u vtrs[4];
#pragma unroll
                    for (int q = 0; q < 4; ++q) { const LAS unsigned char* A0 = lds + ARR + q * (7 * 2048); const LAS unsigned char* fr = lds + FR + q * 7168 + lane * 16;
                        const bf16x8 AKf = *(const LAS bf16x8*)(fr + 4096), RBRK = *(const LAS bf16x8*)(fr + 5120), Tf = *(const LAS bf16x8*)(fr + 6144);
                        vtrs[q] = trd(A0 + 12288 + sw16(4 * g + q_, 2 * vt + (p_ >> 1)) + (p_ & 1) * 8);
                        const f32x4 X1 = __builtin_amdgcn_mfma_f32_16x16x32_bf16(AKf, mk8(vtrs[q], Z2), Z4, 0, 0, 0);
                        Uh[q] = __builtin_amdgcn_mfma_f32_16x16x32_bf16(Tf, mk8(cvt4(X1), Z2), Z4, 0, 0, 0);
                        Yh[q] = __builtin_amdgcn_mfma_f32_16x16x32_bf16(RBRK, mk8(cvt4(Uh[q]), vtrs[q]), Z4, 0, 0, 0); }
#pragma unroll
                    for (int q = 0; q < 4; ++q) { const LAS unsigned char* A0 = lds + ARR + q * (7 * 2048); const LAS unsigned char* fr = lds + FR + q * 7168 + lane * 16;
                        const bf16x8 Ap0 = *(const LAS bf16x8*)(fr), Ap1 = *(const LAS bf16x8*)(fr + 1024), Qp0 = *(const LAS bf16x8*)(fr + 2048), Qp1 = *(const LAS bf16x8*)(fr + 3072);
                        bf16x8 bk[4]; f32x4 wl[4];
#pragma unroll
                        for (int ct = 0; ct < 4; ++ct) { wl[ct] = *(const LAS f32x4*)(lds + WLO + (q * 64 + 16 * ct + 4 * g) * 4); const int o = sw16(4 * g + q_, 2 * ct + (p_ >> 1)) + (p_ & 1) * 8; bk[ct] = mk8(trd(A0 + 2048 + o), trd(A0 + 4096 + o)); }
                        const bf16x8 bs0 = mk8(cvt4(St[0]), cvt4(St[1])), bs1 = mk8(cvt4(St[2]), cvt4(St[3]));
                        f32x4 U = __builtin_amdgcn_mfma_f32_16x16x32_bf16(Ap0, bs0, Uh[q], 0, 0, 0); U = __builtin_amdgcn_mfma_f32_16x16x32_bf16(Ap1, bs1, U, 0, 0, 0);
                        f32x4 Y = __builtin_amdgcn_mfma_f32_16x16x32_bf16(Qp0, bs0, Yh[q], 0, 0, 0); Y = __builtin_amdgcn_mfma_f32_16x16x32_bf16(Qp1, bs1, Y, 0, 0, 0);
                        const bf16x8 UV = mk8(cvt4(U), vtrs[q]);
#pragma unroll
                        for (int ct = 0; ct < 4; ++ct) St[ct] = __builtin_amdgcn_mfma_f32_16x16x32_bf16(bk[ct], UV, St[ct], 0, 0, 0) * wl[ct];
#pragma unroll
                        for (int j = 0; j < 4; ++j) { const int sg = s0 + 16 * q + 4 * g + j; const int t = d ? (T - 1 - sg) : sg; YD[((size_t)d * NTOK + rowbase + t) * 512 + h * 64 + 16 * vt + kl] = Y[j]; }
                    }
                }
                __syncthreads();
            }
#undef CSC_PREFETCH
        }
        if (cpend >= 0) { bgc::finish(a, l, cpend, opq(lane0), wv & 3, lds, cvt_); cpend = -1; }
        for (; cit < bgc::NITEMS; cit += cstride) { bgc::issue(a, l, cit, opq(lane0), cvt_); bgc::finish(a, l, cit, opq(lane0), wv & 3, lds, cvt_); }
#undef BGC_WINDOW
    }
}
constexpr int PH_PER_LAYER = 11, N_PHASES = 1 + 2 * PH_PER_LAYER;
template <int K> __device__ __forceinline__ void run_phase(LAS unsigned char* lds, int l) {
    if constexpr (K == 0) phase_prologue(lds);
    if constexpr (K == 1) phase_modconv(lds, l);
    if constexpr (K == 3) phase_scan(lds, l);
    if constexpr (K == 4) phase_attn(lds, l);
    if constexpr (K == 5) phase_rwpost(lds, l);
    if constexpr (K == 7) phase_ln1_route(lds, l);
    if constexpr (K == 8) phase_gather(lds, l);
    if constexpr (K == 11) phase_ln2(lds, l);
    if constexpr (K == 2 || K == 6 || K == 9 || K == 10) {
        const KA a = ka_get(); unsigned char* ws = a.ws(); const int G = gridDim.x, bid = blockIdx.x;
        bf16* X1 = (bf16*)(ws + WS_X1); bf16* X2 = (bf16*)(ws + WS_X2); bf16* X3 = (bf16*)(ws + WS_X3);
        if constexpr (K == 2) { __syncthreads();
            pg8::Gemm g{X1, (const bf16*)(ws + WS_WINT) + (size_t)l * DINP * DM, NTOK, DINP, DM}; pg8::StaticOrder S; S.init(NTOK, DINP, G, bid);
            pg8::EpiBf16 E{X2, DINP}; pg8::gemm_phase<pg8::EpiBf16, pg8::StaticOrder, true, true>(lds, g, S, E); }
        if constexpr (K == 6) { __syncthreads();
            const int Mrows = (l == 0) ? NTOK : NTX;
            pg8::Gemm g{X1, (const bf16*)(ws + WS_WOT) + (size_t)l * DM * DM, Mrows, DM, DM}; pg8::StaticOrder S; S.init(Mrows, DM, G, bid);
            pg8::EpiBf16 E{X3, DM}; pg8::gemm_phase<pg8::EpiBf16, pg8::StaticOrder, true, true>(lds, g, S, E); }
        if constexpr (K == 9) { moe_tables<false>(lds, l);
            pg8::Gemm g{X2, (const bf16*)(ws + WS_W13T), MAXSLOT, 1024, DM}; pg8::MoeOrder S; S.init((const LAS int*)(lds + PREF_OFF), 4, G, bid);
            pg8::EpiSwiGLU E{X3, DEXP}; pg8::gemm_phase<pg8::EpiSwiGLU, pg8::MoeOrder, true, true>(lds, g, S, E); }
        if constexpr (K == 10) { moe_tables<false>(lds, l);
            pg8::Gemm g{X3, (const bf16*)(ws + WS_W2T), MAXSLOT, 1024, DEXP}; pg8::MoeOrder S; S.init((const LAS int*)(lds + PREF_OFF), 4, G, bid);
            pg8::EpiBf16 E{X2, DM}; pg8::gemm_phase<pg8::EpiBf16, pg8::MoeOrder, true, true>(lds, g, S, E); }
    }
}
__device__ __forceinline__ void grid_sync(LAS unsigned char* lds) {
    const KA a = ka_get(); XcdBarrier b; b.bar = (unsigned*)(a.ws() + WS_CTL) + CW_BAR; b.x = xb_xcc_id(); b.st = (volatile LAS unsigned*)(lds + MISC_OFF) + 8; xcd_barrier(b);
#ifdef PROBE_BAR
    xcd_barrier(b);
#endif
}
#ifndef ONE_LAUNCH
template <int K> __global__ void __launch_bounds__(512, 2) fwd_ph(Args args) {
    extern __shared__ __attribute__((aligned(16))) unsigned char lds_raw[];
    LAS unsigned char* lds = (LAS unsigned char*)lds_raw;
    for (int u = threadIdx.x; u < (LDS_BYTES - LDSCTL_OFF) / 4; u += 512) ((LAS unsigned*)(lds + LDSCTL_OFF))[u] = 0u;
    __syncthreads();
    hw_tid_init();
    __syncthreads();
    run_phase<K>(lds, args.ph_lo);
}
template <int K> static void launch_ph(const Args& a, int grid, hipStream_t stream) {
    static bool attr = false;
    if (!attr) { (void)hipFuncSetAttribute((const void*)fwd_ph<K>, hipFuncAttributeMaxDynamicSharedMemorySize, LDS_BYTES); attr = true; }
    hipLaunchKernelGGL(fwd_ph<K>, dim3(grid), dim3(512), LDS_BYTES, stream, a);
}
#else
__global__ void __launch_bounds__(512, 2) fwd(Args args) {
    extern __shared__ __attribute__((aligned(16))) unsigned char lds_raw[];
    LAS unsigned char* lds = (LAS unsigned char*)lds_raw;
    for (int u = threadIdx.x; u < (LDS_BYTES - LDSCTL_OFF) / 4; u += 512) ((LAS unsigned*)(lds + LDSCTL_OFF))[u] = 0u;
    __syncthreads();
    hw_tid_init();
    __syncthreads();
    (void)xcd_barrier_post((unsigned*)(args.ws + WS_CTL) + CW_BAR, (volatile LAS unsigned*)(lds + MISC_OFF) + 8);
    run_phase<0>(lds, 0);
#ifdef PROBE_P0
    __syncthreads(); run_phase<0>(lds, 0);
#endif
    grid_sync(lds);
#ifndef PROBE_REP
#define PROBE_REP -1
#endif
#define RUNP(K) do { run_phase<K>(lds, l); if (PROBE_REP == K) { __syncthreads(); run_phase<K>(lds, l); } } while (0)
    for (int l = 0; l < 2; ++l) {
        if (l == 0) { RUNP(1); grid_sync(lds); }
        RUNP(2); grid_sync(lds);
        RUNP(3);
        RUNP(4); grid_sync(lds);
        RUNP(5); grid_sync(lds);
        RUNP(6); grid_sync(lds);
        run_phase<7>(lds, l); if (PROBE_REP == 7 && l == 0) { __syncthreads(); run_phase<7>(lds, l); } grid_sync(lds);
        RUNP(8); grid_sync(lds);
        RUNP(9); grid_sync(lds);
        RUNP(10); grid_sync(lds);
        run_phase<11>(lds, l); if (l == 0) grid_sync(lds);
    }
}
#endif

extern "C" void kernel_launch(void* const* d_in, const int* in_sizes, int n_in, void* d_out, int out_size, void* d_ws, size_t ws_size, hipStream_t stream) {
    static int grid = 0;
    if (grid == 0) {
        if (n_in != 30 || in_sizes[0] != NTX * DM || out_size != NTX * DM || ws_size < WS_END) {
            fprintf(stderr, "kernel_launch: unexpected problem (n_in %d, in0 %d, out %d, ws %zu < %zu?); nothing launched\n", n_in, n_in > 0 ? in_sizes[0] : -1, out_size, ws_size, (size_t)WS_END); grid = -1; return; }
        int dev = 0, cus = 0;
        if (hipGetDevice(&dev) != hipSuccess || hipDeviceGetAttribute(&cus, hipDeviceAttributeMultiprocessorCount, dev) != hipSuccess) { grid = -1; return; }
#ifdef ONE_LAUNCH
        if (hipFuncSetAttribute((const void*)fwd, hipFuncAttributeMaxDynamicSharedMemorySize, LDS_BYTES) != hipSuccess) { fprintf(stderr, "kernel_launch: hipFuncSetAttribute failed\n"); grid = -1; return; }
#endif
        (void)hipGetLastError();
        grid = cus > 0 ? cus : 256;
    }
    if (grid < 0) return;
    if (hipMemsetAsync((char*)d_ws + WS_CTL, 0, CTL_ZERO_BYTES, stream) != hipSuccess) return;
    Args a{};
    for (int i = 0; i < 30; ++i) a.in[i] = (const float*)d_in[i];
    a.out = (float*)d_out; a.ws = (unsigned char*)d_ws; a.ph_lo = 0; a.ph_hi = 0;
#ifndef ONE_LAUNCH
    launch_ph<0>(a, grid, stream);
    for (int l = 0; l < 2; ++l) { a.ph_lo = l;
        launch_ph<1>(a, grid, stream); launch_ph<2>(a, grid, stream); launch_ph<3>(a, grid, stream); launch_ph<4>(a, grid, stream); launch_ph<5>(a, grid, stream); launch_ph<6>(a, grid, stream);
        launch_ph<7>(a, grid, stream); launch_ph<8>(a, grid, stream); launch_ph<9>(a, grid, stream); launch_ph<10>(a, grid, stream); launch_ph<11>(a, grid, stream); }
#else
    hipLaunchKernelGGL(fwd, dim3(grid), dim3(512), LDS_BYTES, stream, a);
#endif
}
```

```cpp
#define ONE_LAUNCH 1
#include <hip/hip_runtime.h>
#include <cstdio>
#include <cstdint>

constexpr int DM = 1024, NB = 16, SEQ = 2048, CTXL = 256, NTX = NB * SEQ, NTC = NB * CTXL, NTOK = NTX + NTC;
constexpr int DIN = 3296, DINP = 3328, RWOFF = 1536, NHEAD = 8, HD = 64;
constexpr int NEXP = 32, DEXP = 512, LISTCAP = 2 * NTOK;
constexpr int MAXSLOT = 81920;
constexpr float ALPHA = 1.41421356237309515f, LN_EPS = 1e-6f, GN_EPS = 64e-5f;

constexpr size_t MiB = 1u << 20;
constexpr size_t WS_CTL = 0, CTL_ZERO_BYTES = 1 * MiB;
constexpr size_t WS_MODS = 1 * MiB;
constexpr size_t WS_ROPE = 2 * MiB;
constexpr size_t WS_WINT = 3 * MiB;
constexpr size_t WS_WOT = 16 * MiB;
constexpr size_t WS_W13T = 20 * MiB;
constexpr size_t WS_W2T = 84 * MiB;
constexpr size_t WS_LIST = 116 * MiB;
constexpr size_t WS_TOK = 125 * MiB;
constexpr size_t WS_BONUS = 127 * MiB;
constexpr size_t WS_CS = 130 * MiB;
constexpr size_t WS_X1 = 146 * MiB;
constexpr size_t WS_X2 = 218 * MiB;
constexpr size_t WS_X3 = 452 * MiB;
constexpr size_t WS_END = 596 * MiB;
static_assert(WS_WINT + (size_t)2 * DINP * DM * 2 <= WS_WOT && WS_LIST + (size_t)NEXP * LISTCAP * 4 <= WS_TOK && WS_TOK + (size_t)NTOK * 32 <= WS_BONUS, "ws map");
static_assert(WS_BONUS + (size_t)2 * NTOK * 8 * 4 <= WS_CS && WS_X2 + (size_t)NTOK * DINP * 2 <= WS_X3 && WS_X3 + (size_t)2 * NTOK * 512 * 4 <= WS_END, "ws map");
static_assert((size_t)MAXSLOT * 1024 * 2 <= WS_X3 - WS_X2 && (size_t)MAXSLOT * 512 * 2 <= WS_END - WS_X3, "ws map");
constexpr int CW_BAR = 4096;
constexpr int CW_CNT = 8192;
constexpr int RING_BYTES = 131072, LDSCTL_OFF = RING_BYTES, MISC_OFF = LDSCTL_OFF + 320, LDS_BYTES = 147456;
constexpr int PREF_OFF = LDSCTL_OFF + 512;

#define GAS __attribute__((address_space(1)))
#define LAS __attribute__((address_space(3)))
typedef unsigned short bf16;
typedef unsigned v4u __attribute__((ext_vector_type(4)));
typedef unsigned v2u __attribute__((ext_vector_type(2)));
typedef float f32x4 __attribute__((ext_vector_type(4)));
typedef short bf16x8 __attribute__((ext_vector_type(8)));
typedef GAS unsigned gu32;
#define RLX_AGENT __ATOMIC_RELAXED, __HIP_MEMORY_SCOPE_AGENT
#define LDS_WAIT() asm volatile("s_waitcnt lgkmcnt(0)" ::: "memory")
#define VM_WAIT() asm volatile("s_waitcnt vmcnt(0)" ::: "memory")
__device__ __forceinline__ unsigned f2bf(float f) { unsigned u = __builtin_bit_cast(unsigned, f); return (u + 0x7fffu + ((u >> 16) & 1u)) >> 16; }
typedef float f32x2_t_ __attribute__((ext_vector_type(2))); typedef __bf16 bf16x2_t_ __attribute__((ext_vector_type(2)));
__device__ __forceinline__ unsigned pk2(float lo, float hi) { f32x2_t_ v = {lo, hi}; bf16x2_t_ b = __builtin_convertvector(v, bf16x2_t_); return __builtin_bit_cast(unsigned, b); }
__device__ __forceinline__ unsigned short f2bf1(float f) { return (unsigned short)(pk2(f, 0.f) & 0xffffu); }
__device__ __forceinline__ float bf2f(unsigned short v) { return __builtin_bit_cast(float, (unsigned)v << 16); }
__device__ __forceinline__ float bflo(unsigned w) { return __builtin_bit_cast(float, w << 16); }
__device__ __forceinline__ float bfhi(unsigned w) { return __builtin_bit_cast(float, w & 0xffff0000u); }
__device__ __forceinline__ float sigmoidf_(float x) { return 1.0f / (1.0f + expf(-x)); }
__device__ __forceinline__ float shx(float v, int k, int lane) { return __builtin_bit_cast(float, __builtin_amdgcn_ds_bpermute((lane ^ k) << 2, __builtin_bit_cast(int, v))); }
__device__ __forceinline__ float shi(float v, int src) { return __builtin_bit_cast(float, __builtin_amdgcn_ds_bpermute(src << 2, __builtin_bit_cast(int, v))); }
template <int CTRL> __device__ __forceinline__ float dppmov(float v) { return __builtin_bit_cast(float, __builtin_amdgcn_update_dpp(0, __builtin_bit_cast(int, v), CTRL, 0xF, 0xF, true)); }
__device__ __forceinline__ float wave_sum(float v) {
    v += dppmov<0xB1>(v); v += dppmov<0x4E>(v); v += dppmov<0x141>(v); v += dppmov<0x140>(v);
    const int iv = __builtin_bit_cast(int, v);
    return (__builtin_bit_cast(float, __builtin_amdgcn_readlane(iv, 0)) + __builtin_bit_cast(float, __builtin_amdgcn_readlane(iv, 16))) + (__builtin_bit_cast(float, __builtin_amdgcn_readlane(iv, 32)) + __builtin_bit_cast(float, __builtin_amdgcn_readlane(iv, 48)));
}
__device__ __forceinline__ float red8(float v) { v += dppmov<0xB1>(v); v += dppmov<0x4E>(v); v += dppmov<0x141>(v); return v; }

struct TokInfo { int e0, e1, p0, p1; float g0, g1; int pad0, pad1; };

constexpr int WID_OFF = LDSCTL_OFF + 1536;
__device__ __forceinline__ int hw_slot() { return (int)__builtin_amdgcn_s_getreg((5 << 11) | 4) & 63; }
__device__ __forceinline__ int lane_id() { int l; asm volatile("v_mbcnt_lo_u32_b32 %0, -1, 0\n\tv_mbcnt_hi_u32_b32 %0, -1, %0" : "=v"(l)); return l; }
__device__ __forceinline__ void hw_tid_init() { *(volatile LAS int*)(uintptr_t)(WID_OFF + 4 * hw_slot()) = (int)(threadIdx.x >> 6); }
__device__ __forceinline__ int hw_tid() { const int w = *(volatile LAS int*)(uintptr_t)(WID_OFF + 4 * hw_slot()); int t = (__builtin_amdgcn_readfirstlane(w) << 6) | lane_id(); asm volatile("" : "+v"(t)); return t; }
namespace pg8 {
#define PG8_LAS __attribute__((address_space(3)))
typedef unsigned short bf16_t;
typedef short bf16x8 __attribute__((ext_vector_type(8)));
typedef float f32x4 __attribute__((ext_vector_type(4)));
typedef unsigned u32x4 __attribute__((ext_vector_type(4)));
constexpr int BM = 256, BK = 64, HALF = 128, HTB = HALF * BK * 2  , STAGE_BYTES = 8 * HTB, NXCD = 8, WGM = 8;

__host__ __device__ __forceinline__ int lds_byte(int r, int c) { const int st = (r >> 4) * 2 + (c >> 5), rr = r & 15, cc = c & 31, ob = rr * 64 + cc * 2; return st * 1024 + (ob ^ (((ob >> 9) & 1) << 5)); }
__host__ __device__ __forceinline__ void stage_rc(int b, int& R, int& C) { const int st = b / 1024, sb = b % 1024, swz = sb ^ (((sb >> 9) & 1) << 5); R = (st >> 1) * 16 + swz / 64; C = (st & 1) * 32 + (swz % 64) / 2; }
__host__ __device__ __forceinline__ int perm32(int rho) { const int n = rho >> 4, i = rho & 15; return 8 * (i >> 2) + 4 * n + (i & 3); }

struct Unit { int pm, pn, pnb; };
struct Gemm { const bf16_t* A; const bf16_t* Bt; int M, N, K; };

struct StaticOrder {
    int nM, nN, nwg, G, c;
    __host__ __device__ void init(int M, int N, int G_, int c_) { nM = M / BM; nN = N / BM; nwg = nM * nN; G = G_; c = c_; }
    __host__ __device__ bool next(int i, Unit& u) const {
        const long L = (long)i * G + c; if (L >= nwg) return false;
        int wgid = (int)L; { const int q = nwg / NXCD, r = nwg % NXCD, xcd = wgid % NXCD, off = wgid / NXCD; wgid = (xcd < r ? xcd * (q + 1) : r * (q + 1) + (xcd - r) * q) + off; }
        const int nig = WGM * nN, gid = wgid / nig, fm = gid * WGM, gsz = (nM - fm) < WGM ? (nM - fm) : WGM;
        u.pm = fm + ((wgid % nig) % gsz); u.pn = (wgid % nig) / gsz; u.pnb = u.pn; return true;
    }
    __device__ __forceinline__ void a_ready(const Unit&) const {}
    __device__ __forceinline__ void done(const Unit&) const {}
};

__device__ __forceinline__ unsigned cvt_pk_bf16(float lo, float hi) { unsigned r; asm volatile("v_cvt_pk_bf16_f32 %0, %1, %2" : "=v"(r) : "v"(lo), "v"(hi)); return r; }
template <class Epi, class Sched, bool ALIGN_EPI = false, bool SP2 = false>
__device__ __forceinline__ void gemm_phase(PG8_LAS unsigned char* lds, const Gemm g, const Sched& S, const Epi& E) {
    const int tid = hw_tid(), wid = __builtin_amdgcn_readfirstlane(tid >> 6), lane = tid & 63, wr = wid >> 2, wc = wid & 3, fr = lane & 15, fq = lane >> 4;
    const int K = g.K, nt = K / BK;
    unsigned voffA[2], voffB[2];
#pragma unroll
    for (int i = 0; i < 2; ++i) { int R, C; stage_rc(tid * 16 + i * 8192, R, C); const int Rb = Epi::PERM ? ((R & ~31) + perm32(R & 31)) : R;
        voffA[i] = (unsigned)(R * K + C) * 2u; voffB[i] = (unsigned)(Rb * K + C) * 2u; }
    const size_t kstep = (size_t)(BK * 2);
    const size_t hstep = (size_t)HALF * K * 2;
    const size_t tstep = 2 * hstep;
    const unsigned ldsw = (unsigned)wid * 1024u;
    const int aoff = lds_byte(wr * 64 + fr, fq * 8), boff = lds_byte(wc * 32 + fr, fq * 8);
#define PG8_SA(b, h) (((b) * 2 + (h)) * HTB)
#define PG8_SB(b, h) ((4 + (b) * 2 + (h)) * HTB)
#define PG8_STAGE(bufoff, gbase, voff) do { _Pragma("unroll") for (int _i = 0; _i < 2; ++_i) \
        __builtin_amdgcn_global_load_lds((const unsigned*)((const char*)(gbase) + (voff)[_i]), (PG8_LAS unsigned*)(lds + (bufoff) + ldsw + _i * 8192), 16, 0, 0); } while (0)
#define PG8_LDA(dst, b, h) do { _Pragma("unroll") for (int m = 0; m < 4; ++m) _Pragma("unroll") for (int k = 0; k < 2; ++k) dst[m][k] = *(const PG8_LAS bf16x8*)(lds + PG8_SA(b, h) + aoff + m * 2048 + k * 1024); } while (0)
#define PG8_LDB(dst, b, h) do { _Pragma("unroll") for (int n = 0; n < 2; ++n) _Pragma("unroll") for (int k = 0; k < 2; ++k) dst[n][k] = *(const PG8_LAS bf16x8*)(lds + PG8_SB(b, h) + boff + n * 2048 + k * 1024); } while (0)
#define PG8_MMA(ai, bj, At, Bt) do { __builtin_amdgcn_s_setprio(1); _Pragma("unroll") for (int m = 0; m < 4; ++m) _Pragma("unroll") for (int n = 0; n < 2; ++n) _Pragma("unroll") for (int k = 0; k < 2; ++k) \
        acc[ai][bj][m][n] = __builtin_amdgcn_mfma_f32_16x16x32_bf16(Bt[n][k], At[m][k], acc[ai][bj][m][n], 0, 0, 0); __builtin_amdgcn_s_setprio(0); } while (0)
#define PG8_WAIT_V(n) asm volatile("s_waitcnt vmcnt(" #n ")" ::: "memory")
#define PG8_WAIT_L(n) asm volatile("s_waitcnt lgkmcnt(" #n ")" ::: "memory")
#define PG8_BAR __builtin_amdgcn_s_barrier()
#define PG8_SCHED __builtin_amdgcn_sched_barrier(0)
    Unit cur, nxt; int ui = 0;
    if (!S.next(0, cur)) return;
    f32x4 acc[2][2][4][2];
#pragma unroll
    for (int a = 0; a < 2; ++a)
#pragma unroll
        for (int b = 0; b < 2; ++b)
#pragma unroll
            for (int m = 0; m < 4; ++m)
#pragma unroll
                for (int n = 0; n < 2; ++n) acc[a][b][m][n] = (f32x4){0.f, 0.f, 0.f, 0.f};
    bf16x8 At[4][2], B0[2][2], B1[2][2];
    const char* cA = (const char*)g.A + (size_t)cur.pm * tstep; const char* cB = (const char*)g.Bt + (size_t)cur.pnb * tstep;
    S.a_ready(cur);
    if constexpr (SP2) {
        PG8_STAGE(PG8_SB(0, 0), cB, voffB); PG8_STAGE(PG8_SB(0, 1), cB + hstep, voffB); PG8_STAGE(PG8_SA(0, 0), cA, voffA); PG8_STAGE(PG8_SA(0, 1), cA + hstep, voffA);
        if (wr == 1) PG8_BAR;
        PG8_WAIT_V(2); PG8_BAR;
        PG8_STAGE(PG8_SB(1, 0), cB + kstep, voffB); PG8_STAGE(PG8_SA(1, 0), cA + kstep, voffA); PG8_STAGE(PG8_SB(1, 1), cB + hstep + kstep, voffB);
        PG8_WAIT_V(6); PG8_BAR;
    } else {
        PG8_STAGE(PG8_SB(0, 0), cB, voffB); PG8_STAGE(PG8_SA(0, 0), cA, voffA); PG8_STAGE(PG8_SB(0, 1), cB + hstep, voffB); PG8_STAGE(PG8_SA(0, 1), cA + hstep, voffA);
        if (wr == 1) PG8_BAR;
        PG8_WAIT_V(4); PG8_BAR;
        PG8_STAGE(PG8_SB(1, 0), cB + kstep, voffB); PG8_STAGE(PG8_SA(1, 0), cA + kstep, voffA); PG8_STAGE(PG8_SB(1, 1), cB + hstep + kstep, voffB);
        PG8_WAIT_V(6); PG8_BAR;
    }
    for (;;) {
        const bool has_next = S.next(ui + 1, nxt);
        const char* nA = has_next ? (const char*)g.A + (size_t)nxt.pm * tstep : cA; const char* nB = has_next ? (const char*)g.Bt + (size_t)nxt.pnb * tstep : cB;
        for (int t = 0; t < nt; t += 2) {
            const bool last = (t == nt - 2);
            const char* a1 = cA + (size_t)(t + 1) * kstep;
            const char* a2 = last ? nA : cA + (size_t)(t + 2) * kstep; const char* b2 = last ? nB : cB + (size_t)(t + 2) * kstep;
            const char* a3 = a2 + kstep; const char* b3 = b2 + kstep;
            if (last && has_next) S.a_ready(nxt);
            if constexpr (SP2) {
            PG8_LDB(B0, 0, 0); PG8_LDB(B1, 0, 1); PG8_SCHED; PG8_LDA(At, 0, 0); PG8_STAGE(PG8_SA(1, 1), a1 + hstep, voffA);
            PG8_WAIT_V(8); PG8_WAIT_L(0); PG8_BAR; PG8_MMA(0, 0, At, B0); PG8_MMA(0, 1, At, B1); PG8_BAR; PG8_SCHED;
            PG8_LDA(At, 0, 1); PG8_STAGE(PG8_SB(0, 0), b2, voffB); PG8_STAGE(PG8_SB(0, 1), b2 + hstep, voffB); PG8_STAGE(PG8_SA(0, 0), a2, voffA);
            PG8_WAIT_V(8); PG8_WAIT_L(0); PG8_BAR; PG8_MMA(1, 0, At, B0); PG8_MMA(1, 1, At, B1); PG8_BAR; PG8_SCHED;
            PG8_LDB(B0, 1, 0); PG8_LDB(B1, 1, 1); PG8_SCHED; PG8_LDA(At, 1, 0); PG8_STAGE(PG8_SA(0, 1), a2 + hstep, voffA);
            PG8_WAIT_V(8); PG8_WAIT_L(0); PG8_BAR; PG8_MMA(0, 0, At, B0); PG8_MMA(0, 1, At, B1); PG8_BAR; PG8_SCHED;
            PG8_LDA(At, 1, 1); PG8_STAGE(PG8_SB(1, 0), b3, voffB); PG8_STAGE(PG8_SB(1, 1), b3 + hstep, voffB); PG8_STAGE(PG8_SA(1, 0), a3, voffA);
            PG8_WAIT_V(8); PG8_WAIT_L(0); PG8_BAR; PG8_MMA(1, 0, At, B0); PG8_MMA(1, 1, At, B1); PG8_BAR; PG8_SCHED;
            } else {
            PG8_LDB(B0, 0, 0); PG8_SCHED; PG8_LDA(At, 0, 0); PG8_STAGE(PG8_SA(1, 1), a1 + hstep, voffA);
            PG8_WAIT_L(8); PG8_BAR; PG8_WAIT_L(0); PG8_MMA(0, 0, At, B0); PG8_BAR; PG8_SCHED;
            PG8_LDB(B1, 0, 1); PG8_STAGE(PG8_SB(0, 0), b2, voffB);
            PG8_BAR; PG8_WAIT_L(0); PG8_MMA(0, 1, At, B1); PG8_BAR;
            PG8_LDA(At, 0, 1); PG8_STAGE(PG8_SA(0, 0), a2, voffA);
            PG8_BAR; PG8_WAIT_L(0); PG8_MMA(1, 0, At, B0); PG8_BAR; PG8_SCHED;
            PG8_STAGE(PG8_SB(0, 1), b2 + hstep, voffB);
            PG8_WAIT_V(6); PG8_BAR; PG8_MMA(1, 1, At, B1); PG8_BAR;
            PG8_LDB(B0, 1, 0); PG8_SCHED; PG8_LDA(At, 1, 0); PG8_STAGE(PG8_SA(0, 1), a2 + hstep, voffA);
            PG8_WAIT_L(8); PG8_BAR; PG8_WAIT_L(0); PG8_MMA(0, 0, At, B0); PG8_BAR; PG8_SCHED;
            PG8_LDB(B1, 1, 1); PG8_STAGE(PG8_SB(1, 0), b3, voffB);
            PG8_BAR; PG8_WAIT_L(0); PG8_MMA(0, 1, At, B1); PG8_BAR;
            PG8_LDA(At, 1, 1); PG8_STAGE(PG8_SA(1, 0), a3, voffA);
            PG8_BAR; PG8_WAIT_L(0); PG8_MMA(1, 0, At, B0); PG8_BAR; PG8_SCHED;
            PG8_STAGE(PG8_SB(1, 1), b3 + hstep, voffB);
            PG8_WAIT_V(6); PG8_BAR; PG8_MMA(1, 1, At, B1); PG8_BAR;
            }
        }
        if constexpr (ALIGN_EPI) { if (wr == 0) PG8_BAR; }
        if constexpr (!Epi::AFTER_DRAIN) { E(acc, cur, wr, wc, fr, fq); S.done(cur); }
        if (!has_next) break;
#pragma unroll
        for (int a = 0; a < 2; ++a)
#pragma unroll
            for (int b = 0; b < 2; ++b)
#pragma unroll
                for (int m = 0; m < 4; ++m)
#pragma unroll
                    for (int n = 0; n < 2; ++n) acc[a][b][m][n] = (f32x4){0.f, 0.f, 0.f, 0.f};
        cur = nxt; cA = nA; cB = nB; ++ui;
        if constexpr (ALIGN_EPI) { if (wr == 1) PG8_BAR; }
    }
    PG8_WAIT_V(0);
    if constexpr (!ALIGN_EPI) { if (wr == 0) PG8_BAR; }
    PG8_BAR;
    if constexpr (Epi::AFTER_DRAIN) { E.fused(acc, cur, wr, wc, fr, fq, lds, wid, lane); S.done(cur); }
#undef PG8_SA
#undef PG8_SB
#undef PG8_STAGE
#undef PG8_LDA
#undef PG8_LDB
#undef PG8_MMA
#undef PG8_WAIT_V
#undef PG8_WAIT_L
#undef PG8_BAR
#undef PG8_SCHED
}
}
namespace pg8 {
struct EpiBf16 {
    static constexpr bool PERM = true, AFTER_DRAIN = false;
    bf16_t* O; int ldc;
    __device__ __forceinline__ void operator()(const f32x4 (&acc)[2][2][4][2], const Unit& u, int wr, int wc, int fr, int fq) const {
        const int row0 = u.pm * BM + wr * 64 + fr; const int col0 = u.pn * BM + wc * 32 + 8 * fq;
#pragma unroll
        for (int ai = 0; ai < 2; ++ai)
#pragma unroll
            for (int m = 0; m < 4; ++m) { bf16_t* rowp = O + (size_t)(row0 + ai * HALF + m * 16) * ldc + col0;
#pragma unroll
                for (int bj = 0; bj < 2; ++bj) { const f32x4 v0 = acc[ai][bj][m][0], v1 = acc[ai][bj][m][1];
                    u32x4 w; w.x = cvt_pk_bf16(v0[0], v0[1]); w.y = cvt_pk_bf16(v0[2], v0[3]); w.z = cvt_pk_bf16(v1[0], v1[1]); w.w = cvt_pk_bf16(v1[2], v1[3]);
                    *(u32x4*)(rowp + bj * HALF) = w; } }
    }
};
struct EpiSwiGLU {
    static constexpr bool PERM = true, AFTER_DRAIN = false;
    bf16_t* O; int ldc;
    __device__ __forceinline__ void operator()(const f32x4 (&acc)[2][2][4][2], const Unit& u, int wr, int wc, int fr, int fq) const {
        const int row0 = u.pm * BM + wr * 64 + fr; const int col0 = u.pn * HALF + wc * 32 + 8 * fq;
#pragma unroll
        for (int ai = 0; ai < 2; ++ai)
#pragma unroll
            for (int m = 0; m < 4; ++m) { bf16_t* rowp = O + (size_t)(row0 + ai * HALF + m * 16) * ldc + col0;
                float r[8];
#pragma unroll
                for (int n = 0; n < 2; ++n)
#pragma unroll
                    for (int j = 0; j < 4; ++j) { const float a = acc[ai][0][m][n][j], b = acc[ai][1][m][n][j]; r[n * 4 + j] = a * b * __builtin_amdgcn_rcpf(1.0f + __expf(-a)); }
                u32x4 w; w.x = cvt_pk_bf16(r[0], r[1]); w.y = cvt_pk_bf16(r[2], r[3]); w.z = cvt_pk_bf16(r[4], r[5]); w.w = cvt_pk_bf16(r[6], r[7]);
                *(u32x4*)rowp = w; }
    }
};
struct MoeOrder {
    const PG8_LAS int* pref; int nN, G, c, total;
    __device__ __forceinline__ void init(const PG8_LAS int* pref_, int nN_, int G_, int c_) { pref = pref_; nN = nN_; G = G_; c = c_; total = pref_[32] * nN_; }
    __device__ __forceinline__ bool next(int i, Unit& u) const {
        const int L = i * G + c; if (L >= total) return false;
        const int rt = L / nN, pn = L - rt * nN; int e = 0;
#pragma unroll 1
        for (int k = 1; k < 32; ++k) e += (pref[k] <= rt) ? 1 : 0;
        u.pm = rt; u.pn = pn; u.pnb = e * nN + pn; return true;
    }
    __device__ __forceinline__ void a_ready(const Unit&) const {}
    __device__ __forceinline__ void done(const Unit&) const {}
};
}
#define XB_TMO      128
#define XB_XCNT(j)  (256  + 64 * (j))
#define XB_XSUB(j)  (1280 + 64 * (j))
#define XB_XGEN(j)  (2304 + 64 * (j))
#define XB_TOP      3328
#define XB_TOPGEN   3392
#define XCD_BAR_WORDS 3456
#define XB_SPIN_CAP (1u << 22)

__device__ __forceinline__ unsigned xb_ld(unsigned* p)              { return __hip_atomic_load(p, __ATOMIC_RELAXED, __HIP_MEMORY_SCOPE_AGENT); }
__device__ __forceinline__ unsigned xb_add(unsigned* p, unsigned v) { return __hip_atomic_fetch_add(p, v, __ATOMIC_RELAXED, __HIP_MEMORY_SCOPE_AGENT); }
__device__ __forceinline__ unsigned xb_xcc_id() { return (unsigned)__builtin_amdgcn_s_getreg((3 << 11) | 20) & 0xFu; }
#define XB_SPIN(cond, bar) do { unsigned _sp = 0; while (cond) { __builtin_amdgcn_s_sleep(1); \
    if ((++_sp & 255u) == 0u) { if (xb_ld(&(bar)[XB_TMO])) break; if (_sp > XB_SPIN_CAP) { atomicAdd(&(bar)[XB_TMO], 1u); break; } } } } while (0)

struct XcdBarrier {
    unsigned* bar; unsigned x;
    volatile LAS unsigned* st;
};

__device__ __forceinline__ XcdBarrier xcd_barrier_post(unsigned* bar, volatile LAS unsigned* st) {
    XcdBarrier b; b.bar = bar; b.x = xb_xcc_id(); b.st = st;
    if (hw_tid() == 0) (void)xb_add(&bar[XB_XCNT(b.x)], 1u);
    return b;
}
__device__ __forceinline__ void xcd_barrier_complete(unsigned* bar, unsigned x, unsigned& nloc, unsigned& nx) {
    const unsigned G = gridDim.x * gridDim.y * gridDim.z;
    unsigned sum, cnt, mine, sp = 0u;
    for (;;) {
        sum = 0u; cnt = 0u; mine = 0u;
#pragma unroll
        for (unsigned j = 0; j < 16; ++j) { const unsigned c = xb_ld(&bar[XB_XCNT(j)]); sum += c; cnt += (c > 0u) ? 1u : 0u; mine = (j == x) ? c : mine; }
        if (sum == G) break;
        __builtin_amdgcn_s_sleep(1);
        if ((++sp & 255u) == 0u) { if (xb_ld(&bar[XB_TMO])) break; if (sp > XB_SPIN_CAP) { atomicAdd(&bar[XB_TMO], 1u); break; } }
    }
    nloc = mine > 0u ? mine : 1u; nx = cnt > 0u ? cnt : 1u;
}

__device__ __forceinline__ void xcd_barrier(const XcdBarrier& b) {
    asm volatile("s_waitcnt vmcnt(0)" ::: "memory");
    __syncthreads();
    if (hw_tid() == 0) {
        unsigned* bar = b.bar;
        __builtin_amdgcn_s_waitcnt(0);
        unsigned nloc = b.st[0], nx = b.st[1];
        if (nloc == 0u) { xcd_barrier_complete(bar, b.x, nloc, nx); b.st[0] = nloc; b.st[1] = nx; }
        const unsigned old = xb_add(&bar[XB_XSUB(b.x)], 1u);
        const unsigned gen = old / nloc;
        if (old + 1u == (gen + 1u) * nloc) {
            __builtin_amdgcn_fence(__ATOMIC_RELEASE, "agent");
            asm volatile("s_waitcnt vmcnt(0)" ::: "memory");
            const unsigned og = xb_add(&bar[XB_TOP], 1u);
            const unsigned tg = og / nx;
            if (og + 1u == (tg + 1u) * nx) xb_add(&bar[XB_TOPGEN], 1u);
            else XB_SPIN(xb_ld(&bar[XB_TOPGEN]) == tg, bar);
            __builtin_amdgcn_fence(__ATOMIC_ACQUIRE, "agent");
            xb_add(&bar[XB_XGEN(b.x)], 1u);
            asm volatile("s_waitcnt vmcnt(0)" ::: "memory");
        } else {
            XB_SPIN(xb_ld(&bar[XB_XGEN(b.x)]) == gen, bar);
            __builtin_amdgcn_fence(__ATOMIC_ACQUIRE, "agent");
            asm volatile("s_waitcnt vmcnt(0)" ::: "memory");
        }
    }
    __syncthreads();
}
struct Args { const float* in[30]; float* out; unsigned char* ws; int ph_lo, ph_hi; };
#define CAS __attribute__((address_space(4)))
struct KA { const CAS unsigned char* kp;
    __device__ __forceinline__ const float* in(int i) const { return *(const float* const CAS*)(kp + 8 * i); }
    __device__ __forceinline__ float* out() const { return *(float* const CAS*)(kp + 240); }
    __device__ __forceinline__ unsigned char* ws() const { return *(unsigned char* const CAS*)(kp + 248); } };
__device__ __forceinline__ KA ka_get() { const CAS unsigned char* kp = (const CAS unsigned char*)__builtin_amdgcn_kernarg_segment_ptr(); asm volatile("" : "+s"(kp)); return KA{kp}; }
__device__ __forceinline__ int opaque_tid() { return hw_tid(); }
static_assert(sizeof(Args) == 264, "kernarg layout");
enum { I_X = 0, I_C, I_CTX, I_CCTX, I_ADAW, I_ADAB, I_WIN, I_RPB, I_MUP, I_MUN, I_W0, I_W2, I_A0, I_A2, I_G2, I_KK, I_KA, I_RK, I_GNG, I_GNB, I_WOUT, I_LN1G, I_LN1B, I_LN2G, I_LN2B, I_RW, I_RB, I_EW1, I_EW3, I_EW2 };

__device__ __forceinline__ void transpose_item(const float* W, int N, int k0, int n0, bf16* WT, int ldk, int drow0, LAS float* scr, int lane) {
#pragma unroll 8
    for (int i = 0; i < 32; ++i) { const int kk = 2 * i + (lane >> 5); scr[kk * 33 + (lane & 31)] = W[(size_t)(k0 + kk) * N + n0 + (lane & 31)]; }
    LDS_WAIT(); asm volatile("" ::: "memory");
    const int c = lane & 7;
#pragma unroll
    for (int j = 0; j < 4; ++j) { const int n = (lane >> 3) + 8 * j; const LAS float* s = scr + (8 * c) * 33 + n;
        v4u o; o.x = pk2(s[0 * 33], s[1 * 33]); o.y = pk2(s[2 * 33], s[3 * 33]); o.z = pk2(s[4 * 33], s[5 * 33]); o.w = pk2(s[6 * 33], s[7 * 33]);
        *(GAS v4u*)(WT + (size_t)(drow0 + n) * ldk + k0 + 8 * c) = o; }
    LDS_WAIT(); asm volatile("" ::: "memory");
}

__device__ __forceinline__ void phase_prologue(LAS unsigned char* lds) {
    const KA a = ka_get();
    const int tid = opaque_tid(), lane = tid & 63, wave = __builtin_amdgcn_readfirstlane(tid >> 6), G = gridDim.x, bid = blockIdx.x;
    const int gw = bid * 8 + wave, NGW = G * 8;
    bf16* WINT = (bf16*)(a.ws() + WS_WINT); bf16* WOT = (bf16*)(a.ws() + WS_WOT);
    LAS float* scr = (LAS float*)(lds + wave * 16384);
    constexpr int I_IN = 16 * 103, I_OUT = 16 * 32, I_L = I_IN + I_OUT;
    for (int it = gw; it < 2 * I_L; it += NGW) {
        const int l = it / I_L; int r = it - l * I_L;
        if (r < I_IN) { const int kb = r / 103, nb = r - kb * 103; transpose_item(a.in(I_WIN) + (size_t)l * DM * DIN, DIN, 64 * kb, 32 * nb, WINT + (size_t)l * DINP * DM, DM, 32 * nb, scr, lane); }
        else { r -= I_IN; const int kb = r >> 5, nb = r & 31; transpose_item(a.in(I_WOUT) + (size_t)l * DM * DM, DM, 64 * kb, 32 * nb, WOT + (size_t)l * DM * DM, DM, 32 * nb, scr, lane); }
    }
    for (int i = bid * 512 + tid; i < 8192; i += G * 512) { const int l = i >> 12, r = i & 4095; *(GAS v4u*)(WINT + (size_t)l * DINP * DM + (size_t)DIN * DM + (size_t)r * 8) = (v4u){0u, 0u, 0u, 0u}; }
    { float* rp = (float*)(a.ws() + WS_ROPE); const int i = bid * 512 + tid;
      if (i < 1536) { const int idx = i < 512 ? i : i - 512; const int p = idx >> 4, f = idx & 15; const double inv = exp(-(double)f * (9.210340371976184 / 16.0)); const double ang = (double)p * inv;
          const float cs = (float)cos(ang), sn = (float)sin(ang); if (i < 512) { rp[idx] = cs; rp[512 + idx] = sn; } else { rp[1024 + idx] = cs; rp[2048 + idx] = sn; } } }
    __syncthreads();
    LAS float* sl = (LAS float*)lds; LAS float* red = (LAS float*)(lds + 69632);
    for (int i = tid; i < 17 * 1024; i += 512) { const int r = i >> 10, k = i & 1023; const float v = r < 16 ? a.in(I_C)[r * 1024 + k] : a.in(I_CCTX)[k]; sl[i] = v / (1.0f + expf(-v)); }
    __syncthreads();
    float* mods = (float*)(a.ws() + WS_MODS);
    for (int it = bid; it < 192; it += G) {
        const int l = it / 96, ch = it - l * 96; const int kq = tid >> 6, cl = tid & 63, col = ch * 64 + cl;
        const float* W = a.in(I_ADAW) + (size_t)l * DM * 6144 + col;
        float acc[17];
#pragma unroll
        for (int r = 0; r < 17; ++r) acc[r] = 0.f;
        for (int k0 = kq * 128; k0 < kq * 128 + 128; k0 += 8) { float w8[8];
#pragma unroll
            for (int q = 0; q < 8; ++q) w8[q] = W[(size_t)(k0 + q) * 6144];
#pragma unroll
            for (int r = 0; r < 17; ++r) { const f32x4 s0 = *(const LAS f32x4*)(sl + r * 1024 + k0), s1 = *(const LAS f32x4*)(sl + r * 1024 + k0 + 4);
                acc[r] += s0.x * w8[0] + s0.y * w8[1] + s0.z * w8[2] + s0.w * w8[3] + s1.x * w8[4] + s1.y * w8[5] + s1.z * w8[6] + s1.w * w8[7]; } }
#pragma unroll
        for (int r = 0; r < 17; ++r) red[(kq * 17 + r) * 64 + cl] = acc[r];
        __syncthreads();
        for (int i = tid; i < 17 * 64; i += 512) { const int r = i >> 6, c2 = i & 63; float s = 0.f;
#pragma unroll
            for (int q = 0; q < 8; ++q) s += red[(q * 17 + r) * 64 + c2];
            mods[((size_t)l * 17 + r) * 6144 + ch * 64 + c2] = s + a.in(I_ADAB)[l * 6144 + ch * 64 + c2]; }
        __syncthreads();
    }
}

__device__ __forceinline__ void phase_modconv(LAS unsigned char* lds, int l) {
    const KA a = ka_get();
    const int tid = opaque_tid(), lane = tid & 63, wave = __builtin_amdgcn_readfirstlane(tid >> 6), G = gridDim.x, bid = blockIdx.x;
    const int gw = bid * 8 + wave, NGW = G * 8;
    const float* mods = (const float*)(a.ws() + WS_MODS) + (size_t)l * 17 * 6144;
    bf16* XM = (bf16*)(a.ws() + WS_X1);
    const float* xs = l == 0 ? a.in(I_X) : a.out(); const float* cs = l == 0 ? a.in(I_CTX) : (const float*)(a.ws() + WS_CS);
    for (int m = gw; m < NTOK; m += NGW) {
        const float* src; int mr;
        if (m < NTX) { src = xs + (size_t)m * DM; mr = m / SEQ; } else { src = cs + (size_t)(m - NTX) * DM; mr = 16; }
        const GAS f32x4* xr = (const GAS f32x4*)src + lane; const GAS f32x4* sh = (const GAS f32x4*)(mods + (size_t)mr * 6144) + lane; const GAS f32x4* sc = sh + 256;
        GAS v2u* o8 = (GAS v2u*)(XM + (size_t)m * DM) + lane;
#pragma unroll
        for (int j = 0; j < 4; ++j) { const f32x4 v = xr[64 * j], s = sh[64 * j], c = sc[64 * j]; const f32x4 r = v * (c + 1.0f) + s; v2u w; w.x = pk2(r.x, r.y); w.y = pk2(r.z, r.w); o8[64 * j] = w; }
    }
}

__device__ __forceinline__ void phase_scan_direct(LAS unsigned char* lds, int l) {
    const KA a = ka_get();
    constexpr int TB = 32;
    const int tid = opaque_tid(), lane = tid & 63, wv = __builtin_amdgcn_readfirstlane(tid >> 6);
    LAS float* ops = (LAS float*)lds;
    LAS float* scal = (LAS float*)(lds + 49152);
    LAS float* zl = (LAS float*)(lds + 49664);
    LAS float* rkraw = (LAS float*)(lds + 57856);
    LAS float* ybuf = (LAS float*)(lds + 74240);
    const bf16* PX = (const bf16*)(a.ws() + WS_X2); float* YD = (float*)(a.ws() + WS_X3); float* BON = (float*)(a.ws() + WS_BONUS); const float* rope = (const float*)(a.ws() + WS_ROPE);
    const float* mup = a.in(I_MUP) + l * 1760; const float* mun = a.in(I_MUN) + l * 1760;
    for (int chain = blockIdx.x; chain < 256; chain += gridDim.x) {
        const int b = chain >> 4, h = (chain >> 1) & 7, d = chain & 1, c = lane;
        float w2c[32], a2c[32];
#pragma unroll
        for (int j = 0; j < 32; ++j) { w2c[j] = a.in(I_W2)[((size_t)(l * 2 + d) * 32 + j) * 512 + h * 64 + c]; a2c[j] = a.in(I_A2)[((size_t)(l * 2 + d) * 32 + j) * 512 + h * 64 + c]; }
        const float w0c = a.in(I_W0)[(l * 2 + d) * 512 + h * 64 + c], a0c = a.in(I_A0)[(l * 2 + d) * 512 + h * 64 + c];
        const float kkc = a.in(I_KK)[l * 512 + h * 64 + c], kac = a.in(I_KA)[l * 512 + h * 64 + c], rkc = a.in(I_RK)[l * 512 + h * 64 + c];
        const int colr = h * 64 + c, colk = 512 + colr, colv = 1024 + colr, coll = (c < 32) ? (1536 + d * 32 + c) : (1600 + d * 32 + (c - 32));
        const float mpr = mup[colr], mnr = mun[colr], mpk = mup[colk], mnk = mun[colk], mpv = mup[colv], mnv = mun[colv], mpl = mup[coll], mnl = mun[coll];
        float S[8];
#pragma unroll
        for (int j = 0; j < 8; ++j) S[j] = 0.f;
        const int vl = lane >> 3, kq = lane & 7, vrow = 8 * wv + vl;
        for (int seq = 0; seq < 2; ++seq) {
            const int T = seq ? SEQ : CTXL, rowbase = seq ? b * SEQ : NTX + b * CTXL, nblk = T / TB;
            for (int bi = 0; bi < nblk; ++bi) {
                const int tb = d ? (nblk - 1 - bi) : bi, t0 = tb * TB;
                float zv[4];
#pragma unroll
                for (int i = 0; i < 4; ++i) {
                    const int tl = wv + 8 * i, t = t0 + tl; const bf16* p = PX + (size_t)(rowbase + t) * DINP + RWOFF;
                    const bool hp = t > 0, hn = t + 1 < T;
                    const float cr = bf2f(p[colr]), ck = bf2f(p[colk]), cv = bf2f(p[colv]), cl_ = bf2f(p[coll]);
                    const float pr = hp ? bf2f(p[colr - DINP]) : 0.f, pk = hp ? bf2f(p[colk - DINP]) : 0.f, pv = hp ? bf2f(p[colv - DINP]) : 0.f, pl = hp ? bf2f(p[coll - DINP]) : 0.f;
                    const float nr = hn ? bf2f(p[colr + DINP]) : 0.f, nk = hn ? bf2f(p[colk + DINP]) : 0.f, nv = hn ? bf2f(p[colv + DINP]) : 0.f, nl = hn ? bf2f(p[coll + DINP]) : 0.f;
                    const float zr = cr + mpr * (pr - cr) + mnr * (nr - cr), zk = ck + mpk * (pk - ck) + mnk * (nk - ck);
                    zv[i] = cv + mpv * (pv - cv) + mnv * (nv - cv);
                    const float zz = cl_ + mpl * (pl - cl_) + mnl * (nl - cl_);
                    rkraw[tl * 128 + c] = zr; rkraw[tl * 128 + 64 + c] = zk; zl[tl * 64 + c] = (c < 32) ? tanhf(zz) : zz;
                }
                __syncthreads();
#pragma unroll
                for (int i = 0; i < 4; ++i) {
                    const int tl = wv + 8 * i, t = t0 + tl;
                    float r = rkraw[tl * 128 + c], k = rkraw[tl * 128 + 64 + c];
                    if (seq) { const float rp = rkraw[tl * 128 + (c ^ 16)], kp = rkraw[tl * 128 + 64 + (c ^ 16)]; const int qd = c >> 4, f = c & 15;
                        const int ti = (qd < 2) ? ((t >> 6) * 16 + f) : (1024 + (t & 63) * 16 + f); const float cs = rope[ti], sn = rope[ti + ((qd < 2) ? 512 : 1024)];
                        const float sg = (qd & 1) ? sn : -sn; r = r * cs + rp * sg; k = k * cs + kp * sg; }
                    const float kkr = k * kkc; const float ss = wave_sum(kkr * kkr); const float kk = kkr / fmaxf(sqrtf(ss), 1e-12f);
                    float u = w0c, av = a0c;
#pragma unroll
                    for (int j = 0; j < 32; j += 4) { const f32x4 z1 = *(const LAS f32x4*)(zl + tl * 64 + j), z2 = *(const LAS f32x4*)(zl + tl * 64 + 32 + j);
                        u += z1.x * w2c[j] + z1.y * w2c[j + 1] + z1.z * w2c[j + 2] + z1.w * w2c[j + 3]; av += z2.x * a2c[j] + z2.y * a2c[j + 1] + z2.z * a2c[j + 2] + z2.w * a2c[j + 3]; }
                    const float w = expf(-0.6065306597126334f * sigmoidf_(u)), aa = sigmoidf_(av);
                    const float kd = k * (1.0f + (aa - 1.0f) * kac), nb = -kk * aa;
                    const float c1 = wave_sum(nb * r), c2 = wave_sum(kd * r), bon = wave_sum(r * kd * rkc);
                    LAS float* o = ops + tl * 384 + c; o[0] = kk; o[64] = w * r; o[128] = w; o[192] = nb; o[256] = kd; o[320] = zv[i];
                    if (lane == 0) { scal[tl * 4] = c1; scal[tl * 4 + 1] = c2; BON[((size_t)d * NTOK + rowbase + t) * 8 + h] = bon; }
                }
                __syncthreads();
#pragma unroll 2
                for (int s = 0; s < TB; ++s) {
                    const int tl = d ? (TB - 1 - s) : s; const LAS float* o = ops + tl * 384 + kq * 8;
                    const f32x4 ka = *(const LAS f32x4*)(o), kb = *(const LAS f32x4*)(o + 4), ra = *(const LAS f32x4*)(o + 64), rb = *(const LAS f32x4*)(o + 68);
                    const f32x4 wa = *(const LAS f32x4*)(o + 128), wb = *(const LAS f32x4*)(o + 132), na = *(const LAS f32x4*)(o + 192), nb_ = *(const LAS f32x4*)(o + 196);
                    const f32x4 da = *(const LAS f32x4*)(o + 256), db = *(const LAS f32x4*)(o + 260);
                    const float vv = ops[tl * 384 + 320 + vrow], c1 = scal[tl * 4], c2 = scal[tl * 4 + 1];
                    float sk = S[0] * ka.x + S[1] * ka.y + S[2] * ka.z + S[3] * ka.w + S[4] * kb.x + S[5] * kb.y + S[6] * kb.z + S[7] * kb.w;
                    float yy = S[0] * ra.x + S[1] * ra.y + S[2] * ra.z + S[3] * ra.w + S[4] * rb.x + S[5] * rb.y + S[6] * rb.z + S[7] * rb.w;
                    sk = red8(sk); yy = red8(yy);
                    const float y = yy + sk * c1 + vv * c2;
                    S[0] = S[0] * wa.x + sk * na.x + vv * da.x; S[1] = S[1] * wa.y + sk * na.y + vv * da.y; S[2] = S[2] * wa.z + sk * na.z + vv * da.z; S[3] = S[3] * wa.w + sk * na.w + vv * da.w;
                    S[4] = S[4] * wb.x + sk * nb_.x + vv * db.x; S[5] = S[5] * wb.y + sk * nb_.y + vv * db.y; S[6] = S[6] * wb.z + sk * nb_.z + vv * db.z; S[7] = S[7] * wb.w + sk * nb_.w + vv * db.w;
                    if (kq == 0) ybuf[tl * 64 + vrow] = y;
                }
                __syncthreads();
#pragma unroll
                for (int i = 0; i < 4; ++i) { const int tl = wv + 8 * i; YD[((size_t)d * NTOK + rowbase + t0 + tl) * 512 + h * 64 + c] = ybuf[tl * 64 + c]; }
            }
        }
        __syncthreads();
    }
}

typedef short v4i16_t __attribute__((ext_vector_type(4)));
__device__ __forceinline__ int swz_off(int row, int chunk) { return row * 128 + ((chunk ^ (row & 7)) << 4); }
__device__ __forceinline__ void stage_rows(LAS unsigned char* dst, const bf16* src, int nrows, int tid) {
    for (int idx = tid; idx < nrows * 8; idx += 512) { const int r = idx >> 3, ch = idx & 7; const v4u v = *(const GAS v4u*)(src + (size_t)r * DINP + ch * 8); *(LAS v4u*)(dst + swz_off(r, ch)) = v; }
}
__device__ __forceinline__ bf16x8 q_scale8(bf16x8 q) { const v4u w = __builtin_bit_cast(v4u, q); v4u r;
    r.x = pk2(bflo(w.x) * 0.125f, bfhi(w.x) * 0.125f); r.y = pk2(bflo(w.y) * 0.125f, bfhi(w.y) * 0.125f); r.z = pk2(bflo(w.z) * 0.125f, bfhi(w.z) * 0.125f); r.w = pk2(bflo(w.w) * 0.125f, bfhi(w.w) * 0.125f);
    return __builtin_bit_cast(bf16x8, r); }
struct AttState { float m, l; f32x4 o[4]; };
struct AttOff { int k[2]; int v[4]; int boff; unsigned okm; };
__device__ __forceinline__ AttOff att_offsets(int lane, int wc0, int qc, int cs) { AttOff o; const int kl = lane & 15, g = lane >> 4, q_ = kl >> 2, p_ = kl & 3;
#pragma unroll
    for (int dh = 0; dh < 2; ++dh) o.k[dh] = swz_off(kl, dh * 4 + g);
#pragma unroll
    for (int dt = 0; dt < 4; ++dt) o.v[dt] = swz_off(4 * g + q_, 2 * dt + (p_ >> 1)) + (p_ & 1) * 8;
    o.boff = (wc0 + 4 * g - qc + 15) * 4; o.okm = 0u;
#pragma unroll
    for (int j = 0; j < 8; ++j) { const int kc = wc0 + (j >> 2) * 16 + 4 * g + (j & 3); if ((kc >= cs) && (kc < cs + 16)) o.okm |= 1u << j; }
    return o; }
template <bool LOCAL>
__device__ __forceinline__ void att_kstep(AttState& st, const LAS unsigned char* kb, const LAS unsigned char* vb, int r0, const bf16x8 (&qf)[2], int lane, const AttOff& ao, const LAS float* rpbrow) {
    const LAS unsigned char* kr = kb + r0 * 128; const LAS unsigned char* vr = vb + r0 * 128;
    f32x4 s0 = {0.f, 0.f, 0.f, 0.f}, s1 = {0.f, 0.f, 0.f, 0.f};
#pragma unroll
    for (int dh = 0; dh < 2; ++dh) {
        const bf16x8 k0 = *(const LAS bf16x8*)(kr + ao.k[dh]); const bf16x8 k1 = *(const LAS bf16x8*)(kr + ao.k[dh] + 2048);
        s0 = __builtin_amdgcn_mfma_f32_16x16x32_bf16(k0, qf[dh], s0, 0, 0, 0); s1 = __builtin_amdgcn_mfma_f32_16x16x32_bf16(k1, qf[dh], s1, 0, 0, 0);
    }
    float sc[8];
#pragma unroll
    for (int j = 0; j < 4; ++j) { sc[j] = s0[j]; sc[4 + j] = s1[j]; }
    if (LOCAL) {
        float bv[8]; const unsigned ad = (unsigned)(uintptr_t)rpbrow + (unsigned)ao.boff;
#pragma unroll
        for (int j = 0; j < 8; ++j) asm volatile("ds_read_b32 %0, %1 offset:%2" : "=v"(bv[j]) : "v"(ad), "i"(((j >> 2) * 16 + (j & 3)) * 4));
        asm volatile("s_waitcnt lgkmcnt(0)" : "+v"(bv[0]), "+v"(bv[1]), "+v"(bv[2]), "+v"(bv[3]), "+v"(bv[4]), "+v"(bv[5]), "+v"(bv[6]), "+v"(bv[7]) :: "memory");
#pragma unroll
        for (int j = 0; j < 8; ++j) sc[j] = ((ao.okm >> j) & 1u) ? sc[j] + bv[j] : -INFINITY;
    }
    float mt = fmaxf(fmaxf(fmaxf(sc[0], sc[1]), fmaxf(sc[2], sc[3])), fmaxf(fmaxf(sc[4], sc[5]), fmaxf(sc[6], sc[7])));
    mt = fmaxf(mt, shx(mt, 16, lane)); mt = fmaxf(mt, shx(mt, 32, lane));
    if (__any(mt > st.m)) {
        const float mn = fmaxf(st.m, mt); const float scale = (mn == -INFINITY) ? 1.0f : __expf(st.m - mn); st.l *= scale; st.m = mn;
#pragma unroll
        for (int dt = 0; dt < 4; ++dt) st.o[dt] = st.o[dt] * scale; }
    float p[8], ps = 0.f; const float mref = (st.m == -INFINITY) ? 0.f : st.m;
#pragma unroll
    for (int j = 0; j < 8; ++j) { p[j] = __expf(sc[j] - mref); ps += p[j]; }
    st.l += ps;
    v4u pw; pw.x = pk2(p[0], p[1]); pw.y = pk2(p[2], p[3]); pw.z = pk2(p[4], p[5]); pw.w = pk2(p[6], p[7]);
    const bf16x8 pf = __builtin_bit_cast(bf16x8, pw);
#pragma unroll
    for (int dt = 0; dt < 4; ++dt) {
        const v4i16_t lo = __builtin_amdgcn_ds_read_tr16_b64_v4i16((LAS v4i16_t*)(vr + ao.v[dt]));
        const v4i16_t hi = __builtin_amdgcn_ds_read_tr16_b64_v4i16((LAS v4i16_t*)(vr + ao.v[dt] + 2048));
        const bf16x8 vf = (bf16x8){lo[0], lo[1], lo[2], lo[3], hi[0], hi[1], hi[2], hi[3]};
        st.o[dt] = __builtin_amdgcn_mfma_f32_16x16x32_bf16(vf, pf, st.o[dt], 0, 0, 0);
    }
}
__device__ __forceinline__ void att_merge_store(AttState& st, LAS float* mrg, int qb, int kh, int lane, bf16* orow0  ) {
    LAS float* mine = mrg + qb * (18 * 64) + lane;
    if (kh == 1) { mine[0] = st.m; mine[64] = st.l;
#pragma unroll
        for (int dt = 0; dt < 4; ++dt)
#pragma unroll
            for (int j = 0; j < 4; ++j) mine[(2 + dt * 4 + j) * 64] = st.o[dt][j]; }
    __syncthreads();
    if (kh == 0) {
        const float m1 = mine[0], l1 = mine[64]; const float ms = fmaxf(st.m, m1); const float f0 = __expf(st.m - ms), f1 = __expf(m1 - ms);
        float lc = st.l * f0 + l1 * f1; lc += shx(lc, 16, lane); lc += shx(lc, 32, lane); const float inv = 1.0f / lc;
        const int q = lane & 15, g = lane >> 4;
#pragma unroll
        for (int dt = 0; dt < 4; ++dt) { float r[4];
#pragma unroll
            for (int j = 0; j < 4; ++j) r[j] = (st.o[dt][j] * f0 + mine[(2 + dt * 4 + j) * 64] * f1) * inv;
            v2u w; w.x = pk2(r[0], r[1]); w.y = pk2(r[2], r[3]); *(GAS v2u*)(orow0 + (size_t)q * DM + dt * 16 + 4 * g) = w; }
    }
}
__device__ __forceinline__ void phase_attn(LAS unsigned char* lds, int l) {
    const KA a = ka_get();
    const int tid = opaque_tid(), lane = tid & 63, wv = __builtin_amdgcn_readfirstlane(tid >> 6), qb = wv & 3, kh = wv >> 2;
    LAS unsigned char* KC = lds; LAS unsigned char* VC = lds + 32768; LAS unsigned char* KL = lds + 65536; LAS unsigned char* VL = lds + 98304;
    LAS float* RPB = (LAS float*)(lds + LDSCTL_OFF + 2048); LAS float* mrg = (LAS float*)KL;
    const bf16* PX = (const bf16*)(a.ws() + WS_X2); bf16* CAT = (bf16*)(a.ws() + WS_X1);
    for (int blk = blockIdx.x; blk < 256; blk += gridDim.x) {
        const int bh = blk >> 1, b = bh >> 3, h = bh & 7, half = blk & 1;
        __syncthreads();
        const bf16* ctxrow = PX + (size_t)(NTX + b * CTXL) * DINP + h * 64;
        stage_rows(KC, ctxrow + 512, 256, tid); stage_rows(VC, ctxrow + 1024, 256, tid);
        for (int i = tid; i < 465; i += 512) RPB[i] = a.in(I_RPB)[((size_t)l * 8 + h) * 465 + i];
        __syncthreads();
        const int kl = lane & 15, g = lane >> 4;
        const AttOff ao = att_offsets(lane, min(max(qb * 16 - 8, 0), 32), qb * 16 + kl, min(max(qb * 16 + kl - 8, 0), 48));
        if (l == 0) {
            for (int rr = 0; rr < 2; ++rr) {
                const int q0 = (half * 8 + rr * 4 + qb) * 16; const bf16* qrow = ctxrow + (size_t)(q0 + kl) * DINP;
                bf16x8 qf[2]; qf[0] = q_scale8(*(const GAS bf16x8*)(qrow + 8 * g)); qf[1] = q_scale8(*(const GAS bf16x8*)(qrow + 32 + 8 * g));
                AttState st; st.m = -INFINITY; st.l = 0.f;
#pragma unroll
                for (int dt = 0; dt < 4; ++dt) st.o[dt] = (f32x4){0.f, 0.f, 0.f, 0.f};
                for (int s = 0; s < 4; ++s) att_kstep<false>(st, KC, VC, kh * 128 + s * 32, qf, lane, ao, RPB);
                att_merge_store(st, mrg, qb, kh, lane, CAT + (size_t)(NTX + b * CTXL + q0) * DM + h * 64);
                __syncthreads();
            }
        }
        v4u pfk0[4], pfv0[4], pfk1[4], pfv1[4];
#define ATT_ISSUE(SIDX, pfk, pfv) do { const int i_ = half * 16 + ((SIDX) >> 1); const int rs_ = min(max(i_ - 4, 0), 24); const bf16* lr_ = PX + (size_t)(b * SEQ + (rs_ + 4 * ((SIDX) & 1)) * 64) * DINP + h * 64; \
            _Pragma("unroll") for (int q__ = 0; q__ < 4; ++q__) { const int idx_ = tid + 512 * q__; const bf16* p_ = lr_ + (size_t)(idx_ >> 3) * DINP + (idx_ & 7) * 8; pfk[q__] = *(const GAS v4u*)(p_ + 512); pfv[q__] = *(const GAS v4u*)(p_ + 1024); } } while (0)
        ATT_ISSUE(0, pfk0, pfv0); ATT_ISSUE(1, pfk1, pfv1);
        bf16x8 qn[2]; { const bf16* qrow = PX + (size_t)(b * SEQ + (half * 16) * 64 + qb * 16 + kl) * DINP + h * 64; qn[0] = *(const GAS bf16x8*)(qrow + 8 * g); qn[1] = *(const GAS bf16x8*)(qrow + 32 + 8 * g); }
        for (int ui = 0; ui < 16; ++ui) {
            const int i = half * 16 + ui; const int rs = min(max(i - 4, 0), 24);
            const int qc = qb * 16 + kl, cs = min(max(qc - 8, 0), 48), wc0 = min(max(qb * 16 - 8, 0), 32);
            bf16x8 qf[2]; qf[0] = q_scale8(qn[0]); qf[1] = q_scale8(qn[1]);
            { const int in_ = half * 16 + (ui < 15 ? ui + 1 : ui); const bf16* qrow = PX + (size_t)(b * SEQ + in_ * 64 + qc) * DINP + h * 64; qn[0] = *(const GAS bf16x8*)(qrow + 8 * g); qn[1] = *(const GAS bf16x8*)(qrow + 32 + 8 * g); }
            AttState st; st.m = -INFINITY; st.l = 0.f;
#pragma unroll
            for (int dt = 0; dt < 4; ++dt) st.o[dt] = (f32x4){0.f, 0.f, 0.f, 0.f};
            for (int s = 0; s < 4; ++s) att_kstep<false>(st, KC, VC, kh * 128 + s * 32, qf, lane, ao, RPB);
#define ATT_PASS(pass, pfk, pfv) do { \
                __syncthreads(); \
                _Pragma("unroll") for (int q__ = 0; q__ < 4; ++q__) { const int idx_ = tid + 512 * q__; const int o_ = swz_off(idx_ >> 3, idx_ & 7); *(LAS v4u*)(KL + o_) = pfk[q__]; *(LAS v4u*)(VL + o_) = pfv[q__]; } \
                __syncthreads(); \
                if (ui + 1 < 16) ATT_ISSUE(2 * (ui + 1) + (pass), pfk, pfv); \
                for (int k2 = 0; k2 < 2; ++k2) { const int kr = 2 * kh + k2, arow = rs + 4 * (pass) + kr; \
                    att_kstep<true>(st, KL, VL, kr * 64 + wc0, qf, lane, ao, RPB + (arow - i + 7) * 31); } } while (0)
            ATT_PASS(0, pfk0, pfv0);
            ATT_PASS(1, pfk1, pfv1);
#undef ATT_PASS
            __syncthreads();
            att_merge_store(st, mrg, qb, kh, lane, CAT + (size_t)(b * SEQ + i * 64 + qb * 16) * DM + h * 64);
        }
    }
}

__device__ __forceinline__ void phase_rwpost(LAS unsigned char* lds, int l) {
    const KA a = ka_get();
    const int tid = opaque_tid(), lane = tid & 63, hh = __builtin_amdgcn_readfirstlane(tid >> 6), kl = lane & 15, g = lane >> 4;
    const int er = tid >> 5, cq = tid & 31, c0 = cq * 16, hq = cq >> 2;
    LAS bf16* sig = (LAS bf16*)lds;
    LAS float* Gl = (LAS float*)(lds + 4096);
    const bf16* PX = (const bf16*)(a.ws() + WS_X2); const float* YD = (const float*)(a.ws() + WS_X3); const float* BON = (const float*)(a.ws() + WS_BONUS); bf16* CAT = (bf16*)(a.ws() + WS_X1);
    const float* mup = a.in(I_MUP) + l * 1760; const float* mun = a.in(I_MUN) + l * 1760; const float* g2 = a.in(I_G2) + (size_t)l * 96 * 512;
    const float* gngp = a.in(I_GNG) + l * 512 + c0; const float* gnbp = a.in(I_GNB) + l * 512 + c0;
    bf16x8 gb[3][4];
#pragma unroll
    for (int ks = 0; ks < 3; ++ks)
#pragma unroll
        for (int nt = 0; nt < 4; ++nt) { v4u w; unsigned t[8];
#pragma unroll
            for (int j = 0; j < 8; ++j) t[j] = f2bf(g2[(size_t)(32 * ks + 8 * g + j) * 512 + 64 * hh + 16 * nt + kl]);
            w.x = t[0] | (t[1] << 16); w.y = t[2] | (t[3] << 16); w.z = t[4] | (t[5] << 16); w.w = t[6] | (t[7] << 16); gb[ks][nt] = __builtin_bit_cast(bf16x8, w); }
    const int nch = (l == 0 ? NTOK : NTX) / 16;
    for (int ch = blockIdx.x; ch < nch; ch += gridDim.x) {
        const int row0 = ch * 16;
        __syncthreads();
        for (int idx = tid; idx < 1536; idx += 512) { const int r = idx / 96, j = idx - r * 96, row = row0 + r; int t, T; if (row < NTX) { t = row & (SEQ - 1); T = SEQ; } else { t = (row - NTX) & (CTXL - 1); T = CTXL; }
            const bf16* p = PX + (size_t)row * DINP + RWOFF + 1664 + j; const int op = t > 0 ? -DINP : 0, on = t + 1 < T ? DINP : 0;
            const float cv = bf2f(p[0]), pv = bf2f(p[op]) * (t > 0 ? 1.f : 0.f), nv = bf2f(p[on]) * (t + 1 < T ? 1.f : 0.f);
            const float z = cv + mup[1664 + j] * (pv - cv) + mun[1664 + j] * (nv - cv); sig[r * 96 + j] = f2bf1(sigmoidf_(z)); }
        const int row = row0 + er; int t, T; if (row < NTX) { t = row & (SEQ - 1); T = SEQ; } else { t = (row - NTX) & (CTXL - 1); T = CTXL; }
        const bf16* pvp = PX + (size_t)row * DINP + RWOFF + 1024 + c0; const int op = t > 0 ? -DINP : 0, on = t + 1 < T ? DINP : 0; const float fp = t > 0 ? 1.f : 0.f, fn = t + 1 < T ? 1.f : 0.f;
        v4u vc[2], vp[2], vn[2]; f32x4 y0[4], y1[4];
#pragma unroll
        for (int i = 0; i < 2; ++i) { vc[i] = *(const GAS v4u*)(pvp + 8 * i); vp[i] = *(const GAS v4u*)(pvp + op + 8 * i); vn[i] = *(const GAS v4u*)(pvp + on + 8 * i); }
#pragma unroll
        for (int i = 0; i < 4; ++i) { y0[i] = *(const GAS f32x4*)(YD + (size_t)row * 512 + c0 + 4 * i); y1[i] = *(const GAS f32x4*)(YD + ((size_t)NTOK + row) * 512 + c0 + 4 * i); }
        const float bon = BON[(size_t)row * 8 + hq] + BON[((size_t)NTOK + row) * 8 + hq];
        __syncthreads();
        { f32x4 acc[4];
#pragma unroll
          for (int nt = 0; nt < 4; ++nt) acc[nt] = (f32x4){0.f, 0.f, 0.f, 0.f};
#pragma unroll
          for (int ks = 0; ks < 3; ++ks) { const bf16x8 af = *(const LAS bf16x8*)(sig + kl * 96 + 32 * ks + 8 * g);
#pragma unroll
              for (int nt = 0; nt < 4; ++nt) acc[nt] = __builtin_amdgcn_mfma_f32_16x16x32_bf16(af, gb[ks][nt], acc[nt], 0, 0, 0); }
#pragma unroll
          for (int nt = 0; nt < 4; ++nt)
#pragma unroll
              for (int j = 0; j < 4; ++j) Gl[(4 * g + j) * 512 + 64 * hh + 16 * nt + kl] = acc[nt][j]; }
        __syncthreads();
        f32x4 y[4]; float s = 0.f;
#pragma unroll
        for (int i = 0; i < 4; ++i) { y[i] = y0[i] + y1[i]; s += (y[i].x + y[i].y) + (y[i].z + y[i].w); }
        s += dppmov<0xB1>(s); s += dppmov<0x4E>(s); const float mean = s * (1.0f / 64.0f); float q = 0.f;
#pragma unroll
        for (int i = 0; i < 4; ++i) { y[i] = y[i] - mean; q += (y[i].x * y[i].x + y[i].y * y[i].y) + (y[i].z * y[i].z + y[i].w * y[i].w); }
        q += dppmov<0xB1>(q); q += dppmov<0x4E>(q); const float rstd = 1.0f / sqrtf(q * (1.0f / 64.0f) + GN_EPS);
        unsigned ow[8]; f32x4 mpvv[4], mnvv[4], gngv[4], gnbv[4];
#pragma unroll
        for (int i = 0; i < 4; ++i) { mpvv[i] = *(const GAS f32x4*)(mup + 1024 + c0 + 4 * i); mnvv[i] = *(const GAS f32x4*)(mun + 1024 + c0 + 4 * i); gngv[i] = *(const GAS f32x4*)(gngp + 4 * i); gnbv[i] = *(const GAS f32x4*)(gnbp + 4 * i); }
#pragma unroll
        for (int i = 0; i < 4; ++i) { const unsigned cw0 = vc[i >> 1][(i & 1) * 2], cw1 = vc[i >> 1][(i & 1) * 2 + 1], pw0 = vp[i >> 1][(i & 1) * 2], pw1 = vp[i >> 1][(i & 1) * 2 + 1], nw0 = vn[i >> 1][(i & 1) * 2], nw1 = vn[i >> 1][(i & 1) * 2 + 1];
            const f32x4 cv = {bflo(cw0), bfhi(cw0), bflo(cw1), bfhi(cw1)}, pv = {bflo(pw0) * fp, bfhi(pw0) * fp, bflo(pw1) * fp, bfhi(pw1) * fp}, nv = {bflo(nw0) * fn, bfhi(nw0) * fn, bflo(nw1) * fn, bfhi(nw1) * fn};
            const f32x4 mpv = mpvv[i], mnv = mnvv[i], gng = gngv[i], gnb = gnbv[i];
            const f32x4 zv = cv + mpv * (pv - cv) + mnv * (nv - cv);
            const f32x4 gt = *(const LAS f32x4*)(Gl + er * 512 + c0 + 4 * i);
            const f32x4 o = (y[i] * rstd * gng + gnb + zv * bon) * gt;
            ow[2 * i] = pk2(o.x, o.y); ow[2 * i + 1] = pk2(o.z, o.w); }
        GAS v4u* dst = (GAS v4u*)(CAT + (size_t)row * DM + 512 + c0); dst[0] = (v4u){ow[0], ow[1], ow[2], ow[3]}; dst[1] = (v4u){ow[4], ow[5], ow[6], ow[7]};
    }
}

__device__ __forceinline__ void phase_ln1_route(LAS unsigned char* lds, int l) {
    const KA a = ka_get();
    const int tid = opaque_tid(), lane = tid & 63, wave = __builtin_amdgcn_readfirstlane(tid >> 6), G = gridDim.x, bid = blockIdx.x;
    const int gw = bid * 8 + wave, NGW = G * 8;
    LAS float* rwt = (LAS float*)lds;
#pragma unroll
    for (int i = tid; i < 8192; i += 512) { const int k = i >> 3, eg = i & 7; const f32x4 w4 = *(const GAS f32x4*)(a.in(I_RW) + k * 32 + 4 * eg);
        rwt[(4 * eg) * 1024 + k] = w4.x; rwt[(4 * eg + 1) * 1024 + k] = w4.y; rwt[(4 * eg + 2) * 1024 + k] = w4.z; rwt[(4 * eg + 3) * 1024 + k] = w4.w; }
    if (tid < 32) ((LAS int*)(lds + LDSCTL_OFF + 1024))[tid] = 0;
    __syncthreads();
    const float* mods = (const float*)(a.ws() + WS_MODS) + (size_t)l * 17 * 6144;
    const bf16* O = (const bf16*)(a.ws() + WS_X3); bf16* HM = (bf16*)(a.ws() + WS_X1);
    const float* xs = l == 0 ? a.in(I_X) : a.out(); const float* cs = l == 0 ? a.in(I_CTX) : (const float*)(a.ws() + WS_CS);
    float* xo = a.out(); float* co = (float*)(a.ws() + WS_CS);
    int* HIST = (int*)(a.ws() + WS_LIST); TokInfo* TOK = (TokInfo*)(a.ws() + WS_TOK); LAS int* lcnt = (LAS int*)(lds + LDSCTL_OFF + 1024);
    const GAS f32x4* lg = (const GAS f32x4*)(a.in(I_LN1G) + l * DM) + lane; const GAS f32x4* lb = (const GAS f32x4*)(a.in(I_LN1B) + l * DM) + lane;
    const int Mrows = l == 0 ? NTOK : NTX;
    const float biasv = a.in(I_RB)[(lane >> 1) & 31];
    f32x4 lgv[4], lbv[4];
#pragma unroll
    for (int j = 0; j < 4; ++j) { lgv[j] = lg[64 * j]; lbv[j] = lb[64 * j]; }
    f32x4 nx[4]; v2u no[4];
#define LN1_FETCH(M) do { const int m_ = (M) < Mrows ? (M) : gw; const float* s_ = m_ < NTX ? xs + (size_t)m_ * DM : cs + (size_t)(m_ - NTX) * DM; \
        const GAS f32x4* xr_ = (const GAS f32x4*)s_ + lane; const GAS v2u* or_ = (const GAS v2u*)(O + (size_t)m_ * DM) + lane; \
        _Pragma("unroll") for (int j_ = 0; j_ < 4; ++j_) { nx[j_] = xr_[64 * j_]; no[j_] = or_[64 * j_]; } } while (0)
    LN1_FETCH(gw);
    for (int m = gw; m < Mrows; m += NGW) {
        float* dst; int mr;
        if (m < NTX) { dst = xo + (size_t)m * DM; mr = m / SEQ; } else { dst = co + (size_t)(m - NTX) * DM; mr = 16; }
        const GAS f32x4* md = (const GAS f32x4*)(mods + (size_t)mr * 6144) + lane;
        f32x4 v[4], sc2[4], sh2[4], gt1[4]; float s = 0.f;
#pragma unroll
        for (int j = 0; j < 4; ++j) { gt1[j] = md[512 + 64 * j]; sc2[j] = md[1024 + 64 * j]; sh2[j] = md[768 + 64 * j]; }
#pragma unroll
        for (int j = 0; j < 4; ++j) { const f32x4 x = nx[j], gt = gt1[j]; const v2u ow = no[j]; const f32x4 o = {bflo(ow.x), bfhi(ow.x), bflo(ow.y), bfhi(ow.y)};
            v[j] = x * ALPHA + gt * o; s += (v[j].x + v[j].y) + (v[j].z + v[j].w); }
        LN1_FETCH(m + NGW);
        const float mean = wave_sum(s) * (1.f / DM); float s2 = 0.f;
#pragma unroll
        for (int j = 0; j < 4; ++j) { v[j] = v[j] - mean; s2 += (v[j].x * v[j].x + v[j].y * v[j].y) + (v[j].z * v[j].z + v[j].w * v[j].w); }
        const float rstd = 1.f / sqrtf(wave_sum(s2) * (1.f / DM) + LN_EPS);
        float part[32];
#pragma unroll
        for (int e = 0; e < 32; ++e) part[e] = 0.f;
        GAS f32x4* dr = (GAS f32x4*)dst + lane; GAS v2u* hr = (GAS v2u*)(HM + (size_t)m * DM) + lane;
#pragma unroll
        for (int j = 0; j < 4; ++j) { const f32x4 x1 = v[j] * rstd * lgv[j] + lbv[j]; dr[64 * j] = x1;
            const f32x4 hm = x1 * (sc2[j] + 1.0f) + sh2[j]; v2u w; w.x = pk2(hm.x, hm.y); w.y = pk2(hm.z, hm.w); hr[64 * j] = w;
#pragma unroll
            for (int e8 = 0; e8 < 4; ++e8) { f32x4 rw[8]; const unsigned ra = (unsigned)((256 * j + 4 * lane) * 4 + (e8 >> 1) * 65536);
#pragma unroll
                for (int q = 0; q < 8; ++q) asm volatile("ds_read_b128 %0, %1 offset:%2" : "=v"(rw[q]) : "v"(ra), "i"(((e8 & 1) * 8 + q) * 4096));
                asm volatile("s_waitcnt lgkmcnt(0)" : "+v"(rw[0]), "+v"(rw[1]), "+v"(rw[2]), "+v"(rw[3]), "+v"(rw[4]), "+v"(rw[5]), "+v"(rw[6]), "+v"(rw[7]) :: "memory");
#pragma unroll
                for (int q = 0; q < 8; ++q) part[e8 * 8 + q] += hm.x * rw[q].x + hm.y * rw[q].y + hm.z * rw[q].z + hm.w * rw[q].w;
#ifdef PROBE_ROUTER
                { f32x4 rw2[8];
#pragma unroll
                  for (int q = 0; q < 8; ++q) asm volatile("ds_read_b128 %0, %1 offset:%2" : "=v"(rw2[q]) : "v"(ra), "i"(((e8 & 1) * 8 + q) * 4096));
                  asm volatile("s_waitcnt lgkmcnt(0)" : "+v"(rw2[0]), "+v"(rw2[1]), "+v"(rw2[2]), "+v"(rw2[3]), "+v"(rw2[4]), "+v"(rw2[5]), "+v"(rw2[6]), "+v"(rw2[7]) :: "memory");
#pragma unroll
                  for (int q = 0; q < 8; ++q) { float dmy = hm.x * rw2[q].x + hm.y * rw2[q].y + hm.z * rw2[q].z + hm.w * rw2[q].w; asm volatile("" :: "v"(dmy)); } }
#endif
            } }
        float p16[16], p8[8], p4[4], p2[2], p1;
        { const bool up = (lane & 32) != 0;
#pragma unroll
          for (int e = 0; e < 16; ++e) { const float mine = up ? part[16 + e] : part[e], oth = up ? part[e] : part[16 + e]; p16[e] = mine + shx(oth, 32, lane); } }
        { const bool up = (lane & 16) != 0;
#pragma unroll
          for (int e = 0; e < 8; ++e) { const float mine = up ? p16[8 + e] : p16[e], oth = up ? p16[e] : p16[8 + e]; p8[e] = mine + shx(oth, 16, lane); } }
        { const bool up = (lane & 8) != 0;
#pragma unroll
          for (int e = 0; e < 4; ++e) { const float mine = up ? p8[4 + e] : p8[e], oth = up ? p8[e] : p8[4 + e]; p4[e] = mine + dppmov<0x128>(oth); } }
        { const bool up = (lane & 4) != 0;
#pragma unroll
          for (int e = 0; e < 2; ++e) { const float mine = up ? p4[2 + e] : p4[e], oth = up ? p4[e] : p4[2 + e]; p2[e] = mine + shx(oth, 4, lane); } }
        { const bool up = (lane & 2) != 0; const float mine = up ? p2[1] : p2[0], oth = up ? p2[0] : p2[1]; p1 = mine + dppmov<0x4E>(oth); }
        const float logit = p1 + dppmov<0xB1>(p1);
        const float score = sigmoidf_(logit), sel = score + biasv;
        const int gl = lane & ~7;
        const float q0 = shi(sel, gl), q1 = shi(sel, gl + 2), q2 = shi(sel, gl + 4), q3 = shi(sel, gl + 6);
        const float mx = fmaxf(fmaxf(q0, q1), fmaxf(q2, q3));
        float top2;
        { float a0 = q0, a1 = q1, a2 = q2, a3 = q3; float t;
          if (a0 < a1) { t = a0; a0 = a1; a1 = t; } if (a2 < a3) { t = a2; a2 = a3; a3 = t; } if (a0 < a2) { t = a0; a0 = a2; a2 = t; } if (a1 < a3) { t = a1; a1 = a3; a3 = t; } if (a1 < a2) { t = a1; a1 = a2; a2 = t; }
          top2 = a0 + a1; (void)mx; }
        float best = __builtin_bit_cast(float, __builtin_amdgcn_readlane(__builtin_bit_cast(int, top2), 0)); int gidx = 0;
#pragma unroll
        for (int gg = 1; gg < 8; ++gg) { const float sc = __builtin_bit_cast(float, __builtin_amdgcn_readlane(__builtin_bit_cast(int, top2), gg * 8)); if (sc > best) { best = sc; gidx = gg; } }
        const float r0 = shi(sel, gidx * 8), r1 = shi(sel, gidx * 8 + 2), r2 = shi(sel, gidx * 8 + 4), r3 = shi(sel, gidx * 8 + 6);
        int i0 = 0; float b0 = r0; if (r1 > b0) { b0 = r1; i0 = 1; } if (r2 > b0) { b0 = r2; i0 = 2; } if (r3 > b0) { b0 = r3; i0 = 3; }
        int i1 = -1; float b1 = -INFINITY;
        if (i0 != 0 && r0 > b1) { b1 = r0; i1 = 0; } if (i0 != 1 && r1 > b1) { b1 = r1; i1 = 1; } if (i0 != 2 && r2 > b1) { b1 = r2; i1 = 2; } if (i0 != 3 && r3 > b1) { b1 = r3; i1 = 3; }
        const int e0 = gidx * 4 + i0, e1 = gidx * 4 + i1;
        const float s0 = shi(score, 2 * e0), s1 = shi(score, 2 * e1); const float gs = 1.0f / (s0 + s1);
        if (lane == 0) { const int p0 = __hip_atomic_fetch_add(lcnt + e0, 1, __ATOMIC_RELAXED, __HIP_MEMORY_SCOPE_WORKGROUP), p1_ = __hip_atomic_fetch_add(lcnt + e1, 1, __ATOMIC_RELAXED, __HIP_MEMORY_SCOPE_WORKGROUP);
            TokInfo ti; ti.e0 = e0; ti.e1 = e1; ti.p0 = p0; ti.p1 = p1_; ti.g0 = s0 * gs; ti.g1 = s1 * gs; ti.pad0 = 0; ti.pad1 = 0; TOK[m] = ti; }
    }
    __syncthreads();
    if (tid < 32) HIST[bid * 32 + tid] = lcnt[tid];
}

template <bool FULL> __device__ __forceinline__ void moe_tables(LAS unsigned char* lds, int l) {
    const KA a = ka_get(); const int tid = opaque_tid(), G = gridDim.x;
    LAS int* pref = (LAS int*)(lds + PREF_OFF); LAS int* bb = (LAS int*)lds; LAS int* tot = (LAS int*)(lds + 65536);
    const int* HIST = (const int*)(a.ws() + WS_LIST);
    __syncthreads();
    const int e = tid & 31, grp = tid >> 5;
    int loc[16]; int run = 0;
#pragma unroll
    for (int i = 0; i < 16; ++i) { const int b = grp * 16 + i; loc[i] = (b < G) ? HIST[b * 32 + e] : 0; }
#pragma unroll
    for (int i = 0; i < 16; ++i) { const int v = loc[i]; loc[i] = run; run += v; }
    tot[grp * 32 + e] = run;
    __syncthreads();
    int base = 0, total = 0;
#pragma unroll
    for (int q = 0; q < 16; ++q) { const int v = tot[q * 32 + e]; base += (q < grp) ? v : 0; total += v; }
    if (FULL) {
#pragma unroll
        for (int i = 0; i < 16; ++i) bb[(grp * 16 + i) * 32 + e] = base + loc[i]; }
    if (grp == 0) pref[40 + e] = total;
    __syncthreads();
    if (tid == 0) { int acc = 0; for (int k = 0; k < 32; ++k) { pref[k] = acc; acc += (pref[40 + k] + 255) >> 8; } pref[32] = acc; }
    __syncthreads();
}
__device__ __forceinline__ void phase_gather(LAS unsigned char* lds, int l) {
    const KA a = ka_get();
    const int tid = opaque_tid(), lane = tid & 63, wave = __builtin_amdgcn_readfirstlane(tid >> 6), G = gridDim.x, bid = blockIdx.x;
    const int gw = bid * 8 + wave, NGW = G * 8;
    moe_tables<true>(lds, l);
    const LAS int* pref = (const LAS int*)(lds + PREF_OFF); const LAS int* bb = (const LAS int*)lds;
    const bf16* HM = (const bf16*)(a.ws() + WS_X1); bf16* XB = (bf16*)(a.ws() + WS_X2); const TokInfo* TOK = (const TokInfo*)(a.ws() + WS_TOK);
    const int Mrows = l == 0 ? NTOK : NTX;
    for (int m = gw; m < Mrows; m += NGW) {
        const TokInfo ti = TOK[m]; const int blk = (m % NGW) >> 3;
        const int sl0 = pref[ti.e0] * 256 + bb[blk * 32 + ti.e0] + ti.p0, sl1 = pref[ti.e1] * 256 + bb[blk * 32 + ti.e1] + ti.p1;
        const GAS v4u* srcp = (const GAS v4u*)(HM + (size_t)m * DM) + lane; const v4u v0 = srcp[0], v1 = srcp[64];
        GAS v4u* d0 = (GAS v4u*)(XB + (size_t)sl0 * DM) + lane; GAS v4u* d1 = (GAS v4u*)(XB + (size_t)sl1 * DM) + lane;
        d0[0] = v0; d0[64] = v1; d1[0] = v0; d1[64] = v1;
    }
    for (int e = 0; e < 32; ++e) {
        const int c = pref[40 + e], npad = ((c + 255) & ~255) - c, r0 = pref[e] * 256 + c;
        for (int r = gw; r < npad; r += NGW) { GAS v4u* dst = (GAS v4u*)(XB + (size_t)(r0 + r) * DM) + lane; dst[0] = (v4u){0u, 0u, 0u, 0u}; dst[64] = (v4u){0u, 0u, 0u, 0u}; }
    }
}

__device__ __forceinline__ void phase_ln2(LAS unsigned char* lds, int l) {
    const KA a = ka_get();
    const int tid = opaque_tid(), lane = tid & 63, wave = __builtin_amdgcn_readfirstlane(tid >> 6), G = gridDim.x, bid = blockIdx.x;
    const int gw = bid * 8 + wave, NGW = G * 8;
    moe_tables<true>(lds, l);
    const LAS int* pref = (const LAS int*)(lds + PREF_OFF); const LAS int* bb = (const LAS int*)lds;
    const float* mods = (const float*)(a.ws() + WS_MODS) + (size_t)l * 17 * 6144;
    const bf16* Y = (const bf16*)(a.ws() + WS_X2); const TokInfo* TOK = (const TokInfo*)(a.ws() + WS_TOK);
    float* xo = a.out(); float* co = (float*)(a.ws() + WS_CS);
    const GAS f32x4* lg = (const GAS f32x4*)(a.in(I_LN2G) + l * DM) + lane; const GAS f32x4* lb = (const GAS f32x4*)(a.in(I_LN2B) + l * DM) + lane;
    const int Mrows = l == 0 ? NTOK : NTX;
    f32x4 lgv[4], lbv[4];
#pragma unroll
    for (int j = 0; j < 4; ++j) { lgv[j] = lg[64 * j]; lbv[j] = lb[64 * j]; }
    TokInfo tnext = TOK[gw < Mrows ? gw : 0];
    for (int m = gw; m < Mrows; m += NGW) {
        float* xr_; int mr;
        if (m < NTX) { xr_ = xo + (size_t)m * DM; mr = m / SEQ; } else { xr_ = co + (size_t)(m - NTX) * DM; mr = 16; }
        const TokInfo ti = tnext; tnext = TOK[(m + NGW) < Mrows ? (m + NGW) : m]; const int blk = (m % NGW) >> 3;
        const int sl0 = pref[ti.e0] * 256 + bb[blk * 32 + ti.e0] + ti.p0, sl1 = pref[ti.e1] * 256 + bb[blk * 32 + ti.e1] + ti.p1;
        GAS f32x4* xr = (GAS f32x4*)xr_ + lane; const GAS f32x4* md = (const GAS f32x4*)(mods + (size_t)mr * 6144) + lane;
        const GAS v2u* y0 = (const GAS v2u*)(Y + (size_t)sl0 * DM) + lane; const GAS v2u* y1 = (const GAS v2u*)(Y + (size_t)sl1 * DM) + lane;
        f32x4 v[4], msc[4], msh[4]; float s = 0.f;
        if (l == 0) { const GAS f32x4* mn = (const GAS f32x4*)(mods + (size_t)17 * 6144 + (size_t)mr * 6144) + lane;
#pragma unroll
            for (int j = 0; j < 4; ++j) { msc[j] = mn[256 + 64 * j]; msh[j] = mn[64 * j]; } }
        f32x4 xin[4], gin[4]; v2u ain[4], bin[4];
#pragma unroll
        for (int j = 0; j < 4; ++j) { xin[j] = xr[64 * j]; gin[j] = md[1280 + 64 * j]; ain[j] = y0[64 * j]; bin[j] = y1[64 * j]; }
#pragma unroll
        for (int j = 0; j < 4; ++j) { const f32x4 x = xin[j], gt = gin[j]; const v2u a0 = ain[j], a1 = bin[j];
            const f32x4 ya = {bflo(a0.x), bfhi(a0.x), bflo(a0.y), bfhi(a0.y)}, yb = {bflo(a1.x), bfhi(a1.x), bflo(a1.y), bfhi(a1.y)};
            v[j] = x * ALPHA + gt * (ya * ti.g0 + yb * ti.g1); s += (v[j].x + v[j].y) + (v[j].z + v[j].w); }
        const float mean = wave_sum(s) * (1.f / DM); float s2 = 0.f;
#pragma unroll
        for (int j = 0; j < 4; ++j) { v[j] = v[j] - mean; s2 += (v[j].x * v[j].x + v[j].y * v[j].y) + (v[j].z * v[j].z + v[j].w * v[j].w); }
        const float rstd = 1.f / sqrtf(wave_sum(s2) * (1.f / DM) + LN_EPS);
        if (l == 0) {
            GAS v2u* o8 = (GAS v2u*)((bf16*)(a.ws() + WS_X1) + (size_t)m * DM) + lane;
#pragma unroll
            for (int j = 0; j < 4; ++j) { const f32x4 xn = v[j] * rstd * lgv[j] + lbv[j]; xr[64 * j] = xn; const f32x4 r = xn * (msc[j] + 1.0f) + msh[j]; v2u w; w.x = pk2(r.x, r.y); w.y = pk2(r.z, r.w); o8[64 * j] = w; }
        } else {
#pragma unroll
            for (int j = 0; j < 4; ++j) xr[64 * j] = v[j] * rstd * lgv[j] + lbv[j];
        }
    }
}
namespace csc {
constexpr int ARR = 0;
constexpr int RAW = 0;
constexpr int ZL = 34816;
constexpr int WLO = 57344;
constexpr int FR = 58368;
constexpr int AABT = 87040;
constexpr int LWO = 91136;
constexpr int AAO = 107520;
__device__ __forceinline__ int sw16(int row, int chunk) { return row * 128 + ((chunk ^ (row & 7)) << 4); }
__device__ __forceinline__ v2u cvt4(const f32x4 v) { v2u r; r.x = pk2(v[0], v[1]); r.y = pk2(v[2], v[3]); return r; }
__device__ __forceinline__ bf16x8 mk8(v2u lo, v2u hi) { v4u w; w.x = lo.x; w.y = lo.y; w.z = hi.x; w.w = hi.y; return __builtin_bit_cast(bf16x8, w); }
__device__ __forceinline__ v2u trd(const LAS unsigned char* p) { return __builtin_bit_cast(v2u, __builtin_amdgcn_ds_read_tr16_b64_v4i16((LAS v4i16_t*)p)); }
__device__ __forceinline__ int opq(int v) { asm volatile("" : "+v"(v)); return v; }
__device__ __forceinline__ int opqs(int v) { asm volatile("" : "+s"(v)); return v; }
}
namespace bgc {
constexpr int CBUF = LDSCTL_OFF + 4096, CPITCH = 80, NITEMS = NEXP * 1536;
struct Item { const float* src; bf16* dst; int N, ld; };
__device__ __forceinline__ Item decode(const KA& a, int l, int item) {
    const int e = item / 1536; int r = item - e * 1536; const int m = r >> 9, t = r & 511; const size_t eo = ((size_t)l * NEXP + e) * (size_t)DM * DEXP; Item it;
    if (m < 2) { const int kt = t >> 4, nt = t & 15, j0 = 32 * nt; it.N = DEXP; it.ld = 1024; it.src = (m ? a.in(I_EW3) : a.in(I_EW1)) + eo + (size_t)(32 * kt) * DEXP + j0;
        it.dst = (bf16*)(a.ws() + WS_W13T) + (size_t)e * 1024 * 1024 + (size_t)(256 * (j0 >> 7) + 128 * m + (j0 & 127)) * 1024 + 32 * kt; }
    else { const int kt = t >> 5, nt = t & 31; it.N = DM; it.ld = 512; it.src = a.in(I_EW2) + eo + (size_t)(32 * kt) * DM + 32 * nt; it.dst = (bf16*)(a.ws() + WS_W2T) + (size_t)e * 1024 * 512 + (size_t)(32 * nt) * 512 + 32 * kt; }
    return it; }
__device__ __forceinline__ void issue(const KA& a, int l, int item, int lane, f32x4 (&cv)[4]) { const Item it = decode(a, l, item);
#pragma unroll
    for (int i = 0; i < 4; ++i) cv[i] = *(const GAS f32x4*)(it.src + (size_t)((lane >> 3) + 8 * i) * it.N + (lane & 7) * 4); }
__device__ __forceinline__ void finish(const KA& a, int l, int item, int lane, int slot, LAS unsigned char* lds, const f32x4 (&cv)[4]) { const Item it = decode(a, l, item);
    LAS unsigned char* buf = lds + CBUF + slot * (32 * CPITCH);
#pragma unroll
    for (int i = 0; i < 4; ++i)
#pragma unroll
        for (int u = 0; u < 4; ++u) *(LAS bf16*)(buf + ((lane & 7) * 4 + u) * CPITCH + ((lane >> 3) + 8 * i) * 2) = f2bf1(cv[i][u]);
    LDS_WAIT(); asm volatile("" ::: "memory");
    const int n = lane >> 1, hf = lane & 1; const v4u w0 = *(const LAS v4u*)(buf + n * CPITCH + hf * 32), w1 = *(const LAS v4u*)(buf + n * CPITCH + hf * 32 + 16);
    GAS v4u* d = (GAS v4u*)(it.dst + (size_t)n * it.ld + 16 * hf); d[0] = w0; d[1] = w1;
    LDS_WAIT(); asm volatile("" ::: "memory"); }
}
#ifndef SCAN_PROBE
#define SCAN_PROBE 0
#endif
#define REPK(k) for (int rep_ = 0; rep_ < ((SCAN_PROBE == (k)) ? 2 : 1); ++rep_)
__device__ __forceinline__ void phase_scan(LAS unsigned char* lds, int l) {
    using namespace csc;
    const KA a = ka_get();
    const int tid = opaque_tid(), lane0 = tid & 63, wv = __builtin_amdgcn_readfirstlane(tid >> 6);
    const bf16* PX = (const bf16*)(a.ws() + WS_X2); float* YD = (float*)(a.ws() + WS_X3); float* BON = (float*)(a.ws() + WS_BONUS);
    const float* mup = a.in(I_MUP) + l * 1760; const float* mun = a.in(I_MUN) + l * 1760;
    const f32x4 Z4 = {0.f, 0.f, 0.f, 0.f}; const v2u Z2 = {0u, 0u};
    for (int chain = blockIdx.x; chain < 256; chain += gridDim.x) {
        const int b = chain >> 4, h = (chain >> 1) & 7, d = chain & 1; const int c0_ = opq(lane0);
        float kkc[2], kac[2], rkc[2], mur[2][2], muk[2][2], muv[2][2], mul[2][2], ropef[2]; bf16x8 w2f[2], a2f[2]; float w0c[2], a0c[2];
        { const int ln = c0_, kl = ln & 15, g = ln >> 4, cp = ln & 31;
#pragma unroll
          for (int u = 0; u < 2; ++u) { const int c = 2 * cp + u; ropef[u] = exp2f(-(float)(c & 15) * (13.287712379549449f / 16.0f));
            kkc[u] = a.in(I_KK)[l * 512 + h * 64 + c]; kac[u] = a.in(I_KA)[l * 512 + h * 64 + c]; rkc[u] = a.in(I_RK)[l * 512 + h * 64 + c];
            const int colr = h * 64 + c, coll = (c < 32) ? (1536 + d * 32 + c) : (1600 + d * 32 + (c - 32));
            mur[u][0] = d ? mun[colr] : mup[colr]; mur[u][1] = d ? mup[colr] : mun[colr]; muk[u][0] = d ? mun[512 + colr] : mup[512 + colr]; muk[u][1] = d ? mup[512 + colr] : mun[512 + colr];
            muv[u][0] = d ? mun[1024 + colr] : mup[1024 + colr]; muv[u][1] = d ? mup[1024 + colr] : mun[1024 + colr]; mul[u][0] = d ? mun[coll] : mup[coll]; mul[u][1] = d ? mup[coll] : mun[coll]; }
#pragma unroll
        for (int i = 0; i < 2; ++i) { const int cc = h * 64 + 16 * ((wv >> 2) * 2 + i) + kl; unsigned t[8], u[8];
#pragma unroll
            for (int j = 0; j < 8; ++j) { t[j] = f2bf(a.in(I_W2)[((size_t)(l * 2 + d) * 32 + 8 * g + j) * 512 + cc]); u[j] = f2bf(a.in(I_A2)[((size_t)(l * 2 + d) * 32 + 8 * g + j) * 512 + cc]); }
            w2f[i] = __builtin_bit_cast(bf16x8, (v4u){t[0] | (t[1] << 16), t[2] | (t[3] << 16), t[4] | (t[5] << 16), t[6] | (t[7] << 16)});
            a2f[i] = __builtin_bit_cast(bf16x8, (v4u){u[0] | (u[1] << 16), u[2] | (u[3] << 16), u[4] | (u[5] << 16), u[6] | (u[7] << 16)});
            w0c[i] = a.in(I_W0)[(l * 2 + d) * 512 + cc]; a0c[i] = a.in(I_A0)[(l * 2 + d) * 512 + cc]; } }
        f32x4 St[4] = {Z4, Z4, Z4, Z4};
        f32x4 cvt_[4] = {Z4, Z4, Z4, Z4}; int cit = blockIdx.x * 8 + wv, cpend = -1; const int cstride = gridDim.x * 8;
#define BGC_WINDOW() do { const int ln_ = opq(lane0); if (cpend >= 0) bgc::finish(a, l, cpend, ln_, wv & 3, lds, cvt_); if (cit < bgc::NITEMS) { bgc::issue(a, l, cit, ln_, cvt_); cpend = cit; cit += cstride; } else cpend = -1; } while (0)
        for (int seq = 0; seq < 2; ++seq) {
            const int T = seq ? SEQ : CTXL, rowbase = seq ? b * SEQ : NTX + b * CTXL, ngrp = T / 64;
            v4u pre[5];
#define CSC_PREFETCH(GRP) do { const int s0_ = (GRP) * 64; const int tlo_ = d ? (T - 64 - s0_) : s0_; \
                _Pragma("unroll") for (int i_ = 0; i_ < 5; ++i_) { const int id_ = opq(tid) + 512 * i_; const int rr_ = id_ >> 5, ch_ = id_ & 31; const int t_ = tlo_ - 1 + rr_; \
                    const int col_ = RWOFF + (ch_ < 24 ? (ch_ >> 3) * 512 + h * 64 + (ch_ & 7) * 8 : (ch_ < 28 ? 1536 + d * 32 + (ch_ - 24) * 8 : 1600 + d * 32 + (ch_ - 28) * 8)); \
                    const bool ok_ = (id_ < 66 * 32) && t_ >= 0 && t_ < T; const int tc_ = ok_ ? t_ : 0; \
                    const v4u v_ = *(const GAS v4u*)(PX + (size_t)(rowbase + tc_) * DINP + col_); pre[i_] = ok_ ? v_ : (v4u){0u, 0u, 0u, 0u}; } } while (0)
            CSC_PREFETCH(0);
            for (int grp = 0; grp < ngrp; ++grp) {
                const int s0 = grp * 64;
                int lane = opq(lane0); int c = lane, kl = lane & 15, g = lane >> 4, q_ = kl >> 2, p_ = kl & 3; (void)q_; (void)p_;
#pragma unroll
                for (int i = 0; i < 5; ++i) { const int id = opq(tid) + 512 * i; if (id < 66 * 32) *(LAS v4u*)(lds + RAW + id * 16) = pre[i]; }
                __syncthreads();
                int sl = opqs(wv);
                float Rk[4][2], Rq[4][2], Rr[4][2], Rv[4][2];
                REPK(1) { const int cp = lane & 31, sh = lane >> 5, sb = 8 * sl + 4 * sh; const int rbase = d ? 64 - sb : sb + 1, rdir = d ? -256 : 256;
                  const LAS bf16* p0 = (const LAS bf16*)(lds + RAW) + (rbase * 256 + 2 * cp) - rdir;
                  float pr[6][2], pk[6][2], pv[6][2], pl[6][2];
#pragma unroll
                  for (int j = 0; j < 6; ++j) { const LAS unsigned* p = (const LAS unsigned*)(p0 + j * rdir); const unsigned wr = p[0], wk = p[32], wv_ = p[64], wl = p[96];
                      pr[j][0] = bflo(wr); pr[j][1] = bfhi(wr); pk[j][0] = bflo(wk); pk[j][1] = bfhi(wk); pv[j][0] = bflo(wv_); pv[j][1] = bfhi(wv_); pl[j][0] = bflo(wl); pl[j][1] = bfhi(wl); }
                  const int qd = cp >> 3;
#pragma unroll
                  for (int i = 0; i < 4; ++i) { const int sloc = sb + i; float r[2], k[2], zz[2];
#pragma unroll
                      for (int u = 0; u < 2; ++u) { r[u] = pr[i + 1][u] + mur[u][0] * (pr[i][u] - pr[i + 1][u]) + mur[u][1] * (pr[i + 2][u] - pr[i + 1][u]); k[u] = pk[i + 1][u] + muk[u][0] * (pk[i][u] - pk[i + 1][u]) + muk[u][1] * (pk[i + 2][u] - pk[i + 1][u]);
                          Rv[i][u] = pv[i + 1][u] + muv[u][0] * (pv[i][u] - pv[i + 1][u]) + muv[u][1] * (pv[i + 2][u] - pv[i + 1][u]);
                          const float z = pl[i + 1][u] + mul[u][0] * (pl[i][u] - pl[i + 1][u]) + mul[u][1] * (pl[i + 2][u] - pl[i + 1][u]);
                          const float th = 1.0f - 2.0f * __builtin_amdgcn_rcpf(1.0f + __expf(2.0f * z)); zz[u] = cp < 16 ? th : z; }
                      ((LAS unsigned*)(lds + ZL))[sloc * 32 + cp] = pk2(zz[0], zz[1]);
                      if (seq) { const int t = d ? (T - 1 - (s0 + sloc)) : (s0 + sloc); const float pos = (float)((qd < 2) ? (t >> 6) : (t & 63));
#pragma unroll
                          for (int u = 0; u < 2; ++u) { const float rp = dppmov<0x128>(r[u]), kp = dppmov<0x128>(k[u]); const float ang = pos * ropef[u]; const float cs = __cosf(ang), sn = __sinf(ang);
                              const float sg = (qd & 1) ? sn : -sn; r[u] = r[u] * cs + rp * sg; k[u] = k[u] * cs + kp * sg; } }
                      const float k0 = k[0] * kkc[0], k1 = k[1] * kkc[1]; float ss = k0 * k0 + k1 * k1;
                      ss += dppmov<0xB1>(ss); ss += dppmov<0x4E>(ss); ss += dppmov<0x141>(ss); ss += dppmov<0x140>(ss);
                      { const int iv = __builtin_bit_cast(int, ss); const float a0 = __builtin_bit_cast(float, __builtin_amdgcn_readlane(iv, 0)) + __builtin_bit_cast(float, __builtin_amdgcn_readlane(iv, 16)), a1 = __builtin_bit_cast(float, __builtin_amdgcn_readlane(iv, 32)) + __builtin_bit_cast(float, __builtin_amdgcn_readlane(iv, 48)); ss = sh ? a1 : a0; }
                      const float rn = __builtin_amdgcn_rsqf(fmaxf(ss, 1e-24f));
                      Rk[i][0] = k0 * rn; Rk[i][1] = k1 * rn; Rq[i][0] = k[0]; Rq[i][1] = k[1]; Rr[i][0] = r[0]; Rr[i][1] = r[1]; } }
                __syncthreads();
                lane = opq(lane0); c = lane; kl = lane & 15; g = lane >> 4; q_ = kl >> 2; p_ = kl & 3;
                REPK(2) { const int wq = opqs(wv); const int st = wq & 3; const LAS unsigned char* zrow = lds + ZL + (16 * st + kl) * 128;
                  const bf16x8 zw = *(const LAS bf16x8*)(zrow + 16 * g), za = *(const LAS bf16x8*)(zrow + 64 + 16 * g);
#pragma unroll
                  for (int i = 0; i < 2; ++i) { const int cc = 16 * ((wq >> 2) * 2 + i) + kl;
                      const f32x4 uw = __builtin_amdgcn_mfma_f32_16x16x32_bf16(zw, w2f[i], Z4, 0, 0, 0), ua = __builtin_amdgcn_mfma_f32_16x16x32_bf16(za, a2f[i], Z4, 0, 0, 0);
#pragma unroll
                      for (int j = 0; j < 4; ++j) { const int srow = 16 * st + 4 * g + j;
                          ((LAS float*)(lds + LWO))[srow * 64 + cc] = -0.6065306597126334f * __builtin_amdgcn_rcpf(1.0f + __expf(-(uw[j] + w0c[i]))); ((LAS float*)(lds + AAO))[srow * 64 + cc] = __builtin_amdgcn_rcpf(1.0f + __expf(-(ua[j] + a0c[i]))); } } }
                __syncthreads();
                lane = opq(lane0); c = lane; kl = lane & 15; g = lane >> 4; q_ = kl >> 2; p_ = kl & 3;
                sl = opqs(wv);
                REPK(4) { const int cp = lane & 31, sh = lane >> 5, q = sl >> 1, hf = sl & 1; typedef float f32x2_ __attribute__((ext_vector_type(2)));
                  const LAS f32x2_* lwp = (const LAS f32x2_*)((const LAS float*)(lds + LWO) + (16 * q) * 64 + 2 * cp); const LAS f32x2_* aap = (const LAS f32x2_*)((const LAS float*)(lds + AAO) + (8 * sl + 4 * sh) * 64 + 2 * cp);
                  f32x2_ qs[4];
#pragma unroll
                  for (int j = 0; j < 4; ++j) { qs[j] = lwp[(4 * j) * 32] + lwp[(4 * j + 1) * 32] + lwp[(4 * j + 2) * 32] + lwp[(4 * j + 3) * 32]; }
                  const f32x2_ cL = (qs[0] + qs[1]) + (qs[2] + qs[3]); const int part = 2 * hf + sh;
                  f32x2_ run = part == 0 ? (f32x2_){0.f, 0.f} : (part == 1 ? qs[0] : (part == 2 ? qs[0] + qs[1] : qs[0] + qs[1] + qs[2]));
                  const float wl0 = __expf(cL.x), wl1 = __expf(cL.y);
                  if (part == 3) ((LAS f32x2_*)(lds + WLO))[q * 32 + cp] = (f32x2_){wl0, wl1};
#pragma unroll
                  for (int i = 0; i < 4; ++i) { const int sloc = 8 * sl + 4 * sh + i, s = 4 * part + i; const f32x2_ lwi = lwp[s * 32]; const f32x2_ cprev = run; run = run + lwi; const f32x2_ aa = aap[i * 32];
                      const float kd0 = Rq[i][0] * (1.0f + (aa.x - 1.0f) * kac[0]), kd1 = Rq[i][1] * (1.0f + (aa.y - 1.0f) * kac[1]), nb0 = -Rk[i][0] * aa.x, nb1 = -Rk[i][1] * aa.y;
                      float bon = Rr[i][0] * kd0 * rkc[0] + Rr[i][1] * kd1 * rkc[1];
                      bon += dppmov<0xB1>(bon); bon += dppmov<0x4E>(bon); bon += dppmov<0x141>(bon); bon += dppmov<0x140>(bon);
                      { const int iv = __builtin_bit_cast(int, bon); const float a0 = __builtin_bit_cast(float, __builtin_amdgcn_readlane(iv, 0)) + __builtin_bit_cast(float, __builtin_amdgcn_readlane(iv, 16)), a1 = __builtin_bit_cast(float, __builtin_amdgcn_readlane(iv, 32)) + __builtin_bit_cast(float, __builtin_amdgcn_readlane(iv, 48)); bon = sh ? a1 : a0; }
                      if (cp == 0) { const int t = d ? (T - 1 - (s0 + sloc)) : (s0 + sloc); BON[((size_t)d * NTOK + rowbase + t) * 8 + h] = bon; }
                      const float e1x = __expf(cprev.x), e1y = __expf(cprev.y), e2x = __expf(-run.x), e2y = __expf(-run.y), e3x = __builtin_amdgcn_rcpf(e2x), e3y = __builtin_amdgcn_rcpf(e2y);
                      LAS unsigned char* base = lds + ARR + q * (7 * 2048) + sw16(s, cp >> 2) + (cp & 3) * 4;
                      *(LAS unsigned*)(base) = pk2(Rk[i][0] * e1x, Rk[i][1] * e1y); *(LAS unsigned*)(base + 2048) = pk2(nb0 * e2x, nb1 * e2y); *(LAS unsigned*)(base + 4096) = pk2(kd0 * e2x, kd1 * e2y); *(LAS unsigned*)(base + 6144) = pk2(Rr[i][0] * e3x, Rr[i][1] * e3y);
                      *(LAS unsigned*)(base + 12288) = pk2(Rv[i][0], Rv[i][1]); } }
                __syncthreads();
                lane = opq(lane0); c = lane; kl = lane & 15; g = lane >> 4; q_ = kl >> 2; p_ = kl & 3;
                if (grp + 1 < ngrp) CSC_PREFETCH(grp + 1);
                if (wv < 4) BGC_WINDOW();
                REPK(5) if (wv >= 4) { const int q = opqs(wv) - 4; const LAS unsigned char* A0 = lds + ARR + q * (7 * 2048);
                    bf16x8 at[2], bt[2], kt[2], rt[2];
#pragma unroll
                    for (int ks = 0; ks < 2; ++ks) { const int o = sw16(kl, ks * 4 + g); at[ks] = *(const LAS bf16x8*)(A0 + o); bt[ks] = *(const LAS bf16x8*)(A0 + 2048 + o); kt[ks] = *(const LAS bf16x8*)(A0 + 4096 + o); rt[ks] = *(const LAS bf16x8*)(A0 + 6144 + o); }
                    f32x4 ABt = Z4, AKt = Z4, RBt = Z4, RKt = Z4;
#pragma unroll
                    for (int ks = 0; ks < 2; ++ks) { ABt = __builtin_amdgcn_mfma_f32_16x16x32_bf16(bt[ks], at[ks], ABt, 0, 0, 0); AKt = __builtin_amdgcn_mfma_f32_16x16x32_bf16(kt[ks], at[ks], AKt, 0, 0, 0);
                        RBt = __builtin_amdgcn_mfma_f32_16x16x32_bf16(bt[ks], rt[ks], RBt, 0, 0, 0); RKt = __builtin_amdgcn_mfma_f32_16x16x32_bf16(kt[ks], rt[ks], RKt, 0, 0, 0); }
#pragma unroll
                    for (int j = 0; j < 4; ++j) { const int jj = 4 * g + j; ABt[j] = jj < kl ? ABt[j] : 0.f; AKt[j] = jj < kl ? AKt[j] : 0.f; RBt[j] = jj <= kl ? RBt[j] : 0.f; RKt[j] = jj <= kl ? RKt[j] : 0.f; }
                    float Tr[16]; const float ab0 = ABt[0], ab1 = ABt[1], ab2 = ABt[2], ab3 = ABt[3];
                    const int abi[4] = {__builtin_bit_cast(int, ab0), __builtin_bit_cast(int, ab1), __builtin_bit_cast(int, ab2), __builtin_bit_cast(int, ab3)};
#pragma unroll
                    for (int i = 0; i < 16; ++i) Tr[i] = (i == kl) ? 1.f : 0.f;
#pragma unroll
                    for (int j = 14; j >= 0; --j) { float acc = 0.f;
#pragma unroll
                        for (int i = j + 1; i < 16; ++i) acc += Tr[i] * __builtin_bit_cast(float, __builtin_amdgcn_readlane(abi[j & 3], i + 16 * (j >> 2)));
                        Tr[j] = (j < kl) ? acc : Tr[j]; }
                    float tsel[4];
#pragma unroll
                    for (int e = 0; e < 4; ++e) tsel[e] = g == 0 ? Tr[e] : (g == 1 ? Tr[4 + e] : (g == 2 ? Tr[8 + e] : Tr[12 + e]));
                    v2u tf2; tf2.x = pk2(tsel[0], tsel[1]); tf2.y = pk2(tsel[2], tsel[3]);
                    const bf16x8 Tf = mk8(tf2, Z2), RBf = mk8(cvt4(RBt), Z2);
                    f32x4 AhT[4], QhT[4];
#pragma unroll
                    for (int ct = 0; ct < 4; ++ct) {
                        const bf16x8 Alo = mk8(trd(A0 + sw16(4 * g + q_, 2 * ct + (p_ >> 1)) + (p_ & 1) * 8), Z2);
                        AhT[ct] = __builtin_amdgcn_mfma_f32_16x16x32_bf16(Alo, Tf, Z4, 0, 0, 0);
                        const f32x4 Ah = __builtin_amdgcn_mfma_f32_16x16x32_bf16(Tf, Alo, Z4, 0, 0, 0);
                        const v2u rw = *(const LAS v2u*)(A0 + 6144 + sw16(kl, 2 * ct + (g >> 1)) + (g & 1) * 8);
                        const f32x4 rinit = {bflo(rw.x), bfhi(rw.x), bflo(rw.y), bfhi(rw.y)};
                        QhT[ct] = __builtin_amdgcn_mfma_f32_16x16x32_bf16(mk8(cvt4(Ah), Z2), RBf, rinit, 0, 0, 0); }
                    LAS unsigned char* fr = lds + FR + q * 7168 + lane * 16;
                    *(LAS bf16x8*)(fr) = mk8(cvt4(AhT[0]), cvt4(AhT[1])); *(LAS bf16x8*)(fr + 1024) = mk8(cvt4(AhT[2]), cvt4(AhT[3]));
                    *(LAS bf16x8*)(fr + 2048) = mk8(cvt4(QhT[0]), cvt4(QhT[1])); *(LAS bf16x8*)(fr + 3072) = mk8(cvt4(QhT[2]), cvt4(QhT[3]));
                    *(LAS bf16x8*)(fr + 4096) = mk8(cvt4(AKt), Z2); *(LAS bf16x8*)(fr + 5120) = mk8(cvt4(RBt), cvt4(RKt)); *(LAS bf16x8*)(fr + 6144) = Tf;
                }
                __syncthreads();
                lane = opq(lane0); c = lane; kl = lane & 15; g = lane >> 4; q_ = kl >> 2; p_ = kl & 3;
                if (wv >= 4) BGC_WINDOW();
                if (wv < 4) { const int vt = opqs(wv);
                    f32x4 Uh[4], Yh[4]; v2u vtrs[4];
#pragma unroll
                    for (int q = 0; q < 4; ++q) { const LAS unsigned char* A0 = lds + ARR + q * (7 * 2048); const LAS unsigned char* fr = lds + FR + q * 7168 + lane * 16;
                        const bf16x8 AKf = *(const LAS bf16x8*)(fr + 4096), RBRK = *(const LAS bf16x8*)(fr + 5120), Tf = *(const LAS bf16x8*)(fr + 6144);
                        vtrs[q] = trd(A0 + 12288 + sw16(4 * g + q_, 2 * vt + (p_ >> 1)) + (p_ & 1) * 8);
                        const f32x4 X1 = __builtin_amdgcn_mfma_f32_16x16x32_bf16(AKf, mk8(vtrs[q], Z2), Z4, 0, 0, 0);
                        Uh[q] = __builtin_amdgcn_mfma_f32_16x16x32_bf16(Tf, mk8(cvt4(X1), Z2), Z4, 0, 0, 0);
                        Yh[q] = __builtin_amdgcn_mfma_f32_16x16x32_bf16(RBRK, mk8(cvt4(Uh[q]), vtrs[q]), Z4, 0, 0, 0); }
#pragma unroll
                    for (int q = 0; q < 4; ++q) { const LAS unsigned char* A0 = lds + ARR + q * (7 * 2048); const LAS unsigned char* fr = lds + FR + q * 7168 + lane * 16;
                        const bf16x8 Ap0 = *(const LAS bf16x8*)(fr), Ap1 = *(const LAS bf16x8*)(fr + 1024), Qp0 = *(const LAS bf16x8*)(fr + 2048), Qp1 = *(const LAS bf16x8*)(fr + 3072);
                        bf16x8 bk[4]; f32x4 wl[4];
#pragma unroll
                        for (int ct = 0; ct < 4; ++ct) { wl[ct] = *(const LAS f32x4*)(lds + WLO + (q * 64 + 16 * ct + 4 * g) * 4); const int o = sw16(4 * g + q_, 2 * ct + (p_ >> 1)) + (p_ & 1) * 8; bk[ct] = mk8(trd(A0 + 2048 + o), trd(A0 + 4096 + o)); }
                        const bf16x8 bs0 = mk8(cvt4(St[0]), cvt4(St[1])), bs1 = mk8(cvt4(St[2]), cvt4(St[3]));
                        f32x4 U = __builtin_amdgcn_mfma_f32_16x16x32_bf16(Ap0, bs0, Uh[q], 0, 0, 0); U = __builtin_amdgcn_mfma_f32_16x16x32_bf16(Ap1, bs1, U, 0, 0, 0);
                        f32x4 Y = __builtin_amdgcn_mfma_f32_16x16x32_bf16(Qp0, bs0, Yh[q], 0, 0, 0); Y = __builtin_amdgcn_mfma_f32_16x16x32_bf16(Qp1, bs1, Y, 0, 0, 0);
                        const bf16x8 UV = mk8(cvt4(U), vtrs[q]);
#pragma unroll
                        for (int ct = 0; ct < 4; ++ct) St[ct] = __builtin_amdgcn_mfma_f32_16x16x32_bf16(bk[ct], UV, St[ct], 0, 0, 0) * wl[ct];
#pragma unroll
                        for (int j = 0; j < 4; ++j) { const int sg = s0 + 16 * q + 4 * g + j; const int t = d ? (T - 1 - sg) : sg; YD[((size_t)d * NTOK + rowbase + t) * 512 + h * 64 + 16 * vt + kl] = Y[j]; }
                    }
                }
                __syncthreads();
            }
#undef CSC_PREFETCH
        }
        if (cpend >= 0) { bgc::finish(a, l, cpend, opq(lane0), wv & 3, lds, cvt_); cpend = -1; }
        for (; cit < bgc::NITEMS; cit += cstride) { bgc::issue(a, l, cit, opq(lane0), cvt_); bgc::finish(a, l, cit, opq(lane0), wv & 3, lds, cvt_); }
#undef BGC_WINDOW
    }
}
constexpr int PH_PER_LAYER = 11, N_PHASES = 1 + 2 * PH_PER_LAYER;
template <int K> __device__ __forceinline__ void run_phase(LAS unsigned char* lds, int l) {
    if constexpr (K == 0) phase_prologue(lds);
    if constexpr (K == 1) phase_modconv(lds, l);
    if constexpr (K == 3) phase_scan(lds, l);
    if constexpr (K == 4) phase_attn(lds, l);
    if constexpr (K == 5) phase_rwpost(lds, l);
    if constexpr (K == 7) phase_ln1_route(lds, l);
    if constexpr (K == 8) phase_gather(lds, l);
    if constexpr (K == 11) phase_ln2(lds, l);
    if constexpr (K == 2 || K == 6 || K == 9 || K == 10) {
        const KA a = ka_get(); unsigned char* ws = a.ws(); const int G = gridDim.x, bid = blockIdx.x;
        bf16* X1 = (bf16*)(ws + WS_X1); bf16* X2 = (bf16*)(ws + WS_X2); bf16* X3 = (bf16*)(ws + WS_X3);
        if constexpr (K == 2) { __syncthreads();
            pg8::Gemm g{X1, (const bf16*)(ws + WS_WINT) + (size_t)l * DINP * DM, NTOK, DINP, DM}; pg8::StaticOrder S; S.init(NTOK, DINP, G, bid);
            pg8::EpiBf16 E{X2, DINP}; pg8::gemm_phase<pg8::EpiBf16, pg8::StaticOrder, true, true>(lds, g, S, E); }
        if constexpr (K == 6) { __syncthreads();
            const int Mrows = (l == 0) ? NTOK : NTX;
            pg8::Gemm g{X1, (const bf16*)(ws + WS_WOT) + (size_t)l * DM * DM, Mrows, DM, DM}; pg8::StaticOrder S; S.init(Mrows, DM, G, bid);
            pg8::EpiBf16 E{X3, DM}; pg8::gemm_phase<pg8::EpiBf16, pg8::StaticOrder, true, true>(lds, g, S, E); }
        if constexpr (K == 9) { moe_tables<false>(lds, l);
            pg8::Gemm g{X2, (const bf16*)(ws + WS_W13T), MAXSLOT, 1024, DM}; pg8::MoeOrder S; S.init((const LAS int*)(lds + PREF_OFF), 4, G, bid);
            pg8::EpiSwiGLU E{X3, DEXP}; pg8::gemm_phase<pg8::EpiSwiGLU, pg8::MoeOrder, true, true>(lds, g, S, E); }
        if constexpr (K == 10) { moe_tables<false>(lds, l);
            pg8::Gemm g{X3, (const bf16*)(ws + WS_W2T), MAXSLOT, 1024, DEXP}; pg8::MoeOrder S; S.init((const LAS int*)(lds + PREF_OFF), 4, G, bid);
            pg8::EpiBf16 E{X2, DM}; pg8::gemm_phase<pg8::EpiBf16, pg8::MoeOrder, true, true>(lds, g, S, E); }
    }
}
__device__ __forceinline__ void grid_sync(LAS unsigned char* lds) {
    const KA a = ka_get(); XcdBarrier b; b.bar = (unsigned*)(a.ws() + WS_CTL) + CW_BAR; b.x = xb_xcc_id(); b.st = (volatile LAS unsigned*)(lds + MISC_OFF) + 8; xcd_barrier(b);
#ifdef PROBE_BAR
    xcd_barrier(b);
#endif
}
#ifndef ONE_LAUNCH
template <int K> __global__ void __launch_bounds__(512, 2) fwd_ph(Args args) {
    extern __shared__ __attribute__((aligned(16))) unsigned char lds_raw[];
    LAS unsigned char* lds = (LAS unsigned char*)lds_raw;
    for (int u = threadIdx.x; u < (LDS_BYTES - LDSCTL_OFF) / 4; u += 512) ((LAS unsigned*)(lds + LDSCTL_OFF))[u] = 0u;
    __syncthreads();
    hw_tid_init();
    __syncthreads();
    run_phase<K>(lds, args.ph_lo);
}
template <int K> static void launch_ph(const Args& a, int grid, hipStream_t stream) {
    static bool attr = false;
    if (!attr) { (void)hipFuncSetAttribute((const void*)fwd_ph<K>, hipFuncAttributeMaxDynamicSharedMemorySize, LDS_BYTES); attr = true; }
    hipLaunchKernelGGL(fwd_ph<K>, dim3(grid), dim3(512), LDS_BYTES, stream, a);
}
#else
__global__ void __launch_bounds__(512, 2) fwd(Args args) {
    extern __shared__ __attribute__((aligned(16))) unsigned char lds_raw[];
    LAS unsigned char* lds = (LAS unsigned char*)lds_raw;
    for (int u = threadIdx.x; u < (LDS_BYTES - LDSCTL_OFF) / 4; u += 512) ((LAS unsigned*)(lds + LDSCTL_OFF))[u] = 0u;
    __syncthreads();
    hw_tid_init();
    __syncthreads();
    (void)xcd_barrier_post((unsigned*)(args.ws + WS_CTL) + CW_BAR, (volatile LAS unsigned*)(lds + MISC_OFF) + 8);
    run_phase<0>(lds, 0);
#ifdef PROBE_P0
    __syncthreads(); run_phase<0>(lds, 0);
#endif
    grid_sync(lds);
#ifndef PROBE_REP
#define PROBE_REP -1
#endif
#define RUNP(K) do { run_phase<K>(lds, l); if (PROBE_REP == K) { __syncthreads(); run_phase<K>(lds, l); } } while (0)
    for (int l = 0; l < 2; ++l) {
        if (l == 0) { RUNP(1); grid_sync(lds); }
        RUNP(2); grid_sync(lds);
        RUNP(3);
        RUNP(4); grid_sync(lds);
        RUNP(5); grid_sync(lds);
        RUNP(6); grid_sync(lds);
        run_phase<7>(lds, l); if (PROBE_REP == 7 && l == 0) { __syncthreads(); run_phase<7>(lds, l); } grid_sync(lds);
        RUNP(8); grid_sync(lds);
        RUNP(9); grid_sync(lds);
        RUNP(10); grid_sync(lds);
        run_phase<11>(lds, l); if (l == 0) grid_sync(lds);
    }
}
#endif

extern "C" void kernel_launch(void* const* d_in, const int* in_sizes, int n_in, void* d_out, int out_size, void* d_ws, size_t ws_size, hipStream_t stream) {
    static int grid = 0;
    if (grid == 0) {
        if (n_in != 30 || in_sizes[0] != NTX * DM || out_size != NTX * DM || ws_size < WS_END) {
            fprintf(stderr, "kernel_launch: unexpected problem (n_in %d, in0 %d, out %d, ws %zu < %zu?); nothing launched\n", n_in, n_in > 0 ? in_sizes[0] : -1, out_size, ws_size, (size_t)WS_END); grid = -1; return; }
        int dev = 0, cus = 0;
        if (hipGetDevice(&dev) != hipSuccess || hipDeviceGetAttribute(&cus, hipDeviceAttributeMultiprocessorCount, dev) != hipSuccess) { grid = -1; return; }
#ifdef ONE_LAUNCH
        if (hipFuncSetAttribute((const void*)fwd, hipFuncAttributeMaxDynamicSharedMemorySize, LDS_BYTES) != hipSuccess) { fprintf(stderr, "kernel_launch: hipFuncSetAttribute failed\n"); grid = -1; return; }
#endif
        (void)hipGetLastError();
        grid = cus > 0 ? cus : 256;
    }
    if (grid < 0) return;
    if (hipMemsetAsync((char*)d_ws + WS_CTL, 0, CTL_ZERO_BYTES, stream) != hipSuccess) return;
    Args a{};
    for (int i = 0; i < 30; ++i) a.in[i] = (const float*)d_in[i];
    a.out = (float*)d_out; a.ws = (unsigned char*)d_ws; a.ph_lo = 0; a.ph_hi = 0;
#ifndef ONE_LAUNCH
    launch_ph<0>(a, grid, stream);
    for (int l = 0; l < 2; ++l) { a.ph_lo = l;
        launch_ph<1>(a, grid, stream); launch_ph<2>(a, grid, stream); launch_ph<3>(a, grid, stream); launch_ph<4>(a, grid, stream); launch_ph<5>(a, grid, stream); launch_ph<6>(a, grid, stream);
        launch_ph<7>(a, grid, stream); launch_ph<8>(a, grid, stream); launch_ph<9>(a, grid, stream); launch_ph<10>(a, grid, stream); launch_ph<11>(a, grid, stream); }
#else
    hipLaunchKernelGGL(fwd, dim3(grid), dim3(512), LDS_BYTES, stream, a);
#endif
}
```

```cpp
#define ONE_LAUNCH 1
#include <hip/hip_runtime.h>
#include <cstdio>
#include <cstdint>

constexpr int DM = 1024, NB = 16, SEQ = 2048, CTXL = 256, NTX = NB * SEQ, NTC = NB * CTXL, NTOK = NTX + NTC;
constexpr int DIN = 3296, DINP = 3328, RWOFF = 1536, NHEAD = 8, HD = 64;
constexpr int NEXP = 32, DEXP = 512, LISTCAP = 2 * NTOK;
constexpr int MAXSLOT = 81920;
constexpr float ALPHA = 1.41421356237309515f, LN_EPS = 1e-6f, GN_EPS = 64e-5f;

constexpr size_t MiB = 1u << 20;
constexpr size_t WS_CTL = 0, CTL_ZERO_BYTES = 1 * MiB;
constexpr size_t WS_MODS = 1 * MiB;
constexpr size_t WS_ROPE = 2 * MiB;
constexpr size_t WS_WINT = 3 * MiB;
constexpr size_t WS_WOT = 16 * MiB;
constexpr size_t WS_W13T = 20 * MiB;
constexpr size_t WS_W2T = 84 * MiB;
constexpr size_t WS_LIST = 116 * MiB;
constexpr size_t WS_TOK = 125 * MiB;
constexpr size_t WS_BONUS = 127 * MiB;
constexpr size_t WS_CS = 130 * MiB;
constexpr size_t WS_X1 = 146 * MiB;
constexpr size_t WS_X2 = 218 * MiB;
constexpr size_t WS_XP = WS_X2 + 160 * MiB;
constexpr size_t WS_X3 = 452 * MiB;
constexpr size_t WS_END = 596 * MiB;
static_assert(WS_WINT + (size_t)2 * DINP * DM * 2 <= WS_WOT && WS_LIST + (size_t)NEXP * LISTCAP * 4 <= WS_TOK && WS_TOK + (size_t)NTOK * 32 <= WS_BONUS, "ws map");
static_assert(WS_BONUS + (size_t)2 * NTOK * 8 * 4 <= WS_CS && WS_X2 + (size_t)NTOK * DINP * 2 <= WS_X3 && WS_X3 + (size_t)2 * NTOK * 512 * 4 <= WS_END, "ws map");
static_assert((size_t)MAXSLOT * 1024 * 2 <= WS_XP - WS_X2 && WS_XP + (size_t)NTOK * DM * 2 <= WS_X3 && (size_t)MAXSLOT * 512 * 2 <= WS_END - WS_X3, "ws map");
constexpr int CW_BAR = 4096;
constexpr int CW_CNT = 8192;
constexpr int RING_BYTES = 131072, LDSCTL_OFF = RING_BYTES, MISC_OFF = LDSCTL_OFF + 320, LDS_BYTES = 147456;
constexpr int PREF_OFF = LDSCTL_OFF + 512;

#define GAS __attribute__((address_space(1)))
#define LAS __attribute__((address_space(3)))
typedef unsigned short bf16;
typedef unsigned v4u __attribute__((ext_vector_type(4)));
typedef unsigned v2u __attribute__((ext_vector_type(2)));
typedef float f32x4 __attribute__((ext_vector_type(4)));
typedef short bf16x8 __attribute__((ext_vector_type(8)));
typedef GAS unsigned gu32;
#define RLX_AGENT __ATOMIC_RELAXED, __HIP_MEMORY_SCOPE_AGENT
#define LDS_WAIT() asm volatile("s_waitcnt lgkmcnt(0)" ::: "memory")
#define VM_WAIT() asm volatile("s_waitcnt vmcnt(0)" ::: "memory")
__device__ __forceinline__ unsigned f2bf(float f) { unsigned u = __builtin_bit_cast(unsigned, f); return (u + 0x7fffu + ((u >> 16) & 1u)) >> 16; }
typedef float f32x2_t_ __attribute__((ext_vector_type(2))); typedef __bf16 bf16x2_t_ __attribute__((ext_vector_type(2)));
__device__ __forceinline__ unsigned pk2(float lo, float hi) { f32x2_t_ v = {lo, hi}; bf16x2_t_ b = __builtin_convertvector(v, bf16x2_t_); return __builtin_bit_cast(unsigned, b); }
__device__ __forceinline__ unsigned short f2bf1(float f) { return (unsigned short)(pk2(f, 0.f) & 0xffffu); }
__device__ __forceinline__ float bf2f(unsigned short v) { return __builtin_bit_cast(float, (unsigned)v << 16); }
__device__ __forceinline__ float bflo(unsigned w) { return __builtin_bit_cast(float, w << 16); }
__device__ __forceinline__ float bfhi(unsigned w) { return __builtin_bit_cast(float, w & 0xffff0000u); }
__device__ __forceinline__ float sigmoidf_(float x) { return 1.0f / (1.0f + expf(-x)); }
__device__ __forceinline__ float shx(float v, int k, int lane) { return __builtin_bit_cast(float, __builtin_amdgcn_ds_bpermute((lane ^ k) << 2, __builtin_bit_cast(int, v))); }
__device__ __forceinline__ float shi(float v, int src) { return __builtin_bit_cast(float, __builtin_amdgcn_ds_bpermute(src << 2, __builtin_bit_cast(int, v))); }
template <int CTRL> __device__ __forceinline__ float dppmov(float v) { return __builtin_bit_cast(float, __builtin_amdgcn_update_dpp(0, __builtin_bit_cast(int, v), CTRL, 0xF, 0xF, true)); }
__device__ __forceinline__ float wave_sum(float v) {
    v += dppmov<0xB1>(v); v += dppmov<0x4E>(v); v += dppmov<0x141>(v); v += dppmov<0x140>(v);
    const int iv = __builtin_bit_cast(int, v);
    return (__builtin_bit_cast(float, __builtin_amdgcn_readlane(iv, 0)) + __builtin_bit_cast(float, __builtin_amdgcn_readlane(iv, 16))) + (__builtin_bit_cast(float, __builtin_amdgcn_readlane(iv, 32)) + __builtin_bit_cast(float, __builtin_amdgcn_readlane(iv, 48)));
}
__device__ __forceinline__ float red8(float v) { v += dppmov<0xB1>(v); v += dppmov<0x4E>(v); v += dppmov<0x141>(v); return v; }

struct TokInfo { int e0, e1, p0, p1; float g0, g1; int pad0, pad1; };

constexpr int WID_OFF = LDSCTL_OFF + 1536;
__device__ __forceinline__ int hw_slot() { return (int)__builtin_amdgcn_s_getreg((5 << 11) | 4) & 63; }
__device__ __forceinline__ int lane_id() { int l; asm volatile("v_mbcnt_lo_u32_b32 %0, -1, 0\n\tv_mbcnt_hi_u32_b32 %0, -1, %0" : "=v"(l)); return l; }
__device__ __forceinline__ void hw_tid_init() { *(volatile LAS int*)(uintptr_t)(WID_OFF + 4 * hw_slot()) = (int)(threadIdx.x >> 6); }
__device__ __forceinline__ int hw_tid() { const int w = *(volatile LAS int*)(uintptr_t)(WID_OFF + 4 * hw_slot()); int t = (__builtin_amdgcn_readfirstlane(w) << 6) | lane_id(); asm volatile("" : "+v"(t)); return t; }
namespace pg8 {
#define PG8_LAS __attribute__((address_space(3)))
typedef unsigned short bf16_t;
typedef short bf16x8 __attribute__((ext_vector_type(8)));
typedef float f32x4 __attribute__((ext_vector_type(4)));
typedef unsigned u32x4 __attribute__((ext_vector_type(4)));
constexpr int BM = 256, BK = 64, HALF = 128, HTB = HALF * BK * 2  , STAGE_BYTES = 8 * HTB, NXCD = 8, WGM = 8;

__host__ __device__ __forceinline__ int lds_byte(int r, int c) { const int st = (r >> 4) * 2 + (c >> 5), rr = r & 15, cc = c & 31, ob = rr * 64 + cc * 2; return st * 1024 + (ob ^ (((ob >> 9) & 1) << 5)); }
__host__ __device__ __forceinline__ void stage_rc(int b, int& R, int& C) { const int st = b / 1024, sb = b % 1024, swz = sb ^ (((sb >> 9) & 1) << 5); R = (st >> 1) * 16 + swz / 64; C = (st & 1) * 32 + (swz % 64) / 2; }
__host__ __device__ __forceinline__ int perm32(int rho) { const int n = rho >> 4, i = rho & 15; return 8 * (i >> 2) + 4 * n + (i & 3); }

struct Unit { int pm, pn, pnb; };
struct Gemm { const bf16_t* A; const bf16_t* Bt; int M, N, K; };

struct StaticOrder {
    int nM, nN, nwg, G, c;
    __host__ __device__ void init(int M, int N, int G_, int c_) { nM = M / BM; nN = N / BM; nwg = nM * nN; G = G_; c = c_; }
    __host__ __device__ bool next(int i, Unit& u) const {
        const long L = (long)i * G + c; if (L >= nwg) return false;
        int wgid = (int)L; { const int q = nwg / NXCD, r = nwg % NXCD, xcd = wgid % NXCD, off = wgid / NXCD; wgid = (xcd < r ? xcd * (q + 1) : r * (q + 1) + (xcd - r) * q) + off; }
        const int nig = WGM * nN, gid = wgid / nig, fm = gid * WGM, gsz = (nM - fm) < WGM ? (nM - fm) : WGM;
        u.pm = fm + ((wgid % nig) % gsz); u.pn = (wgid % nig) / gsz; u.pnb = u.pn; return true;
    }
    __device__ __forceinline__ void a_ready(const Unit&) const {}
    __device__ __forceinline__ void done(const Unit&) const {}
};

__device__ __forceinline__ unsigned cvt_pk_bf16(float lo, float hi) { unsigned r; asm volatile("v_cvt_pk_bf16_f32 %0, %1, %2" : "=v"(r) : "v"(lo), "v"(hi)); return r; }
template <class Epi, class Sched, bool ALIGN_EPI = false, bool SP2 = false>
__device__ __forceinline__ void gemm_phase(PG8_LAS unsigned char* lds, const Gemm g, const Sched& S, const Epi& E) {
    const int tid = hw_tid(), wid = __builtin_amdgcn_readfirstlane(tid >> 6), lane = tid & 63, wr = wid >> 2, wc = wid & 3, fr = lane & 15, fq = lane >> 4;
    const int K = g.K, nt = K / BK;
    unsigned voffA[2], voffB[2];
#pragma unroll
    for (int i = 0; i < 2; ++i) { int R, C; stage_rc(tid * 16 + i * 8192, R, C); const int Rb = Epi::PERM ? ((R & ~31) + perm32(R & 31)) : R;
        voffA[i] = (unsigned)(R * K + C) * 2u; voffB[i] = (unsigned)(Rb * K + C) * 2u; }
    const size_t kstep = (size_t)(BK * 2);
    const size_t hstep = (size_t)HALF * K * 2;
    const size_t tstep = 2 * hstep;
    const unsigned ldsw = (unsigned)wid * 1024u;
    const int aoff = lds_byte(wr * 64 + fr, fq * 8), boff = lds_byte(wc * 32 + fr, fq * 8);
#define PG8_SA(b, h) (((b) * 2 + (h)) * HTB)
#define PG8_SB(b, h) ((4 + (b) * 2 + (h)) * HTB)
#define PG8_STAGE(bufoff, gbase, voff) do { _Pragma("unroll") for (int _i = 0; _i < 2; ++_i) \
        __builtin_amdgcn_global_load_lds((const unsigned*)((const char*)(gbase) + (voff)[_i]), (PG8_LAS unsigned*)(lds + (bufoff) + ldsw + _i * 8192), 16, 0, 0); } while (0)
#define PG8_LDA(dst, b, h) do { _Pragma("unroll") for (int m = 0; m < 4; ++m) _Pragma("unroll") for (int k = 0; k < 2; ++k) dst[m][k] = *(const PG8_LAS bf16x8*)(lds + PG8_SA(b, h) + aoff + m * 2048 + k * 1024); } while (0)
#define PG8_LDB(dst, b, h) do { _Pragma("unroll") for (int n = 0; n < 2; ++n) _Pragma("unroll") for (int k = 0; k < 2; ++k) dst[n][k] = *(const PG8_LAS bf16x8*)(lds + PG8_SB(b, h) + boff + n * 2048 + k * 1024); } while (0)
#define PG8_MMA(ai, bj, At, Bt) do { __builtin_amdgcn_s_setprio(1); _Pragma("unroll") for (int m = 0; m < 4; ++m) _Pragma("unroll") for (int n = 0; n < 2; ++n) _Pragma("unroll") for (int k = 0; k < 2; ++k) \
        acc[ai][bj][m][n] = __builtin_amdgcn_mfma_f32_16x16x32_bf16(Bt[n][k], At[m][k], acc[ai][bj][m][n], 0, 0, 0); __builtin_amdgcn_s_setprio(0); } while (0)
#define PG8_WAIT_V(n) asm volatile("s_waitcnt vmcnt(" #n ")" ::: "memory")
#define PG8_WAIT_L(n) asm volatile("s_waitcnt lgkmcnt(" #n ")" ::: "memory")
#define PG8_BAR __builtin_amdgcn_s_barrier()
#define PG8_SCHED __builtin_amdgcn_sched_barrier(0)
    Unit cur, nxt; int ui = 0;
    if (!S.next(0, cur)) return;
    f32x4 acc[2][2][4][2];
#pragma unroll
    for (int a = 0; a < 2; ++a)
#pragma unroll
        for (int b = 0; b < 2; ++b)
#pragma unroll
            for (int m = 0; m < 4; ++m)
#pragma unroll
                for (int n = 0; n < 2; ++n) acc[a][b][m][n] = (f32x4){0.f, 0.f, 0.f, 0.f};
    bf16x8 At[4][2], B0[2][2], B1[2][2];
    const char* cA = (const char*)g.A + (size_t)cur.pm * tstep; const char* cB = (const char*)g.Bt + (size_t)cur.pnb * tstep;
    S.a_ready(cur);
    if constexpr (SP2) {
        PG8_STAGE(PG8_SB(0, 0), cB, voffB); PG8_STAGE(PG8_SB(0, 1), cB + hstep, voffB); PG8_STAGE(PG8_SA(0, 0), cA, voffA); PG8_STAGE(PG8_SA(0, 1), cA + hstep, voffA);
        if (wr == 1) PG8_BAR;
        PG8_WAIT_V(2); PG8_BAR;
        PG8_STAGE(PG8_SB(1, 0), cB + kstep, voffB); PG8_STAGE(PG8_SA(1, 0), cA + kstep, voffA); PG8_STAGE(PG8_SB(1, 1), cB + hstep + kstep, voffB);
        PG8_WAIT_V(6); PG8_BAR;
    } else {
        PG8_STAGE(PG8_SB(0, 0), cB, voffB); PG8_STAGE(PG8_SA(0, 0), cA, voffA); PG8_STAGE(PG8_SB(0, 1), cB + hstep, voffB); PG8_STAGE(PG8_SA(0, 1), cA + hstep, voffA);
        if (wr == 1) PG8_BAR;
        PG8_WAIT_V(4); PG8_BAR;
        PG8_STAGE(PG8_SB(1, 0), cB + kstep, voffB); PG8_STAGE(PG8_SA(1, 0), cA + kstep, voffA); PG8_STAGE(PG8_SB(1, 1), cB + hstep + kstep, voffB);
        PG8_WAIT_V(6); PG8_BAR;
    }
    for (;;) {
        const bool has_next = S.next(ui + 1, nxt);
        const char* nA = has_next ? (const char*)g.A + (size_t)nxt.pm * tstep : cA; const char* nB = has_next ? (const char*)g.Bt + (size_t)nxt.pnb * tstep : cB;
        for (int t = 0; t < nt; t += 2) {
            const bool last = (t == nt - 2);
            const char* a1 = cA + (size_t)(t + 1) * kstep;
            const char* a2 = last ? nA : cA + (size_t)(t + 2) * kstep; const char* b2 = last ? nB : cB + (size_t)(t + 2) * kstep;
            const char* a3 = a2 + kstep; const char* b3 = b2 + kstep;
            if (last && has_next) S.a_ready(nxt);
            if constexpr (SP2) {
            PG8_LDB(B0, 0, 0); PG8_LDB(B1, 0, 1); PG8_SCHED; PG8_LDA(At, 0, 0); PG8_STAGE(PG8_SA(1, 1), a1 + hstep, voffA);
            PG8_WAIT_V(8); PG8_WAIT_L(0); PG8_BAR; PG8_MMA(0, 0, At, B0); PG8_MMA(0, 1, At, B1); PG8_BAR; PG8_SCHED;
            PG8_LDA(At, 0, 1); PG8_STAGE(PG8_SB(0, 0), b2, voffB); PG8_STAGE(PG8_SB(0, 1), b2 + hstep, voffB); PG8_STAGE(PG8_SA(0, 0), a2, voffA);
            PG8_WAIT_V(8); PG8_WAIT_L(0); PG8_BAR; PG8_MMA(1, 0, At, B0); PG8_MMA(1, 1, At, B1); PG8_BAR; PG8_SCHED;
            PG8_LDB(B0, 1, 0); PG8_LDB(B1, 1, 1); PG8_SCHED; PG8_LDA(At, 1, 0); PG8_STAGE(PG8_SA(0, 1), a2 + hstep, voffA);
            PG8_WAIT_V(8); PG8_WAIT_L(0); PG8_BAR; PG8_MMA(0, 0, At, B0); PG8_MMA(0, 1, At, B1); PG8_BAR; PG8_SCHED;
            PG8_LDA(At, 1, 1); PG8_STAGE(PG8_SB(1, 0), b3, voffB); PG8_STAGE(PG8_SB(1, 1), b3 + hstep, voffB); PG8_STAGE(PG8_SA(1, 0), a3, voffA);
            PG8_WAIT_V(8); PG8_WAIT_L(0); PG8_BAR; PG8_MMA(1, 0, At, B0); PG8_MMA(1, 1, At, B1); PG8_BAR; PG8_SCHED;
            } else {
            PG8_LDB(B0, 0, 0); PG8_SCHED; PG8_LDA(At, 0, 0); PG8_STAGE(PG8_SA(1, 1), a1 + hstep, voffA);
            PG8_WAIT_L(8); PG8_BAR; PG8_WAIT_L(0); PG8_MMA(0, 0, At, B0); PG8_BAR; PG8_SCHED;
            PG8_LDB(B1, 0, 1); PG8_STAGE(PG8_SB(0, 0), b2, voffB);
            PG8_BAR; PG8_WAIT_L(0); PG8_MMA(0, 1, At, B1); PG8_BAR;
            PG8_LDA(At, 0, 1); PG8_STAGE(PG8_SA(0, 0), a2, voffA);
            PG8_BAR; PG8_WAIT_L(0); PG8_MMA(1, 0, At, B0); PG8_BAR; PG8_SCHED;
            PG8_STAGE(PG8_SB(0, 1), b2 + hstep, voffB);
            PG8_WAIT_V(6); PG8_BAR; PG8_MMA(1, 1, At, B1); PG8_BAR;
            PG8_LDB(B0, 1, 0); PG8_SCHED; PG8_LDA(At, 1, 0); PG8_STAGE(PG8_SA(0, 1), a2 + hstep, voffA);
            PG8_WAIT_L(8); PG8_BAR; PG8_WAIT_L(0); PG8_MMA(0, 0, At, B0); PG8_BAR; PG8_SCHED;
            PG8_LDB(B1, 1, 1); PG8_STAGE(PG8_SB(1, 0), b3, voffB);
            PG8_BAR; PG8_WAIT_L(0); PG8_MMA(0, 1, At, B1); PG8_BAR;
            PG8_LDA(At, 1, 1); PG8_STAGE(PG8_SA(1, 0), a3, voffA);
            PG8_BAR; PG8_WAIT_L(0); PG8_MMA(1, 0, At, B0); PG8_BAR; PG8_SCHED;
            PG8_STAGE(PG8_SB(1, 1), b3 + hstep, voffB);
            PG8_WAIT_V(6); PG8_BAR; PG8_MMA(1, 1, At, B1); PG8_BAR;
            }
        }
        if constexpr (ALIGN_EPI) { if (wr == 0) PG8_BAR; }
        if constexpr (!Epi::AFTER_DRAIN) { E(acc, cur, wr, wc, fr, fq); S.done(cur); }
        if (!has_next) break;
#pragma unroll
        for (int a = 0; a < 2; ++a)
#pragma unroll
            for (int b = 0; b < 2; ++b)
#pragma unroll
                for (int m = 0; m < 4; ++m)
#pragma unroll
                    for (int n = 0; n < 2; ++n) acc[a][b][m][n] = (f32x4){0.f, 0.f, 0.f, 0.f};
        cur = nxt; cA = nA; cB = nB; ++ui;
        if constexpr (ALIGN_EPI) { if (wr == 1) PG8_BAR; }
    }
    PG8_WAIT_V(0);
    if constexpr (!ALIGN_EPI) { if (wr == 0) PG8_BAR; }
    PG8_BAR;
    if constexpr (Epi::AFTER_DRAIN) { E.fused(acc, cur, wr, wc, fr, fq, lds, wid, lane); S.done(cur); }
#undef PG8_SA
#undef PG8_SB
#undef PG8_STAGE
#undef PG8_LDA
#undef PG8_LDB
#undef PG8_MMA
#undef PG8_WAIT_V
#undef PG8_WAIT_L
#undef PG8_BAR
#undef PG8_SCHED
}
}
namespace pg8 {
struct EpiBf16 {
    static constexpr bool PERM = true, AFTER_DRAIN = false;
    bf16_t* O; int ldc;
    __device__ __forceinline__ void operator()(const f32x4 (&acc)[2][2][4][2], const Unit& u, int wr, int wc, int fr, int fq) const {
        const int row0 = u.pm * BM + wr * 64 + fr; const int col0 = u.pn * BM + wc * 32 + 8 * fq;
#pragma unroll
        for (int ai = 0; ai < 2; ++ai)
#pragma unroll
            for (int m = 0; m < 4; ++m) { bf16_t* rowp = O + (size_t)(row0 + ai * HALF + m * 16) * ldc + col0;
#pragma unroll
                for (int bj = 0; bj < 2; ++bj) { const f32x4 v0 = acc[ai][bj][m][0], v1 = acc[ai][bj][m][1];
                    u32x4 w; w.x = cvt_pk_bf16(v0[0], v0[1]); w.y = cvt_pk_bf16(v0[2], v0[3]); w.z = cvt_pk_bf16(v1[0], v1[1]); w.w = cvt_pk_bf16(v1[2], v1[3]);
                    *(u32x4*)(rowp + bj * HALF) = w; } }
    }
};
struct EpiSwiGLU {
    static constexpr bool PERM = true, AFTER_DRAIN = false;
    bf16_t* O; int ldc;
    __device__ __forceinline__ void operator()(const f32x4 (&acc)[2][2][4][2], const Unit& u, int wr, int wc, int fr, int fq) const {
        const int row0 = u.pm * BM + wr * 64 + fr; const int col0 = u.pn * HALF + wc * 32 + 8 * fq;
#pragma unroll
        for (int ai = 0; ai < 2; ++ai)
#pragma unroll
            for (int m = 0; m < 4; ++m) { bf16_t* rowp = O + (size_t)(row0 + ai * HALF + m * 16) * ldc + col0;
                float r[8];
#pragma unroll
                for (int n = 0; n < 2; ++n)
#pragma unroll
                    for (int j = 0; j < 4; ++j) { const float a = acc[ai][0][m][n][j], b = acc[ai][1][m][n][j]; r[n * 4 + j] = a * b * __builtin_amdgcn_rcpf(1.0f + __expf(-a)); }
                u32x4 w; w.x = cvt_pk_bf16(r[0], r[1]); w.y = cvt_pk_bf16(r[2], r[3]); w.z = cvt_pk_bf16(r[4], r[5]); w.w = cvt_pk_bf16(r[6], r[7]);
                *(u32x4*)rowp = w; }
    }
};
struct MoeOrder {
    const PG8_LAS int* pref; int nN, G, c, total;
    __device__ __forceinline__ void init(const PG8_LAS int* pref_, int nN_, int G_, int c_) { pref = pref_; nN = nN_; G = G_; c = c_; total = pref_[32] * nN_; }
    __device__ __forceinline__ bool next(int i, Unit& u) const {
        const int L = i * G + c; if (L >= total) return false;
        const int rt = L / nN, pn = L - rt * nN; int e = 0;
#pragma unroll 1
        for (int k = 1; k < 32; ++k) e += (pref[k] <= rt) ? 1 : 0;
        u.pm = rt; u.pn = pn; u.pnb = e * nN + pn; return true;
    }
    __device__ __forceinline__ void a_ready(const Unit&) const {}
    __device__ __forceinline__ void done(const Unit&) const {}
};
}
#define XB_TMO      128
#define XB_XCNT(j)  (256  + 64 * (j))
#define XB_XSUB(j)  (1280 + 64 * (j))
#define XB_XGEN(j)  (2304 + 64 * (j))
#define XB_TOP      3328
#define XB_TOPGEN   3392
#define XCD_BAR_WORDS 3456
#define XB_SPIN_CAP (1u << 22)

__device__ __forceinline__ unsigned xb_ld(unsigned* p)              { return __hip_atomic_load(p, __ATOMIC_RELAXED, __HIP_MEMORY_SCOPE_AGENT); }
__device__ __forceinline__ unsigned xb_add(unsigned* p, unsigned v) { return __hip_atomic_fetch_add(p, v, __ATOMIC_RELAXED, __HIP_MEMORY_SCOPE_AGENT); }
__device__ __forceinline__ unsigned xb_xcc_id() { return (unsigned)__builtin_amdgcn_s_getreg((3 << 11) | 20) & 0xFu; }
#define XB_SPIN(cond, bar) do { unsigned _sp = 0; while (cond) { __builtin_amdgcn_s_sleep(1); \
    if ((++_sp & 255u) == 0u) { if (xb_ld(&(bar)[XB_TMO])) break; if (_sp > XB_SPIN_CAP) { atomicAdd(&(bar)[XB_TMO], 1u); break; } } } } while (0)

struct XcdBarrier {
    unsigned* bar; unsigned x;
    volatile LAS unsigned* st;
};

__device__ __forceinline__ XcdBarrier xcd_barrier_post(unsigned* bar, volatile LAS unsigned* st) {
    XcdBarrier b; b.bar = bar; b.x = xb_xcc_id(); b.st = st;
    if (hw_tid() == 0) (void)xb_add(&bar[XB_XCNT(b.x)], 1u);
    return b;
}
__device__ __forceinline__ void xcd_barrier_complete(unsigned* bar, unsigned x, unsigned& nloc, unsigned& nx) {
    const unsigned G = gridDim.x * gridDim.y * gridDim.z;
    unsigned sum, cnt, mine, sp = 0u;
    for (;;) {
        sum = 0u; cnt = 0u; mine = 0u;
#pragma unroll
        for (unsigned j = 0; j < 16; ++j) { const unsigned c = xb_ld(&bar[XB_XCNT(j)]); sum += c; cnt += (c > 0u) ? 1u : 0u; mine = (j == x) ? c : mine; }
        if (sum == G) break;
        __builtin_amdgcn_s_sleep(1);
        if ((++sp & 255u) == 0u) { if (xb_ld(&bar[XB_TMO])) break; if (sp > XB_SPIN_CAP) { atomicAdd(&bar[XB_TMO], 1u); break; } }
    }
    nloc = mine > 0u ? mine : 1u; nx = cnt > 0u ? cnt : 1u;
}

__device__ __forceinline__ void xcd_barrier(const XcdBarrier& b) {
    asm volatile("s_waitcnt vmcnt(0)" ::: "memory");
    __syncthreads();
    if (hw_tid() == 0) {
        unsigned* bar = b.bar;
        __builtin_amdgcn_s_waitcnt(0);
        unsigned nloc = b.st[0], nx = b.st[1];
        if (nloc == 0u) { xcd_barrier_complete(bar, b.x, nloc, nx); b.st[0] = nloc; b.st[1] = nx; }
        const unsigned old = xb_add(&bar[XB_XSUB(b.x)], 1u);
        const unsigned gen = old / nloc;
        if (old + 1u == (gen + 1u) * nloc) {
            __builtin_amdgcn_fence(__ATOMIC_RELEASE, "agent");
            asm volatile("s_waitcnt vmcnt(0)" ::: "memory");
            const unsigned og = xb_add(&bar[XB_TOP], 1u);
            const unsigned tg = og / nx;
            if (og + 1u == (tg + 1u) * nx) xb_add(&bar[XB_TOPGEN], 1u);
            else XB_SPIN(xb_ld(&bar[XB_TOPGEN]) == tg, bar);
            __builtin_amdgcn_fence(__ATOMIC_ACQUIRE, "agent");
            xb_add(&bar[XB_XGEN(b.x)], 1u);
            asm volatile("s_waitcnt vmcnt(0)" ::: "memory");
        } else {
            XB_SPIN(xb_ld(&bar[XB_XGEN(b.x)]) == gen, bar);
            __builtin_amdgcn_fence(__ATOMIC_ACQUIRE, "agent");
            asm volatile("s_waitcnt vmcnt(0)" ::: "memory");
        }
    }
    __syncthreads();
}
struct Args { const float* in[30]; float* out; unsigned char* ws; int ph_lo, ph_hi; };
#define CAS __attribute__((address_space(4)))
struct KA { const CAS unsigned char* kp;
    __device__ __forceinline__ const float* in(int i) const { return *(const float* const CAS*)(kp + 8 * i); }
    __device__ __forceinline__ float* out() const { return *(float* const CAS*)(kp + 240); }
    __device__ __forceinline__ unsigned char* ws() const { return *(unsigned char* const CAS*)(kp + 248); } };
__device__ __forceinline__ KA ka_get() { const CAS unsigned char* kp = (const CAS unsigned char*)__builtin_amdgcn_kernarg_segment_ptr(); asm volatile("" : "+s"(kp)); return KA{kp}; }
__device__ __forceinline__ int opaque_tid() { return hw_tid(); }
static_assert(sizeof(Args) == 264, "kernarg layout");
enum { I_X = 0, I_C, I_CTX, I_CCTX, I_ADAW, I_ADAB, I_WIN, I_RPB, I_MUP, I_MUN, I_W0, I_W2, I_A0, I_A2, I_G2, I_KK, I_KA, I_RK, I_GNG, I_GNB, I_WOUT, I_LN1G, I_LN1B, I_LN2G, I_LN2B, I_RW, I_RB, I_EW1, I_EW3, I_EW2 };

__device__ __forceinline__ void transpose_item(const float* W, int N, int k0, int n0, bf16* WT, int ldk, int drow0, LAS float* scr, int lane) {
#pragma unroll 8
    for (int i = 0; i < 32; ++i) { const int kk = 2 * i + (lane >> 5); scr[kk * 33 + (lane & 31)] = W[(size_t)(k0 + kk) * N + n0 + (lane & 31)]; }
    LDS_WAIT(); asm volatile("" ::: "memory");
    const int c = lane & 7;
#pragma unroll
    for (int j = 0; j < 4; ++j) { const int n = (lane >> 3) + 8 * j; const LAS float* s = scr + (8 * c) * 33 + n;
        v4u o; o.x = pk2(s[0 * 33], s[1 * 33]); o.y = pk2(s[2 * 33], s[3 * 33]); o.z = pk2(s[4 * 33], s[5 * 33]); o.w = pk2(s[6 * 33], s[7 * 33]);
        *(GAS v4u*)(WT + (size_t)(drow0 + n) * ldk + k0 + 8 * c) = o; }
    LDS_WAIT(); asm volatile("" ::: "memory");
}

__device__ __forceinline__ void phase_prologue(LAS unsigned char* lds) {
    const KA a = ka_get();
    const int tid = opaque_tid(), lane = tid & 63, wave = __builtin_amdgcn_readfirstlane(tid >> 6), G = gridDim.x, bid = blockIdx.x;
    const int gw = bid * 8 + wave, NGW = G * 8;
    bf16* WINT = (bf16*)(a.ws() + WS_WINT); bf16* WOT = (bf16*)(a.ws() + WS_WOT);
    LAS float* scr = (LAS float*)(lds + wave * 16384);
    constexpr int I_IN = 16 * 103, I_OUT = 16 * 32, I_L = I_IN + I_OUT;
    for (int it = gw; it < 2 * I_L; it += NGW) {
        const int l = it / I_L; int r = it - l * I_L;
        if (r < I_IN) { const int kb = r / 103, nb = r - kb * 103; transpose_item(a.in(I_WIN) + (size_t)l * DM * DIN, DIN, 64 * kb, 32 * nb, WINT + (size_t)l * DINP * DM, DM, 32 * nb, scr, lane); }
        else { r -= I_IN; const int kb = r >> 5, nb = r & 31; transpose_item(a.in(I_WOUT) + (size_t)l * DM * DM, DM, 64 * kb, 32 * nb, WOT + (size_t)l * DM * DM, DM, 32 * nb, scr, lane); }
    }
    for (int i = bid * 512 + tid; i < 8192; i += G * 512) { const int l = i >> 12, r = i & 4095; *(GAS v4u*)(WINT + (size_t)l * DINP * DM + (size_t)DIN * DM + (size_t)r * 8) = (v4u){0u, 0u, 0u, 0u}; }
    { float* rp = (float*)(a.ws() + WS_ROPE); const int i = bid * 512 + tid;
      if (i < 1536) { const int idx = i < 512 ? i : i - 512; const int p = idx >> 4, f = idx & 15; const double inv = exp(-(double)f * (9.210340371976184 / 16.0)); const double ang = (double)p * inv;
          const float cs = (float)cos(ang), sn = (float)sin(ang); if (i < 512) { rp[idx] = cs; rp[512 + idx] = sn; } else { rp[1024 + idx] = cs; rp[2048 + idx] = sn; } } }
    __syncthreads();
    LAS float* sl = (LAS float*)lds; LAS float* red = (LAS float*)(lds + 69632);
    for (int i = tid; i < 17 * 1024; i += 512) { const int r = i >> 10, k = i & 1023; const float v = r < 16 ? a.in(I_C)[r * 1024 + k] : a.in(I_CCTX)[k]; sl[i] = v / (1.0f + expf(-v)); }
    __syncthreads();
    float* mods = (float*)(a.ws() + WS_MODS);
    for (int it = bid; it < 192; it += G) {
        const int l = it / 96, ch = it - l * 96; const int kq = tid >> 6, cl = tid & 63, col = ch * 64 + cl;
        const float* W = a.in(I_ADAW) + (size_t)l * DM * 6144 + col;
        float acc[17];
#pragma unroll
        for (int r = 0; r < 17; ++r) acc[r] = 0.f;
        for (int k0 = kq * 128; k0 < kq * 128 + 128; k0 += 8) { float w8[8];
#pragma unroll
            for (int q = 0; q < 8; ++q) w8[q] = W[(size_t)(k0 + q) * 6144];
#pragma unroll
            for (int r = 0; r < 17; ++r) { const f32x4 s0 = *(const LAS f32x4*)(sl + r * 1024 + k0), s1 = *(const LAS f32x4*)(sl + r * 1024 + k0 + 4);
                acc[r] += s0.x * w8[0] + s0.y * w8[1] + s0.z * w8[2] + s0.w * w8[3] + s1.x * w8[4] + s1.y * w8[5] + s1.z * w8[6] + s1.w * w8[7]; } }
#pragma unroll
        for (int r = 0; r < 17; ++r) red[(kq * 17 + r) * 64 + cl] = acc[r];
        __syncthreads();
        for (int i = tid; i < 17 * 64; i += 512) { const int r = i >> 6, c2 = i & 63; float s = 0.f;
#pragma unroll
            for (int q = 0; q < 8; ++q) s += red[(q * 17 + r) * 64 + c2];
            mods[((size_t)l * 17 + r) * 6144 + ch * 64 + c2] = s + a.in(I_ADAB)[l * 6144 + ch * 64 + c2]; }
        __syncthreads();
    }
}

__device__ __forceinline__ void phase_modconv(LAS unsigned char* lds, int l) {
    const KA a = ka_get();
    const int tid = opaque_tid(), lane = tid & 63, wave = __builtin_amdgcn_readfirstlane(tid >> 6), G = gridDim.x, bid = blockIdx.x;
    const int gw = bid * 8 + wave, NGW = G * 8;
    const float* mods = (const float*)(a.ws() + WS_MODS) + (size_t)l * 17 * 6144;
    bf16* XM = (bf16*)(a.ws() + WS_X1);
    const float* xs = a.in(I_X); const float* cs = a.in(I_CTX);
    for (int m = gw; m < NTOK; m += NGW) {
        const float* src; int mr;
        if (m < NTX) { src = xs + (size_t)m * DM; mr = m / SEQ; } else { src = cs + (size_t)(m - NTX) * DM; mr = 16; }
        const GAS f32x4* xr = (const GAS f32x4*)src + lane; const GAS f32x4* sh = (const GAS f32x4*)(mods + (size_t)mr * 6144) + lane; const GAS f32x4* sc = sh + 256;
        GAS v2u* o8 = (GAS v2u*)(XM + (size_t)m * DM) + lane;
#pragma unroll
        for (int j = 0; j < 4; ++j) { const f32x4 v = xr[64 * j], s = sh[64 * j], c = sc[64 * j]; const f32x4 r = v * (c + 1.0f) + s; v2u w; w.x = pk2(r.x, r.y); w.y = pk2(r.z, r.w); o8[64 * j] = w; }
    }
}

__device__ __forceinline__ void phase_scan_direct(LAS unsigned char* lds, int l) {
    const KA a = ka_get();
    constexpr int TB = 32;
    const int tid = opaque_tid(), lane = tid & 63, wv = __builtin_amdgcn_readfirstlane(tid >> 6);
    LAS float* ops = (LAS float*)lds;
    LAS float* scal = (LAS float*)(lds + 49152);
    LAS float* zl = (LAS float*)(lds + 49664);
    LAS float* rkraw = (LAS float*)(lds + 57856);
    LAS float* ybuf = (LAS float*)(lds + 74240);
    const bf16* PX = (const bf16*)(a.ws() + WS_X2); float* YD = (float*)(a.ws() + WS_X3); float* BON = (float*)(a.ws() + WS_BONUS); const float* rope = (const float*)(a.ws() + WS_ROPE);
    const float* mup = a.in(I_MUP) + l * 1760; const float* mun = a.in(I_MUN) + l * 1760;
    for (int chain = blockIdx.x; chain < 256; chain += gridDim.x) {
        const int b = chain >> 4, h = (chain >> 1) & 7, d = chain & 1, c = lane;
        float w2c[32], a2c[32];
#pragma unroll
        for (int j = 0; j < 32; ++j) { w2c[j] = a.in(I_W2)[((size_t)(l * 2 + d) * 32 + j) * 512 + h * 64 + c]; a2c[j] = a.in(I_A2)[((size_t)(l * 2 + d) * 32 + j) * 512 + h * 64 + c]; }
        const float w0c = a.in(I_W0)[(l * 2 + d) * 512 + h * 64 + c], a0c = a.in(I_A0)[(l * 2 + d) * 512 + h * 64 + c];
        const float kkc = a.in(I_KK)[l * 512 + h * 64 + c], kac = a.in(I_KA)[l * 512 + h * 64 + c], rkc = a.in(I_RK)[l * 512 + h * 64 + c];
        const int colr = h * 64 + c, colk = 512 + colr, colv = 1024 + colr, coll = (c < 32) ? (1536 + d * 32 + c) : (1600 + d * 32 + (c - 32));
        const float mpr = mup[colr], mnr = mun[colr], mpk = mup[colk], mnk = mun[colk], mpv = mup[colv], mnv = mun[colv], mpl = mup[coll], mnl = mun[coll];
        float S[8];
#pragma unroll
        for (int j = 0; j < 8; ++j) S[j] = 0.f;
        const int vl = lane >> 3, kq = lane & 7, vrow = 8 * wv + vl;
        for (int seq = 0; seq < 2; ++seq) {
            const int T = seq ? SEQ : CTXL, rowbase = seq ? b * SEQ : NTX + b * CTXL, nblk = T / TB;
            for (int bi = 0; bi < nblk; ++bi) {
                const int tb = d ? (nblk - 1 - bi) : bi, t0 = tb * TB;
                float zv[4];
#pragma unroll
                for (int i = 0; i < 4; ++i) {
                    const int tl = wv + 8 * i, t = t0 + tl; const bf16* p = PX + (size_t)(rowbase + t) * DINP + RWOFF;
                    const bool hp = t > 0, hn = t + 1 < T;
                    const float cr = bf2f(p[colr]), ck = bf2f(p[colk]), cv = bf2f(p[colv]), cl_ = bf2f(p[coll]);
                    const float pr = hp ? bf2f(p[colr - DINP]) : 0.f, pk = hp ? bf2f(p[colk - DINP]) : 0.f, pv = hp ? bf2f(p[colv - DINP]) : 0.f, pl = hp ? bf2f(p[coll - DINP]) : 0.f;
                    const float nr = hn ? bf2f(p[colr + DINP]) : 0.f, nk = hn ? bf2f(p[colk + DINP]) : 0.f, nv = hn ? bf2f(p[colv + DINP]) : 0.f, nl = hn ? bf2f(p[coll + DINP]) : 0.f;
                    const float zr = cr + mpr * (pr - cr) + mnr * (nr - cr), zk = ck + mpk * (pk - ck) + mnk * (nk - ck);
                    zv[i] = cv + mpv * (pv - cv) + mnv * (nv - cv);
                    const float zz = cl_ + mpl * (pl - cl_) + mnl * (nl - cl_);
                    rkraw[tl * 128 + c] = zr; rkraw[tl * 128 + 64 + c] = zk; zl[tl * 64 + c] = (c < 32) ? tanhf(zz) : zz;
                }
                __syncthreads();
#pragma unroll
                for (int i = 0; i < 4; ++i) {
                    const int tl = wv + 8 * i, t = t0 + tl;
                    float r = rkraw[tl * 128 + c], k = rkraw[tl * 128 + 64 + c];
                    if (seq) { const float rp = rkraw[tl * 128 + (c ^ 16)], kp = rkraw[tl * 128 + 64 + (c ^ 16)]; const int qd = c >> 4, f = c & 15;
                        const int ti = (qd < 2) ? ((t >> 6) * 16 + f) : (1024 + (t & 63) * 16 + f); const float cs = rope[ti], sn = rope[ti + ((qd < 2) ? 512 : 1024)];
                        const float sg = (qd & 1) ? sn : -sn; r = r * cs + rp * sg; k = k * cs + kp * sg; }
                    const float kkr = k * kkc; const float ss = wave_sum(kkr * kkr); const float kk = kkr / fmaxf(sqrtf(ss), 1e-12f);
                    float u = w0c, av = a0c;
#pragma unroll
                    for (int j = 0; j < 32; j += 4) { const f32x4 z1 = *(const LAS f32x4*)(zl + tl * 64 + j), z2 = *(const LAS f32x4*)(zl + tl * 64 + 32 + j);
                        u += z1.x * w2c[j] + z1.y * w2c[j + 1] + z1.z * w2c[j + 2] + z1.w * w2c[j + 3]; av += z2.x * a2c[j] + z2.y * a2c[j + 1] + z2.z * a2c[j + 2] + z2.w * a2c[j + 3]; }
                    const float w = expf(-0.6065306597126334f * sigmoidf_(u)), aa = sigmoidf_(av);
                    const float kd = k * (1.0f + (aa - 1.0f) * kac), nb = -kk * aa;
                    const float c1 = wave_sum(nb * r), c2 = wave_sum(kd * r), bon = wave_sum(r * kd * rkc);
                    LAS float* o = ops + tl * 384 + c; o[0] = kk; o[64] = w * r; o[128] = w; o[192] = nb; o[256] = kd; o[320] = zv[i];
                    if (lane == 0) { scal[tl * 4] = c1; scal[tl * 4 + 1] = c2; BON[((size_t)d * NTOK + rowbase + t) * 8 + h] = bon; }
                }
                __syncthreads();
#pragma unroll 2
                for (int s = 0; s < TB; ++s) {
                    const int tl = d ? (TB - 1 - s) : s; const LAS float* o = ops + tl * 384 + kq * 8;
                    const f32x4 ka = *(const LAS f32x4*)(o), kb = *(const LAS f32x4*)(o + 4), ra = *(const LAS f32x4*)(o + 64), rb = *(const LAS f32x4*)(o + 68);
                    const f32x4 wa = *(const LAS f32x4*)(o + 128), wb = *(const LAS f32x4*)(o + 132), na = *(const LAS f32x4*)(o + 192), nb_ = *(const LAS f32x4*)(o + 196);
                    const f32x4 da = *(const LAS f32x4*)(o + 256), db = *(const LAS f32x4*)(o + 260);
                    const float vv = ops[tl * 384 + 320 + vrow], c1 = scal[tl * 4], c2 = scal[tl * 4 + 1];
                    float sk = S[0] * ka.x + S[1] * ka.y + S[2] * ka.z + S[3] * ka.w + S[4] * kb.x + S[5] * kb.y + S[6] * kb.z + S[7] * kb.w;
                    float yy = S[0] * ra.x + S[1] * ra.y + S[2] * ra.z + S[3] * ra.w + S[4] * rb.x + S[5] * rb.y + S[6] * rb.z + S[7] * rb.w;
                    sk = red8(sk); yy = red8(yy);
                    const float y = yy + sk * c1 + vv * c2;
                    S[0] = S[0] * wa.x + sk * na.x + vv * da.x; S[1] = S[1] * wa.y + sk * na.y + vv * da.y; S[2] = S[2] * wa.z + sk * na.z + vv * da.z; S[3] = S[3] * wa.w + sk * na.w + vv * da.w;
                    S[4] = S[4] * wb.x + sk * nb_.x + vv * db.x; S[5] = S[5] * wb.y + sk * nb_.y + vv * db.y; S[6] = S[6] * wb.z + sk * nb_.z + vv * db.z; S[7] = S[7] * wb.w + sk * nb_.w + vv * db.w;
                    if (kq == 0) ybuf[tl * 64 + vrow] = y;
                }
                __syncthreads();
#pragma unroll
                for (int i = 0; i < 4; ++i) { const int tl = wv + 8 * i; YD[((size_t)d * NTOK + rowbase + t0 + tl) * 512 + h * 64 + c] = ybuf[tl * 64 + c]; }
            }
        }
        __syncthreads();
    }
}

typedef short v4i16_t __attribute__((ext_vector_type(4)));
__device__ __forceinline__ int swz_off(int row, int chunk) { return row * 128 + ((chunk ^ (row & 7)) << 4); }
__device__ __forceinline__ void stage_rows(LAS unsigned char* dst, const bf16* src, int nrows, int tid) {
    for (int idx = tid; idx < nrows * 8; idx += 512) { const int r = idx >> 3, ch = idx & 7; const v4u v = *(const GAS v4u*)(src + (size_t)r * DINP + ch * 8); *(LAS v4u*)(dst + swz_off(r, ch)) = v; }
}
__device__ __forceinline__ bf16x8 q_scale8(bf16x8 q) { const v4u w = __builtin_bit_cast(v4u, q); v4u r;
    r.x = pk2(bflo(w.x) * 0.125f, bfhi(w.x) * 0.125f); r.y = pk2(bflo(w.y) * 0.125f, bfhi(w.y) * 0.125f); r.z = pk2(bflo(w.z) * 0.125f, bfhi(w.z) * 0.125f); r.w = pk2(bflo(w.w) * 0.125f, bfhi(w.w) * 0.125f);
    return __builtin_bit_cast(bf16x8, r); }
struct AttState { float m, l; f32x4 o[4]; };
struct AttOff { int k[2]; int v[4]; int boff; unsigned okm; };
__device__ __forceinline__ AttOff att_offsets(int lane, int wc0, int qc, int cs) { AttOff o; const int kl = lane & 15, g = lane >> 4, q_ = kl >> 2, p_ = kl & 3;
#pragma unroll
    for (int dh = 0; dh < 2; ++dh) o.k[dh] = swz_off(kl, dh * 4 + g);
#pragma unroll
    for (int dt = 0; dt < 4; ++dt) o.v[dt] = swz_off(4 * g + q_, 2 * dt + (p_ >> 1)) + (p_ & 1) * 8;
    o.boff = (wc0 + 4 * g - qc + 15) * 4; o.okm = 0u;
#pragma unroll
    for (int j = 0; j < 8; ++j) { const int kc = wc0 + (j >> 2) * 16 + 4 * g + (j & 3); if ((kc >= cs) && (kc < cs + 16)) o.okm |= 1u << j; }
    return o; }
template <bool LOCAL>
__device__ __forceinline__ void att_kstep(AttState& st, const LAS unsigned char* kb, const LAS unsigned char* vb, int r0, const bf16x8 (&qf)[2], int lane, const AttOff& ao, const LAS float* rpbrow) {
    const LAS unsigned char* kr = kb + r0 * 128; const LAS unsigned char* vr = vb + r0 * 128;
    f32x4 s0 = {0.f, 0.f, 0.f, 0.f}, s1 = {0.f, 0.f, 0.f, 0.f};
#pragma unroll
    for (int dh = 0; dh < 2; ++dh) {
        const bf16x8 k0 = *(const LAS bf16x8*)(kr + ao.k[dh]); const bf16x8 k1 = *(const LAS bf16x8*)(kr + ao.k[dh] + 2048);
        s0 = __builtin_amdgcn_mfma_f32_16x16x32_bf16(k0, qf[dh], s0, 0, 0, 0); s1 = __builtin_amdgcn_mfma_f32_16x16x32_bf16(k1, qf[dh], s1, 0, 0, 0);
    }
    float sc[8];
#pragma unroll
    for (int j = 0; j < 4; ++j) { sc[j] = s0[j]; sc[4 + j] = s1[j]; }
    if (LOCAL) {
        float bv[8]; const unsigned ad = (unsigned)(uintptr_t)rpbrow + (unsigned)ao.boff;
#pragma unroll
        for (int j = 0; j < 8; ++j) asm volatile("ds_read_b32 %0, %1 offset:%2" : "=v"(bv[j]) : "v"(ad), "i"(((j >> 2) * 16 + (j & 3)) * 4));
        asm volatile("s_waitcnt lgkmcnt(0)" : "+v"(bv[0]), "+v"(bv[1]), "+v"(bv[2]), "+v"(bv[3]), "+v"(bv[4]), "+v"(bv[5]), "+v"(bv[6]), "+v"(bv[7]) :: "memory");
#pragma unroll
        for (int j = 0; j < 8; ++j) sc[j] = ((ao.okm >> j) & 1u) ? sc[j] + bv[j] : -INFINITY;
    }
    float mt = fmaxf(fmaxf(fmaxf(sc[0], sc[1]), fmaxf(sc[2], sc[3])), fmaxf(fmaxf(sc[4], sc[5]), fmaxf(sc[6], sc[7])));
    mt = fmaxf(mt, shx(mt, 16, lane)); mt = fmaxf(mt, shx(mt, 32, lane));
    if (__any(mt > st.m)) {
        const float mn = fmaxf(st.m, mt); const float scale = (mn == -INFINITY) ? 1.0f : __expf(st.m - mn); st.l *= scale; st.m = mn;
#pragma unroll
        for (int dt = 0; dt < 4; ++dt) st.o[dt] = st.o[dt] * scale; }
    float p[8], ps = 0.f; const float mref = (st.m == -INFINITY) ? 0.f : st.m;
#pragma unroll
    for (int j = 0; j < 8; ++j) { p[j] = __expf(sc[j] - mref); ps += p[j]; }
    st.l += ps;
    v4u pw; pw.x = pk2(p[0], p[1]); pw.y = pk2(p[2], p[3]); pw.z = pk2(p[4], p[5]); pw.w = pk2(p[6], p[7]);
    const bf16x8 pf = __builtin_bit_cast(bf16x8, pw);
#pragma unroll
    for (int dt = 0; dt < 4; ++dt) {
        const v4i16_t lo = __builtin_amdgcn_ds_read_tr16_b64_v4i16((LAS v4i16_t*)(vr + ao.v[dt]));
        const v4i16_t hi = __builtin_amdgcn_ds_read_tr16_b64_v4i16((LAS v4i16_t*)(vr + ao.v[dt] + 2048));
        const bf16x8 vf = (bf16x8){lo[0], lo[1], lo[2], lo[3], hi[0], hi[1], hi[2], hi[3]};
        st.o[dt] = __builtin_amdgcn_mfma_f32_16x16x32_bf16(vf, pf, st.o[dt], 0, 0, 0);
    }
}
__device__ __forceinline__ void att_merge_store(AttState& st, LAS float* mrg, int qb, int kh, int lane, bf16* orow0  ) {
    LAS float* mine = mrg + qb * (18 * 64) + lane;
    if (kh == 1) { mine[0] = st.m; mine[64] = st.l;
#pragma unroll
        for (int dt = 0; dt < 4; ++dt)
#pragma unroll
            for (int j = 0; j < 4; ++j) mine[(2 + dt * 4 + j) * 64] = st.o[dt][j]; }
    __syncthreads();
    if (kh == 0) {
        const float m1 = mine[0], l1 = mine[64]; const float ms = fmaxf(st.m, m1); const float f0 = __expf(st.m - ms), f1 = __expf(m1 - ms);
        float lc = st.l * f0 + l1 * f1; lc += shx(lc, 16, lane); lc += shx(lc, 32, lane); const float inv = 1.0f / lc;
        const int q = lane & 15, g = lane >> 4;
#pragma unroll
        for (int dt = 0; dt < 4; ++dt) { float r[4];
#pragma unroll
            for (int j = 0; j < 4; ++j) r[j] = (st.o[dt][j] * f0 + mine[(2 + dt * 4 + j) * 64] * f1) * inv;
            v2u w; w.x = pk2(r[0], r[1]); w.y = pk2(r[2], r[3]); *(GAS v2u*)(orow0 + (size_t)q * DM + dt * 16 + 4 * g) = w; }
    }
}
__device__ __forceinline__ void phase_attn(LAS unsigned char* lds, int l) {
    const KA a = ka_get();
    const int tid = opaque_tid(), lane = tid & 63, wv = __builtin_amdgcn_readfirstlane(tid >> 6), qb = wv & 3, kh = wv >> 2;
    LAS unsigned char* KC = lds; LAS unsigned char* VC = lds + 32768; LAS unsigned char* KL = lds + 65536; LAS unsigned char* VL = lds + 98304;
    LAS float* RPB = (LAS float*)(lds + LDSCTL_OFF + 2048); LAS float* mrg = (LAS float*)KL;
    const bf16* PX = (const bf16*)(a.ws() + WS_X2); bf16* CAT = (bf16*)(a.ws() + WS_X1);
    for (int blk = blockIdx.x; blk < 256; blk += gridDim.x) {
        const int bh = blk >> 1, b = bh >> 3, h = bh & 7, half = blk & 1;
        __syncthreads();
        const bf16* ctxrow = PX + (size_t)(NTX + b * CTXL) * DINP + h * 64;
        stage_rows(KC, ctxrow + 512, 256, tid); stage_rows(VC, ctxrow + 1024, 256, tid);
        for (int i = tid; i < 465; i += 512) RPB[i] = a.in(I_RPB)[((size_t)l * 8 + h) * 465 + i];
        __syncthreads();
        const int kl = lane & 15, g = lane >> 4;
        const AttOff ao = att_offsets(lane, min(max(qb * 16 - 8, 0), 32), qb * 16 + kl, min(max(qb * 16 + kl - 8, 0), 48));
        if (l == 0) {
            for (int rr = 0; rr < 2; ++rr) {
                const int q0 = (half * 8 + rr * 4 + qb) * 16; const bf16* qrow = ctxrow + (size_t)(q0 + kl) * DINP;
                bf16x8 qf[2]; qf[0] = q_scale8(*(const GAS bf16x8*)(qrow + 8 * g)); qf[1] = q_scale8(*(const GAS bf16x8*)(qrow + 32 + 8 * g));
                AttState st; st.m = -INFINITY; st.l = 0.f;
#pragma unroll
                for (int dt = 0; dt < 4; ++dt) st.o[dt] = (f32x4){0.f, 0.f, 0.f, 0.f};
                for (int s = 0; s < 4; ++s) att_kstep<false>(st, KC, VC, kh * 128 + s * 32, qf, lane, ao, RPB);
                att_merge_store(st, mrg, qb, kh, lane, CAT + (size_t)(NTX + b * CTXL + q0) * DM + h * 64);
                __syncthreads();
            }
        }
        v4u pfk0[4], pfv0[4], pfk1[4], pfv1[4];
#define ATT_ISSUE(SIDX, pfk, pfv) do { const int i_ = half * 16 + ((SIDX) >> 1); const int rs_ = min(max(i_ - 4, 0), 24); const bf16* lr_ = PX + (size_t)(b * SEQ + (rs_ + 4 * ((SIDX) & 1)) * 64) * DINP + h * 64; \
            _Pragma("unroll") for (int q__ = 0; q__ < 4; ++q__) { const int idx_ = tid + 512 * q__; const bf16* p_ = lr_ + (size_t)(idx_ >> 3) * DINP + (idx_ & 7) * 8; pfk[q__] = *(const GAS v4u*)(p_ + 512); pfv[q__] = *(const GAS v4u*)(p_ + 1024); } } while (0)
        ATT_ISSUE(0, pfk0, pfv0); ATT_ISSUE(1, pfk1, pfv1);
        bf16x8 qn[2]; { const bf16* qrow = PX + (size_t)(b * SEQ + (half * 16) * 64 + qb * 16 + kl) * DINP + h * 64; qn[0] = *(const GAS bf16x8*)(qrow + 8 * g); qn[1] = *(const GAS bf16x8*)(qrow + 32 + 8 * g); }
        for (int ui = 0; ui < 16; ++ui) {
            const int i = half * 16 + ui; const int rs = min(max(i - 4, 0), 24);
            const int qc = qb * 16 + kl, cs = min(max(qc - 8, 0), 48), wc0 = min(max(qb * 16 - 8, 0), 32);
            bf16x8 qf[2]; qf[0] = q_scale8(qn[0]); qf[1] = q_scale8(qn[1]);
            { const int in_ = half * 16 + (ui < 15 ? ui + 1 : ui); const bf16* qrow = PX + (size_t)(b * SEQ + in_ * 64 + qc) * DINP + h * 64; qn[0] = *(const GAS bf16x8*)(qrow + 8 * g); qn[1] = *(const GAS bf16x8*)(qrow + 32 + 8 * g); }
            AttState st; st.m = -INFINITY; st.l = 0.f;
#pragma unroll
            for (int dt = 0; dt < 4; ++dt) st.o[dt] = (f32x4){0.f, 0.f, 0.f, 0.f};
            for (int s = 0; s < 4; ++s) att_kstep<false>(st, KC, VC, kh * 128 + s * 32, qf, lane, ao, RPB);
#define ATT_PASS(pass, pfk, pfv) do { \
                __syncthreads(); \
                _Pragma("unroll") for (int q__ = 0; q__ < 4; ++q__) { const int idx_ = tid + 512 * q__; const int o_ = swz_off(idx_ >> 3, idx_ & 7); *(LAS v4u*)(KL + o_) = pfk[q__]; *(LAS v4u*)(VL + o_) = pfv[q__]; } \
                __syncthreads(); \
                if (ui + 1 < 16) ATT_ISSUE(2 * (ui + 1) + (pass), pfk, pfv); \
                for (int k2 = 0; k2 < 2; ++k2) { const int kr = 2 * kh + k2, arow = rs + 4 * (pass) + kr; \
                    att_kstep<true>(st, KL, VL, kr * 64 + wc0, qf, lane, ao, RPB + (arow - i + 7) * 31); } } while (0)
            ATT_PASS(0, pfk0, pfv0);
            ATT_PASS(1, pfk1, pfv1);
#undef ATT_PASS
            __syncthreads();
            att_merge_store(st, mrg, qb, kh, lane, CAT + (size_t)(b * SEQ + i * 64 + qb * 16) * DM + h * 64);
        }
    }
}

__device__ __forceinline__ void phase_rwpost(LAS unsigned char* lds, int l) {
    const KA a = ka_get();
    const int tid = opaque_tid(), lane = tid & 63, hh = __builtin_amdgcn_readfirstlane(tid >> 6), kl = lane & 15, g = lane >> 4;
    const int er = tid >> 5, cq = tid & 31, c0 = cq * 16, hq = cq >> 2;
    LAS bf16* sig = (LAS bf16*)lds;
    LAS float* Gl = (LAS float*)(lds + 4096);
    const bf16* PX = (const bf16*)(a.ws() + WS_X2); const float* YD = (const float*)(a.ws() + WS_X3); const float* BON = (const float*)(a.ws() + WS_BONUS); bf16* CAT = (bf16*)(a.ws() + WS_X1);
    const float* mup = a.in(I_MUP) + l * 1760; const float* mun = a.in(I_MUN) + l * 1760; const float* g2 = a.in(I_G2) + (size_t)l * 96 * 512;
    const float* gngp = a.in(I_GNG) + l * 512 + c0; const float* gnbp = a.in(I_GNB) + l * 512 + c0;
    bf16x8 gb[3][4];
#pragma unroll
    for (int ks = 0; ks < 3; ++ks)
#pragma unroll
        for (int nt = 0; nt < 4; ++nt) { v4u w; unsigned t[8];
#pragma unroll
            for (int j = 0; j < 8; ++j) t[j] = f2bf(g2[(size_t)(32 * ks + 8 * g + j) * 512 + 64 * hh + 16 * nt + kl]);
            w.x = t[0] | (t[1] << 16); w.y = t[2] | (t[3] << 16); w.z = t[4] | (t[5] << 16); w.w = t[6] | (t[7] << 16); gb[ks][nt] = __builtin_bit_cast(bf16x8, w); }
    const int nch = (l == 0 ? NTOK : NTX) / 16;
    for (int ch = blockIdx.x; ch < nch; ch += gridDim.x) {
        const int row0 = ch * 16;
        __syncthreads();
        for (int idx = tid; idx < 1536; idx += 512) { const int r = idx / 96, j = idx - r * 96, row = row0 + r; int t, T; if (row < NTX) { t = row & (SEQ - 1); T = SEQ; } else { t = (row - NTX) & (CTXL - 1); T = CTXL; }
            const bf16* p = PX + (size_t)row * DINP + RWOFF + 1664 + j; const int op = t > 0 ? -DINP : 0, on = t + 1 < T ? DINP : 0;
            const float cv = bf2f(p[0]), pv = bf2f(p[op]) * (t > 0 ? 1.f : 0.f), nv = bf2f(p[on]) * (t + 1 < T ? 1.f : 0.f);
            const float z = cv + mup[1664 + j] * (pv - cv) + mun[1664 + j] * (nv - cv); sig[r * 96 + j] = f2bf1(sigmoidf_(z)); }
        const int row = row0 + er; int t, T; if (row < NTX) { t = row & (SEQ - 1); T = SEQ; } else { t = (row - NTX) & (CTXL - 1); T = CTXL; }
        const bf16* pvp = PX + (size_t)row * DINP + RWOFF + 1024 + c0; const int op = t > 0 ? -DINP : 0, on = t + 1 < T ? DINP : 0; const float fp = t > 0 ? 1.f : 0.f, fn = t + 1 < T ? 1.f : 0.f;
        v4u vc[2], vp[2], vn[2]; f32x4 y0[4], y1[4];
#pragma unroll
        for (int i = 0; i < 2; ++i) { vc[i] = *(const GAS v4u*)(pvp + 8 * i); vp[i] = *(const GAS v4u*)(pvp + op + 8 * i); vn[i] = *(const GAS v4u*)(pvp + on + 8 * i); }
#pragma unroll
        for (int i = 0; i < 4; ++i) { y0[i] = *(const GAS f32x4*)(YD + (size_t)row * 512 + c0 + 4 * i); y1[i] = *(const GAS f32x4*)(YD + ((size_t)NTOK + row) * 512 + c0 + 4 * i); }
        const float bon = BON[(size_t)row * 8 + hq] + BON[((size_t)NTOK + row) * 8 + hq];
        __syncthreads();
        { f32x4 acc[4];
#pragma unroll
          for (int nt = 0; nt < 4; ++nt) acc[nt] = (f32x4){0.f, 0.f, 0.f, 0.f};
#pragma unroll
          for (int ks = 0; ks < 3; ++ks) { const bf16x8 af = *(const LAS bf16x8*)(sig + kl * 96 + 32 * ks + 8 * g);
#pragma unroll
              for (int nt = 0; nt < 4; ++nt) acc[nt] = __builtin_amdgcn_mfma_f32_16x16x32_bf16(af, gb[ks][nt], acc[nt], 0, 0, 0); }
#pragma unroll
          for (int nt = 0; nt < 4; ++nt)
#pragma unroll
              for (int j = 0; j < 4; ++j) Gl[(4 * g + j) * 512 + 64 * hh + 16 * nt + kl] = acc[nt][j]; }
        __syncthreads();
        f32x4 y[4]; float s = 0.f;
#pragma unroll
        for (int i = 0; i < 4; ++i) { y[i] = y0[i] + y1[i]; s += (y[i].x + y[i].y) + (y[i].z + y[i].w); }
        s += dppmov<0xB1>(s); s += dppmov<0x4E>(s); const float mean = s * (1.0f / 64.0f); float q = 0.f;
#pragma unroll
        for (int i = 0; i < 4; ++i) { y[i] = y[i] - mean; q += (y[i].x * y[i].x + y[i].y * y[i].y) + (y[i].z * y[i].z + y[i].w * y[i].w); }
        q += dppmov<0xB1>(q); q += dppmov<0x4E>(q); const float rstd = 1.0f / sqrtf(q * (1.0f / 64.0f) + GN_EPS);
        unsigned ow[8]; f32x4 mpvv[4], mnvv[4], gngv[4], gnbv[4];
#pragma unroll
        for (int i = 0; i < 4; ++i) { mpvv[i] = *(const GAS f32x4*)(mup + 1024 + c0 + 4 * i); mnvv[i] = *(const GAS f32x4*)(mun + 1024 + c0 + 4 * i); gngv[i] = *(const GAS f32x4*)(gngp + 4 * i); gnbv[i] = *(const GAS f32x4*)(gnbp + 4 * i); }
#pragma unroll
        for (int i = 0; i < 4; ++i) { const unsigned cw0 = vc[i >> 1][(i & 1) * 2], cw1 = vc[i >> 1][(i & 1) * 2 + 1], pw0 = vp[i >> 1][(i & 1) * 2], pw1 = vp[i >> 1][(i & 1) * 2 + 1], nw0 = vn[i >> 1][(i & 1) * 2], nw1 = vn[i >> 1][(i & 1) * 2 + 1];
            const f32x4 cv = {bflo(cw0), bfhi(cw0), bflo(cw1), bfhi(cw1)}, pv = {bflo(pw0) * fp, bfhi(pw0) * fp, bflo(pw1) * fp, bfhi(pw1) * fp}, nv = {bflo(nw0) * fn, bfhi(nw0) * fn, bflo(nw1) * fn, bfhi(nw1) * fn};
            const f32x4 mpv = mpvv[i], mnv = mnvv[i], gng = gngv[i], gnb = gnbv[i];
            const f32x4 zv = cv + mpv * (pv - cv) + mnv * (nv - cv);
            const f32x4 gt = *(const LAS f32x4*)(Gl + er * 512 + c0 + 4 * i);
            const f32x4 o = (y[i] * rstd * gng + gnb + zv * bon) * gt;
            ow[2 * i] = pk2(o.x, o.y); ow[2 * i + 1] = pk2(o.z, o.w); }
        GAS v4u* dst = (GAS v4u*)(CAT + (size_t)row * DM + 512 + c0); dst[0] = (v4u){ow[0], ow[1], ow[2], ow[3]}; dst[1] = (v4u){ow[4], ow[5], ow[6], ow[7]};
    }
}

template <bool BFIN> __device__ __forceinline__ void phase_ln1_route(LAS unsigned char* lds, int l) {
    const KA a = ka_get();
    const int tid = opaque_tid(), lane = tid & 63, wave = __builtin_amdgcn_readfirstlane(tid >> 6), G = gridDim.x, bid = blockIdx.x;
    const int gw = bid * 8 + wave, NGW = G * 8;
    LAS float* rwt = (LAS float*)lds;
#pragma unroll
    for (int i = tid; i < 8192; i += 512) { const int k = i >> 3, eg = i & 7; const f32x4 w4 = *(const GAS f32x4*)(a.in(I_RW) + k * 32 + 4 * eg);
        rwt[(4 * eg) * 1024 + k] = w4.x; rwt[(4 * eg + 1) * 1024 + k] = w4.y; rwt[(4 * eg + 2) * 1024 + k] = w4.z; rwt[(4 * eg + 3) * 1024 + k] = w4.w; }
    if (tid < 32) ((LAS int*)(lds + LDSCTL_OFF + 1024))[tid] = 0;
    __syncthreads();
    const float* mods = (const float*)(a.ws() + WS_MODS) + (size_t)l * 17 * 6144;
    const bf16* O = (const bf16*)(a.ws() + WS_X3); bf16* HM = (bf16*)(a.ws() + WS_X1);
    const float* xs = a.in(I_X); const float* cs = a.in(I_CTX); const bf16* xb = (const bf16*)a.out(); bf16* XP = (bf16*)(a.ws() + WS_XP);
    int* HIST = (int*)(a.ws() + WS_LIST); TokInfo* TOK = (TokInfo*)(a.ws() + WS_TOK); LAS int* lcnt = (LAS int*)(lds + LDSCTL_OFF + 1024);
    const GAS f32x4* lg = (const GAS f32x4*)(a.in(I_LN1G) + l * DM) + lane; const GAS f32x4* lb = (const GAS f32x4*)(a.in(I_LN1B) + l * DM) + lane;
    const int Mrows = l == 0 ? NTOK : NTX;
    const float biasv = a.in(I_RB)[(lane >> 1) & 31];
    f32x4 lgv[4], lbv[4];
#pragma unroll
    for (int j = 0; j < 4; ++j) { lgv[j] = lg[64 * j]; lbv[j] = lb[64 * j]; }
    f32x4 nx[4]; v2u nxb[4], no[4];
    const int RPW = (Mrows + NGW - 1) / NGW, m0 = gw * RPW, mend = (m0 + RPW < Mrows) ? m0 + RPW : Mrows;
#define LN1_FETCH(M) do { const int m_ = (M) < mend ? (M) : (Mrows - 1); const GAS v2u* or_ = (const GAS v2u*)(O + (size_t)m_ * DM) + lane; \
        if constexpr (BFIN) { const GAS v2u* xr_ = (const GAS v2u*)(xb + (size_t)m_ * DM) + lane; \
            _Pragma("unroll") for (int j_ = 0; j_ < 4; ++j_) { nxb[j_] = xr_[64 * j_]; no[j_] = or_[64 * j_]; } } \
        else { const float* s_ = m_ < NTX ? xs + (size_t)m_ * DM : cs + (size_t)(m_ - NTX) * DM; const GAS f32x4* xr_ = (const GAS f32x4*)s_ + lane; \
            _Pragma("unroll") for (int j_ = 0; j_ < 4; ++j_) { nx[j_] = xr_[64 * j_]; no[j_] = or_[64 * j_]; } } } while (0)
    LN1_FETCH(m0);
    for (int m = m0; m < mend; ) {
        const int mr = m < NTX ? m / SEQ : 16; int segend = m < NTX ? (mr + 1) * SEQ : Mrows; segend = segend < mend ? segend : mend;
        const GAS f32x4* md = (const GAS f32x4*)(mods + (size_t)mr * 6144) + lane;
        f32x4 sc2[4], sh2[4], gt1[4];
#pragma unroll
        for (int j = 0; j < 4; ++j) { gt1[j] = md[512 + 64 * j]; sc2[j] = md[1024 + 64 * j]; sh2[j] = md[768 + 64 * j]; }
      for (; m < segend; ++m) {
        f32x4 v[4]; float s = 0.f;
#pragma unroll
        for (int j = 0; j < 4; ++j) { f32x4 x; if constexpr (BFIN) { const v2u xw = nxb[j]; x = f32x4{bflo(xw.x), bfhi(xw.x), bflo(xw.y), bfhi(xw.y)}; } else x = nx[j];
            const f32x4 gt = gt1[j]; const v2u ow = no[j]; const f32x4 o = {bflo(ow.x), bfhi(ow.x), bflo(ow.y), bfhi(ow.y)};
            v[j] = x * ALPHA + gt * o; s += (v[j].x + v[j].y) + (v[j].z + v[j].w); }
        LN1_FETCH(m + 1);
        const float mean = wave_sum(s) * (1.f / DM); float s2 = 0.f;
#pragma unroll
        for (int j = 0; j < 4; ++j) { v[j] = v[j] - mean; s2 += (v[j].x * v[j].x + v[j].y * v[j].y) + (v[j].z * v[j].z + v[j].w * v[j].w); }
        const float rstd = 1.f / sqrtf(wave_sum(s2) * (1.f / DM) + LN_EPS);
        float part[32];
#pragma unroll
        for (int e = 0; e < 32; ++e) part[e] = 0.f;
        GAS v2u* dr = (GAS v2u*)(XP + (size_t)m * DM) + lane; GAS v2u* hr = (GAS v2u*)(HM + (size_t)m * DM) + lane;
#pragma unroll
        for (int j = 0; j < 4; ++j) { const f32x4 x1 = v[j] * rstd * lgv[j] + lbv[j]; { v2u xw; xw.x = pk2(x1.x, x1.y); xw.y = pk2(x1.z, x1.w); dr[64 * j] = xw; }
            const f32x4 hm = x1 * (sc2[j] + 1.0f) + sh2[j]; v2u w; w.x = pk2(hm.x, hm.y); w.y = pk2(hm.z, hm.w); hr[64 * j] = w;
#pragma unroll
            for (int e8 = 0; e8 < 4; ++e8) { f32x4 rw[8]; const unsigned ra = (unsigned)((256 * j + 4 * lane) * 4 + (e8 >> 1) * 65536);
#pragma unroll
                for (int q = 0; q < 8; ++q) asm volatile("ds_read_b128 %0, %1 offset:%2" : "=v"(rw[q]) : "v"(ra), "i"(((e8 & 1) * 8 + q) * 4096));
                asm volatile("s_waitcnt lgkmcnt(0)" : "+v"(rw[0]), "+v"(rw[1]), "+v"(rw[2]), "+v"(rw[3]), "+v"(rw[4]), "+v"(rw[5]), "+v"(rw[6]), "+v"(rw[7]) :: "memory");
#pragma unroll
                for (int q = 0; q < 8; ++q) part[e8 * 8 + q] += hm.x * rw[q].x + hm.y * rw[q].y + hm.z * rw[q].z + hm.w * rw[q].w;
#ifdef PROBE_ROUTER
                { f32x4 rw2[8];
#pragma unroll
                  for (int q = 0; q < 8; ++q) asm volatile("ds_read_b128 %0, %1 offset:%2" : "=v"(rw2[q]) : "v"(ra), "i"(((e8 & 1) * 8 + q) * 4096));
                  asm volatile("s_waitcnt lgkmcnt(0)" : "+v"(rw2[0]), "+v"(rw2[1]), "+v"(rw2[2]), "+v"(rw2[3]), "+v"(rw2[4]), "+v"(rw2[5]), "+v"(rw2[6]), "+v"(rw2[7]) :: "memory");
#pragma unroll
                  for (int q = 0; q < 8; ++q) { float dmy = hm.x * rw2[q].x + hm.y * rw2[q].y + hm.z * rw2[q].z + hm.w * rw2[q].w; asm volatile("" :: "v"(dmy)); } }
#endif
            } }
        float p16[16], p8[8], p4[4], p2[2], p1;
        { const bool up = (lane & 32) != 0;
#pragma unroll
          for (int e = 0; e < 16; ++e) { const float mine = up ? part[16 + e] : part[e], oth = up ? part[e] : part[16 + e]; p16[e] = mine + shx(oth, 32, lane); } }
        { const bool up = (lane & 16) != 0;
#pragma unroll
          for (int e = 0; e < 8; ++e) { const float mine = up ? p16[8 + e] : p16[e], oth = up ? p16[e] : p16[8 + e]; p8[e] = mine + shx(oth, 16, lane); } }
        { const bool up = (lane & 8) != 0;
#pragma unroll
          for (int e = 0; e < 4; ++e) { const float mine = up ? p8[4 + e] : p8[e], oth = up ? p8[e] : p8[4 + e]; p4[e] = mine + dppmov<0x128>(oth); } }
        { const bool up = (lane & 4) != 0;
#pragma unroll
          for (int e = 0; e < 2; ++e) { const float mine = up ? p4[2 + e] : p4[e], oth = up ? p4[e] : p4[2 + e]; p2[e] = mine + shx(oth, 4, lane); } }
        { const bool up = (lane & 2) != 0; const float mine = up ? p2[1] : p2[0], oth = up ? p2[0] : p2[1]; p1 = mine + dppmov<0x4E>(oth); }
        const float logit = p1 + dppmov<0xB1>(p1);
        const float score = sigmoidf_(logit), sel = score + biasv;
        const int gl = lane & ~7;
        const float q0 = shi(sel, gl), q1 = shi(sel, gl + 2), q2 = shi(sel, gl + 4), q3 = shi(sel, gl + 6);
        const float mx = fmaxf(fmaxf(q0, q1), fmaxf(q2, q3));
        float top2;
        { float a0 = q0, a1 = q1, a2 = q2, a3 = q3; float t;
          if (a0 < a1) { t = a0; a0 = a1; a1 = t; } if (a2 < a3) { t = a2; a2 = a3; a3 = t; } if (a0 < a2) { t = a0; a0 = a2; a2 = t; } if (a1 < a3) { t = a1; a1 = a3; a3 = t; } if (a1 < a2) { t = a1; a1 = a2; a2 = t; }
          top2 = a0 + a1; (void)mx; }
        float best = __builtin_bit_cast(float, __builtin_amdgcn_readlane(__builtin_bit_cast(int, top2), 0)); int gidx = 0;
#pragma unroll
        for (int gg = 1; gg < 8; ++gg) { const float sc = __builtin_bit_cast(float, __builtin_amdgcn_readlane(__builtin_bit_cast(int, top2), gg * 8)); if (sc > best) { best = sc; gidx = gg; } }
        const float r0 = shi(sel, gidx * 8), r1 = shi(sel, gidx * 8 + 2), r2 = shi(sel, gidx * 8 + 4), r3 = shi(sel, gidx * 8 + 6);
        int i0 = 0; float b0 = r0; if (r1 > b0) { b0 = r1; i0 = 1; } if (r2 > b0) { b0 = r2; i0 = 2; } if (r3 > b0) { b0 = r3; i0 = 3; }
        int i1 = -1; float b1 = -INFINITY;
        if (i0 != 0 && r0 > b1) { b1 = r0; i1 = 0; } if (i0 != 1 && r1 > b1) { b1 = r1; i1 = 1; } if (i0 != 2 && r2 > b1) { b1 = r2; i1 = 2; } if (i0 != 3 && r3 > b1) { b1 = r3; i1 = 3; }
        const int e0 = gidx * 4 + i0, e1 = gidx * 4 + i1;
        const float s0 = shi(score, 2 * e0), s1 = shi(score, 2 * e1); const float gs = 1.0f / (s0 + s1);
        if (lane == 0) { const int p0 = __hip_atomic_fetch_add(lcnt + e0, 1, __ATOMIC_RELAXED, __HIP_MEMORY_SCOPE_WORKGROUP), p1_ = __hip_atomic_fetch_add(lcnt + e1, 1, __ATOMIC_RELAXED, __HIP_MEMORY_SCOPE_WORKGROUP);
            TokInfo ti; ti.e0 = e0; ti.e1 = e1; ti.p0 = p0; ti.p1 = p1_; ti.g0 = s0 * gs; ti.g1 = s1 * gs; ti.pad0 = 0; ti.pad1 = 0; TOK[m] = ti; }
      }
    }
    __syncthreads();
    if (tid < 32) HIST[bid * 32 + tid] = lcnt[tid];
}

template <bool FULL> __device__ __forceinline__ void moe_tables(LAS unsigned char* lds, int l) {
    const KA a = ka_get(); const int tid = opaque_tid(), G = gridDim.x;
    LAS int* pref = (LAS int*)(lds + PREF_OFF); LAS int* bb = (LAS int*)lds; LAS int* tot = (LAS int*)(lds + 65536);
    const int* HIST = (const int*)(a.ws() + WS_LIST);
    __syncthreads();
    const int e = tid & 31, grp = tid >> 5;
    int loc[16]; int run = 0;
#pragma unroll
    for (int i = 0; i < 16; ++i) { const int b = grp * 16 + i; loc[i] = (b < G) ? HIST[b * 32 + e] : 0; }
#pragma unroll
    for (int i = 0; i < 16; ++i) { const int v = loc[i]; loc[i] = run; run += v; }
    tot[grp * 32 + e] = run;
    __syncthreads();
    int base = 0, total = 0;
#pragma unroll
    for (int q = 0; q < 16; ++q) { const int v = tot[q * 32 + e]; base += (q < grp) ? v : 0; total += v; }
    if (FULL) {
#pragma unroll
        for (int i = 0; i < 16; ++i) bb[(grp * 16 + i) * 32 + e] = base + loc[i]; }
    if (grp == 0) pref[40 + e] = total;
    __syncthreads();
    if (tid == 0) { int acc = 0; for (int k = 0; k < 32; ++k) { pref[k] = acc; acc += (pref[40 + k] + 255) >> 8; } pref[32] = acc; }
    __syncthreads();
}
__device__ __forceinline__ void phase_gather(LAS unsigned char* lds, int l) {
    const KA a = ka_get();
    const int tid = opaque_tid(), lane = tid & 63, wave = __builtin_amdgcn_readfirstlane(tid >> 6), G = gridDim.x, bid = blockIdx.x;
    const int gw = bid * 8 + wave, NGW = G * 8;
    moe_tables<true>(lds, l);
    const LAS int* pref = (const LAS int*)(lds + PREF_OFF); const LAS int* bb = (const LAS int*)lds;
    const bf16* HM = (const bf16*)(a.ws() + WS_X1); bf16* XB = (bf16*)(a.ws() + WS_X2); const TokInfo* TOK = (const TokInfo*)(a.ws() + WS_TOK);
    const int Mrows = l == 0 ? NTOK : NTX;
    const int RPW = (Mrows + NGW - 1) / NGW;
    for (int m = gw; m < Mrows; m += NGW) {
        const TokInfo ti = TOK[m]; const int blk = (m / RPW) >> 3;
        const int sl0 = pref[ti.e0] * 256 + bb[blk * 32 + ti.e0] + ti.p0, sl1 = pref[ti.e1] * 256 + bb[blk * 32 + ti.e1] + ti.p1;
        const GAS v4u* srcp = (const GAS v4u*)(HM + (size_t)m * DM) + lane; const v4u v0 = srcp[0], v1 = srcp[64];
        GAS v4u* d0 = (GAS v4u*)(XB + (size_t)sl0 * DM) + lane; GAS v4u* d1 = (GAS v4u*)(XB + (size_t)sl1 * DM) + lane;
        d0[0] = v0; d0[64] = v1; d1[0] = v0; d1[64] = v1;
    }
    for (int e = 0; e < 32; ++e) {
        const int c = pref[40 + e], npad = ((c + 255) & ~255) - c, r0 = pref[e] * 256 + c;
        for (int r = gw; r < npad; r += NGW) { GAS v4u* dst = (GAS v4u*)(XB + (size_t)(r0 + r) * DM) + lane; dst[0] = (v4u){0u, 0u, 0u, 0u}; dst[64] = (v4u){0u, 0u, 0u, 0u}; }
    }
}

__device__ __forceinline__ void phase_ln2(LAS unsigned char* lds, int l) {
    const KA a = ka_get();
    const int tid = opaque_tid(), lane = tid & 63, wave = __builtin_amdgcn_readfirstlane(tid >> 6), G = gridDim.x, bid = blockIdx.x;
    const int gw = bid * 8 + wave, NGW = G * 8;
    moe_tables<true>(lds, l);
    const LAS int* pref = (const LAS int*)(lds + PREF_OFF); const LAS int* bb = (const LAS int*)lds;
    const float* mods = (const float*)(a.ws() + WS_MODS) + (size_t)l * 17 * 6144;
    const bf16* Y = (const bf16*)(a.ws() + WS_X2); const TokInfo* TOK = (const TokInfo*)(a.ws() + WS_TOK);
    const bf16* XP = (const bf16*)(a.ws() + WS_XP);
    const GAS f32x4* lg = (const GAS f32x4*)(a.in(I_LN2G) + l * DM) + lane; const GAS f32x4* lb = (const GAS f32x4*)(a.in(I_LN2B) + l * DM) + lane;
    const int Mrows = l == 0 ? NTOK : NTX;
    f32x4 lgv[4], lbv[4];
#pragma unroll
    for (int j = 0; j < 4; ++j) { lgv[j] = lg[64 * j]; lbv[j] = lb[64 * j]; }
    const int RPW = (Mrows + NGW - 1) / NGW, m0 = gw * RPW, mend = (m0 + RPW < Mrows) ? m0 + RPW : Mrows, nrows = mend - m0;
    int sl0v = 0, sl1v = 0; float g0v = 0.f, g1v = 0.f;
    if (lane < nrows) { const TokInfo ti = TOK[m0 + lane]; const LAS int* bbw = bb + bid * 32;
        sl0v = pref[ti.e0] * 256 + bbw[ti.e0] + ti.p0; sl1v = pref[ti.e1] * 256 + bbw[ti.e1] + ti.p1; g0v = ti.g0; g1v = ti.g1; }
    v2u nxin[4], nain[4], nbin[4];
#define LN2_FETCH(J) do { const int j_ = (J) < nrows ? (J) : (nrows - 1); const int s0_ = __builtin_amdgcn_readlane(sl0v, j_), s1_ = __builtin_amdgcn_readlane(sl1v, j_); \
        const GAS v2u* xr_ = (const GAS v2u*)(XP + (size_t)(m0 + j_) * DM) + lane; const GAS v2u* y0_ = (const GAS v2u*)(Y + (size_t)s0_ * DM) + lane; const GAS v2u* y1_ = (const GAS v2u*)(Y + (size_t)s1_ * DM) + lane; \
        _Pragma("unroll") for (int q_ = 0; q_ < 4; ++q_) { nxin[q_] = xr_[64 * q_]; nain[q_] = y0_[64 * q_]; nbin[q_] = y1_[64 * q_]; } } while (0)
    if (nrows > 0) {
    LN2_FETCH(0);
    for (int jr = 0; jr < nrows; ) {
        const int mseg = m0 + jr; const int mr = mseg < NTX ? mseg / SEQ : 16; int segend = mseg < NTX ? (mr + 1) * SEQ : Mrows; segend = (segend < mend ? segend : mend) - m0;
        const GAS f32x4* md = (const GAS f32x4*)(mods + (size_t)mr * 6144) + lane;
        f32x4 gin[4], msc[4], msh[4];
#pragma unroll
        for (int j = 0; j < 4; ++j) gin[j] = md[1280 + 64 * j];
        if (l == 0) { const GAS f32x4* mn = (const GAS f32x4*)(mods + (size_t)17 * 6144 + (size_t)mr * 6144) + lane;
#pragma unroll
            for (int j = 0; j < 4; ++j) { msc[j] = mn[256 + 64 * j]; msh[j] = mn[64 * j]; } }
      for (; jr < segend; ++jr) {
        const int m = m0 + jr;
        const float tg0 = __builtin_bit_cast(float, __builtin_amdgcn_readlane(__builtin_bit_cast(int, g0v), jr)), tg1 = __builtin_bit_cast(float, __builtin_amdgcn_readlane(__builtin_bit_cast(int, g1v), jr));
        f32x4 v[4]; float s = 0.f;
#pragma unroll
        for (int j = 0; j < 4; ++j) { const v2u xw = nxin[j]; const f32x4 x = {bflo(xw.x), bfhi(xw.x), bflo(xw.y), bfhi(xw.y)}, gt = gin[j]; const v2u a0 = nain[j], a1 = nbin[j];
            const f32x4 ya = {bflo(a0.x), bfhi(a0.x), bflo(a0.y), bfhi(a0.y)}, yb = {bflo(a1.x), bfhi(a1.x), bflo(a1.y), bfhi(a1.y)};
            v[j] = x * ALPHA + gt * (ya * tg0 + yb * tg1); s += (v[j].x + v[j].y) + (v[j].z + v[j].w); }
        LN2_FETCH(jr + 1);
        const float mean = wave_sum(s) * (1.f / DM); float s2 = 0.f;
#pragma unroll
        for (int j = 0; j < 4; ++j) { v[j] = v[j] - mean; s2 += (v[j].x * v[j].x + v[j].y * v[j].y) + (v[j].z * v[j].z + v[j].w * v[j].w); }
        const float rstd = 1.f / sqrtf(wave_sum(s2) * (1.f / DM) + LN_EPS);
        if (l == 0) {
            GAS v2u* o8 = (GAS v2u*)((bf16*)(a.ws() + WS_X1) + (size_t)m * DM) + lane; GAS v2u* xs8 = (GAS v2u*)((bf16*)a.out() + (size_t)(m < NTX ? m : 0) * DM) + lane;
            const bool isx = m < NTX;
#pragma unroll
            for (int j = 0; j < 4; ++j) { const f32x4 xn = v[j] * rstd * lgv[j] + lbv[j]; if (isx) { v2u xw; xw.x = pk2(xn.x, xn.y); xw.y = pk2(xn.z, xn.w); xs8[64 * j] = xw; }
                const f32x4 r = xn * (msc[j] + 1.0f) + msh[j]; v2u w; w.x = pk2(r.x, r.y); w.y = pk2(r.z, r.w); o8[64 * j] = w; }
        } else {
            GAS f32x4* of = (GAS f32x4*)(a.out() + (size_t)m * DM) + lane;
#pragma unroll
            for (int j = 0; j < 4; ++j) of[64 * j] = v[j] * rstd * lgv[j] + lbv[j];
        }
      }
    }
    }
}
namespace csc {
constexpr int ARR = 0;
constexpr int RAW = 0;
constexpr int ZL = 34816;
constexpr int WLO = 57344;
constexpr int FR = 58368;
constexpr int AABT = 87040;
constexpr int LWO = 91136;
constexpr int AAO = 107520;
__device__ __forceinline__ int sw16(int row, int chunk) { return row * 128 + ((chunk ^ (row & 7)) << 4); }
__device__ __forceinline__ v2u cvt4(const f32x4 v) { v2u r; r.x = pk2(v[0], v[1]); r.y = pk2(v[2], v[3]); return r; }
__device__ __forceinline__ bf16x8 mk8(v2u lo, v2u hi) { v4u w; w.x = lo.x; w.y = lo.y; w.z = hi.x; w.w = hi.y; return __builtin_bit_cast(bf16x8, w); }
__device__ __forceinline__ v2u trd(const LAS unsigned char* p) { return __builtin_bit_cast(v2u, __builtin_amdgcn_ds_read_tr16_b64_v4i16((LAS v4i16_t*)p)); }
__device__ __forceinline__ int opq(int v) { asm volatile("" : "+v"(v)); return v; }
__device__ __forceinline__ int opqs(int v) { asm volatile("" : "+s"(v)); return v; }
}
namespace bgc {
constexpr int CBUF = LDSCTL_OFF + 4096, CPITCH = 80, NITEMS = NEXP * 1536;
struct Item { const float* src; bf16* dst; int N, ld; };
__device__ __forceinline__ Item decode(const KA& a, int l, int item) {
    const int e = item / 1536; int r = item - e * 1536; const int m = r >> 9, t = r & 511; const size_t eo = ((size_t)l * NEXP + e) * (size_t)DM * DEXP; Item it;
    if (m < 2) { const int kt = t >> 4, nt = t & 15, j0 = 32 * nt; it.N = DEXP; it.ld = 1024; it.src = (m ? a.in(I_EW3) : a.in(I_EW1)) + eo + (size_t)(32 * kt) * DEXP + j0;
        it.dst = (bf16*)(a.ws() + WS_W13T) + (size_t)e * 1024 * 1024 + (size_t)(256 * (j0 >> 7) + 128 * m + (j0 & 127)) * 1024 + 32 * kt; }
    else { const int kt = t >> 5, nt = t & 31; it.N = DM; it.ld = 512; it.src = a.in(I_EW2) + eo + (size_t)(32 * kt) * DM + 32 * nt; it.dst = (bf16*)(a.ws() + WS_W2T) + (size_t)e * 1024 * 512 + (size_t)(32 * nt) * 512 + 32 * kt; }
    return it; }
__device__ __forceinline__ void issue(const KA& a, int l, int item, int lane, f32x4 (&cv)[4]) { const Item it = decode(a, l, item);
#pragma unroll
    for (int i = 0; i < 4; ++i) cv[i] = *(const GAS f32x4*)(it.src + (size_t)((lane >> 3) + 8 * i) * it.N + (lane & 7) * 4); }
__device__ __forceinline__ void finish(const KA& a, int l, int item, int lane, int slot, LAS unsigned char* lds, const f32x4 (&cv)[4]) { const Item it = decode(a, l, item);
    LAS unsigned char* buf = lds + CBUF + slot * (32 * CPITCH);
#pragma unroll
    for (int i = 0; i < 4; ++i)
#pragma unroll
        for (int u = 0; u < 4; ++u) *(LAS bf16*)(buf + ((lane & 7) * 4 + u) * CPITCH + ((lane >> 3) + 8 * i) * 2) = f2bf1(cv[i][u]);
    LDS_WAIT(); asm volatile("" ::: "memory");
    const int n = lane >> 1, hf = lane & 1; const v4u w0 = *(const LAS v4u*)(buf + n * CPITCH + hf * 32), w1 = *(const LAS v4u*)(buf + n * CPITCH + hf * 32 + 16);
    GAS v4u* d = (GAS v4u*)(it.dst + (size_t)n * it.ld + 16 * hf); d[0] = w0; d[1] = w1;
    LDS_WAIT(); asm volatile("" ::: "memory"); }
}
#ifndef SCAN_STAMP
#define SCAN_STAMP 0
#endif
#define STB(k) do { if (SCAN_STAMP == (k)) t0_ = (unsigned)__builtin_amdgcn_s_memrealtime(); } while (0)
#define STE(k) do { if (SCAN_STAMP == (k)) tacc_ += (unsigned)__builtin_amdgcn_s_memrealtime() - t0_; } while (0)
#ifndef SCAN_PROBE
#define SCAN_PROBE 0
#endif
#define REPK(k) for (int rep_ = 0; rep_ < ((SCAN_PROBE == (k)) ? 2 : 1); ++rep_)
__device__ __forceinline__ void phase_scan(LAS unsigned char* lds, int l) {
    using namespace csc;
    const KA a = ka_get();
    const int tid = opaque_tid(), lane0 = tid & 63, wv = __builtin_amdgcn_readfirstlane(tid >> 6);
    const bf16* PX = (const bf16*)(a.ws() + WS_X2); float* YD = (float*)(a.ws() + WS_X3); float* BON = (float*)(a.ws() + WS_BONUS);
    const float* mup = a.in(I_MUP) + l * 1760; const float* mun = a.in(I_MUN) + l * 1760;
    const f32x4 Z4 = {0.f, 0.f, 0.f, 0.f}; const v2u Z2 = {0u, 0u};
    unsigned t0_ = 0, tacc_ = 0; (void)t0_;
    for (int chain = blockIdx.x; chain < 256; chain += gridDim.x) {
        const int b = chain >> 4, h = (chain >> 1) & 7, d = chain & 1; const int c0_ = opq(lane0);
        float kkc[2], kac[2], rkc[2], mur[2][2], muk[2][2], muv[2][2], mul[2][2], ropef[2]; bf16x8 w2f[2], a2f[2]; float w0c[2], a0c[2];
        { const int ln = c0_, kl = ln & 15, g = ln >> 4, cp = ln & 31;
#pragma unroll
          for (int u = 0; u < 2; ++u) { const int c = 2 * cp + u; ropef[u] = exp2f(-(float)(c & 15) * (13.287712379549449f / 16.0f));
            kkc[u] = a.in(I_KK)[l * 512 + h * 64 + c]; kac[u] = a.in(I_KA)[l * 512 + h * 64 + c]; rkc[u] = a.in(I_RK)[l * 512 + h * 64 + c];
            const int colr = h * 64 + c, coll = (c < 32) ? (1536 + d * 32 + c) : (1600 + d * 32 + (c - 32));
            mur[u][0] = d ? mun[colr] : mup[colr]; mur[u][1] = d ? mup[colr] : mun[colr]; muk[u][0] = d ? mun[512 + colr] : mup[512 + colr]; muk[u][1] = d ? mup[512 + colr] : mun[512 + colr];
            muv[u][0] = d ? mun[1024 + colr] : mup[1024 + colr]; muv[u][1] = d ? mup[1024 + colr] : mun[1024 + colr]; mul[u][0] = d ? mun[coll] : mup[coll]; mul[u][1] = d ? mup[coll] : mun[coll]; }
#pragma unroll
        for (int i = 0; i < 2; ++i) { const int cc = h * 64 + 16 * ((wv >> 2) * 2 + i) + kl; unsigned t[8], u[8];
#pragma unroll
            for (int j = 0; j < 8; ++j) { t[j] = f2bf(a.in(I_W2)[((size_t)(l * 2 + d) * 32 + 8 * g + j) * 512 + cc]); u[j] = f2bf(a.in(I_A2)[((size_t)(l * 2 + d) * 32 + 8 * g + j) * 512 + cc]); }
            w2f[i] = __builtin_bit_cast(bf16x8, (v4u){t[0] | (t[1] << 16), t[2] | (t[3] << 16), t[4] | (t[5] << 16), t[6] | (t[7] << 16)});
            a2f[i] = __builtin_bit_cast(bf16x8, (v4u){u[0] | (u[1] << 16), u[2] | (u[3] << 16), u[4] | (u[5] << 16), u[6] | (u[7] << 16)});
            w0c[i] = a.in(I_W0)[(l * 2 + d) * 512 + cc]; a0c[i] = a.in(I_A0)[(l * 2 + d) * 512 + cc]; } }
        f32x4 St[4] = {Z4, Z4, Z4, Z4};
        f32x4 cvt_[4] = {Z4, Z4, Z4, Z4}; int cit = blockIdx.x * 8 + wv, cpend = -1; const int cstride = gridDim.x * 8;
#define BGC_WINDOW() do { const int ln_ = opq(lane0); if (cpend >= 0) bgc::finish(a, l, cpend, ln_, wv & 3, lds, cvt_); if (cit < bgc::NITEMS) { bgc::issue(a, l, cit, ln_, cvt_); cpend = cit; cit += cstride; } else cpend = -1; } while (0)
        for (int seq = 0; seq < 2; ++seq) {
            const int T = seq ? SEQ : CTXL, rowbase = seq ? b * SEQ : NTX + b * CTXL, ngrp = T / 64;
            v4u pre[5];
#define CSC_PREFETCH(GRP) do { const int s0_ = (GRP) * 64; const int tlo_ = d ? (T - 64 - s0_) : s0_; \
                _Pragma("unroll") for (int i_ = 0; i_ < 5; ++i_) { const int id_ = opq(tid) + 512 * i_; const int rr_ = id_ >> 5, ch_ = id_ & 31; const int t_ = tlo_ - 1 + rr_; \
                    const int col_ = RWOFF + (ch_ < 24 ? (ch_ >> 3) * 512 + h * 64 + (ch_ & 7) * 8 : (ch_ < 28 ? 1536 + d * 32 + (ch_ - 24) * 8 : 1600 + d * 32 + (ch_ - 28) * 8)); \
                    const bool ok_ = (id_ < 66 * 32) && t_ >= 0 && t_ < T; const int tc_ = ok_ ? t_ : 0; \
                    const v4u v_ = *(const GAS v4u*)(PX + (size_t)(rowbase + tc_) * DINP + col_); pre[i_] = ok_ ? v_ : (v4u){0u, 0u, 0u, 0u}; } } while (0)
            CSC_PREFETCH(0);
            for (int grp = 0; grp < ngrp; ++grp) {
                const int s0 = grp * 64;
                int lane = opq(lane0); int c = lane, kl = lane & 15, g = lane >> 4, q_ = kl >> 2, p_ = kl & 3; (void)q_; (void)p_;
                STB(1);
#pragma unroll
                for (int i = 0; i < 5; ++i) { const int id = opq(tid) + 512 * i; if (id < 66 * 32) *(LAS v4u*)(lds + RAW + id * 16) = pre[i]; }
                __syncthreads();
                STE(1); STB(2);
                int sl = opqs(wv);
                float Rk[4][2], Rq[4][2], Rr[4][2], Rv[4][2];
                REPK(1) { const int cp = lane & 31, sh = lane >> 5, sb = 8 * sl + 4 * sh; const int rbase = d ? 64 - sb : sb + 1, rdir = d ? -256 : 256;
                  const LAS bf16* p0 = (const LAS bf16*)(lds + RAW) + (rbase * 256 + 2 * cp) - rdir;
                  float pr[6][2], pk[6][2], pv[6][2], pl[6][2];
#pragma unroll
                  for (int j = 0; j < 6; ++j) { const LAS unsigned* p = (const LAS unsigned*)(p0 + j * rdir); const unsigned wr = p[0], wk = p[32], wv_ = p[64], wl = p[96];
                      pr[j][0] = bflo(wr); pr[j][1] = bfhi(wr); pk[j][0] = bflo(wk); pk[j][1] = bfhi(wk); pv[j][0] = bflo(wv_); pv[j][1] = bfhi(wv_); pl[j][0] = bflo(wl); pl[j][1] = bfhi(wl); }
                  const int qd = cp >> 3;
#pragma unroll
                  for (int i = 0; i < 4; ++i) { const int sloc = sb + i; float r[2], k[2], zz[2];
#pragma unroll
                      for (int u = 0; u < 2; ++u) { r[u] = pr[i + 1][u] + mur[u][0] * (pr[i][u] - pr[i + 1][u]) + mur[u][1] * (pr[i + 2][u] - pr[i + 1][u]); k[u] = pk[i + 1][u] + muk[u][0] * (pk[i][u] - pk[i + 1][u]) + muk[u][1] * (pk[i + 2][u] - pk[i + 1][u]);
                          Rv[i][u] = pv[i + 1][u] + muv[u][0] * (pv[i][u] - pv[i + 1][u]) + muv[u][1] * (pv[i + 2][u] - pv[i + 1][u]);
                          const float z = pl[i + 1][u] + mul[u][0] * (pl[i][u] - pl[i + 1][u]) + mul[u][1] * (pl[i + 2][u] - pl[i + 1][u]);
                          const float th = 1.0f - 2.0f * __builtin_amdgcn_rcpf(1.0f + __expf(2.0f * z)); zz[u] = cp < 16 ? th : z; }
                      ((LAS unsigned*)(lds + ZL))[sloc * 32 + cp] = pk2(zz[0], zz[1]);
                      if (seq) { const int t = d ? (T - 1 - (s0 + sloc)) : (s0 + sloc); const float pos = (float)((qd < 2) ? (t >> 6) : (t & 63));
#pragma unroll
                          for (int u = 0; u < 2; ++u) { const float rp = dppmov<0x128>(r[u]), kp = dppmov<0x128>(k[u]); const float ang = pos * ropef[u]; const float cs = __cosf(ang), sn = __sinf(ang);
                              const float sg = (qd & 1) ? sn : -sn; r[u] = r[u] * cs + rp * sg; k[u] = k[u] * cs + kp * sg; } }
                      const float k0 = k[0] * kkc[0], k1 = k[1] * kkc[1]; float ss = k0 * k0 + k1 * k1;
                      ss += dppmov<0xB1>(ss); ss += dppmov<0x4E>(ss); ss += dppmov<0x141>(ss); ss += dppmov<0x140>(ss);
                      { const int iv = __builtin_bit_cast(int, ss); const float a0 = __builtin_bit_cast(float, __builtin_amdgcn_readlane(iv, 0)) + __builtin_bit_cast(float, __builtin_amdgcn_readlane(iv, 16)), a1 = __builtin_bit_cast(float, __builtin_amdgcn_readlane(iv, 32)) + __builtin_bit_cast(float, __builtin_amdgcn_readlane(iv, 48)); ss = sh ? a1 : a0; }
                      const float rn = __builtin_amdgcn_rsqf(fmaxf(ss, 1e-24f));
                      Rk[i][0] = k0 * rn; Rk[i][1] = k1 * rn; Rq[i][0] = k[0]; Rq[i][1] = k[1]; Rr[i][0] = r[0]; Rr[i][1] = r[1]; } }
                __syncthreads();
                STE(2); STB(3);
                lane = opq(lane0); c = lane; kl = lane & 15; g = lane >> 4; q_ = kl >> 2; p_ = kl & 3;
                REPK(2) { const int wq = opqs(wv); const int st = wq & 3; const LAS unsigned char* zrow = lds + ZL + (16 * st + kl) * 128;
                  const bf16x8 zw = *(const LAS bf16x8*)(zrow + 16 * g), za = *(const LAS bf16x8*)(zrow + 64 + 16 * g);
#pragma unroll
                  for (int i = 0; i < 2; ++i) { const int cc = 16 * ((wq >> 2) * 2 + i) + kl;
                      const f32x4 uw = __builtin_amdgcn_mfma_f32_16x16x32_bf16(zw, w2f[i], Z4, 0, 0, 0), ua = __builtin_amdgcn_mfma_f32_16x16x32_bf16(za, a2f[i], Z4, 0, 0, 0);
#pragma unroll
                      for (int j = 0; j < 4; ++j) { const int srow = 16 * st + 4 * g + j;
                          ((LAS float*)(lds + LWO))[srow * 64 + cc] = -0.6065306597126334f * __builtin_amdgcn_rcpf(1.0f + __expf(-(uw[j] + w0c[i]))); ((LAS float*)(lds + AAO))[srow * 64 + cc] = __builtin_amdgcn_rcpf(1.0f + __expf(-(ua[j] + a0c[i]))); } } }
                __syncthreads();
                STE(3); STB(4);
                lane = opq(lane0); c = lane; kl = lane & 15; g = lane >> 4; q_ = kl >> 2; p_ = kl & 3;
                sl = opqs(wv);
                REPK(4) { const int cp = lane & 31, sh = lane >> 5, q = sl >> 1, hf = sl & 1; typedef float f32x2_ __attribute__((ext_vector_type(2)));
                  const LAS f32x2_* lwp = (const LAS f32x2_*)((const LAS float*)(lds + LWO) + (16 * q) * 64 + 2 * cp); const LAS f32x2_* aap = (const LAS f32x2_*)((const LAS float*)(lds + AAO) + (8 * sl + 4 * sh) * 64 + 2 * cp);
                  f32x2_ qs[4];
#pragma unroll
                  for (int j = 0; j < 4; ++j) { qs[j] = lwp[(4 * j) * 32] + lwp[(4 * j + 1) * 32] + lwp[(4 * j + 2) * 32] + lwp[(4 * j + 3) * 32]; }
                  const f32x2_ cL = (qs[0] + qs[1]) + (qs[2] + qs[3]); const int part = 2 * hf + sh;
                  f32x2_ run = part == 0 ? (f32x2_){0.f, 0.f} : (part == 1 ? qs[0] : (part == 2 ? qs[0] + qs[1] : qs[0] + qs[1] + qs[2]));
                  const float wl0 = __expf(cL.x), wl1 = __expf(cL.y);
                  if (part == 3) ((LAS f32x2_*)(lds + WLO))[q * 32 + cp] = (f32x2_){wl0, wl1};
#pragma unroll
                  for (int i = 0; i < 4; ++i) { const int sloc = 8 * sl + 4 * sh + i, s = 4 * part + i; const f32x2_ lwi = lwp[s * 32]; const f32x2_ cprev = run; run = run + lwi; const f32x2_ aa = aap[i * 32];
                      const float kd0 = Rq[i][0] * (1.0f + (aa.x - 1.0f) * kac[0]), kd1 = Rq[i][1] * (1.0f + (aa.y - 1.0f) * kac[1]), nb0 = -Rk[i][0] * aa.x, nb1 = -Rk[i][1] * aa.y;
                      float bon = Rr[i][0] * kd0 * rkc[0] + Rr[i][1] * kd1 * rkc[1];
                      bon += dppmov<0xB1>(bon); bon += dppmov<0x4E>(bon); bon += dppmov<0x141>(bon); bon += dppmov<0x140>(bon);
                      { const int iv = __builtin_bit_cast(int, bon); const float a0 = __builtin_bit_cast(float, __builtin_amdgcn_readlane(iv, 0)) + __builtin_bit_cast(float, __builtin_amdgcn_readlane(iv, 16)), a1 = __builtin_bit_cast(float, __builtin_amdgcn_readlane(iv, 32)) + __builtin_bit_cast(float, __builtin_amdgcn_readlane(iv, 48)); bon = sh ? a1 : a0; }
                      if (cp == 0) { const int t = d ? (T - 1 - (s0 + sloc)) : (s0 + sloc); BON[((size_t)d * NTOK + rowbase + t) * 8 + h] = bon; }
                      const float e1x = __expf(cprev.x), e1y = __expf(cprev.y), e2x = __expf(-run.x), e2y = __expf(-run.y), e3x = __builtin_amdgcn_rcpf(e2x), e3y = __builtin_amdgcn_rcpf(e2y);
                      LAS unsigned char* base = lds + ARR + q * (7 * 2048) + sw16(s, cp >> 2) + (cp & 3) * 4;
                      *(LAS unsigned*)(base) = pk2(Rk[i][0] * e1x, Rk[i][1] * e1y); *(LAS unsigned*)(base + 2048) = pk2(nb0 * e2x, nb1 * e2y); *(LAS unsigned*)(base + 4096) = pk2(kd0 * e2x, kd1 * e2y); *(LAS unsigned*)(base + 6144) = pk2(Rr[i][0] * e3x, Rr[i][1] * e3y);
                      *(LAS unsigned*)(base + 12288) = pk2(Rv[i][0], Rv[i][1]); } }
                __syncthreads();
                STE(4); STB(5);
                lane = opq(lane0); c = lane; kl = lane & 15; g = lane >> 4; q_ = kl >> 2; p_ = kl & 3;
                STB(7); if (wv < 4) { BGC_WINDOW(); if (grp + 1 < ngrp) CSC_PREFETCH(grp + 1); } STE(7);
                STB(8); STB(10);
                REPK(5) if (wv >= 4) { __builtin_amdgcn_s_setprio(3); const int q = opqs(wv) - 4; const LAS unsigned char* A0 = lds + ARR + q * (7 * 2048);
                    STB(11);
                    bf16x8 at[2], bt[2], kt[2], rt[2];
#pragma unroll
                    for (int ks = 0; ks < 2; ++ks) { const int o = sw16(kl, ks * 4 + g); at[ks] = *(const LAS bf16x8*)(A0 + o); bt[ks] = *(const LAS bf16x8*)(A0 + 2048 + o); kt[ks] = *(const LAS bf16x8*)(A0 + 4096 + o); rt[ks] = *(const LAS bf16x8*)(A0 + 6144 + o); }
                    f32x4 ABt = Z4, AKt = Z4, RBt = Z4, RKt = Z4;
#pragma unroll
                    for (int ks = 0; ks < 2; ++ks) { ABt = __builtin_amdgcn_mfma_f32_16x16x32_bf16(bt[ks], at[ks], ABt, 0, 0, 0); AKt = __builtin_amdgcn_mfma_f32_16x16x32_bf16(kt[ks], at[ks], AKt, 0, 0, 0);
                        RBt = __builtin_amdgcn_mfma_f32_16x16x32_bf16(bt[ks], rt[ks], RBt, 0, 0, 0); RKt = __builtin_amdgcn_mfma_f32_16x16x32_bf16(kt[ks], rt[ks], RKt, 0, 0, 0); }
#pragma unroll
                    for (int j = 0; j < 4; ++j) { const int jj = 4 * g + j; ABt[j] = jj < kl ? ABt[j] : 0.f; AKt[j] = jj < kl ? AKt[j] : 0.f; RBt[j] = jj <= kl ? RBt[j] : 0.f; RKt[j] = jj <= kl ? RKt[j] : 0.f; }
                    STE(11); STB(12);
                    float Tr[16]; const float ab0 = ABt[0], ab1 = ABt[1], ab2 = ABt[2], ab3 = ABt[3];
                    const int abi[4] = {__builtin_bit_cast(int, ab0), __builtin_bit_cast(int, ab1), __builtin_bit_cast(int, ab2), __builtin_bit_cast(int, ab3)};
#pragma unroll
                    for (int i = 0; i < 16; ++i) Tr[i] = (i == kl) ? 1.f : 0.f;
#pragma unroll
                    for (int j = 14; j >= 0; --j) { float acc = 0.f;
#pragma unroll
                        for (int i = 15; i > j; --i) acc += Tr[i] * __builtin_bit_cast(float, __builtin_amdgcn_readlane(abi[j & 3], i + 16 * (j >> 2)));
                        Tr[j] = (j < kl) ? acc : Tr[j]; }
                    STE(12); STB(13);
                    float tsel[4];
#pragma unroll
                    for (int e = 0; e < 4; ++e) tsel[e] = g == 0 ? Tr[e] : (g == 1 ? Tr[4 + e] : (g == 2 ? Tr[8 + e] : Tr[12 + e]));
                    v2u tf2; tf2.x = pk2(tsel[0], tsel[1]); tf2.y = pk2(tsel[2], tsel[3]);
                    const bf16x8 Tf = mk8(tf2, Z2), RBf = mk8(cvt4(RBt), Z2);
                    f32x4 AhT[4], QhT[4], Ah[4], rin[4]; bf16x8 Alo[4];
#pragma unroll
                    for (int ct = 0; ct < 4; ++ct) { Alo[ct] = mk8(trd(A0 + sw16(4 * g + q_, 2 * ct + (p_ >> 1)) + (p_ & 1) * 8), Z2);
                        const v2u rw = *(const LAS v2u*)(A0 + 6144 + sw16(kl, 2 * ct + (g >> 1)) + (g & 1) * 8);
                        rin[ct] = (f32x4){bflo(rw.x), bfhi(rw.x), bflo(rw.y), bfhi(rw.y)}; }
#pragma unroll
                    for (int ct = 0; ct < 4; ++ct) { AhT[ct] = __builtin_amdgcn_mfma_f32_16x16x32_bf16(Alo[ct], Tf, Z4, 0, 0, 0);
                        Ah[ct] = __builtin_amdgcn_mfma_f32_16x16x32_bf16(Tf, Alo[ct], Z4, 0, 0, 0); }
#pragma unroll
                    for (int ct = 0; ct < 4; ++ct) QhT[ct] = __builtin_amdgcn_mfma_f32_16x16x32_bf16(mk8(cvt4(Ah[ct]), Z2), RBf, rin[ct], 0, 0, 0);
                    STE(13); STB(14);
                    LAS unsigned char* fr = lds + FR + q * 7168 + lane * 16;
                    *(LAS bf16x8*)(fr) = mk8(cvt4(AhT[0]), cvt4(AhT[1])); *(LAS bf16x8*)(fr + 1024) = mk8(cvt4(AhT[2]), cvt4(AhT[3]));
                    *(LAS bf16x8*)(fr + 2048) = mk8(cvt4(QhT[0]), cvt4(QhT[1])); *(LAS bf16x8*)(fr + 3072) = mk8(cvt4(QhT[2]), cvt4(QhT[3]));
                    *(LAS bf16x8*)(fr + 4096) = mk8(cvt4(AKt), Z2); *(LAS bf16x8*)(fr + 5120) = mk8(cvt4(RBt), cvt4(RKt)); *(LAS bf16x8*)(fr + 6144) = Tf;
                    STE(14);
                    __builtin_amdgcn_s_setprio(0);
                }
                STE(8); STE(10);
                __syncthreads();
                STE(5); STB(6);
                lane = opq(lane0); c = lane; kl = lane & 15; g = lane >> 4; q_ = kl >> 2; p_ = kl & 3;
                if (wv >= 4) { BGC_WINDOW(); if (grp + 1 < ngrp) CSC_PREFETCH(grp + 1); }
                if (wv < 4) { __builtin_amdgcn_s_setprio(3); const int vt = opqs(wv);
#pragma unroll 1
                    for (int q = 0; q < 4; ++q) { const LAS unsigned char* A0 = lds + ARR + q * (7 * 2048); const LAS unsigned char* fr = lds + FR + q * 7168 + lane * 16;
                        const bf16x8 Ap0 = *(const LAS bf16x8*)(fr), Ap1 = *(const LAS bf16x8*)(fr + 1024), Qp0 = *(const LAS bf16x8*)(fr + 2048), Qp1 = *(const LAS bf16x8*)(fr + 3072);
                        const bf16x8 AKf = *(const LAS bf16x8*)(fr + 4096), RBRK = *(const LAS bf16x8*)(fr + 5120), Tf = *(const LAS bf16x8*)(fr + 6144);
                        const v2u vtr = trd(A0 + 12288 + sw16(4 * g + q_, 2 * vt + (p_ >> 1)) + (p_ & 1) * 8);
                        bf16x8 bk[4]; f32x4 wl[4];
#pragma unroll
                        for (int ct = 0; ct < 4; ++ct) { wl[ct] = *(const LAS f32x4*)(lds + WLO + (q * 64 + 16 * ct + 4 * g) * 4); const int o = sw16(4 * g + q_, 2 * ct + (p_ >> 1)) + (p_ & 1) * 8; bk[ct] = mk8(trd(A0 + 2048 + o), trd(A0 + 4096 + o)); }
                        const f32x4 X1 = __builtin_amdgcn_mfma_f32_16x16x32_bf16(AKf, mk8(vtr, Z2), Z4, 0, 0, 0);
                        const f32x4 Uh = __builtin_amdgcn_mfma_f32_16x16x32_bf16(Tf, mk8(cvt4(X1), Z2), Z4, 0, 0, 0);
                        const f32x4 Yh = __builtin_amdgcn_mfma_f32_16x16x32_bf16(RBRK, mk8(cvt4(Uh), vtr), Z4, 0, 0, 0);
                        const bf16x8 bs0 = mk8(cvt4(St[0]), cvt4(St[1])), bs1 = mk8(cvt4(St[2]), cvt4(St[3]));
                        f32x4 U = __builtin_amdgcn_mfma_f32_16x16x32_bf16(Ap0, bs0, Uh, 0, 0, 0); U = __builtin_amdgcn_mfma_f32_16x16x32_bf16(Ap1, bs1, U, 0, 0, 0);
                        f32x4 Y = __builtin_amdgcn_mfma_f32_16x16x32_bf16(Qp0, bs0, Yh, 0, 0, 0); Y = __builtin_amdgcn_mfma_f32_16x16x32_bf16(Qp1, bs1, Y, 0, 0, 0);
                        const bf16x8 UV = mk8(cvt4(U), vtr);
#pragma unroll
                        for (int ct = 0; ct < 4; ++ct) St[ct] = __builtin_amdgcn_mfma_f32_16x16x32_bf16(bk[ct], UV, St[ct], 0, 0, 0) * wl[ct];
#pragma unroll
                        for (int j = 0; j < 4; ++j) { const int sg = s0 + 16 * q + 4 * g + j; const int t = d ? (T - 1 - sg) : sg; YD[((size_t)d * NTOK + rowbase + t) * 512 + h * 64 + 16 * vt + kl] = Y[j]; }
                    }
                    __builtin_amdgcn_s_setprio(0);
                }
                __syncthreads();
                STE(6);
            }
#undef CSC_PREFETCH
        }
        if (cpend >= 0) { bgc::finish(a, l, cpend, opq(lane0), wv & 3, lds, cvt_); cpend = -1; }
        for (; cit < bgc::NITEMS; cit += cstride) { bgc::issue(a, l, cit, opq(lane0), cvt_); bgc::finish(a, l, cit, opq(lane0), wv & 3, lds, cvt_); }
#undef BGC_WINDOW
    }
    if (SCAN_STAMP != 0 && blockIdx.x == 0 && tid == ((SCAN_STAMP == 8 || (SCAN_STAMP >= 11 && SCAN_STAMP <= 14)) ? 256 : ((SCAN_STAMP == 10) ? 448 : 0))) atomicAdd((unsigned*)(a.ws() + WS_CTL) + 2000, tacc_);
}
constexpr int PH_PER_LAYER = 11, N_PHASES = 1 + 2 * PH_PER_LAYER;
template <int K> __device__ __forceinline__ void run_phase(LAS unsigned char* lds, int l) {
    if constexpr (K == 0) phase_prologue(lds);
    if constexpr (K == 1) phase_modconv(lds, l);
    if constexpr (K == 3) phase_scan(lds, l);
    if constexpr (K == 4) phase_attn(lds, l);
    if constexpr (K == 5) phase_rwpost(lds, l);
    if constexpr (K == 7) { if (l == 0) phase_ln1_route<false>(lds, l); else phase_ln1_route<true>(lds, l); }
    if constexpr (K == 8) phase_gather(lds, l);
    if constexpr (K == 11) phase_ln2(lds, l);
    if constexpr (K == 2 || K == 6 || K == 9 || K == 10) {
        const KA a = ka_get(); unsigned char* ws = a.ws(); const int G = gridDim.x, bid = blockIdx.x;
        bf16* X1 = (bf16*)(ws + WS_X1); bf16* X2 = (bf16*)(ws + WS_X2); bf16* X3 = (bf16*)(ws + WS_X3);
        if constexpr (K == 2) { __syncthreads();
            pg8::Gemm g{X1, (const bf16*)(ws + WS_WINT) + (size_t)l * DINP * DM, NTOK, DINP, DM}; pg8::StaticOrder S; S.init(NTOK, DINP, G, bid);
            pg8::EpiBf16 E{X2, DINP}; pg8::gemm_phase<pg8::EpiBf16, pg8::StaticOrder, true, true>(lds, g, S, E); }
        if constexpr (K == 6) { __syncthreads();
            const int Mrows = (l == 0) ? NTOK : NTX;
            pg8::Gemm g{X1, (const bf16*)(ws + WS_WOT) + (size_t)l * DM * DM, Mrows, DM, DM}; pg8::StaticOrder S; S.init(Mrows, DM, G, bid);
            pg8::EpiBf16 E{X3, DM}; pg8::gemm_phase<pg8::EpiBf16, pg8::StaticOrder, true, true>(lds, g, S, E); }
        if constexpr (K == 9) { moe_tables<false>(lds, l);
            pg8::Gemm g{X2, (const bf16*)(ws + WS_W13T), MAXSLOT, 1024, DM}; pg8::MoeOrder S; S.init((const LAS int*)(lds + PREF_OFF), 4, G, bid);
            pg8::EpiSwiGLU E{X3, DEXP}; pg8::gemm_phase<pg8::EpiSwiGLU, pg8::MoeOrder, true, true>(lds, g, S, E); }
        if constexpr (K == 10) { moe_tables<false>(lds, l);
            pg8::Gemm g{X3, (const bf16*)(ws + WS_W2T), MAXSLOT, 1024, DEXP}; pg8::MoeOrder S; S.init((const LAS int*)(lds + PREF_OFF), 4, G, bid);
            pg8::EpiBf16 E{X2, DM}; pg8::gemm_phase<pg8::EpiBf16, pg8::MoeOrder, true, true>(lds, g, S, E); }
    }
}
__device__ __forceinline__ void grid_sync(LAS unsigned char* lds) {
    const KA a = ka_get(); XcdBarrier b; b.bar = (unsigned*)(a.ws() + WS_CTL) + CW_BAR; b.x = xb_xcc_id(); b.st = (volatile LAS unsigned*)(lds + MISC_OFF) + 8; xcd_barrier(b);
#ifdef PROBE_BAR
    xcd_barrier(b);
#endif
}
#ifndef ONE_LAUNCH
template <int K> __global__ void __launch_bounds__(512, 2) fwd_ph(Args args) {
    extern __shared__ __attribute__((aligned(16))) unsigned char lds_raw[];
    LAS unsigned char* lds = (LAS unsigned char*)lds_raw;
    for (int u = threadIdx.x; u < (LDS_BYTES - LDSCTL_OFF) / 4; u += 512) ((LAS unsigned*)(lds + LDSCTL_OFF))[u] = 0u;
    __syncthreads();
    hw_tid_init();
    __syncthreads();
    run_phase<K>(lds, args.ph_lo);
}
template <int K> static void launch_ph(const Args& a, int grid, hipStream_t stream) {
    static bool attr = false;
    if (!attr) { (void)hipFuncSetAttribute((const void*)fwd_ph<K>, hipFuncAttributeMaxDynamicSharedMemorySize, LDS_BYTES); attr = true; }
    hipLaunchKernelGGL(fwd_ph<K>, dim3(grid), dim3(512), LDS_BYTES, stream, a);
}
#else
__global__ void __launch_bounds__(512, 2) fwd(Args args) {
    extern __shared__ __attribute__((aligned(16))) unsigned char lds_raw[];
    LAS unsigned char* lds = (LAS unsigned char*)lds_raw;
    for (int u = threadIdx.x; u < (LDS_BYTES - LDSCTL_OFF) / 4; u += 512) ((LAS unsigned*)(lds + LDSCTL_OFF))[u] = 0u;
    __syncthreads();
    hw_tid_init();
    __syncthreads();
    (void)xcd_barrier_post((unsigned*)(args.ws + WS_CTL) + CW_BAR, (volatile LAS unsigned*)(lds + MISC_OFF) + 8);
    run_phase<0>(lds, 0);
#ifdef PROBE_P0
    __syncthreads(); run_phase<0>(lds, 0);
#endif
    grid_sync(lds);
#ifndef PROBE_REP
#define PROBE_REP -1
#endif
#define RUNP(K) do { run_phase<K>(lds, l); if (PROBE_REP == K) { __syncthreads(); run_phase<K>(lds, l); } } while (0)
    for (int l = 0; l < 2; ++l) {
        if (l == 0) { RUNP(1); grid_sync(lds); }
        RUNP(2); grid_sync(lds);
        RUNP(3);
        RUNP(4); grid_sync(lds);
        RUNP(5); grid_sync(lds);
        RUNP(6); grid_sync(lds);
        run_phase<7>(lds, l); if (PROBE_REP == 7 && l == 0) { __syncthreads(); run_phase<7>(lds, l); } grid_sync(lds);
        RUNP(8); grid_sync(lds);
        RUNP(9); grid_sync(lds);
        RUNP(10); grid_sync(lds);
        RUNP(11); if (l == 0) grid_sync(lds);
    }
#if defined(SCAN_STAMP) && SCAN_STAMP != 0
    if (blockIdx.x == 0 && hw_tid() == 0) { const unsigned long long tk = __hip_atomic_load((unsigned*)(args.ws + WS_CTL) + 2000, __ATOMIC_RELAXED, __HIP_MEMORY_SCOPE_AGENT); const unsigned long long ts = __builtin_amdgcn_s_memrealtime(); while (__builtin_amdgcn_s_memrealtime() - ts < tk) __builtin_amdgcn_s_sleep(8); }
#endif
}
#endif

extern "C" void kernel_launch(void* const* d_in, const int* in_sizes, int n_in, void* d_out, int out_size, void* d_ws, size_t ws_size, hipStream_t stream) {
    static int grid = 0;
    if (grid == 0) {
        if (n_in != 30 || in_sizes[0] != NTX * DM || out_size != NTX * DM || ws_size < WS_END) {
            fprintf(stderr, "kernel_launch: unexpected problem (n_in %d, in0 %d, out %d, ws %zu < %zu?); nothing launched\n", n_in, n_in > 0 ? in_sizes[0] : -1, out_size, ws_size, (size_t)WS_END); grid = -1; return; }
        int dev = 0, cus = 0;
        if (hipGetDevice(&dev) != hipSuccess || hipDeviceGetAttribute(&cus, hipDeviceAttributeMultiprocessorCount, dev) != hipSuccess) { grid = -1; return; }
#ifdef ONE_LAUNCH
        if (hipFuncSetAttribute((const void*)fwd, hipFuncAttributeMaxDynamicSharedMemorySize, LDS_BYTES) != hipSuccess) { fprintf(stderr, "kernel_launch: hipFuncSetAttribute failed\n"); grid = -1; return; }
#endif
        (void)hipGetLastError();
        grid = cus > 0 ? cus : 256;
        if (grid < 72) { fprintf(stderr, "kernel_launch: %d CUs: LN2 keeps a wave's (<= 64) rows' routing records in one register\n", grid); grid = -1; return; }
    }
    if (grid < 0) return;
    if (hipMemsetAsync((char*)d_ws + WS_CTL, 0, CTL_ZERO_BYTES, stream) != hipSuccess) return;
    Args a{};
    for (int i = 0; i < 30; ++i) a.in[i] = (const float*)d_in[i];
    a.out = (float*)d_out; a.ws = (unsigned char*)d_ws; a.ph_lo = 0; a.ph_hi = 0;
#ifndef ONE_LAUNCH
    launch_ph<0>(a, grid, stream);
    for (int l = 0; l < 2; ++l) { a.ph_lo = l;
        launch_ph<1>(a, grid, stream); launch_ph<2>(a, grid, stream); launch_ph<3>(a, grid, stream); launch_ph<4>(a, grid, stream); launch_ph<5>(a, grid, stream); launch_ph<6>(a, grid, stream);
        launch_ph<7>(a, grid, stream); launch_ph<8>(a, grid, stream); launch_ph<9>(a, grid, stream); launch_ph<10>(a, grid, stream); launch_ph<11>(a, grid, stream); }
#else
    hipLaunchKernelGGL(fwd, dim3(grid), dim3(512), LDS_BYTES, stream, a);
#endif
}
```

```cpp
#define ONE_LAUNCH 1
#include <hip/hip_runtime.h>
#include <cstdio>
#include <cstdint>

constexpr int DM = 1024, NB = 16, SEQ = 2048, CTXL = 256, NTX = NB * SEQ, NTC = NB * CTXL, NTOK = NTX + NTC;
constexpr int DIN = 3296, DINP = 3328, RWOFF = 1536, NHEAD = 8, HD = 64;
constexpr int NEXP = 32, DEXP = 512, LISTCAP = 2 * NTOK;
constexpr int MAXSLOT = 81920;
constexpr float ALPHA = 1.41421356237309515f, LN_EPS = 1e-6f, GN_EPS = 64e-5f;

constexpr size_t MiB = 1u << 20;
constexpr size_t WS_CTL = 0, CTL_ZERO_BYTES = 1 * MiB;
constexpr size_t WS_MODS = 1 * MiB;
constexpr size_t WS_ROPE = 2 * MiB;
constexpr size_t WS_WINT = 3 * MiB;
constexpr size_t WS_WOT = 16 * MiB;
constexpr size_t WS_W13T = 20 * MiB;
constexpr size_t WS_W2T = 84 * MiB;
constexpr size_t WS_LIST = 116 * MiB;
constexpr size_t WS_TOK = 125 * MiB;
constexpr size_t WS_BONUS = 127 * MiB;
constexpr size_t WS_CS = 130 * MiB;
constexpr size_t WS_X1 = 146 * MiB;
constexpr size_t WS_X2 = 218 * MiB;
constexpr size_t WS_XP = WS_X2 + 160 * MiB;
constexpr size_t WS_X3 = 452 * MiB;
constexpr size_t WS_END = 596 * MiB;
static_assert(WS_WINT + (size_t)2 * DINP * DM * 2 <= WS_WOT && WS_LIST + (size_t)NEXP * LISTCAP * 4 <= WS_TOK && WS_TOK + (size_t)NTOK * 32 <= WS_BONUS, "ws map");
static_assert(WS_BONUS + (size_t)2 * NTOK * 8 * 4 <= WS_CS && WS_X2 + (size_t)NTOK * DINP * 2 <= WS_X3 && WS_X3 + (size_t)2 * NTOK * 512 * 4 <= WS_END, "ws map");
static_assert((size_t)MAXSLOT * 1024 * 2 <= WS_XP - WS_X2 && WS_XP + (size_t)NTOK * DM * 2 <= WS_X3 && (size_t)MAXSLOT * 512 * 2 <= WS_END - WS_X3, "ws map");
constexpr int CW_BAR = 4096;
constexpr int CW_CNT = 8192;
constexpr int RING_BYTES = 131072, LDSCTL_OFF = RING_BYTES, MISC_OFF = LDSCTL_OFF + 320, LDS_BYTES = 147456;
constexpr int PREF_OFF = LDSCTL_OFF + 512;

#define GAS __attribute__((address_space(1)))
#define LAS __attribute__((address_space(3)))
typedef unsigned short bf16;
typedef unsigned v4u __attribute__((ext_vector_type(4)));
typedef unsigned v2u __attribute__((ext_vector_type(2)));
typedef float f32x4 __attribute__((ext_vector_type(4)));
typedef short bf16x8 __attribute__((ext_vector_type(8)));
typedef GAS unsigned gu32;
#define RLX_AGENT __ATOMIC_RELAXED, __HIP_MEMORY_SCOPE_AGENT
#define LDS_WAIT() asm volatile("s_waitcnt lgkmcnt(0)" ::: "memory")
#define VM_WAIT() asm volatile("s_waitcnt vmcnt(0)" ::: "memory")
__device__ __forceinline__ unsigned f2bf(float f) { unsigned u = __builtin_bit_cast(unsigned, f); return (u + 0x7fffu + ((u >> 16) & 1u)) >> 16; }
typedef float f32x2_t_ __attribute__((ext_vector_type(2))); typedef __bf16 bf16x2_t_ __attribute__((ext_vector_type(2)));
__device__ __forceinline__ unsigned pk2(float lo, float hi) { f32x2_t_ v = {lo, hi}; bf16x2_t_ b = __builtin_convertvector(v, bf16x2_t_); return __builtin_bit_cast(unsigned, b); }
__device__ __forceinline__ unsigned short f2bf1(float f) { return (unsigned short)(pk2(f, 0.f) & 0xffffu); }
__device__ __forceinline__ float bf2f(unsigned short v) { return __builtin_bit_cast(float, (unsigned)v << 16); }
__device__ __forceinline__ float bflo(unsigned w) { return __builtin_bit_cast(float, w << 16); }
__device__ __forceinline__ float bfhi(unsigned w) { return __builtin_bit_cast(float, w & 0xffff0000u); }
__device__ __forceinline__ float sigmoidf_(float x) { return 1.0f / (1.0f + expf(-x)); }
__device__ __forceinline__ float shx(float v, int k, int lane) { return __builtin_bit_cast(float, __builtin_amdgcn_ds_bpermute((lane ^ k) << 2, __builtin_bit_cast(int, v))); }
__device__ __forceinline__ float shi(float v, int src) { return __builtin_bit_cast(float, __builtin_amdgcn_ds_bpermute(src << 2, __builtin_bit_cast(int, v))); }
template <int CTRL> __device__ __forceinline__ float dppmov(float v) { return __builtin_bit_cast(float, __builtin_amdgcn_update_dpp(0, __builtin_bit_cast(int, v), CTRL, 0xF, 0xF, true)); }
__device__ __forceinline__ float wave_sum(float v) {
    v += dppmov<0xB1>(v); v += dppmov<0x4E>(v); v += dppmov<0x141>(v); v += dppmov<0x140>(v);
    const int iv = __builtin_bit_cast(int, v);
    return (__builtin_bit_cast(float, __builtin_amdgcn_readlane(iv, 0)) + __builtin_bit_cast(float, __builtin_amdgcn_readlane(iv, 16))) + (__builtin_bit_cast(float, __builtin_amdgcn_readlane(iv, 32)) + __builtin_bit_cast(float, __builtin_amdgcn_readlane(iv, 48)));
}
__device__ __forceinline__ float red8(float v) { v += dppmov<0xB1>(v); v += dppmov<0x4E>(v); v += dppmov<0x141>(v); return v; }

struct TokInfo { int e0, e1, p0, p1; float g0, g1; int pad0, pad1; };

constexpr int WID_OFF = LDSCTL_OFF + 1536;
__device__ __forceinline__ int hw_slot() { return (int)__builtin_amdgcn_s_getreg((5 << 11) | 4) & 63; }
__device__ __forceinline__ int lane_id() { int l; asm volatile("v_mbcnt_lo_u32_b32 %0, -1, 0\n\tv_mbcnt_hi_u32_b32 %0, -1, %0" : "=v"(l)); return l; }
__device__ __forceinline__ void hw_tid_init() { *(volatile LAS int*)(uintptr_t)(WID_OFF + 4 * hw_slot()) = (int)(threadIdx.x >> 6); }
__device__ __forceinline__ int hw_tid() { const int w = *(volatile LAS int*)(uintptr_t)(WID_OFF + 4 * hw_slot()); int t = (__builtin_amdgcn_readfirstlane(w) << 6) | lane_id(); asm volatile("" : "+v"(t)); return t; }
namespace pg8 {
#define PG8_LAS __attribute__((address_space(3)))
typedef unsigned short bf16_t;
typedef short bf16x8 __attribute__((ext_vector_type(8)));
typedef float f32x4 __attribute__((ext_vector_type(4)));
typedef unsigned u32x4 __attribute__((ext_vector_type(4)));
constexpr int BM = 256, BK = 64, HALF = 128, HTB = HALF * BK * 2  , STAGE_BYTES = 8 * HTB, NXCD = 8, WGM = 8;

__host__ __device__ __forceinline__ int lds_byte(int r, int c) { const int st = (r >> 4) * 2 + (c >> 5), rr = r & 15, cc = c & 31, ob = rr * 64 + cc * 2; return st * 1024 + (ob ^ (((ob >> 9) & 1) << 5)); }
__host__ __device__ __forceinline__ void stage_rc(int b, int& R, int& C) { const int st = b / 1024, sb = b % 1024, swz = sb ^ (((sb >> 9) & 1) << 5); R = (st >> 1) * 16 + swz / 64; C = (st & 1) * 32 + (swz % 64) / 2; }
__host__ __device__ __forceinline__ int perm32(int rho) { const int n = rho >> 4, i = rho & 15; return 8 * (i >> 2) + 4 * n + (i & 3); }

struct Unit { int pm, pn, pnb; };
struct Gemm { const bf16_t* A; const bf16_t* Bt; int M, N, K; };

struct StaticOrder {
    int nM, nN, nwg, G, c;
    __host__ __device__ void init(int M, int N, int G_, int c_) { nM = M / BM; nN = N / BM; nwg = nM * nN; G = G_; c = c_; }
    __host__ __device__ bool next(int i, Unit& u) const {
        const long L = (long)i * G + c; if (L >= nwg) return false;
        int wgid = (int)L; { const int q = nwg / NXCD, r = nwg % NXCD, xcd = wgid % NXCD, off = wgid / NXCD; wgid = (xcd < r ? xcd * (q + 1) : r * (q + 1) + (xcd - r) * q) + off; }
        const int nig = WGM * nN, gid = wgid / nig, fm = gid * WGM, gsz = (nM - fm) < WGM ? (nM - fm) : WGM;
        u.pm = fm + ((wgid % nig) % gsz); u.pn = (wgid % nig) / gsz; u.pnb = u.pn; return true;
    }
    __device__ __forceinline__ void a_ready(const Unit&) const {}
    __device__ __forceinline__ void done(const Unit&) const {}
};

__device__ __forceinline__ unsigned cvt_pk_bf16(float lo, float hi) { unsigned r; asm volatile("v_cvt_pk_bf16_f32 %0, %1, %2" : "=v"(r) : "v"(lo), "v"(hi)); return r; }
template <class Epi, class Sched, bool ALIGN_EPI = false, bool SP2 = false>
__device__ __forceinline__ void gemm_phase(PG8_LAS unsigned char* lds, const Gemm g, const Sched& S, const Epi& E) {
    const int tid = hw_tid(), wid = __builtin_amdgcn_readfirstlane(tid >> 6), lane = tid & 63, wr = wid >> 2, wc = wid & 3, fr = lane & 15, fq = lane >> 4;
    const int K = g.K, nt = K / BK;
    unsigned voffA[2], voffB[2];
#pragma unroll
    for (int i = 0; i < 2; ++i) { int R, C; stage_rc(tid * 16 + i * 8192, R, C); const int Rb = Epi::PERM ? ((R & ~31) + perm32(R & 31)) : R;
        voffA[i] = (unsigned)(R * K + C) * 2u; voffB[i] = (unsigned)(Rb * K + C) * 2u; }
    const size_t kstep = (size_t)(BK * 2);
    const size_t hstep = (size_t)HALF * K * 2;
    const size_t tstep = 2 * hstep;
    const unsigned ldsw = (unsigned)wid * 1024u;
    const int aoff = lds_byte(wr * 64 + fr, fq * 8), boff = lds_byte(wc * 32 + fr, fq * 8);
#define PG8_SA(b, h) (((b) * 2 + (h)) * HTB)
#define PG8_SB(b, h) ((4 + (b) * 2 + (h)) * HTB)
#define PG8_STAGE(bufoff, gbase, voff) do { _Pragma("unroll") for (int _i = 0; _i < 2; ++_i) \
        __builtin_amdgcn_global_load_lds((const unsigned*)((const char*)(gbase) + (voff)[_i]), (PG8_LAS unsigned*)(lds + (bufoff) + ldsw + _i * 8192), 16, 0, 0); } while (0)
#define PG8_LDA(dst, b, h) do { _Pragma("unroll") for (int m = 0; m < 4; ++m) _Pragma("unroll") for (int k = 0; k < 2; ++k) dst[m][k] = *(const PG8_LAS bf16x8*)(lds + PG8_SA(b, h) + aoff + m * 2048 + k * 1024); } while (0)
#define PG8_LDB(dst, b, h) do { _Pragma("unroll") for (int n = 0; n < 2; ++n) _Pragma("unroll") for (int k = 0; k < 2; ++k) dst[n][k] = *(const PG8_LAS bf16x8*)(lds + PG8_SB(b, h) + boff + n * 2048 + k * 1024); } while (0)
#define PG8_MMA(ai, bj, At, Bt) do { __builtin_amdgcn_s_setprio(1); _Pragma("unroll") for (int m = 0; m < 4; ++m) _Pragma("unroll") for (int n = 0; n < 2; ++n) _Pragma("unroll") for (int k = 0; k < 2; ++k) \
        acc[ai][bj][m][n] = __builtin_amdgcn_mfma_f32_16x16x32_bf16(Bt[n][k], At[m][k], acc[ai][bj][m][n], 0, 0, 0); __builtin_amdgcn_s_setprio(0); } while (0)
#define PG8_WAIT_V(n) asm volatile("s_waitcnt vmcnt(" #n ")" ::: "memory")
#define PG8_WAIT_L(n) asm volatile("s_waitcnt lgkmcnt(" #n ")" ::: "memory")
#define PG8_BAR __builtin_amdgcn_s_barrier()
#define PG8_SCHED __builtin_amdgcn_sched_barrier(0)
    Unit cur, nxt; int ui = 0;
    if (!S.next(0, cur)) return;
    f32x4 acc[2][2][4][2];
#pragma unroll
    for (int a = 0; a < 2; ++a)
#pragma unroll
        for (int b = 0; b < 2; ++b)
#pragma unroll
            for (int m = 0; m < 4; ++m)
#pragma unroll
                for (int n = 0; n < 2; ++n) acc[a][b][m][n] = (f32x4){0.f, 0.f, 0.f, 0.f};
    bf16x8 At[4][2], B0[2][2], B1[2][2];
    const char* cA = (const char*)g.A + (size_t)cur.pm * tstep; const char* cB = (const char*)g.Bt + (size_t)cur.pnb * tstep;
    S.a_ready(cur);
    if constexpr (SP2) {
        PG8_STAGE(PG8_SB(0, 0), cB, voffB); PG8_STAGE(PG8_SB(0, 1), cB + hstep, voffB); PG8_STAGE(PG8_SA(0, 0), cA, voffA); PG8_STAGE(PG8_SA(0, 1), cA + hstep, voffA);
        if (wr == 1) PG8_BAR;
        PG8_WAIT_V(2); PG8_BAR;
        PG8_STAGE(PG8_SB(1, 0), cB + kstep, voffB); PG8_STAGE(PG8_SA(1, 0), cA + kstep, voffA); PG8_STAGE(PG8_SB(1, 1), cB + hstep + kstep, voffB);
        PG8_WAIT_V(6); PG8_BAR;
    } else {
        PG8_STAGE(PG8_SB(0, 0), cB, voffB); PG8_STAGE(PG8_SA(0, 0), cA, voffA); PG8_STAGE(PG8_SB(0, 1), cB + hstep, voffB); PG8_STAGE(PG8_SA(0, 1), cA + hstep, voffA);
        if (wr == 1) PG8_BAR;
        PG8_WAIT_V(4); PG8_BAR;
        PG8_STAGE(PG8_SB(1, 0), cB + kstep, voffB); PG8_STAGE(PG8_SA(1, 0), cA + kstep, voffA); PG8_STAGE(PG8_SB(1, 1), cB + hstep + kstep, voffB);
        PG8_WAIT_V(6); PG8_BAR;
    }
    for (;;) {
        const bool has_next = S.next(ui + 1, nxt);
        const char* nA = has_next ? (const char*)g.A + (size_t)nxt.pm * tstep : cA; const char* nB = has_next ? (const char*)g.Bt + (size_t)nxt.pnb * tstep : cB;
        for (int t = 0; t < nt; t += 2) {
            const bool last = (t == nt - 2);
            const char* a1 = cA + (size_t)(t + 1) * kstep;
            const char* a2 = last ? nA : cA + (size_t)(t + 2) * kstep; const char* b2 = last ? nB : cB + (size_t)(t + 2) * kstep;
            const char* a3 = a2 + kstep; const char* b3 = b2 + kstep;
            if (last && has_next) S.a_ready(nxt);
            if constexpr (SP2) {
            PG8_LDB(B0, 0, 0); PG8_LDB(B1, 0, 1); PG8_SCHED; PG8_LDA(At, 0, 0); PG8_STAGE(PG8_SA(1, 1), a1 + hstep, voffA);
            PG8_WAIT_V(8); PG8_WAIT_L(0); PG8_BAR; PG8_MMA(0, 0, At, B0); PG8_MMA(0, 1, At, B1); PG8_BAR; PG8_SCHED;
            PG8_LDA(At, 0, 1); PG8_STAGE(PG8_SB(0, 0), b2, voffB); PG8_STAGE(PG8_SB(0, 1), b2 + hstep, voffB); PG8_STAGE(PG8_SA(0, 0), a2, voffA);
            PG8_WAIT_V(8); PG8_WAIT_L(0); PG8_BAR; PG8_MMA(1, 0, At, B0); PG8_MMA(1, 1, At, B1); PG8_BAR; PG8_SCHED;
            PG8_LDB(B0, 1, 0); PG8_LDB(B1, 1, 1); PG8_SCHED; PG8_LDA(At, 1, 0); PG8_STAGE(PG8_SA(0, 1), a2 + hstep, voffA);
            PG8_WAIT_V(8); PG8_WAIT_L(0); PG8_BAR; PG8_MMA(0, 0, At, B0); PG8_MMA(0, 1, At, B1); PG8_BAR; PG8_SCHED;
            PG8_LDA(At, 1, 1); PG8_STAGE(PG8_SB(1, 0), b3, voffB); PG8_STAGE(PG8_SB(1, 1), b3 + hstep, voffB); PG8_STAGE(PG8_SA(1, 0), a3, voffA);
            PG8_WAIT_V(8); PG8_WAIT_L(0); PG8_BAR; PG8_MMA(1, 0, At, B0); PG8_MMA(1, 1, At, B1); PG8_BAR; PG8_SCHED;
            } else {
            PG8_LDB(B0, 0, 0); PG8_SCHED; PG8_LDA(At, 0, 0); PG8_STAGE(PG8_SA(1, 1), a1 + hstep, voffA);
            PG8_WAIT_L(8); PG8_BAR; PG8_WAIT_L(0); PG8_MMA(0, 0, At, B0); PG8_BAR; PG8_SCHED;
            PG8_LDB(B1, 0, 1); PG8_STAGE(PG8_SB(0, 0), b2, voffB);
            PG8_BAR; PG8_WAIT_L(0); PG8_MMA(0, 1, At, B1); PG8_BAR;
            PG8_LDA(At, 0, 1); PG8_STAGE(PG8_SA(0, 0), a2, voffA);
            PG8_BAR; PG8_WAIT_L(0); PG8_MMA(1, 0, At, B0); PG8_BAR; PG8_SCHED;
            PG8_STAGE(PG8_SB(0, 1), b2 + hstep, voffB);
            PG8_WAIT_V(6); PG8_BAR; PG8_MMA(1, 1, At, B1); PG8_BAR;
            PG8_LDB(B0, 1, 0); PG8_SCHED; PG8_LDA(At, 1, 0); PG8_STAGE(PG8_SA(0, 1), a2 + hstep, voffA);
            PG8_WAIT_L(8); PG8_BAR; PG8_WAIT_L(0); PG8_MMA(0, 0, At, B0); PG8_BAR; PG8_SCHED;
            PG8_LDB(B1, 1, 1); PG8_STAGE(PG8_SB(1, 0), b3, voffB);
            PG8_BAR; PG8_WAIT_L(0); PG8_MMA(0, 1, At, B1); PG8_BAR;
            PG8_LDA(At, 1, 1); PG8_STAGE(PG8_SA(1, 0), a3, voffA);
            PG8_BAR; PG8_WAIT_L(0); PG8_MMA(1, 0, At, B0); PG8_BAR; PG8_SCHED;
            PG8_STAGE(PG8_SB(1, 1), b3 + hstep, voffB);
            PG8_WAIT_V(6); PG8_BAR; PG8_MMA(1, 1, At, B1); PG8_BAR;
            }
        }
        if constexpr (ALIGN_EPI) { if (wr == 0) PG8_BAR; }
        if constexpr (!Epi::AFTER_DRAIN) { E(acc, cur, wr, wc, fr, fq); S.done(cur); }
        if (!has_next) break;
#pragma unroll
        for (int a = 0; a < 2; ++a)
#pragma unroll
            for (int b = 0; b < 2; ++b)
#pragma unroll
                for (int m = 0; m < 4; ++m)
#pragma unroll
                    for (int n = 0; n < 2; ++n) acc[a][b][m][n] = (f32x4){0.f, 0.f, 0.f, 0.f};
        cur = nxt; cA = nA; cB = nB; ++ui;
        if constexpr (ALIGN_EPI) { if (wr == 1) PG8_BAR; }
    }
    PG8_WAIT_V(0);
    if constexpr (!ALIGN_EPI) { if (wr == 0) PG8_BAR; }
    PG8_BAR;
    if constexpr (Epi::AFTER_DRAIN) { E.fused(acc, cur, wr, wc, fr, fq, lds, wid, lane); S.done(cur); }
#undef PG8_SA
#undef PG8_SB
#undef PG8_STAGE
#undef PG8_LDA
#undef PG8_LDB
#undef PG8_MMA
#undef PG8_WAIT_V
#undef PG8_WAIT_L
#undef PG8_BAR
#undef PG8_SCHED
}
}
namespace pg8 {
struct EpiBf16 {
    static constexpr bool PERM = true, AFTER_DRAIN = false;
    bf16_t* O; int ldc;
    __device__ __forceinline__ void operator()(const f32x4 (&acc)[2][2][4][2], const Unit& u, int wr, int wc, int fr, int fq) const {
        const int row0 = u.pm * BM + wr * 64 + fr; const int col0 = u.pn * BM + wc * 32 + 8 * fq;
#pragma unroll
        for (int ai = 0; ai < 2; ++ai)
#pragma unroll
            for (int m = 0; m < 4; ++m) { bf16_t* rowp = O + (size_t)(row0 + ai * HALF + m * 16) * ldc + col0;
#pragma unroll
                for (int bj = 0; bj < 2; ++bj) { const f32x4 v0 = acc[ai][bj][m][0], v1 = acc[ai][bj][m][1];
                    u32x4 w; w.x = cvt_pk_bf16(v0[0], v0[1]); w.y = cvt_pk_bf16(v0[2], v0[3]); w.z = cvt_pk_bf16(v1[0], v1[1]); w.w = cvt_pk_bf16(v1[2], v1[3]);
                    *(u32x4*)(rowp + bj * HALF) = w; } }
    }
};
struct EpiSwiGLU {
    static constexpr bool PERM = true, AFTER_DRAIN = false;
    bf16_t* O; int ldc;
    __device__ __forceinline__ void operator()(const f32x4 (&acc)[2][2][4][2], const Unit& u, int wr, int wc, int fr, int fq) const {
        const int row0 = u.pm * BM + wr * 64 + fr; const int col0 = u.pn * HALF + wc * 32 + 8 * fq;
#pragma unroll
        for (int ai = 0; ai < 2; ++ai)
#pragma unroll
            for (int m = 0; m < 4; ++m) { bf16_t* rowp = O + (size_t)(row0 + ai * HALF + m * 16) * ldc + col0;
                float r[8];
#pragma unroll
                for (int n = 0; n < 2; ++n)
#pragma unroll
                    for (int j = 0; j < 4; ++j) { const float a = acc[ai][0][m][n][j], b = acc[ai][1][m][n][j]; r[n * 4 + j] = a * b * __builtin_amdgcn_rcpf(1.0f + __expf(-a)); }
                u32x4 w; w.x = cvt_pk_bf16(r[0], r[1]); w.y = cvt_pk_bf16(r[2], r[3]); w.z = cvt_pk_bf16(r[4], r[5]); w.w = cvt_pk_bf16(r[6], r[7]);
                *(u32x4*)rowp = w; }
    }
};
struct MoeOrder {
    const PG8_LAS int* pref; int nN, G, c, total;
    __device__ __forceinline__ void init(const PG8_LAS int* pref_, int nN_, int G_, int c_) { pref = pref_; nN = nN_; G = G_; c = c_; total = pref_[32] * nN_; }
    __device__ __forceinline__ bool next(int i, Unit& u) const {
        const int L = i * G + c; if (L >= total) return false;
        const int rt = L / nN, pn = L - rt * nN; int e = 0;
#pragma unroll 1
        for (int k = 1; k < 32; ++k) e += (pref[k] <= rt) ? 1 : 0;
        u.pm = rt; u.pn = pn; u.pnb = e * nN + pn; return true;
    }
    __device__ __forceinline__ void a_ready(const Unit&) const {}
    __device__ __forceinline__ void done(const Unit&) const {}
};
}
#define XB_TMO      128
#define XB_XCNT(j)  (256  + 64 * (j))
#define XB_XSUB(j)  (1280 + 64 * (j))
#define XB_XGEN(j)  (2304 + 64 * (j))
#define XB_TOP      3328
#define XB_TOPGEN   3392
#define XCD_BAR_WORDS 3456
#define XB_SPIN_CAP (1u << 22)

__device__ __forceinline__ unsigned xb_ld(unsigned* p)              { return __hip_atomic_load(p, __ATOMIC_RELAXED, __HIP_MEMORY_SCOPE_AGENT); }
__device__ __forceinline__ unsigned xb_add(unsigned* p, unsigned v) { return __hip_atomic_fetch_add(p, v, __ATOMIC_RELAXED, __HIP_MEMORY_SCOPE_AGENT); }
__device__ __forceinline__ unsigned xb_xcc_id() { return (unsigned)__builtin_amdgcn_s_getreg((3 << 11) | 20) & 0xFu; }
#define XB_SPIN(cond, bar) do { unsigned _sp = 0; while (cond) { __builtin_amdgcn_s_sleep(1); \
    if ((++_sp & 255u) == 0u) { if (xb_ld(&(bar)[XB_TMO])) break; if (_sp > XB_SPIN_CAP) { atomicAdd(&(bar)[XB_TMO], 1u); break; } } } } while (0)

struct XcdBarrier {
    unsigned* bar; unsigned x;
    volatile LAS unsigned* st;
};

__device__ __forceinline__ XcdBarrier xcd_barrier_post(unsigned* bar, volatile LAS unsigned* st) {
    XcdBarrier b; b.bar = bar; b.x = xb_xcc_id(); b.st = st;
    if (hw_tid() == 0) (void)xb_add(&bar[XB_XCNT(b.x)], 1u);
    return b;
}
__device__ __forceinline__ void xcd_barrier_complete(unsigned* bar, unsigned x, unsigned& nloc, unsigned& nx) {
    const unsigned G = gridDim.x * gridDim.y * gridDim.z;
    unsigned sum, cnt, mine, sp = 0u;
    for (;;) {
        sum = 0u; cnt = 0u; mine = 0u;
#pragma unroll
        for (unsigned j = 0; j < 16; ++j) { const unsigned c = xb_ld(&bar[XB_XCNT(j)]); sum += c; cnt += (c > 0u) ? 1u : 0u; mine = (j == x) ? c : mine; }
        if (sum == G) break;
        __builtin_amdgcn_s_sleep(1);
        if ((++sp & 255u) == 0u) { if (xb_ld(&bar[XB_TMO])) break; if (sp > XB_SPIN_CAP) { atomicAdd(&bar[XB_TMO], 1u); break; } }
    }
    nloc = mine > 0u ? mine : 1u; nx = cnt > 0u ? cnt : 1u;
}

__device__ __forceinline__ void xcd_barrier(const XcdBarrier& b) {
    asm volatile("s_waitcnt vmcnt(0)" ::: "memory");
    __syncthreads();
    if (hw_tid() == 0) {
        unsigned* bar = b.bar;
        __builtin_amdgcn_s_waitcnt(0);
        unsigned nloc = b.st[0], nx = b.st[1];
        if (nloc == 0u) { xcd_barrier_complete(bar, b.x, nloc, nx); b.st[0] = nloc; b.st[1] = nx; }
        const unsigned old = xb_add(&bar[XB_XSUB(b.x)], 1u);
        const unsigned gen = old / nloc;
        if (old + 1u == (gen + 1u) * nloc) {
            __builtin_amdgcn_fence(__ATOMIC_RELEASE, "agent");
            asm volatile("s_waitcnt vmcnt(0)" ::: "memory");
            const unsigned og = xb_add(&bar[XB_TOP], 1u);
            const unsigned tg = og / nx;
            if (og + 1u == (tg + 1u) * nx) xb_add(&bar[XB_TOPGEN], 1u);
            else XB_SPIN(xb_ld(&bar[XB_TOPGEN]) == tg, bar);
            __builtin_amdgcn_fence(__ATOMIC_ACQUIRE, "agent");
            xb_add(&bar[XB_XGEN(b.x)], 1u);
            asm volatile("s_waitcnt vmcnt(0)" ::: "memory");
        } else {
            XB_SPIN(xb_ld(&bar[XB_XGEN(b.x)]) == gen, bar);
            __builtin_amdgcn_fence(__ATOMIC_ACQUIRE, "agent");
            asm volatile("s_waitcnt vmcnt(0)" ::: "memory");
        }
    }
    __syncthreads();
}
struct Args { const float* in[30]; float* out; unsigned char* ws; int ph_lo, ph_hi; };
#define CAS __attribute__((address_space(4)))
struct KA { const CAS unsigned char* kp;
    __device__ __forceinline__ const float* in(int i) const { return *(const float* const CAS*)(kp + 8 * i); }
    __device__ __forceinline__ float* out() const { return *(float* const CAS*)(kp + 240); }
    __device__ __forceinline__ unsigned char* ws() const { return *(unsigned char* const CAS*)(kp + 248); } };
__device__ __forceinline__ KA ka_get() { const CAS unsigned char* kp = (const CAS unsigned char*)__builtin_amdgcn_kernarg_segment_ptr(); asm volatile("" : "+s"(kp)); return KA{kp}; }
__device__ __forceinline__ int opaque_tid() { return hw_tid(); }
static_assert(sizeof(Args) == 264, "kernarg layout");
enum { I_X = 0, I_C, I_CTX, I_CCTX, I_ADAW, I_ADAB, I_WIN, I_RPB, I_MUP, I_MUN, I_W0, I_W2, I_A0, I_A2, I_G2, I_KK, I_KA, I_RK, I_GNG, I_GNB, I_WOUT, I_LN1G, I_LN1B, I_LN2G, I_LN2B, I_RW, I_RB, I_EW1, I_EW3, I_EW2 };

__device__ __forceinline__ void transpose_item(const float* W, int N, int k0, int n0, bf16* WT, int ldk, int drow0, LAS float* scr, int lane) {
#pragma unroll 8
    for (int i = 0; i < 32; ++i) { const int kk = 2 * i + (lane >> 5); scr[kk * 33 + (lane & 31)] = W[(size_t)(k0 + kk) * N + n0 + (lane & 31)]; }
    LDS_WAIT(); asm volatile("" ::: "memory");
    const int c = lane & 7;
#pragma unroll
    for (int j = 0; j < 4; ++j) { const int n = (lane >> 3) + 8 * j; const LAS float* s = scr + (8 * c) * 33 + n;
        v4u o; o.x = pk2(s[0 * 33], s[1 * 33]); o.y = pk2(s[2 * 33], s[3 * 33]); o.z = pk2(s[4 * 33], s[5 * 33]); o.w = pk2(s[6 * 33], s[7 * 33]);
        *(GAS v4u*)(WT + (size_t)(drow0 + n) * ldk + k0 + 8 * c) = o; }
    LDS_WAIT(); asm volatile("" ::: "memory");
}

__device__ __forceinline__ void phase_prologue(LAS unsigned char* lds) {
    const KA a = ka_get();
    const int tid = opaque_tid(), lane = tid & 63, wave = __builtin_amdgcn_readfirstlane(tid >> 6), G = gridDim.x, bid = blockIdx.x;
    const int gw = bid * 8 + wave, NGW = G * 8;
    bf16* WINT = (bf16*)(a.ws() + WS_WINT); bf16* WOT = (bf16*)(a.ws() + WS_WOT);
    LAS float* scr = (LAS float*)(lds + wave * 16384);
    constexpr int I_IN = 16 * 103, I_OUT = 16 * 32, I_L = I_IN + I_OUT;
    for (int it = gw; it < 2 * I_L; it += NGW) {
        const int l = it / I_L; int r = it - l * I_L;
        if (r < I_IN) { const int kb = r / 103, nb = r - kb * 103; transpose_item(a.in(I_WIN) + (size_t)l * DM * DIN, DIN, 64 * kb, 32 * nb, WINT + (size_t)l * DINP * DM, DM, 32 * nb, scr, lane); }
        else { r -= I_IN; const int kb = r >> 5, nb = r & 31; transpose_item(a.in(I_WOUT) + (size_t)l * DM * DM, DM, 64 * kb, 32 * nb, WOT + (size_t)l * DM * DM, DM, 32 * nb, scr, lane); }
    }
    for (int i = bid * 512 + tid; i < 8192; i += G * 512) { const int l = i >> 12, r = i & 4095; *(GAS v4u*)(WINT + (size_t)l * DINP * DM + (size_t)DIN * DM + (size_t)r * 8) = (v4u){0u, 0u, 0u, 0u}; }
    { float* rp = (float*)(a.ws() + WS_ROPE); const int i = bid * 512 + tid;
      if (i < 1536) { const int idx = i < 512 ? i : i - 512; const int p = idx >> 4, f = idx & 15; const double inv = exp(-(double)f * (9.210340371976184 / 16.0)); const double ang = (double)p * inv;
          const float cs = (float)cos(ang), sn = (float)sin(ang); if (i < 512) { rp[idx] = cs; rp[512 + idx] = sn; } else { rp[1024 + idx] = cs; rp[2048 + idx] = sn; } } }
    __syncthreads();
    LAS float* sl = (LAS float*)lds; LAS float* red = (LAS float*)(lds + 69632);
    for (int i = tid; i < 17 * 1024; i += 512) { const int r = i >> 10, k = i & 1023; const float v = r < 16 ? a.in(I_C)[r * 1024 + k] : a.in(I_CCTX)[k]; sl[i] = v / (1.0f + expf(-v)); }
    __syncthreads();
    float* mods = (float*)(a.ws() + WS_MODS);
    for (int it = bid; it < 192; it += G) {
        const int l = it / 96, ch = it - l * 96; const int kq = tid >> 6, cl = tid & 63, col = ch * 64 + cl;
        const float* W = a.in(I_ADAW) + (size_t)l * DM * 6144 + col;
        float acc[17];
#pragma unroll
        for (int r = 0; r < 17; ++r) acc[r] = 0.f;
        for (int k0 = kq * 128; k0 < kq * 128 + 128; k0 += 8) { float w8[8];
#pragma unroll
            for (int q = 0; q < 8; ++q) w8[q] = W[(size_t)(k0 + q) * 6144];
#pragma unroll
            for (int r = 0; r < 17; ++r) { const f32x4 s0 = *(const LAS f32x4*)(sl + r * 1024 + k0), s1 = *(const LAS f32x4*)(sl + r * 1024 + k0 + 4);
                acc[r] += s0.x * w8[0] + s0.y * w8[1] + s0.z * w8[2] + s0.w * w8[3] + s1.x * w8[4] + s1.y * w8[5] + s1.z * w8[6] + s1.w * w8[7]; } }
#pragma unroll
        for (int r = 0; r < 17; ++r) red[(kq * 17 + r) * 64 + cl] = acc[r];
        __syncthreads();
        for (int i = tid; i < 17 * 64; i += 512) { const int r = i >> 6, c2 = i & 63; float s = 0.f;
#pragma unroll
            for (int q = 0; q < 8; ++q) s += red[(q * 17 + r) * 64 + c2];
            mods[((size_t)l * 17 + r) * 6144 + ch * 64 + c2] = s + a.in(I_ADAB)[l * 6144 + ch * 64 + c2]; }
        __syncthreads();
    }
}

__device__ __forceinline__ void phase_modconv(LAS unsigned char* lds, int l) {
    const KA a = ka_get();
    const int tid = opaque_tid(), lane = tid & 63, wave = __builtin_amdgcn_readfirstlane(tid >> 6), G = gridDim.x, bid = blockIdx.x;
    const int gw = bid * 8 + wave, NGW = G * 8;
    const float* mods = (const float*)(a.ws() + WS_MODS) + (size_t)l * 17 * 6144;
    bf16* XM = (bf16*)(a.ws() + WS_X1);
    const float* xs = a.in(I_X); const float* cs = a.in(I_CTX);
    for (int m = gw; m < NTOK; m += NGW) {
        const float* src; int mr;
        if (m < NTX) { src = xs + (size_t)m * DM; mr = m / SEQ; } else { src = cs + (size_t)(m - NTX) * DM; mr = 16; }
        const GAS f32x4* xr = (const GAS f32x4*)src + lane; const GAS f32x4* sh = (const GAS f32x4*)(mods + (size_t)mr * 6144) + lane; const GAS f32x4* sc = sh + 256;
        GAS v2u* o8 = (GAS v2u*)(XM + (size_t)m * DM) + lane;
#pragma unroll
        for (int j = 0; j < 4; ++j) { const f32x4 v = xr[64 * j], s = sh[64 * j], c = sc[64 * j]; const f32x4 r = v * (c + 1.0f) + s; v2u w; w.x = pk2(r.x, r.y); w.y = pk2(r.z, r.w); o8[64 * j] = w; }
    }
}

__device__ __forceinline__ void phase_scan_direct(LAS unsigned char* lds, int l) {
    const KA a = ka_get();
    constexpr int TB = 32;
    const int tid = opaque_tid(), lane = tid & 63, wv = __builtin_amdgcn_readfirstlane(tid >> 6);
    LAS float* ops = (LAS float*)lds;
    LAS float* scal = (LAS float*)(lds + 49152);
    LAS float* zl = (LAS float*)(lds + 49664);
    LAS float* rkraw = (LAS float*)(lds + 57856);
    LAS float* ybuf = (LAS float*)(lds + 74240);
    const bf16* PX = (const bf16*)(a.ws() + WS_X2); float* YD = (float*)(a.ws() + WS_X3); float* BON = (float*)(a.ws() + WS_BONUS); const float* rope = (const float*)(a.ws() + WS_ROPE);
    const float* mup = a.in(I_MUP) + l * 1760; const float* mun = a.in(I_MUN) + l * 1760;
    for (int chain = blockIdx.x; chain < 256; chain += gridDim.x) {
        const int b = chain >> 4, h = (chain >> 1) & 7, d = chain & 1, c = lane;
        float w2c[32], a2c[32];
#pragma unroll
        for (int j = 0; j < 32; ++j) { w2c[j] = a.in(I_W2)[((size_t)(l * 2 + d) * 32 + j) * 512 + h * 64 + c]; a2c[j] = a.in(I_A2)[((size_t)(l * 2 + d) * 32 + j) * 512 + h * 64 + c]; }
        const float w0c = a.in(I_W0)[(l * 2 + d) * 512 + h * 64 + c], a0c = a.in(I_A0)[(l * 2 + d) * 512 + h * 64 + c];
        const float kkc = a.in(I_KK)[l * 512 + h * 64 + c], kac = a.in(I_KA)[l * 512 + h * 64 + c], rkc = a.in(I_RK)[l * 512 + h * 64 + c];
        const int colr = h * 64 + c, colk = 512 + colr, colv = 1024 + colr, coll = (c < 32) ? (1536 + d * 32 + c) : (1600 + d * 32 + (c - 32));
        const float mpr = mup[colr], mnr = mun[colr], mpk = mup[colk], mnk = mun[colk], mpv = mup[colv], mnv = mun[colv], mpl = mup[coll], mnl = mun[coll];
        float S[8];
#pragma unroll
        for (int j = 0; j < 8; ++j) S[j] = 0.f;
        const int vl = lane >> 3, kq = lane & 7, vrow = 8 * wv + vl;
        for (int seq = 0; seq < 2; ++seq) {
            const int T = seq ? SEQ : CTXL, rowbase = seq ? b * SEQ : NTX + b * CTXL, nblk = T / TB;
            for (int bi = 0; bi < nblk; ++bi) {
                const int tb = d ? (nblk - 1 - bi) : bi, t0 = tb * TB;
                float zv[4];
#pragma unroll
                for (int i = 0; i < 4; ++i) {
                    const int tl = wv + 8 * i, t = t0 + tl; const bf16* p = PX + (size_t)(rowbase + t) * DINP + RWOFF;
                    const bool hp = t > 0, hn = t + 1 < T;
                    const float cr = bf2f(p[colr]), ck = bf2f(p[colk]), cv = bf2f(p[colv]), cl_ = bf2f(p[coll]);
                    const float pr = hp ? bf2f(p[colr - DINP]) : 0.f, pk = hp ? bf2f(p[colk - DINP]) : 0.f, pv = hp ? bf2f(p[colv - DINP]) : 0.f, pl = hp ? bf2f(p[coll - DINP]) : 0.f;
                    const float nr = hn ? bf2f(p[colr + DINP]) : 0.f, nk = hn ? bf2f(p[colk + DINP]) : 0.f, nv = hn ? bf2f(p[colv + DINP]) : 0.f, nl = hn ? bf2f(p[coll + DINP]) : 0.f;
                    const float zr = cr + mpr * (pr - cr) + mnr * (nr - cr), zk = ck + mpk * (pk - ck) + mnk * (nk - ck);
                    zv[i] = cv + mpv * (pv - cv) + mnv * (nv - cv);
                    const float zz = cl_ + mpl * (pl - cl_) + mnl * (nl - cl_);
                    rkraw[tl * 128 + c] = zr; rkraw[tl * 128 + 64 + c] = zk; zl[tl * 64 + c] = (c < 32) ? tanhf(zz) : zz;
                }
                __syncthreads();
#pragma unroll
                for (int i = 0; i < 4; ++i) {
                    const int tl = wv + 8 * i, t = t0 + tl;
                    float r = rkraw[tl * 128 + c], k = rkraw[tl * 128 + 64 + c];
                    if (seq) { const float rp = rkraw[tl * 128 + (c ^ 16)], kp = rkraw[tl * 128 + 64 + (c ^ 16)]; const int qd = c >> 4, f = c & 15;
                        const int ti = (qd < 2) ? ((t >> 6) * 16 + f) : (1024 + (t & 63) * 16 + f); const float cs = rope[ti], sn = rope[ti + ((qd < 2) ? 512 : 1024)];
                        const float sg = (qd & 1) ? sn : -sn; r = r * cs + rp * sg; k = k * cs + kp * sg; }
                    const float kkr = k * kkc; const float ss = wave_sum(kkr * kkr); const float kk = kkr / fmaxf(sqrtf(ss), 1e-12f);
                    float u = w0c, av = a0c;
#pragma unroll
                    for (int j = 0; j < 32; j += 4) { const f32x4 z1 = *(const LAS f32x4*)(zl + tl * 64 + j), z2 = *(const LAS f32x4*)(zl + tl * 64 + 32 + j);
                        u += z1.x * w2c[j] + z1.y * w2c[j + 1] + z1.z * w2c[j + 2] + z1.w * w2c[j + 3]; av += z2.x * a2c[j] + z2.y * a2c[j + 1] + z2.z * a2c[j + 2] + z2.w * a2c[j + 3]; }
                    const float w = expf(-0.6065306597126334f * sigmoidf_(u)), aa = sigmoidf_(av);
                    const float kd = k * (1.0f + (aa - 1.0f) * kac), nb = -kk * aa;
                    const float c1 = wave_sum(nb * r), c2 = wave_sum(kd * r), bon = wave_sum(r * kd * rkc);
                    LAS float* o = ops + tl * 384 + c; o[0] = kk; o[64] = w * r; o[128] = w; o[192] = nb; o[256] = kd; o[320] = zv[i];
                    if (lane == 0) { scal[tl * 4] = c1; scal[tl * 4 + 1] = c2; BON[((size_t)d * NTOK + rowbase + t) * 8 + h] = bon; }
                }
                __syncthreads();
#pragma unroll 2
                for (int s = 0; s < TB; ++s) {
                    const int tl = d ? (TB - 1 - s) : s; const LAS float* o = ops + tl * 384 + kq * 8;
                    const f32x4 ka = *(const LAS f32x4*)(o), kb = *(const LAS f32x4*)(o + 4), ra = *(const LAS f32x4*)(o + 64), rb = *(const LAS f32x4*)(o + 68);
                    const f32x4 wa = *(const LAS f32x4*)(o + 128), wb = *(const LAS f32x4*)(o + 132), na = *(const LAS f32x4*)(o + 192), nb_ = *(const LAS f32x4*)(o + 196);
                    const f32x4 da = *(const LAS f32x4*)(o + 256), db = *(const LAS f32x4*)(o + 260);
                    const float vv = ops[tl * 384 + 320 + vrow], c1 = scal[tl * 4], c2 = scal[tl * 4 + 1];
                    float sk = S[0] * ka.x + S[1] * ka.y + S[2] * ka.z + S[3] * ka.w + S[4] * kb.x + S[5] * kb.y + S[6] * kb.z + S[7] * kb.w;
                    float yy = S[0] * ra.x + S[1] * ra.y + S[2] * ra.z + S[3] * ra.w + S[4] * rb.x + S[5] * rb.y + S[6] * rb.z + S[7] * rb.w;
                    sk = red8(sk); yy = red8(yy);
                    const float y = yy + sk * c1 + vv * c2;
                    S[0] = S[0] * wa.x + sk * na.x + vv * da.x; S[1] = S[1] * wa.y + sk * na.y + vv * da.y; S[2] = S[2] * wa.z + sk * na.z + vv * da.z; S[3] = S[3] * wa.w + sk * na.w + vv * da.w;
                    S[4] = S[4] * wb.x + sk * nb_.x + vv * db.x; S[5] = S[5] * wb.y + sk * nb_.y + vv * db.y; S[6] = S[6] * wb.z + sk * nb_.z + vv * db.z; S[7] = S[7] * wb.w + sk * nb_.w + vv * db.w;
                    if (kq == 0) ybuf[tl * 64 + vrow] = y;
                }
                __syncthreads();
#pragma unroll
                for (int i = 0; i < 4; ++i) { const int tl = wv + 8 * i; YD[((size_t)d * NTOK + rowbase + t0 + tl) * 512 + h * 64 + c] = ybuf[tl * 64 + c]; }
            }
        }
        __syncthreads();
    }
}

typedef short v4i16_t __attribute__((ext_vector_type(4)));
__device__ __forceinline__ int swz_off(int row, int chunk) { return row * 128 + ((chunk ^ (row & 7)) << 4); }
__device__ __forceinline__ void stage_rows(LAS unsigned char* dst, const bf16* src, int nrows, int tid) {
    for (int idx = tid; idx < nrows * 8; idx += 512) { const int r = idx >> 3, ch = idx & 7; const v4u v = *(const GAS v4u*)(src + (size_t)r * DINP + ch * 8); *(LAS v4u*)(dst + swz_off(r, ch)) = v; }
}
__device__ __forceinline__ bf16x8 q_scale8(bf16x8 q) { const v4u w = __builtin_bit_cast(v4u, q); v4u r;
    r.x = pk2(bflo(w.x) * 0.125f, bfhi(w.x) * 0.125f); r.y = pk2(bflo(w.y) * 0.125f, bfhi(w.y) * 0.125f); r.z = pk2(bflo(w.z) * 0.125f, bfhi(w.z) * 0.125f); r.w = pk2(bflo(w.w) * 0.125f, bfhi(w.w) * 0.125f);
    return __builtin_bit_cast(bf16x8, r); }
struct AttState { float m, l; f32x4 o[4]; };
struct AttOff { int k[2]; int v[4]; int boff; unsigned okm; };
__device__ __forceinline__ AttOff att_offsets(int lane, int wc0, int qc, int cs) { AttOff o; const int kl = lane & 15, g = lane >> 4, q_ = kl >> 2, p_ = kl & 3;
#pragma unroll
    for (int dh = 0; dh < 2; ++dh) o.k[dh] = swz_off(kl, dh * 4 + g);
#pragma unroll
    for (int dt = 0; dt < 4; ++dt) o.v[dt] = swz_off(4 * g + q_, 2 * dt + (p_ >> 1)) + (p_ & 1) * 8;
    o.boff = (wc0 + 4 * g - qc + 15) * 4; o.okm = 0u;
#pragma unroll
    for (int j = 0; j < 8; ++j) { const int kc = wc0 + (j >> 2) * 16 + 4 * g + (j & 3); if ((kc >= cs) && (kc < cs + 16)) o.okm |= 1u << j; }
    return o; }
template <bool LOCAL>
__device__ __forceinline__ void att_kstep(AttState& st, const LAS unsigned char* kb, const LAS unsigned char* vb, int r0, const bf16x8 (&qf)[2], int lane, const AttOff& ao, const LAS float* rpbrow) {
    const LAS unsigned char* kr = kb + r0 * 128; const LAS unsigned char* vr = vb + r0 * 128;
    f32x4 s0 = {0.f, 0.f, 0.f, 0.f}, s1 = {0.f, 0.f, 0.f, 0.f};
#pragma unroll
    for (int dh = 0; dh < 2; ++dh) {
        const bf16x8 k0 = *(const LAS bf16x8*)(kr + ao.k[dh]); const bf16x8 k1 = *(const LAS bf16x8*)(kr + ao.k[dh] + 2048);
        s0 = __builtin_amdgcn_mfma_f32_16x16x32_bf16(k0, qf[dh], s0, 0, 0, 0); s1 = __builtin_amdgcn_mfma_f32_16x16x32_bf16(k1, qf[dh], s1, 0, 0, 0);
    }
    float sc[8];
#pragma unroll
    for (int j = 0; j < 4; ++j) { sc[j] = s0[j]; sc[4 + j] = s1[j]; }
    if (LOCAL) {
        float bv[8]; const unsigned ad = (unsigned)(uintptr_t)rpbrow + (unsigned)ao.boff;
#pragma unroll
        for (int j = 0; j < 8; ++j) asm volatile("ds_read_b32 %0, %1 offset:%2" : "=v"(bv[j]) : "v"(ad), "i"(((j >> 2) * 16 + (j & 3)) * 4));
        asm volatile("s_waitcnt lgkmcnt(0)" : "+v"(bv[0]), "+v"(bv[1]), "+v"(bv[2]), "+v"(bv[3]), "+v"(bv[4]), "+v"(bv[5]), "+v"(bv[6]), "+v"(bv[7]) :: "memory");
#pragma unroll
        for (int j = 0; j < 8; ++j) sc[j] = ((ao.okm >> j) & 1u) ? sc[j] + bv[j] : -INFINITY;
    }
    float mt = fmaxf(fmaxf(fmaxf(sc[0], sc[1]), fmaxf(sc[2], sc[3])), fmaxf(fmaxf(sc[4], sc[5]), fmaxf(sc[6], sc[7])));
    mt = fmaxf(mt, shx(mt, 16, lane)); mt = fmaxf(mt, shx(mt, 32, lane));
    if (__any(mt > st.m)) {
        const float mn = fmaxf(st.m, mt); const float scale = (mn == -INFINITY) ? 1.0f : __expf(st.m - mn); st.l *= scale; st.m = mn;
#pragma unroll
        for (int dt = 0; dt < 4; ++dt) st.o[dt] = st.o[dt] * scale; }
    float p[8], ps = 0.f; const float mref = (st.m == -INFINITY) ? 0.f : st.m;
#pragma unroll
    for (int j = 0; j < 8; ++j) { p[j] = __expf(sc[j] - mref); ps += p[j]; }
    st.l += ps;
    v4u pw; pw.x = pk2(p[0], p[1]); pw.y = pk2(p[2], p[3]); pw.z = pk2(p[4], p[5]); pw.w = pk2(p[6], p[7]);
    const bf16x8 pf = __builtin_bit_cast(bf16x8, pw);
#pragma unroll
    for (int dt = 0; dt < 4; ++dt) {
        const v4i16_t lo = __builtin_amdgcn_ds_read_tr16_b64_v4i16((LAS v4i16_t*)(vr + ao.v[dt]));
        const v4i16_t hi = __builtin_amdgcn_ds_read_tr16_b64_v4i16((LAS v4i16_t*)(vr + ao.v[dt] + 2048));
        const bf16x8 vf = (bf16x8){lo[0], lo[1], lo[2], lo[3], hi[0], hi[1], hi[2], hi[3]};
        st.o[dt] = __builtin_amdgcn_mfma_f32_16x16x32_bf16(vf, pf, st.o[dt], 0, 0, 0);
    }
}
__device__ __forceinline__ void att_merge_store(AttState& st, LAS float* mrg, int qb, int kh, int lane, bf16* orow0  ) {
    LAS float* mine = mrg + qb * (18 * 64) + lane;
    if (kh == 1) { mine[0] = st.m; mine[64] = st.l;
#pragma unroll
        for (int dt = 0; dt < 4; ++dt)
#pragma unroll
            for (int j = 0; j < 4; ++j) mine[(2 + dt * 4 + j) * 64] = st.o[dt][j]; }
    __syncthreads();
    if (kh == 0) {
        const float m1 = mine[0], l1 = mine[64]; const float ms = fmaxf(st.m, m1); const float f0 = __expf(st.m - ms), f1 = __expf(m1 - ms);
        float lc = st.l * f0 + l1 * f1; lc += shx(lc, 16, lane); lc += shx(lc, 32, lane); const float inv = 1.0f / lc;
        const int q = lane & 15, g = lane >> 4;
#pragma unroll
        for (int dt = 0; dt < 4; ++dt) { float r[4];
#pragma unroll
            for (int j = 0; j < 4; ++j) r[j] = (st.o[dt][j] * f0 + mine[(2 + dt * 4 + j) * 64] * f1) * inv;
            v2u w; w.x = pk2(r[0], r[1]); w.y = pk2(r[2], r[3]); *(GAS v2u*)(orow0 + (size_t)q * DM + dt * 16 + 4 * g) = w; }
    }
}
__device__ __forceinline__ void phase_attn(LAS unsigned char* lds, int l) {
    const KA a = ka_get();
    const int tid = opaque_tid(), lane = tid & 63, wv = __builtin_amdgcn_readfirstlane(tid >> 6), qb = wv & 3, kh = wv >> 2;
    LAS unsigned char* KC = lds; LAS unsigned char* VC = lds + 32768; LAS unsigned char* KL = lds + 65536; LAS unsigned char* VL = lds + 98304;
    LAS float* RPB = (LAS float*)(lds + LDSCTL_OFF + 2048); LAS float* mrg = (LAS float*)KL;
    const bf16* PX = (const bf16*)(a.ws() + WS_X2); bf16* CAT = (bf16*)(a.ws() + WS_X1);
    for (int blk = blockIdx.x; blk < 256; blk += gridDim.x) {
        const int bh = blk >> 1, b = bh >> 3, h = bh & 7, half = blk & 1;
        __syncthreads();
        const bf16* ctxrow = PX + (size_t)(NTX + b * CTXL) * DINP + h * 64;
        stage_rows(KC, ctxrow + 512, 256, tid); stage_rows(VC, ctxrow + 1024, 256, tid);
        for (int i = tid; i < 465; i += 512) RPB[i] = a.in(I_RPB)[((size_t)l * 8 + h) * 465 + i];
        __syncthreads();
        const int kl = lane & 15, g = lane >> 4;
        const AttOff ao = att_offsets(lane, min(max(qb * 16 - 8, 0), 32), qb * 16 + kl, min(max(qb * 16 + kl - 8, 0), 48));
        if (l == 0) {
            for (int rr = 0; rr < 2; ++rr) {
                const int q0 = (half * 8 + rr * 4 + qb) * 16; const bf16* qrow = ctxrow + (size_t)(q0 + kl) * DINP;
                bf16x8 qf[2]; qf[0] = q_scale8(*(const GAS bf16x8*)(qrow + 8 * g)); qf[1] = q_scale8(*(const GAS bf16x8*)(qrow + 32 + 8 * g));
                AttState st; st.m = -INFINITY; st.l = 0.f;
#pragma unroll
                for (int dt = 0; dt < 4; ++dt) st.o[dt] = (f32x4){0.f, 0.f, 0.f, 0.f};
                for (int s = 0; s < 4; ++s) att_kstep<false>(st, KC, VC, kh * 128 + s * 32, qf, lane, ao, RPB);
                att_merge_store(st, mrg, qb, kh, lane, CAT + (size_t)(NTX + b * CTXL + q0) * DM + h * 64);
                __syncthreads();
            }
        }
        v4u pfk0[4], pfv0[4], pfk1[4], pfv1[4];
#define ATT_ISSUE(SIDX, pfk, pfv) do { const int i_ = half * 16 + ((SIDX) >> 1); const int rs_ = min(max(i_ - 4, 0), 24); const bf16* lr_ = PX + (size_t)(b * SEQ + (rs_ + 4 * ((SIDX) & 1)) * 64) * DINP + h * 64; \
            _Pragma("unroll") for (int q__ = 0; q__ < 4; ++q__) { const int idx_ = tid + 512 * q__; const bf16* p_ = lr_ + (size_t)(idx_ >> 3) * DINP + (idx_ & 7) * 8; pfk[q__] = *(const GAS v4u*)(p_ + 512); pfv[q__] = *(const GAS v4u*)(p_ + 1024); } } while (0)
        ATT_ISSUE(0, pfk0, pfv0); ATT_ISSUE(1, pfk1, pfv1);
        bf16x8 qn[2]; { const bf16* qrow = PX + (size_t)(b * SEQ + (half * 16) * 64 + qb * 16 + kl) * DINP + h * 64; qn[0] = *(const GAS bf16x8*)(qrow + 8 * g); qn[1] = *(const GAS bf16x8*)(qrow + 32 + 8 * g); }
        for (int ui = 0; ui < 16; ++ui) {
            const int i = half * 16 + ui; const int rs = min(max(i - 4, 0), 24);
            const int qc = qb * 16 + kl, cs = min(max(qc - 8, 0), 48), wc0 = min(max(qb * 16 - 8, 0), 32);
            bf16x8 qf[2]; qf[0] = q_scale8(qn[0]); qf[1] = q_scale8(qn[1]);
            { const int in_ = half * 16 + (ui < 15 ? ui + 1 : ui); const bf16* qrow = PX + (size_t)(b * SEQ + in_ * 64 + qc) * DINP + h * 64; qn[0] = *(const GAS bf16x8*)(qrow + 8 * g); qn[1] = *(const GAS bf16x8*)(qrow + 32 + 8 * g); }
            AttState st; st.m = -INFINITY; st.l = 0.f;
#pragma unroll
            for (int dt = 0; dt < 4; ++dt) st.o[dt] = (f32x4){0.f, 0.f, 0.f, 0.f};
            for (int s = 0; s < 4; ++s) att_kstep<false>(st, KC, VC, kh * 128 + s * 32, qf, lane, ao, RPB);
#define ATT_PASS(pass, pfk, pfv) do { \
                __syncthreads(); \
                _Pragma("unroll") for (int q__ = 0; q__ < 4; ++q__) { const int idx_ = tid + 512 * q__; const int o_ = swz_off(idx_ >> 3, idx_ & 7); *(LAS v4u*)(KL + o_) = pfk[q__]; *(LAS v4u*)(VL + o_) = pfv[q__]; } \
                __syncthreads(); \
                if (ui + 1 < 16) ATT_ISSUE(2 * (ui + 1) + (pass), pfk, pfv); \
                for (int k2 = 0; k2 < 2; ++k2) { const int kr = 2 * kh + k2, arow = rs + 4 * (pass) + kr; \
                    att_kstep<true>(st, KL, VL, kr * 64 + wc0, qf, lane, ao, RPB + (arow - i + 7) * 31); } } while (0)
            ATT_PASS(0, pfk0, pfv0);
            ATT_PASS(1, pfk1, pfv1);
#undef ATT_PASS
            __syncthreads();
            att_merge_store(st, mrg, qb, kh, lane, CAT + (size_t)(b * SEQ + i * 64 + qb * 16) * DM + h * 64);
        }
    }
}

__device__ __forceinline__ void phase_rwpost(LAS unsigned char* lds, int l) {
    const KA a = ka_get();
    const int tid = opaque_tid(), lane = tid & 63, hh = __builtin_amdgcn_readfirstlane(tid >> 6), kl = lane & 15, g = lane >> 4;
    const int er = tid >> 5, cq = tid & 31, c0 = cq * 16, hq = cq >> 2;
    LAS bf16* sig = (LAS bf16*)lds;
    LAS float* Gl = (LAS float*)(lds + 4096);
    const bf16* PX = (const bf16*)(a.ws() + WS_X2); const float* YD = (const float*)(a.ws() + WS_X3); const float* BON = (const float*)(a.ws() + WS_BONUS); bf16* CAT = (bf16*)(a.ws() + WS_X1);
    const float* mup = a.in(I_MUP) + l * 1760; const float* mun = a.in(I_MUN) + l * 1760; const float* g2 = a.in(I_G2) + (size_t)l * 96 * 512;
    const float* gngp = a.in(I_GNG) + l * 512 + c0; const float* gnbp = a.in(I_GNB) + l * 512 + c0;
    bf16x8 gb[3][4];
#pragma unroll
    for (int ks = 0; ks < 3; ++ks)
#pragma unroll
        for (int nt = 0; nt < 4; ++nt) { v4u w; unsigned t[8];
#pragma unroll
            for (int j = 0; j < 8; ++j) t[j] = f2bf(g2[(size_t)(32 * ks + 8 * g + j) * 512 + 64 * hh + 16 * nt + kl]);
            w.x = t[0] | (t[1] << 16); w.y = t[2] | (t[3] << 16); w.z = t[4] | (t[5] << 16); w.w = t[6] | (t[7] << 16); gb[ks][nt] = __builtin_bit_cast(bf16x8, w); }
    const int nch = (l == 0 ? NTOK : NTX) / 16;
    for (int ch = blockIdx.x; ch < nch; ch += gridDim.x) {
        const int row0 = ch * 16;
        __syncthreads();
        for (int idx = tid; idx < 1536; idx += 512) { const int r = idx / 96, j = idx - r * 96, row = row0 + r; int t, T; if (row < NTX) { t = row & (SEQ - 1); T = SEQ; } else { t = (row - NTX) & (CTXL - 1); T = CTXL; }
            const bf16* p = PX + (size_t)row * DINP + RWOFF + 1664 + j; const int op = t > 0 ? -DINP : 0, on = t + 1 < T ? DINP : 0;
            const float cv = bf2f(p[0]), pv = bf2f(p[op]) * (t > 0 ? 1.f : 0.f), nv = bf2f(p[on]) * (t + 1 < T ? 1.f : 0.f);
            const float z = cv + mup[1664 + j] * (pv - cv) + mun[1664 + j] * (nv - cv); sig[r * 96 + j] = f2bf1(sigmoidf_(z)); }
        const int row = row0 + er; int t, T; if (row < NTX) { t = row & (SEQ - 1); T = SEQ; } else { t = (row - NTX) & (CTXL - 1); T = CTXL; }
        const bf16* pvp = PX + (size_t)row * DINP + RWOFF + 1024 + c0; const int op = t > 0 ? -DINP : 0, on = t + 1 < T ? DINP : 0; const float fp = t > 0 ? 1.f : 0.f, fn = t + 1 < T ? 1.f : 0.f;
        v4u vc[2], vp[2], vn[2]; f32x4 y0[4], y1[4];
#pragma unroll
        for (int i = 0; i < 2; ++i) { vc[i] = *(const GAS v4u*)(pvp + 8 * i); vp[i] = *(const GAS v4u*)(pvp + op + 8 * i); vn[i] = *(const GAS v4u*)(pvp + on + 8 * i); }
#pragma unroll
        for (int i = 0; i < 4; ++i) { y0[i] = *(const GAS f32x4*)(YD + (size_t)row * 512 + c0 + 4 * i); y1[i] = *(const GAS f32x4*)(YD + ((size_t)NTOK + row) * 512 + c0 + 4 * i); }
        const float bon = BON[(size_t)row * 8 + hq] + BON[((size_t)NTOK + row) * 8 + hq];
        __syncthreads();
        { f32x4 acc[4];
#pragma unroll
          for (int nt = 0; nt < 4; ++nt) acc[nt] = (f32x4){0.f, 0.f, 0.f, 0.f};
#pragma unroll
          for (int ks = 0; ks < 3; ++ks) { const bf16x8 af = *(const LAS bf16x8*)(sig + kl * 96 + 32 * ks + 8 * g);
#pragma unroll
              for (int nt = 0; nt < 4; ++nt) acc[nt] = __builtin_amdgcn_mfma_f32_16x16x32_bf16(af, gb[ks][nt], acc[nt], 0, 0, 0); }
#pragma unroll
          for (int nt = 0; nt < 4; ++nt)
#pragma unroll
              for (int j = 0; j < 4; ++j) Gl[(4 * g + j) * 512 + 64 * hh + 16 * nt + kl] = acc[nt][j]; }
        __syncthreads();
        f32x4 y[4]; float s = 0.f;
#pragma unroll
        for (int i = 0; i < 4; ++i) { y[i] = y0[i] + y1[i]; s += (y[i].x + y[i].y) + (y[i].z + y[i].w); }
        s += dppmov<0xB1>(s); s += dppmov<0x4E>(s); const float mean = s * (1.0f / 64.0f); float q = 0.f;
#pragma unroll
        for (int i = 0; i < 4; ++i) { y[i] = y[i] - mean; q += (y[i].x * y[i].x + y[i].y * y[i].y) + (y[i].z * y[i].z + y[i].w * y[i].w); }
        q += dppmov<0xB1>(q); q += dppmov<0x4E>(q); const float rstd = 1.0f / sqrtf(q * (1.0f / 64.0f) + GN_EPS);
        unsigned ow[8]; f32x4 mpvv[4], mnvv[4], gngv[4], gnbv[4];
#pragma unroll
        for (int i = 0; i < 4; ++i) { mpvv[i] = *(const GAS f32x4*)(mup + 1024 + c0 + 4 * i); mnvv[i] = *(const GAS f32x4*)(mun + 1024 + c0 + 4 * i); gngv[i] = *(const GAS f32x4*)(gngp + 4 * i); gnbv[i] = *(const GAS f32x4*)(gnbp + 4 * i); }
#pragma unroll
        for (int i = 0; i < 4; ++i) { const unsigned cw0 = vc[i >> 1][(i & 1) * 2], cw1 = vc[i >> 1][(i & 1) * 2 + 1], pw0 = vp[i >> 1][(i & 1) * 2], pw1 = vp[i >> 1][(i & 1) * 2 + 1], nw0 = vn[i >> 1][(i & 1) * 2], nw1 = vn[i >> 1][(i & 1) * 2 + 1];
            const f32x4 cv = {bflo(cw0), bfhi(cw0), bflo(cw1), bfhi(cw1)}, pv = {bflo(pw0) * fp, bfhi(pw0) * fp, bflo(pw1) * fp, bfhi(pw1) * fp}, nv = {bflo(nw0) * fn, bfhi(nw0) * fn, bflo(nw1) * fn, bfhi(nw1) * fn};
            const f32x4 mpv = mpvv[i], mnv = mnvv[i], gng = gngv[i], gnb = gnbv[i];
            const f32x4 zv = cv + mpv * (pv - cv) + mnv * (nv - cv);
            const f32x4 gt = *(const LAS f32x4*)(Gl + er * 512 + c0 + 4 * i);
            const f32x4 o = (y[i] * rstd * gng + gnb + zv * bon) * gt;
            ow[2 * i] = pk2(o.x, o.y); ow[2 * i + 1] = pk2(o.z, o.w); }
        GAS v4u* dst = (GAS v4u*)(CAT + (size_t)row * DM + 512 + c0); dst[0] = (v4u){ow[0], ow[1], ow[2], ow[3]}; dst[1] = (v4u){ow[4], ow[5], ow[6], ow[7]};
    }
}

struct RowMap { int WPB, RPWX, RPWC; };
__device__ __forceinline__ RowMap rowmap(int NGW) { RowMap r; r.WPB = NGW / NB; r.RPWX = SEQ / r.WPB; r.RPWC = NTC / NGW; return r; }
__device__ __forceinline__ int route_wave(int m, const RowMap& r) { if (m < NTX) { const int b = m / SEQ, t = m - b * SEQ; return b * r.WPB + t / r.RPWX; } return (m - NTX) / r.RPWC; }
typedef _Float16 f16x8 __attribute__((ext_vector_type(8)));
typedef _Float16 f16x2_ __attribute__((ext_vector_type(2)));
__device__ __forceinline__ unsigned pkh(float a, float b) { f32x2_t_ v = {a, b}; f16x2_ h = __builtin_convertvector(v, f16x2_); return __builtin_bit_cast(unsigned, h); }
__device__ __forceinline__ void split_h(float a, float b, unsigned& hi, unsigned& lo) { hi = pkh(a, b); const f16x2_ hh = __builtin_bit_cast(f16x2_, hi); lo = pkh(a - (float)hh.x, b - (float)hh.y); }
constexpr int LN1_ROWB = 4112, LN1_RED = 67584;
template <bool BFIN> __device__ __forceinline__ void phase_ln1_route(LAS unsigned char* lds, int l) {
    const KA a = ka_get();
    const int tid = opaque_tid(), lane = tid & 63, wave = __builtin_amdgcn_readfirstlane(tid >> 6), G = gridDim.x, bid = blockIdx.x;
    const int gw = bid * 8 + wave, NGW = G * 8;
    if (tid < 32) ((LAS int*)(lds + LDSCTL_OFF + 1024))[tid] = 0;
    f16x8 Wh[2][4], Wl[2][4];
    { const float* RW = a.in(I_RW) + (size_t)(128 * wave + 8 * (lane >> 4)) * 32 + (lane & 15);
#pragma unroll
      for (int nt = 0; nt < 2; ++nt)
#pragma unroll
        for (int ks = 0; ks < 4; ++ks) { unsigned h[4], lo[4];
#pragma unroll
            for (int t = 0; t < 4; ++t) { const float w0 = RW[(32 * ks + 2 * t) * 32 + 16 * nt] * 256.f, w1 = RW[(32 * ks + 2 * t + 1) * 32 + 16 * nt] * 256.f; split_h(w0, w1, h[t], lo[t]); }
            Wh[nt][ks] = __builtin_bit_cast(f16x8, (v4u){h[0], h[1], h[2], h[3]}); Wl[nt][ks] = __builtin_bit_cast(f16x8, (v4u){lo[0], lo[1], lo[2], lo[3]}); } }
    __syncthreads();
    const float* mods = (const float*)(a.ws() + WS_MODS) + (size_t)l * 17 * 6144;
    const bf16* O = (const bf16*)(a.ws() + WS_X3); bf16* HM = (bf16*)(a.ws() + WS_X1);
    const float* xs = a.in(I_X); const float* cs = a.in(I_CTX); const bf16* xb = (const bf16*)a.out(); bf16* XP = (bf16*)(a.ws() + WS_XP);
    int* HIST = (int*)(a.ws() + WS_LIST); TokInfo* TOK = (TokInfo*)(a.ws() + WS_TOK); LAS int* lcnt = (LAS int*)(lds + LDSCTL_OFF + 1024);
    const GAS f32x4* lg = (const GAS f32x4*)(a.in(I_LN1G) + l * DM) + lane; const GAS f32x4* lb = (const GAS f32x4*)(a.in(I_LN1B) + l * DM) + lane;
    const float biasv = a.in(I_RB)[(lane >> 1) & 31];
    f32x4 lgv[4], lbv[4];
#pragma unroll
    for (int j = 0; j < 4; ++j) { lgv[j] = lg[64 * j]; lbv[j] = lb[64 * j]; }
    const RowMap rm = rowmap(NGW);
    const int bx = gw / rm.WPB, xbase = bx * SEQ + (gw - bx * rm.WPB) * rm.RPWX, cbase = NTX + gw * rm.RPWC, nxr = rm.RPWX, ntot = nxr + (BFIN ? 0 : rm.RPWC);
    f32x4 nx[4]; v2u nxb[4], no[4];
#define LN1_ROW(J) ((J) < nxr ? xbase + (J) : cbase + (J) - nxr)
#define LN1_FETCH(J) do { const int jj_ = (J) < ntot ? (J) : ntot - 1; const int m_ = LN1_ROW(jj_); const GAS v2u* or_ = (const GAS v2u*)(O + (size_t)m_ * DM) + lane; \
        if constexpr (BFIN) { const GAS v2u* xr_ = (const GAS v2u*)(xb + (size_t)m_ * DM) + lane; \
            _Pragma("unroll") for (int j_ = 0; j_ < 4; ++j_) { nxb[j_] = xr_[64 * j_]; no[j_] = or_[64 * j_]; } } \
        else { const float* s_ = m_ < NTX ? xs + (size_t)m_ * DM : cs + (size_t)(m_ - NTX) * DM; const GAS f32x4* xr_ = (const GAS f32x4*)s_ + lane; \
            _Pragma("unroll") for (int j_ = 0; j_ < 4; ++j_) { nx[j_] = xr_[64 * j_]; no[j_] = or_[64 * j_]; } } } while (0)
    LN1_FETCH(0);
    const unsigned afrag = (unsigned)((lane & 15) * LN1_ROWB + (128 * wave + 8 * (lane >> 4)) * 2);
    LAS float* red = (LAS float*)(lds + LN1_RED);
    for (int seg = 0; seg < (BFIN ? 1 : 2); ++seg) {
        const int j0 = seg ? nxr : 0, j1 = seg ? ntot : nxr; const int mr = seg ? 16 : bx;
        const GAS f32x4* md = (const GAS f32x4*)(mods + (size_t)mr * 6144) + lane;
        f32x4 sc2[4], sh2[4], gt1[4];
#pragma unroll
        for (int j = 0; j < 4; ++j) { gt1[j] = md[512 + 64 * j]; sc2[j] = md[1024 + 64 * j]; sh2[j] = md[768 + 64 * j]; }
      for (int jb = j0; jb < j1; jb += 2) {
#pragma unroll
        for (int r = 0; r < 2; ++r) {
            const int m = LN1_ROW(jb + r);
            f32x4 v[4]; float s = 0.f;
#pragma unroll
            for (int j = 0; j < 4; ++j) { f32x4 x; if constexpr (BFIN) { const v2u xw = nxb[j]; x = f32x4{bflo(xw.x), bfhi(xw.x), bflo(xw.y), bfhi(xw.y)}; } else x = nx[j];
                const f32x4 gt = gt1[j]; const v2u ow = no[j]; const f32x4 o = {bflo(ow.x), bfhi(ow.x), bflo(ow.y), bfhi(ow.y)};
                v[j] = x * ALPHA + gt * o; s += (v[j].x + v[j].y) + (v[j].z + v[j].w); }
            LN1_FETCH(jb + r + 1);
            const float mean = wave_sum(s) * (1.f / DM); float s2 = 0.f;
#pragma unroll
            for (int j = 0; j < 4; ++j) { v[j] = v[j] - mean; s2 += (v[j].x * v[j].x + v[j].y * v[j].y) + (v[j].z * v[j].z + v[j].w * v[j].w); }
            const float rstd = 1.f / sqrtf(wave_sum(s2) * (1.f / DM) + LN_EPS);
            GAS v2u* dr = (GAS v2u*)(XP + (size_t)m * DM) + lane; GAS v2u* hr = (GAS v2u*)(HM + (size_t)m * DM) + lane;
            const unsigned trow = (unsigned)((2 * wave + r) * LN1_ROWB + 8 * lane);
#pragma unroll
            for (int j = 0; j < 4; ++j) { const f32x4 x1 = v[j] * rstd * lgv[j] + lbv[j]; { v2u xw; xw.x = pk2(x1.x, x1.y); xw.y = pk2(x1.z, x1.w); dr[64 * j] = xw; }
                const f32x4 hm = x1 * (sc2[j] + 1.0f) + sh2[j]; v2u w; w.x = pk2(hm.x, hm.y); w.y = pk2(hm.z, hm.w); hr[64 * j] = w;
                unsigned h0_, l0_, h1_, l1_; split_h(hm.x, hm.y, h0_, l0_); split_h(hm.z, hm.w, h1_, l1_); const v2u hh = {h0_, h1_}, hl = {l0_, l1_};
                *(LAS v2u*)(lds + trow + 512 * j) = hh; *(LAS v2u*)(lds + trow + 2048 + 512 * j) = hl; }
        }
        __syncthreads();
        {
            f32x4 acc0 = {0.f, 0.f, 0.f, 0.f}, acc1 = {0.f, 0.f, 0.f, 0.f};
            f16x8 ah[4], al[4];
#pragma unroll
            for (int ks = 0; ks < 4; ++ks) { ah[ks] = *(const LAS f16x8*)(lds + afrag + 64 * ks); al[ks] = *(const LAS f16x8*)(lds + afrag + 2048 + 64 * ks); }
#pragma unroll
            for (int ks = 0; ks < 4; ++ks) {
                acc0 = __builtin_amdgcn_mfma_f32_16x16x32_f16(al[ks], Wh[0][ks], acc0, 0, 0, 0); acc1 = __builtin_amdgcn_mfma_f32_16x16x32_f16(al[ks], Wh[1][ks], acc1, 0, 0, 0);
                acc0 = __builtin_amdgcn_mfma_f32_16x16x32_f16(ah[ks], Wl[0][ks], acc0, 0, 0, 0); acc1 = __builtin_amdgcn_mfma_f32_16x16x32_f16(ah[ks], Wl[1][ks], acc1, 0, 0, 0);
                acc0 = __builtin_amdgcn_mfma_f32_16x16x32_f16(ah[ks], Wh[0][ks], acc0, 0, 0, 0); acc1 = __builtin_amdgcn_mfma_f32_16x16x32_f16(ah[ks], Wh[1][ks], acc1, 0, 0, 0); }
            LAS float* rw_ = red + (wave * 16 + 4 * (lane >> 4)) * 32 + (lane & 15);
#pragma unroll
            for (int i = 0; i < 4; ++i) { rw_[i * 32] = acc0[i]; rw_[i * 32 + 16] = acc1[i]; }
        }
        __syncthreads();
#pragma unroll 1
        for (int r = 0; r < 2; ++r) {
            const int m = LN1_ROW(jb + r);
            const LAS float* rr = red + (2 * wave + r) * 32 + ((lane >> 1) & 31); float lsum[8];
#pragma unroll
            for (int w = 0; w < 8; ++w) lsum[w] = rr[w * 512];
            const float logit = (((lsum[0] + lsum[1]) + (lsum[2] + lsum[3])) + ((lsum[4] + lsum[5]) + (lsum[6] + lsum[7]))) * (1.f / 256.f);
        const float score = sigmoidf_(logit), sel = score + biasv;
        const int gl = lane & ~7;
        const float q0 = shi(sel, gl), q1 = shi(sel, gl + 2), q2 = shi(sel, gl + 4), q3 = shi(sel, gl + 6);
        const float mx = fmaxf(fmaxf(q0, q1), fmaxf(q2, q3));
        float top2;
        { float a0 = q0, a1 = q1, a2 = q2, a3 = q3; float t;
          if (a0 < a1) { t = a0; a0 = a1; a1 = t; } if (a2 < a3) { t = a2; a2 = a3; a3 = t; } if (a0 < a2) { t = a0; a0 = a2; a2 = t; } if (a1 < a3) { t = a1; a1 = a3; a3 = t; } if (a1 < a2) { t = a1; a1 = a2; a2 = t; }
          top2 = a0 + a1; (void)mx; }
        float best = __builtin_bit_cast(float, __builtin_amdgcn_readlane(__builtin_bit_cast(int, top2), 0)); int gidx = 0;
#pragma unroll
        for (int gg = 1; gg < 8; ++gg) { const float sc = __builtin_bit_cast(float, __builtin_amdgcn_readlane(__builtin_bit_cast(int, top2), gg * 8)); if (sc > best) { best = sc; gidx = gg; } }
        const float r0 = shi(sel, gidx * 8), r1 = shi(sel, gidx * 8 + 2), r2 = shi(sel, gidx * 8 + 4), r3 = shi(sel, gidx * 8 + 6);
        int i0 = 0; float b0 = r0; if (r1 > b0) { b0 = r1; i0 = 1; } if (r2 > b0) { b0 = r2; i0 = 2; } if (r3 > b0) { b0 = r3; i0 = 3; }
        int i1 = -1; float b1 = -INFINITY;
        if (i0 != 0 && r0 > b1) { b1 = r0; i1 = 0; } if (i0 != 1 && r1 > b1) { b1 = r1; i1 = 1; } if (i0 != 2 && r2 > b1) { b1 = r2; i1 = 2; } if (i0 != 3 && r3 > b1) { b1 = r3; i1 = 3; }
        const int e0 = gidx * 4 + i0, e1 = gidx * 4 + i1;
        const float s0 = shi(score, 2 * e0), s1 = shi(score, 2 * e1); const float gs = 1.0f / (s0 + s1);
        if (lane == 0) { const int p0 = __hip_atomic_fetch_add(lcnt + e0, 1, __ATOMIC_RELAXED, __HIP_MEMORY_SCOPE_WORKGROUP), p1_ = __hip_atomic_fetch_add(lcnt + e1, 1, __ATOMIC_RELAXED, __HIP_MEMORY_SCOPE_WORKGROUP);
            TokInfo ti; ti.e0 = e0; ti.e1 = e1; ti.p0 = p0; ti.p1 = p1_; ti.g0 = s0 * gs; ti.g1 = s1 * gs; ti.pad0 = 0; ti.pad1 = 0; TOK[m] = ti; }
        }
      }
    }
    __syncthreads();
    if (tid < 32) HIST[bid * 32 + tid] = lcnt[tid];
}

template <bool FULL> __device__ __forceinline__ void moe_tables(LAS unsigned char* lds, int l) {
    const KA a = ka_get(); const int tid = opaque_tid(), G = gridDim.x;
    LAS int* pref = (LAS int*)(lds + PREF_OFF); LAS int* bb = (LAS int*)lds; LAS int* tot = (LAS int*)(lds + 65536);
    const int* HIST = (const int*)(a.ws() + WS_LIST);
    __syncthreads();
    const int e = tid & 31, grp = tid >> 5;
    int loc[16]; int run = 0;
#pragma unroll
    for (int i = 0; i < 16; ++i) { const int b = grp * 16 + i; loc[i] = (b < G) ? HIST[b * 32 + e] : 0; }
#pragma unroll
    for (int i = 0; i < 16; ++i) { const int v = loc[i]; loc[i] = run; run += v; }
    tot[grp * 32 + e] = run;
    __syncthreads();
    int base = 0, total = 0;
#pragma unroll
    for (int q = 0; q < 16; ++q) { const int v = tot[q * 32 + e]; base += (q < grp) ? v : 0; total += v; }
    if (FULL) {
#pragma unroll
        for (int i = 0; i < 16; ++i) bb[(grp * 16 + i) * 32 + e] = base + loc[i]; }
    if (grp == 0) pref[40 + e] = total;
    __syncthreads();
    if (tid == 0) { int acc = 0; for (int k = 0; k < 32; ++k) { pref[k] = acc; acc += (pref[40 + k] + 255) >> 8; } pref[32] = acc; }
    __syncthreads();
}
__device__ __forceinline__ void phase_gather(LAS unsigned char* lds, int l) {
    const KA a = ka_get();
    const int tid = opaque_tid(), lane = tid & 63, wave = __builtin_amdgcn_readfirstlane(tid >> 6), G = gridDim.x, bid = blockIdx.x;
    const int gw = bid * 8 + wave, NGW = G * 8;
    moe_tables<true>(lds, l);
    const LAS int* pref = (const LAS int*)(lds + PREF_OFF); const LAS int* bb = (const LAS int*)lds;
    const bf16* HM = (const bf16*)(a.ws() + WS_X1); bf16* XB = (bf16*)(a.ws() + WS_X2); const TokInfo* TOK = (const TokInfo*)(a.ws() + WS_TOK);
    const int Mrows = l == 0 ? NTOK : NTX;
    const RowMap rm = rowmap(NGW);
    for (int m = gw; m < Mrows; m += NGW) {
        const TokInfo ti = TOK[m]; const int blk = route_wave(m, rm) >> 3;
        const int sl0 = pref[ti.e0] * 256 + bb[blk * 32 + ti.e0] + ti.p0, sl1 = pref[ti.e1] * 256 + bb[blk * 32 + ti.e1] + ti.p1;
        const GAS v4u* srcp = (const GAS v4u*)(HM + (size_t)m * DM) + lane; const v4u v0 = srcp[0], v1 = srcp[64];
        GAS v4u* d0 = (GAS v4u*)(XB + (size_t)sl0 * DM) + lane; GAS v4u* d1 = (GAS v4u*)(XB + (size_t)sl1 * DM) + lane;
        d0[0] = v0; d0[64] = v1; d1[0] = v0; d1[64] = v1;
    }
    for (int e = 0; e < 32; ++e) {
        const int c = pref[40 + e], npad = ((c + 255) & ~255) - c, r0 = pref[e] * 256 + c;
        for (int r = gw; r < npad; r += NGW) { GAS v4u* dst = (GAS v4u*)(XB + (size_t)(r0 + r) * DM) + lane; dst[0] = (v4u){0u, 0u, 0u, 0u}; dst[64] = (v4u){0u, 0u, 0u, 0u}; }
    }
}

__device__ __forceinline__ void phase_ln2(LAS unsigned char* lds, int l) {
    const KA a = ka_get();
    const int tid = opaque_tid(), lane = tid & 63, wave = __builtin_amdgcn_readfirstlane(tid >> 6), G = gridDim.x, bid = blockIdx.x;
    const int gw = bid * 8 + wave, NGW = G * 8;
    moe_tables<true>(lds, l);
    const LAS int* pref = (const LAS int*)(lds + PREF_OFF); const LAS int* bb = (const LAS int*)lds;
    const float* mods = (const float*)(a.ws() + WS_MODS) + (size_t)l * 17 * 6144;
    const bf16* Y = (const bf16*)(a.ws() + WS_X2); const TokInfo* TOK = (const TokInfo*)(a.ws() + WS_TOK);
    const bf16* XP = (const bf16*)(a.ws() + WS_XP);
    const GAS f32x4* lg = (const GAS f32x4*)(a.in(I_LN2G) + l * DM) + lane; const GAS f32x4* lb = (const GAS f32x4*)(a.in(I_LN2B) + l * DM) + lane;
    const int Mrows = l == 0 ? NTOK : NTX;
    f32x4 lgv[4], lbv[4];
#pragma unroll
    for (int j = 0; j < 4; ++j) { lgv[j] = lg[64 * j]; lbv[j] = lb[64 * j]; }
    const int RPW = (Mrows + NGW - 1) / NGW, m0 = gw * RPW, mend = (m0 + RPW < Mrows) ? m0 + RPW : Mrows, nrows = mend - m0;
    int sl0v = 0, sl1v = 0; float g0v = 0.f, g1v = 0.f;
    if (lane < nrows) { const TokInfo ti = TOK[m0 + lane]; const LAS int* bbw = bb + (route_wave(m0 + lane, rowmap(NGW)) >> 3) * 32;
        sl0v = pref[ti.e0] * 256 + bbw[ti.e0] + ti.p0; sl1v = pref[ti.e1] * 256 + bbw[ti.e1] + ti.p1; g0v = ti.g0; g1v = ti.g1; }
    v2u nxin[4], nain[4], nbin[4];
#define LN2_FETCH(J) do { const int j_ = (J) < nrows ? (J) : (nrows - 1); const int s0_ = __builtin_amdgcn_readlane(sl0v, j_), s1_ = __builtin_amdgcn_readlane(sl1v, j_); \
        const GAS v2u* xr_ = (const GAS v2u*)(XP + (size_t)(m0 + j_) * DM) + lane; const GAS v2u* y0_ = (const GAS v2u*)(Y + (size_t)s0_ * DM) + lane; const GAS v2u* y1_ = (const GAS v2u*)(Y + (size_t)s1_ * DM) + lane; \
        _Pragma("unroll") for (int q_ = 0; q_ < 4; ++q_) { nxin[q_] = xr_[64 * q_]; nain[q_] = y0_[64 * q_]; nbin[q_] = y1_[64 * q_]; } } while (0)
    if (nrows > 0) {
    LN2_FETCH(0);
    for (int jr = 0; jr < nrows; ) {
        const int mseg = m0 + jr; const int mr = mseg < NTX ? mseg / SEQ : 16; int segend = mseg < NTX ? (mr + 1) * SEQ : Mrows; segend = (segend < mend ? segend : mend) - m0;
        const GAS f32x4* md = (const GAS f32x4*)(mods + (size_t)mr * 6144) + lane;
        f32x4 gin[4], msc[4], msh[4];
#pragma unroll
        for (int j = 0; j < 4; ++j) gin[j] = md[1280 + 64 * j];
        if (l == 0) { const GAS f32x4* mn = (const GAS f32x4*)(mods + (size_t)17 * 6144 + (size_t)mr * 6144) + lane;
#pragma unroll
            for (int j = 0; j < 4; ++j) { msc[j] = mn[256 + 64 * j]; msh[j] = mn[64 * j]; } }
      for (; jr < segend; ++jr) {
        const int m = m0 + jr;
        const float tg0 = __builtin_bit_cast(float, __builtin_amdgcn_readlane(__builtin_bit_cast(int, g0v), jr)), tg1 = __builtin_bit_cast(float, __builtin_amdgcn_readlane(__builtin_bit_cast(int, g1v), jr));
        f32x4 v[4]; float s = 0.f;
#pragma unroll
        for (int j = 0; j < 4; ++j) { const v2u xw = nxin[j]; const f32x4 x = {bflo(xw.x), bfhi(xw.x), bflo(xw.y), bfhi(xw.y)}, gt = gin[j]; const v2u a0 = nain[j], a1 = nbin[j];
            const f32x4 ya = {bflo(a0.x), bfhi(a0.x), bflo(a0.y), bfhi(a0.y)}, yb = {bflo(a1.x), bfhi(a1.x), bflo(a1.y), bfhi(a1.y)};
            v[j] = x * ALPHA + gt * (ya * tg0 + yb * tg1); s += (v[j].x + v[j].y) + (v[j].z + v[j].w); }
        LN2_FETCH(jr + 1);
        const float mean = wave_sum(s) * (1.f / DM); float s2 = 0.f;
#pragma unroll
        for (int j = 0; j < 4; ++j) { v[j] = v[j] - mean; s2 += (v[j].x * v[j].x + v[j].y * v[j].y) + (v[j].z * v[j].z + v[j].w * v[j].w); }
        const float rstd = 1.f / sqrtf(wave_sum(s2) * (1.f / DM) + LN_EPS);
        if (l == 0) {
            GAS v2u* o8 = (GAS v2u*)((bf16*)(a.ws() + WS_X1) + (size_t)m * DM) + lane; GAS v2u* xs8 = (GAS v2u*)((bf16*)a.out() + (size_t)(m < NTX ? m : 0) * DM) + lane;
            const bool isx = m < NTX;
#pragma unroll
            for (int j = 0; j < 4; ++j) { const f32x4 xn = v[j] * rstd * lgv[j] + lbv[j]; if (isx) { v2u xw; xw.x = pk2(xn.x, xn.y); xw.y = pk2(xn.z, xn.w); xs8[64 * j] = xw; }
                const f32x4 r = xn * (msc[j] + 1.0f) + msh[j]; v2u w; w.x = pk2(r.x, r.y); w.y = pk2(r.z, r.w); o8[64 * j] = w; }
        } else {
            GAS f32x4* of = (GAS f32x4*)(a.out() + (size_t)m * DM) + lane;
#pragma unroll
            for (int j = 0; j < 4; ++j) of[64 * j] = v[j] * rstd * lgv[j] + lbv[j];
        }
      }
    }
    }
}
namespace csc {
constexpr int ARR = 0;
constexpr int RAW = 0;
constexpr int ZL = 34816;
constexpr int WLO = 57344;
constexpr int FR = 58368;
constexpr int AABT = 87040;
constexpr int LWO = 91136;
constexpr int AAO = 107520;
__device__ __forceinline__ int sw16(int row, int chunk) { return row * 128 + ((chunk ^ (row & 7)) << 4); }
__device__ __forceinline__ v2u cvt4(const f32x4 v) { v2u r; r.x = pk2(v[0], v[1]); r.y = pk2(v[2], v[3]); return r; }
__device__ __forceinline__ bf16x8 mk8(v2u lo, v2u hi) { v4u w; w.x = lo.x; w.y = lo.y; w.z = hi.x; w.w = hi.y; return __builtin_bit_cast(bf16x8, w); }
__device__ __forceinline__ v2u trd(const LAS unsigned char* p) { return __builtin_bit_cast(v2u, __builtin_amdgcn_ds_read_tr16_b64_v4i16((LAS v4i16_t*)p)); }
__device__ __forceinline__ int opq(int v) { asm volatile("" : "+v"(v)); return v; }
__device__ __forceinline__ int opqs(int v) { asm volatile("" : "+s"(v)); return v; }
}
namespace bgc {
constexpr int CBUF = LDSCTL_OFF + 4096, CPITCH = 80, NITEMS = NEXP * 1536;
struct Item { const float* src; bf16* dst; int N, ld; };
__device__ __forceinline__ Item decode(const KA& a, int l, int item) {
    const int e = item / 1536; int r = item - e * 1536; const int m = r >> 9, t = r & 511; const size_t eo = ((size_t)l * NEXP + e) * (size_t)DM * DEXP; Item it;
    if (m < 2) { const int kt = t >> 4, nt = t & 15, j0 = 32 * nt; it.N = DEXP; it.ld = 1024; it.src = (m ? a.in(I_EW3) : a.in(I_EW1)) + eo + (size_t)(32 * kt) * DEXP + j0;
        it.dst = (bf16*)(a.ws() + WS_W13T) + (size_t)e * 1024 * 1024 + (size_t)(256 * (j0 >> 7) + 128 * m + (j0 & 127)) * 1024 + 32 * kt; }
    else { const int kt = t >> 5, nt = t & 31; it.N = DM; it.ld = 512; it.src = a.in(I_EW2) + eo + (size_t)(32 * kt) * DM + 32 * nt; it.dst = (bf16*)(a.ws() + WS_W2T) + (size_t)e * 1024 * 512 + (size_t)(32 * nt) * 512 + 32 * kt; }
    return it; }
__device__ __forceinline__ void issue(const KA& a, int l, int item, int lane, f32x4 (&cv)[4]) { const Item it = decode(a, l, item);
#pragma unroll
    for (int i = 0; i < 4; ++i) cv[i] = *(const GAS f32x4*)(it.src + (size_t)((lane >> 3) + 8 * i) * it.N + (lane & 7) * 4); }
__device__ __forceinline__ void finish(const KA& a, int l, int item, int lane, int slot, LAS unsigned char* lds, const f32x4 (&cv)[4]) { const Item it = decode(a, l, item);
    LAS unsigned char* buf = lds + CBUF + slot * (32 * CPITCH);
#pragma unroll
    for (int i = 0; i < 4; ++i)
#pragma unroll
        for (int u = 0; u < 4; ++u) *(LAS bf16*)(buf + ((lane & 7) * 4 + u) * CPITCH + ((lane >> 3) + 8 * i) * 2) = f2bf1(cv[i][u]);
    LDS_WAIT(); asm volatile("" ::: "memory");
    const int n = lane >> 1, hf = lane & 1; const v4u w0 = *(const LAS v4u*)(buf + n * CPITCH + hf * 32), w1 = *(const LAS v4u*)(buf + n * CPITCH + hf * 32 + 16);
    GAS v4u* d = (GAS v4u*)(it.dst + (size_t)n * it.ld + 16 * hf); d[0] = w0; d[1] = w1;
    LDS_WAIT(); asm volatile("" ::: "memory"); }
}
#ifndef SCAN_STAMP
#define SCAN_STAMP 0
#endif
#define STB(k) do { if (SCAN_STAMP == (k)) t0_ = (unsigned)__builtin_amdgcn_s_memrealtime(); } while (0)
#define STE(k) do { if (SCAN_STAMP == (k)) tacc_ += (unsigned)__builtin_amdgcn_s_memrealtime() - t0_; } while (0)
#ifndef SCAN_PROBE
#define SCAN_PROBE 0
#endif
#define REPK(k) for (int rep_ = 0; rep_ < ((SCAN_PROBE == (k)) ? 2 : 1); ++rep_)
__device__ __forceinline__ void phase_scan(LAS unsigned char* lds, int l) {
    using namespace csc;
    const KA a = ka_get();
    const int tid = opaque_tid(), lane0 = tid & 63, wv = __builtin_amdgcn_readfirstlane(tid >> 6);
    const bf16* PX = (const bf16*)(a.ws() + WS_X2); float* YD = (float*)(a.ws() + WS_X3); float* BON = (float*)(a.ws() + WS_BONUS);
    const float* mup = a.in(I_MUP) + l * 1760; const float* mun = a.in(I_MUN) + l * 1760;
    const f32x4 Z4 = {0.f, 0.f, 0.f, 0.f}; const v2u Z2 = {0u, 0u};
    unsigned t0_ = 0, tacc_ = 0; (void)t0_;
    for (int chain = blockIdx.x; chain < 256; chain += gridDim.x) {
        const int b = chain >> 4, h = (chain >> 1) & 7, d = chain & 1; const int c0_ = opq(lane0);
        float kkc[2], kac[2], rkc[2], mur[2][2], muk[2][2], muv[2][2], mul[2][2], ropef[2]; bf16x8 w2f[2], a2f[2]; float w0c[2], a0c[2];
        { const int ln = c0_, kl = ln & 15, g = ln >> 4, cp = ln & 31;
#pragma unroll
          for (int u = 0; u < 2; ++u) { const int c = 2 * cp + u; ropef[u] = exp2f(-(float)(c & 15) * (13.287712379549449f / 16.0f));
            kkc[u] = a.in(I_KK)[l * 512 + h * 64 + c]; kac[u] = a.in(I_KA)[l * 512 + h * 64 + c]; rkc[u] = a.in(I_RK)[l * 512 + h * 64 + c];
            const int colr = h * 64 + c, coll = (c < 32) ? (1536 + d * 32 + c) : (1600 + d * 32 + (c - 32));
            mur[u][0] = d ? mun[colr] : mup[colr]; mur[u][1] = d ? mup[colr] : mun[colr]; muk[u][0] = d ? mun[512 + colr] : mup[512 + colr]; muk[u][1] = d ? mup[512 + colr] : mun[512 + colr];
            muv[u][0] = d ? mun[1024 + colr] : mup[1024 + colr]; muv[u][1] = d ? mup[1024 + colr] : mun[1024 + colr]; mul[u][0] = d ? mun[coll] : mup[coll]; mul[u][1] = d ? mup[coll] : mun[coll]; }
#pragma unroll
        for (int i = 0; i < 2; ++i) { const int cc = h * 64 + 16 * ((wv >> 2) * 2 + i) + kl; unsigned t[8], u[8];
#pragma unroll
            for (int j = 0; j < 8; ++j) { t[j] = f2bf(a.in(I_W2)[((size_t)(l * 2 + d) * 32 + 8 * g + j) * 512 + cc]); u[j] = f2bf(a.in(I_A2)[((size_t)(l * 2 + d) * 32 + 8 * g + j) * 512 + cc]); }
            w2f[i] = __builtin_bit_cast(bf16x8, (v4u){t[0] | (t[1] << 16), t[2] | (t[3] << 16), t[4] | (t[5] << 16), t[6] | (t[7] << 16)});
            a2f[i] = __builtin_bit_cast(bf16x8, (v4u){u[0] | (u[1] << 16), u[2] | (u[3] << 16), u[4] | (u[5] << 16), u[6] | (u[7] << 16)});
            w0c[i] = a.in(I_W0)[(l * 2 + d) * 512 + cc]; a0c[i] = a.in(I_A0)[(l * 2 + d) * 512 + cc]; } }
        f32x4 St[4] = {Z4, Z4, Z4, Z4};
        f32x4 cvt_[4] = {Z4, Z4, Z4, Z4}; int cit = blockIdx.x * 8 + wv, cpend = -1; const int cstride = gridDim.x * 8;
#define BGC_WINDOW() do { const int ln_ = opq(lane0); if (cpend >= 0) bgc::finish(a, l, cpend, ln_, wv & 3, lds, cvt_); if (cit < bgc::NITEMS) { bgc::issue(a, l, cit, ln_, cvt_); cpend = cit; cit += cstride; } else cpend = -1; } while (0)
        for (int seq = 0; seq < 2; ++seq) {
            const int T = seq ? SEQ : CTXL, rowbase = seq ? b * SEQ : NTX + b * CTXL, ngrp = T / 64;
            v4u pre[5];
#define CSC_PREFETCH(GRP) do { const int s0_ = (GRP) * 64; const int tlo_ = d ? (T - 64 - s0_) : s0_; \
                _Pragma("unroll") for (int i_ = 0; i_ < 5; ++i_) { const int id_ = opq(tid) + 512 * i_; const int rr_ = id_ >> 5, ch_ = id_ & 31; const int t_ = tlo_ - 1 + rr_; \
                    const int col_ = RWOFF + (ch_ < 24 ? (ch_ >> 3) * 512 + h * 64 + (ch_ & 7) * 8 : (ch_ < 28 ? 1536 + d * 32 + (ch_ - 24) * 8 : 1600 + d * 32 + (ch_ - 28) * 8)); \
                    const bool ok_ = (id_ < 66 * 32) && t_ >= 0 && t_ < T; const int tc_ = ok_ ? t_ : 0; \
                    const v4u v_ = *(const GAS v4u*)(PX + (size_t)(rowbase + tc_) * DINP + col_); pre[i_] = ok_ ? v_ : (v4u){0u, 0u, 0u, 0u}; } } while (0)
            CSC_PREFETCH(0);
            for (int grp = 0; grp < ngrp; ++grp) {
                const int s0 = grp * 64;
                int lane = opq(lane0); int c = lane, kl = lane & 15, g = lane >> 4, q_ = kl >> 2, p_ = kl & 3; (void)q_; (void)p_;
                STB(1);
#pragma unroll
                for (int i = 0; i < 5; ++i) { const int id = opq(tid) + 512 * i; if (id < 66 * 32) *(LAS v4u*)(lds + RAW + id * 16) = pre[i]; }
                __syncthreads();
                STE(1); STB(2);
                int sl = opqs(wv);
                float Rk[4][2], Rq[4][2], Rr[4][2], Rv[4][2];
                REPK(1) { const int cp = lane & 31, sh = lane >> 5, sb = 8 * sl + 4 * sh; const int rbase = d ? 64 - sb : sb + 1, rdir = d ? -256 : 256;
                  const LAS bf16* p0 = (const LAS bf16*)(lds + RAW) + (rbase * 256 + 2 * cp) - rdir;
                  float pr[6][2], pk[6][2], pv[6][2], pl[6][2];
#pragma unroll
                  for (int j = 0; j < 6; ++j) { const LAS unsigned* p = (const LAS unsigned*)(p0 + j * rdir); const unsigned wr = p[0], wk = p[32], wv_ = p[64], wl = p[96];
                      pr[j][0] = bflo(wr); pr[j][1] = bfhi(wr); pk[j][0] = bflo(wk); pk[j][1] = bfhi(wk); pv[j][0] = bflo(wv_); pv[j][1] = bfhi(wv_); pl[j][0] = bflo(wl); pl[j][1] = bfhi(wl); }
                  const int qd = cp >> 3;
#pragma unroll
                  for (int i = 0; i < 4; ++i) { const int sloc = sb + i; float r[2], k[2], zz[2];
#pragma unroll
                      for (int u = 0; u < 2; ++u) { r[u] = pr[i + 1][u] + mur[u][0] * (pr[i][u] - pr[i + 1][u]) + mur[u][1] * (pr[i + 2][u] - pr[i + 1][u]); k[u] = pk[i + 1][u] + muk[u][0] * (pk[i][u] - pk[i + 1][u]) + muk[u][1] * (pk[i + 2][u] - pk[i + 1][u]);
                          Rv[i][u] = pv[i + 1][u] + muv[u][0] * (pv[i][u] - pv[i + 1][u]) + muv[u][1] * (pv[i + 2][u] - pv[i + 1][u]);
                          const float z = pl[i + 1][u] + mul[u][0] * (pl[i][u] - pl[i + 1][u]) + mul[u][1] * (pl[i + 2][u] - pl[i + 1][u]);
                          const float th = 1.0f - 2.0f * __builtin_amdgcn_rcpf(1.0f + __expf(2.0f * z)); zz[u] = cp < 16 ? th : z; }
                      ((LAS unsigned*)(lds + ZL))[sloc * 32 + cp] = pk2(zz[0], zz[1]);
                      if (seq) { const int t = d ? (T - 1 - (s0 + sloc)) : (s0 + sloc); const float pos = (float)((qd < 2) ? (t >> 6) : (t & 63));
#pragma unroll
                          for (int u = 0; u < 2; ++u) { const float rp = dppmov<0x128>(r[u]), kp = dppmov<0x128>(k[u]); const float ang = pos * ropef[u]; const float cs = __cosf(ang), sn = __sinf(ang);
                              const float sg = (qd & 1) ? sn : -sn; r[u] = r[u] * cs + rp * sg; k[u] = k[u] * cs + kp * sg; } }
                      const float k0 = k[0] * kkc[0], k1 = k[1] * kkc[1]; float ss = k0 * k0 + k1 * k1;
                      ss += dppmov<0xB1>(ss); ss += dppmov<0x4E>(ss); ss += dppmov<0x141>(ss); ss += dppmov<0x140>(ss);
                      { const int iv = __builtin_bit_cast(int, ss); const float a0 = __builtin_bit_cast(float, __builtin_amdgcn_readlane(iv, 0)) + __builtin_bit_cast(float, __builtin_amdgcn_readlane(iv, 16)), a1 = __builtin_bit_cast(float, __builtin_amdgcn_readlane(iv, 32)) + __builtin_bit_cast(float, __builtin_amdgcn_readlane(iv, 48)); ss = sh ? a1 : a0; }
                      const float rn = __builtin_amdgcn_rsqf(fmaxf(ss, 1e-24f));
                      Rk[i][0] = k0 * rn; Rk[i][1] = k1 * rn; Rq[i][0] = k[0]; Rq[i][1] = k[1]; Rr[i][0] = r[0]; Rr[i][1] = r[1]; } }
                __syncthreads();
                STE(2); STB(3);
                lane = opq(lane0); c = lane; kl = lane & 15; g = lane >> 4; q_ = kl >> 2; p_ = kl & 3;
                REPK(2) { const int wq = opqs(wv); const int st = wq & 3; const LAS unsigned char* zrow = lds + ZL + (16 * st + kl) * 128;
                  const bf16x8 zw = *(const LAS bf16x8*)(zrow + 16 * g), za = *(const LAS bf16x8*)(zrow + 64 + 16 * g);
#pragma unroll
                  for (int i = 0; i < 2; ++i) { const int cc = 16 * ((wq >> 2) * 2 + i) + kl;
                      const f32x4 uw = __builtin_amdgcn_mfma_f32_16x16x32_bf16(zw, w2f[i], Z4, 0, 0, 0), ua = __builtin_amdgcn_mfma_f32_16x16x32_bf16(za, a2f[i], Z4, 0, 0, 0);
#pragma unroll
                      for (int j = 0; j < 4; ++j) { const int srow = 16 * st + 4 * g + j;
                          ((LAS float*)(lds + LWO))[srow * 64 + cc] = -0.6065306597126334f * __builtin_amdgcn_rcpf(1.0f + __expf(-(uw[j] + w0c[i]))); ((LAS float*)(lds + AAO))[srow * 64 + cc] = __builtin_amdgcn_rcpf(1.0f + __expf(-(ua[j] + a0c[i]))); } } }
                __syncthreads();
                STE(3); STB(4);
                lane = opq(lane0); c = lane; kl = lane & 15; g = lane >> 4; q_ = kl >> 2; p_ = kl & 3;
                sl = opqs(wv);
                REPK(4) { const int cp = lane & 31, sh = lane >> 5, q = sl >> 1, hf = sl & 1; typedef float f32x2_ __attribute__((ext_vector_type(2)));
                  const LAS f32x2_* lwp = (const LAS f32x2_*)((const LAS float*)(lds + LWO) + (16 * q) * 64 + 2 * cp); const LAS f32x2_* aap = (const LAS f32x2_*)((const LAS float*)(lds + AAO) + (8 * sl + 4 * sh) * 64 + 2 * cp);
                  f32x2_ qs[4];
#pragma unroll
                  for (int j = 0; j < 4; ++j) { qs[j] = lwp[(4 * j) * 32] + lwp[(4 * j + 1) * 32] + lwp[(4 * j + 2) * 32] + lwp[(4 * j + 3) * 32]; }
                  const f32x2_ cL = (qs[0] + qs[1]) + (qs[2] + qs[3]); const int part = 2 * hf + sh;
                  f32x2_ run = part == 0 ? (f32x2_){0.f, 0.f} : (part == 1 ? qs[0] : (part == 2 ? qs[0] + qs[1] : qs[0] + qs[1] + qs[2]));
                  const float wl0 = __expf(cL.x), wl1 = __expf(cL.y);
                  if (part == 3) ((LAS f32x2_*)(lds + WLO))[q * 32 + cp] = (f32x2_){wl0, wl1};
#pragma unroll
                  for (int i = 0; i < 4; ++i) { const int sloc = 8 * sl + 4 * sh + i, s = 4 * part + i; const f32x2_ lwi = lwp[s * 32]; const f32x2_ cprev = run; run = run + lwi; const f32x2_ aa = aap[i * 32];
                      const float kd0 = Rq[i][0] * (1.0f + (aa.x - 1.0f) * kac[0]), kd1 = Rq[i][1] * (1.0f + (aa.y - 1.0f) * kac[1]), nb0 = -Rk[i][0] * aa.x, nb1 = -Rk[i][1] * aa.y;
                      float bon = Rr[i][0] * kd0 * rkc[0] + Rr[i][1] * kd1 * rkc[1];
                      bon += dppmov<0xB1>(bon); bon += dppmov<0x4E>(bon); bon += dppmov<0x141>(bon); bon += dppmov<0x140>(bon);
                      { const int iv = __builtin_bit_cast(int, bon); const float a0 = __builtin_bit_cast(float, __builtin_amdgcn_readlane(iv, 0)) + __builtin_bit_cast(float, __builtin_amdgcn_readlane(iv, 16)), a1 = __builtin_bit_cast(float, __builtin_amdgcn_readlane(iv, 32)) + __builtin_bit_cast(float, __builtin_amdgcn_readlane(iv, 48)); bon = sh ? a1 : a0; }
                      if (cp == 0) { const int t = d ? (T - 1 - (s0 + sloc)) : (s0 + sloc); BON[((size_t)d * NTOK + rowbase + t) * 8 + h] = bon; }
                      const float e1x = __expf(cprev.x), e1y = __expf(cprev.y), e2x = __expf(-run.x), e2y = __expf(-run.y), e3x = __builtin_amdgcn_rcpf(e2x), e3y = __builtin_amdgcn_rcpf(e2y);
                      LAS unsigned char* base = lds + ARR + q * (7 * 2048) + sw16(s, cp >> 2) + (cp & 3) * 4;
                      *(LAS unsigned*)(base) = pk2(Rk[i][0] * e1x, Rk[i][1] * e1y); *(LAS unsigned*)(base + 2048) = pk2(nb0 * e2x, nb1 * e2y); *(LAS unsigned*)(base + 4096) = pk2(kd0 * e2x, kd1 * e2y); *(LAS unsigned*)(base + 6144) = pk2(Rr[i][0] * e3x, Rr[i][1] * e3y);
                      *(LAS unsigned*)(base + 12288) = pk2(Rv[i][0], Rv[i][1]); } }
                __syncthreads();
                STE(4); STB(5);
                lane = opq(lane0); c = lane; kl = lane & 15; g = lane >> 4; q_ = kl >> 2; p_ = kl & 3;
                STB(7); if (wv < 4) { BGC_WINDOW(); if (grp + 1 < ngrp) CSC_PREFETCH(grp + 1); } STE(7);
                STB(8); STB(10);
                REPK(5) if (wv >= 4) { __builtin_amdgcn_s_setprio(3); const int q = opqs(wv) - 4; const LAS unsigned char* A0 = lds + ARR + q * (7 * 2048);
                    STB(11);
                    bf16x8 at[2], bt[2], kt[2], rt[2];
#pragma unroll
                    for (int ks = 0; ks < 2; ++ks) { const int o = sw16(kl, ks * 4 + g); at[ks] = *(const LAS bf16x8*)(A0 + o); bt[ks] = *(const LAS bf16x8*)(A0 + 2048 + o); kt[ks] = *(const LAS bf16x8*)(A0 + 4096 + o); rt[ks] = *(const LAS bf16x8*)(A0 + 6144 + o); }
                    f32x4 ABt = Z4, AKt = Z4, RBt = Z4, RKt = Z4;
#pragma unroll
                    for (int ks = 0; ks < 2; ++ks) { ABt = __builtin_amdgcn_mfma_f32_16x16x32_bf16(bt[ks], at[ks], ABt, 0, 0, 0); AKt = __builtin_amdgcn_mfma_f32_16x16x32_bf16(kt[ks], at[ks], AKt, 0, 0, 0);
                        RBt = __builtin_amdgcn_mfma_f32_16x16x32_bf16(bt[ks], rt[ks], RBt, 0, 0, 0); RKt = __builtin_amdgcn_mfma_f32_16x16x32_bf16(kt[ks], rt[ks], RKt, 0, 0, 0); }
#pragma unroll
                    for (int j = 0; j < 4; ++j) { const int jj = 4 * g + j; ABt[j] = jj < kl ? ABt[j] : 0.f; AKt[j] = jj < kl ? AKt[j] : 0.f; RBt[j] = jj <= kl ? RBt[j] : 0.f; RKt[j] = jj <= kl ? RKt[j] : 0.f; }
                    STE(11); STB(12);
                    float Tr[16]; const float ab0 = ABt[0], ab1 = ABt[1], ab2 = ABt[2], ab3 = ABt[3];
                    const int abi[4] = {__builtin_bit_cast(int, ab0), __builtin_bit_cast(int, ab1), __builtin_bit_cast(int, ab2), __builtin_bit_cast(int, ab3)};
#pragma unroll
                    for (int i = 0; i < 16; ++i) Tr[i] = (i == kl) ? 1.f : 0.f;
#pragma unroll
                    for (int j = 14; j >= 0; --j) { float acc = 0.f;
#pragma unroll
                        for (int i = 15; i > j; --i) acc += Tr[i] * __builtin_bit_cast(float, __builtin_amdgcn_readlane(abi[j & 3], i + 16 * (j >> 2)));
                        Tr[j] = (j < kl) ? acc : Tr[j]; }
                    STE(12); STB(13);
                    float tsel[4];
#pragma unroll
                    for (int e = 0; e < 4; ++e) tsel[e] = g == 0 ? Tr[e] : (g == 1 ? Tr[4 + e] : (g == 2 ? Tr[8 + e] : Tr[12 + e]));
                    v2u tf2; tf2.x = pk2(tsel[0], tsel[1]); tf2.y = pk2(tsel[2], tsel[3]);
                    const bf16x8 Tf = mk8(tf2, Z2), RBf = mk8(cvt4(RBt), Z2);
                    f32x4 AhT[4], QhT[4], Ah[4], rin[4]; bf16x8 Alo[4];
#pragma unroll
                    for (int ct = 0; ct < 4; ++ct) { Alo[ct] = mk8(trd(A0 + sw16(4 * g + q_, 2 * ct + (p_ >> 1)) + (p_ & 1) * 8), Z2);
                        const v2u rw = *(const LAS v2u*)(A0 + 6144 + sw16(kl, 2 * ct + (g >> 1)) + (g & 1) * 8);
                        rin[ct] = (f32x4){bflo(rw.x), bfhi(rw.x), bflo(rw.y), bfhi(rw.y)}; }
#pragma unroll
                    for (int ct = 0; ct < 4; ++ct) { AhT[ct] = __builtin_amdgcn_mfma_f32_16x16x32_bf16(Alo[ct], Tf, Z4, 0, 0, 0);
                        Ah[ct] = __builtin_amdgcn_mfma_f32_16x16x32_bf16(Tf, Alo[ct], Z4, 0, 0, 0); }
#pragma unroll
                    for (int ct = 0; ct < 4; ++ct) QhT[ct] = __builtin_amdgcn_mfma_f32_16x16x32_bf16(mk8(cvt4(Ah[ct]), Z2), RBf, rin[ct], 0, 0, 0);
                    STE(13); STB(14);
                    LAS unsigned char* fr = lds + FR + q * 7168 + lane * 16;
                    *(LAS bf16x8*)(fr) = mk8(cvt4(AhT[0]), cvt4(AhT[1])); *(LAS bf16x8*)(fr + 1024) = mk8(cvt4(AhT[2]), cvt4(AhT[3]));
                    *(LAS bf16x8*)(fr + 2048) = mk8(cvt4(QhT[0]), cvt4(QhT[1])); *(LAS bf16x8*)(fr + 3072) = mk8(cvt4(QhT[2]), cvt4(QhT[3]));
                    *(LAS bf16x8*)(fr + 4096) = mk8(cvt4(AKt), Z2); *(LAS bf16x8*)(fr + 5120) = mk8(cvt4(RBt), cvt4(RKt)); *(LAS bf16x8*)(fr + 6144) = Tf;
                    STE(14);
                    __builtin_amdgcn_s_setprio(0);
                }
                STE(8); STE(10);
                __syncthreads();
                STE(5); STB(6);
                lane = opq(lane0); c = lane; kl = lane & 15; g = lane >> 4; q_ = kl >> 2; p_ = kl & 3;
                if (wv >= 4) { BGC_WINDOW(); if (grp + 1 < ngrp) CSC_PREFETCH(grp + 1); }
                if (wv < 4) { __builtin_amdgcn_s_setprio(3); const int vt = opqs(wv);
#pragma unroll 1
                    for (int q = 0; q < 4; ++q) { const LAS unsigned char* A0 = lds + ARR + q * (7 * 2048); const LAS unsigned char* fr = lds + FR + q * 7168 + lane * 16;
                        const bf16x8 Ap0 = *(const LAS bf16x8*)(fr), Ap1 = *(const LAS bf16x8*)(fr + 1024), Qp0 = *(const LAS bf16x8*)(fr + 2048), Qp1 = *(const LAS bf16x8*)(fr + 3072);
                        const bf16x8 AKf = *(const LAS bf16x8*)(fr + 4096), RBRK = *(const LAS bf16x8*)(fr + 5120), Tf = *(const LAS bf16x8*)(fr + 6144);
                        const v2u vtr = trd(A0 + 12288 + sw16(4 * g + q_, 2 * vt + (p_ >> 1)) + (p_ & 1) * 8);
                        bf16x8 bk[4]; f32x4 wl[4];
#pragma unroll
                        for (int ct = 0; ct < 4; ++ct) { wl[ct] = *(const LAS f32x4*)(lds + WLO + (q * 64 + 16 * ct + 4 * g) * 4); const int o = sw16(4 * g + q_, 2 * ct + (p_ >> 1)) + (p_ & 1) * 8; bk[ct] = mk8(trd(A0 + 2048 + o), trd(A0 + 4096 + o)); }
                        const f32x4 X1 = __builtin_amdgcn_mfma_f32_16x16x32_bf16(AKf, mk8(vtr, Z2), Z4, 0, 0, 0);
                        const f32x4 Uh = __builtin_amdgcn_mfma_f32_16x16x32_bf16(Tf, mk8(cvt4(X1), Z2), Z4, 0, 0, 0);
                        const f32x4 Yh = __builtin_amdgcn_mfma_f32_16x16x32_bf16(RBRK, mk8(cvt4(Uh), vtr), Z4, 0, 0, 0);
                        const bf16x8 bs0 = mk8(cvt4(St[0]), cvt4(St[1])), bs1 = mk8(cvt4(St[2]), cvt4(St[3]));
                        f32x4 U = __builtin_amdgcn_mfma_f32_16x16x32_bf16(Ap0, bs0, Uh, 0, 0, 0); U = __builtin_amdgcn_mfma_f32_16x16x32_bf16(Ap1, bs1, U, 0, 0, 0);
                        f32x4 Y = __builtin_amdgcn_mfma_f32_16x16x32_bf16(Qp0, bs0, Yh, 0, 0, 0); Y = __builtin_amdgcn_mfma_f32_16x16x32_bf16(Qp1, bs1, Y, 0, 0, 0);
                        const bf16x8 UV = mk8(cvt4(U), vtr);
#pragma unroll
                        for (int ct = 0; ct < 4; ++ct) St[ct] = __builtin_amdgcn_mfma_f32_16x16x32_bf16(bk[ct], UV, St[ct], 0, 0, 0) * wl[ct];
#pragma unroll
                        for (int j = 0; j < 4; ++j) { const int sg = s0 + 16 * q + 4 * g + j; const int t = d ? (T - 1 - sg) : sg; YD[((size_t)d * NTOK + rowbase + t) * 512 + h * 64 + 16 * vt + kl] = Y[j]; }
                    }
                    __builtin_amdgcn_s_setprio(0);
                }
                __syncthreads();
                STE(6);
            }
#undef CSC_PREFETCH
        }
        if (cpend >= 0) { bgc::finish(a, l, cpend, opq(lane0), wv & 3, lds, cvt_); cpend = -1; }
        for (; cit < bgc::NITEMS; cit += cstride) { bgc::issue(a, l, cit, opq(lane0), cvt_); bgc::finish(a, l, cit, opq(lane0), wv & 3, lds, cvt_); }
#undef BGC_WINDOW
    }
    if (SCAN_STAMP != 0 && blockIdx.x == 0 && tid == ((SCAN_STAMP == 8 || (SCAN_STAMP >= 11 && SCAN_STAMP <= 14)) ? 256 : ((SCAN_STAMP == 10) ? 448 : 0))) atomicAdd((unsigned*)(a.ws() + WS_CTL) + 2000, tacc_);
}
constexpr int PH_PER_LAYER = 11, N_PHASES = 1 + 2 * PH_PER_LAYER;
template <int K> __device__ __forceinline__ void run_phase(LAS unsigned char* lds, int l) {
    if constexpr (K == 0) phase_prologue(lds);
    if constexpr (K == 1) phase_modconv(lds, l);
    if constexpr (K == 3) phase_scan(lds, l);
    if constexpr (K == 4) phase_attn(lds, l);
    if constexpr (K == 5) phase_rwpost(lds, l);
    if constexpr (K == 7) { if (l == 0) phase_ln1_route<false>(lds, l); else phase_ln1_route<true>(lds, l); }
    if constexpr (K == 8) phase_gather(lds, l);
    if constexpr (K == 11) phase_ln2(lds, l);
    if constexpr (K == 2 || K == 6 || K == 9 || K == 10) {
        const KA a = ka_get(); unsigned char* ws = a.ws(); const int G = gridDim.x, bid = blockIdx.x;
        bf16* X1 = (bf16*)(ws + WS_X1); bf16* X2 = (bf16*)(ws + WS_X2); bf16* X3 = (bf16*)(ws + WS_X3);
        if constexpr (K == 2) { __syncthreads();
            pg8::Gemm g{X1, (const bf16*)(ws + WS_WINT) + (size_t)l * DINP * DM, NTOK, DINP, DM}; pg8::StaticOrder S; S.init(NTOK, DINP, G, bid);
            pg8::EpiBf16 E{X2, DINP}; pg8::gemm_phase<pg8::EpiBf16, pg8::StaticOrder, true, true>(lds, g, S, E); }
        if constexpr (K == 6) { __syncthreads();
            const int Mrows = (l == 0) ? NTOK : NTX;
            pg8::Gemm g{X1, (const bf16*)(ws + WS_WOT) + (size_t)l * DM * DM, Mrows, DM, DM}; pg8::StaticOrder S; S.init(Mrows, DM, G, bid);
            pg8::EpiBf16 E{X3, DM}; pg8::gemm_phase<pg8::EpiBf16, pg8::StaticOrder, true, true>(lds, g, S, E); }
        if constexpr (K == 9) { moe_tables<false>(lds, l);
            pg8::Gemm g{X2, (const bf16*)(ws + WS_W13T), MAXSLOT, 1024, DM}; pg8::MoeOrder S; S.init((const LAS int*)(lds + PREF_OFF), 4, G, bid);
            pg8::EpiSwiGLU E{X3, DEXP}; pg8::gemm_phase<pg8::EpiSwiGLU, pg8::MoeOrder, true, true>(lds, g, S, E); }
        if constexpr (K == 10) { moe_tables<false>(lds, l);
            pg8::Gemm g{X3, (const bf16*)(ws + WS_W2T), MAXSLOT, 1024, DEXP}; pg8::MoeOrder S; S.init((const LAS int*)(lds + PREF_OFF), 4, G, bid);
            pg8::EpiBf16 E{X2, DM}; pg8::gemm_phase<pg8::EpiBf16, pg8::MoeOrder, true, true>(lds, g, S, E); }
    }
}
__device__ __forceinline__ void grid_sync(LAS unsigned char* lds) {
    const KA a = ka_get(); XcdBarrier b; b.bar = (unsigned*)(a.ws() + WS_CTL) + CW_BAR; b.x = xb_xcc_id(); b.st = (volatile LAS unsigned*)(lds + MISC_OFF) + 8; xcd_barrier(b);
#ifdef PROBE_BAR
    xcd_barrier(b);
#endif
}
#ifndef ONE_LAUNCH
template <int K> __global__ void __launch_bounds__(512, 2) fwd_ph(Args args) {
    extern __shared__ __attribute__((aligned(16))) unsigned char lds_raw[];
    LAS unsigned char* lds = (LAS unsigned char*)lds_raw;
    for (int u = threadIdx.x; u < (LDS_BYTES - LDSCTL_OFF) / 4; u += 512) ((LAS unsigned*)(lds + LDSCTL_OFF))[u] = 0u;
    __syncthreads();
    hw_tid_init();
    __syncthreads();
    run_phase<K>(lds, args.ph_lo);
}
template <int K> static void launch_ph(const Args& a, int grid, hipStream_t stream) {
    static bool attr = false;
    if (!attr) { (void)hipFuncSetAttribute((const void*)fwd_ph<K>, hipFuncAttributeMaxDynamicSharedMemorySize, LDS_BYTES); attr = true; }
    hipLaunchKernelGGL(fwd_ph<K>, dim3(grid), dim3(512), LDS_BYTES, stream, a);
}
#else
__global__ void __launch_bounds__(512, 2) fwd(Args args) {
    extern __shared__ __attribute__((aligned(16))) unsigned char lds_raw[];
    LAS unsigned char* lds = (LAS unsigned char*)lds_raw;
    for (int u = threadIdx.x; u < (LDS_BYTES - LDSCTL_OFF) / 4; u += 512) ((LAS unsigned*)(lds + LDSCTL_OFF))[u] = 0u;
    __syncthreads();
    hw_tid_init();
    __syncthreads();
    (void)xcd_barrier_post((unsigned*)(args.ws + WS_CTL) + CW_BAR, (volatile LAS unsigned*)(lds + MISC_OFF) + 8);
    run_phase<0>(lds, 0);
#ifdef PROBE_P0
    __syncthreads(); run_phase<0>(lds, 0);
#endif
    grid_sync(lds);
#ifndef PROBE_REP
#define PROBE_REP -1
#endif
#define RUNP(K) do { run_phase<K>(lds, l); if (PROBE_REP == K) { __syncthreads(); run_phase<K>(lds, l); } } while (0)
    for (int l = 0; l < 2; ++l) {
        if (l == 0) { RUNP(1); grid_sync(lds); }
        RUNP(2); grid_sync(lds);
        RUNP(3);
        RUNP(4); grid_sync(lds);
        RUNP(5); grid_sync(lds);
        RUNP(6); grid_sync(lds);
        run_phase<7>(lds, l); if (PROBE_REP == 7 && l == 0) { __syncthreads(); run_phase<7>(lds, l); } grid_sync(lds);
        RUNP(8); grid_sync(lds);
        RUNP(9); grid_sync(lds);
        RUNP(10); grid_sync(lds);
        RUNP(11); if (l == 0) grid_sync(lds);
    }
#if defined(SCAN_STAMP) && SCAN_STAMP != 0
    if (blockIdx.x == 0 && hw_tid() == 0) { const unsigned long long tk = __hip_atomic_load((unsigned*)(args.ws + WS_CTL) + 2000, __ATOMIC_RELAXED, __HIP_MEMORY_SCOPE_AGENT); const unsigned long long ts = __builtin_amdgcn_s_memrealtime(); while (__builtin_amdgcn_s_memrealtime() - ts < tk) __builtin_amdgcn_s_sleep(8); }
#endif
}
#endif

extern "C" void kernel_launch(void* const* d_in, const int* in_sizes, int n_in, void* d_out, int out_size, void* d_ws, size_t ws_size, hipStream_t stream) {
    static int grid = 0;
    if (grid == 0) {
        if (n_in != 30 || in_sizes[0] != NTX * DM || out_size != NTX * DM || ws_size < WS_END) {
            fprintf(stderr, "kernel_launch: unexpected problem (n_in %d, in0 %d, out %d, ws %zu < %zu?); nothing launched\n", n_in, n_in > 0 ? in_sizes[0] : -1, out_size, ws_size, (size_t)WS_END); grid = -1; return; }
        int dev = 0, cus = 0;
        if (hipGetDevice(&dev) != hipSuccess || hipDeviceGetAttribute(&cus, hipDeviceAttributeMultiprocessorCount, dev) != hipSuccess) { grid = -1; return; }
#ifdef ONE_LAUNCH
        if (hipFuncSetAttribute((const void*)fwd, hipFuncAttributeMaxDynamicSharedMemorySize, LDS_BYTES) != hipSuccess) { fprintf(stderr, "kernel_launch: hipFuncSetAttribute failed\n"); grid = -1; return; }
#endif
        (void)hipGetLastError();
        grid = cus > 0 ? cus : 256;
        if (grid != 256 && grid != 128) { fprintf(stderr, "kernel_launch: %d CUs: the LN1/LN2 row maps need 128 or 256 workgroups\n", grid); grid = -1; return; }
    }
    if (grid < 0) return;
    if (hipMemsetAsync((char*)d_ws + WS_CTL, 0, CTL_ZERO_BYTES, stream) != hipSuccess) return;
    Args a{};
    for (int i = 0; i < 30; ++i) a.in[i] = (const float*)d_in[i];
    a.out = (float*)d_out; a.ws = (unsigned char*)d_ws; a.ph_lo = 0; a.ph_hi = 0;
#ifndef ONE_LAUNCH
    launch_ph<0>(a, grid, stream);
    for (int l = 0; l < 2; ++l) { a.ph_lo = l;
        launch_ph<1>(a, grid, stream); launch_ph<2>(a, grid, stream); launch_ph<3>(a, grid, stream); launch_ph<4>(a, grid, stream); launch_ph<5>(a, grid, stream); launch_ph<6>(a, grid, stream);
        launch_ph<7>(a, grid, stream); launch_ph<8>(a, grid, stream); launch_ph<9>(a, grid, stream); launch_ph<10>(a, grid, stream); launch_ph<11>(a, grid, stream); }
#else
    hipLaunchKernelGGL(fwd, dim3(grid), dim3(512), LDS_BYTES, stream, a);
#endif
}
```

```cpp
#define ONE_LAUNCH 1
#include <hip/hip_runtime.h>
#include <cstdio>
#include <cstdint>

constexpr int DM = 1024, NB = 16, SEQ = 2048, CTXL = 256, NTX = NB * SEQ, NTC = NB * CTXL, NTOK = NTX + NTC;
constexpr int DIN = 3296, DINP = 3328, RWOFF = 1536, NHEAD = 8, HD = 64;
constexpr int NEXP = 32, DEXP = 512, LISTCAP = 2 * NTOK;
constexpr int MAXSLOT = 81920;
constexpr float ALPHA = 1.41421356237309515f, LN_EPS = 1e-6f, GN_EPS = 64e-5f;

constexpr size_t MiB = 1u << 20;
constexpr size_t WS_CTL = 0, CTL_ZERO_BYTES = 1 * MiB;
constexpr size_t WS_MODS = 1 * MiB;
constexpr size_t WS_ROPE = 2 * MiB;
constexpr size_t WS_WINT = 3 * MiB;
constexpr size_t WS_WOT = 16 * MiB;
constexpr size_t WS_W13T = 20 * MiB;
constexpr size_t WS_W2T = 84 * MiB;
constexpr size_t WS_LIST = 116 * MiB;
constexpr size_t WS_TOK = 125 * MiB;
constexpr size_t WS_BONUS = 127 * MiB;
constexpr size_t WS_CS = 130 * MiB;
constexpr size_t WS_X1 = 146 * MiB;
constexpr size_t WS_X2 = 218 * MiB;
constexpr size_t WS_XP = WS_X2 + 160 * MiB;
constexpr size_t WS_X3 = 452 * MiB;
constexpr size_t WS_END = 596 * MiB;
static_assert(WS_WINT + (size_t)2 * DINP * DM * 2 <= WS_WOT && WS_LIST + (size_t)NEXP * LISTCAP * 4 <= WS_TOK && WS_TOK + (size_t)NTOK * 32 <= WS_BONUS, "ws map");
static_assert(WS_BONUS + (size_t)2 * NTOK * 8 * 4 <= WS_CS && WS_X2 + (size_t)NTOK * DINP * 2 <= WS_X3 && WS_X3 + (size_t)2 * NTOK * 512 * 4 <= WS_END, "ws map");
static_assert((size_t)MAXSLOT * 1024 * 2 <= WS_XP - WS_X2 && WS_XP + (size_t)NTOK * DM * 2 <= WS_X3 && (size_t)MAXSLOT * 512 * 2 <= WS_END - WS_X3, "ws map");
constexpr int CW_BAR = 4096;
constexpr int CW_CNT = 8192;
constexpr int RING_BYTES = 131072, LDSCTL_OFF = RING_BYTES, MISC_OFF = LDSCTL_OFF + 320, LDS_BYTES = 147456;
constexpr int PREF_OFF = LDSCTL_OFF + 512;

#define GAS __attribute__((address_space(1)))
#define LAS __attribute__((address_space(3)))
typedef unsigned short bf16;
typedef unsigned v4u __attribute__((ext_vector_type(4)));
typedef unsigned v2u __attribute__((ext_vector_type(2)));
typedef float f32x4 __attribute__((ext_vector_type(4)));
typedef short bf16x8 __attribute__((ext_vector_type(8)));
typedef GAS unsigned gu32;
#define RLX_AGENT __ATOMIC_RELAXED, __HIP_MEMORY_SCOPE_AGENT
#define LDS_WAIT() asm volatile("s_waitcnt lgkmcnt(0)" ::: "memory")
#define VM_WAIT() asm volatile("s_waitcnt vmcnt(0)" ::: "memory")
__device__ __forceinline__ unsigned f2bf(float f) { unsigned u = __builtin_bit_cast(unsigned, f); return (u + 0x7fffu + ((u >> 16) & 1u)) >> 16; }
typedef float f32x2_t_ __attribute__((ext_vector_type(2))); typedef __bf16 bf16x2_t_ __attribute__((ext_vector_type(2)));
__device__ __forceinline__ unsigned pk2(float lo, float hi) { f32x2_t_ v = {lo, hi}; bf16x2_t_ b = __builtin_convertvector(v, bf16x2_t_); return __builtin_bit_cast(unsigned, b); }
__device__ __forceinline__ unsigned short f2bf1(float f) { return (unsigned short)(pk2(f, 0.f) & 0xffffu); }
__device__ __forceinline__ float bf2f(unsigned short v) { return __builtin_bit_cast(float, (unsigned)v << 16); }
__device__ __forceinline__ float bflo(unsigned w) { return __builtin_bit_cast(float, w << 16); }
__device__ __forceinline__ float bfhi(unsigned w) { return __builtin_bit_cast(float, w & 0xffff0000u); }
__device__ __forceinline__ float sigmoidf_(float x) { return 1.0f / (1.0f + expf(-x)); }
__device__ __forceinline__ float shx(float v, int k, int lane) { return __builtin_bit_cast(float, __builtin_amdgcn_ds_bpermute((lane ^ k) << 2, __builtin_bit_cast(int, v))); }
__device__ __forceinline__ float shi(float v, int src) { return __builtin_bit_cast(float, __builtin_amdgcn_ds_bpermute(src << 2, __builtin_bit_cast(int, v))); }
template <int CTRL> __device__ __forceinline__ float dppmov(float v) { return __builtin_bit_cast(float, __builtin_amdgcn_update_dpp(0, __builtin_bit_cast(int, v), CTRL, 0xF, 0xF, true)); }
__device__ __forceinline__ float wave_sum(float v) {
    v += dppmov<0xB1>(v); v += dppmov<0x4E>(v); v += dppmov<0x141>(v); v += dppmov<0x140>(v);
    const int iv = __builtin_bit_cast(int, v);
    return (__builtin_bit_cast(float, __builtin_amdgcn_readlane(iv, 0)) + __builtin_bit_cast(float, __builtin_amdgcn_readlane(iv, 16))) + (__builtin_bit_cast(float, __builtin_amdgcn_readlane(iv, 32)) + __builtin_bit_cast(float, __builtin_amdgcn_readlane(iv, 48)));
}
__device__ __forceinline__ float red8(float v) { v += dppmov<0xB1>(v); v += dppmov<0x4E>(v); v += dppmov<0x141>(v); return v; }

struct TokInfo { int e0, e1, p0, p1; float g0, g1; int pad0, pad1; };

constexpr int WID_OFF = LDSCTL_OFF + 1536;
__device__ __forceinline__ int hw_slot() { return (int)__builtin_amdgcn_s_getreg((5 << 11) | 4) & 63; }
__device__ __forceinline__ int lane_id() { int l; asm volatile("v_mbcnt_lo_u32_b32 %0, -1, 0\n\tv_mbcnt_hi_u32_b32 %0, -1, %0" : "=v"(l)); return l; }
__device__ __forceinline__ void hw_tid_init() { *(volatile LAS int*)(uintptr_t)(WID_OFF + 4 * hw_slot()) = (int)(threadIdx.x >> 6); }
__device__ __forceinline__ int hw_tid() { const int w = *(volatile LAS int*)(uintptr_t)(WID_OFF + 4 * hw_slot()); int t = (__builtin_amdgcn_readfirstlane(w) << 6) | lane_id(); asm volatile("" : "+v"(t)); return t; }
namespace pg8 {
#define PG8_LAS __attribute__((address_space(3)))
typedef unsigned short bf16_t;
typedef short bf16x8 __attribute__((ext_vector_type(8)));
typedef float f32x4 __attribute__((ext_vector_type(4)));
typedef unsigned u32x4 __attribute__((ext_vector_type(4)));
constexpr int BM = 256, BK = 64, HALF = 128, HTB = HALF * BK * 2  , STAGE_BYTES = 8 * HTB, NXCD = 8, WGM = 8;

__host__ __device__ __forceinline__ int lds_byte(int r, int c) { const int st = (r >> 4) * 2 + (c >> 5), rr = r & 15, cc = c & 31, ob = rr * 64 + cc * 2; return st * 1024 + (ob ^ (((ob >> 9) & 1) << 5)); }
__host__ __device__ __forceinline__ void stage_rc(int b, int& R, int& C) { const int st = b / 1024, sb = b % 1024, swz = sb ^ (((sb >> 9) & 1) << 5); R = (st >> 1) * 16 + swz / 64; C = (st & 1) * 32 + (swz % 64) / 2; }
__host__ __device__ __forceinline__ int perm32(int rho) { const int n = rho >> 4, i = rho & 15; return 8 * (i >> 2) + 4 * n + (i & 3); }

struct Unit { int pm, pn, pnb; };
struct Gemm { const bf16_t* A; const bf16_t* Bt; int M, N, K; };

struct StaticOrder {
    int nM, nN, nwg, G, c;
    __host__ __device__ void init(int M, int N, int G_, int c_) { nM = M / BM; nN = N / BM; nwg = nM * nN; G = G_; c = c_; }
    __host__ __device__ bool next(int i, Unit& u) const {
        const long L = (long)i * G + c; if (L >= nwg) return false;
        int wgid = (int)L; { const int q = nwg / NXCD, r = nwg % NXCD, xcd = wgid % NXCD, off = wgid / NXCD; wgid = (xcd < r ? xcd * (q + 1) : r * (q + 1) + (xcd - r) * q) + off; }
        const int nig = WGM * nN, gid = wgid / nig, fm = gid * WGM, gsz = (nM - fm) < WGM ? (nM - fm) : WGM;
        u.pm = fm + ((wgid % nig) % gsz); u.pn = (wgid % nig) / gsz; u.pnb = u.pn; return true;
    }
    __device__ __forceinline__ void a_ready(const Unit&) const {}
    __device__ __forceinline__ void done(const Unit&) const {}
};

__device__ __forceinline__ unsigned cvt_pk_bf16(float lo, float hi) { unsigned r; asm volatile("v_cvt_pk_bf16_f32 %0, %1, %2" : "=v"(r) : "v"(lo), "v"(hi)); return r; }
template <class Epi, class Sched, bool ALIGN_EPI = false, bool SP2 = false>
__device__ __forceinline__ void gemm_phase(PG8_LAS unsigned char* lds, const Gemm g, const Sched& S, const Epi& E) {
    const int tid = hw_tid(), wid = __builtin_amdgcn_readfirstlane(tid >> 6), lane = tid & 63, wr = wid >> 2, wc = wid & 3, fr = lane & 15, fq = lane >> 4;
    const int K = g.K, nt = K / BK;
    unsigned voffA[2], voffB[2];
#pragma unroll
    for (int i = 0; i < 2; ++i) { int R, C; stage_rc(tid * 16 + i * 8192, R, C); const int Rb = Epi::PERM ? ((R & ~31) + perm32(R & 31)) : R;
        voffA[i] = (unsigned)(R * K + C) * 2u; voffB[i] = (unsigned)(Rb * K + C) * 2u; }
    const size_t kstep = (size_t)(BK * 2);
    const size_t hstep = (size_t)HALF * K * 2;
    const size_t tstep = 2 * hstep;
    const unsigned ldsw = (unsigned)wid * 1024u;
    const int aoff = lds_byte(wr * 64 + fr, fq * 8), boff = lds_byte(wc * 32 + fr, fq * 8);
#define PG8_SA(b, h) (((b) * 2 + (h)) * HTB)
#define PG8_SB(b, h) ((4 + (b) * 2 + (h)) * HTB)
#define PG8_STAGE(bufoff, gbase, voff) do { _Pragma("unroll") for (int _i = 0; _i < 2; ++_i) \
        __builtin_amdgcn_global_load_lds((const unsigned*)((const char*)(gbase) + (voff)[_i]), (PG8_LAS unsigned*)(lds + (bufoff) + ldsw + _i * 8192), 16, 0, 0); } while (0)
#define PG8_LDA(dst, b, h) do { _Pragma("unroll") for (int m = 0; m < 4; ++m) _Pragma("unroll") for (int k = 0; k < 2; ++k) dst[m][k] = *(const PG8_LAS bf16x8*)(lds + PG8_SA(b, h) + aoff + m * 2048 + k * 1024); } while (0)
#define PG8_LDB(dst, b, h) do { _Pragma("unroll") for (int n = 0; n < 2; ++n) _Pragma("unroll") for (int k = 0; k < 2; ++k) dst[n][k] = *(const PG8_LAS bf16x8*)(lds + PG8_SB(b, h) + boff + n * 2048 + k * 1024); } while (0)
#define PG8_MMA(ai, bj, At, Bt) do { __builtin_amdgcn_s_setprio(1); _Pragma("unroll") for (int m = 0; m < 4; ++m) _Pragma("unroll") for (int n = 0; n < 2; ++n) _Pragma("unroll") for (int k = 0; k < 2; ++k) \
        acc[ai][bj][m][n] = __builtin_amdgcn_mfma_f32_16x16x32_bf16(Bt[n][k], At[m][k], acc[ai][bj][m][n], 0, 0, 0); __builtin_amdgcn_s_setprio(0); } while (0)
#define PG8_WAIT_V(n) asm volatile("s_waitcnt vmcnt(" #n ")" ::: "memory")
#define PG8_WAIT_L(n) asm volatile("s_waitcnt lgkmcnt(" #n ")" ::: "memory")
#define PG8_BAR __builtin_amdgcn_s_barrier()
#define PG8_SCHED __builtin_amdgcn_sched_barrier(0)
    Unit cur, nxt; int ui = 0;
    if (!S.next(0, cur)) return;
    f32x4 acc[2][2][4][2];
#pragma unroll
    for (int a = 0; a < 2; ++a)
#pragma unroll
        for (int b = 0; b < 2; ++b)
#pragma unroll
            for (int m = 0; m < 4; ++m)
#pragma unroll
                for (int n = 0; n < 2; ++n) acc[a][b][m][n] = (f32x4){0.f, 0.f, 0.f, 0.f};
    bf16x8 At[4][2], B0[2][2], B1[2][2];
    const char* cA = (const char*)g.A + (size_t)cur.pm * tstep; const char* cB = (const char*)g.Bt + (size_t)cur.pnb * tstep;
    S.a_ready(cur);
    if constexpr (SP2) {
        PG8_STAGE(PG8_SB(0, 0), cB, voffB); PG8_STAGE(PG8_SB(0, 1), cB + hstep, voffB); PG8_STAGE(PG8_SA(0, 0), cA, voffA); PG8_STAGE(PG8_SA(0, 1), cA + hstep, voffA);
        if (wr == 1) PG8_BAR;
        PG8_WAIT_V(2); PG8_BAR;
        PG8_STAGE(PG8_SB(1, 0), cB + kstep, voffB); PG8_STAGE(PG8_SA(1, 0), cA + kstep, voffA); PG8_STAGE(PG8_SB(1, 1), cB + hstep + kstep, voffB);
        PG8_WAIT_V(6); PG8_BAR;
    } else {
        PG8_STAGE(PG8_SB(0, 0), cB, voffB); PG8_STAGE(PG8_SA(0, 0), cA, voffA); PG8_STAGE(PG8_SB(0, 1), cB + hstep, voffB); PG8_STAGE(PG8_SA(0, 1), cA + hstep, voffA);
        if (wr == 1) PG8_BAR;
        PG8_WAIT_V(4); PG8_BAR;
        PG8_STAGE(PG8_SB(1, 0), cB + kstep, voffB); PG8_STAGE(PG8_SA(1, 0), cA + kstep, voffA); PG8_STAGE(PG8_SB(1, 1), cB + hstep + kstep, voffB);
        PG8_WAIT_V(6); PG8_BAR;
    }
    for (;;) {
        const bool has_next = S.next(ui + 1, nxt);
        const char* nA = has_next ? (const char*)g.A + (size_t)nxt.pm * tstep : cA; const char* nB = has_next ? (const char*)g.Bt + (size_t)nxt.pnb * tstep : cB;
        for (int t = 0; t < nt; t += 2) {
            const bool last = (t == nt - 2);
            const char* a1 = cA + (size_t)(t + 1) * kstep;
            const char* a2 = last ? nA : cA + (size_t)(t + 2) * kstep; const char* b2 = last ? nB : cB + (size_t)(t + 2) * kstep;
            const char* a3 = a2 + kstep; const char* b3 = b2 + kstep;
            if (last && has_next) S.a_ready(nxt);
            if constexpr (SP2) {
            PG8_LDB(B0, 0, 0); PG8_LDB(B1, 0, 1); PG8_SCHED; PG8_LDA(At, 0, 0); PG8_STAGE(PG8_SA(1, 1), a1 + hstep, voffA);
            PG8_WAIT_V(8); PG8_WAIT_L(0); PG8_BAR; PG8_MMA(0, 0, At, B0); PG8_MMA(0, 1, At, B1); PG8_BAR; PG8_SCHED;
            PG8_LDA(At, 0, 1); PG8_STAGE(PG8_SB(0, 0), b2, voffB); PG8_STAGE(PG8_SB(0, 1), b2 + hstep, voffB); PG8_STAGE(PG8_SA(0, 0), a2, voffA);
            PG8_WAIT_V(8); PG8_WAIT_L(0); PG8_BAR; PG8_MMA(1, 0, At, B0); PG8_MMA(1, 1, At, B1); PG8_BAR; PG8_SCHED;
            PG8_LDB(B0, 1, 0); PG8_LDB(B1, 1, 1); PG8_SCHED; PG8_LDA(At, 1, 0); PG8_STAGE(PG8_SA(0, 1), a2 + hstep, voffA);
            PG8_WAIT_V(8); PG8_WAIT_L(0); PG8_BAR; PG8_MMA(0, 0, At, B0); PG8_MMA(0, 1, At, B1); PG8_BAR; PG8_SCHED;
            PG8_LDA(At, 1, 1); PG8_STAGE(PG8_SB(1, 0), b3, voffB); PG8_STAGE(PG8_SB(1, 1), b3 + hstep, voffB); PG8_STAGE(PG8_SA(1, 0), a3, voffA);
            PG8_WAIT_V(8); PG8_WAIT_L(0); PG8_BAR; PG8_MMA(1, 0, At, B0); PG8_MMA(1, 1, At, B1); PG8_BAR; PG8_SCHED;
            } else {
            PG8_LDB(B0, 0, 0); PG8_SCHED; PG8_LDA(At, 0, 0); PG8_STAGE(PG8_SA(1, 1), a1 + hstep, voffA);
            PG8_WAIT_L(8); PG8_BAR; PG8_WAIT_L(0); PG8_MMA(0, 0, At, B0); PG8_BAR; PG8_SCHED;
            PG8_LDB(B1, 0, 1); PG8_STAGE(PG8_SB(0, 0), b2, voffB);
            PG8_BAR; PG8_WAIT_L(0); PG8_MMA(0, 1, At, B1); PG8_BAR;
            PG8_LDA(At, 0, 1); PG8_STAGE(PG8_SA(0, 0), a2, voffA);
            PG8_BAR; PG8_WAIT_L(0); PG8_MMA(1, 0, At, B0); PG8_BAR; PG8_SCHED;
            PG8_STAGE(PG8_SB(0, 1), b2 + hstep, voffB);
            PG8_WAIT_V(6); PG8_BAR; PG8_MMA(1, 1, At, B1); PG8_BAR;
            PG8_LDB(B0, 1, 0); PG8_SCHED; PG8_LDA(At, 1, 0); PG8_STAGE(PG8_SA(0, 1), a2 + hstep, voffA);
            PG8_WAIT_L(8); PG8_BAR; PG8_WAIT_L(0); PG8_MMA(0, 0, At, B0); PG8_BAR; PG8_SCHED;
            PG8_LDB(B1, 1, 1); PG8_STAGE(PG8_SB(1, 0), b3, voffB);
            PG8_BAR; PG8_WAIT_L(0); PG8_MMA(0, 1, At, B1); PG8_BAR;
            PG8_LDA(At, 1, 1); PG8_STAGE(PG8_SA(1, 0), a3, voffA);
            PG8_BAR; PG8_WAIT_L(0); PG8_MMA(1, 0, At, B0); PG8_BAR; PG8_SCHED;
            PG8_STAGE(PG8_SB(1, 1), b3 + hstep, voffB);
            PG8_WAIT_V(6); PG8_BAR; PG8_MMA(1, 1, At, B1); PG8_BAR;
            }
        }
        if constexpr (ALIGN_EPI) { if (wr == 0) PG8_BAR; }
        if constexpr (!Epi::AFTER_DRAIN) { E(acc, cur, wr, wc, fr, fq); S.done(cur); }
        if (!has_next) break;
#pragma unroll
        for (int a = 0; a < 2; ++a)
#pragma unroll
            for (int b = 0; b < 2; ++b)
#pragma unroll
                for (int m = 0; m < 4; ++m)
#pragma unroll
                    for (int n = 0; n < 2; ++n) acc[a][b][m][n] = (f32x4){0.f, 0.f, 0.f, 0.f};
        cur = nxt; cA = nA; cB = nB; ++ui;
        if constexpr (ALIGN_EPI) { if (wr == 1) PG8_BAR; }
    }
    PG8_WAIT_V(0);
    if constexpr (!ALIGN_EPI) { if (wr == 0) PG8_BAR; }
    PG8_BAR;
    if constexpr (Epi::AFTER_DRAIN) { E.fused(acc, cur, wr, wc, fr, fq, lds, wid, lane); S.done(cur); }
#undef PG8_SA
#undef PG8_SB
#undef PG8_STAGE
#undef PG8_LDA
#undef PG8_LDB
#undef PG8_MMA
#undef PG8_WAIT_V
#undef PG8_WAIT_L
#undef PG8_BAR
#undef PG8_SCHED
}
}
namespace pg8 {
struct EpiBf16 {
    static constexpr bool PERM = true, AFTER_DRAIN = false;
    bf16_t* O; int ldc;
    __device__ __forceinline__ void operator()(const f32x4 (&acc)[2][2][4][2], const Unit& u, int wr, int wc, int fr, int fq) const {
        const int row0 = u.pm * BM + wr * 64 + fr; const int col0 = u.pn * BM + wc * 32 + 8 * fq;
#pragma unroll
        for (int ai = 0; ai < 2; ++ai)
#pragma unroll
            for (int m = 0; m < 4; ++m) { bf16_t* rowp = O + (size_t)(row0 + ai * HALF + m * 16) * ldc + col0;
#pragma unroll
                for (int bj = 0; bj < 2; ++bj) { const f32x4 v0 = acc[ai][bj][m][0], v1 = acc[ai][bj][m][1];
                    u32x4 w; w.x = cvt_pk_bf16(v0[0], v0[1]); w.y = cvt_pk_bf16(v0[2], v0[3]); w.z = cvt_pk_bf16(v1[0], v1[1]); w.w = cvt_pk_bf16(v1[2], v1[3]);
                    *(u32x4*)(rowp + bj * HALF) = w; } }
    }
};
struct EpiSwiGLU {
    static constexpr bool PERM = true, AFTER_DRAIN = false;
    bf16_t* O; int ldc;
    __device__ __forceinline__ void operator()(const f32x4 (&acc)[2][2][4][2], const Unit& u, int wr, int wc, int fr, int fq) const {
        const int row0 = u.pm * BM + wr * 64 + fr; const int col0 = u.pn * HALF + wc * 32 + 8 * fq;
#pragma unroll
        for (int ai = 0; ai < 2; ++ai)
#pragma unroll
            for (int m = 0; m < 4; ++m) { bf16_t* rowp = O + (size_t)(row0 + ai * HALF + m * 16) * ldc + col0;
                float r[8];
#pragma unroll
                for (int n = 0; n < 2; ++n)
#pragma unroll
                    for (int j = 0; j < 4; ++j) { const float a = acc[ai][0][m][n][j], b = acc[ai][1][m][n][j]; r[n * 4 + j] = a * b * __builtin_amdgcn_rcpf(1.0f + __expf(-a)); }
                u32x4 w; w.x = cvt_pk_bf16(r[0], r[1]); w.y = cvt_pk_bf16(r[2], r[3]); w.z = cvt_pk_bf16(r[4], r[5]); w.w = cvt_pk_bf16(r[6], r[7]);
                *(u32x4*)rowp = w; }
    }
};
struct MoeOrder {
    const PG8_LAS int* pref; int nN, G, c, total;
    __device__ __forceinline__ void init(const PG8_LAS int* pref_, int nN_, int G_, int c_) { pref = pref_; nN = nN_; G = G_; c = c_; total = pref_[32] * nN_; }
    __device__ __forceinline__ bool next(int i, Unit& u) const {
        const int L = i * G + c; if (L >= total) return false;
        const int rt = L / nN, pn = L - rt * nN; int e = 0;
#pragma unroll 1
        for (int k = 1; k < 32; ++k) e += (pref[k] <= rt) ? 1 : 0;
        u.pm = rt; u.pn = pn; u.pnb = e * nN + pn; return true;
    }
    __device__ __forceinline__ void a_ready(const Unit&) const {}
    __device__ __forceinline__ void done(const Unit&) const {}
};
}
#define XB_TMO      128
#define XB_XCNT(j)  (256  + 64 * (j))
#define XB_XSUB(j)  (1280 + 64 * (j))
#define XB_XGEN(j)  (2304 + 64 * (j))
#define XB_TOP      3328
#define XB_TOPGEN   3392
#define XCD_BAR_WORDS 3456
#define XB_SPIN_CAP (1u << 22)

__device__ __forceinline__ unsigned xb_ld(unsigned* p)              { return __hip_atomic_load(p, __ATOMIC_RELAXED, __HIP_MEMORY_SCOPE_AGENT); }
__device__ __forceinline__ unsigned xb_add(unsigned* p, unsigned v) { return __hip_atomic_fetch_add(p, v, __ATOMIC_RELAXED, __HIP_MEMORY_SCOPE_AGENT); }
__device__ __forceinline__ unsigned xb_xcc_id() { return (unsigned)__builtin_amdgcn_s_getreg((3 << 11) | 20) & 0xFu; }
#define XB_SPIN(cond, bar) do { unsigned _sp = 0; while (cond) { __builtin_amdgcn_s_sleep(1); \
    if ((++_sp & 255u) == 0u) { if (xb_ld(&(bar)[XB_TMO])) break; if (_sp > XB_SPIN_CAP) { atomicAdd(&(bar)[XB_TMO], 1u); break; } } } } while (0)

struct XcdBarrier {
    unsigned* bar; unsigned x;
    volatile LAS unsigned* st;
};

__device__ __forceinline__ XcdBarrier xcd_barrier_post(unsigned* bar, volatile LAS unsigned* st) {
    XcdBarrier b; b.bar = bar; b.x = xb_xcc_id(); b.st = st;
    if (hw_tid() == 0) (void)xb_add(&bar[XB_XCNT(b.x)], 1u);
    return b;
}
__device__ __forceinline__ void xcd_barrier_complete(unsigned* bar, unsigned x, unsigned& nloc, unsigned& nx) {
    const unsigned G = gridDim.x * gridDim.y * gridDim.z;
    unsigned sum, cnt, mine, sp = 0u;
    for (;;) {
        sum = 0u; cnt = 0u; mine = 0u;
#pragma unroll
        for (unsigned j = 0; j < 16; ++j) { const unsigned c = xb_ld(&bar[XB_XCNT(j)]); sum += c; cnt += (c > 0u) ? 1u : 0u; mine = (j == x) ? c : mine; }
        if (sum == G) break;
        __builtin_amdgcn_s_sleep(1);
        if ((++sp & 255u) == 0u) { if (xb_ld(&bar[XB_TMO])) break; if (sp > XB_SPIN_CAP) { atomicAdd(&bar[XB_TMO], 1u); break; } }
    }
    nloc = mine > 0u ? mine : 1u; nx = cnt > 0u ? cnt : 1u;
}

__device__ __forceinline__ void xcd_barrier(const XcdBarrier& b) {
    asm volatile("s_waitcnt vmcnt(0)" ::: "memory");
    __syncthreads();
    if (hw_tid() == 0) {
        unsigned* bar = b.bar;
        __builtin_amdgcn_s_waitcnt(0);
        unsigned nloc = b.st[0], nx = b.st[1];
        if (nloc == 0u) { xcd_barrier_complete(bar, b.x, nloc, nx); b.st[0] = nloc; b.st[1] = nx; }
        const unsigned old = xb_add(&bar[XB_XSUB(b.x)], 1u);
        const unsigned gen = old / nloc;
        if (old + 1u == (gen + 1u) * nloc) {
            __builtin_amdgcn_fence(__ATOMIC_RELEASE, "agent");
            asm volatile("s_waitcnt vmcnt(0)" ::: "memory");
            const unsigned og = xb_add(&bar[XB_TOP], 1u);
            const unsigned tg = og / nx;
            if (og + 1u == (tg + 1u) * nx) xb_add(&bar[XB_TOPGEN], 1u);
            else XB_SPIN(xb_ld(&bar[XB_TOPGEN]) == tg, bar);
            __builtin_amdgcn_fence(__ATOMIC_ACQUIRE, "agent");
            xb_add(&bar[XB_XGEN(b.x)], 1u);
            asm volatile("s_waitcnt vmcnt(0)" ::: "memory");
        } else {
            XB_SPIN(xb_ld(&bar[XB_XGEN(b.x)]) == gen, bar);
            __builtin_amdgcn_fence(__ATOMIC_ACQUIRE, "agent");
            asm volatile("s_waitcnt vmcnt(0)" ::: "memory");
        }
    }
    __syncthreads();
}
struct Args { const float* in[30]; float* out; unsigned char* ws; int ph_lo, ph_hi; };
#define CAS __attribute__((address_space(4)))
struct KA { const CAS unsigned char* kp;
    __device__ __forceinline__ const float* in(int i) const { return *(const float* const CAS*)(kp + 8 * i); }
    __device__ __forceinline__ float* out() const { return *(float* const CAS*)(kp + 240); }
    __device__ __forceinline__ unsigned char* ws() const { return *(unsigned char* const CAS*)(kp + 248); } };
__device__ __forceinline__ KA ka_get() { const CAS unsigned char* kp = (const CAS unsigned char*)__builtin_amdgcn_kernarg_segment_ptr(); asm volatile("" : "+s"(kp)); return KA{kp}; }
__device__ __forceinline__ int opaque_tid() { return hw_tid(); }
static_assert(sizeof(Args) == 264, "kernarg layout");
enum { I_X = 0, I_C, I_CTX, I_CCTX, I_ADAW, I_ADAB, I_WIN, I_RPB, I_MUP, I_MUN, I_W0, I_W2, I_A0, I_A2, I_G2, I_KK, I_KA, I_RK, I_GNG, I_GNB, I_WOUT, I_LN1G, I_LN1B, I_LN2G, I_LN2B, I_RW, I_RB, I_EW1, I_EW3, I_EW2 };

__device__ __forceinline__ void transpose_item(const float* W, int N, int k0, int n0, bf16* WT, int ldk, int drow0, LAS float* scr, int lane) {
#pragma unroll 8
    for (int i = 0; i < 32; ++i) { const int kk = 2 * i + (lane >> 5); scr[kk * 33 + (lane & 31)] = W[(size_t)(k0 + kk) * N + n0 + (lane & 31)]; }
    LDS_WAIT(); asm volatile("" ::: "memory");
    const int c = lane & 7;
#pragma unroll
    for (int j = 0; j < 4; ++j) { const int n = (lane >> 3) + 8 * j; const LAS float* s = scr + (8 * c) * 33 + n;
        v4u o; o.x = pk2(s[0 * 33], s[1 * 33]); o.y = pk2(s[2 * 33], s[3 * 33]); o.z = pk2(s[4 * 33], s[5 * 33]); o.w = pk2(s[6 * 33], s[7 * 33]);
        *(GAS v4u*)(WT + (size_t)(drow0 + n) * ldk + k0 + 8 * c) = o; }
    LDS_WAIT(); asm volatile("" ::: "memory");
}

__device__ __forceinline__ void phase_prologue(LAS unsigned char* lds) {
    const KA a = ka_get();
    const int tid = opaque_tid(), lane = tid & 63, wave = __builtin_amdgcn_readfirstlane(tid >> 6), G = gridDim.x, bid = blockIdx.x;
    const int gw = bid * 8 + wave, NGW = G * 8;
    bf16* WINT = (bf16*)(a.ws() + WS_WINT); bf16* WOT = (bf16*)(a.ws() + WS_WOT);
    LAS float* scr = (LAS float*)(lds + wave * 16384);
    constexpr int I_IN = 16 * 103, I_OUT = 16 * 32, I_L = I_IN + I_OUT;
    for (int it = gw; it < 2 * I_L; it += NGW) {
        const int l = it / I_L; int r = it - l * I_L;
        if (r < I_IN) { const int kb = r / 103, nb = r - kb * 103; transpose_item(a.in(I_WIN) + (size_t)l * DM * DIN, DIN, 64 * kb, 32 * nb, WINT + (size_t)l * DINP * DM, DM, 32 * nb, scr, lane); }
        else { r -= I_IN; const int kb = r >> 5, nb = r & 31; transpose_item(a.in(I_WOUT) + (size_t)l * DM * DM, DM, 64 * kb, 32 * nb, WOT + (size_t)l * DM * DM, DM, 32 * nb, scr, lane); }
    }
    for (int i = bid * 512 + tid; i < 8192; i += G * 512) { const int l = i >> 12, r = i & 4095; *(GAS v4u*)(WINT + (size_t)l * DINP * DM + (size_t)DIN * DM + (size_t)r * 8) = (v4u){0u, 0u, 0u, 0u}; }
    { float* rp = (float*)(a.ws() + WS_ROPE); const int i = bid * 512 + tid;
      if (i < 1536) { const int idx = i < 512 ? i : i - 512; const int p = idx >> 4, f = idx & 15; const double inv = exp(-(double)f * (9.210340371976184 / 16.0)); const double ang = (double)p * inv;
          const float cs = (float)cos(ang), sn = (float)sin(ang); if (i < 512) { rp[idx] = cs; rp[512 + idx] = sn; } else { rp[1024 + idx] = cs; rp[2048 + idx] = sn; } } }
    __syncthreads();
    LAS float* sl = (LAS float*)lds; LAS float* red = (LAS float*)(lds + 69632);
    for (int i = tid; i < 17 * 1024; i += 512) { const int r = i >> 10, k = i & 1023; const float v = r < 16 ? a.in(I_C)[r * 1024 + k] : a.in(I_CCTX)[k]; sl[i] = v / (1.0f + expf(-v)); }
    __syncthreads();
    float* mods = (float*)(a.ws() + WS_MODS);
    for (int it = bid; it < 192; it += G) {
        const int l = it / 96, ch = it - l * 96; const int kq = tid >> 6, cl = tid & 63, col = ch * 64 + cl;
        const float* W = a.in(I_ADAW) + (size_t)l * DM * 6144 + col;
        float acc[17];
#pragma unroll
        for (int r = 0; r < 17; ++r) acc[r] = 0.f;
        for (int k0 = kq * 128; k0 < kq * 128 + 128; k0 += 8) { float w8[8];
#pragma unroll
            for (int q = 0; q < 8; ++q) w8[q] = W[(size_t)(k0 + q) * 6144];
#pragma unroll
            for (int r = 0; r < 17; ++r) { const f32x4 s0 = *(const LAS f32x4*)(sl + r * 1024 + k0), s1 = *(const LAS f32x4*)(sl + r * 1024 + k0 + 4);
                acc[r] += s0.x * w8[0] + s0.y * w8[1] + s0.z * w8[2] + s0.w * w8[3] + s1.x * w8[4] + s1.y * w8[5] + s1.z * w8[6] + s1.w * w8[7]; } }
#pragma unroll
        for (int r = 0; r < 17; ++r) red[(kq * 17 + r) * 64 + cl] = acc[r];
        __syncthreads();
        for (int i = tid; i < 17 * 64; i += 512) { const int r = i >> 6, c2 = i & 63; float s = 0.f;
#pragma unroll
            for (int q = 0; q < 8; ++q) s += red[(q * 17 + r) * 64 + c2];
            mods[((size_t)l * 17 + r) * 6144 + ch * 64 + c2] = s + a.in(I_ADAB)[l * 6144 + ch * 64 + c2]; }
        __syncthreads();
    }
}

__device__ __forceinline__ void phase_modconv(LAS unsigned char* lds, int l) {
    const KA a = ka_get();
    const int tid = opaque_tid(), lane = tid & 63, wave = __builtin_amdgcn_readfirstlane(tid >> 6), G = gridDim.x, bid = blockIdx.x;
    const int gw = bid * 8 + wave, NGW = G * 8;
    const float* mods = (const float*)(a.ws() + WS_MODS) + (size_t)l * 17 * 6144;
    bf16* XM = (bf16*)(a.ws() + WS_X1);
    const float* xs = a.in(I_X); const float* cs = a.in(I_CTX);
    for (int m = gw; m < NTOK; m += NGW) {
        const float* src; int mr;
        if (m < NTX) { src = xs + (size_t)m * DM; mr = m / SEQ; } else { src = cs + (size_t)(m - NTX) * DM; mr = 16; }
        const GAS f32x4* xr = (const GAS f32x4*)src + lane; const GAS f32x4* sh = (const GAS f32x4*)(mods + (size_t)mr * 6144) + lane; const GAS f32x4* sc = sh + 256;
        GAS v2u* o8 = (GAS v2u*)(XM + (size_t)m * DM) + lane;
#pragma unroll
        for (int j = 0; j < 4; ++j) { const f32x4 v = xr[64 * j], s = sh[64 * j], c = sc[64 * j]; const f32x4 r = v * (c + 1.0f) + s; v2u w; w.x = pk2(r.x, r.y); w.y = pk2(r.z, r.w); o8[64 * j] = w; }
    }
}

__device__ __forceinline__ void phase_scan_direct(LAS unsigned char* lds, int l) {
    const KA a = ka_get();
    constexpr int TB = 32;
    const int tid = opaque_tid(), lane = tid & 63, wv = __builtin_amdgcn_readfirstlane(tid >> 6);
    LAS float* ops = (LAS float*)lds;
    LAS float* scal = (LAS float*)(lds + 49152);
    LAS float* zl = (LAS float*)(lds + 49664);
    LAS float* rkraw = (LAS float*)(lds + 57856);
    LAS float* ybuf = (LAS float*)(lds + 74240);
    const bf16* PX = (const bf16*)(a.ws() + WS_X2); float* YD = (float*)(a.ws() + WS_X3); float* BON = (float*)(a.ws() + WS_BONUS); const float* rope = (const float*)(a.ws() + WS_ROPE);
    const float* mup = a.in(I_MUP) + l * 1760; const float* mun = a.in(I_MUN) + l * 1760;
    for (int chain = blockIdx.x; chain < 256; chain += gridDim.x) {
        const int b = chain >> 4, h = (chain >> 1) & 7, d = chain & 1, c = lane;
        float w2c[32], a2c[32];
#pragma unroll
        for (int j = 0; j < 32; ++j) { w2c[j] = a.in(I_W2)[((size_t)(l * 2 + d) * 32 + j) * 512 + h * 64 + c]; a2c[j] = a.in(I_A2)[((size_t)(l * 2 + d) * 32 + j) * 512 + h * 64 + c]; }
        const float w0c = a.in(I_W0)[(l * 2 + d) * 512 + h * 64 + c], a0c = a.in(I_A0)[(l * 2 + d) * 512 + h * 64 + c];
        const float kkc = a.in(I_KK)[l * 512 + h * 64 + c], kac = a.in(I_KA)[l * 512 + h * 64 + c], rkc = a.in(I_RK)[l * 512 + h * 64 + c];
        const int colr = h * 64 + c, colk = 512 + colr, colv = 1024 + colr, coll = (c < 32) ? (1536 + d * 32 + c) : (1600 + d * 32 + (c - 32));
        const float mpr = mup[colr], mnr = mun[colr], mpk = mup[colk], mnk = mun[colk], mpv = mup[colv], mnv = mun[colv], mpl = mup[coll], mnl = mun[coll];
        float S[8];
#pragma unroll
        for (int j = 0; j < 8; ++j) S[j] = 0.f;
        const int vl = lane >> 3, kq = lane & 7, vrow = 8 * wv + vl;
        for (int seq = 0; seq < 2; ++seq) {
            const int T = seq ? SEQ : CTXL, rowbase = seq ? b * SEQ : NTX + b * CTXL, nblk = T / TB;
            for (int bi = 0; bi < nblk; ++bi) {
                const int tb = d ? (nblk - 1 - bi) : bi, t0 = tb * TB;
                float zv[4];
#pragma unroll
                for (int i = 0; i < 4; ++i) {
                    const int tl = wv + 8 * i, t = t0 + tl; const bf16* p = PX + (size_t)(rowbase + t) * DINP + RWOFF;
                    const bool hp = t > 0, hn = t + 1 < T;
                    const float cr = bf2f(p[colr]), ck = bf2f(p[colk]), cv = bf2f(p[colv]), cl_ = bf2f(p[coll]);
                    const float pr = hp ? bf2f(p[colr - DINP]) : 0.f, pk = hp ? bf2f(p[colk - DINP]) : 0.f, pv = hp ? bf2f(p[colv - DINP]) : 0.f, pl = hp ? bf2f(p[coll - DINP]) : 0.f;
                    const float nr = hn ? bf2f(p[colr + DINP]) : 0.f, nk = hn ? bf2f(p[colk + DINP]) : 0.f, nv = hn ? bf2f(p[colv + DINP]) : 0.f, nl = hn ? bf2f(p[coll + DINP]) : 0.f;
                    const float zr = cr + mpr * (pr - cr) + mnr * (nr - cr), zk = ck + mpk * (pk - ck) + mnk * (nk - ck);
                    zv[i] = cv + mpv * (pv - cv) + mnv * (nv - cv);
                    const float zz = cl_ + mpl * (pl - cl_) + mnl * (nl - cl_);
                    rkraw[tl * 128 + c] = zr; rkraw[tl * 128 + 64 + c] = zk; zl[tl * 64 + c] = (c < 32) ? tanhf(zz) : zz;
                }
                __syncthreads();
#pragma unroll
                for (int i = 0; i < 4; ++i) {
                    const int tl = wv + 8 * i, t = t0 + tl;
                    float r = rkraw[tl * 128 + c], k = rkraw[tl * 128 + 64 + c];
                    if (seq) { const float rp = rkraw[tl * 128 + (c ^ 16)], kp = rkraw[tl * 128 + 64 + (c ^ 16)]; const int qd = c >> 4, f = c & 15;
                        const int ti = (qd < 2) ? ((t >> 6) * 16 + f) : (1024 + (t & 63) * 16 + f); const float cs = rope[ti], sn = rope[ti + ((qd < 2) ? 512 : 1024)];
                        const float sg = (qd & 1) ? sn : -sn; r = r * cs + rp * sg; k = k * cs + kp * sg; }
                    const float kkr = k * kkc; const float ss = wave_sum(kkr * kkr); const float kk = kkr / fmaxf(sqrtf(ss), 1e-12f);
                    float u = w0c, av = a0c;
#pragma unroll
                    for (int j = 0; j < 32; j += 4) { const f32x4 z1 = *(const LAS f32x4*)(zl + tl * 64 + j), z2 = *(const LAS f32x4*)(zl + tl * 64 + 32 + j);
                        u += z1.x * w2c[j] + z1.y * w2c[j + 1] + z1.z * w2c[j + 2] + z1.w * w2c[j + 3]; av += z2.x * a2c[j] + z2.y * a2c[j + 1] + z2.z * a2c[j + 2] + z2.w * a2c[j + 3]; }
                    const float w = expf(-0.6065306597126334f * sigmoidf_(u)), aa = sigmoidf_(av);
                    const float kd = k * (1.0f + (aa - 1.0f) * kac), nb = -kk * aa;
                    const float c1 = wave_sum(nb * r), c2 = wave_sum(kd * r), bon = wave_sum(r * kd * rkc);
                    LAS float* o = ops + tl * 384 + c; o[0] = kk; o[64] = w * r; o[128] = w; o[192] = nb; o[256] = kd; o[320] = zv[i];
                    if (lane == 0) { scal[tl * 4] = c1; scal[tl * 4 + 1] = c2; BON[((size_t)d * NTOK + rowbase + t) * 8 + h] = bon; }
                }
                __syncthreads();
#pragma unroll 2
                for (int s = 0; s < TB; ++s) {
                    const int tl = d ? (TB - 1 - s) : s; const LAS float* o = ops + tl * 384 + kq * 8;
                    const f32x4 ka = *(const LAS f32x4*)(o), kb = *(const LAS f32x4*)(o + 4), ra = *(const LAS f32x4*)(o + 64), rb = *(const LAS f32x4*)(o + 68);
                    const f32x4 wa = *(const LAS f32x4*)(o + 128), wb = *(const LAS f32x4*)(o + 132), na = *(const LAS f32x4*)(o + 192), nb_ = *(const LAS f32x4*)(o + 196);
                    const f32x4 da = *(const LAS f32x4*)(o + 256), db = *(const LAS f32x4*)(o + 260);
                    const float vv = ops[tl * 384 + 320 + vrow], c1 = scal[tl * 4], c2 = scal[tl * 4 + 1];
                    float sk = S[0] * ka.x + S[1] * ka.y + S[2] * ka.z + S[3] * ka.w + S[4] * kb.x + S[5] * kb.y + S[6] * kb.z + S[7] * kb.w;
                    float yy = S[0] * ra.x + S[1] * ra.y + S[2] * ra.z + S[3] * ra.w + S[4] * rb.x + S[5] * rb.y + S[6] * rb.z + S[7] * rb.w;
                    sk = red8(sk); yy = red8(yy);
                    const float y = yy + sk * c1 + vv * c2;
                    S[0] = S[0] * wa.x + sk * na.x + vv * da.x; S[1] = S[1] * wa.y + sk * na.y + vv * da.y; S[2] = S[2] * wa.z + sk * na.z + vv * da.z; S[3] = S[3] * wa.w + sk * na.w + vv * da.w;
                    S[4] = S[4] * wb.x + sk * nb_.x + vv * db.x; S[5] = S[5] * wb.y + sk * nb_.y + vv * db.y; S[6] = S[6] * wb.z + sk * nb_.z + vv * db.z; S[7] = S[7] * wb.w + sk * nb_.w + vv * db.w;
                    if (kq == 0) ybuf[tl * 64 + vrow] = y;
                }
                __syncthreads();
#pragma unroll
                for (int i = 0; i < 4; ++i) { const int tl = wv + 8 * i; YD[((size_t)d * NTOK + rowbase + t0 + tl) * 512 + h * 64 + c] = ybuf[tl * 64 + c]; }
            }
        }
        __syncthreads();
    }
}

typedef short v4i16_t __attribute__((ext_vector_type(4)));
__device__ __forceinline__ int swz_off(int row, int chunk) { return row * 128 + ((chunk ^ (row & 7)) << 4); }
__device__ __forceinline__ void stage_rows(LAS unsigned char* dst, const bf16* src, int nrows, int tid) {
    for (int idx = tid; idx < nrows * 8; idx += 512) { const int r = idx >> 3, ch = idx & 7; const v4u v = *(const GAS v4u*)(src + (size_t)r * DINP + ch * 8); *(LAS v4u*)(dst + swz_off(r, ch)) = v; }
}
__device__ __forceinline__ bf16x8 q_scale8(bf16x8 q) { const v4u w = __builtin_bit_cast(v4u, q); v4u r;
    r.x = pk2(bflo(w.x) * 0.125f, bfhi(w.x) * 0.125f); r.y = pk2(bflo(w.y) * 0.125f, bfhi(w.y) * 0.125f); r.z = pk2(bflo(w.z) * 0.125f, bfhi(w.z) * 0.125f); r.w = pk2(bflo(w.w) * 0.125f, bfhi(w.w) * 0.125f);
    return __builtin_bit_cast(bf16x8, r); }
struct AttState { float m, l; f32x4 o[4]; };
struct AttOff { int k[2]; int v[4]; int boff; unsigned okm; };
__device__ __forceinline__ AttOff att_offsets(int lane, int wc0, int qc, int cs) { AttOff o; const int kl = lane & 15, g = lane >> 4, q_ = kl >> 2, p_ = kl & 3;
#pragma unroll
    for (int dh = 0; dh < 2; ++dh) o.k[dh] = swz_off(kl, dh * 4 + g);
#pragma unroll
    for (int dt = 0; dt < 4; ++dt) o.v[dt] = swz_off(4 * g + q_, 2 * dt + (p_ >> 1)) + (p_ & 1) * 8;
    o.boff = (wc0 + 4 * g - qc + 15) * 4; o.okm = 0u;
#pragma unroll
    for (int j = 0; j < 8; ++j) { const int kc = wc0 + (j >> 2) * 16 + 4 * g + (j & 3); if ((kc >= cs) && (kc < cs + 16)) o.okm |= 1u << j; }
    return o; }
template <bool LOCAL>
__device__ __forceinline__ void att_kstep(AttState& st, const LAS unsigned char* kb, const LAS unsigned char* vb, int r0, const bf16x8 (&qf)[2], int lane, const AttOff& ao, const LAS float* rpbrow) {
    const LAS unsigned char* kr = kb + r0 * 128; const LAS unsigned char* vr = vb + r0 * 128;
    f32x4 s0 = {0.f, 0.f, 0.f, 0.f}, s1 = {0.f, 0.f, 0.f, 0.f};
#pragma unroll
    for (int dh = 0; dh < 2; ++dh) {
        const bf16x8 k0 = *(const LAS bf16x8*)(kr + ao.k[dh]); const bf16x8 k1 = *(const LAS bf16x8*)(kr + ao.k[dh] + 2048);
        s0 = __builtin_amdgcn_mfma_f32_16x16x32_bf16(k0, qf[dh], s0, 0, 0, 0); s1 = __builtin_amdgcn_mfma_f32_16x16x32_bf16(k1, qf[dh], s1, 0, 0, 0);
    }
    float sc[8];
#pragma unroll
    for (int j = 0; j < 4; ++j) { sc[j] = s0[j]; sc[4 + j] = s1[j]; }
    if (LOCAL) {
        float bv[8]; const unsigned ad = (unsigned)(uintptr_t)rpbrow + (unsigned)ao.boff;
#pragma unroll
        for (int j = 0; j < 8; ++j) asm volatile("ds_read_b32 %0, %1 offset:%2" : "=v"(bv[j]) : "v"(ad), "i"(((j >> 2) * 16 + (j & 3)) * 4));
        asm volatile("s_waitcnt lgkmcnt(0)" : "+v"(bv[0]), "+v"(bv[1]), "+v"(bv[2]), "+v"(bv[3]), "+v"(bv[4]), "+v"(bv[5]), "+v"(bv[6]), "+v"(bv[7]) :: "memory");
#pragma unroll
        for (int j = 0; j < 8; ++j) sc[j] = ((ao.okm >> j) & 1u) ? sc[j] + bv[j] : -INFINITY;
    }
    float mt = fmaxf(fmaxf(fmaxf(sc[0], sc[1]), fmaxf(sc[2], sc[3])), fmaxf(fmaxf(sc[4], sc[5]), fmaxf(sc[6], sc[7])));
    mt = fmaxf(mt, shx(mt, 16, lane)); mt = fmaxf(mt, shx(mt, 32, lane));
    if (__any(mt > st.m)) {
        const float mn = fmaxf(st.m, mt); const float scale = (mn == -INFINITY) ? 1.0f : __expf(st.m - mn); st.l *= scale; st.m = mn;
#pragma unroll
        for (int dt = 0; dt < 4; ++dt) st.o[dt] = st.o[dt] * scale; }
    float p[8], ps = 0.f; const float mref = (st.m == -INFINITY) ? 0.f : st.m;
#pragma unroll
    for (int j = 0; j < 8; ++j) { p[j] = __expf(sc[j] - mref); ps += p[j]; }
    st.l += ps;
    v4u pw; pw.x = pk2(p[0], p[1]); pw.y = pk2(p[2], p[3]); pw.z = pk2(p[4], p[5]); pw.w = pk2(p[6], p[7]);
    const bf16x8 pf = __builtin_bit_cast(bf16x8, pw);
#pragma unroll
    for (int dt = 0; dt < 4; ++dt) {
        const v4i16_t lo = __builtin_amdgcn_ds_read_tr16_b64_v4i16((LAS v4i16_t*)(vr + ao.v[dt]));
        const v4i16_t hi = __builtin_amdgcn_ds_read_tr16_b64_v4i16((LAS v4i16_t*)(vr + ao.v[dt] + 2048));
        const bf16x8 vf = (bf16x8){lo[0], lo[1], lo[2], lo[3], hi[0], hi[1], hi[2], hi[3]};
        st.o[dt] = __builtin_amdgcn_mfma_f32_16x16x32_bf16(vf, pf, st.o[dt], 0, 0, 0);
    }
}
__device__ __forceinline__ void att_merge_store(AttState& st, LAS float* mrg, int qb, int kh, int lane, bf16* orow0  ) {
    LAS float* mine = mrg + qb * (18 * 64) + lane;
    if (kh == 1) { mine[0] = st.m; mine[64] = st.l;
#pragma unroll
        for (int dt = 0; dt < 4; ++dt)
#pragma unroll
            for (int j = 0; j < 4; ++j) mine[(2 + dt * 4 + j) * 64] = st.o[dt][j]; }
    __syncthreads();
    if (kh == 0) {
        const float m1 = mine[0], l1 = mine[64]; const float ms = fmaxf(st.m, m1); const float f0 = __expf(st.m - ms), f1 = __expf(m1 - ms);
        float lc = st.l * f0 + l1 * f1; lc += shx(lc, 16, lane); lc += shx(lc, 32, lane); const float inv = 1.0f / lc;
        const int q = lane & 15, g = lane >> 4;
#pragma unroll
        for (int dt = 0; dt < 4; ++dt) { float r[4];
#pragma unroll
            for (int j = 0; j < 4; ++j) r[j] = (st.o[dt][j] * f0 + mine[(2 + dt * 4 + j) * 64] * f1) * inv;
            v2u w; w.x = pk2(r[0], r[1]); w.y = pk2(r[2], r[3]); *(GAS v2u*)(orow0 + (size_t)q * DM + dt * 16 + 4 * g) = w; }
    }
}
__device__ __forceinline__ void phase_attn(LAS unsigned char* lds, int l) {
    const KA a = ka_get();
    const int tid = opaque_tid(), lane = tid & 63, wv = __builtin_amdgcn_readfirstlane(tid >> 6), qb = wv & 3, kh = wv >> 2;
    LAS unsigned char* KC = lds; LAS unsigned char* VC = lds + 32768; LAS unsigned char* KL = lds + 65536; LAS unsigned char* VL = lds + 98304;
    LAS float* RPB = (LAS float*)(lds + LDSCTL_OFF + 2048); LAS float* mrg = (LAS float*)KL;
    const bf16* PX = (const bf16*)(a.ws() + WS_X2); bf16* CAT = (bf16*)(a.ws() + WS_X1);
    for (int blk = blockIdx.x; blk < 256; blk += gridDim.x) {
        const int bh = blk >> 1, b = bh >> 3, h = bh & 7, half = blk & 1;
        __syncthreads();
        const bf16* ctxrow = PX + (size_t)(NTX + b * CTXL) * DINP + h * 64;
        stage_rows(KC, ctxrow + 512, 256, tid); stage_rows(VC, ctxrow + 1024, 256, tid);
        for (int i = tid; i < 465; i += 512) RPB[i] = a.in(I_RPB)[((size_t)l * 8 + h) * 465 + i];
        __syncthreads();
        const int kl = lane & 15, g = lane >> 4;
        const AttOff ao = att_offsets(lane, min(max(qb * 16 - 8, 0), 32), qb * 16 + kl, min(max(qb * 16 + kl - 8, 0), 48));
        if (l == 0) {
            for (int rr = 0; rr < 2; ++rr) {
                const int q0 = (half * 8 + rr * 4 + qb) * 16; const bf16* qrow = ctxrow + (size_t)(q0 + kl) * DINP;
                bf16x8 qf[2]; qf[0] = q_scale8(*(const GAS bf16x8*)(qrow + 8 * g)); qf[1] = q_scale8(*(const GAS bf16x8*)(qrow + 32 + 8 * g));
                AttState st; st.m = -INFINITY; st.l = 0.f;
#pragma unroll
                for (int dt = 0; dt < 4; ++dt) st.o[dt] = (f32x4){0.f, 0.f, 0.f, 0.f};
                for (int s = 0; s < 4; ++s) att_kstep<false>(st, KC, VC, kh * 128 + s * 32, qf, lane, ao, RPB);
                att_merge_store(st, mrg, qb, kh, lane, CAT + (size_t)(NTX + b * CTXL + q0) * DM + h * 64);
                __syncthreads();
            }
        }
        v4u pfk0[4], pfv0[4], pfk1[4], pfv1[4];
#define ATT_ISSUE(SIDX, pfk, pfv) do { const int i_ = half * 16 + ((SIDX) >> 1); const int rs_ = min(max(i_ - 4, 0), 24); const bf16* lr_ = PX + (size_t)(b * SEQ + (rs_ + 4 * ((SIDX) & 1)) * 64) * DINP + h * 64; \
            _Pragma("unroll") for (int q__ = 0; q__ < 4; ++q__) { const int idx_ = tid + 512 * q__; const bf16* p_ = lr_ + (size_t)(idx_ >> 3) * DINP + (idx_ & 7) * 8; pfk[q__] = *(const GAS v4u*)(p_ + 512); pfv[q__] = *(const GAS v4u*)(p_ + 1024); } } while (0)
        ATT_ISSUE(0, pfk0, pfv0); ATT_ISSUE(1, pfk1, pfv1);
        bf16x8 qn[2]; { const bf16* qrow = PX + (size_t)(b * SEQ + (half * 16) * 64 + qb * 16 + kl) * DINP + h * 64; qn[0] = *(const GAS bf16x8*)(qrow + 8 * g); qn[1] = *(const GAS bf16x8*)(qrow + 32 + 8 * g); }
        for (int ui = 0; ui < 16; ++ui) {
            const int i = half * 16 + ui; const int rs = min(max(i - 4, 0), 24);
            const int qc = qb * 16 + kl, cs = min(max(qc - 8, 0), 48), wc0 = min(max(qb * 16 - 8, 0), 32);
            bf16x8 qf[2]; qf[0] = q_scale8(qn[0]); qf[1] = q_scale8(qn[1]);
            { const int in_ = half * 16 + (ui < 15 ? ui + 1 : ui); const bf16* qrow = PX + (size_t)(b * SEQ + in_ * 64 + qc) * DINP + h * 64; qn[0] = *(const GAS bf16x8*)(qrow + 8 * g); qn[1] = *(const GAS bf16x8*)(qrow + 32 + 8 * g); }
            AttState st; st.m = -INFINITY; st.l = 0.f;
#pragma unroll
            for (int dt = 0; dt < 4; ++dt) st.o[dt] = (f32x4){0.f, 0.f, 0.f, 0.f};
            for (int s = 0; s < 4; ++s) att_kstep<false>(st, KC, VC, kh * 128 + s * 32, qf, lane, ao, RPB);
#define ATT_PASS(pass, pfk, pfv) do { \
                __syncthreads(); \
                _Pragma("unroll") for (int q__ = 0; q__ < 4; ++q__) { const int idx_ = tid + 512 * q__; const int o_ = swz_off(idx_ >> 3, idx_ & 7); *(LAS v4u*)(KL + o_) = pfk[q__]; *(LAS v4u*)(VL + o_) = pfv[q__]; } \
                __syncthreads(); \
                if (ui + 1 < 16) ATT_ISSUE(2 * (ui + 1) + (pass), pfk, pfv); \
                for (int k2 = 0; k2 < 2; ++k2) { const int kr = 2 * kh + k2, arow = rs + 4 * (pass) + kr; \
                    att_kstep<true>(st, KL, VL, kr * 64 + wc0, qf, lane, ao, RPB + (arow - i + 7) * 31); } } while (0)
            ATT_PASS(0, pfk0, pfv0);
            ATT_PASS(1, pfk1, pfv1);
#undef ATT_PASS
            __syncthreads();
            att_merge_store(st, mrg, qb, kh, lane, CAT + (size_t)(b * SEQ + i * 64 + qb * 16) * DM + h * 64);
        }
    }
}

__device__ __forceinline__ void phase_rwpost(LAS unsigned char* lds, int l) {
    const KA a = ka_get();
    const int tid = opaque_tid(), lane = tid & 63, hh = __builtin_amdgcn_readfirstlane(tid >> 6), kl = lane & 15, g = lane >> 4;
    const int er = tid >> 5, cq = tid & 31, c0 = cq * 16, hq = cq >> 2;
    LAS bf16* sig = (LAS bf16*)lds;
    LAS float* Gl = (LAS float*)(lds + 4096);
    const bf16* PX = (const bf16*)(a.ws() + WS_X2); const float* YD = (const float*)(a.ws() + WS_X3); const float* BON = (const float*)(a.ws() + WS_BONUS); bf16* CAT = (bf16*)(a.ws() + WS_X1);
    const float* mup = a.in(I_MUP) + l * 1760; const float* mun = a.in(I_MUN) + l * 1760; const float* g2 = a.in(I_G2) + (size_t)l * 96 * 512;
    const float* gngp = a.in(I_GNG) + l * 512 + c0; const float* gnbp = a.in(I_GNB) + l * 512 + c0;
    bf16x8 gb[3][4];
#pragma unroll
    for (int ks = 0; ks < 3; ++ks)
#pragma unroll
        for (int nt = 0; nt < 4; ++nt) { v4u w; unsigned t[8];
#pragma unroll
            for (int j = 0; j < 8; ++j) t[j] = f2bf(g2[(size_t)(32 * ks + 8 * g + j) * 512 + 64 * hh + 16 * nt + kl]);
            w.x = t[0] | (t[1] << 16); w.y = t[2] | (t[3] << 16); w.z = t[4] | (t[5] << 16); w.w = t[6] | (t[7] << 16); gb[ks][nt] = __builtin_bit_cast(bf16x8, w); }
    const int nch = (l == 0 ? NTOK : NTX) / 16;
    LAS float* Pl = (LAS float*)(lds + 40960);
    Pl[tid] = mup[1024 + tid]; Pl[512 + tid] = mun[1024 + tid]; Pl[1024 + tid] = a.in(I_GNG)[l * 512 + tid]; Pl[1536 + tid] = a.in(I_GNB)[l * 512 + tid];
    int sr[3], sj[3]; float smp[3], smn[3];
#pragma unroll
    for (int k = 0; k < 3; ++k) { const int idx = tid + 512 * k; sr[k] = idx / 96; sj[k] = idx - sr[k] * 96; smp[k] = mup[1664 + sj[k]]; smn[k] = mun[1664 + sj[k]]; }
    unsigned short rawc[3], rawp[3], rawn[3]; v4u vc[2], vp[2], vn[2]; f32x4 y0[4], y1[4]; float bon0, bon1;
#define RWP_TT(ROW, t_, T_) int t_, T_; if ((ROW) < NTX) { t_ = (ROW) & (SEQ - 1); T_ = SEQ; } else { t_ = ((ROW) - NTX) & (CTXL - 1); T_ = CTXL; }
#define RWP_RAW(CH) do { const int ch_ = (CH) < nch ? (CH) : blockIdx.x; _Pragma("unroll") for (int k = 0; k < 3; ++k) { const int row_ = ch_ * 16 + sr[k]; RWP_TT(row_, t_, T_) \
            const bf16* p_ = PX + (size_t)row_ * DINP + RWOFF + 1664 + sj[k]; rawc[k] = p_[0]; rawp[k] = p_[t_ > 0 ? -DINP : 0]; rawn[k] = p_[t_ + 1 < T_ ? DINP : 0]; } } while (0)
#define RWP_Y(CH) do { const int ch_ = (CH) < nch ? (CH) : blockIdx.x; const int row_ = ch_ * 16 + er; \
        _Pragma("unroll") for (int i = 0; i < 4; ++i) { y0[i] = *(const GAS f32x4*)(YD + (size_t)row_ * 512 + c0 + 4 * i); y1[i] = *(const GAS f32x4*)(YD + ((size_t)NTOK + row_) * 512 + c0 + 4 * i); } } while (0)
#define RWP_V(CH) do { const int ch_ = (CH) < nch ? (CH) : blockIdx.x; const int row_ = ch_ * 16 + er; RWP_TT(row_, t_, T_) const bf16* pvp_ = PX + (size_t)row_ * DINP + RWOFF + 1024 + c0; const int op_ = t_ > 0 ? -DINP : 0, on_ = t_ + 1 < T_ ? DINP : 0; \
        _Pragma("unroll") for (int i = 0; i < 2; ++i) { vc[i] = *(const GAS v4u*)(pvp_ + 8 * i); vp[i] = *(const GAS v4u*)(pvp_ + op_ + 8 * i); vn[i] = *(const GAS v4u*)(pvp_ + on_ + 8 * i); } \
        bon0 = BON[(size_t)row_ * 8 + hq]; bon1 = BON[((size_t)NTOK + row_) * 8 + hq]; } while (0)
    RWP_RAW(blockIdx.x); RWP_Y(blockIdx.x); RWP_V(blockIdx.x);
    for (int ch = blockIdx.x; ch < nch; ch += gridDim.x) {
        const int row0 = ch * 16;
        __syncthreads();
#pragma unroll
        for (int k = 0; k < 3; ++k) { const int row_ = row0 + sr[k]; RWP_TT(row_, t, T)
            const float cv = bf2f(rawc[k]), pv = bf2f(rawp[k]) * (t > 0 ? 1.f : 0.f), nv = bf2f(rawn[k]) * (t + 1 < T ? 1.f : 0.f);
            const float z = cv + smp[k] * (pv - cv) + smn[k] * (nv - cv); sig[sr[k] * 96 + sj[k]] = f2bf1(sigmoidf_(z)); }
        RWP_RAW(ch + (int)gridDim.x);
        const int row = row0 + er; RWP_TT(row, t, T) const float fp = t > 0 ? 1.f : 0.f, fn = t + 1 < T ? 1.f : 0.f;
        __syncthreads();
        { f32x4 acc[4];
#pragma unroll
          for (int nt = 0; nt < 4; ++nt) acc[nt] = (f32x4){0.f, 0.f, 0.f, 0.f};
#pragma unroll
          for (int ks = 0; ks < 3; ++ks) { const bf16x8 af = *(const LAS bf16x8*)(sig + kl * 96 + 32 * ks + 8 * g);
#pragma unroll
              for (int nt = 0; nt < 4; ++nt) acc[nt] = __builtin_amdgcn_mfma_f32_16x16x32_bf16(af, gb[ks][nt], acc[nt], 0, 0, 0); }
#pragma unroll
          for (int nt = 0; nt < 4; ++nt)
#pragma unroll
              for (int j = 0; j < 4; ++j) Gl[(4 * g + j) * 512 + 64 * hh + 16 * nt + kl] = acc[nt][j]; }
        __syncthreads();
        f32x4 y[4]; float s = 0.f;
#pragma unroll
        for (int i = 0; i < 4; ++i) { y[i] = y0[i] + y1[i]; s += (y[i].x + y[i].y) + (y[i].z + y[i].w); }
        RWP_Y(ch + (int)gridDim.x);
        s += dppmov<0xB1>(s); s += dppmov<0x4E>(s); const float mean = s * (1.0f / 64.0f); float q = 0.f;
#pragma unroll
        for (int i = 0; i < 4; ++i) { y[i] = y[i] - mean; q += (y[i].x * y[i].x + y[i].y * y[i].y) + (y[i].z * y[i].z + y[i].w * y[i].w); }
        q += dppmov<0xB1>(q); q += dppmov<0x4E>(q); const float rstd = 1.0f / sqrtf(q * (1.0f / 64.0f) + GN_EPS);
        const float bon = bon0 + bon1;
        unsigned ow[8];
#pragma unroll
        for (int i = 0; i < 4; ++i) { const unsigned cw0 = vc[i >> 1][(i & 1) * 2], cw1 = vc[i >> 1][(i & 1) * 2 + 1], pw0 = vp[i >> 1][(i & 1) * 2], pw1 = vp[i >> 1][(i & 1) * 2 + 1], nw0 = vn[i >> 1][(i & 1) * 2], nw1 = vn[i >> 1][(i & 1) * 2 + 1];
            const f32x4 cv = {bflo(cw0), bfhi(cw0), bflo(cw1), bfhi(cw1)}, pv = {bflo(pw0) * fp, bfhi(pw0) * fp, bflo(pw1) * fp, bfhi(pw1) * fp}, nv = {bflo(nw0) * fn, bfhi(nw0) * fn, bflo(nw1) * fn, bfhi(nw1) * fn};
            const f32x4 mpv = *(const LAS f32x4*)(Pl + c0 + 4 * i), mnv = *(const LAS f32x4*)(Pl + 512 + c0 + 4 * i), gng = *(const LAS f32x4*)(Pl + 1024 + c0 + 4 * i), gnb = *(const LAS f32x4*)(Pl + 1536 + c0 + 4 * i);
            const f32x4 zv = cv + mpv * (pv - cv) + mnv * (nv - cv);
            const f32x4 gt = *(const LAS f32x4*)(Gl + er * 512 + c0 + 4 * i);
            const f32x4 o = (y[i] * rstd * gng + gnb + zv * bon) * gt;
            ow[2 * i] = pk2(o.x, o.y); ow[2 * i + 1] = pk2(o.z, o.w); }
        RWP_V(ch + (int)gridDim.x);
        GAS v4u* dst = (GAS v4u*)(CAT + (size_t)row * DM + 512 + c0); dst[0] = (v4u){ow[0], ow[1], ow[2], ow[3]}; dst[1] = (v4u){ow[4], ow[5], ow[6], ow[7]};
    }
#undef RWP_TT
#undef RWP_RAW
#undef RWP_Y
#undef RWP_V
}

struct RowMap { int WPB, RPWX, RPWC; };
__device__ __forceinline__ RowMap rowmap(int NGW) { RowMap r; r.WPB = NGW / NB; r.RPWX = SEQ / r.WPB; r.RPWC = NTC / NGW; return r; }
__device__ __forceinline__ int route_wave(int m, const RowMap& r) { if (m < NTX) { const int b = m / SEQ, t = m - b * SEQ; return b * r.WPB + t / r.RPWX; } return (m - NTX) / r.RPWC; }
typedef _Float16 f16x8 __attribute__((ext_vector_type(8)));
typedef _Float16 f16x2_ __attribute__((ext_vector_type(2)));
__device__ __forceinline__ unsigned pkh(float a, float b) { f32x2_t_ v = {a, b}; f16x2_ h = __builtin_convertvector(v, f16x2_); return __builtin_bit_cast(unsigned, h); }
__device__ __forceinline__ void split_h(float a, float b, unsigned& hi, unsigned& lo) { hi = pkh(a, b); const f16x2_ hh = __builtin_bit_cast(f16x2_, hi); lo = pkh(a - (float)hh.x, b - (float)hh.y); }
constexpr int LN1_ROWB = 4112, LN1_RED = 67584;
template <bool BFIN> __device__ __forceinline__ void phase_ln1_route(LAS unsigned char* lds, int l) {
    const KA a = ka_get();
    const int tid = opaque_tid(), lane = tid & 63, wave = __builtin_amdgcn_readfirstlane(tid >> 6), G = gridDim.x, bid = blockIdx.x;
    const int gw = bid * 8 + wave, NGW = G * 8;
    if (tid < 32) ((LAS int*)(lds + LDSCTL_OFF + 1024))[tid] = 0;
    f16x8 Wh[2][4], Wl[2][4];
    { const float* RW = a.in(I_RW) + (size_t)(128 * wave + 8 * (lane >> 4)) * 32 + (lane & 15);
#pragma unroll
      for (int nt = 0; nt < 2; ++nt)
#pragma unroll
        for (int ks = 0; ks < 4; ++ks) { unsigned h[4], lo[4];
#pragma unroll
            for (int t = 0; t < 4; ++t) { const float w0 = RW[(32 * ks + 2 * t) * 32 + 16 * nt] * 256.f, w1 = RW[(32 * ks + 2 * t + 1) * 32 + 16 * nt] * 256.f; split_h(w0, w1, h[t], lo[t]); }
            Wh[nt][ks] = __builtin_bit_cast(f16x8, (v4u){h[0], h[1], h[2], h[3]}); Wl[nt][ks] = __builtin_bit_cast(f16x8, (v4u){lo[0], lo[1], lo[2], lo[3]}); } }
    __syncthreads();
    const float* mods = (const float*)(a.ws() + WS_MODS) + (size_t)l * 17 * 6144;
    const bf16* O = (const bf16*)(a.ws() + WS_X3); bf16* HM = (bf16*)(a.ws() + WS_X1);
    const float* xs = a.in(I_X); const float* cs = a.in(I_CTX); const bf16* xb = (const bf16*)a.out(); bf16* XP = (bf16*)(a.ws() + WS_XP);
    int* HIST = (int*)(a.ws() + WS_LIST); TokInfo* TOK = (TokInfo*)(a.ws() + WS_TOK); LAS int* lcnt = (LAS int*)(lds + LDSCTL_OFF + 1024);
    const GAS f32x4* lg = (const GAS f32x4*)(a.in(I_LN1G) + l * DM) + lane; const GAS f32x4* lb = (const GAS f32x4*)(a.in(I_LN1B) + l * DM) + lane;
    const float biasv = a.in(I_RB)[(lane >> 1) & 31];
    f32x4 lgv[4], lbv[4];
#pragma unroll
    for (int j = 0; j < 4; ++j) { lgv[j] = lg[64 * j]; lbv[j] = lb[64 * j]; }
    const RowMap rm = rowmap(NGW);
    const int bx = gw / rm.WPB, xbase = bx * SEQ + (gw - bx * rm.WPB) * rm.RPWX, cbase = NTX + gw * rm.RPWC, nxr = rm.RPWX, ntot = nxr + (BFIN ? 0 : rm.RPWC);
    f32x4 nx[4]; v2u nxb[4], no[4];
#define LN1_ROW(J) ((J) < nxr ? xbase + (J) : cbase + (J) - nxr)
#define LN1_FETCH(J) do { const int jj_ = (J) < ntot ? (J) : ntot - 1; const int m_ = LN1_ROW(jj_); const GAS v2u* or_ = (const GAS v2u*)(O + (size_t)m_ * DM) + lane; \
        if constexpr (BFIN) { const GAS v2u* xr_ = (const GAS v2u*)(xb + (size_t)m_ * DM) + lane; \
            _Pragma("unroll") for (int j_ = 0; j_ < 4; ++j_) { nxb[j_] = xr_[64 * j_]; no[j_] = or_[64 * j_]; } } \
        else { const float* s_ = m_ < NTX ? xs + (size_t)m_ * DM : cs + (size_t)(m_ - NTX) * DM; const GAS f32x4* xr_ = (const GAS f32x4*)s_ + lane; \
            _Pragma("unroll") for (int j_ = 0; j_ < 4; ++j_) { nx[j_] = xr_[64 * j_]; no[j_] = or_[64 * j_]; } } } while (0)
    LN1_FETCH(0);
    const unsigned afrag = (unsigned)((lane & 15) * LN1_ROWB + (128 * wave + 8 * (lane >> 4)) * 2);
    LAS float* red = (LAS float*)(lds + LN1_RED);
    for (int seg = 0; seg < (BFIN ? 1 : 2); ++seg) {
        const int j0 = seg ? nxr : 0, j1 = seg ? ntot : nxr; const int mr = seg ? 16 : bx;
        const GAS f32x4* md = (const GAS f32x4*)(mods + (size_t)mr * 6144) + lane;
        f32x4 sc2[4], sh2[4], gt1[4];
#pragma unroll
        for (int j = 0; j < 4; ++j) { gt1[j] = md[512 + 64 * j]; sc2[j] = md[1024 + 64 * j]; sh2[j] = md[768 + 64 * j]; }
      for (int jb = j0; jb < j1; jb += 2) {
#pragma unroll
        for (int r = 0; r < 2; ++r) {
            const int m = LN1_ROW(jb + r);
            f32x4 v[4]; float s = 0.f;
#pragma unroll
            for (int j = 0; j < 4; ++j) { f32x4 x; if constexpr (BFIN) { const v2u xw = nxb[j]; x = f32x4{bflo(xw.x), bfhi(xw.x), bflo(xw.y), bfhi(xw.y)}; } else x = nx[j];
                const f32x4 gt = gt1[j]; const v2u ow = no[j]; const f32x4 o = {bflo(ow.x), bfhi(ow.x), bflo(ow.y), bfhi(ow.y)};
                v[j] = x * ALPHA + gt * o; s += (v[j].x + v[j].y) + (v[j].z + v[j].w); }
            LN1_FETCH(jb + r + 1);
            const float mean = wave_sum(s) * (1.f / DM); float s2 = 0.f;
#pragma unroll
            for (int j = 0; j < 4; ++j) { v[j] = v[j] - mean; s2 += (v[j].x * v[j].x + v[j].y * v[j].y) + (v[j].z * v[j].z + v[j].w * v[j].w); }
            const float rstd = 1.f / sqrtf(wave_sum(s2) * (1.f / DM) + LN_EPS);
            GAS v2u* dr = (GAS v2u*)(XP + (size_t)m * DM) + lane; GAS v2u* hr = (GAS v2u*)(HM + (size_t)m * DM) + lane;
            const unsigned trow = (unsigned)((2 * wave + r) * LN1_ROWB + 8 * lane);
#pragma unroll
            for (int j = 0; j < 4; ++j) { const f32x4 x1 = v[j] * rstd * lgv[j] + lbv[j]; { v2u xw; xw.x = pk2(x1.x, x1.y); xw.y = pk2(x1.z, x1.w); dr[64 * j] = xw; }
                const f32x4 hm = x1 * (sc2[j] + 1.0f) + sh2[j]; v2u w; w.x = pk2(hm.x, hm.y); w.y = pk2(hm.z, hm.w); hr[64 * j] = w;
                unsigned h0_, l0_, h1_, l1_; split_h(hm.x, hm.y, h0_, l0_); split_h(hm.z, hm.w, h1_, l1_); const v2u hh = {h0_, h1_}, hl = {l0_, l1_};
                *(LAS v2u*)(lds + trow + 512 * j) = hh; *(LAS v2u*)(lds + trow + 2048 + 512 * j) = hl; }
        }
        __syncthreads();
        {
            f32x4 acc0 = {0.f, 0.f, 0.f, 0.f}, acc1 = {0.f, 0.f, 0.f, 0.f};
            f16x8 ah[4], al[4];
#pragma unroll
            for (int ks = 0; ks < 4; ++ks) { ah[ks] = *(const LAS f16x8*)(lds + afrag + 64 * ks); al[ks] = *(const LAS f16x8*)(lds + afrag + 2048 + 64 * ks); }
#pragma unroll
            for (int ks = 0; ks < 4; ++ks) {
                acc0 = __builtin_amdgcn_mfma_f32_16x16x32_f16(al[ks], Wh[0][ks], acc0, 0, 0, 0); acc1 = __builtin_amdgcn_mfma_f32_16x16x32_f16(al[ks], Wh[1][ks], acc1, 0, 0, 0);
                acc0 = __builtin_amdgcn_mfma_f32_16x16x32_f16(ah[ks], Wl[0][ks], acc0, 0, 0, 0); acc1 = __builtin_amdgcn_mfma_f32_16x16x32_f16(ah[ks], Wl[1][ks], acc1, 0, 0, 0);
                acc0 = __builtin_amdgcn_mfma_f32_16x16x32_f16(ah[ks], Wh[0][ks], acc0, 0, 0, 0); acc1 = __builtin_amdgcn_mfma_f32_16x16x32_f16(ah[ks], Wh[1][ks], acc1, 0, 0, 0); }
            LAS float* rw_ = red + (wave * 16 + 4 * (lane >> 4)) * 32 + (lane & 15);
#pragma unroll
            for (int i = 0; i < 4; ++i) { rw_[i * 32] = acc0[i]; rw_[i * 32 + 16] = acc1[i]; }
        }
        __syncthreads();
#pragma unroll 1
        for (int r = 0; r < 2; ++r) {
            const int m = LN1_ROW(jb + r);
            const LAS float* rr = red + (2 * wave + r) * 32 + ((lane >> 1) & 31); float lsum[8];
#pragma unroll
            for (int w = 0; w < 8; ++w) lsum[w] = rr[w * 512];
            const float logit = (((lsum[0] + lsum[1]) + (lsum[2] + lsum[3])) + ((lsum[4] + lsum[5]) + (lsum[6] + lsum[7]))) * (1.f / 256.f);
        const float score = sigmoidf_(logit), sel = score + biasv;
        const int gl = lane & ~7;
        const float q0 = shi(sel, gl), q1 = shi(sel, gl + 2), q2 = shi(sel, gl + 4), q3 = shi(sel, gl + 6);
        const float mx = fmaxf(fmaxf(q0, q1), fmaxf(q2, q3));
        float top2;
        { float a0 = q0, a1 = q1, a2 = q2, a3 = q3; float t;
          if (a0 < a1) { t = a0; a0 = a1; a1 = t; } if (a2 < a3) { t = a2; a2 = a3; a3 = t; } if (a0 < a2) { t = a0; a0 = a2; a2 = t; } if (a1 < a3) { t = a1; a1 = a3; a3 = t; } if (a1 < a2) { t = a1; a1 = a2; a2 = t; }
          top2 = a0 + a1; (void)mx; }
        float best = __builtin_bit_cast(float, __builtin_amdgcn_readlane(__builtin_bit_cast(int, top2), 0)); int gidx = 0;
#pragma unroll
        for (int gg = 1; gg < 8; ++gg) { const float sc = __builtin_bit_cast(float, __builtin_amdgcn_readlane(__builtin_bit_cast(int, top2), gg * 8)); if (sc > best) { best = sc; gidx = gg; } }
        const float r0 = shi(sel, gidx * 8), r1 = shi(sel, gidx * 8 + 2), r2 = shi(sel, gidx * 8 + 4), r3 = shi(sel, gidx * 8 + 6);
        int i0 = 0; float b0 = r0; if (r1 > b0) { b0 = r1; i0 = 1; } if (r2 > b0) { b0 = r2; i0 = 2; } if (r3 > b0) { b0 = r3; i0 = 3; }
        int i1 = -1; float b1 = -INFINITY;
        if (i0 != 0 && r0 > b1) { b1 = r0; i1 = 0; } if (i0 != 1 && r1 > b1) { b1 = r1; i1 = 1; } if (i0 != 2 && r2 > b1) { b1 = r2; i1 = 2; } if (i0 != 3 && r3 > b1) { b1 = r3; i1 = 3; }
        const int e0 = gidx * 4 + i0, e1 = gidx * 4 + i1;
        const float s0 = shi(score, 2 * e0), s1 = shi(score, 2 * e1); const float gs = 1.0f / (s0 + s1);
        if (lane == 0) { const int p0 = __hip_atomic_fetch_add(lcnt + e0, 1, __ATOMIC_RELAXED, __HIP_MEMORY_SCOPE_WORKGROUP), p1_ = __hip_atomic_fetch_add(lcnt + e1, 1, __ATOMIC_RELAXED, __HIP_MEMORY_SCOPE_WORKGROUP);
            TokInfo ti; ti.e0 = e0; ti.e1 = e1; ti.p0 = p0; ti.p1 = p1_; ti.g0 = s0 * gs; ti.g1 = s1 * gs; ti.pad0 = 0; ti.pad1 = 0; TOK[m] = ti; }
        }
      }
    }
    __syncthreads();
    if (tid < 32) HIST[bid * 32 + tid] = lcnt[tid];
}

template <bool FULL> __device__ __forceinline__ void moe_tables(LAS unsigned char* lds, int l) {
    const KA a = ka_get(); const int tid = opaque_tid(), G = gridDim.x;
    LAS int* pref = (LAS int*)(lds + PREF_OFF); LAS int* bb = (LAS int*)lds; LAS int* tot = (LAS int*)(lds + 65536);
    const int* HIST = (const int*)(a.ws() + WS_LIST);
    __syncthreads();
    const int e = tid & 31, grp = tid >> 5;
    int loc[16]; int run = 0;
#pragma unroll
    for (int i = 0; i < 16; ++i) { const int b = grp * 16 + i; loc[i] = (b < G) ? HIST[b * 32 + e] : 0; }
#pragma unroll
    for (int i = 0; i < 16; ++i) { const int v = loc[i]; loc[i] = run; run += v; }
    tot[grp * 32 + e] = run;
    __syncthreads();
    int base = 0, total = 0;
#pragma unroll
    for (int q = 0; q < 16; ++q) { const int v = tot[q * 32 + e]; base += (q < grp) ? v : 0; total += v; }
    if (FULL) {
#pragma unroll
        for (int i = 0; i < 16; ++i) bb[(grp * 16 + i) * 32 + e] = base + loc[i]; }
    if (grp == 0) pref[40 + e] = total;
    __syncthreads();
    if (tid == 0) { int acc = 0; for (int k = 0; k < 32; ++k) { pref[k] = acc; acc += (pref[40 + k] + 255) >> 8; } pref[32] = acc; }
    __syncthreads();
}
__device__ __forceinline__ void phase_gather(LAS unsigned char* lds, int l) {
    const KA a = ka_get();
    const int tid = opaque_tid(), lane = tid & 63, wave = __builtin_amdgcn_readfirstlane(tid >> 6), G = gridDim.x, bid = blockIdx.x;
    const int gw = bid * 8 + wave, NGW = G * 8;
    moe_tables<true>(lds, l);
    const LAS int* pref = (const LAS int*)(lds + PREF_OFF); const LAS int* bb = (const LAS int*)lds;
    const bf16* HM = (const bf16*)(a.ws() + WS_X1); bf16* XB = (bf16*)(a.ws() + WS_X2); const TokInfo* TOK = (const TokInfo*)(a.ws() + WS_TOK);
    const int Mrows = l == 0 ? NTOK : NTX;
    const RowMap rm = rowmap(NGW);
    for (int m = gw; m < Mrows; m += NGW) {
        const TokInfo ti = TOK[m]; const int blk = route_wave(m, rm) >> 3;
        const int sl0 = pref[ti.e0] * 256 + bb[blk * 32 + ti.e0] + ti.p0, sl1 = pref[ti.e1] * 256 + bb[blk * 32 + ti.e1] + ti.p1;
        const GAS v4u* srcp = (const GAS v4u*)(HM + (size_t)m * DM) + lane; const v4u v0 = srcp[0], v1 = srcp[64];
        GAS v4u* d0 = (GAS v4u*)(XB + (size_t)sl0 * DM) + lane; GAS v4u* d1 = (GAS v4u*)(XB + (size_t)sl1 * DM) + lane;
        d0[0] = v0; d0[64] = v1; d1[0] = v0; d1[64] = v1;
    }
    for (int e = 0; e < 32; ++e) {
        const int c = pref[40 + e], npad = ((c + 255) & ~255) - c, r0 = pref[e] * 256 + c;
        for (int r = gw; r < npad; r += NGW) { GAS v4u* dst = (GAS v4u*)(XB + (size_t)(r0 + r) * DM) + lane; dst[0] = (v4u){0u, 0u, 0u, 0u}; dst[64] = (v4u){0u, 0u, 0u, 0u}; }
    }
}

__device__ __forceinline__ void phase_ln2(LAS unsigned char* lds, int l) {
    const KA a = ka_get();
    const int tid = opaque_tid(), lane = tid & 63, wave = __builtin_amdgcn_readfirstlane(tid >> 6), G = gridDim.x, bid = blockIdx.x;
    const int gw = bid * 8 + wave, NGW = G * 8;
    moe_tables<true>(lds, l);
    const LAS int* pref = (const LAS int*)(lds + PREF_OFF); const LAS int* bb = (const LAS int*)lds;
    const float* mods = (const float*)(a.ws() + WS_MODS) + (size_t)l * 17 * 6144;
    const bf16* Y = (const bf16*)(a.ws() + WS_X2); const TokInfo* TOK = (const TokInfo*)(a.ws() + WS_TOK);
    const bf16* XP = (const bf16*)(a.ws() + WS_XP);
    const GAS f32x4* lg = (const GAS f32x4*)(a.in(I_LN2G) + l * DM) + lane; const GAS f32x4* lb = (const GAS f32x4*)(a.in(I_LN2B) + l * DM) + lane;
    const int Mrows = l == 0 ? NTOK : NTX;
    f32x4 lgv[4], lbv[4];
#pragma unroll
    for (int j = 0; j < 4; ++j) { lgv[j] = lg[64 * j]; lbv[j] = lb[64 * j]; }
    const int RPW = (Mrows + NGW - 1) / NGW, m0 = gw * RPW, mend = (m0 + RPW < Mrows) ? m0 + RPW : Mrows, nrows = mend - m0;
    int sl0v = 0, sl1v = 0; float g0v = 0.f, g1v = 0.f;
    if (lane < nrows) { const TokInfo ti = TOK[m0 + lane]; const LAS int* bbw = bb + (route_wave(m0 + lane, rowmap(NGW)) >> 3) * 32;
        sl0v = pref[ti.e0] * 256 + bbw[ti.e0] + ti.p0; sl1v = pref[ti.e1] * 256 + bbw[ti.e1] + ti.p1; g0v = ti.g0; g1v = ti.g1; }
    v2u nxin[4], nain[4], nbin[4];
#define LN2_FETCH(J) do { const int j_ = (J) < nrows ? (J) : (nrows - 1); const int s0_ = __builtin_amdgcn_readlane(sl0v, j_), s1_ = __builtin_amdgcn_readlane(sl1v, j_); \
        const GAS v2u* xr_ = (const GAS v2u*)(XP + (size_t)(m0 + j_) * DM) + lane; const GAS v2u* y0_ = (const GAS v2u*)(Y + (size_t)s0_ * DM) + lane; const GAS v2u* y1_ = (const GAS v2u*)(Y + (size_t)s1_ * DM) + lane; \
        _Pragma("unroll") for (int q_ = 0; q_ < 4; ++q_) { nxin[q_] = xr_[64 * q_]; nain[q_] = y0_[64 * q_]; nbin[q_] = y1_[64 * q_]; } } while (0)
    if (nrows > 0) {
    LN2_FETCH(0);
    for (int jr = 0; jr < nrows; ) {
        const int mseg = m0 + jr; const int mr = mseg < NTX ? mseg / SEQ : 16; int segend = mseg < NTX ? (mr + 1) * SEQ : Mrows; segend = (segend < mend ? segend : mend) - m0;
        const GAS f32x4* md = (const GAS f32x4*)(mods + (size_t)mr * 6144) + lane;
        f32x4 gin[4], msc[4], msh[4];
#pragma unroll
        for (int j = 0; j < 4; ++j) gin[j] = md[1280 + 64 * j];
        if (l == 0) { const GAS f32x4* mn = (const GAS f32x4*)(mods + (size_t)17 * 6144 + (size_t)mr * 6144) + lane;
#pragma unroll
            for (int j = 0; j < 4; ++j) { msc[j] = mn[256 + 64 * j]; msh[j] = mn[64 * j]; } }
      for (; jr < segend; ++jr) {
        const int m = m0 + jr;
        const float tg0 = __builtin_bit_cast(float, __builtin_amdgcn_readlane(__builtin_bit_cast(int, g0v), jr)), tg1 = __builtin_bit_cast(float, __builtin_amdgcn_readlane(__builtin_bit_cast(int, g1v), jr));
        f32x4 v[4]; float s = 0.f;
#pragma unroll
        for (int j = 0; j < 4; ++j) { const v2u xw = nxin[j]; const f32x4 x = {bflo(xw.x), bfhi(xw.x), bflo(xw.y), bfhi(xw.y)}, gt = gin[j]; const v2u a0 = nain[j], a1 = nbin[j];
            const f32x4 ya = {bflo(a0.x), bfhi(a0.x), bflo(a0.y), bfhi(a0.y)}, yb = {bflo(a1.x), bfhi(a1.x), bflo(a1.y), bfhi(a1.y)};
            v[j] = x * ALPHA + gt * (ya * tg0 + yb * tg1); s += (v[j].x + v[j].y) + (v[j].z + v[j].w); }
        LN2_FETCH(jr + 1);
        const float mean = wave_sum(s) * (1.f / DM); float s2 = 0.f;
#pragma unroll
        for (int j = 0; j < 4; ++j) { v[j] = v[j] - mean; s2 += (v[j].x * v[j].x + v[j].y * v[j].y) + (v[j].z * v[j].z + v[j].w * v[j].w); }
        const float rstd = 1.f / sqrtf(wave_sum(s2) * (1.f / DM) + LN_EPS);
        if (l == 0) {
            GAS v2u* o8 = (GAS v2u*)((bf16*)(a.ws() + WS_X1) + (size_t)m * DM) + lane; GAS v2u* xs8 = (GAS v2u*)((bf16*)a.out() + (size_t)(m < NTX ? m : 0) * DM) + lane;
            const bool isx = m < NTX;
#pragma unroll
            for (int j = 0; j < 4; ++j) { const f32x4 xn = v[j] * rstd * lgv[j] + lbv[j]; if (isx) { v2u xw; xw.x = pk2(xn.x, xn.y); xw.y = pk2(xn.z, xn.w); xs8[64 * j] = xw; }
                const f32x4 r = xn * (msc[j] + 1.0f) + msh[j]; v2u w; w.x = pk2(r.x, r.y); w.y = pk2(r.z, r.w); o8[64 * j] = w; }
        } else {
            GAS f32x4* of = (GAS f32x4*)(a.out() + (size_t)m * DM) + lane;
#pragma unroll
            for (int j = 0; j < 4; ++j) of[64 * j] = v[j] * rstd * lgv[j] + lbv[j];
        }
      }
    }
    }
}
namespace csc {
constexpr int ARR = 0;
constexpr int RAW = 0;
constexpr int ZL = 34816;
constexpr int WLO = 57344;
constexpr int FR = 58368;
constexpr int AABT = 87040;
constexpr int LWO = 91136;
constexpr int AAO = 107520;
__device__ __forceinline__ int sw16(int row, int chunk) { return row * 128 + ((chunk ^ (row & 7)) << 4); }
__device__ __forceinline__ v2u cvt4(const f32x4 v) { v2u r; r.x = pk2(v[0], v[1]); r.y = pk2(v[2], v[3]); return r; }
__device__ __forceinline__ bf16x8 mk8(v2u lo, v2u hi) { v4u w; w.x = lo.x; w.y = lo.y; w.z = hi.x; w.w = hi.y; return __builtin_bit_cast(bf16x8, w); }
__device__ __forceinline__ v2u trd(const LAS unsigned char* p) { return __builtin_bit_cast(v2u, __builtin_amdgcn_ds_read_tr16_b64_v4i16((LAS v4i16_t*)p)); }
__device__ __forceinline__ int opq(int v) { asm volatile("" : "+v"(v)); return v; }
__device__ __forceinline__ int opqs(int v) { asm volatile("" : "+s"(v)); return v; }
}
namespace bgc {
constexpr int CBUF = LDSCTL_OFF + 4096, CPITCH = 80, NITEMS = NEXP * 1536;
struct Item { const float* src; bf16* dst; int N, ld; };
__device__ __forceinline__ Item decode(const KA& a, int l, int item) {
    const int e = item / 1536; int r = item - e * 1536; const int m = r >> 9, t = r & 511; const size_t eo = ((size_t)l * NEXP + e) * (size_t)DM * DEXP; Item it;
    if (m < 2) { const int kt = t >> 4, nt = t & 15, j0 = 32 * nt; it.N = DEXP; it.ld = 1024; it.src = (m ? a.in(I_EW3) : a.in(I_EW1)) + eo + (size_t)(32 * kt) * DEXP + j0;
        it.dst = (bf16*)(a.ws() + WS_W13T) + (size_t)e * 1024 * 1024 + (size_t)(256 * (j0 >> 7) + 128 * m + (j0 & 127)) * 1024 + 32 * kt; }
    else { const int kt = t >> 5, nt = t & 31; it.N = DM; it.ld = 512; it.src = a.in(I_EW2) + eo + (size_t)(32 * kt) * DM + 32 * nt; it.dst = (bf16*)(a.ws() + WS_W2T) + (size_t)e * 1024 * 512 + (size_t)(32 * nt) * 512 + 32 * kt; }
    return it; }
__device__ __forceinline__ void issue(const KA& a, int l, int item, int lane, f32x4 (&cv)[4]) { const Item it = decode(a, l, item);
#pragma unroll
    for (int i = 0; i < 4; ++i) cv[i] = *(const GAS f32x4*)(it.src + (size_t)((lane >> 3) + 8 * i) * it.N + (lane & 7) * 4); }
__device__ __forceinline__ void finish(const KA& a, int l, int item, int lane, int slot, LAS unsigned char* lds, const f32x4 (&cv)[4]) { const Item it = decode(a, l, item);
    LAS unsigned char* buf = lds + CBUF + slot * (32 * CPITCH);
#pragma unroll
    for (int i = 0; i < 4; ++i)
#pragma unroll
        for (int u = 0; u < 4; ++u) *(LAS bf16*)(buf + ((lane & 7) * 4 + u) * CPITCH + ((lane >> 3) + 8 * i) * 2) = f2bf1(cv[i][u]);
    LDS_WAIT(); asm volatile("" ::: "memory");
    const int n = lane >> 1, hf = lane & 1; const v4u w0 = *(const LAS v4u*)(buf + n * CPITCH + hf * 32), w1 = *(const LAS v4u*)(buf + n * CPITCH + hf * 32 + 16);
    GAS v4u* d = (GAS v4u*)(it.dst + (size_t)n * it.ld + 16 * hf); d[0] = w0; d[1] = w1;
    LDS_WAIT(); asm volatile("" ::: "memory"); }
}
#ifndef SCAN_STAMP
#define SCAN_STAMP 0
#endif
#define STB(k) do { if (SCAN_STAMP == (k)) t0_ = (unsigned)__builtin_amdgcn_s_memrealtime(); } while (0)
#define STE(k) do { if (SCAN_STAMP == (k)) tacc_ += (unsigned)__builtin_amdgcn_s_memrealtime() - t0_; } while (0)
#ifndef SCAN_PROBE
#define SCAN_PROBE 0
#endif
#define REPK(k) for (int rep_ = 0; rep_ < ((SCAN_PROBE == (k)) ? 2 : 1); ++rep_)
__device__ __forceinline__ void phase_scan(LAS unsigned char* lds, int l) {
    using namespace csc;
    const KA a = ka_get();
    const int tid = opaque_tid(), lane0 = tid & 63, wv = __builtin_amdgcn_readfirstlane(tid >> 6);
    const bf16* PX = (const bf16*)(a.ws() + WS_X2); float* YD = (float*)(a.ws() + WS_X3); float* BON = (float*)(a.ws() + WS_BONUS);
    const float* mup = a.in(I_MUP) + l * 1760; const float* mun = a.in(I_MUN) + l * 1760;
    const f32x4 Z4 = {0.f, 0.f, 0.f, 0.f}; const v2u Z2 = {0u, 0u};
    unsigned t0_ = 0, tacc_ = 0; (void)t0_;
    for (int chain = blockIdx.x; chain < 256; chain += gridDim.x) {
        const int b = chain >> 4, h = (chain >> 1) & 7, d = chain & 1; const int c0_ = opq(lane0);
        float kkc[2], kac[2], rkc[2], mur[2][2], muk[2][2], muv[2][2], mul[2][2], ropef[2]; bf16x8 w2f[2], a2f[2]; float w0c[2], a0c[2];
        { const int ln = c0_, kl = ln & 15, g = ln >> 4, cp = ln & 31;
#pragma unroll
          for (int u = 0; u < 2; ++u) { const int c = 2 * cp + u; ropef[u] = exp2f(-(float)(c & 15) * (13.287712379549449f / 16.0f));
            kkc[u] = a.in(I_KK)[l * 512 + h * 64 + c]; kac[u] = a.in(I_KA)[l * 512 + h * 64 + c]; rkc[u] = a.in(I_RK)[l * 512 + h * 64 + c];
            const int colr = h * 64 + c, coll = (c < 32) ? (1536 + d * 32 + c) : (1600 + d * 32 + (c - 32));
            mur[u][0] = d ? mun[colr] : mup[colr]; mur[u][1] = d ? mup[colr] : mun[colr]; muk[u][0] = d ? mun[512 + colr] : mup[512 + colr]; muk[u][1] = d ? mup[512 + colr] : mun[512 + colr];
            muv[u][0] = d ? mun[1024 + colr] : mup[1024 + colr]; muv[u][1] = d ? mup[1024 + colr] : mun[1024 + colr]; mul[u][0] = d ? mun[coll] : mup[coll]; mul[u][1] = d ? mup[coll] : mun[coll]; }
#pragma unroll
        for (int i = 0; i < 2; ++i) { const int cc = h * 64 + 16 * ((wv >> 2) * 2 + i) + kl; unsigned t[8], u[8];
#pragma unroll
            for (int j = 0; j < 8; ++j) { t[j] = f2bf(a.in(I_W2)[((size_t)(l * 2 + d) * 32 + 8 * g + j) * 512 + cc]); u[j] = f2bf(a.in(I_A2)[((size_t)(l * 2 + d) * 32 + 8 * g + j) * 512 + cc]); }
            w2f[i] = __builtin_bit_cast(bf16x8, (v4u){t[0] | (t[1] << 16), t[2] | (t[3] << 16), t[4] | (t[5] << 16), t[6] | (t[7] << 16)});
            a2f[i] = __builtin_bit_cast(bf16x8, (v4u){u[0] | (u[1] << 16), u[2] | (u[3] << 16), u[4] | (u[5] << 16), u[6] | (u[7] << 16)});
            w0c[i] = a.in(I_W0)[(l * 2 + d) * 512 + cc]; a0c[i] = a.in(I_A0)[(l * 2 + d) * 512 + cc]; } }
        f32x4 St[4] = {Z4, Z4, Z4, Z4};
        f32x4 cvt_[4] = {Z4, Z4, Z4, Z4}; int cit = blockIdx.x * 8 + wv, cpend = -1; const int cstride = gridDim.x * 8;
#define BGC_WINDOW() do { const int ln_ = opq(lane0); if (cpend >= 0) bgc::finish(a, l, cpend, ln_, wv & 3, lds, cvt_); if (cit < bgc::NITEMS) { bgc::issue(a, l, cit, ln_, cvt_); cpend = cit; cit += cstride; } else cpend = -1; } while (0)
        for (int seq = 0; seq < 2; ++seq) {
            const int T = seq ? SEQ : CTXL, rowbase = seq ? b * SEQ : NTX + b * CTXL, ngrp = T / 64;
            v4u pre[5];
#define CSC_PREFETCH(GRP) do { const int s0_ = (GRP) * 64; const int tlo_ = d ? (T - 64 - s0_) : s0_; \
                _Pragma("unroll") for (int i_ = 0; i_ < 5; ++i_) { const int id_ = opq(tid) + 512 * i_; const int rr_ = id_ >> 5, ch_ = id_ & 31; const int t_ = tlo_ - 1 + rr_; \
                    const int col_ = RWOFF + (ch_ < 24 ? (ch_ >> 3) * 512 + h * 64 + (ch_ & 7) * 8 : (ch_ < 28 ? 1536 + d * 32 + (ch_ - 24) * 8 : 1600 + d * 32 + (ch_ - 28) * 8)); \
                    const bool ok_ = (id_ < 66 * 32) && t_ >= 0 && t_ < T; const int tc_ = ok_ ? t_ : 0; \
                    const v4u v_ = *(const GAS v4u*)(PX + (size_t)(rowbase + tc_) * DINP + col_); pre[i_] = ok_ ? v_ : (v4u){0u, 0u, 0u, 0u}; } } while (0)
            CSC_PREFETCH(0);
            for (int grp = 0; grp < ngrp; ++grp) {
                const int s0 = grp * 64;
                int lane = opq(lane0); int c = lane, kl = lane & 15, g = lane >> 4, q_ = kl >> 2, p_ = kl & 3; (void)q_; (void)p_;
                STB(1);
#pragma unroll
                for (int i = 0; i < 5; ++i) { const int id = opq(tid) + 512 * i; if (id < 66 * 32) *(LAS v4u*)(lds + RAW + id * 16) = pre[i]; }
                __syncthreads();
                STE(1); STB(2);
                int sl = opqs(wv);
                float Rk[4][2], Rq[4][2], Rr[4][2], Rv[4][2];
                REPK(1) { const int cp = lane & 31, sh = lane >> 5, sb = 8 * sl + 4 * sh; const int rbase = d ? 64 - sb : sb + 1, rdir = d ? -256 : 256;
                  const LAS bf16* p0 = (const LAS bf16*)(lds + RAW) + (rbase * 256 + 2 * cp) - rdir;
                  float pr[6][2], pk[6][2], pv[6][2], pl[6][2];
#pragma unroll
                  for (int j = 0; j < 6; ++j) { const LAS unsigned* p = (const LAS unsigned*)(p0 + j * rdir); const unsigned wr = p[0], wk = p[32], wv_ = p[64], wl = p[96];
                      pr[j][0] = bflo(wr); pr[j][1] = bfhi(wr); pk[j][0] = bflo(wk); pk[j][1] = bfhi(wk); pv[j][0] = bflo(wv_); pv[j][1] = bfhi(wv_); pl[j][0] = bflo(wl); pl[j][1] = bfhi(wl); }
                  const int qd = cp >> 3;
#pragma unroll
                  for (int i = 0; i < 4; ++i) { const int sloc = sb + i; float r[2], k[2], zz[2];
#pragma unroll
                      for (int u = 0; u < 2; ++u) { r[u] = pr[i + 1][u] + mur[u][0] * (pr[i][u] - pr[i + 1][u]) + mur[u][1] * (pr[i + 2][u] - pr[i + 1][u]); k[u] = pk[i + 1][u] + muk[u][0] * (pk[i][u] - pk[i + 1][u]) + muk[u][1] * (pk[i + 2][u] - pk[i + 1][u]);
                          Rv[i][u] = pv[i + 1][u] + muv[u][0] * (pv[i][u] - pv[i + 1][u]) + muv[u][1] * (pv[i + 2][u] - pv[i + 1][u]);
                          const float z = pl[i + 1][u] + mul[u][0] * (pl[i][u] - pl[i + 1][u]) + mul[u][1] * (pl[i + 2][u] - pl[i + 1][u]);
                          const float th = 1.0f - 2.0f * __builtin_amdgcn_rcpf(1.0f + __expf(2.0f * z)); zz[u] = cp < 16 ? th : z; }
                      ((LAS unsigned*)(lds + ZL))[sloc * 32 + cp] = pk2(zz[0], zz[1]);
                      if (seq) { const int t = d ? (T - 1 - (s0 + sloc)) : (s0 + sloc); const float pos = (float)((qd < 2) ? (t >> 6) : (t & 63));
#pragma unroll
                          for (int u = 0; u < 2; ++u) { const float rp = dppmov<0x128>(r[u]), kp = dppmov<0x128>(k[u]); const float ang = pos * ropef[u]; const float cs = __cosf(ang), sn = __sinf(ang);
                              const float sg = (qd & 1) ? sn : -sn; r[u] = r[u] * cs + rp * sg; k[u] = k[u] * cs + kp * sg; } }
                      const float k0 = k[0] * kkc[0], k1 = k[1] * kkc[1]; float ss = k0 * k0 + k1 * k1;
                      ss += dppmov<0xB1>(ss); ss += dppmov<0x4E>(ss); ss += dppmov<0x141>(ss); ss += dppmov<0x140>(ss);
                      { const int iv = __builtin_bit_cast(int, ss); const float a0 = __builtin_bit_cast(float, __builtin_amdgcn_readlane(iv, 0)) + __builtin_bit_cast(float, __builtin_amdgcn_readlane(iv, 16)), a1 = __builtin_bit_cast(float, __builtin_amdgcn_readlane(iv, 32)) + __builtin_bit_cast(float, __builtin_amdgcn_readlane(iv, 48)); ss = sh ? a1 : a0; }
                      const float rn = __builtin_amdgcn_rsqf(fmaxf(ss, 1e-24f));
                      Rk[i][0] = k0 * rn; Rk[i][1] = k1 * rn; Rq[i][0] = k[0]; Rq[i][1] = k[1]; Rr[i][0] = r[0]; Rr[i][1] = r[1]; } }
                __syncthreads();
                STE(2); STB(3);
                lane = opq(lane0); c = lane; kl = lane & 15; g = lane >> 4; q_ = kl >> 2; p_ = kl & 3;
                REPK(2) { const int wq = opqs(wv); const int st = wq & 3; const LAS unsigned char* zrow = lds + ZL + (16 * st + kl) * 128;
                  const bf16x8 zw = *(const LAS bf16x8*)(zrow + 16 * g), za = *(const LAS bf16x8*)(zrow + 64 + 16 * g);
#pragma unroll
                  for (int i = 0; i < 2; ++i) { const int cc = 16 * ((wq >> 2) * 2 + i) + kl;
                      const f32x4 uw = __builtin_amdgcn_mfma_f32_16x16x32_bf16(zw, w2f[i], Z4, 0, 0, 0), ua = __builtin_amdgcn_mfma_f32_16x16x32_bf16(za, a2f[i], Z4, 0, 0, 0);
#pragma unroll
                      for (int j = 0; j < 4; ++j) { const int srow = 16 * st + 4 * g + j;
                          ((LAS float*)(lds + LWO))[srow * 64 + cc] = -0.6065306597126334f * __builtin_amdgcn_rcpf(1.0f + __expf(-(uw[j] + w0c[i]))); ((LAS float*)(lds + AAO))[srow * 64 + cc] = __builtin_amdgcn_rcpf(1.0f + __expf(-(ua[j] + a0c[i]))); } } }
                __syncthreads();
                STE(3); STB(4);
                lane = opq(lane0); c = lane; kl = lane & 15; g = lane >> 4; q_ = kl >> 2; p_ = kl & 3;
                sl = opqs(wv);
                REPK(4) { const int cp = lane & 31, sh = lane >> 5, q = sl >> 1, hf = sl & 1; typedef float f32x2_ __attribute__((ext_vector_type(2)));
                  const LAS f32x2_* lwp = (const LAS f32x2_*)((const LAS float*)(lds + LWO) + (16 * q) * 64 + 2 * cp); const LAS f32x2_* aap = (const LAS f32x2_*)((const LAS float*)(lds + AAO) + (8 * sl + 4 * sh) * 64 + 2 * cp);
                  f32x2_ qs[4];
#pragma unroll
                  for (int j = 0; j < 4; ++j) { qs[j] = lwp[(4 * j) * 32] + lwp[(4 * j + 1) * 32] + lwp[(4 * j + 2) * 32] + lwp[(4 * j + 3) * 32]; }
                  const f32x2_ cL = (qs[0] + qs[1]) + (qs[2] + qs[3]); const int part = 2 * hf + sh;
                  f32x2_ run = part == 0 ? (f32x2_){0.f, 0.f} : (part == 1 ? qs[0] : (part == 2 ? qs[0] + qs[1] : qs[0] + qs[1] + qs[2]));
                  const float wl0 = __expf(cL.x), wl1 = __expf(cL.y);
                  if (part == 3) ((LAS f32x2_*)(lds + WLO))[q * 32 + cp] = (f32x2_){wl0, wl1};
#pragma unroll
                  for (int i = 0; i < 4; ++i) { const int sloc = 8 * sl + 4 * sh + i, s = 4 * part + i; const f32x2_ lwi = lwp[s * 32]; const f32x2_ cprev = run; run = run + lwi; const f32x2_ aa = aap[i * 32];
                      const float kd0 = Rq[i][0] * (1.0f + (aa.x - 1.0f) * kac[0]), kd1 = Rq[i][1] * (1.0f + (aa.y - 1.0f) * kac[1]), nb0 = -Rk[i][0] * aa.x, nb1 = -Rk[i][1] * aa.y;
                      float bon = Rr[i][0] * kd0 * rkc[0] + Rr[i][1] * kd1 * rkc[1];
                      bon += dppmov<0xB1>(bon); bon += dppmov<0x4E>(bon); bon += dppmov<0x141>(bon); bon += dppmov<0x140>(bon);
                      { const int iv = __builtin_bit_cast(int, bon); const float a0 = __builtin_bit_cast(float, __builtin_amdgcn_readlane(iv, 0)) + __builtin_bit_cast(float, __builtin_amdgcn_readlane(iv, 16)), a1 = __builtin_bit_cast(float, __builtin_amdgcn_readlane(iv, 32)) + __builtin_bit_cast(float, __builtin_amdgcn_readlane(iv, 48)); bon = sh ? a1 : a0; }
                      if (cp == 0) { const int t = d ? (T - 1 - (s0 + sloc)) : (s0 + sloc); BON[((size_t)d * NTOK + rowbase + t) * 8 + h] = bon; }
                      const float e1x = __expf(cprev.x), e1y = __expf(cprev.y), e2x = __expf(-run.x), e2y = __expf(-run.y), e3x = __builtin_amdgcn_rcpf(e2x), e3y = __builtin_amdgcn_rcpf(e2y);
                      LAS unsigned char* base = lds + ARR + q * (7 * 2048) + sw16(s, cp >> 2) + (cp & 3) * 4;
                      *(LAS unsigned*)(base) = pk2(Rk[i][0] * e1x, Rk[i][1] * e1y); *(LAS unsigned*)(base + 2048) = pk2(nb0 * e2x, nb1 * e2y); *(LAS unsigned*)(base + 4096) = pk2(kd0 * e2x, kd1 * e2y); *(LAS unsigned*)(base + 6144) = pk2(Rr[i][0] * e3x, Rr[i][1] * e3y);
                      *(LAS unsigned*)(base + 12288) = pk2(Rv[i][0], Rv[i][1]); } }
                __syncthreads();
                STE(4); STB(5);
                lane = opq(lane0); c = lane; kl = lane & 15; g = lane >> 4; q_ = kl >> 2; p_ = kl & 3;
                STB(7); if (wv < 4) { BGC_WINDOW(); if (grp + 1 < ngrp) CSC_PREFETCH(grp + 1); } STE(7);
                STB(8); STB(10);
                REPK(5) if (wv >= 4) { __builtin_amdgcn_s_setprio(3); const int q = opqs(wv) - 4; const LAS unsigned char* A0 = lds + ARR + q * (7 * 2048);
                    STB(11);
                    bf16x8 at[2], bt[2], kt[2], rt[2];
#pragma unroll
                    for (int ks = 0; ks < 2; ++ks) { const int o = sw16(kl, ks * 4 + g); at[ks] = *(const LAS bf16x8*)(A0 + o); bt[ks] = *(const LAS bf16x8*)(A0 + 2048 + o); kt[ks] = *(const LAS bf16x8*)(A0 + 4096 + o); rt[ks] = *(const LAS bf16x8*)(A0 + 6144 + o); }
                    f32x4 ABt = Z4, AKt = Z4, RBt = Z4, RKt = Z4;
#pragma unroll
                    for (int ks = 0; ks < 2; ++ks) { ABt = __builtin_amdgcn_mfma_f32_16x16x32_bf16(bt[ks], at[ks], ABt, 0, 0, 0); AKt = __builtin_amdgcn_mfma_f32_16x16x32_bf16(kt[ks], at[ks], AKt, 0, 0, 0);
                        RBt = __builtin_amdgcn_mfma_f32_16x16x32_bf16(bt[ks], rt[ks], RBt, 0, 0, 0); RKt = __builtin_amdgcn_mfma_f32_16x16x32_bf16(kt[ks], rt[ks], RKt, 0, 0, 0); }
#pragma unroll
                    for (int j = 0; j < 4; ++j) { const int jj = 4 * g + j; ABt[j] = jj < kl ? ABt[j] : 0.f; AKt[j] = jj < kl ? AKt[j] : 0.f; RBt[j] = jj <= kl ? RBt[j] : 0.f; RKt[j] = jj <= kl ? RKt[j] : 0.f; }
                    STE(11); STB(12);
                    float Tr[16]; const float ab0 = ABt[0], ab1 = ABt[1], ab2 = ABt[2], ab3 = ABt[3];
                    const int abi[4] = {__builtin_bit_cast(int, ab0), __builtin_bit_cast(int, ab1), __builtin_bit_cast(int, ab2), __builtin_bit_cast(int, ab3)};
#pragma unroll
                    for (int i = 0; i < 16; ++i) Tr[i] = (i == kl) ? 1.f : 0.f;
#pragma unroll
                    for (int j = 14; j >= 0; --j) { float acc = 0.f;
#pragma unroll
                        for (int i = 15; i > j; --i) acc += Tr[i] * __builtin_bit_cast(float, __builtin_amdgcn_readlane(abi[j & 3], i + 16 * (j >> 2)));
                        Tr[j] = (j < kl) ? acc : Tr[j]; }
                    STE(12); STB(13);
                    float tsel[4];
#pragma unroll
                    for (int e = 0; e < 4; ++e) tsel[e] = g == 0 ? Tr[e] : (g == 1 ? Tr[4 + e] : (g == 2 ? Tr[8 + e] : Tr[12 + e]));
                    v2u tf2; tf2.x = pk2(tsel[0], tsel[1]); tf2.y = pk2(tsel[2], tsel[3]);
                    const bf16x8 Tf = mk8(tf2, Z2), RBf = mk8(cvt4(RBt), Z2);
                    f32x4 AhT[4], QhT[4], Ah[4], rin[4]; bf16x8 Alo[4];
#pragma unroll
                    for (int ct = 0; ct < 4; ++ct) { Alo[ct] = mk8(trd(A0 + sw16(4 * g + q_, 2 * ct + (p_ >> 1)) + (p_ & 1) * 8), Z2);
                        const v2u rw = *(const LAS v2u*)(A0 + 6144 + sw16(kl, 2 * ct + (g >> 1)) + (g & 1) * 8);
                        rin[ct] = (f32x4){bflo(rw.x), bfhi(rw.x), bflo(rw.y), bfhi(rw.y)}; }
#pragma unroll
                    for (int ct = 0; ct < 4; ++ct) { AhT[ct] = __builtin_amdgcn_mfma_f32_16x16x32_bf16(Alo[ct], Tf, Z4, 0, 0, 0);
                        Ah[ct] = __builtin_amdgcn_mfma_f32_16x16x32_bf16(Tf, Alo[ct], Z4, 0, 0, 0); }
#pragma unroll
                    for (int ct = 0; ct < 4; ++ct) QhT[ct] = __builtin_amdgcn_mfma_f32_16x16x32_bf16(mk8(cvt4(Ah[ct]), Z2), RBf, rin[ct], 0, 0, 0);
                    STE(13); STB(14);
                    LAS unsigned char* fr = lds + FR + q * 7168 + lane * 16;
                    *(LAS bf16x8*)(fr) = mk8(cvt4(AhT[0]), cvt4(AhT[1])); *(LAS bf16x8*)(fr + 1024) = mk8(cvt4(AhT[2]), cvt4(AhT[3]));
                    *(LAS bf16x8*)(fr + 2048) = mk8(cvt4(QhT[0]), cvt4(QhT[1])); *(LAS bf16x8*)(fr + 3072) = mk8(cvt4(QhT[2]), cvt4(QhT[3]));
                    *(LAS bf16x8*)(fr + 4096) = mk8(cvt4(AKt), Z2); *(LAS bf16x8*)(fr + 5120) = mk8(cvt4(RBt), cvt4(RKt)); *(LAS bf16x8*)(fr + 6144) = Tf;
                    STE(14);
                    __builtin_amdgcn_s_setprio(0);
                }
                STE(8); STE(10);
                __syncthreads();
                STE(5); STB(6);
                lane = opq(lane0); c = lane; kl = lane & 15; g = lane >> 4; q_ = kl >> 2; p_ = kl & 3;
                if (wv >= 4) { BGC_WINDOW(); if (grp + 1 < ngrp) CSC_PREFETCH(grp + 1); }
                if (wv < 4) { __builtin_amdgcn_s_setprio(3); const int vt = opqs(wv);
#pragma unroll 1
                    for (int q = 0; q < 4; ++q) { const LAS unsigned char* A0 = lds + ARR + q * (7 * 2048); const LAS unsigned char* fr = lds + FR + q * 7168 + lane * 16;
                        const bf16x8 Ap0 = *(const LAS bf16x8*)(fr), Ap1 = *(const LAS bf16x8*)(fr + 1024), Qp0 = *(const LAS bf16x8*)(fr + 2048), Qp1 = *(const LAS bf16x8*)(fr + 3072);
                        const bf16x8 AKf = *(const LAS bf16x8*)(fr + 4096), RBRK = *(const LAS bf16x8*)(fr + 5120), Tf = *(const LAS bf16x8*)(fr + 6144);
                        const v2u vtr = trd(A0 + 12288 + sw16(4 * g + q_, 2 * vt + (p_ >> 1)) + (p_ & 1) * 8);
                        bf16x8 bk[4]; f32x4 wl[4];
#pragma unroll
                        for (int ct = 0; ct < 4; ++ct) { wl[ct] = *(const LAS f32x4*)(lds + WLO + (q * 64 + 16 * ct + 4 * g) * 4); const int o = sw16(4 * g + q_, 2 * ct + (p_ >> 1)) + (p_ & 1) * 8; bk[ct] = mk8(trd(A0 + 2048 + o), trd(A0 + 4096 + o)); }
                        const f32x4 X1 = __builtin_amdgcn_mfma_f32_16x16x32_bf16(AKf, mk8(vtr, Z2), Z4, 0, 0, 0);
                        const f32x4 Uh = __builtin_amdgcn_mfma_f32_16x16x32_bf16(Tf, mk8(cvt4(X1), Z2), Z4, 0, 0, 0);
                        const f32x4 Yh = __builtin_amdgcn_mfma_f32_16x16x32_bf16(RBRK, mk8(cvt4(Uh), vtr), Z4, 0, 0, 0);
                        const bf16x8 bs0 = mk8(cvt4(St[0]), cvt4(St[1])), bs1 = mk8(cvt4(St[2]), cvt4(St[3]));
                        f32x4 U = __builtin_amdgcn_mfma_f32_16x16x32_bf16(Ap0, bs0, Uh, 0, 0, 0); U = __builtin_amdgcn_mfma_f32_16x16x32_bf16(Ap1, bs1, U, 0, 0, 0);
                        f32x4 Y = __builtin_amdgcn_mfma_f32_16x16x32_bf16(Qp0, bs0, Yh, 0, 0, 0); Y = __builtin_amdgcn_mfma_f32_16x16x32_bf16(Qp1, bs1, Y, 0, 0, 0);
                        const bf16x8 UV = mk8(cvt4(U), vtr);
#pragma unroll
                        for (int ct = 0; ct < 4; ++ct) St[ct] = __builtin_amdgcn_mfma_f32_16x16x32_bf16(bk[ct], UV, St[ct], 0, 0, 0) * wl[ct];
#pragma unroll
                        for (int j = 0; j < 4; ++j) { const int sg = s0 + 16 * q + 4 * g + j; const int t = d ? (T - 1 - sg) : sg; YD[((size_t)d * NTOK + rowbase + t) * 512 + h * 64 + 16 * vt + kl] = Y[j]; }
                    }
                    __builtin_amdgcn_s_setprio(0);
                }
                __syncthreads();
                STE(6);
            }
#undef CSC_PREFETCH
        }
        if (cpend >= 0) { bgc::finish(a, l, cpend, opq(lane0), wv & 3, lds, cvt_); cpend = -1; }
        for (; cit < bgc::NITEMS; cit += cstride) { bgc::issue(a, l, cit, opq(lane0), cvt_); bgc::finish(a, l, cit, opq(lane0), wv & 3, lds, cvt_); }
#undef BGC_WINDOW
    }
    if (SCAN_STAMP != 0 && blockIdx.x == 0 && tid == ((SCAN_STAMP == 8 || (SCAN_STAMP >= 11 && SCAN_STAMP <= 14)) ? 256 : ((SCAN_STAMP == 10) ? 448 : 0))) atomicAdd((unsigned*)(a.ws() + WS_CTL) + 2000, tacc_);
}
constexpr int PH_PER_LAYER = 11, N_PHASES = 1 + 2 * PH_PER_LAYER;
template <int K> __device__ __forceinline__ void run_phase(LAS unsigned char* lds, int l) {
    if constexpr (K == 0) phase_prologue(lds);
    if constexpr (K == 1) phase_modconv(lds, l);
    if constexpr (K == 3) phase_scan(lds, l);
    if constexpr (K == 4) phase_attn(lds, l);
    if constexpr (K == 5) phase_rwpost(lds, l);
    if constexpr (K == 7) { if (l == 0) phase_ln1_route<false>(lds, l); else phase_ln1_route<true>(lds, l); }
    if constexpr (K == 8) phase_gather(lds, l);
    if constexpr (K == 11) phase_ln2(lds, l);
    if constexpr (K == 2 || K == 6 || K == 9 || K == 10) {
        const KA a = ka_get(); unsigned char* ws = a.ws(); const int G = gridDim.x, bid = blockIdx.x;
        bf16* X1 = (bf16*)(ws + WS_X1); bf16* X2 = (bf16*)(ws + WS_X2); bf16* X3 = (bf16*)(ws + WS_X3);
        if constexpr (K == 2) { __syncthreads();
            pg8::Gemm g{X1, (const bf16*)(ws + WS_WINT) + (size_t)l * DINP * DM, NTOK, DINP, DM}; pg8::StaticOrder S; S.init(NTOK, DINP, G, bid);
            pg8::EpiBf16 E{X2, DINP}; pg8::gemm_phase<pg8::EpiBf16, pg8::StaticOrder, true, true>(lds, g, S, E); }
        if constexpr (K == 6) { __syncthreads();
            const int Mrows = (l == 0) ? NTOK : NTX;
            pg8::Gemm g{X1, (const bf16*)(ws + WS_WOT) + (size_t)l * DM * DM, Mrows, DM, DM}; pg8::StaticOrder S; S.init(Mrows, DM, G, bid);
            pg8::EpiBf16 E{X3, DM}; pg8::gemm_phase<pg8::EpiBf16, pg8::StaticOrder, true, true>(lds, g, S, E); }
        if constexpr (K == 9) { moe_tables<false>(lds, l);
            pg8::Gemm g{X2, (const bf16*)(ws + WS_W13T), MAXSLOT, 1024, DM}; pg8::MoeOrder S; S.init((const LAS int*)(lds + PREF_OFF), 4, G, bid);
            pg8::EpiSwiGLU E{X3, DEXP}; pg8::gemm_phase<pg8::EpiSwiGLU, pg8::MoeOrder, true, true>(lds, g, S, E); }
        if constexpr (K == 10) { moe_tables<false>(lds, l);
            pg8::Gemm g{X3, (const bf16*)(ws + WS_W2T), MAXSLOT, 1024, DEXP}; pg8::MoeOrder S; S.init((const LAS int*)(lds + PREF_OFF), 4, G, bid);
            pg8::EpiBf16 E{X2, DM}; pg8::gemm_phase<pg8::EpiBf16, pg8::MoeOrder, true, true>(lds, g, S, E); }
    }
}
__device__ __forceinline__ void grid_sync(LAS unsigned char* lds) {
    const KA a = ka_get(); XcdBarrier b; b.bar = (unsigned*)(a.ws() + WS_CTL) + CW_BAR; b.x = xb_xcc_id(); b.st = (volatile LAS unsigned*)(lds + MISC_OFF) + 8; xcd_barrier(b);
#ifdef PROBE_BAR
    xcd_barrier(b);
#endif
}
#ifndef ONE_LAUNCH
template <int K> __global__ void __launch_bounds__(512, 2) fwd_ph(Args args) {
    extern __shared__ __attribute__((aligned(16))) unsigned char lds_raw[];
    LAS unsigned char* lds = (LAS unsigned char*)lds_raw;
    for (int u = threadIdx.x; u < (LDS_BYTES - LDSCTL_OFF) / 4; u += 512) ((LAS unsigned*)(lds + LDSCTL_OFF))[u] = 0u;
    __syncthreads();
    hw_tid_init();
    __syncthreads();
    run_phase<K>(lds, args.ph_lo);
}
template <int K> static void launch_ph(const Args& a, int grid, hipStream_t stream) {
    static bool attr = false;
    if (!attr) { (void)hipFuncSetAttribute((const void*)fwd_ph<K>, hipFuncAttributeMaxDynamicSharedMemorySize, LDS_BYTES); attr = true; }
    hipLaunchKernelGGL(fwd_ph<K>, dim3(grid), dim3(512), LDS_BYTES, stream, a);
}
#else
__global__ void __launch_bounds__(512, 2) fwd(Args args) {
    extern __shared__ __attribute__((aligned(16))) unsigned char lds_raw[];
    LAS unsigned char* lds = (LAS unsigned char*)lds_raw;
    for (int u = threadIdx.x; u < (LDS_BYTES - LDSCTL_OFF) / 4; u += 512) ((LAS unsigned*)(lds + LDSCTL_OFF))[u] = 0u;
    __syncthreads();
    hw_tid_init();
    __syncthreads();
    (void)xcd_barrier_post((unsigned*)(args.ws + WS_CTL) + CW_BAR, (volatile LAS unsigned*)(lds + MISC_OFF) + 8);
    run_phase<0>(lds, 0);
#ifdef PROBE_P0
    __syncthreads(); run_phase<0>(lds, 0);
#endif
    grid_sync(lds);
#ifndef PROBE_REP
#define PROBE_REP -1
#endif
#define RUNP(K) do { run_phase<K>(lds, l); if (PROBE_REP == K) { __syncthreads(); run_phase<K>(lds, l); } } while (0)
    for (int l = 0; l < 2; ++l) {
        if (l == 0) { RUNP(1); grid_sync(lds); }
        RUNP(2); grid_sync(lds);
        RUNP(3);
        RUNP(4); grid_sync(lds);
        RUNP(5); grid_sync(lds);
        RUNP(6); grid_sync(lds);
        run_phase<7>(lds, l); if (PROBE_REP == 7 && l == 0) { __syncthreads(); run_phase<7>(lds, l); } grid_sync(lds);
        RUNP(8); grid_sync(lds);
        RUNP(9); grid_sync(lds);
        RUNP(10); grid_sync(lds);
        RUNP(11); if (l == 0) grid_sync(lds);
    }
#if defined(SCAN_STAMP) && SCAN_STAMP != 0
    if (blockIdx.x == 0 && hw_tid() == 0) { const unsigned long long tk = __hip_atomic_load((unsigned*)(args.ws + WS_CTL) + 2000, __ATOMIC_RELAXED, __HIP_MEMORY_SCOPE_AGENT); const unsigned long long ts = __builtin_amdgcn_s_memrealtime(); while (__builtin_amdgcn_s_memrealtime() - ts < tk) __builtin_amdgcn_s_sleep(8); }
#endif
}
#endif

extern "C" void kernel_launch(void* const* d_in, const int* in_sizes, int n_in, void* d_out, int out_size, void* d_ws, size_t ws_size, hipStream_t stream) {
    static int grid = 0;
    if (grid == 0) {
        if (n_in != 30 || in_sizes[0] != NTX * DM || out_size != NTX * DM || ws_size < WS_END) {
            fprintf(stderr, "kernel_launch: unexpected problem (n_in %d, in0 %d, out %d, ws %zu < %zu?); nothing launched\n", n_in, n_in > 0 ? in_sizes[0] : -1, out_size, ws_size, (size_t)WS_END); grid = -1; return; }
        int dev = 0, cus = 0;
        if (hipGetDevice(&dev) != hipSuccess || hipDeviceGetAttribute(&cus, hipDeviceAttributeMultiprocessorCount, dev) != hipSuccess) { grid = -1; return; }
#ifdef ONE_LAUNCH
        if (hipFuncSetAttribute((const void*)fwd, hipFuncAttributeMaxDynamicSharedMemorySize, LDS_BYTES) != hipSuccess) { fprintf(stderr, "kernel_launch: hipFuncSetAttribute failed\n"); grid = -1; return; }
#endif
        (void)hipGetLastError();
        grid = cus > 0 ? cus : 256;
        if (grid != 256 && grid != 128) { fprintf(stderr, "kernel_launch: %d CUs: the LN1/LN2 row maps need 128 or 256 workgroups\n", grid); grid = -1; return; }
    }
    if (grid < 0) return;
    if (hipMemsetAsync((char*)d_ws + WS_CTL, 0, CTL_ZERO_BYTES, stream) != hipSuccess) return;
    Args a{};
    for (int i = 0; i < 30; ++i) a.in[i] = (const float*)d_in[i];
    a.out = (float*)d_out; a.ws = (unsigned char*)d_ws; a.ph_lo = 0; a.ph_hi = 0;
#ifndef ONE_LAUNCH
    launch_ph<0>(a, grid, stream);
    for (int l = 0; l < 2; ++l) { a.ph_lo = l;
        launch_ph<1>(a, grid, stream); launch_ph<2>(a, grid, stream); launch_ph<3>(a, grid, stream); launch_ph<4>(a, grid, stream); launch_ph<5>(a, grid, stream); launch_ph<6>(a, grid, stream);
        launch_ph<7>(a, grid, stream); launch_ph<8>(a, grid, stream); launch_ph<9>(a, grid, stream); launch_ph<10>(a, grid, stream); launch_ph<11>(a, grid, stream); }
#else
    hipLaunchKernelGGL(fwd, dim3(grid), dim3(512), LDS_BYTES, stream, a);
#endif
}
```

```cpp
#define ONE_LAUNCH 1
#include <hip/hip_runtime.h>
#include <cstdio>
#include <cstdint>

constexpr int DM = 1024, NB = 16, SEQ = 2048, CTXL = 256, NTX = NB * SEQ, NTC = NB * CTXL, NTOK = NTX + NTC;
constexpr int DIN = 3296, DINP = 3328, RWOFF = 1536, NHEAD = 8, HD = 64;
constexpr int NEXP = 32, DEXP = 512, LISTCAP = 2 * NTOK;
constexpr int MAXSLOT = 81920;
constexpr float ALPHA = 1.41421356237309515f, LN_EPS = 1e-6f, GN_EPS = 64e-5f;

constexpr size_t MiB = 1u << 20;
constexpr size_t WS_CTL = 0, CTL_ZERO_BYTES = 1 * MiB;
constexpr size_t WS_MODS = 1 * MiB;
constexpr size_t WS_ROPE = 2 * MiB;
constexpr size_t WS_WINT = 3 * MiB;
constexpr size_t WS_WOT = 16 * MiB;
constexpr size_t WS_W13T = 20 * MiB;
constexpr size_t WS_W2T = 84 * MiB;
constexpr size_t WS_LIST = 116 * MiB;
constexpr size_t WS_TOK = 125 * MiB;
constexpr size_t WS_BONUS = 127 * MiB;
constexpr size_t WS_CS = 130 * MiB;
constexpr size_t WS_X1 = 146 * MiB;
constexpr size_t WS_X2 = 218 * MiB;
constexpr size_t WS_XP = WS_X2 + 160 * MiB;
constexpr size_t WS_X3 = 452 * MiB;
constexpr size_t WS_END = 596 * MiB;
static_assert(WS_WINT + (size_t)2 * DINP * DM * 2 <= WS_WOT && WS_LIST + (size_t)NEXP * LISTCAP * 4 <= WS_TOK && WS_TOK + (size_t)NTOK * 32 <= WS_BONUS, "ws map");
static_assert(WS_BONUS + (size_t)2 * NTOK * 8 * 4 <= WS_CS && WS_X2 + (size_t)NTOK * DINP * 2 <= WS_X3 && WS_X3 + (size_t)2 * NTOK * 512 * 4 <= WS_END, "ws map");
static_assert((size_t)MAXSLOT * 1024 * 2 <= WS_XP - WS_X2 && WS_XP + (size_t)NTOK * DM * 2 <= WS_X3 && (size_t)MAXSLOT * 512 * 2 <= WS_END - WS_X3, "ws map");
constexpr int CW_BAR = 4096;
constexpr int CW_CNT = 8192;
constexpr int RING_BYTES = 131072, LDSCTL_OFF = RING_BYTES, MISC_OFF = LDSCTL_OFF + 320, LDS_BYTES = 147456;
constexpr int PREF_OFF = LDSCTL_OFF + 512;

#define GAS __attribute__((address_space(1)))
#define LAS __attribute__((address_space(3)))
typedef unsigned short bf16;
typedef unsigned v4u __attribute__((ext_vector_type(4)));
typedef unsigned v2u __attribute__((ext_vector_type(2)));
typedef float f32x4 __attribute__((ext_vector_type(4)));
typedef short bf16x8 __attribute__((ext_vector_type(8)));
typedef GAS unsigned gu32;
#define RLX_AGENT __ATOMIC_RELAXED, __HIP_MEMORY_SCOPE_AGENT
#define LDS_WAIT() asm volatile("s_waitcnt lgkmcnt(0)" ::: "memory")
#define VM_WAIT() asm volatile("s_waitcnt vmcnt(0)" ::: "memory")
__device__ __forceinline__ unsigned f2bf(float f) { unsigned u = __builtin_bit_cast(unsigned, f); return (u + 0x7fffu + ((u >> 16) & 1u)) >> 16; }
typedef float f32x2_t_ __attribute__((ext_vector_type(2))); typedef __bf16 bf16x2_t_ __attribute__((ext_vector_type(2)));
__device__ __forceinline__ unsigned pk2(float lo, float hi) { f32x2_t_ v = {lo, hi}; bf16x2_t_ b = __builtin_convertvector(v, bf16x2_t_); return __builtin_bit_cast(unsigned, b); }
__device__ __forceinline__ unsigned short f2bf1(float f) { return (unsigned short)(pk2(f, 0.f) & 0xffffu); }
__device__ __forceinline__ float bf2f(unsigned short v) { return __builtin_bit_cast(float, (unsigned)v << 16); }
__device__ __forceinline__ float bflo(unsigned w) { return __builtin_bit_cast(float, w << 16); }
__device__ __forceinline__ float bfhi(unsigned w) { return __builtin_bit_cast(float, w & 0xffff0000u); }
__device__ __forceinline__ float sigmoidf_(float x) { return 1.0f / (1.0f + expf(-x)); }
__device__ __forceinline__ float shx(float v, int k, int lane) { return __builtin_bit_cast(float, __builtin_amdgcn_ds_bpermute((lane ^ k) << 2, __builtin_bit_cast(int, v))); }
__device__ __forceinline__ float shi(float v, int src) { return __builtin_bit_cast(float, __builtin_amdgcn_ds_bpermute(src << 2, __builtin_bit_cast(int, v))); }
template <int CTRL> __device__ __forceinline__ float dppmov(float v) { return __builtin_bit_cast(float, __builtin_amdgcn_update_dpp(0, __builtin_bit_cast(int, v), CTRL, 0xF, 0xF, true)); }
__device__ __forceinline__ float wave_sum(float v) {
    v += dppmov<0xB1>(v); v += dppmov<0x4E>(v); v += dppmov<0x141>(v); v += dppmov<0x140>(v);
    const int iv = __builtin_bit_cast(int, v);
    return (__builtin_bit_cast(float, __builtin_amdgcn_readlane(iv, 0)) + __builtin_bit_cast(float, __builtin_amdgcn_readlane(iv, 16))) + (__builtin_bit_cast(float, __builtin_amdgcn_readlane(iv, 32)) + __builtin_bit_cast(float, __builtin_amdgcn_readlane(iv, 48)));
}
__device__ __forceinline__ float red8(float v) { v += dppmov<0xB1>(v); v += dppmov<0x4E>(v); v += dppmov<0x141>(v); return v; }

struct TokInfo { int e0, e1, p0, p1; float g0, g1; int pad0, pad1; };

constexpr int WID_OFF = LDSCTL_OFF + 1536;
__device__ __forceinline__ int hw_slot() { return (int)__builtin_amdgcn_s_getreg((5 << 11) | 4) & 63; }
__device__ __forceinline__ int lane_id() { int l; asm volatile("v_mbcnt_lo_u32_b32 %0, -1, 0\n\tv_mbcnt_hi_u32_b32 %0, -1, %0" : "=v"(l)); return l; }
__device__ __forceinline__ void hw_tid_init() { *(volatile LAS int*)(uintptr_t)(WID_OFF + 4 * hw_slot()) = (int)(threadIdx.x >> 6); }
__device__ __forceinline__ int hw_tid() { const int w = *(volatile LAS int*)(uintptr_t)(WID_OFF + 4 * hw_slot()); int t = (__builtin_amdgcn_readfirstlane(w) << 6) | lane_id(); asm volatile("" : "+v"(t)); return t; }
namespace pg8 {
#define PG8_LAS __attribute__((address_space(3)))
typedef unsigned short bf16_t;
typedef short bf16x8 __attribute__((ext_vector_type(8)));
typedef float f32x4 __attribute__((ext_vector_type(4)));
typedef unsigned u32x4 __attribute__((ext_vector_type(4)));
constexpr int BM = 256, BK = 64, HALF = 128, HTB = HALF * BK * 2  , STAGE_BYTES = 8 * HTB, NXCD = 8, WGM = 8;

__host__ __device__ __forceinline__ int lds_byte(int r, int c) { const int st = (r >> 4) * 2 + (c >> 5), rr = r & 15, cc = c & 31, ob = rr * 64 + cc * 2; return st * 1024 + (ob ^ (((ob >> 9) & 1) << 5)); }
__host__ __device__ __forceinline__ void stage_rc(int b, int& R, int& C) { const int st = b / 1024, sb = b % 1024, swz = sb ^ (((sb >> 9) & 1) << 5); R = (st >> 1) * 16 + swz / 64; C = (st & 1) * 32 + (swz % 64) / 2; }
__host__ __device__ __forceinline__ int perm32(int rho) { const int n = rho >> 4, i = rho & 15; return 8 * (i >> 2) + 4 * n + (i & 3); }

struct Unit { int pm, pn, pnb; };
struct Gemm { const bf16_t* A; const bf16_t* Bt; int M, N, K; };

struct StaticOrder {
    int nM, nN, nwg, G, c;
    __host__ __device__ void init(int M, int N, int G_, int c_) { nM = M / BM; nN = N / BM; nwg = nM * nN; G = G_; c = c_; }
    __host__ __device__ bool next(int i, Unit& u) const {
        const long L = (long)i * G + c; if (L >= nwg) return false;
        int wgid = (int)L; { const int q = nwg / NXCD, r = nwg % NXCD, xcd = wgid % NXCD, off = wgid / NXCD; wgid = (xcd < r ? xcd * (q + 1) : r * (q + 1) + (xcd - r) * q) + off; }
        const int nig = WGM * nN, gid = wgid / nig, fm = gid * WGM, gsz = (nM - fm) < WGM ? (nM - fm) : WGM;
        u.pm = fm + ((wgid % nig) % gsz); u.pn = (wgid % nig) / gsz; u.pnb = u.pn; return true;
    }
    __device__ __forceinline__ void a_ready(const Unit&) const {}
    __device__ __forceinline__ void done(const Unit&) const {}
};

__device__ __forceinline__ unsigned cvt_pk_bf16(float lo, float hi) { unsigned r; asm volatile("v_cvt_pk_bf16_f32 %0, %1, %2" : "=v"(r) : "v"(lo), "v"(hi)); return r; }
template <class Epi, class Sched, bool ALIGN_EPI = false, bool SP2 = false>
__device__ __forceinline__ void gemm_phase(PG8_LAS unsigned char* lds, const Gemm g, const Sched& S, const Epi& E) {
    const int tid = hw_tid(), wid = __builtin_amdgcn_readfirstlane(tid >> 6), lane = tid & 63, wr = wid >> 2, wc = wid & 3, fr = lane & 15, fq = lane >> 4;
    const int K = g.K, nt = K / BK;
    unsigned voffA[2], voffB[2];
#pragma unroll
    for (int i = 0; i < 2; ++i) { int R, C; stage_rc(tid * 16 + i * 8192, R, C); const int Rb = Epi::PERM ? ((R & ~31) + perm32(R & 31)) : R;
        voffA[i] = (unsigned)(R * K + C) * 2u; voffB[i] = (unsigned)(Rb * K + C) * 2u; }
    const size_t kstep = (size_t)(BK * 2);
    const size_t hstep = (size_t)HALF * K * 2;
    const size_t tstep = 2 * hstep;
    const unsigned ldsw = (unsigned)wid * 1024u;
    const int aoff = lds_byte(wr * 64 + fr, fq * 8), boff = lds_byte(wc * 32 + fr, fq * 8);
#define PG8_SA(b, h) (((b) * 2 + (h)) * HTB)
#define PG8_SB(b, h) ((4 + (b) * 2 + (h)) * HTB)
#define PG8_STAGE(bufoff, gbase, voff) do { _Pragma("unroll") for (int _i = 0; _i < 2; ++_i) \
        __builtin_amdgcn_global_load_lds((const unsigned*)((const char*)(gbase) + (voff)[_i]), (PG8_LAS unsigned*)(lds + (bufoff) + ldsw + _i * 8192), 16, 0, 0); } while (0)
#define PG8_LDA(dst, b, h) do { _Pragma("unroll") for (int m = 0; m < 4; ++m) _Pragma("unroll") for (int k = 0; k < 2; ++k) dst[m][k] = *(const PG8_LAS bf16x8*)(lds + PG8_SA(b, h) + aoff + m * 2048 + k * 1024); } while (0)
#define PG8_LDB(dst, b, h) do { _Pragma("unroll") for (int n = 0; n < 2; ++n) _Pragma("unroll") for (int k = 0; k < 2; ++k) dst[n][k] = *(const PG8_LAS bf16x8*)(lds + PG8_SB(b, h) + boff + n * 2048 + k * 1024); } while (0)
#define PG8_MMA(ai, bj, At, Bt) do { __builtin_amdgcn_s_setprio(1); _Pragma("unroll") for (int m = 0; m < 4; ++m) _Pragma("unroll") for (int n = 0; n < 2; ++n) _Pragma("unroll") for (int k = 0; k < 2; ++k) \
        acc[ai][bj][m][n] = __builtin_amdgcn_mfma_f32_16x16x32_bf16(Bt[n][k], At[m][k], acc[ai][bj][m][n], 0, 0, 0); __builtin_amdgcn_s_setprio(0); } while (0)
#define PG8_WAIT_V(n) asm volatile("s_waitcnt vmcnt(" #n ")" ::: "memory")
#define PG8_WAIT_L(n) asm volatile("s_waitcnt lgkmcnt(" #n ")" ::: "memory")
#define PG8_BAR __builtin_amdgcn_s_barrier()
#define PG8_SCHED __builtin_amdgcn_sched_barrier(0)
    Unit cur, nxt; int ui = 0;
    if (!S.next(0, cur)) return;
    f32x4 acc[2][2][4][2];
#pragma unroll
    for (int a = 0; a < 2; ++a)
#pragma unroll
        for (int b = 0; b < 2; ++b)
#pragma unroll
            for (int m = 0; m < 4; ++m)
#pragma unroll
                for (int n = 0; n < 2; ++n) acc[a][b][m][n] = (f32x4){0.f, 0.f, 0.f, 0.f};
    bf16x8 At[4][2], B0[2][2], B1[2][2];
    const char* cA = (const char*)g.A + (size_t)cur.pm * tstep; const char* cB = (const char*)g.Bt + (size_t)cur.pnb * tstep;
    S.a_ready(cur);
    if constexpr (SP2) {
        PG8_STAGE(PG8_SB(0, 0), cB, voffB); PG8_STAGE(PG8_SB(0, 1), cB + hstep, voffB); PG8_STAGE(PG8_SA(0, 0), cA, voffA); PG8_STAGE(PG8_SA(0, 1), cA + hstep, voffA);
        if (wr == 1) PG8_BAR;
        PG8_WAIT_V(2); PG8_BAR;
        PG8_STAGE(PG8_SB(1, 0), cB + kstep, voffB); PG8_STAGE(PG8_SA(1, 0), cA + kstep, voffA); PG8_STAGE(PG8_SB(1, 1), cB + hstep + kstep, voffB);
        PG8_WAIT_V(6); PG8_BAR;
    } else {
        PG8_STAGE(PG8_SB(0, 0), cB, voffB); PG8_STAGE(PG8_SA(0, 0), cA, voffA); PG8_STAGE(PG8_SB(0, 1), cB + hstep, voffB); PG8_STAGE(PG8_SA(0, 1), cA + hstep, voffA);
        if (wr == 1) PG8_BAR;
        PG8_WAIT_V(4); PG8_BAR;
        PG8_STAGE(PG8_SB(1, 0), cB + kstep, voffB); PG8_STAGE(PG8_SA(1, 0), cA + kstep, voffA); PG8_STAGE(PG8_SB(1, 1), cB + hstep + kstep, voffB);
        PG8_WAIT_V(6); PG8_BAR;
    }
    for (;;) {
        const bool has_next = S.next(ui + 1, nxt);
        const char* nA = has_next ? (const char*)g.A + (size_t)nxt.pm * tstep : cA; const char* nB = has_next ? (const char*)g.Bt + (size_t)nxt.pnb * tstep : cB;
        for (int t = 0; t < nt; t += 2) {
            const bool last = (t == nt - 2);
            const char* a1 = cA + (size_t)(t + 1) * kstep;
            const char* a2 = last ? nA : cA + (size_t)(t + 2) * kstep; const char* b2 = last ? nB : cB + (size_t)(t + 2) * kstep;
            const char* a3 = a2 + kstep; const char* b3 = b2 + kstep;
            if (last && has_next) S.a_ready(nxt);
            if constexpr (SP2) {
            PG8_LDB(B0, 0, 0); PG8_LDB(B1, 0, 1); PG8_SCHED; PG8_LDA(At, 0, 0); PG8_STAGE(PG8_SA(1, 1), a1 + hstep, voffA);
            PG8_WAIT_V(8); PG8_WAIT_L(0); PG8_BAR; PG8_MMA(0, 0, At, B0); PG8_MMA(0, 1, At, B1); PG8_BAR; PG8_SCHED;
            PG8_LDA(At, 0, 1); PG8_STAGE(PG8_SB(0, 0), b2, voffB); PG8_STAGE(PG8_SB(0, 1), b2 + hstep, voffB); PG8_STAGE(PG8_SA(0, 0), a2, voffA);
            PG8_WAIT_V(8); PG8_WAIT_L(0); PG8_BAR; PG8_MMA(1, 0, At, B0); PG8_MMA(1, 1, At, B1); PG8_BAR; PG8_SCHED;
            PG8_LDB(B0, 1, 0); PG8_LDB(B1, 1, 1); PG8_SCHED; PG8_LDA(At, 1, 0); PG8_STAGE(PG8_SA(0, 1), a2 + hstep, voffA);
            PG8_WAIT_V(8); PG8_WAIT_L(0); PG8_BAR; PG8_MMA(0, 0, At, B0); PG8_MMA(0, 1, At, B1); PG8_BAR; PG8_SCHED;
            PG8_LDA(At, 1, 1); PG8_STAGE(PG8_SB(1, 0), b3, voffB); PG8_STAGE(PG8_SB(1, 1), b3 + hstep, voffB); PG8_STAGE(PG8_SA(1, 0), a3, voffA);
            PG8_WAIT_V(8); PG8_WAIT_L(0); PG8_BAR; PG8_MMA(1, 0, At, B0); PG8_MMA(1, 1, At, B1); PG8_BAR; PG8_SCHED;
            } else {
            PG8_LDB(B0, 0, 0); PG8_SCHED; PG8_LDA(At, 0, 0); PG8_STAGE(PG8_SA(1, 1), a1 + hstep, voffA);
            PG8_WAIT_L(8); PG8_BAR; PG8_WAIT_L(0); PG8_MMA(0, 0, At, B0); PG8_BAR; PG8_SCHED;
            PG8_LDB(B1, 0, 1); PG8_STAGE(PG8_SB(0, 0), b2, voffB);
            PG8_BAR; PG8_WAIT_L(0); PG8_MMA(0, 1, At, B1); PG8_BAR;
            PG8_LDA(At, 0, 1); PG8_STAGE(PG8_SA(0, 0), a2, voffA);
            PG8_BAR; PG8_WAIT_L(0); PG8_MMA(1, 0, At, B0); PG8_BAR; PG8_SCHED;
            PG8_STAGE(PG8_SB(0, 1), b2 + hstep, voffB);
            PG8_WAIT_V(6); PG8_BAR; PG8_MMA(1, 1, At, B1); PG8_BAR;
            PG8_LDB(B0, 1, 0); PG8_SCHED; PG8_LDA(At, 1, 0); PG8_STAGE(PG8_SA(0, 1), a2 + hstep, voffA);
            PG8_WAIT_L(8); PG8_BAR; PG8_WAIT_L(0); PG8_MMA(0, 0, At, B0); PG8_BAR; PG8_SCHED;
            PG8_LDB(B1, 1, 1); PG8_STAGE(PG8_SB(1, 0), b3, voffB);
            PG8_BAR; PG8_WAIT_L(0); PG8_MMA(0, 1, At, B1); PG8_BAR;
            PG8_LDA(At, 1, 1); PG8_STAGE(PG8_SA(1, 0), a3, voffA);
            PG8_BAR; PG8_WAIT_L(0); PG8_MMA(1, 0, At, B0); PG8_BAR; PG8_SCHED;
            PG8_STAGE(PG8_SB(1, 1), b3 + hstep, voffB);
            PG8_WAIT_V(6); PG8_BAR; PG8_MMA(1, 1, At, B1); PG8_BAR;
            }
        }
        if constexpr (ALIGN_EPI) { if (wr == 0) PG8_BAR; }
        if constexpr (!Epi::AFTER_DRAIN) { E(acc, cur, wr, wc, fr, fq); S.done(cur); }
        if (!has_next) break;
#pragma unroll
        for (int a = 0; a < 2; ++a)
#pragma unroll
            for (int b = 0; b < 2; ++b)
#pragma unroll
                for (int m = 0; m < 4; ++m)
#pragma unroll
                    for (int n = 0; n < 2; ++n) acc[a][b][m][n] = (f32x4){0.f, 0.f, 0.f, 0.f};
        cur = nxt; cA = nA; cB = nB; ++ui;
        if constexpr (ALIGN_EPI) { if (wr == 1) PG8_BAR; }
    }
    PG8_WAIT_V(0);
    if constexpr (!ALIGN_EPI) { if (wr == 0) PG8_BAR; }
    PG8_BAR;
    if constexpr (Epi::AFTER_DRAIN) { E.fused(acc, cur, wr, wc, fr, fq, lds, wid, lane); S.done(cur); }
#undef PG8_SA
#undef PG8_SB
#undef PG8_STAGE
#undef PG8_LDA
#undef PG8_LDB
#undef PG8_MMA
#undef PG8_WAIT_V
#undef PG8_WAIT_L
#undef PG8_BAR
#undef PG8_SCHED
}
}
namespace pg8 {
struct EpiBf16 {
    static constexpr bool PERM = true, AFTER_DRAIN = false;
    bf16_t* O; int ldc;
    __device__ __forceinline__ void operator()(const f32x4 (&acc)[2][2][4][2], const Unit& u, int wr, int wc, int fr, int fq) const {
        const int row0 = u.pm * BM + wr * 64 + fr; const int col0 = u.pn * BM + wc * 32 + 8 * fq;
#pragma unroll
        for (int ai = 0; ai < 2; ++ai)
#pragma unroll
            for (int m = 0; m < 4; ++m) { bf16_t* rowp = O + (size_t)(row0 + ai * HALF + m * 16) * ldc + col0;
#pragma unroll
                for (int bj = 0; bj < 2; ++bj) { const f32x4 v0 = acc[ai][bj][m][0], v1 = acc[ai][bj][m][1];
                    u32x4 w; w.x = cvt_pk_bf16(v0[0], v0[1]); w.y = cvt_pk_bf16(v0[2], v0[3]); w.z = cvt_pk_bf16(v1[0], v1[1]); w.w = cvt_pk_bf16(v1[2], v1[3]);
                    *(u32x4*)(rowp + bj * HALF) = w; } }
    }
};
struct EpiSwiGLU {
    static constexpr bool PERM = true, AFTER_DRAIN = false;
    bf16_t* O; int ldc;
    __device__ __forceinline__ void operator()(const f32x4 (&acc)[2][2][4][2], const Unit& u, int wr, int wc, int fr, int fq) const {
        const int row0 = u.pm * BM + wr * 64 + fr; const int col0 = u.pn * HALF + wc * 32 + 8 * fq;
#pragma unroll
        for (int ai = 0; ai < 2; ++ai)
#pragma unroll
            for (int m = 0; m < 4; ++m) { bf16_t* rowp = O + (size_t)(row0 + ai * HALF + m * 16) * ldc + col0;
                float r[8];
#pragma unroll
                for (int n = 0; n < 2; ++n)
#pragma unroll
                    for (int j = 0; j < 4; ++j) { const float a = acc[ai][0][m][n][j], b = acc[ai][1][m][n][j]; r[n * 4 + j] = a * b * __builtin_amdgcn_rcpf(1.0f + __expf(-a)); }
                u32x4 w; w.x = cvt_pk_bf16(r[0], r[1]); w.y = cvt_pk_bf16(r[2], r[3]); w.z = cvt_pk_bf16(r[4], r[5]); w.w = cvt_pk_bf16(r[6], r[7]);
                *(u32x4*)rowp = w; }
    }
};
struct MoeOrder {
    const PG8_LAS int* pref; int nN, G, c, total;
    __device__ __forceinline__ void init(const PG8_LAS int* pref_, int nN_, int G_, int c_) { pref = pref_; nN = nN_; G = G_; c = c_; total = pref_[32] * nN_; }
    __device__ __forceinline__ bool next(int i, Unit& u) const {
        const int L = i * G + c; if (L >= total) return false;
        const int rt = L / nN, pn = L - rt * nN; int e = 0;
#pragma unroll 1
        for (int k = 1; k < 32; ++k) e += (pref[k] <= rt) ? 1 : 0;
        u.pm = rt; u.pn = pn; u.pnb = e * nN + pn; return true;
    }
    __device__ __forceinline__ void a_ready(const Unit&) const {}
    __device__ __forceinline__ void done(const Unit&) const {}
};
}
#define XB_TMO      128
#define XB_XCNT(j)  (256  + 64 * (j))
#define XB_XSUB(j)  (1280 + 64 * (j))
#define XB_XGEN(j)  (2304 + 64 * (j))
#define XB_TOP      3328
#define XB_TOPGEN   3392
#define XCD_BAR_WORDS 3456
#define XB_SPIN_CAP (1u << 22)

__device__ __forceinline__ unsigned xb_ld(unsigned* p)              { return __hip_atomic_load(p, __ATOMIC_RELAXED, __HIP_MEMORY_SCOPE_AGENT); }
__device__ __forceinline__ unsigned xb_add(unsigned* p, unsigned v) { return __hip_atomic_fetch_add(p, v, __ATOMIC_RELAXED, __HIP_MEMORY_SCOPE_AGENT); }
__device__ __forceinline__ unsigned xb_xcc_id() { return (unsigned)__builtin_amdgcn_s_getreg((3 << 11) | 20) & 0xFu; }
#define XB_SPIN(cond, bar) do { unsigned _sp = 0; while (cond) { __builtin_amdgcn_s_sleep(1); \
    if ((++_sp & 255u) == 0u) { if (xb_ld(&(bar)[XB_TMO])) break; if (_sp > XB_SPIN_CAP) { atomicAdd(&(bar)[XB_TMO], 1u); break; } } } } while (0)

struct XcdBarrier {
    unsigned* bar; unsigned x;
    volatile LAS unsigned* st;
};

__device__ __forceinline__ XcdBarrier xcd_barrier_post(unsigned* bar, volatile LAS unsigned* st) {
    XcdBarrier b; b.bar = bar; b.x = xb_xcc_id(); b.st = st;
    if (hw_tid() == 0) (void)xb_add(&bar[XB_XCNT(b.x)], 1u);
    return b;
}
__device__ __forceinline__ void xcd_barrier_complete(unsigned* bar, unsigned x, unsigned& nloc, unsigned& nx) {
    const unsigned G = gridDim.x * gridDim.y * gridDim.z;
    unsigned sum, cnt, mine, sp = 0u;
    for (;;) {
        sum = 0u; cnt = 0u; mine = 0u;
#pragma unroll
        for (unsigned j = 0; j < 16; ++j) { const unsigned c = xb_ld(&bar[XB_XCNT(j)]); sum += c; cnt += (c > 0u) ? 1u : 0u; mine = (j == x) ? c : mine; }
        if (sum == G) break;
        __builtin_amdgcn_s_sleep(1);
        if ((++sp & 255u) == 0u) { if (xb_ld(&bar[XB_TMO])) break; if (sp > XB_SPIN_CAP) { atomicAdd(&bar[XB_TMO], 1u); break; } }
    }
    nloc = mine > 0u ? mine : 1u; nx = cnt > 0u ? cnt : 1u;
}

__device__ __forceinline__ void xcd_barrier(const XcdBarrier& b) {
    asm volatile("s_waitcnt vmcnt(0)" ::: "memory");
    __syncthreads();
    if (hw_tid() == 0) {
        unsigned* bar = b.bar;
        __builtin_amdgcn_s_waitcnt(0);
        unsigned nloc = b.st[0], nx = b.st[1];
        if (nloc == 0u) { xcd_barrier_complete(bar, b.x, nloc, nx); b.st[0] = nloc; b.st[1] = nx; }
        const unsigned old = xb_add(&bar[XB_XSUB(b.x)], 1u);
        const unsigned gen = old / nloc;
        if (old + 1u == (gen + 1u) * nloc) {
            __builtin_amdgcn_fence(__ATOMIC_RELEASE, "agent");
            asm volatile("s_waitcnt vmcnt(0)" ::: "memory");
            const unsigned og = xb_add(&bar[XB_TOP], 1u);
            const unsigned tg = og / nx;
            if (og + 1u == (tg + 1u) * nx) xb_add(&bar[XB_TOPGEN], 1u);
            else XB_SPIN(xb_ld(&bar[XB_TOPGEN]) == tg, bar);
            __builtin_amdgcn_fence(__ATOMIC_ACQUIRE, "agent");
            xb_add(&bar[XB_XGEN(b.x)], 1u);
            asm volatile("s_waitcnt vmcnt(0)" ::: "memory");
        } else {
            XB_SPIN(xb_ld(&bar[XB_XGEN(b.x)]) == gen, bar);
            __builtin_amdgcn_fence(__ATOMIC_ACQUIRE, "agent");
            asm volatile("s_waitcnt vmcnt(0)" ::: "memory");
        }
    }
    __syncthreads();
}
struct Args { const float* in[30]; float* out; unsigned char* ws; int ph_lo, ph_hi; };
#define CAS __attribute__((address_space(4)))
struct KA { const CAS unsigned char* kp;
    __device__ __forceinline__ const float* in(int i) const { return *(const float* const CAS*)(kp + 8 * i); }
    __device__ __forceinline__ float* out() const { return *(float* const CAS*)(kp + 240); }
    __device__ __forceinline__ unsigned char* ws() const { return *(unsigned char* const CAS*)(kp + 248); } };
__device__ __forceinline__ KA ka_get() { const CAS unsigned char* kp = (const CAS unsigned char*)__builtin_amdgcn_kernarg_segment_ptr(); asm volatile("" : "+s"(kp)); return KA{kp}; }
__device__ __forceinline__ int opaque_tid() { return hw_tid(); }
static_assert(sizeof(Args) == 264, "kernarg layout");
enum { I_X = 0, I_C, I_CTX, I_CCTX, I_ADAW, I_ADAB, I_WIN, I_RPB, I_MUP, I_MUN, I_W0, I_W2, I_A0, I_A2, I_G2, I_KK, I_KA, I_RK, I_GNG, I_GNB, I_WOUT, I_LN1G, I_LN1B, I_LN2G, I_LN2B, I_RW, I_RB, I_EW1, I_EW3, I_EW2 };

__device__ __forceinline__ void transpose_item(const float* W, int N, int k0, int n0, bf16* WT, int ldk, int drow0, LAS float* scr, int lane) {
#pragma unroll 8
    for (int i = 0; i < 32; ++i) { const int kk = 2 * i + (lane >> 5); scr[kk * 33 + (lane & 31)] = W[(size_t)(k0 + kk) * N + n0 + (lane & 31)]; }
    LDS_WAIT(); asm volatile("" ::: "memory");
    const int c = lane & 7;
#pragma unroll
    for (int j = 0; j < 4; ++j) { const int n = (lane >> 3) + 8 * j; const LAS float* s = scr + (8 * c) * 33 + n;
        v4u o; o.x = pk2(s[0 * 33], s[1 * 33]); o.y = pk2(s[2 * 33], s[3 * 33]); o.z = pk2(s[4 * 33], s[5 * 33]); o.w = pk2(s[6 * 33], s[7 * 33]);
        *(GAS v4u*)(WT + (size_t)(drow0 + n) * ldk + k0 + 8 * c) = o; }
    LDS_WAIT(); asm volatile("" ::: "memory");
}

__device__ __forceinline__ void phase_prologue(LAS unsigned char* lds) {
    const KA a = ka_get();
    const int tid = opaque_tid(), lane = tid & 63, wave = __builtin_amdgcn_readfirstlane(tid >> 6), G = gridDim.x, bid = blockIdx.x;
    const int gw = bid * 8 + wave, NGW = G * 8;
    bf16* WINT = (bf16*)(a.ws() + WS_WINT); bf16* WOT = (bf16*)(a.ws() + WS_WOT);
    LAS float* scr = (LAS float*)(lds + wave * 16384);
    constexpr int I_IN = 16 * 103, I_OUT = 16 * 32, I_L = I_IN + I_OUT;
    for (int it = gw; it < 2 * I_L; it += NGW) {
        const int l = it / I_L; int r = it - l * I_L;
        if (r < I_IN) { const int kb = r / 103, nb = r - kb * 103; transpose_item(a.in(I_WIN) + (size_t)l * DM * DIN, DIN, 64 * kb, 32 * nb, WINT + (size_t)l * DINP * DM, DM, 32 * nb, scr, lane); }
        else { r -= I_IN; const int kb = r >> 5, nb = r & 31; transpose_item(a.in(I_WOUT) + (size_t)l * DM * DM, DM, 64 * kb, 32 * nb, WOT + (size_t)l * DM * DM, DM, 32 * nb, scr, lane); }
    }
    for (int i = bid * 512 + tid; i < 8192; i += G * 512) { const int l = i >> 12, r = i & 4095; *(GAS v4u*)(WINT + (size_t)l * DINP * DM + (size_t)DIN * DM + (size_t)r * 8) = (v4u){0u, 0u, 0u, 0u}; }
    { float* rp = (float*)(a.ws() + WS_ROPE); const int i = bid * 512 + tid;
      if (i < 1536) { const int idx = i < 512 ? i : i - 512; const int p = idx >> 4, f = idx & 15; const double inv = exp(-(double)f * (9.210340371976184 / 16.0)); const double ang = (double)p * inv;
          const float cs = (float)cos(ang), sn = (float)sin(ang); if (i < 512) { rp[idx] = cs; rp[512 + idx] = sn; } else { rp[1024 + idx] = cs; rp[2048 + idx] = sn; } } }
    __syncthreads();
    LAS float* sl = (LAS float*)lds; LAS float* red = (LAS float*)(lds + 69632);
    for (int i = tid; i < 17 * 1024; i += 512) { const int r = i >> 10, k = i & 1023; const float v = r < 16 ? a.in(I_C)[r * 1024 + k] : a.in(I_CCTX)[k]; sl[i] = v / (1.0f + expf(-v)); }
    __syncthreads();
    float* mods = (float*)(a.ws() + WS_MODS);
    for (int it = bid; it < 192; it += G) {
        const int l = it / 96, ch = it - l * 96; const int kq = tid >> 6, cl = tid & 63, col = ch * 64 + cl;
        const float* W = a.in(I_ADAW) + (size_t)l * DM * 6144 + col;
        float acc[17];
#pragma unroll
        for (int r = 0; r < 17; ++r) acc[r] = 0.f;
        for (int k0 = kq * 128; k0 < kq * 128 + 128; k0 += 8) { float w8[8];
#pragma unroll
            for (int q = 0; q < 8; ++q) w8[q] = W[(size_t)(k0 + q) * 6144];
#pragma unroll
            for (int r = 0; r < 17; ++r) { const f32x4 s0 = *(const LAS f32x4*)(sl + r * 1024 + k0), s1 = *(const LAS f32x4*)(sl + r * 1024 + k0 + 4);
                acc[r] += s0.x * w8[0] + s0.y * w8[1] + s0.z * w8[2] + s0.w * w8[3] + s1.x * w8[4] + s1.y * w8[5] + s1.z * w8[6] + s1.w * w8[7]; } }
#pragma unroll
        for (int r = 0; r < 17; ++r) red[(kq * 17 + r) * 64 + cl] = acc[r];
        __syncthreads();
        for (int i = tid; i < 17 * 64; i += 512) { const int r = i >> 6, c2 = i & 63; float s = 0.f;
#pragma unroll
            for (int q = 0; q < 8; ++q) s += red[(q * 17 + r) * 64 + c2];
            mods[((size_t)l * 17 + r) * 6144 + ch * 64 + c2] = s + a.in(I_ADAB)[l * 6144 + ch * 64 + c2]; }
        __syncthreads();
    }
}

__device__ __forceinline__ void phase_modconv(LAS unsigned char* lds, int l) {
    const KA a = ka_get();
    const int tid = opaque_tid(), lane = tid & 63, wave = __builtin_amdgcn_readfirstlane(tid >> 6), G = gridDim.x, bid = blockIdx.x;
    const int gw = bid * 8 + wave, NGW = G * 8;
    const float* mods = (const float*)(a.ws() + WS_MODS) + (size_t)l * 17 * 6144;
    bf16* XM = (bf16*)(a.ws() + WS_X1);
    const float* xs = a.in(I_X); const float* cs = a.in(I_CTX);
    for (int m = gw; m < NTOK; m += NGW) {
        const float* src; int mr;
        if (m < NTX) { src = xs + (size_t)m * DM; mr = m / SEQ; } else { src = cs + (size_t)(m - NTX) * DM; mr = 16; }
        const GAS f32x4* xr = (const GAS f32x4*)src + lane; const GAS f32x4* sh = (const GAS f32x4*)(mods + (size_t)mr * 6144) + lane; const GAS f32x4* sc = sh + 256;
        GAS v2u* o8 = (GAS v2u*)(XM + (size_t)m * DM) + lane;
#pragma unroll
        for (int j = 0; j < 4; ++j) { const f32x4 v = xr[64 * j], s = sh[64 * j], c = sc[64 * j]; const f32x4 r = v * (c + 1.0f) + s; v2u w; w.x = pk2(r.x, r.y); w.y = pk2(r.z, r.w); o8[64 * j] = w; }
    }
}

__device__ __forceinline__ void phase_scan_direct(LAS unsigned char* lds, int l) {
    const KA a = ka_get();
    constexpr int TB = 32;
    const int tid = opaque_tid(), lane = tid & 63, wv = __builtin_amdgcn_readfirstlane(tid >> 6);
    LAS float* ops = (LAS float*)lds;
    LAS float* scal = (LAS float*)(lds + 49152);
    LAS float* zl = (LAS float*)(lds + 49664);
    LAS float* rkraw = (LAS float*)(lds + 57856);
    LAS float* ybuf = (LAS float*)(lds + 74240);
    const bf16* PX = (const bf16*)(a.ws() + WS_X2); float* YD = (float*)(a.ws() + WS_X3); float* BON = (float*)(a.ws() + WS_BONUS); const float* rope = (const float*)(a.ws() + WS_ROPE);
    const float* mup = a.in(I_MUP) + l * 1760; const float* mun = a.in(I_MUN) + l * 1760;
    for (int chain = blockIdx.x; chain < 256; chain += gridDim.x) {
        const int b = chain >> 4, h = (chain >> 1) & 7, d = chain & 1, c = lane;
        float w2c[32], a2c[32];
#pragma unroll
        for (int j = 0; j < 32; ++j) { w2c[j] = a.in(I_W2)[((size_t)(l * 2 + d) * 32 + j) * 512 + h * 64 + c]; a2c[j] = a.in(I_A2)[((size_t)(l * 2 + d) * 32 + j) * 512 + h * 64 + c]; }
        const float w0c = a.in(I_W0)[(l * 2 + d) * 512 + h * 64 + c], a0c = a.in(I_A0)[(l * 2 + d) * 512 + h * 64 + c];
        const float kkc = a.in(I_KK)[l * 512 + h * 64 + c], kac = a.in(I_KA)[l * 512 + h * 64 + c], rkc = a.in(I_RK)[l * 512 + h * 64 + c];
        const int colr = h * 64 + c, colk = 512 + colr, colv = 1024 + colr, coll = (c < 32) ? (1536 + d * 32 + c) : (1600 + d * 32 + (c - 32));
        const float mpr = mup[colr], mnr = mun[colr], mpk = mup[colk], mnk = mun[colk], mpv = mup[colv], mnv = mun[colv], mpl = mup[coll], mnl = mun[coll];
        float S[8];
#pragma unroll
        for (int j = 0; j < 8; ++j) S[j] = 0.f;
        const int vl = lane >> 3, kq = lane & 7, vrow = 8 * wv + vl;
        for (int seq = 0; seq < 2; ++seq) {
            const int T = seq ? SEQ : CTXL, rowbase = seq ? b * SEQ : NTX + b * CTXL, nblk = T / TB;
            for (int bi = 0; bi < nblk; ++bi) {
                const int tb = d ? (nblk - 1 - bi) : bi, t0 = tb * TB;
                float zv[4];
#pragma unroll
                for (int i = 0; i < 4; ++i) {
                    const int tl = wv + 8 * i, t = t0 + tl; const bf16* p = PX + (size_t)(rowbase + t) * DINP + RWOFF;
                    const bool hp = t > 0, hn = t + 1 < T;
                    const float cr = bf2f(p[colr]), ck = bf2f(p[colk]), cv = bf2f(p[colv]), cl_ = bf2f(p[coll]);
                    const float pr = hp ? bf2f(p[colr - DINP]) : 0.f, pk = hp ? bf2f(p[colk - DINP]) : 0.f, pv = hp ? bf2f(p[colv - DINP]) : 0.f, pl = hp ? bf2f(p[coll - DINP]) : 0.f;
                    const float nr = hn ? bf2f(p[colr + DINP]) : 0.f, nk = hn ? bf2f(p[colk + DINP]) : 0.f, nv = hn ? bf2f(p[colv + DINP]) : 0.f, nl = hn ? bf2f(p[coll + DINP]) : 0.f;
                    const float zr = cr + mpr * (pr - cr) + mnr * (nr - cr), zk = ck + mpk * (pk - ck) + mnk * (nk - ck);
                    zv[i] = cv + mpv * (pv - cv) + mnv * (nv - cv);
                    const float zz = cl_ + mpl * (pl - cl_) + mnl * (nl - cl_);
                    rkraw[tl * 128 + c] = zr; rkraw[tl * 128 + 64 + c] = zk; zl[tl * 64 + c] = (c < 32) ? tanhf(zz) : zz;
                }
                __syncthreads();
#pragma unroll
                for (int i = 0; i < 4; ++i) {
                    const int tl = wv + 8 * i, t = t0 + tl;
                    float r = rkraw[tl * 128 + c], k = rkraw[tl * 128 + 64 + c];
                    if (seq) { const float rp = rkraw[tl * 128 + (c ^ 16)], kp = rkraw[tl * 128 + 64 + (c ^ 16)]; const int qd = c >> 4, f = c & 15;
                        const int ti = (qd < 2) ? ((t >> 6) * 16 + f) : (1024 + (t & 63) * 16 + f); const float cs = rope[ti], sn = rope[ti + ((qd < 2) ? 512 : 1024)];
                        const float sg = (qd & 1) ? sn : -sn; r = r * cs + rp * sg; k = k * cs + kp * sg; }
                    const float kkr = k * kkc; const float ss = wave_sum(kkr * kkr); const float kk = kkr / fmaxf(sqrtf(ss), 1e-12f);
                    float u = w0c, av = a0c;
#pragma unroll
                    for (int j = 0; j < 32; j += 4) { const f32x4 z1 = *(const LAS f32x4*)(zl + tl * 64 + j), z2 = *(const LAS f32x4*)(zl + tl * 64 + 32 + j);
                        u += z1.x * w2c[j] + z1.y * w2c[j + 1] + z1.z * w2c[j + 2] + z1.w * w2c[j + 3]; av += z2.x * a2c[j] + z2.y * a2c[j + 1] + z2.z * a2c[j + 2] + z2.w * a2c[j + 3]; }
                    const float w = expf(-0.6065306597126334f * sigmoidf_(u)), aa = sigmoidf_(av);
                    const float kd = k * (1.0f + (aa - 1.0f) * kac), nb = -kk * aa;
                    const float c1 = wave_sum(nb * r), c2 = wave_sum(kd * r), bon = wave_sum(r * kd * rkc);
                    LAS float* o = ops + tl * 384 + c; o[0] = kk; o[64] = w * r; o[128] = w; o[192] = nb; o[256] = kd; o[320] = zv[i];
                    if (lane == 0) { scal[tl * 4] = c1; scal[tl * 4 + 1] = c2; BON[((size_t)d * NTOK + rowbase + t) * 8 + h] = bon; }
                }
                __syncthreads();
#pragma unroll 2
                for (int s = 0; s < TB; ++s) {
                    const int tl = d ? (TB - 1 - s) : s; const LAS float* o = ops + tl * 384 + kq * 8;
                    const f32x4 ka = *(const LAS f32x4*)(o), kb = *(const LAS f32x4*)(o + 4), ra = *(const LAS f32x4*)(o + 64), rb = *(const LAS f32x4*)(o + 68);
                    const f32x4 wa = *(const LAS f32x4*)(o + 128), wb = *(const LAS f32x4*)(o + 132), na = *(const LAS f32x4*)(o + 192), nb_ = *(const LAS f32x4*)(o + 196);
                    const f32x4 da = *(const LAS f32x4*)(o + 256), db = *(const LAS f32x4*)(o + 260);
                    const float vv = ops[tl * 384 + 320 + vrow], c1 = scal[tl * 4], c2 = scal[tl * 4 + 1];
                    float sk = S[0] * ka.x + S[1] * ka.y + S[2] * ka.z + S[3] * ka.w + S[4] * kb.x + S[5] * kb.y + S[6] * kb.z + S[7] * kb.w;
                    float yy = S[0] * ra.x + S[1] * ra.y + S[2] * ra.z + S[3] * ra.w + S[4] * rb.x + S[5] * rb.y + S[6] * rb.z + S[7] * rb.w;
                    sk = red8(sk); yy = red8(yy);
                    const float y = yy + sk * c1 + vv * c2;
                    S[0] = S[0] * wa.x + sk * na.x + vv * da.x; S[1] = S[1] * wa.y + sk * na.y + vv * da.y; S[2] = S[2] * wa.z + sk * na.z + vv * da.z; S[3] = S[3] * wa.w + sk * na.w + vv * da.w;
                    S[4] = S[4] * wb.x + sk * nb_.x + vv * db.x; S[5] = S[5] * wb.y + sk * nb_.y + vv * db.y; S[6] = S[6] * wb.z + sk * nb_.z + vv * db.z; S[7] = S[7] * wb.w + sk * nb_.w + vv * db.w;
                    if (kq == 0) ybuf[tl * 64 + vrow] = y;
                }
                __syncthreads();
#pragma unroll
                for (int i = 0; i < 4; ++i) { const int tl = wv + 8 * i; YD[((size_t)d * NTOK + rowbase + t0 + tl) * 512 + h * 64 + c] = ybuf[tl * 64 + c]; }
            }
        }
        __syncthreads();
    }
}

typedef short v4i16_t __attribute__((ext_vector_type(4)));
__device__ __forceinline__ int swz_off(int row, int chunk) { return row * 128 + ((chunk ^ (row & 7)) << 4); }
__device__ __forceinline__ void stage_rows(LAS unsigned char* dst, const bf16* src, int nrows, int tid) {
    for (int idx = tid; idx < nrows * 8; idx += 512) { const int r = idx >> 3, ch = idx & 7; const v4u v = *(const GAS v4u*)(src + (size_t)r * DINP + ch * 8); *(LAS v4u*)(dst + swz_off(r, ch)) = v; }
}
__device__ __forceinline__ bf16x8 q_scale8(bf16x8 q) { const v4u w = __builtin_bit_cast(v4u, q); v4u r;
    r.x = pk2(bflo(w.x) * 0.125f, bfhi(w.x) * 0.125f); r.y = pk2(bflo(w.y) * 0.125f, bfhi(w.y) * 0.125f); r.z = pk2(bflo(w.z) * 0.125f, bfhi(w.z) * 0.125f); r.w = pk2(bflo(w.w) * 0.125f, bfhi(w.w) * 0.125f);
    return __builtin_bit_cast(bf16x8, r); }
struct AttState { float m, l; f32x4 o[4]; };
struct AttOff { int k[2]; int v[4]; int boff; unsigned okm; };
__device__ __forceinline__ AttOff att_offsets(int lane, int wc0, int qc, int cs) { AttOff o; const int kl = lane & 15, g = lane >> 4, q_ = kl >> 2, p_ = kl & 3;
#pragma unroll
    for (int dh = 0; dh < 2; ++dh) o.k[dh] = swz_off(kl, dh * 4 + g);
#pragma unroll
    for (int dt = 0; dt < 4; ++dt) o.v[dt] = swz_off(4 * g + q_, 2 * dt + (p_ >> 1)) + (p_ & 1) * 8;
    o.boff = (wc0 + 4 * g - qc + 15) * 4; o.okm = 0u;
#pragma unroll
    for (int j = 0; j < 8; ++j) { const int kc = wc0 + (j >> 2) * 16 + 4 * g + (j & 3); if ((kc >= cs) && (kc < cs + 16)) o.okm |= 1u << j; }
    return o; }
template <bool LOCAL>
__device__ __forceinline__ void att_kstep(AttState& st, const LAS unsigned char* kb, const LAS unsigned char* vb, int r0, const bf16x8 (&qf)[2], int lane, const AttOff& ao, const LAS float* rpbrow) {
    const LAS unsigned char* kr = kb + r0 * 128; const LAS unsigned char* vr = vb + r0 * 128;
    f32x4 s0 = {0.f, 0.f, 0.f, 0.f}, s1 = {0.f, 0.f, 0.f, 0.f};
#pragma unroll
    for (int dh = 0; dh < 2; ++dh) {
        const bf16x8 k0 = *(const LAS bf16x8*)(kr + ao.k[dh]); const bf16x8 k1 = *(const LAS bf16x8*)(kr + ao.k[dh] + 2048);
        s0 = __builtin_amdgcn_mfma_f32_16x16x32_bf16(k0, qf[dh], s0, 0, 0, 0); s1 = __builtin_amdgcn_mfma_f32_16x16x32_bf16(k1, qf[dh], s1, 0, 0, 0);
    }
    float sc[8];
#pragma unroll
    for (int j = 0; j < 4; ++j) { sc[j] = s0[j]; sc[4 + j] = s1[j]; }
    if (LOCAL) {
        float bv[8]; const unsigned ad = (unsigned)(uintptr_t)rpbrow + (unsigned)ao.boff;
#pragma unroll
        for (int j = 0; j < 8; ++j) asm volatile("ds_read_b32 %0, %1 offset:%2" : "=v"(bv[j]) : "v"(ad), "i"(((j >> 2) * 16 + (j & 3)) * 4));
        asm volatile("s_waitcnt lgkmcnt(0)" : "+v"(bv[0]), "+v"(bv[1]), "+v"(bv[2]), "+v"(bv[3]), "+v"(bv[4]), "+v"(bv[5]), "+v"(bv[6]), "+v"(bv[7]) :: "memory");
#pragma unroll
        for (int j = 0; j < 8; ++j) sc[j] = ((ao.okm >> j) & 1u) ? sc[j] + bv[j] : -INFINITY;
    }
    float mt = fmaxf(fmaxf(fmaxf(sc[0], sc[1]), fmaxf(sc[2], sc[3])), fmaxf(fmaxf(sc[4], sc[5]), fmaxf(sc[6], sc[7])));
    mt = fmaxf(mt, shx(mt, 16, lane)); mt = fmaxf(mt, shx(mt, 32, lane));
    if (__any(mt > st.m)) {
        const float mn = fmaxf(st.m, mt); const float scale = (mn == -INFINITY) ? 1.0f : __expf(st.m - mn); st.l *= scale; st.m = mn;
#pragma unroll
        for (int dt = 0; dt < 4; ++dt) st.o[dt] = st.o[dt] * scale; }
    float p[8], ps = 0.f; const float mref = (st.m == -INFINITY) ? 0.f : st.m;
#pragma unroll
    for (int j = 0; j < 8; ++j) { p[j] = __expf(sc[j] - mref); ps += p[j]; }
    st.l += ps;
    v4u pw; pw.x = pk2(p[0], p[1]); pw.y = pk2(p[2], p[3]); pw.z = pk2(p[4], p[5]); pw.w = pk2(p[6], p[7]);
    const bf16x8 pf = __builtin_bit_cast(bf16x8, pw);
#pragma unroll
    for (int dt = 0; dt < 4; ++dt) {
        const v4i16_t lo = __builtin_amdgcn_ds_read_tr16_b64_v4i16((LAS v4i16_t*)(vr + ao.v[dt]));
        const v4i16_t hi = __builtin_amdgcn_ds_read_tr16_b64_v4i16((LAS v4i16_t*)(vr + ao.v[dt] + 2048));
        const bf16x8 vf = (bf16x8){lo[0], lo[1], lo[2], lo[3], hi[0], hi[1], hi[2], hi[3]};
        st.o[dt] = __builtin_amdgcn_mfma_f32_16x16x32_bf16(vf, pf, st.o[dt], 0, 0, 0);
    }
}
__device__ __forceinline__ void att_merge_store(AttState& st, LAS float* mrg, int qb, int kh, int lane, bf16* orow0  ) {
    LAS float* mine = mrg + qb * (18 * 64) + lane;
    if (kh == 1) { mine[0] = st.m; mine[64] = st.l;
#pragma unroll
        for (int dt = 0; dt < 4; ++dt)
#pragma unroll
            for (int j = 0; j < 4; ++j) mine[(2 + dt * 4 + j) * 64] = st.o[dt][j]; }
    __syncthreads();
    if (kh == 0) {
        const float m1 = mine[0], l1 = mine[64]; const float ms = fmaxf(st.m, m1); const float f0 = __expf(st.m - ms), f1 = __expf(m1 - ms);
        float lc = st.l * f0 + l1 * f1; lc += shx(lc, 16, lane); lc += shx(lc, 32, lane); const float inv = 1.0f / lc;
        const int q = lane & 15, g = lane >> 4;
#pragma unroll
        for (int dt = 0; dt < 4; ++dt) { float r[4];
#pragma unroll
            for (int j = 0; j < 4; ++j) r[j] = (st.o[dt][j] * f0 + mine[(2 + dt * 4 + j) * 64] * f1) * inv;
            v2u w; w.x = pk2(r[0], r[1]); w.y = pk2(r[2], r[3]); *(GAS v2u*)(orow0 + (size_t)q * DM + dt * 16 + 4 * g) = w; }
    }
}
__device__ __forceinline__ void phase_attn(LAS unsigned char* lds, int l) {
    const KA a = ka_get();
    const int tid = opaque_tid(), lane = tid & 63, wv = __builtin_amdgcn_readfirstlane(tid >> 6), qb = wv & 3, kh = wv >> 2;
    LAS unsigned char* KC = lds; LAS unsigned char* VC = lds + 32768; LAS unsigned char* KL = lds + 65536; LAS unsigned char* VL = lds + 98304;
    LAS float* RPB = (LAS float*)(lds + LDSCTL_OFF + 2048); LAS float* mrg = (LAS float*)KL;
    const bf16* PX = (const bf16*)(a.ws() + WS_X2); bf16* CAT = (bf16*)(a.ws() + WS_X1);
    for (int blk = blockIdx.x; blk < 256; blk += gridDim.x) {
        const int bh = blk >> 1, b = bh >> 3, h = bh & 7, half = blk & 1;
        __syncthreads();
        const bf16* ctxrow = PX + (size_t)(NTX + b * CTXL) * DINP + h * 64;
        stage_rows(KC, ctxrow + 512, 256, tid); stage_rows(VC, ctxrow + 1024, 256, tid);
        for (int i = tid; i < 465; i += 512) RPB[i] = a.in(I_RPB)[((size_t)l * 8 + h) * 465 + i];
        __syncthreads();
        const int kl = lane & 15, g = lane >> 4;
        const AttOff ao = att_offsets(lane, min(max(qb * 16 - 8, 0), 32), qb * 16 + kl, min(max(qb * 16 + kl - 8, 0), 48));
        if (l == 0) {
            for (int rr = 0; rr < 2; ++rr) {
                const int q0 = (half * 8 + rr * 4 + qb) * 16; const bf16* qrow = ctxrow + (size_t)(q0 + kl) * DINP;
                bf16x8 qf[2]; qf[0] = q_scale8(*(const GAS bf16x8*)(qrow + 8 * g)); qf[1] = q_scale8(*(const GAS bf16x8*)(qrow + 32 + 8 * g));
                AttState st; st.m = -INFINITY; st.l = 0.f;
#pragma unroll
                for (int dt = 0; dt < 4; ++dt) st.o[dt] = (f32x4){0.f, 0.f, 0.f, 0.f};
                for (int s = 0; s < 4; ++s) att_kstep<false>(st, KC, VC, kh * 128 + s * 32, qf, lane, ao, RPB);
                att_merge_store(st, mrg, qb, kh, lane, CAT + (size_t)(NTX + b * CTXL + q0) * DM + h * 64);
                __syncthreads();
            }
        }
        v4u pfk0[4], pfv0[4], pfk1[4], pfv1[4];
#define ATT_ISSUE(SIDX, pfk, pfv) do { const int i_ = half * 16 + ((SIDX) >> 1); const int rs_ = min(max(i_ - 4, 0), 24); const bf16* lr_ = PX + (size_t)(b * SEQ + (rs_ + 4 * ((SIDX) & 1)) * 64) * DINP + h * 64; \
            _Pragma("unroll") for (int q__ = 0; q__ < 4; ++q__) { const int idx_ = tid + 512 * q__; const bf16* p_ = lr_ + (size_t)(idx_ >> 3) * DINP + (idx_ & 7) * 8; pfk[q__] = *(const GAS v4u*)(p_ + 512); pfv[q__] = *(const GAS v4u*)(p_ + 1024); } } while (0)
        ATT_ISSUE(0, pfk0, pfv0); ATT_ISSUE(1, pfk1, pfv1);
        bf16x8 qn[2]; { const bf16* qrow = PX + (size_t)(b * SEQ + (half * 16) * 64 + qb * 16 + kl) * DINP + h * 64; qn[0] = *(const GAS bf16x8*)(qrow + 8 * g); qn[1] = *(const GAS bf16x8*)(qrow + 32 + 8 * g); }
        for (int ui = 0; ui < 16; ++ui) {
            const int i = half * 16 + ui; const int rs = min(max(i - 4, 0), 24);
            const int qc = qb * 16 + kl, cs = min(max(qc - 8, 0), 48), wc0 = min(max(qb * 16 - 8, 0), 32);
            bf16x8 qf[2]; qf[0] = q_scale8(qn[0]); qf[1] = q_scale8(qn[1]);
            { const int in_ = half * 16 + (ui < 15 ? ui + 1 : ui); const bf16* qrow = PX + (size_t)(b * SEQ + in_ * 64 + qc) * DINP + h * 64; qn[0] = *(const GAS bf16x8*)(qrow + 8 * g); qn[1] = *(const GAS bf16x8*)(qrow + 32 + 8 * g); }
            AttState st; st.m = -INFINITY; st.l = 0.f;
#pragma unroll
            for (int dt = 0; dt < 4; ++dt) st.o[dt] = (f32x4){0.f, 0.f, 0.f, 0.f};
            for (int s = 0; s < 4; ++s) att_kstep<false>(st, KC, VC, kh * 128 + s * 32, qf, lane, ao, RPB);
#define ATT_PASS(pass, pfk, pfv) do { \
                __syncthreads(); \
                _Pragma("unroll") for (int q__ = 0; q__ < 4; ++q__) { const int idx_ = tid + 512 * q__; const int o_ = swz_off(idx_ >> 3, idx_ & 7); *(LAS v4u*)(KL + o_) = pfk[q__]; *(LAS v4u*)(VL + o_) = pfv[q__]; } \
                __syncthreads(); \
                if (ui + 1 < 16) ATT_ISSUE(2 * (ui + 1) + (pass), pfk, pfv); \
                for (int k2 = 0; k2 < 2; ++k2) { const int kr = 2 * kh + k2, arow = rs + 4 * (pass) + kr; \
                    att_kstep<true>(st, KL, VL, kr * 64 + wc0, qf, lane, ao, RPB + (arow - i + 7) * 31); } } while (0)
            ATT_PASS(0, pfk0, pfv0);
            ATT_PASS(1, pfk1, pfv1);
#undef ATT_PASS
            __syncthreads();
            att_merge_store(st, mrg, qb, kh, lane, CAT + (size_t)(b * SEQ + i * 64 + qb * 16) * DM + h * 64);
        }
    }
}

__device__ __forceinline__ void phase_rwpost(LAS unsigned char* lds, int l) {
    const KA a = ka_get();
    const int tid = opaque_tid(), lane = tid & 63, hh = __builtin_amdgcn_readfirstlane(tid >> 6), kl = lane & 15, g = lane >> 4;
    const int er = tid >> 5, cq = tid & 31, c0 = cq * 16, hq = cq >> 2;
    LAS bf16* sig = (LAS bf16*)lds;
    LAS float* Gl = (LAS float*)(lds + 4096);
    const bf16* PX = (const bf16*)(a.ws() + WS_X2); const bf16* YD = (const bf16*)(a.ws() + WS_X3); const float* BON = (const float*)(a.ws() + WS_BONUS); bf16* CAT = (bf16*)(a.ws() + WS_X1);
    const float* mup = a.in(I_MUP) + l * 1760; const float* mun = a.in(I_MUN) + l * 1760; const float* g2 = a.in(I_G2) + (size_t)l * 96 * 512;
    const float* gngp = a.in(I_GNG) + l * 512 + c0; const float* gnbp = a.in(I_GNB) + l * 512 + c0;
    bf16x8 gb[3][4];
#pragma unroll
    for (int ks = 0; ks < 3; ++ks)
#pragma unroll
        for (int nt = 0; nt < 4; ++nt) { v4u w; unsigned t[8];
#pragma unroll
            for (int j = 0; j < 8; ++j) t[j] = f2bf(g2[(size_t)(32 * ks + 8 * g + j) * 512 + 64 * hh + 16 * nt + kl]);
            w.x = t[0] | (t[1] << 16); w.y = t[2] | (t[3] << 16); w.z = t[4] | (t[5] << 16); w.w = t[6] | (t[7] << 16); gb[ks][nt] = __builtin_bit_cast(bf16x8, w); }
    const int nch = (l == 0 ? NTOK : NTX) / 16;
    LAS float* Pl = (LAS float*)(lds + 40960);
    Pl[tid] = mup[1024 + tid]; Pl[512 + tid] = mun[1024 + tid]; Pl[1024 + tid] = a.in(I_GNG)[l * 512 + tid]; Pl[1536 + tid] = a.in(I_GNB)[l * 512 + tid];
    int sr[3], sj[3]; float smp[3], smn[3];
#pragma unroll
    for (int k = 0; k < 3; ++k) { const int idx = tid + 512 * k; sr[k] = idx / 96; sj[k] = idx - sr[k] * 96; smp[k] = mup[1664 + sj[k]]; smn[k] = mun[1664 + sj[k]]; }
    unsigned short rawc[3], rawp[3], rawn[3]; v4u vc[2], vp[2], vn[2], y0[2], y1[2]; float bon0, bon1;
#define RWP_TT(ROW, t_, T_) int t_, T_; if ((ROW) < NTX) { t_ = (ROW) & (SEQ - 1); T_ = SEQ; } else { t_ = ((ROW) - NTX) & (CTXL - 1); T_ = CTXL; }
#define RWP_RAW(CH) do { const int ch_ = (CH) < nch ? (CH) : blockIdx.x; _Pragma("unroll") for (int k = 0; k < 3; ++k) { const int row_ = ch_ * 16 + sr[k]; RWP_TT(row_, t_, T_) \
            const bf16* p_ = PX + (size_t)row_ * DINP + RWOFF + 1664 + sj[k]; rawc[k] = p_[0]; rawp[k] = p_[t_ > 0 ? -DINP : 0]; rawn[k] = p_[t_ + 1 < T_ ? DINP : 0]; } } while (0)
#define RWP_Y(CH) do { const int ch_ = (CH) < nch ? (CH) : blockIdx.x; const int row_ = ch_ * 16 + er; \
        _Pragma("unroll") for (int i = 0; i < 2; ++i) { y0[i] = *(const GAS v4u*)(YD + (size_t)row_ * 512 + c0 + 8 * i); y1[i] = *(const GAS v4u*)(YD + ((size_t)NTOK + row_) * 512 + c0 + 8 * i); } } while (0)
#define RWP_V(CH) do { const int ch_ = (CH) < nch ? (CH) : blockIdx.x; const int row_ = ch_ * 16 + er; RWP_TT(row_, t_, T_) const bf16* pvp_ = PX + (size_t)row_ * DINP + RWOFF + 1024 + c0; const int op_ = t_ > 0 ? -DINP : 0, on_ = t_ + 1 < T_ ? DINP : 0; \
        _Pragma("unroll") for (int i = 0; i < 2; ++i) { vc[i] = *(const GAS v4u*)(pvp_ + 8 * i); vp[i] = *(const GAS v4u*)(pvp_ + op_ + 8 * i); vn[i] = *(const GAS v4u*)(pvp_ + on_ + 8 * i); } \
        bon0 = BON[(size_t)row_ * 8 + hq]; bon1 = BON[((size_t)NTOK + row_) * 8 + hq]; } while (0)
    RWP_RAW(blockIdx.x); RWP_Y(blockIdx.x); RWP_V(blockIdx.x);
    for (int ch = blockIdx.x; ch < nch; ch += gridDim.x) {
        const int row0 = ch * 16;
        __syncthreads();
#pragma unroll
        for (int k = 0; k < 3; ++k) { const int row_ = row0 + sr[k]; RWP_TT(row_, t, T)
            const float cv = bf2f(rawc[k]), pv = bf2f(rawp[k]) * (t > 0 ? 1.f : 0.f), nv = bf2f(rawn[k]) * (t + 1 < T ? 1.f : 0.f);
            const float z = cv + smp[k] * (pv - cv) + smn[k] * (nv - cv); sig[sr[k] * 96 + sj[k]] = f2bf1(sigmoidf_(z)); }
        RWP_RAW(ch + (int)gridDim.x);
        const int row = row0 + er; RWP_TT(row, t, T) const float fp = t > 0 ? 1.f : 0.f, fn = t + 1 < T ? 1.f : 0.f;
        __syncthreads();
        { f32x4 acc[4];
#pragma unroll
          for (int nt = 0; nt < 4; ++nt) acc[nt] = (f32x4){0.f, 0.f, 0.f, 0.f};
#pragma unroll
          for (int ks = 0; ks < 3; ++ks) { const bf16x8 af = *(const LAS bf16x8*)(sig + kl * 96 + 32 * ks + 8 * g);
#pragma unroll
              for (int nt = 0; nt < 4; ++nt) acc[nt] = __builtin_amdgcn_mfma_f32_16x16x32_bf16(af, gb[ks][nt], acc[nt], 0, 0, 0); }
#pragma unroll
          for (int nt = 0; nt < 4; ++nt)
#pragma unroll
              for (int j = 0; j < 4; ++j) Gl[(4 * g + j) * 512 + 64 * hh + 16 * nt + kl] = acc[nt][j]; }
        __syncthreads();
        f32x4 y[4]; float s = 0.f;
#pragma unroll
        for (int i = 0; i < 4; ++i) { const unsigned a0 = y0[i >> 1][(i & 1) * 2], a1 = y0[i >> 1][(i & 1) * 2 + 1], b0 = y1[i >> 1][(i & 1) * 2], b1 = y1[i >> 1][(i & 1) * 2 + 1];
            y[i] = (f32x4){bflo(a0) + bflo(b0), bfhi(a0) + bfhi(b0), bflo(a1) + bflo(b1), bfhi(a1) + bfhi(b1)}; s += (y[i].x + y[i].y) + (y[i].z + y[i].w); }
        RWP_Y(ch + (int)gridDim.x);
        s += dppmov<0xB1>(s); s += dppmov<0x4E>(s); const float mean = s * (1.0f / 64.0f); float q = 0.f;
#pragma unroll
        for (int i = 0; i < 4; ++i) { y[i] = y[i] - mean; q += (y[i].x * y[i].x + y[i].y * y[i].y) + (y[i].z * y[i].z + y[i].w * y[i].w); }
        q += dppmov<0xB1>(q); q += dppmov<0x4E>(q); const float rstd = 1.0f / sqrtf(q * (1.0f / 64.0f) + GN_EPS);
        const float bon = bon0 + bon1;
        unsigned ow[8];
#pragma unroll
        for (int i = 0; i < 4; ++i) { const unsigned cw0 = vc[i >> 1][(i & 1) * 2], cw1 = vc[i >> 1][(i & 1) * 2 + 1], pw0 = vp[i >> 1][(i & 1) * 2], pw1 = vp[i >> 1][(i & 1) * 2 + 1], nw0 = vn[i >> 1][(i & 1) * 2], nw1 = vn[i >> 1][(i & 1) * 2 + 1];
            const f32x4 cv = {bflo(cw0), bfhi(cw0), bflo(cw1), bfhi(cw1)}, pv = {bflo(pw0) * fp, bfhi(pw0) * fp, bflo(pw1) * fp, bfhi(pw1) * fp}, nv = {bflo(nw0) * fn, bfhi(nw0) * fn, bflo(nw1) * fn, bfhi(nw1) * fn};
            const f32x4 mpv = *(const LAS f32x4*)(Pl + c0 + 4 * i), mnv = *(const LAS f32x4*)(Pl + 512 + c0 + 4 * i), gng = *(const LAS f32x4*)(Pl + 1024 + c0 + 4 * i), gnb = *(const LAS f32x4*)(Pl + 1536 + c0 + 4 * i);
            const f32x4 zv = cv + mpv * (pv - cv) + mnv * (nv - cv);
            const f32x4 gt = *(const LAS f32x4*)(Gl + er * 512 + c0 + 4 * i);
            const f32x4 o = (y[i] * rstd * gng + gnb + zv * bon) * gt;
            ow[2 * i] = pk2(o.x, o.y); ow[2 * i + 1] = pk2(o.z, o.w); }
        RWP_V(ch + (int)gridDim.x);
        GAS v4u* dst = (GAS v4u*)(CAT + (size_t)row * DM + 512 + c0); dst[0] = (v4u){ow[0], ow[1], ow[2], ow[3]}; dst[1] = (v4u){ow[4], ow[5], ow[6], ow[7]};
    }
#undef RWP_TT
#undef RWP_RAW
#undef RWP_Y
#undef RWP_V
}

struct RowMap { int WPB, RPWX, RPWC; };
__device__ __forceinline__ RowMap rowmap(int NGW) { RowMap r; r.WPB = NGW / NB; r.RPWX = SEQ / r.WPB; r.RPWC = NTC / NGW; return r; }
__device__ __forceinline__ int route_wave(int m, const RowMap& r) { if (m < NTX) { const int b = m / SEQ, t = m - b * SEQ; return b * r.WPB + t / r.RPWX; } return (m - NTX) / r.RPWC; }
typedef _Float16 f16x8 __attribute__((ext_vector_type(8)));
typedef _Float16 f16x2_ __attribute__((ext_vector_type(2)));
__device__ __forceinline__ unsigned pkh(float a, float b) { f32x2_t_ v = {a, b}; f16x2_ h = __builtin_convertvector(v, f16x2_); return __builtin_bit_cast(unsigned, h); }
__device__ __forceinline__ void split_h(float a, float b, unsigned& hi, unsigned& lo) { hi = pkh(a, b); const f16x2_ hh = __builtin_bit_cast(f16x2_, hi); lo = pkh(a - (float)hh.x, b - (float)hh.y); }
constexpr int LN1_ROWB = 4112, LN1_RED = 67584;
template <bool BFIN> __device__ __forceinline__ void phase_ln1_route(LAS unsigned char* lds, int l) {
    const KA a = ka_get();
    const int tid = opaque_tid(), lane = tid & 63, wave = __builtin_amdgcn_readfirstlane(tid >> 6), G = gridDim.x, bid = blockIdx.x;
    const int gw = bid * 8 + wave, NGW = G * 8;
    if (tid < 32) ((LAS int*)(lds + LDSCTL_OFF + 1024))[tid] = 0;
    f16x8 Wh[2][4], Wl[2][4];
    { const float* RW = a.in(I_RW) + (size_t)(128 * wave + 8 * (lane >> 4)) * 32 + (lane & 15);
#pragma unroll
      for (int nt = 0; nt < 2; ++nt)
#pragma unroll
        for (int ks = 0; ks < 4; ++ks) { unsigned h[4], lo[4];
#pragma unroll
            for (int t = 0; t < 4; ++t) { const float w0 = RW[(32 * ks + 2 * t) * 32 + 16 * nt] * 256.f, w1 = RW[(32 * ks + 2 * t + 1) * 32 + 16 * nt] * 256.f; split_h(w0, w1, h[t], lo[t]); }
            Wh[nt][ks] = __builtin_bit_cast(f16x8, (v4u){h[0], h[1], h[2], h[3]}); Wl[nt][ks] = __builtin_bit_cast(f16x8, (v4u){lo[0], lo[1], lo[2], lo[3]}); } }
    __syncthreads();
    const float* mods = (const float*)(a.ws() + WS_MODS) + (size_t)l * 17 * 6144;
    const bf16* O = (const bf16*)(a.ws() + WS_X3); bf16* HM = (bf16*)(a.ws() + WS_X1);
    const float* xs = a.in(I_X); const float* cs = a.in(I_CTX); const bf16* xb = (const bf16*)a.out(); bf16* XP = (bf16*)(a.ws() + WS_XP);
    int* HIST = (int*)(a.ws() + WS_LIST); TokInfo* TOK = (TokInfo*)(a.ws() + WS_TOK); LAS int* lcnt = (LAS int*)(lds + LDSCTL_OFF + 1024);
    const GAS f32x4* lg = (const GAS f32x4*)(a.in(I_LN1G) + l * DM) + lane; const GAS f32x4* lb = (const GAS f32x4*)(a.in(I_LN1B) + l * DM) + lane;
    const float biasv = a.in(I_RB)[(lane >> 1) & 31];
    f32x4 lgv[4], lbv[4];
#pragma unroll
    for (int j = 0; j < 4; ++j) { lgv[j] = lg[64 * j]; lbv[j] = lb[64 * j]; }
    const RowMap rm = rowmap(NGW);
    const int bx = gw / rm.WPB, xbase = bx * SEQ + (gw - bx * rm.WPB) * rm.RPWX, cbase = NTX + gw * rm.RPWC, nxr = rm.RPWX, ntot = nxr + (BFIN ? 0 : rm.RPWC);
    f32x4 nx[4]; v2u nxb[4], no[4];
#define LN1_ROW(J) ((J) < nxr ? xbase + (J) : cbase + (J) - nxr)
#define LN1_FETCH(J) do { const int jj_ = (J) < ntot ? (J) : ntot - 1; const int m_ = LN1_ROW(jj_); const GAS v2u* or_ = (const GAS v2u*)(O + (size_t)m_ * DM) + lane; \
        if constexpr (BFIN) { const GAS v2u* xr_ = (const GAS v2u*)(xb + (size_t)m_ * DM) + lane; \
            _Pragma("unroll") for (int j_ = 0; j_ < 4; ++j_) { nxb[j_] = xr_[64 * j_]; no[j_] = or_[64 * j_]; } } \
        else { const float* s_ = m_ < NTX ? xs + (size_t)m_ * DM : cs + (size_t)(m_ - NTX) * DM; const GAS f32x4* xr_ = (const GAS f32x4*)s_ + lane; \
            _Pragma("unroll") for (int j_ = 0; j_ < 4; ++j_) { nx[j_] = xr_[64 * j_]; no[j_] = or_[64 * j_]; } } } while (0)
    LN1_FETCH(0);
    const unsigned afrag = (unsigned)((lane & 15) * LN1_ROWB + (128 * wave + 8 * (lane >> 4)) * 2);
    LAS float* red = (LAS float*)(lds + LN1_RED);
    for (int seg = 0; seg < (BFIN ? 1 : 2); ++seg) {
        const int j0 = seg ? nxr : 0, j1 = seg ? ntot : nxr; const int mr = seg ? 16 : bx;
        const GAS f32x4* md = (const GAS f32x4*)(mods + (size_t)mr * 6144) + lane;
        f32x4 sc2[4], sh2[4], gt1[4];
#pragma unroll
        for (int j = 0; j < 4; ++j) { gt1[j] = md[512 + 64 * j]; sc2[j] = md[1024 + 64 * j]; sh2[j] = md[768 + 64 * j]; }
      for (int jb = j0; jb < j1; jb += 2) {
#pragma unroll
        for (int r = 0; r < 2; ++r) {
            const int m = LN1_ROW(jb + r);
            f32x4 v[4]; float s = 0.f;
#pragma unroll
            for (int j = 0; j < 4; ++j) { f32x4 x; if constexpr (BFIN) { const v2u xw = nxb[j]; x = f32x4{bflo(xw.x), bfhi(xw.x), bflo(xw.y), bfhi(xw.y)}; } else x = nx[j];
                const f32x4 gt = gt1[j]; const v2u ow = no[j]; const f32x4 o = {bflo(ow.x), bfhi(ow.x), bflo(ow.y), bfhi(ow.y)};
                v[j] = x * ALPHA + gt * o; s += (v[j].x + v[j].y) + (v[j].z + v[j].w); }
            LN1_FETCH(jb + r + 1);
            const float mean = wave_sum(s) * (1.f / DM); float s2 = 0.f;
#pragma unroll
            for (int j = 0; j < 4; ++j) { v[j] = v[j] - mean; s2 += (v[j].x * v[j].x + v[j].y * v[j].y) + (v[j].z * v[j].z + v[j].w * v[j].w); }
            const float rstd = 1.f / sqrtf(wave_sum(s2) * (1.f / DM) + LN_EPS);
            GAS v2u* dr = (GAS v2u*)(XP + (size_t)m * DM) + lane; GAS v2u* hr = (GAS v2u*)(HM + (size_t)m * DM) + lane;
            const unsigned trow = (unsigned)((2 * wave + r) * LN1_ROWB + 8 * lane);
#pragma unroll
            for (int j = 0; j < 4; ++j) { const f32x4 x1 = v[j] * rstd * lgv[j] + lbv[j]; { v2u xw; xw.x = pk2(x1.x, x1.y); xw.y = pk2(x1.z, x1.w); dr[64 * j] = xw; }
                const f32x4 hm = x1 * (sc2[j] + 1.0f) + sh2[j]; v2u w; w.x = pk2(hm.x, hm.y); w.y = pk2(hm.z, hm.w); hr[64 * j] = w;
                unsigned h0_, l0_, h1_, l1_; split_h(hm.x, hm.y, h0_, l0_); split_h(hm.z, hm.w, h1_, l1_); const v2u hh = {h0_, h1_}, hl = {l0_, l1_};
                *(LAS v2u*)(lds + trow + 512 * j) = hh; *(LAS v2u*)(lds + trow + 2048 + 512 * j) = hl; }
        }
        __syncthreads();
        {
            f32x4 acc0 = {0.f, 0.f, 0.f, 0.f}, acc1 = {0.f, 0.f, 0.f, 0.f};
            f16x8 ah[4], al[4];
#pragma unroll
            for (int ks = 0; ks < 4; ++ks) { ah[ks] = *(const LAS f16x8*)(lds + afrag + 64 * ks); al[ks] = *(const LAS f16x8*)(lds + afrag + 2048 + 64 * ks); }
#pragma unroll
            for (int ks = 0; ks < 4; ++ks) {
                acc0 = __builtin_amdgcn_mfma_f32_16x16x32_f16(al[ks], Wh[0][ks], acc0, 0, 0, 0); acc1 = __builtin_amdgcn_mfma_f32_16x16x32_f16(al[ks], Wh[1][ks], acc1, 0, 0, 0);
                acc0 = __builtin_amdgcn_mfma_f32_16x16x32_f16(ah[ks], Wl[0][ks], acc0, 0, 0, 0); acc1 = __builtin_amdgcn_mfma_f32_16x16x32_f16(ah[ks], Wl[1][ks], acc1, 0, 0, 0);
                acc0 = __builtin_amdgcn_mfma_f32_16x16x32_f16(ah[ks], Wh[0][ks], acc0, 0, 0, 0); acc1 = __builtin_amdgcn_mfma_f32_16x16x32_f16(ah[ks], Wh[1][ks], acc1, 0, 0, 0); }
            LAS float* rw_ = red + (wave * 16 + 4 * (lane >> 4)) * 32 + (lane & 15);
#pragma unroll
            for (int i = 0; i < 4; ++i) { rw_[i * 32] = acc0[i]; rw_[i * 32 + 16] = acc1[i]; }
        }
        __syncthreads();
#pragma unroll 1
        for (int r = 0; r < 2; ++r) {
            const int m = LN1_ROW(jb + r);
            const LAS float* rr = red + (2 * wave + r) * 32 + ((lane >> 1) & 31); float lsum[8];
#pragma unroll
            for (int w = 0; w < 8; ++w) lsum[w] = rr[w * 512];
            const float logit = (((lsum[0] + lsum[1]) + (lsum[2] + lsum[3])) + ((lsum[4] + lsum[5]) + (lsum[6] + lsum[7]))) * (1.f / 256.f);
        const float score = sigmoidf_(logit), sel = score + biasv;
        const int gl = lane & ~7;
        const float q0 = shi(sel, gl), q1 = shi(sel, gl + 2), q2 = shi(sel, gl + 4), q3 = shi(sel, gl + 6);
        const float mx = fmaxf(fmaxf(q0, q1), fmaxf(q2, q3));
        float top2;
        { float a0 = q0, a1 = q1, a2 = q2, a3 = q3; float t;
          if (a0 < a1) { t = a0; a0 = a1; a1 = t; } if (a2 < a3) { t = a2; a2 = a3; a3 = t; } if (a0 < a2) { t = a0; a0 = a2; a2 = t; } if (a1 < a3) { t = a1; a1 = a3; a3 = t; } if (a1 < a2) { t = a1; a1 = a2; a2 = t; }
          top2 = a0 + a1; (void)mx; }
        float best = __builtin_bit_cast(float, __builtin_amdgcn_readlane(__builtin_bit_cast(int, top2), 0)); int gidx = 0;
#pragma unroll
        for (int gg = 1; gg < 8; ++gg) { const float sc = __builtin_bit_cast(float, __builtin_amdgcn_readlane(__builtin_bit_cast(int, top2), gg * 8)); if (sc > best) { best = sc; gidx = gg; } }
        const float r0 = shi(sel, gidx * 8), r1 = shi(sel, gidx * 8 + 2), r2 = shi(sel, gidx * 8 + 4), r3 = shi(sel, gidx * 8 + 6);
        int i0 = 0; float b0 = r0; if (r1 > b0) { b0 = r1; i0 = 1; } if (r2 > b0) { b0 = r2; i0 = 2; } if (r3 > b0) { b0 = r3; i0 = 3; }
        int i1 = -1; float b1 = -INFINITY;
        if (i0 != 0 && r0 > b1) { b1 = r0; i1 = 0; } if (i0 != 1 && r1 > b1) { b1 = r1; i1 = 1; } if (i0 != 2 && r2 > b1) { b1 = r2; i1 = 2; } if (i0 != 3 && r3 > b1) { b1 = r3; i1 = 3; }
        const int e0 = gidx * 4 + i0, e1 = gidx * 4 + i1;
        const float s0 = shi(score, 2 * e0), s1 = shi(score, 2 * e1); const float gs = 1.0f / (s0 + s1);
        if (lane == 0) { const int p0 = __hip_atomic_fetch_add(lcnt + e0, 1, __ATOMIC_RELAXED, __HIP_MEMORY_SCOPE_WORKGROUP), p1_ = __hip_atomic_fetch_add(lcnt + e1, 1, __ATOMIC_RELAXED, __HIP_MEMORY_SCOPE_WORKGROUP);
            TokInfo ti; ti.e0 = e0; ti.e1 = e1; ti.p0 = p0; ti.p1 = p1_; ti.g0 = s0 * gs; ti.g1 = s1 * gs; ti.pad0 = 0; ti.pad1 = 0; TOK[m] = ti; }
        }
      }
    }
    __syncthreads();
    if (tid < 32) HIST[bid * 32 + tid] = lcnt[tid];
}

template <bool FULL> __device__ __forceinline__ void moe_tables(LAS unsigned char* lds, int l) {
    const KA a = ka_get(); const int tid = opaque_tid(), G = gridDim.x;
    LAS int* pref = (LAS int*)(lds + PREF_OFF); LAS int* bb = (LAS int*)lds; LAS int* tot = (LAS int*)(lds + 65536);
    const int* HIST = (const int*)(a.ws() + WS_LIST);
    __syncthreads();
    const int e = tid & 31, grp = tid >> 5;
    int loc[16]; int run = 0;
#pragma unroll
    for (int i = 0; i < 16; ++i) { const int b = grp * 16 + i; loc[i] = (b < G) ? HIST[b * 32 + e] : 0; }
#pragma unroll
    for (int i = 0; i < 16; ++i) { const int v = loc[i]; loc[i] = run; run += v; }
    tot[grp * 32 + e] = run;
    __syncthreads();
    int base = 0, total = 0;
#pragma unroll
    for (int q = 0; q < 16; ++q) { const int v = tot[q * 32 + e]; base += (q < grp) ? v : 0; total += v; }
    if (FULL) {
#pragma unroll
        for (int i = 0; i < 16; ++i) bb[(grp * 16 + i) * 32 + e] = base + loc[i]; }
    if (grp == 0) pref[40 + e] = total;
    __syncthreads();
    if (tid == 0) { int acc = 0; for (int k = 0; k < 32; ++k) { pref[k] = acc; acc += (pref[40 + k] + 255) >> 8; } pref[32] = acc; }
    __syncthreads();
}
__device__ __forceinline__ void phase_gather(LAS unsigned char* lds, int l) {
    const KA a = ka_get();
    const int tid = opaque_tid(), lane = tid & 63, wave = __builtin_amdgcn_readfirstlane(tid >> 6), G = gridDim.x, bid = blockIdx.x;
    const int gw = bid * 8 + wave, NGW = G * 8;
    moe_tables<true>(lds, l);
    const LAS int* pref = (const LAS int*)(lds + PREF_OFF); const LAS int* bb = (const LAS int*)lds;
    const bf16* HM = (const bf16*)(a.ws() + WS_X1); bf16* XB = (bf16*)(a.ws() + WS_X2); const TokInfo* TOK = (const TokInfo*)(a.ws() + WS_TOK);
    const int Mrows = l == 0 ? NTOK : NTX;
    const RowMap rm = rowmap(NGW);
    for (int m = gw; m < Mrows; m += NGW) {
        const TokInfo ti = TOK[m]; const int blk = route_wave(m, rm) >> 3;
        const int sl0 = pref[ti.e0] * 256 + bb[blk * 32 + ti.e0] + ti.p0, sl1 = pref[ti.e1] * 256 + bb[blk * 32 + ti.e1] + ti.p1;
        const GAS v4u* srcp = (const GAS v4u*)(HM + (size_t)m * DM) + lane; const v4u v0 = srcp[0], v1 = srcp[64];
        GAS v4u* d0 = (GAS v4u*)(XB + (size_t)sl0 * DM) + lane; GAS v4u* d1 = (GAS v4u*)(XB + (size_t)sl1 * DM) + lane;
        d0[0] = v0; d0[64] = v1; d1[0] = v0; d1[64] = v1;
    }
    for (int e = 0; e < 32; ++e) {
        const int c = pref[40 + e], npad = ((c + 255) & ~255) - c, r0 = pref[e] * 256 + c;
        for (int r = gw; r < npad; r += NGW) { GAS v4u* dst = (GAS v4u*)(XB + (size_t)(r0 + r) * DM) + lane; dst[0] = (v4u){0u, 0u, 0u, 0u}; dst[64] = (v4u){0u, 0u, 0u, 0u}; }
    }
}

__device__ __forceinline__ void phase_ln2(LAS unsigned char* lds, int l) {
    const KA a = ka_get();
    const int tid = opaque_tid(), lane = tid & 63, wave = __builtin_amdgcn_readfirstlane(tid >> 6), G = gridDim.x, bid = blockIdx.x;
    const int gw = bid * 8 + wave, NGW = G * 8;
    moe_tables<true>(lds, l);
    const LAS int* pref = (const LAS int*)(lds + PREF_OFF); const LAS int* bb = (const LAS int*)lds;
    const float* mods = (const float*)(a.ws() + WS_MODS) + (size_t)l * 17 * 6144;
    const bf16* Y = (const bf16*)(a.ws() + WS_X2); const TokInfo* TOK = (const TokInfo*)(a.ws() + WS_TOK);
    const bf16* XP = (const bf16*)(a.ws() + WS_XP);
    const GAS f32x4* lg = (const GAS f32x4*)(a.in(I_LN2G) + l * DM) + lane; const GAS f32x4* lb = (const GAS f32x4*)(a.in(I_LN2B) + l * DM) + lane;
    const int Mrows = l == 0 ? NTOK : NTX;
    f32x4 lgv[4], lbv[4];
#pragma unroll
    for (int j = 0; j < 4; ++j) { lgv[j] = lg[64 * j]; lbv[j] = lb[64 * j]; }
    const int RPW = (Mrows + NGW - 1) / NGW, m0 = gw * RPW, mend = (m0 + RPW < Mrows) ? m0 + RPW : Mrows, nrows = mend - m0;
    int sl0v = 0, sl1v = 0; float g0v = 0.f, g1v = 0.f;
    if (lane < nrows) { const TokInfo ti = TOK[m0 + lane]; const LAS int* bbw = bb + (route_wave(m0 + lane, rowmap(NGW)) >> 3) * 32;
        sl0v = pref[ti.e0] * 256 + bbw[ti.e0] + ti.p0; sl1v = pref[ti.e1] * 256 + bbw[ti.e1] + ti.p1; g0v = ti.g0; g1v = ti.g1; }
    v2u nxin[4], nain[4], nbin[4];
#define LN2_FETCH(J) do { const int j_ = (J) < nrows ? (J) : (nrows - 1); const int s0_ = __builtin_amdgcn_readlane(sl0v, j_), s1_ = __builtin_amdgcn_readlane(sl1v, j_); \
        const GAS v2u* xr_ = (const GAS v2u*)(XP + (size_t)(m0 + j_) * DM) + lane; const GAS v2u* y0_ = (const GAS v2u*)(Y + (size_t)s0_ * DM) + lane; const GAS v2u* y1_ = (const GAS v2u*)(Y + (size_t)s1_ * DM) + lane; \
        _Pragma("unroll") for (int q_ = 0; q_ < 4; ++q_) { nxin[q_] = xr_[64 * q_]; nain[q_] = y0_[64 * q_]; nbin[q_] = y1_[64 * q_]; } } while (0)
    if (nrows > 0) {
    LN2_FETCH(0);
    for (int jr = 0; jr < nrows; ) {
        const int mseg = m0 + jr; const int mr = mseg < NTX ? mseg / SEQ : 16; int segend = mseg < NTX ? (mr + 1) * SEQ : Mrows; segend = (segend < mend ? segend : mend) - m0;
        const GAS f32x4* md = (const GAS f32x4*)(mods + (size_t)mr * 6144) + lane;
        f32x4 gin[4], msc[4], msh[4];
#pragma unroll
        for (int j = 0; j < 4; ++j) gin[j] = md[1280 + 64 * j];
        if (l == 0) { const GAS f32x4* mn = (const GAS f32x4*)(mods + (size_t)17 * 6144 + (size_t)mr * 6144) + lane;
#pragma unroll
            for (int j = 0; j < 4; ++j) { msc[j] = mn[256 + 64 * j]; msh[j] = mn[64 * j]; } }
      for (; jr < segend; ++jr) {
        const int m = m0 + jr;
        const float tg0 = __builtin_bit_cast(float, __builtin_amdgcn_readlane(__builtin_bit_cast(int, g0v), jr)), tg1 = __builtin_bit_cast(float, __builtin_amdgcn_readlane(__builtin_bit_cast(int, g1v), jr));
        f32x4 v[4]; float s = 0.f;
#pragma unroll
        for (int j = 0; j < 4; ++j) { const v2u xw = nxin[j]; const f32x4 x = {bflo(xw.x), bfhi(xw.x), bflo(xw.y), bfhi(xw.y)}, gt = gin[j]; const v2u a0 = nain[j], a1 = nbin[j];
            const f32x4 ya = {bflo(a0.x), bfhi(a0.x), bflo(a0.y), bfhi(a0.y)}, yb = {bflo(a1.x), bfhi(a1.x), bflo(a1.y), bfhi(a1.y)};
            v[j] = x * ALPHA + gt * (ya * tg0 + yb * tg1); s += (v[j].x + v[j].y) + (v[j].z + v[j].w); }
        LN2_FETCH(jr + 1);
        const float mean = wave_sum(s) * (1.f / DM); float s2 = 0.f;
#pragma unroll
        for (int j = 0; j < 4; ++j) { v[j] = v[j] - mean; s2 += (v[j].x * v[j].x + v[j].y * v[j].y) + (v[j].z * v[j].z + v[j].w * v[j].w); }
        const float rstd = 1.f / sqrtf(wave_sum(s2) * (1.f / DM) + LN_EPS);
        if (l == 0) {
            GAS v2u* o8 = (GAS v2u*)((bf16*)(a.ws() + WS_X1) + (size_t)m * DM) + lane; GAS v2u* xs8 = (GAS v2u*)((bf16*)a.out() + (size_t)(m < NTX ? m : 0) * DM) + lane;
            const bool isx = m < NTX;
#pragma unroll
            for (int j = 0; j < 4; ++j) { const f32x4 xn = v[j] * rstd * lgv[j] + lbv[j]; if (isx) { v2u xw; xw.x = pk2(xn.x, xn.y); xw.y = pk2(xn.z, xn.w); xs8[64 * j] = xw; }
                const f32x4 r = xn * (msc[j] + 1.0f) + msh[j]; v2u w; w.x = pk2(r.x, r.y); w.y = pk2(r.z, r.w); o8[64 * j] = w; }
        } else {
            GAS f32x4* of = (GAS f32x4*)(a.out() + (size_t)m * DM) + lane;
#pragma unroll
            for (int j = 0; j < 4; ++j) of[64 * j] = v[j] * rstd * lgv[j] + lbv[j];
        }
      }
    }
    }
}
namespace csc {
constexpr int ARR = 0;
constexpr int RAW = 0;
constexpr int ZL = 34816;
constexpr int WLO = 57344;
constexpr int FR = 58368;
constexpr int AABT = 87040;
constexpr int LWO = 91136;
constexpr int AAO = 107520;
__device__ __forceinline__ int sw16(int row, int chunk) { return row * 128 + ((chunk ^ (row & 7)) << 4); }
__device__ __forceinline__ v2u cvt4(const f32x4 v) { v2u r; r.x = pk2(v[0], v[1]); r.y = pk2(v[2], v[3]); return r; }
__device__ __forceinline__ bf16x8 mk8(v2u lo, v2u hi) { v4u w; w.x = lo.x; w.y = lo.y; w.z = hi.x; w.w = hi.y; return __builtin_bit_cast(bf16x8, w); }
__device__ __forceinline__ v2u trd(const LAS unsigned char* p) { return __builtin_bit_cast(v2u, __builtin_amdgcn_ds_read_tr16_b64_v4i16((LAS v4i16_t*)p)); }
__device__ __forceinline__ int opq(int v) { asm volatile("" : "+v"(v)); return v; }
__device__ __forceinline__ int opqs(int v) { asm volatile("" : "+s"(v)); return v; }
}
namespace bgc {
constexpr int CBUF = LDSCTL_OFF + 4096, CPITCH = 80, NITEMS = NEXP * 1536;
struct Item { const float* src; bf16* dst; int N, ld; };
__device__ __forceinline__ Item decode(const KA& a, int l, int item) {
    const int e = item / 1536; int r = item - e * 1536; const int m = r >> 9, t = r & 511; const size_t eo = ((size_t)l * NEXP + e) * (size_t)DM * DEXP; Item it;
    if (m < 2) { const int kt = t >> 4, nt = t & 15, j0 = 32 * nt; it.N = DEXP; it.ld = 1024; it.src = (m ? a.in(I_EW3) : a.in(I_EW1)) + eo + (size_t)(32 * kt) * DEXP + j0;
        it.dst = (bf16*)(a.ws() + WS_W13T) + (size_t)e * 1024 * 1024 + (size_t)(256 * (j0 >> 7) + 128 * m + (j0 & 127)) * 1024 + 32 * kt; }
    else { const int kt = t >> 5, nt = t & 31; it.N = DM; it.ld = 512; it.src = a.in(I_EW2) + eo + (size_t)(32 * kt) * DM + 32 * nt; it.dst = (bf16*)(a.ws() + WS_W2T) + (size_t)e * 1024 * 512 + (size_t)(32 * nt) * 512 + 32 * kt; }
    return it; }
__device__ __forceinline__ void issue(const KA& a, int l, int item, int lane, f32x4 (&cv)[4]) { const Item it = decode(a, l, item);
#pragma unroll
    for (int i = 0; i < 4; ++i) cv[i] = *(const GAS f32x4*)(it.src + (size_t)((lane >> 3) + 8 * i) * it.N + (lane & 7) * 4); }
__device__ __forceinline__ void finish(const KA& a, int l, int item, int lane, int slot, LAS unsigned char* lds, const f32x4 (&cv)[4]) { const Item it = decode(a, l, item);
    LAS unsigned char* buf = lds + CBUF + slot * (32 * CPITCH);
#pragma unroll
    for (int i = 0; i < 4; ++i)
#pragma unroll
        for (int u = 0; u < 4; ++u) *(LAS bf16*)(buf + ((lane & 7) * 4 + u) * CPITCH + ((lane >> 3) + 8 * i) * 2) = f2bf1(cv[i][u]);
    LDS_WAIT(); asm volatile("" ::: "memory");
    const int n = lane >> 1, hf = lane & 1; const v4u w0 = *(const LAS v4u*)(buf + n * CPITCH + hf * 32), w1 = *(const LAS v4u*)(buf + n * CPITCH + hf * 32 + 16);
    GAS v4u* d = (GAS v4u*)(it.dst + (size_t)n * it.ld + 16 * hf); d[0] = w0; d[1] = w1;
    LDS_WAIT(); asm volatile("" ::: "memory"); }
}
#ifndef SCAN_STAMP
#define SCAN_STAMP 0
#endif
#define STB(k) do { if (SCAN_STAMP == (k)) t0_ = (unsigned)__builtin_amdgcn_s_memrealtime(); } while (0)
#define STE(k) do { if (SCAN_STAMP == (k)) tacc_ += (unsigned)__builtin_amdgcn_s_memrealtime() - t0_; } while (0)
#ifndef SCAN_PROBE
#define SCAN_PROBE 0
#endif
#define REPK(k) for (int rep_ = 0; rep_ < ((SCAN_PROBE == (k)) ? 2 : 1); ++rep_)
__device__ __forceinline__ void phase_scan(LAS unsigned char* lds, int l) {
    using namespace csc;
    const KA a = ka_get();
    const int tid = opaque_tid(), lane0 = tid & 63, wv = __builtin_amdgcn_readfirstlane(tid >> 6);
    const bf16* PX = (const bf16*)(a.ws() + WS_X2); bf16* YD = (bf16*)(a.ws() + WS_X3); float* BON = (float*)(a.ws() + WS_BONUS);
    const float* mup = a.in(I_MUP) + l * 1760; const float* mun = a.in(I_MUN) + l * 1760;
    const f32x4 Z4 = {0.f, 0.f, 0.f, 0.f}; const v2u Z2 = {0u, 0u};
    unsigned t0_ = 0, tacc_ = 0; (void)t0_;
    for (int chain = blockIdx.x; chain < 256; chain += gridDim.x) {
        const int b = chain >> 4, h = (chain >> 1) & 7, d = chain & 1; const int c0_ = opq(lane0);
        float kkc[2], kac[2], rkc[2], mur[2][2], muk[2][2], muv[2][2], mul[2][2], ropef[2]; bf16x8 w2f[2], a2f[2]; float w0c[2], a0c[2];
        { const int ln = c0_, kl = ln & 15, g = ln >> 4, cp = ln & 31;
#pragma unroll
          for (int u = 0; u < 2; ++u) { const int c = 2 * cp + u; ropef[u] = exp2f(-(float)(c & 15) * (13.287712379549449f / 16.0f));
            kkc[u] = a.in(I_KK)[l * 512 + h * 64 + c]; kac[u] = a.in(I_KA)[l * 512 + h * 64 + c]; rkc[u] = a.in(I_RK)[l * 512 + h * 64 + c];
            const int colr = h * 64 + c, coll = (c < 32) ? (1536 + d * 32 + c) : (1600 + d * 32 + (c - 32));
            mur[u][0] = d ? mun[colr] : mup[colr]; mur[u][1] = d ? mup[colr] : mun[colr]; muk[u][0] = d ? mun[512 + colr] : mup[512 + colr]; muk[u][1] = d ? mup[512 + colr] : mun[512 + colr];
            muv[u][0] = d ? mun[1024 + colr] : mup[1024 + colr]; muv[u][1] = d ? mup[1024 + colr] : mun[1024 + colr]; mul[u][0] = d ? mun[coll] : mup[coll]; mul[u][1] = d ? mup[coll] : mun[coll]; }
#pragma unroll
        for (int i = 0; i < 2; ++i) { const int cc = h * 64 + 16 * ((wv >> 2) * 2 + i) + kl; unsigned t[8], u[8];
#pragma unroll
            for (int j = 0; j < 8; ++j) { t[j] = f2bf(a.in(I_W2)[((size_t)(l * 2 + d) * 32 + 8 * g + j) * 512 + cc]); u[j] = f2bf(a.in(I_A2)[((size_t)(l * 2 + d) * 32 + 8 * g + j) * 512 + cc]); }
            w2f[i] = __builtin_bit_cast(bf16x8, (v4u){t[0] | (t[1] << 16), t[2] | (t[3] << 16), t[4] | (t[5] << 16), t[6] | (t[7] << 16)});
            a2f[i] = __builtin_bit_cast(bf16x8, (v4u){u[0] | (u[1] << 16), u[2] | (u[3] << 16), u[4] | (u[5] << 16), u[6] | (u[7] << 16)});
            w0c[i] = a.in(I_W0)[(l * 2 + d) * 512 + cc]; a0c[i] = a.in(I_A0)[(l * 2 + d) * 512 + cc]; } }
        f32x4 St[4] = {Z4, Z4, Z4, Z4};
        f32x4 cvt_[4] = {Z4, Z4, Z4, Z4}; int cit = blockIdx.x * 8 + wv, cpend = -1; const int cstride = gridDim.x * 8;
#define BGC_WINDOW() do { const int ln_ = opq(lane0); if (cpend >= 0) bgc::finish(a, l, cpend, ln_, wv & 3, lds, cvt_); if (cit < bgc::NITEMS) { bgc::issue(a, l, cit, ln_, cvt_); cpend = cit; cit += cstride; } else cpend = -1; } while (0)
        for (int seq = 0; seq < 2; ++seq) {
            const int T = seq ? SEQ : CTXL, rowbase = seq ? b * SEQ : NTX + b * CTXL, ngrp = T / 64;
            v4u pre[5];
#define CSC_PREFETCH(GRP) do { const int s0_ = (GRP) * 64; const int tlo_ = d ? (T - 64 - s0_) : s0_; \
                _Pragma("unroll") for (int i_ = 0; i_ < 5; ++i_) { const int id_ = opq(tid) + 512 * i_; const int rr_ = id_ >> 5, ch_ = id_ & 31; const int t_ = tlo_ - 1 + rr_; \
                    const int col_ = RWOFF + (ch_ < 24 ? (ch_ >> 3) * 512 + h * 64 + (ch_ & 7) * 8 : (ch_ < 28 ? 1536 + d * 32 + (ch_ - 24) * 8 : 1600 + d * 32 + (ch_ - 28) * 8)); \
                    const bool ok_ = (id_ < 66 * 32) && t_ >= 0 && t_ < T; const int tc_ = ok_ ? t_ : 0; \
                    const v4u v_ = *(const GAS v4u*)(PX + (size_t)(rowbase + tc_) * DINP + col_); pre[i_] = ok_ ? v_ : (v4u){0u, 0u, 0u, 0u}; } } while (0)
            CSC_PREFETCH(0);
            for (int grp = 0; grp < ngrp; ++grp) {
                const int s0 = grp * 64;
                int lane = opq(lane0); int c = lane, kl = lane & 15, g = lane >> 4, q_ = kl >> 2, p_ = kl & 3; (void)q_; (void)p_;
                STB(1);
#pragma unroll
                for (int i = 0; i < 5; ++i) { const int id = opq(tid) + 512 * i; if (id < 66 * 32) *(LAS v4u*)(lds + RAW + id * 16) = pre[i]; }
                __syncthreads();
                STE(1); STB(2);
                int sl = opqs(wv);
                float Rk[4][2], Rq[4][2], Rr[4][2], Rv[4][2];
                REPK(1) { const int cp = lane & 31, sh = lane >> 5, sb = 8 * sl + 4 * sh; const int rbase = d ? 64 - sb : sb + 1, rdir = d ? -256 : 256;
                  const LAS bf16* p0 = (const LAS bf16*)(lds + RAW) + (rbase * 256 + 2 * cp) - rdir;
                  float pr[6][2], pk[6][2], pv[6][2], pl[6][2];
#pragma unroll
                  for (int j = 0; j < 6; ++j) { const LAS unsigned* p = (const LAS unsigned*)(p0 + j * rdir); const unsigned wr = p[0], wk = p[32], wv_ = p[64], wl = p[96];
                      pr[j][0] = bflo(wr); pr[j][1] = bfhi(wr); pk[j][0] = bflo(wk); pk[j][1] = bfhi(wk); pv[j][0] = bflo(wv_); pv[j][1] = bfhi(wv_); pl[j][0] = bflo(wl); pl[j][1] = bfhi(wl); }
                  const int qd = cp >> 3;
#pragma unroll
                  for (int i = 0; i < 4; ++i) { const int sloc = sb + i; float r[2], k[2], zz[2];
#pragma unroll
                      for (int u = 0; u < 2; ++u) { r[u] = pr[i + 1][u] + mur[u][0] * (pr[i][u] - pr[i + 1][u]) + mur[u][1] * (pr[i + 2][u] - pr[i + 1][u]); k[u] = pk[i + 1][u] + muk[u][0] * (pk[i][u] - pk[i + 1][u]) + muk[u][1] * (pk[i + 2][u] - pk[i + 1][u]);
                          Rv[i][u] = pv[i + 1][u] + muv[u][0] * (pv[i][u] - pv[i + 1][u]) + muv[u][1] * (pv[i + 2][u] - pv[i + 1][u]);
                          const float z = pl[i + 1][u] + mul[u][0] * (pl[i][u] - pl[i + 1][u]) + mul[u][1] * (pl[i + 2][u] - pl[i + 1][u]);
                          const float th = 1.0f - 2.0f * __builtin_amdgcn_rcpf(1.0f + __expf(2.0f * z)); zz[u] = cp < 16 ? th : z; }
                      ((LAS unsigned*)(lds + ZL))[sloc * 32 + cp] = pk2(zz[0], zz[1]);
                      if (seq) { const int t = d ? (T - 1 - (s0 + sloc)) : (s0 + sloc); const float pos = (float)((qd < 2) ? (t >> 6) : (t & 63));
#pragma unroll
                          for (int u = 0; u < 2; ++u) { const float rp = dppmov<0x128>(r[u]), kp = dppmov<0x128>(k[u]); const float ang = pos * ropef[u]; const float cs = __cosf(ang), sn = __sinf(ang);
                              const float sg = (qd & 1) ? sn : -sn; r[u] = r[u] * cs + rp * sg; k[u] = k[u] * cs + kp * sg; } }
                      const float k0 = k[0] * kkc[0], k1 = k[1] * kkc[1]; float ss = k0 * k0 + k1 * k1;
                      ss += dppmov<0xB1>(ss); ss += dppmov<0x4E>(ss); ss += dppmov<0x141>(ss); ss += dppmov<0x140>(ss);
                      { const int iv = __builtin_bit_cast(int, ss); const float a0 = __builtin_bit_cast(float, __builtin_amdgcn_readlane(iv, 0)) + __builtin_bit_cast(float, __builtin_amdgcn_readlane(iv, 16)), a1 = __builtin_bit_cast(float, __builtin_amdgcn_readlane(iv, 32)) + __builtin_bit_cast(float, __builtin_amdgcn_readlane(iv, 48)); ss = sh ? a1 : a0; }
                      const float rn = __builtin_amdgcn_rsqf(fmaxf(ss, 1e-24f));
                      Rk[i][0] = k0 * rn; Rk[i][1] = k1 * rn; Rq[i][0] = k[0]; Rq[i][1] = k[1]; Rr[i][0] = r[0]; Rr[i][1] = r[1]; } }
                __syncthreads();
                STE(2); STB(3);
                lane = opq(lane0); c = lane; kl = lane & 15; g = lane >> 4; q_ = kl >> 2; p_ = kl & 3;
                REPK(2) { const int wq = opqs(wv); const int st = wq & 3; const LAS unsigned char* zrow = lds + ZL + (16 * st + kl) * 128;
                  const bf16x8 zw = *(const LAS bf16x8*)(zrow + 16 * g), za = *(const LAS bf16x8*)(zrow + 64 + 16 * g);
#pragma unroll
                  for (int i = 0; i < 2; ++i) { const int cc = 16 * ((wq >> 2) * 2 + i) + kl;
                      const f32x4 uw = __builtin_amdgcn_mfma_f32_16x16x32_bf16(zw, w2f[i], Z4, 0, 0, 0), ua = __builtin_amdgcn_mfma_f32_16x16x32_bf16(za, a2f[i], Z4, 0, 0, 0);
#pragma unroll
                      for (int j = 0; j < 4; ++j) { const int srow = 16 * st + 4 * g + j;
                          ((LAS float*)(lds + LWO))[srow * 64 + cc] = -0.6065306597126334f * __builtin_amdgcn_rcpf(1.0f + __expf(-(uw[j] + w0c[i]))); ((LAS float*)(lds + AAO))[srow * 64 + cc] = __builtin_amdgcn_rcpf(1.0f + __expf(-(ua[j] + a0c[i]))); } } }
                __syncthreads();
                STE(3); STB(4);
                lane = opq(lane0); c = lane; kl = lane & 15; g = lane >> 4; q_ = kl >> 2; p_ = kl & 3;
                sl = opqs(wv);
                REPK(4) { const int cp = lane & 31, sh = lane >> 5, q = sl >> 1, hf = sl & 1; typedef float f32x2_ __attribute__((ext_vector_type(2)));
                  const LAS f32x2_* lwp = (const LAS f32x2_*)((const LAS float*)(lds + LWO) + (16 * q) * 64 + 2 * cp); const LAS f32x2_* aap = (const LAS f32x2_*)((const LAS float*)(lds + AAO) + (8 * sl + 4 * sh) * 64 + 2 * cp);
                  f32x2_ qs[4];
#pragma unroll
                  for (int j = 0; j < 4; ++j) { qs[j] = lwp[(4 * j) * 32] + lwp[(4 * j + 1) * 32] + lwp[(4 * j + 2) * 32] + lwp[(4 * j + 3) * 32]; }
                  const f32x2_ cL = (qs[0] + qs[1]) + (qs[2] + qs[3]); const int part = 2 * hf + sh;
                  f32x2_ run = part == 0 ? (f32x2_){0.f, 0.f} : (part == 1 ? qs[0] : (part == 2 ? qs[0] + qs[1] : qs[0] + qs[1] + qs[2]));
                  const float wl0 = __expf(cL.x), wl1 = __expf(cL.y);
                  if (part == 3) ((LAS f32x2_*)(lds + WLO))[q * 32 + cp] = (f32x2_){wl0, wl1};
#pragma unroll
                  for (int i = 0; i < 4; ++i) { const int sloc = 8 * sl + 4 * sh + i, s = 4 * part + i; const f32x2_ lwi = lwp[s * 32]; const f32x2_ cprev = run; run = run + lwi; const f32x2_ aa = aap[i * 32];
                      const float kd0 = Rq[i][0] * (1.0f + (aa.x - 1.0f) * kac[0]), kd1 = Rq[i][1] * (1.0f + (aa.y - 1.0f) * kac[1]), nb0 = -Rk[i][0] * aa.x, nb1 = -Rk[i][1] * aa.y;
                      float bon = Rr[i][0] * kd0 * rkc[0] + Rr[i][1] * kd1 * rkc[1];
                      bon += dppmov<0xB1>(bon); bon += dppmov<0x4E>(bon); bon += dppmov<0x141>(bon); bon += dppmov<0x140>(bon);
                      { const int iv = __builtin_bit_cast(int, bon); const float a0 = __builtin_bit_cast(float, __builtin_amdgcn_readlane(iv, 0)) + __builtin_bit_cast(float, __builtin_amdgcn_readlane(iv, 16)), a1 = __builtin_bit_cast(float, __builtin_amdgcn_readlane(iv, 32)) + __builtin_bit_cast(float, __builtin_amdgcn_readlane(iv, 48)); bon = sh ? a1 : a0; }
                      if (cp == 0) { const int t = d ? (T - 1 - (s0 + sloc)) : (s0 + sloc); BON[((size_t)d * NTOK + rowbase + t) * 8 + h] = bon; }
                      const float e1x = __expf(cprev.x), e1y = __expf(cprev.y), e2x = __expf(-run.x), e2y = __expf(-run.y), e3x = __builtin_amdgcn_rcpf(e2x), e3y = __builtin_amdgcn_rcpf(e2y);
                      LAS unsigned char* base = lds + ARR + q * (7 * 2048) + sw16(s, cp >> 2) + (cp & 3) * 4;
                      *(LAS unsigned*)(base) = pk2(Rk[i][0] * e1x, Rk[i][1] * e1y); *(LAS unsigned*)(base + 2048) = pk2(nb0 * e2x, nb1 * e2y); *(LAS unsigned*)(base + 4096) = pk2(kd0 * e2x, kd1 * e2y); *(LAS unsigned*)(base + 6144) = pk2(Rr[i][0] * e3x, Rr[i][1] * e3y);
                      *(LAS unsigned*)(base + 12288) = pk2(Rv[i][0], Rv[i][1]); } }
                __syncthreads();
                STE(4); STB(5);
                lane = opq(lane0); c = lane; kl = lane & 15; g = lane >> 4; q_ = kl >> 2; p_ = kl & 3;
                STB(7); if (wv < 4) { BGC_WINDOW(); if (grp + 1 < ngrp) CSC_PREFETCH(grp + 1); } STE(7);
                STB(8); STB(10);
                REPK(5) if (wv >= 4) { __builtin_amdgcn_s_setprio(3); const int q = opqs(wv) - 4; const LAS unsigned char* A0 = lds + ARR + q * (7 * 2048);
                    STB(11);
                    bf16x8 at[2], bt[2], kt[2], rt[2];
#pragma unroll
                    for (int ks = 0; ks < 2; ++ks) { const int o = sw16(kl, ks * 4 + g); at[ks] = *(const LAS bf16x8*)(A0 + o); bt[ks] = *(const LAS bf16x8*)(A0 + 2048 + o); kt[ks] = *(const LAS bf16x8*)(A0 + 4096 + o); rt[ks] = *(const LAS bf16x8*)(A0 + 6144 + o); }
                    f32x4 ABt = Z4, AKt = Z4, RBt = Z4, RKt = Z4;
#pragma unroll
                    for (int ks = 0; ks < 2; ++ks) { ABt = __builtin_amdgcn_mfma_f32_16x16x32_bf16(bt[ks], at[ks], ABt, 0, 0, 0); AKt = __builtin_amdgcn_mfma_f32_16x16x32_bf16(kt[ks], at[ks], AKt, 0, 0, 0);
                        RBt = __builtin_amdgcn_mfma_f32_16x16x32_bf16(bt[ks], rt[ks], RBt, 0, 0, 0); RKt = __builtin_amdgcn_mfma_f32_16x16x32_bf16(kt[ks], rt[ks], RKt, 0, 0, 0); }
#pragma unroll
                    for (int j = 0; j < 4; ++j) { const int jj = 4 * g + j; ABt[j] = jj < kl ? ABt[j] : 0.f; AKt[j] = jj < kl ? AKt[j] : 0.f; RBt[j] = jj <= kl ? RBt[j] : 0.f; RKt[j] = jj <= kl ? RKt[j] : 0.f; }
                    STE(11); STB(12);
                    float Tr[16]; const float ab0 = ABt[0], ab1 = ABt[1], ab2 = ABt[2], ab3 = ABt[3];
                    const int abi[4] = {__builtin_bit_cast(int, ab0), __builtin_bit_cast(int, ab1), __builtin_bit_cast(int, ab2), __builtin_bit_cast(int, ab3)};
#pragma unroll
                    for (int i = 0; i < 16; ++i) Tr[i] = (i == kl) ? 1.f : 0.f;
#pragma unroll
                    for (int j = 14; j >= 0; --j) { float acc = 0.f;
#pragma unroll
                        for (int i = 15; i > j; --i) acc += Tr[i] * __builtin_bit_cast(float, __builtin_amdgcn_readlane(abi[j & 3], i + 16 * (j >> 2)));
                        Tr[j] = (j < kl) ? acc : Tr[j]; }
                    STE(12); STB(13);
                    float tsel[4];
#pragma unroll
                    for (int e = 0; e < 4; ++e) tsel[e] = g == 0 ? Tr[e] : (g == 1 ? Tr[4 + e] : (g == 2 ? Tr[8 + e] : Tr[12 + e]));
                    v2u tf2; tf2.x = pk2(tsel[0], tsel[1]); tf2.y = pk2(tsel[2], tsel[3]);
                    const bf16x8 Tf = mk8(tf2, Z2), RBf = mk8(cvt4(RBt), Z2);
                    f32x4 AhT[4], QhT[4], Ah[4], rin[4]; bf16x8 Alo[4];
#pragma unroll
                    for (int ct = 0; ct < 4; ++ct) { Alo[ct] = mk8(trd(A0 + sw16(4 * g + q_, 2 * ct + (p_ >> 1)) + (p_ & 1) * 8), Z2);
                        const v2u rw = *(const LAS v2u*)(A0 + 6144 + sw16(kl, 2 * ct + (g >> 1)) + (g & 1) * 8);
                        rin[ct] = (f32x4){bflo(rw.x), bfhi(rw.x), bflo(rw.y), bfhi(rw.y)}; }
#pragma unroll
                    for (int ct = 0; ct < 4; ++ct) { AhT[ct] = __builtin_amdgcn_mfma_f32_16x16x32_bf16(Alo[ct], Tf, Z4, 0, 0, 0);
                        Ah[ct] = __builtin_amdgcn_mfma_f32_16x16x32_bf16(Tf, Alo[ct], Z4, 0, 0, 0); }
#pragma unroll
                    for (int ct = 0; ct < 4; ++ct) QhT[ct] = __builtin_amdgcn_mfma_f32_16x16x32_bf16(mk8(cvt4(Ah[ct]), Z2), RBf, rin[ct], 0, 0, 0);
                    STE(13); STB(14);
                    LAS unsigned char* fr = lds + FR + q * 7168 + lane * 16;
                    *(LAS bf16x8*)(fr) = mk8(cvt4(AhT[0]), cvt4(AhT[1])); *(LAS bf16x8*)(fr + 1024) = mk8(cvt4(AhT[2]), cvt4(AhT[3]));
                    *(LAS bf16x8*)(fr + 2048) = mk8(cvt4(QhT[0]), cvt4(QhT[1])); *(LAS bf16x8*)(fr + 3072) = mk8(cvt4(QhT[2]), cvt4(QhT[3]));
                    *(LAS bf16x8*)(fr + 4096) = mk8(cvt4(AKt), Z2); *(LAS bf16x8*)(fr + 5120) = mk8(cvt4(RBt), cvt4(RKt)); *(LAS bf16x8*)(fr + 6144) = Tf;
                    STE(14);
                    __builtin_amdgcn_s_setprio(0);
                }
                STE(8); STE(10);
                __syncthreads();
                STE(5); STB(6);
                lane = opq(lane0); c = lane; kl = lane & 15; g = lane >> 4; q_ = kl >> 2; p_ = kl & 3;
                if (wv >= 4) { BGC_WINDOW(); if (grp + 1 < ngrp) CSC_PREFETCH(grp + 1); }
                if (wv < 4) { __builtin_amdgcn_s_setprio(3); const int vt = opqs(wv);
#pragma unroll 1
                    for (int q = 0; q < 4; ++q) { const LAS unsigned char* A0 = lds + ARR + q * (7 * 2048); const LAS unsigned char* fr = lds + FR + q * 7168 + lane * 16;
                        const bf16x8 Ap0 = *(const LAS bf16x8*)(fr), Ap1 = *(const LAS bf16x8*)(fr + 1024), Qp0 = *(const LAS bf16x8*)(fr + 2048), Qp1 = *(const LAS bf16x8*)(fr + 3072);
                        const bf16x8 AKf = *(const LAS bf16x8*)(fr + 4096), RBRK = *(const LAS bf16x8*)(fr + 5120), Tf = *(const LAS bf16x8*)(fr + 6144);
                        const v2u vtr = trd(A0 + 12288 + sw16(4 * g + q_, 2 * vt + (p_ >> 1)) + (p_ & 1) * 8);
                        bf16x8 bk[4]; f32x4 wl[4];
#pragma unroll
                        for (int ct = 0; ct < 4; ++ct) { wl[ct] = *(const LAS f32x4*)(lds + WLO + (q * 64 + 16 * ct + 4 * g) * 4); const int o = sw16(4 * g + q_, 2 * ct + (p_ >> 1)) + (p_ & 1) * 8; bk[ct] = mk8(trd(A0 + 2048 + o), trd(A0 + 4096 + o)); }
                        const f32x4 X1 = __builtin_amdgcn_mfma_f32_16x16x32_bf16(AKf, mk8(vtr, Z2), Z4, 0, 0, 0);
                        const f32x4 Uh = __builtin_amdgcn_mfma_f32_16x16x32_bf16(Tf, mk8(cvt4(X1), Z2), Z4, 0, 0, 0);
                        const f32x4 Yh = __builtin_amdgcn_mfma_f32_16x16x32_bf16(RBRK, mk8(cvt4(Uh), vtr), Z4, 0, 0, 0);
                        const bf16x8 bs0 = mk8(cvt4(St[0]), cvt4(St[1])), bs1 = mk8(cvt4(St[2]), cvt4(St[3]));
                        f32x4 U = __builtin_amdgcn_mfma_f32_16x16x32_bf16(Ap0, bs0, Uh, 0, 0, 0); U = __builtin_amdgcn_mfma_f32_16x16x32_bf16(Ap1, bs1, U, 0, 0, 0);
                        f32x4 Y = __builtin_amdgcn_mfma_f32_16x16x32_bf16(Qp0, bs0, Yh, 0, 0, 0); Y = __builtin_amdgcn_mfma_f32_16x16x32_bf16(Qp1, bs1, Y, 0, 0, 0);
                        const bf16x8 UV = mk8(cvt4(U), vtr);
#pragma unroll
                        for (int ct = 0; ct < 4; ++ct) St[ct] = __builtin_amdgcn_mfma_f32_16x16x32_bf16(bk[ct], UV, St[ct], 0, 0, 0) * wl[ct];
#pragma unroll
                        for (int jj = 0; jj < 2; ++jj) {
                            const float pe = dppmov<0xB1>(Y[jj]), po = dppmov<0xB1>(Y[2 + jj]); const bool odd = (kl & 1) != 0;
                            const unsigned w = odd ? pk2(po, Y[2 + jj]) : pk2(Y[jj], pe);
                            const int sg = s0 + 16 * q + 4 * g + jj + (odd ? 2 : 0); const int t = d ? (T - 1 - sg) : sg;
                            *(GAS unsigned*)(YD + ((size_t)d * NTOK + rowbase + t) * 512 + h * 64 + 16 * vt + (kl & ~1)) = w; }
                    }
                    __builtin_amdgcn_s_setprio(0);
                }
                __syncthreads();
                STE(6);
            }
#undef CSC_PREFETCH
        }
        if (cpend >= 0) { bgc::finish(a, l, cpend, opq(lane0), wv & 3, lds, cvt_); cpend = -1; }
        for (; cit < bgc::NITEMS; cit += cstride) { bgc::issue(a, l, cit, opq(lane0), cvt_); bgc::finish(a, l, cit, opq(lane0), wv & 3, lds, cvt_); }
#undef BGC_WINDOW
    }
    if (SCAN_STAMP != 0 && blockIdx.x == 0 && tid == ((SCAN_STAMP == 8 || (SCAN_STAMP >= 11 && SCAN_STAMP <= 14)) ? 256 : ((SCAN_STAMP == 10) ? 448 : 0))) atomicAdd((unsigned*)(a.ws() + WS_CTL) + 2000, tacc_);
}
constexpr int PH_PER_LAYER = 11, N_PHASES = 1 + 2 * PH_PER_LAYER;
template <int K> __device__ __forceinline__ void run_phase(LAS unsigned char* lds, int l) {
    if constexpr (K == 0) phase_prologue(lds);
    if constexpr (K == 1) phase_modconv(lds, l);
    if constexpr (K == 3) phase_scan(lds, l);
    if constexpr (K == 4) phase_attn(lds, l);
    if constexpr (K == 5) phase_rwpost(lds, l);
    if constexpr (K == 7) { if (l == 0) phase_ln1_route<false>(lds, l); else phase_ln1_route<true>(lds, l); }
    if constexpr (K == 8) phase_gather(lds, l);
    if constexpr (K == 11) phase_ln2(lds, l);
    if constexpr (K == 2 || K == 6 || K == 9 || K == 10) {
        const KA a = ka_get(); unsigned char* ws = a.ws(); const int G = gridDim.x, bid = blockIdx.x;
        bf16* X1 = (bf16*)(ws + WS_X1); bf16* X2 = (bf16*)(ws + WS_X2); bf16* X3 = (bf16*)(ws + WS_X3);
        if constexpr (K == 2) { __syncthreads();
            pg8::Gemm g{X1, (const bf16*)(ws + WS_WINT) + (size_t)l * DINP * DM, NTOK, DINP, DM}; pg8::StaticOrder S; S.init(NTOK, DINP, G, bid);
            pg8::EpiBf16 E{X2, DINP}; pg8::gemm_phase<pg8::EpiBf16, pg8::StaticOrder, true, true>(lds, g, S, E); }
        if constexpr (K == 6) { __syncthreads();
            const int Mrows = (l == 0) ? NTOK : NTX;
            pg8::Gemm g{X1, (const bf16*)(ws + WS_WOT) + (size_t)l * DM * DM, Mrows, DM, DM}; pg8::StaticOrder S; S.init(Mrows, DM, G, bid);
            pg8::EpiBf16 E{X3, DM}; pg8::gemm_phase<pg8::EpiBf16, pg8::StaticOrder, true, true>(lds, g, S, E); }
        if constexpr (K == 9) { moe_tables<false>(lds, l);
            pg8::Gemm g{X2, (const bf16*)(ws + WS_W13T), MAXSLOT, 1024, DM}; pg8::MoeOrder S; S.init((const LAS int*)(lds + PREF_OFF), 4, G, bid);
            pg8::EpiSwiGLU E{X3, DEXP}; pg8::gemm_phase<pg8::EpiSwiGLU, pg8::MoeOrder, true, true>(lds, g, S, E); }
        if constexpr (K == 10) { moe_tables<false>(lds, l);
            pg8::Gemm g{X3, (const bf16*)(ws + WS_W2T), MAXSLOT, 1024, DEXP}; pg8::MoeOrder S; S.init((const LAS int*)(lds + PREF_OFF), 4, G, bid);
            pg8::EpiBf16 E{X2, DM}; pg8::gemm_phase<pg8::EpiBf16, pg8::MoeOrder, true, true>(lds, g, S, E); }
    }
}
__device__ __forceinline__ void grid_sync(LAS unsigned char* lds) {
    const KA a = ka_get(); XcdBarrier b; b.bar = (unsigned*)(a.ws() + WS_CTL) + CW_BAR; b.x = xb_xcc_id(); b.st = (volatile LAS unsigned*)(lds + MISC_OFF) + 8; xcd_barrier(b);
#ifdef PROBE_BAR
    xcd_barrier(b);
#endif
}
#ifndef ONE_LAUNCH
template <int K> __global__ void __launch_bounds__(512, 2) fwd_ph(Args args) {
    extern __shared__ __attribute__((aligned(16))) unsigned char lds_raw[];
    LAS unsigned char* lds = (LAS unsigned char*)lds_raw;
    for (int u = threadIdx.x; u < (LDS_BYTES - LDSCTL_OFF) / 4; u += 512) ((LAS unsigned*)(lds + LDSCTL_OFF))[u] = 0u;
    __syncthreads();
    hw_tid_init();
    __syncthreads();
    run_phase<K>(lds, args.ph_lo);
}
template <int K> static void launch_ph(const Args& a, int grid, hipStream_t stream) {
    static bool attr = false;
    if (!attr) { (void)hipFuncSetAttribute((const void*)fwd_ph<K>, hipFuncAttributeMaxDynamicSharedMemorySize, LDS_BYTES); attr = true; }
    hipLaunchKernelGGL(fwd_ph<K>, dim3(grid), dim3(512), LDS_BYTES, stream, a);
}
#else
__global__ void __launch_bounds__(512, 2) fwd(Args args) {
    extern __shared__ __attribute__((aligned(16))) unsigned char lds_raw[];
    LAS unsigned char* lds = (LAS unsigned char*)lds_raw;
    for (int u = threadIdx.x; u < (LDS_BYTES - LDSCTL_OFF) / 4; u += 512) ((LAS unsigned*)(lds + LDSCTL_OFF))[u] = 0u;
    __syncthreads();
    hw_tid_init();
    __syncthreads();
    (void)xcd_barrier_post((unsigned*)(args.ws + WS_CTL) + CW_BAR, (volatile LAS unsigned*)(lds + MISC_OFF) + 8);
    run_phase<0>(lds, 0);
#ifdef PROBE_P0
    __syncthreads(); run_phase<0>(lds, 0);
#endif
    grid_sync(lds);
#ifndef PROBE_REP
#define PROBE_REP -1
#endif
#define RUNP(K) do { run_phase<K>(lds, l); if (PROBE_REP == K) { __syncthreads(); run_phase<K>(lds, l); } } while (0)
    for (int l = 0; l < 2; ++l) {
        if (l == 0) { RUNP(1); grid_sync(lds); }
        RUNP(2); grid_sync(lds);
        RUNP(3);
        RUNP(4); grid_sync(lds);
        RUNP(5); grid_sync(lds);
        RUNP(6); grid_sync(lds);
        run_phase<7>(lds, l); if (PROBE_REP == 7 && l == 0) { __syncthreads(); run_phase<7>(lds, l); } grid_sync(lds);
        RUNP(8); grid_sync(lds);
        RUNP(9); grid_sync(lds);
        RUNP(10); grid_sync(lds);
        RUNP(11); if (l == 0) grid_sync(lds);
    }
#if defined(SCAN_STAMP) && SCAN_STAMP != 0
    if (blockIdx.x == 0 && hw_tid() == 0) { const unsigned long long tk = __hip_atomic_load((unsigned*)(args.ws + WS_CTL) + 2000, __ATOMIC_RELAXED, __HIP_MEMORY_SCOPE_AGENT); const unsigned long long ts = __builtin_amdgcn_s_memrealtime(); while (__builtin_amdgcn_s_memrealtime() - ts < tk) __builtin_amdgcn_s_sleep(8); }
#endif
}
#endif

extern "C" void kernel_launch(void* const* d_in, const int* in_sizes, int n_in, void* d_out, int out_size, void* d_ws, size_t ws_size, hipStream_t stream) {
    static int grid = 0;
    if (grid == 0) {
        if (n_in != 30 || in_sizes[0] != NTX * DM || out_size != NTX * DM || ws_size < WS_END) {
            fprintf(stderr, "kernel_launch: unexpected problem (n_in %d, in0 %d, out %d, ws %zu < %zu?); nothing launched\n", n_in, n_in > 0 ? in_sizes[0] : -1, out_size, ws_size, (size_t)WS_END); grid = -1; return; }
        int dev = 0, cus = 0;
        if (hipGetDevice(&dev) != hipSuccess || hipDeviceGetAttribute(&cus, hipDeviceAttributeMultiprocessorCount, dev) != hipSuccess) { grid = -1; return; }
#ifdef ONE_LAUNCH
        if (hipFuncSetAttribute((const void*)fwd, hipFuncAttributeMaxDynamicSharedMemorySize, LDS_BYTES) != hipSuccess) { fprintf(stderr, "kernel_launch: hipFuncSetAttribute failed\n"); grid = -1; return; }
#endif
        (void)hipGetLastError();
        grid = cus > 0 ? cus : 256;
        if (grid != 256 && grid != 128) { fprintf(stderr, "kernel_launch: %d CUs: the LN1/LN2 row maps need 128 or 256 workgroups\n", grid); grid = -1; return; }
    }
    if (grid < 0) return;
    if (hipMemsetAsync((char*)d_ws + WS_CTL, 0, CTL_ZERO_BYTES, stream) != hipSuccess) return;
    Args a{};
    for (int i = 0; i < 30; ++i) a.in[i] = (const float*)d_in[i];
    a.out = (float*)d_out; a.ws = (unsigned char*)d_ws; a.ph_lo = 0; a.ph_hi = 0;
#ifndef ONE_LAUNCH
    launch_ph<0>(a, grid, stream);
    for (int l = 0; l < 2; ++l) { a.ph_lo = l;
        launch_ph<1>(a, grid, stream); launch_ph<2>(a, grid, stream); launch_ph<3>(a, grid, stream); launch_ph<4>(a, grid, stream); launch_ph<5>(a, grid, stream); launch_ph<6>(a, grid, stream);
        launch_ph<7>(a, grid, stream); launch_ph<8>(a, grid, stream); launch_ph<9>(a, grid, stream); launch_ph<10>(a, grid, stream); launch_ph<11>(a, grid, stream); }
#else
    hipLaunchKernelGGL(fwd, dim3(grid), dim3(512), LDS_BYTES, stream, a);
#endif
}
```

```cpp
#define ONE_LAUNCH 1
#include <hip/hip_runtime.h>
#include <cstdio>
#include <cstdint>

constexpr int DM = 1024, NB = 16, SEQ = 2048, CTXL = 256, NTX = NB * SEQ, NTC = NB * CTXL, NTOK = NTX + NTC;
constexpr int DIN = 3296, DINP = 3328, RWOFF = 1536, NHEAD = 8, HD = 64;
constexpr int NEXP = 32, DEXP = 512, LISTCAP = 2 * NTOK;
constexpr int MAXSLOT = 81920;
constexpr float ALPHA = 1.41421356237309515f, LN_EPS = 1e-6f, GN_EPS = 64e-5f;

constexpr size_t MiB = 1u << 20;
constexpr size_t WS_CTL = 0, CTL_ZERO_BYTES = 1 * MiB;
constexpr size_t WS_MODS = 1 * MiB;
constexpr size_t WS_ROPE = 2 * MiB;
constexpr size_t WS_WINT = 3 * MiB;
constexpr size_t WS_WOT = 16 * MiB;
constexpr size_t WS_W13T = 20 * MiB;
constexpr size_t WS_W2T = 84 * MiB;
constexpr size_t WS_LIST = 116 * MiB;
constexpr size_t WS_TOK = 125 * MiB;
constexpr size_t WS_BONUS = 127 * MiB;
constexpr size_t WS_CS = 130 * MiB;
constexpr size_t WS_X1 = 146 * MiB;
constexpr size_t WS_X2 = 218 * MiB;
constexpr size_t WS_XP = WS_X2 + 160 * MiB;
constexpr size_t WS_X3 = 452 * MiB;
constexpr size_t WS_END = 596 * MiB;
static_assert(WS_WINT + (size_t)2 * DINP * DM * 2 <= WS_WOT && WS_LIST + (size_t)NEXP * LISTCAP * 4 <= WS_TOK && WS_TOK + (size_t)NTOK * 32 <= WS_BONUS, "ws map");
static_assert(WS_BONUS + (size_t)2 * NTOK * 8 * 4 <= WS_CS && WS_X2 + (size_t)NTOK * DINP * 2 <= WS_X3 && WS_X3 + (size_t)2 * NTOK * 512 * 4 <= WS_END, "ws map");
static_assert((size_t)MAXSLOT * 1024 * 2 <= WS_XP - WS_X2 && WS_XP + (size_t)NTOK * DM * 2 <= WS_X3 && (size_t)MAXSLOT * 512 * 2 <= WS_END - WS_X3, "ws map");
constexpr int CW_BAR = 4096;
constexpr int CW_CNT = 8192;
constexpr int RING_BYTES = 131072, LDSCTL_OFF = RING_BYTES, MISC_OFF = LDSCTL_OFF + 320, LDS_BYTES = 147456;
constexpr int PREF_OFF = LDSCTL_OFF + 512;

#define GAS __attribute__((address_space(1)))
#define LAS __attribute__((address_space(3)))
typedef unsigned short bf16;
typedef unsigned v4u __attribute__((ext_vector_type(4)));
typedef unsigned v2u __attribute__((ext_vector_type(2)));
typedef float f32x4 __attribute__((ext_vector_type(4)));
typedef short bf16x8 __attribute__((ext_vector_type(8)));
typedef GAS unsigned gu32;
#define RLX_AGENT __ATOMIC_RELAXED, __HIP_MEMORY_SCOPE_AGENT
#define LDS_WAIT() asm volatile("s_waitcnt lgkmcnt(0)" ::: "memory")
#define VM_WAIT() asm volatile("s_waitcnt vmcnt(0)" ::: "memory")
__device__ __forceinline__ unsigned f2bf(float f) { unsigned u = __builtin_bit_cast(unsigned, f); return (u + 0x7fffu + ((u >> 16) & 1u)) >> 16; }
typedef float f32x2_t_ __attribute__((ext_vector_type(2))); typedef __bf16 bf16x2_t_ __attribute__((ext_vector_type(2)));
__device__ __forceinline__ unsigned pk2(float lo, float hi) { f32x2_t_ v = {lo, hi}; bf16x2_t_ b = __builtin_convertvector(v, bf16x2_t_); return __builtin_bit_cast(unsigned, b); }
__device__ __forceinline__ unsigned short f2bf1(float f) { return (unsigned short)(pk2(f, 0.f) & 0xffffu); }
__device__ __forceinline__ float bf2f(unsigned short v) { return __builtin_bit_cast(float, (unsigned)v << 16); }
__device__ __forceinline__ float bflo(unsigned w) { return __builtin_bit_cast(float, w << 16); }
__device__ __forceinline__ float bfhi(unsigned w) { return __builtin_bit_cast(float, w & 0xffff0000u); }
__device__ __forceinline__ float sigmoidf_(float x) { return 1.0f / (1.0f + expf(-x)); }
__device__ __forceinline__ float shx(float v, int k, int lane) { return __builtin_bit_cast(float, __builtin_amdgcn_ds_bpermute((lane ^ k) << 2, __builtin_bit_cast(int, v))); }
__device__ __forceinline__ float shi(float v, int src) { return __builtin_bit_cast(float, __builtin_amdgcn_ds_bpermute(src << 2, __builtin_bit_cast(int, v))); }
template <int CTRL> __device__ __forceinline__ float dppmov(float v) { return __builtin_bit_cast(float, __builtin_amdgcn_update_dpp(0, __builtin_bit_cast(int, v), CTRL, 0xF, 0xF, true)); }
__device__ __forceinline__ float wave_sum(float v) {
    v += dppmov<0xB1>(v); v += dppmov<0x4E>(v); v += dppmov<0x141>(v); v += dppmov<0x140>(v);
    const int iv = __builtin_bit_cast(int, v);
    return (__builtin_bit_cast(float, __builtin_amdgcn_readlane(iv, 0)) + __builtin_bit_cast(float, __builtin_amdgcn_readlane(iv, 16))) + (__builtin_bit_cast(float, __builtin_amdgcn_readlane(iv, 32)) + __builtin_bit_cast(float, __builtin_amdgcn_readlane(iv, 48)));
}
__device__ __forceinline__ float red8(float v) { v += dppmov<0xB1>(v); v += dppmov<0x4E>(v); v += dppmov<0x141>(v); return v; }

struct TokInfo { int e0, e1, p0, p1; float g0, g1; int pad0, pad1; };

constexpr int WID_OFF = LDSCTL_OFF + 1536;
__device__ __forceinline__ int hw_slot() { return (int)__builtin_amdgcn_s_getreg((5 << 11) | 4) & 63; }
__device__ __forceinline__ int lane_id() { int l; asm volatile("v_mbcnt_lo_u32_b32 %0, -1, 0\n\tv_mbcnt_hi_u32_b32 %0, -1, %0" : "=v"(l)); return l; }
__device__ __forceinline__ void hw_tid_init() { *(volatile LAS int*)(uintptr_t)(WID_OFF + 4 * hw_slot()) = (int)(threadIdx.x >> 6); }
__device__ __forceinline__ int hw_tid() { const int w = *(volatile LAS int*)(uintptr_t)(WID_OFF + 4 * hw_slot()); int t = (__builtin_amdgcn_readfirstlane(w) << 6) | lane_id(); asm volatile("" : "+v"(t)); return t; }
namespace pg8 {
#define PG8_LAS __attribute__((address_space(3)))
typedef unsigned short bf16_t;
typedef short bf16x8 __attribute__((ext_vector_type(8)));
typedef float f32x4 __attribute__((ext_vector_type(4)));
typedef unsigned u32x4 __attribute__((ext_vector_type(4)));
constexpr int BM = 256, BK = 64, HALF = 128, HTB = HALF * BK * 2  , STAGE_BYTES = 8 * HTB, NXCD = 8, WGM = 8;

__host__ __device__ __forceinline__ int lds_byte(int r, int c) { const int st = (r >> 4) * 2 + (c >> 5), rr = r & 15, cc = c & 31, ob = rr * 64 + cc * 2; return st * 1024 + (ob ^ (((ob >> 9) & 1) << 5)); }
__host__ __device__ __forceinline__ void stage_rc(int b, int& R, int& C) { const int st = b / 1024, sb = b % 1024, swz = sb ^ (((sb >> 9) & 1) << 5); R = (st >> 1) * 16 + swz / 64; C = (st & 1) * 32 + (swz % 64) / 2; }
__host__ __device__ __forceinline__ int perm32(int rho) { const int n = rho >> 4, i = rho & 15; return 8 * (i >> 2) + 4 * n + (i & 3); }

struct Unit { int pm, pn, pnb; };
struct Gemm { const bf16_t* A; const bf16_t* Bt; int M, N, K; };

struct StaticOrder {
    int nM, nN, nwg, G, c;
    __host__ __device__ void init(int M, int N, int G_, int c_) { nM = M / BM; nN = N / BM; nwg = nM * nN; G = G_; c = c_; }
    __host__ __device__ bool next(int i, Unit& u) const {
        const long L = (long)i * G + c; if (L >= nwg) return false;
        int wgid = (int)L; { const int q = nwg / NXCD, r = nwg % NXCD, xcd = wgid % NXCD, off = wgid / NXCD; wgid = (xcd < r ? xcd * (q + 1) : r * (q + 1) + (xcd - r) * q) + off; }
        const int nig = WGM * nN, gid = wgid / nig, fm = gid * WGM, gsz = (nM - fm) < WGM ? (nM - fm) : WGM;
        u.pm = fm + ((wgid % nig) % gsz); u.pn = (wgid % nig) / gsz; u.pnb = u.pn; return true;
    }
    __device__ __forceinline__ void a_ready(const Unit&) const {}
    __device__ __forceinline__ void done(const Unit&) const {}
};

__device__ __forceinline__ unsigned cvt_pk_bf16(float lo, float hi) { unsigned r; asm volatile("v_cvt_pk_bf16_f32 %0, %1, %2" : "=v"(r) : "v"(lo), "v"(hi)); return r; }
template <class Epi, class Sched, bool ALIGN_EPI = false, bool SP2 = false>
__device__ __forceinline__ void gemm_phase(PG8_LAS unsigned char* lds, const Gemm g, const Sched& S, const Epi& E) {
    const int tid = hw_tid(), wid = __builtin_amdgcn_readfirstlane(tid >> 6), lane = tid & 63, wr = wid >> 2, wc = wid & 3, fr = lane & 15, fq = lane >> 4;
    const int K = g.K, nt = K / BK;
    unsigned voffA[2], voffB[2];
#pragma unroll
    for (int i = 0; i < 2; ++i) { int R, C; stage_rc(tid * 16 + i * 8192, R, C); const int Rb = Epi::PERM ? ((R & ~31) + perm32(R & 31)) : R;
        voffA[i] = (unsigned)(R * K + C) * 2u; voffB[i] = (unsigned)(Rb * K + C) * 2u; }
    const size_t kstep = (size_t)(BK * 2);
    const size_t hstep = (size_t)HALF * K * 2;
    const size_t tstep = 2 * hstep;
    const unsigned ldsw = (unsigned)wid * 1024u;
    const int aoff = lds_byte(wr * 64 + fr, fq * 8), boff = lds_byte(wc * 32 + fr, fq * 8);
#define PG8_SA(b, h) (((b) * 2 + (h)) * HTB)
#define PG8_SB(b, h) ((4 + (b) * 2 + (h)) * HTB)
#define PG8_STAGE(bufoff, gbase, voff) do { _Pragma("unroll") for (int _i = 0; _i < 2; ++_i) \
        __builtin_amdgcn_global_load_lds((const unsigned*)((const char*)(gbase) + (voff)[_i]), (PG8_LAS unsigned*)(lds + (bufoff) + ldsw + _i * 8192), 16, 0, 0); } while (0)
#define PG8_LDA(dst, b, h) do { _Pragma("unroll") for (int m = 0; m < 4; ++m) _Pragma("unroll") for (int k = 0; k < 2; ++k) dst[m][k] = *(const PG8_LAS bf16x8*)(lds + PG8_SA(b, h) + aoff + m * 2048 + k * 1024); } while (0)
#define PG8_LDB(dst, b, h) do { _Pragma("unroll") for (int n = 0; n < 2; ++n) _Pragma("unroll") for (int k = 0; k < 2; ++k) dst[n][k] = *(const PG8_LAS bf16x8*)(lds + PG8_SB(b, h) + boff + n * 2048 + k * 1024); } while (0)
#define PG8_MMA(ai, bj, At, Bt) do { __builtin_amdgcn_s_setprio(1); _Pragma("unroll") for (int m = 0; m < 4; ++m) _Pragma("unroll") for (int n = 0; n < 2; ++n) _Pragma("unroll") for (int k = 0; k < 2; ++k) \
        acc[ai][bj][m][n] = __builtin_amdgcn_mfma_f32_16x16x32_bf16(Bt[n][k], At[m][k], acc[ai][bj][m][n], 0, 0, 0); __builtin_amdgcn_s_setprio(0); } while (0)
#define PG8_WAIT_V(n) asm volatile("s_waitcnt vmcnt(" #n ")" ::: "memory")
#define PG8_WAIT_L(n) asm volatile("s_waitcnt lgkmcnt(" #n ")" ::: "memory")
#define PG8_BAR __builtin_amdgcn_s_barrier()
#define PG8_SCHED __builtin_amdgcn_sched_barrier(0)
    Unit cur, nxt; int ui = 0;
    if (!S.next(0, cur)) return;
    f32x4 acc[2][2][4][2];
#pragma unroll
    for (int a = 0; a < 2; ++a)
#pragma unroll
        for (int b = 0; b < 2; ++b)
#pragma unroll
            for (int m = 0; m < 4; ++m)
#pragma unroll
                for (int n = 0; n < 2; ++n) acc[a][b][m][n] = (f32x4){0.f, 0.f, 0.f, 0.f};
    bf16x8 At[4][2], B0[2][2], B1[2][2];
    const char* cA = (const char*)g.A + (size_t)cur.pm * tstep; const char* cB = (const char*)g.Bt + (size_t)cur.pnb * tstep;
    S.a_ready(cur);
    if constexpr (SP2) {
        PG8_STAGE(PG8_SB(0, 0), cB, voffB); PG8_STAGE(PG8_SB(0, 1), cB + hstep, voffB); PG8_STAGE(PG8_SA(0, 0), cA, voffA); PG8_STAGE(PG8_SA(0, 1), cA + hstep, voffA);
        if (wr == 1) PG8_BAR;
        PG8_WAIT_V(2); PG8_BAR;
        PG8_STAGE(PG8_SB(1, 0), cB + kstep, voffB); PG8_STAGE(PG8_SA(1, 0), cA + kstep, voffA); PG8_STAGE(PG8_SB(1, 1), cB + hstep + kstep, voffB);
        PG8_WAIT_V(6); PG8_BAR;
    } else {
        PG8_STAGE(PG8_SB(0, 0), cB, voffB); PG8_STAGE(PG8_SA(0, 0), cA, voffA); PG8_STAGE(PG8_SB(0, 1), cB + hstep, voffB); PG8_STAGE(PG8_SA(0, 1), cA + hstep, voffA);
        if (wr == 1) PG8_BAR;
        PG8_WAIT_V(4); PG8_BAR;
        PG8_STAGE(PG8_SB(1, 0), cB + kstep, voffB); PG8_STAGE(PG8_SA(1, 0), cA + kstep, voffA); PG8_STAGE(PG8_SB(1, 1), cB + hstep + kstep, voffB);
        PG8_WAIT_V(6); PG8_BAR;
    }
    for (;;) {
        const bool has_next = S.next(ui + 1, nxt);
        const char* nA = has_next ? (const char*)g.A + (size_t)nxt.pm * tstep : cA; const char* nB = has_next ? (const char*)g.Bt + (size_t)nxt.pnb * tstep : cB;
        for (int t = 0; t < nt; t += 2) {
            const bool last = (t == nt - 2);
            const char* a1 = cA + (size_t)(t + 1) * kstep;
            const char* a2 = last ? nA : cA + (size_t)(t + 2) * kstep; const char* b2 = last ? nB : cB + (size_t)(t + 2) * kstep;
            const char* a3 = a2 + kstep; const char* b3 = b2 + kstep;
            if (last && has_next) S.a_ready(nxt);
            if constexpr (SP2) {
            PG8_LDB(B0, 0, 0); PG8_LDB(B1, 0, 1); PG8_SCHED; PG8_LDA(At, 0, 0); PG8_STAGE(PG8_SA(1, 1), a1 + hstep, voffA);
            PG8_WAIT_V(8); PG8_WAIT_L(0); PG8_BAR; PG8_MMA(0, 0, At, B0); PG8_MMA(0, 1, At, B1); PG8_BAR; PG8_SCHED;
            PG8_LDA(At, 0, 1); PG8_STAGE(PG8_SB(0, 0), b2, voffB); PG8_STAGE(PG8_SB(0, 1), b2 + hstep, voffB); PG8_STAGE(PG8_SA(0, 0), a2, voffA);
            PG8_WAIT_V(8); PG8_WAIT_L(0); PG8_BAR; PG8_MMA(1, 0, At, B0); PG8_MMA(1, 1, At, B1); PG8_BAR; PG8_SCHED;
            PG8_LDB(B0, 1, 0); PG8_LDB(B1, 1, 1); PG8_SCHED; PG8_LDA(At, 1, 0); PG8_STAGE(PG8_SA(0, 1), a2 + hstep, voffA);
            PG8_WAIT_V(8); PG8_WAIT_L(0); PG8_BAR; PG8_MMA(0, 0, At, B0); PG8_MMA(0, 1, At, B1); PG8_BAR; PG8_SCHED;
            PG8_LDA(At, 1, 1); PG8_STAGE(PG8_SB(1, 0), b3, voffB); PG8_STAGE(PG8_SB(1, 1), b3 + hstep, voffB); PG8_STAGE(PG8_SA(1, 0), a3, voffA);
            PG8_WAIT_V(8); PG8_WAIT_L(0); PG8_BAR; PG8_MMA(1, 0, At, B0); PG8_MMA(1, 1, At, B1); PG8_BAR; PG8_SCHED;
            } else {
            PG8_LDB(B0, 0, 0); PG8_SCHED; PG8_LDA(At, 0, 0); PG8_STAGE(PG8_SA(1, 1), a1 + hstep, voffA);
            PG8_WAIT_L(8); PG8_BAR; PG8_WAIT_L(0); PG8_MMA(0, 0, At, B0); PG8_BAR; PG8_SCHED;
            PG8_LDB(B1, 0, 1); PG8_STAGE(PG8_SB(0, 0), b2, voffB);
            PG8_BAR; PG8_WAIT_L(0); PG8_MMA(0, 1, At, B1); PG8_BAR;
            PG8_LDA(At, 0, 1); PG8_STAGE(PG8_SA(0, 0), a2, voffA);
            PG8_BAR; PG8_WAIT_L(0); PG8_MMA(1, 0, At, B0); PG8_BAR; PG8_SCHED;
            PG8_STAGE(PG8_SB(0, 1), b2 + hstep, voffB);
            PG8_WAIT_V(6); PG8_BAR; PG8_MMA(1, 1, At, B1); PG8_BAR;
            PG8_LDB(B0, 1, 0); PG8_SCHED; PG8_LDA(At, 1, 0); PG8_STAGE(PG8_SA(0, 1), a2 + hstep, voffA);
            PG8_WAIT_L(8); PG8_BAR; PG8_WAIT_L(0); PG8_MMA(0, 0, At, B0); PG8_BAR; PG8_SCHED;
            PG8_LDB(B1, 1, 1); PG8_STAGE(PG8_SB(1, 0), b3, voffB);
            PG8_BAR; PG8_WAIT_L(0); PG8_MMA(0, 1, At, B1); PG8_BAR;
            PG8_LDA(At, 1, 1); PG8_STAGE(PG8_SA(1, 0), a3, voffA);
            PG8_BAR; PG8_WAIT_L(0); PG8_MMA(1, 0, At, B0); PG8_BAR; PG8_SCHED;
            PG8_STAGE(PG8_SB(1, 1), b3 + hstep, voffB);
            PG8_WAIT_V(6); PG8_BAR; PG8_MMA(1, 1, At, B1); PG8_BAR;
            }
        }
        if constexpr (ALIGN_EPI) { if (wr == 0) PG8_BAR; }
        if constexpr (!Epi::AFTER_DRAIN) { E(acc, cur, wr, wc, fr, fq); S.done(cur); }
        if (!has_next) break;
#pragma unroll
        for (int a = 0; a < 2; ++a)
#pragma unroll
            for (int b = 0; b < 2; ++b)
#pragma unroll
                for (int m = 0; m < 4; ++m)
#pragma unroll
                    for (int n = 0; n < 2; ++n) acc[a][b][m][n] = (f32x4){0.f, 0.f, 0.f, 0.f};
        cur = nxt; cA = nA; cB = nB; ++ui;
        if constexpr (ALIGN_EPI) { if (wr == 1) PG8_BAR; }
    }
    PG8_WAIT_V(0);
    if constexpr (!ALIGN_EPI) { if (wr == 0) PG8_BAR; }
    PG8_BAR;
    if constexpr (Epi::AFTER_DRAIN) { E.fused(acc, cur, wr, wc, fr, fq, lds, wid, lane); S.done(cur); }
#undef PG8_SA
#undef PG8_SB
#undef PG8_STAGE
#undef PG8_LDA
#undef PG8_LDB
#undef PG8_MMA
#undef PG8_WAIT_V
#undef PG8_WAIT_L
#undef PG8_BAR
#undef PG8_SCHED
}
}
namespace pg8 {
struct EpiBf16 {
    static constexpr bool PERM = true, AFTER_DRAIN = false;
    bf16_t* O; int ldc;
    __device__ __forceinline__ void operator()(const f32x4 (&acc)[2][2][4][2], const Unit& u, int wr, int wc, int fr, int fq) const {
        const int row0 = u.pm * BM + wr * 64 + fr; const int col0 = u.pn * BM + wc * 32 + 8 * fq;
#pragma unroll
        for (int ai = 0; ai < 2; ++ai)
#pragma unroll
            for (int m = 0; m < 4; ++m) { bf16_t* rowp = O + (size_t)(row0 + ai * HALF + m * 16) * ldc + col0;
#pragma unroll
                for (int bj = 0; bj < 2; ++bj) { const f32x4 v0 = acc[ai][bj][m][0], v1 = acc[ai][bj][m][1];
                    u32x4 w; w.x = cvt_pk_bf16(v0[0], v0[1]); w.y = cvt_pk_bf16(v0[2], v0[3]); w.z = cvt_pk_bf16(v1[0], v1[1]); w.w = cvt_pk_bf16(v1[2], v1[3]);
                    *(u32x4*)(rowp + bj * HALF) = w; } }
    }
};
struct EpiSwiGLU {
    static constexpr bool PERM = true, AFTER_DRAIN = false;
    bf16_t* O; int ldc;
    __device__ __forceinline__ void operator()(const f32x4 (&acc)[2][2][4][2], const Unit& u, int wr, int wc, int fr, int fq) const {
        const int row0 = u.pm * BM + wr * 64 + fr; const int col0 = u.pn * HALF + wc * 32 + 8 * fq;
#pragma unroll
        for (int ai = 0; ai < 2; ++ai)
#pragma unroll
            for (int m = 0; m < 4; ++m) { bf16_t* rowp = O + (size_t)(row0 + ai * HALF + m * 16) * ldc + col0;
                float r[8];
#pragma unroll
                for (int n = 0; n < 2; ++n)
#pragma unroll
                    for (int j = 0; j < 4; ++j) { const float a = acc[ai][0][m][n][j], b = acc[ai][1][m][n][j]; r[n * 4 + j] = a * b * __builtin_amdgcn_rcpf(1.0f + __expf(-a)); }
                u32x4 w; w.x = cvt_pk_bf16(r[0], r[1]); w.y = cvt_pk_bf16(r[2], r[3]); w.z = cvt_pk_bf16(r[4], r[5]); w.w = cvt_pk_bf16(r[6], r[7]);
                *(u32x4*)rowp = w; }
    }
};
struct MoeOrder {
    const PG8_LAS int* pref; int nN, G, c, total;
    __device__ __forceinline__ void init(const PG8_LAS int* pref_, int nN_, int G_, int c_) { pref = pref_; nN = nN_; G = G_; c = c_; total = pref_[32] * nN_; }
    __device__ __forceinline__ bool next(int i, Unit& u) const {
        const int L = i * G + c; if (L >= total) return false;
        const int rt = L / nN, pn = L - rt * nN; int e = 0;
#pragma unroll 1
        for (int k = 1; k < 32; ++k) e += (pref[k] <= rt) ? 1 : 0;
        u.pm = rt; u.pn = pn; u.pnb = e * nN + pn; return true;
    }
    __device__ __forceinline__ void a_ready(const Unit&) const {}
    __device__ __forceinline__ void done(const Unit&) const {}
};
}
#define XB_TMO      128
#define XB_XCNT(j)  (256  + 64 * (j))
#define XB_XSUB(j)  (1280 + 64 * (j))
#define XB_XGEN(j)  (2304 + 64 * (j))
#define XB_TOP      3328
#define XB_TOPGEN   3392
#define XCD_BAR_WORDS 3456
#define XB_SPIN_CAP (1u << 22)

__device__ __forceinline__ unsigned xb_ld(unsigned* p)              { return __hip_atomic_load(p, __ATOMIC_RELAXED, __HIP_MEMORY_SCOPE_AGENT); }
__device__ __forceinline__ unsigned xb_add(unsigned* p, unsigned v) { return __hip_atomic_fetch_add(p, v, __ATOMIC_RELAXED, __HIP_MEMORY_SCOPE_AGENT); }
__device__ __forceinline__ unsigned xb_xcc_id() { return (unsigned)__builtin_amdgcn_s_getreg((3 << 11) | 20) & 0xFu; }
#define XB_SPIN(cond, bar) do { unsigned _sp = 0; while (cond) { __builtin_amdgcn_s_sleep(1); \
    if ((++_sp & 255u) == 0u) { if (xb_ld(&(bar)[XB_TMO])) break; if (_sp > XB_SPIN_CAP) { atomicAdd(&(bar)[XB_TMO], 1u); break; } } } } while (0)

struct XcdBarrier {
    unsigned* bar; unsigned x;
    volatile LAS unsigned* st;
};

__device__ __forceinline__ XcdBarrier xcd_barrier_post(unsigned* bar, volatile LAS unsigned* st) {
    XcdBarrier b; b.bar = bar; b.x = xb_xcc_id(); b.st = st;
    if (hw_tid() == 0) (void)xb_add(&bar[XB_XCNT(b.x)], 1u);
    return b;
}
__device__ __forceinline__ void xcd_barrier_complete(unsigned* bar, unsigned x, unsigned& nloc, unsigned& nx) {
    const unsigned G = gridDim.x * gridDim.y * gridDim.z;
    unsigned sum, cnt, mine, sp = 0u;
    for (;;) {
        sum = 0u; cnt = 0u; mine = 0u;
#pragma unroll
        for (unsigned j = 0; j < 16; ++j) { const unsigned c = xb_ld(&bar[XB_XCNT(j)]); sum += c; cnt += (c > 0u) ? 1u : 0u; mine = (j == x) ? c : mine; }
        if (sum == G) break;
        __builtin_amdgcn_s_sleep(1);
        if ((++sp & 255u) == 0u) { if (xb_ld(&bar[XB_TMO])) break; if (sp > XB_SPIN_CAP) { atomicAdd(&bar[XB_TMO], 1u); break; } }
    }
    nloc = mine > 0u ? mine : 1u; nx = cnt > 0u ? cnt : 1u;
}

__device__ __forceinline__ void xcd_barrier(const XcdBarrier& b) {
    asm volatile("s_waitcnt vmcnt(0)" ::: "memory");
    __syncthreads();
    if (hw_tid() == 0) {
        unsigned* bar = b.bar;
        __builtin_amdgcn_s_waitcnt(0);
        unsigned nloc = b.st[0], nx = b.st[1];
        if (nloc == 0u) { xcd_barrier_complete(bar, b.x, nloc, nx); b.st[0] = nloc; b.st[1] = nx; }
        const unsigned old = xb_add(&bar[XB_XSUB(b.x)], 1u);
        const unsigned gen = old / nloc;
        if (old + 1u == (gen + 1u) * nloc) {
            __builtin_amdgcn_fence(__ATOMIC_RELEASE, "agent");
            asm volatile("s_waitcnt vmcnt(0)" ::: "memory");
            const unsigned og = xb_add(&bar[XB_TOP], 1u);
            const unsigned tg = og / nx;
            if (og + 1u == (tg + 1u) * nx) xb_add(&bar[XB_TOPGEN], 1u);
            else XB_SPIN(xb_ld(&bar[XB_TOPGEN]) == tg, bar);
            __builtin_amdgcn_fence(__ATOMIC_ACQUIRE, "agent");
            xb_add(&bar[XB_XGEN(b.x)], 1u);
            asm volatile("s_waitcnt vmcnt(0)" ::: "memory");
        } else {
            XB_SPIN(xb_ld(&bar[XB_XGEN(b.x)]) == gen, bar);
            __builtin_amdgcn_fence(__ATOMIC_ACQUIRE, "agent");
            asm volatile("s_waitcnt vmcnt(0)" ::: "memory");
        }
    }
    __syncthreads();
}
struct Args { const float* in[30]; float* out; unsigned char* ws; int ph_lo, ph_hi; };
#define CAS __attribute__((address_space(4)))
struct KA { const CAS unsigned char* kp;
    __device__ __forceinline__ const float* in(int i) const { return *(const float* const CAS*)(kp + 8 * i); }
    __device__ __forceinline__ float* out() const { return *(float* const CAS*)(kp + 240); }
    __device__ __forceinline__ unsigned char* ws() const { return *(unsigned char* const CAS*)(kp + 248); } };
__device__ __forceinline__ KA ka_get() { const CAS unsigned char* kp = (const CAS unsigned char*)__builtin_amdgcn_kernarg_segment_ptr(); asm volatile("" : "+s"(kp)); return KA{kp}; }
__device__ __forceinline__ int opaque_tid() { return hw_tid(); }
static_assert(sizeof(Args) == 264, "kernarg layout");
enum { I_X = 0, I_C, I_CTX, I_CCTX, I_ADAW, I_ADAB, I_WIN, I_RPB, I_MUP, I_MUN, I_W0, I_W2, I_A0, I_A2, I_G2, I_KK, I_KA, I_RK, I_GNG, I_GNB, I_WOUT, I_LN1G, I_LN1B, I_LN2G, I_LN2B, I_RW, I_RB, I_EW1, I_EW3, I_EW2 };

__device__ __forceinline__ void transpose_item(const float* W, int N, int k0, int n0, bf16* WT, int ldk, int drow0, LAS float* scr, int lane) {
#pragma unroll 8
    for (int i = 0; i < 32; ++i) { const int kk = 2 * i + (lane >> 5); scr[kk * 33 + (lane & 31)] = W[(size_t)(k0 + kk) * N + n0 + (lane & 31)]; }
    LDS_WAIT(); asm volatile("" ::: "memory");
    const int c = lane & 7;
#pragma unroll
    for (int j = 0; j < 4; ++j) { const int n = (lane >> 3) + 8 * j; const LAS float* s = scr + (8 * c) * 33 + n;
        v4u o; o.x = pk2(s[0 * 33], s[1 * 33]); o.y = pk2(s[2 * 33], s[3 * 33]); o.z = pk2(s[4 * 33], s[5 * 33]); o.w = pk2(s[6 * 33], s[7 * 33]);
        *(GAS v4u*)(WT + (size_t)(drow0 + n) * ldk + k0 + 8 * c) = o; }
    LDS_WAIT(); asm volatile("" ::: "memory");
}

__device__ __forceinline__ void phase_prologue(LAS unsigned char* lds) {
    const KA a = ka_get();
    const int tid = opaque_tid(), lane = tid & 63, wave = __builtin_amdgcn_readfirstlane(tid >> 6), G = gridDim.x, bid = blockIdx.x;
    const int gw = bid * 8 + wave, NGW = G * 8;
    bf16* WINT = (bf16*)(a.ws() + WS_WINT); bf16* WOT = (bf16*)(a.ws() + WS_WOT);
    LAS float* scr = (LAS float*)(lds + wave * 16384);
    constexpr int I_IN = 16 * 103, I_OUT = 16 * 32, I_L = I_IN + I_OUT;
    for (int it = gw; it < 2 * I_L; it += NGW) {
        const int l = it / I_L; int r = it - l * I_L;
        if (r < I_IN) { const int kb = r / 103, nb = r - kb * 103; transpose_item(a.in(I_WIN) + (size_t)l * DM * DIN, DIN, 64 * kb, 32 * nb, WINT + (size_t)l * DINP * DM, DM, 32 * nb, scr, lane); }
        else { r -= I_IN; const int kb = r >> 5, nb = r & 31; transpose_item(a.in(I_WOUT) + (size_t)l * DM * DM, DM, 64 * kb, 32 * nb, WOT + (size_t)l * DM * DM, DM, 32 * nb, scr, lane); }
    }
    for (int i = bid * 512 + tid; i < 8192; i += G * 512) { const int l = i >> 12, r = i & 4095; *(GAS v4u*)(WINT + (size_t)l * DINP * DM + (size_t)DIN * DM + (size_t)r * 8) = (v4u){0u, 0u, 0u, 0u}; }
    { float* rp = (float*)(a.ws() + WS_ROPE); const int i = bid * 512 + tid;
      if (i < 1536) { const int idx = i < 512 ? i : i - 512; const int p = idx >> 4, f = idx & 15; const double inv = exp(-(double)f * (9.210340371976184 / 16.0)); const double ang = (double)p * inv;
          const float cs = (float)cos(ang), sn = (float)sin(ang); if (i < 512) { rp[idx] = cs; rp[512 + idx] = sn; } else { rp[1024 + idx] = cs; rp[2048 + idx] = sn; } } }
    __syncthreads();
    LAS float* sl = (LAS float*)lds; LAS float* red = (LAS float*)(lds + 69632);
    for (int i = tid; i < 17 * 1024; i += 512) { const int r = i >> 10, k = i & 1023; const float v = r < 16 ? a.in(I_C)[r * 1024 + k] : a.in(I_CCTX)[k]; sl[i] = v / (1.0f + expf(-v)); }
    __syncthreads();
    float* mods = (float*)(a.ws() + WS_MODS);
    for (int it = bid; it < 192; it += G) {
        const int l = it / 96, ch = it - l * 96; const int kq = tid >> 6, cl = tid & 63, col = ch * 64 + cl;
        const float* W = a.in(I_ADAW) + (size_t)l * DM * 6144 + col;
        float acc[17];
#pragma unroll
        for (int r = 0; r < 17; ++r) acc[r] = 0.f;
        for (int k0 = kq * 128; k0 < kq * 128 + 128; k0 += 8) { float w8[8];
#pragma unroll
            for (int q = 0; q < 8; ++q) w8[q] = W[(size_t)(k0 + q) * 6144];
#pragma unroll
            for (int r = 0; r < 17; ++r) { const f32x4 s0 = *(const LAS f32x4*)(sl + r * 1024 + k0), s1 = *(const LAS f32x4*)(sl + r * 1024 + k0 + 4);
                acc[r] += s0.x * w8[0] + s0.y * w8[1] + s0.z * w8[2] + s0.w * w8[3] + s1.x * w8[4] + s1.y * w8[5] + s1.z * w8[6] + s1.w * w8[7]; } }
#pragma unroll
        for (int r = 0; r < 17; ++r) red[(kq * 17 + r) * 64 + cl] = acc[r];
        __syncthreads();
        for (int i = tid; i < 17 * 64; i += 512) { const int r = i >> 6, c2 = i & 63; float s = 0.f;
#pragma unroll
            for (int q = 0; q < 8; ++q) s += red[(q * 17 + r) * 64 + c2];
            mods[((size_t)l * 17 + r) * 6144 + ch * 64 + c2] = s + a.in(I_ADAB)[l * 6144 + ch * 64 + c2]; }
        __syncthreads();
    }
}

__device__ __forceinline__ void phase_modconv(LAS unsigned char* lds, int l) {
    const KA a = ka_get();
    const int tid = opaque_tid(), lane = tid & 63, wave = __builtin_amdgcn_readfirstlane(tid >> 6), G = gridDim.x, bid = blockIdx.x;
    const int gw = bid * 8 + wave, NGW = G * 8;
    const float* mods = (const float*)(a.ws() + WS_MODS) + (size_t)l * 17 * 6144;
    bf16* XM = (bf16*)(a.ws() + WS_X1);
    const float* xs = a.in(I_X); const float* cs = a.in(I_CTX);
    const int RPW = (NTOK + NGW - 1) / NGW, m0 = gw * RPW, mend = (m0 + RPW < NTOK) ? m0 + RPW : NTOK;
    if (m0 < mend) {
        f32x4 nx[4];
#define MODC_FETCH(M) do { const int m_ = (M) < mend ? (M) : mend - 1; const GAS f32x4* xr_ = (const GAS f32x4*)(m_ < NTX ? xs + (size_t)m_ * DM : cs + (size_t)(m_ - NTX) * DM) + lane; \
            _Pragma("unroll") for (int j_ = 0; j_ < 4; ++j_) nx[j_] = xr_[64 * j_]; } while (0)
        MODC_FETCH(m0);
        for (int m = m0; m < mend; ) {
            const int mr = m < NTX ? m / SEQ : 16; int segend = m < NTX ? (mr + 1) * SEQ : NTOK; segend = segend < mend ? segend : mend;
            const GAS f32x4* sh = (const GAS f32x4*)(mods + (size_t)mr * 6144) + lane; const GAS f32x4* sc = sh + 256;
            f32x4 shv[4], scv[4];
#pragma unroll
            for (int j = 0; j < 4; ++j) { shv[j] = sh[64 * j]; scv[j] = sc[64 * j]; }
            for (; m < segend; ++m) {
                f32x4 v[4];
#pragma unroll
                for (int j = 0; j < 4; ++j) v[j] = nx[j];
                MODC_FETCH(m + 1);
                GAS v2u* o8 = (GAS v2u*)(XM + (size_t)m * DM) + lane;
#pragma unroll
                for (int j = 0; j < 4; ++j) { const f32x4 r = v[j] * (scv[j] + 1.0f) + shv[j]; v2u w; w.x = pk2(r.x, r.y); w.y = pk2(r.z, r.w); o8[64 * j] = w; }
            }
        }
#undef MODC_FETCH
    }
}

__device__ __forceinline__ void phase_scan_direct(LAS unsigned char* lds, int l) {
    const KA a = ka_get();
    constexpr int TB = 32;
    const int tid = opaque_tid(), lane = tid & 63, wv = __builtin_amdgcn_readfirstlane(tid >> 6);
    LAS float* ops = (LAS float*)lds;
    LAS float* scal = (LAS float*)(lds + 49152);
    LAS float* zl = (LAS float*)(lds + 49664);
    LAS float* rkraw = (LAS float*)(lds + 57856);
    LAS float* ybuf = (LAS float*)(lds + 74240);
    const bf16* PX = (const bf16*)(a.ws() + WS_X2); float* YD = (float*)(a.ws() + WS_X3); float* BON = (float*)(a.ws() + WS_BONUS); const float* rope = (const float*)(a.ws() + WS_ROPE);
    const float* mup = a.in(I_MUP) + l * 1760; const float* mun = a.in(I_MUN) + l * 1760;
    for (int chain = blockIdx.x; chain < 256; chain += gridDim.x) {
        const int b = chain >> 4, h = (chain >> 1) & 7, d = chain & 1, c = lane;
        float w2c[32], a2c[32];
#pragma unroll
        for (int j = 0; j < 32; ++j) { w2c[j] = a.in(I_W2)[((size_t)(l * 2 + d) * 32 + j) * 512 + h * 64 + c]; a2c[j] = a.in(I_A2)[((size_t)(l * 2 + d) * 32 + j) * 512 + h * 64 + c]; }
        const float w0c = a.in(I_W0)[(l * 2 + d) * 512 + h * 64 + c], a0c = a.in(I_A0)[(l * 2 + d) * 512 + h * 64 + c];
        const float kkc = a.in(I_KK)[l * 512 + h * 64 + c], kac = a.in(I_KA)[l * 512 + h * 64 + c], rkc = a.in(I_RK)[l * 512 + h * 64 + c];
        const int colr = h * 64 + c, colk = 512 + colr, colv = 1024 + colr, coll = (c < 32) ? (1536 + d * 32 + c) : (1600 + d * 32 + (c - 32));
        const float mpr = mup[colr], mnr = mun[colr], mpk = mup[colk], mnk = mun[colk], mpv = mup[colv], mnv = mun[colv], mpl = mup[coll], mnl = mun[coll];
        float S[8];
#pragma unroll
        for (int j = 0; j < 8; ++j) S[j] = 0.f;
        const int vl = lane >> 3, kq = lane & 7, vrow = 8 * wv + vl;
        for (int seq = 0; seq < 2; ++seq) {
            const int T = seq ? SEQ : CTXL, rowbase = seq ? b * SEQ : NTX + b * CTXL, nblk = T / TB;
            for (int bi = 0; bi < nblk; ++bi) {
                const int tb = d ? (nblk - 1 - bi) : bi, t0 = tb * TB;
                float zv[4];
#pragma unroll
                for (int i = 0; i < 4; ++i) {
                    const int tl = wv + 8 * i, t = t0 + tl; const bf16* p = PX + (size_t)(rowbase + t) * DINP + RWOFF;
                    const bool hp = t > 0, hn = t + 1 < T;
                    const float cr = bf2f(p[colr]), ck = bf2f(p[colk]), cv = bf2f(p[colv]), cl_ = bf2f(p[coll]);
                    const float pr = hp ? bf2f(p[colr - DINP]) : 0.f, pk = hp ? bf2f(p[colk - DINP]) : 0.f, pv = hp ? bf2f(p[colv - DINP]) : 0.f, pl = hp ? bf2f(p[coll - DINP]) : 0.f;
                    const float nr = hn ? bf2f(p[colr + DINP]) : 0.f, nk = hn ? bf2f(p[colk + DINP]) : 0.f, nv = hn ? bf2f(p[colv + DINP]) : 0.f, nl = hn ? bf2f(p[coll + DINP]) : 0.f;
                    const float zr = cr + mpr * (pr - cr) + mnr * (nr - cr), zk = ck + mpk * (pk - ck) + mnk * (nk - ck);
                    zv[i] = cv + mpv * (pv - cv) + mnv * (nv - cv);
                    const float zz = cl_ + mpl * (pl - cl_) + mnl * (nl - cl_);
                    rkraw[tl * 128 + c] = zr; rkraw[tl * 128 + 64 + c] = zk; zl[tl * 64 + c] = (c < 32) ? tanhf(zz) : zz;
                }
                __syncthreads();
#pragma unroll
                for (int i = 0; i < 4; ++i) {
                    const int tl = wv + 8 * i, t = t0 + tl;
                    float r = rkraw[tl * 128 + c], k = rkraw[tl * 128 + 64 + c];
                    if (seq) { const float rp = rkraw[tl * 128 + (c ^ 16)], kp = rkraw[tl * 128 + 64 + (c ^ 16)]; const int qd = c >> 4, f = c & 15;
                        const int ti = (qd < 2) ? ((t >> 6) * 16 + f) : (1024 + (t & 63) * 16 + f); const float cs = rope[ti], sn = rope[ti + ((qd < 2) ? 512 : 1024)];
                        const float sg = (qd & 1) ? sn : -sn; r = r * cs + rp * sg; k = k * cs + kp * sg; }
                    const float kkr = k * kkc; const float ss = wave_sum(kkr * kkr); const float kk = kkr / fmaxf(sqrtf(ss), 1e-12f);
                    float u = w0c, av = a0c;
#pragma unroll
                    for (int j = 0; j < 32; j += 4) { const f32x4 z1 = *(const LAS f32x4*)(zl + tl * 64 + j), z2 = *(const LAS f32x4*)(zl + tl * 64 + 32 + j);
                        u += z1.x * w2c[j] + z1.y * w2c[j + 1] + z1.z * w2c[j + 2] + z1.w * w2c[j + 3]; av += z2.x * a2c[j] + z2.y * a2c[j + 1] + z2.z * a2c[j + 2] + z2.w * a2c[j + 3]; }
                    const float w = expf(-0.6065306597126334f * sigmoidf_(u)), aa = sigmoidf_(av);
                    const float kd = k * (1.0f + (aa - 1.0f) * kac), nb = -kk * aa;
                    const float c1 = wave_sum(nb * r), c2 = wave_sum(kd * r), bon = wave_sum(r * kd * rkc);
                    LAS float* o = ops + tl * 384 + c; o[0] = kk; o[64] = w * r; o[128] = w; o[192] = nb; o[256] = kd; o[320] = zv[i];
                    if (lane == 0) { scal[tl * 4] = c1; scal[tl * 4 + 1] = c2; BON[((size_t)d * NTOK + rowbase + t) * 8 + h] = bon; }
                }
                __syncthreads();
#pragma unroll 2
                for (int s = 0; s < TB; ++s) {
                    const int tl = d ? (TB - 1 - s) : s; const LAS float* o = ops + tl * 384 + kq * 8;
                    const f32x4 ka = *(const LAS f32x4*)(o), kb = *(const LAS f32x4*)(o + 4), ra = *(const LAS f32x4*)(o + 64), rb = *(const LAS f32x4*)(o + 68);
                    const f32x4 wa = *(const LAS f32x4*)(o + 128), wb = *(const LAS f32x4*)(o + 132), na = *(const LAS f32x4*)(o + 192), nb_ = *(const LAS f32x4*)(o + 196);
                    const f32x4 da = *(const LAS f32x4*)(o + 256), db = *(const LAS f32x4*)(o + 260);
                    const float vv = ops[tl * 384 + 320 + vrow], c1 = scal[tl * 4], c2 = scal[tl * 4 + 1];
                    float sk = S[0] * ka.x + S[1] * ka.y + S[2] * ka.z + S[3] * ka.w + S[4] * kb.x + S[5] * kb.y + S[6] * kb.z + S[7] * kb.w;
                    float yy = S[0] * ra.x + S[1] * ra.y + S[2] * ra.z + S[3] * ra.w + S[4] * rb.x + S[5] * rb.y + S[6] * rb.z + S[7] * rb.w;
                    sk = red8(sk); yy = red8(yy);
                    const float y = yy + sk * c1 + vv * c2;
                    S[0] = S[0] * wa.x + sk * na.x + vv * da.x; S[1] = S[1] * wa.y + sk * na.y + vv * da.y; S[2] = S[2] * wa.z + sk * na.z + vv * da.z; S[3] = S[3] * wa.w + sk * na.w + vv * da.w;
                    S[4] = S[4] * wb.x + sk * nb_.x + vv * db.x; S[5] = S[5] * wb.y + sk * nb_.y + vv * db.y; S[6] = S[6] * wb.z + sk * nb_.z + vv * db.z; S[7] = S[7] * wb.w + sk * nb_.w + vv * db.w;
                    if (kq == 0) ybuf[tl * 64 + vrow] = y;
                }
                __syncthreads();
#pragma unroll
                for (int i = 0; i < 4; ++i) { const int tl = wv + 8 * i; YD[((size_t)d * NTOK + rowbase + t0 + tl) * 512 + h * 64 + c] = ybuf[tl * 64 + c]; }
            }
        }
        __syncthreads();
    }
}

typedef short v4i16_t __attribute__((ext_vector_type(4)));
__device__ __forceinline__ int swz_off(int row, int chunk) { return row * 128 + ((chunk ^ (row & 7)) << 4); }
__device__ __forceinline__ void stage_rows(LAS unsigned char* dst, const bf16* src, int nrows, int tid) {
    for (int idx = tid; idx < nrows * 8; idx += 512) { const int r = idx >> 3, ch = idx & 7; const v4u v = *(const GAS v4u*)(src + (size_t)r * DINP + ch * 8); *(LAS v4u*)(dst + swz_off(r, ch)) = v; }
}
__device__ __forceinline__ bf16x8 q_scale8(bf16x8 q) { const v4u w = __builtin_bit_cast(v4u, q); v4u r;
    r.x = pk2(bflo(w.x) * 0.125f, bfhi(w.x) * 0.125f); r.y = pk2(bflo(w.y) * 0.125f, bfhi(w.y) * 0.125f); r.z = pk2(bflo(w.z) * 0.125f, bfhi(w.z) * 0.125f); r.w = pk2(bflo(w.w) * 0.125f, bfhi(w.w) * 0.125f);
    return __builtin_bit_cast(bf16x8, r); }
struct AttState { float m, l; f32x4 o[4]; };
struct AttOff { int k[2]; int v[4]; int boff; unsigned okm; };
__device__ __forceinline__ AttOff att_offsets(int lane, int wc0, int qc, int cs) { AttOff o; const int kl = lane & 15, g = lane >> 4, q_ = kl >> 2, p_ = kl & 3;
#pragma unroll
    for (int dh = 0; dh < 2; ++dh) o.k[dh] = swz_off(kl, dh * 4 + g);
#pragma unroll
    for (int dt = 0; dt < 4; ++dt) o.v[dt] = swz_off(4 * g + q_, 2 * dt + (p_ >> 1)) + (p_ & 1) * 8;
    o.boff = (wc0 + 4 * g - qc + 15) * 4; o.okm = 0u;
#pragma unroll
    for (int j = 0; j < 8; ++j) { const int kc = wc0 + (j >> 2) * 16 + 4 * g + (j & 3); if ((kc >= cs) && (kc < cs + 16)) o.okm |= 1u << j; }
    return o; }
template <bool LOCAL>
__device__ __forceinline__ void att_kstep(AttState& st, const LAS unsigned char* kb, const LAS unsigned char* vb, int r0, const bf16x8 (&qf)[2], int lane, const AttOff& ao, const LAS float* rpbrow) {
    const LAS unsigned char* kr = kb + r0 * 128; const LAS unsigned char* vr = vb + r0 * 128;
    f32x4 s0 = {0.f, 0.f, 0.f, 0.f}, s1 = {0.f, 0.f, 0.f, 0.f};
#pragma unroll
    for (int dh = 0; dh < 2; ++dh) {
        const bf16x8 k0 = *(const LAS bf16x8*)(kr + ao.k[dh]); const bf16x8 k1 = *(const LAS bf16x8*)(kr + ao.k[dh] + 2048);
        s0 = __builtin_amdgcn_mfma_f32_16x16x32_bf16(k0, qf[dh], s0, 0, 0, 0); s1 = __builtin_amdgcn_mfma_f32_16x16x32_bf16(k1, qf[dh], s1, 0, 0, 0);
    }
    float sc[8];
#pragma unroll
    for (int j = 0; j < 4; ++j) { sc[j] = s0[j]; sc[4 + j] = s1[j]; }
    if (LOCAL) {
        float bv[8]; const unsigned ad = (unsigned)(uintptr_t)rpbrow + (unsigned)ao.boff;
#pragma unroll
        for (int j = 0; j < 8; ++j) asm volatile("ds_read_b32 %0, %1 offset:%2" : "=v"(bv[j]) : "v"(ad), "i"(((j >> 2) * 16 + (j & 3)) * 4));
        asm volatile("s_waitcnt lgkmcnt(0)" : "+v"(bv[0]), "+v"(bv[1]), "+v"(bv[2]), "+v"(bv[3]), "+v"(bv[4]), "+v"(bv[5]), "+v"(bv[6]), "+v"(bv[7]) :: "memory");
#pragma unroll
        for (int j = 0; j < 8; ++j) sc[j] = ((ao.okm >> j) & 1u) ? sc[j] + bv[j] : -INFINITY;
    }
    float mt = fmaxf(fmaxf(fmaxf(sc[0], sc[1]), fmaxf(sc[2], sc[3])), fmaxf(fmaxf(sc[4], sc[5]), fmaxf(sc[6], sc[7])));
    mt = fmaxf(mt, shx(mt, 16, lane)); mt = fmaxf(mt, shx(mt, 32, lane));
    if (__any(mt > st.m)) {
        const float mn = fmaxf(st.m, mt); const float scale = (mn == -INFINITY) ? 1.0f : __expf(st.m - mn); st.l *= scale; st.m = mn;
#pragma unroll
        for (int dt = 0; dt < 4; ++dt) st.o[dt] = st.o[dt] * scale; }
    float p[8], ps = 0.f; const float mref = (st.m == -INFINITY) ? 0.f : st.m;
#pragma unroll
    for (int j = 0; j < 8; ++j) { p[j] = __expf(sc[j] - mref); ps += p[j]; }
    st.l += ps;
    v4u pw; pw.x = pk2(p[0], p[1]); pw.y = pk2(p[2], p[3]); pw.z = pk2(p[4], p[5]); pw.w = pk2(p[6], p[7]);
    const bf16x8 pf = __builtin_bit_cast(bf16x8, pw);
#pragma unroll
    for (int dt = 0; dt < 4; ++dt) {
        const v4i16_t lo = __builtin_amdgcn_ds_read_tr16_b64_v4i16((LAS v4i16_t*)(vr + ao.v[dt]));
        const v4i16_t hi = __builtin_amdgcn_ds_read_tr16_b64_v4i16((LAS v4i16_t*)(vr + ao.v[dt] + 2048));
        const bf16x8 vf = (bf16x8){lo[0], lo[1], lo[2], lo[3], hi[0], hi[1], hi[2], hi[3]};
        st.o[dt] = __builtin_amdgcn_mfma_f32_16x16x32_bf16(vf, pf, st.o[dt], 0, 0, 0);
    }
}
__device__ __forceinline__ void att_merge_store(AttState& st, LAS float* mrg, int qb, int kh, int lane, bf16* orow0  ) {
    LAS float* mine = mrg + qb * (18 * 64) + lane;
    if (kh == 1) { mine[0] = st.m; mine[64] = st.l;
#pragma unroll
        for (int dt = 0; dt < 4; ++dt)
#pragma unroll
            for (int j = 0; j < 4; ++j) mine[(2 + dt * 4 + j) * 64] = st.o[dt][j]; }
    __syncthreads();
    if (kh == 0) {
        const float m1 = mine[0], l1 = mine[64]; const float ms = fmaxf(st.m, m1); const float f0 = __expf(st.m - ms), f1 = __expf(m1 - ms);
        float lc = st.l * f0 + l1 * f1; lc += shx(lc, 16, lane); lc += shx(lc, 32, lane); const float inv = 1.0f / lc;
        const int q = lane & 15, g = lane >> 4;
#pragma unroll
        for (int dt = 0; dt < 4; ++dt) { float r[4];
#pragma unroll
            for (int j = 0; j < 4; ++j) r[j] = (st.o[dt][j] * f0 + mine[(2 + dt * 4 + j) * 64] * f1) * inv;
            v2u w; w.x = pk2(r[0], r[1]); w.y = pk2(r[2], r[3]); *(GAS v2u*)(orow0 + (size_t)q * DM + dt * 16 + 4 * g) = w; }
    }
}
__device__ __forceinline__ void phase_attn(LAS unsigned char* lds, int l) {
    const KA a = ka_get();
    const int tid = opaque_tid(), lane = tid & 63, wv = __builtin_amdgcn_readfirstlane(tid >> 6), qb = wv & 3, kh = wv >> 2;
    LAS unsigned char* KC = lds; LAS unsigned char* VC = lds + 32768; LAS unsigned char* KL = lds + 65536; LAS unsigned char* VL = lds + 98304;
    LAS float* RPB = (LAS float*)(lds + LDSCTL_OFF + 2048); LAS float* mrg = (LAS float*)KL;
    const bf16* PX = (const bf16*)(a.ws() + WS_X2); bf16* CAT = (bf16*)(a.ws() + WS_X1);
    for (int blk = blockIdx.x; blk < 256; blk += gridDim.x) {
        const int bh = blk >> 1, b = bh >> 3, h = bh & 7, half = blk & 1;
        __syncthreads();
        const bf16* ctxrow = PX + (size_t)(NTX + b * CTXL) * DINP + h * 64;
        stage_rows(KC, ctxrow + 512, 256, tid); stage_rows(VC, ctxrow + 1024, 256, tid);
        for (int i = tid; i < 465; i += 512) RPB[i] = a.in(I_RPB)[((size_t)l * 8 + h) * 465 + i];
        __syncthreads();
        const int kl = lane & 15, g = lane >> 4;
        const AttOff ao = att_offsets(lane, min(max(qb * 16 - 8, 0), 32), qb * 16 + kl, min(max(qb * 16 + kl - 8, 0), 48));
        if (l == 0) {
            for (int rr = 0; rr < 2; ++rr) {
                const int q0 = (half * 8 + rr * 4 + qb) * 16; const bf16* qrow = ctxrow + (size_t)(q0 + kl) * DINP;
                bf16x8 qf[2]; qf[0] = q_scale8(*(const GAS bf16x8*)(qrow + 8 * g)); qf[1] = q_scale8(*(const GAS bf16x8*)(qrow + 32 + 8 * g));
                AttState st; st.m = -INFINITY; st.l = 0.f;
#pragma unroll
                for (int dt = 0; dt < 4; ++dt) st.o[dt] = (f32x4){0.f, 0.f, 0.f, 0.f};
                for (int s = 0; s < 4; ++s) att_kstep<false>(st, KC, VC, kh * 128 + s * 32, qf, lane, ao, RPB);
                att_merge_store(st, mrg, qb, kh, lane, CAT + (size_t)(NTX + b * CTXL + q0) * DM + h * 64);
                __syncthreads();
            }
        }
        v4u pfk0[4], pfv0[4], pfk1[4], pfv1[4];
#define ATT_ISSUE(SIDX, pfk, pfv) do { const int i_ = half * 16 + ((SIDX) >> 1); const int rs_ = min(max(i_ - 4, 0), 24); const bf16* lr_ = PX + (size_t)(b * SEQ + (rs_ + 4 * ((SIDX) & 1)) * 64) * DINP + h * 64; \
            _Pragma("unroll") for (int q__ = 0; q__ < 4; ++q__) { const int idx_ = tid + 512 * q__; const bf16* p_ = lr_ + (size_t)(idx_ >> 3) * DINP + (idx_ & 7) * 8; pfk[q__] = *(const GAS v4u*)(p_ + 512); pfv[q__] = *(const GAS v4u*)(p_ + 1024); } } while (0)
        ATT_ISSUE(0, pfk0, pfv0); ATT_ISSUE(1, pfk1, pfv1);
        bf16x8 qn[2]; { const bf16* qrow = PX + (size_t)(b * SEQ + (half * 16) * 64 + qb * 16 + kl) * DINP + h * 64; qn[0] = *(const GAS bf16x8*)(qrow + 8 * g); qn[1] = *(const GAS bf16x8*)(qrow + 32 + 8 * g); }
        for (int ui = 0; ui < 16; ++ui) {
            const int i = half * 16 + ui; const int rs = min(max(i - 4, 0), 24);
            const int qc = qb * 16 + kl, cs = min(max(qc - 8, 0), 48), wc0 = min(max(qb * 16 - 8, 0), 32);
            bf16x8 qf[2]; qf[0] = q_scale8(qn[0]); qf[1] = q_scale8(qn[1]);
            { const int in_ = half * 16 + (ui < 15 ? ui + 1 : ui); const bf16* qrow = PX + (size_t)(b * SEQ + in_ * 64 + qc) * DINP + h * 64; qn[0] = *(const GAS bf16x8*)(qrow + 8 * g); qn[1] = *(const GAS bf16x8*)(qrow + 32 + 8 * g); }
            AttState st; st.m = -INFINITY; st.l = 0.f;
#pragma unroll
            for (int dt = 0; dt < 4; ++dt) st.o[dt] = (f32x4){0.f, 0.f, 0.f, 0.f};
            for (int s = 0; s < 4; ++s) att_kstep<false>(st, KC, VC, kh * 128 + s * 32, qf, lane, ao, RPB);
#define ATT_PASS(pass, pfk, pfv) do { \
                __syncthreads(); \
                _Pragma("unroll") for (int q__ = 0; q__ < 4; ++q__) { const int idx_ = tid + 512 * q__; const int o_ = swz_off(idx_ >> 3, idx_ & 7); *(LAS v4u*)(KL + o_) = pfk[q__]; *(LAS v4u*)(VL + o_) = pfv[q__]; } \
                __syncthreads(); \
                if (ui + 1 < 16) ATT_ISSUE(2 * (ui + 1) + (pass), pfk, pfv); \
                for (int k2 = 0; k2 < 2; ++k2) { const int kr = 2 * kh + k2, arow = rs + 4 * (pass) + kr; \
                    att_kstep<true>(st, KL, VL, kr * 64 + wc0, qf, lane, ao, RPB + (arow - i + 7) * 31); } } while (0)
            ATT_PASS(0, pfk0, pfv0);
            ATT_PASS(1, pfk1, pfv1);
#undef ATT_PASS
            __syncthreads();
            att_merge_store(st, mrg, qb, kh, lane, CAT + (size_t)(b * SEQ + i * 64 + qb * 16) * DM + h * 64);
        }
    }
}

__device__ __forceinline__ void phase_rwpost(LAS unsigned char* lds, int l) {
    const KA a = ka_get();
    const int tid = opaque_tid(), lane = tid & 63, hh = __builtin_amdgcn_readfirstlane(tid >> 6), kl = lane & 15, g = lane >> 4;
    const int er = tid >> 5, cq = tid & 31, c0 = cq * 16, hq = cq >> 2;
    LAS bf16* sig = (LAS bf16*)lds;
    LAS float* Gl = (LAS float*)(lds + 4096);
    const bf16* PX = (const bf16*)(a.ws() + WS_X2); const bf16* YD = (const bf16*)(a.ws() + WS_X3); const float* BON = (const float*)(a.ws() + WS_BONUS); bf16* CAT = (bf16*)(a.ws() + WS_X1);
    const float* mup = a.in(I_MUP) + l * 1760; const float* mun = a.in(I_MUN) + l * 1760; const float* g2 = a.in(I_G2) + (size_t)l * 96 * 512;
    const float* gngp = a.in(I_GNG) + l * 512 + c0; const float* gnbp = a.in(I_GNB) + l * 512 + c0;
    bf16x8 gb[3][4];
#pragma unroll
    for (int ks = 0; ks < 3; ++ks)
#pragma unroll
        for (int nt = 0; nt < 4; ++nt) { v4u w; unsigned t[8];
#pragma unroll
            for (int j = 0; j < 8; ++j) t[j] = f2bf(g2[(size_t)(32 * ks + 8 * g + j) * 512 + 64 * hh + 16 * nt + kl]);
            w.x = t[0] | (t[1] << 16); w.y = t[2] | (t[3] << 16); w.z = t[4] | (t[5] << 16); w.w = t[6] | (t[7] << 16); gb[ks][nt] = __builtin_bit_cast(bf16x8, w); }
    const int nch = (l == 0 ? NTOK : NTX) / 16;
    LAS float* Pl = (LAS float*)(lds + 40960);
    Pl[tid] = mup[1024 + tid]; Pl[512 + tid] = mun[1024 + tid]; Pl[1024 + tid] = a.in(I_GNG)[l * 512 + tid]; Pl[1536 + tid] = a.in(I_GNB)[l * 512 + tid];
    int sr[3], sj[3]; float smp[3], smn[3];
#pragma unroll
    for (int k = 0; k < 3; ++k) { const int idx = tid + 512 * k; sr[k] = idx / 96; sj[k] = idx - sr[k] * 96; smp[k] = mup[1664 + sj[k]]; smn[k] = mun[1664 + sj[k]]; }
    unsigned short rawc[3], rawp[3], rawn[3]; v4u vc[2], vp[2], vn[2], y0[2], y1[2]; float bon0, bon1;
#define RWP_TT(ROW, t_, T_) int t_, T_; if ((ROW) < NTX) { t_ = (ROW) & (SEQ - 1); T_ = SEQ; } else { t_ = ((ROW) - NTX) & (CTXL - 1); T_ = CTXL; }
#define RWP_RAW(CH) do { const int ch_ = (CH) < nch ? (CH) : blockIdx.x; _Pragma("unroll") for (int k = 0; k < 3; ++k) { const int row_ = ch_ * 16 + sr[k]; RWP_TT(row_, t_, T_) \
            const bf16* p_ = PX + (size_t)row_ * DINP + RWOFF + 1664 + sj[k]; rawc[k] = p_[0]; rawp[k] = p_[t_ > 0 ? -DINP : 0]; rawn[k] = p_[t_ + 1 < T_ ? DINP : 0]; } } while (0)
#define RWP_Y(CH) do { const int ch_ = (CH) < nch ? (CH) : blockIdx.x; const int row_ = ch_ * 16 + er; \
        _Pragma("unroll") for (int i = 0; i < 2; ++i) { y0[i] = *(const GAS v4u*)(YD + (size_t)row_ * 512 + c0 + 8 * i); y1[i] = *(const GAS v4u*)(YD + ((size_t)NTOK + row_) * 512 + c0 + 8 * i); } } while (0)
#define RWP_V(CH) do { const int ch_ = (CH) < nch ? (CH) : blockIdx.x; const int row_ = ch_ * 16 + er; RWP_TT(row_, t_, T_) const bf16* pvp_ = PX + (size_t)row_ * DINP + RWOFF + 1024 + c0; const int op_ = t_ > 0 ? -DINP : 0, on_ = t_ + 1 < T_ ? DINP : 0; \
        _Pragma("unroll") for (int i = 0; i < 2; ++i) { vc[i] = *(const GAS v4u*)(pvp_ + 8 * i); vp[i] = *(const GAS v4u*)(pvp_ + op_ + 8 * i); vn[i] = *(const GAS v4u*)(pvp_ + on_ + 8 * i); } \
        bon0 = BON[(size_t)row_ * 8 + hq]; bon1 = BON[((size_t)NTOK + row_) * 8 + hq]; } while (0)
    RWP_RAW(blockIdx.x); RWP_Y(blockIdx.x); RWP_V(blockIdx.x);
    for (int ch = blockIdx.x; ch < nch; ch += gridDim.x) {
        const int row0 = ch * 16;
        __syncthreads();
#pragma unroll
        for (int k = 0; k < 3; ++k) { const int row_ = row0 + sr[k]; RWP_TT(row_, t, T)
            const float cv = bf2f(rawc[k]), pv = bf2f(rawp[k]) * (t > 0 ? 1.f : 0.f), nv = bf2f(rawn[k]) * (t + 1 < T ? 1.f : 0.f);
            const float z = cv + smp[k] * (pv - cv) + smn[k] * (nv - cv); sig[sr[k] * 96 + sj[k]] = f2bf1(sigmoidf_(z)); }
        RWP_RAW(ch + (int)gridDim.x);
        const int row = row0 + er; RWP_TT(row, t, T) const float fp = t > 0 ? 1.f : 0.f, fn = t + 1 < T ? 1.f : 0.f;
        __syncthreads();
        { f32x4 acc[4];
#pragma unroll
          for (int nt = 0; nt < 4; ++nt) acc[nt] = (f32x4){0.f, 0.f, 0.f, 0.f};
#pragma unroll
          for (int ks = 0; ks < 3; ++ks) { const bf16x8 af = *(const LAS bf16x8*)(sig + kl * 96 + 32 * ks + 8 * g);
#pragma unroll
              for (int nt = 0; nt < 4; ++nt) acc[nt] = __builtin_amdgcn_mfma_f32_16x16x32_bf16(af, gb[ks][nt], acc[nt], 0, 0, 0); }
#pragma unroll
          for (int nt = 0; nt < 4; ++nt)
#pragma unroll
              for (int j = 0; j < 4; ++j) Gl[(4 * g + j) * 512 + 64 * hh + 16 * nt + kl] = acc[nt][j]; }
        __syncthreads();
        f32x4 y[4]; float s = 0.f;
#pragma unroll
        for (int i = 0; i < 4; ++i) { const unsigned a0 = y0[i >> 1][(i & 1) * 2], a1 = y0[i >> 1][(i & 1) * 2 + 1], b0 = y1[i >> 1][(i & 1) * 2], b1 = y1[i >> 1][(i & 1) * 2 + 1];
            y[i] = (f32x4){bflo(a0) + bflo(b0), bfhi(a0) + bfhi(b0), bflo(a1) + bflo(b1), bfhi(a1) + bfhi(b1)}; s += (y[i].x + y[i].y) + (y[i].z + y[i].w); }
        RWP_Y(ch + (int)gridDim.x);
        s += dppmov<0xB1>(s); s += dppmov<0x4E>(s); const float mean = s * (1.0f / 64.0f); float q = 0.f;
#pragma unroll
        for (int i = 0; i < 4; ++i) { y[i] = y[i] - mean; q += (y[i].x * y[i].x + y[i].y * y[i].y) + (y[i].z * y[i].z + y[i].w * y[i].w); }
        q += dppmov<0xB1>(q); q += dppmov<0x4E>(q); const float rstd = 1.0f / sqrtf(q * (1.0f / 64.0f) + GN_EPS);
        const float bon = bon0 + bon1;
        unsigned ow[8];
#pragma unroll
        for (int i = 0; i < 4; ++i) { const unsigned cw0 = vc[i >> 1][(i & 1) * 2], cw1 = vc[i >> 1][(i & 1) * 2 + 1], pw0 = vp[i >> 1][(i & 1) * 2], pw1 = vp[i >> 1][(i & 1) * 2 + 1], nw0 = vn[i >> 1][(i & 1) * 2], nw1 = vn[i >> 1][(i & 1) * 2 + 1];
            const f32x4 cv = {bflo(cw0), bfhi(cw0), bflo(cw1), bfhi(cw1)}, pv = {bflo(pw0) * fp, bfhi(pw0) * fp, bflo(pw1) * fp, bfhi(pw1) * fp}, nv = {bflo(nw0) * fn, bfhi(nw0) * fn, bflo(nw1) * fn, bfhi(nw1) * fn};
            const f32x4 mpv = *(const LAS f32x4*)(Pl + c0 + 4 * i), mnv = *(const LAS f32x4*)(Pl + 512 + c0 + 4 * i), gng = *(const LAS f32x4*)(Pl + 1024 + c0 + 4 * i), gnb = *(const LAS f32x4*)(Pl + 1536 + c0 + 4 * i);
            const f32x4 zv = cv + mpv * (pv - cv) + mnv * (nv - cv);
            const f32x4 gt = *(const LAS f32x4*)(Gl + er * 512 + c0 + 4 * i);
            const f32x4 o = (y[i] * rstd * gng + gnb + zv * bon) * gt;
            ow[2 * i] = pk2(o.x, o.y); ow[2 * i + 1] = pk2(o.z, o.w); }
        RWP_V(ch + (int)gridDim.x);
        GAS v4u* dst = (GAS v4u*)(CAT + (size_t)row * DM + 512 + c0); dst[0] = (v4u){ow[0], ow[1], ow[2], ow[3]}; dst[1] = (v4u){ow[4], ow[5], ow[6], ow[7]};
    }
#undef RWP_TT
#undef RWP_RAW
#undef RWP_Y
#undef RWP_V
}

struct RowMap { int WPB, RPWX, RPWC; };
__device__ __forceinline__ RowMap rowmap(int NGW) { RowMap r; r.WPB = NGW / NB; r.RPWX = SEQ / r.WPB; r.RPWC = NTC / NGW; return r; }
__device__ __forceinline__ int route_wave(int m, const RowMap& r) { if (m < NTX) { const int b = m / SEQ, t = m - b * SEQ; return b * r.WPB + t / r.RPWX; } return (m - NTX) / r.RPWC; }
typedef _Float16 f16x8 __attribute__((ext_vector_type(8)));
typedef _Float16 f16x2_ __attribute__((ext_vector_type(2)));
__device__ __forceinline__ unsigned pkh(float a, float b) { f32x2_t_ v = {a, b}; f16x2_ h = __builtin_convertvector(v, f16x2_); return __builtin_bit_cast(unsigned, h); }
__device__ __forceinline__ void split_h(float a, float b, unsigned& hi, unsigned& lo) { hi = pkh(a, b); const f16x2_ hh = __builtin_bit_cast(f16x2_, hi); lo = pkh(a - (float)hh.x, b - (float)hh.y); }
constexpr int LN1_ROWB = 4112, LN1_RED = 67584;
template <bool BFIN> __device__ __forceinline__ void phase_ln1_route(LAS unsigned char* lds, int l) {
    const KA a = ka_get();
    const int tid = opaque_tid(), lane = tid & 63, wave = __builtin_amdgcn_readfirstlane(tid >> 6), G = gridDim.x, bid = blockIdx.x;
    const int gw = bid * 8 + wave, NGW = G * 8;
    if (tid < 32) ((LAS int*)(lds + LDSCTL_OFF + 1024))[tid] = 0;
    f16x8 Wh[2][4], Wl[2][4];
    { const float* RW = a.in(I_RW) + (size_t)(128 * wave + 8 * (lane >> 4)) * 32 + (lane & 15);
#pragma unroll
      for (int nt = 0; nt < 2; ++nt)
#pragma unroll
        for (int ks = 0; ks < 4; ++ks) { unsigned h[4], lo[4];
#pragma unroll
            for (int t = 0; t < 4; ++t) { const float w0 = RW[(32 * ks + 2 * t) * 32 + 16 * nt] * 256.f, w1 = RW[(32 * ks + 2 * t + 1) * 32 + 16 * nt] * 256.f; split_h(w0, w1, h[t], lo[t]); }
            Wh[nt][ks] = __builtin_bit_cast(f16x8, (v4u){h[0], h[1], h[2], h[3]}); Wl[nt][ks] = __builtin_bit_cast(f16x8, (v4u){lo[0], lo[1], lo[2], lo[3]}); } }
    __syncthreads();
    const float* mods = (const float*)(a.ws() + WS_MODS) + (size_t)l * 17 * 6144;
    const bf16* O = (const bf16*)(a.ws() + WS_X3); bf16* HM = (bf16*)(a.ws() + WS_X1);
    const float* xs = a.in(I_X); const float* cs = a.in(I_CTX); const bf16* xb = (const bf16*)a.out(); bf16* XP = (bf16*)(a.ws() + WS_XP);
    int* HIST = (int*)(a.ws() + WS_LIST); TokInfo* TOK = (TokInfo*)(a.ws() + WS_TOK); LAS int* lcnt = (LAS int*)(lds + LDSCTL_OFF + 1024);
    const GAS f32x4* lg = (const GAS f32x4*)(a.in(I_LN1G) + l * DM) + lane; const GAS f32x4* lb = (const GAS f32x4*)(a.in(I_LN1B) + l * DM) + lane;
    const float biasv = a.in(I_RB)[(lane >> 1) & 31];
    f32x4 lgv[4], lbv[4];
#pragma unroll
    for (int j = 0; j < 4; ++j) { lgv[j] = lg[64 * j]; lbv[j] = lb[64 * j]; }
    const RowMap rm = rowmap(NGW);
    const int bx = gw / rm.WPB, xbase = bx * SEQ + (gw - bx * rm.WPB) * rm.RPWX, cbase = NTX + gw * rm.RPWC, nxr = rm.RPWX, ntot = nxr + (BFIN ? 0 : rm.RPWC);
    f32x4 nx[4]; v2u nxb[4], no[4];
#define LN1_ROW(J) ((J) < nxr ? xbase + (J) : cbase + (J) - nxr)
#define LN1_FETCH(J) do { const int jj_ = (J) < ntot ? (J) : ntot - 1; const int m_ = LN1_ROW(jj_); const GAS v2u* or_ = (const GAS v2u*)(O + (size_t)m_ * DM) + lane; \
        if constexpr (BFIN) { const GAS v2u* xr_ = (const GAS v2u*)(xb + (size_t)m_ * DM) + lane; \
            _Pragma("unroll") for (int j_ = 0; j_ < 4; ++j_) { nxb[j_] = xr_[64 * j_]; no[j_] = or_[64 * j_]; } } \
        else { const float* s_ = m_ < NTX ? xs + (size_t)m_ * DM : cs + (size_t)(m_ - NTX) * DM; const GAS f32x4* xr_ = (const GAS f32x4*)s_ + lane; \
            _Pragma("unroll") for (int j_ = 0; j_ < 4; ++j_) { nx[j_] = xr_[64 * j_]; no[j_] = or_[64 * j_]; } } } while (0)
    LN1_FETCH(0);
    const unsigned afrag = (unsigned)((lane & 15) * LN1_ROWB + (128 * wave + 8 * (lane >> 4)) * 2);
    LAS float* red = (LAS float*)(lds + LN1_RED);
    for (int seg = 0; seg < (BFIN ? 1 : 2); ++seg) {
        const int j0 = seg ? nxr : 0, j1 = seg ? ntot : nxr; const int mr = seg ? 16 : bx;
        const GAS f32x4* md = (const GAS f32x4*)(mods + (size_t)mr * 6144) + lane;
        f32x4 sc2[4], sh2[4], gt1[4];
#pragma unroll
        for (int j = 0; j < 4; ++j) { gt1[j] = md[512 + 64 * j]; sc2[j] = md[1024 + 64 * j]; sh2[j] = md[768 + 64 * j]; }
      for (int jb = j0; jb < j1; jb += 2) {
#pragma unroll
        for (int r = 0; r < 2; ++r) {
            const int m = LN1_ROW(jb + r);
            f32x4 v[4]; float s = 0.f;
#pragma unroll
            for (int j = 0; j < 4; ++j) { f32x4 x; if constexpr (BFIN) { const v2u xw = nxb[j]; x = f32x4{bflo(xw.x), bfhi(xw.x), bflo(xw.y), bfhi(xw.y)}; } else x = nx[j];
                const f32x4 gt = gt1[j]; const v2u ow = no[j]; const f32x4 o = {bflo(ow.x), bfhi(ow.x), bflo(ow.y), bfhi(ow.y)};
                v[j] = x * ALPHA + gt * o; s += (v[j].x + v[j].y) + (v[j].z + v[j].w); }
            LN1_FETCH(jb + r + 1);
            const float mean = wave_sum(s) * (1.f / DM); float s2 = 0.f;
#pragma unroll
            for (int j = 0; j < 4; ++j) { v[j] = v[j] - mean; s2 += (v[j].x * v[j].x + v[j].y * v[j].y) + (v[j].z * v[j].z + v[j].w * v[j].w); }
            const float rstd = 1.f / sqrtf(wave_sum(s2) * (1.f / DM) + LN_EPS);
            GAS v2u* dr = (GAS v2u*)(XP + (size_t)m * DM) + lane; GAS v2u* hr = (GAS v2u*)(HM + (size_t)m * DM) + lane;
            const unsigned trow = (unsigned)((2 * wave + r) * LN1_ROWB + 8 * lane);
#pragma unroll
            for (int j = 0; j < 4; ++j) { const f32x4 x1 = v[j] * rstd * lgv[j] + lbv[j]; { v2u xw; xw.x = pk2(x1.x, x1.y); xw.y = pk2(x1.z, x1.w); dr[64 * j] = xw; }
                const f32x4 hm = x1 * (sc2[j] + 1.0f) + sh2[j]; v2u w; w.x = pk2(hm.x, hm.y); w.y = pk2(hm.z, hm.w); hr[64 * j] = w;
                unsigned h0_, l0_, h1_, l1_; split_h(hm.x, hm.y, h0_, l0_); split_h(hm.z, hm.w, h1_, l1_); const v2u hh = {h0_, h1_}, hl = {l0_, l1_};
                *(LAS v2u*)(lds + trow + 512 * j) = hh; *(LAS v2u*)(lds + trow + 2048 + 512 * j) = hl; }
        }
        __syncthreads();
        {
            f32x4 acc0 = {0.f, 0.f, 0.f, 0.f}, acc1 = {0.f, 0.f, 0.f, 0.f};
            f16x8 ah[4], al[4];
#pragma unroll
            for (int ks = 0; ks < 4; ++ks) { ah[ks] = *(const LAS f16x8*)(lds + afrag + 64 * ks); al[ks] = *(const LAS f16x8*)(lds + afrag + 2048 + 64 * ks); }
#pragma unroll
            for (int ks = 0; ks < 4; ++ks) {
                acc0 = __builtin_amdgcn_mfma_f32_16x16x32_f16(al[ks], Wh[0][ks], acc0, 0, 0, 0); acc1 = __builtin_amdgcn_mfma_f32_16x16x32_f16(al[ks], Wh[1][ks], acc1, 0, 0, 0);
                acc0 = __builtin_amdgcn_mfma_f32_16x16x32_f16(ah[ks], Wl[0][ks], acc0, 0, 0, 0); acc1 = __builtin_amdgcn_mfma_f32_16x16x32_f16(ah[ks], Wl[1][ks], acc1, 0, 0, 0);
                acc0 = __builtin_amdgcn_mfma_f32_16x16x32_f16(ah[ks], Wh[0][ks], acc0, 0, 0, 0); acc1 = __builtin_amdgcn_mfma_f32_16x16x32_f16(ah[ks], Wh[1][ks], acc1, 0, 0, 0); }
            LAS float* rw_ = red + (wave * 16 + 4 * (lane >> 4)) * 32 + (lane & 15);
#pragma unroll
            for (int i = 0; i < 4; ++i) { rw_[i * 32] = acc0[i]; rw_[i * 32 + 16] = acc1[i]; }
        }
        __syncthreads();
#pragma unroll 1
        for (int r = 0; r < 2; ++r) {
            const int m = LN1_ROW(jb + r);
            const LAS float* rr = red + (2 * wave + r) * 32 + ((lane >> 1) & 31); float lsum[8];
#pragma unroll
            for (int w = 0; w < 8; ++w) lsum[w] = rr[w * 512];
            const float logit = (((lsum[0] + lsum[1]) + (lsum[2] + lsum[3])) + ((lsum[4] + lsum[5]) + (lsum[6] + lsum[7]))) * (1.f / 256.f);
        const float score = sigmoidf_(logit), sel = score + biasv;
        const int gl = lane & ~7;
        const float q0 = shi(sel, gl), q1 = shi(sel, gl + 2), q2 = shi(sel, gl + 4), q3 = shi(sel, gl + 6);
        const float mx = fmaxf(fmaxf(q0, q1), fmaxf(q2, q3));
        float top2;
        { float a0 = q0, a1 = q1, a2 = q2, a3 = q3; float t;
          if (a0 < a1) { t = a0; a0 = a1; a1 = t; } if (a2 < a3) { t = a2; a2 = a3; a3 = t; } if (a0 < a2) { t = a0; a0 = a2; a2 = t; } if (a1 < a3) { t = a1; a1 = a3; a3 = t; } if (a1 < a2) { t = a1; a1 = a2; a2 = t; }
          top2 = a0 + a1; (void)mx; }
        float best = __builtin_bit_cast(float, __builtin_amdgcn_readlane(__builtin_bit_cast(int, top2), 0)); int gidx = 0;
#pragma unroll
        for (int gg = 1; gg < 8; ++gg) { const float sc = __builtin_bit_cast(float, __builtin_amdgcn_readlane(__builtin_bit_cast(int, top2), gg * 8)); if (sc > best) { best = sc; gidx = gg; } }
        const float r0 = shi(sel, gidx * 8), r1 = shi(sel, gidx * 8 + 2), r2 = shi(sel, gidx * 8 + 4), r3 = shi(sel, gidx * 8 + 6);
        int i0 = 0; float b0 = r0; if (r1 > b0) { b0 = r1; i0 = 1; } if (r2 > b0) { b0 = r2; i0 = 2; } if (r3 > b0) { b0 = r3; i0 = 3; }
        int i1 = -1; float b1 = -INFINITY;
        if (i0 != 0 && r0 > b1) { b1 = r0; i1 = 0; } if (i0 != 1 && r1 > b1) { b1 = r1; i1 = 1; } if (i0 != 2 && r2 > b1) { b1 = r2; i1 = 2; } if (i0 != 3 && r3 > b1) { b1 = r3; i1 = 3; }
        const int e0 = gidx * 4 + i0, e1 = gidx * 4 + i1;
        const float s0 = shi(score, 2 * e0), s1 = shi(score, 2 * e1); const float gs = 1.0f / (s0 + s1);
        if (lane == 0) { const int p0 = __hip_atomic_fetch_add(lcnt + e0, 1, __ATOMIC_RELAXED, __HIP_MEMORY_SCOPE_WORKGROUP), p1_ = __hip_atomic_fetch_add(lcnt + e1, 1, __ATOMIC_RELAXED, __HIP_MEMORY_SCOPE_WORKGROUP);
            TokInfo ti; ti.e0 = e0; ti.e1 = e1; ti.p0 = p0; ti.p1 = p1_; ti.g0 = s0 * gs; ti.g1 = s1 * gs; ti.pad0 = 0; ti.pad1 = 0; TOK[m] = ti; }
        }
      }
    }
    __syncthreads();
    if (tid < 32) HIST[bid * 32 + tid] = lcnt[tid];
}

template <bool FULL> __device__ __forceinline__ void moe_tables(LAS unsigned char* lds, int l) {
    const KA a = ka_get(); const int tid = opaque_tid(), G = gridDim.x;
    LAS int* pref = (LAS int*)(lds + PREF_OFF); LAS int* bb = (LAS int*)lds; LAS int* tot = (LAS int*)(lds + 65536);
    const int* HIST = (const int*)(a.ws() + WS_LIST);
    __syncthreads();
    const int e = tid & 31, grp = tid >> 5;
    int loc[16]; int run = 0;
#pragma unroll
    for (int i = 0; i < 16; ++i) { const int b = grp * 16 + i; loc[i] = (b < G) ? HIST[b * 32 + e] : 0; }
#pragma unroll
    for (int i = 0; i < 16; ++i) { const int v = loc[i]; loc[i] = run; run += v; }
    tot[grp * 32 + e] = run;
    __syncthreads();
    int base = 0, total = 0;
#pragma unroll
    for (int q = 0; q < 16; ++q) { const int v = tot[q * 32 + e]; base += (q < grp) ? v : 0; total += v; }
    if (FULL) {
#pragma unroll
        for (int i = 0; i < 16; ++i) bb[(grp * 16 + i) * 32 + e] = base + loc[i]; }
    if (grp == 0) pref[40 + e] = total;
    __syncthreads();
    if (tid == 0) { int acc = 0; for (int k = 0; k < 32; ++k) { pref[k] = acc; acc += (pref[40 + k] + 255) >> 8; } pref[32] = acc; }
    __syncthreads();
}
__device__ __forceinline__ void phase_gather(LAS unsigned char* lds, int l) {
    const KA a = ka_get();
    const int tid = opaque_tid(), lane = tid & 63, wave = __builtin_amdgcn_readfirstlane(tid >> 6), G = gridDim.x, bid = blockIdx.x;
    const int gw = bid * 8 + wave, NGW = G * 8;
    moe_tables<true>(lds, l);
    const LAS int* pref = (const LAS int*)(lds + PREF_OFF); const LAS int* bb = (const LAS int*)lds;
    const bf16* HM = (const bf16*)(a.ws() + WS_X1); bf16* XB = (bf16*)(a.ws() + WS_X2); const TokInfo* TOK = (const TokInfo*)(a.ws() + WS_TOK);
    const int Mrows = l == 0 ? NTOK : NTX;
    const RowMap rm = rowmap(NGW);
    {
        const int RPW = (Mrows + NGW - 1) / NGW, m0 = gw * RPW, mend = (m0 + RPW < Mrows) ? m0 + RPW : Mrows, nrows = mend - m0;
        int sl0v = 0, sl1v = 0;
        if (lane < nrows) { const int m = m0 + lane; const TokInfo ti = TOK[m]; const int blk = route_wave(m, rm) >> 3;
            sl0v = pref[ti.e0] * 256 + bb[blk * 32 + ti.e0] + ti.p0; sl1v = pref[ti.e1] * 256 + bb[blk * 32 + ti.e1] + ti.p1; }
        if (nrows > 0) {
            const GAS v4u* srcp = (const GAS v4u*)(HM + (size_t)m0 * DM) + lane; v4u n0 = srcp[0], n1 = srcp[64];
            for (int j = 0; j < nrows; ++j) {
                const v4u v0 = n0, v1 = n1; const int jn = j + 1 < nrows ? j + 1 : j;
                const GAS v4u* np = (const GAS v4u*)(HM + (size_t)(m0 + jn) * DM) + lane; n0 = np[0]; n1 = np[64];
                const int sl0 = __builtin_amdgcn_readlane(sl0v, j), sl1 = __builtin_amdgcn_readlane(sl1v, j);
                GAS v4u* d0 = (GAS v4u*)(XB + (size_t)sl0 * DM) + lane; GAS v4u* d1 = (GAS v4u*)(XB + (size_t)sl1 * DM) + lane;
                d0[0] = v0; d0[64] = v1; d1[0] = v0; d1[64] = v1;
            }
        }
    }
    for (int e = 0; e < 32; ++e) {
        const int c = pref[40 + e], npad = ((c + 255) & ~255) - c, r0 = pref[e] * 256 + c;
        for (int r = gw; r < npad; r += NGW) { GAS v4u* dst = (GAS v4u*)(XB + (size_t)(r0 + r) * DM) + lane; dst[0] = (v4u){0u, 0u, 0u, 0u}; dst[64] = (v4u){0u, 0u, 0u, 0u}; }
    }
}

__device__ __forceinline__ void phase_ln2(LAS unsigned char* lds, int l) {
    const KA a = ka_get();
    const int tid = opaque_tid(), lane = tid & 63, wave = __builtin_amdgcn_readfirstlane(tid >> 6), G = gridDim.x, bid = blockIdx.x;
    const int gw = bid * 8 + wave, NGW = G * 8;
    moe_tables<true>(lds, l);
    const LAS int* pref = (const LAS int*)(lds + PREF_OFF); const LAS int* bb = (const LAS int*)lds;
    const float* mods = (const float*)(a.ws() + WS_MODS) + (size_t)l * 17 * 6144;
    const bf16* Y = (const bf16*)(a.ws() + WS_X2); const TokInfo* TOK = (const TokInfo*)(a.ws() + WS_TOK);
    const bf16* XP = (const bf16*)(a.ws() + WS_XP);
    const GAS f32x4* lg = (const GAS f32x4*)(a.in(I_LN2G) + l * DM) + lane; const GAS f32x4* lb = (const GAS f32x4*)(a.in(I_LN2B) + l * DM) + lane;
    const int Mrows = l == 0 ? NTOK : NTX;
    f32x4 lgv[4], lbv[4];
#pragma unroll
    for (int j = 0; j < 4; ++j) { lgv[j] = lg[64 * j]; lbv[j] = lb[64 * j]; }
    const int RPW = (Mrows + NGW - 1) / NGW, m0 = gw * RPW, mend = (m0 + RPW < Mrows) ? m0 + RPW : Mrows, nrows = mend - m0;
    int sl0v = 0, sl1v = 0; float g0v = 0.f, g1v = 0.f;
    if (lane < nrows) { const TokInfo ti = TOK[m0 + lane]; const LAS int* bbw = bb + (route_wave(m0 + lane, rowmap(NGW)) >> 3) * 32;
        sl0v = pref[ti.e0] * 256 + bbw[ti.e0] + ti.p0; sl1v = pref[ti.e1] * 256 + bbw[ti.e1] + ti.p1; g0v = ti.g0; g1v = ti.g1; }
    v2u nxin[4], nain[4], nbin[4];
#define LN2_FETCH(J) do { const int j_ = (J) < nrows ? (J) : (nrows - 1); const int s0_ = __builtin_amdgcn_readlane(sl0v, j_), s1_ = __builtin_amdgcn_readlane(sl1v, j_); \
        const GAS v2u* xr_ = (const GAS v2u*)(XP + (size_t)(m0 + j_) * DM) + lane; const GAS v2u* y0_ = (const GAS v2u*)(Y + (size_t)s0_ * DM) + lane; const GAS v2u* y1_ = (const GAS v2u*)(Y + (size_t)s1_ * DM) + lane; \
        _Pragma("unroll") for (int q_ = 0; q_ < 4; ++q_) { nxin[q_] = xr_[64 * q_]; nain[q_] = y0_[64 * q_]; nbin[q_] = y1_[64 * q_]; } } while (0)
    if (nrows > 0) {
    LN2_FETCH(0);
    for (int jr = 0; jr < nrows; ) {
        const int mseg = m0 + jr; const int mr = mseg < NTX ? mseg / SEQ : 16; int segend = mseg < NTX ? (mr + 1) * SEQ : Mrows; segend = (segend < mend ? segend : mend) - m0;
        const GAS f32x4* md = (const GAS f32x4*)(mods + (size_t)mr * 6144) + lane;
        f32x4 gin[4], msc[4], msh[4];
#pragma unroll
        for (int j = 0; j < 4; ++j) gin[j] = md[1280 + 64 * j];
        if (l == 0) { const GAS f32x4* mn = (const GAS f32x4*)(mods + (size_t)17 * 6144 + (size_t)mr * 6144) + lane;
#pragma unroll
            for (int j = 0; j < 4; ++j) { msc[j] = mn[256 + 64 * j]; msh[j] = mn[64 * j]; } }
      for (; jr < segend; ++jr) {
        const int m = m0 + jr;
        const float tg0 = __builtin_bit_cast(float, __builtin_amdgcn_readlane(__builtin_bit_cast(int, g0v), jr)), tg1 = __builtin_bit_cast(float, __builtin_amdgcn_readlane(__builtin_bit_cast(int, g1v), jr));
        f32x4 v[4]; float s = 0.f;
#pragma unroll
        for (int j = 0; j < 4; ++j) { const v2u xw = nxin[j]; const f32x4 x = {bflo(xw.x), bfhi(xw.x), bflo(xw.y), bfhi(xw.y)}, gt = gin[j]; const v2u a0 = nain[j], a1 = nbin[j];
            const f32x4 ya = {bflo(a0.x), bfhi(a0.x), bflo(a0.y), bfhi(a0.y)}, yb = {bflo(a1.x), bfhi(a1.x), bflo(a1.y), bfhi(a1.y)};
            v[j] = x * ALPHA + gt * (ya * tg0 + yb * tg1); s += (v[j].x + v[j].y) + (v[j].z + v[j].w); }
        LN2_FETCH(jr + 1);
        const float mean = wave_sum(s) * (1.f / DM); float s2 = 0.f;
#pragma unroll
        for (int j = 0; j < 4; ++j) { v[j] = v[j] - mean; s2 += (v[j].x * v[j].x + v[j].y * v[j].y) + (v[j].z * v[j].z + v[j].w * v[j].w); }
        const float rstd = 1.f / sqrtf(wave_sum(s2) * (1.f / DM) + LN_EPS);
        if (l == 0) {
            GAS v2u* o8 = (GAS v2u*)((bf16*)(a.ws() + WS_X1) + (size_t)m * DM) + lane; GAS v2u* xs8 = (GAS v2u*)((bf16*)a.out() + (size_t)(m < NTX ? m : 0) * DM) + lane;
            const bool isx = m < NTX;
#pragma unroll
            for (int j = 0; j < 4; ++j) { const f32x4 xn = v[j] * rstd * lgv[j] + lbv[j]; if (isx) { v2u xw; xw.x = pk2(xn.x, xn.y); xw.y = pk2(xn.z, xn.w); xs8[64 * j] = xw; }
                const f32x4 r = xn * (msc[j] + 1.0f) + msh[j]; v2u w; w.x = pk2(r.x, r.y); w.y = pk2(r.z, r.w); o8[64 * j] = w; }
        } else {
            GAS f32x4* of = (GAS f32x4*)(a.out() + (size_t)m * DM) + lane;
#pragma unroll
            for (int j = 0; j < 4; ++j) of[64 * j] = v[j] * rstd * lgv[j] + lbv[j];
        }
      }
    }
    }
}
namespace csc {
constexpr int ARR = 0;
constexpr int RAW = 0;
constexpr int ZL = 34816;
constexpr int WLO = 57344;
constexpr int FR = 58368;
constexpr int AABT = 87040;
constexpr int LWO = 91136;
constexpr int AAO = 107520;
__device__ __forceinline__ int sw16(int row, int chunk) { return row * 128 + ((chunk ^ (row & 7)) << 4); }
__device__ __forceinline__ v2u cvt4(const f32x4 v) { v2u r; r.x = pk2(v[0], v[1]); r.y = pk2(v[2], v[3]); return r; }
__device__ __forceinline__ bf16x8 mk8(v2u lo, v2u hi) { v4u w; w.x = lo.x; w.y = lo.y; w.z = hi.x; w.w = hi.y; return __builtin_bit_cast(bf16x8, w); }
__device__ __forceinline__ v2u trd(const LAS unsigned char* p) { return __builtin_bit_cast(v2u, __builtin_amdgcn_ds_read_tr16_b64_v4i16((LAS v4i16_t*)p)); }
__device__ __forceinline__ int opq(int v) { asm volatile("" : "+v"(v)); return v; }
__device__ __forceinline__ int opqs(int v) { asm volatile("" : "+s"(v)); return v; }
}
namespace bgc {
constexpr int CBUF = LDSCTL_OFF + 4096, CPITCH = 80, NITEMS = NEXP * 1536;
struct Item { const float* src; bf16* dst; int N, ld; };
__device__ __forceinline__ Item decode(const KA& a, int l, int item) {
    const int e = item / 1536; int r = item - e * 1536; const int m = r >> 9, t = r & 511; const size_t eo = ((size_t)l * NEXP + e) * (size_t)DM * DEXP; Item it;
    if (m < 2) { const int kt = t >> 4, nt = t & 15, j0 = 32 * nt; it.N = DEXP; it.ld = 1024; it.src = (m ? a.in(I_EW3) : a.in(I_EW1)) + eo + (size_t)(32 * kt) * DEXP + j0;
        it.dst = (bf16*)(a.ws() + WS_W13T) + (size_t)e * 1024 * 1024 + (size_t)(256 * (j0 >> 7) + 128 * m + (j0 & 127)) * 1024 + 32 * kt; }
    else { const int kt = t >> 5, nt = t & 31; it.N = DM; it.ld = 512; it.src = a.in(I_EW2) + eo + (size_t)(32 * kt) * DM + 32 * nt; it.dst = (bf16*)(a.ws() + WS_W2T) + (size_t)e * 1024 * 512 + (size_t)(32 * nt) * 512 + 32 * kt; }
    return it; }
__device__ __forceinline__ void issue(const KA& a, int l, int item, int lane, f32x4 (&cv)[4]) { const Item it = decode(a, l, item);
#pragma unroll
    for (int i = 0; i < 4; ++i) cv[i] = *(const GAS f32x4*)(it.src + (size_t)((lane >> 3) + 8 * i) * it.N + (lane & 7) * 4); }
__device__ __forceinline__ void finish(const KA& a, int l, int item, int lane, int slot, LAS unsigned char* lds, const f32x4 (&cv)[4]) { const Item it = decode(a, l, item);
    LAS unsigned char* buf = lds + CBUF + slot * (32 * CPITCH);
#pragma unroll
    for (int i = 0; i < 4; ++i)
#pragma unroll
        for (int u = 0; u < 4; ++u) *(LAS bf16*)(buf + ((lane & 7) * 4 + u) * CPITCH + ((lane >> 3) + 8 * i) * 2) = f2bf1(cv[i][u]);
    LDS_WAIT(); asm volatile("" ::: "memory");
    const int n = lane >> 1, hf = lane & 1; const v4u w0 = *(const LAS v4u*)(buf + n * CPITCH + hf * 32), w1 = *(const LAS v4u*)(buf + n * CPITCH + hf * 32 + 16);
    GAS v4u* d = (GAS v4u*)(it.dst + (size_t)n * it.ld + 16 * hf); d[0] = w0; d[1] = w1;
    LDS_WAIT(); asm volatile("" ::: "memory"); }
}
#ifndef SCAN_STAMP
#define SCAN_STAMP 0
#endif
#define STB(k) do { if (SCAN_STAMP == (k)) t0_ = (unsigned)__builtin_amdgcn_s_memrealtime(); } while (0)
#define STE(k) do { if (SCAN_STAMP == (k)) tacc_ += (unsigned)__builtin_amdgcn_s_memrealtime() - t0_; } while (0)
#ifndef SCAN_PROBE
#define SCAN_PROBE 0
#endif
#define REPK(k) for (int rep_ = 0; rep_ < ((SCAN_PROBE == (k)) ? 2 : 1); ++rep_)
__device__ __forceinline__ void phase_scan(LAS unsigned char* lds, int l) {
    using namespace csc;
    const KA a = ka_get();
    const int tid = opaque_tid(), lane0 = tid & 63, wv = __builtin_amdgcn_readfirstlane(tid >> 6);
    const bf16* PX = (const bf16*)(a.ws() + WS_X2); bf16* YD = (bf16*)(a.ws() + WS_X3); float* BON = (float*)(a.ws() + WS_BONUS);
    const float* mup = a.in(I_MUP) + l * 1760; const float* mun = a.in(I_MUN) + l * 1760;
    const f32x4 Z4 = {0.f, 0.f, 0.f, 0.f}; const v2u Z2 = {0u, 0u};
    unsigned t0_ = 0, tacc_ = 0; (void)t0_;
    for (int chain = blockIdx.x; chain < 256; chain += gridDim.x) {
        const int b = chain >> 4, h = (chain >> 1) & 7, d = chain & 1; const int c0_ = opq(lane0);
        float kkc[2], kac[2], rkc[2], mur[2][2], muk[2][2], muv[2][2], mul[2][2], ropef[2]; bf16x8 w2f[2], a2f[2]; float w0c[2], a0c[2];
        { const int ln = c0_, kl = ln & 15, g = ln >> 4, cp = ln & 31;
#pragma unroll
          for (int u = 0; u < 2; ++u) { const int c = 2 * cp + u; ropef[u] = exp2f(-(float)(c & 15) * (13.287712379549449f / 16.0f));
            kkc[u] = a.in(I_KK)[l * 512 + h * 64 + c]; kac[u] = a.in(I_KA)[l * 512 + h * 64 + c]; rkc[u] = a.in(I_RK)[l * 512 + h * 64 + c];
            const int colr = h * 64 + c, coll = (c < 32) ? (1536 + d * 32 + c) : (1600 + d * 32 + (c - 32));
            mur[u][0] = d ? mun[colr] : mup[colr]; mur[u][1] = d ? mup[colr] : mun[colr]; muk[u][0] = d ? mun[512 + colr] : mup[512 + colr]; muk[u][1] = d ? mup[512 + colr] : mun[512 + colr];
            muv[u][0] = d ? mun[1024 + colr] : mup[1024 + colr]; muv[u][1] = d ? mup[1024 + colr] : mun[1024 + colr]; mul[u][0] = d ? mun[coll] : mup[coll]; mul[u][1] = d ? mup[coll] : mun[coll]; }
#pragma unroll
        for (int i = 0; i < 2; ++i) { const int cc = h * 64 + 16 * ((wv >> 2) * 2 + i) + kl; unsigned t[8], u[8];
#pragma unroll
            for (int j = 0; j < 8; ++j) { t[j] = f2bf(a.in(I_W2)[((size_t)(l * 2 + d) * 32 + 8 * g + j) * 512 + cc]); u[j] = f2bf(a.in(I_A2)[((size_t)(l * 2 + d) * 32 + 8 * g + j) * 512 + cc]); }
            w2f[i] = __builtin_bit_cast(bf16x8, (v4u){t[0] | (t[1] << 16), t[2] | (t[3] << 16), t[4] | (t[5] << 16), t[6] | (t[7] << 16)});
            a2f[i] = __builtin_bit_cast(bf16x8, (v4u){u[0] | (u[1] << 16), u[2] | (u[3] << 16), u[4] | (u[5] << 16), u[6] | (u[7] << 16)});
            w0c[i] = a.in(I_W0)[(l * 2 + d) * 512 + cc]; a0c[i] = a.in(I_A0)[(l * 2 + d) * 512 + cc]; } }
        f32x4 St[4] = {Z4, Z4, Z4, Z4};
        f32x4 cvt_[4] = {Z4, Z4, Z4, Z4}; int cit = blockIdx.x * 8 + wv, cpend = -1; const int cstride = gridDim.x * 8;
#define BGC_WINDOW() do { const int ln_ = opq(lane0); if (cpend >= 0) bgc::finish(a, l, cpend, ln_, wv & 3, lds, cvt_); if (cit < bgc::NITEMS) { bgc::issue(a, l, cit, ln_, cvt_); cpend = cit; cit += cstride; } else cpend = -1; } while (0)
        for (int seq = 0; seq < 2; ++seq) {
            const int T = seq ? SEQ : CTXL, rowbase = seq ? b * SEQ : NTX + b * CTXL, ngrp = T / 64;
            v4u pre[5];
#define CSC_PREFETCH(GRP) do { const int s0_ = (GRP) * 64; const int tlo_ = d ? (T - 64 - s0_) : s0_; \
                _Pragma("unroll") for (int i_ = 0; i_ < 5; ++i_) { const int id_ = opq(tid) + 512 * i_; const int rr_ = id_ >> 5, ch_ = id_ & 31; const int t_ = tlo_ - 1 + rr_; \
                    const int col_ = RWOFF + (ch_ < 24 ? (ch_ >> 3) * 512 + h * 64 + (ch_ & 7) * 8 : (ch_ < 28 ? 1536 + d * 32 + (ch_ - 24) * 8 : 1600 + d * 32 + (ch_ - 28) * 8)); \
                    const bool ok_ = (id_ < 66 * 32) && t_ >= 0 && t_ < T; const int tc_ = ok_ ? t_ : 0; \
                    const v4u v_ = *(const GAS v4u*)(PX + (size_t)(rowbase + tc_) * DINP + col_); pre[i_] = ok_ ? v_ : (v4u){0u, 0u, 0u, 0u}; } } while (0)
            CSC_PREFETCH(0);
            for (int grp = 0; grp < ngrp; ++grp) {
                const int s0 = grp * 64;
                int lane = opq(lane0); int c = lane, kl = lane & 15, g = lane >> 4, q_ = kl >> 2, p_ = kl & 3; (void)q_; (void)p_;
                STB(1);
#pragma unroll
                for (int i = 0; i < 5; ++i) { const int id = opq(tid) + 512 * i; if (id < 66 * 32) *(LAS v4u*)(lds + RAW + id * 16) = pre[i]; }
                __syncthreads();
                STE(1); STB(2);
                int sl = opqs(wv);
                float Rk[4][2], Rq[4][2], Rr[4][2], Rv[4][2];
                REPK(1) { const int cp = lane & 31, sh = lane >> 5, sb = 8 * sl + 4 * sh; const int rbase = d ? 64 - sb : sb + 1, rdir = d ? -256 : 256;
                  const LAS bf16* p0 = (const LAS bf16*)(lds + RAW) + (rbase * 256 + 2 * cp) - rdir;
                  float pr[6][2], pk[6][2], pv[6][2], pl[6][2];
#pragma unroll
                  for (int j = 0; j < 6; ++j) { const LAS unsigned* p = (const LAS unsigned*)(p0 + j * rdir); const unsigned wr = p[0], wk = p[32], wv_ = p[64], wl = p[96];
                      pr[j][0] = bflo(wr); pr[j][1] = bfhi(wr); pk[j][0] = bflo(wk); pk[j][1] = bfhi(wk); pv[j][0] = bflo(wv_); pv[j][1] = bfhi(wv_); pl[j][0] = bflo(wl); pl[j][1] = bfhi(wl); }
                  const int qd = cp >> 3;
#pragma unroll
                  for (int i = 0; i < 4; ++i) { const int sloc = sb + i; float r[2], k[2], zz[2];
#pragma unroll
                      for (int u = 0; u < 2; ++u) { r[u] = pr[i + 1][u] + mur[u][0] * (pr[i][u] - pr[i + 1][u]) + mur[u][1] * (pr[i + 2][u] - pr[i + 1][u]); k[u] = pk[i + 1][u] + muk[u][0] * (pk[i][u] - pk[i + 1][u]) + muk[u][1] * (pk[i + 2][u] - pk[i + 1][u]);
                          Rv[i][u] = pv[i + 1][u] + muv[u][0] * (pv[i][u] - pv[i + 1][u]) + muv[u][1] * (pv[i + 2][u] - pv[i + 1][u]);
                          const float z = pl[i + 1][u] + mul[u][0] * (pl[i][u] - pl[i + 1][u]) + mul[u][1] * (pl[i + 2][u] - pl[i + 1][u]);
                          const float th = 1.0f - 2.0f * __builtin_amdgcn_rcpf(1.0f + __expf(2.0f * z)); zz[u] = cp < 16 ? th : z; }
                      ((LAS unsigned*)(lds + ZL))[sloc * 32 + cp] = pk2(zz[0], zz[1]);
                      if (seq) { const int t = d ? (T - 1 - (s0 + sloc)) : (s0 + sloc); const float pos = (float)((qd < 2) ? (t >> 6) : (t & 63));
#pragma unroll
                          for (int u = 0; u < 2; ++u) { const float rp = dppmov<0x128>(r[u]), kp = dppmov<0x128>(k[u]); const float ang = pos * ropef[u]; const float cs = __cosf(ang), sn = __sinf(ang);
                              const float sg = (qd & 1) ? sn : -sn; r[u] = r[u] * cs + rp * sg; k[u] = k[u] * cs + kp * sg; } }
                      const float k0 = k[0] * kkc[0], k1 = k[1] * kkc[1]; float ss = k0 * k0 + k1 * k1;
                      ss += dppmov<0xB1>(ss); ss += dppmov<0x4E>(ss); ss += dppmov<0x141>(ss); ss += dppmov<0x140>(ss);
                      { const int iv = __builtin_bit_cast(int, ss); const float a0 = __builtin_bit_cast(float, __builtin_amdgcn_readlane(iv, 0)) + __builtin_bit_cast(float, __builtin_amdgcn_readlane(iv, 16)), a1 = __builtin_bit_cast(float, __builtin_amdgcn_readlane(iv, 32)) + __builtin_bit_cast(float, __builtin_amdgcn_readlane(iv, 48)); ss = sh ? a1 : a0; }
                      const float rn = __builtin_amdgcn_rsqf(fmaxf(ss, 1e-24f));
                      Rk[i][0] = k0 * rn; Rk[i][1] = k1 * rn; Rq[i][0] = k[0]; Rq[i][1] = k[1]; Rr[i][0] = r[0]; Rr[i][1] = r[1]; } }
                __syncthreads();
                STE(2); STB(3);
                lane = opq(lane0); c = lane; kl = lane & 15; g = lane >> 4; q_ = kl >> 2; p_ = kl & 3;
                REPK(2) { const int wq = opqs(wv); const int st = wq & 3; const LAS unsigned char* zrow = lds + ZL + (16 * st + kl) * 128;
                  const bf16x8 zw = *(const LAS bf16x8*)(zrow + 16 * g), za = *(const LAS bf16x8*)(zrow + 64 + 16 * g);
#pragma unroll
                  for (int i = 0; i < 2; ++i) { const int cc = 16 * ((wq >> 2) * 2 + i) + kl;
                      const f32x4 uw = __builtin_amdgcn_mfma_f32_16x16x32_bf16(zw, w2f[i], Z4, 0, 0, 0), ua = __builtin_amdgcn_mfma_f32_16x16x32_bf16(za, a2f[i], Z4, 0, 0, 0);
#pragma unroll
                      for (int j = 0; j < 4; ++j) { const int srow = 16 * st + 4 * g + j;
                          ((LAS float*)(lds + LWO))[srow * 64 + cc] = -0.6065306597126334f * __builtin_amdgcn_rcpf(1.0f + __expf(-(uw[j] + w0c[i]))); ((LAS float*)(lds + AAO))[srow * 64 + cc] = __builtin_amdgcn_rcpf(1.0f + __expf(-(ua[j] + a0c[i]))); } } }
                __syncthreads();
                STE(3); STB(4);
                lane = opq(lane0); c = lane; kl = lane & 15; g = lane >> 4; q_ = kl >> 2; p_ = kl & 3;
                sl = opqs(wv);
                REPK(4) { const int cp = lane & 31, sh = lane >> 5, q = sl >> 1, hf = sl & 1; typedef float f32x2_ __attribute__((ext_vector_type(2)));
                  const LAS f32x2_* lwp = (const LAS f32x2_*)((const LAS float*)(lds + LWO) + (16 * q) * 64 + 2 * cp); const LAS f32x2_* aap = (const LAS f32x2_*)((const LAS float*)(lds + AAO) + (8 * sl + 4 * sh) * 64 + 2 * cp);
                  f32x2_ qs[4];
#pragma unroll
                  for (int j = 0; j < 4; ++j) { qs[j] = lwp[(4 * j) * 32] + lwp[(4 * j + 1) * 32] + lwp[(4 * j + 2) * 32] + lwp[(4 * j + 3) * 32]; }
                  const f32x2_ cL = (qs[0] + qs[1]) + (qs[2] + qs[3]); const int part = 2 * hf + sh;
                  f32x2_ run = part == 0 ? (f32x2_){0.f, 0.f} : (part == 1 ? qs[0] : (part == 2 ? qs[0] + qs[1] : qs[0] + qs[1] + qs[2]));
                  const float wl0 = __expf(cL.x), wl1 = __expf(cL.y);
                  if (part == 3) ((LAS f32x2_*)(lds + WLO))[q * 32 + cp] = (f32x2_){wl0, wl1};
#pragma unroll
                  for (int i = 0; i < 4; ++i) { const int sloc = 8 * sl + 4 * sh + i, s = 4 * part + i; const f32x2_ lwi = lwp[s * 32]; const f32x2_ cprev = run; run = run + lwi; const f32x2_ aa = aap[i * 32];
                      const float kd0 = Rq[i][0] * (1.0f + (aa.x - 1.0f) * kac[0]), kd1 = Rq[i][1] * (1.0f + (aa.y - 1.0f) * kac[1]), nb0 = -Rk[i][0] * aa.x, nb1 = -Rk[i][1] * aa.y;
                      float bon = Rr[i][0] * kd0 * rkc[0] + Rr[i][1] * kd1 * rkc[1];
                      bon += dppmov<0xB1>(bon); bon += dppmov<0x4E>(bon); bon += dppmov<0x141>(bon); bon += dppmov<0x140>(bon);
                      { const int iv = __builtin_bit_cast(int, bon); const float a0 = __builtin_bit_cast(float, __builtin_amdgcn_readlane(iv, 0)) + __builtin_bit_cast(float, __builtin_amdgcn_readlane(iv, 16)), a1 = __builtin_bit_cast(float, __builtin_amdgcn_readlane(iv, 32)) + __builtin_bit_cast(float, __builtin_amdgcn_readlane(iv, 48)); bon = sh ? a1 : a0; }
                      if (cp == 0) { const int t = d ? (T - 1 - (s0 + sloc)) : (s0 + sloc); BON[((size_t)d * NTOK + rowbase + t) * 8 + h] = bon; }
                      const float e1x = __expf(cprev.x), e1y = __expf(cprev.y), e2x = __expf(-run.x), e2y = __expf(-run.y), e3x = __builtin_amdgcn_rcpf(e2x), e3y = __builtin_amdgcn_rcpf(e2y);
                      LAS unsigned char* base = lds + ARR + q * (7 * 2048) + sw16(s, cp >> 2) + (cp & 3) * 4;
                      *(LAS unsigned*)(base) = pk2(Rk[i][0] * e1x, Rk[i][1] * e1y); *(LAS unsigned*)(base + 2048) = pk2(nb0 * e2x, nb1 * e2y); *(LAS unsigned*)(base + 4096) = pk2(kd0 * e2x, kd1 * e2y); *(LAS unsigned*)(base + 6144) = pk2(Rr[i][0] * e3x, Rr[i][1] * e3y);
                      *(LAS unsigned*)(base + 12288) = pk2(Rv[i][0], Rv[i][1]); } }
                __syncthreads();
                STE(4); STB(5);
                lane = opq(lane0); c = lane; kl = lane & 15; g = lane >> 4; q_ = kl >> 2; p_ = kl & 3;
                STB(7); if (wv < 4) { BGC_WINDOW(); if (grp + 1 < ngrp) CSC_PREFETCH(grp + 1); } STE(7);
                STB(8); STB(10);
                REPK(5) if (wv >= 4) { __builtin_amdgcn_s_setprio(3); const int q = opqs(wv) - 4; const LAS unsigned char* A0 = lds + ARR + q * (7 * 2048);
                    STB(11);
                    bf16x8 at[2], bt[2], kt[2], rt[2];
#pragma unroll
                    for (int ks = 0; ks < 2; ++ks) { const int o = sw16(kl, ks * 4 + g); at[ks] = *(const LAS bf16x8*)(A0 + o); bt[ks] = *(const LAS bf16x8*)(A0 + 2048 + o); kt[ks] = *(const LAS bf16x8*)(A0 + 4096 + o); rt[ks] = *(const LAS bf16x8*)(A0 + 6144 + o); }
                    f32x4 ABt = Z4, AKt = Z4, RBt = Z4, RKt = Z4;
#pragma unroll
                    for (int ks = 0; ks < 2; ++ks) { ABt = __builtin_amdgcn_mfma_f32_16x16x32_bf16(bt[ks], at[ks], ABt, 0, 0, 0); AKt = __builtin_amdgcn_mfma_f32_16x16x32_bf16(kt[ks], at[ks], AKt, 0, 0, 0);
                        RBt = __builtin_amdgcn_mfma_f32_16x16x32_bf16(bt[ks], rt[ks], RBt, 0, 0, 0); RKt = __builtin_amdgcn_mfma_f32_16x16x32_bf16(kt[ks], rt[ks], RKt, 0, 0, 0); }
#pragma unroll
                    for (int j = 0; j < 4; ++j) { const int jj = 4 * g + j; ABt[j] = jj < kl ? ABt[j] : 0.f; AKt[j] = jj < kl ? AKt[j] : 0.f; RBt[j] = jj <= kl ? RBt[j] : 0.f; RKt[j] = jj <= kl ? RKt[j] : 0.f; }
                    STE(11); STB(12);
                    float Tr[16]; const float ab0 = ABt[0], ab1 = ABt[1], ab2 = ABt[2], ab3 = ABt[3];
                    const int abi[4] = {__builtin_bit_cast(int, ab0), __builtin_bit_cast(int, ab1), __builtin_bit_cast(int, ab2), __builtin_bit_cast(int, ab3)};
#pragma unroll
                    for (int i = 0; i < 16; ++i) Tr[i] = (i == kl) ? 1.f : 0.f;
#pragma unroll
                    for (int j = 14; j >= 0; --j) { float acc = 0.f;
#pragma unroll
                        for (int i = 15; i > j; --i) acc += Tr[i] * __builtin_bit_cast(float, __builtin_amdgcn_readlane(abi[j & 3], i + 16 * (j >> 2)));
                        Tr[j] = (j < kl) ? acc : Tr[j]; }
                    STE(12); STB(13);
                    float tsel[4];
#pragma unroll
                    for (int e = 0; e < 4; ++e) tsel[e] = g == 0 ? Tr[e] : (g == 1 ? Tr[4 + e] : (g == 2 ? Tr[8 + e] : Tr[12 + e]));
                    v2u tf2; tf2.x = pk2(tsel[0], tsel[1]); tf2.y = pk2(tsel[2], tsel[3]);
                    const bf16x8 Tf = mk8(tf2, Z2), RBf = mk8(cvt4(RBt), Z2);
                    f32x4 AhT[4], QhT[4], Ah[4], rin[4]; bf16x8 Alo[4];
#pragma unroll
                    for (int ct = 0; ct < 4; ++ct) { Alo[ct] = mk8(trd(A0 + sw16(4 * g + q_, 2 * ct + (p_ >> 1)) + (p_ & 1) * 8), Z2);
                        const v2u rw = *(const LAS v2u*)(A0 + 6144 + sw16(kl, 2 * ct + (g >> 1)) + (g & 1) * 8);
                        rin[ct] = (f32x4){bflo(rw.x), bfhi(rw.x), bflo(rw.y), bfhi(rw.y)}; }
#pragma unroll
                    for (int ct = 0; ct < 4; ++ct) { AhT[ct] = __builtin_amdgcn_mfma_f32_16x16x32_bf16(Alo[ct], Tf, Z4, 0, 0, 0);
                        Ah[ct] = __builtin_amdgcn_mfma_f32_16x16x32_bf16(Tf, Alo[ct], Z4, 0, 0, 0); }
#pragma unroll
                    for (int ct = 0; ct < 4; ++ct) QhT[ct] = __builtin_amdgcn_mfma_f32_16x16x32_bf16(mk8(cvt4(Ah[ct]), Z2), RBf, rin[ct], 0, 0, 0);
                    STE(13); STB(14);
                    LAS unsigned char* fr = lds + FR + q * 7168 + lane * 16;
                    *(LAS bf16x8*)(fr) = mk8(cvt4(AhT[0]), cvt4(AhT[1])); *(LAS bf16x8*)(fr + 1024) = mk8(cvt4(AhT[2]), cvt4(AhT[3]));
                    *(LAS bf16x8*)(fr + 2048) = mk8(cvt4(QhT[0]), cvt4(QhT[1])); *(LAS bf16x8*)(fr + 3072) = mk8(cvt4(QhT[2]), cvt4(QhT[3]));
                    *(LAS bf16x8*)(fr + 4096) = mk8(cvt4(AKt), Z2); *(LAS bf16x8*)(fr + 5120) = mk8(cvt4(RBt), cvt4(RKt)); *(LAS bf16x8*)(fr + 6144) = Tf;
                    STE(14);
                    __builtin_amdgcn_s_setprio(0);
                }
                STE(8); STE(10);
                __syncthreads();
                STE(5); STB(6);
                lane = opq(lane0); c = lane; kl = lane & 15; g = lane >> 4; q_ = kl >> 2; p_ = kl & 3;
                if (wv >= 4) { BGC_WINDOW(); if (grp + 1 < ngrp) CSC_PREFETCH(grp + 1); }
                if (wv < 4) { __builtin_amdgcn_s_setprio(3); const int vt = opqs(wv);
#pragma unroll 1
                    for (int q = 0; q < 4; ++q) { const LAS unsigned char* A0 = lds + ARR + q * (7 * 2048); const LAS unsigned char* fr = lds + FR + q * 7168 + lane * 16;
                        const bf16x8 Ap0 = *(const LAS bf16x8*)(fr), Ap1 = *(const LAS bf16x8*)(fr + 1024), Qp0 = *(const LAS bf16x8*)(fr + 2048), Qp1 = *(const LAS bf16x8*)(fr + 3072);
                        const bf16x8 AKf = *(const LAS bf16x8*)(fr + 4096), RBRK = *(const LAS bf16x8*)(fr + 5120), Tf = *(const LAS bf16x8*)(fr + 6144);
                        const v2u vtr = trd(A0 + 12288 + sw16(4 * g + q_, 2 * vt + (p_ >> 1)) + (p_ & 1) * 8);
                        bf16x8 bk[4]; f32x4 wl[4];
#pragma unroll
                        for (int ct = 0; ct < 4; ++ct) { wl[ct] = *(const LAS f32x4*)(lds + WLO + (q * 64 + 16 * ct + 4 * g) * 4); const int o = sw16(4 * g + q_, 2 * ct + (p_ >> 1)) + (p_ & 1) * 8; bk[ct] = mk8(trd(A0 + 2048 + o), trd(A0 + 4096 + o)); }
                        const f32x4 X1 = __builtin_amdgcn_mfma_f32_16x16x32_bf16(AKf, mk8(vtr, Z2), Z4, 0, 0, 0);
                        const f32x4 Uh = __builtin_amdgcn_mfma_f32_16x16x32_bf16(Tf, mk8(cvt4(X1), Z2), Z4, 0, 0, 0);
                        const f32x4 Yh = __builtin_amdgcn_mfma_f32_16x16x32_bf16(RBRK, mk8(cvt4(Uh), vtr), Z4, 0, 0, 0);
                        const bf16x8 bs0 = mk8(cvt4(St[0]), cvt4(St[1])), bs1 = mk8(cvt4(St[2]), cvt4(St[3]));
                        f32x4 U = __builtin_amdgcn_mfma_f32_16x16x32_bf16(Ap0, bs0, Uh, 0, 0, 0); U = __builtin_amdgcn_mfma_f32_16x16x32_bf16(Ap1, bs1, U, 0, 0, 0);
                        f32x4 Y = __builtin_amdgcn_mfma_f32_16x16x32_bf16(Qp0, bs0, Yh, 0, 0, 0); Y = __builtin_amdgcn_mfma_f32_16x16x32_bf16(Qp1, bs1, Y, 0, 0, 0);
                        const bf16x8 UV = mk8(cvt4(U), vtr);
#pragma unroll
                        for (int ct = 0; ct < 4; ++ct) St[ct] = __builtin_amdgcn_mfma_f32_16x16x32_bf16(bk[ct], UV, St[ct], 0, 0, 0) * wl[ct];
#pragma unroll
                        for (int jj = 0; jj < 2; ++jj) {
                            const float pe = dppmov<0xB1>(Y[jj]), po = dppmov<0xB1>(Y[2 + jj]); const bool odd = (kl & 1) != 0;
                            const unsigned w = odd ? pk2(po, Y[2 + jj]) : pk2(Y[jj], pe);
                            const int sg = s0 + 16 * q + 4 * g + jj + (odd ? 2 : 0); const int t = d ? (T - 1 - sg) : sg;
                            *(GAS unsigned*)(YD + ((size_t)d * NTOK + rowbase + t) * 512 + h * 64 + 16 * vt + (kl & ~1)) = w; }
                    }
                    __builtin_amdgcn_s_setprio(0);
                }
                __syncthreads();
                STE(6);
            }
#undef CSC_PREFETCH
        }
        if (cpend >= 0) { bgc::finish(a, l, cpend, opq(lane0), wv & 3, lds, cvt_); cpend = -1; }
        for (; cit < bgc::NITEMS; cit += cstride) { bgc::issue(a, l, cit, opq(lane0), cvt_); bgc::finish(a, l, cit, opq(lane0), wv & 3, lds, cvt_); }
#undef BGC_WINDOW
    }
    if (SCAN_STAMP != 0 && blockIdx.x == 0 && tid == ((SCAN_STAMP == 8 || (SCAN_STAMP >= 11 && SCAN_STAMP <= 14)) ? 256 : ((SCAN_STAMP == 10) ? 448 : 0))) atomicAdd((unsigned*)(a.ws() + WS_CTL) + 2000, tacc_);
}
constexpr int PH_PER_LAYER = 11, N_PHASES = 1 + 2 * PH_PER_LAYER;
template <int K> __device__ __forceinline__ void run_phase(LAS unsigned char* lds, int l) {
    if constexpr (K == 0) phase_prologue(lds);
    if constexpr (K == 1) phase_modconv(lds, l);
    if constexpr (K == 3) phase_scan(lds, l);
    if constexpr (K == 4) phase_attn(lds, l);
    if constexpr (K == 5) phase_rwpost(lds, l);
    if constexpr (K == 7) { if (l == 0) phase_ln1_route<false>(lds, l); else phase_ln1_route<true>(lds, l); }
    if constexpr (K == 8) phase_gather(lds, l);
    if constexpr (K == 11) phase_ln2(lds, l);
    if constexpr (K == 2 || K == 6 || K == 9 || K == 10) {
        const KA a = ka_get(); unsigned char* ws = a.ws(); const int G = gridDim.x, bid = blockIdx.x;
        bf16* X1 = (bf16*)(ws + WS_X1); bf16* X2 = (bf16*)(ws + WS_X2); bf16* X3 = (bf16*)(ws + WS_X3);
        if constexpr (K == 2) { __syncthreads();
            pg8::Gemm g{X1, (const bf16*)(ws + WS_WINT) + (size_t)l * DINP * DM, NTOK, DINP, DM}; pg8::StaticOrder S; S.init(NTOK, DINP, G, bid);
            pg8::EpiBf16 E{X2, DINP}; pg8::gemm_phase<pg8::EpiBf16, pg8::StaticOrder, true, true>(lds, g, S, E); }
        if constexpr (K == 6) { __syncthreads();
            const int Mrows = (l == 0) ? NTOK : NTX;
            pg8::Gemm g{X1, (const bf16*)(ws + WS_WOT) + (size_t)l * DM * DM, Mrows, DM, DM}; pg8::StaticOrder S; S.init(Mrows, DM, G, bid);
            pg8::EpiBf16 E{X3, DM}; pg8::gemm_phase<pg8::EpiBf16, pg8::StaticOrder, true, true>(lds, g, S, E); }
        if constexpr (K == 9) { moe_tables<false>(lds, l);
            pg8::Gemm g{X2, (const bf16*)(ws + WS_W13T), MAXSLOT, 1024, DM}; pg8::MoeOrder S; S.init((const LAS int*)(lds + PREF_OFF), 4, G, bid);
            pg8::EpiSwiGLU E{X3, DEXP}; pg8::gemm_phase<pg8::EpiSwiGLU, pg8::MoeOrder, true, true>(lds, g, S, E); }
        if constexpr (K == 10) { moe_tables<false>(lds, l);
            pg8::Gemm g{X3, (const bf16*)(ws + WS_W2T), MAXSLOT, 1024, DEXP}; pg8::MoeOrder S; S.init((const LAS int*)(lds + PREF_OFF), 4, G, bid);
            pg8::EpiBf16 E{X2, DM}; pg8::gemm_phase<pg8::EpiBf16, pg8::MoeOrder, true, true>(lds, g, S, E); }
    }
}
__device__ __forceinline__ void grid_sync(LAS unsigned char* lds) {
    const KA a = ka_get(); XcdBarrier b; b.bar = (unsigned*)(a.ws() + WS_CTL) + CW_BAR; b.x = xb_xcc_id(); b.st = (volatile LAS unsigned*)(lds + MISC_OFF) + 8; xcd_barrier(b);
#ifdef PROBE_BAR
    xcd_barrier(b);
#endif
}
#ifndef ONE_LAUNCH
template <int K> __global__ void __launch_bounds__(512, 2) fwd_ph(Args args) {
    extern __shared__ __attribute__((aligned(16))) unsigned char lds_raw[];
    LAS unsigned char* lds = (LAS unsigned char*)lds_raw;
    for (int u = threadIdx.x; u < (LDS_BYTES - LDSCTL_OFF) / 4; u += 512) ((LAS unsigned*)(lds + LDSCTL_OFF))[u] = 0u;
    __syncthreads();
    hw_tid_init();
    __syncthreads();
    run_phase<K>(lds, args.ph_lo);
}
template <int K> static void launch_ph(const Args& a, int grid, hipStream_t stream) {
    static bool attr = false;
    if (!attr) { (void)hipFuncSetAttribute((const void*)fwd_ph<K>, hipFuncAttributeMaxDynamicSharedMemorySize, LDS_BYTES); attr = true; }
    hipLaunchKernelGGL(fwd_ph<K>, dim3(grid), dim3(512), LDS_BYTES, stream, a);
}
#else
__global__ void __launch_bounds__(512, 2) fwd(Args args) {
    extern __shared__ __attribute__((aligned(16))) unsigned char lds_raw[];
    LAS unsigned char* lds = (LAS unsigned char*)lds_raw;
    for (int u = threadIdx.x; u < (LDS_BYTES - LDSCTL_OFF) / 4; u += 512) ((LAS unsigned*)(lds + LDSCTL_OFF))[u] = 0u;
    __syncthreads();
    hw_tid_init();
    __syncthreads();
    (void)xcd_barrier_post((unsigned*)(args.ws + WS_CTL) + CW_BAR, (volatile LAS unsigned*)(lds + MISC_OFF) + 8);
    run_phase<0>(lds, 0);
#ifdef PROBE_P0
    __syncthreads(); run_phase<0>(lds, 0);
#endif
    grid_sync(lds);
#ifndef PROBE_REP
#define PROBE_REP -1
#endif
#define RUNP(K) do { run_phase<K>(lds, l); if (PROBE_REP == K) { __syncthreads(); run_phase<K>(lds, l); } } while (0)
    for (int l = 0; l < 2; ++l) {
        if (l == 0) { RUNP(1); grid_sync(lds); }
        RUNP(2); grid_sync(lds);
        RUNP(3);
        RUNP(4); grid_sync(lds);
        RUNP(5); grid_sync(lds);
        RUNP(6); grid_sync(lds);
        run_phase<7>(lds, l); if (PROBE_REP == 7 && l == 0) { __syncthreads(); run_phase<7>(lds, l); } grid_sync(lds);
        RUNP(8); grid_sync(lds);
        RUNP(9); grid_sync(lds);
        RUNP(10); grid_sync(lds);
        RUNP(11); if (l == 0) grid_sync(lds);
    }
#if defined(SCAN_STAMP) && SCAN_STAMP != 0
    if (blockIdx.x == 0 && hw_tid() == 0) { const unsigned long long tk = __hip_atomic_load((unsigned*)(args.ws + WS_CTL) + 2000, __ATOMIC_RELAXED, __HIP_MEMORY_SCOPE_AGENT); const unsigned long long ts = __builtin_amdgcn_s_memrealtime(); while (__builtin_amdgcn_s_memrealtime() - ts < tk) __builtin_amdgcn_s_sleep(8); }
#endif
}
#endif

extern "C" void kernel_launch(void* const* d_in, const int* in_sizes, int n_in, void* d_out, int out_size, void* d_ws, size_t ws_size, hipStream_t stream) {
    static int grid = 0;
    if (grid == 0) {
        if (n_in != 30 || in_sizes[0] != NTX * DM || out_size != NTX * DM || ws_size < WS_END) {
            fprintf(stderr, "kernel_launch: unexpected problem (n_in %d, in0 %d, out %d, ws %zu < %zu?); nothing launched\n", n_in, n_in > 0 ? in_sizes[0] : -1, out_size, ws_size, (size_t)WS_END); grid = -1; return; }
        int dev = 0, cus = 0;
        if (hipGetDevice(&dev) != hipSuccess || hipDeviceGetAttribute(&cus, hipDeviceAttributeMultiprocessorCount, dev) != hipSuccess) { grid = -1; return; }
#ifdef ONE_LAUNCH
        if (hipFuncSetAttribute((const void*)fwd, hipFuncAttributeMaxDynamicSharedMemorySize, LDS_BYTES) != hipSuccess) { fprintf(stderr, "kernel_launch: hipFuncSetAttribute failed\n"); grid = -1; return; }
#endif
        (void)hipGetLastError();
        grid = cus > 0 ? cus : 256;
        if (grid != 256 && grid != 128) { fprintf(stderr, "kernel_launch: %d CUs: the LN1/LN2 row maps need 128 or 256 workgroups\n", grid); grid = -1; return; }
    }
    if (grid < 0) return;
    if (hipMemsetAsync((char*)d_ws + WS_CTL, 0, CTL_ZERO_BYTES, stream) != hipSuccess) return;
    Args a{};
    for (int i = 0; i < 30; ++i) a.in[i] = (const float*)d_in[i];
    a.out = (float*)d_out; a.ws = (unsigned char*)d_ws; a.ph_lo = 0; a.ph_hi = 0;
#ifndef ONE_LAUNCH
    launch_ph<0>(a, grid, stream);
    for (int l = 0; l < 2; ++l) { a.ph_lo = l;
        launch_ph<1>(a, grid, stream); launch_ph<2>(a, grid, stream); launch_ph<3>(a, grid, stream); launch_ph<4>(a, grid, stream); launch_ph<5>(a, grid, stream); launch_ph<6>(a, grid, stream);
        launch_ph<7>(a, grid, stream); launch_ph<8>(a, grid, stream); launch_ph<9>(a, grid, stream); launch_ph<10>(a, grid, stream); launch_ph<11>(a, grid, stream); }
#else
    hipLaunchKernelGGL(fwd, dim3(grid), dim3(512), LDS_BYTES, stream, a);
#endif
}
```

```cpp
#define ONE_LAUNCH 1
#include <hip/hip_runtime.h>
#include <cstdio>
#include <cstdint>

constexpr int DM = 1024, NB = 16, SEQ = 2048, CTXL = 256, NTX = NB * SEQ, NTC = NB * CTXL, NTOK = NTX + NTC;
constexpr int DIN = 3296, DINP = 3328, RWOFF = 1536, NHEAD = 8, HD = 64;
constexpr int NEXP = 32, DEXP = 512, LISTCAP = 2 * NTOK;
constexpr int MAXSLOT = 81920;
constexpr float ALPHA = 1.41421356237309515f, LN_EPS = 1e-6f, GN_EPS = 64e-5f;

constexpr size_t MiB = 1u << 20;
constexpr size_t WS_CTL = 0, CTL_ZERO_BYTES = 1 * MiB;
constexpr size_t WS_MODS = 1 * MiB;
constexpr size_t WS_ROPE = 2 * MiB;
constexpr size_t WS_WINT = 3 * MiB;
constexpr size_t WS_WOT = 16 * MiB;
constexpr size_t WS_W13T = 20 * MiB;
constexpr size_t WS_W2T = 84 * MiB;
constexpr size_t WS_LIST = 116 * MiB;
constexpr size_t WS_TOK = 125 * MiB;
constexpr size_t WS_BONUS = 127 * MiB;
constexpr size_t WS_CS = 130 * MiB;
constexpr size_t WS_X1 = 146 * MiB;
constexpr size_t WS_X2 = 218 * MiB;
constexpr size_t WS_XP = WS_X2 + 160 * MiB;
constexpr size_t WS_X3 = 452 * MiB;
constexpr size_t WS_END = 596 * MiB;
static_assert(WS_WINT + (size_t)2 * DINP * DM * 2 <= WS_WOT && WS_LIST + (size_t)NEXP * LISTCAP * 4 <= WS_TOK && WS_TOK + (size_t)NTOK * 32 <= WS_BONUS, "ws map");
static_assert(WS_BONUS + (size_t)2 * NTOK * 8 * 4 <= WS_CS && WS_X2 + (size_t)NTOK * DINP * 2 <= WS_X3 && WS_X3 + (size_t)2 * NTOK * 512 * 4 <= WS_END, "ws map");
static_assert((size_t)MAXSLOT * 1024 * 2 <= WS_XP - WS_X2 && WS_XP + (size_t)NTOK * DM * 2 <= WS_X3 && (size_t)MAXSLOT * 512 * 2 <= WS_END - WS_X3, "ws map");
constexpr int CW_BAR = 4096;
constexpr int CW_CNT = 8192;
constexpr int RING_BYTES = 131072, LDSCTL_OFF = RING_BYTES, MISC_OFF = LDSCTL_OFF + 320, LDS_BYTES = 163840;
constexpr int PREF_OFF = LDSCTL_OFF + 512;

#define GAS __attribute__((address_space(1)))
#define LAS __attribute__((address_space(3)))
typedef unsigned short bf16;
typedef unsigned v4u __attribute__((ext_vector_type(4)));
typedef unsigned v2u __attribute__((ext_vector_type(2)));
typedef float f32x4 __attribute__((ext_vector_type(4)));
typedef short bf16x8 __attribute__((ext_vector_type(8)));
typedef GAS unsigned gu32;
#define RLX_AGENT __ATOMIC_RELAXED, __HIP_MEMORY_SCOPE_AGENT
#define LDS_WAIT() asm volatile("s_waitcnt lgkmcnt(0)" ::: "memory")
#define VM_WAIT() asm volatile("s_waitcnt vmcnt(0)" ::: "memory")
__device__ __forceinline__ unsigned f2bf(float f) { unsigned u = __builtin_bit_cast(unsigned, f); return (u + 0x7fffu + ((u >> 16) & 1u)) >> 16; }
typedef float f32x2_t_ __attribute__((ext_vector_type(2))); typedef __bf16 bf16x2_t_ __attribute__((ext_vector_type(2)));
__device__ __forceinline__ unsigned pk2(float lo, float hi) { f32x2_t_ v = {lo, hi}; bf16x2_t_ b = __builtin_convertvector(v, bf16x2_t_); return __builtin_bit_cast(unsigned, b); }
__device__ __forceinline__ unsigned short f2bf1(float f) { return (unsigned short)(pk2(f, 0.f) & 0xffffu); }
__device__ __forceinline__ float bf2f(unsigned short v) { return __builtin_bit_cast(float, (unsigned)v << 16); }
__device__ __forceinline__ float bflo(unsigned w) { return __builtin_bit_cast(float, w << 16); }
__device__ __forceinline__ float bfhi(unsigned w) { return __builtin_bit_cast(float, w & 0xffff0000u); }
__device__ __forceinline__ float sigmoidf_(float x) { return 1.0f / (1.0f + expf(-x)); }
__device__ __forceinline__ float shx(float v, int k, int lane) { return __builtin_bit_cast(float, __builtin_amdgcn_ds_bpermute((lane ^ k) << 2, __builtin_bit_cast(int, v))); }
__device__ __forceinline__ float shi(float v, int src) { return __builtin_bit_cast(float, __builtin_amdgcn_ds_bpermute(src << 2, __builtin_bit_cast(int, v))); }
template <int CTRL> __device__ __forceinline__ float dppmov(float v) { return __builtin_bit_cast(float, __builtin_amdgcn_update_dpp(0, __builtin_bit_cast(int, v), CTRL, 0xF, 0xF, true)); }
__device__ __forceinline__ float wave_sum(float v) {
    v += dppmov<0xB1>(v); v += dppmov<0x4E>(v); v += dppmov<0x141>(v); v += dppmov<0x140>(v);
    const int iv = __builtin_bit_cast(int, v);
    return (__builtin_bit_cast(float, __builtin_amdgcn_readlane(iv, 0)) + __builtin_bit_cast(float, __builtin_amdgcn_readlane(iv, 16))) + (__builtin_bit_cast(float, __builtin_amdgcn_readlane(iv, 32)) + __builtin_bit_cast(float, __builtin_amdgcn_readlane(iv, 48)));
}
__device__ __forceinline__ float fmx(float a, float b) { float r; asm("v_max_f32 %0, %1, %2" : "=v"(r) : "v"(a), "v"(b)); return r; }
__device__ __forceinline__ float xmax16(float v) { float a = v, b = v; asm volatile("s_nop 1\n\tv_permlane16_swap_b32 %0, %1" : "+v"(a), "+v"(b)); return fmx(a, b); }
__device__ __forceinline__ float xmax32(float v) { float a = v, b = v; asm volatile("s_nop 1\n\tv_permlane32_swap_b32 %0, %1" : "+v"(a), "+v"(b)); return fmx(a, b); }
__device__ __forceinline__ float xsum16(float v) { float a = v, b = v; asm volatile("s_nop 1\n\tv_permlane16_swap_b32 %0, %1" : "+v"(a), "+v"(b)); return a + b; }
__device__ __forceinline__ float xsum32(float v) { float a = v, b = v; asm volatile("s_nop 1\n\tv_permlane32_swap_b32 %0, %1" : "+v"(a), "+v"(b)); return a + b; }
__device__ __forceinline__ float red8(float v) { v += dppmov<0xB1>(v); v += dppmov<0x4E>(v); v += dppmov<0x141>(v); return v; }

struct TokInfo { int e0, e1, p0, p1; float g0, g1; int pad0, pad1; };

constexpr int WID_OFF = LDSCTL_OFF + 1536;
__device__ __forceinline__ int hw_slot() { return (int)__builtin_amdgcn_s_getreg((5 << 11) | 4) & 63; }
__device__ __forceinline__ int lane_id() { int l; asm volatile("v_mbcnt_lo_u32_b32 %0, -1, 0\n\tv_mbcnt_hi_u32_b32 %0, -1, %0" : "=v"(l)); return l; }
__device__ __forceinline__ void hw_tid_init() { *(volatile LAS int*)(uintptr_t)(WID_OFF + 4 * hw_slot()) = (int)(threadIdx.x >> 6); }
__device__ __forceinline__ int hw_tid() { const int w = *(volatile LAS int*)(uintptr_t)(WID_OFF + 4 * hw_slot()); int t = (__builtin_amdgcn_readfirstlane(w) << 6) | lane_id(); asm volatile("" : "+v"(t)); return t; }
namespace pg8 {
#define PG8_LAS __attribute__((address_space(3)))
typedef unsigned short bf16_t;
typedef short bf16x8 __attribute__((ext_vector_type(8)));
typedef float f32x4 __attribute__((ext_vector_type(4)));
typedef unsigned u32x4 __attribute__((ext_vector_type(4)));
constexpr int BM = 256, BK = 64, HALF = 128, HTB = HALF * BK * 2  , STAGE_BYTES = 8 * HTB, NXCD = 8, WGM = 8;

__host__ __device__ __forceinline__ int lds_byte(int r, int c) { const int st = (r >> 4) * 2 + (c >> 5), rr = r & 15, cc = c & 31, ob = rr * 64 + cc * 2; return st * 1024 + (ob ^ (((ob >> 9) & 1) << 5)); }
__host__ __device__ __forceinline__ void stage_rc(int b, int& R, int& C) { const int st = b / 1024, sb = b % 1024, swz = sb ^ (((sb >> 9) & 1) << 5); R = (st >> 1) * 16 + swz / 64; C = (st & 1) * 32 + (swz % 64) / 2; }
__host__ __device__ __forceinline__ int perm32(int rho) { const int n = rho >> 4, i = rho & 15; return 8 * (i >> 2) + 4 * n + (i & 3); }

struct Unit { int pm, pn, pnb; };
struct Gemm { const bf16_t* A; const bf16_t* Bt; int M, N, K; };

struct StaticOrder {
    int nM, nN, nwg, G, c;
    __host__ __device__ void init(int M, int N, int G_, int c_) { nM = M / BM; nN = N / BM; nwg = nM * nN; G = G_; c = c_; }
    __host__ __device__ bool next(int i, Unit& u) const {
        const long L = (long)i * G + c; if (L >= nwg) return false;
        int wgid = (int)L; { const int q = nwg / NXCD, r = nwg % NXCD, xcd = wgid % NXCD, off = wgid / NXCD; wgid = (xcd < r ? xcd * (q + 1) : r * (q + 1) + (xcd - r) * q) + off; }
        const int nig = WGM * nN, gid = wgid / nig, fm = gid * WGM, gsz = (nM - fm) < WGM ? (nM - fm) : WGM;
        u.pm = fm + ((wgid % nig) % gsz); u.pn = (wgid % nig) / gsz; u.pnb = u.pn; return true;
    }
    __device__ __forceinline__ void a_ready(const Unit&) const {}
    __device__ __forceinline__ void done(const Unit&) const {}
};

__device__ __forceinline__ unsigned cvt_pk_bf16(float lo, float hi) { unsigned r; asm volatile("v_cvt_pk_bf16_f32 %0, %1, %2" : "=v"(r) : "v"(lo), "v"(hi)); return r; }
template <class Epi, class Sched, bool ALIGN_EPI = false, bool SP2 = false>
__device__ __forceinline__ void gemm_phase(PG8_LAS unsigned char* lds, const Gemm g, const Sched& S, const Epi& E) {
    const int tid = hw_tid(), wid = __builtin_amdgcn_readfirstlane(tid >> 6), lane = tid & 63, wr = wid >> 2, wc = wid & 3, fr = lane & 15, fq = lane >> 4;
    const int K = g.K, nt = K / BK;
    unsigned voffA[2], voffB[2];
#pragma unroll
    for (int i = 0; i < 2; ++i) { int R, C; stage_rc(tid * 16 + i * 8192, R, C); const int Rb = Epi::PERM ? ((R & ~31) + perm32(R & 31)) : R;
        voffA[i] = (unsigned)(R * K + C) * 2u; voffB[i] = (unsigned)(Rb * K + C) * 2u; }
    const size_t kstep = (size_t)(BK * 2);
    const size_t hstep = (size_t)HALF * K * 2;
    const size_t tstep = 2 * hstep;
    const unsigned ldsw = (unsigned)wid * 1024u;
    const int aoff = lds_byte(wr * 64 + fr, fq * 8), boff = lds_byte(wc * 32 + fr, fq * 8);
#define PG8_SA(b, h) (((b) * 2 + (h)) * HTB)
#define PG8_SB(b, h) ((4 + (b) * 2 + (h)) * HTB)
#define PG8_STAGE(bufoff, gbase, voff) do { _Pragma("unroll") for (int _i = 0; _i < 2; ++_i) \
        __builtin_amdgcn_global_load_lds((const unsigned*)((const char*)(gbase) + (voff)[_i]), (PG8_LAS unsigned*)(lds + (bufoff) + ldsw + _i * 8192), 16, 0, 0); } while (0)
#define PG8_LDA(dst, b, h) do { _Pragma("unroll") for (int m = 0; m < 4; ++m) _Pragma("unroll") for (int k = 0; k < 2; ++k) dst[m][k] = *(const PG8_LAS bf16x8*)(lds + PG8_SA(b, h) + aoff + m * 2048 + k * 1024); } while (0)
#define PG8_LDB(dst, b, h) do { _Pragma("unroll") for (int n = 0; n < 2; ++n) _Pragma("unroll") for (int k = 0; k < 2; ++k) dst[n][k] = *(const PG8_LAS bf16x8*)(lds + PG8_SB(b, h) + boff + n * 2048 + k * 1024); } while (0)
#define PG8_MMA(ai, bj, At, Bt) do { __builtin_amdgcn_s_setprio(1); _Pragma("unroll") for (int m = 0; m < 4; ++m) _Pragma("unroll") for (int n = 0; n < 2; ++n) _Pragma("unroll") for (int k = 0; k < 2; ++k) \
        acc[ai][bj][m][n] = __builtin_amdgcn_mfma_f32_16x16x32_bf16(Bt[n][k], At[m][k], acc[ai][bj][m][n], 0, 0, 0); __builtin_amdgcn_s_setprio(0); } while (0)
#define PG8_WAIT_V(n) asm volatile("s_waitcnt vmcnt(" #n ")" ::: "memory")
#define PG8_WAIT_L(n) asm volatile("s_waitcnt lgkmcnt(" #n ")" ::: "memory")
#define PG8_BAR __builtin_amdgcn_s_barrier()
#define PG8_SCHED __builtin_amdgcn_sched_barrier(0)
    Unit cur, nxt; int ui = 0;
    if (!S.next(0, cur)) return;
    f32x4 acc[2][2][4][2];
#pragma unroll
    for (int a = 0; a < 2; ++a)
#pragma unroll
        for (int b = 0; b < 2; ++b)
#pragma unroll
            for (int m = 0; m < 4; ++m)
#pragma unroll
                for (int n = 0; n < 2; ++n) acc[a][b][m][n] = (f32x4){0.f, 0.f, 0.f, 0.f};
    bf16x8 At[4][2], B0[2][2], B1[2][2];
    const char* cA = (const char*)g.A + (size_t)cur.pm * tstep; const char* cB = (const char*)g.Bt + (size_t)cur.pnb * tstep;
    S.a_ready(cur);
    if constexpr (SP2) {
        PG8_STAGE(PG8_SB(0, 0), cB, voffB); PG8_STAGE(PG8_SB(0, 1), cB + hstep, voffB); PG8_STAGE(PG8_SA(0, 0), cA, voffA); PG8_STAGE(PG8_SA(0, 1), cA + hstep, voffA);
        if (wr == 1) PG8_BAR;
        PG8_WAIT_V(2); PG8_BAR;
        PG8_STAGE(PG8_SB(1, 0), cB + kstep, voffB); PG8_STAGE(PG8_SA(1, 0), cA + kstep, voffA); PG8_STAGE(PG8_SB(1, 1), cB + hstep + kstep, voffB);
        PG8_WAIT_V(6); PG8_BAR;
    } else {
        PG8_STAGE(PG8_SB(0, 0), cB, voffB); PG8_STAGE(PG8_SA(0, 0), cA, voffA); PG8_STAGE(PG8_SB(0, 1), cB + hstep, voffB); PG8_STAGE(PG8_SA(0, 1), cA + hstep, voffA);
        if (wr == 1) PG8_BAR;
        PG8_WAIT_V(4); PG8_BAR;
        PG8_STAGE(PG8_SB(1, 0), cB + kstep, voffB); PG8_STAGE(PG8_SA(1, 0), cA + kstep, voffA); PG8_STAGE(PG8_SB(1, 1), cB + hstep + kstep, voffB);
        PG8_WAIT_V(6); PG8_BAR;
    }
    for (;;) {
        const bool has_next = S.next(ui + 1, nxt);
        const char* nA = has_next ? (const char*)g.A + (size_t)nxt.pm * tstep : cA; const char* nB = has_next ? (const char*)g.Bt + (size_t)nxt.pnb * tstep : cB;
        for (int t = 0; t < nt; t += 2) {
            const bool last = (t == nt - 2);
            const char* a1 = cA + (size_t)(t + 1) * kstep;
            const char* a2 = last ? nA : cA + (size_t)(t + 2) * kstep; const char* b2 = last ? nB : cB + (size_t)(t + 2) * kstep;
            const char* a3 = a2 + kstep; const char* b3 = b2 + kstep;
            if (last && has_next) S.a_ready(nxt);
            if constexpr (SP2) {
            PG8_LDB(B0, 0, 0); PG8_LDB(B1, 0, 1); PG8_SCHED; PG8_LDA(At, 0, 0); PG8_STAGE(PG8_SA(1, 1), a1 + hstep, voffA);
            PG8_WAIT_V(8); PG8_WAIT_L(0); PG8_BAR; PG8_MMA(0, 0, At, B0); PG8_MMA(0, 1, At, B1); PG8_BAR; PG8_SCHED;
            PG8_LDA(At, 0, 1); PG8_STAGE(PG8_SB(0, 0), b2, voffB); PG8_STAGE(PG8_SB(0, 1), b2 + hstep, voffB); PG8_STAGE(PG8_SA(0, 0), a2, voffA);
            PG8_WAIT_V(8); PG8_WAIT_L(0); PG8_BAR; PG8_MMA(1, 0, At, B0); PG8_MMA(1, 1, At, B1); PG8_BAR; PG8_SCHED;
            PG8_LDB(B0, 1, 0); PG8_LDB(B1, 1, 1); PG8_SCHED; PG8_LDA(At, 1, 0); PG8_STAGE(PG8_SA(0, 1), a2 + hstep, voffA);
            PG8_WAIT_V(8); PG8_WAIT_L(0); PG8_BAR; PG8_MMA(0, 0, At, B0); PG8_MMA(0, 1, At, B1); PG8_BAR; PG8_SCHED;
            PG8_LDA(At, 1, 1); PG8_STAGE(PG8_SB(1, 0), b3, voffB); PG8_STAGE(PG8_SB(1, 1), b3 + hstep, voffB); PG8_STAGE(PG8_SA(1, 0), a3, voffA);
            PG8_WAIT_V(8); PG8_WAIT_L(0); PG8_BAR; PG8_MMA(1, 0, At, B0); PG8_MMA(1, 1, At, B1); PG8_BAR; PG8_SCHED;
            } else {
            PG8_LDB(B0, 0, 0); PG8_SCHED; PG8_LDA(At, 0, 0); PG8_STAGE(PG8_SA(1, 1), a1 + hstep, voffA);
            PG8_WAIT_L(8); PG8_BAR; PG8_WAIT_L(0); PG8_MMA(0, 0, At, B0); PG8_BAR; PG8_SCHED;
            PG8_LDB(B1, 0, 1); PG8_STAGE(PG8_SB(0, 0), b2, voffB);
            PG8_BAR; PG8_WAIT_L(0); PG8_MMA(0, 1, At, B1); PG8_BAR;
            PG8_LDA(At, 0, 1); PG8_STAGE(PG8_SA(0, 0), a2, voffA);
            PG8_BAR; PG8_WAIT_L(0); PG8_MMA(1, 0, At, B0); PG8_BAR; PG8_SCHED;
            PG8_STAGE(PG8_SB(0, 1), b2 + hstep, voffB);
            PG8_WAIT_V(6); PG8_BAR; PG8_MMA(1, 1, At, B1); PG8_BAR;
            PG8_LDB(B0, 1, 0); PG8_SCHED; PG8_LDA(At, 1, 0); PG8_STAGE(PG8_SA(0, 1), a2 + hstep, voffA);
            PG8_WAIT_L(8); PG8_BAR; PG8_WAIT_L(0); PG8_MMA(0, 0, At, B0); PG8_BAR; PG8_SCHED;
            PG8_LDB(B1, 1, 1); PG8_STAGE(PG8_SB(1, 0), b3, voffB);
            PG8_BAR; PG8_WAIT_L(0); PG8_MMA(0, 1, At, B1); PG8_BAR;
            PG8_LDA(At, 1, 1); PG8_STAGE(PG8_SA(1, 0), a3, voffA);
            PG8_BAR; PG8_WAIT_L(0); PG8_MMA(1, 0, At, B0); PG8_BAR; PG8_SCHED;
            PG8_STAGE(PG8_SB(1, 1), b3 + hstep, voffB);
            PG8_WAIT_V(6); PG8_BAR; PG8_MMA(1, 1, At, B1); PG8_BAR;
            }
        }
        if constexpr (ALIGN_EPI) { if (wr == 0) PG8_BAR; }
        if constexpr (!Epi::AFTER_DRAIN) { E(acc, cur, wr, wc, fr, fq); S.done(cur); }
        if (!has_next) break;
#pragma unroll
        for (int a = 0; a < 2; ++a)
#pragma unroll
            for (int b = 0; b < 2; ++b)
#pragma unroll
                for (int m = 0; m < 4; ++m)
#pragma unroll
                    for (int n = 0; n < 2; ++n) acc[a][b][m][n] = (f32x4){0.f, 0.f, 0.f, 0.f};
        cur = nxt; cA = nA; cB = nB; ++ui;
        if constexpr (ALIGN_EPI) { if (wr == 1) PG8_BAR; }
    }
    PG8_WAIT_V(0);
    if constexpr (!ALIGN_EPI) { if (wr == 0) PG8_BAR; }
    PG8_BAR;
    if constexpr (Epi::AFTER_DRAIN) { E.fused(acc, cur, wr, wc, fr, fq, lds, wid, lane); S.done(cur); }
#undef PG8_SA
#undef PG8_SB
#undef PG8_STAGE
#undef PG8_LDA
#undef PG8_LDB
#undef PG8_MMA
#undef PG8_WAIT_V
#undef PG8_WAIT_L
#undef PG8_BAR
#undef PG8_SCHED
}
}
namespace pg8 {
struct EpiBf16 {
    static constexpr bool PERM = true, AFTER_DRAIN = false;
    bf16_t* O; int ldc;
    __device__ __forceinline__ void operator()(const f32x4 (&acc)[2][2][4][2], const Unit& u, int wr, int wc, int fr, int fq) const {
        const int row0 = u.pm * BM + wr * 64 + fr; const int col0 = u.pn * BM + wc * 32 + 8 * fq;
#pragma unroll
        for (int ai = 0; ai < 2; ++ai)
#pragma unroll
            for (int m = 0; m < 4; ++m) { bf16_t* rowp = O + (size_t)(row0 + ai * HALF + m * 16) * ldc + col0;
#pragma unroll
                for (int bj = 0; bj < 2; ++bj) { const f32x4 v0 = acc[ai][bj][m][0], v1 = acc[ai][bj][m][1];
                    u32x4 w; w.x = cvt_pk_bf16(v0[0], v0[1]); w.y = cvt_pk_bf16(v0[2], v0[3]); w.z = cvt_pk_bf16(v1[0], v1[1]); w.w = cvt_pk_bf16(v1[2], v1[3]);
                    *(u32x4*)(rowp + bj * HALF) = w; } }
    }
};
struct EpiSwiGLU {
    static constexpr bool PERM = true, AFTER_DRAIN = false;
    bf16_t* O; int ldc;
    __device__ __forceinline__ void operator()(const f32x4 (&acc)[2][2][4][2], const Unit& u, int wr, int wc, int fr, int fq) const {
        const int row0 = u.pm * BM + wr * 64 + fr; const int col0 = u.pn * HALF + wc * 32 + 8 * fq;
#pragma unroll
        for (int ai = 0; ai < 2; ++ai)
#pragma unroll
            for (int m = 0; m < 4; ++m) { bf16_t* rowp = O + (size_t)(row0 + ai * HALF + m * 16) * ldc + col0;
                float r[8];
#pragma unroll
                for (int n = 0; n < 2; ++n)
#pragma unroll
                    for (int j = 0; j < 4; ++j) { const float a = acc[ai][0][m][n][j], b = acc[ai][1][m][n][j]; r[n * 4 + j] = a * b * __builtin_amdgcn_rcpf(1.0f + __expf(-a)); }
                u32x4 w; w.x = cvt_pk_bf16(r[0], r[1]); w.y = cvt_pk_bf16(r[2], r[3]); w.z = cvt_pk_bf16(r[4], r[5]); w.w = cvt_pk_bf16(r[6], r[7]);
                *(u32x4*)rowp = w; }
    }
};
struct MoeOrder {
    const PG8_LAS int* pref; int nN, G, c, total;
    __device__ __forceinline__ void init(const PG8_LAS int* pref_, int nN_, int G_, int c_) { pref = pref_; nN = nN_; G = G_; c = c_; total = pref_[32] * nN_; }
    __device__ __forceinline__ bool next(int i, Unit& u) const {
        const int L = i * G + c; if (L >= total) return false;
        const int rt = L / nN, pn = L - rt * nN; int e = 0;
#pragma unroll 1
        for (int k = 1; k < 32; ++k) e += (pref[k] <= rt) ? 1 : 0;
        u.pm = rt; u.pn = pn; u.pnb = e * nN + pn; return true;
    }
    __device__ __forceinline__ void a_ready(const Unit&) const {}
    __device__ __forceinline__ void done(const Unit&) const {}
};
}
#define XB_TMO      128
#define XB_XCNT(j)  (256  + 64 * (j))
#define XB_XSUB(j)  (1280 + 64 * (j))
#define XB_XGEN(j)  (2304 + 64 * (j))
#define XB_TOP      3328
#define XB_TOPGEN   3392
#define XCD_BAR_WORDS 3456
#define XB_SPIN_CAP (1u << 22)

__device__ __forceinline__ unsigned xb_ld(unsigned* p)              { return __hip_atomic_load(p, __ATOMIC_RELAXED, __HIP_MEMORY_SCOPE_AGENT); }
__device__ __forceinline__ unsigned xb_add(unsigned* p, unsigned v) { return __hip_atomic_fetch_add(p, v, __ATOMIC_RELAXED, __HIP_MEMORY_SCOPE_AGENT); }
__device__ __forceinline__ unsigned xb_xcc_id() { return (unsigned)__builtin_amdgcn_s_getreg((3 << 11) | 20) & 0xFu; }
#define XB_SPIN(cond, bar) do { unsigned _sp = 0; while (cond) { __builtin_amdgcn_s_sleep(1); \
    if ((++_sp & 255u) == 0u) { if (xb_ld(&(bar)[XB_TMO])) break; if (_sp > XB_SPIN_CAP) { atomicAdd(&(bar)[XB_TMO], 1u); break; } } } } while (0)

struct XcdBarrier {
    unsigned* bar; unsigned x;
    volatile LAS unsigned* st;
};

__device__ __forceinline__ XcdBarrier xcd_barrier_post(unsigned* bar, volatile LAS unsigned* st) {
    XcdBarrier b; b.bar = bar; b.x = xb_xcc_id(); b.st = st;
    if (hw_tid() == 0) (void)xb_add(&bar[XB_XCNT(b.x)], 1u);
    return b;
}
__device__ __forceinline__ void xcd_barrier_complete(unsigned* bar, unsigned x, unsigned& nloc, unsigned& nx) {
    const unsigned G = gridDim.x * gridDim.y * gridDim.z;
    unsigned sum, cnt, mine, sp = 0u;
    for (;;) {
        sum = 0u; cnt = 0u; mine = 0u;
#pragma unroll
        for (unsigned j = 0; j < 16; ++j) { const unsigned c = xb_ld(&bar[XB_XCNT(j)]); sum += c; cnt += (c > 0u) ? 1u : 0u; mine = (j == x) ? c : mine; }
        if (sum == G) break;
        __builtin_amdgcn_s_sleep(1);
        if ((++sp & 255u) == 0u) { if (xb_ld(&bar[XB_TMO])) break; if (sp > XB_SPIN_CAP) { atomicAdd(&bar[XB_TMO], 1u); break; } }
    }
    nloc = mine > 0u ? mine : 1u; nx = cnt > 0u ? cnt : 1u;
}

__device__ __forceinline__ void xcd_barrier(const XcdBarrier& b) {
    asm volatile("s_waitcnt vmcnt(0)" ::: "memory");
    __syncthreads();
    if (hw_tid() == 0) {
        unsigned* bar = b.bar;
        __builtin_amdgcn_s_waitcnt(0);
        unsigned nloc = b.st[0], nx = b.st[1];
        if (nloc == 0u) { xcd_barrier_complete(bar, b.x, nloc, nx); b.st[0] = nloc; b.st[1] = nx; }
        const unsigned old = xb_add(&bar[XB_XSUB(b.x)], 1u);
        const unsigned gen = old / nloc;
        if (old + 1u == (gen + 1u) * nloc) {
            __builtin_amdgcn_fence(__ATOMIC_RELEASE, "agent");
            asm volatile("s_waitcnt vmcnt(0)" ::: "memory");
            const unsigned og = xb_add(&bar[XB_TOP], 1u);
            const unsigned tg = og / nx;
            if (og + 1u == (tg + 1u) * nx) xb_add(&bar[XB_TOPGEN], 1u);
            else XB_SPIN(xb_ld(&bar[XB_TOPGEN]) == tg, bar);
            __builtin_amdgcn_fence(__ATOMIC_ACQUIRE, "agent");
            xb_add(&bar[XB_XGEN(b.x)], 1u);
            asm volatile("s_waitcnt vmcnt(0)" ::: "memory");
        } else {
            XB_SPIN(xb_ld(&bar[XB_XGEN(b.x)]) == gen, bar);
            __builtin_amdgcn_fence(__ATOMIC_ACQUIRE, "agent");
            asm volatile("s_waitcnt vmcnt(0)" ::: "memory");
        }
    }
    __syncthreads();
}
struct Args { const float* in[30]; float* out; unsigned char* ws; int ph_lo, ph_hi; };
#define CAS __attribute__((address_space(4)))
struct KA { const CAS unsigned char* kp;
    __device__ __forceinline__ const float* in(int i) const { return *(const float* const CAS*)(kp + 8 * i); }
    __device__ __forceinline__ float* out() const { return *(float* const CAS*)(kp + 240); }
    __device__ __forceinline__ unsigned char* ws() const { return *(unsigned char* const CAS*)(kp + 248); } };
__device__ __forceinline__ KA ka_get() { const CAS unsigned char* kp = (const CAS unsigned char*)__builtin_amdgcn_kernarg_segment_ptr(); asm volatile("" : "+s"(kp)); return KA{kp}; }
__device__ __forceinline__ int opaque_tid() { return hw_tid(); }
static_assert(sizeof(Args) == 264, "kernarg layout");
enum { I_X = 0, I_C, I_CTX, I_CCTX, I_ADAW, I_ADAB, I_WIN, I_RPB, I_MUP, I_MUN, I_W0, I_W2, I_A0, I_A2, I_G2, I_KK, I_KA, I_RK, I_GNG, I_GNB, I_WOUT, I_LN1G, I_LN1B, I_LN2G, I_LN2B, I_RW, I_RB, I_EW1, I_EW3, I_EW2 };

__device__ __forceinline__ void transpose_item(const float* W, int N, int k0, int n0, bf16* WT, int ldk, int drow0, LAS float* scr, int lane) {
#pragma unroll 8
    for (int i = 0; i < 32; ++i) { const int kk = 2 * i + (lane >> 5); scr[kk * 33 + (lane & 31)] = W[(size_t)(k0 + kk) * N + n0 + (lane & 31)]; }
    LDS_WAIT(); asm volatile("" ::: "memory");
    const int c = lane & 7;
#pragma unroll
    for (int j = 0; j < 4; ++j) { const int n = (lane >> 3) + 8 * j; const LAS float* s = scr + (8 * c) * 33 + n;
        v4u o; o.x = pk2(s[0 * 33], s[1 * 33]); o.y = pk2(s[2 * 33], s[3 * 33]); o.z = pk2(s[4 * 33], s[5 * 33]); o.w = pk2(s[6 * 33], s[7 * 33]);
        *(GAS v4u*)(WT + (size_t)(drow0 + n) * ldk + k0 + 8 * c) = o; }
    LDS_WAIT(); asm volatile("" ::: "memory");
}

__device__ __forceinline__ void phase_prologue(LAS unsigned char* lds) {
    const KA a = ka_get();
    const int tid = opaque_tid(), lane = tid & 63, wave = __builtin_amdgcn_readfirstlane(tid >> 6), G = gridDim.x, bid = blockIdx.x;
    const int gw = bid * 8 + wave, NGW = G * 8;
    bf16* WINT = (bf16*)(a.ws() + WS_WINT); bf16* WOT = (bf16*)(a.ws() + WS_WOT);
    LAS float* scr = (LAS float*)(lds + wave * 16384);
    constexpr int I_IN = 16 * 103, I_OUT = 16 * 32, I_L = I_IN + I_OUT;
    for (int it = gw; it < 2 * I_L; it += NGW) {
        const int l = it / I_L; int r = it - l * I_L;
        if (r < I_IN) { const int kb = r / 103, nb = r - kb * 103; transpose_item(a.in(I_WIN) + (size_t)l * DM * DIN, DIN, 64 * kb, 32 * nb, WINT + (size_t)l * DINP * DM, DM, 32 * nb, scr, lane); }
        else { r -= I_IN; const int kb = r >> 5, nb = r & 31; transpose_item(a.in(I_WOUT) + (size_t)l * DM * DM, DM, 64 * kb, 32 * nb, WOT + (size_t)l * DM * DM, DM, 32 * nb, scr, lane); }
    }
    for (int i = bid * 512 + tid; i < 8192; i += G * 512) { const int l = i >> 12, r = i & 4095; *(GAS v4u*)(WINT + (size_t)l * DINP * DM + (size_t)DIN * DM + (size_t)r * 8) = (v4u){0u, 0u, 0u, 0u}; }
    { float* rp = (float*)(a.ws() + WS_ROPE); const int i = bid * 512 + tid;
      if (i < 1536) { const int idx = i < 512 ? i : i - 512; const int p = idx >> 4, f = idx & 15; const double inv = exp(-(double)f * (9.210340371976184 / 16.0)); const double ang = (double)p * inv;
          const float cs = (float)cos(ang), sn = (float)sin(ang); if (i < 512) { rp[idx] = cs; rp[512 + idx] = sn; } else { rp[1024 + idx] = cs; rp[2048 + idx] = sn; } } }
    __syncthreads();
    LAS float* sl = (LAS float*)lds; LAS float* red = (LAS float*)(lds + 69632);
    for (int i = tid; i < 17 * 1024; i += 512) { const int r = i >> 10, k = i & 1023; const float v = r < 16 ? a.in(I_C)[r * 1024 + k] : a.in(I_CCTX)[k]; sl[i] = v / (1.0f + expf(-v)); }
    __syncthreads();
    float* mods = (float*)(a.ws() + WS_MODS);
    for (int it = bid; it < 192; it += G) {
        const int l = it / 96, ch = it - l * 96; const int kq = tid >> 6, cl = tid & 63, col = ch * 64 + cl;
        const float* W = a.in(I_ADAW) + (size_t)l * DM * 6144 + col;
        float acc[17];
#pragma unroll
        for (int r = 0; r < 17; ++r) acc[r] = 0.f;
        for (int k0 = kq * 128; k0 < kq * 128 + 128; k0 += 8) { float w8[8];
#pragma unroll
            for (int q = 0; q < 8; ++q) w8[q] = W[(size_t)(k0 + q) * 6144];
#pragma unroll
            for (int r = 0; r < 17; ++r) { const f32x4 s0 = *(const LAS f32x4*)(sl + r * 1024 + k0), s1 = *(const LAS f32x4*)(sl + r * 1024 + k0 + 4);
                acc[r] += s0.x * w8[0] + s0.y * w8[1] + s0.z * w8[2] + s0.w * w8[3] + s1.x * w8[4] + s1.y * w8[5] + s1.z * w8[6] + s1.w * w8[7]; } }
#pragma unroll
        for (int r = 0; r < 17; ++r) red[(kq * 17 + r) * 64 + cl] = acc[r];
        __syncthreads();
        for (int i = tid; i < 17 * 64; i += 512) { const int r = i >> 6, c2 = i & 63; float s = 0.f;
#pragma unroll
            for (int q = 0; q < 8; ++q) s += red[(q * 17 + r) * 64 + c2];
            mods[((size_t)l * 17 + r) * 6144 + ch * 64 + c2] = s + a.in(I_ADAB)[l * 6144 + ch * 64 + c2]; }
        __syncthreads();
    }
}

__device__ __forceinline__ void phase_modconv(LAS unsigned char* lds, int l) {
    const KA a = ka_get();
    const int tid = opaque_tid(), lane = tid & 63, wave = __builtin_amdgcn_readfirstlane(tid >> 6), G = gridDim.x, bid = blockIdx.x;
    const int gw = bid * 8 + wave, NGW = G * 8;
    const float* mods = (const float*)(a.ws() + WS_MODS) + (size_t)l * 17 * 6144;
    bf16* XM = (bf16*)(a.ws() + WS_X1);
    const float* xs = a.in(I_X); const float* cs = a.in(I_CTX);
    const int RPW = (NTOK + NGW - 1) / NGW, m0 = gw * RPW, mend = (m0 + RPW < NTOK) ? m0 + RPW : NTOK;
    if (m0 < mend) {
        f32x4 nx[4];
#define MODC_FETCH(M) do { const int m_ = (M) < mend ? (M) : mend - 1; const GAS f32x4* xr_ = (const GAS f32x4*)(m_ < NTX ? xs + (size_t)m_ * DM : cs + (size_t)(m_ - NTX) * DM) + lane; \
            _Pragma("unroll") for (int j_ = 0; j_ < 4; ++j_) nx[j_] = xr_[64 * j_]; } while (0)
        MODC_FETCH(m0);
        for (int m = m0; m < mend; ) {
            const int mr = m < NTX ? m / SEQ : 16; int segend = m < NTX ? (mr + 1) * SEQ : NTOK; segend = segend < mend ? segend : mend;
            const GAS f32x4* sh = (const GAS f32x4*)(mods + (size_t)mr * 6144) + lane; const GAS f32x4* sc = sh + 256;
            f32x4 shv[4], scv[4];
#pragma unroll
            for (int j = 0; j < 4; ++j) { shv[j] = sh[64 * j]; scv[j] = sc[64 * j]; }
            for (; m < segend; ++m) {
                f32x4 v[4];
#pragma unroll
                for (int j = 0; j < 4; ++j) v[j] = nx[j];
                MODC_FETCH(m + 1);
                GAS v2u* o8 = (GAS v2u*)(XM + (size_t)m * DM) + lane;
#pragma unroll
                for (int j = 0; j < 4; ++j) { const f32x4 r = v[j] * (scv[j] + 1.0f) + shv[j]; v2u w; w.x = pk2(r.x, r.y); w.y = pk2(r.z, r.w); o8[64 * j] = w; }
            }
        }
#undef MODC_FETCH
    }
}

__device__ __forceinline__ void phase_scan_direct(LAS unsigned char* lds, int l) {
    const KA a = ka_get();
    constexpr int TB = 32;
    const int tid = opaque_tid(), lane = tid & 63, wv = __builtin_amdgcn_readfirstlane(tid >> 6);
    LAS float* ops = (LAS float*)lds;
    LAS float* scal = (LAS float*)(lds + 49152);
    LAS float* zl = (LAS float*)(lds + 49664);
    LAS float* rkraw = (LAS float*)(lds + 57856);
    LAS float* ybuf = (LAS float*)(lds + 74240);
    const bf16* PX = (const bf16*)(a.ws() + WS_X2); float* YD = (float*)(a.ws() + WS_X3); float* BON = (float*)(a.ws() + WS_BONUS); const float* rope = (const float*)(a.ws() + WS_ROPE);
    const float* mup = a.in(I_MUP) + l * 1760; const float* mun = a.in(I_MUN) + l * 1760;
    for (int chain = blockIdx.x; chain < 256; chain += gridDim.x) {
        const int b = chain >> 4, h = (chain >> 1) & 7, d = chain & 1, c = lane;
        float w2c[32], a2c[32];
#pragma unroll
        for (int j = 0; j < 32; ++j) { w2c[j] = a.in(I_W2)[((size_t)(l * 2 + d) * 32 + j) * 512 + h * 64 + c]; a2c[j] = a.in(I_A2)[((size_t)(l * 2 + d) * 32 + j) * 512 + h * 64 + c]; }
        const float w0c = a.in(I_W0)[(l * 2 + d) * 512 + h * 64 + c], a0c = a.in(I_A0)[(l * 2 + d) * 512 + h * 64 + c];
        const float kkc = a.in(I_KK)[l * 512 + h * 64 + c], kac = a.in(I_KA)[l * 512 + h * 64 + c], rkc = a.in(I_RK)[l * 512 + h * 64 + c];
        const int colr = h * 64 + c, colk = 512 + colr, colv = 1024 + colr, coll = (c < 32) ? (1536 + d * 32 + c) : (1600 + d * 32 + (c - 32));
        const float mpr = mup[colr], mnr = mun[colr], mpk = mup[colk], mnk = mun[colk], mpv = mup[colv], mnv = mun[colv], mpl = mup[coll], mnl = mun[coll];
        float S[8];
#pragma unroll
        for (int j = 0; j < 8; ++j) S[j] = 0.f;
        const int vl = lane >> 3, kq = lane & 7, vrow = 8 * wv + vl;
        for (int seq = 0; seq < 2; ++seq) {
            const int T = seq ? SEQ : CTXL, rowbase = seq ? b * SEQ : NTX + b * CTXL, nblk = T / TB;
            for (int bi = 0; bi < nblk; ++bi) {
                const int tb = d ? (nblk - 1 - bi) : bi, t0 = tb * TB;
                float zv[4];
#pragma unroll
                for (int i = 0; i < 4; ++i) {
                    const int tl = wv + 8 * i, t = t0 + tl; const bf16* p = PX + (size_t)(rowbase + t) * DINP + RWOFF;
                    const bool hp = t > 0, hn = t + 1 < T;
                    const float cr = bf2f(p[colr]), ck = bf2f(p[colk]), cv = bf2f(p[colv]), cl_ = bf2f(p[coll]);
                    const float pr = hp ? bf2f(p[colr - DINP]) : 0.f, pk = hp ? bf2f(p[colk - DINP]) : 0.f, pv = hp ? bf2f(p[colv - DINP]) : 0.f, pl = hp ? bf2f(p[coll - DINP]) : 0.f;
                    const float nr = hn ? bf2f(p[colr + DINP]) : 0.f, nk = hn ? bf2f(p[colk + DINP]) : 0.f, nv = hn ? bf2f(p[colv + DINP]) : 0.f, nl = hn ? bf2f(p[coll + DINP]) : 0.f;
                    const float zr = cr + mpr * (pr - cr) + mnr * (nr - cr), zk = ck + mpk * (pk - ck) + mnk * (nk - ck);
                    zv[i] = cv + mpv * (pv - cv) + mnv * (nv - cv);
                    const float zz = cl_ + mpl * (pl - cl_) + mnl * (nl - cl_);
                    rkraw[tl * 128 + c] = zr; rkraw[tl * 128 + 64 + c] = zk; zl[tl * 64 + c] = (c < 32) ? tanhf(zz) : zz;
                }
                __syncthreads();
#pragma unroll
                for (int i = 0; i < 4; ++i) {
                    const int tl = wv + 8 * i, t = t0 + tl;
                    float r = rkraw[tl * 128 + c], k = rkraw[tl * 128 + 64 + c];
                    if (seq) { const float rp = rkraw[tl * 128 + (c ^ 16)], kp = rkraw[tl * 128 + 64 + (c ^ 16)]; const int qd = c >> 4, f = c & 15;
                        const int ti = (qd < 2) ? ((t >> 6) * 16 + f) : (1024 + (t & 63) * 16 + f); const float cs = rope[ti], sn = rope[ti + ((qd < 2) ? 512 : 1024)];
                        const float sg = (qd & 1) ? sn : -sn; r = r * cs + rp * sg; k = k * cs + kp * sg; }
                    const float kkr = k * kkc; const float ss = wave_sum(kkr * kkr); const float kk = kkr / fmaxf(sqrtf(ss), 1e-12f);
                    float u = w0c, av = a0c;
#pragma unroll
                    for (int j = 0; j < 32; j += 4) { const f32x4 z1 = *(const LAS f32x4*)(zl + tl * 64 + j), z2 = *(const LAS f32x4*)(zl + tl * 64 + 32 + j);
                        u += z1.x * w2c[j] + z1.y * w2c[j + 1] + z1.z * w2c[j + 2] + z1.w * w2c[j + 3]; av += z2.x * a2c[j] + z2.y * a2c[j + 1] + z2.z * a2c[j + 2] + z2.w * a2c[j + 3]; }
                    const float w = expf(-0.6065306597126334f * sigmoidf_(u)), aa = sigmoidf_(av);
                    const float kd = k * (1.0f + (aa - 1.0f) * kac), nb = -kk * aa;
                    const float c1 = wave_sum(nb * r), c2 = wave_sum(kd * r), bon = wave_sum(r * kd * rkc);
                    LAS float* o = ops + tl * 384 + c; o[0] = kk; o[64] = w * r; o[128] = w; o[192] = nb; o[256] = kd; o[320] = zv[i];
                    if (lane == 0) { scal[tl * 4] = c1; scal[tl * 4 + 1] = c2; BON[((size_t)d * NTOK + rowbase + t) * 8 + h] = bon; }
                }
                __syncthreads();
#pragma unroll 2
                for (int s = 0; s < TB; ++s) {
                    const int tl = d ? (TB - 1 - s) : s; const LAS float* o = ops + tl * 384 + kq * 8;
                    const f32x4 ka = *(const LAS f32x4*)(o), kb = *(const LAS f32x4*)(o + 4), ra = *(const LAS f32x4*)(o + 64), rb = *(const LAS f32x4*)(o + 68);
                    const f32x4 wa = *(const LAS f32x4*)(o + 128), wb = *(const LAS f32x4*)(o + 132), na = *(const LAS f32x4*)(o + 192), nb_ = *(const LAS f32x4*)(o + 196);
                    const f32x4 da = *(const LAS f32x4*)(o + 256), db = *(const LAS f32x4*)(o + 260);
                    const float vv = ops[tl * 384 + 320 + vrow], c1 = scal[tl * 4], c2 = scal[tl * 4 + 1];
                    float sk = S[0] * ka.x + S[1] * ka.y + S[2] * ka.z + S[3] * ka.w + S[4] * kb.x + S[5] * kb.y + S[6] * kb.z + S[7] * kb.w;
                    float yy = S[0] * ra.x + S[1] * ra.y + S[2] * ra.z + S[3] * ra.w + S[4] * rb.x + S[5] * rb.y + S[6] * rb.z + S[7] * rb.w;
                    sk = red8(sk); yy = red8(yy);
                    const float y = yy + sk * c1 + vv * c2;
                    S[0] = S[0] * wa.x + sk * na.x + vv * da.x; S[1] = S[1] * wa.y + sk * na.y + vv * da.y; S[2] = S[2] * wa.z + sk * na.z + vv * da.z; S[3] = S[3] * wa.w + sk * na.w + vv * da.w;
                    S[4] = S[4] * wb.x + sk * nb_.x + vv * db.x; S[5] = S[5] * wb.y + sk * nb_.y + vv * db.y; S[6] = S[6] * wb.z + sk * nb_.z + vv * db.z; S[7] = S[7] * wb.w + sk * nb_.w + vv * db.w;
                    if (kq == 0) ybuf[tl * 64 + vrow] = y;
                }
                __syncthreads();
#pragma unroll
                for (int i = 0; i < 4; ++i) { const int tl = wv + 8 * i; YD[((size_t)d * NTOK + rowbase + t0 + tl) * 512 + h * 64 + c] = ybuf[tl * 64 + c]; }
            }
        }
        __syncthreads();
    }
}

typedef short v4i16_t __attribute__((ext_vector_type(4)));
__device__ __forceinline__ int swz_off(int row, int chunk) { return row * 128 + ((chunk ^ (row & 7)) << 4); }
__device__ __forceinline__ void stage_rows(LAS unsigned char* dst, const bf16* src, int nrows, int tid) {
    for (int idx = tid; idx < nrows * 8; idx += 512) { const int r = idx >> 3, ch = idx & 7; const v4u v = *(const GAS v4u*)(src + (size_t)r * DINP + ch * 8); *(LAS v4u*)(dst + swz_off(r, ch)) = v; }
}
__device__ __forceinline__ bf16x8 q_scale8(bf16x8 q) { const v4u w = __builtin_bit_cast(v4u, q); v4u r;
    r.x = pk2(bflo(w.x) * 0.125f, bfhi(w.x) * 0.125f); r.y = pk2(bflo(w.y) * 0.125f, bfhi(w.y) * 0.125f); r.z = pk2(bflo(w.z) * 0.125f, bfhi(w.z) * 0.125f); r.w = pk2(bflo(w.w) * 0.125f, bfhi(w.w) * 0.125f);
    return __builtin_bit_cast(bf16x8, r); }
struct AttState { float m, l; f32x4 o[4]; };
struct AttOff { int k[2]; int v[4]; int boff; unsigned okm; };
__device__ __forceinline__ AttOff att_offsets(int lane, int wc0, int qc, int cs) { AttOff o; const int kl = lane & 15, g = lane >> 4, q_ = kl >> 2, p_ = kl & 3;
#pragma unroll
    for (int dh = 0; dh < 2; ++dh) o.k[dh] = swz_off(kl, dh * 4 + g);
#pragma unroll
    for (int dt = 0; dt < 4; ++dt) o.v[dt] = swz_off(4 * g + q_, 2 * dt + (p_ >> 1)) + (p_ & 1) * 8;
    o.boff = (wc0 + 4 * g - qc + 15) * 4; o.okm = 0u;
#pragma unroll
    for (int j = 0; j < 8; ++j) { const int kc = wc0 + (j >> 2) * 16 + 4 * g + (j & 3); if ((kc >= cs) && (kc < cs + 16)) o.okm |= 1u << j; }
    return o; }
template <bool LOCAL>
__device__ __forceinline__ void att_kstep(AttState& st, const LAS unsigned char* kb, const LAS unsigned char* vb, int r0, const bf16x8 (&qf)[2], int lane, const AttOff& ao, const LAS float* rpbrow) {
    const LAS unsigned char* kr = kb + r0 * 128; const LAS unsigned char* vr = vb + r0 * 128;
    f32x4 s0 = {0.f, 0.f, 0.f, 0.f}, s1 = {0.f, 0.f, 0.f, 0.f};
#pragma unroll
    for (int dh = 0; dh < 2; ++dh) {
        const bf16x8 k0 = *(const LAS bf16x8*)(kr + ao.k[dh]); const bf16x8 k1 = *(const LAS bf16x8*)(kr + ao.k[dh] + 2048);
        s0 = __builtin_amdgcn_mfma_f32_16x16x32_bf16(k0, qf[dh], s0, 0, 0, 0); s1 = __builtin_amdgcn_mfma_f32_16x16x32_bf16(k1, qf[dh], s1, 0, 0, 0);
    }
    float sc[8];
#pragma unroll
    for (int j = 0; j < 4; ++j) { sc[j] = s0[j]; sc[4 + j] = s1[j]; }
    if (LOCAL) {
        float bv[8]; const unsigned ad = (unsigned)(uintptr_t)rpbrow + (unsigned)ao.boff;
#pragma unroll
        for (int j = 0; j < 8; ++j) asm volatile("ds_read_b32 %0, %1 offset:%2" : "=v"(bv[j]) : "v"(ad), "i"(((j >> 2) * 16 + (j & 3)) * 4));
        asm volatile("s_waitcnt lgkmcnt(0)" : "+v"(bv[0]), "+v"(bv[1]), "+v"(bv[2]), "+v"(bv[3]), "+v"(bv[4]), "+v"(bv[5]), "+v"(bv[6]), "+v"(bv[7]) :: "memory");
#pragma unroll
        for (int j = 0; j < 8; ++j) sc[j] = ((ao.okm >> j) & 1u) ? sc[j] + bv[j] : -INFINITY;
    }
    float mt = fmaxf(fmaxf(fmaxf(sc[0], sc[1]), fmaxf(sc[2], sc[3])), fmaxf(fmaxf(sc[4], sc[5]), fmaxf(sc[6], sc[7])));
    mt = xmax16(mt); mt = xmax32(mt);
    if (__any(mt > st.m)) {
        const float mn = fmaxf(st.m, mt); const float scale = (mn == -INFINITY) ? 1.0f : __expf(st.m - mn); st.l *= scale; st.m = mn;
#pragma unroll
        for (int dt = 0; dt < 4; ++dt) st.o[dt] = st.o[dt] * scale; }
    float p[8], ps = 0.f; const float mref = (st.m == -INFINITY) ? 0.f : st.m;
#pragma unroll
    for (int j = 0; j < 8; ++j) { p[j] = __expf(sc[j] - mref); ps += p[j]; }
    st.l += ps;
    v4u pw; pw.x = pk2(p[0], p[1]); pw.y = pk2(p[2], p[3]); pw.z = pk2(p[4], p[5]); pw.w = pk2(p[6], p[7]);
    const bf16x8 pf = __builtin_bit_cast(bf16x8, pw);
#pragma unroll
    for (int dt = 0; dt < 4; ++dt) {
        const v4i16_t lo = __builtin_amdgcn_ds_read_tr16_b64_v4i16((LAS v4i16_t*)(vr + ao.v[dt]));
        const v4i16_t hi = __builtin_amdgcn_ds_read_tr16_b64_v4i16((LAS v4i16_t*)(vr + ao.v[dt] + 2048));
        const bf16x8 vf = (bf16x8){lo[0], lo[1], lo[2], lo[3], hi[0], hi[1], hi[2], hi[3]};
        st.o[dt] = __builtin_amdgcn_mfma_f32_16x16x32_bf16(vf, pf, st.o[dt], 0, 0, 0);
    }
}
__device__ __forceinline__ void att_merge_store(AttState& st, LAS float* mrg, int qb, int kh, int lane, bf16* orow0  ) {
    LAS float* mine = mrg + qb * (18 * 64) + lane;
    if (kh == 1) { mine[0] = st.m; mine[64] = st.l;
#pragma unroll
        for (int dt = 0; dt < 4; ++dt)
#pragma unroll
            for (int j = 0; j < 4; ++j) mine[(2 + dt * 4 + j) * 64] = st.o[dt][j]; }
    __syncthreads();
    if (kh == 0) {
        const float m1 = mine[0], l1 = mine[64]; const float ms = fmaxf(st.m, m1); const float f0 = __expf(st.m - ms), f1 = __expf(m1 - ms);
        float lc = st.l * f0 + l1 * f1; lc = xsum16(lc); lc = xsum32(lc); const float inv = 1.0f / lc;
        const int q = lane & 15, g = lane >> 4;
#pragma unroll
        for (int dt = 0; dt < 4; ++dt) { float r[4];
#pragma unroll
            for (int j = 0; j < 4; ++j) r[j] = (st.o[dt][j] * f0 + mine[(2 + dt * 4 + j) * 64] * f1) * inv;
            v2u w; w.x = pk2(r[0], r[1]); w.y = pk2(r[2], r[3]); *(GAS v2u*)(orow0 + (size_t)q * DM + dt * 16 + 4 * g) = w; }
    }
}
__device__ __forceinline__ void phase_attn(LAS unsigned char* lds, int l) {
    const KA a = ka_get();
    const int tid = opaque_tid(), lane = tid & 63, wv = __builtin_amdgcn_readfirstlane(tid >> 6), qb = wv & 3, kh = wv >> 2;
    LAS unsigned char* KC = lds; LAS unsigned char* VC = lds + 32768; LAS unsigned char* KL = lds + 65536; LAS unsigned char* VL = lds + 98304;
    LAS float* RPB = (LAS float*)(lds + LDSCTL_OFF + 2048); LAS float* mrg = (LAS float*)(lds + LDSCTL_OFF + 4096);
    const bf16* PX = (const bf16*)(a.ws() + WS_X2); bf16* CAT = (bf16*)(a.ws() + WS_X1);
    for (int blk = blockIdx.x; blk < 256; blk += gridDim.x) {
        const int bh = blk >> 1, b = bh >> 3, h = bh & 7, half = blk & 1;
        __syncthreads();
        const bf16* ctxrow = PX + (size_t)(NTX + b * CTXL) * DINP + h * 64;
        stage_rows(KC, ctxrow + 512, 256, tid); stage_rows(VC, ctxrow + 1024, 256, tid);
        for (int i = tid; i < 465; i += 512) RPB[i] = a.in(I_RPB)[((size_t)l * 8 + h) * 465 + i];
        __syncthreads();
        const int kl = lane & 15, g = lane >> 4;
        const AttOff ao = att_offsets(lane, min(max(qb * 16 - 8, 0), 32), qb * 16 + kl, min(max(qb * 16 + kl - 8, 0), 48));
        if (l == 0) {
            for (int rr = 0; rr < 2; ++rr) {
                const int q0 = (half * 8 + rr * 4 + qb) * 16; const bf16* qrow = ctxrow + (size_t)(q0 + kl) * DINP;
                bf16x8 qf[2]; qf[0] = q_scale8(*(const GAS bf16x8*)(qrow + 8 * g)); qf[1] = q_scale8(*(const GAS bf16x8*)(qrow + 32 + 8 * g));
                AttState st; st.m = -INFINITY; st.l = 0.f;
#pragma unroll
                for (int dt = 0; dt < 4; ++dt) st.o[dt] = (f32x4){0.f, 0.f, 0.f, 0.f};
                for (int s = 0; s < 4; ++s) att_kstep<false>(st, KC, VC, kh * 128 + s * 32, qf, lane, ao, RPB);
                att_merge_store(st, mrg, qb, kh, lane, CAT + (size_t)(NTX + b * CTXL + q0) * DM + h * 64);
                __syncthreads();
            }
        }
        v4u pfk0[4], pfv0[4], pfk1[4], pfv1[4];
#define ATT_ISSUE(SIDX, pfk, pfv) do { const int i_ = half * 16 + ((SIDX) >> 1); const int rs_ = min(max(i_ - 4, 0), 24); const bf16* lr_ = PX + (size_t)(b * SEQ + (rs_ + 4 * ((SIDX) & 1)) * 64) * DINP + h * 64; \
            _Pragma("unroll") for (int q__ = 0; q__ < 4; ++q__) { const int idx_ = tid + 512 * q__; const bf16* p_ = lr_ + (size_t)(idx_ >> 3) * DINP + (idx_ & 7) * 8; pfk[q__] = *(const GAS v4u*)(p_ + 512); pfv[q__] = *(const GAS v4u*)(p_ + 1024); } } while (0)
        bf16x8 qn[2]; { const bf16* qrow = PX + (size_t)(b * SEQ + (half * 16) * 64 + qb * 16 + kl) * DINP + h * 64; qn[0] = *(const GAS bf16x8*)(qrow + 8 * g); qn[1] = *(const GAS bf16x8*)(qrow + 32 + 8 * g); }
        ATT_ISSUE(0, pfk0, pfv0); ATT_ISSUE(1, pfk1, pfv1);
#define ATT_STAGE(pfk, pfv) do { _Pragma("unroll") for (int q__ = 0; q__ < 4; ++q__) { const int idx_ = tid + 512 * q__; const int o_ = swz_off(idx_ >> 3, idx_ & 7); *(LAS v4u*)(KL + o_) = pfk[q__]; *(LAS v4u*)(VL + o_) = pfv[q__]; } } while (0)
#define ATT_LOCAL(pass) do { for (int k2 = 0; k2 < 2; ++k2) { const int kr = 2 * kh + k2, arow = rs + 4 * (pass) + kr; att_kstep<true>(st, KL, VL, kr * 64 + wc0, qf, lane, ao, RPB + (arow - i + 7) * 31); } } while (0)
        for (int ui = 0; ui < 16; ++ui) {
            const int i = half * 16 + ui; const int rs = min(max(i - 4, 0), 24); const int un = ui + 1 < 16 ? ui + 1 : ui;
            const int qc = qb * 16 + kl, wc0 = min(max(qb * 16 - 8, 0), 32);
            bf16x8 qf[2]; qf[0] = q_scale8(qn[0]); qf[1] = q_scale8(qn[1]);
            { const bf16* qrow = PX + (size_t)(b * SEQ + (half * 16 + un) * 64 + qc) * DINP + h * 64; qn[0] = *(const GAS bf16x8*)(qrow + 8 * g); qn[1] = *(const GAS bf16x8*)(qrow + 32 + 8 * g); }
            ATT_STAGE(pfk0, pfv0); ATT_ISSUE(2 * un, pfk0, pfv0);
            AttState st; st.m = -INFINITY; st.l = 0.f;
#pragma unroll
            for (int dt = 0; dt < 4; ++dt) st.o[dt] = (f32x4){0.f, 0.f, 0.f, 0.f};
            for (int s = 0; s < 4; ++s) att_kstep<false>(st, KC, VC, kh * 128 + s * 32, qf, lane, ao, RPB);
            __syncthreads();
            ATT_LOCAL(0);
            __syncthreads();
            ATT_STAGE(pfk1, pfv1); ATT_ISSUE(2 * un + 1, pfk1, pfv1);
            __syncthreads();
            ATT_LOCAL(1);
            att_merge_store(st, mrg, qb, kh, lane, CAT + (size_t)(b * SEQ + i * 64 + qb * 16) * DM + h * 64);
        }
#undef ATT_STAGE
#undef ATT_LOCAL
    }
}

__device__ __forceinline__ void phase_rwpost(LAS unsigned char* lds, int l) {
    const KA a = ka_get();
    const int tid = opaque_tid(), lane = tid & 63, hh = __builtin_amdgcn_readfirstlane(tid >> 6), kl = lane & 15, g = lane >> 4;
    const int er = tid >> 5, cq = tid & 31, c0 = cq * 16, hq = cq >> 2;
    LAS bf16* sig = (LAS bf16*)lds;
    LAS float* Gl = (LAS float*)(lds + 4096);
    const bf16* PX = (const bf16*)(a.ws() + WS_X2); const bf16* YD = (const bf16*)(a.ws() + WS_X3); const float* BON = (const float*)(a.ws() + WS_BONUS); bf16* CAT = (bf16*)(a.ws() + WS_X1);
    const float* mup = a.in(I_MUP) + l * 1760; const float* mun = a.in(I_MUN) + l * 1760; const float* g2 = a.in(I_G2) + (size_t)l * 96 * 512;
    const float* gngp = a.in(I_GNG) + l * 512 + c0; const float* gnbp = a.in(I_GNB) + l * 512 + c0;
    bf16x8 gb[3][4];
#pragma unroll
    for (int ks = 0; ks < 3; ++ks)
#pragma unroll
        for (int nt = 0; nt < 4; ++nt) { v4u w; unsigned t[8];
#pragma unroll
            for (int j = 0; j < 8; ++j) t[j] = f2bf(g2[(size_t)(32 * ks + 8 * g + j) * 512 + 64 * hh + 16 * nt + kl]);
            w.x = t[0] | (t[1] << 16); w.y = t[2] | (t[3] << 16); w.z = t[4] | (t[5] << 16); w.w = t[6] | (t[7] << 16); gb[ks][nt] = __builtin_bit_cast(bf16x8, w); }
    const int nch = (l == 0 ? NTOK : NTX) / 16;
    LAS float* Pl = (LAS float*)(lds + 40960);
    Pl[tid] = mup[1024 + tid]; Pl[512 + tid] = mun[1024 + tid]; Pl[1024 + tid] = a.in(I_GNG)[l * 512 + tid]; Pl[1536 + tid] = a.in(I_GNB)[l * 512 + tid];
    int sr[3], sj[3]; float smp[3], smn[3];
#pragma unroll
    for (int k = 0; k < 3; ++k) { const int idx = tid + 512 * k; sr[k] = idx / 96; sj[k] = idx - sr[k] * 96; smp[k] = mup[1664 + sj[k]]; smn[k] = mun[1664 + sj[k]]; }
    unsigned short rawc[3], rawp[3], rawn[3]; v4u vc[2], vp[2], vn[2], y0[2], y1[2]; float bon0, bon1;
#define RWP_TT(ROW, t_, T_) int t_, T_; if ((ROW) < NTX) { t_ = (ROW) & (SEQ - 1); T_ = SEQ; } else { t_ = ((ROW) - NTX) & (CTXL - 1); T_ = CTXL; }
#define RWP_RAW(CH) do { const int ch_ = (CH) < nch ? (CH) : blockIdx.x; _Pragma("unroll") for (int k = 0; k < 3; ++k) { const int row_ = ch_ * 16 + sr[k]; RWP_TT(row_, t_, T_) \
            const bf16* p_ = PX + (size_t)row_ * DINP + RWOFF + 1664 + sj[k]; rawc[k] = p_[0]; rawp[k] = p_[t_ > 0 ? -DINP : 0]; rawn[k] = p_[t_ + 1 < T_ ? DINP : 0]; } } while (0)
#define RWP_Y(CH) do { const int ch_ = (CH) < nch ? (CH) : blockIdx.x; const int row_ = ch_ * 16 + er; \
        _Pragma("unroll") for (int i = 0; i < 2; ++i) { y0[i] = *(const GAS v4u*)(YD + (size_t)row_ * 512 + c0 + 8 * i); y1[i] = *(const GAS v4u*)(YD + ((size_t)NTOK + row_) * 512 + c0 + 8 * i); } } while (0)
#define RWP_V(CH) do { const int ch_ = (CH) < nch ? (CH) : blockIdx.x; const int row_ = ch_ * 16 + er; RWP_TT(row_, t_, T_) const bf16* pvp_ = PX + (size_t)row_ * DINP + RWOFF + 1024 + c0; const int op_ = t_ > 0 ? -DINP : 0, on_ = t_ + 1 < T_ ? DINP : 0; \
        _Pragma("unroll") for (int i = 0; i < 2; ++i) { vc[i] = *(const GAS v4u*)(pvp_ + 8 * i); vp[i] = *(const GAS v4u*)(pvp_ + op_ + 8 * i); vn[i] = *(const GAS v4u*)(pvp_ + on_ + 8 * i); } \
        bon0 = BON[(size_t)row_ * 8 + hq]; bon1 = BON[((size_t)NTOK + row_) * 8 + hq]; } while (0)
    RWP_RAW(blockIdx.x); RWP_Y(blockIdx.x); RWP_V(blockIdx.x);
    for (int ch = blockIdx.x; ch < nch; ch += gridDim.x) {
        const int row0 = ch * 16;
        __syncthreads();
#pragma unroll
        for (int k = 0; k < 3; ++k) { const int row_ = row0 + sr[k]; RWP_TT(row_, t, T)
            const float cv = bf2f(rawc[k]), pv = bf2f(rawp[k]) * (t > 0 ? 1.f : 0.f), nv = bf2f(rawn[k]) * (t + 1 < T ? 1.f : 0.f);
            const float z = cv + smp[k] * (pv - cv) + smn[k] * (nv - cv); sig[sr[k] * 96 + sj[k]] = f2bf1(sigmoidf_(z)); }
        RWP_RAW(ch + (int)gridDim.x);
        const int row = row0 + er; RWP_TT(row, t, T) const float fp = t > 0 ? 1.f : 0.f, fn = t + 1 < T ? 1.f : 0.f;
        __syncthreads();
        { f32x4 acc[4];
#pragma unroll
          for (int nt = 0; nt < 4; ++nt) acc[nt] = (f32x4){0.f, 0.f, 0.f, 0.f};
#pragma unroll
          for (int ks = 0; ks < 3; ++ks) { const bf16x8 af = *(const LAS bf16x8*)(sig + kl * 96 + 32 * ks + 8 * g);
#pragma unroll
              for (int nt = 0; nt < 4; ++nt) acc[nt] = __builtin_amdgcn_mfma_f32_16x16x32_bf16(af, gb[ks][nt], acc[nt], 0, 0, 0); }
#pragma unroll
          for (int nt = 0; nt < 4; ++nt)
#pragma unroll
              for (int j = 0; j < 4; ++j) Gl[(4 * g + j) * 512 + 64 * hh + 16 * nt + kl] = acc[nt][j]; }
        __syncthreads();
        f32x4 y[4]; float s = 0.f;
#pragma unroll
        for (int i = 0; i < 4; ++i) { const unsigned a0 = y0[i >> 1][(i & 1) * 2], a1 = y0[i >> 1][(i & 1) * 2 + 1], b0 = y1[i >> 1][(i & 1) * 2], b1 = y1[i >> 1][(i & 1) * 2 + 1];
            y[i] = (f32x4){bflo(a0) + bflo(b0), bfhi(a0) + bfhi(b0), bflo(a1) + bflo(b1), bfhi(a1) + bfhi(b1)}; s += (y[i].x + y[i].y) + (y[i].z + y[i].w); }
        RWP_Y(ch + (int)gridDim.x);
        s += dppmov<0xB1>(s); s += dppmov<0x4E>(s); const float mean = s * (1.0f / 64.0f); float q = 0.f;
#pragma unroll
        for (int i = 0; i < 4; ++i) { y[i] = y[i] - mean; q += (y[i].x * y[i].x + y[i].y * y[i].y) + (y[i].z * y[i].z + y[i].w * y[i].w); }
        q += dppmov<0xB1>(q); q += dppmov<0x4E>(q); const float rstd = 1.0f / sqrtf(q * (1.0f / 64.0f) + GN_EPS);
        const float bon = bon0 + bon1;
        unsigned ow[8];
#pragma unroll
        for (int i = 0; i < 4; ++i) { const unsigned cw0 = vc[i >> 1][(i & 1) * 2], cw1 = vc[i >> 1][(i & 1) * 2 + 1], pw0 = vp[i >> 1][(i & 1) * 2], pw1 = vp[i >> 1][(i & 1) * 2 + 1], nw0 = vn[i >> 1][(i & 1) * 2], nw1 = vn[i >> 1][(i & 1) * 2 + 1];
            const f32x4 cv = {bflo(cw0), bfhi(cw0), bflo(cw1), bfhi(cw1)}, pv = {bflo(pw0) * fp, bfhi(pw0) * fp, bflo(pw1) * fp, bfhi(pw1) * fp}, nv = {bflo(nw0) * fn, bfhi(nw0) * fn, bflo(nw1) * fn, bfhi(nw1) * fn};
            const f32x4 mpv = *(const LAS f32x4*)(Pl + c0 + 4 * i), mnv = *(const LAS f32x4*)(Pl + 512 + c0 + 4 * i), gng = *(const LAS f32x4*)(Pl + 1024 + c0 + 4 * i), gnb = *(const LAS f32x4*)(Pl + 1536 + c0 + 4 * i);
            const f32x4 zv = cv + mpv * (pv - cv) + mnv * (nv - cv);
            const f32x4 gt = *(const LAS f32x4*)(Gl + er * 512 + c0 + 4 * i);
            const f32x4 o = (y[i] * rstd * gng + gnb + zv * bon) * gt;
            ow[2 * i] = pk2(o.x, o.y); ow[2 * i + 1] = pk2(o.z, o.w); }
        RWP_V(ch + (int)gridDim.x);
        GAS v4u* dst = (GAS v4u*)(CAT + (size_t)row * DM + 512 + c0); dst[0] = (v4u){ow[0], ow[1], ow[2], ow[3]}; dst[1] = (v4u){ow[4], ow[5], ow[6], ow[7]};
    }
#undef RWP_TT
#undef RWP_RAW
#undef RWP_Y
#undef RWP_V
}

struct RowMap { int WPB, RPWX, RPWC; };
__device__ __forceinline__ RowMap rowmap(int NGW) { RowMap r; r.WPB = NGW / NB; r.RPWX = SEQ / r.WPB; r.RPWC = NTC / NGW; return r; }
__device__ __forceinline__ int route_wave(int m, const RowMap& r) { if (m < NTX) { const int b = m / SEQ, t = m - b * SEQ; return b * r.WPB + t / r.RPWX; } return (m - NTX) / r.RPWC; }
typedef _Float16 f16x8 __attribute__((ext_vector_type(8)));
typedef _Float16 f16x2_ __attribute__((ext_vector_type(2)));
__device__ __forceinline__ unsigned pkh(float a, float b) { f32x2_t_ v = {a, b}; f16x2_ h = __builtin_convertvector(v, f16x2_); return __builtin_bit_cast(unsigned, h); }
__device__ __forceinline__ void split_h(float a, float b, unsigned& hi, unsigned& lo) { hi = pkh(a, b); const f16x2_ hh = __builtin_bit_cast(f16x2_, hi); lo = pkh(a - (float)hh.x, b - (float)hh.y); }
constexpr int LN1_ROWB = 4112, LN1_RED = 67584;
template <bool BFIN> __device__ __forceinline__ void phase_ln1_route(LAS unsigned char* lds, int l) {
    const KA a = ka_get();
    const int tid = opaque_tid(), lane = tid & 63, wave = __builtin_amdgcn_readfirstlane(tid >> 6), G = gridDim.x, bid = blockIdx.x;
    const int gw = bid * 8 + wave, NGW = G * 8;
    if (tid < 32) ((LAS int*)(lds + LDSCTL_OFF + 1024))[tid] = 0;
    f16x8 Wh[2][4], Wl[2][4];
    { const float* RW = a.in(I_RW) + (size_t)(128 * wave + 8 * (lane >> 4)) * 32 + (lane & 15);
#pragma unroll
      for (int nt = 0; nt < 2; ++nt)
#pragma unroll
        for (int ks = 0; ks < 4; ++ks) { unsigned h[4], lo[4];
#pragma unroll
            for (int t = 0; t < 4; ++t) { const float w0 = RW[(32 * ks + 2 * t) * 32 + 16 * nt] * 256.f, w1 = RW[(32 * ks + 2 * t + 1) * 32 + 16 * nt] * 256.f; split_h(w0, w1, h[t], lo[t]); }
            Wh[nt][ks] = __builtin_bit_cast(f16x8, (v4u){h[0], h[1], h[2], h[3]}); Wl[nt][ks] = __builtin_bit_cast(f16x8, (v4u){lo[0], lo[1], lo[2], lo[3]}); } }
    __syncthreads();
    const float* mods = (const float*)(a.ws() + WS_MODS) + (size_t)l * 17 * 6144;
    const bf16* O = (const bf16*)(a.ws() + WS_X3); bf16* HM = (bf16*)(a.ws() + WS_X1);
    const float* xs = a.in(I_X); const float* cs = a.in(I_CTX); const bf16* xb = (const bf16*)a.out(); bf16* XP = (bf16*)(a.ws() + WS_XP);
    int* HIST = (int*)(a.ws() + WS_LIST); TokInfo* TOK = (TokInfo*)(a.ws() + WS_TOK); LAS int* lcnt = (LAS int*)(lds + LDSCTL_OFF + 1024);
    const GAS f32x4* lg = (const GAS f32x4*)(a.in(I_LN1G) + l * DM) + lane; const GAS f32x4* lb = (const GAS f32x4*)(a.in(I_LN1B) + l * DM) + lane;
    const float biasv = a.in(I_RB)[(lane >> 1) & 31];
    f32x4 lgv[4], lbv[4];
#pragma unroll
    for (int j = 0; j < 4; ++j) { lgv[j] = lg[64 * j]; lbv[j] = lb[64 * j]; }
    const RowMap rm = rowmap(NGW);
    const int bx = gw / rm.WPB, xbase = bx * SEQ + (gw - bx * rm.WPB) * rm.RPWX, cbase = NTX + gw * rm.RPWC, nxr = rm.RPWX, ntot = nxr + (BFIN ? 0 : rm.RPWC);
    f32x4 nx[4]; v2u nxb[4], no[4];
#define LN1_ROW(J) ((J) < nxr ? xbase + (J) : cbase + (J) - nxr)
#define LN1_FETCH(J) do { const int jj_ = (J) < ntot ? (J) : ntot - 1; const int m_ = LN1_ROW(jj_); const GAS v2u* or_ = (const GAS v2u*)(O + (size_t)m_ * DM) + lane; \
        if constexpr (BFIN) { const GAS v2u* xr_ = (const GAS v2u*)(xb + (size_t)m_ * DM) + lane; \
            _Pragma("unroll") for (int j_ = 0; j_ < 4; ++j_) { nxb[j_] = xr_[64 * j_]; no[j_] = or_[64 * j_]; } } \
        else { const float* s_ = m_ < NTX ? xs + (size_t)m_ * DM : cs + (size_t)(m_ - NTX) * DM; const GAS f32x4* xr_ = (const GAS f32x4*)s_ + lane; \
            _Pragma("unroll") for (int j_ = 0; j_ < 4; ++j_) { nx[j_] = xr_[64 * j_]; no[j_] = or_[64 * j_]; } } } while (0)
    LN1_FETCH(0);
    const unsigned afrag = (unsigned)((lane & 15) * LN1_ROWB + (128 * wave + 8 * (lane >> 4)) * 2);
    LAS float* red = (LAS float*)(lds + LN1_RED);
    for (int seg = 0; seg < (BFIN ? 1 : 2); ++seg) {
        const int j0 = seg ? nxr : 0, j1 = seg ? ntot : nxr; const int mr = seg ? 16 : bx;
        const GAS f32x4* md = (const GAS f32x4*)(mods + (size_t)mr * 6144) + lane;
        f32x4 sc2[4], sh2[4], gt1[4];
#pragma unroll
        for (int j = 0; j < 4; ++j) { gt1[j] = md[512 + 64 * j]; sc2[j] = md[1024 + 64 * j]; sh2[j] = md[768 + 64 * j]; }
      for (int jb = j0; jb < j1; jb += 2) {
#pragma unroll
        for (int r = 0; r < 2; ++r) {
            const int m = LN1_ROW(jb + r);
            f32x4 v[4]; float s = 0.f;
#pragma unroll
            for (int j = 0; j < 4; ++j) { f32x4 x; if constexpr (BFIN) { const v2u xw = nxb[j]; x = f32x4{bflo(xw.x), bfhi(xw.x), bflo(xw.y), bfhi(xw.y)}; } else x = nx[j];
                const f32x4 gt = gt1[j]; const v2u ow = no[j]; const f32x4 o = {bflo(ow.x), bfhi(ow.x), bflo(ow.y), bfhi(ow.y)};
                v[j] = x * ALPHA + gt * o; s += (v[j].x + v[j].y) + (v[j].z + v[j].w); }
            LN1_FETCH(jb + r + 1);
            const float mean = wave_sum(s) * (1.f / DM); float s2 = 0.f;
#pragma unroll
            for (int j = 0; j < 4; ++j) { v[j] = v[j] - mean; s2 += (v[j].x * v[j].x + v[j].y * v[j].y) + (v[j].z * v[j].z + v[j].w * v[j].w); }
            const float rstd = 1.f / sqrtf(wave_sum(s2) * (1.f / DM) + LN_EPS);
            GAS v2u* dr = (GAS v2u*)(XP + (size_t)m * DM) + lane; GAS v2u* hr = (GAS v2u*)(HM + (size_t)m * DM) + lane;
            const unsigned trow = (unsigned)((2 * wave + r) * LN1_ROWB + 8 * lane);
#pragma unroll
            for (int j = 0; j < 4; ++j) { const f32x4 x1 = v[j] * rstd * lgv[j] + lbv[j]; { v2u xw; xw.x = pk2(x1.x, x1.y); xw.y = pk2(x1.z, x1.w); dr[64 * j] = xw; }
                const f32x4 hm = x1 * (sc2[j] + 1.0f) + sh2[j]; v2u w; w.x = pk2(hm.x, hm.y); w.y = pk2(hm.z, hm.w); hr[64 * j] = w;
                unsigned h0_, l0_, h1_, l1_; split_h(hm.x, hm.y, h0_, l0_); split_h(hm.z, hm.w, h1_, l1_); const v2u hh = {h0_, h1_}, hl = {l0_, l1_};
                *(LAS v2u*)(lds + trow + 512 * j) = hh; *(LAS v2u*)(lds + trow + 2048 + 512 * j) = hl; }
        }
        __syncthreads();
        {
            f32x4 acc0 = {0.f, 0.f, 0.f, 0.f}, acc1 = {0.f, 0.f, 0.f, 0.f};
            f16x8 ah[4], al[4];
#pragma unroll
            for (int ks = 0; ks < 4; ++ks) { ah[ks] = *(const LAS f16x8*)(lds + afrag + 64 * ks); al[ks] = *(const LAS f16x8*)(lds + afrag + 2048 + 64 * ks); }
#pragma unroll
            for (int ks = 0; ks < 4; ++ks) {
                acc0 = __builtin_amdgcn_mfma_f32_16x16x32_f16(al[ks], Wh[0][ks], acc0, 0, 0, 0); acc1 = __builtin_amdgcn_mfma_f32_16x16x32_f16(al[ks], Wh[1][ks], acc1, 0, 0, 0);
                acc0 = __builtin_amdgcn_mfma_f32_16x16x32_f16(ah[ks], Wl[0][ks], acc0, 0, 0, 0); acc1 = __builtin_amdgcn_mfma_f32_16x16x32_f16(ah[ks], Wl[1][ks], acc1, 0, 0, 0);
                acc0 = __builtin_amdgcn_mfma_f32_16x16x32_f16(ah[ks], Wh[0][ks], acc0, 0, 0, 0); acc1 = __builtin_amdgcn_mfma_f32_16x16x32_f16(ah[ks], Wh[1][ks], acc1, 0, 0, 0); }
            LAS float* rw_ = red + (wave * 16 + 4 * (lane >> 4)) * 32 + (lane & 15);
#pragma unroll
            for (int i = 0; i < 4; ++i) { rw_[i * 32] = acc0[i]; rw_[i * 32 + 16] = acc1[i]; }
        }
        __syncthreads();
#pragma unroll 1
        for (int r = 0; r < 2; ++r) {
            const int m = LN1_ROW(jb + r);
            const LAS float* rr = red + (2 * wave + r) * 32 + ((lane >> 1) & 31); float lsum[8];
#pragma unroll
            for (int w = 0; w < 8; ++w) lsum[w] = rr[w * 512];
            const float logit = (((lsum[0] + lsum[1]) + (lsum[2] + lsum[3])) + ((lsum[4] + lsum[5]) + (lsum[6] + lsum[7]))) * (1.f / 256.f);
        const float score = sigmoidf_(logit), sel = score + biasv;
        const int gl = lane & ~7;
        const float q0 = shi(sel, gl), q1 = shi(sel, gl + 2), q2 = shi(sel, gl + 4), q3 = shi(sel, gl + 6);
        const float mx = fmaxf(fmaxf(q0, q1), fmaxf(q2, q3));
        float top2;
        { float a0 = q0, a1 = q1, a2 = q2, a3 = q3; float t;
          if (a0 < a1) { t = a0; a0 = a1; a1 = t; } if (a2 < a3) { t = a2; a2 = a3; a3 = t; } if (a0 < a2) { t = a0; a0 = a2; a2 = t; } if (a1 < a3) { t = a1; a1 = a3; a3 = t; } if (a1 < a2) { t = a1; a1 = a2; a2 = t; }
          top2 = a0 + a1; (void)mx; }
        float best = __builtin_bit_cast(float, __builtin_amdgcn_readlane(__builtin_bit_cast(int, top2), 0)); int gidx = 0;
#pragma unroll
        for (int gg = 1; gg < 8; ++gg) { const float sc = __builtin_bit_cast(float, __builtin_amdgcn_readlane(__builtin_bit_cast(int, top2), gg * 8)); if (sc > best) { best = sc; gidx = gg; } }
        const float r0 = shi(sel, gidx * 8), r1 = shi(sel, gidx * 8 + 2), r2 = shi(sel, gidx * 8 + 4), r3 = shi(sel, gidx * 8 + 6);
        int i0 = 0; float b0 = r0; if (r1 > b0) { b0 = r1; i0 = 1; } if (r2 > b0) { b0 = r2; i0 = 2; } if (r3 > b0) { b0 = r3; i0 = 3; }
        int i1 = -1; float b1 = -INFINITY;
        if (i0 != 0 && r0 > b1) { b1 = r0; i1 = 0; } if (i0 != 1 && r1 > b1) { b1 = r1; i1 = 1; } if (i0 != 2 && r2 > b1) { b1 = r2; i1 = 2; } if (i0 != 3 && r3 > b1) { b1 = r3; i1 = 3; }
        const int e0 = gidx * 4 + i0, e1 = gidx * 4 + i1;
        const float s0 = shi(score, 2 * e0), s1 = shi(score, 2 * e1); const float gs = 1.0f / (s0 + s1);
        if (lane == 0) { const int p0 = __hip_atomic_fetch_add(lcnt + e0, 1, __ATOMIC_RELAXED, __HIP_MEMORY_SCOPE_WORKGROUP), p1_ = __hip_atomic_fetch_add(lcnt + e1, 1, __ATOMIC_RELAXED, __HIP_MEMORY_SCOPE_WORKGROUP);
            TokInfo ti; ti.e0 = e0; ti.e1 = e1; ti.p0 = p0; ti.p1 = p1_; ti.g0 = s0 * gs; ti.g1 = s1 * gs; ti.pad0 = 0; ti.pad1 = 0; TOK[m] = ti; }
        }
      }
    }
    __syncthreads();
    if (tid < 32) HIST[bid * 32 + tid] = lcnt[tid];
}

template <bool FULL> __device__ __forceinline__ void moe_tables(LAS unsigned char* lds, int l) {
    const KA a = ka_get(); const int tid = opaque_tid(), G = gridDim.x;
    LAS int* pref = (LAS int*)(lds + PREF_OFF); LAS int* bb = (LAS int*)lds; LAS int* tot = (LAS int*)(lds + 65536);
    const int* HIST = (const int*)(a.ws() + WS_LIST);
    __syncthreads();
    const int e = tid & 31, grp = tid >> 5;
    int loc[16]; int run = 0;
#pragma unroll
    for (int i = 0; i < 16; ++i) { const int b = grp * 16 + i; loc[i] = (b < G) ? HIST[b * 32 + e] : 0; }
#pragma unroll
    for (int i = 0; i < 16; ++i) { const int v = loc[i]; loc[i] = run; run += v; }
    tot[grp * 32 + e] = run;
    __syncthreads();
    int base = 0, total = 0;
#pragma unroll
    for (int q = 0; q < 16; ++q) { const int v = tot[q * 32 + e]; base += (q < grp) ? v : 0; total += v; }
    if (FULL) {
#pragma unroll
        for (int i = 0; i < 16; ++i) bb[(grp * 16 + i) * 32 + e] = base + loc[i]; }
    if (grp == 0) pref[40 + e] = total;
    __syncthreads();
    if (tid == 0) { int acc = 0; for (int k = 0; k < 32; ++k) { pref[k] = acc; acc += (pref[40 + k] + 255) >> 8; } pref[32] = acc; }
    __syncthreads();
}
__device__ __forceinline__ void phase_gather(LAS unsigned char* lds, int l) {
    const KA a = ka_get();
    const int tid = opaque_tid(), lane = tid & 63, wave = __builtin_amdgcn_readfirstlane(tid >> 6), G = gridDim.x, bid = blockIdx.x;
    const int gw = bid * 8 + wave, NGW = G * 8;
    moe_tables<true>(lds, l);
    const LAS int* pref = (const LAS int*)(lds + PREF_OFF); const LAS int* bb = (const LAS int*)lds;
    const bf16* HM = (const bf16*)(a.ws() + WS_X1); bf16* XB = (bf16*)(a.ws() + WS_X2); const TokInfo* TOK = (const TokInfo*)(a.ws() + WS_TOK);
    const int Mrows = l == 0 ? NTOK : NTX;
    const RowMap rm = rowmap(NGW);
    {
        const int RPW = (Mrows + NGW - 1) / NGW, m0 = gw * RPW, mend = (m0 + RPW < Mrows) ? m0 + RPW : Mrows, nrows = mend - m0;
        int sl0v = 0, sl1v = 0;
        if (lane < nrows) { const int m = m0 + lane; const TokInfo ti = TOK[m]; const int blk = route_wave(m, rm) >> 3;
            sl0v = pref[ti.e0] * 256 + bb[blk * 32 + ti.e0] + ti.p0; sl1v = pref[ti.e1] * 256 + bb[blk * 32 + ti.e1] + ti.p1; }
        if (nrows > 0) {
            const GAS v4u* srcp = (const GAS v4u*)(HM + (size_t)m0 * DM) + lane; v4u n0 = srcp[0], n1 = srcp[64];
            for (int j = 0; j < nrows; ++j) {
                const v4u v0 = n0, v1 = n1; const int jn = j + 1 < nrows ? j + 1 : j;
                const GAS v4u* np = (const GAS v4u*)(HM + (size_t)(m0 + jn) * DM) + lane; n0 = np[0]; n1 = np[64];
                const int sl0 = __builtin_amdgcn_readlane(sl0v, j), sl1 = __builtin_amdgcn_readlane(sl1v, j);
                GAS v4u* d0 = (GAS v4u*)(XB + (size_t)sl0 * DM) + lane; GAS v4u* d1 = (GAS v4u*)(XB + (size_t)sl1 * DM) + lane;
                d0[0] = v0; d0[64] = v1; d1[0] = v0; d1[64] = v1;
            }
        }
    }
    for (int e = 0; e < 32; ++e) {
        const int c = pref[40 + e], npad = ((c + 255) & ~255) - c, r0 = pref[e] * 256 + c;
        for (int r = gw; r < npad; r += NGW) { GAS v4u* dst = (GAS v4u*)(XB + (size_t)(r0 + r) * DM) + lane; dst[0] = (v4u){0u, 0u, 0u, 0u}; dst[64] = (v4u){0u, 0u, 0u, 0u}; }
    }
}

__device__ __forceinline__ void phase_ln2(LAS unsigned char* lds, int l) {
    const KA a = ka_get();
    const int tid = opaque_tid(), lane = tid & 63, wave = __builtin_amdgcn_readfirstlane(tid >> 6), G = gridDim.x, bid = blockIdx.x;
    const int gw = bid * 8 + wave, NGW = G * 8;
    moe_tables<true>(lds, l);
    const LAS int* pref = (const LAS int*)(lds + PREF_OFF); const LAS int* bb = (const LAS int*)lds;
    const float* mods = (const float*)(a.ws() + WS_MODS) + (size_t)l * 17 * 6144;
    const bf16* Y = (const bf16*)(a.ws() + WS_X2); const TokInfo* TOK = (const TokInfo*)(a.ws() + WS_TOK);
    const bf16* XP = (const bf16*)(a.ws() + WS_XP);
    const GAS f32x4* lg = (const GAS f32x4*)(a.in(I_LN2G) + l * DM) + lane; const GAS f32x4* lb = (const GAS f32x4*)(a.in(I_LN2B) + l * DM) + lane;
    const int Mrows = l == 0 ? NTOK : NTX;
    f32x4 lgv[4], lbv[4];
#pragma unroll
    for (int j = 0; j < 4; ++j) { lgv[j] = lg[64 * j]; lbv[j] = lb[64 * j]; }
    const int RPW = (Mrows + NGW - 1) / NGW, m0 = gw * RPW, mend = (m0 + RPW < Mrows) ? m0 + RPW : Mrows, nrows = mend - m0;
    int sl0v = 0, sl1v = 0; float g0v = 0.f, g1v = 0.f;
    if (lane < nrows) { const TokInfo ti = TOK[m0 + lane]; const LAS int* bbw = bb + (route_wave(m0 + lane, rowmap(NGW)) >> 3) * 32;
        sl0v = pref[ti.e0] * 256 + bbw[ti.e0] + ti.p0; sl1v = pref[ti.e1] * 256 + bbw[ti.e1] + ti.p1; g0v = ti.g0; g1v = ti.g1; }
    v2u nxin[4], nain[4], nbin[4];
#define LN2_FETCH(J) do { const int j_ = (J) < nrows ? (J) : (nrows - 1); const int s0_ = __builtin_amdgcn_readlane(sl0v, j_), s1_ = __builtin_amdgcn_readlane(sl1v, j_); \
        const GAS v2u* xr_ = (const GAS v2u*)(XP + (size_t)(m0 + j_) * DM) + lane; const GAS v2u* y0_ = (const GAS v2u*)(Y + (size_t)s0_ * DM) + lane; const GAS v2u* y1_ = (const GAS v2u*)(Y + (size_t)s1_ * DM) + lane; \
        _Pragma("unroll") for (int q_ = 0; q_ < 4; ++q_) { nxin[q_] = xr_[64 * q_]; nain[q_] = y0_[64 * q_]; nbin[q_] = y1_[64 * q_]; } } while (0)
    if (nrows > 0) {
    LN2_FETCH(0);
    for (int jr = 0; jr < nrows; ) {
        const int mseg = m0 + jr; const int mr = mseg < NTX ? mseg / SEQ : 16; int segend = mseg < NTX ? (mr + 1) * SEQ : Mrows; segend = (segend < mend ? segend : mend) - m0;
        const GAS f32x4* md = (const GAS f32x4*)(mods + (size_t)mr * 6144) + lane;
        f32x4 gin[4], msc[4], msh[4];
#pragma unroll
        for (int j = 0; j < 4; ++j) gin[j] = md[1280 + 64 * j];
        if (l == 0) { const GAS f32x4* mn = (const GAS f32x4*)(mods + (size_t)17 * 6144 + (size_t)mr * 6144) + lane;
#pragma unroll
            for (int j = 0; j < 4; ++j) { msc[j] = mn[256 + 64 * j]; msh[j] = mn[64 * j]; } }
      for (; jr < segend; ++jr) {
        const int m = m0 + jr;
        const float tg0 = __builtin_bit_cast(float, __builtin_amdgcn_readlane(__builtin_bit_cast(int, g0v), jr)), tg1 = __builtin_bit_cast(float, __builtin_amdgcn_readlane(__builtin_bit_cast(int, g1v), jr));
        f32x4 v[4]; float s = 0.f;
#pragma unroll
        for (int j = 0; j < 4; ++j) { const v2u xw = nxin[j]; const f32x4 x = {bflo(xw.x), bfhi(xw.x), bflo(xw.y), bfhi(xw.y)}, gt = gin[j]; const v2u a0 = nain[j], a1 = nbin[j];
            const f32x4 ya = {bflo(a0.x), bfhi(a0.x), bflo(a0.y), bfhi(a0.y)}, yb = {bflo(a1.x), bfhi(a1.x), bflo(a1.y), bfhi(a1.y)};
            v[j] = x * ALPHA + gt * (ya * tg0 + yb * tg1); s += (v[j].x + v[j].y) + (v[j].z + v[j].w); }
        LN2_FETCH(jr + 1);
        const float mean = wave_sum(s) * (1.f / DM); float s2 = 0.f;
#pragma unroll
        for (int j = 0; j < 4; ++j) { v[j] = v[j] - mean; s2 += (v[j].x * v[j].x + v[j].y * v[j].y) + (v[j].z * v[j].z + v[j].w * v[j].w); }
        const float rstd = 1.f / sqrtf(wave_sum(s2) * (1.f / DM) + LN_EPS);
        if (l == 0) {
            GAS v2u* o8 = (GAS v2u*)((bf16*)(a.ws() + WS_X1) + (size_t)m * DM) + lane; GAS v2u* xs8 = (GAS v2u*)((bf16*)a.out() + (size_t)(m < NTX ? m : 0) * DM) + lane;
            const bool isx = m < NTX;
#pragma unroll
            for (int j = 0; j < 4; ++j) { const f32x4 xn = v[j] * rstd * lgv[j] + lbv[j]; if (isx) { v2u xw; xw.x = pk2(xn.x, xn.y); xw.y = pk2(xn.z, xn.w); xs8[64 * j] = xw; }
                const f32x4 r = xn * (msc[j] + 1.0f) + msh[j]; v2u w; w.x = pk2(r.x, r.y); w.y = pk2(r.z, r.w); o8[64 * j] = w; }
        } else {
            GAS f32x4* of = (GAS f32x4*)(a.out() + (size_t)m * DM) + lane;
#pragma unroll
            for (int j = 0; j < 4; ++j) of[64 * j] = v[j] * rstd * lgv[j] + lbv[j];
        }
      }
    }
    }
}
namespace csc {
constexpr int ARR = 0;
constexpr int RAW = 0;
constexpr int ZL = 34816;
constexpr int WLO = 57344;
constexpr int FR = 58368;
constexpr int AABT = 87040;
constexpr int LWO = 91136;
constexpr int AAO = 107520;
__device__ __forceinline__ int sw16(int row, int chunk) { return row * 128 + ((chunk ^ (row & 7)) << 4); }
__device__ __forceinline__ v2u cvt4(const f32x4 v) { v2u r; r.x = pk2(v[0], v[1]); r.y = pk2(v[2], v[3]); return r; }
__device__ __forceinline__ bf16x8 mk8(v2u lo, v2u hi) { v4u w; w.x = lo.x; w.y = lo.y; w.z = hi.x; w.w = hi.y; return __builtin_bit_cast(bf16x8, w); }
__device__ __forceinline__ v2u trd(const LAS unsigned char* p) { return __builtin_bit_cast(v2u, __builtin_amdgcn_ds_read_tr16_b64_v4i16((LAS v4i16_t*)p)); }
__device__ __forceinline__ int opq(int v) { asm volatile("" : "+v"(v)); return v; }
__device__ __forceinline__ int opqs(int v) { asm volatile("" : "+s"(v)); return v; }
}
namespace bgc {
constexpr int CBUF = LDSCTL_OFF + 4096, CPITCH = 80, NITEMS = NEXP * 1536;
struct Item { const float* src; bf16* dst; int N, ld; };
__device__ __forceinline__ Item decode(const KA& a, int l, int item) {
    const int e = item / 1536; int r = item - e * 1536; const int m = r >> 9, t = r & 511; const size_t eo = ((size_t)l * NEXP + e) * (size_t)DM * DEXP; Item it;
    if (m < 2) { const int kt = t >> 4, nt = t & 15, j0 = 32 * nt; it.N = DEXP; it.ld = 1024; it.src = (m ? a.in(I_EW3) : a.in(I_EW1)) + eo + (size_t)(32 * kt) * DEXP + j0;
        it.dst = (bf16*)(a.ws() + WS_W13T) + (size_t)e * 1024 * 1024 + (size_t)(256 * (j0 >> 7) + 128 * m + (j0 & 127)) * 1024 + 32 * kt; }
    else { const int kt = t >> 5, nt = t & 31; it.N = DM; it.ld = 512; it.src = a.in(I_EW2) + eo + (size_t)(32 * kt) * DM + 32 * nt; it.dst = (bf16*)(a.ws() + WS_W2T) + (size_t)e * 1024 * 512 + (size_t)(32 * nt) * 512 + 32 * kt; }
    return it; }
__device__ __forceinline__ void issue(const KA& a, int l, int item, int lane, f32x4 (&cv)[4]) { const Item it = decode(a, l, item);
#pragma unroll
    for (int i = 0; i < 4; ++i) cv[i] = *(const GAS f32x4*)(it.src + (size_t)((lane >> 3) + 8 * i) * it.N + (lane & 7) * 4); }
__device__ __forceinline__ void finish(const KA& a, int l, int item, int lane, int slot, LAS unsigned char* lds, const f32x4 (&cv)[4]) { const Item it = decode(a, l, item);
    LAS unsigned char* buf = lds + CBUF + slot * (32 * CPITCH);
#pragma unroll
    for (int i = 0; i < 4; ++i)
#pragma unroll
        for (int u = 0; u < 4; ++u) *(LAS bf16*)(buf + ((lane & 7) * 4 + u) * CPITCH + ((lane >> 3) + 8 * i) * 2) = f2bf1(cv[i][u]);
    LDS_WAIT(); asm volatile("" ::: "memory");
    const int n = lane >> 1, hf = lane & 1; const v4u w0 = *(const LAS v4u*)(buf + n * CPITCH + hf * 32), w1 = *(const LAS v4u*)(buf + n * CPITCH + hf * 32 + 16);
    GAS v4u* d = (GAS v4u*)(it.dst + (size_t)n * it.ld + 16 * hf); d[0] = w0; d[1] = w1;
    LDS_WAIT(); asm volatile("" ::: "memory"); }
}
#ifndef SCAN_STAMP
#define SCAN_STAMP 0
#endif
#define STB(k) do { if (SCAN_STAMP == (k)) t0_ = (unsigned)__builtin_amdgcn_s_memrealtime(); } while (0)
#define STE(k) do { if (SCAN_STAMP == (k)) tacc_ += (unsigned)__builtin_amdgcn_s_memrealtime() - t0_; } while (0)
#ifndef SCAN_PROBE
#define SCAN_PROBE 0
#endif
#define REPK(k) for (int rep_ = 0; rep_ < ((SCAN_PROBE == (k)) ? 2 : 1); ++rep_)
__device__ __forceinline__ void phase_scan(LAS unsigned char* lds, int l) {
    using namespace csc;
    const KA a = ka_get();
    const int tid = opaque_tid(), lane0 = tid & 63, wv = __builtin_amdgcn_readfirstlane(tid >> 6);
    const bf16* PX = (const bf16*)(a.ws() + WS_X2); bf16* YD = (bf16*)(a.ws() + WS_X3); float* BON = (float*)(a.ws() + WS_BONUS);
    const float* mup = a.in(I_MUP) + l * 1760; const float* mun = a.in(I_MUN) + l * 1760;
    const f32x4 Z4 = {0.f, 0.f, 0.f, 0.f}; const v2u Z2 = {0u, 0u};
    unsigned t0_ = 0, tacc_ = 0; (void)t0_;
    for (int chain = blockIdx.x; chain < 256; chain += gridDim.x) {
        const int b = chain >> 4, h = (chain >> 1) & 7, d = chain & 1; const int c0_ = opq(lane0);
        float kkc[2], kac[2], rkc[2], mur[2][2], muk[2][2], muv[2][2], mul[2][2], ropef[2]; bf16x8 w2f[2], a2f[2]; float w0c[2], a0c[2];
        { const int ln = c0_, kl = ln & 15, g = ln >> 4, cp = ln & 31;
#pragma unroll
          for (int u = 0; u < 2; ++u) { const int c = 2 * cp + u; ropef[u] = exp2f(-(float)(c & 15) * (13.287712379549449f / 16.0f));
            kkc[u] = a.in(I_KK)[l * 512 + h * 64 + c]; kac[u] = a.in(I_KA)[l * 512 + h * 64 + c]; rkc[u] = a.in(I_RK)[l * 512 + h * 64 + c];
            const int colr = h * 64 + c, coll = (c < 32) ? (1536 + d * 32 + c) : (1600 + d * 32 + (c - 32));
            mur[u][0] = d ? mun[colr] : mup[colr]; mur[u][1] = d ? mup[colr] : mun[colr]; muk[u][0] = d ? mun[512 + colr] : mup[512 + colr]; muk[u][1] = d ? mup[512 + colr] : mun[512 + colr];
            muv[u][0] = d ? mun[1024 + colr] : mup[1024 + colr]; muv[u][1] = d ? mup[1024 + colr] : mun[1024 + colr]; mul[u][0] = d ? mun[coll] : mup[coll]; mul[u][1] = d ? mup[coll] : mun[coll]; }
#pragma unroll
        for (int i = 0; i < 2; ++i) { const int cc = h * 64 + 16 * ((wv >> 2) * 2 + i) + kl; unsigned t[8], u[8];
#pragma unroll
            for (int j = 0; j < 8; ++j) { t[j] = f2bf(a.in(I_W2)[((size_t)(l * 2 + d) * 32 + 8 * g + j) * 512 + cc]); u[j] = f2bf(a.in(I_A2)[((size_t)(l * 2 + d) * 32 + 8 * g + j) * 512 + cc]); }
            w2f[i] = __builtin_bit_cast(bf16x8, (v4u){t[0] | (t[1] << 16), t[2] | (t[3] << 16), t[4] | (t[5] << 16), t[6] | (t[7] << 16)});
            a2f[i] = __builtin_bit_cast(bf16x8, (v4u){u[0] | (u[1] << 16), u[2] | (u[3] << 16), u[4] | (u[5] << 16), u[6] | (u[7] << 16)});
            w0c[i] = a.in(I_W0)[(l * 2 + d) * 512 + cc]; a0c[i] = a.in(I_A0)[(l * 2 + d) * 512 + cc]; } }
        f32x4 St[4] = {Z4, Z4, Z4, Z4};
        f32x4 cvt_[4] = {Z4, Z4, Z4, Z4}; int cit = blockIdx.x * 8 + wv, cpend = -1; const int cstride = gridDim.x * 8;
#define BGC_WINDOW() do { const int ln_ = opq(lane0); if (cpend >= 0) bgc::finish(a, l, cpend, ln_, wv & 3, lds, cvt_); if (cit < bgc::NITEMS) { bgc::issue(a, l, cit, ln_, cvt_); cpend = cit; cit += cstride; } else cpend = -1; } while (0)
        for (int seq = 0; seq < 2; ++seq) {
            const int T = seq ? SEQ : CTXL, rowbase = seq ? b * SEQ : NTX + b * CTXL, ngrp = T / 64;
            v4u pre[5];
#define CSC_PREFETCH(GRP) do { const int s0_ = (GRP) * 64; const int tlo_ = d ? (T - 64 - s0_) : s0_; \
                _Pragma("unroll") for (int i_ = 0; i_ < 5; ++i_) { const int id_ = opq(tid) + 512 * i_; const int rr_ = id_ >> 5, ch_ = id_ & 31; const int t_ = tlo_ - 1 + rr_; \
                    const int col_ = RWOFF + (ch_ < 24 ? (ch_ >> 3) * 512 + h * 64 + (ch_ & 7) * 8 : (ch_ < 28 ? 1536 + d * 32 + (ch_ - 24) * 8 : 1600 + d * 32 + (ch_ - 28) * 8)); \
                    const bool ok_ = (id_ < 66 * 32) && t_ >= 0 && t_ < T; const int tc_ = ok_ ? t_ : 0; \
                    const v4u v_ = *(const GAS v4u*)(PX + (size_t)(rowbase + tc_) * DINP + col_); pre[i_] = ok_ ? v_ : (v4u){0u, 0u, 0u, 0u}; } } while (0)
            CSC_PREFETCH(0);
            for (int grp = 0; grp < ngrp; ++grp) {
                const int s0 = grp * 64;
                int lane = opq(lane0); int c = lane, kl = lane & 15, g = lane >> 4, q_ = kl >> 2, p_ = kl & 3; (void)q_; (void)p_;
                STB(1);
#pragma unroll
                for (int i = 0; i < 5; ++i) { const int id = opq(tid) + 512 * i; if (id < 66 * 32) *(LAS v4u*)(lds + RAW + id * 16) = pre[i]; }
                __syncthreads();
                STE(1); STB(2);
                int sl = opqs(wv);
                float Rk[4][2], Rq[4][2], Rr[4][2], Rv[4][2];
                REPK(1) { const int cp = lane & 31, sh = lane >> 5, sb = 8 * sl + 4 * sh; const int rbase = d ? 64 - sb : sb + 1, rdir = d ? -256 : 256;
                  const LAS bf16* p0 = (const LAS bf16*)(lds + RAW) + (rbase * 256 + 2 * cp) - rdir;
                  float pr[6][2], pk[6][2], pv[6][2], pl[6][2];
#pragma unroll
                  for (int j = 0; j < 6; ++j) { const LAS unsigned* p = (const LAS unsigned*)(p0 + j * rdir); const unsigned wr = p[0], wk = p[32], wv_ = p[64], wl = p[96];
                      pr[j][0] = bflo(wr); pr[j][1] = bfhi(wr); pk[j][0] = bflo(wk); pk[j][1] = bfhi(wk); pv[j][0] = bflo(wv_); pv[j][1] = bfhi(wv_); pl[j][0] = bflo(wl); pl[j][1] = bfhi(wl); }
                  const int qd = cp >> 3;
#pragma unroll
                  for (int i = 0; i < 4; ++i) { const int sloc = sb + i; float r[2], k[2], zz[2];
#pragma unroll
                      for (int u = 0; u < 2; ++u) { r[u] = pr[i + 1][u] + mur[u][0] * (pr[i][u] - pr[i + 1][u]) + mur[u][1] * (pr[i + 2][u] - pr[i + 1][u]); k[u] = pk[i + 1][u] + muk[u][0] * (pk[i][u] - pk[i + 1][u]) + muk[u][1] * (pk[i + 2][u] - pk[i + 1][u]);
                          Rv[i][u] = pv[i + 1][u] + muv[u][0] * (pv[i][u] - pv[i + 1][u]) + muv[u][1] * (pv[i + 2][u] - pv[i + 1][u]);
                          const float z = pl[i + 1][u] + mul[u][0] * (pl[i][u] - pl[i + 1][u]) + mul[u][1] * (pl[i + 2][u] - pl[i + 1][u]);
                          const float th = 1.0f - 2.0f * __builtin_amdgcn_rcpf(1.0f + __expf(2.0f * z)); zz[u] = cp < 16 ? th : z; }
                      ((LAS unsigned*)(lds + ZL))[sloc * 32 + cp] = pk2(zz[0], zz[1]);
                      if (seq) { const int t = d ? (T - 1 - (s0 + sloc)) : (s0 + sloc); const float pos = (float)((qd < 2) ? (t >> 6) : (t & 63));
#pragma unroll
                          for (int u = 0; u < 2; ++u) { const float rp = dppmov<0x128>(r[u]), kp = dppmov<0x128>(k[u]); const float ang = pos * ropef[u]; const float cs = __cosf(ang), sn = __sinf(ang);
                              const float sg = (qd & 1) ? sn : -sn; r[u] = r[u] * cs + rp * sg; k[u] = k[u] * cs + kp * sg; } }
                      const float k0 = k[0] * kkc[0], k1 = k[1] * kkc[1]; float ss = k0 * k0 + k1 * k1;
                      ss += dppmov<0xB1>(ss); ss += dppmov<0x4E>(ss); ss += dppmov<0x141>(ss); ss += dppmov<0x140>(ss);
                      { const int iv = __builtin_bit_cast(int, ss); const float a0 = __builtin_bit_cast(float, __builtin_amdgcn_readlane(iv, 0)) + __builtin_bit_cast(float, __builtin_amdgcn_readlane(iv, 16)), a1 = __builtin_bit_cast(float, __builtin_amdgcn_readlane(iv, 32)) + __builtin_bit_cast(float, __builtin_amdgcn_readlane(iv, 48)); ss = sh ? a1 : a0; }
                      const float rn = __builtin_amdgcn_rsqf(fmaxf(ss, 1e-24f));
                      Rk[i][0] = k0 * rn; Rk[i][1] = k1 * rn; Rq[i][0] = k[0]; Rq[i][1] = k[1]; Rr[i][0] = r[0]; Rr[i][1] = r[1]; } }
                __syncthreads();
                STE(2); STB(3);
                lane = opq(lane0); c = lane; kl = lane & 15; g = lane >> 4; q_ = kl >> 2; p_ = kl & 3;
                REPK(2) { const int wq = opqs(wv); const int st = wq & 3; const LAS unsigned char* zrow = lds + ZL + (16 * st + kl) * 128;
                  const bf16x8 zw = *(const LAS bf16x8*)(zrow + 16 * g), za = *(const LAS bf16x8*)(zrow + 64 + 16 * g);
#pragma unroll
                  for (int i = 0; i < 2; ++i) { const int cc = 16 * ((wq >> 2) * 2 + i) + kl;
                      const f32x4 uw = __builtin_amdgcn_mfma_f32_16x16x32_bf16(zw, w2f[i], Z4, 0, 0, 0), ua = __builtin_amdgcn_mfma_f32_16x16x32_bf16(za, a2f[i], Z4, 0, 0, 0);
#pragma unroll
                      for (int j = 0; j < 4; ++j) { const int srow = 16 * st + 4 * g + j;
                          ((LAS float*)(lds + LWO))[srow * 64 + cc] = -0.6065306597126334f * __builtin_amdgcn_rcpf(1.0f + __expf(-(uw[j] + w0c[i]))); ((LAS float*)(lds + AAO))[srow * 64 + cc] = __builtin_amdgcn_rcpf(1.0f + __expf(-(ua[j] + a0c[i]))); } } }
                __syncthreads();
                STE(3); STB(4);
                lane = opq(lane0); c = lane; kl = lane & 15; g = lane >> 4; q_ = kl >> 2; p_ = kl & 3;
                sl = opqs(wv);
                REPK(4) { const int cp = lane & 31, sh = lane >> 5, q = sl >> 1, hf = sl & 1; typedef float f32x2_ __attribute__((ext_vector_type(2)));
                  const LAS f32x2_* lwp = (const LAS f32x2_*)((const LAS float*)(lds + LWO) + (16 * q) * 64 + 2 * cp); const LAS f32x2_* aap = (const LAS f32x2_*)((const LAS float*)(lds + AAO) + (8 * sl + 4 * sh) * 64 + 2 * cp);
                  f32x2_ qs[4];
#pragma unroll
                  for (int j = 0; j < 4; ++j) { qs[j] = lwp[(4 * j) * 32] + lwp[(4 * j + 1) * 32] + lwp[(4 * j + 2) * 32] + lwp[(4 * j + 3) * 32]; }
                  const f32x2_ cL = (qs[0] + qs[1]) + (qs[2] + qs[3]); const int part = 2 * hf + sh;
                  f32x2_ run = part == 0 ? (f32x2_){0.f, 0.f} : (part == 1 ? qs[0] : (part == 2 ? qs[0] + qs[1] : qs[0] + qs[1] + qs[2]));
                  const float wl0 = __expf(cL.x), wl1 = __expf(cL.y);
                  if (part == 3) ((LAS f32x2_*)(lds + WLO))[q * 32 + cp] = (f32x2_){wl0, wl1};
#pragma unroll
                  for (int i = 0; i < 4; ++i) { const int sloc = 8 * sl + 4 * sh + i, s = 4 * part + i; const f32x2_ lwi = lwp[s * 32]; const f32x2_ cprev = run; run = run + lwi; const f32x2_ aa = aap[i * 32];
                      const float kd0 = Rq[i][0] * (1.0f + (aa.x - 1.0f) * kac[0]), kd1 = Rq[i][1] * (1.0f + (aa.y - 1.0f) * kac[1]), nb0 = -Rk[i][0] * aa.x, nb1 = -Rk[i][1] * aa.y;
                      float bon = Rr[i][0] * kd0 * rkc[0] + Rr[i][1] * kd1 * rkc[1];
                      bon += dppmov<0xB1>(bon); bon += dppmov<0x4E>(bon); bon += dppmov<0x141>(bon); bon += dppmov<0x140>(bon);
                      { const int iv = __builtin_bit_cast(int, bon); const float a0 = __builtin_bit_cast(float, __builtin_amdgcn_readlane(iv, 0)) + __builtin_bit_cast(float, __builtin_amdgcn_readlane(iv, 16)), a1 = __builtin_bit_cast(float, __builtin_amdgcn_readlane(iv, 32)) + __builtin_bit_cast(float, __builtin_amdgcn_readlane(iv, 48)); bon = sh ? a1 : a0; }
                      if (cp == 0) { const int t = d ? (T - 1 - (s0 + sloc)) : (s0 + sloc); BON[((size_t)d * NTOK + rowbase + t) * 8 + h] = bon; }
                      const float e1x = __expf(cprev.x), e1y = __expf(cprev.y), e2x = __expf(-run.x), e2y = __expf(-run.y), e3x = __builtin_amdgcn_rcpf(e2x), e3y = __builtin_amdgcn_rcpf(e2y);
                      LAS unsigned char* base = lds + ARR + q * (7 * 2048) + sw16(s, cp >> 2) + (cp & 3) * 4;
                      *(LAS unsigned*)(base) = pk2(Rk[i][0] * e1x, Rk[i][1] * e1y); *(LAS unsigned*)(base + 2048) = pk2(nb0 * e2x, nb1 * e2y); *(LAS unsigned*)(base + 4096) = pk2(kd0 * e2x, kd1 * e2y); *(LAS unsigned*)(base + 6144) = pk2(Rr[i][0] * e3x, Rr[i][1] * e3y);
                      *(LAS unsigned*)(base + 12288) = pk2(Rv[i][0], Rv[i][1]); } }
                __syncthreads();
                STE(4); STB(5);
                lane = opq(lane0); c = lane; kl = lane & 15; g = lane >> 4; q_ = kl >> 2; p_ = kl & 3;
                STB(7); if (wv < 4) { BGC_WINDOW(); if (grp + 1 < ngrp) CSC_PREFETCH(grp + 1); } STE(7);
                STB(8); STB(10);
                REPK(5) if (wv >= 4) { __builtin_amdgcn_s_setprio(3); const int q = opqs(wv) - 4; const LAS unsigned char* A0 = lds + ARR + q * (7 * 2048);
                    STB(11);
                    bf16x8 at[2], bt[2], kt[2], rt[2];
#pragma unroll
                    for (int ks = 0; ks < 2; ++ks) { const int o = sw16(kl, ks * 4 + g); at[ks] = *(const LAS bf16x8*)(A0 + o); bt[ks] = *(const LAS bf16x8*)(A0 + 2048 + o); kt[ks] = *(const LAS bf16x8*)(A0 + 4096 + o); rt[ks] = *(const LAS bf16x8*)(A0 + 6144 + o); }
                    f32x4 ABt = Z4, AKt = Z4, RBt = Z4, RKt = Z4;
#pragma unroll
                    for (int ks = 0; ks < 2; ++ks) { ABt = __builtin_amdgcn_mfma_f32_16x16x32_bf16(bt[ks], at[ks], ABt, 0, 0, 0); AKt = __builtin_amdgcn_mfma_f32_16x16x32_bf16(kt[ks], at[ks], AKt, 0, 0, 0);
                        RBt = __builtin_amdgcn_mfma_f32_16x16x32_bf16(bt[ks], rt[ks], RBt, 0, 0, 0); RKt = __builtin_amdgcn_mfma_f32_16x16x32_bf16(kt[ks], rt[ks], RKt, 0, 0, 0); }
#pragma unroll
                    for (int j = 0; j < 4; ++j) { const int jj = 4 * g + j; ABt[j] = jj < kl ? ABt[j] : 0.f; AKt[j] = jj < kl ? AKt[j] : 0.f; RBt[j] = jj <= kl ? RBt[j] : 0.f; RKt[j] = jj <= kl ? RKt[j] : 0.f; }
                    STE(11); STB(12);
                    float Tr[16]; const float ab0 = ABt[0], ab1 = ABt[1], ab2 = ABt[2], ab3 = ABt[3];
                    const int abi[4] = {__builtin_bit_cast(int, ab0), __builtin_bit_cast(int, ab1), __builtin_bit_cast(int, ab2), __builtin_bit_cast(int, ab3)};
#pragma unroll
                    for (int i = 0; i < 16; ++i) Tr[i] = (i == kl) ? 1.f : 0.f;
#pragma unroll
                    for (int j = 14; j >= 0; --j) { float acc = 0.f;
#pragma unroll
                        for (int i = 15; i > j; --i) acc += Tr[i] * __builtin_bit_cast(float, __builtin_amdgcn_readlane(abi[j & 3], i + 16 * (j >> 2)));
                        Tr[j] = (j < kl) ? acc : Tr[j]; }
                    STE(12); STB(13);
                    float tsel[4];
#pragma unroll
                    for (int e = 0; e < 4; ++e) tsel[e] = g == 0 ? Tr[e] : (g == 1 ? Tr[4 + e] : (g == 2 ? Tr[8 + e] : Tr[12 + e]));
                    v2u tf2; tf2.x = pk2(tsel[0], tsel[1]); tf2.y = pk2(tsel[2], tsel[3]);
                    const bf16x8 Tf = mk8(tf2, Z2), RBf = mk8(cvt4(RBt), Z2);
                    f32x4 AhT[4], QhT[4], Ah[4], rin[4]; bf16x8 Alo[4];
#pragma unroll
                    for (int ct = 0; ct < 4; ++ct) { Alo[ct] = mk8(trd(A0 + sw16(4 * g + q_, 2 * ct + (p_ >> 1)) + (p_ & 1) * 8), Z2);
                        const v2u rw = *(const LAS v2u*)(A0 + 6144 + sw16(kl, 2 * ct + (g >> 1)) + (g & 1) * 8);
                        rin[ct] = (f32x4){bflo(rw.x), bfhi(rw.x), bflo(rw.y), bfhi(rw.y)}; }
#pragma unroll
                    for (int ct = 0; ct < 4; ++ct) { AhT[ct] = __builtin_amdgcn_mfma_f32_16x16x32_bf16(Alo[ct], Tf, Z4, 0, 0, 0);
                        Ah[ct] = __builtin_amdgcn_mfma_f32_16x16x32_bf16(Tf, Alo[ct], Z4, 0, 0, 0); }
#pragma unroll
                    for (int ct = 0; ct < 4; ++ct) QhT[ct] = __builtin_amdgcn_mfma_f32_16x16x32_bf16(mk8(cvt4(Ah[ct]), Z2), RBf, rin[ct], 0, 0, 0);
                    STE(13); STB(14);
                    LAS unsigned char* fr = lds + FR + q * 7168 + lane * 16;
                    *(LAS bf16x8*)(fr) = mk8(cvt4(AhT[0]), cvt4(AhT[1])); *(LAS bf16x8*)(fr + 1024) = mk8(cvt4(AhT[2]), cvt4(AhT[3]));
                    *(LAS bf16x8*)(fr + 2048) = mk8(cvt4(QhT[0]), cvt4(QhT[1])); *(LAS bf16x8*)(fr + 3072) = mk8(cvt4(QhT[2]), cvt4(QhT[3]));
                    *(LAS bf16x8*)(fr + 4096) = mk8(cvt4(AKt), Z2); *(LAS bf16x8*)(fr + 5120) = mk8(cvt4(RBt), cvt4(RKt)); *(LAS bf16x8*)(fr + 6144) = Tf;
                    STE(14);
                    __builtin_amdgcn_s_setprio(0);
                }
                STE(8); STE(10);
                __syncthreads();
                STE(5); STB(6);
                lane = opq(lane0); c = lane; kl = lane & 15; g = lane >> 4; q_ = kl >> 2; p_ = kl & 3;
                if (wv >= 4) { BGC_WINDOW(); if (grp + 1 < ngrp) CSC_PREFETCH(grp + 1); }
                if (wv < 4) { __builtin_amdgcn_s_setprio(3); const int vt = opqs(wv);
#pragma unroll 1
                    for (int q = 0; q < 4; ++q) { const LAS unsigned char* A0 = lds + ARR + q * (7 * 2048); const LAS unsigned char* fr = lds + FR + q * 7168 + lane * 16;
                        const bf16x8 Ap0 = *(const LAS bf16x8*)(fr), Ap1 = *(const LAS bf16x8*)(fr + 1024), Qp0 = *(const LAS bf16x8*)(fr + 2048), Qp1 = *(const LAS bf16x8*)(fr + 3072);
                        const bf16x8 AKf = *(const LAS bf16x8*)(fr + 4096), RBRK = *(const LAS bf16x8*)(fr + 5120), Tf = *(const LAS bf16x8*)(fr + 6144);
                        const v2u vtr = trd(A0 + 12288 + sw16(4 * g + q_, 2 * vt + (p_ >> 1)) + (p_ & 1) * 8);
                        bf16x8 bk[4]; f32x4 wl[4];
#pragma unroll
                        for (int ct = 0; ct < 4; ++ct) { wl[ct] = *(const LAS f32x4*)(lds + WLO + (q * 64 + 16 * ct + 4 * g) * 4); const int o = sw16(4 * g + q_, 2 * ct + (p_ >> 1)) + (p_ & 1) * 8; bk[ct] = mk8(trd(A0 + 2048 + o), trd(A0 + 4096 + o)); }
                        const f32x4 X1 = __builtin_amdgcn_mfma_f32_16x16x32_bf16(AKf, mk8(vtr, Z2), Z4, 0, 0, 0);
                        const f32x4 Uh = __builtin_amdgcn_mfma_f32_16x16x32_bf16(Tf, mk8(cvt4(X1), Z2), Z4, 0, 0, 0);
                        const f32x4 Yh = __builtin_amdgcn_mfma_f32_16x16x32_bf16(RBRK, mk8(cvt4(Uh), vtr), Z4, 0, 0, 0);
                        const bf16x8 bs0 = mk8(cvt4(St[0]), cvt4(St[1])), bs1 = mk8(cvt4(St[2]), cvt4(St[3]));
                        f32x4 U = __builtin_amdgcn_mfma_f32_16x16x32_bf16(Ap0, bs0, Uh, 0, 0, 0); U = __builtin_amdgcn_mfma_f32_16x16x32_bf16(Ap1, bs1, U, 0, 0, 0);
                        f32x4 Y = __builtin_amdgcn_mfma_f32_16x16x32_bf16(Qp0, bs0, Yh, 0, 0, 0); Y = __builtin_amdgcn_mfma_f32_16x16x32_bf16(Qp1, bs1, Y, 0, 0, 0);
                        const bf16x8 UV = mk8(cvt4(U), vtr);
#pragma unroll
                        for (int ct = 0; ct < 4; ++ct) St[ct] = __builtin_amdgcn_mfma_f32_16x16x32_bf16(bk[ct], UV, St[ct], 0, 0, 0) * wl[ct];
#pragma unroll
                        for (int jj = 0; jj < 2; ++jj) {
                            const float pe = dppmov<0xB1>(Y[jj]), po = dppmov<0xB1>(Y[2 + jj]); const bool odd = (kl & 1) != 0;
                            const unsigned w = odd ? pk2(po, Y[2 + jj]) : pk2(Y[jj], pe);
                            const int sg = s0 + 16 * q + 4 * g + jj + (odd ? 2 : 0); const int t = d ? (T - 1 - sg) : sg;
                            *(GAS unsigned*)(YD + ((size_t)d * NTOK + rowbase + t) * 512 + h * 64 + 16 * vt + (kl & ~1)) = w; }
                    }
                    __builtin_amdgcn_s_setprio(0);
                }
                __syncthreads();
                STE(6);
            }
#undef CSC_PREFETCH
        }
        if (cpend >= 0) { bgc::finish(a, l, cpend, opq(lane0), wv & 3, lds, cvt_); cpend = -1; }
        for (; cit < bgc::NITEMS; cit += cstride) { bgc::issue(a, l, cit, opq(lane0), cvt_); bgc::finish(a, l, cit, opq(lane0), wv & 3, lds, cvt_); }
#undef BGC_WINDOW
    }
    if (SCAN_STAMP != 0 && blockIdx.x == 0 && tid == ((SCAN_STAMP == 8 || (SCAN_STAMP >= 11 && SCAN_STAMP <= 14)) ? 256 : ((SCAN_STAMP == 10) ? 448 : 0))) atomicAdd((unsigned*)(a.ws() + WS_CTL) + 2000, tacc_);
}
constexpr int PH_PER_LAYER = 11, N_PHASES = 1 + 2 * PH_PER_LAYER;
template <int K> __device__ __forceinline__ void run_phase(LAS unsigned char* lds, int l) {
    if constexpr (K == 0) phase_prologue(lds);
    if constexpr (K == 1) phase_modconv(lds, l);
    if constexpr (K == 3) phase_scan(lds, l);
    if constexpr (K == 4) phase_attn(lds, l);
    if constexpr (K == 5) phase_rwpost(lds, l);
    if constexpr (K == 7) { if (l == 0) phase_ln1_route<false>(lds, l); else phase_ln1_route<true>(lds, l); }
    if constexpr (K == 8) phase_gather(lds, l);
    if constexpr (K == 11) phase_ln2(lds, l);
    if constexpr (K == 2 || K == 6 || K == 9 || K == 10) {
        const KA a = ka_get(); unsigned char* ws = a.ws(); const int G = gridDim.x, bid = blockIdx.x;
        bf16* X1 = (bf16*)(ws + WS_X1); bf16* X2 = (bf16*)(ws + WS_X2); bf16* X3 = (bf16*)(ws + WS_X3);
        if constexpr (K == 2) { __syncthreads();
            pg8::Gemm g{X1, (const bf16*)(ws + WS_WINT) + (size_t)l * DINP * DM, NTOK, DINP, DM}; pg8::StaticOrder S; S.init(NTOK, DINP, G, bid);
            pg8::EpiBf16 E{X2, DINP}; pg8::gemm_phase<pg8::EpiBf16, pg8::StaticOrder, true, true>(lds, g, S, E); }
        if constexpr (K == 6) { __syncthreads();
            const int Mrows = (l == 0) ? NTOK : NTX;
            pg8::Gemm g{X1, (const bf16*)(ws + WS_WOT) + (size_t)l * DM * DM, Mrows, DM, DM}; pg8::StaticOrder S; S.init(Mrows, DM, G, bid);
            pg8::EpiBf16 E{X3, DM}; pg8::gemm_phase<pg8::EpiBf16, pg8::StaticOrder, true, true>(lds, g, S, E); }
        if constexpr (K == 9) { moe_tables<false>(lds, l);
            pg8::Gemm g{X2, (const bf16*)(ws + WS_W13T), MAXSLOT, 1024, DM}; pg8::MoeOrder S; S.init((const LAS int*)(lds + PREF_OFF), 4, G, bid);
            pg8::EpiSwiGLU E{X3, DEXP}; pg8::gemm_phase<pg8::EpiSwiGLU, pg8::MoeOrder, true, true>(lds, g, S, E); }
        if constexpr (K == 10) { moe_tables<false>(lds, l);
            pg8::Gemm g{X3, (const bf16*)(ws + WS_W2T), MAXSLOT, 1024, DEXP}; pg8::MoeOrder S; S.init((const LAS int*)(lds + PREF_OFF), 4, G, bid);
            pg8::EpiBf16 E{X2, DM}; pg8::gemm_phase<pg8::EpiBf16, pg8::MoeOrder, true, true>(lds, g, S, E); }
    }
}
__device__ __forceinline__ void grid_sync(LAS unsigned char* lds) {
    const KA a = ka_get(); XcdBarrier b; b.bar = (unsigned*)(a.ws() + WS_CTL) + CW_BAR; b.x = xb_xcc_id(); b.st = (volatile LAS unsigned*)(lds + MISC_OFF) + 8; xcd_barrier(b);
#ifdef PROBE_BAR
    xcd_barrier(b);
#endif
}
#ifndef ONE_LAUNCH
template <int K> __global__ void __launch_bounds__(512, 2) fwd_ph(Args args) {
    extern __shared__ __attribute__((aligned(16))) unsigned char lds_raw[];
    LAS unsigned char* lds = (LAS unsigned char*)lds_raw;
    for (int u = threadIdx.x; u < (LDS_BYTES - LDSCTL_OFF) / 4; u += 512) ((LAS unsigned*)(lds + LDSCTL_OFF))[u] = 0u;
    __syncthreads();
    hw_tid_init();
    __syncthreads();
    run_phase<K>(lds, args.ph_lo);
}
template <int K> static void launch_ph(const Args& a, int grid, hipStream_t stream) {
    static bool attr = false;
    if (!attr) { (void)hipFuncSetAttribute((const void*)fwd_ph<K>, hipFuncAttributeMaxDynamicSharedMemorySize, LDS_BYTES); attr = true; }
    hipLaunchKernelGGL(fwd_ph<K>, dim3(grid), dim3(512), LDS_BYTES, stream, a);
}
#else
__global__ void __launch_bounds__(512, 2) fwd(Args args) {
    extern __shared__ __attribute__((aligned(16))) unsigned char lds_raw[];
    LAS unsigned char* lds = (LAS unsigned char*)lds_raw;
    for (int u = threadIdx.x; u < (LDS_BYTES - LDSCTL_OFF) / 4; u += 512) ((LAS unsigned*)(lds + LDSCTL_OFF))[u] = 0u;
    __syncthreads();
    hw_tid_init();
    __syncthreads();
    (void)xcd_barrier_post((unsigned*)(args.ws + WS_CTL) + CW_BAR, (volatile LAS unsigned*)(lds + MISC_OFF) + 8);
    run_phase<0>(lds, 0);
#ifdef PROBE_P0
    __syncthreads(); run_phase<0>(lds, 0);
#endif
    grid_sync(lds);
#ifndef PROBE_REP
#define PROBE_REP -1
#endif
#define RUNP(K) do { run_phase<K>(lds, l); if (PROBE_REP == K) { __syncthreads(); run_phase<K>(lds, l); } } while (0)
    for (int l = 0; l < 2; ++l) {
        if (l == 0) { RUNP(1); grid_sync(lds); }
        RUNP(2); grid_sync(lds);
        RUNP(3);
        RUNP(4); grid_sync(lds);
        RUNP(5); grid_sync(lds);
        RUNP(6); grid_sync(lds);
        run_phase<7>(lds, l); if (PROBE_REP == 7 && l == 0) { __syncthreads(); run_phase<7>(lds, l); } grid_sync(lds);
        RUNP(8); grid_sync(lds);
        RUNP(9); grid_sync(lds);
        RUNP(10); grid_sync(lds);
        RUNP(11); if (l == 0) grid_sync(lds);
    }
#if defined(SCAN_STAMP) && SCAN_STAMP != 0
    if (blockIdx.x == 0 && hw_tid() == 0) { const unsigned long long tk = __hip_atomic_load((unsigned*)(args.ws + WS_CTL) + 2000, __ATOMIC_RELAXED, __HIP_MEMORY_SCOPE_AGENT); const unsigned long long ts = __builtin_amdgcn_s_memrealtime(); while (__builtin_amdgcn_s_memrealtime() - ts < tk) __builtin_amdgcn_s_sleep(8); }
#endif
}
#endif

extern "C" void kernel_launch(void* const* d_in, const int* in_sizes, int n_in, void* d_out, int out_size, void* d_ws, size_t ws_size, hipStream_t stream) {
    static int grid = 0;
    if (grid == 0) {
        if (n_in != 30 || in_sizes[0] != NTX * DM || out_size != NTX * DM || ws_size < WS_END) {
            fprintf(stderr, "kernel_launch: unexpected problem (n_in %d, in0 %d, out %d, ws %zu < %zu?); nothing launched\n", n_in, n_in > 0 ? in_sizes[0] : -1, out_size, ws_size, (size_t)WS_END); grid = -1; return; }
        int dev = 0, cus = 0;
        if (hipGetDevice(&dev) != hipSuccess || hipDeviceGetAttribute(&cus, hipDeviceAttributeMultiprocessorCount, dev) != hipSuccess) { grid = -1; return; }
#ifdef ONE_LAUNCH
        if (hipFuncSetAttribute((const void*)fwd, hipFuncAttributeMaxDynamicSharedMemorySize, LDS_BYTES) != hipSuccess) { fprintf(stderr, "kernel_launch: hipFuncSetAttribute failed\n"); grid = -1; return; }
#endif
        (void)hipGetLastError();
        grid = cus > 0 ? cus : 256;
        if (grid != 256 && grid != 128) { fprintf(stderr, "kernel_launch: %d CUs: the LN1/LN2 row maps need 128 or 256 workgroups\n", grid); grid = -1; return; }
    }
    if (grid < 0) return;
    if (hipMemsetAsync((char*)d_ws + WS_CTL, 0, CTL_ZERO_BYTES, stream) != hipSuccess) return;
    Args a{};
    for (int i = 0; i < 30; ++i) a.in[i] = (const float*)d_in[i];
    a.out = (float*)d_out; a.ws = (unsigned char*)d_ws; a.ph_lo = 0; a.ph_hi = 0;
#ifndef ONE_LAUNCH
    launch_ph<0>(a, grid, stream);
    for (int l = 0; l < 2; ++l) { a.ph_lo = l;
        launch_ph<1>(a, grid, stream); launch_ph<2>(a, grid, stream); launch_ph<3>(a, grid, stream); launch_ph<4>(a, grid, stream); launch_ph<5>(a, grid, stream); launch_ph<6>(a, grid, stream);
        launch_ph<7>(a, grid, stream); launch_ph<8>(a, grid, stream); launch_ph<9>(a, grid, stream); launch_ph<10>(a, grid, stream); launch_ph<11>(a, grid, stream); }
#else
    hipLaunchKernelGGL(fwd, dim3(grid), dim3(512), LDS_BYTES, stream, a);
#endif
}
```

```cpp
#define ONE_LAUNCH 1
#include <hip/hip_runtime.h>
#include <cstdio>
#include <cstdint>

constexpr int DM = 1024, NB = 16, SEQ = 2048, CTXL = 256, NTX = NB * SEQ, NTC = NB * CTXL, NTOK = NTX + NTC;
constexpr int DIN = 3296, DINP = 3328, RWOFF = 1536, NHEAD = 8, HD = 64;
constexpr int NEXP = 32, DEXP = 512, LISTCAP = 2 * NTOK;
constexpr int MAXSLOT = 81920;
constexpr float ALPHA = 1.41421356237309515f, LN_EPS = 1e-6f, GN_EPS = 64e-5f;

constexpr size_t MiB = 1u << 20;
constexpr size_t WS_CTL = 0, CTL_ZERO_BYTES = 1 * MiB;
constexpr size_t WS_MODS = 1 * MiB;
constexpr size_t WS_ROPE = 2 * MiB;
constexpr size_t WS_WINT = 3 * MiB;
constexpr size_t WS_WOT = 16 * MiB;
constexpr size_t WS_W13T = 20 * MiB;
constexpr size_t WS_W2T = 84 * MiB;
constexpr size_t WS_LIST = 116 * MiB;
constexpr size_t WS_TBL = 124 * MiB;
constexpr size_t WS_ZROW = WS_TBL + 64 * 1024;
constexpr size_t WS_ROWOFF = WS_TBL + 256 * 1024;
constexpr size_t WS_TOK = 125 * MiB;
constexpr size_t WS_BONUS = 127 * MiB;
constexpr size_t WS_CS = 130 * MiB;
constexpr size_t WS_X1 = 146 * MiB;
constexpr size_t WS_X2 = 218 * MiB;
constexpr size_t WS_XP = WS_X2 + 160 * MiB;
constexpr size_t WS_X3 = 452 * MiB;
constexpr size_t WS_END = 596 * MiB;
static_assert(WS_WINT + (size_t)2 * DINP * DM * 2 <= WS_WOT && WS_LIST + (size_t)NEXP * LISTCAP * 4 <= WS_TOK && WS_TOK + (size_t)NTOK * 32 <= WS_BONUS, "ws map");
static_assert(WS_BONUS + (size_t)2 * NTOK * 8 * 4 <= WS_CS && WS_X2 + (size_t)NTOK * DINP * 2 <= WS_X3 && WS_X3 + (size_t)2 * NTOK * 512 * 4 <= WS_END, "ws map");
static_assert((size_t)MAXSLOT * 1024 * 2 <= WS_XP - WS_X2 && WS_XP + (size_t)NTOK * DM * 2 <= WS_X3 && (size_t)MAXSLOT * 512 * 2 <= WS_END - WS_X3, "ws map");
constexpr int CW_BAR = 4096;
constexpr int CW_CNT = 8192;
constexpr int RING_BYTES = 131072, LDS_BYTES = 163840, LDSCTL_OFF = LDS_BYTES - 12288, MISC_OFF = LDSCTL_OFF + 320;
constexpr int PREF_OFF = LDSCTL_OFF + 512;

#define GAS __attribute__((address_space(1)))
#define LAS __attribute__((address_space(3)))
typedef unsigned short bf16;
typedef unsigned v4u __attribute__((ext_vector_type(4)));
typedef unsigned v2u __attribute__((ext_vector_type(2)));
typedef float f32x4 __attribute__((ext_vector_type(4)));
typedef short bf16x8 __attribute__((ext_vector_type(8)));
typedef GAS unsigned gu32;
#define RLX_AGENT __ATOMIC_RELAXED, __HIP_MEMORY_SCOPE_AGENT
#define LDS_WAIT() asm volatile("s_waitcnt lgkmcnt(0)" ::: "memory")
#define VM_WAIT() asm volatile("s_waitcnt vmcnt(0)" ::: "memory")
__device__ __forceinline__ unsigned f2bf(float f) { unsigned u = __builtin_bit_cast(unsigned, f); return (u + 0x7fffu + ((u >> 16) & 1u)) >> 16; }
typedef float f32x2_t_ __attribute__((ext_vector_type(2))); typedef __bf16 bf16x2_t_ __attribute__((ext_vector_type(2)));
__device__ __forceinline__ unsigned pk2(float lo, float hi) { f32x2_t_ v = {lo, hi}; bf16x2_t_ b = __builtin_convertvector(v, bf16x2_t_); return __builtin_bit_cast(unsigned, b); }
__device__ __forceinline__ unsigned short f2bf1(float f) { return (unsigned short)(pk2(f, 0.f) & 0xffffu); }
__device__ __forceinline__ float bf2f(unsigned short v) { return __builtin_bit_cast(float, (unsigned)v << 16); }
__device__ __forceinline__ float bflo(unsigned w) { return __builtin_bit_cast(float, w << 16); }
__device__ __forceinline__ float bfhi(unsigned w) { return __builtin_bit_cast(float, w & 0xffff0000u); }
__device__ __forceinline__ float sigmoidf_(float x) { return 1.0f / (1.0f + expf(-x)); }
__device__ __forceinline__ float shx(float v, int k, int lane) { return __builtin_bit_cast(float, __builtin_amdgcn_ds_bpermute((lane ^ k) << 2, __builtin_bit_cast(int, v))); }
__device__ __forceinline__ float shi(float v, int src) { return __builtin_bit_cast(float, __builtin_amdgcn_ds_bpermute(src << 2, __builtin_bit_cast(int, v))); }
template <int CTRL> __device__ __forceinline__ float dppmov(float v) { return __builtin_bit_cast(float, __builtin_amdgcn_update_dpp(0, __builtin_bit_cast(int, v), CTRL, 0xF, 0xF, true)); }
__device__ __forceinline__ float wave_sum(float v) {
    v += dppmov<0xB1>(v); v += dppmov<0x4E>(v); v += dppmov<0x141>(v); v += dppmov<0x140>(v);
    const int iv = __builtin_bit_cast(int, v);
    return (__builtin_bit_cast(float, __builtin_amdgcn_readlane(iv, 0)) + __builtin_bit_cast(float, __builtin_amdgcn_readlane(iv, 16))) + (__builtin_bit_cast(float, __builtin_amdgcn_readlane(iv, 32)) + __builtin_bit_cast(float, __builtin_amdgcn_readlane(iv, 48)));
}
__device__ __forceinline__ float fmx(float a, float b) { float r; asm("v_max_f32 %0, %1, %2" : "=v"(r) : "v"(a), "v"(b)); return r; }
__device__ __forceinline__ float xmax16(float v) { float a = v, b = v; asm("s_nop 1\n\tv_permlane16_swap_b32 %0, %1" : "+v"(a), "+v"(b)); return fmx(a, b); }
__device__ __forceinline__ float xmax32(float v) { float a = v, b = v; asm("s_nop 1\n\tv_permlane32_swap_b32 %0, %1" : "+v"(a), "+v"(b)); return fmx(a, b); }
__device__ __forceinline__ float xsum16(float v) { float a = v, b = v; asm("s_nop 1\n\tv_permlane16_swap_b32 %0, %1" : "+v"(a), "+v"(b)); return a + b; }
__device__ __forceinline__ float xsum32(float v) { float a = v, b = v; asm("s_nop 1\n\tv_permlane32_swap_b32 %0, %1" : "+v"(a), "+v"(b)); return a + b; }
__device__ __forceinline__ float red8(float v) { v += dppmov<0xB1>(v); v += dppmov<0x4E>(v); v += dppmov<0x141>(v); return v; }

struct TokInfo { int e0, e1, p0, p1; float g0, g1; int pad0, pad1; };

constexpr int WID_OFF = LDSCTL_OFF + 1536;
__device__ __forceinline__ int hw_slot() { return (int)__builtin_amdgcn_s_getreg((5 << 11) | 4) & 63; }
__device__ __forceinline__ int lane_id() { int l; asm volatile("v_mbcnt_lo_u32_b32 %0, -1, 0\n\tv_mbcnt_hi_u32_b32 %0, -1, %0" : "=v"(l)); return l; }
__device__ __forceinline__ void hw_tid_init() { *(volatile LAS int*)(uintptr_t)(WID_OFF + 4 * hw_slot()) = (int)(threadIdx.x >> 6); }
__device__ __forceinline__ int hw_tid() { const int w = *(volatile LAS int*)(uintptr_t)(WID_OFF + 4 * hw_slot()); int t = (__builtin_amdgcn_readfirstlane(w) << 6) | lane_id(); asm volatile("" : "+v"(t)); return t; }
namespace pg8 {
#define PG8_LAS __attribute__((address_space(3)))
typedef unsigned short bf16_t;
typedef short bf16x8 __attribute__((ext_vector_type(8)));
typedef float f32x4 __attribute__((ext_vector_type(4)));
typedef unsigned u32x4 __attribute__((ext_vector_type(4)));
constexpr int BM = 256, BK = 64, HALF = 128, HTB = HALF * BK * 2  , STAGE_BYTES = 8 * HTB, NXCD = 8, WGM = 8;

__host__ __device__ __forceinline__ int lds_byte(int r, int c) { const int st = (r >> 4) * 2 + (c >> 5), rr = r & 15, cc = c & 31, ob = rr * 64 + cc * 2; return st * 1024 + (ob ^ (((ob >> 9) & 1) << 5)); }
__host__ __device__ __forceinline__ void stage_rc(int b, int& R, int& C) { const int st = b / 1024, sb = b % 1024, swz = sb ^ (((sb >> 9) & 1) << 5); R = (st >> 1) * 16 + swz / 64; C = (st & 1) * 32 + (swz % 64) / 2; }
__host__ __device__ __forceinline__ int perm32(int rho) { const int n = rho >> 4, i = rho & 15; return 8 * (i >> 2) + 4 * n + (i & 3); }

struct Unit { int pm, pn, pnb; };
struct Gemm { const bf16_t* A; const bf16_t* Bt; int M, N, K; };

struct StaticOrder {
    int nM, nN, nwg, G, c;
    __host__ __device__ void init(int M, int N, int G_, int c_) { nM = M / BM; nN = N / BM; nwg = nM * nN; G = G_; c = c_; }
    __host__ __device__ bool next(int i, Unit& u) const {
        const long L = (long)i * G + c; if (L >= nwg) return false;
        int wgid = (int)L; { const int q = nwg / NXCD, r = nwg % NXCD, xcd = wgid % NXCD, off = wgid / NXCD; wgid = (xcd < r ? xcd * (q + 1) : r * (q + 1) + (xcd - r) * q) + off; }
        const int nig = WGM * nN, gid = wgid / nig, fm = gid * WGM, gsz = (nM - fm) < WGM ? (nM - fm) : WGM;
        u.pm = fm + ((wgid % nig) % gsz); u.pn = (wgid % nig) / gsz; u.pnb = u.pn; return true;
    }
    __device__ __forceinline__ void a_ready(const Unit&) const {}
    __device__ __forceinline__ void done(const Unit&) const {}
};

__device__ __forceinline__ unsigned cvt_pk_bf16(float lo, float hi) { unsigned r; asm volatile("v_cvt_pk_bf16_f32 %0, %1, %2" : "=v"(r) : "v"(lo), "v"(hi)); return r; }
template <class Epi, class Sched, bool ALIGN_EPI = false, bool SP2 = false, bool GATHER = false>
__device__ __forceinline__ void gemm_phase(PG8_LAS unsigned char* lds, const Gemm g, const Sched& S, const Epi& E, const PG8_LAS unsigned* rowl = nullptr) {
    static_assert(!GATHER || SP2, "GATHER is wired into the SP2 loop only");
    const int tid = hw_tid(), wid = __builtin_amdgcn_readfirstlane(tid >> 6), lane = tid & 63, wr = wid >> 2, wc = wid & 3, fr = lane & 15, fq = lane >> 4;
    const int K = g.K, nt = K / BK;
    unsigned voffA[2], voffB[2];
#pragma unroll
    for (int i = 0; i < 2; ++i) { int R, C; stage_rc(tid * 16 + i * 8192, R, C); const int Rb = Epi::PERM ? ((R & ~31) + perm32(R & 31)) : R;
        voffA[i] = (unsigned)(R * K + C) * 2u; voffB[i] = (unsigned)(Rb * K + C) * 2u; }
    unsigned voG[2][2] = {{0u, 0u}, {0u, 0u}}, voN[2][2] = {{0u, 0u}, {0u, 0u}};
#define PG8_ROWS(u, vo) do { _Pragma("unroll") for (int h_ = 0; h_ < 2; ++h_) _Pragma("unroll") for (int i_ = 0; i_ < 2; ++i_) { int R_, C_; stage_rc(tid * 16 + i_ * 8192, R_, C_); vo[h_][i_] = rowl[(u) * 256 + h_ * HALF + R_] + (unsigned)(C_ * 2); } } while (0)
    const size_t kstep = (size_t)(BK * 2);
    const size_t hstep = (size_t)HALF * K * 2;
    const size_t tstep = 2 * hstep;
    const unsigned ldsw = (unsigned)wid * 1024u;
    const int aoff = lds_byte(wr * 64 + fr, fq * 8), boff = lds_byte(wc * 32 + fr, fq * 8);
#define PG8_SA(b, h) (((b) * 2 + (h)) * HTB)
#define PG8_SB(b, h) ((4 + (b) * 2 + (h)) * HTB)
#define PG8_STAGE(bufoff, gbase, voff) do { _Pragma("unroll") for (int _i = 0; _i < 2; ++_i) \
        __builtin_amdgcn_global_load_lds((const unsigned*)((const char*)(gbase) + (voff)[_i]), (PG8_LAS unsigned*)(lds + (bufoff) + ldsw + _i * 8192), 16, 0, 0); } while (0)
#define PG8_STAGE_G(bufoff, gbase, va, vb, sel) do { _Pragma("unroll") for (int _i = 0; _i < 2; ++_i) \
        __builtin_amdgcn_global_load_lds((const unsigned*)((const char*)(gbase) + ((sel) ? (vb)[_i] : (va)[_i])), (PG8_LAS unsigned*)(lds + (bufoff) + ldsw + _i * 8192), 16, 0, 0); } while (0)
#define PG8_STAGE_A(bufoff, base, h, NEXT) do { if constexpr (GATHER) PG8_STAGE_G(bufoff, base, voG[h], voN[h], NEXT); else PG8_STAGE(bufoff, (base) + (h) * hstep, voffA); } while (0)
#define PG8_LDA(dst, b, h) do { _Pragma("unroll") for (int m = 0; m < 4; ++m) _Pragma("unroll") for (int k = 0; k < 2; ++k) dst[m][k] = *(const PG8_LAS bf16x8*)(lds + PG8_SA(b, h) + aoff + m * 2048 + k * 1024); } while (0)
#define PG8_LDB(dst, b, h) do { _Pragma("unroll") for (int n = 0; n < 2; ++n) _Pragma("unroll") for (int k = 0; k < 2; ++k) dst[n][k] = *(const PG8_LAS bf16x8*)(lds + PG8_SB(b, h) + boff + n * 2048 + k * 1024); } while (0)
#define PG8_MMA(ai, bj, At, Bt) do { __builtin_amdgcn_s_setprio(1); _Pragma("unroll") for (int m = 0; m < 4; ++m) _Pragma("unroll") for (int n = 0; n < 2; ++n) _Pragma("unroll") for (int k = 0; k < 2; ++k) \
        acc[ai][bj][m][n] = __builtin_amdgcn_mfma_f32_16x16x32_bf16(Bt[n][k], At[m][k], acc[ai][bj][m][n], 0, 0, 0); __builtin_amdgcn_s_setprio(0); } while (0)
#define PG8_WAIT_V(n) asm volatile("s_waitcnt vmcnt(" #n ")" ::: "memory")
#define PG8_WAIT_L(n) asm volatile("s_waitcnt lgkmcnt(" #n ")" ::: "memory")
#define PG8_BAR __builtin_amdgcn_s_barrier()
#define PG8_SCHED __builtin_amdgcn_sched_barrier(0)
    Unit cur, nxt; int ui = 0;
    if (!S.next(0, cur)) return;
    f32x4 acc[2][2][4][2];
#pragma unroll
    for (int a = 0; a < 2; ++a)
#pragma unroll
        for (int b = 0; b < 2; ++b)
#pragma unroll
            for (int m = 0; m < 4; ++m)
#pragma unroll
                for (int n = 0; n < 2; ++n) acc[a][b][m][n] = (f32x4){0.f, 0.f, 0.f, 0.f};
    bf16x8 At[4][2], B0[2][2], B1[2][2];
    const char* cA = (const char*)g.A + (GATHER ? (size_t)0 : (size_t)cur.pm * tstep); const char* cB = (const char*)g.Bt + (size_t)cur.pnb * tstep;
    if constexpr (GATHER) PG8_ROWS(0, voG);
    S.a_ready(cur);
    if constexpr (SP2) {
        PG8_STAGE(PG8_SB(0, 0), cB, voffB); PG8_STAGE(PG8_SB(0, 1), cB + hstep, voffB); PG8_STAGE_A(PG8_SA(0, 0), cA, 0, false); PG8_STAGE_A(PG8_SA(0, 1), cA, 1, false);
        if (wr == 1) PG8_BAR;
        PG8_WAIT_V(2); PG8_BAR;
        PG8_STAGE(PG8_SB(1, 0), cB + kstep, voffB); PG8_STAGE_A(PG8_SA(1, 0), cA + kstep, 0, false); PG8_STAGE(PG8_SB(1, 1), cB + hstep + kstep, voffB);
        PG8_WAIT_V(6); PG8_BAR;
    } else {
        PG8_STAGE(PG8_SB(0, 0), cB, voffB); PG8_STAGE(PG8_SA(0, 0), cA, voffA); PG8_STAGE(PG8_SB(0, 1), cB + hstep, voffB); PG8_STAGE(PG8_SA(0, 1), cA + hstep, voffA);
        if (wr == 1) PG8_BAR;
        PG8_WAIT_V(4); PG8_BAR;
        PG8_STAGE(PG8_SB(1, 0), cB + kstep, voffB); PG8_STAGE(PG8_SA(1, 0), cA + kstep, voffA); PG8_STAGE(PG8_SB(1, 1), cB + hstep + kstep, voffB);
        PG8_WAIT_V(6); PG8_BAR;
    }
    for (;;) {
        const bool has_next = S.next(ui + 1, nxt);
        const char* nA = (has_next && !GATHER) ? (const char*)g.A + (size_t)nxt.pm * tstep : cA; const char* nB = has_next ? (const char*)g.Bt + (size_t)nxt.pnb * tstep : cB;
        if constexpr (GATHER) { if (has_next) PG8_ROWS(ui + 1, voN); }
        for (int t = 0; t < nt; t += 2) {
            const bool last = (t == nt - 2);
            const char* a1 = cA + (size_t)(t + 1) * kstep;
            const char* a2 = last ? nA : cA + (size_t)(t + 2) * kstep; const char* b2 = last ? nB : cB + (size_t)(t + 2) * kstep;
            const char* a3 = a2 + kstep; const char* b3 = b2 + kstep;
            if (last && has_next) S.a_ready(nxt);
            if constexpr (SP2) {
            const bool nx_ = last && has_next;
            PG8_LDB(B0, 0, 0); PG8_LDB(B1, 0, 1); PG8_SCHED; PG8_LDA(At, 0, 0); PG8_STAGE_A(PG8_SA(1, 1), a1, 1, false);
            PG8_WAIT_V(8); PG8_WAIT_L(0); PG8_BAR; PG8_MMA(0, 0, At, B0); PG8_MMA(0, 1, At, B1); PG8_BAR; PG8_SCHED;
            PG8_LDA(At, 0, 1); PG8_STAGE(PG8_SB(0, 0), b2, voffB); PG8_STAGE(PG8_SB(0, 1), b2 + hstep, voffB); PG8_STAGE_A(PG8_SA(0, 0), a2, 0, nx_);
            PG8_WAIT_V(8); PG8_WAIT_L(0); PG8_BAR; PG8_MMA(1, 0, At, B0); PG8_MMA(1, 1, At, B1); PG8_BAR; PG8_SCHED;
            PG8_LDB(B0, 1, 0); PG8_LDB(B1, 1, 1); PG8_SCHED; PG8_LDA(At, 1, 0); PG8_STAGE_A(PG8_SA(0, 1), a2, 1, nx_);
            PG8_WAIT_V(8); PG8_WAIT_L(0); PG8_BAR; PG8_MMA(0, 0, At, B0); PG8_MMA(0, 1, At, B1); PG8_BAR; PG8_SCHED;
            PG8_LDA(At, 1, 1); PG8_STAGE(PG8_SB(1, 0), b3, voffB); PG8_STAGE(PG8_SB(1, 1), b3 + hstep, voffB); PG8_STAGE_A(PG8_SA(1, 0), a3, 0, nx_);
            PG8_WAIT_V(8); PG8_WAIT_L(0); PG8_BAR; PG8_MMA(1, 0, At, B0); PG8_MMA(1, 1, At, B1); PG8_BAR; PG8_SCHED;
            } else {
            PG8_LDB(B0, 0, 0); PG8_SCHED; PG8_LDA(At, 0, 0); PG8_STAGE(PG8_SA(1, 1), a1 + hstep, voffA);
            PG8_WAIT_L(8); PG8_BAR; PG8_WAIT_L(0); PG8_MMA(0, 0, At, B0); PG8_BAR; PG8_SCHED;
            PG8_LDB(B1, 0, 1); PG8_STAGE(PG8_SB(0, 0), b2, voffB);
            PG8_BAR; PG8_WAIT_L(0); PG8_MMA(0, 1, At, B1); PG8_BAR;
            PG8_LDA(At, 0, 1); PG8_STAGE(PG8_SA(0, 0), a2, voffA);
            PG8_BAR; PG8_WAIT_L(0); PG8_MMA(1, 0, At, B0); PG8_BAR; PG8_SCHED;
            PG8_STAGE(PG8_SB(0, 1), b2 + hstep, voffB);
            PG8_WAIT_V(6); PG8_BAR; PG8_MMA(1, 1, At, B1); PG8_BAR;
            PG8_LDB(B0, 1, 0); PG8_SCHED; PG8_LDA(At, 1, 0); PG8_STAGE(PG8_SA(0, 1), a2 + hstep, voffA);
            PG8_WAIT_L(8); PG8_BAR; PG8_WAIT_L(0); PG8_MMA(0, 0, At, B0); PG8_BAR; PG8_SCHED;
            PG8_LDB(B1, 1, 1); PG8_STAGE(PG8_SB(1, 0), b3, voffB);
            PG8_BAR; PG8_WAIT_L(0); PG8_MMA(0, 1, At, B1); PG8_BAR;
            PG8_LDA(At, 1, 1); PG8_STAGE(PG8_SA(1, 0), a3, voffA);
            PG8_BAR; PG8_WAIT_L(0); PG8_MMA(1, 0, At, B0); PG8_BAR; PG8_SCHED;
            PG8_STAGE(PG8_SB(1, 1), b3 + hstep, voffB);
            PG8_WAIT_V(6); PG8_BAR; PG8_MMA(1, 1, At, B1); PG8_BAR;
            }
        }
        if constexpr (ALIGN_EPI) { if (wr == 0) PG8_BAR; }
        if constexpr (!Epi::AFTER_DRAIN) { E(acc, cur, wr, wc, fr, fq); S.done(cur); }
        if (!has_next) break;
#pragma unroll
        for (int a = 0; a < 2; ++a)
#pragma unroll
            for (int b = 0; b < 2; ++b)
#pragma unroll
                for (int m = 0; m < 4; ++m)
#pragma unroll
                    for (int n = 0; n < 2; ++n) acc[a][b][m][n] = (f32x4){0.f, 0.f, 0.f, 0.f};
        cur = nxt; cA = nA; cB = nB; ++ui;
        if constexpr (GATHER) { _Pragma("unroll") for (int h_ = 0; h_ < 2; ++h_) _Pragma("unroll") for (int i_ = 0; i_ < 2; ++i_) voG[h_][i_] = voN[h_][i_]; }
        if constexpr (ALIGN_EPI) { if (wr == 1) PG8_BAR; }
    }
    PG8_WAIT_V(0);
    if constexpr (!ALIGN_EPI) { if (wr == 0) PG8_BAR; }
    PG8_BAR;
    if constexpr (Epi::AFTER_DRAIN) { E.fused(acc, cur, wr, wc, fr, fq, lds, wid, lane); S.done(cur); }
#undef PG8_SA
#undef PG8_SB
#undef PG8_STAGE
#undef PG8_STAGE_G
#undef PG8_STAGE_A
#undef PG8_ROWS
#undef PG8_LDA
#undef PG8_LDB
#undef PG8_MMA
#undef PG8_WAIT_V
#undef PG8_WAIT_L
#undef PG8_BAR
#undef PG8_SCHED
}
}
namespace pg8 {
struct EpiBf16 {
    static constexpr bool PERM = true, AFTER_DRAIN = false;
    bf16_t* O; int ldc;
    __device__ __forceinline__ void operator()(const f32x4 (&acc)[2][2][4][2], const Unit& u, int wr, int wc, int fr, int fq) const {
        const int row0 = u.pm * BM + wr * 64 + fr; const int col0 = u.pn * BM + wc * 32 + 8 * fq;
#pragma unroll
        for (int ai = 0; ai < 2; ++ai)
#pragma unroll
            for (int m = 0; m < 4; ++m) { bf16_t* rowp = O + (size_t)(row0 + ai * HALF + m * 16) * ldc + col0;
#pragma unroll
                for (int bj = 0; bj < 2; ++bj) { const f32x4 v0 = acc[ai][bj][m][0], v1 = acc[ai][bj][m][1];
                    u32x4 w; w.x = cvt_pk_bf16(v0[0], v0[1]); w.y = cvt_pk_bf16(v0[2], v0[3]); w.z = cvt_pk_bf16(v1[0], v1[1]); w.w = cvt_pk_bf16(v1[2], v1[3]);
                    *(u32x4*)(rowp + bj * HALF) = w; } }
    }
};
struct EpiSwiGLU {
    static constexpr bool PERM = true, AFTER_DRAIN = false;
    bf16_t* O; int ldc;
    __device__ __forceinline__ void operator()(const f32x4 (&acc)[2][2][4][2], const Unit& u, int wr, int wc, int fr, int fq) const {
        const int row0 = u.pm * BM + wr * 64 + fr; const int col0 = u.pn * HALF + wc * 32 + 8 * fq;
#pragma unroll
        for (int ai = 0; ai < 2; ++ai)
#pragma unroll
            for (int m = 0; m < 4; ++m) { bf16_t* rowp = O + (size_t)(row0 + ai * HALF + m * 16) * ldc + col0;
                float r[8];
#pragma unroll
                for (int n = 0; n < 2; ++n)
#pragma unroll
                    for (int j = 0; j < 4; ++j) { const float a = acc[ai][0][m][n][j], b = acc[ai][1][m][n][j]; r[n * 4 + j] = a * b * __builtin_amdgcn_rcpf(1.0f + __expf(-a)); }
                u32x4 w; w.x = cvt_pk_bf16(r[0], r[1]); w.y = cvt_pk_bf16(r[2], r[3]); w.z = cvt_pk_bf16(r[4], r[5]); w.w = cvt_pk_bf16(r[6], r[7]);
                *(u32x4*)rowp = w; }
    }
};
struct MoeOrder {
    const PG8_LAS int* pref; int nN, G, c, total;
    __device__ __forceinline__ void init(const PG8_LAS int* pref_, int nN_, int G_, int c_, bool xcd = true) { pref = pref_; nN = nN_; G = G_; c = (xcd && (G_ & 7) == 0) ? (c_ & 7) * (G_ >> 3) + (c_ >> 3) : c_; total = pref_[32] * nN_; }
    __device__ __forceinline__ bool next(int i, Unit& u) const {
        const int L = i * G + c; if (L >= total) return false;
        const int rt = L / nN, pn = L - rt * nN; int e = 0;
#pragma unroll 1
        for (int k = 1; k < 32; ++k) e += (pref[k] <= rt) ? 1 : 0;
        u.pm = rt; u.pn = pn; u.pnb = e * nN + pn; return true;
    }
    __device__ __forceinline__ void a_ready(const Unit&) const {}
    __device__ __forceinline__ void done(const Unit&) const {}
};
}
#define XB_TMO      128
#define XB_XCNT(j)  (256  + 64 * (j))
#define XB_XSUB(j)  (1280 + 64 * (j))
#define XB_XGEN(j)  (2304 + 64 * (j))
#define XB_TOP      3328
#define XB_TOPGEN   3392
#define XCD_BAR_WORDS 3456
#define XB_SPIN_CAP (1u << 22)

__device__ __forceinline__ unsigned xb_ld(unsigned* p)              { return __hip_atomic_load(p, __ATOMIC_RELAXED, __HIP_MEMORY_SCOPE_AGENT); }
__device__ __forceinline__ unsigned xb_add(unsigned* p, unsigned v) { return __hip_atomic_fetch_add(p, v, __ATOMIC_RELAXED, __HIP_MEMORY_SCOPE_AGENT); }
__device__ __forceinline__ unsigned xb_xcc_id() { return (unsigned)__builtin_amdgcn_s_getreg((3 << 11) | 20) & 0xFu; }
#define XB_SPIN(cond, bar) do { unsigned _sp = 0; while (cond) { __builtin_amdgcn_s_sleep(1); \
    if ((++_sp & 255u) == 0u) { if (xb_ld(&(bar)[XB_TMO])) break; if (_sp > XB_SPIN_CAP) { atomicAdd(&(bar)[XB_TMO], 1u); break; } } } } while (0)

struct XcdBarrier {
    unsigned* bar; unsigned x;
    volatile LAS unsigned* st;
};

__device__ __forceinline__ XcdBarrier xcd_barrier_post(unsigned* bar, volatile LAS unsigned* st) {
    XcdBarrier b; b.bar = bar; b.x = xb_xcc_id(); b.st = st;
    if (hw_tid() == 0) (void)xb_add(&bar[XB_XCNT(b.x)], 1u);
    return b;
}
__device__ __forceinline__ void xcd_barrier_complete(unsigned* bar, unsigned x, unsigned& nloc, unsigned& nx) {
    const unsigned G = gridDim.x * gridDim.y * gridDim.z;
    unsigned sum, cnt, mine, sp = 0u;
    for (;;) {
        sum = 0u; cnt = 0u; mine = 0u;
#pragma unroll
        for (unsigned j = 0; j < 16; ++j) { const unsigned c = xb_ld(&bar[XB_XCNT(j)]); sum += c; cnt += (c > 0u) ? 1u : 0u; mine = (j == x) ? c : mine; }
        if (sum == G) break;
        __builtin_amdgcn_s_sleep(1);
        if ((++sp & 255u) == 0u) { if (xb_ld(&bar[XB_TMO])) break; if (sp > XB_SPIN_CAP) { atomicAdd(&bar[XB_TMO], 1u); break; } }
    }
    nloc = mine > 0u ? mine : 1u; nx = cnt > 0u ? cnt : 1u;
}

__device__ __forceinline__ void xcd_barrier(const XcdBarrier& b) {
    asm volatile("s_waitcnt vmcnt(0)" ::: "memory");
    __syncthreads();
    if (hw_tid() == 0) {
        unsigned* bar = b.bar;
        __builtin_amdgcn_s_waitcnt(0);
        unsigned nloc = b.st[0], nx = b.st[1];
        if (nloc == 0u) { xcd_barrier_complete(bar, b.x, nloc, nx); b.st[0] = nloc; b.st[1] = nx; }
        const unsigned old = xb_add(&bar[XB_XSUB(b.x)], 1u);
        const unsigned gen = old / nloc;
        if (old + 1u == (gen + 1u) * nloc) {
            __builtin_amdgcn_fence(__ATOMIC_RELEASE, "agent");
            asm volatile("s_waitcnt vmcnt(0)" ::: "memory");
            const unsigned og = xb_add(&bar[XB_TOP], 1u);
            const unsigned tg = og / nx;
            if (og + 1u == (tg + 1u) * nx) xb_add(&bar[XB_TOPGEN], 1u);
            else XB_SPIN(xb_ld(&bar[XB_TOPGEN]) == tg, bar);
            __builtin_amdgcn_fence(__ATOMIC_ACQUIRE, "agent");
            xb_add(&bar[XB_XGEN(b.x)], 1u);
            asm volatile("s_waitcnt vmcnt(0)" ::: "memory");
        } else {
            XB_SPIN(xb_ld(&bar[XB_XGEN(b.x)]) == gen, bar);
            __builtin_amdgcn_fence(__ATOMIC_ACQUIRE, "agent");
            asm volatile("s_waitcnt vmcnt(0)" ::: "memory");
        }
    }
    __syncthreads();
}
struct Args { const float* in[30]; float* out; unsigned char* ws; int ph_lo, ph_hi; };
#define CAS __attribute__((address_space(4)))
struct KA { const CAS unsigned char* kp;
    __device__ __forceinline__ const float* in(int i) const { return *(const float* const CAS*)(kp + 8 * i); }
    __device__ __forceinline__ float* out() const { return *(float* const CAS*)(kp + 240); }
    __device__ __forceinline__ unsigned char* ws() const { return *(unsigned char* const CAS*)(kp + 248); } };
__device__ __forceinline__ KA ka_get() { const CAS unsigned char* kp = (const CAS unsigned char*)__builtin_amdgcn_kernarg_segment_ptr(); asm volatile("" : "+s"(kp)); return KA{kp}; }
__device__ __forceinline__ int opaque_tid() { return hw_tid(); }
static_assert(sizeof(Args) == 264, "kernarg layout");
enum { I_X = 0, I_C, I_CTX, I_CCTX, I_ADAW, I_ADAB, I_WIN, I_RPB, I_MUP, I_MUN, I_W0, I_W2, I_A0, I_A2, I_G2, I_KK, I_KA, I_RK, I_GNG, I_GNB, I_WOUT, I_LN1G, I_LN1B, I_LN2G, I_LN2B, I_RW, I_RB, I_EW1, I_EW3, I_EW2 };

__device__ __forceinline__ void transpose_item(const float* W, int N, int k0, int n0, bf16* WT, int ldk, int drow0, LAS float* scr, int lane) {
#pragma unroll 8
    for (int i = 0; i < 32; ++i) { const int kk = 2 * i + (lane >> 5); scr[kk * 33 + (lane & 31)] = W[(size_t)(k0 + kk) * N + n0 + (lane & 31)]; }
    LDS_WAIT(); asm volatile("" ::: "memory");
    const int c = lane & 7;
#pragma unroll
    for (int j = 0; j < 4; ++j) { const int n = (lane >> 3) + 8 * j; const LAS float* s = scr + (8 * c) * 33 + n;
        v4u o; o.x = pk2(s[0 * 33], s[1 * 33]); o.y = pk2(s[2 * 33], s[3 * 33]); o.z = pk2(s[4 * 33], s[5 * 33]); o.w = pk2(s[6 * 33], s[7 * 33]);
        *(GAS v4u*)(WT + (size_t)(drow0 + n) * ldk + k0 + 8 * c) = o; }
    LDS_WAIT(); asm volatile("" ::: "memory");
}

__device__ __forceinline__ void phase_prologue(LAS unsigned char* lds) {
    const KA a = ka_get();
    const int tid = opaque_tid(), lane = tid & 63, wave = __builtin_amdgcn_readfirstlane(tid >> 6), G = gridDim.x, bid = blockIdx.x;
    const int gw = bid * 8 + wave, NGW = G * 8;
    bf16* WINT = (bf16*)(a.ws() + WS_WINT); bf16* WOT = (bf16*)(a.ws() + WS_WOT);
    if (bid == 0) ((unsigned*)(a.ws() + WS_ZROW))[tid] = 0u;
    LAS float* scr = (LAS float*)(lds + wave * 16384);
    constexpr int I_IN = 16 * 103, I_OUT = 16 * 32, I_L = I_IN + I_OUT;
    for (int it = gw; it < 2 * I_L; it += NGW) {
        const int l = it / I_L; int r = it - l * I_L;
        if (r < I_IN) { const int kb = r / 103, nb = r - kb * 103; transpose_item(a.in(I_WIN) + (size_t)l * DM * DIN, DIN, 64 * kb, 32 * nb, WINT + (size_t)l * DINP * DM, DM, 32 * nb, scr, lane); }
        else { r -= I_IN; const int kb = r >> 5, nb = r & 31; transpose_item(a.in(I_WOUT) + (size_t)l * DM * DM, DM, 64 * kb, 32 * nb, WOT + (size_t)l * DM * DM, DM, 32 * nb, scr, lane); }
    }
    for (int i = bid * 512 + tid; i < 8192; i += G * 512) { const int l = i >> 12, r = i & 4095; *(GAS v4u*)(WINT + (size_t)l * DINP * DM + (size_t)DIN * DM + (size_t)r * 8) = (v4u){0u, 0u, 0u, 0u}; }
    __syncthreads();
    LAS float* sl = (LAS float*)lds; LAS float* red = (LAS float*)(lds + 69632);
    for (int i = tid; i < 17 * 1024; i += 512) { const int r = i >> 10, k = i & 1023; const float v = r < 16 ? a.in(I_C)[r * 1024 + k] : a.in(I_CCTX)[k]; sl[i] = v / (1.0f + expf(-v)); }
    __syncthreads();
    float* mods = (float*)(a.ws() + WS_MODS);
    for (int it = bid; it < 192; it += G) {
        const int l = it / 96, ch = it - l * 96; const int kq = tid >> 6, cl = tid & 63, col = ch * 64 + cl;
        const float* W = a.in(I_ADAW) + (size_t)l * DM * 6144 + col;
        float acc[17];
#pragma unroll
        for (int r = 0; r < 17; ++r) acc[r] = 0.f;
        for (int k0 = kq * 128; k0 < kq * 128 + 128; k0 += 8) { float w8[8];
#pragma unroll
            for (int q = 0; q < 8; ++q) w8[q] = W[(size_t)(k0 + q) * 6144];
#pragma unroll
            for (int r = 0; r < 17; ++r) { const f32x4 s0 = *(const LAS f32x4*)(sl + r * 1024 + k0), s1 = *(const LAS f32x4*)(sl + r * 1024 + k0 + 4);
                acc[r] += s0.x * w8[0] + s0.y * w8[1] + s0.z * w8[2] + s0.w * w8[3] + s1.x * w8[4] + s1.y * w8[5] + s1.z * w8[6] + s1.w * w8[7]; } }
#pragma unroll
        for (int r = 0; r < 17; ++r) red[(kq * 17 + r) * 64 + cl] = acc[r];
        __syncthreads();
        for (int i = tid; i < 17 * 64; i += 512) { const int r = i >> 6, c2 = i & 63; float s = 0.f;
#pragma unroll
            for (int q = 0; q < 8; ++q) s += red[(q * 17 + r) * 64 + c2];
            mods[((size_t)l * 17 + r) * 6144 + ch * 64 + c2] = s + a.in(I_ADAB)[l * 6144 + ch * 64 + c2]; }
        __syncthreads();
    }
}

__device__ __forceinline__ void phase_modconv(LAS unsigned char* lds, int l) {
    const KA a = ka_get();
    const int tid = opaque_tid(), lane = tid & 63, wave = __builtin_amdgcn_readfirstlane(tid >> 6), G = gridDim.x, bid = blockIdx.x;
    const int gw = bid * 8 + wave, NGW = G * 8;
    const float* mods = (const float*)(a.ws() + WS_MODS) + (size_t)l * 17 * 6144;
    bf16* XM = (bf16*)(a.ws() + WS_X1);
    const float* xs = a.in(I_X); const float* cs = a.in(I_CTX);
    const int RPW = (NTOK + NGW - 1) / NGW, m0 = gw * RPW, mend = (m0 + RPW < NTOK) ? m0 + RPW : NTOK;
    if (m0 < mend) {
        f32x4 nx[4];
#define MODC_FETCH(M) do { const int m_ = (M) < mend ? (M) : mend - 1; const GAS f32x4* xr_ = (const GAS f32x4*)(m_ < NTX ? xs + (size_t)m_ * DM : cs + (size_t)(m_ - NTX) * DM) + lane; \
            _Pragma("unroll") for (int j_ = 0; j_ < 4; ++j_) nx[j_] = xr_[64 * j_]; } while (0)
        MODC_FETCH(m0);
        for (int m = m0; m < mend; ) {
            const int mr = m < NTX ? m / SEQ : 16; int segend = m < NTX ? (mr + 1) * SEQ : NTOK; segend = segend < mend ? segend : mend;
            const GAS f32x4* sh = (const GAS f32x4*)(mods + (size_t)mr * 6144) + lane; const GAS f32x4* sc = sh + 256;
            f32x4 shv[4], scv[4];
#pragma unroll
            for (int j = 0; j < 4; ++j) { shv[j] = sh[64 * j]; scv[j] = sc[64 * j]; }
            for (; m < segend; ++m) {
                f32x4 v[4];
#pragma unroll
                for (int j = 0; j < 4; ++j) v[j] = nx[j];
                MODC_FETCH(m + 1);
                GAS v2u* o8 = (GAS v2u*)(XM + (size_t)m * DM) + lane;
#pragma unroll
                for (int j = 0; j < 4; ++j) { const f32x4 r = v[j] * (scv[j] + 1.0f) + shv[j]; v2u w; w.x = pk2(r.x, r.y); w.y = pk2(r.z, r.w); o8[64 * j] = w; }
            }
        }
#undef MODC_FETCH
    }
}

__device__ __forceinline__ void phase_scan_direct(LAS unsigned char* lds, int l) {
    const KA a = ka_get();
    constexpr int TB = 32;
    const int tid = opaque_tid(), lane = tid & 63, wv = __builtin_amdgcn_readfirstlane(tid >> 6);
    LAS float* ops = (LAS float*)lds;
    LAS float* scal = (LAS float*)(lds + 49152);
    LAS float* zl = (LAS float*)(lds + 49664);
    LAS float* rkraw = (LAS float*)(lds + 57856);
    LAS float* ybuf = (LAS float*)(lds + 74240);
    const bf16* PX = (const bf16*)(a.ws() + WS_X2); float* YD = (float*)(a.ws() + WS_X3); float* BON = (float*)(a.ws() + WS_BONUS); const float* rope = (const float*)(a.ws() + WS_ROPE);
    const float* mup = a.in(I_MUP) + l * 1760; const float* mun = a.in(I_MUN) + l * 1760;
    for (int chain = blockIdx.x; chain < 256; chain += gridDim.x) {
        const int b = chain >> 4, h = (chain >> 1) & 7, d = chain & 1, c = lane;
        float w2c[32], a2c[32];
#pragma unroll
        for (int j = 0; j < 32; ++j) { w2c[j] = a.in(I_W2)[((size_t)(l * 2 + d) * 32 + j) * 512 + h * 64 + c]; a2c[j] = a.in(I_A2)[((size_t)(l * 2 + d) * 32 + j) * 512 + h * 64 + c]; }
        const float w0c = a.in(I_W0)[(l * 2 + d) * 512 + h * 64 + c], a0c = a.in(I_A0)[(l * 2 + d) * 512 + h * 64 + c];
        const float kkc = a.in(I_KK)[l * 512 + h * 64 + c], kac = a.in(I_KA)[l * 512 + h * 64 + c], rkc = a.in(I_RK)[l * 512 + h * 64 + c];
        const int colr = h * 64 + c, colk = 512 + colr, colv = 1024 + colr, coll = (c < 32) ? (1536 + d * 32 + c) : (1600 + d * 32 + (c - 32));
        const float mpr = mup[colr], mnr = mun[colr], mpk = mup[colk], mnk = mun[colk], mpv = mup[colv], mnv = mun[colv], mpl = mup[coll], mnl = mun[coll];
        float S[8];
#pragma unroll
        for (int j = 0; j < 8; ++j) S[j] = 0.f;
        const int vl = lane >> 3, kq = lane & 7, vrow = 8 * wv + vl;
        for (int seq = 0; seq < 2; ++seq) {
            const int T = seq ? SEQ : CTXL, rowbase = seq ? b * SEQ : NTX + b * CTXL, nblk = T / TB;
            for (int bi = 0; bi < nblk; ++bi) {
                const int tb = d ? (nblk - 1 - bi) : bi, t0 = tb * TB;
                float zv[4];
#pragma unroll
                for (int i = 0; i < 4; ++i) {
                    const int tl = wv + 8 * i, t = t0 + tl; const bf16* p = PX + (size_t)(rowbase + t) * DINP + RWOFF;
                    const bool hp = t > 0, hn = t + 1 < T;
                    const float cr = bf2f(p[colr]), ck = bf2f(p[colk]), cv = bf2f(p[colv]), cl_ = bf2f(p[coll]);
                    const float pr = hp ? bf2f(p[colr - DINP]) : 0.f, pk = hp ? bf2f(p[colk - DINP]) : 0.f, pv = hp ? bf2f(p[colv - DINP]) : 0.f, pl = hp ? bf2f(p[coll - DINP]) : 0.f;
                    const float nr = hn ? bf2f(p[colr + DINP]) : 0.f, nk = hn ? bf2f(p[colk + DINP]) : 0.f, nv = hn ? bf2f(p[colv + DINP]) : 0.f, nl = hn ? bf2f(p[coll + DINP]) : 0.f;
                    const float zr = cr + mpr * (pr - cr) + mnr * (nr - cr), zk = ck + mpk * (pk - ck) + mnk * (nk - ck);
                    zv[i] = cv + mpv * (pv - cv) + mnv * (nv - cv);
                    const float zz = cl_ + mpl * (pl - cl_) + mnl * (nl - cl_);
                    rkraw[tl * 128 + c] = zr; rkraw[tl * 128 + 64 + c] = zk; zl[tl * 64 + c] = (c < 32) ? tanhf(zz) : zz;
                }
                __syncthreads();
#pragma unroll
                for (int i = 0; i < 4; ++i) {
                    const int tl = wv + 8 * i, t = t0 + tl;
                    float r = rkraw[tl * 128 + c], k = rkraw[tl * 128 + 64 + c];
                    if (seq) { const float rp = rkraw[tl * 128 + (c ^ 16)], kp = rkraw[tl * 128 + 64 + (c ^ 16)]; const int qd = c >> 4, f = c & 15;
                        const int ti = (qd < 2) ? ((t >> 6) * 16 + f) : (1024 + (t & 63) * 16 + f); const float cs = rope[ti], sn = rope[ti + ((qd < 2) ? 512 : 1024)];
                        const float sg = (qd & 1) ? sn : -sn; r = r * cs + rp * sg; k = k * cs + kp * sg; }
                    const float kkr = k * kkc; const float ss = wave_sum(kkr * kkr); const float kk = kkr / fmaxf(sqrtf(ss), 1e-12f);
                    float u = w0c, av = a0c;
#pragma unroll
                    for (int j = 0; j < 32; j += 4) { const f32x4 z1 = *(const LAS f32x4*)(zl + tl * 64 + j), z2 = *(const LAS f32x4*)(zl + tl * 64 + 32 + j);
                        u += z1.x * w2c[j] + z1.y * w2c[j + 1] + z1.z * w2c[j + 2] + z1.w * w2c[j + 3]; av += z2.x * a2c[j] + z2.y * a2c[j + 1] + z2.z * a2c[j + 2] + z2.w * a2c[j + 3]; }
                    const float w = expf(-0.6065306597126334f * sigmoidf_(u)), aa = sigmoidf_(av);
                    const float kd = k * (1.0f + (aa - 1.0f) * kac), nb = -kk * aa;
                    const float c1 = wave_sum(nb * r), c2 = wave_sum(kd * r), bon = wave_sum(r * kd * rkc);
                    LAS float* o = ops + tl * 384 + c; o[0] = kk; o[64] = w * r; o[128] = w; o[192] = nb; o[256] = kd; o[320] = zv[i];
                    if (lane == 0) { scal[tl * 4] = c1; scal[tl * 4 + 1] = c2; BON[((size_t)d * NTOK + rowbase + t) * 8 + h] = bon; }
                }
                __syncthreads();
#pragma unroll 2
                for (int s = 0; s < TB; ++s) {
                    const int tl = d ? (TB - 1 - s) : s; const LAS float* o = ops + tl * 384 + kq * 8;
                    const f32x4 ka = *(const LAS f32x4*)(o), kb = *(const LAS f32x4*)(o + 4), ra = *(const LAS f32x4*)(o + 64), rb = *(const LAS f32x4*)(o + 68);
                    const f32x4 wa = *(const LAS f32x4*)(o + 128), wb = *(const LAS f32x4*)(o + 132), na = *(const LAS f32x4*)(o + 192), nb_ = *(const LAS f32x4*)(o + 196);
                    const f32x4 da = *(const LAS f32x4*)(o + 256), db = *(const LAS f32x4*)(o + 260);
                    const float vv = ops[tl * 384 + 320 + vrow], c1 = scal[tl * 4], c2 = scal[tl * 4 + 1];
                    float sk = S[0] * ka.x + S[1] * ka.y + S[2] * ka.z + S[3] * ka.w + S[4] * kb.x + S[5] * kb.y + S[6] * kb.z + S[7] * kb.w;
                    float yy = S[0] * ra.x + S[1] * ra.y + S[2] * ra.z + S[3] * ra.w + S[4] * rb.x + S[5] * rb.y + S[6] * rb.z + S[7] * rb.w;
                    sk = red8(sk); yy = red8(yy);
                    const float y = yy + sk * c1 + vv * c2;
                    S[0] = S[0] * wa.x + sk * na.x + vv * da.x; S[1] = S[1] * wa.y + sk * na.y + vv * da.y; S[2] = S[2] * wa.z + sk * na.z + vv * da.z; S[3] = S[3] * wa.w + sk * na.w + vv * da.w;
                    S[4] = S[4] * wb.x + sk * nb_.x + vv * db.x; S[5] = S[5] * wb.y + sk * nb_.y + vv * db.y; S[6] = S[6] * wb.z + sk * nb_.z + vv * db.z; S[7] = S[7] * wb.w + sk * nb_.w + vv * db.w;
                    if (kq == 0) ybuf[tl * 64 + vrow] = y;
                }
                __syncthreads();
#pragma unroll
                for (int i = 0; i < 4; ++i) { const int tl = wv + 8 * i; YD[((size_t)d * NTOK + rowbase + t0 + tl) * 512 + h * 64 + c] = ybuf[tl * 64 + c]; }
            }
        }
        __syncthreads();
    }
}

typedef short v4i16_t __attribute__((ext_vector_type(4)));
__device__ __forceinline__ int swz_off(int row, int chunk) { return row * 128 + ((chunk ^ (row & 7)) << 4); }
__device__ __forceinline__ void stage_rows(LAS unsigned char* dst, const bf16* src, int nrows, int tid) {
    for (int idx = tid; idx < nrows * 8; idx += 512) { const int r = idx >> 3, ch = idx & 7; const v4u v = *(const GAS v4u*)(src + (size_t)r * DINP + ch * 8); *(LAS v4u*)(dst + swz_off(r, ch)) = v; }
}
__device__ __forceinline__ bf16x8 q_scale8(bf16x8 q) { const v4u w = __builtin_bit_cast(v4u, q); v4u r;
    r.x = pk2(bflo(w.x) * 0.125f, bfhi(w.x) * 0.125f); r.y = pk2(bflo(w.y) * 0.125f, bfhi(w.y) * 0.125f); r.z = pk2(bflo(w.z) * 0.125f, bfhi(w.z) * 0.125f); r.w = pk2(bflo(w.w) * 0.125f, bfhi(w.w) * 0.125f);
    return __builtin_bit_cast(bf16x8, r); }
#ifndef ATT_THR
#define ATT_THR 8.0f
#endif
struct AttState { float m, l; f32x4 o[4]; };
struct AttOff { int k[2]; int v[4]; int boff; unsigned okm; };
__device__ __forceinline__ AttOff att_offsets(int lane, int wc0, int qc, int cs) { AttOff o; const int kl = lane & 15, g = lane >> 4, q_ = kl >> 2, p_ = kl & 3;
#pragma unroll
    for (int dh = 0; dh < 2; ++dh) o.k[dh] = swz_off(kl, dh * 4 + g);
#pragma unroll
    for (int dt = 0; dt < 4; ++dt) o.v[dt] = swz_off(4 * g + q_, 2 * dt + (p_ >> 1)) + (p_ & 1) * 8;
    o.boff = (wc0 + 4 * g - qc + 15) * 4; o.okm = 0u;
#pragma unroll
    for (int j = 0; j < 8; ++j) { const int kc = wc0 + (j >> 2) * 16 + 4 * g + (j & 3); if ((kc >= cs) && (kc < cs + 16)) o.okm |= 1u << j; }
    return o; }
template <bool LOCAL, bool PREK = false>
__device__ __forceinline__ void att_kstep(AttState& st, const LAS unsigned char* kb, const LAS unsigned char* vb, int r0, const bf16x8 (&qf)[2], int lane, const AttOff& ao, const LAS float* rpbrow, const bf16x8* kpre = nullptr) {
    const LAS unsigned char* kr = kb + r0 * 128; const LAS unsigned char* vr = vb + r0 * 128;
    f32x4 s0 = {0.f, 0.f, 0.f, 0.f}, s1 = {0.f, 0.f, 0.f, 0.f};
    if (LOCAL) {
        const unsigned ad = (unsigned)(uintptr_t)rpbrow + (unsigned)ao.boff; f32x2_t_ b2[4];
#pragma unroll
        for (int j2 = 0; j2 < 4; ++j2) asm volatile("ds_read2_b32 %0, %1 offset0:%2 offset1:%3" : "=v"(b2[j2]) : "v"(ad), "i"((j2 >> 1) * 16 + (j2 & 1) * 2), "i"((j2 >> 1) * 16 + (j2 & 1) * 2 + 1));
        asm volatile("s_waitcnt lgkmcnt(0)" : "+v"(b2[0]), "+v"(b2[1]), "+v"(b2[2]), "+v"(b2[3]) :: "memory");
#pragma unroll
        for (int j = 0; j < 4; ++j) { const float b_lo = (j & 1) ? b2[j >> 1].y : b2[j >> 1].x, b_hi = (j & 1) ? b2[2 + (j >> 1)].y : b2[2 + (j >> 1)].x;
            s0[j] = ((ao.okm >> j) & 1u) ? b_lo : -INFINITY; s1[j] = ((ao.okm >> (4 + j)) & 1u) ? b_hi : -INFINITY; }
    }
#pragma unroll
    for (int dh = 0; dh < 2; ++dh) {
        bf16x8 k0, k1; if constexpr (PREK) { k0 = kpre[2 * dh]; k1 = kpre[2 * dh + 1]; } else { k0 = *(const LAS bf16x8*)(kr + ao.k[dh]); k1 = *(const LAS bf16x8*)(kr + ao.k[dh] + 2048); }
        s0 = __builtin_amdgcn_mfma_f32_16x16x32_bf16(k0, qf[dh], s0, 0, 0, 0); s1 = __builtin_amdgcn_mfma_f32_16x16x32_bf16(k1, qf[dh], s1, 0, 0, 0);
    }
    float sc[8];
#pragma unroll
    for (int j = 0; j < 4; ++j) { sc[j] = s0[j]; sc[4 + j] = s1[j]; }
    float mt; { const float m1_ = fmaxf(fmaxf(sc[0], sc[1]), sc[2]), m2_ = fmaxf(fmaxf(sc[3], sc[4]), sc[5]), m3_ = fmaxf(fmaxf(sc[6], sc[7]), m1_); mt = fmaxf(m2_, m3_); }
    if (__any(mt > st.m + ATT_THR)) {
        mt = xmax16(mt); mt = xmax32(mt);
        const float mn = fmaxf(st.m, mt); const float scale = (mn == -INFINITY) ? 1.0f : __expf(st.m - mn); st.l *= scale; st.m = mn;
#pragma unroll
        for (int dt = 0; dt < 4; ++dt) st.o[dt] = st.o[dt] * scale; }
    float p[8]; const float mref = (st.m == -INFINITY) ? 0.f : st.m;
    { const f32x2_t_ l2 = {1.44269504088896341f, 1.44269504088896341f}; const float nm_ = -mref * 1.44269504088896341f; const f32x2_t_ nm = {nm_, nm_}; f32x2_t_ acc = {0.f, 0.f};
#pragma unroll
      for (int j = 0; j < 4; ++j) { const f32x2_t_ s2 = {sc[2 * j], sc[2 * j + 1]}; const f32x2_t_ t = __builtin_elementwise_fma(s2, l2, nm);
          p[2 * j] = __builtin_amdgcn_exp2f(t.x); p[2 * j + 1] = __builtin_amdgcn_exp2f(t.y); const f32x2_t_ pp = {p[2 * j], p[2 * j + 1]}; acc += pp; }
      st.l += acc.x + acc.y; }
    v4u pw; pw.x = pk2(p[0], p[1]); pw.y = pk2(p[2], p[3]); pw.z = pk2(p[4], p[5]); pw.w = pk2(p[6], p[7]);
    const bf16x8 pf = __builtin_bit_cast(bf16x8, pw);
#pragma unroll
    for (int dt = 0; dt < 4; ++dt) {
        const v4i16_t lo = __builtin_amdgcn_ds_read_tr16_b64_v4i16((LAS v4i16_t*)(vr + ao.v[dt]));
        const v4i16_t hi = __builtin_amdgcn_ds_read_tr16_b64_v4i16((LAS v4i16_t*)(vr + ao.v[dt] + 2048));
        const bf16x8 vf = (bf16x8){lo[0], lo[1], lo[2], lo[3], hi[0], hi[1], hi[2], hi[3]};
        st.o[dt] = __builtin_amdgcn_mfma_f32_16x16x32_bf16(vf, pf, st.o[dt], 0, 0, 0);
    }
}
__device__ __forceinline__ void att_merge_store(AttState& st, LAS float* mrg, int qb, int kh, int lane, bf16* orow0  ) {
    LAS float* mine = mrg + qb * (18 * 64) + lane;
    if (kh == 1) { mine[0] = st.m; mine[64] = st.l;
#pragma unroll
        for (int dt = 0; dt < 4; ++dt)
#pragma unroll
            for (int j = 0; j < 4; ++j) mine[(2 + dt * 4 + j) * 64] = st.o[dt][j]; }
    __syncthreads();
    if (kh == 0) {
        const float m1 = mine[0], l1 = mine[64]; const float ms = fmaxf(st.m, m1); const float f0 = __expf(st.m - ms), f1 = __expf(m1 - ms);
        float lc = st.l * f0 + l1 * f1; lc = xsum16(lc); lc = xsum32(lc); const float inv = 1.0f / lc;
        const int q = lane & 15, g = lane >> 4;
#pragma unroll
        for (int dt = 0; dt < 4; ++dt) { float r[4];
#pragma unroll
            for (int j = 0; j < 4; ++j) r[j] = (st.o[dt][j] * f0 + mine[(2 + dt * 4 + j) * 64] * f1) * inv;
            v2u w; w.x = pk2(r[0], r[1]); w.y = pk2(r[2], r[3]); *(GAS v2u*)(orow0 + (size_t)q * DM + dt * 16 + 4 * g) = w; }
    }
}
__device__ __forceinline__ void phase_attn(LAS unsigned char* lds, int l) {
    const KA a = ka_get();
    const int tid = opaque_tid(), lane = tid & 63, wv = __builtin_amdgcn_readfirstlane(tid >> 6), qb = wv & 3, kh = wv >> 2;
    LAS unsigned char* KC = lds; LAS unsigned char* VC = lds + 32768; LAS unsigned char* KL = lds + 65536; LAS unsigned char* VL = lds + 98304;
    LAS float* RPB = (LAS float*)(lds + 141312); LAS float* mrg = (LAS float*)(lds + 122880);
    const bf16* PX = (const bf16*)(a.ws() + WS_X2); bf16* CAT = (bf16*)(a.ws() + WS_X1);
    for (int blk = blockIdx.x; blk < 256; blk += gridDim.x) {
        const int bh = blk >> 1, b = bh >> 3, h = bh & 7, half = blk & 1;
        __syncthreads();
        const bf16* ctxrow = PX + (size_t)(NTX + b * CTXL) * DINP + h * 64;
        stage_rows(KC, ctxrow + 512, 256, tid); stage_rows(VC, ctxrow + 1024, 256, tid);
        for (int i = tid; i < 465; i += 512) RPB[i] = a.in(I_RPB)[((size_t)l * 8 + h) * 465 + i];
        __syncthreads();
        const int kl = lane & 15, g = lane >> 4;
        const AttOff ao = att_offsets(lane, min(max(qb * 16 - 8, 0), 32), qb * 16 + kl, min(max(qb * 16 + kl - 8, 0), 48));
        if (l == 0) {
            for (int rr = 0; rr < 2; ++rr) {
                const int q0 = (half * 8 + rr * 4 + qb) * 16; const bf16* qrow = ctxrow + (size_t)(q0 + kl) * DINP;
                bf16x8 qf[2]; qf[0] = q_scale8(*(const GAS bf16x8*)(qrow + 8 * g)); qf[1] = q_scale8(*(const GAS bf16x8*)(qrow + 32 + 8 * g));
                AttState st; st.m = -INFINITY; st.l = 0.f;
#pragma unroll
                for (int dt = 0; dt < 4; ++dt) st.o[dt] = (f32x4){0.f, 0.f, 0.f, 0.f};
                for (int s = 0; s < 4; ++s) att_kstep<false>(st, KC, VC, kh * 128 + s * 32, qf, lane, ao, RPB);
                att_merge_store(st, mrg, qb, kh, lane, CAT + (size_t)(NTX + b * CTXL + q0) * DM + h * 64);
                __syncthreads();
            }
        }
        v4u pfk0[3], pfv0[3], pfk1[3], pfv1[3], pfk2[3], pfv2[3];
        const int rw = kh, tok = tid >> 3, pc = tid & 7;
#define ATT_ISSUE(UP, P, pfk, pfv) do { const int base_ = min(max(half * 16 + 2 * (UP) - 4, 0), 24); \
            _Pragma("unroll") for (int q__ = 0; q__ < 3; ++q__) { const int gr_ = min(base_ + 3 * (P) + q__, 31); const bf16* p_ = PX + (size_t)(b * SEQ + gr_ * 64 + tok) * DINP + h * 64 + pc * 8; pfk[q__] = *(const GAS v4u*)(p_ + 512); pfv[q__] = *(const GAS v4u*)(p_ + 1024); } } while (0)
#define ATT_STAGE(pfk, pfv) do { _Pragma("unroll") for (int q__ = 0; q__ < 3; ++q__) { const int o_ = swz_off(q__ * 64 + tok, pc); *(LAS v4u*)(KL + o_) = pfk[q__]; *(LAS v4u*)(VL + o_) = pfv[q__]; } } while (0)
#define ATT_LOCAL(P) do { for (int kr = 0; kr < 3; ++kr) { const int rel = 3 * (P) + kr; if (rel >= off && rel < off + 8) att_kstep<true>(st, KL, VL, kr * 64 + wc0, qf, lane, ao, RPB + (base + rel - iq + 7) * 31); } } while (0)
        const int qc = qb * 16 + kl, wc0 = min(max(qb * 16 - 8, 0), 32);
        bf16x8 qn[2]; { const bf16* qrow = PX + (size_t)(b * SEQ + (half * 16 + rw) * 64 + qc) * DINP + h * 64; qn[0] = *(const GAS bf16x8*)(qrow + 8 * g); qn[1] = *(const GAS bf16x8*)(qrow + 32 + 8 * g); }
        ATT_ISSUE(0, 0, pfk0, pfv0); ATT_ISSUE(0, 1, pfk1, pfv1); ATT_ISSUE(0, 2, pfk2, pfv2);
        for (int up = 0; up < 8; ++up) {
            const int i0 = half * 16 + 2 * up, iq = i0 + rw, base = min(max(i0 - 4, 0), 24), off = min(max(iq - 4, 0), 24) - base, un = up + 1 < 8 ? up + 1 : up;
            bf16x8 qf[2]; qf[0] = q_scale8(qn[0]); qf[1] = q_scale8(qn[1]);
            { const bf16* qrow = PX + (size_t)(b * SEQ + (half * 16 + 2 * un + rw) * 64 + qc) * DINP + h * 64; qn[0] = *(const GAS bf16x8*)(qrow + 8 * g); qn[1] = *(const GAS bf16x8*)(qrow + 32 + 8 * g); }
            ATT_STAGE(pfk0, pfv0); ATT_ISSUE(un, 0, pfk0, pfv0);
            AttState st; st.m = -INFINITY; st.l = 0.f;
#pragma unroll
            for (int dt = 0; dt < 4; ++dt) st.o[dt] = (f32x4){0.f, 0.f, 0.f, 0.f};
            {
#define ATT_LOADK(kf, S) do { const LAS unsigned char* kr_ = KC + (S) * 32 * 128; kf[0] = *(const LAS bf16x8*)(kr_ + ao.k[0]); kf[1] = *(const LAS bf16x8*)(kr_ + ao.k[0] + 2048); kf[2] = *(const LAS bf16x8*)(kr_ + ao.k[1]); kf[3] = *(const LAS bf16x8*)(kr_ + ao.k[1] + 2048); } while (0)
                bf16x8 kfa[4], kfb[4]; ATT_LOADK(kfa, 0);
#pragma unroll 1
                for (int s = 0; s < 8; s += 2) { ATT_LOADK(kfb, s + 1); att_kstep<false, true>(st, KC, VC, s * 32, qf, lane, ao, RPB, kfa);
                    ATT_LOADK(kfa, (s + 2 < 8 ? s + 2 : 7)); att_kstep<false, true>(st, KC, VC, (s + 1) * 32, qf, lane, ao, RPB, kfb); }
#undef ATT_LOADK
            }
            __syncthreads();
            ATT_LOCAL(0);
            __syncthreads();
            ATT_STAGE(pfk1, pfv1); ATT_ISSUE(un, 1, pfk1, pfv1);
            __syncthreads();
            ATT_LOCAL(1);
            __syncthreads();
            ATT_STAGE(pfk2, pfv2); ATT_ISSUE(un, 2, pfk2, pfv2);
            __syncthreads();
            ATT_LOCAL(2);
            __syncthreads();
            {
                float lc = st.l; lc = xsum16(lc); lc = xsum32(lc); const float inv = 1.0f / lc;
                bf16* orow = CAT + (size_t)(b * SEQ + iq * 64 + qb * 16 + kl) * DM + h * 64;
#pragma unroll
                for (int dt = 0; dt < 4; ++dt) { v2u w; w.x = pk2(st.o[dt][0] * inv, st.o[dt][1] * inv); w.y = pk2(st.o[dt][2] * inv, st.o[dt][3] * inv); *(GAS v2u*)(orow + dt * 16 + 4 * g) = w; }
            }
        }
#undef ATT_STAGE
#undef ATT_LOCAL
#undef ATT_ISSUE
    }
}

__device__ __forceinline__ void phase_rwpost(LAS unsigned char* lds, int l) {
    const KA a = ka_get();
    const int tid = opaque_tid(), lane = tid & 63, hh = __builtin_amdgcn_readfirstlane(tid >> 6), kl = lane & 15, g = lane >> 4;
    const int er = tid >> 5, cq = tid & 31, c0 = cq * 16, hq = cq >> 2;
    LAS bf16* sig = (LAS bf16*)lds;
    LAS float* Gl = (LAS float*)(lds + 4096);
    const bf16* PX = (const bf16*)(a.ws() + WS_X2); const bf16* YD = (const bf16*)(a.ws() + WS_X3); const float* BON = (const float*)(a.ws() + WS_BONUS); bf16* CAT = (bf16*)(a.ws() + WS_X1);
    const float* mup = a.in(I_MUP) + l * 1760; const float* mun = a.in(I_MUN) + l * 1760; const float* g2 = a.in(I_G2) + (size_t)l * 96 * 512;
    const float* gngp = a.in(I_GNG) + l * 512 + c0; const float* gnbp = a.in(I_GNB) + l * 512 + c0;
    bf16x8 gb[3][4];
#pragma unroll
    for (int ks = 0; ks < 3; ++ks)
#pragma unroll
        for (int nt = 0; nt < 4; ++nt) { v4u w; unsigned t[8];
#pragma unroll
            for (int j = 0; j < 8; ++j) t[j] = f2bf(g2[(size_t)(32 * ks + 8 * g + j) * 512 + 64 * hh + 16 * nt + kl]);
            w.x = t[0] | (t[1] << 16); w.y = t[2] | (t[3] << 16); w.z = t[4] | (t[5] << 16); w.w = t[6] | (t[7] << 16); gb[ks][nt] = __builtin_bit_cast(bf16x8, w); }
    const int nch = (l == 0 ? NTOK : NTX) / 16;
    LAS float* Pl = (LAS float*)(lds + 40960);
    Pl[tid] = mup[1024 + tid]; Pl[512 + tid] = mun[1024 + tid]; Pl[1024 + tid] = a.in(I_GNG)[l * 512 + tid]; Pl[1536 + tid] = a.in(I_GNB)[l * 512 + tid];
    int sr[3], sj[3]; float smp[3], smn[3];
#pragma unroll
    for (int k = 0; k < 3; ++k) { const int idx = tid + 512 * k; sr[k] = idx / 96; sj[k] = idx - sr[k] * 96; smp[k] = mup[1664 + sj[k]]; smn[k] = mun[1664 + sj[k]]; }
    unsigned short rawc[3], rawp[3], rawn[3]; v4u vc[2], vp[2], vn[2], y0[2], y1[2]; float bon0, bon1;
#define RWP_TT(ROW, t_, T_) int t_, T_; if ((ROW) < NTX) { t_ = (ROW) & (SEQ - 1); T_ = SEQ; } else { t_ = ((ROW) - NTX) & (CTXL - 1); T_ = CTXL; }
#define RWP_RAW(CH) do { const int ch_ = (CH) < nch ? (CH) : blockIdx.x; _Pragma("unroll") for (int k = 0; k < 3; ++k) { const int row_ = ch_ * 16 + sr[k]; RWP_TT(row_, t_, T_) \
            const bf16* p_ = PX + (size_t)row_ * DINP + RWOFF + 1664 + sj[k]; rawc[k] = p_[0]; rawp[k] = p_[t_ > 0 ? -DINP : 0]; rawn[k] = p_[t_ + 1 < T_ ? DINP : 0]; } } while (0)
#define RWP_Y(CH) do { const int ch_ = (CH) < nch ? (CH) : blockIdx.x; const int row_ = ch_ * 16 + er; \
        _Pragma("unroll") for (int i = 0; i < 2; ++i) { y0[i] = *(const GAS v4u*)(YD + (size_t)row_ * 512 + c0 + 8 * i); y1[i] = *(const GAS v4u*)(YD + ((size_t)NTOK + row_) * 512 + c0 + 8 * i); } } while (0)
#define RWP_V(CH) do { const int ch_ = (CH) < nch ? (CH) : blockIdx.x; const int row_ = ch_ * 16 + er; RWP_TT(row_, t_, T_) const bf16* pvp_ = PX + (size_t)row_ * DINP + RWOFF + 1024 + c0; const int op_ = t_ > 0 ? -DINP : 0, on_ = t_ + 1 < T_ ? DINP : 0; \
        _Pragma("unroll") for (int i = 0; i < 2; ++i) { vc[i] = *(const GAS v4u*)(pvp_ + 8 * i); vp[i] = *(const GAS v4u*)(pvp_ + op_ + 8 * i); vn[i] = *(const GAS v4u*)(pvp_ + on_ + 8 * i); } \
        bon0 = BON[(size_t)row_ * 8 + hq]; bon1 = BON[((size_t)NTOK + row_) * 8 + hq]; } while (0)
    RWP_RAW(blockIdx.x); RWP_Y(blockIdx.x); RWP_V(blockIdx.x);
    for (int ch = blockIdx.x; ch < nch; ch += gridDim.x) {
        const int row0 = ch * 16;
        __syncthreads();
#pragma unroll
        for (int k = 0; k < 3; ++k) { const int row_ = row0 + sr[k]; RWP_TT(row_, t, T)
            const float cv = bf2f(rawc[k]), pv = bf2f(rawp[k]) * (t > 0 ? 1.f : 0.f), nv = bf2f(rawn[k]) * (t + 1 < T ? 1.f : 0.f);
            const float z = cv + smp[k] * (pv - cv) + smn[k] * (nv - cv); sig[sr[k] * 96 + sj[k]] = f2bf1(sigmoidf_(z)); }
        RWP_RAW(ch + (int)gridDim.x);
        const int row = row0 + er; RWP_TT(row, t, T) const float fp = t > 0 ? 1.f : 0.f, fn = t + 1 < T ? 1.f : 0.f;
        __syncthreads();
        { f32x4 acc[4];
#pragma unroll
          for (int nt = 0; nt < 4; ++nt) acc[nt] = (f32x4){0.f, 0.f, 0.f, 0.f};
#pragma unroll
          for (int ks = 0; ks < 3; ++ks) { const bf16x8 af = *(const LAS bf16x8*)(sig + kl * 96 + 32 * ks + 8 * g);
#pragma unroll
              for (int nt = 0; nt < 4; ++nt) acc[nt] = __builtin_amdgcn_mfma_f32_16x16x32_bf16(af, gb[ks][nt], acc[nt], 0, 0, 0); }
#pragma unroll
          for (int nt = 0; nt < 4; ++nt)
#pragma unroll
              for (int j = 0; j < 4; ++j) Gl[(4 * g + j) * 512 + 64 * hh + 16 * nt + kl] = acc[nt][j]; }
        __syncthreads();
        f32x4 y[4]; float s = 0.f;
#pragma unroll
        for (int i = 0; i < 4; ++i) { const unsigned a0 = y0[i >> 1][(i & 1) * 2], a1 = y0[i >> 1][(i & 1) * 2 + 1], b0 = y1[i >> 1][(i & 1) * 2], b1 = y1[i >> 1][(i & 1) * 2 + 1];
            y[i] = (f32x4){bflo(a0) + bflo(b0), bfhi(a0) + bfhi(b0), bflo(a1) + bflo(b1), bfhi(a1) + bfhi(b1)}; s += (y[i].x + y[i].y) + (y[i].z + y[i].w); }
        RWP_Y(ch + (int)gridDim.x);
        s += dppmov<0xB1>(s); s += dppmov<0x4E>(s); const float mean = s * (1.0f / 64.0f); float q = 0.f;
#pragma unroll
        for (int i = 0; i < 4; ++i) { y[i] = y[i] - mean; q += (y[i].x * y[i].x + y[i].y * y[i].y) + (y[i].z * y[i].z + y[i].w * y[i].w); }
        q += dppmov<0xB1>(q); q += dppmov<0x4E>(q); const float rstd = 1.0f / sqrtf(q * (1.0f / 64.0f) + GN_EPS);
        const float bon = bon0 + bon1;
        unsigned ow[8];
#pragma unroll
        for (int i = 0; i < 4; ++i) { const unsigned cw0 = vc[i >> 1][(i & 1) * 2], cw1 = vc[i >> 1][(i & 1) * 2 + 1], pw0 = vp[i >> 1][(i & 1) * 2], pw1 = vp[i >> 1][(i & 1) * 2 + 1], nw0 = vn[i >> 1][(i & 1) * 2], nw1 = vn[i >> 1][(i & 1) * 2 + 1];
            const f32x4 cv = {bflo(cw0), bfhi(cw0), bflo(cw1), bfhi(cw1)}, pv = {bflo(pw0) * fp, bfhi(pw0) * fp, bflo(pw1) * fp, bfhi(pw1) * fp}, nv = {bflo(nw0) * fn, bfhi(nw0) * fn, bflo(nw1) * fn, bfhi(nw1) * fn};
            const f32x4 mpv = *(const LAS f32x4*)(Pl + c0 + 4 * i), mnv = *(const LAS f32x4*)(Pl + 512 + c0 + 4 * i), gng = *(const LAS f32x4*)(Pl + 1024 + c0 + 4 * i), gnb = *(const LAS f32x4*)(Pl + 1536 + c0 + 4 * i);
            const f32x4 zv = cv + mpv * (pv - cv) + mnv * (nv - cv);
            const f32x4 gt = *(const LAS f32x4*)(Gl + er * 512 + c0 + 4 * i);
            const f32x4 o = (y[i] * rstd * gng + gnb + zv * bon) * gt;
            ow[2 * i] = pk2(o.x, o.y); ow[2 * i + 1] = pk2(o.z, o.w); }
        RWP_V(ch + (int)gridDim.x);
        GAS v4u* dst = (GAS v4u*)(CAT + (size_t)row * DM + 512 + c0); dst[0] = (v4u){ow[0], ow[1], ow[2], ow[3]}; dst[1] = (v4u){ow[4], ow[5], ow[6], ow[7]};
    }
#undef RWP_TT
#undef RWP_RAW
#undef RWP_Y
#undef RWP_V
}

struct RowMap { int WPB, RPWX, RPWC; };
__device__ __forceinline__ RowMap rowmap(int NGW) { RowMap r; r.WPB = NGW / NB; r.RPWX = SEQ / r.WPB; r.RPWC = NTC / NGW; return r; }
__device__ __forceinline__ int route_wave(int m, const RowMap& r) { if (m < NTX) { const int b = m / SEQ, t = m - b * SEQ; return b * r.WPB + t / r.RPWX; } return (m - NTX) / r.RPWC; }
typedef _Float16 f16x8 __attribute__((ext_vector_type(8)));
typedef _Float16 f16x2_ __attribute__((ext_vector_type(2)));
__device__ __forceinline__ unsigned pkh(float a, float b) { f32x2_t_ v = {a, b}; f16x2_ h = __builtin_convertvector(v, f16x2_); return __builtin_bit_cast(unsigned, h); }
__device__ __forceinline__ void split_h(float a, float b, unsigned& hi, unsigned& lo) { hi = pkh(a, b); const f16x2_ hh = __builtin_bit_cast(f16x2_, hi); lo = pkh(a - (float)hh.x, b - (float)hh.y); }
constexpr int LN1_ROWB = 4112, LN1_RED = 67584;
template <bool BFIN> __device__ __forceinline__ void phase_ln1_route(LAS unsigned char* lds, int l) {
    const KA a = ka_get();
    const int tid = opaque_tid(), lane = tid & 63, wave = __builtin_amdgcn_readfirstlane(tid >> 6), G = gridDim.x, bid = blockIdx.x;
    const int gw = bid * 8 + wave, NGW = G * 8;
    if (tid < 32) ((LAS int*)(lds + LDSCTL_OFF + 1024))[tid] = 0;
    f16x8 Wh[2][4], Wl[2][4];
    { const float* RW = a.in(I_RW) + (size_t)(128 * wave + 8 * (lane >> 4)) * 32 + (lane & 15);
#pragma unroll
      for (int nt = 0; nt < 2; ++nt)
#pragma unroll
        for (int ks = 0; ks < 4; ++ks) { unsigned h[4], lo[4];
#pragma unroll
            for (int t = 0; t < 4; ++t) { const float w0 = RW[(32 * ks + 2 * t) * 32 + 16 * nt] * 256.f, w1 = RW[(32 * ks + 2 * t + 1) * 32 + 16 * nt] * 256.f; split_h(w0, w1, h[t], lo[t]); }
            Wh[nt][ks] = __builtin_bit_cast(f16x8, (v4u){h[0], h[1], h[2], h[3]}); Wl[nt][ks] = __builtin_bit_cast(f16x8, (v4u){lo[0], lo[1], lo[2], lo[3]}); } }
    __syncthreads();
    const float* mods = (const float*)(a.ws() + WS_MODS) + (size_t)l * 17 * 6144;
    const bf16* O = (const bf16*)(a.ws() + WS_X3); bf16* HM = (bf16*)(a.ws() + WS_X1);
    const float* xs = a.in(I_X); const float* cs = a.in(I_CTX); const bf16* xb = (const bf16*)a.out(); bf16* XP = (bf16*)(a.ws() + WS_XP);
    int* HIST = (int*)(a.ws() + WS_LIST); TokInfo* TOK = (TokInfo*)(a.ws() + WS_TOK); LAS int* lcnt = (LAS int*)(lds + LDSCTL_OFF + 1024);
    const GAS f32x4* lg = (const GAS f32x4*)(a.in(I_LN1G) + l * DM) + lane; const GAS f32x4* lb = (const GAS f32x4*)(a.in(I_LN1B) + l * DM) + lane;
    const float biasv = a.in(I_RB)[(lane >> 1) & 31];
    f32x4 lgv[4], lbv[4];
#pragma unroll
    for (int j = 0; j < 4; ++j) { lgv[j] = lg[64 * j]; lbv[j] = lb[64 * j]; }
    const RowMap rm = rowmap(NGW);
    const int bx = gw / rm.WPB, xbase = bx * SEQ + (gw - bx * rm.WPB) * rm.RPWX, cbase = NTX + gw * rm.RPWC, nxr = rm.RPWX, ntot = nxr + (BFIN ? 0 : rm.RPWC);
    f32x4 nx[4]; v2u nxb[4], no[4];
#define LN1_ROW(J) ((J) < nxr ? xbase + (J) : cbase + (J) - nxr)
#define LN1_FETCH(J) do { const int jj_ = (J) < ntot ? (J) : ntot - 1; const int m_ = LN1_ROW(jj_); const GAS v2u* or_ = (const GAS v2u*)(O + (size_t)m_ * DM) + lane; \
        if constexpr (BFIN) { const GAS v2u* xr_ = (const GAS v2u*)(xb + (size_t)m_ * DM) + lane; \
            _Pragma("unroll") for (int j_ = 0; j_ < 4; ++j_) { nxb[j_] = xr_[64 * j_]; no[j_] = or_[64 * j_]; } } \
        else { const float* s_ = m_ < NTX ? xs + (size_t)m_ * DM : cs + (size_t)(m_ - NTX) * DM; const GAS f32x4* xr_ = (const GAS f32x4*)s_ + lane; \
            _Pragma("unroll") for (int j_ = 0; j_ < 4; ++j_) { nx[j_] = xr_[64 * j_]; no[j_] = or_[64 * j_]; } } } while (0)
    LN1_FETCH(0);
    const unsigned afrag = (unsigned)((lane & 15) * LN1_ROWB + (128 * wave + 8 * (lane >> 4)) * 2);
    LAS float* red = (LAS float*)(lds + LN1_RED);
    for (int seg = 0; seg < (BFIN ? 1 : 2); ++seg) {
        const int j0 = seg ? nxr : 0, j1 = seg ? ntot : nxr; const int mr = seg ? 16 : bx;
        const GAS f32x4* md = (const GAS f32x4*)(mods + (size_t)mr * 6144) + lane;
        f32x4 sc2[4], sh2[4], gt1[4];
#pragma unroll
        for (int j = 0; j < 4; ++j) { gt1[j] = md[512 + 64 * j]; sc2[j] = md[1024 + 64 * j]; sh2[j] = md[768 + 64 * j]; }
      for (int jb = j0; jb < j1; jb += 2) {
#pragma unroll
        for (int r = 0; r < 2; ++r) {
            const int m = LN1_ROW(jb + r);
            f32x4 v[4]; float s = 0.f;
#pragma unroll
            for (int j = 0; j < 4; ++j) { f32x4 x; if constexpr (BFIN) { const v2u xw = nxb[j]; x = f32x4{bflo(xw.x), bfhi(xw.x), bflo(xw.y), bfhi(xw.y)}; } else x = nx[j];
                const f32x4 gt = gt1[j]; const v2u ow = no[j]; const f32x4 o = {bflo(ow.x), bfhi(ow.x), bflo(ow.y), bfhi(ow.y)};
                v[j] = x * ALPHA + gt * o; s += (v[j].x + v[j].y) + (v[j].z + v[j].w); }
            LN1_FETCH(jb + r + 1);
            const float mean = wave_sum(s) * (1.f / DM); float s2 = 0.f;
#pragma unroll
            for (int j = 0; j < 4; ++j) { v[j] = v[j] - mean; s2 += (v[j].x * v[j].x + v[j].y * v[j].y) + (v[j].z * v[j].z + v[j].w * v[j].w); }
            const float rstd = 1.f / sqrtf(wave_sum(s2) * (1.f / DM) + LN_EPS);
            GAS v2u* dr = (GAS v2u*)(XP + (size_t)m * DM) + lane; GAS v2u* hr = (GAS v2u*)(HM + (size_t)m * DM) + lane;
            const unsigned trow = (unsigned)((2 * wave + r) * LN1_ROWB + 8 * lane);
#pragma unroll
            for (int j = 0; j < 4; ++j) { const f32x4 x1 = v[j] * rstd * lgv[j] + lbv[j]; { v2u xw; xw.x = pk2(x1.x, x1.y); xw.y = pk2(x1.z, x1.w); dr[64 * j] = xw; }
                const f32x4 hm = x1 * (sc2[j] + 1.0f) + sh2[j]; v2u w; w.x = pk2(hm.x, hm.y); w.y = pk2(hm.z, hm.w); hr[64 * j] = w;
                unsigned h0_, l0_, h1_, l1_; split_h(hm.x, hm.y, h0_, l0_); split_h(hm.z, hm.w, h1_, l1_); const v2u hh = {h0_, h1_}, hl = {l0_, l1_};
                *(LAS v2u*)(lds + trow + 512 * j) = hh; *(LAS v2u*)(lds + trow + 2048 + 512 * j) = hl; }
        }
        __syncthreads();
        {
            f32x4 acc0 = {0.f, 0.f, 0.f, 0.f}, acc1 = {0.f, 0.f, 0.f, 0.f};
            f16x8 ah[4], al[4];
#pragma unroll
            for (int ks = 0; ks < 4; ++ks) { ah[ks] = *(const LAS f16x8*)(lds + afrag + 64 * ks); al[ks] = *(const LAS f16x8*)(lds + afrag + 2048 + 64 * ks); }
#pragma unroll
            for (int ks = 0; ks < 4; ++ks) {
                acc0 = __builtin_amdgcn_mfma_f32_16x16x32_f16(al[ks], Wh[0][ks], acc0, 0, 0, 0); acc1 = __builtin_amdgcn_mfma_f32_16x16x32_f16(al[ks], Wh[1][ks], acc1, 0, 0, 0);
                acc0 = __builtin_amdgcn_mfma_f32_16x16x32_f16(ah[ks], Wl[0][ks], acc0, 0, 0, 0); acc1 = __builtin_amdgcn_mfma_f32_16x16x32_f16(ah[ks], Wl[1][ks], acc1, 0, 0, 0);
                acc0 = __builtin_amdgcn_mfma_f32_16x16x32_f16(ah[ks], Wh[0][ks], acc0, 0, 0, 0); acc1 = __builtin_amdgcn_mfma_f32_16x16x32_f16(ah[ks], Wh[1][ks], acc1, 0, 0, 0); }
            LAS float* rw_ = red + (wave * 16 + 4 * (lane >> 4)) * 32 + (lane & 15);
#pragma unroll
            for (int i = 0; i < 4; ++i) { rw_[i * 32] = acc0[i]; rw_[i * 32 + 16] = acc1[i]; }
        }
        __syncthreads();
#pragma unroll 1
        for (int r = 0; r < 2; ++r) {
            const int m = LN1_ROW(jb + r);
            const LAS float* rr = red + (2 * wave + r) * 32 + ((lane >> 1) & 31); float lsum[8];
#pragma unroll
            for (int w = 0; w < 8; ++w) lsum[w] = rr[w * 512];
            const float logit = (((lsum[0] + lsum[1]) + (lsum[2] + lsum[3])) + ((lsum[4] + lsum[5]) + (lsum[6] + lsum[7]))) * (1.f / 256.f);
        const float score = sigmoidf_(logit), sel = score + biasv;
        const int gl = lane & ~7;
        const float q0 = shi(sel, gl), q1 = shi(sel, gl + 2), q2 = shi(sel, gl + 4), q3 = shi(sel, gl + 6);
        const float mx = fmaxf(fmaxf(q0, q1), fmaxf(q2, q3));
        float top2;
        { float a0 = q0, a1 = q1, a2 = q2, a3 = q3; float t;
          if (a0 < a1) { t = a0; a0 = a1; a1 = t; } if (a2 < a3) { t = a2; a2 = a3; a3 = t; } if (a0 < a2) { t = a0; a0 = a2; a2 = t; } if (a1 < a3) { t = a1; a1 = a3; a3 = t; } if (a1 < a2) { t = a1; a1 = a2; a2 = t; }
          top2 = a0 + a1; (void)mx; }
        float best = __builtin_bit_cast(float, __builtin_amdgcn_readlane(__builtin_bit_cast(int, top2), 0)); int gidx = 0;
#pragma unroll
        for (int gg = 1; gg < 8; ++gg) { const float sc = __builtin_bit_cast(float, __builtin_amdgcn_readlane(__builtin_bit_cast(int, top2), gg * 8)); if (sc > best) { best = sc; gidx = gg; } }
        const float r0 = shi(sel, gidx * 8), r1 = shi(sel, gidx * 8 + 2), r2 = shi(sel, gidx * 8 + 4), r3 = shi(sel, gidx * 8 + 6);
        int i0 = 0; float b0 = r0; if (r1 > b0) { b0 = r1; i0 = 1; } if (r2 > b0) { b0 = r2; i0 = 2; } if (r3 > b0) { b0 = r3; i0 = 3; }
        int i1 = -1; float b1 = -INFINITY;
        if (i0 != 0 && r0 > b1) { b1 = r0; i1 = 0; } if (i0 != 1 && r1 > b1) { b1 = r1; i1 = 1; } if (i0 != 2 && r2 > b1) { b1 = r2; i1 = 2; } if (i0 != 3 && r3 > b1) { b1 = r3; i1 = 3; }
        const int e0 = gidx * 4 + i0, e1 = gidx * 4 + i1;
        const float s0 = shi(score, 2 * e0), s1 = shi(score, 2 * e1); const float gs = 1.0f / (s0 + s1);
        if (lane == 0) { const int p0 = __hip_atomic_fetch_add(lcnt + e0, 1, __ATOMIC_RELAXED, __HIP_MEMORY_SCOPE_WORKGROUP), p1_ = __hip_atomic_fetch_add(lcnt + e1, 1, __ATOMIC_RELAXED, __HIP_MEMORY_SCOPE_WORKGROUP);
            TokInfo ti; ti.e0 = e0; ti.e1 = e1; ti.p0 = p0; ti.p1 = p1_; ti.g0 = s0 * gs; ti.g1 = s1 * gs; ti.pad0 = 0; ti.pad1 = 0; TOK[m] = ti; }
        }
      }
    }
    __syncthreads();
    if (tid < 32) HIST[bid * 32 + tid] = lcnt[tid];
}

template <bool FULL> __device__ __forceinline__ void moe_tables(LAS unsigned char* lds, int l) {
    const KA a = ka_get(); const int tid = opaque_tid(), G = gridDim.x;
    LAS int* pref = (LAS int*)(lds + PREF_OFF); LAS int* bb = (LAS int*)lds; LAS int* tot = (LAS int*)(lds + 65536);
    const int* HIST = (const int*)(a.ws() + WS_LIST);
    __syncthreads();
    const int e = tid & 31, grp = tid >> 5;
    int loc[16]; int run = 0;
#pragma unroll
    for (int i = 0; i < 16; ++i) { const int b = grp * 16 + i; loc[i] = (b < G) ? HIST[b * 32 + e] : 0; }
#pragma unroll
    for (int i = 0; i < 16; ++i) { const int v = loc[i]; loc[i] = run; run += v; }
    tot[grp * 32 + e] = run;
    __syncthreads();
    int base = 0, total = 0;
#pragma unroll
    for (int q = 0; q < 16; ++q) { const int v = tot[q * 32 + e]; base += (q < grp) ? v : 0; total += v; }
    if (FULL) {
#pragma unroll
        for (int i = 0; i < 16; ++i) bb[(grp * 16 + i) * 32 + e] = base + loc[i]; }
    if (grp == 0) pref[40 + e] = total;
    __syncthreads();
    if (tid == 0) { int acc = 0; for (int k = 0; k < 32; ++k) { pref[k] = acc; acc += (pref[40 + k] + 255) >> 8; } pref[32] = acc; }
    __syncthreads();
}
__device__ __forceinline__ void phase_gather(LAS unsigned char* lds, int l) {
    const KA a = ka_get();
    const int tid = opaque_tid(), lane = tid & 63, wave = __builtin_amdgcn_readfirstlane(tid >> 6), G = gridDim.x, bid = blockIdx.x;
    const int gw = bid * 8 + wave, NGW = G * 8;
    moe_tables<true>(lds, l);
    const LAS int* pref = (const LAS int*)(lds + PREF_OFF); const LAS int* bb = (const LAS int*)lds;
    unsigned* ROWOFF = (unsigned*)(a.ws() + WS_ROWOFF);
    if (bid == 0) {
        int* TBL = (int*)(a.ws() + WS_TBL);
        if (tid < 80) TBL[tid] = pref[tid];
        for (int i = tid; i < G * 32; i += 512) TBL[128 + i] = bb[i];
        ((unsigned*)(a.ws() + WS_ZROW))[tid] = 0u; }
    const TokInfo* TOK = (const TokInfo*)(a.ws() + WS_TOK);
    const int Mrows = l == 0 ? NTOK : NTX;
    const RowMap rm = rowmap(NGW);
    for (int m = bid * 512 + tid; m < Mrows; m += G * 512) {
        const TokInfo ti = TOK[m]; const int blk = route_wave(m, rm) >> 3;
        const int sl0 = pref[ti.e0] * 256 + bb[blk * 32 + ti.e0] + ti.p0, sl1 = pref[ti.e1] * 256 + bb[blk * 32 + ti.e1] + ti.p1;
        const unsigned off = (unsigned)(WS_X1 + (size_t)m * (DM * 2)); ROWOFF[sl0] = off; ROWOFF[sl1] = off; }
    for (int e = 0; e < 32; ++e) {
        const int c = pref[40 + e], npad = ((c + 255) & ~255) - c, r0 = pref[e] * 256 + c;
        for (int r = gw * 64 + lane; r < npad; r += NGW * 64) ROWOFF[r0 + r] = (unsigned)WS_ZROW; }
}

__device__ __forceinline__ void phase_ln2(LAS unsigned char* lds, int l) {
    const KA a = ka_get();
    const int tid = opaque_tid(), lane = tid & 63, wave = __builtin_amdgcn_readfirstlane(tid >> 6), G = gridDim.x, bid = blockIdx.x;
    const int gw = bid * 8 + wave, NGW = G * 8;
    const int* pref = (const int*)(a.ws() + WS_TBL); const int* bb = pref + 128;
    const float* mods = (const float*)(a.ws() + WS_MODS) + (size_t)l * 17 * 6144;
    const bf16* Y = (const bf16*)(a.ws() + WS_X2); const TokInfo* TOK = (const TokInfo*)(a.ws() + WS_TOK);
    const bf16* XP = (const bf16*)(a.ws() + WS_XP);
    const GAS f32x4* lg = (const GAS f32x4*)(a.in(I_LN2G) + l * DM) + lane; const GAS f32x4* lb = (const GAS f32x4*)(a.in(I_LN2B) + l * DM) + lane;
    const int Mrows = l == 0 ? NTOK : NTX;
    f32x4 lgv[4], lbv[4];
#pragma unroll
    for (int j = 0; j < 4; ++j) { lgv[j] = lg[64 * j]; lbv[j] = lb[64 * j]; }
    const RowMap rm = rowmap(NGW);
    const int bx = gw / rm.WPB, xbase = bx * SEQ + (gw - bx * rm.WPB) * rm.RPWX, cbase = NTX + gw * rm.RPWC, nxr = rm.RPWX, ntot = nxr + (l == 0 ? rm.RPWC : 0);
#define LN2_ROW(J) ((J) < nxr ? xbase + (J) : cbase + (J) - nxr)
    int sl0v = 0, sl1v = 0; float g0v = 0.f, g1v = 0.f;
    if (lane < ntot) { const TokInfo ti = TOK[LN2_ROW(lane)]; const int* bbw = bb + bid * 32;
        sl0v = pref[ti.e0] * 256 + bbw[ti.e0] + ti.p0; sl1v = pref[ti.e1] * 256 + bbw[ti.e1] + ti.p1; g0v = ti.g0; g1v = ti.g1; }
    v2u xA[4], aA[4], bA[4], xB[4], aB[4], bB[4];
#define LN2_FETCH(J, xin, ain, bin) do { const int j_ = (J) < ntot ? (J) : (ntot - 1); const int s0_ = __builtin_amdgcn_readlane(sl0v, j_), s1_ = __builtin_amdgcn_readlane(sl1v, j_); \
        const GAS v2u* xr_ = (const GAS v2u*)(XP + (size_t)LN2_ROW(j_) * DM) + lane; const GAS v2u* y0_ = (const GAS v2u*)(Y + (size_t)s0_ * DM) + lane; const GAS v2u* y1_ = (const GAS v2u*)(Y + (size_t)s1_ * DM) + lane; \
        _Pragma("unroll") for (int q_ = 0; q_ < 4; ++q_) { xin[q_] = xr_[64 * q_]; ain[q_] = y0_[64 * q_]; bin[q_] = y1_[64 * q_]; } } while (0)
#define LN2_BODY(JR, xin, ain, bin) do { const int jr_ = (JR); const int m = LN2_ROW(jr_); \
        const float tg0 = __builtin_bit_cast(float, __builtin_amdgcn_readlane(__builtin_bit_cast(int, g0v), jr_)), tg1 = __builtin_bit_cast(float, __builtin_amdgcn_readlane(__builtin_bit_cast(int, g1v), jr_)); \
        f32x4 v[4]; float s = 0.f; \
        _Pragma("unroll") for (int j = 0; j < 4; ++j) { const v2u xw = xin[j]; const f32x4 x = {bflo(xw.x), bfhi(xw.x), bflo(xw.y), bfhi(xw.y)}, gt = gin[j]; const v2u a0 = ain[j], a1 = bin[j]; \
            const f32x4 ya = {bflo(a0.x), bfhi(a0.x), bflo(a0.y), bfhi(a0.y)}, yb = {bflo(a1.x), bfhi(a1.x), bflo(a1.y), bfhi(a1.y)}; \
            v[j] = x * ALPHA + gt * (ya * tg0 + yb * tg1); s += (v[j].x + v[j].y) + (v[j].z + v[j].w); } \
        LN2_FETCH(jr_ + 2, xin, ain, bin); \
        const float mean = wave_sum(s) * (1.f / DM); float s2 = 0.f; \
        _Pragma("unroll") for (int j = 0; j < 4; ++j) { v[j] = v[j] - mean; s2 += (v[j].x * v[j].x + v[j].y * v[j].y) + (v[j].z * v[j].z + v[j].w * v[j].w); } \
        const float rstd = 1.f / sqrtf(wave_sum(s2) * (1.f / DM) + LN_EPS); \
        if (l == 0) {        \
            GAS v2u* o8 = (GAS v2u*)((bf16*)(a.ws() + WS_X1) + (size_t)m * DM) + lane; GAS v2u* xs8 = (GAS v2u*)((bf16*)a.out() + (size_t)(m < NTX ? m : 0) * DM) + lane; const bool isx = m < NTX; \
            _Pragma("unroll") for (int j = 0; j < 4; ++j) { const f32x4 xn = v[j] * rstd * lgv[j] + lbv[j]; if (isx) { v2u xw; xw.x = pk2(xn.x, xn.y); xw.y = pk2(xn.z, xn.w); xs8[64 * j] = xw; } \
                const f32x4 r = xn * (msc[j] + 1.0f) + msh[j]; v2u w; w.x = pk2(r.x, r.y); w.y = pk2(r.z, r.w); o8[64 * j] = w; } \
        } else { GAS f32x4* of = (GAS f32x4*)(a.out() + (size_t)m * DM) + lane; \
            _Pragma("unroll") for (int j = 0; j < 4; ++j) of[64 * j] = v[j] * rstd * lgv[j] + lbv[j]; } } while (0)
    LN2_FETCH(0, xA, aA, bA); LN2_FETCH(1, xB, aB, bB);
    for (int seg = 0; seg < (l == 0 ? 2 : 1); ++seg) {
        const int j0 = seg ? nxr : 0, j1 = seg ? ntot : nxr; const int mr = seg ? 16 : bx;
        const GAS f32x4* md = (const GAS f32x4*)(mods + (size_t)mr * 6144) + lane;
        f32x4 gin[4], msc[4], msh[4];
#pragma unroll
        for (int j = 0; j < 4; ++j) gin[j] = md[1280 + 64 * j];
        if (l == 0) { const GAS f32x4* mn = (const GAS f32x4*)(mods + (size_t)17 * 6144 + (size_t)mr * 6144) + lane;
#pragma unroll
            for (int j = 0; j < 4; ++j) { msc[j] = mn[256 + 64 * j]; msh[j] = mn[64 * j]; } }
        for (int jr = j0; jr < j1; jr += 2) { LN2_BODY(jr, xA, aA, bA); LN2_BODY(jr + 1, xB, aB, bB); }
    }
#undef LN2_ROW
#undef LN2_FETCH
#undef LN2_BODY
}
namespace csc {
constexpr int ARR = 0;
constexpr int CHS = 5 * 2048, VSL = 8192;
constexpr int RAW = 0;
constexpr int WLO = 40960;
constexpr int FR = 41984;
constexpr int ZL = FR;
constexpr int LWO = FR + 8192;
constexpr int AAO = FR + 24576;
constexpr int BANK = FR + 32768;
__device__ __forceinline__ int sw16(int row, int chunk) { return row * 128 + ((chunk ^ (row & 7)) << 4); }
__device__ __forceinline__ v2u cvt4(const f32x4 v) { v2u r; r.x = pk2(v[0], v[1]); r.y = pk2(v[2], v[3]); return r; }
__device__ __forceinline__ bf16x8 mk8(v2u lo, v2u hi) { v4u w; w.x = lo.x; w.y = lo.y; w.z = hi.x; w.w = hi.y; return __builtin_bit_cast(bf16x8, w); }
__device__ __forceinline__ v2u trd(const LAS unsigned char* p) { return __builtin_bit_cast(v2u, __builtin_amdgcn_ds_read_tr16_b64_v4i16((LAS v4i16_t*)p)); }
__device__ __forceinline__ int opq(int v) { asm volatile("" : "+v"(v)); return v; }
__device__ __forceinline__ int opqs(int v) { asm volatile("" : "+s"(v)); return v; }
}
namespace bgc {
constexpr int CBUF = LDSCTL_OFF + 2048, CPITCH = 80, NITEMS = NEXP * 1536;
struct Item { const float* src; bf16* dst; int N, ld; };
__device__ __forceinline__ Item decode(const KA& a, int l, int item) {
    const int e = item / 1536; int r = item - e * 1536; const int m = r >> 9, t = r & 511; const size_t eo = ((size_t)l * NEXP + e) * (size_t)DM * DEXP; Item it;
    if (m < 2) { const int kt = t >> 4, nt = t & 15, j0 = 32 * nt; it.N = DEXP; it.ld = 1024; it.src = (m ? a.in(I_EW3) : a.in(I_EW1)) + eo + (size_t)(32 * kt) * DEXP + j0;
        it.dst = (bf16*)(a.ws() + WS_W13T) + (size_t)e * 1024 * 1024 + (size_t)(256 * (j0 >> 7) + 128 * m + (j0 & 127)) * 1024 + 32 * kt; }
    else { const int kt = t >> 5, nt = t & 31; it.N = DM; it.ld = 512; it.src = a.in(I_EW2) + eo + (size_t)(32 * kt) * DM + 32 * nt; it.dst = (bf16*)(a.ws() + WS_W2T) + (size_t)e * 1024 * 512 + (size_t)(32 * nt) * 512 + 32 * kt; }
    return it; }
__device__ __forceinline__ void issue(const KA& a, int l, int item, int lane, f32x4 (&cv)[4]) { const Item it = decode(a, l, item);
#pragma unroll
    for (int i = 0; i < 4; ++i) cv[i] = *(const GAS f32x4*)(it.src + (size_t)((lane >> 3) + 8 * i) * it.N + (lane & 7) * 4); }
__device__ __forceinline__ void finish(const KA& a, int l, int item, int lane, int slot, LAS unsigned char* lds, const f32x4 (&cv)[4]) { const Item it = decode(a, l, item);
    LAS unsigned char* buf = lds + CBUF + slot * (32 * CPITCH);
#pragma unroll
    for (int i = 0; i < 4; ++i)
#pragma unroll
        for (int u = 0; u < 4; ++u) *(LAS bf16*)(buf + ((lane & 7) * 4 + u) * CPITCH + ((lane >> 3) + 8 * i) * 2) = f2bf1(cv[i][u]);
    LDS_WAIT(); asm volatile("" ::: "memory");
    const int n = lane >> 1, hf = lane & 1; const v4u w0 = *(const LAS v4u*)(buf + n * CPITCH + hf * 32), w1 = *(const LAS v4u*)(buf + n * CPITCH + hf * 32 + 16);
    GAS v4u* d = (GAS v4u*)(it.dst + (size_t)n * it.ld + 16 * hf); d[0] = w0; d[1] = w1;
    LDS_WAIT(); asm volatile("" ::: "memory"); }
}
#ifndef SCAN_STAMP
#define SCAN_STAMP 0
#endif
#define STB(k) do { if (SCAN_STAMP == (k)) t0_ = (unsigned)__builtin_amdgcn_s_memrealtime(); } while (0)
#define STE(k) do { if (SCAN_STAMP == (k)) tacc_ += (unsigned)__builtin_amdgcn_s_memrealtime() - t0_; } while (0)
#ifndef SCAN_PROBE
#define SCAN_PROBE 0
#endif
#define REPK(k) for (int rep_ = 0; rep_ < ((SCAN_PROBE == (k)) ? 2 : 1); ++rep_)
__device__ __forceinline__ void phase_scan(LAS unsigned char* lds, int l) {
    using namespace csc;
    const KA a = ka_get();
    const int tid = opaque_tid(), lane0 = tid & 63, wv = __builtin_amdgcn_readfirstlane(tid >> 6);
    const bf16* PX = (const bf16*)(a.ws() + WS_X2); bf16* YD = (bf16*)(a.ws() + WS_X3); float* BON = (float*)(a.ws() + WS_BONUS);
    const float* mup = a.in(I_MUP) + l * 1760; const float* mun = a.in(I_MUN) + l * 1760;
    const f32x4 Z4 = {0.f, 0.f, 0.f, 0.f}; const v2u Z2 = {0u, 0u};
    unsigned t0_ = 0, tacc_ = 0; (void)t0_;
    for (int chain = blockIdx.x; chain < 256; chain += gridDim.x) {
        const int b = chain >> 4, h = (chain >> 1) & 7, d = chain & 1; const int c0_ = opq(lane0);
        float kkc[2], kac[2], rkc[2], mur[2][2], muk[2][2], muv[2][2], mul[2][2], ropef[2]; bf16x8 w2f[2], a2f[2]; float w0c[2], a0c[2];
        { const int ln = c0_, kl = ln & 15, g = ln >> 4, cp = ln & 31;
#pragma unroll
          for (int u = 0; u < 2; ++u) { const int c = 2 * cp + u; ropef[u] = exp2f(-(float)(c & 15) * (13.287712379549449f / 16.0f));
            kkc[u] = a.in(I_KK)[l * 512 + h * 64 + c]; kac[u] = a.in(I_KA)[l * 512 + h * 64 + c]; rkc[u] = a.in(I_RK)[l * 512 + h * 64 + c];
            const int colr = h * 64 + c, coll = (c < 32) ? (1536 + d * 32 + c) : (1600 + d * 32 + (c - 32));
            mur[u][0] = d ? mun[colr] : mup[colr]; mur[u][1] = d ? mup[colr] : mun[colr]; muk[u][0] = d ? mun[512 + colr] : mup[512 + colr]; muk[u][1] = d ? mup[512 + colr] : mun[512 + colr];
            muv[u][0] = d ? mun[1024 + colr] : mup[1024 + colr]; muv[u][1] = d ? mup[1024 + colr] : mun[1024 + colr]; mul[u][0] = d ? mun[coll] : mup[coll]; mul[u][1] = d ? mup[coll] : mun[coll]; }
#pragma unroll
        for (int i = 0; i < 2; ++i) { const int cc = h * 64 + 16 * ((wv >> 2) * 2 + i) + kl; unsigned t[8], u[8];
#pragma unroll
            for (int j = 0; j < 8; ++j) { t[j] = f2bf(a.in(I_W2)[((size_t)(l * 2 + d) * 32 + 8 * g + j) * 512 + cc]); u[j] = f2bf(a.in(I_A2)[((size_t)(l * 2 + d) * 32 + 8 * g + j) * 512 + cc]); }
            w2f[i] = __builtin_bit_cast(bf16x8, (v4u){t[0] | (t[1] << 16), t[2] | (t[3] << 16), t[4] | (t[5] << 16), t[6] | (t[7] << 16)});
            a2f[i] = __builtin_bit_cast(bf16x8, (v4u){u[0] | (u[1] << 16), u[2] | (u[3] << 16), u[4] | (u[5] << 16), u[6] | (u[7] << 16)});
            w0c[i] = a.in(I_W0)[(l * 2 + d) * 512 + cc]; a0c[i] = a.in(I_A0)[(l * 2 + d) * 512 + cc]; } }
        f32x4 St[4] = {Z4, Z4, Z4, Z4};
        f32x4 cvt_[4] = {Z4, Z4, Z4, Z4}; int cit = blockIdx.x * 8 + wv, cpend = -1; const int cstride = gridDim.x * 8;
#define BGC_WINDOW() do { const int ln_ = opq(lane0); if (cpend >= 0) bgc::finish(a, l, cpend, ln_, wv & 3, lds, cvt_); if (cit < bgc::NITEMS) { bgc::issue(a, l, cit, ln_, cvt_); cpend = cit; cit += cstride; } else cpend = -1; } while (0)
        for (int seq = 0; seq < 2; ++seq) {
            const int T = seq ? SEQ : CTXL, rowbase = seq ? b * SEQ : NTX + b * CTXL, ngrp = T / 64;
#define CSC_PREFETCH(GRP) do { const int s0_ = (GRP) * 64; const int tlo_ = d ? (T - 64 - s0_) : s0_; LAS unsigned char* lbn_ = lds + __builtin_amdgcn_readfirstlane(((GRP) & 1) * BANK); \
                _Pragma("unroll") for (int i_ = 0; i_ < 5; ++i_) { if (i_ < 4 || wv == 0) { const int id_ = opq(tid) + 512 * i_; const int rr_ = id_ >> 5, ch_ = id_ & 31; const int t_ = tlo_ - 1 + rr_; \
                    const int col_ = RWOFF + (ch_ < 24 ? (ch_ >> 3) * 512 + h * 64 + (ch_ & 7) * 8 : (ch_ < 28 ? 1536 + d * 32 + (ch_ - 24) * 8 : 1600 + d * 32 + (ch_ - 28) * 8)); \
                    const bool ok_ = t_ >= 0 && t_ < T; const bf16* src_ = ok_ ? PX + (size_t)(rowbase + t_) * DINP + col_ : (const bf16*)(a.ws() + WS_ZROW); \
                    __builtin_amdgcn_global_load_lds((const unsigned*)src_, (LAS unsigned*)(lbn_ + RAW + (512 * i_ + 64 * wv) * 16), 16, 0, 0); } } } while (0)
            CSC_PREFETCH(0);
            VM_WAIT(); __syncthreads();
            float ccs[4][2], csn[4][2];
            { const int ln_ = opq(lane0), sh_ = ln_ >> 5, sb_ = 8 * wv + 4 * sh_;
#pragma unroll
              for (int i = 0; i < 4; ++i)
#pragma unroll
                  for (int u = 0; u < 2; ++u) { const int sl_ = sb_ + i; const float pos = (float)(d ? (63 - sl_) : sl_); const float ang = pos * ropef[u]; ccs[i][u] = __cosf(ang); csn[i][u] = __sinf(ang); asm volatile("" : "+v"(ccs[i][u]), "+v"(csn[i][u])); } }
            for (int grp = 0; grp < ngrp; ++grp) {
                const int s0 = grp * 64;
                LAS unsigned char* lb = lds + opqs((grp & 1) * BANK); LAS unsigned char* lbs = lb;
                int lane = opq(lane0); int c = lane, kl = lane & 15, g = lane >> 4, q_ = kl >> 2, p_ = kl & 3; (void)q_; (void)p_;
                STB(1);
                STE(1); STB(2);
                int sl = opqs(wv);
                float Rk[4][2], Rq[4][2], Rr[4][2], Rv[4][2];
                REPK(1) { const int cp = lane & 31, sh = lane >> 5, sb = 8 * sl + 4 * sh; const int rbase = d ? 64 - sb : sb + 1, rdir = d ? -256 : 256;
                  const LAS bf16* p0 = (const LAS bf16*)(lb + RAW) + (rbase * 256 + 2 * cp) - rdir;
                  float pr[6][2], pk[6][2], pv[6][2], pl[6][2];
#pragma unroll
                  for (int j = 0; j < 6; ++j) { const LAS unsigned* p = (const LAS unsigned*)(p0 + j * rdir); const unsigned wr = p[0], wk = p[32], wv_ = p[64], wl = p[96];
                      pr[j][0] = bflo(wr); pr[j][1] = bfhi(wr); pk[j][0] = bflo(wk); pk[j][1] = bfhi(wk); pv[j][0] = bflo(wv_); pv[j][1] = bfhi(wv_); pl[j][0] = bflo(wl); pl[j][1] = bfhi(wl); }
                  const int qd = cp >> 3;
                  float rcs[2], rsn[2];
                  { const int trow = d ? (T / 64 - 1 - grp) : grp;
#pragma unroll
                    for (int u = 0; u < 2; ++u) { const float ang = (float)trow * ropef[u]; rcs[u] = __cosf(ang); rsn[u] = __sinf(ang); } }
#pragma unroll
                  for (int i = 0; i < 4; ++i) { const int sloc = sb + i; float r[2], k[2], zz[2];
#pragma unroll
                      for (int u = 0; u < 2; ++u) { r[u] = pr[i + 1][u] + mur[u][0] * (pr[i][u] - pr[i + 1][u]) + mur[u][1] * (pr[i + 2][u] - pr[i + 1][u]); k[u] = pk[i + 1][u] + muk[u][0] * (pk[i][u] - pk[i + 1][u]) + muk[u][1] * (pk[i + 2][u] - pk[i + 1][u]);
                          Rv[i][u] = pv[i + 1][u] + muv[u][0] * (pv[i][u] - pv[i + 1][u]) + muv[u][1] * (pv[i + 2][u] - pv[i + 1][u]);
                          const float z = pl[i + 1][u] + mul[u][0] * (pl[i][u] - pl[i + 1][u]) + mul[u][1] * (pl[i + 2][u] - pl[i + 1][u]);
                          const float th = 1.0f - 2.0f * __builtin_amdgcn_rcpf(1.0f + __builtin_amdgcn_exp2f(2.88539008177792681f * z));        zz[u] = cp < 16 ? th : z; }
                      ((LAS unsigned*)(lb + ZL))[sloc * 32 + cp] = pk2(zz[0], zz[1]);
                      if (seq) {
#pragma unroll
                          for (int u = 0; u < 2; ++u) { const float rp = dppmov<0x128>(r[u]), kp = dppmov<0x128>(k[u]); const float cs = (qd < 2) ? rcs[u] : ccs[i][u], sn = (qd < 2) ? rsn[u] : csn[i][u];
                              const float sg = (qd & 1) ? sn : -sn; r[u] = r[u] * cs + rp * sg; k[u] = k[u] * cs + kp * sg; } }
                      const float k0 = k[0] * kkc[0], k1 = k[1] * kkc[1]; float ss = k0 * k0 + k1 * k1;
                      ss += dppmov<0xB1>(ss); ss += dppmov<0x4E>(ss); ss += dppmov<0x141>(ss); ss += dppmov<0x140>(ss);
                      ss = xsum16(ss);
                      const float rn = __builtin_amdgcn_rsqf(fmaxf(ss, 1e-24f));
                      Rk[i][0] = k0 * rn; Rk[i][1] = k1 * rn; Rq[i][0] = k[0]; Rq[i][1] = k[1]; Rr[i][0] = r[0]; Rr[i][1] = r[1]; } }
                __syncthreads();
                STE(2); STB(3);
                lane = opq(lane0); c = lane; kl = lane & 15; g = lane >> 4; q_ = kl >> 2; p_ = kl & 3;
                REPK(2) { const int wq = opqs(wv); const int st = wq & 3; const LAS unsigned char* zrow = lb + ZL + (16 * st + kl) * 128;
                  const bf16x8 zw = *(const LAS bf16x8*)(zrow + 16 * g), za = *(const LAS bf16x8*)(zrow + 64 + 16 * g);
#pragma unroll
                  for (int i = 0; i < 2; ++i) { const int cc = 16 * ((wq >> 2) * 2 + i) + kl;
                      const f32x4 uw = __builtin_amdgcn_mfma_f32_16x16x32_bf16(zw, w2f[i], Z4, 0, 0, 0), ua = __builtin_amdgcn_mfma_f32_16x16x32_bf16(za, a2f[i], Z4, 0, 0, 0);
                      float w0n[2], a0n[2]; w0n[i] = -1.44269504088896341f * w0c[i]; a0n[i] = -1.44269504088896341f * a0c[i];
#pragma unroll
                      for (int j = 0; j < 4; ++j) { const int srow = 16 * st + 4 * g + j;
                          ((LAS float*)(lb + LWO))[srow * 64 + cc] = -0.875038774914528f * __builtin_amdgcn_rcpf(1.0f + __builtin_amdgcn_exp2f(__builtin_fmaf(uw[j], -1.44269504088896341f, w0n[i])));
                          ((LAS bf16*)(lb + AAO))[srow * 64 + cc] = f2bf1(__builtin_amdgcn_rcpf(1.0f + __builtin_amdgcn_exp2f(__builtin_fmaf(ua[j], -1.44269504088896341f, a0n[i])))); } } }
                __syncthreads();
                STE(3); STB(4);
                lane = opq(lane0); c = lane; kl = lane & 15; g = lane >> 4; q_ = kl >> 2; p_ = kl & 3;
                sl = opqs(wv);
                REPK(4) { const int cp = lane & 31, sh = lane >> 5, q = sl >> 1, hf = sl & 1; typedef float f32x2_ __attribute__((ext_vector_type(2)));
                  const LAS f32x2_* lwp = (const LAS f32x2_*)((const LAS float*)(lb + LWO) + (16 * q) * 64 + 2 * cp); const LAS unsigned* aap = (const LAS unsigned*)(lb + AAO) + (8 * sl + 4 * sh) * 32 + cp;
                  f32x2_ qs[4];
#pragma unroll
                  for (int j = 0; j < 4; ++j) { qs[j] = lwp[(4 * j) * 32] + lwp[(4 * j + 1) * 32] + lwp[(4 * j + 2) * 32] + lwp[(4 * j + 3) * 32]; }
                  const f32x2_ cL = (qs[0] + qs[1]) + (qs[2] + qs[3]); const int part = 2 * hf + sh;
                  f32x2_ run = part == 0 ? (f32x2_){0.f, 0.f} : (part == 1 ? qs[0] : (part == 2 ? qs[0] + qs[1] : qs[0] + qs[1] + qs[2]));
                  const float wl0 = __builtin_amdgcn_exp2f(cL.x), wl1 = __builtin_amdgcn_exp2f(cL.y);
                  if (part == 3) ((LAS f32x2_*)(lb + WLO))[q * 32 + cp] = (f32x2_){wl0, wl1};
                  float e3x = __builtin_amdgcn_exp2f(run.x), e3y = __builtin_amdgcn_exp2f(run.y);
#pragma unroll
                  for (int i = 0; i < 4; ++i) { const int sloc = 8 * sl + 4 * sh + i, s = 4 * part + i; const f32x2_ lwi = lwp[s * 32]; run = run + lwi; const unsigned aw_ = aap[i * 32]; const f32x2_ aa = {bflo(aw_), bfhi(aw_)};
                      const float kd0 = Rq[i][0] * (1.0f + (aa.x - 1.0f) * kac[0]), kd1 = Rq[i][1] * (1.0f + (aa.y - 1.0f) * kac[1]), nb0 = -Rk[i][0] * aa.x, nb1 = -Rk[i][1] * aa.y;
                      float bon = Rr[i][0] * kd0 * rkc[0] + Rr[i][1] * kd1 * rkc[1];
                      bon += dppmov<0xB1>(bon); bon += dppmov<0x4E>(bon); bon += dppmov<0x141>(bon); bon += dppmov<0x140>(bon);
                      bon = xsum16(bon);
                      if (cp == 0) { const int t = d ? (T - 1 - (s0 + sloc)) : (s0 + sloc); BON[((size_t)d * NTOK + rowbase + t) * 8 + h] = bon; }
                      const float e1x = e3x, e1y = e3y; e3x = __builtin_amdgcn_exp2f(run.x); e3y = __builtin_amdgcn_exp2f(run.y); const float e2x = __builtin_amdgcn_rcpf(e3x), e2y = __builtin_amdgcn_rcpf(e3y);
                      LAS unsigned char* base = lb + ARR + q * CHS + sw16(s, cp >> 2) + (cp & 3) * 4;
                      *(LAS unsigned*)(base) = pk2(Rk[i][0] * e1x, Rk[i][1] * e1y); *(LAS unsigned*)(base + 2048) = pk2(nb0 * e2x, nb1 * e2y); *(LAS unsigned*)(base + 4096) = pk2(kd0 * e2x, kd1 * e2y); *(LAS unsigned*)(base + 6144) = pk2(Rr[i][0] * e3x, Rr[i][1] * e3y);
                      *(LAS unsigned*)(base + VSL) = pk2(Rv[i][0], Rv[i][1]); } }
                __syncthreads();
                STE(4); STB(5);
                lane = opq(lane0); c = lane; kl = lane & 15; g = lane >> 4; q_ = kl >> 2; p_ = kl & 3;
                STB(7); if (wv < 4) { BGC_WINDOW(); if (grp + 1 < ngrp) CSC_PREFETCH(grp + 1); } STE(7);
                STB(8); STB(10);
                REPK(5) if (wv >= 4) { __builtin_amdgcn_s_setprio(3); const int q = opqs(wv) - 4; const LAS unsigned char* A0 = lb + ARR + q * CHS;
                    STB(11);
                    bf16x8 at[2], bt[2], kt[2], rt[2];
#pragma unroll
                    for (int ks = 0; ks < 2; ++ks) { const int o = sw16(kl, ks * 4 + g); at[ks] = *(const LAS bf16x8*)(A0 + o); bt[ks] = *(const LAS bf16x8*)(A0 + 2048 + o); kt[ks] = *(const LAS bf16x8*)(A0 + 4096 + o); rt[ks] = *(const LAS bf16x8*)(A0 + 6144 + o); }
                    f32x4 ABt = Z4, AKt = Z4, RBt = Z4, RKt = Z4;
#pragma unroll
                    for (int ks = 0; ks < 2; ++ks) { ABt = __builtin_amdgcn_mfma_f32_16x16x32_bf16(bt[ks], at[ks], ABt, 0, 0, 0); AKt = __builtin_amdgcn_mfma_f32_16x16x32_bf16(kt[ks], at[ks], AKt, 0, 0, 0);
                        RBt = __builtin_amdgcn_mfma_f32_16x16x32_bf16(bt[ks], rt[ks], RBt, 0, 0, 0); RKt = __builtin_amdgcn_mfma_f32_16x16x32_bf16(kt[ks], rt[ks], RKt, 0, 0, 0); }
#pragma unroll
                    for (int j = 0; j < 4; ++j) { const int jj = 4 * g + j; ABt[j] = jj < kl ? ABt[j] : 0.f; AKt[j] = jj < kl ? AKt[j] : 0.f; RBt[j] = jj <= kl ? RBt[j] : 0.f; RKt[j] = jj <= kl ? RKt[j] : 0.f; }
                    STE(11); STB(12);
                    float Nall[16];
#pragma unroll
                    for (int gp = 0; gp < 4; ++gp)
#pragma unroll
                        for (int j = 0; j < 4; ++j) Nall[4 * gp + j] = shi(ABt[j], kl + 16 * gp);
                    float Tq[4];
#pragma unroll
                    for (int r = 0; r < 4; ++r) Tq[r] = (4 * g + r == kl) ? 1.f : 0.f;
#define TSTEP(i) do { _Pragma("unroll") for (int r = 0; r < 4; ++r) Tq[r] = __builtin_fmaf(Nall[i], dppmov<0x150 + (i)>(Tq[r]), Tq[r]); } while (0)
                    TSTEP(0);
                    TSTEP(1);
                    TSTEP(2);
                    TSTEP(3);
                    TSTEP(4);
                    TSTEP(5);
                    TSTEP(6);
                    TSTEP(7);
                    TSTEP(8);
                    TSTEP(9);
                    TSTEP(10);
                    TSTEP(11);
                    TSTEP(12);
                    TSTEP(13);
                    TSTEP(14);
#undef TSTEP
                    STE(12); STB(13);
                    v2u tf2; tf2.x = pk2(Tq[0], Tq[1]); tf2.y = pk2(Tq[2], Tq[3]);
                    const bf16x8 Tf = mk8(tf2, Z2), RBf = mk8(cvt4(RBt), Z2);
                    f32x4 AhT[4], QhT[4], Ah[4], rin[4]; bf16x8 Alo[4];
#pragma unroll
                    for (int ct = 0; ct < 4; ++ct) { Alo[ct] = mk8(trd(A0 + sw16(4 * g + q_, 2 * ct + (p_ >> 1)) + (p_ & 1) * 8), Z2);
                        const v2u rw = *(const LAS v2u*)(A0 + 6144 + sw16(kl, 2 * ct + (g >> 1)) + (g & 1) * 8);
                        rin[ct] = (f32x4){bflo(rw.x), bfhi(rw.x), bflo(rw.y), bfhi(rw.y)}; }
#pragma unroll
                    for (int ct = 0; ct < 4; ++ct) { AhT[ct] = __builtin_amdgcn_mfma_f32_16x16x32_bf16(Alo[ct], Tf, Z4, 0, 0, 0);
                        Ah[ct] = __builtin_amdgcn_mfma_f32_16x16x32_bf16(Tf, Alo[ct], Z4, 0, 0, 0); }
#pragma unroll
                    for (int ct = 0; ct < 4; ++ct) QhT[ct] = __builtin_amdgcn_mfma_f32_16x16x32_bf16(mk8(cvt4(Ah[ct]), Z2), RBf, rin[ct], 0, 0, 0);
                    STE(13); STB(14);
                    LAS unsigned char* fr = lb + FR + q * 7168 + lane * 16;
                    *(LAS bf16x8*)(fr) = mk8(cvt4(AhT[0]), cvt4(AhT[1])); *(LAS bf16x8*)(fr + 1024) = mk8(cvt4(AhT[2]), cvt4(AhT[3]));
                    *(LAS bf16x8*)(fr + 2048) = mk8(cvt4(QhT[0]), cvt4(QhT[1])); *(LAS bf16x8*)(fr + 3072) = mk8(cvt4(QhT[2]), cvt4(QhT[3]));
                    *(LAS bf16x8*)(fr + 4096) = mk8(cvt4(AKt), Z2); *(LAS bf16x8*)(fr + 5120) = mk8(cvt4(RBt), cvt4(RKt)); *(LAS bf16x8*)(fr + 6144) = Tf;
                    STE(14);
                    __builtin_amdgcn_s_setprio(0);
                }
                STE(8); STE(10);
                __syncthreads();
                STE(5); STB(6);
                lane = opq(lane0); c = lane; kl = lane & 15; g = lane >> 4; q_ = kl >> 2; p_ = kl & 3;
                if (wv >= 4) { BGC_WINDOW(); if (grp + 1 < ngrp) CSC_PREFETCH(grp + 1); }
                if (wv < 4) { __builtin_amdgcn_s_setprio(3); const int vt = opqs(wv);
#define S_LOAD(Q, F) do { const int q__ = (Q) < 4 ? (Q) : 3; const LAS unsigned char* A0_ = lbs + ARR + q__ * CHS; const LAS unsigned char* fr_ = lbs + FR + q__ * 7168 + lane * 16; \
                        F##Ap0 = *(const LAS bf16x8*)(fr_); F##Ap1 = *(const LAS bf16x8*)(fr_ + 1024); F##Qp0 = *(const LAS bf16x8*)(fr_ + 2048); F##Qp1 = *(const LAS bf16x8*)(fr_ + 3072); \
                        F##AKf = *(const LAS bf16x8*)(fr_ + 4096); F##RBRK = *(const LAS bf16x8*)(fr_ + 5120); F##Tf = *(const LAS bf16x8*)(fr_ + 6144); \
                        F##vtr = trd(A0_ + VSL + sw16(4 * g + q_, 2 * vt + (p_ >> 1)) + (p_ & 1) * 8);        \
                        } while (0)
#define S_STEP(Q, F) do { const int q = (Q); f32x4 wl[4]; bf16x8 bk[4]; const LAS unsigned char* A0 = lbs + ARR + q * CHS;        \
                        _Pragma("unroll") for (int ct = 0; ct < 4; ++ct) { wl[ct] = *(const LAS f32x4*)(lbs + WLO + (q * 64 + 16 * ct + 4 * g) * 4); const int o = sw16(4 * g + q_, 2 * ct + (p_ >> 1)) + (p_ & 1) * 8; bk[ct] = mk8(trd(A0 + 2048 + o), trd(A0 + 4096 + o)); } \
                        const f32x4 X1 = __builtin_amdgcn_mfma_f32_16x16x32_bf16(F##AKf, mk8(F##vtr, Z2), Z4, 0, 0, 0); \
                        const f32x4 Uh = __builtin_amdgcn_mfma_f32_16x16x32_bf16(F##Tf, mk8(cvt4(X1), Z2), Z4, 0, 0, 0); \
                        const f32x4 Yh = __builtin_amdgcn_mfma_f32_16x16x32_bf16(F##RBRK, mk8(cvt4(Uh), F##vtr), Z4, 0, 0, 0); \
                        const bf16x8 bs0 = mk8(cvt4(St[0]), cvt4(St[1])), bs1 = mk8(cvt4(St[2]), cvt4(St[3])); \
                        f32x4 U = __builtin_amdgcn_mfma_f32_16x16x32_bf16(F##Ap0, bs0, Uh, 0, 0, 0); U = __builtin_amdgcn_mfma_f32_16x16x32_bf16(F##Ap1, bs1, U, 0, 0, 0); \
                        f32x4 Y = __builtin_amdgcn_mfma_f32_16x16x32_bf16(F##Qp0, bs0, Yh, 0, 0, 0); Y = __builtin_amdgcn_mfma_f32_16x16x32_bf16(F##Qp1, bs1, Y, 0, 0, 0); \
                        const bf16x8 UV = mk8(cvt4(U), F##vtr); \
                        _Pragma("unroll") for (int ct = 0; ct < 4; ++ct) St[ct] = __builtin_amdgcn_mfma_f32_16x16x32_bf16(bk[ct], UV, St[ct], 0, 0, 0) * wl[ct];        \
                        _Pragma("unroll") for (int jj = 0; jj < 2; ++jj) {        \
                            const float pe = dppmov<0xB1>(Y[jj]), po = dppmov<0xB1>(Y[2 + jj]); const bool odd = (kl & 1) != 0; \
                            const unsigned w = odd ? pk2(po, Y[2 + jj]) : pk2(Y[jj], pe); \
                            const int sg = s0 + 16 * q + 4 * g + jj + (odd ? 2 : 0); const int t = d ? (T - 1 - sg) : sg; \
                            *(GAS unsigned*)(YD + ((size_t)d * NTOK + rowbase + t) * 512 + h * 64 + 16 * vt + (kl & ~1)) = w; } } while (0)
                    bf16x8 FaAp0, FaAp1, FaQp0, FaQp1, FaAKf, FaRBRK, FaTf; v2u Favtr; bf16x8 FbAp0, FbAp1, FbQp0, FbQp1, FbAKf, FbRBRK, FbTf; v2u Fbvtr;
                    S_LOAD(0, Fa);
#pragma unroll 1
                    for (int qq = 0; qq < 4; qq += 2) { S_LOAD(qq + 1, Fb); S_STEP(qq, Fa); S_LOAD(qq + 2, Fa); S_STEP(qq + 1, Fb); }
#undef S_LOAD
#undef S_STEP
                    __builtin_amdgcn_s_setprio(0);
                }
                VM_WAIT();
                __syncthreads();
                STE(6);
            }
#undef CSC_PREFETCH
        }
        if (cpend >= 0) { bgc::finish(a, l, cpend, opq(lane0), wv & 3, lds, cvt_); cpend = -1; }
        for (; cit < bgc::NITEMS; cit += cstride) { bgc::issue(a, l, cit, opq(lane0), cvt_); bgc::finish(a, l, cit, opq(lane0), wv & 3, lds, cvt_); }
#undef BGC_WINDOW
    }
    if (SCAN_STAMP != 0 && blockIdx.x == 0 && tid == ((SCAN_STAMP == 8 || (SCAN_STAMP >= 11 && SCAN_STAMP <= 14)) ? 256 : ((SCAN_STAMP == 10) ? 448 : 0))) atomicAdd((unsigned*)(a.ws() + WS_CTL) + 2000, tacc_);
}
#ifndef GEMM2_XCD
#define GEMM2_XCD true
#endif
constexpr int PH_PER_LAYER = 11, N_PHASES = 1 + 2 * PH_PER_LAYER;
template <int K> __device__ __forceinline__ void run_phase(LAS unsigned char* lds, int l) {
    if constexpr (K == 0) phase_prologue(lds);
    if constexpr (K == 1) phase_modconv(lds, l);
    if constexpr (K == 3) phase_scan(lds, l);
    if constexpr (K == 4) phase_attn(lds, l);
    if constexpr (K == 5) phase_rwpost(lds, l);
    if constexpr (K == 7) { if (l == 0) phase_ln1_route<false>(lds, l); else phase_ln1_route<true>(lds, l); }
    if constexpr (K == 8) phase_gather(lds, l);
    if constexpr (K == 11) phase_ln2(lds, l);
    if constexpr (K == 2 || K == 6 || K == 9 || K == 10) {
        const KA a = ka_get(); unsigned char* ws = a.ws(); const int G = gridDim.x, bid = blockIdx.x;
        bf16* X1 = (bf16*)(ws + WS_X1); bf16* X2 = (bf16*)(ws + WS_X2); bf16* X3 = (bf16*)(ws + WS_X3);
        if constexpr (K == 2) { __syncthreads();
            pg8::Gemm g{X1, (const bf16*)(ws + WS_WINT) + (size_t)l * DINP * DM, NTOK, DINP, DM}; pg8::StaticOrder S; S.init(NTOK, DINP, G, bid);
            pg8::EpiBf16 E{X2, DINP}; pg8::gemm_phase<pg8::EpiBf16, pg8::StaticOrder, true, true>(lds, g, S, E); }
        if constexpr (K == 6) { __syncthreads();
            const int Mrows = (l == 0) ? NTOK : NTX;
            pg8::Gemm g{X1, (const bf16*)(ws + WS_WOT) + (size_t)l * DM * DM, Mrows, DM, DM}; pg8::StaticOrder S; S.init(Mrows, DM, G, bid);
            pg8::EpiBf16 E{X3, DM}; pg8::gemm_phase<pg8::EpiBf16, pg8::StaticOrder, true, true>(lds, g, S, E); }
        if constexpr (K == 9) { __syncthreads(); if (hw_tid() < 80) ((LAS int*)(lds + PREF_OFF))[hw_tid()] = ((const int*)(ws + WS_TBL))[hw_tid()]; __syncthreads();
            pg8::Gemm g{(const bf16*)ws, (const bf16*)(ws + WS_W13T), MAXSLOT, 1024, DM}; pg8::MoeOrder S; S.init((const LAS int*)(lds + PREF_OFF), 4, G, bid);
            LAS unsigned* rowl = (LAS unsigned*)(lds + RING_BYTES);
            { const unsigned* ROWOFF = (const unsigned*)(ws + WS_ROWOFF); pg8::Unit u; const int t_ = hw_tid();
              for (int i = 0; i < 16 && S.next(i, u); ++i) if (t_ < 256) rowl[i * 256 + t_] = ROWOFF[u.pm * 256 + t_]; }
            __syncthreads();
            pg8::EpiSwiGLU E{X3, DEXP}; pg8::gemm_phase<pg8::EpiSwiGLU, pg8::MoeOrder, true, true, true>(lds, g, S, E, rowl); }
        if constexpr (K == 10) { __syncthreads(); if (hw_tid() < 80) ((LAS int*)(lds + PREF_OFF))[hw_tid()] = ((const int*)(ws + WS_TBL))[hw_tid()]; __syncthreads();
            pg8::Gemm g{X3, (const bf16*)(ws + WS_W2T), MAXSLOT, 1024, DEXP}; pg8::MoeOrder S; S.init((const LAS int*)(lds + PREF_OFF), 4, G, bid, GEMM2_XCD);
            pg8::EpiBf16 E{X2, DM}; pg8::gemm_phase<pg8::EpiBf16, pg8::MoeOrder, true, true>(lds, g, S, E); }
    }
}
__device__ __forceinline__ void grid_sync(LAS unsigned char* lds) {
    const KA a = ka_get(); XcdBarrier b; b.bar = (unsigned*)(a.ws() + WS_CTL) + CW_BAR; b.x = xb_xcc_id(); b.st = (volatile LAS unsigned*)(lds + MISC_OFF) + 8; xcd_barrier(b);
#ifdef PROBE_BAR
    xcd_barrier(b);
#endif
}
#ifndef ONE_LAUNCH
template <int K> __global__ void __launch_bounds__(512, 2) fwd_ph(Args args) {
    extern __shared__ __attribute__((aligned(16))) unsigned char lds_raw[];
    LAS unsigned char* lds = (LAS unsigned char*)lds_raw;
    for (int u = threadIdx.x; u < (LDS_BYTES - LDSCTL_OFF) / 4; u += 512) ((LAS unsigned*)(lds + LDSCTL_OFF))[u] = 0u;
    __syncthreads();
    hw_tid_init();
    __syncthreads();
    run_phase<K>(lds, args.ph_lo);
}
template <int K> static void launch_ph(const Args& a, int grid, hipStream_t stream) {
    static bool attr = false;
    if (!attr) { (void)hipFuncSetAttribute((const void*)fwd_ph<K>, hipFuncAttributeMaxDynamicSharedMemorySize, LDS_BYTES); attr = true; }
    hipLaunchKernelGGL(fwd_ph<K>, dim3(grid), dim3(512), LDS_BYTES, stream, a);
}
#else
__global__ void __launch_bounds__(512, 2) fwd(Args args) {
    extern __shared__ __attribute__((aligned(16))) unsigned char lds_raw[];
    LAS unsigned char* lds = (LAS unsigned char*)lds_raw;
    for (int u = threadIdx.x; u < (LDS_BYTES - LDSCTL_OFF) / 4; u += 512) ((LAS unsigned*)(lds + LDSCTL_OFF))[u] = 0u;
    __syncthreads();
    hw_tid_init();
    __syncthreads();
    (void)xcd_barrier_post((unsigned*)(args.ws + WS_CTL) + CW_BAR, (volatile LAS unsigned*)(lds + MISC_OFF) + 8);
    run_phase<0>(lds, 0);
#ifdef PROBE_P0
    __syncthreads(); run_phase<0>(lds, 0);
#endif
    grid_sync(lds);
#ifndef PROBE_REP
#define PROBE_REP -1
#endif
#define RUNP(K) do { run_phase<K>(lds, l); if (PROBE_REP == K) { __syncthreads(); run_phase<K>(lds, l); } } while (0)
    for (int l = 0; l < 2; ++l) {
        if (l == 0) { RUNP(1); grid_sync(lds); }
        RUNP(2); grid_sync(lds);
        RUNP(3);
        RUNP(4); grid_sync(lds);
        RUNP(5); grid_sync(lds);
        RUNP(6); grid_sync(lds);
        run_phase<7>(lds, l); if (PROBE_REP == 7 && l == 0) { __syncthreads(); run_phase<7>(lds, l); } grid_sync(lds);
        RUNP(8); grid_sync(lds);
        RUNP(9); grid_sync(lds);
        RUNP(10); grid_sync(lds);
        RUNP(11); if (l == 0) grid_sync(lds);
    }
#if defined(SCAN_STAMP) && SCAN_STAMP != 0
    if (blockIdx.x == 0 && hw_tid() == 0) { const unsigned long long tk = __hip_atomic_load((unsigned*)(args.ws + WS_CTL) + 2000, __ATOMIC_RELAXED, __HIP_MEMORY_SCOPE_AGENT); const unsigned long long ts = __builtin_amdgcn_s_memrealtime(); while (__builtin_amdgcn_s_memrealtime() - ts < tk) __builtin_amdgcn_s_sleep(8); }
#endif
}
#endif

extern "C" void kernel_launch(void* const* d_in, const int* in_sizes, int n_in, void* d_out, int out_size, void* d_ws, size_t ws_size, hipStream_t stream) {
    static int grid = 0;
    if (grid == 0) {
        if (n_in != 30 || in_sizes[0] != NTX * DM || out_size != NTX * DM || ws_size < WS_END) {
            fprintf(stderr, "kernel_launch: unexpected problem (n_in %d, in0 %d, out %d, ws %zu < %zu?); nothing launched\n", n_in, n_in > 0 ? in_sizes[0] : -1, out_size, ws_size, (size_t)WS_END); grid = -1; return; }
        int dev = 0, cus = 0;
        if (hipGetDevice(&dev) != hipSuccess || hipDeviceGetAttribute(&cus, hipDeviceAttributeMultiprocessorCount, dev) != hipSuccess) { grid = -1; return; }
#ifdef ONE_LAUNCH
        if (hipFuncSetAttribute((const void*)fwd, hipFuncAttributeMaxDynamicSharedMemorySize, LDS_BYTES) != hipSuccess) { fprintf(stderr, "kernel_launch: hipFuncSetAttribute failed\n"); grid = -1; return; }
#endif
        (void)hipGetLastError();
        grid = cus > 0 ? cus : 256;
        if (grid != 256 && grid != 128) { fprintf(stderr, "kernel_launch: %d CUs: the LN1/LN2 row maps need 128 or 256 workgroups\n", grid); grid = -1; return; }
    }
    if (grid < 0) return;
    if (hipMemsetAsync((char*)d_ws + WS_CTL, 0, CTL_ZERO_BYTES, stream) != hipSuccess) return;
    Args a{};
    for (int i = 0; i < 30; ++i) a.in[i] = (const float*)d_in[i];
    a.out = (float*)d_out; a.ws = (unsigned char*)d_ws; a.ph_lo = 0; a.ph_hi = 0;
#ifndef ONE_LAUNCH
    launch_ph<0>(a, grid, stream);
    for (int l = 0; l < 2; ++l) { a.ph_lo = l;
        launch_ph<1>(a, grid, stream); launch_ph<2>(a, grid, stream); launch_ph<3>(a, grid, stream); launch_ph<4>(a, grid, stream); launch_ph<5>(a, grid, stream); launch_ph<6>(a, grid, stream);
        launch_ph<7>(a, grid, stream); launch_ph<8>(a, grid, stream); launch_ph<9>(a, grid, stream); launch_ph<10>(a, grid, stream); launch_ph<11>(a, grid, stream); }
#else
    hipLaunchKernelGGL(fwd, dim3(grid), dim3(512), LDS_BYTES, stream, a);
#endif
}
```
